# Optimizing an MI355X kernel written in HIP

```python
import math
import jax
import jax.numpy as jnp
from jax import lax
import numpy as np

D_MODEL = 1024
BATCH = 2
SEQ = 16384
DEPTH = 2

HEAD_DIM = 64
ATTN_HQ = 8
ATTN_HKV = 2
ATTN_GROUP = ATTN_HQ // ATTN_HKV
WINDOW = 128
ATTN_BLOCK = 128
ROT_DIM = HEAD_DIM // 4
ROPE_THETA = 500000.0
DN_H = 4
DN_DK = 64
DN_DV = 64
DN_CONV = 4
DN_CHUNK = 64
CV_GROUPS = 4
CV_C = CV_GROUPS * HEAD_DIM
CV_K = 31
ATTN_QW = ATTN_HQ * HEAD_DIM
ATTN_KVW = ATTN_HKV * HEAD_DIM
DN_KW = DN_H * DN_DK
DN_VW = DN_H * DN_DV
D_MIX = ATTN_QW + DN_VW + CV_C
IN_SIZES = (ATTN_QW, ATTN_KVW, ATTN_KVW, DN_KW, DN_KW, DN_VW, DN_H, DN_H, DN_VW, 2 * CV_C)
N_IN = ATTN_QW + 2 * ATTN_KVW + 2 * DN_KW + 2 * DN_VW + 2 * DN_H + 2 * CV_C
D_FF = 2816
N_EXPERTS = 8
TOP_K = 2
D_FF_EXPERT = 1024
N_DENSE = (DEPTH + 1) // 2
N_MOE = DEPTH // 2
EPS = 1e-6

kernel_name = 'hymba_style_swa_deltanet_conformer_moe_adaln'


def rmsnorm(x, g):
    xf = x.astype(jnp.float32)
    y = xf * lax.rsqrt(jnp.mean(xf * xf, axis=-1, keepdims=True) + EPS)
    return (y * g.astype(jnp.float32)).astype(x.dtype)


def layernorm(x, g, b):
    xf = x.astype(jnp.float32)
    mu = jnp.mean(xf, axis=-1, keepdims=True)
    xc = xf - mu
    y = xc * lax.rsqrt(jnp.mean(xc * xc, axis=-1, keepdims=True) + EPS)
    return (y * g.astype(jnp.float32) + b.astype(jnp.float32)).astype(x.dtype)


def l2norm(x):
    return x * lax.rsqrt(jnp.sum(x * x, axis=-1, keepdims=True) + EPS)


def causal_dwconv(x, w):
    K, C = w.shape
    return lax.conv_general_dilated(x, w[:, None, :].astype(x.dtype), window_strides=(1,), padding=[(K - 1, 0)],
                                    dimension_numbers=('NWC', 'WIO', 'NWC'), feature_group_count=C)


def partial_rope(x, cos, sin):
    half = ROT_DIM // 2
    x1 = x[..., :half].astype(jnp.float32)
    x2 = x[..., half:ROT_DIM].astype(jnp.float32)
    r1 = (x1 * cos - x2 * sin).astype(x.dtype)
    r2 = (x2 * cos + x1 * sin).astype(x.dtype)
    return jnp.concatenate([r1, r2, x[..., ROT_DIM:]], axis=-1)


def swa_attention(q, k, v, sinks):
    B, S = q.shape[0], q.shape[1]
    NB = S // ATTN_BLOCK
    qb = q.reshape(B, NB, ATTN_BLOCK, ATTN_HKV, ATTN_GROUP, HEAD_DIM)

    def band(t):
        tp = jnp.pad(t, ((0, 0), (ATTN_BLOCK, 0), (0, 0), (0, 0)))
        tb = tp.reshape(B, NB + 1, ATTN_BLOCK, ATTN_HKV, HEAD_DIM)
        return jnp.concatenate([tb[:, :-1], tb[:, 1:]], axis=2)

    kb, vb = band(k), band(v)
    s = jnp.einsum('bnqhgd,bnkhd->bnhgqk', qb, kb, preferred_element_type=jnp.float32) * (HEAD_DIM ** -0.5)
    qi = jnp.arange(ATTN_BLOCK)[:, None]
    kj = jnp.arange(2 * ATTN_BLOCK)[None, :]
    diff = qi + ATTN_BLOCK - kj
    band_ok = (diff >= 0) & (diff < WINDOW)
    key_pos = jnp.arange(NB)[:, None] * ATTN_BLOCK - ATTN_BLOCK + kj
    valid = band_ok[None] & (key_pos >= 0)[:, None, :]
    s = jnp.where(valid[None, :, None, None], s, -jnp.inf)
    sink = sinks.astype(jnp.float32).reshape(1, 1, ATTN_HKV, ATTN_GROUP, 1, 1)
    m = jnp.maximum(jnp.max(s, axis=-1, keepdims=True), sink)
    p = jnp.exp(s - m)
    p = p / (jnp.sum(p, axis=-1, keepdims=True) + jnp.exp(sink - m))
    o = jnp.einsum('bnhgqk,bnkhd->bnqhgd', p.astype(v.dtype), vb)
    return o.reshape(B, S, ATTN_QW)


def gated_delta_rule(q, k, v, g, beta):
    B, S, H, DK = q.shape
    DV = v.shape[-1]
    C = DN_CHUNK
    N = S // C
    q = q * (DK ** -0.5)

    def chunk(t):
        return t.reshape(B, N, C, H, t.shape[-1]).transpose(0, 3, 1, 2, 4)

    qc, kc, vc = chunk(q), chunk(k), chunk(v)
    gc = jnp.cumsum(g.reshape(B, N, C, H).transpose(0, 3, 1, 2), axis=-1)
    bc = beta.reshape(B, N, C, H).transpose(0, 3, 1, 2)
    tril_incl = jnp.tril(jnp.ones((C, C), dtype=bool))
    strict = jnp.tril(jnp.ones((C, C), dtype=bool), -1)
    decay = jnp.exp(jnp.where(tril_incl, gc[..., :, None] - gc[..., None, :], -jnp.inf))
    kbeta = kc * bc[..., None]
    L = jnp.where(strict, jnp.einsum('bhnid,bhnjd->bhnij', kbeta, kc) * decay, 0.0)
    eye = jnp.eye(C, dtype=jnp.float32)
    T = lax.linalg.triangular_solve(eye + L, jnp.broadcast_to(eye, L.shape), left_side=True, lower=True,
                                    unit_diagonal=True)
    u = jnp.einsum('bhnij,bhnjd->bhnid', T, vc * bc[..., None])
    w = jnp.einsum('bhnij,bhnjd->bhnid', T, kbeta * jnp.exp(gc)[..., None])
    a_intra = jnp.einsum('bhnid,bhnjd->bhnij', qc, kc) * decay
    qg = qc * jnp.exp(gc)[..., None]
    kg = kc * jnp.exp(gc[..., -1:] - gc)[..., None]
    glast = jnp.exp(gc[..., -1])

    def step(state, inp):
        q_i, k_i, u_i, w_i, a_i, gl = inp
        v_new = u_i - jnp.einsum('bhck,bhkv->bhcv', w_i, state)
        o = jnp.einsum('bhck,bhkv->bhcv', q_i, state) + jnp.einsum('bhij,bhjv->bhiv', a_i, v_new)
        state = state * gl[..., None, None] + jnp.einsum('bhck,bhcv->bhkv', k_i, v_new)
        return state, o

    xs = tuple(jnp.moveaxis(t, 2, 0) for t in (qg, kg, u, w, a_intra, glast))
    s0 = jnp.zeros((B, H, DK, DV), jnp.float32)
    _, o = lax.scan(step, s0, xs)
    o = jnp.moveaxis(o, 0, 2).transpose(0, 2, 3, 1, 4)
    return o.reshape(B, S, H, DV)


def token_mixer(h, cos, sin, w_in, sinks, dn_conv_w, dn_a_log, dn_dt_bias, dn_norm_g,
                cv_dw_w, cv_dw_b, cv_ln_g, cv_ln_b, w_out):
    B, S, _ = h.shape
    f32 = jnp.float32
    proj = h @ w_in
    idx = np.cumsum(IN_SIZES)[:-1].tolist()
    aq, ak, av, dq, dk, dv, db, da, dz, cv = jnp.split(proj, idx, axis=-1)

    q = partial_rope(aq.reshape(B, S, ATTN_HQ, HEAD_DIM), cos, sin)
    k = partial_rope(ak.reshape(B, S, ATTN_HKV, HEAD_DIM), cos, sin)
    v = av.reshape(B, S, ATTN_HKV, HEAD_DIM)
    y_attn = swa_attention(q, k, v, sinks)

    qkv = jax.nn.silu(causal_dwconv(jnp.concatenate([dq, dk, dv], axis=-1), dn_conv_w))
    dq, dk, dv = jnp.split(qkv, [DN_KW, 2 * DN_KW], axis=-1)
    qd = l2norm(dq.reshape(B, S, DN_H, DN_DK).astype(f32))
    kd = l2norm(dk.reshape(B, S, DN_H, DN_DK).astype(f32))
    vd = dv.reshape(B, S, DN_H, DN_DV).astype(f32)
    beta = jax.nn.sigmoid(db.astype(f32))
    g = -jnp.exp(dn_a_log.astype(f32)) * jax.nn.softplus(da.astype(f32) + dn_dt_bias.astype(f32))
    o = gated_delta_rule(qd, kd, vd, g, beta)
    o = o * lax.rsqrt(jnp.mean(o * o, axis=-1, keepdims=True) + EPS) * dn_norm_g.astype(f32)
    o = o * jax.nn.silu(dz.reshape(B, S, DN_H, DN_DV).astype(f32))
    y_dn = o.reshape(B, S, DN_VW).astype(h.dtype)

    ca, cb = jnp.split(cv, 2, axis=-1)
    u = ca * jax.nn.sigmoid(cb)
    u = causal_dwconv(u, cv_dw_w) + cv_dw_b
    y_cv = jax.nn.silu(layernorm(u, cv_ln_g, cv_ln_b))

    return jnp.concatenate([y_attn, y_dn, y_cv], axis=-1) @ w_out


def swiglu(h, w_gate, w_up, w_down):
    return (jax.nn.silu(h @ w_gate) * (h @ w_up)) @ w_down


def moe_ffn(h, router_w, router_b, w_gate, w_up, w_down):
    B, S, D = h.shape
    t = h.reshape(B * S, D)
    logits = (t @ router_w).astype(jnp.float32) + router_b.astype(jnp.float32)
    top_v, top_i = lax.top_k(logits, TOP_K)
    top_p = jax.nn.softmax(top_v, axis=-1)
    combine = jnp.sum(jax.nn.one_hot(top_i, N_EXPERTS, dtype=jnp.float32) * top_p[..., None], axis=1)
    out = jnp.zeros_like(t)
    for e in range(N_EXPERTS):
        out = out + combine[:, e:e + 1].astype(t.dtype) * swiglu(t, w_gate[e], w_up[e], w_down[e])
    return out.reshape(B, S, D)


def modulate(x, g, shift, scale):
    return rmsnorm(x, g) * (1.0 + scale[:, None, :]) + shift[:, None, :]


def setup_inputs(seed: int = 0) -> dict:
    key = jax.random.key(seed)
    ks = jax.random.split(key, 32)
    f32 = jnp.float32

    def nrm(k, shape, s):
        return jax.random.normal(k, shape, f32) * s

    def gain(k, shape):
        return 1.0 + 0.02 * jax.random.normal(k, shape, f32)

    dt = jnp.exp(jax.random.uniform(ks[10], (DEPTH, DN_H), f32, math.log(1e-3), math.log(1e-1)))
    return {
        'x': nrm(ks[0], (BATCH, SEQ, D_MODEL), 1.0),
        'c': nrm(ks[1], (BATCH, D_MODEL), 1.0),
        'positions': jnp.broadcast_to(jnp.arange(SEQ, dtype=jnp.int32), (BATCH, SEQ)),
        'ada_w': nrm(ks[2], (DEPTH, 2, D_MODEL, 3 * D_MODEL), D_MODEL ** -0.5),
        'ada_b': nrm(ks[3], (DEPTH, 2, 3 * D_MODEL), 0.01),
        'norm_mix_g': gain(ks[4], (DEPTH, D_MODEL)),
        'norm_ffn_g': gain(ks[5], (DEPTH, D_MODEL)),
        'w_in': nrm(ks[6], (DEPTH, D_MODEL, N_IN), D_MODEL ** -0.5),
        'attn_sinks': nrm(ks[7], (DEPTH, ATTN_HQ), 0.5),
        'dn_conv_w': nrm(ks[8], (DEPTH, DN_CONV, 2 * DN_KW + DN_VW), DN_CONV ** -0.5),
        'dn_a_log': jnp.log(jax.random.uniform(ks[9], (DEPTH, DN_H), f32, 1.0, 16.0)),
        'dn_dt_bias': jnp.log(jnp.expm1(dt)),
        'dn_norm_g': gain(ks[11], (DEPTH, DN_DV)),
        'cv_dw_w': nrm(ks[12], (DEPTH, CV_K, CV_C), CV_K ** -0.5),
        'cv_dw_b': nrm(ks[13], (DEPTH, CV_C), 0.01),
        'cv_ln_g': gain(ks[14], (DEPTH, CV_C)),
        'cv_ln_b': nrm(ks[15], (DEPTH, CV_C), 0.01),
        'w_out': nrm(ks[16], (DEPTH, D_MIX, D_MODEL), D_MIX ** -0.5),
        'ffn_w_gate': nrm(ks[17], (N_DENSE, D_MODEL, D_FF), D_MODEL ** -0.5),
        'ffn_w_up': nrm(ks[18], (N_DENSE, D_MODEL, D_FF), D_MODEL ** -0.5),
        'ffn_w_down': nrm(ks[19], (N_DENSE, D_FF, D_MODEL), D_FF ** -0.5),
        'router_w': nrm(ks[20], (N_MOE, D_MODEL, N_EXPERTS), D_MODEL ** -0.5),
        'router_b': nrm(ks[21], (N_MOE, N_EXPERTS), 0.01),
        'moe_w_gate': nrm(ks[22], (N_MOE, N_EXPERTS, D_MODEL, D_FF_EXPERT), D_MODEL ** -0.5),
        'moe_w_up': nrm(ks[23], (N_MOE, N_EXPERTS, D_MODEL, D_FF_EXPERT), D_MODEL ** -0.5),
        'moe_w_down': nrm(ks[24], (N_MOE, N_EXPERTS, D_FF_EXPERT, D_MODEL), D_FF_EXPERT ** -0.5),
        'final_norm_g': gain(ks[25], (D_MODEL,)),
    }


def reference(x, c, positions, ada_w, ada_b, norm_mix_g, norm_ffn_g, w_in, attn_sinks, dn_conv_w, dn_a_log,
              dn_dt_bias, dn_norm_g, cv_dw_w, cv_dw_b, cv_ln_g, cv_ln_b, w_out, ffn_w_gate, ffn_w_up, ffn_w_down,
              router_w, router_b, moe_w_gate, moe_w_up, moe_w_down, final_norm_g):
    inv_freq = ROPE_THETA ** (-jnp.arange(0, ROT_DIM, 2, dtype=jnp.float32) / ROT_DIM)
    ang = positions.astype(jnp.float32)[..., None] * inv_freq
    cos = jnp.cos(ang)[:, :, None, :]
    sin = jnp.sin(ang)[:, :, None, :]
    c_act = jax.nn.silu(c)
    for l in range(DEPTH):
        mod = jnp.einsum('bd,kde->kbe', c_act, ada_w[l]) + ada_b[l][:, None, :]
        sh1, sc1, gt1 = jnp.split(mod[0], 3, axis=-1)
        sh2, sc2, gt2 = jnp.split(mod[1], 3, axis=-1)
        h = modulate(x, norm_mix_g[l], sh1, sc1)
        y = token_mixer(h, cos, sin, w_in[l], attn_sinks[l], dn_conv_w[l], dn_a_log[l], dn_dt_bias[l],
                        dn_norm_g[l], cv_dw_w[l], cv_dw_b[l], cv_ln_g[l], cv_ln_b[l], w_out[l])
        x = x + gt1[:, None, :] * y
        h = modulate(x, norm_ffn_g[l], sh2, sc2)
        if l % 2 == 0:
            j = l // 2
            f = swiglu(h, ffn_w_gate[j], ffn_w_up[j], ffn_w_down[j])
        else:
            j = l // 2
            f = moe_ffn(h, router_w[j], router_b[j], moe_w_gate[j], moe_w_up[j], moe_w_down[j])
        x = x + gt2[:, None, :] * f
    return rmsnorm(x, final_norm_g)
```

```cpp
#include <hip/hip_runtime.h>
#include <cstdio>
#include <cstdint>

#define LAS __attribute__((address_space(3)))
#define GAS __attribute__((address_space(1)))
typedef unsigned short bf16_t;
typedef float f32x4 __attribute__((ext_vector_type(4)));
typedef unsigned u32x2 __attribute__((ext_vector_type(2)));
typedef unsigned u32x4 __attribute__((ext_vector_type(4)));

#ifndef MK_ONE_LAUNCH
#define MK_ONE_LAUNCH 0
#endif

constexpr int BATCH = 2, SEQ = 16384, T = BATCH * SEQ, D = 1024, DEPTH = 2;
constexpr int N_IN = 2312, NP = 2304;
constexpr int C_AQ = 0, C_AK = 512, C_AV = 640, C_DQ = 768, C_DK = 1024, C_DV = 1280, C_DZ = 1536, C_CA = 1792, C_CB = 2048;
constexpr int W_DB = 1536;
constexpr int D_FF = 2816, NE = 8, D_FFE = 1024;
constexpr int WINDOW = 128, CV_K = 31, CV_C = 256, DN_CONV = 4;
constexpr float EPS = 1e-6f;
constexpr int MOE_CAP = 67584;

constexpr size_t MiB = 1u << 20;
constexpr size_t WS_CTL = 0, CTL_ZERO_BYTES = 1 * MiB;
constexpr size_t WS_MOD = 1 * MiB;
constexpr size_t WS_CS = 2 * MiB;
constexpr size_t WS_BG = 4 * MiB;
constexpr size_t WS_ROUTE = 5 * MiB;
constexpr size_t WS_POS = 6 * MiB;
constexpr size_t WS_RMAP = 7 * MiB;
constexpr size_t WS_WT = 8 * MiB;
constexpr size_t WS_H = 88 * MiB;
constexpr size_t WS_PROJ = 152 * MiB;
constexpr size_t WS_YMIX = 296 * MiB;
constexpr size_t WS_DNQKV = 360 * MiB;
constexpr size_t WS_ODN = 456 * MiB;
constexpr size_t WS_ACT = 152 * MiB;
constexpr size_t WS_ACTM = 152 * MiB;
constexpr size_t WS_YMOE = 284 * MiB;
constexpr size_t WS_END = 512 * MiB;
constexpr int CW_BAR = 4096;
constexpr int CW_MOECNT = 16384;

constexpr int NWAVES = 8, NTHREADS = 512;
constexpr int LDS_BYTES = 147456;
constexpr int MISC_OFF = 131072 + 320;

constexpr int PH_PRO = 0, PH_LAYER0 = 1, PH_PER_LAYER = 10, PH_FINAL = 21, NPH = 22;
enum { K_NORM1 = 0, K_GEMM_IN, K_DN_PREP, K_MIX, K_DN_OUT, K_GEMM_OUT, K_NORM2, K_MOE_LIST, K_FFN1, K_FFN2 };

struct Args {
    const float* x; const float* c; const int* pos; const float* ada_w; const float* ada_b; const float* nmg; const float* nfg;
    const float* w_in; const float* sinks; const float* dn_conv_w; const float* dn_a_log; const float* dn_dt_bias; const float* dn_norm_g;
    const float* cv_dw_w; const float* cv_dw_b; const float* cv_ln_g; const float* cv_ln_b; const float* w_out;
    const float* ffn_wg; const float* ffn_wu; const float* ffn_wd; const float* router_w; const float* router_b;
    const float* moe_wg; const float* moe_wu; const float* moe_wd; const float* final_g;
    float* out; unsigned char* ws; int ph_lo, ph_hi;
};

__device__ __forceinline__ float bf2f(unsigned u) { return __uint_as_float(u << 16); }
__device__ __forceinline__ unsigned f2bf(float f) { unsigned u = __float_as_uint(f); return (u + 0x7fffu + ((u >> 16) & 1u)) >> 16; }
__device__ __forceinline__ unsigned pk2(float lo, float hi) { return f2bf(lo) | (f2bf(hi) << 16); }
__device__ __forceinline__ float wave_sum(float v) {
#pragma unroll
    for (int o = 1; o < 64; o <<= 1) v += __shfl_xor(v, o);
    return v;
}
__device__ __forceinline__ float wave_max(float v) {
#pragma unroll
    for (int o = 1; o < 64; o <<= 1) v = fmaxf(v, __shfl_xor(v, o));
    return v;
}
__device__ __forceinline__ float sigmoidf_(float x) { return 1.0f / (1.0f + __expf(-x)); }
__device__ __forceinline__ float siluf_(float x) { return x / (1.0f + __expf(-x)); }
__device__ __forceinline__ float softplusf_(float x) { return fmaxf(x, 0.f) + log1pf(__expf(-fabsf(x))); }

#define XB_TMO      128
#define XB_XCNT(j)  (256  + 64 * (j))
#define XB_XSUB(j)  (1280 + 64 * (j))
#define XB_XGEN(j)  (2304 + 64 * (j))
#define XB_TOP      3328
#define XB_TOPGEN   3392
#define XCD_BAR_WORDS 3456
#define XB_SPIN_CAP (1u << 18)

__device__ __forceinline__ unsigned xb_ld(unsigned* p)              { return __hip_atomic_load(p, __ATOMIC_RELAXED, __HIP_MEMORY_SCOPE_AGENT); }
__device__ __forceinline__ unsigned xb_add(unsigned* p, unsigned v) { return __hip_atomic_fetch_add(p, v, __ATOMIC_RELAXED, __HIP_MEMORY_SCOPE_AGENT); }
__device__ __forceinline__ unsigned xb_xcc_id() { return (unsigned)__builtin_amdgcn_s_getreg((3 << 11) | 20) & 0xFu; }
#define XB_SPIN(cond, bar) do { unsigned _sp = 0; while (cond) { __builtin_amdgcn_s_sleep(1); \
    if ((++_sp & 255u) == 0u) { if (xb_ld(&(bar)[XB_TMO])) break; if (_sp > XB_SPIN_CAP) { atomicAdd(&(bar)[XB_TMO], 1u); break; } } } } while (0)

struct XcdBarrier { unsigned* bar; unsigned x; volatile LAS unsigned* st; };

__device__ __forceinline__ XcdBarrier xcd_barrier_post(unsigned* bar, volatile LAS unsigned* st) {
    XcdBarrier b; b.bar = bar; b.x = xb_xcc_id(); b.st = st;
    if (threadIdx.x == 0) (void)xb_add(&bar[XB_XCNT(b.x)], 1u);
    return b;
}
__device__ __forceinline__ void xcd_barrier_complete(unsigned* bar, unsigned x, unsigned& nloc, unsigned& nx) {
    const unsigned G = gridDim.x * gridDim.y * gridDim.z;
    unsigned sum, cnt, mine, sp = 0u;
    for (;;) {
        sum = 0u; cnt = 0u; mine = 0u;
#pragma unroll
        for (unsigned j = 0; j < 16; ++j) { const unsigned c = xb_ld(&bar[XB_XCNT(j)]); sum += c; cnt += (c > 0u) ? 1u : 0u; mine = (j == x) ? c : mine; }
        if (sum == G) break;
        __builtin_amdgcn_s_sleep(1);
        if ((++sp & 255u) == 0u) { if (xb_ld(&bar[XB_TMO])) break; if (sp > XB_SPIN_CAP) { atomicAdd(&bar[XB_TMO], 1u); break; } }
    }
    nloc = mine > 0u ? mine : 1u; nx = cnt > 0u ? cnt : 1u;
}
__device__ __forceinline__ void xcd_barrier(const XcdBarrier& b) {
    asm volatile("s_waitcnt vmcnt(0)" ::: "memory");
    __syncthreads();
    if (threadIdx.x == 0) {
        unsigned* bar = b.bar;
        __builtin_amdgcn_s_waitcnt(0);
        unsigned nloc = b.st[0], nx = b.st[1];
        if (nloc == 0u) { xcd_barrier_complete(bar, b.x, nloc, nx); b.st[0] = nloc; b.st[1] = nx; }
        const unsigned old = xb_add(&bar[XB_XSUB(b.x)], 1u);
        const unsigned gen = old / nloc;
        if (old + 1u == (gen + 1u) * nloc) {
            __builtin_amdgcn_fence(__ATOMIC_RELEASE, "agent");
            asm volatile("s_waitcnt vmcnt(0)" ::: "memory");
            const unsigned og = xb_add(&bar[XB_TOP], 1u);
            const unsigned tg = og / nx;
            if (og + 1u == (tg + 1u) * nx) xb_add(&bar[XB_TOPGEN], 1u);
            else XB_SPIN(xb_ld(&bar[XB_TOPGEN]) == tg, bar);
            __builtin_amdgcn_fence(__ATOMIC_ACQUIRE, "agent");
            xb_add(&bar[XB_XGEN(b.x)], 1u);
            asm volatile("s_waitcnt vmcnt(0)" ::: "memory");
        } else {
            XB_SPIN(xb_ld(&bar[XB_XGEN(b.x)]) == gen, bar);
            __builtin_amdgcn_fence(__ATOMIC_ACQUIRE, "agent");
            asm volatile("s_waitcnt vmcnt(0)" ::: "memory");
        }
    }
    __syncthreads();
}

struct Frame {
    LAS unsigned char* lds;
    int tid, lane, wave, gw, ngw, bid, nb;
    unsigned char* ws;
};

__device__ __forceinline__ void frame_refresh(Frame& F, const Args& a, LAS unsigned char* lds) {
    int tid = threadIdx.x; asm volatile("" : "+v"(tid));
    int bid = blockIdx.x; asm volatile("" : "+s"(bid));
    unsigned char* ws = a.ws; asm volatile("" : "+s"(ws));
    F.lds = lds; F.tid = tid; F.lane = tid & 63; F.wave = __builtin_amdgcn_readfirstlane(tid >> 6);
    F.bid = bid; F.nb = gridDim.x; F.gw = F.bid * NWAVES + F.wave; F.ngw = F.nb * NWAVES; F.ws = ws;
}
__device__ __forceinline__ void ph_pro_naive(const Args& a, Frame& F) {
    float* MOD = (float*)(F.ws + WS_MOD);
    LAS float* red = (LAS float*)F.lds;
    for (int it = F.bid; it < 4 * 48; it += F.nb) {
        const int lk = it / 48, cg = it % 48, e = cg * 64 + F.lane;
        const float* W = a.ada_w + (size_t)lk * D * 3072 + e;
        float a0 = 0.f, a1 = 0.f;
        const int d0 = F.wave * 128;
#pragma unroll 8
        for (int d = d0; d < d0 + 128; ++d) {
            const float w = W[(size_t)d * 3072];
            a0 += siluf_(a.c[d]) * w; a1 += siluf_(a.c[D + d]) * w;
        }
        red[(F.wave * 2 + 0) * 64 + F.lane] = a0; red[(F.wave * 2 + 1) * 64 + F.lane] = a1;
        __syncthreads();
        if (F.wave < 2) {
            float s = 0.f;
            for (int w = 0; w < 8; ++w) s += red[(w * 2 + F.wave) * 64 + F.lane];
            MOD[((size_t)lk * 2 + F.wave) * 3072 + e] = s + a.ada_b[lk * 3072 + e];
        }
        __syncthreads();
    }
    float* CS = (float*)(F.ws + WS_CS);
    for (int idx = F.bid * NTHREADS + F.tid; idx < T * 8; idx += F.nb * NTHREADS) {
        const int t = idx >> 3, i = idx & 7;
        const float inv = powf(500000.0f, -(float)(2 * i) / 16.0f);
        const float ang = (float)a.pos[t] * inv;
        CS[t * 16 + i] = cosf(ang); CS[t * 16 + 8 + i] = sinf(ang);
    }
}

template <int MODE>
__device__ __forceinline__ void ph_norm(const Args& a, Frame& F, int l, const float* xin, const float* gain, const float* modk  ,
                                        const float* W8, int pitch) {
    bf16_t* H = (bf16_t*)(F.ws + WS_H);
    LAS float* W8T = (LAS float*)F.lds;
    if (MODE != 0) {
        for (int i = F.tid; i < 8192; i += NTHREADS) { const int d = i >> 3, j = i & 7; W8T[j * 1024 + d] = W8[(size_t)d * pitch + j]; }
        __syncthreads();
    }
    for (int row = F.gw; row < T; row += F.ngw) {
        const int b = row / SEQ;
        const f32x4* xr = (const f32x4*)(xin + (size_t)row * D) + F.lane;
        f32x4 v[4]; float ss = 0.f;
#pragma unroll
        for (int j = 0; j < 4; ++j) { v[j] = xr[64 * j]; ss += (v[j].x * v[j].x + v[j].y * v[j].y) + (v[j].z * v[j].z + v[j].w * v[j].w); }
        const float rstd = rsqrtf(wave_sum(ss) * (1.0f / D) + EPS);
        const float* sh = modk + (size_t)b * 3072; const float* sc = sh + 1024;
        float acc[8];
#pragma unroll
        for (int e = 0; e < 8; ++e) acc[e] = 0.f;
#pragma unroll
        for (int j = 0; j < 4; ++j) {
            const int d = 256 * j + 4 * F.lane;
            const f32x4 g4 = *(const f32x4*)(gain + d), s4 = *(const f32x4*)(sc + d), h4 = *(const f32x4*)(sh + d);
            f32x4 hv = (v[j] * rstd) * g4; hv = hv * (s4 + 1.0f) + h4;
            u32x2 o; o.x = pk2(hv.x, hv.y); o.y = pk2(hv.z, hv.w);
            *(u32x2*)(H + (size_t)row * D + d) = o;
            if (MODE != 0) {
#pragma unroll
                for (int e = 0; e < 8; ++e) { const f32x4 w4 = *(const LAS f32x4*)(W8T + e * 1024 + d); acc[e] += (hv.x * w4.x + hv.y * w4.y) + (hv.z * w4.z + hv.w * w4.w); }
            }
            asm volatile("" ::: "memory");
        }
        if (MODE != 0) {
#pragma unroll
            for (int e = 0; e < 8; ++e) acc[e] = wave_sum(acc[e]);
        }
        if (MODE == 1 && F.lane == 0) {
            float* BG = (float*)(F.ws + WS_BG) + (size_t)row * 8;
#pragma unroll
            for (int h = 0; h < 4; ++h) {
                BG[h] = sigmoidf_(acc[h]);
                BG[4 + h] = -__expf(a.dn_a_log[l * 4 + h]) * softplusf_(acc[4 + h] + a.dn_dt_bias[l * 4 + h]);
            }
        }
        if (MODE == 2 && F.lane == 0) {
            float v0 = -INFINITY, v1 = -INFINITY; int e0 = 0, e1 = 0;
#pragma unroll
            for (int e = 0; e < 8; ++e) { const float lg = acc[e] + a.router_b[e]; if (lg > v0) { v1 = v0; e1 = e0; v0 = lg; e0 = e; } else if (lg > v1) { v1 = lg; e1 = e; } }
            const float ex = __expf(v1 - v0), p0 = 1.0f / (1.0f + ex), p1 = ex / (1.0f + ex);
            unsigned* cnt = (unsigned*)(F.ws + WS_CTL) + CW_MOECNT;
            const int q0 = (int)atomicAdd(cnt + 64 * e0, 1u), q1 = (int)atomicAdd(cnt + 64 * e1, 1u);
            int* R = (int*)(F.ws + WS_ROUTE) + (size_t)row * 4; R[0] = e0; R[1] = e1; ((float*)R)[2] = p0; ((float*)R)[3] = p1;
            int* P = (int*)(F.ws + WS_POS) + (size_t)row * 2; P[0] = q0; P[1] = q1;
        }
    }
    if (MODE != 0) __syncthreads();
}

template <bool DUAL, class Epi>
__device__ __forceinline__ void gemm_naive(Frame& F, const bf16_t* A, int lda, const int* rowmap, int m_base, int Mrows, int K,
                                           const float* W0, const float* W1, int ldw, int N, int skip_at, int skip, const Epi& epi) {
    LAS float* As = (LAS float*)F.lds;
    LAS float* Bs = As + 16 * 132;
    LAS float* Bs2 = Bs + 16 * 128;
    const int ntm = Mrows / 128, ntn = N / 128;
    const int ty = F.tid >> 4, tx = F.tid & 15;
    const int ar = F.tid >> 2, ak = (F.tid & 3) * 4;
    const int bk = F.tid >> 5, bc = (F.tid & 31) * 4;
    for (int tile = F.bid; tile < ntm * ntn; tile += F.nb) {
        const int tm = tile / ntn, tn = tile % ntn, m0 = m_base + tm * 128, n0 = tn * 128;
        const int wn0 = (n0 >= skip_at) ? n0 + skip : n0;
        const int arow = rowmap ? rowmap[m0 + ar] : (m0 + ar);
        const bf16_t* ap = A + (size_t)arow * lda + ak;
        float acc0[4][8], acc1[4][8];
#pragma unroll
        for (int i = 0; i < 4; ++i)
#pragma unroll
            for (int j = 0; j < 8; ++j) { acc0[i][j] = 0.f; acc1[i][j] = 0.f; }
        for (int k0 = 0; k0 < K; k0 += 16) {
            const u32x2 av = *(const u32x2*)(ap + k0);
            const f32x4 bv = *(const f32x4*)(W0 + (size_t)(k0 + bk) * ldw + wn0 + bc);
            f32x4 bv2 = (f32x4){0.f, 0.f, 0.f, 0.f};
            if (DUAL) bv2 = *(const f32x4*)(W1 + (size_t)(k0 + bk) * ldw + wn0 + bc);
            __syncthreads();
            As[(ak + 0) * 132 + ar] = bf2f(av.x & 0xffffu); As[(ak + 1) * 132 + ar] = bf2f(av.x >> 16);
            As[(ak + 2) * 132 + ar] = bf2f(av.y & 0xffffu); As[(ak + 3) * 132 + ar] = bf2f(av.y >> 16);
            *(LAS f32x4*)(Bs + bk * 128 + bc) = bv;
            if (DUAL) *(LAS f32x4*)(Bs2 + bk * 128 + bc) = bv2;
            __syncthreads();
#pragma unroll 2
            for (int kk = 0; kk < 16; ++kk) {
                const f32x4 a4 = *(const LAS f32x4*)(As + kk * 132 + ty * 4);
                const f32x4 b0 = *(const LAS f32x4*)(Bs + kk * 128 + tx * 8), b1 = *(const LAS f32x4*)(Bs + kk * 128 + tx * 8 + 4);
                const float av4[4] = {a4.x, a4.y, a4.z, a4.w};
                const float bb[8] = {b0.x, b0.y, b0.z, b0.w, b1.x, b1.y, b1.z, b1.w};
#pragma unroll
                for (int i = 0; i < 4; ++i)
#pragma unroll
                    for (int j = 0; j < 8; ++j) acc0[i][j] += av4[i] * bb[j];
                if (DUAL) {
                    const f32x4 c0 = *(const LAS f32x4*)(Bs2 + kk * 128 + tx * 8), c1 = *(const LAS f32x4*)(Bs2 + kk * 128 + tx * 8 + 4);
                    const float cc[8] = {c0.x, c0.y, c0.z, c0.w, c1.x, c1.y, c1.z, c1.w};
#pragma unroll
                    for (int i = 0; i < 4; ++i)
#pragma unroll
                        for (int j = 0; j < 8; ++j) acc1[i][j] += av4[i] * cc[j];
                }
            }
        }
#pragma unroll
        for (int i = 0; i < 4; ++i)
#pragma unroll
            for (int j = 0; j < 8; ++j) epi(m0 + ty * 4 + i, n0 + tx * 8 + j, acc0[i][j], acc1[i][j]);
    }
    __syncthreads();
}
struct EpiStoreBf16 { bf16_t* C; int ldc; __device__ __forceinline__ void operator()(int m, int n, float a0, float) const { C[(size_t)m * ldc + n] = (bf16_t)f2bf(a0); } };
struct EpiSwiglu { bf16_t* C; int ldc; __device__ __forceinline__ void operator()(int m, int n, float a0, float a1) const { C[(size_t)m * ldc + n] = (bf16_t)f2bf(siluf_(a0) * a1); } };
struct EpiResid { const float* xin; float* xout; const float* gate;   __device__ __forceinline__ void operator()(int m, int n, float a0, float) const {
    const int b = m / SEQ; xout[(size_t)m * D + n] = xin[(size_t)m * D + n] + gate[(size_t)b * 3072 + n] * a0; } };

__device__ __forceinline__ void ph_dn_prep_naive(const Args& a, Frame& F, int l) {
    const bf16_t* P = (const bf16_t*)(F.ws + WS_PROJ);
    float* Q = (float*)(F.ws + WS_DNQKV);
    const float* cw = a.dn_conv_w + (size_t)l * DN_CONV * 768;
    for (int t = F.gw; t < T; t += F.ngw) {
        const int s = t % SEQ;
#pragma unroll
        for (int j = 0; j < 12; ++j) {
            const int c = F.lane + 64 * j;
            float acc = 0.f;
#pragma unroll
            for (int k = 0; k < DN_CONV; ++k) { const int sp = s - (DN_CONV - 1) + k; if (sp >= 0) acc += cw[k * 768 + c] * bf2f(P[(size_t)(t - (DN_CONV - 1) + k) * NP + C_DQ + c]); }
            float val = siluf_(acc);
            if (j < 8) { const float n2 = wave_sum(val * val); val *= rsqrtf(n2 + EPS); if (j < 4) val *= 0.125f; }
            Q[(size_t)t * 768 + c] = val;
        }
    }
}
__device__ __forceinline__ void ph_dn_scan_naive(const Args& a, Frame& F) {
    const float* Q = (const float*)(F.ws + WS_DNQKV); const float* BG = (const float*)(F.ws + WS_BG); float* O = (float*)(F.ws + WS_ODN);
    for (int task = F.gw; task < BATCH * 4 * 64; task += F.ngw) {
        const int col = task & 63, h = (task >> 6) & 3, b = task >> 8;
        float S = 0.f;
        for (int s0 = 0; s0 < SEQ; s0 += 8) {
            float q8[8], k8[8], v8[8], b8[8], g8[8];
#pragma unroll
            for (int i = 0; i < 8; ++i) { const size_t t = (size_t)b * SEQ + s0 + i; q8[i] = Q[t * 768 + h * 64 + F.lane]; k8[i] = Q[t * 768 + 256 + h * 64 + F.lane]; v8[i] = Q[t * 768 + 512 + h * 64 + col];
                b8[i] = BG[t * 8 + h]; g8[i] = BG[t * 8 + 4 + h]; }
#pragma unroll
            for (int i = 0; i < 8; ++i) {
                const float eg = __expf(g8[i]);
                const float kS = wave_sum(k8[i] * S);
                const float dl = b8[i] * (v8[i] - eg * kS);
                S = eg * S + k8[i] * dl;
                const float o = wave_sum(q8[i] * S);
                if (F.lane == 0) O[((size_t)b * SEQ + s0 + i) * 256 + h * 64 + col] = o;
            }
        }
    }
}
__device__ __forceinline__ void ph_dn_out_naive(const Args& a, Frame& F, int l) {
    const float* O = (const float*)(F.ws + WS_ODN); const bf16_t* P = (const bf16_t*)(F.ws + WS_PROJ); bf16_t* Y = (bf16_t*)(F.ws + WS_YMIX);
    for (int task = F.gw; task < T * 4; task += F.ngw) {
        const int t = task >> 2, h = task & 3;
        const float o = O[(size_t)t * 256 + h * 64 + F.lane];
        const float ms = wave_sum(o * o) * (1.0f / 64.0f);
        const float z = bf2f(P[(size_t)t * NP + C_DZ + h * 64 + F.lane]);
        const float y = o * rsqrtf(ms + EPS) * a.dn_norm_g[l * 64 + F.lane] * siluf_(z);
        Y[(size_t)t * D + 512 + h * 64 + F.lane] = (bf16_t)f2bf(y);
    }
}
__device__ __forceinline__ float rope_lane(float x, int lane, const float* cs) {
    const float xp = __shfl(x, lane ^ 8);
    if (lane < 8) return x * cs[lane] - xp * cs[8 + lane];
    if (lane < 16) return x * cs[lane - 8] + xp * cs[lane];
    return x;
}
__device__ __forceinline__ void ph_attn_naive(const Args& a, Frame& F, int l) {
    const bf16_t* P = (const bf16_t*)(F.ws + WS_PROJ); bf16_t* Y = (bf16_t*)(F.ws + WS_YMIX); const float* CS = (const float*)(F.ws + WS_CS);
    for (int task = F.gw; task < T * 8; task += F.ngw) {
        const int t = task >> 3, hq = task & 7, hk = hq >> 2, s = t % SEQ;
        float q = bf2f(P[(size_t)t * NP + C_AQ + hq * 64 + F.lane]);
        q = rope_lane(q, F.lane, CS + (size_t)t * 16);
        float sc0 = -INFINITY, sc1 = -INFINITY;
        for (int j = 0; j < WINDOW; ++j) {
            const int sp = s - (WINDOW - 1) + j;
            if (sp < 0) continue;
            const size_t tk = (size_t)t - (WINDOW - 1) + j;
            float k = bf2f(P[tk * NP + C_AK + hk * 64 + F.lane]);
            k = rope_lane(k, F.lane, CS + tk * 16);
            const float sc = wave_sum(q * k) * 0.125f;
            if (F.lane == (j & 63)) { if (j < 64) sc0 = sc; else sc1 = sc; }
        }
        const float sink = a.sinks[l * 8 + hq];
        const float m = fmaxf(wave_max(fmaxf(sc0, sc1)), sink);
        const float p0 = __expf(sc0 - m), p1 = __expf(sc1 - m);
        const float den = wave_sum(p0 + p1) + __expf(sink - m);
        float o = 0.f;
        for (int j = 0; j < WINDOW; ++j) {
            const int sp = s - (WINDOW - 1) + j;
            if (sp < 0) continue;
            const size_t tk = (size_t)t - (WINDOW - 1) + j;
            const float p = __shfl(j < 64 ? p0 : p1, j & 63);
            o += p * bf2f(P[tk * NP + C_AV + hk * 64 + F.lane]);
        }
        Y[(size_t)t * D + hq * 64 + F.lane] = (bf16_t)f2bf(o / den);
    }
}
__device__ __forceinline__ void ph_conv_naive(const Args& a, Frame& F, int l) {
    const bf16_t* P = (const bf16_t*)(F.ws + WS_PROJ); bf16_t* Y = (bf16_t*)(F.ws + WS_YMIX);
    const float* w = a.cv_dw_w + (size_t)l * CV_K * CV_C;
    for (int t = F.gw; t < T; t += F.ngw) {
        const int s = t % SEQ, c0 = 4 * F.lane;
        f32x4 acc = *(const f32x4*)(a.cv_dw_b + l * CV_C + c0);
        for (int k = 0; k < CV_K; ++k) {
            const int sp = s - (CV_K - 1) + k;
            if (sp < 0) continue;
            const size_t tk = (size_t)t - (CV_K - 1) + k;
            const u32x2 ca = *(const u32x2*)(P + tk * NP + C_CA + c0), cb = *(const u32x2*)(P + tk * NP + C_CB + c0);
            const f32x4 w4 = *(const f32x4*)(w + k * CV_C + c0);
            acc.x += w4.x * (bf2f(ca.x & 0xffffu) * sigmoidf_(bf2f(cb.x & 0xffffu)));
            acc.y += w4.y * (bf2f(ca.x >> 16) * sigmoidf_(bf2f(cb.x >> 16)));
            acc.z += w4.z * (bf2f(ca.y & 0xffffu) * sigmoidf_(bf2f(cb.y & 0xffffu)));
            acc.w += w4.w * (bf2f(ca.y >> 16) * sigmoidf_(bf2f(cb.y >> 16)));
        }
        const float mean = wave_sum((acc.x + acc.y) + (acc.z + acc.w)) * (1.0f / CV_C);
        const f32x4 dv = acc - mean;
        const float var = wave_sum((dv.x * dv.x + dv.y * dv.y) + (dv.z * dv.z + dv.w * dv.w)) * (1.0f / CV_C);
        const float rstd = rsqrtf(var + EPS);
        const f32x4 g4 = *(const f32x4*)(a.cv_ln_g + l * CV_C + c0), b4 = *(const f32x4*)(a.cv_ln_b + l * CV_C + c0);
        const f32x4 y = (dv * rstd) * g4 + b4;
        u32x2 o; o.x = pk2(siluf_(y.x), siluf_(y.y)); o.y = pk2(siluf_(y.z), siluf_(y.w));
        *(u32x2*)(Y + (size_t)t * D + 768 + c0) = o;
    }
}
__device__ __forceinline__ void moe_bases(Frame& F, int (&base)[9], int (&cnt)[8]) {
    const unsigned* c = (const unsigned*)(F.ws + WS_CTL) + CW_MOECNT;
    int acc = 0;
#pragma unroll
    for (int e = 0; e < 8; ++e) { cnt[e] = (int)__hip_atomic_load(c + 64 * e, __ATOMIC_RELAXED, __HIP_MEMORY_SCOPE_AGENT); base[e] = acc; acc += (cnt[e] + 255) & ~255; }
    base[8] = acc;
}
__device__ __forceinline__ void moe_range(Frame& F, int e, int& lo, int& hi) {
    const unsigned* c = (const unsigned*)(F.ws + WS_CTL) + CW_MOECNT;
    int acc = 0; lo = 0; hi = 0;
#pragma unroll
    for (int k = 0; k < 8; ++k) { const int n = ((int)__hip_atomic_load(c + 64 * k, __ATOMIC_RELAXED, __HIP_MEMORY_SCOPE_AGENT) + 255) & ~255; if (k == e) { lo = acc; hi = acc + n; } acc += n; }
}
__device__ __forceinline__ void ph_moe_list(const Args& a, Frame& F) {
    int base[9], cnt[8]; moe_bases(F, base, cnt);
    int* RM = (int*)(F.ws + WS_RMAP); const int* R = (const int*)(F.ws + WS_ROUTE); const int* Pq = (const int*)(F.ws + WS_POS);
    for (int t = F.bid * NTHREADS + F.tid; t < T; t += F.nb * NTHREADS) {
        const int e0 = R[t * 4], e1 = R[t * 4 + 1];
        int b0 = 0, b1 = 0;
#pragma unroll
        for (int e = 0; e < 8; ++e) { if (e == e0) b0 = base[e]; if (e == e1) b1 = base[e]; }
        RM[b0 + Pq[t * 2]] = t; RM[b1 + Pq[t * 2 + 1]] = t;
    }
    if (F.bid == 0) {
#pragma unroll
        for (int e = 0; e < 8; ++e) { const int lo = base[e] + cnt[e], hi = base[e + 1]; for (int r = lo + F.tid; r < hi; r += NTHREADS) RM[r] = 0; }
    }
}
__device__ __forceinline__ void ph_final(const Args& a, Frame& F) {
    int base[9], cnt[8]; moe_bases(F, base, cnt);
    const float* MOD = (const float*)(F.ws + WS_MOD);
    const bf16_t* YM = (const bf16_t*)(F.ws + WS_YMOE); const int* R = (const int*)(F.ws + WS_ROUTE); const int* Pq = (const int*)(F.ws + WS_POS);
    for (int row = F.gw; row < T; row += F.ngw) {
        const int b = row / SEQ;
        const int e0 = R[row * 4], e1 = R[row * 4 + 1]; const float p0 = ((const float*)R)[row * 4 + 2], p1 = ((const float*)R)[row * 4 + 3];
        int b0 = 0, b1 = 0;
#pragma unroll
        for (int e = 0; e < 8; ++e) { if (e == e0) b0 = base[e]; if (e == e1) b1 = base[e]; }
        const size_t s0 = (size_t)(b0 + Pq[row * 2]), s1 = (size_t)(b1 + Pq[row * 2 + 1]);
        const float* gt2 = MOD + ((size_t)(1 * 2 + 1) * 2 + b) * 3072 + 2048;
        f32x4* xr = (f32x4*)(a.out + (size_t)row * D) + F.lane;
        f32x4 v[4]; float ss = 0.f;
#pragma unroll
        for (int j = 0; j < 4; ++j) {
            const int d = 256 * j + 4 * F.lane;
            const u32x2 y0 = *(const u32x2*)(YM + s0 * D + d), y1 = *(const u32x2*)(YM + s1 * D + d);
            const f32x4 g4 = *(const f32x4*)(gt2 + d);
            f32x4 f; f.x = p0 * bf2f(y0.x & 0xffffu) + p1 * bf2f(y1.x & 0xffffu); f.y = p0 * bf2f(y0.x >> 16) + p1 * bf2f(y1.x >> 16);
            f.z = p0 * bf2f(y0.y & 0xffffu) + p1 * bf2f(y1.y & 0xffffu); f.w = p0 * bf2f(y0.y >> 16) + p1 * bf2f(y1.y >> 16);
            v[j] = xr[64 * j] + g4 * f;
            ss += (v[j].x * v[j].x + v[j].y * v[j].y) + (v[j].z * v[j].z + v[j].w * v[j].w);
        }
        const float rstd = rsqrtf(wave_sum(ss) * (1.0f / D) + EPS);
#pragma unroll
        for (int j = 0; j < 4; ++j) { const f32x4 g4 = *(const f32x4*)(a.final_g + 256 * j + 4 * F.lane); xr[64 * j] = (v[j] * rstd) * g4; }
    }
}

__global__ void __launch_bounds__(NTHREADS, 2) fwd(Args a) {
    extern __shared__ __attribute__((aligned(16))) unsigned char lds_raw[];
    Frame F;
    F.lds = (LAS unsigned char*)lds_raw;
    F.tid = threadIdx.x; F.lane = F.tid & 63; F.wave = __builtin_amdgcn_readfirstlane(F.tid >> 6);
    F.bid = blockIdx.x; F.nb = gridDim.x; F.gw = F.bid * NWAVES + F.wave; F.ngw = F.nb * NWAVES; F.ws = a.ws;
    volatile LAS unsigned* MISC = (volatile LAS unsigned*)(F.lds + MISC_OFF);
    for (int u = F.tid; u < 32; u += NTHREADS) MISC[u] = 0u;
    __syncthreads();
    unsigned* ctl = (unsigned*)(a.ws + WS_CTL);
    const int lo = a.ph_lo, hi = a.ph_hi;
    const bool multi = (hi - lo) > 1;
    XcdBarrier bar; bar.bar = ctl + CW_BAR; bar.x = 0; bar.st = MISC + 8;
    if (multi) bar = xcd_barrier_post(ctl + CW_BAR, MISC + 8);
#define IN(k) (lo <= (k) && (k) < hi && (frame_refresh(F, a, (LAS unsigned char*)lds_raw), true))
#define SEAM(k) do { if (IN((k) + 1) && IN(k)) xcd_barrier(bar); } while (0)
    float* MOD = (float*)(a.ws + WS_MOD);
    bf16_t* H = (bf16_t*)(a.ws + WS_H); bf16_t* PROJ = (bf16_t*)(a.ws + WS_PROJ); bf16_t* YMIX = (bf16_t*)(a.ws + WS_YMIX);
    bf16_t* ACT = (bf16_t*)(a.ws + WS_ACT); bf16_t* ACTM = (bf16_t*)(a.ws + WS_ACTM); bf16_t* YMOE = (bf16_t*)(a.ws + WS_YMOE);

    if (IN(PH_PRO)) { ph_pro_naive(a, F); SEAM(PH_PRO); }

#define LAYER_BODY(l) {\
        const int pb = PH_LAYER0 + PH_PER_LAYER * l; \
        const float* xin = (l == 0) ? a.x : a.out; \
        const float* mod0 = MOD + (size_t)(l * 2 + 0) * 2 * 3072; const float* mod1 = MOD + (size_t)(l * 2 + 1) * 2 * 3072; \
        if (IN(pb + K_NORM1)) { ph_norm<1>(a, F, l, xin, a.nmg + l * D, mod0, a.w_in + (size_t)l * D * N_IN + W_DB, N_IN); SEAM(pb + K_NORM1); } \
        if (IN(pb + K_GEMM_IN)) { \
            EpiStoreBf16 E{PROJ, NP}; \
            gemm_naive<false>(F, H, D, nullptr, 0, T, D, a.w_in + (size_t)l * D * N_IN, nullptr, N_IN, NP, 1536, 8, E); \
            SEAM(pb + K_GEMM_IN); \
        } \
        if (IN(pb + K_DN_PREP)) { ph_dn_prep_naive(a, F, l); SEAM(pb + K_DN_PREP); } \
        if (IN(pb + K_MIX)) { ph_dn_scan_naive(a, F); ph_attn_naive(a, F, l); ph_conv_naive(a, F, l); SEAM(pb + K_MIX); } \
        if (IN(pb + K_DN_OUT)) { ph_dn_out_naive(a, F, l); SEAM(pb + K_DN_OUT); } \
        if (IN(pb + K_GEMM_OUT)) { \
            EpiResid E{xin, a.out, mod0 + 2048}; \
            gemm_naive<false>(F, YMIX, D, nullptr, 0, T, D, a.w_out + (size_t)l * D * D, nullptr, D, D, 1 << 30, 0, E); \
            SEAM(pb + K_GEMM_OUT); \
        } \
        if (l == 0) { \
            if (IN(pb + K_NORM2)) { ph_norm<0>(a, F, l, a.out, a.nfg + l * D, mod1, nullptr, 0); SEAM(pb + K_NORM2); } \
            if (IN(pb + K_MOE_LIST)) { SEAM(pb + K_MOE_LIST); } \
            if (IN(pb + K_FFN1)) { \
                EpiSwiglu E{ACT, D_FF}; \
                gemm_naive<true>(F, H, D, nullptr, 0, T, D, a.ffn_wg, a.ffn_wu, D_FF, D_FF, 1 << 30, 0, E); \
                SEAM(pb + K_FFN1); \
            } \
            if (IN(pb + K_FFN2)) { \
                EpiResid E{a.out, a.out, mod1 + 2048}; \
                gemm_naive<false>(F, ACT, D_FF, nullptr, 0, T, D_FF, a.ffn_wd, nullptr, D, D, 1 << 30, 0, E); \
                SEAM(pb + K_FFN2); \
            } \
        } else { \
            if (IN(pb + K_NORM2)) { ph_norm<2>(a, F, l, a.out, a.nfg + l * D, mod1, a.router_w, NE); SEAM(pb + K_NORM2); } \
            if (IN(pb + K_MOE_LIST)) { ph_moe_list(a, F); SEAM(pb + K_MOE_LIST); } \
            if (IN(pb + K_FFN1)) { \
                const int* RM = (const int*)(a.ws + WS_RMAP); \
                EpiSwiglu E{ACTM, D_FFE}; \
                for (int e = 0; e < NE; ++e) { int elo, ehi; moe_range(F, e, elo, ehi); \
                    gemm_naive<true>(F, H, D, RM, elo, ehi - elo, D, a.moe_wg + (size_t)e * D * D_FFE, a.moe_wu + (size_t)e * D * D_FFE, D_FFE, D_FFE, 1 << 30, 0, E); } \
                SEAM(pb + K_FFN1); \
            } \
            if (IN(pb + K_FFN2)) { \
                EpiStoreBf16 E{YMOE, D}; \
                for (int e = 0; e < NE; ++e) { int elo, ehi; moe_range(F, e, elo, ehi); \
                    gemm_naive<false>(F, ACTM, D_FFE, nullptr, elo, ehi - elo, D_FFE, a.moe_wd + (size_t)e * D_FFE * D, nullptr, D, D, 1 << 30, 0, E); } \
                SEAM(pb + K_FFN2); \
            } \
        } \
    }
    LAYER_BODY(0)
    LAYER_BODY(1)
#undef LAYER_BODY
    if (IN(PH_FINAL)) { ph_final(a, F); }
#undef IN
#undef SEAM
}

extern "C" void kernel_launch(void* const* d_in, const int* in_sizes, int n_in, void* d_out, int out_size, void* d_ws, size_t ws_size, hipStream_t stream) {
    static int grid = 0;
    if (grid == 0) {
        if (n_in != 27 || out_size != T * D || ws_size < WS_END) { fprintf(stderr, "kernel_launch: unexpected shapes n_in %d out %d ws %zu\n", n_in, out_size, ws_size); grid = -1; return; }
        int dev = 0, cus = 0, per_cu = 0;
        if (hipGetDevice(&dev) != hipSuccess || hipDeviceGetAttribute(&cus, hipDeviceAttributeMultiprocessorCount, dev) != hipSuccess) { grid = -1; return; }
        if (hipFuncSetAttribute((const void*)fwd, hipFuncAttributeMaxDynamicSharedMemorySize, LDS_BYTES) != hipSuccess) { fprintf(stderr, "kernel_launch: hipFuncSetAttribute failed\n"); grid = -1; return; }
        if (hipOccupancyMaxActiveBlocksPerMultiprocessor(&per_cu, (const void*)fwd, NTHREADS, LDS_BYTES) != hipSuccess || per_cu < 1) fprintf(stderr, "kernel_launch: occupancy query says %d\n", per_cu);
        (void)hipGetLastError();
        grid = cus;
    }
    if (grid < 0) return;
    (void)hipMemsetAsync((char*)d_ws + WS_CTL, 0, CTL_ZERO_BYTES, stream);
    Args a{};
    const void** pp = (const void**)&a;
    for (int i = 0; i < 27; ++i) pp[i] = d_in[i];
    a.out = (float*)d_out; a.ws = (unsigned char*)d_ws;
#if MK_ONE_LAUNCH
    a.ph_lo = 0; a.ph_hi = NPH;
    hipLaunchKernelGGL(fwd, dim3(grid), dim3(NTHREADS), LDS_BYTES, stream, a);
#else
    static const int phases[] = {0, 1, 2, 3, 4, 5, 6, 7, 9, 10, 11, 12, 13, 14, 15, 16, 17, 18, 19, 20, 21};
    for (int p : phases) { a.ph_lo = p; a.ph_hi = p + 1; hipLaunchKernelGGL(fwd, dim3(grid), dim3(NTHREADS), LDS_BYTES, stream, a); }
#endif
}
```

```cpp
#include <hip/hip_runtime.h>
#include <cstdio>
#include <cstdint>

#define LAS __attribute__((address_space(3)))
#define GAS __attribute__((address_space(1)))
typedef unsigned short bf16_t;
typedef float f32x4 __attribute__((ext_vector_type(4)));
typedef unsigned u32x2 __attribute__((ext_vector_type(2)));
typedef unsigned u32x4 __attribute__((ext_vector_type(4)));

#ifndef MK_ONE_LAUNCH
#define MK_ONE_LAUNCH 1
#endif

constexpr int BATCH = 2, SEQ = 16384, T = BATCH * SEQ, D = 1024, DEPTH = 2;
constexpr int N_IN = 2312, NP = 2304;
constexpr int C_AQ = 0, C_AK = 512, C_AV = 640, C_DQ = 768, C_DK = 1024, C_DV = 1280, C_DZ = 1536, C_CA = 1792, C_CB = 2048;
constexpr int W_DB = 1536;
constexpr int D_FF = 2816, NE = 8, D_FFE = 1024;
constexpr int WINDOW = 128, CV_K = 31, CV_C = 256, DN_CONV = 4;
constexpr float EPS = 1e-6f;
constexpr int MOE_CAP = 67584;

constexpr size_t MiB = 1u << 20;
constexpr size_t WS_CTL = 0, CTL_ZERO_BYTES = 1 * MiB;
constexpr size_t WS_MOD = 1 * MiB;
constexpr size_t WS_CS = 2 * MiB;
constexpr size_t WS_BG = 4 * MiB;
constexpr size_t WS_ROUTE = 5 * MiB;
constexpr size_t WS_POS = 6 * MiB;
constexpr size_t WS_RMAP = 7 * MiB;
constexpr size_t WS_WT = 8 * MiB;
constexpr size_t WS_H = 88 * MiB;
constexpr size_t WS_PROJ = 152 * MiB;
constexpr size_t WS_YMIX = 296 * MiB;
constexpr size_t WS_DNQKV = 360 * MiB;
constexpr size_t WS_ODN = 456 * MiB;
constexpr size_t WS_ACT = 152 * MiB;
constexpr size_t WS_ACTM = 152 * MiB;
constexpr size_t WS_YMOE = 284 * MiB;
constexpr size_t WS_END = 512 * MiB;
constexpr int CW_BAR = 4096;
constexpr int CW_MOECNT = 16384;

constexpr int NWAVES = 8, NTHREADS = 512;
constexpr int LDS_BYTES = 147456;
constexpr int MISC_OFF = 131072 + 320;

constexpr int PH_PRO = 0, PH_LAYER0 = 1, PH_PER_LAYER = 10, PH_FINAL = 21, NPH = 22;
enum { K_NORM1 = 0, K_GEMM_IN, K_DN_PREP, K_MIX, K_DN_OUT, K_GEMM_OUT, K_NORM2, K_MOE_LIST, K_FFN1, K_FFN2 };

struct Args {
    const float* x; const float* c; const int* pos; const float* ada_w; const float* ada_b; const float* nmg; const float* nfg;
    const float* w_in; const float* sinks; const float* dn_conv_w; const float* dn_a_log; const float* dn_dt_bias; const float* dn_norm_g;
    const float* cv_dw_w; const float* cv_dw_b; const float* cv_ln_g; const float* cv_ln_b; const float* w_out;
    const float* ffn_wg; const float* ffn_wu; const float* ffn_wd; const float* router_w; const float* router_b;
    const float* moe_wg; const float* moe_wu; const float* moe_wd; const float* final_g;
    float* out; unsigned char* ws; int ph_lo, ph_hi;
};

__device__ __forceinline__ float bf2f(unsigned u) { return __uint_as_float(u << 16); }
__device__ __forceinline__ unsigned f2bf(float f) { unsigned u = __float_as_uint(f); return (u + 0x7fffu + ((u >> 16) & 1u)) >> 16; }
__device__ __forceinline__ unsigned pk2(float lo, float hi) { return f2bf(lo) | (f2bf(hi) << 16); }
__device__ __forceinline__ float wave_sum(float v) {
#pragma unroll
    for (int o = 1; o < 64; o <<= 1) v += __shfl_xor(v, o);
    return v;
}
__device__ __forceinline__ float wave_max(float v) {
#pragma unroll
    for (int o = 1; o < 64; o <<= 1) v = fmaxf(v, __shfl_xor(v, o));
    return v;
}
__device__ __forceinline__ float sigmoidf_(float x) { return 1.0f / (1.0f + __expf(-x)); }
__device__ __forceinline__ float siluf_(float x) { return x / (1.0f + __expf(-x)); }
__device__ __forceinline__ float softplusf_(float x) { return fmaxf(x, 0.f) + log1pf(__expf(-fabsf(x))); }

#define XB_TMO      128
#define XB_XCNT(j)  (256  + 64 * (j))
#define XB_XSUB(j)  (1280 + 64 * (j))
#define XB_XGEN(j)  (2304 + 64 * (j))
#define XB_TOP      3328
#define XB_TOPGEN   3392
#define XCD_BAR_WORDS 3456
#define XB_SPIN_CAP (1u << 18)

__device__ __forceinline__ unsigned xb_ld(unsigned* p)              { return __hip_atomic_load(p, __ATOMIC_RELAXED, __HIP_MEMORY_SCOPE_AGENT); }
__device__ __forceinline__ unsigned xb_add(unsigned* p, unsigned v) { return __hip_atomic_fetch_add(p, v, __ATOMIC_RELAXED, __HIP_MEMORY_SCOPE_AGENT); }
__device__ __forceinline__ unsigned xb_xcc_id() { return (unsigned)__builtin_amdgcn_s_getreg((3 << 11) | 20) & 0xFu; }
#define XB_SPIN(cond, bar) do { unsigned _sp = 0; while (cond) { __builtin_amdgcn_s_sleep(1); \
    if ((++_sp & 255u) == 0u) { if (xb_ld(&(bar)[XB_TMO])) break; if (_sp > XB_SPIN_CAP) { atomicAdd(&(bar)[XB_TMO], 1u); break; } } } } while (0)

struct XcdBarrier { unsigned* bar; unsigned x; volatile LAS unsigned* st; };

__device__ __forceinline__ XcdBarrier xcd_barrier_post(unsigned* bar, volatile LAS unsigned* st) {
    XcdBarrier b; b.bar = bar; b.x = xb_xcc_id(); b.st = st;
    if (threadIdx.x == 0) (void)xb_add(&bar[XB_XCNT(b.x)], 1u);
    return b;
}
__device__ __forceinline__ void xcd_barrier_complete(unsigned* bar, unsigned x, unsigned& nloc, unsigned& nx) {
    const unsigned G = gridDim.x * gridDim.y * gridDim.z;
    unsigned sum, cnt, mine, sp = 0u;
    for (;;) {
        sum = 0u; cnt = 0u; mine = 0u;
#pragma unroll
        for (unsigned j = 0; j < 16; ++j) { const unsigned c = xb_ld(&bar[XB_XCNT(j)]); sum += c; cnt += (c > 0u) ? 1u : 0u; mine = (j == x) ? c : mine; }
        if (sum == G) break;
        __builtin_amdgcn_s_sleep(1);
        if ((++sp & 255u) == 0u) { if (xb_ld(&bar[XB_TMO])) break; if (sp > XB_SPIN_CAP) { atomicAdd(&bar[XB_TMO], 1u); break; } }
    }
    nloc = mine > 0u ? mine : 1u; nx = cnt > 0u ? cnt : 1u;
}
__device__ __forceinline__ void xcd_barrier(const XcdBarrier& b) {
    asm volatile("s_waitcnt vmcnt(0)" ::: "memory");
    __syncthreads();
    if (threadIdx.x == 0) {
        unsigned* bar = b.bar;
        __builtin_amdgcn_s_waitcnt(0);
        unsigned nloc = b.st[0], nx = b.st[1];
        if (nloc == 0u) { xcd_barrier_complete(bar, b.x, nloc, nx); b.st[0] = nloc; b.st[1] = nx; }
        const unsigned old = xb_add(&bar[XB_XSUB(b.x)], 1u);
        const unsigned gen = old / nloc;
        if (old + 1u == (gen + 1u) * nloc) {
            __builtin_amdgcn_fence(__ATOMIC_RELEASE, "agent");
            asm volatile("s_waitcnt vmcnt(0)" ::: "memory");
            const unsigned og = xb_add(&bar[XB_TOP], 1u);
            const unsigned tg = og / nx;
            if (og + 1u == (tg + 1u) * nx) xb_add(&bar[XB_TOPGEN], 1u);
            else XB_SPIN(xb_ld(&bar[XB_TOPGEN]) == tg, bar);
            __builtin_amdgcn_fence(__ATOMIC_ACQUIRE, "agent");
            xb_add(&bar[XB_XGEN(b.x)], 1u);
            asm volatile("s_waitcnt vmcnt(0)" ::: "memory");
        } else {
            XB_SPIN(xb_ld(&bar[XB_XGEN(b.x)]) == gen, bar);
            __builtin_amdgcn_fence(__ATOMIC_ACQUIRE, "agent");
            asm volatile("s_waitcnt vmcnt(0)" ::: "memory");
        }
    }
    __syncthreads();
}

struct Frame {
    LAS unsigned char* lds;
    int tid, lane, wave, gw, ngw, bid, nb;
    unsigned char* ws;
};

__device__ __forceinline__ void frame_refresh(Frame& F, const Args& a, LAS unsigned char* lds) {
    int tid = threadIdx.x; asm volatile("" : "+v"(tid));
    int bid = blockIdx.x; asm volatile("" : "+s"(bid));
    unsigned char* ws = a.ws; asm volatile("" : "+s"(ws));
    F.lds = lds; F.tid = tid; F.lane = tid & 63; F.wave = __builtin_amdgcn_readfirstlane(tid >> 6);
    F.bid = bid; F.nb = gridDim.x; F.gw = F.bid * NWAVES + F.wave; F.ngw = F.nb * NWAVES; F.ws = ws;
}
__device__ __forceinline__ void ph_pro_naive(const Args& a, Frame& F) {
    float* MOD = (float*)(F.ws + WS_MOD);
    LAS float* red = (LAS float*)F.lds;
    for (int it = F.bid; it < 4 * 48; it += F.nb) {
        const int lk = it / 48, cg = it % 48, e = cg * 64 + F.lane;
        const float* W = a.ada_w + (size_t)lk * D * 3072 + e;
        float a0 = 0.f, a1 = 0.f;
        const int d0 = F.wave * 128;
#pragma unroll 8
        for (int d = d0; d < d0 + 128; ++d) {
            const float w = W[(size_t)d * 3072];
            a0 += siluf_(a.c[d]) * w; a1 += siluf_(a.c[D + d]) * w;
        }
        red[(F.wave * 2 + 0) * 64 + F.lane] = a0; red[(F.wave * 2 + 1) * 64 + F.lane] = a1;
        __syncthreads();
        if (F.wave < 2) {
            float s = 0.f;
            for (int w = 0; w < 8; ++w) s += red[(w * 2 + F.wave) * 64 + F.lane];
            MOD[((size_t)lk * 2 + F.wave) * 3072 + e] = s + a.ada_b[lk * 3072 + e];
        }
        __syncthreads();
    }
    float* CS = (float*)(F.ws + WS_CS);
    for (int idx = F.bid * NTHREADS + F.tid; idx < T * 8; idx += F.nb * NTHREADS) {
        const int t = idx >> 3, i = idx & 7;
        const float inv = powf(500000.0f, -(float)(2 * i) / 16.0f);
        const float ang = (float)a.pos[t] * inv;
        CS[t * 16 + i] = cosf(ang); CS[t * 16 + 8 + i] = sinf(ang);
    }
}

template <int MODE>
__device__ __forceinline__ void ph_norm(const Args& a, Frame& F, int l, const float* xin, const float* gain, const float* modk  ,
                                        const float* W8, int pitch) {
    bf16_t* H = (bf16_t*)(F.ws + WS_H);
    LAS float* W8T = (LAS float*)F.lds;
    if (MODE != 0) {
        for (int i = F.tid; i < 8192; i += NTHREADS) { const int d = i >> 3, j = i & 7; W8T[j * 1024 + d] = W8[(size_t)d * pitch + j]; }
        __syncthreads();
    }
    for (int row = F.gw; row < T; row += F.ngw) {
        const int b = row / SEQ;
        const f32x4* xr = (const f32x4*)(xin + (size_t)row * D) + F.lane;
        f32x4 v[4]; float ss = 0.f;
#pragma unroll
        for (int j = 0; j < 4; ++j) { v[j] = xr[64 * j]; ss += (v[j].x * v[j].x + v[j].y * v[j].y) + (v[j].z * v[j].z + v[j].w * v[j].w); }
        const float rstd = rsqrtf(wave_sum(ss) * (1.0f / D) + EPS);
        const float* sh = modk + (size_t)b * 3072; const float* sc = sh + 1024;
        float acc[8];
#pragma unroll
        for (int e = 0; e < 8; ++e) acc[e] = 0.f;
#pragma unroll
        for (int j = 0; j < 4; ++j) {
            const int d = 256 * j + 4 * F.lane;
            const f32x4 g4 = *(const f32x4*)(gain + d), s4 = *(const f32x4*)(sc + d), h4 = *(const f32x4*)(sh + d);
            f32x4 hv = (v[j] * rstd) * g4; hv = hv * (s4 + 1.0f) + h4;
            u32x2 o; o.x = pk2(hv.x, hv.y); o.y = pk2(hv.z, hv.w);
            *(u32x2*)(H + (size_t)row * D + d) = o;
            if (MODE != 0) {
#pragma unroll
                for (int e = 0; e < 8; ++e) { const f32x4 w4 = *(const LAS f32x4*)(W8T + e * 1024 + d); acc[e] += (hv.x * w4.x + hv.y * w4.y) + (hv.z * w4.z + hv.w * w4.w); }
            }
            asm volatile("" ::: "memory");
        }
        if (MODE != 0) {
#pragma unroll
            for (int e = 0; e < 8; ++e) acc[e] = wave_sum(acc[e]);
        }
        if (MODE == 1 && F.lane == 0) {
            float* BG = (float*)(F.ws + WS_BG) + (size_t)row * 8;
#pragma unroll
            for (int h = 0; h < 4; ++h) {
                BG[h] = sigmoidf_(acc[h]);
                BG[4 + h] = -__expf(a.dn_a_log[l * 4 + h]) * softplusf_(acc[4 + h] + a.dn_dt_bias[l * 4 + h]);
            }
        }
        if (MODE == 2 && F.lane == 0) {
            float v0 = -INFINITY, v1 = -INFINITY; int e0 = 0, e1 = 0;
#pragma unroll
            for (int e = 0; e < 8; ++e) { const float lg = acc[e] + a.router_b[e]; if (lg > v0) { v1 = v0; e1 = e0; v0 = lg; e0 = e; } else if (lg > v1) { v1 = lg; e1 = e; } }
            const float ex = __expf(v1 - v0), p0 = 1.0f / (1.0f + ex), p1 = ex / (1.0f + ex);
            unsigned* cnt = (unsigned*)(F.ws + WS_CTL) + CW_MOECNT;
            const int q0 = (int)atomicAdd(cnt + 64 * e0, 1u), q1 = (int)atomicAdd(cnt + 64 * e1, 1u);
            int* R = (int*)(F.ws + WS_ROUTE) + (size_t)row * 4; R[0] = e0; R[1] = e1; ((float*)R)[2] = p0; ((float*)R)[3] = p1;
            int* P = (int*)(F.ws + WS_POS) + (size_t)row * 2; P[0] = q0; P[1] = q1;
        }
    }
    if (MODE != 0) __syncthreads();
}

template <bool DUAL, class Epi>
__device__ __forceinline__ void gemm_naive(Frame& F, const bf16_t* A, int lda, const int* rowmap, int m_base, int Mrows, int K,
                                           const float* W0, const float* W1, int ldw, int N, int skip_at, int skip, const Epi& epi) {
    LAS float* As = (LAS float*)F.lds;
    LAS float* Bs = As + 16 * 132;
    LAS float* Bs2 = Bs + 16 * 128;
    const int ntm = Mrows / 128, ntn = N / 128;
    const int ty = F.tid >> 4, tx = F.tid & 15;
    const int ar = F.tid >> 2, ak = (F.tid & 3) * 4;
    const int bk = F.tid >> 5, bc = (F.tid & 31) * 4;
    for (int tile = F.bid; tile < ntm * ntn; tile += F.nb) {
        const int tm = tile / ntn, tn = tile % ntn, m0 = m_base + tm * 128, n0 = tn * 128;
        const int wn0 = (n0 >= skip_at) ? n0 + skip : n0;
        const int arow = rowmap ? rowmap[m0 + ar] : (m0 + ar);
        const bf16_t* ap = A + (size_t)arow * lda + ak;
        float acc0[4][8], acc1[4][8];
#pragma unroll
        for (int i = 0; i < 4; ++i)
#pragma unroll
            for (int j = 0; j < 8; ++j) { acc0[i][j] = 0.f; acc1[i][j] = 0.f; }
        for (int k0 = 0; k0 < K; k0 += 16) {
            const u32x2 av = *(const u32x2*)(ap + k0);
            const f32x4 bv = *(const f32x4*)(W0 + (size_t)(k0 + bk) * ldw + wn0 + bc);
            f32x4 bv2 = (f32x4){0.f, 0.f, 0.f, 0.f};
            if (DUAL) bv2 = *(const f32x4*)(W1 + (size_t)(k0 + bk) * ldw + wn0 + bc);
            __syncthreads();
            As[(ak + 0) * 132 + ar] = bf2f(av.x & 0xffffu); As[(ak + 1) * 132 + ar] = bf2f(av.x >> 16);
            As[(ak + 2) * 132 + ar] = bf2f(av.y & 0xffffu); As[(ak + 3) * 132 + ar] = bf2f(av.y >> 16);
            *(LAS f32x4*)(Bs + bk * 128 + bc) = bv;
            if (DUAL) *(LAS f32x4*)(Bs2 + bk * 128 + bc) = bv2;
            __syncthreads();
#pragma unroll 2
            for (int kk = 0; kk < 16; ++kk) {
                const f32x4 a4 = *(const LAS f32x4*)(As + kk * 132 + ty * 4);
                const f32x4 b0 = *(const LAS f32x4*)(Bs + kk * 128 + tx * 8), b1 = *(const LAS f32x4*)(Bs + kk * 128 + tx * 8 + 4);
                const float av4[4] = {a4.x, a4.y, a4.z, a4.w};
                const float bb[8] = {b0.x, b0.y, b0.z, b0.w, b1.x, b1.y, b1.z, b1.w};
#pragma unroll
                for (int i = 0; i < 4; ++i)
#pragma unroll
                    for (int j = 0; j < 8; ++j) acc0[i][j] += av4[i] * bb[j];
                if (DUAL) {
                    const f32x4 c0 = *(const LAS f32x4*)(Bs2 + kk * 128 + tx * 8), c1 = *(const LAS f32x4*)(Bs2 + kk * 128 + tx * 8 + 4);
                    const float cc[8] = {c0.x, c0.y, c0.z, c0.w, c1.x, c1.y, c1.z, c1.w};
#pragma unroll
                    for (int i = 0; i < 4; ++i)
#pragma unroll
                        for (int j = 0; j < 8; ++j) acc1[i][j] += av4[i] * cc[j];
                }
            }
        }
#pragma unroll
        for (int i = 0; i < 4; ++i)
#pragma unroll
            for (int j = 0; j < 8; ++j) epi(m0 + ty * 4 + i, n0 + tx * 8 + j, acc0[i][j], acc1[i][j]);
    }
    __syncthreads();
}
struct EpiStoreBf16 { bf16_t* C; int ldc; __device__ __forceinline__ void operator()(int m, int n, float a0, float) const { C[(size_t)m * ldc + n] = (bf16_t)f2bf(a0); } };
struct EpiSwiglu { bf16_t* C; int ldc; __device__ __forceinline__ void operator()(int m, int n, float a0, float a1) const { C[(size_t)m * ldc + n] = (bf16_t)f2bf(siluf_(a0) * a1); } };
struct EpiResid { const float* xin; float* xout; const float* gate;   __device__ __forceinline__ void operator()(int m, int n, float a0, float) const {
    const int b = m / SEQ; xout[(size_t)m * D + n] = xin[(size_t)m * D + n] + gate[(size_t)b * 3072 + n] * a0; } };

__device__ __forceinline__ void ph_dn_prep_naive(const Args& a, Frame& F, int l) {
    const bf16_t* P = (const bf16_t*)(F.ws + WS_PROJ);
    float* Q = (float*)(F.ws + WS_DNQKV);
    const float* cw = a.dn_conv_w + (size_t)l * DN_CONV * 768;
    for (int t = F.gw; t < T; t += F.ngw) {
        const int s = t % SEQ;
#pragma unroll
        for (int j = 0; j < 12; ++j) {
            const int c = F.lane + 64 * j;
            float acc = 0.f;
#pragma unroll
            for (int k = 0; k < DN_CONV; ++k) { const int sp = s - (DN_CONV - 1) + k; if (sp >= 0) acc += cw[k * 768 + c] * bf2f(P[(size_t)(t - (DN_CONV - 1) + k) * NP + C_DQ + c]); }
            float val = siluf_(acc);
            if (j < 8) { const float n2 = wave_sum(val * val); val *= rsqrtf(n2 + EPS); if (j < 4) val *= 0.125f; }
            Q[(size_t)t * 768 + c] = val;
        }
    }
}
__device__ __forceinline__ void ph_dn_scan_naive(const Args& a, Frame& F) {
    const float* Q = (const float*)(F.ws + WS_DNQKV); const float* BG = (const float*)(F.ws + WS_BG); float* O = (float*)(F.ws + WS_ODN);
    for (int task = F.gw; task < BATCH * 4 * 64; task += F.ngw) {
        const int col = task & 63, h = (task >> 6) & 3, b = task >> 8;
        float S = 0.f;
        for (int s0 = 0; s0 < SEQ; s0 += 8) {
            float q8[8], k8[8], v8[8], b8[8], g8[8];
#pragma unroll
            for (int i = 0; i < 8; ++i) { const size_t t = (size_t)b * SEQ + s0 + i; q8[i] = Q[t * 768 + h * 64 + F.lane]; k8[i] = Q[t * 768 + 256 + h * 64 + F.lane]; v8[i] = Q[t * 768 + 512 + h * 64 + col];
                b8[i] = BG[t * 8 + h]; g8[i] = BG[t * 8 + 4 + h]; }
#pragma unroll
            for (int i = 0; i < 8; ++i) {
                const float eg = __expf(g8[i]);
                const float kS = wave_sum(k8[i] * S);
                const float dl = b8[i] * (v8[i] - eg * kS);
                S = eg * S + k8[i] * dl;
                const float o = wave_sum(q8[i] * S);
                if (F.lane == 0) O[((size_t)b * SEQ + s0 + i) * 256 + h * 64 + col] = o;
            }
        }
    }
}
__device__ __forceinline__ void ph_dn_out_naive(const Args& a, Frame& F, int l) {
    const float* O = (const float*)(F.ws + WS_ODN); const bf16_t* P = (const bf16_t*)(F.ws + WS_PROJ); bf16_t* Y = (bf16_t*)(F.ws + WS_YMIX);
    for (int task = F.gw; task < T * 4; task += F.ngw) {
        const int t = task >> 2, h = task & 3;
        const float o = O[(size_t)t * 256 + h * 64 + F.lane];
        const float ms = wave_sum(o * o) * (1.0f / 64.0f);
        const float z = bf2f(P[(size_t)t * NP + C_DZ + h * 64 + F.lane]);
        const float y = o * rsqrtf(ms + EPS) * a.dn_norm_g[l * 64 + F.lane] * siluf_(z);
        Y[(size_t)t * D + 512 + h * 64 + F.lane] = (bf16_t)f2bf(y);
    }
}
__device__ __forceinline__ float rope_lane(float x, int lane, const float* cs) {
    const float xp = __shfl(x, lane ^ 8);
    if (lane < 8) return x * cs[lane] - xp * cs[8 + lane];
    if (lane < 16) return x * cs[lane - 8] + xp * cs[lane];
    return x;
}
__device__ __forceinline__ void ph_attn_naive(const Args& a, Frame& F, int l) {
    const bf16_t* P = (const bf16_t*)(F.ws + WS_PROJ); bf16_t* Y = (bf16_t*)(F.ws + WS_YMIX); const float* CS = (const float*)(F.ws + WS_CS);
    for (int task = F.gw; task < T * 8; task += F.ngw) {
        const int t = task >> 3, hq = task & 7, hk = hq >> 2, s = t % SEQ;
        float q = bf2f(P[(size_t)t * NP + C_AQ + hq * 64 + F.lane]);
        q = rope_lane(q, F.lane, CS + (size_t)t * 16);
        float sc0 = -INFINITY, sc1 = -INFINITY;
        for (int j = 0; j < WINDOW; ++j) {
            const int sp = s - (WINDOW - 1) + j;
            if (sp < 0) continue;
            const size_t tk = (size_t)t - (WINDOW - 1) + j;
            float k = bf2f(P[tk * NP + C_AK + hk * 64 + F.lane]);
            k = rope_lane(k, F.lane, CS + tk * 16);
            const float sc = wave_sum(q * k) * 0.125f;
            if (F.lane == (j & 63)) { if (j < 64) sc0 = sc; else sc1 = sc; }
        }
        const float sink = a.sinks[l * 8 + hq];
        const float m = fmaxf(wave_max(fmaxf(sc0, sc1)), sink);
        const float p0 = __expf(sc0 - m), p1 = __expf(sc1 - m);
        const float den = wave_sum(p0 + p1) + __expf(sink - m);
        float o = 0.f;
        for (int j = 0; j < WINDOW; ++j) {
            const int sp = s - (WINDOW - 1) + j;
            if (sp < 0) continue;
            const size_t tk = (size_t)t - (WINDOW - 1) + j;
            const float p = __shfl(j < 64 ? p0 : p1, j & 63);
            o += p * bf2f(P[tk * NP + C_AV + hk * 64 + F.lane]);
        }
        Y[(size_t)t * D + hq * 64 + F.lane] = (bf16_t)f2bf(o / den);
    }
}
__device__ __forceinline__ void ph_conv_naive(const Args& a, Frame& F, int l) {
    const bf16_t* P = (const bf16_t*)(F.ws + WS_PROJ); bf16_t* Y = (bf16_t*)(F.ws + WS_YMIX);
    const float* w = a.cv_dw_w + (size_t)l * CV_K * CV_C;
    for (int t = F.gw; t < T; t += F.ngw) {
        const int s = t % SEQ, c0 = 4 * F.lane;
        f32x4 acc = *(const f32x4*)(a.cv_dw_b + l * CV_C + c0);
        for (int k = 0; k < CV_K; ++k) {
            const int sp = s - (CV_K - 1) + k;
            if (sp < 0) continue;
            const size_t tk = (size_t)t - (CV_K - 1) + k;
            const u32x2 ca = *(const u32x2*)(P + tk * NP + C_CA + c0), cb = *(const u32x2*)(P + tk * NP + C_CB + c0);
            const f32x4 w4 = *(const f32x4*)(w + k * CV_C + c0);
            acc.x += w4.x * (bf2f(ca.x & 0xffffu) * sigmoidf_(bf2f(cb.x & 0xffffu)));
            acc.y += w4.y * (bf2f(ca.x >> 16) * sigmoidf_(bf2f(cb.x >> 16)));
            acc.z += w4.z * (bf2f(ca.y & 0xffffu) * sigmoidf_(bf2f(cb.y & 0xffffu)));
            acc.w += w4.w * (bf2f(ca.y >> 16) * sigmoidf_(bf2f(cb.y >> 16)));
        }
        const float mean = wave_sum((acc.x + acc.y) + (acc.z + acc.w)) * (1.0f / CV_C);
        const f32x4 dv = acc - mean;
        const float var = wave_sum((dv.x * dv.x + dv.y * dv.y) + (dv.z * dv.z + dv.w * dv.w)) * (1.0f / CV_C);
        const float rstd = rsqrtf(var + EPS);
        const f32x4 g4 = *(const f32x4*)(a.cv_ln_g + l * CV_C + c0), b4 = *(const f32x4*)(a.cv_ln_b + l * CV_C + c0);
        const f32x4 y = (dv * rstd) * g4 + b4;
        u32x2 o; o.x = pk2(siluf_(y.x), siluf_(y.y)); o.y = pk2(siluf_(y.z), siluf_(y.w));
        *(u32x2*)(Y + (size_t)t * D + 768 + c0) = o;
    }
}
__device__ __forceinline__ void moe_bases(Frame& F, int (&base)[9], int (&cnt)[8]) {
    const unsigned* c = (const unsigned*)(F.ws + WS_CTL) + CW_MOECNT;
    int acc = 0;
#pragma unroll
    for (int e = 0; e < 8; ++e) { cnt[e] = (int)__hip_atomic_load(c + 64 * e, __ATOMIC_RELAXED, __HIP_MEMORY_SCOPE_AGENT); base[e] = acc; acc += (cnt[e] + 255) & ~255; }
    base[8] = acc;
}
__device__ __forceinline__ void moe_range(Frame& F, int e, int& lo, int& hi) {
    const unsigned* c = (const unsigned*)(F.ws + WS_CTL) + CW_MOECNT;
    int acc = 0; lo = 0; hi = 0;
#pragma unroll
    for (int k = 0; k < 8; ++k) { const int n = ((int)__hip_atomic_load(c + 64 * k, __ATOMIC_RELAXED, __HIP_MEMORY_SCOPE_AGENT) + 255) & ~255; if (k == e) { lo = acc; hi = acc + n; } acc += n; }
}
__device__ __forceinline__ void ph_moe_list(const Args& a, Frame& F) {
    int base[9], cnt[8]; moe_bases(F, base, cnt);
    int* RM = (int*)(F.ws + WS_RMAP); const int* R = (const int*)(F.ws + WS_ROUTE); const int* Pq = (const int*)(F.ws + WS_POS);
    for (int t = F.bid * NTHREADS + F.tid; t < T; t += F.nb * NTHREADS) {
        const int e0 = R[t * 4], e1 = R[t * 4 + 1];
        int b0 = 0, b1 = 0;
#pragma unroll
        for (int e = 0; e < 8; ++e) { if (e == e0) b0 = base[e]; if (e == e1) b1 = base[e]; }
        RM[b0 + Pq[t * 2]] = t; RM[b1 + Pq[t * 2 + 1]] = t;
    }
    if (F.bid == 0) {
#pragma unroll
        for (int e = 0; e < 8; ++e) { const int lo = base[e] + cnt[e], hi = base[e + 1]; for (int r = lo + F.tid; r < hi; r += NTHREADS) RM[r] = 0; }
    }
}
__device__ __forceinline__ void ph_final(const Args& a, Frame& F) {
    int base[9], cnt[8]; moe_bases(F, base, cnt);
    const float* MOD = (const float*)(F.ws + WS_MOD);
    const bf16_t* YM = (const bf16_t*)(F.ws + WS_YMOE); const int* R = (const int*)(F.ws + WS_ROUTE); const int* Pq = (const int*)(F.ws + WS_POS);
    for (int row = F.gw; row < T; row += F.ngw) {
        const int b = row / SEQ;
        const int e0 = R[row * 4], e1 = R[row * 4 + 1]; const float p0 = ((const float*)R)[row * 4 + 2], p1 = ((const float*)R)[row * 4 + 3];
        int b0 = 0, b1 = 0;
#pragma unroll
        for (int e = 0; e < 8; ++e) { if (e == e0) b0 = base[e]; if (e == e1) b1 = base[e]; }
        const size_t s0 = (size_t)(b0 + Pq[row * 2]), s1 = (size_t)(b1 + Pq[row * 2 + 1]);
        const float* gt2 = MOD + ((size_t)(1 * 2 + 1) * 2 + b) * 3072 + 2048;
        f32x4* xr = (f32x4*)(a.out + (size_t)row * D) + F.lane;
        f32x4 v[4]; float ss = 0.f;
#pragma unroll
        for (int j = 0; j < 4; ++j) {
            const int d = 256 * j + 4 * F.lane;
            const u32x2 y0 = *(const u32x2*)(YM + s0 * D + d), y1 = *(const u32x2*)(YM + s1 * D + d);
            const f32x4 g4 = *(const f32x4*)(gt2 + d);
            f32x4 f; f.x = p0 * bf2f(y0.x & 0xffffu) + p1 * bf2f(y1.x & 0xffffu); f.y = p0 * bf2f(y0.x >> 16) + p1 * bf2f(y1.x >> 16);
            f.z = p0 * bf2f(y0.y & 0xffffu) + p1 * bf2f(y1.y & 0xffffu); f.w = p0 * bf2f(y0.y >> 16) + p1 * bf2f(y1.y >> 16);
            v[j] = xr[64 * j] + g4 * f;
            ss += (v[j].x * v[j].x + v[j].y * v[j].y) + (v[j].z * v[j].z + v[j].w * v[j].w);
        }
        const float rstd = rsqrtf(wave_sum(ss) * (1.0f / D) + EPS);
#pragma unroll
        for (int j = 0; j < 4; ++j) { const f32x4 g4 = *(const f32x4*)(a.final_g + 256 * j + 4 * F.lane); xr[64 * j] = (v[j] * rstd) * g4; }
    }
}

__global__ void __launch_bounds__(NTHREADS, 2) fwd(Args a) {
    extern __shared__ __attribute__((aligned(16))) unsigned char lds_raw[];
    Frame F;
    F.lds = (LAS unsigned char*)lds_raw;
    F.tid = threadIdx.x; F.lane = F.tid & 63; F.wave = __builtin_amdgcn_readfirstlane(F.tid >> 6);
    F.bid = blockIdx.x; F.nb = gridDim.x; F.gw = F.bid * NWAVES + F.wave; F.ngw = F.nb * NWAVES; F.ws = a.ws;
    volatile LAS unsigned* MISC = (volatile LAS unsigned*)(F.lds + MISC_OFF);
    for (int u = F.tid; u < 32; u += NTHREADS) MISC[u] = 0u;
    __syncthreads();
    unsigned* ctl = (unsigned*)(a.ws + WS_CTL);
    const int lo = a.ph_lo, hi = a.ph_hi;
    const bool multi = (hi - lo) > 1;
    XcdBarrier bar; bar.bar = ctl + CW_BAR; bar.x = 0; bar.st = MISC + 8;
    if (multi) bar = xcd_barrier_post(ctl + CW_BAR, MISC + 8);
#define IN(k) (lo <= (k) && (k) < hi && (frame_refresh(F, a, (LAS unsigned char*)lds_raw), true))
#define SEAM(k) do { if (IN((k) + 1) && IN(k)) xcd_barrier(bar); } while (0)
    float* MOD = (float*)(a.ws + WS_MOD);
    bf16_t* H = (bf16_t*)(a.ws + WS_H); bf16_t* PROJ = (bf16_t*)(a.ws + WS_PROJ); bf16_t* YMIX = (bf16_t*)(a.ws + WS_YMIX);
    bf16_t* ACT = (bf16_t*)(a.ws + WS_ACT); bf16_t* ACTM = (bf16_t*)(a.ws + WS_ACTM); bf16_t* YMOE = (bf16_t*)(a.ws + WS_YMOE);

    if (IN(PH_PRO)) { ph_pro_naive(a, F); SEAM(PH_PRO); }

#define LAYER_BODY(l) {\
        const int pb = PH_LAYER0 + PH_PER_LAYER * l; \
        const float* xin = (l == 0) ? a.x : a.out; \
        const float* mod0 = MOD + (size_t)(l * 2 + 0) * 2 * 3072; const float* mod1 = MOD + (size_t)(l * 2 + 1) * 2 * 3072; \
        if (IN(pb + K_NORM1)) { ph_norm<1>(a, F, l, xin, a.nmg + l * D, mod0, a.w_in + (size_t)l * D * N_IN + W_DB, N_IN); SEAM(pb + K_NORM1); } \
        if (IN(pb + K_GEMM_IN)) { \
            EpiStoreBf16 E{PROJ, NP}; \
            gemm_naive<false>(F, H, D, nullptr, 0, T, D, a.w_in + (size_t)l * D * N_IN, nullptr, N_IN, NP, 1536, 8, E); \
            SEAM(pb + K_GEMM_IN); \
        } \
        if (IN(pb + K_DN_PREP)) { ph_dn_prep_naive(a, F, l); SEAM(pb + K_DN_PREP); } \
        if (IN(pb + K_MIX)) { ph_dn_scan_naive(a, F); ph_attn_naive(a, F, l); ph_conv_naive(a, F, l); SEAM(pb + K_MIX); } \
        if (IN(pb + K_DN_OUT)) { ph_dn_out_naive(a, F, l); SEAM(pb + K_DN_OUT); } \
        if (IN(pb + K_GEMM_OUT)) { \
            EpiResid E{xin, a.out, mod0 + 2048}; \
            gemm_naive<false>(F, YMIX, D, nullptr, 0, T, D, a.w_out + (size_t)l * D * D, nullptr, D, D, 1 << 30, 0, E); \
            SEAM(pb + K_GEMM_OUT); \
        } \
        if (l == 0) { \
            if (IN(pb + K_NORM2)) { ph_norm<0>(a, F, l, a.out, a.nfg + l * D, mod1, nullptr, 0); SEAM(pb + K_NORM2); } \
            if (IN(pb + K_MOE_LIST)) { SEAM(pb + K_MOE_LIST); } \
            if (IN(pb + K_FFN1)) { \
                EpiSwiglu E{ACT, D_FF}; \
                gemm_naive<true>(F, H, D, nullptr, 0, T, D, a.ffn_wg, a.ffn_wu, D_FF, D_FF, 1 << 30, 0, E); \
                SEAM(pb + K_FFN1); \
            } \
            if (IN(pb + K_FFN2)) { \
                EpiResid E{a.out, a.out, mod1 + 2048}; \
                gemm_naive<false>(F, ACT, D_FF, nullptr, 0, T, D_FF, a.ffn_wd, nullptr, D, D, 1 << 30, 0, E); \
                SEAM(pb + K_FFN2); \
            } \
        } else { \
            if (IN(pb + K_NORM2)) { ph_norm<2>(a, F, l, a.out, a.nfg + l * D, mod1, a.router_w, NE); SEAM(pb + K_NORM2); } \
            if (IN(pb + K_MOE_LIST)) { ph_moe_list(a, F); SEAM(pb + K_MOE_LIST); } \
            if (IN(pb + K_FFN1)) { \
                const int* RM = (const int*)(a.ws + WS_RMAP); \
                EpiSwiglu E{ACTM, D_FFE}; \
                for (int e = 0; e < NE; ++e) { int elo, ehi; moe_range(F, e, elo, ehi); \
                    gemm_naive<true>(F, H, D, RM, elo, ehi - elo, D, a.moe_wg + (size_t)e * D * D_FFE, a.moe_wu + (size_t)e * D * D_FFE, D_FFE, D_FFE, 1 << 30, 0, E); } \
                SEAM(pb + K_FFN1); \
            } \
            if (IN(pb + K_FFN2)) { \
                EpiStoreBf16 E{YMOE, D}; \
                for (int e = 0; e < NE; ++e) { int elo, ehi; moe_range(F, e, elo, ehi); \
                    gemm_naive<false>(F, ACTM, D_FFE, nullptr, elo, ehi - elo, D_FFE, a.moe_wd + (size_t)e * D_FFE * D, nullptr, D, D, 1 << 30, 0, E); } \
                SEAM(pb + K_FFN2); \
            } \
        } \
    }
    LAYER_BODY(0)
    LAYER_BODY(1)
#undef LAYER_BODY
    if (IN(PH_FINAL)) { ph_final(a, F); }
#undef IN
#undef SEAM
}

extern "C" void kernel_launch(void* const* d_in, const int* in_sizes, int n_in, void* d_out, int out_size, void* d_ws, size_t ws_size, hipStream_t stream) {
    static int grid = 0;
    if (grid == 0) {
        if (n_in != 27 || out_size != T * D || ws_size < WS_END) { fprintf(stderr, "kernel_launch: unexpected shapes n_in %d out %d ws %zu\n", n_in, out_size, ws_size); grid = -1; return; }
        int dev = 0, cus = 0, per_cu = 0;
        if (hipGetDevice(&dev) != hipSuccess || hipDeviceGetAttribute(&cus, hipDeviceAttributeMultiprocessorCount, dev) != hipSuccess) { grid = -1; return; }
        if (hipFuncSetAttribute((const void*)fwd, hipFuncAttributeMaxDynamicSharedMemorySize, LDS_BYTES) != hipSuccess) { fprintf(stderr, "kernel_launch: hipFuncSetAttribute failed\n"); grid = -1; return; }
        if (hipOccupancyMaxActiveBlocksPerMultiprocessor(&per_cu, (const void*)fwd, NTHREADS, LDS_BYTES) != hipSuccess || per_cu < 1) fprintf(stderr, "kernel_launch: occupancy query says %d\n", per_cu);
        (void)hipGetLastError();
        grid = cus;
    }
    if (grid < 0) return;
    (void)hipMemsetAsync((char*)d_ws + WS_CTL, 0, CTL_ZERO_BYTES, stream);
    Args a{};
    const void** pp = (const void**)&a;
    for (int i = 0; i < 27; ++i) pp[i] = d_in[i];
    a.out = (float*)d_out; a.ws = (unsigned char*)d_ws;
#if MK_ONE_LAUNCH
    a.ph_lo = 0; a.ph_hi = NPH;
    hipLaunchKernelGGL(fwd, dim3(grid), dim3(NTHREADS), LDS_BYTES, stream, a);
#else
    static const int phases[] = {0, 1, 2, 3, 4, 5, 6, 7, 9, 10, 11, 12, 13, 14, 15, 16, 17, 18, 19, 20, 21};
    for (int p : phases) { a.ph_lo = p; a.ph_hi = p + 1; hipLaunchKernelGGL(fwd, dim3(grid), dim3(NTHREADS), LDS_BYTES, stream, a); }
#endif
}
```

```cpp
#include <hip/hip_runtime.h>
#include <cstdio>
#include <cstdint>

#define LAS __attribute__((address_space(3)))
#define GAS __attribute__((address_space(1)))
typedef unsigned short bf16_t;
typedef float f32x4 __attribute__((ext_vector_type(4)));
typedef unsigned u32x2 __attribute__((ext_vector_type(2)));
typedef unsigned u32x4 __attribute__((ext_vector_type(4)));

#ifndef GEMM_MASK
#define GEMM_MASK 63
#endif
#ifndef MK_ONE_LAUNCH
#define MK_ONE_LAUNCH 1
#endif

constexpr int BATCH = 2, SEQ = 16384, T = BATCH * SEQ, D = 1024, DEPTH = 2;
constexpr int N_IN = 2312, NP = 2304;
constexpr int C_AQ = 0, C_AK = 512, C_AV = 640, C_DQ = 768, C_DK = 1024, C_DV = 1280, C_DZ = 1536, C_CA = 1792, C_CB = 2048;
constexpr int W_DB = 1536;
constexpr int D_FF = 2816, NE = 8, D_FFE = 1024;
constexpr int WINDOW = 128, CV_K = 31, CV_C = 256, DN_CONV = 4;
constexpr float EPS = 1e-6f;
constexpr int MOE_CAP = 67584;

constexpr size_t MiB = 1u << 20;
constexpr size_t WS_CTL = 0, CTL_ZERO_BYTES = 1 * MiB;
constexpr size_t WS_MOD = 1 * MiB;
constexpr size_t WS_CS = 2 * MiB;
constexpr size_t WS_BG = 4 * MiB;
constexpr size_t WS_ROUTE = 5 * MiB;
constexpr size_t WS_POS = 6 * MiB;
constexpr size_t WS_RMAP = 7 * MiB;
constexpr size_t WS_WT = 8 * MiB;
constexpr size_t WS_H = 88 * MiB;
constexpr size_t WS_PROJ = 152 * MiB;
constexpr size_t WS_YMIX = 296 * MiB;
constexpr size_t WS_DNQKV = 360 * MiB;
constexpr size_t WS_ODN = 456 * MiB;
constexpr size_t WS_ACT = 152 * MiB;
constexpr size_t WS_ACTM = 152 * MiB;
constexpr size_t WS_YMOE = 284 * MiB;
constexpr size_t WS_END = 512 * MiB;
constexpr int CW_BAR = 4096;
constexpr int CW_MOECNT = 16384;

constexpr int NWAVES = 8, NTHREADS = 512;
constexpr int LDS_BYTES = 147456;
constexpr int MISC_OFF = 131072 + 320;
constexpr int RI_OFF = 132096;

constexpr int PH_PRO = 0, PH_LAYER0 = 1, PH_PER_LAYER = 10, PH_FINAL = 21, NPH = 22;
enum { K_NORM1 = 0, K_GEMM_IN, K_DN_PREP, K_MIX, K_DN_OUT, K_GEMM_OUT, K_NORM2, K_MOE_LIST, K_FFN1, K_FFN2 };

struct Args {
    const float* x; const float* c; const int* pos; const float* ada_w; const float* ada_b; const float* nmg; const float* nfg;
    const float* w_in; const float* sinks; const float* dn_conv_w; const float* dn_a_log; const float* dn_dt_bias; const float* dn_norm_g;
    const float* cv_dw_w; const float* cv_dw_b; const float* cv_ln_g; const float* cv_ln_b; const float* w_out;
    const float* ffn_wg; const float* ffn_wu; const float* ffn_wd; const float* router_w; const float* router_b;
    const float* moe_wg; const float* moe_wu; const float* moe_wd; const float* final_g;
    float* out; unsigned char* ws; int ph_lo, ph_hi;
};

__device__ __forceinline__ float bf2f(unsigned u) { return __uint_as_float(u << 16); }
__device__ __forceinline__ unsigned f2bf(float f) { unsigned u = __float_as_uint(f); return (u + 0x7fffu + ((u >> 16) & 1u)) >> 16; }
__device__ __forceinline__ unsigned pk2(float lo, float hi) { return f2bf(lo) | (f2bf(hi) << 16); }
__device__ __forceinline__ float wave_sum(float v) {
#pragma unroll
    for (int o = 1; o < 64; o <<= 1) v += __shfl_xor(v, o);
    return v;
}
__device__ __forceinline__ float wave_max(float v) {
#pragma unroll
    for (int o = 1; o < 64; o <<= 1) v = fmaxf(v, __shfl_xor(v, o));
    return v;
}
__device__ __forceinline__ float sigmoidf_(float x) { return 1.0f / (1.0f + __expf(-x)); }
__device__ __forceinline__ float siluf_(float x) { return x / (1.0f + __expf(-x)); }
__device__ __forceinline__ float softplusf_(float x) { return fmaxf(x, 0.f) + log1pf(__expf(-fabsf(x))); }

#define XB_TMO      128
#define XB_XCNT(j)  (256  + 64 * (j))
#define XB_XSUB(j)  (1280 + 64 * (j))
#define XB_XGEN(j)  (2304 + 64 * (j))
#define XB_TOP      3328
#define XB_TOPGEN   3392
#define XCD_BAR_WORDS 3456
#define XB_SPIN_CAP (1u << 18)

__device__ __forceinline__ unsigned xb_ld(unsigned* p)              { return __hip_atomic_load(p, __ATOMIC_RELAXED, __HIP_MEMORY_SCOPE_AGENT); }
__device__ __forceinline__ unsigned xb_add(unsigned* p, unsigned v) { return __hip_atomic_fetch_add(p, v, __ATOMIC_RELAXED, __HIP_MEMORY_SCOPE_AGENT); }
__device__ __forceinline__ unsigned xb_xcc_id() { return (unsigned)__builtin_amdgcn_s_getreg((3 << 11) | 20) & 0xFu; }
#define XB_SPIN(cond, bar) do { unsigned _sp = 0; while (cond) { __builtin_amdgcn_s_sleep(1); \
    if ((++_sp & 255u) == 0u) { if (xb_ld(&(bar)[XB_TMO])) break; if (_sp > XB_SPIN_CAP) { atomicAdd(&(bar)[XB_TMO], 1u); break; } } } } while (0)

struct XcdBarrier { unsigned* bar; unsigned x; volatile LAS unsigned* st; };

__device__ __forceinline__ XcdBarrier xcd_barrier_post(unsigned* bar, volatile LAS unsigned* st) {
    XcdBarrier b; b.bar = bar; b.x = xb_xcc_id(); b.st = st;
    if (threadIdx.x == 0) (void)xb_add(&bar[XB_XCNT(b.x)], 1u);
    return b;
}
__device__ __forceinline__ void xcd_barrier_complete(unsigned* bar, unsigned x, unsigned& nloc, unsigned& nx) {
    const unsigned G = gridDim.x * gridDim.y * gridDim.z;
    unsigned sum, cnt, mine, sp = 0u;
    for (;;) {
        sum = 0u; cnt = 0u; mine = 0u;
#pragma unroll
        for (unsigned j = 0; j < 16; ++j) { const unsigned c = xb_ld(&bar[XB_XCNT(j)]); sum += c; cnt += (c > 0u) ? 1u : 0u; mine = (j == x) ? c : mine; }
        if (sum == G) break;
        __builtin_amdgcn_s_sleep(1);
        if ((++sp & 255u) == 0u) { if (xb_ld(&bar[XB_TMO])) break; if (sp > XB_SPIN_CAP) { atomicAdd(&bar[XB_TMO], 1u); break; } }
    }
    nloc = mine > 0u ? mine : 1u; nx = cnt > 0u ? cnt : 1u;
}
__device__ __forceinline__ void xcd_barrier(const XcdBarrier& b) {
    asm volatile("s_waitcnt vmcnt(0)" ::: "memory");
    __syncthreads();
    if (threadIdx.x == 0) {
        unsigned* bar = b.bar;
        __builtin_amdgcn_s_waitcnt(0);
        unsigned nloc = b.st[0], nx = b.st[1];
        if (nloc == 0u) { xcd_barrier_complete(bar, b.x, nloc, nx); b.st[0] = nloc; b.st[1] = nx; }
        const unsigned old = xb_add(&bar[XB_XSUB(b.x)], 1u);
        const unsigned gen = old / nloc;
        if (old + 1u == (gen + 1u) * nloc) {
            __builtin_amdgcn_fence(__ATOMIC_RELEASE, "agent");
            asm volatile("s_waitcnt vmcnt(0)" ::: "memory");
            const unsigned og = xb_add(&bar[XB_TOP], 1u);
            const unsigned tg = og / nx;
            if (og + 1u == (tg + 1u) * nx) xb_add(&bar[XB_TOPGEN], 1u);
            else XB_SPIN(xb_ld(&bar[XB_TOPGEN]) == tg, bar);
            __builtin_amdgcn_fence(__ATOMIC_ACQUIRE, "agent");
            xb_add(&bar[XB_XGEN(b.x)], 1u);
            asm volatile("s_waitcnt vmcnt(0)" ::: "memory");
        } else {
            XB_SPIN(xb_ld(&bar[XB_XGEN(b.x)]) == gen, bar);
            __builtin_amdgcn_fence(__ATOMIC_ACQUIRE, "agent");
            asm volatile("s_waitcnt vmcnt(0)" ::: "memory");
        }
    }
    __syncthreads();
}

struct Frame {
    LAS unsigned char* lds;
    int tid, lane, wave, gw, ngw, bid, nb;
    unsigned char* ws;
};

__device__ __forceinline__ void frame_refresh(Frame& F, const Args& a, LAS unsigned char* lds) {
    int tid = threadIdx.x; asm volatile("" : "+v"(tid));
    int bid = blockIdx.x; asm volatile("" : "+s"(bid));
    unsigned char* ws = a.ws; asm volatile("" : "+s"(ws));
    F.lds = lds; F.tid = tid; F.lane = tid & 63; F.wave = __builtin_amdgcn_readfirstlane(tid >> 6);
    F.bid = bid; F.nb = gridDim.x; F.gw = F.bid * NWAVES + F.wave; F.ngw = F.nb * NWAVES; F.ws = ws;
}
__device__ __forceinline__ void ph_pro_naive(const Args& a, Frame& F) {
    float* MOD = (float*)(F.ws + WS_MOD);
    LAS float* red = (LAS float*)F.lds;
    for (int it = F.bid; it < 4 * 48; it += F.nb) {
        const int lk = it / 48, cg = it % 48, e = cg * 64 + F.lane;
        const float* W = a.ada_w + (size_t)lk * D * 3072 + e;
        float a0 = 0.f, a1 = 0.f;
        const int d0 = F.wave * 128;
#pragma unroll 8
        for (int d = d0; d < d0 + 128; ++d) {
            const float w = W[(size_t)d * 3072];
            a0 += siluf_(a.c[d]) * w; a1 += siluf_(a.c[D + d]) * w;
        }
        red[(F.wave * 2 + 0) * 64 + F.lane] = a0; red[(F.wave * 2 + 1) * 64 + F.lane] = a1;
        __syncthreads();
        if (F.wave < 2) {
            float s = 0.f;
            for (int w = 0; w < 8; ++w) s += red[(w * 2 + F.wave) * 64 + F.lane];
            MOD[((size_t)lk * 2 + F.wave) * 3072 + e] = s + a.ada_b[lk * 3072 + e];
        }
        __syncthreads();
    }
    float* CS = (float*)(F.ws + WS_CS);
    for (int idx = F.bid * NTHREADS + F.tid; idx < T * 8; idx += F.nb * NTHREADS) {
        const int t = idx >> 3, i = idx & 7;
        const float inv = powf(500000.0f, -(float)(2 * i) / 16.0f);
        const float ang = (float)a.pos[t] * inv;
        CS[t * 16 + i] = cosf(ang); CS[t * 16 + 8 + i] = sinf(ang);
    }
}

template <int MODE>
__device__ __forceinline__ void ph_norm(const Args& a, Frame& F, int l, const float* xin, const float* gain, const float* modk  ,
                                        const float* W8, int pitch) {
    bf16_t* H = (bf16_t*)(F.ws + WS_H);
    LAS float* W8T = (LAS float*)F.lds;
    if (MODE != 0) {
        for (int i = F.tid; i < 8192; i += NTHREADS) { const int d = i >> 3, j = i & 7; W8T[j * 1024 + d] = W8[(size_t)d * pitch + j]; }
        __syncthreads();
    }
    for (int row = F.gw; row < T; row += F.ngw) {
        const int b = row / SEQ;
        const f32x4* xr = (const f32x4*)(xin + (size_t)row * D) + F.lane;
        f32x4 v[4]; float ss = 0.f;
#pragma unroll
        for (int j = 0; j < 4; ++j) { v[j] = xr[64 * j]; ss += (v[j].x * v[j].x + v[j].y * v[j].y) + (v[j].z * v[j].z + v[j].w * v[j].w); }
        const float rstd = rsqrtf(wave_sum(ss) * (1.0f / D) + EPS);
        const float* sh = modk + (size_t)b * 3072; const float* sc = sh + 1024;
        float acc[8];
#pragma unroll
        for (int e = 0; e < 8; ++e) acc[e] = 0.f;
#pragma unroll
        for (int j = 0; j < 4; ++j) {
            const int d = 256 * j + 4 * F.lane;
            const f32x4 g4 = *(const f32x4*)(gain + d), s4 = *(const f32x4*)(sc + d), h4 = *(const f32x4*)(sh + d);
            f32x4 hv = (v[j] * rstd) * g4; hv = hv * (s4 + 1.0f) + h4;
            u32x2 o; o.x = pk2(hv.x, hv.y); o.y = pk2(hv.z, hv.w);
            *(u32x2*)(H + (size_t)row * D + d) = o;
            if (MODE != 0) {
#pragma unroll
                for (int e = 0; e < 8; ++e) { const f32x4 w4 = *(const LAS f32x4*)(W8T + e * 1024 + d); acc[e] += (hv.x * w4.x + hv.y * w4.y) + (hv.z * w4.z + hv.w * w4.w); }
            }
            asm volatile("" ::: "memory");
        }
        if (MODE != 0) {
#pragma unroll
            for (int e = 0; e < 8; ++e) acc[e] = wave_sum(acc[e]);
        }
        if (MODE == 1 && F.lane == 0) {
            float* BG = (float*)(F.ws + WS_BG) + (size_t)row * 8;
#pragma unroll
            for (int h = 0; h < 4; ++h) {
                BG[h] = sigmoidf_(acc[h]);
                BG[4 + h] = -__expf(a.dn_a_log[l * 4 + h]) * softplusf_(acc[4 + h] + a.dn_dt_bias[l * 4 + h]);
            }
        }
        if (MODE == 2 && F.lane == 0) {
            float v0 = -INFINITY, v1 = -INFINITY; int e0 = 0, e1 = 0;
#pragma unroll
            for (int e = 0; e < 8; ++e) { const float lg = acc[e] + a.router_b[e]; if (lg > v0) { v1 = v0; e1 = e0; v0 = lg; e0 = e; } else if (lg > v1) { v1 = lg; e1 = e; } }
            const float ex = __expf(v1 - v0), p0 = 1.0f / (1.0f + ex), p1 = ex / (1.0f + ex);
            unsigned* cnt = (unsigned*)(F.ws + WS_CTL) + CW_MOECNT;
            const int q0 = (int)atomicAdd(cnt + 64 * e0, 1u), q1 = (int)atomicAdd(cnt + 64 * e1, 1u);
            int* R = (int*)(F.ws + WS_ROUTE) + (size_t)row * 4; R[0] = e0; R[1] = e1; ((float*)R)[2] = p0; ((float*)R)[3] = p1;
            int* P = (int*)(F.ws + WS_POS) + (size_t)row * 2; P[0] = q0; P[1] = q1;
        }
    }
    if (MODE != 0) __syncthreads();
}

template <bool DUAL, class Epi>
__device__ __forceinline__ void gemm_naive(Frame& F, const bf16_t* A, int lda, const int* rowmap, int m_base, int Mrows, int K,
                                           const float* W0, const float* W1, int ldw, int N, int skip_at, int skip, const Epi& epi) {
    LAS float* As = (LAS float*)F.lds;
    LAS float* Bs = As + 16 * 132;
    LAS float* Bs2 = Bs + 16 * 128;
    const int ntm = Mrows / 128, ntn = N / 128;
    const int ty = F.tid >> 4, tx = F.tid & 15;
    const int ar = F.tid >> 2, ak = (F.tid & 3) * 4;
    const int bk = F.tid >> 5, bc = (F.tid & 31) * 4;
    for (int tile = F.bid; tile < ntm * ntn; tile += F.nb) {
        const int tm = tile / ntn, tn = tile % ntn, m0 = m_base + tm * 128, n0 = tn * 128;
        const int wn0 = (n0 >= skip_at) ? n0 + skip : n0;
        const int arow = rowmap ? rowmap[m0 + ar] : (m0 + ar);
        const bf16_t* ap = A + (size_t)arow * lda + ak;
        float acc0[4][8], acc1[4][8];
#pragma unroll
        for (int i = 0; i < 4; ++i)
#pragma unroll
            for (int j = 0; j < 8; ++j) { acc0[i][j] = 0.f; acc1[i][j] = 0.f; }
        for (int k0 = 0; k0 < K; k0 += 16) {
            const u32x2 av = *(const u32x2*)(ap + k0);
            const f32x4 bv = *(const f32x4*)(W0 + (size_t)(k0 + bk) * ldw + wn0 + bc);
            f32x4 bv2 = (f32x4){0.f, 0.f, 0.f, 0.f};
            if (DUAL) bv2 = *(const f32x4*)(W1 + (size_t)(k0 + bk) * ldw + wn0 + bc);
            __syncthreads();
            As[(ak + 0) * 132 + ar] = bf2f(av.x & 0xffffu); As[(ak + 1) * 132 + ar] = bf2f(av.x >> 16);
            As[(ak + 2) * 132 + ar] = bf2f(av.y & 0xffffu); As[(ak + 3) * 132 + ar] = bf2f(av.y >> 16);
            *(LAS f32x4*)(Bs + bk * 128 + bc) = bv;
            if (DUAL) *(LAS f32x4*)(Bs2 + bk * 128 + bc) = bv2;
            __syncthreads();
#pragma unroll 2
            for (int kk = 0; kk < 16; ++kk) {
                const f32x4 a4 = *(const LAS f32x4*)(As + kk * 132 + ty * 4);
                const f32x4 b0 = *(const LAS f32x4*)(Bs + kk * 128 + tx * 8), b1 = *(const LAS f32x4*)(Bs + kk * 128 + tx * 8 + 4);
                const float av4[4] = {a4.x, a4.y, a4.z, a4.w};
                const float bb[8] = {b0.x, b0.y, b0.z, b0.w, b1.x, b1.y, b1.z, b1.w};
#pragma unroll
                for (int i = 0; i < 4; ++i)
#pragma unroll
                    for (int j = 0; j < 8; ++j) acc0[i][j] += av4[i] * bb[j];
                if (DUAL) {
                    const f32x4 c0 = *(const LAS f32x4*)(Bs2 + kk * 128 + tx * 8), c1 = *(const LAS f32x4*)(Bs2 + kk * 128 + tx * 8 + 4);
                    const float cc[8] = {c0.x, c0.y, c0.z, c0.w, c1.x, c1.y, c1.z, c1.w};
#pragma unroll
                    for (int i = 0; i < 4; ++i)
#pragma unroll
                        for (int j = 0; j < 8; ++j) acc1[i][j] += av4[i] * cc[j];
                }
            }
        }
#pragma unroll
        for (int i = 0; i < 4; ++i)
#pragma unroll
            for (int j = 0; j < 8; ++j) epi(m0 + ty * 4 + i, n0 + tx * 8 + j, acc0[i][j], acc1[i][j]);
    }
    __syncthreads();
}
struct EpiStoreBf16 { bf16_t* C; int ldc; __device__ __forceinline__ void operator()(int m, int n, float a0, float) const { C[(size_t)m * ldc + n] = (bf16_t)f2bf(a0); } };
struct EpiSwiglu { bf16_t* C; int ldc; __device__ __forceinline__ void operator()(int m, int n, float a0, float a1) const { C[(size_t)m * ldc + n] = (bf16_t)f2bf(siluf_(a0) * a1); } };
struct EpiResid { const float* xin; float* xout; const float* gate;   __device__ __forceinline__ void operator()(int m, int n, float a0, float) const {
    const int b = m / SEQ; xout[(size_t)m * D + n] = xin[(size_t)m * D + n] + gate[(size_t)b * 3072 + n] * a0; } };

__device__ __forceinline__ void ph_dn_prep_naive(const Args& a, Frame& F, int l) {
    const bf16_t* P = (const bf16_t*)(F.ws + WS_PROJ);
    float* Q = (float*)(F.ws + WS_DNQKV);
    const float* cw = a.dn_conv_w + (size_t)l * DN_CONV * 768;
    for (int t = F.gw; t < T; t += F.ngw) {
        const int s = t % SEQ;
#pragma unroll
        for (int j = 0; j < 12; ++j) {
            const int c = F.lane + 64 * j;
            float acc = 0.f;
#pragma unroll
            for (int k = 0; k < DN_CONV; ++k) { const int sp = s - (DN_CONV - 1) + k; if (sp >= 0) acc += cw[k * 768 + c] * bf2f(P[(size_t)(t - (DN_CONV - 1) + k) * NP + C_DQ + c]); }
            float val = siluf_(acc);
            if (j < 8) { const float n2 = wave_sum(val * val); val *= rsqrtf(n2 + EPS); if (j < 4) val *= 0.125f; }
            Q[(size_t)t * 768 + c] = val;
        }
    }
}
__device__ __forceinline__ void ph_dn_scan_naive(const Args& a, Frame& F) {
    const float* Q = (const float*)(F.ws + WS_DNQKV); const float* BG = (const float*)(F.ws + WS_BG); float* O = (float*)(F.ws + WS_ODN);
    for (int task = F.gw; task < BATCH * 4 * 64; task += F.ngw) {
        const int col = task & 63, h = (task >> 6) & 3, b = task >> 8;
        float S = 0.f;
        for (int s0 = 0; s0 < SEQ; s0 += 8) {
            float q8[8], k8[8], v8[8], b8[8], g8[8];
#pragma unroll
            for (int i = 0; i < 8; ++i) { const size_t t = (size_t)b * SEQ + s0 + i; q8[i] = Q[t * 768 + h * 64 + F.lane]; k8[i] = Q[t * 768 + 256 + h * 64 + F.lane]; v8[i] = Q[t * 768 + 512 + h * 64 + col];
                b8[i] = BG[t * 8 + h]; g8[i] = BG[t * 8 + 4 + h]; }
#pragma unroll
            for (int i = 0; i < 8; ++i) {
                const float eg = __expf(g8[i]);
                const float kS = wave_sum(k8[i] * S);
                const float dl = b8[i] * (v8[i] - eg * kS);
                S = eg * S + k8[i] * dl;
                const float o = wave_sum(q8[i] * S);
                if (F.lane == 0) O[((size_t)b * SEQ + s0 + i) * 256 + h * 64 + col] = o;
            }
        }
    }
}
__device__ __forceinline__ void ph_dn_out_naive(const Args& a, Frame& F, int l) {
    const float* O = (const float*)(F.ws + WS_ODN); const bf16_t* P = (const bf16_t*)(F.ws + WS_PROJ); bf16_t* Y = (bf16_t*)(F.ws + WS_YMIX);
    for (int task = F.gw; task < T * 4; task += F.ngw) {
        const int t = task >> 2, h = task & 3;
        const float o = O[(size_t)t * 256 + h * 64 + F.lane];
        const float ms = wave_sum(o * o) * (1.0f / 64.0f);
        const float z = bf2f(P[(size_t)t * NP + C_DZ + h * 64 + F.lane]);
        const float y = o * rsqrtf(ms + EPS) * a.dn_norm_g[l * 64 + F.lane] * siluf_(z);
        Y[(size_t)t * D + 512 + h * 64 + F.lane] = (bf16_t)f2bf(y);
    }
}
__device__ __forceinline__ float rope_lane(float x, int lane, const float* cs) {
    const float xp = __shfl(x, lane ^ 8);
    if (lane < 8) return x * cs[lane] - xp * cs[8 + lane];
    if (lane < 16) return x * cs[lane - 8] + xp * cs[lane];
    return x;
}
__device__ __forceinline__ void ph_attn_naive(const Args& a, Frame& F, int l) {
    const bf16_t* P = (const bf16_t*)(F.ws + WS_PROJ); bf16_t* Y = (bf16_t*)(F.ws + WS_YMIX); const float* CS = (const float*)(F.ws + WS_CS);
    for (int task = F.gw; task < T * 8; task += F.ngw) {
        const int t = task >> 3, hq = task & 7, hk = hq >> 2, s = t % SEQ;
        float q = bf2f(P[(size_t)t * NP + C_AQ + hq * 64 + F.lane]);
        q = rope_lane(q, F.lane, CS + (size_t)t * 16);
        float sc0 = -INFINITY, sc1 = -INFINITY;
        for (int j = 0; j < WINDOW; ++j) {
            const int sp = s - (WINDOW - 1) + j;
            if (sp < 0) continue;
            const size_t tk = (size_t)t - (WINDOW - 1) + j;
            float k = bf2f(P[tk * NP + C_AK + hk * 64 + F.lane]);
            k = rope_lane(k, F.lane, CS + tk * 16);
            const float sc = wave_sum(q * k) * 0.125f;
            if (F.lane == (j & 63)) { if (j < 64) sc0 = sc; else sc1 = sc; }
        }
        const float sink = a.sinks[l * 8 + hq];
        const float m = fmaxf(wave_max(fmaxf(sc0, sc1)), sink);
        const float p0 = __expf(sc0 - m), p1 = __expf(sc1 - m);
        const float den = wave_sum(p0 + p1) + __expf(sink - m);
        float o = 0.f;
        for (int j = 0; j < WINDOW; ++j) {
            const int sp = s - (WINDOW - 1) + j;
            if (sp < 0) continue;
            const size_t tk = (size_t)t - (WINDOW - 1) + j;
            const float p = __shfl(j < 64 ? p0 : p1, j & 63);
            o += p * bf2f(P[tk * NP + C_AV + hk * 64 + F.lane]);
        }
        Y[(size_t)t * D + hq * 64 + F.lane] = (bf16_t)f2bf(o / den);
    }
}
__device__ __forceinline__ void ph_conv_naive(const Args& a, Frame& F, int l) {
    const bf16_t* P = (const bf16_t*)(F.ws + WS_PROJ); bf16_t* Y = (bf16_t*)(F.ws + WS_YMIX);
    const float* w = a.cv_dw_w + (size_t)l * CV_K * CV_C;
    for (int t = F.gw; t < T; t += F.ngw) {
        const int s = t % SEQ, c0 = 4 * F.lane;
        f32x4 acc = *(const f32x4*)(a.cv_dw_b + l * CV_C + c0);
        for (int k = 0; k < CV_K; ++k) {
            const int sp = s - (CV_K - 1) + k;
            if (sp < 0) continue;
            const size_t tk = (size_t)t - (CV_K - 1) + k;
            const u32x2 ca = *(const u32x2*)(P + tk * NP + C_CA + c0), cb = *(const u32x2*)(P + tk * NP + C_CB + c0);
            const f32x4 w4 = *(const f32x4*)(w + k * CV_C + c0);
            acc.x += w4.x * (bf2f(ca.x & 0xffffu) * sigmoidf_(bf2f(cb.x & 0xffffu)));
            acc.y += w4.y * (bf2f(ca.x >> 16) * sigmoidf_(bf2f(cb.x >> 16)));
            acc.z += w4.z * (bf2f(ca.y & 0xffffu) * sigmoidf_(bf2f(cb.y & 0xffffu)));
            acc.w += w4.w * (bf2f(ca.y >> 16) * sigmoidf_(bf2f(cb.y >> 16)));
        }
        const float mean = wave_sum((acc.x + acc.y) + (acc.z + acc.w)) * (1.0f / CV_C);
        const f32x4 dv = acc - mean;
        const float var = wave_sum((dv.x * dv.x + dv.y * dv.y) + (dv.z * dv.z + dv.w * dv.w)) * (1.0f / CV_C);
        const float rstd = rsqrtf(var + EPS);
        const f32x4 g4 = *(const f32x4*)(a.cv_ln_g + l * CV_C + c0), b4 = *(const f32x4*)(a.cv_ln_b + l * CV_C + c0);
        const f32x4 y = (dv * rstd) * g4 + b4;
        u32x2 o; o.x = pk2(siluf_(y.x), siluf_(y.y)); o.y = pk2(siluf_(y.z), siluf_(y.w));
        *(u32x2*)(Y + (size_t)t * D + 768 + c0) = o;
    }
}
__device__ __forceinline__ void moe_bases(Frame& F, int (&base)[9], int (&cnt)[8]) {
    const unsigned* c = (const unsigned*)(F.ws + WS_CTL) + CW_MOECNT;
    int acc = 0;
#pragma unroll
    for (int e = 0; e < 8; ++e) { cnt[e] = (int)__hip_atomic_load(c + 64 * e, __ATOMIC_RELAXED, __HIP_MEMORY_SCOPE_AGENT); base[e] = acc; acc += (cnt[e] + 255) & ~255; }
    base[8] = acc;
}
__device__ __forceinline__ void moe_range(Frame& F, int e, int& lo, int& hi) {
    const unsigned* c = (const unsigned*)(F.ws + WS_CTL) + CW_MOECNT;
    int acc = 0; lo = 0; hi = 0;
#pragma unroll
    for (int k = 0; k < 8; ++k) { const int n = ((int)__hip_atomic_load(c + 64 * k, __ATOMIC_RELAXED, __HIP_MEMORY_SCOPE_AGENT) + 255) & ~255; if (k == e) { lo = acc; hi = acc + n; } acc += n; }
}
__device__ __forceinline__ void ph_moe_list(const Args& a, Frame& F) {
    int base[9], cnt[8]; moe_bases(F, base, cnt);
    int* RM = (int*)(F.ws + WS_RMAP); const int* R = (const int*)(F.ws + WS_ROUTE); const int* Pq = (const int*)(F.ws + WS_POS);
    for (int t = F.bid * NTHREADS + F.tid; t < T; t += F.nb * NTHREADS) {
        const int e0 = R[t * 4], e1 = R[t * 4 + 1];
        int b0 = 0, b1 = 0;
#pragma unroll
        for (int e = 0; e < 8; ++e) { if (e == e0) b0 = base[e]; if (e == e1) b1 = base[e]; }
        RM[b0 + Pq[t * 2]] = t; RM[b1 + Pq[t * 2 + 1]] = t;
    }
    if (F.bid == 0) {
#pragma unroll
        for (int e = 0; e < 8; ++e) { const int lo = base[e] + cnt[e], hi = base[e + 1]; for (int r = lo + F.tid; r < hi; r += NTHREADS) RM[r] = 0; }
    }
}
__device__ __forceinline__ void ph_final(const Args& a, Frame& F) {
    int base[9], cnt[8]; moe_bases(F, base, cnt);
    const float* MOD = (const float*)(F.ws + WS_MOD);
    const bf16_t* YM = (const bf16_t*)(F.ws + WS_YMOE); const int* R = (const int*)(F.ws + WS_ROUTE); const int* Pq = (const int*)(F.ws + WS_POS);
    for (int row = F.gw; row < T; row += F.ngw) {
        const int b = row / SEQ;
        const int e0 = R[row * 4], e1 = R[row * 4 + 1]; const float p0 = ((const float*)R)[row * 4 + 2], p1 = ((const float*)R)[row * 4 + 3];
        int b0 = 0, b1 = 0;
#pragma unroll
        for (int e = 0; e < 8; ++e) { if (e == e0) b0 = base[e]; if (e == e1) b1 = base[e]; }
        const size_t s0 = (size_t)(b0 + Pq[row * 2]), s1 = (size_t)(b1 + Pq[row * 2 + 1]);
        const float* gt2 = MOD + ((size_t)(1 * 2 + 1) * 2 + b) * 3072 + 2048;
        f32x4* xr = (f32x4*)(a.out + (size_t)row * D) + F.lane;
        f32x4 v[4]; float ss = 0.f;
#pragma unroll
        for (int j = 0; j < 4; ++j) {
            const int d = 256 * j + 4 * F.lane;
            const u32x2 y0 = *(const u32x2*)(YM + s0 * D + d), y1 = *(const u32x2*)(YM + s1 * D + d);
            const f32x4 g4 = *(const f32x4*)(gt2 + d);
            f32x4 f; f.x = p0 * bf2f(y0.x & 0xffffu) + p1 * bf2f(y1.x & 0xffffu); f.y = p0 * bf2f(y0.x >> 16) + p1 * bf2f(y1.x >> 16);
            f.z = p0 * bf2f(y0.y & 0xffffu) + p1 * bf2f(y1.y & 0xffffu); f.w = p0 * bf2f(y0.y >> 16) + p1 * bf2f(y1.y >> 16);
            v[j] = xr[64 * j] + g4 * f;
            ss += (v[j].x * v[j].x + v[j].y * v[j].y) + (v[j].z * v[j].z + v[j].w * v[j].w);
        }
        const float rstd = rsqrtf(wave_sum(ss) * (1.0f / D) + EPS);
#pragma unroll
        for (int j = 0; j < 4; ++j) { const f32x4 g4 = *(const f32x4*)(a.final_g + 256 * j + 4 * F.lane); xr[64 * j] = (v[j] * rstd) * g4; }
    }
}


namespace pg8 {
typedef short bf16x8 __attribute__((ext_vector_type(8)));
constexpr int BM = 256, BK = 64, HALF = 128, HTB = HALF * BK * 2, STAGE_BYTES = 8 * HTB;
__device__ __forceinline__ int lds_byte(int r, int c) { const int st = (r >> 4) * 2 + (c >> 5), rr = r & 15, cc = c & 31, ob = rr * 64 + cc * 2; return st * 1024 + (ob ^ (((ob >> 9) & 1) << 5)); }
__device__ __forceinline__ void stage_rc(int b, int& R, int& C) { const int st = b / 1024, sb = b % 1024, swz = sb ^ (((sb >> 9) & 1) << 5); R = (st >> 1) * 16 + swz / 64; C = (st & 1) * 32 + (swz % 64) / 2; }
__device__ __forceinline__ int perm32(int rho) { const int n = rho >> 4, i = rho & 15; return 8 * (i >> 2) + 4 * n + (i & 3); }
struct Unit { int pm, pn; };
struct Gemm { const bf16_t* A; const bf16_t* Bt; int K; };
constexpr int NXCD = 8, WGM = 8;
struct StaticOrder {
    int nM, nN, nwg, G, c;
    __device__ void init(int M, int N, int G_, int c_) { nM = M / BM; nN = N / BM; nwg = nM * nN; G = G_; c = c_; }
    __device__ __forceinline__ bool next(int i, Unit& u) const {
        const long L = (long)i * G + c; if (L >= nwg) return false;
        int wgid = (int)L; { const int q = nwg / NXCD, r = nwg % NXCD, xcd = wgid % NXCD, off = wgid / NXCD; wgid = (xcd < r ? xcd * (q + 1) : r * (q + 1) + (xcd - r) * q) + off; }
        const int nig = WGM * nN, gid = wgid / nig, fm = gid * WGM, gsz = (nM - fm) < WGM ? (nM - fm) : WGM;
        u.pm = fm + ((wgid % nig) % gsz); u.pn = (wgid % nig) / gsz; return true;
    }
};
template <int NT> struct MoeOrder {
    int bt[9]; int G, c;
    __device__ __forceinline__ bool next(int i, Unit& u) const {
        const int L = i * G + c; if (L >= bt[8] * NT) return false;
        const int q = L / NT, tn = L % NT; int e = 0;
#pragma unroll
        for (int k = 1; k < 8; ++k) e += (q >= bt[k]) ? 1 : 0;
        u.pm = q; u.pn = e * NT + tn; return true;
    }
};
__device__ __forceinline__ unsigned cvt_pk_bf16(float lo, float hi) { unsigned r; asm volatile("v_cvt_pk_bf16_f32 %0, %1, %2" : "=v"(r) : "v"(lo), "v"(hi)); return r; }
__device__ __forceinline__ float fast_silu(float x) { return x * __builtin_amdgcn_rcpf(1.0f + __builtin_amdgcn_exp2f(x * -1.4426950408889634f)); }

struct EpiBf16 {
    static constexpr bool PERM = true;
    bf16_t* O; int ldc; int nmod;
    __device__ __forceinline__ void operator()(const f32x4 (&acc)[2][2][4][2], const Unit& u, int wr, int wc, int fr, int fq) const {
        const int row0 = u.pm * BM + wr * 64 + fr, col0 = (u.pn % nmod) * BM + wc * 32 + 8 * fq;
#pragma unroll
        for (int ai = 0; ai < 2; ++ai)
#pragma unroll
            for (int m = 0; m < 4; ++m) { bf16_t* rowp = O + (size_t)(row0 + ai * HALF + m * 16) * ldc + col0;
#pragma unroll
                for (int bj = 0; bj < 2; ++bj) { const f32x4 v0 = acc[ai][bj][m][0], v1 = acc[ai][bj][m][1];
                    u32x4 w; w.x = cvt_pk_bf16(v0[0], v0[1]); w.y = cvt_pk_bf16(v0[2], v0[3]); w.z = cvt_pk_bf16(v1[0], v1[1]); w.w = cvt_pk_bf16(v1[2], v1[3]);
                    *(u32x4*)(rowp + bj * HALF) = w; } }
    }
};
struct EpiSwiGLU {
    static constexpr bool PERM = true;
    bf16_t* O; int ldc; int nmod;
    __device__ __forceinline__ void operator()(const f32x4 (&acc)[2][2][4][2], const Unit& u, int wr, int wc, int fr, int fq) const {
        const int row0 = u.pm * BM + wr * 64 + fr, col0 = (u.pn % nmod) * HALF + wc * 32 + 8 * fq;
#pragma unroll
        for (int ai = 0; ai < 2; ++ai)
#pragma unroll
            for (int m = 0; m < 4; ++m) {
                const f32x4 g0 = acc[ai][0][m][0], g1 = acc[ai][0][m][1], u0 = acc[ai][1][m][0], u1 = acc[ai][1][m][1];
                u32x4 w;
                w.x = cvt_pk_bf16(fast_silu(g0[0]) * u0[0], fast_silu(g0[1]) * u0[1]); w.y = cvt_pk_bf16(fast_silu(g0[2]) * u0[2], fast_silu(g0[3]) * u0[3]);
                w.z = cvt_pk_bf16(fast_silu(g1[0]) * u1[0], fast_silu(g1[1]) * u1[1]); w.w = cvt_pk_bf16(fast_silu(g1[2]) * u1[2], fast_silu(g1[3]) * u1[3]);
                *(u32x4*)(O + (size_t)(row0 + ai * HALF + m * 16) * ldc + col0) = w; }
    }
};
struct EpiResidF32 {
    static constexpr bool PERM = false;
    const float* xin; float* xout; const float* gate;
    __device__ __forceinline__ void operator()(const f32x4 (&acc)[2][2][4][2], const Unit& u, int wr, int wc, int fr, int fq) const {
        const int row0 = u.pm * BM + wr * 64 + fr, col0 = u.pn * BM + wc * 32 + 4 * fq;
        const float* gp = gate + (size_t)((u.pm * BM) / SEQ) * 3072 + col0;
#pragma unroll
        for (int bj = 0; bj < 2; ++bj)
#pragma unroll
            for (int n = 0; n < 2; ++n) { const f32x4 g4 = *(const f32x4*)(gp + bj * HALF + n * 16);
#pragma unroll
                for (int ai = 0; ai < 2; ++ai)
#pragma unroll
                    for (int m = 0; m < 4; ++m) { const size_t off = (size_t)(row0 + ai * HALF + m * 16) * D + col0 + bj * HALF + n * 16;
                        const f32x4 x4 = *(const f32x4*)(xin + off); *(f32x4*)(xout + off) = x4 + g4 * acc[ai][bj][m][n]; } }
    }
};

template <class Epi, class Sched, bool GATHER, bool ALIGN_EPI, bool SP2>
__device__ __forceinline__ void gemm_phase(LAS unsigned char* lds, const LAS int* RI, const Gemm g, const Sched& S, const Epi& E) {
    const int tid = threadIdx.x, wid = __builtin_amdgcn_readfirstlane(tid >> 6), lane = tid & 63, wr = wid >> 2, wc = wid & 3, fr = lane & 15, fq = lane >> 4;
    const int K = g.K, nt = K / BK;
    unsigned voffB[2]; int Ra[2]; unsigned Ca2[2];
#pragma unroll
    for (int i = 0; i < 2; ++i) { int R, C; stage_rc(tid * 16 + i * 8192, R, C); const int Rb = Epi::PERM ? ((R & ~31) + perm32(R & 31)) : R;
        Ra[i] = R; Ca2[i] = (unsigned)C * 2u; voffB[i] = (unsigned)(Rb * K + C) * 2u; }
    const size_t kstep = (size_t)(BK * 2);
    const size_t hstep = (size_t)HALF * K * 2;
    const size_t tstep = 2 * hstep;
    const unsigned rowb = (unsigned)K * 2u;
    const unsigned ldsw = (unsigned)wid * 1024u;
    const int aoff = lds_byte(wr * 64 + fr, fq * 8), boff = lds_byte(wc * 32 + fr, fq * 8);
#define PG8_SA(b, h) (((b) * 2 + (h)) * HTB)
#define PG8_SB(b, h) ((4 + (b) * 2 + (h)) * HTB)
#define PG8_STAGE_B(bufoff, gbase) do { _Pragma("unroll") for (int _i = 0; _i < 2; ++_i) \
        __builtin_amdgcn_global_load_lds((const unsigned*)((const char*)(gbase) + voffB[_i]), (LAS unsigned*)(lds + (bufoff) + ldsw + _i * 8192), 16, 0, 0); } while (0)
#define PG8_STAGE_A(bufoff, kb, off) do { _Pragma("unroll") for (int _i = 0; _i < 2; ++_i) \
        __builtin_amdgcn_global_load_lds((const unsigned*)((const char*)g.A + (size_t)(kb) + (off)[_i]), (LAS unsigned*)(lds + (bufoff) + ldsw + _i * 8192), 16, 0, 0); } while (0)
#define PG8_LDA(dst, b, h) do { _Pragma("unroll") for (int m = 0; m < 4; ++m) _Pragma("unroll") for (int k = 0; k < 2; ++k) dst[m][k] = *(const LAS bf16x8*)(lds + PG8_SA(b, h) + aoff + m * 2048 + k * 1024); } while (0)
#define PG8_LDB(dst, b, h) do { _Pragma("unroll") for (int n = 0; n < 2; ++n) _Pragma("unroll") for (int k = 0; k < 2; ++k) dst[n][k] = *(const LAS bf16x8*)(lds + PG8_SB(b, h) + boff + n * 2048 + k * 1024); } while (0)
#define PG8_MMA(ai, bj, At, Bt) do { __builtin_amdgcn_s_setprio(1); _Pragma("unroll") for (int m = 0; m < 4; ++m) _Pragma("unroll") for (int n = 0; n < 2; ++n) _Pragma("unroll") for (int k = 0; k < 2; ++k) \
        acc[ai][bj][m][n] = __builtin_amdgcn_mfma_f32_16x16x32_bf16(Bt[n][k], At[m][k], acc[ai][bj][m][n], 0, 0, 0); __builtin_amdgcn_s_setprio(0); } while (0)
#define PG8_WAIT_V(n) asm volatile("s_waitcnt vmcnt(" #n ")" ::: "memory")
#define PG8_WAIT_L(n) asm volatile("s_waitcnt lgkmcnt(" #n ")" ::: "memory")
#define PG8_BAR __builtin_amdgcn_s_barrier()
#define PG8_SCHED __builtin_amdgcn_sched_barrier(0)
#define PG8_AOFFS(dst, ui_, un_) do { _Pragma("unroll") for (int _h = 0; _h < 2; ++_h) _Pragma("unroll") for (int _i = 0; _i < 2; ++_i) { \
        const unsigned _row = GATHER ? (unsigned)RI[(ui_) * 256 + _h * HALF + Ra[_i]] : (unsigned)((un_).pm * BM + _h * HALF + Ra[_i]); dst[_h][_i] = _row * rowb + Ca2[_i]; } } while (0)
    Unit cur, nxt; int ui = 0;
    if (!S.next(0, cur)) return;
    f32x4 acc[2][2][4][2];
#pragma unroll
    for (int a = 0; a < 2; ++a)
#pragma unroll
        for (int b = 0; b < 2; ++b)
#pragma unroll
            for (int m = 0; m < 4; ++m)
#pragma unroll
                for (int n = 0; n < 2; ++n) acc[a][b][m][n] = (f32x4){0.f, 0.f, 0.f, 0.f};
    bf16x8 At[4][2], B0[2][2], B1[2][2];
    unsigned cv[2][2], nv[2][2];
    PG8_AOFFS(cv, 0, cur);
    const char* cB = (const char*)g.Bt + (size_t)cur.pn * tstep;
    if constexpr (SP2) {
        PG8_STAGE_B(PG8_SB(0, 0), cB); PG8_STAGE_B(PG8_SB(0, 1), cB + hstep); PG8_STAGE_A(PG8_SA(0, 0), 0, cv[0]); PG8_STAGE_A(PG8_SA(0, 1), 0, cv[1]);
        if (wr == 1) PG8_BAR;
        PG8_WAIT_V(2); PG8_BAR;
        PG8_STAGE_B(PG8_SB(1, 0), cB + kstep); PG8_STAGE_A(PG8_SA(1, 0), kstep, cv[0]); PG8_STAGE_B(PG8_SB(1, 1), cB + hstep + kstep);
        PG8_WAIT_V(6); PG8_BAR;
    } else {
        PG8_STAGE_B(PG8_SB(0, 0), cB); PG8_STAGE_A(PG8_SA(0, 0), 0, cv[0]); PG8_STAGE_B(PG8_SB(0, 1), cB + hstep); PG8_STAGE_A(PG8_SA(0, 1), 0, cv[1]);
        if (wr == 1) PG8_BAR;
        PG8_WAIT_V(4); PG8_BAR;
        PG8_STAGE_B(PG8_SB(1, 0), cB + kstep); PG8_STAGE_A(PG8_SA(1, 0), kstep, cv[0]); PG8_STAGE_B(PG8_SB(1, 1), cB + hstep + kstep);
        PG8_WAIT_V(6); PG8_BAR;
    }
    for (;;) {
        const bool has_next = S.next(ui + 1, nxt);
        const char* nB = has_next ? (const char*)g.Bt + (size_t)nxt.pn * tstep : cB;
        if (has_next) { PG8_AOFFS(nv, ui + 1, nxt); }
        else {
#pragma unroll
            for (int h = 0; h < 2; ++h)
#pragma unroll
                for (int i = 0; i < 2; ++i) nv[h][i] = cv[h][i]; }
        for (int t = 0; t < nt; t += 2) {
            const bool last = (t == nt - 2);
            const size_t kb1 = (size_t)(t + 1) * kstep, kb2 = last ? (size_t)0 : (size_t)(t + 2) * kstep, kb3 = kb2 + kstep;
            const char* b2 = last ? nB : cB + (size_t)(t + 2) * kstep; const char* b3 = b2 + kstep;
            unsigned o2[2][2];
#pragma unroll
            for (int h = 0; h < 2; ++h)
#pragma unroll
                for (int i = 0; i < 2; ++i) o2[h][i] = last ? nv[h][i] : cv[h][i];
            if constexpr (SP2) {
            PG8_LDB(B0, 0, 0); PG8_LDB(B1, 0, 1); PG8_SCHED; PG8_LDA(At, 0, 0); PG8_STAGE_A(PG8_SA(1, 1), kb1, cv[1]);
            PG8_WAIT_V(8); PG8_WAIT_L(0); PG8_BAR; PG8_MMA(0, 0, At, B0); PG8_MMA(0, 1, At, B1); PG8_BAR; PG8_SCHED;
            PG8_LDA(At, 0, 1); PG8_STAGE_B(PG8_SB(0, 0), b2); PG8_STAGE_B(PG8_SB(0, 1), b2 + hstep); PG8_STAGE_A(PG8_SA(0, 0), kb2, o2[0]);
            PG8_WAIT_V(8); PG8_WAIT_L(0); PG8_BAR; PG8_MMA(1, 0, At, B0); PG8_MMA(1, 1, At, B1); PG8_BAR; PG8_SCHED;
            PG8_LDB(B0, 1, 0); PG8_LDB(B1, 1, 1); PG8_SCHED; PG8_LDA(At, 1, 0); PG8_STAGE_A(PG8_SA(0, 1), kb2, o2[1]);
            PG8_WAIT_V(8); PG8_WAIT_L(0); PG8_BAR; PG8_MMA(0, 0, At, B0); PG8_MMA(0, 1, At, B1); PG8_BAR; PG8_SCHED;
            PG8_LDA(At, 1, 1); PG8_STAGE_B(PG8_SB(1, 0), b3); PG8_STAGE_B(PG8_SB(1, 1), b3 + hstep); PG8_STAGE_A(PG8_SA(1, 0), kb3, o2[0]);
            PG8_WAIT_V(8); PG8_WAIT_L(0); PG8_BAR; PG8_MMA(1, 0, At, B0); PG8_MMA(1, 1, At, B1); PG8_BAR; PG8_SCHED;
            } else {
            PG8_LDB(B0, 0, 0); PG8_SCHED; PG8_LDA(At, 0, 0); PG8_STAGE_A(PG8_SA(1, 1), kb1, cv[1]);
            PG8_WAIT_L(8); PG8_BAR; PG8_WAIT_L(0); PG8_MMA(0, 0, At, B0); PG8_BAR; PG8_SCHED;
            PG8_LDB(B1, 0, 1); PG8_STAGE_B(PG8_SB(0, 0), b2);
            PG8_BAR; PG8_WAIT_L(0); PG8_MMA(0, 1, At, B1); PG8_BAR;
            PG8_LDA(At, 0, 1); PG8_STAGE_A(PG8_SA(0, 0), kb2, o2[0]);
            PG8_BAR; PG8_WAIT_L(0); PG8_MMA(1, 0, At, B0); PG8_BAR; PG8_SCHED;
            PG8_STAGE_B(PG8_SB(0, 1), b2 + hstep);
            PG8_WAIT_V(6); PG8_BAR; PG8_MMA(1, 1, At, B1); PG8_BAR;
            PG8_LDB(B0, 1, 0); PG8_SCHED; PG8_LDA(At, 1, 0); PG8_STAGE_A(PG8_SA(0, 1), kb2, o2[1]);
            PG8_WAIT_L(8); PG8_BAR; PG8_WAIT_L(0); PG8_MMA(0, 0, At, B0); PG8_BAR; PG8_SCHED;
            PG8_LDB(B1, 1, 1); PG8_STAGE_B(PG8_SB(1, 0), b3);
            PG8_BAR; PG8_WAIT_L(0); PG8_MMA(0, 1, At, B1); PG8_BAR;
            PG8_LDA(At, 1, 1); PG8_STAGE_A(PG8_SA(1, 0), kb3, o2[0]);
            PG8_BAR; PG8_WAIT_L(0); PG8_MMA(1, 0, At, B0); PG8_BAR; PG8_SCHED;
            PG8_STAGE_B(PG8_SB(1, 1), b3 + hstep);
            PG8_WAIT_V(6); PG8_BAR; PG8_MMA(1, 1, At, B1); PG8_BAR;
            }
        }
        if constexpr (ALIGN_EPI) { if (wr == 0) PG8_BAR; }
        E(acc, cur, wr, wc, fr, fq);
        if (!has_next) break;
#pragma unroll
        for (int a = 0; a < 2; ++a)
#pragma unroll
            for (int b = 0; b < 2; ++b)
#pragma unroll
                for (int m = 0; m < 4; ++m)
#pragma unroll
                    for (int n = 0; n < 2; ++n) acc[a][b][m][n] = (f32x4){0.f, 0.f, 0.f, 0.f};
        cur = nxt; cB = nB; ++ui;
#pragma unroll
        for (int h = 0; h < 2; ++h)
#pragma unroll
            for (int i = 0; i < 2; ++i) cv[h][i] = nv[h][i];
        if constexpr (ALIGN_EPI) { if (wr == 1) PG8_BAR; }
    }
    PG8_WAIT_V(0);
    if constexpr (!ALIGN_EPI) { if (wr == 0) PG8_BAR; }
    PG8_BAR;
#undef PG8_SA
#undef PG8_SB
#undef PG8_STAGE_A
#undef PG8_STAGE_B
#undef PG8_LDA
#undef PG8_LDB
#undef PG8_MMA
#undef PG8_WAIT_V
#undef PG8_WAIT_L
#undef PG8_BAR
#undef PG8_SCHED
#undef PG8_AOFFS
}
}

__device__ __forceinline__ void transpose_item(const float* W, int pitch, int k0, int n0, bf16_t* WT, int Kd, int drow0, LAS float* scr, int lane) {
#pragma unroll 8
    for (int i = 0; i < 32; ++i) { const int kk = 2 * i + (lane >> 5); scr[kk * 33 + (lane & 31)] = W[(size_t)(k0 + kk) * pitch + n0 + (lane & 31)]; }
    asm volatile("s_waitcnt lgkmcnt(0)" ::: "memory");
    const int c = lane & 7;
#pragma unroll
    for (int j = 0; j < 4; ++j) { const int n = (lane >> 3) + 8 * j; const LAS float* s = scr + (8 * c) * 33 + n;
        u32x4 o; o.x = pk2(s[0 * 33], s[1 * 33]); o.y = pk2(s[2 * 33], s[3 * 33]); o.z = pk2(s[4 * 33], s[5 * 33]); o.w = pk2(s[6 * 33], s[7 * 33]);
        *(u32x4*)(WT + (size_t)(drow0 + n) * Kd + k0 + 8 * c) = o; }
    asm volatile("s_waitcnt lgkmcnt(0)" ::: "memory");
}
constexpr size_t WT_WIN = 0, WT_WOUT = WT_WIN + (size_t)2 * NP * D, WT_FGU = WT_WOUT + (size_t)2 * D * D, WT_FD = WT_FGU + (size_t)2 * D_FF * D,
                 WT_MGU = WT_FD + (size_t)D * D_FF, WT_MD = WT_MGU + (size_t)NE * 2 * D_FFE * D, WT_END = WT_MD + (size_t)NE * D * D_FFE;
static_assert(WT_END * 2 <= 80 * MiB, "weight copies fit");
__device__ __forceinline__ void ph_pro_weights(const Args& a, Frame& F) {
    LAS float* scr = (LAS float*)(F.lds + F.wave * 16384);
    bf16_t* WT = (bf16_t*)(F.ws + WS_WT);
    constexpr int I_IN0 = 16 * 48, I_IN1 = 16 * 24, I_OUT = 16 * 32, I_FG = 16 * 88, I_FD = 44 * 32, I_M = 16 * 32;
    constexpr int NITEMS = 2 * (I_IN0 + I_IN1 + I_OUT) + 2 * I_FG + I_FD + 24 * I_M;
    for (int it = F.gw; it < NITEMS; it += F.ngw) {
        int r = it; const float* src; int pitch, k0, n0, Kd, drow0; bf16_t* dst;
        if (r < 2 * I_IN0) { const int l = r / I_IN0; r %= I_IN0; src = a.w_in + (size_t)l * D * N_IN; pitch = N_IN; k0 = (r / 48) * 64; n0 = (r % 48) * 32; dst = WT + WT_WIN + (size_t)l * NP * D; Kd = D; drow0 = n0; }
        else if ((r -= 2 * I_IN0) < 2 * I_IN1) { const int l = r / I_IN1; r %= I_IN1; src = a.w_in + (size_t)l * D * N_IN + 1544; pitch = N_IN; k0 = (r / 24) * 64; n0 = (r % 24) * 32; dst = WT + WT_WIN + (size_t)l * NP * D; Kd = D; drow0 = 1536 + n0; }
        else if ((r -= 2 * I_IN1) < 2 * I_OUT) { const int l = r / I_OUT; r %= I_OUT; src = a.w_out + (size_t)l * D * D; pitch = D; k0 = (r / 32) * 64; n0 = (r % 32) * 32; dst = WT + WT_WOUT + (size_t)l * D * D; Kd = D; drow0 = n0; }
        else if ((r -= 2 * I_OUT) < 2 * I_FG) { const int up = r / I_FG; r %= I_FG; src = up ? a.ffn_wu : a.ffn_wg; pitch = D_FF; k0 = (r / 88) * 64; n0 = (r % 88) * 32; dst = WT + WT_FGU; Kd = D; drow0 = (n0 / 128) * 256 + up * 128 + (n0 % 128); }
        else if ((r -= 2 * I_FG) < I_FD) { src = a.ffn_wd; pitch = D; k0 = (r / 32) * 64; n0 = (r % 32) * 32; dst = WT + WT_FD; Kd = D_FF; drow0 = n0; }
        else if ((r -= I_FD) < 16 * I_M) { const int e = r / (2 * I_M); r %= 2 * I_M; const int up = r / I_M; r %= I_M; src = (up ? a.moe_wu : a.moe_wg) + (size_t)e * D * D_FFE; pitch = D_FFE; k0 = (r / 32) * 64; n0 = (r % 32) * 32;
            dst = WT + WT_MGU + (size_t)e * 2 * D_FFE * D; Kd = D; drow0 = (n0 / 128) * 256 + up * 128 + (n0 % 128); }
        else { r -= 16 * I_M; const int e = r / I_M; r %= I_M; src = a.moe_wd + (size_t)e * D_FFE * D; pitch = D; k0 = (r / 32) * 64; n0 = (r % 32) * 32; dst = WT + WT_MD + (size_t)e * D * D_FFE; Kd = D_FFE; drow0 = n0; }
        transpose_item(src, pitch, k0, n0, dst, Kd, drow0, scr, F.lane);
    }
}

template <int NT> __device__ __forceinline__ void moe_order_init(Frame& F, pg8::MoeOrder<NT>& S) {
    const unsigned* c = (const unsigned*)(F.ws + WS_CTL) + CW_MOECNT;
    int acc = 0;
#pragma unroll
    for (int e = 0; e < 8; ++e) { S.bt[e] = acc; acc += ((int)__hip_atomic_load(c + 64 * e, __ATOMIC_RELAXED, __HIP_MEMORY_SCOPE_AGENT) + 255) >> 8; }
    S.bt[8] = acc; S.G = F.nb; S.c = F.bid;
}
template <int NT> __device__ __forceinline__ void moe_ri_preload(Frame& F, const pg8::MoeOrder<NT>& S) {
    LAS int* RI = (LAS int*)(F.lds + RI_OFF); const int* RM = (const int*)(F.ws + WS_RMAP);
    for (int i = 0; i < 15; ++i) { pg8::Unit u; if (!S.next(i, u)) break; if (F.tid < 256) RI[i * 256 + F.tid] = RM[u.pm * 256 + F.tid]; }
    __syncthreads();
}

__global__ void __launch_bounds__(NTHREADS, 2) fwd(Args a) {
    extern __shared__ __attribute__((aligned(16))) unsigned char lds_raw[];
    Frame F;
    F.lds = (LAS unsigned char*)lds_raw;
    F.tid = threadIdx.x; F.lane = F.tid & 63; F.wave = __builtin_amdgcn_readfirstlane(F.tid >> 6);
    F.bid = blockIdx.x; F.nb = gridDim.x; F.gw = F.bid * NWAVES + F.wave; F.ngw = F.nb * NWAVES; F.ws = a.ws;
    volatile LAS unsigned* MISC = (volatile LAS unsigned*)(F.lds + MISC_OFF);
    for (int u = F.tid; u < 32; u += NTHREADS) MISC[u] = 0u;
    __syncthreads();
    unsigned* ctl = (unsigned*)(a.ws + WS_CTL);
    const int lo = a.ph_lo, hi = a.ph_hi;
    const bool multi = (hi - lo) > 1;
    XcdBarrier bar; bar.bar = ctl + CW_BAR; bar.x = 0; bar.st = MISC + 8;
    if (multi) bar = xcd_barrier_post(ctl + CW_BAR, MISC + 8);
#define IN(k) (lo <= (k) && (k) < hi && (frame_refresh(F, a, (LAS unsigned char*)lds_raw), true))
#define SEAM(k) do { if (IN((k) + 1) && IN(k)) xcd_barrier(bar); } while (0)
    float* MOD = (float*)(a.ws + WS_MOD);
    bf16_t* H = (bf16_t*)(a.ws + WS_H); bf16_t* PROJ = (bf16_t*)(a.ws + WS_PROJ); bf16_t* YMIX = (bf16_t*)(a.ws + WS_YMIX);
    bf16_t* WT = (bf16_t*)(a.ws + WS_WT);
    bf16_t* ACT = (bf16_t*)(a.ws + WS_ACT); bf16_t* ACTM = (bf16_t*)(a.ws + WS_ACTM); bf16_t* YMOE = (bf16_t*)(a.ws + WS_YMOE);

    if (IN(PH_PRO)) { ph_pro_naive(a, F); if (GEMM_MASK) ph_pro_weights(a, F); SEAM(PH_PRO); }

#define LAYER_BODY(l) {\
        const int pb = PH_LAYER0 + PH_PER_LAYER * l; \
        const float* xin = (l == 0) ? a.x : a.out; \
        const float* mod0 = MOD + (size_t)(l * 2 + 0) * 2 * 3072; const float* mod1 = MOD + (size_t)(l * 2 + 1) * 2 * 3072; \
        if (IN(pb + K_NORM1)) { ph_norm<1>(a, F, l, xin, a.nmg + l * D, mod0, a.w_in + (size_t)l * D * N_IN + W_DB, N_IN); SEAM(pb + K_NORM1); } \
        if (IN(pb + K_GEMM_IN)) { \
            if constexpr ((GEMM_MASK & 1) != 0) { pg8::Gemm g{H, WT + WT_WIN + (size_t)l * NP * D, D}; pg8::StaticOrder S; S.init(T, NP, F.nb, F.bid); pg8::EpiBf16 E{PROJ, NP, 1 << 20}; \
                pg8::gemm_phase<pg8::EpiBf16, pg8::StaticOrder, false, true, true>(F.lds, nullptr, g, S, E); } else { \
            EpiStoreBf16 E{PROJ, NP}; \
            gemm_naive<false>(F, H, D, nullptr, 0, T, D, a.w_in + (size_t)l * D * N_IN, nullptr, N_IN, NP, 1536, 8, E); } \
            SEAM(pb + K_GEMM_IN); \
        } \
        if (IN(pb + K_DN_PREP)) { ph_dn_prep_naive(a, F, l); SEAM(pb + K_DN_PREP); } \
        if (IN(pb + K_MIX)) { ph_dn_scan_naive(a, F); ph_attn_naive(a, F, l); ph_conv_naive(a, F, l); SEAM(pb + K_MIX); } \
        if (IN(pb + K_DN_OUT)) { ph_dn_out_naive(a, F, l); SEAM(pb + K_DN_OUT); } \
        if (IN(pb + K_GEMM_OUT)) { \
            if constexpr ((GEMM_MASK & 2) != 0) { pg8::Gemm g{YMIX, WT + WT_WOUT + (size_t)l * D * D, D}; pg8::StaticOrder S; S.init(T, D, F.nb, F.bid); pg8::EpiResidF32 E{xin, a.out, mod0 + 2048}; \
                pg8::gemm_phase<pg8::EpiResidF32, pg8::StaticOrder, false, true, true>(F.lds, nullptr, g, S, E); } else { \
            EpiResid E{xin, a.out, mod0 + 2048}; \
            gemm_naive<false>(F, YMIX, D, nullptr, 0, T, D, a.w_out + (size_t)l * D * D, nullptr, D, D, 1 << 30, 0, E); } \
            SEAM(pb + K_GEMM_OUT); \
        } \
        if (l == 0) { \
            if (IN(pb + K_NORM2)) { ph_norm<0>(a, F, l, a.out, a.nfg + l * D, mod1, nullptr, 0); SEAM(pb + K_NORM2); } \
            if (IN(pb + K_MOE_LIST)) { SEAM(pb + K_MOE_LIST); } \
            if (IN(pb + K_FFN1)) { \
                if constexpr ((GEMM_MASK & 4) != 0) { pg8::Gemm g{H, WT + WT_FGU, D}; pg8::StaticOrder S; S.init(T, 2 * D_FF, F.nb, F.bid); pg8::EpiSwiGLU E{ACT, D_FF, 1 << 20}; \
                    pg8::gemm_phase<pg8::EpiSwiGLU, pg8::StaticOrder, false, true, true>(F.lds, nullptr, g, S, E); } else { \
                EpiSwiglu E{ACT, D_FF}; \
                gemm_naive<true>(F, H, D, nullptr, 0, T, D, a.ffn_wg, a.ffn_wu, D_FF, D_FF, 1 << 30, 0, E); } \
                SEAM(pb + K_FFN1); \
            } \
            if (IN(pb + K_FFN2)) { \
                if constexpr ((GEMM_MASK & 8) != 0) { pg8::Gemm g{ACT, WT + WT_FD, D_FF}; pg8::StaticOrder S; S.init(T, D, F.nb, F.bid); pg8::EpiResidF32 E{a.out, a.out, mod1 + 2048}; \
                    pg8::gemm_phase<pg8::EpiResidF32, pg8::StaticOrder, false, true, true>(F.lds, nullptr, g, S, E); } else { \
                EpiResid E{a.out, a.out, mod1 + 2048}; \
                gemm_naive<false>(F, ACT, D_FF, nullptr, 0, T, D_FF, a.ffn_wd, nullptr, D, D, 1 << 30, 0, E); } \
                SEAM(pb + K_FFN2); \
            } \
        } else { \
            if (IN(pb + K_NORM2)) { ph_norm<2>(a, F, l, a.out, a.nfg + l * D, mod1, a.router_w, NE); SEAM(pb + K_NORM2); } \
            if (IN(pb + K_MOE_LIST)) { ph_moe_list(a, F); SEAM(pb + K_MOE_LIST); } \
            if (IN(pb + K_FFN1)) { \
                if constexpr ((GEMM_MASK & 16) != 0) { pg8::MoeOrder<8> S; moe_order_init<8>(F, S); moe_ri_preload<8>(F, S); \
                    pg8::Gemm g{H, WT + WT_MGU, D}; pg8::EpiSwiGLU E{ACTM, D_FFE, 8}; \
                    pg8::gemm_phase<pg8::EpiSwiGLU, pg8::MoeOrder<8>, true, true, true>(F.lds, (const LAS int*)(F.lds + RI_OFF), g, S, E); } else { \
                const int* RM = (const int*)(a.ws + WS_RMAP); \
                EpiSwiglu E{ACTM, D_FFE}; \
                for (int e = 0; e < NE; ++e) { int elo, ehi; moe_range(F, e, elo, ehi); \
                    gemm_naive<true>(F, H, D, RM, elo, ehi - elo, D, a.moe_wg + (size_t)e * D * D_FFE, a.moe_wu + (size_t)e * D * D_FFE, D_FFE, D_FFE, 1 << 30, 0, E); } } \
                SEAM(pb + K_FFN1); \
            } \
            if (IN(pb + K_FFN2)) { \
                if constexpr ((GEMM_MASK & 32) != 0) { pg8::MoeOrder<4> S; moe_order_init<4>(F, S); \
                    pg8::Gemm g{ACTM, WT + WT_MD, D_FFE}; pg8::EpiBf16 E{YMOE, D, 4}; \
                    pg8::gemm_phase<pg8::EpiBf16, pg8::MoeOrder<4>, false, true, true>(F.lds, nullptr, g, S, E); } else { \
                EpiStoreBf16 E{YMOE, D}; \
                for (int e = 0; e < NE; ++e) { int elo, ehi; moe_range(F, e, elo, ehi); \
                    gemm_naive<false>(F, ACTM, D_FFE, nullptr, elo, ehi - elo, D_FFE, a.moe_wd + (size_t)e * D_FFE * D, nullptr, D, D, 1 << 30, 0, E); } } \
                SEAM(pb + K_FFN2); \
            } \
        } \
    }
    LAYER_BODY(0)
    LAYER_BODY(1)
#undef LAYER_BODY
    if (IN(PH_FINAL)) { ph_final(a, F); }
#undef IN
#undef SEAM
}

extern "C" void kernel_launch(void* const* d_in, const int* in_sizes, int n_in, void* d_out, int out_size, void* d_ws, size_t ws_size, hipStream_t stream) {
    static int grid = 0;
    if (grid == 0) {
        if (n_in != 27 || out_size != T * D || ws_size < WS_END) { fprintf(stderr, "kernel_launch: unexpected shapes n_in %d out %d ws %zu\n", n_in, out_size, ws_size); grid = -1; return; }
        int dev = 0, cus = 0, per_cu = 0;
        if (hipGetDevice(&dev) != hipSuccess || hipDeviceGetAttribute(&cus, hipDeviceAttributeMultiprocessorCount, dev) != hipSuccess) { grid = -1; return; }
        if (hipFuncSetAttribute((const void*)fwd, hipFuncAttributeMaxDynamicSharedMemorySize, LDS_BYTES) != hipSuccess) { fprintf(stderr, "kernel_launch: hipFuncSetAttribute failed\n"); grid = -1; return; }
        if (hipOccupancyMaxActiveBlocksPerMultiprocessor(&per_cu, (const void*)fwd, NTHREADS, LDS_BYTES) != hipSuccess || per_cu < 1) fprintf(stderr, "kernel_launch: occupancy query says %d\n", per_cu);
        (void)hipGetLastError();
        grid = cus;
    }
    if (grid < 0) return;
    (void)hipMemsetAsync((char*)d_ws + WS_CTL, 0, CTL_ZERO_BYTES, stream);
    Args a{};
    const void** pp = (const void**)&a;
    for (int i = 0; i < 27; ++i) pp[i] = d_in[i];
    a.out = (float*)d_out; a.ws = (unsigned char*)d_ws;
#if MK_ONE_LAUNCH
    a.ph_lo = 0; a.ph_hi = NPH;
    hipLaunchKernelGGL(fwd, dim3(grid), dim3(NTHREADS), LDS_BYTES, stream, a);
#else
    static const int phases[] = {0, 1, 2, 3, 4, 5, 6, 7, 9, 10, 11, 12, 13, 14, 15, 16, 17, 18, 19, 20, 21};
    for (int p : phases) { a.ph_lo = p; a.ph_hi = p + 1; hipLaunchKernelGGL(fwd, dim3(grid), dim3(NTHREADS), LDS_BYTES, stream, a); }
#endif
}
```

```cpp
#include <hip/hip_runtime.h>
#include <cstdio>
#include <cstdint>

#define LAS __attribute__((address_space(3)))
#define GAS __attribute__((address_space(1)))
typedef unsigned short bf16_t;
typedef float f32x4 __attribute__((ext_vector_type(4)));
typedef unsigned u32x2 __attribute__((ext_vector_type(2)));
typedef unsigned u32x4 __attribute__((ext_vector_type(4)));

#ifndef GEMM_MASK
#define GEMM_MASK 63
#endif
#ifndef ATTN_MFMA
#define ATTN_MFMA 1
#endif
#ifndef MK_ONE_LAUNCH
#define MK_ONE_LAUNCH 1
#endif

constexpr int BATCH = 2, SEQ = 16384, T = BATCH * SEQ, D = 1024, DEPTH = 2;
constexpr int N_IN = 2312, NP = 2304;
constexpr int C_AQ = 0, C_AK = 512, C_AV = 640, C_DQ = 768, C_DK = 1024, C_DV = 1280, C_DZ = 1536, C_CA = 1792, C_CB = 2048;
constexpr int W_DB = 1536;
constexpr int D_FF = 2816, NE = 8, D_FFE = 1024;
constexpr int WINDOW = 128, CV_K = 31, CV_C = 256, DN_CONV = 4;
constexpr float EPS = 1e-6f;
constexpr int MOE_CAP = 67584;

constexpr size_t MiB = 1u << 20;
constexpr size_t WS_CTL = 0, CTL_ZERO_BYTES = 1 * MiB;
constexpr size_t WS_MOD = 1 * MiB;
constexpr size_t WS_CS = 2 * MiB;
constexpr size_t WS_BG = 4 * MiB;
constexpr size_t WS_ROUTE = 5 * MiB;
constexpr size_t WS_POS = 6 * MiB;
constexpr size_t WS_RMAP = 7 * MiB;
constexpr size_t WS_WT = 8 * MiB;
constexpr size_t WS_H = 88 * MiB;
constexpr size_t WS_PROJ = 152 * MiB;
constexpr size_t WS_YMIX = 296 * MiB;
constexpr size_t WS_DNQKV = 360 * MiB;
constexpr size_t WS_ODN = 456 * MiB;
constexpr size_t WS_ACT = 152 * MiB;
constexpr size_t WS_ACTM = 152 * MiB;
constexpr size_t WS_YMOE = 284 * MiB;
constexpr size_t WS_END = 512 * MiB;
constexpr int CW_BAR = 4096;
constexpr int CW_MOECNT = 16384;

constexpr int NWAVES = 8, NTHREADS = 512;
constexpr int LDS_BYTES = 147456;
constexpr int MISC_OFF = 131072 + 320;
constexpr int RI_OFF = 132096;

constexpr int PH_PRO = 0, PH_LAYER0 = 1, PH_PER_LAYER = 10, PH_FINAL = 21, NPH = 22;
enum { K_NORM1 = 0, K_GEMM_IN, K_DN_PREP, K_MIX, K_DN_OUT, K_GEMM_OUT, K_NORM2, K_MOE_LIST, K_FFN1, K_FFN2 };

struct Args {
    const float* x; const float* c; const int* pos; const float* ada_w; const float* ada_b; const float* nmg; const float* nfg;
    const float* w_in; const float* sinks; const float* dn_conv_w; const float* dn_a_log; const float* dn_dt_bias; const float* dn_norm_g;
    const float* cv_dw_w; const float* cv_dw_b; const float* cv_ln_g; const float* cv_ln_b; const float* w_out;
    const float* ffn_wg; const float* ffn_wu; const float* ffn_wd; const float* router_w; const float* router_b;
    const float* moe_wg; const float* moe_wu; const float* moe_wd; const float* final_g;
    float* out; unsigned char* ws; int ph_lo, ph_hi;
};

__device__ __forceinline__ float bf2f(unsigned u) { return __uint_as_float(u << 16); }
__device__ __forceinline__ unsigned f2bf(float f) { unsigned u = __float_as_uint(f); return (u + 0x7fffu + ((u >> 16) & 1u)) >> 16; }
__device__ __forceinline__ unsigned pk2(float lo, float hi) { return f2bf(lo) | (f2bf(hi) << 16); }
__device__ __forceinline__ float wave_sum(float v) {
#pragma unroll
    for (int o = 1; o < 64; o <<= 1) v += __shfl_xor(v, o);
    return v;
}
__device__ __forceinline__ float wave_max(float v) {
#pragma unroll
    for (int o = 1; o < 64; o <<= 1) v = fmaxf(v, __shfl_xor(v, o));
    return v;
}
__device__ __forceinline__ float sigmoidf_(float x) { return 1.0f / (1.0f + __expf(-x)); }
__device__ __forceinline__ float siluf_(float x) { return x / (1.0f + __expf(-x)); }
__device__ __forceinline__ float softplusf_(float x) { return fmaxf(x, 0.f) + log1pf(__expf(-fabsf(x))); }

#define XB_TMO      128
#define XB_XCNT(j)  (256  + 64 * (j))
#define XB_XSUB(j)  (1280 + 64 * (j))
#define XB_XGEN(j)  (2304 + 64 * (j))
#define XB_TOP      3328
#define XB_TOPGEN   3392
#define XCD_BAR_WORDS 3456
#define XB_SPIN_CAP (1u << 18)

__device__ __forceinline__ unsigned xb_ld(unsigned* p)              { return __hip_atomic_load(p, __ATOMIC_RELAXED, __HIP_MEMORY_SCOPE_AGENT); }
__device__ __forceinline__ unsigned xb_add(unsigned* p, unsigned v) { return __hip_atomic_fetch_add(p, v, __ATOMIC_RELAXED, __HIP_MEMORY_SCOPE_AGENT); }
__device__ __forceinline__ unsigned xb_xcc_id() { return (unsigned)__builtin_amdgcn_s_getreg((3 << 11) | 20) & 0xFu; }
#define XB_SPIN(cond, bar) do { unsigned _sp = 0; while (cond) { __builtin_amdgcn_s_sleep(1); \
    if ((++_sp & 255u) == 0u) { if (xb_ld(&(bar)[XB_TMO])) break; if (_sp > XB_SPIN_CAP) { atomicAdd(&(bar)[XB_TMO], 1u); break; } } } } while (0)

struct XcdBarrier { unsigned* bar; unsigned x; volatile LAS unsigned* st; };

__device__ __forceinline__ XcdBarrier xcd_barrier_post(unsigned* bar, volatile LAS unsigned* st) {
    XcdBarrier b; b.bar = bar; b.x = xb_xcc_id(); b.st = st;
    if (threadIdx.x == 0) (void)xb_add(&bar[XB_XCNT(b.x)], 1u);
    return b;
}
__device__ __forceinline__ void xcd_barrier_complete(unsigned* bar, unsigned x, unsigned& nloc, unsigned& nx) {
    const unsigned G = gridDim.x * gridDim.y * gridDim.z;
    unsigned sum, cnt, mine, sp = 0u;
    for (;;) {
        sum = 0u; cnt = 0u; mine = 0u;
#pragma unroll
        for (unsigned j = 0; j < 16; ++j) { const unsigned c = xb_ld(&bar[XB_XCNT(j)]); sum += c; cnt += (c > 0u) ? 1u : 0u; mine = (j == x) ? c : mine; }
        if (sum == G) break;
        __builtin_amdgcn_s_sleep(1);
        if ((++sp & 255u) == 0u) { if (xb_ld(&bar[XB_TMO])) break; if (sp > XB_SPIN_CAP) { atomicAdd(&bar[XB_TMO], 1u); break; } }
    }
    nloc = mine > 0u ? mine : 1u; nx = cnt > 0u ? cnt : 1u;
}
__device__ __forceinline__ void xcd_barrier(const XcdBarrier& b) {
    asm volatile("s_waitcnt vmcnt(0)" ::: "memory");
    __syncthreads();
    if (threadIdx.x == 0) {
        unsigned* bar = b.bar;
        __builtin_amdgcn_s_waitcnt(0);
        unsigned nloc = b.st[0], nx = b.st[1];
        if (nloc == 0u) { xcd_barrier_complete(bar, b.x, nloc, nx); b.st[0] = nloc; b.st[1] = nx; }
        const unsigned old = xb_add(&bar[XB_XSUB(b.x)], 1u);
        const unsigned gen = old / nloc;
        if (old + 1u == (gen + 1u) * nloc) {
            __builtin_amdgcn_fence(__ATOMIC_RELEASE, "agent");
            asm volatile("s_waitcnt vmcnt(0)" ::: "memory");
            const unsigned og = xb_add(&bar[XB_TOP], 1u);
            const unsigned tg = og / nx;
            if (og + 1u == (tg + 1u) * nx) xb_add(&bar[XB_TOPGEN], 1u);
            else XB_SPIN(xb_ld(&bar[XB_TOPGEN]) == tg, bar);
            __builtin_amdgcn_fence(__ATOMIC_ACQUIRE, "agent");
            xb_add(&bar[XB_XGEN(b.x)], 1u);
            asm volatile("s_waitcnt vmcnt(0)" ::: "memory");
        } else {
            XB_SPIN(xb_ld(&bar[XB_XGEN(b.x)]) == gen, bar);
            __builtin_amdgcn_fence(__ATOMIC_ACQUIRE, "agent");
            asm volatile("s_waitcnt vmcnt(0)" ::: "memory");
        }
    }
    __syncthreads();
}

struct Frame {
    LAS unsigned char* lds;
    int tid, lane, wave, gw, ngw, bid, nb;
    unsigned char* ws;
};

__device__ __forceinline__ void frame_refresh(Frame& F, const Args& a, LAS unsigned char* lds) {
    int tid = threadIdx.x; asm volatile("" : "+v"(tid));
    int bid = blockIdx.x; asm volatile("" : "+s"(bid));
    unsigned char* ws = a.ws; asm volatile("" : "+s"(ws));
    F.lds = lds; F.tid = tid; F.lane = tid & 63; F.wave = __builtin_amdgcn_readfirstlane(tid >> 6);
    F.bid = bid; F.nb = gridDim.x; F.gw = F.bid * NWAVES + F.wave; F.ngw = F.nb * NWAVES; F.ws = ws;
}
__device__ __forceinline__ void ph_pro_naive(const Args& a, Frame& F) {
    float* MOD = (float*)(F.ws + WS_MOD);
    LAS float* red = (LAS float*)F.lds;
    for (int it = F.bid; it < 4 * 48; it += F.nb) {
        const int lk = it / 48, cg = it % 48, e = cg * 64 + F.lane;
        const float* W = a.ada_w + (size_t)lk * D * 3072 + e;
        float a0 = 0.f, a1 = 0.f;
        const int d0 = F.wave * 128;
#pragma unroll 8
        for (int d = d0; d < d0 + 128; ++d) {
            const float w = W[(size_t)d * 3072];
            a0 += siluf_(a.c[d]) * w; a1 += siluf_(a.c[D + d]) * w;
        }
        red[(F.wave * 2 + 0) * 64 + F.lane] = a0; red[(F.wave * 2 + 1) * 64 + F.lane] = a1;
        __syncthreads();
        if (F.wave < 2) {
            float s = 0.f;
            for (int w = 0; w < 8; ++w) s += red[(w * 2 + F.wave) * 64 + F.lane];
            MOD[((size_t)lk * 2 + F.wave) * 3072 + e] = s + a.ada_b[lk * 3072 + e];
        }
        __syncthreads();
    }
    float* CS = (float*)(F.ws + WS_CS);
    for (int idx = F.bid * NTHREADS + F.tid; idx < T * 8; idx += F.nb * NTHREADS) {
        const int t = idx >> 3, i = idx & 7;
        const float inv = powf(500000.0f, -(float)(2 * i) / 16.0f);
        const float ang = (float)a.pos[t] * inv;
        CS[t * 16 + i] = cosf(ang); CS[t * 16 + 8 + i] = sinf(ang);
    }
}

template <int MODE>
__device__ __forceinline__ void ph_norm(const Args& a, Frame& F, int l, const float* xin, const float* gain, const float* modk  ,
                                        const float* W8, int pitch) {
    bf16_t* H = (bf16_t*)(F.ws + WS_H);
    LAS float* W8T = (LAS float*)F.lds;
    if (MODE != 0) {
        for (int i = F.tid; i < 8192; i += NTHREADS) { const int d = i >> 3, j = i & 7; W8T[j * 1024 + d] = W8[(size_t)d * pitch + j]; }
        __syncthreads();
    }
    for (int row = F.gw; row < T; row += F.ngw) {
        const int b = row / SEQ;
        const f32x4* xr = (const f32x4*)(xin + (size_t)row * D) + F.lane;
        f32x4 v[4]; float ss = 0.f;
#pragma unroll
        for (int j = 0; j < 4; ++j) { v[j] = xr[64 * j]; ss += (v[j].x * v[j].x + v[j].y * v[j].y) + (v[j].z * v[j].z + v[j].w * v[j].w); }
        const float rstd = rsqrtf(wave_sum(ss) * (1.0f / D) + EPS);
        const float* sh = modk + (size_t)b * 3072; const float* sc = sh + 1024;
        float acc[8];
#pragma unroll
        for (int e = 0; e < 8; ++e) acc[e] = 0.f;
#pragma unroll
        for (int j = 0; j < 4; ++j) {
            const int d = 256 * j + 4 * F.lane;
            const f32x4 g4 = *(const f32x4*)(gain + d), s4 = *(const f32x4*)(sc + d), h4 = *(const f32x4*)(sh + d);
            f32x4 hv = (v[j] * rstd) * g4; hv = hv * (s4 + 1.0f) + h4;
            u32x2 o; o.x = pk2(hv.x, hv.y); o.y = pk2(hv.z, hv.w);
            *(u32x2*)(H + (size_t)row * D + d) = o;
            if (MODE != 0) {
#pragma unroll
                for (int e = 0; e < 8; ++e) { const f32x4 w4 = *(const LAS f32x4*)(W8T + e * 1024 + d); acc[e] += (hv.x * w4.x + hv.y * w4.y) + (hv.z * w4.z + hv.w * w4.w); }
            }
            asm volatile("" ::: "memory");
        }
        if (MODE != 0) {
#pragma unroll
            for (int e = 0; e < 8; ++e) acc[e] = wave_sum(acc[e]);
        }
        if (MODE == 1 && F.lane == 0) {
            float* BG = (float*)(F.ws + WS_BG) + (size_t)row * 8;
#pragma unroll
            for (int h = 0; h < 4; ++h) {
                BG[h] = sigmoidf_(acc[h]);
                BG[4 + h] = -__expf(a.dn_a_log[l * 4 + h]) * softplusf_(acc[4 + h] + a.dn_dt_bias[l * 4 + h]);
            }
        }
        if (MODE == 2 && F.lane == 0) {
            float v0 = -INFINITY, v1 = -INFINITY; int e0 = 0, e1 = 0;
#pragma unroll
            for (int e = 0; e < 8; ++e) { const float lg = acc[e] + a.router_b[e]; if (lg > v0) { v1 = v0; e1 = e0; v0 = lg; e0 = e; } else if (lg > v1) { v1 = lg; e1 = e; } }
            const float ex = __expf(v1 - v0), p0 = 1.0f / (1.0f + ex), p1 = ex / (1.0f + ex);
            unsigned* cnt = (unsigned*)(F.ws + WS_CTL) + CW_MOECNT;
            const int q0 = (int)atomicAdd(cnt + 64 * e0, 1u), q1 = (int)atomicAdd(cnt + 64 * e1, 1u);
            int* R = (int*)(F.ws + WS_ROUTE) + (size_t)row * 4; R[0] = e0; R[1] = e1; ((float*)R)[2] = p0; ((float*)R)[3] = p1;
            int* P = (int*)(F.ws + WS_POS) + (size_t)row * 2; P[0] = q0; P[1] = q1;
        }
    }
    if (MODE != 0) __syncthreads();
}

template <bool DUAL, class Epi>
__device__ __forceinline__ void gemm_naive(Frame& F, const bf16_t* A, int lda, const int* rowmap, int m_base, int Mrows, int K,
                                           const float* W0, const float* W1, int ldw, int N, int skip_at, int skip, const Epi& epi) {
    LAS float* As = (LAS float*)F.lds;
    LAS float* Bs = As + 16 * 132;
    LAS float* Bs2 = Bs + 16 * 128;
    const int ntm = Mrows / 128, ntn = N / 128;
    const int ty = F.tid >> 4, tx = F.tid & 15;
    const int ar = F.tid >> 2, ak = (F.tid & 3) * 4;
    const int bk = F.tid >> 5, bc = (F.tid & 31) * 4;
    for (int tile = F.bid; tile < ntm * ntn; tile += F.nb) {
        const int tm = tile / ntn, tn = tile % ntn, m0 = m_base + tm * 128, n0 = tn * 128;
        const int wn0 = (n0 >= skip_at) ? n0 + skip : n0;
        const int arow = rowmap ? rowmap[m0 + ar] : (m0 + ar);
        const bf16_t* ap = A + (size_t)arow * lda + ak;
        float acc0[4][8], acc1[4][8];
#pragma unroll
        for (int i = 0; i < 4; ++i)
#pragma unroll
            for (int j = 0; j < 8; ++j) { acc0[i][j] = 0.f; acc1[i][j] = 0.f; }
        for (int k0 = 0; k0 < K; k0 += 16) {
            const u32x2 av = *(const u32x2*)(ap + k0);
            const f32x4 bv = *(const f32x4*)(W0 + (size_t)(k0 + bk) * ldw + wn0 + bc);
            f32x4 bv2 = (f32x4){0.f, 0.f, 0.f, 0.f};
            if (DUAL) bv2 = *(const f32x4*)(W1 + (size_t)(k0 + bk) * ldw + wn0 + bc);
            __syncthreads();
            As[(ak + 0) * 132 + ar] = bf2f(av.x & 0xffffu); As[(ak + 1) * 132 + ar] = bf2f(av.x >> 16);
            As[(ak + 2) * 132 + ar] = bf2f(av.y & 0xffffu); As[(ak + 3) * 132 + ar] = bf2f(av.y >> 16);
            *(LAS f32x4*)(Bs + bk * 128 + bc) = bv;
            if (DUAL) *(LAS f32x4*)(Bs2 + bk * 128 + bc) = bv2;
            __syncthreads();
#pragma unroll 2
            for (int kk = 0; kk < 16; ++kk) {
                const f32x4 a4 = *(const LAS f32x4*)(As + kk * 132 + ty * 4);
                const f32x4 b0 = *(const LAS f32x4*)(Bs + kk * 128 + tx * 8), b1 = *(const LAS f32x4*)(Bs + kk * 128 + tx * 8 + 4);
                const float av4[4] = {a4.x, a4.y, a4.z, a4.w};
                const float bb[8] = {b0.x, b0.y, b0.z, b0.w, b1.x, b1.y, b1.z, b1.w};
#pragma unroll
                for (int i = 0; i < 4; ++i)
#pragma unroll
                    for (int j = 0; j < 8; ++j) acc0[i][j] += av4[i] * bb[j];
                if (DUAL) {
                    const f32x4 c0 = *(const LAS f32x4*)(Bs2 + kk * 128 + tx * 8), c1 = *(const LAS f32x4*)(Bs2 + kk * 128 + tx * 8 + 4);
                    const float cc[8] = {c0.x, c0.y, c0.z, c0.w, c1.x, c1.y, c1.z, c1.w};
#pragma unroll
                    for (int i = 0; i < 4; ++i)
#pragma unroll
                        for (int j = 0; j < 8; ++j) acc1[i][j] += av4[i] * cc[j];
                }
            }
        }
#pragma unroll
        for (int i = 0; i < 4; ++i)
#pragma unroll
            for (int j = 0; j < 8; ++j) epi(m0 + ty * 4 + i, n0 + tx * 8 + j, acc0[i][j], acc1[i][j]);
    }
    __syncthreads();
}
struct EpiStoreBf16 { bf16_t* C; int ldc; __device__ __forceinline__ void operator()(int m, int n, float a0, float) const { C[(size_t)m * ldc + n] = (bf16_t)f2bf(a0); } };
struct EpiSwiglu { bf16_t* C; int ldc; __device__ __forceinline__ void operator()(int m, int n, float a0, float a1) const { C[(size_t)m * ldc + n] = (bf16_t)f2bf(siluf_(a0) * a1); } };
struct EpiResid { const float* xin; float* xout; const float* gate;   __device__ __forceinline__ void operator()(int m, int n, float a0, float) const {
    const int b = m / SEQ; xout[(size_t)m * D + n] = xin[(size_t)m * D + n] + gate[(size_t)b * 3072 + n] * a0; } };

__device__ __forceinline__ void ph_dn_prep_naive(const Args& a, Frame& F, int l) {
    const bf16_t* P = (const bf16_t*)(F.ws + WS_PROJ);
    float* Q = (float*)(F.ws + WS_DNQKV);
    const float* cw = a.dn_conv_w + (size_t)l * DN_CONV * 768;
    for (int t = F.gw; t < T; t += F.ngw) {
        const int s = t % SEQ;
#pragma unroll
        for (int j = 0; j < 12; ++j) {
            const int c = F.lane + 64 * j;
            float acc = 0.f;
#pragma unroll
            for (int k = 0; k < DN_CONV; ++k) { const int sp = s - (DN_CONV - 1) + k; if (sp >= 0) acc += cw[k * 768 + c] * bf2f(P[(size_t)(t - (DN_CONV - 1) + k) * NP + C_DQ + c]); }
            float val = siluf_(acc);
            if (j < 8) { const float n2 = wave_sum(val * val); val *= rsqrtf(n2 + EPS); if (j < 4) val *= 0.125f; }
            Q[(size_t)t * 768 + c] = val;
        }
    }
}
__device__ __forceinline__ void ph_dn_scan_naive(const Args& a, Frame& F) {
    const float* Q = (const float*)(F.ws + WS_DNQKV); const float* BG = (const float*)(F.ws + WS_BG); float* O = (float*)(F.ws + WS_ODN);
    for (int task = F.gw; task < BATCH * 4 * 64; task += F.ngw) {
        const int col = task & 63, h = (task >> 6) & 3, b = task >> 8;
        float S = 0.f;
        for (int s0 = 0; s0 < SEQ; s0 += 8) {
            float q8[8], k8[8], v8[8], b8[8], g8[8];
#pragma unroll
            for (int i = 0; i < 8; ++i) { const size_t t = (size_t)b * SEQ + s0 + i; q8[i] = Q[t * 768 + h * 64 + F.lane]; k8[i] = Q[t * 768 + 256 + h * 64 + F.lane]; v8[i] = Q[t * 768 + 512 + h * 64 + col];
                b8[i] = BG[t * 8 + h]; g8[i] = BG[t * 8 + 4 + h]; }
#pragma unroll
            for (int i = 0; i < 8; ++i) {
                const float eg = __expf(g8[i]);
                const float kS = wave_sum(k8[i] * S);
                const float dl = b8[i] * (v8[i] - eg * kS);
                S = eg * S + k8[i] * dl;
                const float o = wave_sum(q8[i] * S);
                if (F.lane == 0) O[((size_t)b * SEQ + s0 + i) * 256 + h * 64 + col] = o;
            }
        }
    }
}
__device__ __forceinline__ void ph_dn_out_naive(const Args& a, Frame& F, int l) {
    const float* O = (const float*)(F.ws + WS_ODN); const bf16_t* P = (const bf16_t*)(F.ws + WS_PROJ); bf16_t* Y = (bf16_t*)(F.ws + WS_YMIX);
    for (int task = F.gw; task < T * 4; task += F.ngw) {
        const int t = task >> 2, h = task & 3;
        const float o = O[(size_t)t * 256 + h * 64 + F.lane];
        const float ms = wave_sum(o * o) * (1.0f / 64.0f);
        const float z = bf2f(P[(size_t)t * NP + C_DZ + h * 64 + F.lane]);
        const float y = o * rsqrtf(ms + EPS) * a.dn_norm_g[l * 64 + F.lane] * siluf_(z);
        Y[(size_t)t * D + 512 + h * 64 + F.lane] = (bf16_t)f2bf(y);
    }
}
__device__ __forceinline__ float rope_lane(float x, int lane, const float* cs) {
    const float xp = __shfl(x, lane ^ 8);
    if (lane < 8) return x * cs[lane] - xp * cs[8 + lane];
    if (lane < 16) return x * cs[lane - 8] + xp * cs[lane];
    return x;
}
__device__ __forceinline__ void ph_attn_naive(const Args& a, Frame& F, int l) {
    const bf16_t* P = (const bf16_t*)(F.ws + WS_PROJ); bf16_t* Y = (bf16_t*)(F.ws + WS_YMIX); const float* CS = (const float*)(F.ws + WS_CS);
    for (int task = F.gw; task < T * 8; task += F.ngw) {
        const int t = task >> 3, hq = task & 7, hk = hq >> 2, s = t % SEQ;
        float q = bf2f(P[(size_t)t * NP + C_AQ + hq * 64 + F.lane]);
        if (!ATTN_MFMA) q = rope_lane(q, F.lane, CS + (size_t)t * 16);
        float sc0 = -INFINITY, sc1 = -INFINITY;
        for (int j = 0; j < WINDOW; ++j) {
            const int sp = s - (WINDOW - 1) + j;
            if (sp < 0) continue;
            const size_t tk = (size_t)t - (WINDOW - 1) + j;
            float k = bf2f(P[tk * NP + C_AK + hk * 64 + F.lane]);
            if (!ATTN_MFMA) k = rope_lane(k, F.lane, CS + tk * 16);
            const float sc = wave_sum(q * k) * 0.125f;
            if (F.lane == (j & 63)) { if (j < 64) sc0 = sc; else sc1 = sc; }
        }
        const float sink = a.sinks[l * 8 + hq];
        const float m = fmaxf(wave_max(fmaxf(sc0, sc1)), sink);
        const float p0 = __expf(sc0 - m), p1 = __expf(sc1 - m);
        const float den = wave_sum(p0 + p1) + __expf(sink - m);
        float o = 0.f;
        for (int j = 0; j < WINDOW; ++j) {
            const int sp = s - (WINDOW - 1) + j;
            if (sp < 0) continue;
            const size_t tk = (size_t)t - (WINDOW - 1) + j;
            const float p = __shfl(j < 64 ? p0 : p1, j & 63);
            o += p * bf2f(P[tk * NP + C_AV + hk * 64 + F.lane]);
        }
        Y[(size_t)t * D + hq * 64 + F.lane] = (bf16_t)f2bf(o / den);
    }
}

typedef float f32x16 __attribute__((ext_vector_type(16)));
typedef short s16x4 __attribute__((ext_vector_type(4)));
typedef short bf16x8_t __attribute__((ext_vector_type(8)));
__device__ __forceinline__ unsigned cvtpk(float lo, float hi) { typedef float f2_t __attribute__((ext_vector_type(2))); typedef __bf16 b2_t __attribute__((ext_vector_type(2)));
    f2_t v = {lo, hi}; b2_t b = __builtin_convertvector(v, b2_t); return __builtin_bit_cast(unsigned, b); }
__device__ __forceinline__ void ph_rope(const Args& a, Frame& F) {
    bf16_t* P = (bf16_t*)(F.ws + WS_PROJ); const float* CS = (const float*)(F.ws + WS_CS);
    for (int it = F.bid * NTHREADS + F.tid; it < T * 10; it += F.nb * NTHREADS) {
        const int t = it / 10, hh = it % 10;
        bf16_t* p = P + (size_t)t * NP + hh * 64;
        const u32x4 x1 = *(const u32x4*)p, x2 = *(const u32x4*)(p + 8);
        const f32x4 c0 = *(const f32x4*)(CS + (size_t)t * 16), c1 = *(const f32x4*)(CS + (size_t)t * 16 + 4), s0 = *(const f32x4*)(CS + (size_t)t * 16 + 8), s1 = *(const f32x4*)(CS + (size_t)t * 16 + 12);
        const float cs[8] = {c0.x, c0.y, c0.z, c0.w, c1.x, c1.y, c1.z, c1.w}, sn[8] = {s0.x, s0.y, s0.z, s0.w, s1.x, s1.y, s1.z, s1.w};
        const unsigned xa[4] = {x1.x, x1.y, x1.z, x1.w}, xb[4] = {x2.x, x2.y, x2.z, x2.w};
        unsigned ra[4], rb[4];
#pragma unroll
        for (int i = 0; i < 4; ++i) {
            const float a0 = bf2f(xa[i] & 0xffffu), a1 = bf2f(xa[i] >> 16), b0 = bf2f(xb[i] & 0xffffu), b1 = bf2f(xb[i] >> 16);
            ra[i] = pk2(a0 * cs[2 * i] - b0 * sn[2 * i], a1 * cs[2 * i + 1] - b1 * sn[2 * i + 1]);
            rb[i] = pk2(b0 * cs[2 * i] + a0 * sn[2 * i], b1 * cs[2 * i + 1] + a1 * sn[2 * i + 1]);
        }
        *(u32x4*)p = (u32x4){ra[0], ra[1], ra[2], ra[3]}; *(u32x4*)(p + 8) = (u32x4){rb[0], rb[1], rb[2], rb[3]};
    }
}
constexpr int AT_KROW = 144, AT_VOFF = 256 * AT_KROW;
__device__ __forceinline__ void ph_attn_mfma(const Args& a, Frame& F, int l) {
    const bf16_t* P = (const bf16_t*)(F.ws + WS_PROJ); bf16_t* Y = (bf16_t*)(F.ws + WS_YMIX);
    LAS unsigned char* Kl = F.lds; LAS unsigned char* Vl = F.lds + AT_VOFF;
    const int lane = F.lane, r = lane & 31, h = lane >> 5, g = F.wave >> 1, qh = F.wave & 1;
    const int i16 = lane & 15, tq_ = i16 >> 2, tp_ = i16 & 3, g16 = (lane >> 4) & 1, sw = (tq_ >> 1) & 1;
    const int vlane = (4 * h + tq_) * 128 + (2 * g16 + (tp_ >> 1)) * 16 + (tp_ & 1) * 8;
    const float C = 0.125f * 1.4426950408889634f;
    for (int u = F.bid; u < BATCH * 128 * 2; u += F.nb) {
        const int hk = u & 1, n = (u >> 1) & 127, b = u >> 8;
        const int tq0 = b * SEQ + n * 128, tk0 = tq0 - 128;
        __syncthreads();
#pragma unroll
        for (int i = 0; i < 4; ++i) {
            const int piece = F.tid + NTHREADS * i, key = piece >> 3, c = piece & 7;
            u32x4 kv = (u32x4){0u, 0u, 0u, 0u}, vv = kv;
            if (n > 0 || key >= 128) { const bf16_t* rowp = P + (size_t)(tk0 + key) * NP; kv = *(const u32x4*)(rowp + C_AK + hk * 64 + c * 8); vv = *(const u32x4*)(rowp + C_AV + hk * 64 + c * 8); }
            *(LAS u32x4*)(Kl + key * AT_KROW + c * 16) = kv;
            *(LAS u32x4*)(Vl + key * 128 + ((c ^ (((key >> 1) & 1) << 2)) * 16)) = vv;
        }
        __syncthreads();
        const int hq = hk * 4 + g;
        const float sinkl = a.sinks[l * 8 + hq] * 1.4426950408889634f;
#pragma unroll 1
        for (int sb = 0; sb < 2; ++sb) {
            const int q0 = qh * 64 + sb * 32, kt0 = qh * 2 + sb;
            const size_t tq = (size_t)(tq0 + q0 + r);
            bf16x8_t qf[4];
#pragma unroll
            for (int ks = 0; ks < 4; ++ks) qf[ks] = *(const bf16x8_t*)(P + tq * NP + hq * 64 + 16 * ks + 8 * h);
            f32x16 S[5];
#pragma unroll
            for (int kr = 0; kr < 5; ++kr) {
                f32x16 acc;
#pragma unroll
                for (int i = 0; i < 16; ++i) acc[i] = 0.f;
#pragma unroll
                for (int ks = 0; ks < 4; ++ks) { const bf16x8_t kf = *(const LAS bf16x8_t*)(Kl + (32 * (kt0 + kr) + r) * AT_KROW + (16 * ks + 8 * h) * 2);
                    acc = __builtin_amdgcn_mfma_f32_32x32x16_bf16(kf, qf[ks], acc, 0, 0, 0); }
                S[kr] = acc;
            }
            float m = sinkl;
#pragma unroll
            for (int kr = 0; kr < 5; ++kr) {
                const bool tile_ok = !(n == 0 && (kt0 + kr) < 4);
#pragma unroll
                for (int i = 0; i < 16; ++i) {
                    const int kl = (i & 3) + 8 * (i >> 2) + 4 * h;
                    bool ok = tile_ok; if (kr == 0) ok = ok && (kl > r); if (kr == 4) ok = ok && (kl <= r);
                    const float sv = ok ? S[kr][i] * C : -INFINITY; S[kr][i] = sv; m = fmaxf(m, sv);
                }
            }
            m = fmaxf(m, __shfl_xor(m, 32));
            float lsum = 0.f;
#pragma unroll
            for (int kr = 0; kr < 5; ++kr)
#pragma unroll
                for (int i = 0; i < 16; ++i) { const float p = __builtin_amdgcn_exp2f(S[kr][i] - m); S[kr][i] = p; lsum += p; }
            lsum += __shfl_xor(lsum, 32); lsum += __builtin_amdgcn_exp2f(sinkl - m);
            f32x16 O0, O1;
#pragma unroll
            for (int i = 0; i < 16; ++i) { O0[i] = 0.f; O1[i] = 0.f; }
#pragma unroll
            for (int kr = 0; kr < 5; ++kr) {
#pragma unroll
                for (int s2 = 0; s2 < 2; ++s2) {
                    u32x4 pw; pw.x = cvtpk(S[kr][8 * s2 + 0], S[kr][8 * s2 + 1]); pw.y = cvtpk(S[kr][8 * s2 + 2], S[kr][8 * s2 + 3]); pw.z = cvtpk(S[kr][8 * s2 + 4], S[kr][8 * s2 + 5]); pw.w = cvtpk(S[kr][8 * s2 + 6], S[kr][8 * s2 + 7]);
                    const bf16x8_t pf = __builtin_bit_cast(bf16x8_t, pw);
                    const int kb = (32 * (kt0 + kr) + 16 * s2) * 128 + vlane;
                    const s16x4 lo0 = __builtin_amdgcn_ds_read_tr16_b64_v4i16((LAS s16x4*)(Vl + kb + (0 ^ sw) * 64));
                    const s16x4 hi0 = __builtin_amdgcn_ds_read_tr16_b64_v4i16((LAS s16x4*)(Vl + kb + 8 * 128 + (0 ^ sw) * 64));
                    const s16x4 lo1 = __builtin_amdgcn_ds_read_tr16_b64_v4i16((LAS s16x4*)(Vl + kb + (1 ^ sw) * 64));
                    const s16x4 hi1 = __builtin_amdgcn_ds_read_tr16_b64_v4i16((LAS s16x4*)(Vl + kb + 8 * 128 + (1 ^ sw) * 64));
                    const bf16x8_t va0 = __builtin_shufflevector(lo0, hi0, 0, 1, 2, 3, 4, 5, 6, 7), va1 = __builtin_shufflevector(lo1, hi1, 0, 1, 2, 3, 4, 5, 6, 7);
                    O0 = __builtin_amdgcn_mfma_f32_32x32x16_bf16(va0, pf, O0, 0, 0, 0);
                    O1 = __builtin_amdgcn_mfma_f32_32x32x16_bf16(va1, pf, O1, 0, 0, 0);
                }
            }
            const float inv = 1.0f / lsum;
            bf16_t* yp = Y + tq * D + hq * 64 + 4 * h;
#pragma unroll
            for (int gq = 0; gq < 4; ++gq) {
                u32x2 o0; o0.x = cvtpk(O0[4 * gq] * inv, O0[4 * gq + 1] * inv); o0.y = cvtpk(O0[4 * gq + 2] * inv, O0[4 * gq + 3] * inv);
                u32x2 o1; o1.x = cvtpk(O1[4 * gq] * inv, O1[4 * gq + 1] * inv); o1.y = cvtpk(O1[4 * gq + 2] * inv, O1[4 * gq + 3] * inv);
                *(u32x2*)(yp + 8 * gq) = o0; *(u32x2*)(yp + 32 + 8 * gq) = o1;
            }
        }
    }
    __syncthreads();
}

__device__ __forceinline__ void ph_conv_naive(const Args& a, Frame& F, int l) {
    const bf16_t* P = (const bf16_t*)(F.ws + WS_PROJ); bf16_t* Y = (bf16_t*)(F.ws + WS_YMIX);
    const float* w = a.cv_dw_w + (size_t)l * CV_K * CV_C;
    for (int t = F.gw; t < T; t += F.ngw) {
        const int s = t % SEQ, c0 = 4 * F.lane;
        f32x4 acc = *(const f32x4*)(a.cv_dw_b + l * CV_C + c0);
        for (int k = 0; k < CV_K; ++k) {
            const int sp = s - (CV_K - 1) + k;
            if (sp < 0) continue;
            const size_t tk = (size_t)t - (CV_K - 1) + k;
            const u32x2 ca = *(const u32x2*)(P + tk * NP + C_CA + c0), cb = *(const u32x2*)(P + tk * NP + C_CB + c0);
            const f32x4 w4 = *(const f32x4*)(w + k * CV_C + c0);
            acc.x += w4.x * (bf2f(ca.x & 0xffffu) * sigmoidf_(bf2f(cb.x & 0xffffu)));
            acc.y += w4.y * (bf2f(ca.x >> 16) * sigmoidf_(bf2f(cb.x >> 16)));
            acc.z += w4.z * (bf2f(ca.y & 0xffffu) * sigmoidf_(bf2f(cb.y & 0xffffu)));
            acc.w += w4.w * (bf2f(ca.y >> 16) * sigmoidf_(bf2f(cb.y >> 16)));
        }
        const float mean = wave_sum((acc.x + acc.y) + (acc.z + acc.w)) * (1.0f / CV_C);
        const f32x4 dv = acc - mean;
        const float var = wave_sum((dv.x * dv.x + dv.y * dv.y) + (dv.z * dv.z + dv.w * dv.w)) * (1.0f / CV_C);
        const float rstd = rsqrtf(var + EPS);
        const f32x4 g4 = *(const f32x4*)(a.cv_ln_g + l * CV_C + c0), b4 = *(const f32x4*)(a.cv_ln_b + l * CV_C + c0);
        const f32x4 y = (dv * rstd) * g4 + b4;
        u32x2 o; o.x = pk2(siluf_(y.x), siluf_(y.y)); o.y = pk2(siluf_(y.z), siluf_(y.w));
        *(u32x2*)(Y + (size_t)t * D + 768 + c0) = o;
    }
}
__device__ __forceinline__ void moe_bases(Frame& F, int (&base)[9], int (&cnt)[8]) {
    const unsigned* c = (const unsigned*)(F.ws + WS_CTL) + CW_MOECNT;
    int acc = 0;
#pragma unroll
    for (int e = 0; e < 8; ++e) { cnt[e] = (int)__hip_atomic_load(c + 64 * e, __ATOMIC_RELAXED, __HIP_MEMORY_SCOPE_AGENT); base[e] = acc; acc += (cnt[e] + 255) & ~255; }
    base[8] = acc;
}
__device__ __forceinline__ void moe_range(Frame& F, int e, int& lo, int& hi) {
    const unsigned* c = (const unsigned*)(F.ws + WS_CTL) + CW_MOECNT;
    int acc = 0; lo = 0; hi = 0;
#pragma unroll
    for (int k = 0; k < 8; ++k) { const int n = ((int)__hip_atomic_load(c + 64 * k, __ATOMIC_RELAXED, __HIP_MEMORY_SCOPE_AGENT) + 255) & ~255; if (k == e) { lo = acc; hi = acc + n; } acc += n; }
}
__device__ __forceinline__ void ph_moe_list(const Args& a, Frame& F) {
    int base[9], cnt[8]; moe_bases(F, base, cnt);
    int* RM = (int*)(F.ws + WS_RMAP); const int* R = (const int*)(F.ws + WS_ROUTE); const int* Pq = (const int*)(F.ws + WS_POS);
    for (int t = F.bid * NTHREADS + F.tid; t < T; t += F.nb * NTHREADS) {
        const int e0 = R[t * 4], e1 = R[t * 4 + 1];
        int b0 = 0, b1 = 0;
#pragma unroll
        for (int e = 0; e < 8; ++e) { if (e == e0) b0 = base[e]; if (e == e1) b1 = base[e]; }
        RM[b0 + Pq[t * 2]] = t; RM[b1 + Pq[t * 2 + 1]] = t;
    }
    if (F.bid == 0) {
#pragma unroll
        for (int e = 0; e < 8; ++e) { const int lo = base[e] + cnt[e], hi = base[e + 1]; for (int r = lo + F.tid; r < hi; r += NTHREADS) RM[r] = 0; }
    }
}
__device__ __forceinline__ void ph_final(const Args& a, Frame& F) {
    int base[9], cnt[8]; moe_bases(F, base, cnt);
    const float* MOD = (const float*)(F.ws + WS_MOD);
    const bf16_t* YM = (const bf16_t*)(F.ws + WS_YMOE); const int* R = (const int*)(F.ws + WS_ROUTE); const int* Pq = (const int*)(F.ws + WS_POS);
    for (int row = F.gw; row < T; row += F.ngw) {
        const int b = row / SEQ;
        const int e0 = R[row * 4], e1 = R[row * 4 + 1]; const float p0 = ((const float*)R)[row * 4 + 2], p1 = ((const float*)R)[row * 4 + 3];
        int b0 = 0, b1 = 0;
#pragma unroll
        for (int e = 0; e < 8; ++e) { if (e == e0) b0 = base[e]; if (e == e1) b1 = base[e]; }
        const size_t s0 = (size_t)(b0 + Pq[row * 2]), s1 = (size_t)(b1 + Pq[row * 2 + 1]);
        const float* gt2 = MOD + ((size_t)(1 * 2 + 1) * 2 + b) * 3072 + 2048;
        f32x4* xr = (f32x4*)(a.out + (size_t)row * D) + F.lane;
        f32x4 v[4]; float ss = 0.f;
#pragma unroll
        for (int j = 0; j < 4; ++j) {
            const int d = 256 * j + 4 * F.lane;
            const u32x2 y0 = *(const u32x2*)(YM + s0 * D + d), y1 = *(const u32x2*)(YM + s1 * D + d);
            const f32x4 g4 = *(const f32x4*)(gt2 + d);
            f32x4 f; f.x = p0 * bf2f(y0.x & 0xffffu) + p1 * bf2f(y1.x & 0xffffu); f.y = p0 * bf2f(y0.x >> 16) + p1 * bf2f(y1.x >> 16);
            f.z = p0 * bf2f(y0.y & 0xffffu) + p1 * bf2f(y1.y & 0xffffu); f.w = p0 * bf2f(y0.y >> 16) + p1 * bf2f(y1.y >> 16);
            v[j] = xr[64 * j] + g4 * f;
            ss += (v[j].x * v[j].x + v[j].y * v[j].y) + (v[j].z * v[j].z + v[j].w * v[j].w);
        }
        const float rstd = rsqrtf(wave_sum(ss) * (1.0f / D) + EPS);
#pragma unroll
        for (int j = 0; j < 4; ++j) { const f32x4 g4 = *(const f32x4*)(a.final_g + 256 * j + 4 * F.lane); xr[64 * j] = (v[j] * rstd) * g4; }
    }
}


namespace pg8 {
typedef short bf16x8 __attribute__((ext_vector_type(8)));
constexpr int BM = 256, BK = 64, HALF = 128, HTB = HALF * BK * 2, STAGE_BYTES = 8 * HTB;
__device__ __forceinline__ int lds_byte(int r, int c) { const int st = (r >> 4) * 2 + (c >> 5), rr = r & 15, cc = c & 31, ob = rr * 64 + cc * 2; return st * 1024 + (ob ^ (((ob >> 9) & 1) << 5)); }
__device__ __forceinline__ void stage_rc(int b, int& R, int& C) { const int st = b / 1024, sb = b % 1024, swz = sb ^ (((sb >> 9) & 1) << 5); R = (st >> 1) * 16 + swz / 64; C = (st & 1) * 32 + (swz % 64) / 2; }
__device__ __forceinline__ int perm32(int rho) { const int n = rho >> 4, i = rho & 15; return 8 * (i >> 2) + 4 * n + (i & 3); }
struct Unit { int pm, pn; };
struct Gemm { const bf16_t* A; const bf16_t* Bt; int K; };
constexpr int NXCD = 8, WGM = 8;
struct StaticOrder {
    int nM, nN, nwg, G, c;
    __device__ void init(int M, int N, int G_, int c_) { nM = M / BM; nN = N / BM; nwg = nM * nN; G = G_; c = c_; }
    __device__ __forceinline__ bool next(int i, Unit& u) const {
        const long L = (long)i * G + c; if (L >= nwg) return false;
        int wgid = (int)L; { const int q = nwg / NXCD, r = nwg % NXCD, xcd = wgid % NXCD, off = wgid / NXCD; wgid = (xcd < r ? xcd * (q + 1) : r * (q + 1) + (xcd - r) * q) + off; }
        const int nig = WGM * nN, gid = wgid / nig, fm = gid * WGM, gsz = (nM - fm) < WGM ? (nM - fm) : WGM;
        u.pm = fm + ((wgid % nig) % gsz); u.pn = (wgid % nig) / gsz; return true;
    }
};
template <int NT> struct MoeOrder {
    int bt[9]; int G, c;
    __device__ __forceinline__ bool next(int i, Unit& u) const {
        const int L = i * G + c; if (L >= bt[8] * NT) return false;
        const int q = L / NT, tn = L % NT; int e = 0;
#pragma unroll
        for (int k = 1; k < 8; ++k) e += (q >= bt[k]) ? 1 : 0;
        u.pm = q; u.pn = e * NT + tn; return true;
    }
};
__device__ __forceinline__ unsigned cvt_pk_bf16(float lo, float hi) { unsigned r; asm volatile("v_cvt_pk_bf16_f32 %0, %1, %2" : "=v"(r) : "v"(lo), "v"(hi)); return r; }
__device__ __forceinline__ float fast_silu(float x) { return x * __builtin_amdgcn_rcpf(1.0f + __builtin_amdgcn_exp2f(x * -1.4426950408889634f)); }

struct EpiBf16 {
    static constexpr bool PERM = true;
    bf16_t* O; int ldc; int nmod;
    __device__ __forceinline__ void operator()(const f32x4 (&acc)[2][2][4][2], const Unit& u, int wr, int wc, int fr, int fq) const {
        const int row0 = u.pm * BM + wr * 64 + fr, col0 = (u.pn % nmod) * BM + wc * 32 + 8 * fq;
#pragma unroll
        for (int ai = 0; ai < 2; ++ai)
#pragma unroll
            for (int m = 0; m < 4; ++m) { bf16_t* rowp = O + (size_t)(row0 + ai * HALF + m * 16) * ldc + col0;
#pragma unroll
                for (int bj = 0; bj < 2; ++bj) { const f32x4 v0 = acc[ai][bj][m][0], v1 = acc[ai][bj][m][1];
                    u32x4 w; w.x = cvt_pk_bf16(v0[0], v0[1]); w.y = cvt_pk_bf16(v0[2], v0[3]); w.z = cvt_pk_bf16(v1[0], v1[1]); w.w = cvt_pk_bf16(v1[2], v1[3]);
                    *(u32x4*)(rowp + bj * HALF) = w; } }
    }
};
struct EpiSwiGLU {
    static constexpr bool PERM = true;
    bf16_t* O; int ldc; int nmod;
    __device__ __forceinline__ void operator()(const f32x4 (&acc)[2][2][4][2], const Unit& u, int wr, int wc, int fr, int fq) const {
        const int row0 = u.pm * BM + wr * 64 + fr, col0 = (u.pn % nmod) * HALF + wc * 32 + 8 * fq;
#pragma unroll
        for (int ai = 0; ai < 2; ++ai)
#pragma unroll
            for (int m = 0; m < 4; ++m) {
                const f32x4 g0 = acc[ai][0][m][0], g1 = acc[ai][0][m][1], u0 = acc[ai][1][m][0], u1 = acc[ai][1][m][1];
                u32x4 w;
                w.x = cvt_pk_bf16(fast_silu(g0[0]) * u0[0], fast_silu(g0[1]) * u0[1]); w.y = cvt_pk_bf16(fast_silu(g0[2]) * u0[2], fast_silu(g0[3]) * u0[3]);
                w.z = cvt_pk_bf16(fast_silu(g1[0]) * u1[0], fast_silu(g1[1]) * u1[1]); w.w = cvt_pk_bf16(fast_silu(g1[2]) * u1[2], fast_silu(g1[3]) * u1[3]);
                *(u32x4*)(O + (size_t)(row0 + ai * HALF + m * 16) * ldc + col0) = w; }
    }
};
struct EpiResidF32 {
    static constexpr bool PERM = false;
    const float* xin; float* xout; const float* gate;
    __device__ __forceinline__ void operator()(const f32x4 (&acc)[2][2][4][2], const Unit& u, int wr, int wc, int fr, int fq) const {
        const int row0 = u.pm * BM + wr * 64 + fr, col0 = u.pn * BM + wc * 32 + 4 * fq;
        const float* gp = gate + (size_t)((u.pm * BM) / SEQ) * 3072 + col0;
#pragma unroll
        for (int bj = 0; bj < 2; ++bj)
#pragma unroll
            for (int n = 0; n < 2; ++n) { const f32x4 g4 = *(const f32x4*)(gp + bj * HALF + n * 16);
#pragma unroll
                for (int ai = 0; ai < 2; ++ai)
#pragma unroll
                    for (int m = 0; m < 4; ++m) { const size_t off = (size_t)(row0 + ai * HALF + m * 16) * D + col0 + bj * HALF + n * 16;
                        const f32x4 x4 = *(const f32x4*)(xin + off); *(f32x4*)(xout + off) = x4 + g4 * acc[ai][bj][m][n]; } }
    }
};

template <class Epi, class Sched, bool GATHER, bool ALIGN_EPI, bool SP2>
__device__ __forceinline__ void gemm_phase(LAS unsigned char* lds, const LAS int* RI, const Gemm g, const Sched& S, const Epi& E) {
    const int tid = threadIdx.x, wid = __builtin_amdgcn_readfirstlane(tid >> 6), lane = tid & 63, wr = wid >> 2, wc = wid & 3, fr = lane & 15, fq = lane >> 4;
    const int K = g.K, nt = K / BK;
    unsigned voffB[2]; int Ra[2]; unsigned Ca2[2];
#pragma unroll
    for (int i = 0; i < 2; ++i) { int R, C; stage_rc(tid * 16 + i * 8192, R, C); const int Rb = Epi::PERM ? ((R & ~31) + perm32(R & 31)) : R;
        Ra[i] = R; Ca2[i] = (unsigned)C * 2u; voffB[i] = (unsigned)(Rb * K + C) * 2u; }
    const size_t kstep = (size_t)(BK * 2);
    const size_t hstep = (size_t)HALF * K * 2;
    const size_t tstep = 2 * hstep;
    const unsigned rowb = (unsigned)K * 2u;
    const unsigned ldsw = (unsigned)wid * 1024u;
    const int aoff = lds_byte(wr * 64 + fr, fq * 8), boff = lds_byte(wc * 32 + fr, fq * 8);
#define PG8_SA(b, h) (((b) * 2 + (h)) * HTB)
#define PG8_SB(b, h) ((4 + (b) * 2 + (h)) * HTB)
#define PG8_STAGE_B(bufoff, gbase) do { _Pragma("unroll") for (int _i = 0; _i < 2; ++_i) \
        __builtin_amdgcn_global_load_lds((const unsigned*)((const char*)(gbase) + voffB[_i]), (LAS unsigned*)(lds + (bufoff) + ldsw + _i * 8192), 16, 0, 0); } while (0)
#define PG8_STAGE_A(bufoff, kb, off) do { _Pragma("unroll") for (int _i = 0; _i < 2; ++_i) \
        __builtin_amdgcn_global_load_lds((const unsigned*)((const char*)g.A + (size_t)(kb) + (off)[_i]), (LAS unsigned*)(lds + (bufoff) + ldsw + _i * 8192), 16, 0, 0); } while (0)
#define PG8_LDA(dst, b, h) do { _Pragma("unroll") for (int m = 0; m < 4; ++m) _Pragma("unroll") for (int k = 0; k < 2; ++k) dst[m][k] = *(const LAS bf16x8*)(lds + PG8_SA(b, h) + aoff + m * 2048 + k * 1024); } while (0)
#define PG8_LDB(dst, b, h) do { _Pragma("unroll") for (int n = 0; n < 2; ++n) _Pragma("unroll") for (int k = 0; k < 2; ++k) dst[n][k] = *(const LAS bf16x8*)(lds + PG8_SB(b, h) + boff + n * 2048 + k * 1024); } while (0)
#define PG8_MMA(ai, bj, At, Bt) do { __builtin_amdgcn_s_setprio(1); _Pragma("unroll") for (int m = 0; m < 4; ++m) _Pragma("unroll") for (int n = 0; n < 2; ++n) _Pragma("unroll") for (int k = 0; k < 2; ++k) \
        acc[ai][bj][m][n] = __builtin_amdgcn_mfma_f32_16x16x32_bf16(Bt[n][k], At[m][k], acc[ai][bj][m][n], 0, 0, 0); __builtin_amdgcn_s_setprio(0); } while (0)
#define PG8_WAIT_V(n) asm volatile("s_waitcnt vmcnt(" #n ")" ::: "memory")
#define PG8_WAIT_L(n) asm volatile("s_waitcnt lgkmcnt(" #n ")" ::: "memory")
#define PG8_BAR __builtin_amdgcn_s_barrier()
#define PG8_SCHED __builtin_amdgcn_sched_barrier(0)
#define PG8_AOFFS(dst, ui_, un_) do { _Pragma("unroll") for (int _h = 0; _h < 2; ++_h) _Pragma("unroll") for (int _i = 0; _i < 2; ++_i) { \
        const unsigned _row = GATHER ? (unsigned)RI[(ui_) * 256 + _h * HALF + Ra[_i]] : (unsigned)((un_).pm * BM + _h * HALF + Ra[_i]); dst[_h][_i] = _row * rowb + Ca2[_i]; } } while (0)
    Unit cur, nxt; int ui = 0;
    if (!S.next(0, cur)) return;
    f32x4 acc[2][2][4][2];
#pragma unroll
    for (int a = 0; a < 2; ++a)
#pragma unroll
        for (int b = 0; b < 2; ++b)
#pragma unroll
            for (int m = 0; m < 4; ++m)
#pragma unroll
                for (int n = 0; n < 2; ++n) acc[a][b][m][n] = (f32x4){0.f, 0.f, 0.f, 0.f};
    bf16x8 At[4][2], B0[2][2], B1[2][2];
    unsigned cv[2][2], nv[2][2];
    PG8_AOFFS(cv, 0, cur);
    const char* cB = (const char*)g.Bt + (size_t)cur.pn * tstep;
    if constexpr (SP2) {
        PG8_STAGE_B(PG8_SB(0, 0), cB); PG8_STAGE_B(PG8_SB(0, 1), cB + hstep); PG8_STAGE_A(PG8_SA(0, 0), 0, cv[0]); PG8_STAGE_A(PG8_SA(0, 1), 0, cv[1]);
        if (wr == 1) PG8_BAR;
        PG8_WAIT_V(2); PG8_BAR;
        PG8_STAGE_B(PG8_SB(1, 0), cB + kstep); PG8_STAGE_A(PG8_SA(1, 0), kstep, cv[0]); PG8_STAGE_B(PG8_SB(1, 1), cB + hstep + kstep);
        PG8_WAIT_V(6); PG8_BAR;
    } else {
        PG8_STAGE_B(PG8_SB(0, 0), cB); PG8_STAGE_A(PG8_SA(0, 0), 0, cv[0]); PG8_STAGE_B(PG8_SB(0, 1), cB + hstep); PG8_STAGE_A(PG8_SA(0, 1), 0, cv[1]);
        if (wr == 1) PG8_BAR;
        PG8_WAIT_V(4); PG8_BAR;
        PG8_STAGE_B(PG8_SB(1, 0), cB + kstep); PG8_STAGE_A(PG8_SA(1, 0), kstep, cv[0]); PG8_STAGE_B(PG8_SB(1, 1), cB + hstep + kstep);
        PG8_WAIT_V(6); PG8_BAR;
    }
    for (;;) {
        const bool has_next = S.next(ui + 1, nxt);
        const char* nB = has_next ? (const char*)g.Bt + (size_t)nxt.pn * tstep : cB;
        if (has_next) { PG8_AOFFS(nv, ui + 1, nxt); }
        else {
#pragma unroll
            for (int h = 0; h < 2; ++h)
#pragma unroll
                for (int i = 0; i < 2; ++i) nv[h][i] = cv[h][i]; }
        for (int t = 0; t < nt; t += 2) {
            const bool last = (t == nt - 2);
            const size_t kb1 = (size_t)(t + 1) * kstep, kb2 = last ? (size_t)0 : (size_t)(t + 2) * kstep, kb3 = kb2 + kstep;
            const char* b2 = last ? nB : cB + (size_t)(t + 2) * kstep; const char* b3 = b2 + kstep;
            unsigned o2[2][2];
#pragma unroll
            for (int h = 0; h < 2; ++h)
#pragma unroll
                for (int i = 0; i < 2; ++i) o2[h][i] = last ? nv[h][i] : cv[h][i];
            if constexpr (SP2) {
            PG8_LDB(B0, 0, 0); PG8_LDB(B1, 0, 1); PG8_SCHED; PG8_LDA(At, 0, 0); PG8_STAGE_A(PG8_SA(1, 1), kb1, cv[1]);
            PG8_WAIT_V(8); PG8_WAIT_L(0); PG8_BAR; PG8_MMA(0, 0, At, B0); PG8_MMA(0, 1, At, B1); PG8_BAR; PG8_SCHED;
            PG8_LDA(At, 0, 1); PG8_STAGE_B(PG8_SB(0, 0), b2); PG8_STAGE_B(PG8_SB(0, 1), b2 + hstep); PG8_STAGE_A(PG8_SA(0, 0), kb2, o2[0]);
            PG8_WAIT_V(8); PG8_WAIT_L(0); PG8_BAR; PG8_MMA(1, 0, At, B0); PG8_MMA(1, 1, At, B1); PG8_BAR; PG8_SCHED;
            PG8_LDB(B0, 1, 0); PG8_LDB(B1, 1, 1); PG8_SCHED; PG8_LDA(At, 1, 0); PG8_STAGE_A(PG8_SA(0, 1), kb2, o2[1]);
            PG8_WAIT_V(8); PG8_WAIT_L(0); PG8_BAR; PG8_MMA(0, 0, At, B0); PG8_MMA(0, 1, At, B1); PG8_BAR; PG8_SCHED;
            PG8_LDA(At, 1, 1); PG8_STAGE_B(PG8_SB(1, 0), b3); PG8_STAGE_B(PG8_SB(1, 1), b3 + hstep); PG8_STAGE_A(PG8_SA(1, 0), kb3, o2[0]);
            PG8_WAIT_V(8); PG8_WAIT_L(0); PG8_BAR; PG8_MMA(1, 0, At, B0); PG8_MMA(1, 1, At, B1); PG8_BAR; PG8_SCHED;
            } else {
            PG8_LDB(B0, 0, 0); PG8_SCHED; PG8_LDA(At, 0, 0); PG8_STAGE_A(PG8_SA(1, 1), kb1, cv[1]);
            PG8_WAIT_L(8); PG8_BAR; PG8_WAIT_L(0); PG8_MMA(0, 0, At, B0); PG8_BAR; PG8_SCHED;
            PG8_LDB(B1, 0, 1); PG8_STAGE_B(PG8_SB(0, 0), b2);
            PG8_BAR; PG8_WAIT_L(0); PG8_MMA(0, 1, At, B1); PG8_BAR;
            PG8_LDA(At, 0, 1); PG8_STAGE_A(PG8_SA(0, 0), kb2, o2[0]);
            PG8_BAR; PG8_WAIT_L(0); PG8_MMA(1, 0, At, B0); PG8_BAR; PG8_SCHED;
            PG8_STAGE_B(PG8_SB(0, 1), b2 + hstep);
            PG8_WAIT_V(6); PG8_BAR; PG8_MMA(1, 1, At, B1); PG8_BAR;
            PG8_LDB(B0, 1, 0); PG8_SCHED; PG8_LDA(At, 1, 0); PG8_STAGE_A(PG8_SA(0, 1), kb2, o2[1]);
            PG8_WAIT_L(8); PG8_BAR; PG8_WAIT_L(0); PG8_MMA(0, 0, At, B0); PG8_BAR; PG8_SCHED;
            PG8_LDB(B1, 1, 1); PG8_STAGE_B(PG8_SB(1, 0), b3);
            PG8_BAR; PG8_WAIT_L(0); PG8_MMA(0, 1, At, B1); PG8_BAR;
            PG8_LDA(At, 1, 1); PG8_STAGE_A(PG8_SA(1, 0), kb3, o2[0]);
            PG8_BAR; PG8_WAIT_L(0); PG8_MMA(1, 0, At, B0); PG8_BAR; PG8_SCHED;
            PG8_STAGE_B(PG8_SB(1, 1), b3 + hstep);
            PG8_WAIT_V(6); PG8_BAR; PG8_MMA(1, 1, At, B1); PG8_BAR;
            }
        }
        if constexpr (ALIGN_EPI) { if (wr == 0) PG8_BAR; }
        E(acc, cur, wr, wc, fr, fq);
        if (!has_next) break;
#pragma unroll
        for (int a = 0; a < 2; ++a)
#pragma unroll
            for (int b = 0; b < 2; ++b)
#pragma unroll
                for (int m = 0; m < 4; ++m)
#pragma unroll
                    for (int n = 0; n < 2; ++n) acc[a][b][m][n] = (f32x4){0.f, 0.f, 0.f, 0.f};
        cur = nxt; cB = nB; ++ui;
#pragma unroll
        for (int h = 0; h < 2; ++h)
#pragma unroll
            for (int i = 0; i < 2; ++i) cv[h][i] = nv[h][i];
        if constexpr (ALIGN_EPI) { if (wr == 1) PG8_BAR; }
    }
    PG8_WAIT_V(0);
    if constexpr (!ALIGN_EPI) { if (wr == 0) PG8_BAR; }
    PG8_BAR;
#undef PG8_SA
#undef PG8_SB
#undef PG8_STAGE_A
#undef PG8_STAGE_B
#undef PG8_LDA
#undef PG8_LDB
#undef PG8_MMA
#undef PG8_WAIT_V
#undef PG8_WAIT_L
#undef PG8_BAR
#undef PG8_SCHED
#undef PG8_AOFFS
}
}

__device__ __forceinline__ void transpose_item(const float* W, int pitch, int k0, int n0, bf16_t* WT, int Kd, int drow0, LAS float* scr, int lane) {
#pragma unroll 8
    for (int i = 0; i < 32; ++i) { const int kk = 2 * i + (lane >> 5); scr[kk * 33 + (lane & 31)] = W[(size_t)(k0 + kk) * pitch + n0 + (lane & 31)]; }
    asm volatile("s_waitcnt lgkmcnt(0)" ::: "memory");
    const int c = lane & 7;
#pragma unroll
    for (int j = 0; j < 4; ++j) { const int n = (lane >> 3) + 8 * j; const LAS float* s = scr + (8 * c) * 33 + n;
        u32x4 o; o.x = pk2(s[0 * 33], s[1 * 33]); o.y = pk2(s[2 * 33], s[3 * 33]); o.z = pk2(s[4 * 33], s[5 * 33]); o.w = pk2(s[6 * 33], s[7 * 33]);
        *(u32x4*)(WT + (size_t)(drow0 + n) * Kd + k0 + 8 * c) = o; }
    asm volatile("s_waitcnt lgkmcnt(0)" ::: "memory");
}
constexpr size_t WT_WIN = 0, WT_WOUT = WT_WIN + (size_t)2 * NP * D, WT_FGU = WT_WOUT + (size_t)2 * D * D, WT_FD = WT_FGU + (size_t)2 * D_FF * D,
                 WT_MGU = WT_FD + (size_t)D * D_FF, WT_MD = WT_MGU + (size_t)NE * 2 * D_FFE * D, WT_END = WT_MD + (size_t)NE * D * D_FFE;
static_assert(WT_END * 2 <= 80 * MiB, "weight copies fit");
__device__ __forceinline__ void ph_pro_weights(const Args& a, Frame& F) {
    LAS float* scr = (LAS float*)(F.lds + F.wave * 16384);
    bf16_t* WT = (bf16_t*)(F.ws + WS_WT);
    constexpr int I_IN0 = 16 * 48, I_IN1 = 16 * 24, I_OUT = 16 * 32, I_FG = 16 * 88, I_FD = 44 * 32, I_M = 16 * 32;
    constexpr int NITEMS = 2 * (I_IN0 + I_IN1 + I_OUT) + 2 * I_FG + I_FD + 24 * I_M;
    for (int it = F.gw; it < NITEMS; it += F.ngw) {
        int r = it; const float* src; int pitch, k0, n0, Kd, drow0; bf16_t* dst;
        if (r < 2 * I_IN0) { const int l = r / I_IN0; r %= I_IN0; src = a.w_in + (size_t)l * D * N_IN; pitch = N_IN; k0 = (r / 48) * 64; n0 = (r % 48) * 32; dst = WT + WT_WIN + (size_t)l * NP * D; Kd = D; drow0 = n0; }
        else if ((r -= 2 * I_IN0) < 2 * I_IN1) { const int l = r / I_IN1; r %= I_IN1; src = a.w_in + (size_t)l * D * N_IN + 1544; pitch = N_IN; k0 = (r / 24) * 64; n0 = (r % 24) * 32; dst = WT + WT_WIN + (size_t)l * NP * D; Kd = D; drow0 = 1536 + n0; }
        else if ((r -= 2 * I_IN1) < 2 * I_OUT) { const int l = r / I_OUT; r %= I_OUT; src = a.w_out + (size_t)l * D * D; pitch = D; k0 = (r / 32) * 64; n0 = (r % 32) * 32; dst = WT + WT_WOUT + (size_t)l * D * D; Kd = D; drow0 = n0; }
        else if ((r -= 2 * I_OUT) < 2 * I_FG) { const int up = r / I_FG; r %= I_FG; src = up ? a.ffn_wu : a.ffn_wg; pitch = D_FF; k0 = (r / 88) * 64; n0 = (r % 88) * 32; dst = WT + WT_FGU; Kd = D; drow0 = (n0 / 128) * 256 + up * 128 + (n0 % 128); }
        else if ((r -= 2 * I_FG) < I_FD) { src = a.ffn_wd; pitch = D; k0 = (r / 32) * 64; n0 = (r % 32) * 32; dst = WT + WT_FD; Kd = D_FF; drow0 = n0; }
        else if ((r -= I_FD) < 16 * I_M) { const int e = r / (2 * I_M); r %= 2 * I_M; const int up = r / I_M; r %= I_M; src = (up ? a.moe_wu : a.moe_wg) + (size_t)e * D * D_FFE; pitch = D_FFE; k0 = (r / 32) * 64; n0 = (r % 32) * 32;
            dst = WT + WT_MGU + (size_t)e * 2 * D_FFE * D; Kd = D; drow0 = (n0 / 128) * 256 + up * 128 + (n0 % 128); }
        else { r -= 16 * I_M; const int e = r / I_M; r %= I_M; src = a.moe_wd + (size_t)e * D_FFE * D; pitch = D; k0 = (r / 32) * 64; n0 = (r % 32) * 32; dst = WT + WT_MD + (size_t)e * D * D_FFE; Kd = D_FFE; drow0 = n0; }
        transpose_item(src, pitch, k0, n0, dst, Kd, drow0, scr, F.lane);
    }
}

template <int NT> __device__ __forceinline__ void moe_order_init(Frame& F, pg8::MoeOrder<NT>& S) {
    const unsigned* c = (const unsigned*)(F.ws + WS_CTL) + CW_MOECNT;
    int acc = 0;
#pragma unroll
    for (int e = 0; e < 8; ++e) { S.bt[e] = acc; acc += ((int)__hip_atomic_load(c + 64 * e, __ATOMIC_RELAXED, __HIP_MEMORY_SCOPE_AGENT) + 255) >> 8; }
    S.bt[8] = acc; S.G = F.nb; S.c = F.bid;
}
template <int NT> __device__ __forceinline__ void moe_ri_preload(Frame& F, const pg8::MoeOrder<NT>& S) {
    LAS int* RI = (LAS int*)(F.lds + RI_OFF); const int* RM = (const int*)(F.ws + WS_RMAP);
    for (int i = 0; i < 15; ++i) { pg8::Unit u; if (!S.next(i, u)) break; if (F.tid < 256) RI[i * 256 + F.tid] = RM[u.pm * 256 + F.tid]; }
    __syncthreads();
}

__global__ void __launch_bounds__(NTHREADS, 2) fwd(Args a) {
    extern __shared__ __attribute__((aligned(16))) unsigned char lds_raw[];
    Frame F;
    F.lds = (LAS unsigned char*)lds_raw;
    F.tid = threadIdx.x; F.lane = F.tid & 63; F.wave = __builtin_amdgcn_readfirstlane(F.tid >> 6);
    F.bid = blockIdx.x; F.nb = gridDim.x; F.gw = F.bid * NWAVES + F.wave; F.ngw = F.nb * NWAVES; F.ws = a.ws;
    volatile LAS unsigned* MISC = (volatile LAS unsigned*)(F.lds + MISC_OFF);
    for (int u = F.tid; u < 32; u += NTHREADS) MISC[u] = 0u;
    __syncthreads();
    unsigned* ctl = (unsigned*)(a.ws + WS_CTL);
    const int lo = a.ph_lo, hi = a.ph_hi;
    const bool multi = (hi - lo) > 1;
    XcdBarrier bar; bar.bar = ctl + CW_BAR; bar.x = 0; bar.st = MISC + 8;
    if (multi) bar = xcd_barrier_post(ctl + CW_BAR, MISC + 8);
#define IN(k) (lo <= (k) && (k) < hi && (frame_refresh(F, a, (LAS unsigned char*)lds_raw), true))
#define SEAM(k) do { if (IN((k) + 1) && IN(k)) xcd_barrier(bar); } while (0)
    float* MOD = (float*)(a.ws + WS_MOD);
    bf16_t* H = (bf16_t*)(a.ws + WS_H); bf16_t* PROJ = (bf16_t*)(a.ws + WS_PROJ); bf16_t* YMIX = (bf16_t*)(a.ws + WS_YMIX);
    bf16_t* WT = (bf16_t*)(a.ws + WS_WT);
    bf16_t* ACT = (bf16_t*)(a.ws + WS_ACT); bf16_t* ACTM = (bf16_t*)(a.ws + WS_ACTM); bf16_t* YMOE = (bf16_t*)(a.ws + WS_YMOE);

    if (IN(PH_PRO)) { ph_pro_naive(a, F); if (GEMM_MASK) ph_pro_weights(a, F); SEAM(PH_PRO); }

#define LAYER_BODY(l) {\
        const int pb = PH_LAYER0 + PH_PER_LAYER * l; \
        const float* xin = (l == 0) ? a.x : a.out; \
        const float* mod0 = MOD + (size_t)(l * 2 + 0) * 2 * 3072; const float* mod1 = MOD + (size_t)(l * 2 + 1) * 2 * 3072; \
        if (IN(pb + K_NORM1)) { ph_norm<1>(a, F, l, xin, a.nmg + l * D, mod0, a.w_in + (size_t)l * D * N_IN + W_DB, N_IN); SEAM(pb + K_NORM1); } \
        if (IN(pb + K_GEMM_IN)) { \
            if constexpr ((GEMM_MASK & 1) != 0) { pg8::Gemm g{H, WT + WT_WIN + (size_t)l * NP * D, D}; pg8::StaticOrder S; S.init(T, NP, F.nb, F.bid); pg8::EpiBf16 E{PROJ, NP, 1 << 20}; \
                pg8::gemm_phase<pg8::EpiBf16, pg8::StaticOrder, false, true, true>(F.lds, nullptr, g, S, E); } else { \
            EpiStoreBf16 E{PROJ, NP}; \
            gemm_naive<false>(F, H, D, nullptr, 0, T, D, a.w_in + (size_t)l * D * N_IN, nullptr, N_IN, NP, 1536, 8, E); } \
            SEAM(pb + K_GEMM_IN); \
        } \
        if (IN(pb + K_DN_PREP)) { ph_dn_prep_naive(a, F, l); if (ATTN_MFMA) ph_rope(a, F); SEAM(pb + K_DN_PREP); } \
        if (IN(pb + K_MIX)) { ph_dn_scan_naive(a, F); if (ATTN_MFMA) ph_attn_mfma(a, F, l); else ph_attn_naive(a, F, l); ph_conv_naive(a, F, l); SEAM(pb + K_MIX); } \
        if (IN(pb + K_DN_OUT)) { ph_dn_out_naive(a, F, l); SEAM(pb + K_DN_OUT); } \
        if (IN(pb + K_GEMM_OUT)) { \
            if constexpr ((GEMM_MASK & 2) != 0) { pg8::Gemm g{YMIX, WT + WT_WOUT + (size_t)l * D * D, D}; pg8::StaticOrder S; S.init(T, D, F.nb, F.bid); pg8::EpiResidF32 E{xin, a.out, mod0 + 2048}; \
                pg8::gemm_phase<pg8::EpiResidF32, pg8::StaticOrder, false, true, true>(F.lds, nullptr, g, S, E); } else { \
            EpiResid E{xin, a.out, mod0 + 2048}; \
            gemm_naive<false>(F, YMIX, D, nullptr, 0, T, D, a.w_out + (size_t)l * D * D, nullptr, D, D, 1 << 30, 0, E); } \
            SEAM(pb + K_GEMM_OUT); \
        } \
        if (l == 0) { \
            if (IN(pb + K_NORM2)) { ph_norm<0>(a, F, l, a.out, a.nfg + l * D, mod1, nullptr, 0); SEAM(pb + K_NORM2); } \
            if (IN(pb + K_MOE_LIST)) { SEAM(pb + K_MOE_LIST); } \
            if (IN(pb + K_FFN1)) { \
                if constexpr ((GEMM_MASK & 4) != 0) { pg8::Gemm g{H, WT + WT_FGU, D}; pg8::StaticOrder S; S.init(T, 2 * D_FF, F.nb, F.bid); pg8::EpiSwiGLU E{ACT, D_FF, 1 << 20}; \
                    pg8::gemm_phase<pg8::EpiSwiGLU, pg8::StaticOrder, false, true, true>(F.lds, nullptr, g, S, E); } else { \
                EpiSwiglu E{ACT, D_FF}; \
                gemm_naive<true>(F, H, D, nullptr, 0, T, D, a.ffn_wg, a.ffn_wu, D_FF, D_FF, 1 << 30, 0, E); } \
                SEAM(pb + K_FFN1); \
            } \
            if (IN(pb + K_FFN2)) { \
                if constexpr ((GEMM_MASK & 8) != 0) { pg8::Gemm g{ACT, WT + WT_FD, D_FF}; pg8::StaticOrder S; S.init(T, D, F.nb, F.bid); pg8::EpiResidF32 E{a.out, a.out, mod1 + 2048}; \
                    pg8::gemm_phase<pg8::EpiResidF32, pg8::StaticOrder, false, true, true>(F.lds, nullptr, g, S, E); } else { \
                EpiResid E{a.out, a.out, mod1 + 2048}; \
                gemm_naive<false>(F, ACT, D_FF, nullptr, 0, T, D_FF, a.ffn_wd, nullptr, D, D, 1 << 30, 0, E); } \
                SEAM(pb + K_FFN2); \
            } \
        } else { \
            if (IN(pb + K_NORM2)) { ph_norm<2>(a, F, l, a.out, a.nfg + l * D, mod1, a.router_w, NE); SEAM(pb + K_NORM2); } \
            if (IN(pb + K_MOE_LIST)) { ph_moe_list(a, F); SEAM(pb + K_MOE_LIST); } \
            if (IN(pb + K_FFN1)) { \
                if constexpr ((GEMM_MASK & 16) != 0) { pg8::MoeOrder<8> S; moe_order_init<8>(F, S); moe_ri_preload<8>(F, S); \
                    pg8::Gemm g{H, WT + WT_MGU, D}; pg8::EpiSwiGLU E{ACTM, D_FFE, 8}; \
                    pg8::gemm_phase<pg8::EpiSwiGLU, pg8::MoeOrder<8>, true, true, true>(F.lds, (const LAS int*)(F.lds + RI_OFF), g, S, E); } else { \
                const int* RM = (const int*)(a.ws + WS_RMAP); \
                EpiSwiglu E{ACTM, D_FFE}; \
                for (int e = 0; e < NE; ++e) { int elo, ehi; moe_range(F, e, elo, ehi); \
                    gemm_naive<true>(F, H, D, RM, elo, ehi - elo, D, a.moe_wg + (size_t)e * D * D_FFE, a.moe_wu + (size_t)e * D * D_FFE, D_FFE, D_FFE, 1 << 30, 0, E); } } \
                SEAM(pb + K_FFN1); \
            } \
            if (IN(pb + K_FFN2)) { \
                if constexpr ((GEMM_MASK & 32) != 0) { pg8::MoeOrder<4> S; moe_order_init<4>(F, S); \
                    pg8::Gemm g{ACTM, WT + WT_MD, D_FFE}; pg8::EpiBf16 E{YMOE, D, 4}; \
                    pg8::gemm_phase<pg8::EpiBf16, pg8::MoeOrder<4>, false, true, true>(F.lds, nullptr, g, S, E); } else { \
                EpiStoreBf16 E{YMOE, D}; \
                for (int e = 0; e < NE; ++e) { int elo, ehi; moe_range(F, e, elo, ehi); \
                    gemm_naive<false>(F, ACTM, D_FFE, nullptr, elo, ehi - elo, D_FFE, a.moe_wd + (size_t)e * D_FFE * D, nullptr, D, D, 1 << 30, 0, E); } } \
                SEAM(pb + K_FFN2); \
            } \
        } \
    }
    LAYER_BODY(0)
    LAYER_BODY(1)
#undef LAYER_BODY
    if (IN(PH_FINAL)) { ph_final(a, F); }
#undef IN
#undef SEAM
}

extern "C" void kernel_launch(void* const* d_in, const int* in_sizes, int n_in, void* d_out, int out_size, void* d_ws, size_t ws_size, hipStream_t stream) {
    static int grid = 0;
    if (grid == 0) {
        if (n_in != 27 || out_size != T * D || ws_size < WS_END) { fprintf(stderr, "kernel_launch: unexpected shapes n_in %d out %d ws %zu\n", n_in, out_size, ws_size); grid = -1; return; }
        int dev = 0, cus = 0, per_cu = 0;
        if (hipGetDevice(&dev) != hipSuccess || hipDeviceGetAttribute(&cus, hipDeviceAttributeMultiprocessorCount, dev) != hipSuccess) { grid = -1; return; }
        if (hipFuncSetAttribute((const void*)fwd, hipFuncAttributeMaxDynamicSharedMemorySize, LDS_BYTES) != hipSuccess) { fprintf(stderr, "kernel_launch: hipFuncSetAttribute failed\n"); grid = -1; return; }
        if (hipOccupancyMaxActiveBlocksPerMultiprocessor(&per_cu, (const void*)fwd, NTHREADS, LDS_BYTES) != hipSuccess || per_cu < 1) fprintf(stderr, "kernel_launch: occupancy query says %d\n", per_cu);
        (void)hipGetLastError();
        grid = cus;
    }
    if (grid < 0) return;
    (void)hipMemsetAsync((char*)d_ws + WS_CTL, 0, CTL_ZERO_BYTES, stream);
    Args a{};
    const void** pp = (const void**)&a;
    for (int i = 0; i < 27; ++i) pp[i] = d_in[i];
    a.out = (float*)d_out; a.ws = (unsigned char*)d_ws;
#if MK_ONE_LAUNCH
    a.ph_lo = 0; a.ph_hi = NPH;
    hipLaunchKernelGGL(fwd, dim3(grid), dim3(NTHREADS), LDS_BYTES, stream, a);
#else
    static const int phases[] = {0, 1, 2, 3, 4, 5, 6, 7, 9, 10, 11, 12, 13, 14, 15, 16, 17, 18, 19, 20, 21};
    for (int p : phases) { a.ph_lo = p; a.ph_hi = p + 1; hipLaunchKernelGGL(fwd, dim3(grid), dim3(NTHREADS), LDS_BYTES, stream, a); }
#endif
}
```

```cpp
#include <hip/hip_runtime.h>
#include <cstdio>
#include <cstdint>

#define LAS __attribute__((address_space(3)))
#define GAS __attribute__((address_space(1)))
typedef unsigned short bf16_t;
typedef float f32x4 __attribute__((ext_vector_type(4)));
typedef unsigned u32x2 __attribute__((ext_vector_type(2)));
typedef unsigned u32x4 __attribute__((ext_vector_type(4)));

#ifndef GEMM_MASK
#define GEMM_MASK 63
#endif
#ifndef ATTN_MFMA
#define ATTN_MFMA 1
#endif
#ifndef DN_CHUNKED
#define DN_CHUNKED 1
#endif
#ifndef MK_ONE_LAUNCH
#define MK_ONE_LAUNCH 1
#endif

constexpr int BATCH = 2, SEQ = 16384, T = BATCH * SEQ, D = 1024, DEPTH = 2;
constexpr int N_IN = 2312, NP = 2304;
constexpr int C_AQ = 0, C_AK = 512, C_AV = 640, C_DQ = 768, C_DK = 1024, C_DV = 1280, C_DZ = 1536, C_CA = 1792, C_CB = 2048;
constexpr int W_DB = 1536;
constexpr int D_FF = 2816, NE = 8, D_FFE = 1024;
constexpr int WINDOW = 128, CV_K = 31, CV_C = 256, DN_CONV = 4;
constexpr float EPS = 1e-6f;
constexpr int MOE_CAP = 67584;

constexpr size_t MiB = 1u << 20;
constexpr size_t WS_CTL = 0, CTL_ZERO_BYTES = 1 * MiB;
constexpr size_t WS_MOD = 1 * MiB;
constexpr size_t WS_CS = 2 * MiB;
constexpr size_t WS_BG = 4 * MiB;
constexpr size_t WS_ROUTE = 5 * MiB;
constexpr size_t WS_POS = 6 * MiB;
constexpr size_t WS_RMAP = 7 * MiB;
constexpr size_t WS_WT = 8 * MiB;
constexpr size_t WS_H = 88 * MiB;
constexpr size_t WS_PROJ = 152 * MiB;
constexpr size_t WS_YMIX = 296 * MiB;
constexpr size_t WS_DNQKV = 360 * MiB;
constexpr size_t WS_ODN = 456 * MiB;
constexpr size_t WS_ACT = 152 * MiB;
constexpr size_t WS_ACTM = 152 * MiB;
constexpr size_t WS_YMOE = 284 * MiB;
constexpr size_t WS_END = 512 * MiB;
constexpr int CW_BAR = 4096;
constexpr int CW_MOECNT = 16384;

constexpr int NWAVES = 8, NTHREADS = 512;
constexpr int LDS_BYTES = 147456;
constexpr int MISC_OFF = 131072 + 320;
constexpr int RI_OFF = 132096;

constexpr int PH_PRO = 0, PH_LAYER0 = 1, PH_PER_LAYER = 10, PH_FINAL = 21, NPH = 22;
enum { K_NORM1 = 0, K_GEMM_IN, K_DN_PREP, K_MIX, K_DN_OUT, K_GEMM_OUT, K_NORM2, K_MOE_LIST, K_FFN1, K_FFN2 };

struct Args {
    const float* x; const float* c; const int* pos; const float* ada_w; const float* ada_b; const float* nmg; const float* nfg;
    const float* w_in; const float* sinks; const float* dn_conv_w; const float* dn_a_log; const float* dn_dt_bias; const float* dn_norm_g;
    const float* cv_dw_w; const float* cv_dw_b; const float* cv_ln_g; const float* cv_ln_b; const float* w_out;
    const float* ffn_wg; const float* ffn_wu; const float* ffn_wd; const float* router_w; const float* router_b;
    const float* moe_wg; const float* moe_wu; const float* moe_wd; const float* final_g;
    float* out; unsigned char* ws; int ph_lo, ph_hi;
};

__device__ __forceinline__ float bf2f(unsigned u) { return __uint_as_float(u << 16); }
__device__ __forceinline__ unsigned f2bf(float f) { unsigned u = __float_as_uint(f); return (u + 0x7fffu + ((u >> 16) & 1u)) >> 16; }
__device__ __forceinline__ unsigned pk2(float lo, float hi) { return f2bf(lo) | (f2bf(hi) << 16); }
__device__ __forceinline__ float wave_sum(float v) {
#pragma unroll
    for (int o = 1; o < 64; o <<= 1) v += __shfl_xor(v, o);
    return v;
}
__device__ __forceinline__ float wave_max(float v) {
#pragma unroll
    for (int o = 1; o < 64; o <<= 1) v = fmaxf(v, __shfl_xor(v, o));
    return v;
}
__device__ __forceinline__ float sigmoidf_(float x) { return 1.0f / (1.0f + __expf(-x)); }
__device__ __forceinline__ float siluf_(float x) { return x / (1.0f + __expf(-x)); }
__device__ __forceinline__ float softplusf_(float x) { return fmaxf(x, 0.f) + log1pf(__expf(-fabsf(x))); }

#define XB_TMO      128
#define XB_XCNT(j)  (256  + 64 * (j))
#define XB_XSUB(j)  (1280 + 64 * (j))
#define XB_XGEN(j)  (2304 + 64 * (j))
#define XB_TOP      3328
#define XB_TOPGEN   3392
#define XCD_BAR_WORDS 3456
#define XB_SPIN_CAP (1u << 18)

__device__ __forceinline__ unsigned xb_ld(unsigned* p)              { return __hip_atomic_load(p, __ATOMIC_RELAXED, __HIP_MEMORY_SCOPE_AGENT); }
__device__ __forceinline__ unsigned xb_add(unsigned* p, unsigned v) { return __hip_atomic_fetch_add(p, v, __ATOMIC_RELAXED, __HIP_MEMORY_SCOPE_AGENT); }
__device__ __forceinline__ unsigned xb_xcc_id() { return (unsigned)__builtin_amdgcn_s_getreg((3 << 11) | 20) & 0xFu; }
#define XB_SPIN(cond, bar) do { unsigned _sp = 0; while (cond) { __builtin_amdgcn_s_sleep(1); \
    if ((++_sp & 255u) == 0u) { if (xb_ld(&(bar)[XB_TMO])) break; if (_sp > XB_SPIN_CAP) { atomicAdd(&(bar)[XB_TMO], 1u); break; } } } } while (0)

struct XcdBarrier { unsigned* bar; unsigned x; volatile LAS unsigned* st; };

__device__ __forceinline__ XcdBarrier xcd_barrier_post(unsigned* bar, volatile LAS unsigned* st) {
    XcdBarrier b; b.bar = bar; b.x = xb_xcc_id(); b.st = st;
    if (threadIdx.x == 0) (void)xb_add(&bar[XB_XCNT(b.x)], 1u);
    return b;
}
__device__ __forceinline__ void xcd_barrier_complete(unsigned* bar, unsigned x, unsigned& nloc, unsigned& nx) {
    const unsigned G = gridDim.x * gridDim.y * gridDim.z;
    unsigned sum, cnt, mine, sp = 0u;
    for (;;) {
        sum = 0u; cnt = 0u; mine = 0u;
#pragma unroll
        for (unsigned j = 0; j < 16; ++j) { const unsigned c = xb_ld(&bar[XB_XCNT(j)]); sum += c; cnt += (c > 0u) ? 1u : 0u; mine = (j == x) ? c : mine; }
        if (sum == G) break;
        __builtin_amdgcn_s_sleep(1);
        if ((++sp & 255u) == 0u) { if (xb_ld(&bar[XB_TMO])) break; if (sp > XB_SPIN_CAP) { atomicAdd(&bar[XB_TMO], 1u); break; } }
    }
    nloc = mine > 0u ? mine : 1u; nx = cnt > 0u ? cnt : 1u;
}
__device__ __forceinline__ void xcd_barrier(const XcdBarrier& b) {
    asm volatile("s_waitcnt vmcnt(0)" ::: "memory");
    __syncthreads();
    if (threadIdx.x == 0) {
        unsigned* bar = b.bar;
        __builtin_amdgcn_s_waitcnt(0);
        unsigned nloc = b.st[0], nx = b.st[1];
        if (nloc == 0u) { xcd_barrier_complete(bar, b.x, nloc, nx); b.st[0] = nloc; b.st[1] = nx; }
        const unsigned old = xb_add(&bar[XB_XSUB(b.x)], 1u);
        const unsigned gen = old / nloc;
        if (old + 1u == (gen + 1u) * nloc) {
            __builtin_amdgcn_fence(__ATOMIC_RELEASE, "agent");
            asm volatile("s_waitcnt vmcnt(0)" ::: "memory");
            const unsigned og = xb_add(&bar[XB_TOP], 1u);
            const unsigned tg = og / nx;
            if (og + 1u == (tg + 1u) * nx) xb_add(&bar[XB_TOPGEN], 1u);
            else XB_SPIN(xb_ld(&bar[XB_TOPGEN]) == tg, bar);
            __builtin_amdgcn_fence(__ATOMIC_ACQUIRE, "agent");
            xb_add(&bar[XB_XGEN(b.x)], 1u);
            asm volatile("s_waitcnt vmcnt(0)" ::: "memory");
        } else {
            XB_SPIN(xb_ld(&bar[XB_XGEN(b.x)]) == gen, bar);
            __builtin_amdgcn_fence(__ATOMIC_ACQUIRE, "agent");
            asm volatile("s_waitcnt vmcnt(0)" ::: "memory");
        }
    }
    __syncthreads();
}

struct Frame {
    LAS unsigned char* lds;
    int tid, lane, wave, gw, ngw, bid, nb;
    unsigned char* ws;
};

__device__ __forceinline__ void frame_refresh(Frame& F, const Args& a, LAS unsigned char* lds) {
    int tid = threadIdx.x; asm volatile("" : "+v"(tid));
    int bid = blockIdx.x; asm volatile("" : "+s"(bid));
    unsigned char* ws = a.ws; asm volatile("" : "+s"(ws));
    F.lds = lds; F.tid = tid; F.lane = tid & 63; F.wave = __builtin_amdgcn_readfirstlane(tid >> 6);
    F.bid = bid; F.nb = gridDim.x; F.gw = F.bid * NWAVES + F.wave; F.ngw = F.nb * NWAVES; F.ws = ws;
}
__device__ __forceinline__ void ph_pro_naive(const Args& a, Frame& F) {
    float* MOD = (float*)(F.ws + WS_MOD);
    LAS float* red = (LAS float*)F.lds;
    for (int it = F.bid; it < 4 * 48; it += F.nb) {
        const int lk = it / 48, cg = it % 48, e = cg * 64 + F.lane;
        const float* W = a.ada_w + (size_t)lk * D * 3072 + e;
        float a0 = 0.f, a1 = 0.f;
        const int d0 = F.wave * 128;
#pragma unroll 8
        for (int d = d0; d < d0 + 128; ++d) {
            const float w = W[(size_t)d * 3072];
            a0 += siluf_(a.c[d]) * w; a1 += siluf_(a.c[D + d]) * w;
        }
        red[(F.wave * 2 + 0) * 64 + F.lane] = a0; red[(F.wave * 2 + 1) * 64 + F.lane] = a1;
        __syncthreads();
        if (F.wave < 2) {
            float s = 0.f;
            for (int w = 0; w < 8; ++w) s += red[(w * 2 + F.wave) * 64 + F.lane];
            MOD[((size_t)lk * 2 + F.wave) * 3072 + e] = s + a.ada_b[lk * 3072 + e];
        }
        __syncthreads();
    }
    float* CS = (float*)(F.ws + WS_CS);
    for (int idx = F.bid * NTHREADS + F.tid; idx < T * 8; idx += F.nb * NTHREADS) {
        const int t = idx >> 3, i = idx & 7;
        const float inv = powf(500000.0f, -(float)(2 * i) / 16.0f);
        const float ang = (float)a.pos[t] * inv;
        CS[t * 16 + i] = cosf(ang); CS[t * 16 + 8 + i] = sinf(ang);
    }
}

template <int MODE>
__device__ __forceinline__ void ph_norm(const Args& a, Frame& F, int l, const float* xin, const float* gain, const float* modk  ,
                                        const float* W8, int pitch) {
    bf16_t* H = (bf16_t*)(F.ws + WS_H);
    LAS float* W8T = (LAS float*)F.lds;
    if (MODE != 0) {
        for (int i = F.tid; i < 8192; i += NTHREADS) { const int d = i >> 3, j = i & 7; W8T[j * 1024 + d] = W8[(size_t)d * pitch + j]; }
        __syncthreads();
    }
    for (int row = F.gw; row < T; row += F.ngw) {
        const int b = row / SEQ;
        const f32x4* xr = (const f32x4*)(xin + (size_t)row * D) + F.lane;
        f32x4 v[4]; float ss = 0.f;
#pragma unroll
        for (int j = 0; j < 4; ++j) { v[j] = xr[64 * j]; ss += (v[j].x * v[j].x + v[j].y * v[j].y) + (v[j].z * v[j].z + v[j].w * v[j].w); }
        const float rstd = rsqrtf(wave_sum(ss) * (1.0f / D) + EPS);
        const float* sh = modk + (size_t)b * 3072; const float* sc = sh + 1024;
        float acc[8];
#pragma unroll
        for (int e = 0; e < 8; ++e) acc[e] = 0.f;
#pragma unroll
        for (int j = 0; j < 4; ++j) {
            const int d = 256 * j + 4 * F.lane;
            const f32x4 g4 = *(const f32x4*)(gain + d), s4 = *(const f32x4*)(sc + d), h4 = *(const f32x4*)(sh + d);
            f32x4 hv = (v[j] * rstd) * g4; hv = hv * (s4 + 1.0f) + h4;
            u32x2 o; o.x = pk2(hv.x, hv.y); o.y = pk2(hv.z, hv.w);
            *(u32x2*)(H + (size_t)row * D + d) = o;
            if (MODE != 0) {
#pragma unroll
                for (int e = 0; e < 8; ++e) { const f32x4 w4 = *(const LAS f32x4*)(W8T + e * 1024 + d); acc[e] += (hv.x * w4.x + hv.y * w4.y) + (hv.z * w4.z + hv.w * w4.w); }
            }
            asm volatile("" ::: "memory");
        }
        if (MODE != 0) {
#pragma unroll
            for (int e = 0; e < 8; ++e) acc[e] = wave_sum(acc[e]);
        }
        if (MODE == 1 && F.lane == 0) {
            float* BG = (float*)(F.ws + WS_BG) + (size_t)row * 8;
#pragma unroll
            for (int h = 0; h < 4; ++h) {
                BG[h] = sigmoidf_(acc[h]);
                BG[4 + h] = -__expf(a.dn_a_log[l * 4 + h]) * softplusf_(acc[4 + h] + a.dn_dt_bias[l * 4 + h]);
            }
        }
        if (MODE == 2 && F.lane == 0) {
            float v0 = -INFINITY, v1 = -INFINITY; int e0 = 0, e1 = 0;
#pragma unroll
            for (int e = 0; e < 8; ++e) { const float lg = acc[e] + a.router_b[e]; if (lg > v0) { v1 = v0; e1 = e0; v0 = lg; e0 = e; } else if (lg > v1) { v1 = lg; e1 = e; } }
            const float ex = __expf(v1 - v0), p0 = 1.0f / (1.0f + ex), p1 = ex / (1.0f + ex);
            unsigned* cnt = (unsigned*)(F.ws + WS_CTL) + CW_MOECNT;
            const int q0 = (int)atomicAdd(cnt + 64 * e0, 1u), q1 = (int)atomicAdd(cnt + 64 * e1, 1u);
            int* R = (int*)(F.ws + WS_ROUTE) + (size_t)row * 4; R[0] = e0; R[1] = e1; ((float*)R)[2] = p0; ((float*)R)[3] = p1;
            int* P = (int*)(F.ws + WS_POS) + (size_t)row * 2; P[0] = q0; P[1] = q1;
        }
    }
    if (MODE != 0) __syncthreads();
}

template <bool DUAL, class Epi>
__device__ __forceinline__ void gemm_naive(Frame& F, const bf16_t* A, int lda, const int* rowmap, int m_base, int Mrows, int K,
                                           const float* W0, const float* W1, int ldw, int N, int skip_at, int skip, const Epi& epi) {
    LAS float* As = (LAS float*)F.lds;
    LAS float* Bs = As + 16 * 132;
    LAS float* Bs2 = Bs + 16 * 128;
    const int ntm = Mrows / 128, ntn = N / 128;
    const int ty = F.tid >> 4, tx = F.tid & 15;
    const int ar = F.tid >> 2, ak = (F.tid & 3) * 4;
    const int bk = F.tid >> 5, bc = (F.tid & 31) * 4;
    for (int tile = F.bid; tile < ntm * ntn; tile += F.nb) {
        const int tm = tile / ntn, tn = tile % ntn, m0 = m_base + tm * 128, n0 = tn * 128;
        const int wn0 = (n0 >= skip_at) ? n0 + skip : n0;
        const int arow = rowmap ? rowmap[m0 + ar] : (m0 + ar);
        const bf16_t* ap = A + (size_t)arow * lda + ak;
        float acc0[4][8], acc1[4][8];
#pragma unroll
        for (int i = 0; i < 4; ++i)
#pragma unroll
            for (int j = 0; j < 8; ++j) { acc0[i][j] = 0.f; acc1[i][j] = 0.f; }
        for (int k0 = 0; k0 < K; k0 += 16) {
            const u32x2 av = *(const u32x2*)(ap + k0);
            const f32x4 bv = *(const f32x4*)(W0 + (size_t)(k0 + bk) * ldw + wn0 + bc);
            f32x4 bv2 = (f32x4){0.f, 0.f, 0.f, 0.f};
            if (DUAL) bv2 = *(const f32x4*)(W1 + (size_t)(k0 + bk) * ldw + wn0 + bc);
            __syncthreads();
            As[(ak + 0) * 132 + ar] = bf2f(av.x & 0xffffu); As[(ak + 1) * 132 + ar] = bf2f(av.x >> 16);
            As[(ak + 2) * 132 + ar] = bf2f(av.y & 0xffffu); As[(ak + 3) * 132 + ar] = bf2f(av.y >> 16);
            *(LAS f32x4*)(Bs + bk * 128 + bc) = bv;
            if (DUAL) *(LAS f32x4*)(Bs2 + bk * 128 + bc) = bv2;
            __syncthreads();
#pragma unroll 2
            for (int kk = 0; kk < 16; ++kk) {
                const f32x4 a4 = *(const LAS f32x4*)(As + kk * 132 + ty * 4);
                const f32x4 b0 = *(const LAS f32x4*)(Bs + kk * 128 + tx * 8), b1 = *(const LAS f32x4*)(Bs + kk * 128 + tx * 8 + 4);
                const float av4[4] = {a4.x, a4.y, a4.z, a4.w};
                const float bb[8] = {b0.x, b0.y, b0.z, b0.w, b1.x, b1.y, b1.z, b1.w};
#pragma unroll
                for (int i = 0; i < 4; ++i)
#pragma unroll
                    for (int j = 0; j < 8; ++j) acc0[i][j] += av4[i] * bb[j];
                if (DUAL) {
                    const f32x4 c0 = *(const LAS f32x4*)(Bs2 + kk * 128 + tx * 8), c1 = *(const LAS f32x4*)(Bs2 + kk * 128 + tx * 8 + 4);
                    const float cc[8] = {c0.x, c0.y, c0.z, c0.w, c1.x, c1.y, c1.z, c1.w};
#pragma unroll
                    for (int i = 0; i < 4; ++i)
#pragma unroll
                        for (int j = 0; j < 8; ++j) acc1[i][j] += av4[i] * cc[j];
                }
            }
        }
#pragma unroll
        for (int i = 0; i < 4; ++i)
#pragma unroll
            for (int j = 0; j < 8; ++j) epi(m0 + ty * 4 + i, n0 + tx * 8 + j, acc0[i][j], acc1[i][j]);
    }
    __syncthreads();
}
struct EpiStoreBf16 { bf16_t* C; int ldc; __device__ __forceinline__ void operator()(int m, int n, float a0, float) const { C[(size_t)m * ldc + n] = (bf16_t)f2bf(a0); } };
struct EpiSwiglu { bf16_t* C; int ldc; __device__ __forceinline__ void operator()(int m, int n, float a0, float a1) const { C[(size_t)m * ldc + n] = (bf16_t)f2bf(siluf_(a0) * a1); } };
struct EpiResid { const float* xin; float* xout; const float* gate;   __device__ __forceinline__ void operator()(int m, int n, float a0, float) const {
    const int b = m / SEQ; xout[(size_t)m * D + n] = xin[(size_t)m * D + n] + gate[(size_t)b * 3072 + n] * a0; } };

__device__ __forceinline__ void ph_dn_prep_naive(const Args& a, Frame& F, int l) {
    const bf16_t* P = (const bf16_t*)(F.ws + WS_PROJ);
    float* Q = (float*)(F.ws + WS_DNQKV);
    const float* cw = a.dn_conv_w + (size_t)l * DN_CONV * 768;
    for (int t = F.gw; t < T; t += F.ngw) {
        const int s = t % SEQ;
#pragma unroll
        for (int j = 0; j < 12; ++j) {
            const int c = F.lane + 64 * j;
            float acc = 0.f;
#pragma unroll
            for (int k = 0; k < DN_CONV; ++k) { const int sp = s - (DN_CONV - 1) + k; if (sp >= 0) acc += cw[k * 768 + c] * bf2f(P[(size_t)(t - (DN_CONV - 1) + k) * NP + C_DQ + c]); }
            float val = siluf_(acc);
            if (j < 8) { const float n2 = wave_sum(val * val); val *= rsqrtf(n2 + EPS); if (j < 4) val *= 0.125f; }
            Q[(size_t)t * 768 + c] = val;
        }
    }
}
__device__ __forceinline__ void ph_dn_scan_naive(const Args& a, Frame& F) {
    const float* Q = (const float*)(F.ws + WS_DNQKV); const float* BG = (const float*)(F.ws + WS_BG); float* O = (float*)(F.ws + WS_ODN);
    for (int task = F.gw; task < BATCH * 4 * 64; task += F.ngw) {
        const int col = task & 63, h = (task >> 6) & 3, b = task >> 8;
        float S = 0.f;
        for (int s0 = 0; s0 < SEQ; s0 += 8) {
            float q8[8], k8[8], v8[8], b8[8], g8[8];
#pragma unroll
            for (int i = 0; i < 8; ++i) { const size_t t = (size_t)b * SEQ + s0 + i; q8[i] = Q[t * 768 + h * 64 + F.lane]; k8[i] = Q[t * 768 + 256 + h * 64 + F.lane]; v8[i] = Q[t * 768 + 512 + h * 64 + col];
                b8[i] = BG[t * 8 + h]; g8[i] = BG[t * 8 + 4 + h]; }
#pragma unroll
            for (int i = 0; i < 8; ++i) {
                const float eg = __expf(g8[i]);
                const float kS = wave_sum(k8[i] * S);
                const float dl = b8[i] * (v8[i] - eg * kS);
                S = eg * S + k8[i] * dl;
                const float o = wave_sum(q8[i] * S);
                if (F.lane == 0) O[((size_t)b * SEQ + s0 + i) * 256 + h * 64 + col] = o;
            }
        }
    }
}
__device__ __forceinline__ void ph_dn_out_naive(const Args& a, Frame& F, int l) {
    const float* O = (const float*)(F.ws + WS_ODN); const bf16_t* P = (const bf16_t*)(F.ws + WS_PROJ); bf16_t* Y = (bf16_t*)(F.ws + WS_YMIX);
    for (int task = F.gw; task < T * 4; task += F.ngw) {
        const int t = task >> 2, h = task & 3;
        const float o = O[(size_t)t * 256 + h * 64 + F.lane];
        const float ms = wave_sum(o * o) * (1.0f / 64.0f);
        const float z = bf2f(P[(size_t)t * NP + C_DZ + h * 64 + F.lane]);
        const float y = o * rsqrtf(ms + EPS) * a.dn_norm_g[l * 64 + F.lane] * siluf_(z);
        Y[(size_t)t * D + 512 + h * 64 + F.lane] = (bf16_t)f2bf(y);
    }
}
__device__ __forceinline__ float rope_lane(float x, int lane, const float* cs) {
    const float xp = __shfl(x, lane ^ 8);
    if (lane < 8) return x * cs[lane] - xp * cs[8 + lane];
    if (lane < 16) return x * cs[lane - 8] + xp * cs[lane];
    return x;
}
__device__ __forceinline__ void ph_attn_naive(const Args& a, Frame& F, int l) {
    const bf16_t* P = (const bf16_t*)(F.ws + WS_PROJ); bf16_t* Y = (bf16_t*)(F.ws + WS_YMIX); const float* CS = (const float*)(F.ws + WS_CS);
    for (int task = F.gw; task < T * 8; task += F.ngw) {
        const int t = task >> 3, hq = task & 7, hk = hq >> 2, s = t % SEQ;
        float q = bf2f(P[(size_t)t * NP + C_AQ + hq * 64 + F.lane]);
        if (!ATTN_MFMA) q = rope_lane(q, F.lane, CS + (size_t)t * 16);
        float sc0 = -INFINITY, sc1 = -INFINITY;
        for (int j = 0; j < WINDOW; ++j) {
            const int sp = s - (WINDOW - 1) + j;
            if (sp < 0) continue;
            const size_t tk = (size_t)t - (WINDOW - 1) + j;
            float k = bf2f(P[tk * NP + C_AK + hk * 64 + F.lane]);
            if (!ATTN_MFMA) k = rope_lane(k, F.lane, CS + tk * 16);
            const float sc = wave_sum(q * k) * 0.125f;
            if (F.lane == (j & 63)) { if (j < 64) sc0 = sc; else sc1 = sc; }
        }
        const float sink = a.sinks[l * 8 + hq];
        const float m = fmaxf(wave_max(fmaxf(sc0, sc1)), sink);
        const float p0 = __expf(sc0 - m), p1 = __expf(sc1 - m);
        const float den = wave_sum(p0 + p1) + __expf(sink - m);
        float o = 0.f;
        for (int j = 0; j < WINDOW; ++j) {
            const int sp = s - (WINDOW - 1) + j;
            if (sp < 0) continue;
            const size_t tk = (size_t)t - (WINDOW - 1) + j;
            const float p = __shfl(j < 64 ? p0 : p1, j & 63);
            o += p * bf2f(P[tk * NP + C_AV + hk * 64 + F.lane]);
        }
        Y[(size_t)t * D + hq * 64 + F.lane] = (bf16_t)f2bf(o / den);
    }
}

typedef float f32x16 __attribute__((ext_vector_type(16)));
typedef short s16x4 __attribute__((ext_vector_type(4)));
typedef short bf16x8_t __attribute__((ext_vector_type(8)));
__device__ __forceinline__ unsigned cvtpk(float lo, float hi) { typedef float f2_t __attribute__((ext_vector_type(2))); typedef __bf16 b2_t __attribute__((ext_vector_type(2)));
    f2_t v = {lo, hi}; b2_t b = __builtin_convertvector(v, b2_t); return __builtin_bit_cast(unsigned, b); }
__device__ __forceinline__ void ph_rope(const Args& a, Frame& F) {
    bf16_t* P = (bf16_t*)(F.ws + WS_PROJ); const float* CS = (const float*)(F.ws + WS_CS);
    for (int it = F.bid * NTHREADS + F.tid; it < T * 10; it += F.nb * NTHREADS) {
        const int t = it / 10, hh = it % 10;
        bf16_t* p = P + (size_t)t * NP + hh * 64;
        const u32x4 x1 = *(const u32x4*)p, x2 = *(const u32x4*)(p + 8);
        const f32x4 c0 = *(const f32x4*)(CS + (size_t)t * 16), c1 = *(const f32x4*)(CS + (size_t)t * 16 + 4), s0 = *(const f32x4*)(CS + (size_t)t * 16 + 8), s1 = *(const f32x4*)(CS + (size_t)t * 16 + 12);
        const float cs[8] = {c0.x, c0.y, c0.z, c0.w, c1.x, c1.y, c1.z, c1.w}, sn[8] = {s0.x, s0.y, s0.z, s0.w, s1.x, s1.y, s1.z, s1.w};
        const unsigned xa[4] = {x1.x, x1.y, x1.z, x1.w}, xb[4] = {x2.x, x2.y, x2.z, x2.w};
        unsigned ra[4], rb[4];
#pragma unroll
        for (int i = 0; i < 4; ++i) {
            const float a0 = bf2f(xa[i] & 0xffffu), a1 = bf2f(xa[i] >> 16), b0 = bf2f(xb[i] & 0xffffu), b1 = bf2f(xb[i] >> 16);
            ra[i] = pk2(a0 * cs[2 * i] - b0 * sn[2 * i], a1 * cs[2 * i + 1] - b1 * sn[2 * i + 1]);
            rb[i] = pk2(b0 * cs[2 * i] + a0 * sn[2 * i], b1 * cs[2 * i + 1] + a1 * sn[2 * i + 1]);
        }
        *(u32x4*)p = (u32x4){ra[0], ra[1], ra[2], ra[3]}; *(u32x4*)(p + 8) = (u32x4){rb[0], rb[1], rb[2], rb[3]};
    }
}
constexpr int AT_KROW = 144, AT_VOFF = 256 * AT_KROW;
__device__ __forceinline__ void ph_attn_mfma(const Args& a, Frame& F, int l) {
    const bf16_t* P = (const bf16_t*)(F.ws + WS_PROJ); bf16_t* Y = (bf16_t*)(F.ws + WS_YMIX);
    LAS unsigned char* Kl = F.lds; LAS unsigned char* Vl = F.lds + AT_VOFF;
    const int lane = F.lane, r = lane & 31, h = lane >> 5, g = F.wave >> 1, qh = F.wave & 1;
    const int i16 = lane & 15, tq_ = i16 >> 2, tp_ = i16 & 3, g16 = (lane >> 4) & 1, sw = (tq_ >> 1) & 1;
    const int vlane = (4 * h + tq_) * 128 + (2 * g16 + (tp_ >> 1)) * 16 + (tp_ & 1) * 8;
    const float C = 0.125f * 1.4426950408889634f;
    for (int u = F.bid; u < BATCH * 128 * 2; u += F.nb) {
        const int hk = u & 1, n = (u >> 1) & 127, b = u >> 8;
        const int tq0 = b * SEQ + n * 128, tk0 = tq0 - 128;
        __syncthreads();
#pragma unroll
        for (int i = 0; i < 4; ++i) {
            const int piece = F.tid + NTHREADS * i, key = piece >> 3, c = piece & 7;
            u32x4 kv = (u32x4){0u, 0u, 0u, 0u}, vv = kv;
            if (n > 0 || key >= 128) { const bf16_t* rowp = P + (size_t)(tk0 + key) * NP; kv = *(const u32x4*)(rowp + C_AK + hk * 64 + c * 8); vv = *(const u32x4*)(rowp + C_AV + hk * 64 + c * 8); }
            *(LAS u32x4*)(Kl + key * AT_KROW + c * 16) = kv;
            *(LAS u32x4*)(Vl + key * 128 + ((c ^ (((key >> 1) & 1) << 2)) * 16)) = vv;
        }
        __syncthreads();
        const int hq = hk * 4 + g;
        const float sinkl = a.sinks[l * 8 + hq] * 1.4426950408889634f;
#pragma unroll 1
        for (int sb = 0; sb < 2; ++sb) {
            const int q0 = qh * 64 + sb * 32, kt0 = qh * 2 + sb;
            const size_t tq = (size_t)(tq0 + q0 + r);
            bf16x8_t qf[4];
#pragma unroll
            for (int ks = 0; ks < 4; ++ks) qf[ks] = *(const bf16x8_t*)(P + tq * NP + hq * 64 + 16 * ks + 8 * h);
            f32x16 S[5];
#pragma unroll
            for (int kr = 0; kr < 5; ++kr) {
                f32x16 acc;
#pragma unroll
                for (int i = 0; i < 16; ++i) acc[i] = 0.f;
#pragma unroll
                for (int ks = 0; ks < 4; ++ks) { const bf16x8_t kf = *(const LAS bf16x8_t*)(Kl + (32 * (kt0 + kr) + r) * AT_KROW + (16 * ks + 8 * h) * 2);
                    acc = __builtin_amdgcn_mfma_f32_32x32x16_bf16(kf, qf[ks], acc, 0, 0, 0); }
                S[kr] = acc;
            }
            float m = sinkl;
#pragma unroll
            for (int kr = 0; kr < 5; ++kr) {
                const bool tile_ok = !(n == 0 && (kt0 + kr) < 4);
#pragma unroll
                for (int i = 0; i < 16; ++i) {
                    const int kl = (i & 3) + 8 * (i >> 2) + 4 * h;
                    bool ok = tile_ok; if (kr == 0) ok = ok && (kl > r); if (kr == 4) ok = ok && (kl <= r);
                    const float sv = ok ? S[kr][i] * C : -INFINITY; S[kr][i] = sv; m = fmaxf(m, sv);
                }
            }
            m = fmaxf(m, __shfl_xor(m, 32));
            float lsum = 0.f;
#pragma unroll
            for (int kr = 0; kr < 5; ++kr)
#pragma unroll
                for (int i = 0; i < 16; ++i) { const float p = __builtin_amdgcn_exp2f(S[kr][i] - m); S[kr][i] = p; lsum += p; }
            lsum += __shfl_xor(lsum, 32); lsum += __builtin_amdgcn_exp2f(sinkl - m);
            f32x16 O0, O1;
#pragma unroll
            for (int i = 0; i < 16; ++i) { O0[i] = 0.f; O1[i] = 0.f; }
#pragma unroll
            for (int kr = 0; kr < 5; ++kr) {
#pragma unroll
                for (int s2 = 0; s2 < 2; ++s2) {
                    u32x4 pw; pw.x = cvtpk(S[kr][8 * s2 + 0], S[kr][8 * s2 + 1]); pw.y = cvtpk(S[kr][8 * s2 + 2], S[kr][8 * s2 + 3]); pw.z = cvtpk(S[kr][8 * s2 + 4], S[kr][8 * s2 + 5]); pw.w = cvtpk(S[kr][8 * s2 + 6], S[kr][8 * s2 + 7]);
                    const bf16x8_t pf = __builtin_bit_cast(bf16x8_t, pw);
                    const int kb = (32 * (kt0 + kr) + 16 * s2) * 128 + vlane;
                    const s16x4 lo0 = __builtin_amdgcn_ds_read_tr16_b64_v4i16((LAS s16x4*)(Vl + kb + (0 ^ sw) * 64));
                    const s16x4 hi0 = __builtin_amdgcn_ds_read_tr16_b64_v4i16((LAS s16x4*)(Vl + kb + 8 * 128 + (0 ^ sw) * 64));
                    const s16x4 lo1 = __builtin_amdgcn_ds_read_tr16_b64_v4i16((LAS s16x4*)(Vl + kb + (1 ^ sw) * 64));
                    const s16x4 hi1 = __builtin_amdgcn_ds_read_tr16_b64_v4i16((LAS s16x4*)(Vl + kb + 8 * 128 + (1 ^ sw) * 64));
                    const bf16x8_t va0 = __builtin_shufflevector(lo0, hi0, 0, 1, 2, 3, 4, 5, 6, 7), va1 = __builtin_shufflevector(lo1, hi1, 0, 1, 2, 3, 4, 5, 6, 7);
                    O0 = __builtin_amdgcn_mfma_f32_32x32x16_bf16(va0, pf, O0, 0, 0, 0);
                    O1 = __builtin_amdgcn_mfma_f32_32x32x16_bf16(va1, pf, O1, 0, 0, 0);
                }
            }
            const float inv = 1.0f / lsum;
            bf16_t* yp = Y + tq * D + hq * 64 + 4 * h;
#pragma unroll
            for (int gq = 0; gq < 4; ++gq) {
                u32x2 o0; o0.x = cvtpk(O0[4 * gq] * inv, O0[4 * gq + 1] * inv); o0.y = cvtpk(O0[4 * gq + 2] * inv, O0[4 * gq + 3] * inv);
                u32x2 o1; o1.x = cvtpk(O1[4 * gq] * inv, O1[4 * gq + 1] * inv); o1.y = cvtpk(O1[4 * gq + 2] * inv, O1[4 * gq + 3] * inv);
                *(u32x2*)(yp + 8 * gq) = o0; *(u32x2*)(yp + 32 + 8 * gq) = o1;
            }
        }
    }
    __syncthreads();
}


constexpr size_t WS_DN_MR = 360 * MiB, WS_DN_BNT = 376 * MiB, WS_DN_QP = 392 * MiB, WS_DN_OLT = 408 * MiB, WS_DN_ST = 424 * MiB;
constexpr int DL = 72, LB = 9216;
constexpr int L_KR = 0, L_KT = LB, L_QR = 2 * LB, L_VT = 3 * LB, L_AR = 4 * LB, L_T1 = 5 * LB, L_T2 = 6 * LB, L_UT = 7 * LB, L_UPT = 8 * LB, L_WPT = 9 * LB, L_WT = 0;
constexpr int L_LR = 7 * LB, L_L21 = L_LR + 17408, L_T11T = L_L21 + 4608, L_T22R = L_T11T + 4608, L_YT = L_T22R + 4608, L_GC = 100352, L_BETA = L_GC + 256;
static_assert(L_YT + 4608 == L_GC && L_GC + 512 <= 131072, "DeltaNet LDS map");
template <int KS> __device__ __forceinline__ f32x4 mm16(const LAS unsigned char* lds, int offX, int offY, int tx, int ty, int lane) {
    f32x4 acc = (f32x4){0.f, 0.f, 0.f, 0.f};
    const int l15 = lane & 15, q = lane >> 4;
#pragma unroll
    for (int ks = 0; ks < KS; ++ks) {
        const bf16x8_t xa = *(const LAS bf16x8_t*)(lds + offX + ((16 * tx + l15) * DL + 32 * ks + 8 * q) * 2);
        const bf16x8_t yb = *(const LAS bf16x8_t*)(lds + offY + ((16 * ty + l15) * DL + 32 * ks + 8 * q) * 2);
        acc = __builtin_amdgcn_mfma_f32_16x16x32_bf16(xa, yb, acc, 0, 0, 0);
    }
    return acc;
}
__device__ __forceinline__ u32x2 pack4(f32x4 v) { u32x2 o; o.x = cvtpk(v.x, v.y); o.y = cvtpk(v.z, v.w); return o; }

__device__ __forceinline__ void ph_dn_chunk(const Args& a, Frame& F, int l) {
    const bf16_t* P = (const bf16_t*)(F.ws + WS_PROJ); const float* BG = (const float*)(F.ws + WS_BG);
    bf16_t* MR = (bf16_t*)(F.ws + WS_DN_MR); bf16_t* BNT = (bf16_t*)(F.ws + WS_DN_BNT); bf16_t* QP = (bf16_t*)(F.ws + WS_DN_QP); bf16_t* OLT = (bf16_t*)(F.ws + WS_DN_OLT);
    LAS unsigned char* lds = F.lds;
    LAS float* gcL = (LAS float*)(lds + L_GC); LAS float* betaL = (LAS float*)(lds + L_BETA);
    const float* cw = a.dn_conv_w + (size_t)l * DN_CONV * 768;
    const int lane = F.lane, w = F.wave, l15 = lane & 15, q4 = lane >> 4;
    for (int unit = F.bid; unit < BATCH * 4 * 256; unit += F.nb) {
        const int n = unit & 255, h = (unit >> 8) & 3, b = unit >> 10;
        const int t0 = b * SEQ + n * 64;
        __syncthreads();
        {
            const int i = F.tid >> 3, c8 = F.tid & 7, t = t0 + i, sq = n * 64 + i;
#pragma unroll
            for (int kd = 0; kd < 3; ++kd) {
                const int cb = kd * 256 + h * 64 + c8 * 8;
                float acc[8];
#pragma unroll
                for (int e = 0; e < 8; ++e) acc[e] = 0.f;
#pragma unroll
                for (int k = 0; k < DN_CONV; ++k) {
                    if (sq - (DN_CONV - 1) + k >= 0) {
                        const u32x4 xv = *(const u32x4*)(P + (size_t)(t - (DN_CONV - 1) + k) * NP + C_DQ + cb);
                        const f32x4 w0 = *(const f32x4*)(cw + k * 768 + cb), w1 = *(const f32x4*)(cw + k * 768 + cb + 4);
                        acc[0] += w0.x * bf2f(xv.x & 0xffffu); acc[1] += w0.y * bf2f(xv.x >> 16); acc[2] += w0.z * bf2f(xv.y & 0xffffu); acc[3] += w0.w * bf2f(xv.y >> 16);
                        acc[4] += w1.x * bf2f(xv.z & 0xffffu); acc[5] += w1.y * bf2f(xv.z >> 16); acc[6] += w1.z * bf2f(xv.w & 0xffffu); acc[7] += w1.w * bf2f(xv.w >> 16);
                    }
                }
                float ss = 0.f;
#pragma unroll
                for (int e = 0; e < 8; ++e) { acc[e] = siluf_(acc[e]); ss += acc[e] * acc[e]; }
                if (kd < 2) {
                    ss += __shfl_xor(ss, 1); ss += __shfl_xor(ss, 2); ss += __shfl_xor(ss, 4);
                    const float rn = rsqrtf(ss + EPS) * (kd == 0 ? 0.125f : 1.0f);
#pragma unroll
                    for (int e = 0; e < 8; ++e) acc[e] *= rn;
                }
                u32x4 pk; pk.x = cvtpk(acc[0], acc[1]); pk.y = cvtpk(acc[2], acc[3]); pk.z = cvtpk(acc[4], acc[5]); pk.w = cvtpk(acc[6], acc[7]);
                if (kd == 0) *(LAS u32x4*)(lds + L_QR + (i * DL + c8 * 8) * 2) = pk;
                if (kd == 1) *(LAS u32x4*)(lds + L_KR + (i * DL + c8 * 8) * 2) = pk;
                if (kd >= 1) {
                    LAS bf16_t* Tt = (LAS bf16_t*)(lds + (kd == 1 ? L_KT : L_VT));
                    const unsigned pw[4] = {pk.x, pk.y, pk.z, pk.w};
#pragma unroll
                    for (int e = 0; e < 8; ++e) Tt[(c8 * 8 + e) * DL + i] = (bf16_t)((pw[e >> 1] >> (16 * (e & 1))) & 0xffffu);
                }
            }
            for (int idx = F.tid; idx < 2 * LB / 16; idx += NTHREADS) *(LAS u32x4*)(lds + L_T1 + idx * 16) = (u32x4){0u, 0u, 0u, 0u};
            if (w == 0) {
                const float be = BG[(size_t)(t0 + lane) * 8 + h]; float x = BG[(size_t)(t0 + lane) * 8 + 4 + h];
#pragma unroll
                for (int o = 1; o < 64; o <<= 1) { const float y = __shfl_up(x, o); if (lane >= o) x += y; }
                gcL[lane] = x; betaL[lane] = be;
            }
        }
        __syncthreads();
#pragma unroll
        for (int tt = 0; tt < 2; ++tt) {
            const int tidx = 2 * w + tt, tx = tidx >> 2, ty = tidx & 3, i = 16 * ty + l15, j0 = 16 * tx + 4 * q4;
            const float gi = gcL[i], bi = betaL[i]; const f32x4 gj = *(const LAS f32x4*)(gcL + j0);
            const float gjv[4] = {gj.x, gj.y, gj.z, gj.w};
            const f32x4 zk = mm16<2>(lds, L_KR, L_KR, tx, ty, lane);
            const f32x4 zq = mm16<2>(lds, L_KR, L_QR, tx, ty, lane);
            f32x4 lv, av;
#pragma unroll
            for (int r = 0; r < 4; ++r) { const float dc = __expf(fminf(gi - gjv[r], 0.f)); lv[r] = (j0 + r < i) ? bi * zk[r] * dc : 0.f; av[r] = (j0 + r <= i) ? zq[r] * dc : 0.f; }
            *(LAS f32x4*)(lds + L_LR + (i * 68 + j0) * 4) = lv;
            if (i >= 32 && j0 < 32) *(LAS u32x2*)(lds + L_L21 + ((i - 32) * DL + j0) * 2) = pack4(lv);
            *(LAS u32x2*)(lds + L_AR + (i * DL + j0) * 2) = pack4(av);
        }
        __syncthreads();
        if (w == 0) {
            const int blk = lane >> 5, jp = lane & 31;
            const LAS float* Lb = (const LAS float*)(lds + L_LR) + (32 * blk) * 68 + 32 * blk;
            float x[32];
#pragma unroll
            for (int i = 0; i < 32; ++i) {
                float sacc = (i == jp) ? 1.f : 0.f;
#pragma unroll
                for (int m0 = 0; m0 < i; m0 += 4) {
                    const f32x4 l4 = *(const LAS f32x4*)(Lb + i * 68 + m0);
                    sacc -= l4.x * x[m0];
                    if (m0 + 1 < i) sacc -= l4.y * x[m0 + 1];
                    if (m0 + 2 < i) sacc -= l4.z * x[m0 + 2];
                    if (m0 + 3 < i) sacc -= l4.w * x[m0 + 3];
                }
                x[i] = sacc;
            }
            const int jg = 32 * blk + jp; const float bj = betaL[jg], bej = bj * __expf(gcL[jg]);
            LAS bf16_t* T1 = (LAS bf16_t*)(lds + L_T1); LAS bf16_t* T2 = (LAS bf16_t*)(lds + L_T2);
#pragma unroll
            for (int i = 0; i < 32; ++i) { T1[(32 * blk + i) * DL + jg] = (bf16_t)f2bf(x[i] * bj); T2[(32 * blk + i) * DL + jg] = (bf16_t)f2bf(x[i] * bej); }
            if (blk == 0) {
#pragma unroll
                for (int c = 0; c < 4; ++c) { u32x4 pk; pk.x = cvtpk(x[8 * c], x[8 * c + 1]); pk.y = cvtpk(x[8 * c + 2], x[8 * c + 3]); pk.z = cvtpk(x[8 * c + 4], x[8 * c + 5]); pk.w = cvtpk(x[8 * c + 6], x[8 * c + 7]);
                    *(LAS u32x4*)(lds + L_T11T + (jp * DL + 8 * c) * 2) = pk; }
            } else {
                LAS bf16_t* T22 = (LAS bf16_t*)(lds + L_T22R);
#pragma unroll
                for (int i = 0; i < 32; ++i) T22[i * DL + jp] = (bf16_t)f2bf(x[i]);
            }
        }
        __syncthreads();
        if (w < 4) {
            const int tx = w >> 1, ty = w & 1;
            const f32x4 z = mm16<1>(lds, L_L21, L_T11T, tx, ty, lane);
            *(LAS u32x2*)(lds + L_YT + ((16 * ty + l15) * DL + 16 * tx + 4 * q4) * 2) = pack4(z);
        }
        __syncthreads();
        if (w < 4) {
            const int tx = w >> 1, ty = w & 1, y = 16 * ty + l15, x0 = 16 * tx + 4 * q4;
            const f32x4 z = mm16<1>(lds, L_T22R, L_YT, tx, ty, lane);
            const float bj = betaL[y], bej = bj * __expf(gcL[y]);
            LAS bf16_t* T1 = (LAS bf16_t*)(lds + L_T1); LAS bf16_t* T2 = (LAS bf16_t*)(lds + L_T2);
#pragma unroll
            for (int r = 0; r < 4; ++r) { T1[(32 + x0 + r) * DL + y] = (bf16_t)f2bf(-z[r] * bj); T2[(32 + x0 + r) * DL + y] = (bf16_t)f2bf(-z[r] * bej); }
        }
        __syncthreads();
        const float gl = gcL[63];
#pragma unroll
        for (int tt = 0; tt < 2; ++tt) {
            const int tidx = 2 * w + tt, tx = tidx >> 2, ty = tidx & 3, y = 16 * ty + l15, x0 = 16 * tx + 4 * q4;
            const f32x4 gx = *(const LAS f32x4*)(gcL + x0);
            f32x4 sc; sc.x = __expf(gl - gx.x); sc.y = __expf(gl - gx.y); sc.z = __expf(gl - gx.z); sc.w = __expf(gl - gx.w);
            const f32x4 zu = mm16<2>(lds, L_T1, L_VT, tx, ty, lane);
            const f32x4 zw = mm16<2>(lds, L_T2, L_KT, tx, ty, lane);
            *(LAS u32x2*)(lds + L_UT + (y * DL + x0) * 2) = pack4(zu); *(LAS u32x2*)(lds + L_UPT + (y * DL + x0) * 2) = pack4(zu * sc);
            *(LAS u32x2*)(lds + L_WT + (y * DL + x0) * 2) = pack4(zw); *(LAS u32x2*)(lds + L_WPT + (y * DL + x0) * 2) = pack4(zw * sc);
        }
        __syncthreads();
        {
            const size_t cho = (size_t)unit * 4096;
            const float egl = __expf(gl);
#pragma unroll
            for (int tt = 0; tt < 2; ++tt) {
                const int tidx = 2 * w + tt, tx = tidx >> 2, ty = tidx & 3, y = 16 * ty + l15, x0 = 16 * tx + 4 * q4;
                f32x4 zm = mm16<2>(lds, L_WPT, L_KT, tx, ty, lane);
#pragma unroll
                for (int r = 0; r < 4; ++r) zm[r] = ((x0 + r) == y ? egl : 0.f) - zm[r];
                *(u32x2*)(MR + cho + y * 64 + x0) = pack4(zm);
                const f32x4 zb = mm16<2>(lds, L_KT, L_UPT, tx, ty, lane);
                *(u32x2*)(BNT + cho + y * 64 + x0) = pack4(zb);
                const f32x4 zq = mm16<2>(lds, L_WT, L_AR, tx, ty, lane);
                const u32x2 qv = *(const LAS u32x2*)(lds + L_QR + (y * DL + x0) * 2); const float eg = __expf(gcL[y]);
                f32x4 qp; qp.x = bf2f(qv.x & 0xffffu) * eg - zq.x; qp.y = bf2f(qv.x >> 16) * eg - zq.y; qp.z = bf2f(qv.y & 0xffffu) * eg - zq.z; qp.w = bf2f(qv.y >> 16) * eg - zq.w;
                *(u32x2*)(QP + cho + y * 64 + x0) = pack4(qp);
                const f32x4 zo = mm16<2>(lds, L_AR, L_UT, tx, ty, lane);
                *(u32x2*)(OLT + cho + y * 64 + x0) = pack4(zo);
            }
        }
    }
    __syncthreads();
}
__device__ __forceinline__ void ph_dn_scan(const Args& a, Frame& F) {
    if (F.bid >= BATCH * 4 || F.wave >= 4) return;
    const bf16_t* MR = (const bf16_t*)(F.ws + WS_DN_MR); const bf16_t* BNT = (const bf16_t*)(F.ws + WS_DN_BNT); bf16_t* ST = (bf16_t*)(F.ws + WS_DN_ST);
    const int lane = F.lane, l15 = lane & 15, q4 = lane >> 4, dv = 16 * F.wave + l15;
    f32x4 S[4];
#pragma unroll
    for (int ti = 0; ti < 4; ++ti) S[ti] = (f32x4){0.f, 0.f, 0.f, 0.f};
    u32x2 Alo[4][2], Ahi[4][2], Bc[4];
    const size_t ch0 = (size_t)F.bid * 256;
#define DN_LOAD(chv) do { const bf16_t* m_ = MR + (chv) * 4096; const bf16_t* b_ = BNT + (chv) * 4096; \
        _Pragma("unroll") for (int ti = 0; ti < 4; ++ti) { _Pragma("unroll") for (int ks = 0; ks < 2; ++ks) { \
            Alo[ti][ks] = *(const u32x2*)(m_ + (16 * ti + l15) * 64 + 32 * ks + 4 * q4); Ahi[ti][ks] = *(const u32x2*)(m_ + (16 * ti + l15) * 64 + 32 * ks + 16 + 4 * q4); } \
            Bc[ti] = *(const u32x2*)(b_ + dv * 64 + 16 * ti + 4 * q4); } } while (0)
    DN_LOAD(ch0);
    for (int n = 0; n < 256; ++n) {
        const size_t ch = ch0 + n;
        u32x2 cAlo[4][2], cAhi[4][2], cBc[4];
#pragma unroll
        for (int ti = 0; ti < 4; ++ti) { cBc[ti] = Bc[ti];
#pragma unroll
            for (int ks = 0; ks < 2; ++ks) { cAlo[ti][ks] = Alo[ti][ks]; cAhi[ti][ks] = Ahi[ti][ks]; } }
        if (n + 1 < 256) DN_LOAD(ch + 1);
        u32x2 sp[4];
#pragma unroll
        for (int ti = 0; ti < 4; ++ti) { sp[ti] = pack4(S[ti]); *(u32x2*)(ST + ch * 4096 + dv * 64 + 16 * ti + 4 * q4) = sp[ti]; }
        const bf16x8_t b0 = __builtin_bit_cast(bf16x8_t, (u32x4){sp[0].x, sp[0].y, sp[1].x, sp[1].y});
        const bf16x8_t b1 = __builtin_bit_cast(bf16x8_t, (u32x4){sp[2].x, sp[2].y, sp[3].x, sp[3].y});
#pragma unroll
        for (int ti = 0; ti < 4; ++ti) {
            f32x4 c; c.x = bf2f(cBc[ti].x & 0xffffu); c.y = bf2f(cBc[ti].x >> 16); c.z = bf2f(cBc[ti].y & 0xffffu); c.w = bf2f(cBc[ti].y >> 16);
            const bf16x8_t a0 = __builtin_bit_cast(bf16x8_t, (u32x4){cAlo[ti][0].x, cAlo[ti][0].y, cAhi[ti][0].x, cAhi[ti][0].y});
            const bf16x8_t a1 = __builtin_bit_cast(bf16x8_t, (u32x4){cAlo[ti][1].x, cAlo[ti][1].y, cAhi[ti][1].x, cAhi[ti][1].y});
            c = __builtin_amdgcn_mfma_f32_16x16x32_bf16(a0, b0, c, 0, 0, 0);
            c = __builtin_amdgcn_mfma_f32_16x16x32_bf16(a1, b1, c, 0, 0, 0);
            S[ti] = c;
        }
    }
#undef DN_LOAD
}
__device__ __forceinline__ void ph_dn_out(const Args& a, Frame& F, int l) {
    const bf16_t* QP = (const bf16_t*)(F.ws + WS_DN_QP); const bf16_t* OLT = (const bf16_t*)(F.ws + WS_DN_OLT); const bf16_t* ST = (const bf16_t*)(F.ws + WS_DN_ST);
    const bf16_t* P = (const bf16_t*)(F.ws + WS_PROJ); bf16_t* Y = (bf16_t*)(F.ws + WS_YMIX);
    const int lane = F.lane, l15 = lane & 15, q4 = lane >> 4, ti = F.wave & 3;
    for (int pr = F.bid; pr < 1024; pr += F.nb) {
        const int unit = 2 * pr + (F.wave >> 2), n = unit & 255, h = (unit >> 8) & 3, b = unit >> 10;
        const size_t cho = (size_t)unit * 4096;
        bf16x8_t af[2];
#pragma unroll
        for (int ks = 0; ks < 2; ++ks) af[ks] = *(const bf16x8_t*)(QP + cho + (16 * ti + l15) * 64 + 32 * ks + 8 * q4);
        f32x4 acc[4];
#pragma unroll
        for (int tj = 0; tj < 4; ++tj) {
            const u32x2 ov = *(const u32x2*)(OLT + cho + (16 * tj + l15) * 64 + 16 * ti + 4 * q4);
            f32x4 c; c.x = bf2f(ov.x & 0xffffu); c.y = bf2f(ov.x >> 16); c.z = bf2f(ov.y & 0xffffu); c.w = bf2f(ov.y >> 16);
#pragma unroll
            for (int ks = 0; ks < 2; ++ks) { const bf16x8_t bfv = *(const bf16x8_t*)(ST + cho + (16 * tj + l15) * 64 + 32 * ks + 8 * q4); c = __builtin_amdgcn_mfma_f32_16x16x32_bf16(af[ks], bfv, c, 0, 0, 0); }
            acc[tj] = c;
        }
        f32x4 ss = acc[0] * acc[0] + acc[1] * acc[1] + acc[2] * acc[2] + acc[3] * acc[3];
#pragma unroll
        for (int o = 1; o < 16; o <<= 1) { ss.x += __shfl_xor(ss.x, o); ss.y += __shfl_xor(ss.y, o); ss.z += __shfl_xor(ss.z, o); ss.w += __shfl_xor(ss.w, o); }
        const float rs[4] = {rsqrtf(ss.x * (1.f / 64.f) + EPS), rsqrtf(ss.y * (1.f / 64.f) + EPS), rsqrtf(ss.z * (1.f / 64.f) + EPS), rsqrtf(ss.w * (1.f / 64.f) + EPS)};
        const size_t trow0 = (size_t)b * SEQ + n * 64 + 16 * ti + 4 * q4;
#pragma unroll
        for (int tj = 0; tj < 4; ++tj) {
            const int dvv = 16 * tj + l15; const float gn = a.dn_norm_g[l * 64 + dvv];
#pragma unroll
            for (int r = 0; r < 4; ++r) {
                const size_t t = trow0 + r;
                const float z = bf2f(P[t * NP + C_DZ + h * 64 + dvv]);
                Y[t * D + 512 + h * 64 + dvv] = (bf16_t)f2bf(acc[tj][r] * rs[r] * gn * siluf_(z));
            }
        }
    }
}

__device__ __forceinline__ void ph_conv_naive(const Args& a, Frame& F, int l) {
    const bf16_t* P = (const bf16_t*)(F.ws + WS_PROJ); bf16_t* Y = (bf16_t*)(F.ws + WS_YMIX);
    const float* w = a.cv_dw_w + (size_t)l * CV_K * CV_C;
    for (int t = F.gw; t < T; t += F.ngw) {
        const int s = t % SEQ, c0 = 4 * F.lane;
        f32x4 acc = *(const f32x4*)(a.cv_dw_b + l * CV_C + c0);
        for (int k = 0; k < CV_K; ++k) {
            const int sp = s - (CV_K - 1) + k;
            if (sp < 0) continue;
            const size_t tk = (size_t)t - (CV_K - 1) + k;
            const u32x2 ca = *(const u32x2*)(P + tk * NP + C_CA + c0), cb = *(const u32x2*)(P + tk * NP + C_CB + c0);
            const f32x4 w4 = *(const f32x4*)(w + k * CV_C + c0);
            acc.x += w4.x * (bf2f(ca.x & 0xffffu) * sigmoidf_(bf2f(cb.x & 0xffffu)));
            acc.y += w4.y * (bf2f(ca.x >> 16) * sigmoidf_(bf2f(cb.x >> 16)));
            acc.z += w4.z * (bf2f(ca.y & 0xffffu) * sigmoidf_(bf2f(cb.y & 0xffffu)));
            acc.w += w4.w * (bf2f(ca.y >> 16) * sigmoidf_(bf2f(cb.y >> 16)));
        }
        const float mean = wave_sum((acc.x + acc.y) + (acc.z + acc.w)) * (1.0f / CV_C);
        const f32x4 dv = acc - mean;
        const float var = wave_sum((dv.x * dv.x + dv.y * dv.y) + (dv.z * dv.z + dv.w * dv.w)) * (1.0f / CV_C);
        const float rstd = rsqrtf(var + EPS);
        const f32x4 g4 = *(const f32x4*)(a.cv_ln_g + l * CV_C + c0), b4 = *(const f32x4*)(a.cv_ln_b + l * CV_C + c0);
        const f32x4 y = (dv * rstd) * g4 + b4;
        u32x2 o; o.x = pk2(siluf_(y.x), siluf_(y.y)); o.y = pk2(siluf_(y.z), siluf_(y.w));
        *(u32x2*)(Y + (size_t)t * D + 768 + c0) = o;
    }
}
__device__ __forceinline__ void moe_bases(Frame& F, int (&base)[9], int (&cnt)[8]) {
    const unsigned* c = (const unsigned*)(F.ws + WS_CTL) + CW_MOECNT;
    int acc = 0;
#pragma unroll
    for (int e = 0; e < 8; ++e) { cnt[e] = (int)__hip_atomic_load(c + 64 * e, __ATOMIC_RELAXED, __HIP_MEMORY_SCOPE_AGENT); base[e] = acc; acc += (cnt[e] + 255) & ~255; }
    base[8] = acc;
}
__device__ __forceinline__ void moe_range(Frame& F, int e, int& lo, int& hi) {
    const unsigned* c = (const unsigned*)(F.ws + WS_CTL) + CW_MOECNT;
    int acc = 0; lo = 0; hi = 0;
#pragma unroll
    for (int k = 0; k < 8; ++k) { const int n = ((int)__hip_atomic_load(c + 64 * k, __ATOMIC_RELAXED, __HIP_MEMORY_SCOPE_AGENT) + 255) & ~255; if (k == e) { lo = acc; hi = acc + n; } acc += n; }
}
__device__ __forceinline__ void ph_moe_list(const Args& a, Frame& F) {
    int base[9], cnt[8]; moe_bases(F, base, cnt);
    int* RM = (int*)(F.ws + WS_RMAP); const int* R = (const int*)(F.ws + WS_ROUTE); const int* Pq = (const int*)(F.ws + WS_POS);
    for (int t = F.bid * NTHREADS + F.tid; t < T; t += F.nb * NTHREADS) {
        const int e0 = R[t * 4], e1 = R[t * 4 + 1];
        int b0 = 0, b1 = 0;
#pragma unroll
        for (int e = 0; e < 8; ++e) { if (e == e0) b0 = base[e]; if (e == e1) b1 = base[e]; }
        RM[b0 + Pq[t * 2]] = t; RM[b1 + Pq[t * 2 + 1]] = t;
    }
    if (F.bid == 0) {
#pragma unroll
        for (int e = 0; e < 8; ++e) { const int lo = base[e] + cnt[e], hi = base[e + 1]; for (int r = lo + F.tid; r < hi; r += NTHREADS) RM[r] = 0; }
    }
}
__device__ __forceinline__ void ph_final(const Args& a, Frame& F) {
    int base[9], cnt[8]; moe_bases(F, base, cnt);
    const float* MOD = (const float*)(F.ws + WS_MOD);
    const bf16_t* YM = (const bf16_t*)(F.ws + WS_YMOE); const int* R = (const int*)(F.ws + WS_ROUTE); const int* Pq = (const int*)(F.ws + WS_POS);
    for (int row = F.gw; row < T; row += F.ngw) {
        const int b = row / SEQ;
        const int e0 = R[row * 4], e1 = R[row * 4 + 1]; const float p0 = ((const float*)R)[row * 4 + 2], p1 = ((const float*)R)[row * 4 + 3];
        int b0 = 0, b1 = 0;
#pragma unroll
        for (int e = 0; e < 8; ++e) { if (e == e0) b0 = base[e]; if (e == e1) b1 = base[e]; }
        const size_t s0 = (size_t)(b0 + Pq[row * 2]), s1 = (size_t)(b1 + Pq[row * 2 + 1]);
        const float* gt2 = MOD + ((size_t)(1 * 2 + 1) * 2 + b) * 3072 + 2048;
        f32x4* xr = (f32x4*)(a.out + (size_t)row * D) + F.lane;
        f32x4 v[4]; float ss = 0.f;
#pragma unroll
        for (int j = 0; j < 4; ++j) {
            const int d = 256 * j + 4 * F.lane;
            const u32x2 y0 = *(const u32x2*)(YM + s0 * D + d), y1 = *(const u32x2*)(YM + s1 * D + d);
            const f32x4 g4 = *(const f32x4*)(gt2 + d);
            f32x4 f; f.x = p0 * bf2f(y0.x & 0xffffu) + p1 * bf2f(y1.x & 0xffffu); f.y = p0 * bf2f(y0.x >> 16) + p1 * bf2f(y1.x >> 16);
            f.z = p0 * bf2f(y0.y & 0xffffu) + p1 * bf2f(y1.y & 0xffffu); f.w = p0 * bf2f(y0.y >> 16) + p1 * bf2f(y1.y >> 16);
            v[j] = xr[64 * j] + g4 * f;
            ss += (v[j].x * v[j].x + v[j].y * v[j].y) + (v[j].z * v[j].z + v[j].w * v[j].w);
        }
        const float rstd = rsqrtf(wave_sum(ss) * (1.0f / D) + EPS);
#pragma unroll
        for (int j = 0; j < 4; ++j) { const f32x4 g4 = *(const f32x4*)(a.final_g + 256 * j + 4 * F.lane); xr[64 * j] = (v[j] * rstd) * g4; }
    }
}


namespace pg8 {
typedef short bf16x8 __attribute__((ext_vector_type(8)));
constexpr int BM = 256, BK = 64, HALF = 128, HTB = HALF * BK * 2, STAGE_BYTES = 8 * HTB;
__device__ __forceinline__ int lds_byte(int r, int c) { const int st = (r >> 4) * 2 + (c >> 5), rr = r & 15, cc = c & 31, ob = rr * 64 + cc * 2; return st * 1024 + (ob ^ (((ob >> 9) & 1) << 5)); }
__device__ __forceinline__ void stage_rc(int b, int& R, int& C) { const int st = b / 1024, sb = b % 1024, swz = sb ^ (((sb >> 9) & 1) << 5); R = (st >> 1) * 16 + swz / 64; C = (st & 1) * 32 + (swz % 64) / 2; }
__device__ __forceinline__ int perm32(int rho) { const int n = rho >> 4, i = rho & 15; return 8 * (i >> 2) + 4 * n + (i & 3); }
struct Unit { int pm, pn; };
struct Gemm { const bf16_t* A; const bf16_t* Bt; int K; };
constexpr int NXCD = 8, WGM = 8;
struct StaticOrder {
    int nM, nN, nwg, G, c;
    __device__ void init(int M, int N, int G_, int c_) { nM = M / BM; nN = N / BM; nwg = nM * nN; G = G_; c = c_; }
    __device__ __forceinline__ bool next(int i, Unit& u) const {
        const long L = (long)i * G + c; if (L >= nwg) return false;
        int wgid = (int)L; { const int q = nwg / NXCD, r = nwg % NXCD, xcd = wgid % NXCD, off = wgid / NXCD; wgid = (xcd < r ? xcd * (q + 1) : r * (q + 1) + (xcd - r) * q) + off; }
        const int nig = WGM * nN, gid = wgid / nig, fm = gid * WGM, gsz = (nM - fm) < WGM ? (nM - fm) : WGM;
        u.pm = fm + ((wgid % nig) % gsz); u.pn = (wgid % nig) / gsz; return true;
    }
};
template <int NT> struct MoeOrder {
    int bt[9]; int G, c;
    __device__ __forceinline__ bool next(int i, Unit& u) const {
        const int L = i * G + c; if (L >= bt[8] * NT) return false;
        const int q = L / NT, tn = L % NT; int e = 0;
#pragma unroll
        for (int k = 1; k < 8; ++k) e += (q >= bt[k]) ? 1 : 0;
        u.pm = q; u.pn = e * NT + tn; return true;
    }
};
__device__ __forceinline__ unsigned cvt_pk_bf16(float lo, float hi) { unsigned r; asm volatile("v_cvt_pk_bf16_f32 %0, %1, %2" : "=v"(r) : "v"(lo), "v"(hi)); return r; }
__device__ __forceinline__ float fast_silu(float x) { return x * __builtin_amdgcn_rcpf(1.0f + __builtin_amdgcn_exp2f(x * -1.4426950408889634f)); }

struct EpiBf16 {
    static constexpr bool PERM = true;
    bf16_t* O; int ldc; int nmod;
    __device__ __forceinline__ void operator()(const f32x4 (&acc)[2][2][4][2], const Unit& u, int wr, int wc, int fr, int fq) const {
        const int row0 = u.pm * BM + wr * 64 + fr, col0 = (u.pn % nmod) * BM + wc * 32 + 8 * fq;
#pragma unroll
        for (int ai = 0; ai < 2; ++ai)
#pragma unroll
            for (int m = 0; m < 4; ++m) { bf16_t* rowp = O + (size_t)(row0 + ai * HALF + m * 16) * ldc + col0;
#pragma unroll
                for (int bj = 0; bj < 2; ++bj) { const f32x4 v0 = acc[ai][bj][m][0], v1 = acc[ai][bj][m][1];
                    u32x4 w; w.x = cvt_pk_bf16(v0[0], v0[1]); w.y = cvt_pk_bf16(v0[2], v0[3]); w.z = cvt_pk_bf16(v1[0], v1[1]); w.w = cvt_pk_bf16(v1[2], v1[3]);
                    *(u32x4*)(rowp + bj * HALF) = w; } }
    }
};
struct EpiSwiGLU {
    static constexpr bool PERM = true;
    bf16_t* O; int ldc; int nmod;
    __device__ __forceinline__ void operator()(const f32x4 (&acc)[2][2][4][2], const Unit& u, int wr, int wc, int fr, int fq) const {
        const int row0 = u.pm * BM + wr * 64 + fr, col0 = (u.pn % nmod) * HALF + wc * 32 + 8 * fq;
#pragma unroll
        for (int ai = 0; ai < 2; ++ai)
#pragma unroll
            for (int m = 0; m < 4; ++m) {
                const f32x4 g0 = acc[ai][0][m][0], g1 = acc[ai][0][m][1], u0 = acc[ai][1][m][0], u1 = acc[ai][1][m][1];
                u32x4 w;
                w.x = cvt_pk_bf16(fast_silu(g0[0]) * u0[0], fast_silu(g0[1]) * u0[1]); w.y = cvt_pk_bf16(fast_silu(g0[2]) * u0[2], fast_silu(g0[3]) * u0[3]);
                w.z = cvt_pk_bf16(fast_silu(g1[0]) * u1[0], fast_silu(g1[1]) * u1[1]); w.w = cvt_pk_bf16(fast_silu(g1[2]) * u1[2], fast_silu(g1[3]) * u1[3]);
                *(u32x4*)(O + (size_t)(row0 + ai * HALF + m * 16) * ldc + col0) = w; }
    }
};
struct EpiResidF32 {
    static constexpr bool PERM = false;
    const float* xin; float* xout; const float* gate;
    __device__ __forceinline__ void operator()(const f32x4 (&acc)[2][2][4][2], const Unit& u, int wr, int wc, int fr, int fq) const {
        const int row0 = u.pm * BM + wr * 64 + fr, col0 = u.pn * BM + wc * 32 + 4 * fq;
        const float* gp = gate + (size_t)((u.pm * BM) / SEQ) * 3072 + col0;
#pragma unroll
        for (int bj = 0; bj < 2; ++bj)
#pragma unroll
            for (int n = 0; n < 2; ++n) { const f32x4 g4 = *(const f32x4*)(gp + bj * HALF + n * 16);
#pragma unroll
                for (int ai = 0; ai < 2; ++ai)
#pragma unroll
                    for (int m = 0; m < 4; ++m) { const size_t off = (size_t)(row0 + ai * HALF + m * 16) * D + col0 + bj * HALF + n * 16;
                        const f32x4 x4 = *(const f32x4*)(xin + off); *(f32x4*)(xout + off) = x4 + g4 * acc[ai][bj][m][n]; } }
    }
};

template <class Epi, class Sched, bool GATHER, bool ALIGN_EPI, bool SP2>
__device__ __forceinline__ void gemm_phase(LAS unsigned char* lds, const LAS int* RI, const Gemm g, const Sched& S, const Epi& E) {
    const int tid = threadIdx.x, wid = __builtin_amdgcn_readfirstlane(tid >> 6), lane = tid & 63, wr = wid >> 2, wc = wid & 3, fr = lane & 15, fq = lane >> 4;
    const int K = g.K, nt = K / BK;
    unsigned voffB[2]; int Ra[2]; unsigned Ca2[2];
#pragma unroll
    for (int i = 0; i < 2; ++i) { int R, C; stage_rc(tid * 16 + i * 8192, R, C); const int Rb = Epi::PERM ? ((R & ~31) + perm32(R & 31)) : R;
        Ra[i] = R; Ca2[i] = (unsigned)C * 2u; voffB[i] = (unsigned)(Rb * K + C) * 2u; }
    const size_t kstep = (size_t)(BK * 2);
    const size_t hstep = (size_t)HALF * K * 2;
    const size_t tstep = 2 * hstep;
    const unsigned rowb = (unsigned)K * 2u;
    const unsigned ldsw = (unsigned)wid * 1024u;
    const int aoff = lds_byte(wr * 64 + fr, fq * 8), boff = lds_byte(wc * 32 + fr, fq * 8);
#define PG8_SA(b, h) (((b) * 2 + (h)) * HTB)
#define PG8_SB(b, h) ((4 + (b) * 2 + (h)) * HTB)
#define PG8_STAGE_B(bufoff, gbase) do { _Pragma("unroll") for (int _i = 0; _i < 2; ++_i) \
        __builtin_amdgcn_global_load_lds((const unsigned*)((const char*)(gbase) + voffB[_i]), (LAS unsigned*)(lds + (bufoff) + ldsw + _i * 8192), 16, 0, 0); } while (0)
#define PG8_STAGE_A(bufoff, kb, off) do { _Pragma("unroll") for (int _i = 0; _i < 2; ++_i) \
        __builtin_amdgcn_global_load_lds((const unsigned*)((const char*)g.A + (size_t)(kb) + (off)[_i]), (LAS unsigned*)(lds + (bufoff) + ldsw + _i * 8192), 16, 0, 0); } while (0)
#define PG8_LDA(dst, b, h) do { _Pragma("unroll") for (int m = 0; m < 4; ++m) _Pragma("unroll") for (int k = 0; k < 2; ++k) dst[m][k] = *(const LAS bf16x8*)(lds + PG8_SA(b, h) + aoff + m * 2048 + k * 1024); } while (0)
#define PG8_LDB(dst, b, h) do { _Pragma("unroll") for (int n = 0; n < 2; ++n) _Pragma("unroll") for (int k = 0; k < 2; ++k) dst[n][k] = *(const LAS bf16x8*)(lds + PG8_SB(b, h) + boff + n * 2048 + k * 1024); } while (0)
#define PG8_MMA(ai, bj, At, Bt) do { __builtin_amdgcn_s_setprio(1); _Pragma("unroll") for (int m = 0; m < 4; ++m) _Pragma("unroll") for (int n = 0; n < 2; ++n) _Pragma("unroll") for (int k = 0; k < 2; ++k) \
        acc[ai][bj][m][n] = __builtin_amdgcn_mfma_f32_16x16x32_bf16(Bt[n][k], At[m][k], acc[ai][bj][m][n], 0, 0, 0); __builtin_amdgcn_s_setprio(0); } while (0)
#define PG8_WAIT_V(n) asm volatile("s_waitcnt vmcnt(" #n ")" ::: "memory")
#define PG8_WAIT_L(n) asm volatile("s_waitcnt lgkmcnt(" #n ")" ::: "memory")
#define PG8_BAR __builtin_amdgcn_s_barrier()
#define PG8_SCHED __builtin_amdgcn_sched_barrier(0)
#define PG8_AOFFS(dst, ui_, un_) do { _Pragma("unroll") for (int _h = 0; _h < 2; ++_h) _Pragma("unroll") for (int _i = 0; _i < 2; ++_i) { \
        const unsigned _row = GATHER ? (unsigned)RI[(ui_) * 256 + _h * HALF + Ra[_i]] : (unsigned)((un_).pm * BM + _h * HALF + Ra[_i]); dst[_h][_i] = _row * rowb + Ca2[_i]; } } while (0)
    Unit cur, nxt; int ui = 0;
    if (!S.next(0, cur)) return;
    f32x4 acc[2][2][4][2];
#pragma unroll
    for (int a = 0; a < 2; ++a)
#pragma unroll
        for (int b = 0; b < 2; ++b)
#pragma unroll
            for (int m = 0; m < 4; ++m)
#pragma unroll
                for (int n = 0; n < 2; ++n) acc[a][b][m][n] = (f32x4){0.f, 0.f, 0.f, 0.f};
    bf16x8 At[4][2], B0[2][2], B1[2][2];
    unsigned cv[2][2], nv[2][2];
    PG8_AOFFS(cv, 0, cur);
    const char* cB = (const char*)g.Bt + (size_t)cur.pn * tstep;
    if constexpr (SP2) {
        PG8_STAGE_B(PG8_SB(0, 0), cB); PG8_STAGE_B(PG8_SB(0, 1), cB + hstep); PG8_STAGE_A(PG8_SA(0, 0), 0, cv[0]); PG8_STAGE_A(PG8_SA(0, 1), 0, cv[1]);
        if (wr == 1) PG8_BAR;
        PG8_WAIT_V(2); PG8_BAR;
        PG8_STAGE_B(PG8_SB(1, 0), cB + kstep); PG8_STAGE_A(PG8_SA(1, 0), kstep, cv[0]); PG8_STAGE_B(PG8_SB(1, 1), cB + hstep + kstep);
        PG8_WAIT_V(6); PG8_BAR;
    } else {
        PG8_STAGE_B(PG8_SB(0, 0), cB); PG8_STAGE_A(PG8_SA(0, 0), 0, cv[0]); PG8_STAGE_B(PG8_SB(0, 1), cB + hstep); PG8_STAGE_A(PG8_SA(0, 1), 0, cv[1]);
        if (wr == 1) PG8_BAR;
        PG8_WAIT_V(4); PG8_BAR;
        PG8_STAGE_B(PG8_SB(1, 0), cB + kstep); PG8_STAGE_A(PG8_SA(1, 0), kstep, cv[0]); PG8_STAGE_B(PG8_SB(1, 1), cB + hstep + kstep);
        PG8_WAIT_V(6); PG8_BAR;
    }
    for (;;) {
        const bool has_next = S.next(ui + 1, nxt);
        const char* nB = has_next ? (const char*)g.Bt + (size_t)nxt.pn * tstep : cB;
        if (has_next) { PG8_AOFFS(nv, ui + 1, nxt); }
        else {
#pragma unroll
            for (int h = 0; h < 2; ++h)
#pragma unroll
                for (int i = 0; i < 2; ++i) nv[h][i] = cv[h][i]; }
        for (int t = 0; t < nt; t += 2) {
            const bool last = (t == nt - 2);
            const size_t kb1 = (size_t)(t + 1) * kstep, kb2 = last ? (size_t)0 : (size_t)(t + 2) * kstep, kb3 = kb2 + kstep;
            const char* b2 = last ? nB : cB + (size_t)(t + 2) * kstep; const char* b3 = b2 + kstep;
            unsigned o2[2][2];
#pragma unroll
            for (int h = 0; h < 2; ++h)
#pragma unroll
                for (int i = 0; i < 2; ++i) o2[h][i] = last ? nv[h][i] : cv[h][i];
            if constexpr (SP2) {
            PG8_LDB(B0, 0, 0); PG8_LDB(B1, 0, 1); PG8_SCHED; PG8_LDA(At, 0, 0); PG8_STAGE_A(PG8_SA(1, 1), kb1, cv[1]);
            PG8_WAIT_V(8); PG8_WAIT_L(0); PG8_BAR; PG8_MMA(0, 0, At, B0); PG8_MMA(0, 1, At, B1); PG8_BAR; PG8_SCHED;
            PG8_LDA(At, 0, 1); PG8_STAGE_B(PG8_SB(0, 0), b2); PG8_STAGE_B(PG8_SB(0, 1), b2 + hstep); PG8_STAGE_A(PG8_SA(0, 0), kb2, o2[0]);
            PG8_WAIT_V(8); PG8_WAIT_L(0); PG8_BAR; PG8_MMA(1, 0, At, B0); PG8_MMA(1, 1, At, B1); PG8_BAR; PG8_SCHED;
            PG8_LDB(B0, 1, 0); PG8_LDB(B1, 1, 1); PG8_SCHED; PG8_LDA(At, 1, 0); PG8_STAGE_A(PG8_SA(0, 1), kb2, o2[1]);
            PG8_WAIT_V(8); PG8_WAIT_L(0); PG8_BAR; PG8_MMA(0, 0, At, B0); PG8_MMA(0, 1, At, B1); PG8_BAR; PG8_SCHED;
            PG8_LDA(At, 1, 1); PG8_STAGE_B(PG8_SB(1, 0), b3); PG8_STAGE_B(PG8_SB(1, 1), b3 + hstep); PG8_STAGE_A(PG8_SA(1, 0), kb3, o2[0]);
            PG8_WAIT_V(8); PG8_WAIT_L(0); PG8_BAR; PG8_MMA(1, 0, At, B0); PG8_MMA(1, 1, At, B1); PG8_BAR; PG8_SCHED;
            } else {
            PG8_LDB(B0, 0, 0); PG8_SCHED; PG8_LDA(At, 0, 0); PG8_STAGE_A(PG8_SA(1, 1), kb1, cv[1]);
            PG8_WAIT_L(8); PG8_BAR; PG8_WAIT_L(0); PG8_MMA(0, 0, At, B0); PG8_BAR; PG8_SCHED;
            PG8_LDB(B1, 0, 1); PG8_STAGE_B(PG8_SB(0, 0), b2);
            PG8_BAR; PG8_WAIT_L(0); PG8_MMA(0, 1, At, B1); PG8_BAR;
            PG8_LDA(At, 0, 1); PG8_STAGE_A(PG8_SA(0, 0), kb2, o2[0]);
            PG8_BAR; PG8_WAIT_L(0); PG8_MMA(1, 0, At, B0); PG8_BAR; PG8_SCHED;
            PG8_STAGE_B(PG8_SB(0, 1), b2 + hstep);
            PG8_WAIT_V(6); PG8_BAR; PG8_MMA(1, 1, At, B1); PG8_BAR;
            PG8_LDB(B0, 1, 0); PG8_SCHED; PG8_LDA(At, 1, 0); PG8_STAGE_A(PG8_SA(0, 1), kb2, o2[1]);
            PG8_WAIT_L(8); PG8_BAR; PG8_WAIT_L(0); PG8_MMA(0, 0, At, B0); PG8_BAR; PG8_SCHED;
            PG8_LDB(B1, 1, 1); PG8_STAGE_B(PG8_SB(1, 0), b3);
            PG8_BAR; PG8_WAIT_L(0); PG8_MMA(0, 1, At, B1); PG8_BAR;
            PG8_LDA(At, 1, 1); PG8_STAGE_A(PG8_SA(1, 0), kb3, o2[0]);
            PG8_BAR; PG8_WAIT_L(0); PG8_MMA(1, 0, At, B0); PG8_BAR; PG8_SCHED;
            PG8_STAGE_B(PG8_SB(1, 1), b3 + hstep);
            PG8_WAIT_V(6); PG8_BAR; PG8_MMA(1, 1, At, B1); PG8_BAR;
            }
        }
        if constexpr (ALIGN_EPI) { if (wr == 0) PG8_BAR; }
        E(acc, cur, wr, wc, fr, fq);
        if (!has_next) break;
#pragma unroll
        for (int a = 0; a < 2; ++a)
#pragma unroll
            for (int b = 0; b < 2; ++b)
#pragma unroll
                for (int m = 0; m < 4; ++m)
#pragma unroll
                    for (int n = 0; n < 2; ++n) acc[a][b][m][n] = (f32x4){0.f, 0.f, 0.f, 0.f};
        cur = nxt; cB = nB; ++ui;
#pragma unroll
        for (int h = 0; h < 2; ++h)
#pragma unroll
            for (int i = 0; i < 2; ++i) cv[h][i] = nv[h][i];
        if constexpr (ALIGN_EPI) { if (wr == 1) PG8_BAR; }
    }
    PG8_WAIT_V(0);
    if constexpr (!ALIGN_EPI) { if (wr == 0) PG8_BAR; }
    PG8_BAR;
#undef PG8_SA
#undef PG8_SB
#undef PG8_STAGE_A
#undef PG8_STAGE_B
#undef PG8_LDA
#undef PG8_LDB
#undef PG8_MMA
#undef PG8_WAIT_V
#undef PG8_WAIT_L
#undef PG8_BAR
#undef PG8_SCHED
#undef PG8_AOFFS
}
}

__device__ __forceinline__ void transpose_item(const float* W, int pitch, int k0, int n0, bf16_t* WT, int Kd, int drow0, LAS float* scr, int lane) {
#pragma unroll 8
    for (int i = 0; i < 32; ++i) { const int kk = 2 * i + (lane >> 5); scr[kk * 33 + (lane & 31)] = W[(size_t)(k0 + kk) * pitch + n0 + (lane & 31)]; }
    asm volatile("s_waitcnt lgkmcnt(0)" ::: "memory");
    const int c = lane & 7;
#pragma unroll
    for (int j = 0; j < 4; ++j) { const int n = (lane >> 3) + 8 * j; const LAS float* s = scr + (8 * c) * 33 + n;
        u32x4 o; o.x = pk2(s[0 * 33], s[1 * 33]); o.y = pk2(s[2 * 33], s[3 * 33]); o.z = pk2(s[4 * 33], s[5 * 33]); o.w = pk2(s[6 * 33], s[7 * 33]);
        *(u32x4*)(WT + (size_t)(drow0 + n) * Kd + k0 + 8 * c) = o; }
    asm volatile("s_waitcnt lgkmcnt(0)" ::: "memory");
}
constexpr size_t WT_WIN = 0, WT_WOUT = WT_WIN + (size_t)2 * NP * D, WT_FGU = WT_WOUT + (size_t)2 * D * D, WT_FD = WT_FGU + (size_t)2 * D_FF * D,
                 WT_MGU = WT_FD + (size_t)D * D_FF, WT_MD = WT_MGU + (size_t)NE * 2 * D_FFE * D, WT_END = WT_MD + (size_t)NE * D * D_FFE;
static_assert(WT_END * 2 <= 80 * MiB, "weight copies fit");
__device__ __forceinline__ void ph_pro_weights(const Args& a, Frame& F) {
    LAS float* scr = (LAS float*)(F.lds + F.wave * 16384);
    bf16_t* WT = (bf16_t*)(F.ws + WS_WT);
    constexpr int I_IN0 = 16 * 48, I_IN1 = 16 * 24, I_OUT = 16 * 32, I_FG = 16 * 88, I_FD = 44 * 32, I_M = 16 * 32;
    constexpr int NITEMS = 2 * (I_IN0 + I_IN1 + I_OUT) + 2 * I_FG + I_FD + 24 * I_M;
    for (int it = F.gw; it < NITEMS; it += F.ngw) {
        int r = it; const float* src; int pitch, k0, n0, Kd, drow0; bf16_t* dst;
        if (r < 2 * I_IN0) { const int l = r / I_IN0; r %= I_IN0; src = a.w_in + (size_t)l * D * N_IN; pitch = N_IN; k0 = (r / 48) * 64; n0 = (r % 48) * 32; dst = WT + WT_WIN + (size_t)l * NP * D; Kd = D; drow0 = n0; }
        else if ((r -= 2 * I_IN0) < 2 * I_IN1) { const int l = r / I_IN1; r %= I_IN1; src = a.w_in + (size_t)l * D * N_IN + 1544; pitch = N_IN; k0 = (r / 24) * 64; n0 = (r % 24) * 32; dst = WT + WT_WIN + (size_t)l * NP * D; Kd = D; drow0 = 1536 + n0; }
        else if ((r -= 2 * I_IN1) < 2 * I_OUT) { const int l = r / I_OUT; r %= I_OUT; src = a.w_out + (size_t)l * D * D; pitch = D; k0 = (r / 32) * 64; n0 = (r % 32) * 32; dst = WT + WT_WOUT + (size_t)l * D * D; Kd = D; drow0 = n0; }
        else if ((r -= 2 * I_OUT) < 2 * I_FG) { const int up = r / I_FG; r %= I_FG; src = up ? a.ffn_wu : a.ffn_wg; pitch = D_FF; k0 = (r / 88) * 64; n0 = (r % 88) * 32; dst = WT + WT_FGU; Kd = D; drow0 = (n0 / 128) * 256 + up * 128 + (n0 % 128); }
        else if ((r -= 2 * I_FG) < I_FD) { src = a.ffn_wd; pitch = D; k0 = (r / 32) * 64; n0 = (r % 32) * 32; dst = WT + WT_FD; Kd = D_FF; drow0 = n0; }
        else if ((r -= I_FD) < 16 * I_M) { const int e = r / (2 * I_M); r %= 2 * I_M; const int up = r / I_M; r %= I_M; src = (up ? a.moe_wu : a.moe_wg) + (size_t)e * D * D_FFE; pitch = D_FFE; k0 = (r / 32) * 64; n0 = (r % 32) * 32;
            dst = WT + WT_MGU + (size_t)e * 2 * D_FFE * D; Kd = D; drow0 = (n0 / 128) * 256 + up * 128 + (n0 % 128); }
        else { r -= 16 * I_M; const int e = r / I_M; r %= I_M; src = a.moe_wd + (size_t)e * D_FFE * D; pitch = D; k0 = (r / 32) * 64; n0 = (r % 32) * 32; dst = WT + WT_MD + (size_t)e * D * D_FFE; Kd = D_FFE; drow0 = n0; }
        transpose_item(src, pitch, k0, n0, dst, Kd, drow0, scr, F.lane);
    }
}

template <int NT> __device__ __forceinline__ void moe_order_init(Frame& F, pg8::MoeOrder<NT>& S) {
    const unsigned* c = (const unsigned*)(F.ws + WS_CTL) + CW_MOECNT;
    int acc = 0;
#pragma unroll
    for (int e = 0; e < 8; ++e) { S.bt[e] = acc; acc += ((int)__hip_atomic_load(c + 64 * e, __ATOMIC_RELAXED, __HIP_MEMORY_SCOPE_AGENT) + 255) >> 8; }
    S.bt[8] = acc; S.G = F.nb; S.c = F.bid;
}
template <int NT> __device__ __forceinline__ void moe_ri_preload(Frame& F, const pg8::MoeOrder<NT>& S) {
    LAS int* RI = (LAS int*)(F.lds + RI_OFF); const int* RM = (const int*)(F.ws + WS_RMAP);
    for (int i = 0; i < 15; ++i) { pg8::Unit u; if (!S.next(i, u)) break; if (F.tid < 256) RI[i * 256 + F.tid] = RM[u.pm * 256 + F.tid]; }
    __syncthreads();
}

__global__ void __launch_bounds__(NTHREADS, 2) fwd(Args a) {
    extern __shared__ __attribute__((aligned(16))) unsigned char lds_raw[];
    Frame F;
    F.lds = (LAS unsigned char*)lds_raw;
    F.tid = threadIdx.x; F.lane = F.tid & 63; F.wave = __builtin_amdgcn_readfirstlane(F.tid >> 6);
    F.bid = blockIdx.x; F.nb = gridDim.x; F.gw = F.bid * NWAVES + F.wave; F.ngw = F.nb * NWAVES; F.ws = a.ws;
    volatile LAS unsigned* MISC = (volatile LAS unsigned*)(F.lds + MISC_OFF);
    for (int u = F.tid; u < 32; u += NTHREADS) MISC[u] = 0u;
    __syncthreads();
    unsigned* ctl = (unsigned*)(a.ws + WS_CTL);
    const int lo = a.ph_lo, hi = a.ph_hi;
    const bool multi = (hi - lo) > 1;
    XcdBarrier bar; bar.bar = ctl + CW_BAR; bar.x = 0; bar.st = MISC + 8;
    if (multi) bar = xcd_barrier_post(ctl + CW_BAR, MISC + 8);
#define IN(k) (lo <= (k) && (k) < hi && (frame_refresh(F, a, (LAS unsigned char*)lds_raw), true))
#define SEAM(k) do { if (IN((k) + 1) && IN(k)) xcd_barrier(bar); } while (0)
    float* MOD = (float*)(a.ws + WS_MOD);
    bf16_t* H = (bf16_t*)(a.ws + WS_H); bf16_t* PROJ = (bf16_t*)(a.ws + WS_PROJ); bf16_t* YMIX = (bf16_t*)(a.ws + WS_YMIX);
    bf16_t* WT = (bf16_t*)(a.ws + WS_WT);
    bf16_t* ACT = (bf16_t*)(a.ws + WS_ACT); bf16_t* ACTM = (bf16_t*)(a.ws + WS_ACTM); bf16_t* YMOE = (bf16_t*)(a.ws + WS_YMOE);

    if (IN(PH_PRO)) { ph_pro_naive(a, F); if (GEMM_MASK) ph_pro_weights(a, F); SEAM(PH_PRO); }

#define LAYER_BODY(l) {\
        const int pb = PH_LAYER0 + PH_PER_LAYER * l; \
        const float* xin = (l == 0) ? a.x : a.out; \
        const float* mod0 = MOD + (size_t)(l * 2 + 0) * 2 * 3072; const float* mod1 = MOD + (size_t)(l * 2 + 1) * 2 * 3072; \
        if (IN(pb + K_NORM1)) { ph_norm<1>(a, F, l, xin, a.nmg + l * D, mod0, a.w_in + (size_t)l * D * N_IN + W_DB, N_IN); SEAM(pb + K_NORM1); } \
        if (IN(pb + K_GEMM_IN)) { \
            if constexpr ((GEMM_MASK & 1) != 0) { pg8::Gemm g{H, WT + WT_WIN + (size_t)l * NP * D, D}; pg8::StaticOrder S; S.init(T, NP, F.nb, F.bid); pg8::EpiBf16 E{PROJ, NP, 1 << 20}; \
                pg8::gemm_phase<pg8::EpiBf16, pg8::StaticOrder, false, true, true>(F.lds, nullptr, g, S, E); } else { \
            EpiStoreBf16 E{PROJ, NP}; \
            gemm_naive<false>(F, H, D, nullptr, 0, T, D, a.w_in + (size_t)l * D * N_IN, nullptr, N_IN, NP, 1536, 8, E); } \
            SEAM(pb + K_GEMM_IN); \
        } \
        if (IN(pb + K_DN_PREP)) { if (DN_CHUNKED) ph_dn_chunk(a, F, l); else ph_dn_prep_naive(a, F, l); if (ATTN_MFMA) ph_rope(a, F); SEAM(pb + K_DN_PREP); } \
        if (IN(pb + K_MIX)) { if (DN_CHUNKED) ph_dn_scan(a, F); else ph_dn_scan_naive(a, F); if (ATTN_MFMA) ph_attn_mfma(a, F, l); else ph_attn_naive(a, F, l); ph_conv_naive(a, F, l); SEAM(pb + K_MIX); } \
        if (IN(pb + K_DN_OUT)) { if (DN_CHUNKED) ph_dn_out(a, F, l); else ph_dn_out_naive(a, F, l); SEAM(pb + K_DN_OUT); } \
        if (IN(pb + K_GEMM_OUT)) { \
            if constexpr ((GEMM_MASK & 2) != 0) { pg8::Gemm g{YMIX, WT + WT_WOUT + (size_t)l * D * D, D}; pg8::StaticOrder S; S.init(T, D, F.nb, F.bid); pg8::EpiResidF32 E{xin, a.out, mod0 + 2048}; \
                pg8::gemm_phase<pg8::EpiResidF32, pg8::StaticOrder, false, true, true>(F.lds, nullptr, g, S, E); } else { \
            EpiResid E{xin, a.out, mod0 + 2048}; \
            gemm_naive<false>(F, YMIX, D, nullptr, 0, T, D, a.w_out + (size_t)l * D * D, nullptr, D, D, 1 << 30, 0, E); } \
            SEAM(pb + K_GEMM_OUT); \
        } \
        if (l == 0) { \
            if (IN(pb + K_NORM2)) { ph_norm<0>(a, F, l, a.out, a.nfg + l * D, mod1, nullptr, 0); SEAM(pb + K_NORM2); } \
            if (IN(pb + K_MOE_LIST)) { SEAM(pb + K_MOE_LIST); } \
            if (IN(pb + K_FFN1)) { \
                if constexpr ((GEMM_MASK & 4) != 0) { pg8::Gemm g{H, WT + WT_FGU, D}; pg8::StaticOrder S; S.init(T, 2 * D_FF, F.nb, F.bid); pg8::EpiSwiGLU E{ACT, D_FF, 1 << 20}; \
                    pg8::gemm_phase<pg8::EpiSwiGLU, pg8::StaticOrder, false, true, true>(F.lds, nullptr, g, S, E); } else { \
                EpiSwiglu E{ACT, D_FF}; \
                gemm_naive<true>(F, H, D, nullptr, 0, T, D, a.ffn_wg, a.ffn_wu, D_FF, D_FF, 1 << 30, 0, E); } \
                SEAM(pb + K_FFN1); \
            } \
            if (IN(pb + K_FFN2)) { \
                if constexpr ((GEMM_MASK & 8) != 0) { pg8::Gemm g{ACT, WT + WT_FD, D_FF}; pg8::StaticOrder S; S.init(T, D, F.nb, F.bid); pg8::EpiResidF32 E{a.out, a.out, mod1 + 2048}; \
                    pg8::gemm_phase<pg8::EpiResidF32, pg8::StaticOrder, false, true, true>(F.lds, nullptr, g, S, E); } else { \
                EpiResid E{a.out, a.out, mod1 + 2048}; \
                gemm_naive<false>(F, ACT, D_FF, nullptr, 0, T, D_FF, a.ffn_wd, nullptr, D, D, 1 << 30, 0, E); } \
                SEAM(pb + K_FFN2); \
            } \
        } else { \
            if (IN(pb + K_NORM2)) { ph_norm<2>(a, F, l, a.out, a.nfg + l * D, mod1, a.router_w, NE); SEAM(pb + K_NORM2); } \
            if (IN(pb + K_MOE_LIST)) { ph_moe_list(a, F); SEAM(pb + K_MOE_LIST); } \
            if (IN(pb + K_FFN1)) { \
                if constexpr ((GEMM_MASK & 16) != 0) { pg8::MoeOrder<8> S; moe_order_init<8>(F, S); moe_ri_preload<8>(F, S); \
                    pg8::Gemm g{H, WT + WT_MGU, D}; pg8::EpiSwiGLU E{ACTM, D_FFE, 8}; \
                    pg8::gemm_phase<pg8::EpiSwiGLU, pg8::MoeOrder<8>, true, true, true>(F.lds, (const LAS int*)(F.lds + RI_OFF), g, S, E); } else { \
                const int* RM = (const int*)(a.ws + WS_RMAP); \
                EpiSwiglu E{ACTM, D_FFE}; \
                for (int e = 0; e < NE; ++e) { int elo, ehi; moe_range(F, e, elo, ehi); \
                    gemm_naive<true>(F, H, D, RM, elo, ehi - elo, D, a.moe_wg + (size_t)e * D * D_FFE, a.moe_wu + (size_t)e * D * D_FFE, D_FFE, D_FFE, 1 << 30, 0, E); } } \
                SEAM(pb + K_FFN1); \
            } \
            if (IN(pb + K_FFN2)) { \
                if constexpr ((GEMM_MASK & 32) != 0) { pg8::MoeOrder<4> S; moe_order_init<4>(F, S); \
                    pg8::Gemm g{ACTM, WT + WT_MD, D_FFE}; pg8::EpiBf16 E{YMOE, D, 4}; \
                    pg8::gemm_phase<pg8::EpiBf16, pg8::MoeOrder<4>, false, true, true>(F.lds, nullptr, g, S, E); } else { \
                EpiStoreBf16 E{YMOE, D}; \
                for (int e = 0; e < NE; ++e) { int elo, ehi; moe_range(F, e, elo, ehi); \
                    gemm_naive<false>(F, ACTM, D_FFE, nullptr, elo, ehi - elo, D_FFE, a.moe_wd + (size_t)e * D_FFE * D, nullptr, D, D, 1 << 30, 0, E); } } \
                SEAM(pb + K_FFN2); \
            } \
        } \
    }
    LAYER_BODY(0)
    LAYER_BODY(1)
#undef LAYER_BODY
    if (IN(PH_FINAL)) { ph_final(a, F); }
#undef IN
#undef SEAM
}

extern "C" void kernel_launch(void* const* d_in, const int* in_sizes, int n_in, void* d_out, int out_size, void* d_ws, size_t ws_size, hipStream_t stream) {
    static int grid = 0;
    if (grid == 0) {
        if (n_in != 27 || out_size != T * D || ws_size < WS_END) { fprintf(stderr, "kernel_launch: unexpected shapes n_in %d out %d ws %zu\n", n_in, out_size, ws_size); grid = -1; return; }
        int dev = 0, cus = 0, per_cu = 0;
        if (hipGetDevice(&dev) != hipSuccess || hipDeviceGetAttribute(&cus, hipDeviceAttributeMultiprocessorCount, dev) != hipSuccess) { grid = -1; return; }
        if (hipFuncSetAttribute((const void*)fwd, hipFuncAttributeMaxDynamicSharedMemorySize, LDS_BYTES) != hipSuccess) { fprintf(stderr, "kernel_launch: hipFuncSetAttribute failed\n"); grid = -1; return; }
        if (hipOccupancyMaxActiveBlocksPerMultiprocessor(&per_cu, (const void*)fwd, NTHREADS, LDS_BYTES) != hipSuccess || per_cu < 1) fprintf(stderr, "kernel_launch: occupancy query says %d\n", per_cu);
        (void)hipGetLastError();
        grid = cus;
    }
    if (grid < 0) return;
    (void)hipMemsetAsync((char*)d_ws + WS_CTL, 0, CTL_ZERO_BYTES, stream);
    Args a{};
    const void** pp = (const void**)&a;
    for (int i = 0; i < 27; ++i) pp[i] = d_in[i];
    a.out = (float*)d_out; a.ws = (unsigned char*)d_ws;
#if MK_ONE_LAUNCH
    a.ph_lo = 0; a.ph_hi = NPH;
    hipLaunchKernelGGL(fwd, dim3(grid), dim3(NTHREADS), LDS_BYTES, stream, a);
#else
    static const int phases[] = {0, 1, 2, 3, 4, 5, 6, 7, 9, 10, 11, 12, 13, 14, 15, 16, 17, 18, 19, 20, 21};
    for (int p : phases) { a.ph_lo = p; a.ph_hi = p + 1; hipLaunchKernelGGL(fwd, dim3(grid), dim3(NTHREADS), LDS_BYTES, stream, a); }
#endif
}
```

```cpp
#include <hip/hip_runtime.h>
#include <cstdio>
#include <cstdint>

#define LAS __attribute__((address_space(3)))
#define GAS __attribute__((address_space(1)))
typedef unsigned short bf16_t;
typedef float f32x4 __attribute__((ext_vector_type(4)));
typedef unsigned u32x2 __attribute__((ext_vector_type(2)));
typedef unsigned u32x4 __attribute__((ext_vector_type(4)));

#ifndef GEMM_MASK
#define GEMM_MASK 63
#endif
#ifndef ATTN_MFMA
#define ATTN_MFMA 1
#endif
#ifndef DN_CHUNKED
#define DN_CHUNKED 1
#endif
#ifndef CONV_FAST
#define CONV_FAST 1
#endif
#ifndef PROBE_MASK
#define PROBE_MASK 0
#endif
#define REP(bit) for (int rep_ = 0; rep_ < ((PROBE_MASK & (bit)) ? 2 : 1); ++rep_)
#ifndef MK_ONE_LAUNCH
#define MK_ONE_LAUNCH 1
#endif

constexpr int BATCH = 2, SEQ = 16384, T = BATCH * SEQ, D = 1024, DEPTH = 2;
constexpr int N_IN = 2312, NP = 2304;
constexpr int C_AQ = 0, C_AK = 512, C_AV = 640, C_DQ = 768, C_DK = 1024, C_DV = 1280, C_DZ = 1536, C_CA = 1792, C_CB = 2048;
constexpr int W_DB = 1536;
constexpr int D_FF = 2816, NE = 8, D_FFE = 1024;
constexpr int WINDOW = 128, CV_K = 31, CV_C = 256, DN_CONV = 4;
constexpr float EPS = 1e-6f;
constexpr int NSCAN = BATCH * 4 * 4;
constexpr int MOE_CAP = 67584;

constexpr size_t MiB = 1u << 20;
constexpr size_t WS_CTL = 0, CTL_ZERO_BYTES = 1 * MiB;
constexpr size_t WS_MOD = 1 * MiB;
constexpr size_t WS_CS = 2 * MiB;
constexpr size_t WS_BG = 4 * MiB;
constexpr size_t WS_ROUTE = 5 * MiB;
constexpr size_t WS_POS = 6 * MiB;
constexpr size_t WS_RMAP = 7 * MiB;
constexpr size_t WS_WT = 8 * MiB;
constexpr size_t WS_H = 88 * MiB;
constexpr size_t WS_PROJ = 152 * MiB;
constexpr size_t WS_YMIX = 296 * MiB;
constexpr size_t WS_DNQKV = 360 * MiB;
constexpr size_t WS_ODN = 456 * MiB;
constexpr size_t WS_ACT = 152 * MiB;
constexpr size_t WS_ACTM = 152 * MiB;
constexpr size_t WS_YMOE = 284 * MiB;
constexpr size_t WS_END = 512 * MiB;
constexpr int CW_BAR = 4096;
constexpr int CW_MOECNT = 16384;

constexpr int NWAVES = 8, NTHREADS = 512;
constexpr int LDS_BYTES = 147456;
constexpr int MISC_OFF = 131072 + 320;
constexpr int RI_OFF = 132096;

constexpr int PH_PRO = 0, PH_LAYER0 = 1, PH_PER_LAYER = 10, PH_FINAL = 21, NPH = 22;
enum { K_NORM1 = 0, K_GEMM_IN, K_DN_PREP, K_MIX, K_DN_OUT, K_GEMM_OUT, K_NORM2, K_MOE_LIST, K_FFN1, K_FFN2 };

struct Args {
    const float* x; const float* c; const int* pos; const float* ada_w; const float* ada_b; const float* nmg; const float* nfg;
    const float* w_in; const float* sinks; const float* dn_conv_w; const float* dn_a_log; const float* dn_dt_bias; const float* dn_norm_g;
    const float* cv_dw_w; const float* cv_dw_b; const float* cv_ln_g; const float* cv_ln_b; const float* w_out;
    const float* ffn_wg; const float* ffn_wu; const float* ffn_wd; const float* router_w; const float* router_b;
    const float* moe_wg; const float* moe_wu; const float* moe_wd; const float* final_g;
    float* out; unsigned char* ws; int ph_lo, ph_hi;
};

__device__ __forceinline__ float bf2f(unsigned u) { return __uint_as_float(u << 16); }
__device__ __forceinline__ unsigned f2bf(float f) { unsigned u = __float_as_uint(f); return (u + 0x7fffu + ((u >> 16) & 1u)) >> 16; }
__device__ __forceinline__ unsigned pk2(float lo, float hi) { return f2bf(lo) | (f2bf(hi) << 16); }
__device__ __forceinline__ float wave_sum(float v) {
#pragma unroll
    for (int o = 1; o < 64; o <<= 1) v += __shfl_xor(v, o);
    return v;
}
__device__ __forceinline__ float wave_max(float v) {
#pragma unroll
    for (int o = 1; o < 64; o <<= 1) v = fmaxf(v, __shfl_xor(v, o));
    return v;
}
__device__ __forceinline__ float sigmoidf_(float x) { return 1.0f / (1.0f + __expf(-x)); }
__device__ __forceinline__ float siluf_(float x) { return x / (1.0f + __expf(-x)); }
__device__ __forceinline__ float softplusf_(float x) { return fmaxf(x, 0.f) + log1pf(__expf(-fabsf(x))); }

#define XB_TMO      128
#define XB_XCNT(j)  (256  + 64 * (j))
#define XB_XSUB(j)  (1280 + 64 * (j))
#define XB_XGEN(j)  (2304 + 64 * (j))
#define XB_TOP      3328
#define XB_TOPGEN   3392
#define XCD_BAR_WORDS 3456
#define XB_SPIN_CAP (1u << 18)

__device__ __forceinline__ unsigned xb_ld(unsigned* p)              { return __hip_atomic_load(p, __ATOMIC_RELAXED, __HIP_MEMORY_SCOPE_AGENT); }
__device__ __forceinline__ unsigned xb_add(unsigned* p, unsigned v) { return __hip_atomic_fetch_add(p, v, __ATOMIC_RELAXED, __HIP_MEMORY_SCOPE_AGENT); }
__device__ __forceinline__ unsigned xb_xcc_id() { return (unsigned)__builtin_amdgcn_s_getreg((3 << 11) | 20) & 0xFu; }
#define XB_SPIN(cond, bar) do { unsigned _sp = 0; while (cond) { __builtin_amdgcn_s_sleep(1); \
    if ((++_sp & 255u) == 0u) { if (xb_ld(&(bar)[XB_TMO])) break; if (_sp > XB_SPIN_CAP) { atomicAdd(&(bar)[XB_TMO], 1u); break; } } } } while (0)

struct XcdBarrier { unsigned* bar; unsigned x; volatile LAS unsigned* st; };

__device__ __forceinline__ XcdBarrier xcd_barrier_post(unsigned* bar, volatile LAS unsigned* st) {
    XcdBarrier b; b.bar = bar; b.x = xb_xcc_id(); b.st = st;
    if (threadIdx.x == 0) (void)xb_add(&bar[XB_XCNT(b.x)], 1u);
    return b;
}
__device__ __forceinline__ void xcd_barrier_complete(unsigned* bar, unsigned x, unsigned& nloc, unsigned& nx) {
    const unsigned G = gridDim.x * gridDim.y * gridDim.z;
    unsigned sum, cnt, mine, sp = 0u;
    for (;;) {
        sum = 0u; cnt = 0u; mine = 0u;
#pragma unroll
        for (unsigned j = 0; j < 16; ++j) { const unsigned c = xb_ld(&bar[XB_XCNT(j)]); sum += c; cnt += (c > 0u) ? 1u : 0u; mine = (j == x) ? c : mine; }
        if (sum == G) break;
        __builtin_amdgcn_s_sleep(1);
        if ((++sp & 255u) == 0u) { if (xb_ld(&bar[XB_TMO])) break; if (sp > XB_SPIN_CAP) { atomicAdd(&bar[XB_TMO], 1u); break; } }
    }
    nloc = mine > 0u ? mine : 1u; nx = cnt > 0u ? cnt : 1u;
}
__device__ __forceinline__ void xcd_barrier(const XcdBarrier& b) {
    asm volatile("s_waitcnt vmcnt(0)" ::: "memory");
    __syncthreads();
    if (threadIdx.x == 0) {
        unsigned* bar = b.bar;
        __builtin_amdgcn_s_waitcnt(0);
        unsigned nloc = b.st[0], nx = b.st[1];
        if (nloc == 0u) { xcd_barrier_complete(bar, b.x, nloc, nx); b.st[0] = nloc; b.st[1] = nx; }
        const unsigned old = xb_add(&bar[XB_XSUB(b.x)], 1u);
        const unsigned gen = old / nloc;
        if (old + 1u == (gen + 1u) * nloc) {
            __builtin_amdgcn_fence(__ATOMIC_RELEASE, "agent");
            asm volatile("s_waitcnt vmcnt(0)" ::: "memory");
            const unsigned og = xb_add(&bar[XB_TOP], 1u);
            const unsigned tg = og / nx;
            if (og + 1u == (tg + 1u) * nx) xb_add(&bar[XB_TOPGEN], 1u);
            else XB_SPIN(xb_ld(&bar[XB_TOPGEN]) == tg, bar);
            __builtin_amdgcn_fence(__ATOMIC_ACQUIRE, "agent");
            xb_add(&bar[XB_XGEN(b.x)], 1u);
            asm volatile("s_waitcnt vmcnt(0)" ::: "memory");
        } else {
            XB_SPIN(xb_ld(&bar[XB_XGEN(b.x)]) == gen, bar);
            __builtin_amdgcn_fence(__ATOMIC_ACQUIRE, "agent");
            asm volatile("s_waitcnt vmcnt(0)" ::: "memory");
        }
    }
    __syncthreads();
}

struct Frame {
    LAS unsigned char* lds;
    int tid, lane, wave, gw, ngw, bid, nb;
    GAS unsigned char* ws;
};

__device__ __forceinline__ void frame_refresh(Frame& F, const Args& a, LAS unsigned char* lds) {
    int tid = threadIdx.x; asm volatile("" : "+v"(tid));
    int bid = blockIdx.x; asm volatile("" : "+s"(bid));
    unsigned char* ws = a.ws; asm volatile("" : "+s"(ws));
    F.lds = lds; F.tid = tid; F.lane = tid & 63; F.wave = __builtin_amdgcn_readfirstlane(tid >> 6);
    F.bid = bid; F.nb = gridDim.x; F.gw = F.bid * NWAVES + F.wave; F.ngw = F.nb * NWAVES; F.ws = (GAS unsigned char*)ws;
}
__device__ __forceinline__ void ph_pro_naive(const Args& a, Frame& F) {
    float* MOD = (float*)(F.ws + WS_MOD);
    LAS float* red = (LAS float*)F.lds;
    for (int it = F.bid; it < 4 * 48; it += F.nb) {
        const int lk = it / 48, cg = it % 48, e = cg * 64 + F.lane;
        const float* W = a.ada_w + (size_t)lk * D * 3072 + e;
        float a0 = 0.f, a1 = 0.f;
        const int d0 = F.wave * 128;
#pragma unroll 8
        for (int d = d0; d < d0 + 128; ++d) {
            const float w = W[(size_t)d * 3072];
            a0 += siluf_(a.c[d]) * w; a1 += siluf_(a.c[D + d]) * w;
        }
        red[(F.wave * 2 + 0) * 64 + F.lane] = a0; red[(F.wave * 2 + 1) * 64 + F.lane] = a1;
        __syncthreads();
        if (F.wave < 2) {
            float s = 0.f;
            for (int w = 0; w < 8; ++w) s += red[(w * 2 + F.wave) * 64 + F.lane];
            MOD[((size_t)lk * 2 + F.wave) * 3072 + e] = s + a.ada_b[lk * 3072 + e];
        }
        __syncthreads();
    }
    float* CS = (float*)(F.ws + WS_CS);
    for (int idx = F.bid * NTHREADS + F.tid; idx < T * 8; idx += F.nb * NTHREADS) {
        const int t = idx >> 3, i = idx & 7;
        const float inv = powf(500000.0f, -(float)(2 * i) / 16.0f);
        const float ang = (float)a.pos[t] * inv;
        CS[t * 16 + i] = cosf(ang); CS[t * 16 + 8 + i] = sinf(ang);
    }
}

template <int MODE>
__device__ __forceinline__ void ph_norm(const Args& a, Frame& F, int l, const float* xin, const float* gain, const float* modk  ,
                                        const float* W8, int pitch) {
    bf16_t* H = (bf16_t*)(F.ws + WS_H);
    LAS float* W8T = (LAS float*)F.lds;
    if (MODE != 0) {
        for (int i = F.tid; i < 8192; i += NTHREADS) { const int d = i >> 3, j = i & 7; W8T[j * 1024 + d] = W8[(size_t)d * pitch + j]; }
        __syncthreads();
    }
    f32x4 vn[4], A4[4], B4[4]; int cur_b = -1;
    if (F.gw < T) {
#pragma unroll
        for (int j = 0; j < 4; ++j) vn[j] = ((const f32x4*)(xin + (size_t)F.gw * D) + F.lane)[64 * j];
    }
    for (int row = F.gw; row < T; row += F.ngw) {
        const int b = row / SEQ;
        f32x4 v[4]; float ss = 0.f;
#pragma unroll
        for (int j = 0; j < 4; ++j) { v[j] = vn[j]; ss += (v[j].x * v[j].x + v[j].y * v[j].y) + (v[j].z * v[j].z + v[j].w * v[j].w); }
        if (row + F.ngw < T) {
#pragma unroll
            for (int j = 0; j < 4; ++j) vn[j] = ((const f32x4*)(xin + (size_t)(row + F.ngw) * D) + F.lane)[64 * j];
        }
        if (b != cur_b) {
            cur_b = b; const float* sh = modk + (size_t)b * 3072; const float* sc = sh + 1024;
#pragma unroll
            for (int j = 0; j < 4; ++j) { const int d = 256 * j + 4 * F.lane; A4[j] = *(const f32x4*)(gain + d) * (*(const f32x4*)(sc + d) + 1.0f); B4[j] = *(const f32x4*)(sh + d); }
        }
        const float rstd = rsqrtf(wave_sum(ss) * (1.0f / D) + EPS);
        float acc[8];
#pragma unroll
        for (int e = 0; e < 8; ++e) acc[e] = 0.f;
#pragma unroll
        for (int j = 0; j < 4; ++j) {
            const int d = 256 * j + 4 * F.lane;
            const f32x4 hv = (v[j] * rstd) * A4[j] + B4[j];
            u32x2 o; o.x = pk2(hv.x, hv.y); o.y = pk2(hv.z, hv.w);
            *(u32x2*)(H + (size_t)row * D + d) = o;
            if (MODE != 0) {
#pragma unroll
                for (int e = 0; e < 8; ++e) { const f32x4 w4 = *(const LAS f32x4*)(W8T + e * 1024 + d); acc[e] += (hv.x * w4.x + hv.y * w4.y) + (hv.z * w4.z + hv.w * w4.w); }
            }
        }
        if (MODE != 0) {
#pragma unroll
            for (int e = 0; e < 8; ++e) acc[e] = wave_sum(acc[e]);
        }
        if (MODE == 1 && F.lane == 0) {
            float* BG = (float*)(F.ws + WS_BG) + (size_t)row * 8;
#pragma unroll
            for (int h = 0; h < 4; ++h) {
                BG[h] = sigmoidf_(acc[h]);
                BG[4 + h] = -__expf(a.dn_a_log[l * 4 + h]) * softplusf_(acc[4 + h] + a.dn_dt_bias[l * 4 + h]);
            }
        }
        if (MODE == 2 && F.lane == 0) {
            float v0 = -INFINITY, v1 = -INFINITY; int e0 = 0, e1 = 0;
#pragma unroll
            for (int e = 0; e < 8; ++e) { const float lg = acc[e] + a.router_b[e]; if (lg > v0) { v1 = v0; e1 = e0; v0 = lg; e0 = e; } else if (lg > v1) { v1 = lg; e1 = e; } }
            const float ex = __expf(v1 - v0), p0 = 1.0f / (1.0f + ex), p1 = ex / (1.0f + ex);
            unsigned* cnt = (unsigned*)(F.ws + WS_CTL) + CW_MOECNT;
            const int q0 = (int)atomicAdd(cnt + 64 * e0, 1u), q1 = (int)atomicAdd(cnt + 64 * e1, 1u);
            int* R = (int*)(F.ws + WS_ROUTE) + (size_t)row * 4; R[0] = e0; R[1] = e1; ((float*)R)[2] = p0; ((float*)R)[3] = p1;
            int* P = (int*)(F.ws + WS_POS) + (size_t)row * 2; P[0] = q0; P[1] = q1;
        }
    }
    if (MODE != 0) __syncthreads();
}

template <bool DUAL, class Epi>
__device__ __forceinline__ void gemm_naive(Frame& F, const bf16_t* A, int lda, const int* rowmap, int m_base, int Mrows, int K,
                                           const float* W0, const float* W1, int ldw, int N, int skip_at, int skip, const Epi& epi) {
    LAS float* As = (LAS float*)F.lds;
    LAS float* Bs = As + 16 * 132;
    LAS float* Bs2 = Bs + 16 * 128;
    const int ntm = Mrows / 128, ntn = N / 128;
    const int ty = F.tid >> 4, tx = F.tid & 15;
    const int ar = F.tid >> 2, ak = (F.tid & 3) * 4;
    const int bk = F.tid >> 5, bc = (F.tid & 31) * 4;
    for (int tile = F.bid; tile < ntm * ntn; tile += F.nb) {
        const int tm = tile / ntn, tn = tile % ntn, m0 = m_base + tm * 128, n0 = tn * 128;
        const int wn0 = (n0 >= skip_at) ? n0 + skip : n0;
        const int arow = rowmap ? rowmap[m0 + ar] : (m0 + ar);
        const bf16_t* ap = A + (size_t)arow * lda + ak;
        float acc0[4][8], acc1[4][8];
#pragma unroll
        for (int i = 0; i < 4; ++i)
#pragma unroll
            for (int j = 0; j < 8; ++j) { acc0[i][j] = 0.f; acc1[i][j] = 0.f; }
        for (int k0 = 0; k0 < K; k0 += 16) {
            const u32x2 av = *(const u32x2*)(ap + k0);
            const f32x4 bv = *(const f32x4*)(W0 + (size_t)(k0 + bk) * ldw + wn0 + bc);
            f32x4 bv2 = (f32x4){0.f, 0.f, 0.f, 0.f};
            if (DUAL) bv2 = *(const f32x4*)(W1 + (size_t)(k0 + bk) * ldw + wn0 + bc);
            __syncthreads();
            As[(ak + 0) * 132 + ar] = bf2f(av.x & 0xffffu); As[(ak + 1) * 132 + ar] = bf2f(av.x >> 16);
            As[(ak + 2) * 132 + ar] = bf2f(av.y & 0xffffu); As[(ak + 3) * 132 + ar] = bf2f(av.y >> 16);
            *(LAS f32x4*)(Bs + bk * 128 + bc) = bv;
            if (DUAL) *(LAS f32x4*)(Bs2 + bk * 128 + bc) = bv2;
            __syncthreads();
#pragma unroll 2
            for (int kk = 0; kk < 16; ++kk) {
                const f32x4 a4 = *(const LAS f32x4*)(As + kk * 132 + ty * 4);
                const f32x4 b0 = *(const LAS f32x4*)(Bs + kk * 128 + tx * 8), b1 = *(const LAS f32x4*)(Bs + kk * 128 + tx * 8 + 4);
                const float av4[4] = {a4.x, a4.y, a4.z, a4.w};
                const float bb[8] = {b0.x, b0.y, b0.z, b0.w, b1.x, b1.y, b1.z, b1.w};
#pragma unroll
                for (int i = 0; i < 4; ++i)
#pragma unroll
                    for (int j = 0; j < 8; ++j) acc0[i][j] += av4[i] * bb[j];
                if (DUAL) {
                    const f32x4 c0 = *(const LAS f32x4*)(Bs2 + kk * 128 + tx * 8), c1 = *(const LAS f32x4*)(Bs2 + kk * 128 + tx * 8 + 4);
                    const float cc[8] = {c0.x, c0.y, c0.z, c0.w, c1.x, c1.y, c1.z, c1.w};
#pragma unroll
                    for (int i = 0; i < 4; ++i)
#pragma unroll
                        for (int j = 0; j < 8; ++j) acc1[i][j] += av4[i] * cc[j];
                }
            }
        }
#pragma unroll
        for (int i = 0; i < 4; ++i)
#pragma unroll
            for (int j = 0; j < 8; ++j) epi(m0 + ty * 4 + i, n0 + tx * 8 + j, acc0[i][j], acc1[i][j]);
    }
    __syncthreads();
}
struct EpiStoreBf16 { bf16_t* C; int ldc; __device__ __forceinline__ void operator()(int m, int n, float a0, float) const { C[(size_t)m * ldc + n] = (bf16_t)f2bf(a0); } };
struct EpiSwiglu { bf16_t* C; int ldc; __device__ __forceinline__ void operator()(int m, int n, float a0, float a1) const { C[(size_t)m * ldc + n] = (bf16_t)f2bf(siluf_(a0) * a1); } };
struct EpiResid { const float* xin; float* xout; const float* gate;   __device__ __forceinline__ void operator()(int m, int n, float a0, float) const {
    const int b = m / SEQ; xout[(size_t)m * D + n] = xin[(size_t)m * D + n] + gate[(size_t)b * 3072 + n] * a0; } };

__device__ __forceinline__ void ph_dn_prep_naive(const Args& a, Frame& F, int l) {
    const bf16_t* P = (const bf16_t*)(F.ws + WS_PROJ);
    float* Q = (float*)(F.ws + WS_DNQKV);
    const float* cw = a.dn_conv_w + (size_t)l * DN_CONV * 768;
    for (int t = F.gw; t < T; t += F.ngw) {
        const int s = t % SEQ;
#pragma unroll
        for (int j = 0; j < 12; ++j) {
            const int c = F.lane + 64 * j;
            float acc = 0.f;
#pragma unroll
            for (int k = 0; k < DN_CONV; ++k) { const int sp = s - (DN_CONV - 1) + k; if (sp >= 0) acc += cw[k * 768 + c] * bf2f(P[(size_t)(t - (DN_CONV - 1) + k) * NP + C_DQ + c]); }
            float val = siluf_(acc);
            if (j < 8) { const float n2 = wave_sum(val * val); val *= rsqrtf(n2 + EPS); if (j < 4) val *= 0.125f; }
            Q[(size_t)t * 768 + c] = val;
        }
    }
}
__device__ __forceinline__ void ph_dn_scan_naive(const Args& a, Frame& F) {
    const float* Q = (const float*)(F.ws + WS_DNQKV); const float* BG = (const float*)(F.ws + WS_BG); float* O = (float*)(F.ws + WS_ODN);
    for (int task = F.gw; task < BATCH * 4 * 64; task += F.ngw) {
        const int col = task & 63, h = (task >> 6) & 3, b = task >> 8;
        float S = 0.f;
        for (int s0 = 0; s0 < SEQ; s0 += 8) {
            float q8[8], k8[8], v8[8], b8[8], g8[8];
#pragma unroll
            for (int i = 0; i < 8; ++i) { const size_t t = (size_t)b * SEQ + s0 + i; q8[i] = Q[t * 768 + h * 64 + F.lane]; k8[i] = Q[t * 768 + 256 + h * 64 + F.lane]; v8[i] = Q[t * 768 + 512 + h * 64 + col];
                b8[i] = BG[t * 8 + h]; g8[i] = BG[t * 8 + 4 + h]; }
#pragma unroll
            for (int i = 0; i < 8; ++i) {
                const float eg = __expf(g8[i]);
                const float kS = wave_sum(k8[i] * S);
                const float dl = b8[i] * (v8[i] - eg * kS);
                S = eg * S + k8[i] * dl;
                const float o = wave_sum(q8[i] * S);
                if (F.lane == 0) O[((size_t)b * SEQ + s0 + i) * 256 + h * 64 + col] = o;
            }
        }
    }
}
__device__ __forceinline__ void ph_dn_out_naive(const Args& a, Frame& F, int l) {
    const float* O = (const float*)(F.ws + WS_ODN); const bf16_t* P = (const bf16_t*)(F.ws + WS_PROJ); bf16_t* Y = (bf16_t*)(F.ws + WS_YMIX);
    for (int task = F.gw; task < T * 4; task += F.ngw) {
        const int t = task >> 2, h = task & 3;
        const float o = O[(size_t)t * 256 + h * 64 + F.lane];
        const float ms = wave_sum(o * o) * (1.0f / 64.0f);
        const float z = bf2f(P[(size_t)t * NP + C_DZ + h * 64 + F.lane]);
        const float y = o * rsqrtf(ms + EPS) * a.dn_norm_g[l * 64 + F.lane] * siluf_(z);
        Y[(size_t)t * D + 512 + h * 64 + F.lane] = (bf16_t)f2bf(y);
    }
}
__device__ __forceinline__ float rope_lane(float x, int lane, const float* cs) {
    const float xp = __shfl(x, lane ^ 8);
    if (lane < 8) return x * cs[lane] - xp * cs[8 + lane];
    if (lane < 16) return x * cs[lane - 8] + xp * cs[lane];
    return x;
}
__device__ __forceinline__ void ph_attn_naive(const Args& a, Frame& F, int l) {
    const bf16_t* P = (const bf16_t*)(F.ws + WS_PROJ); bf16_t* Y = (bf16_t*)(F.ws + WS_YMIX); const float* CS = (const float*)(F.ws + WS_CS);
    for (int task = F.gw; task < T * 8; task += F.ngw) {
        const int t = task >> 3, hq = task & 7, hk = hq >> 2, s = t % SEQ;
        float q = bf2f(P[(size_t)t * NP + C_AQ + hq * 64 + F.lane]);
        if (!ATTN_MFMA) q = rope_lane(q, F.lane, CS + (size_t)t * 16);
        float sc0 = -INFINITY, sc1 = -INFINITY;
        for (int j = 0; j < WINDOW; ++j) {
            const int sp = s - (WINDOW - 1) + j;
            if (sp < 0) continue;
            const size_t tk = (size_t)t - (WINDOW - 1) + j;
            float k = bf2f(P[tk * NP + C_AK + hk * 64 + F.lane]);
            if (!ATTN_MFMA) k = rope_lane(k, F.lane, CS + tk * 16);
            const float sc = wave_sum(q * k) * 0.125f;
            if (F.lane == (j & 63)) { if (j < 64) sc0 = sc; else sc1 = sc; }
        }
        const float sink = a.sinks[l * 8 + hq];
        const float m = fmaxf(wave_max(fmaxf(sc0, sc1)), sink);
        const float p0 = __expf(sc0 - m), p1 = __expf(sc1 - m);
        const float den = wave_sum(p0 + p1) + __expf(sink - m);
        float o = 0.f;
        for (int j = 0; j < WINDOW; ++j) {
            const int sp = s - (WINDOW - 1) + j;
            if (sp < 0) continue;
            const size_t tk = (size_t)t - (WINDOW - 1) + j;
            const float p = __shfl(j < 64 ? p0 : p1, j & 63);
            o += p * bf2f(P[tk * NP + C_AV + hk * 64 + F.lane]);
        }
        Y[(size_t)t * D + hq * 64 + F.lane] = (bf16_t)f2bf(o / den);
    }
}

typedef float f32x16 __attribute__((ext_vector_type(16)));
typedef short s16x4 __attribute__((ext_vector_type(4)));
typedef short bf16x8_t __attribute__((ext_vector_type(8)));
__device__ __forceinline__ unsigned cvtpk(float lo, float hi) { typedef float f2_t __attribute__((ext_vector_type(2))); typedef __bf16 b2_t __attribute__((ext_vector_type(2)));
    f2_t v = {lo, hi}; b2_t b = __builtin_convertvector(v, b2_t); return __builtin_bit_cast(unsigned, b); }
__device__ __forceinline__ void ph_rope(const Args& a, Frame& F) {
    bf16_t* P = (bf16_t*)(F.ws + WS_PROJ); const float* CS = (const float*)(F.ws + WS_CS);
    for (int it = F.bid * NTHREADS + F.tid; it < T * 10; it += F.nb * NTHREADS) {
        const int t = it / 10, hh = it % 10;
        bf16_t* p = P + (size_t)t * NP + hh * 64;
        const u32x4 x1 = *(const u32x4*)p, x2 = *(const u32x4*)(p + 8);
        const f32x4 c0 = *(const f32x4*)(CS + (size_t)t * 16), c1 = *(const f32x4*)(CS + (size_t)t * 16 + 4), s0 = *(const f32x4*)(CS + (size_t)t * 16 + 8), s1 = *(const f32x4*)(CS + (size_t)t * 16 + 12);
        const float cs[8] = {c0.x, c0.y, c0.z, c0.w, c1.x, c1.y, c1.z, c1.w}, sn[8] = {s0.x, s0.y, s0.z, s0.w, s1.x, s1.y, s1.z, s1.w};
        const unsigned xa[4] = {x1.x, x1.y, x1.z, x1.w}, xb[4] = {x2.x, x2.y, x2.z, x2.w};
        unsigned ra[4], rb[4];
#pragma unroll
        for (int i = 0; i < 4; ++i) {
            const float a0 = bf2f(xa[i] & 0xffffu), a1 = bf2f(xa[i] >> 16), b0 = bf2f(xb[i] & 0xffffu), b1 = bf2f(xb[i] >> 16);
            ra[i] = pk2(a0 * cs[2 * i] - b0 * sn[2 * i], a1 * cs[2 * i + 1] - b1 * sn[2 * i + 1]);
            rb[i] = pk2(b0 * cs[2 * i] + a0 * sn[2 * i], b1 * cs[2 * i + 1] + a1 * sn[2 * i + 1]);
        }
        *(u32x4*)p = (u32x4){ra[0], ra[1], ra[2], ra[3]}; *(u32x4*)(p + 8) = (u32x4){rb[0], rb[1], rb[2], rb[3]};
    }
}
constexpr int AT_KROW = 144, AT_VOFF = 256 * AT_KROW;
__device__ __forceinline__ void ph_attn_mfma(const Args& a, Frame& F, int l) {
    const bf16_t* P = (const bf16_t*)(F.ws + WS_PROJ); bf16_t* Y = (bf16_t*)(F.ws + WS_YMIX);
    LAS unsigned char* Kl = F.lds; LAS unsigned char* Vl = F.lds + AT_VOFF;
    const int lane = F.lane, r = lane & 31, h = lane >> 5, g = F.wave >> 1, qh = F.wave & 1;
    const int i16 = lane & 15, tq_ = i16 >> 2, tp_ = i16 & 3, g16 = (lane >> 4) & 1, sw = (tq_ >> 1) & 1;
    const int vlane = (4 * h + tq_) * 128 + (2 * g16 + (tp_ >> 1)) * 16 + (tp_ & 1) * 8;
    const float C = 0.125f * 1.4426950408889634f;
    const int nsc = NSCAN;
    if (F.bid < nsc) return;
    for (int u = F.bid - nsc; u < BATCH * 128 * 2; u += F.nb - nsc) {
        const int hk = u & 1, n = (u >> 1) & 127, b = u >> 8;
        const int tq0 = b * SEQ + n * 128, tk0 = tq0 - 128;
        __syncthreads();
#pragma unroll
        for (int i = 0; i < 4; ++i) {
            const int piece = F.tid + NTHREADS * i, key = piece >> 3, c = piece & 7;
            u32x4 kv = (u32x4){0u, 0u, 0u, 0u}, vv = kv;
            if (n > 0 || key >= 128) { const bf16_t* rowp = P + (size_t)(tk0 + key) * NP; kv = *(const u32x4*)(rowp + C_AK + hk * 64 + c * 8); vv = *(const u32x4*)(rowp + C_AV + hk * 64 + c * 8); }
            *(LAS u32x4*)(Kl + key * AT_KROW + c * 16) = kv;
            *(LAS u32x4*)(Vl + key * 128 + ((c ^ (((key >> 1) & 1) << 2)) * 16)) = vv;
        }
        __syncthreads();
        const int hq = hk * 4 + g;
        const float sinkl = a.sinks[l * 8 + hq] * 1.4426950408889634f;
#pragma unroll 1
        for (int sb = 0; sb < 2; ++sb) {
            const int q0 = qh * 64 + sb * 32, kt0 = qh * 2 + sb;
            const size_t tq = (size_t)(tq0 + q0 + r);
            bf16x8_t qf[4];
#pragma unroll
            for (int ks = 0; ks < 4; ++ks) qf[ks] = *(const bf16x8_t*)(P + tq * NP + hq * 64 + 16 * ks + 8 * h);
            f32x16 S[5];
#pragma unroll
            for (int kr = 0; kr < 5; ++kr) {
                f32x16 acc;
#pragma unroll
                for (int i = 0; i < 16; ++i) acc[i] = 0.f;
#pragma unroll
                for (int ks = 0; ks < 4; ++ks) { const bf16x8_t kf = *(const LAS bf16x8_t*)(Kl + (32 * (kt0 + kr) + r) * AT_KROW + (16 * ks + 8 * h) * 2);
                    acc = __builtin_amdgcn_mfma_f32_32x32x16_bf16(kf, qf[ks], acc, 0, 0, 0); }
                S[kr] = acc;
            }
            float m = sinkl;
#pragma unroll
            for (int kr = 0; kr < 5; ++kr) {
                const bool tile_ok = !(n == 0 && (kt0 + kr) < 4);
#pragma unroll
                for (int i = 0; i < 16; ++i) {
                    const int kl = (i & 3) + 8 * (i >> 2) + 4 * h;
                    bool ok = tile_ok; if (kr == 0) ok = ok && (kl > r); if (kr == 4) ok = ok && (kl <= r);
                    const float sv = ok ? S[kr][i] * C : -INFINITY; S[kr][i] = sv; m = fmaxf(m, sv);
                }
            }
            m = fmaxf(m, __shfl_xor(m, 32));
            float lsum = 0.f;
#pragma unroll
            for (int kr = 0; kr < 5; ++kr)
#pragma unroll
                for (int i = 0; i < 16; ++i) { const float p = __builtin_amdgcn_exp2f(S[kr][i] - m); S[kr][i] = p; lsum += p; }
            lsum += __shfl_xor(lsum, 32); lsum += __builtin_amdgcn_exp2f(sinkl - m);
            f32x16 O0, O1;
#pragma unroll
            for (int i = 0; i < 16; ++i) { O0[i] = 0.f; O1[i] = 0.f; }
#pragma unroll
            for (int kr = 0; kr < 5; ++kr) {
#pragma unroll
                for (int s2 = 0; s2 < 2; ++s2) {
                    u32x4 pw; pw.x = cvtpk(S[kr][8 * s2 + 0], S[kr][8 * s2 + 1]); pw.y = cvtpk(S[kr][8 * s2 + 2], S[kr][8 * s2 + 3]); pw.z = cvtpk(S[kr][8 * s2 + 4], S[kr][8 * s2 + 5]); pw.w = cvtpk(S[kr][8 * s2 + 6], S[kr][8 * s2 + 7]);
                    const bf16x8_t pf = __builtin_bit_cast(bf16x8_t, pw);
                    const int kb = (32 * (kt0 + kr) + 16 * s2) * 128 + vlane;
                    const s16x4 lo0 = __builtin_amdgcn_ds_read_tr16_b64_v4i16((LAS s16x4*)(Vl + kb + (0 ^ sw) * 64));
                    const s16x4 hi0 = __builtin_amdgcn_ds_read_tr16_b64_v4i16((LAS s16x4*)(Vl + kb + 8 * 128 + (0 ^ sw) * 64));
                    const s16x4 lo1 = __builtin_amdgcn_ds_read_tr16_b64_v4i16((LAS s16x4*)(Vl + kb + (1 ^ sw) * 64));
                    const s16x4 hi1 = __builtin_amdgcn_ds_read_tr16_b64_v4i16((LAS s16x4*)(Vl + kb + 8 * 128 + (1 ^ sw) * 64));
                    const bf16x8_t va0 = __builtin_shufflevector(lo0, hi0, 0, 1, 2, 3, 4, 5, 6, 7), va1 = __builtin_shufflevector(lo1, hi1, 0, 1, 2, 3, 4, 5, 6, 7);
                    O0 = __builtin_amdgcn_mfma_f32_32x32x16_bf16(va0, pf, O0, 0, 0, 0);
                    O1 = __builtin_amdgcn_mfma_f32_32x32x16_bf16(va1, pf, O1, 0, 0, 0);
                }
            }
            const float inv = 1.0f / lsum;
            bf16_t* yp = Y + tq * D + hq * 64 + 4 * h;
#pragma unroll
            for (int gq = 0; gq < 4; ++gq) {
                u32x2 o0; o0.x = cvtpk(O0[4 * gq] * inv, O0[4 * gq + 1] * inv); o0.y = cvtpk(O0[4 * gq + 2] * inv, O0[4 * gq + 3] * inv);
                u32x2 o1; o1.x = cvtpk(O1[4 * gq] * inv, O1[4 * gq + 1] * inv); o1.y = cvtpk(O1[4 * gq + 2] * inv, O1[4 * gq + 3] * inv);
                *(u32x2*)(yp + 8 * gq) = o0; *(u32x2*)(yp + 32 + 8 * gq) = o1;
            }
        }
    }
    __syncthreads();
}


constexpr size_t WS_DN_MR = 360 * MiB, WS_DN_BNT = 376 * MiB, WS_DN_QP = 392 * MiB, WS_DN_OLT = 408 * MiB, WS_DN_ST = 424 * MiB;
constexpr int DL = 72, LB = 9216;
constexpr int L_KR = 0, L_KT = LB, L_QR = 2 * LB, L_VT = 3 * LB, L_AR = 4 * LB, L_T1 = 5 * LB, L_T2 = 6 * LB, L_UT = 7 * LB, L_UPT = 8 * LB, L_WPT = 9 * LB, L_WT = 0;
constexpr int L_LR = 7 * LB, L_L21 = L_LR + 17408, L_T11T = L_L21 + 4608, L_T22R = L_T11T + 4608, L_YT = L_T22R + 4608, L_GC = 100352, L_BETA = L_GC + 256;
static_assert(L_YT + 4608 == L_GC && L_GC + 512 <= 131072, "DeltaNet LDS map");
template <int KS> __device__ __forceinline__ f32x4 mm16(const LAS unsigned char* lds, int offX, int offY, int tx, int ty, int lane) {
    f32x4 acc = (f32x4){0.f, 0.f, 0.f, 0.f};
    const int l15 = lane & 15, q = lane >> 4;
#pragma unroll
    for (int ks = 0; ks < KS; ++ks) {
        const bf16x8_t xa = *(const LAS bf16x8_t*)(lds + offX + ((16 * tx + l15) * DL + 32 * ks + 8 * q) * 2);
        const bf16x8_t yb = *(const LAS bf16x8_t*)(lds + offY + ((16 * ty + l15) * DL + 32 * ks + 8 * q) * 2);
        acc = __builtin_amdgcn_mfma_f32_16x16x32_bf16(xa, yb, acc, 0, 0, 0);
    }
    return acc;
}
__device__ __forceinline__ u32x2 pack4(f32x4 v) { u32x2 o; o.x = cvtpk(v.x, v.y); o.y = cvtpk(v.z, v.w); return o; }

__device__ __forceinline__ void ph_dn_chunk(const Args& a, Frame& F, int l) {
    const bf16_t* P = (const bf16_t*)(F.ws + WS_PROJ); const float* BG = (const float*)(F.ws + WS_BG);
    bf16_t* MR = (bf16_t*)(F.ws + WS_DN_MR); bf16_t* BNT = (bf16_t*)(F.ws + WS_DN_BNT); bf16_t* QP = (bf16_t*)(F.ws + WS_DN_QP); bf16_t* OLT = (bf16_t*)(F.ws + WS_DN_OLT);
    LAS unsigned char* lds = F.lds;
    LAS float* gcL = (LAS float*)(lds + L_GC); LAS float* betaL = (LAS float*)(lds + L_BETA);
    const float* cw = a.dn_conv_w + (size_t)l * DN_CONV * 768;
    const int lane = F.lane, w = F.wave, l15 = lane & 15, q4 = lane >> 4;
    for (int unit = F.bid; unit < BATCH * 4 * 256; unit += F.nb) {
        const int n = unit & 255, h = (unit >> 8) & 3, b = unit >> 10;
        const int t0 = b * SEQ + n * 64;
        __syncthreads();
        {
            const int i = F.tid >> 3, c8 = F.tid & 7, t = t0 + i, sq = n * 64 + i;
#pragma unroll
            for (int kd = 0; kd < 3; ++kd) {
                const int cb = kd * 256 + h * 64 + c8 * 8;
                float acc[8];
#pragma unroll
                for (int e = 0; e < 8; ++e) acc[e] = 0.f;
#pragma unroll
                for (int k = 0; k < DN_CONV; ++k) {
                    if (sq - (DN_CONV - 1) + k >= 0) {
                        const u32x4 xv = *(const u32x4*)(P + (size_t)(t - (DN_CONV - 1) + k) * NP + C_DQ + cb);
                        const f32x4 w0 = *(const f32x4*)(cw + k * 768 + cb), w1 = *(const f32x4*)(cw + k * 768 + cb + 4);
                        acc[0] += w0.x * bf2f(xv.x & 0xffffu); acc[1] += w0.y * bf2f(xv.x >> 16); acc[2] += w0.z * bf2f(xv.y & 0xffffu); acc[3] += w0.w * bf2f(xv.y >> 16);
                        acc[4] += w1.x * bf2f(xv.z & 0xffffu); acc[5] += w1.y * bf2f(xv.z >> 16); acc[6] += w1.z * bf2f(xv.w & 0xffffu); acc[7] += w1.w * bf2f(xv.w >> 16);
                    }
                }
                float ss = 0.f;
#pragma unroll
                for (int e = 0; e < 8; ++e) { acc[e] = siluf_(acc[e]); ss += acc[e] * acc[e]; }
                if (kd < 2) {
                    ss += __shfl_xor(ss, 1); ss += __shfl_xor(ss, 2); ss += __shfl_xor(ss, 4);
                    const float rn = rsqrtf(ss + EPS) * (kd == 0 ? 0.125f : 1.0f);
#pragma unroll
                    for (int e = 0; e < 8; ++e) acc[e] *= rn;
                }
                u32x4 pk; pk.x = cvtpk(acc[0], acc[1]); pk.y = cvtpk(acc[2], acc[3]); pk.z = cvtpk(acc[4], acc[5]); pk.w = cvtpk(acc[6], acc[7]);
                if (kd == 0) *(LAS u32x4*)(lds + L_QR + (i * DL + c8 * 8) * 2) = pk;
                if (kd == 1) *(LAS u32x4*)(lds + L_KR + (i * DL + c8 * 8) * 2) = pk;
                if (kd >= 1) {
                    LAS bf16_t* Tt = (LAS bf16_t*)(lds + (kd == 1 ? L_KT : L_VT));
                    const unsigned pw[4] = {pk.x, pk.y, pk.z, pk.w};
#pragma unroll
                    for (int e = 0; e < 8; ++e) Tt[(c8 * 8 + e) * DL + i] = (bf16_t)((pw[e >> 1] >> (16 * (e & 1))) & 0xffffu);
                }
            }
            for (int idx = F.tid; idx < 2 * LB / 16; idx += NTHREADS) *(LAS u32x4*)(lds + L_T1 + idx * 16) = (u32x4){0u, 0u, 0u, 0u};
            if (w == 0) {
                const float be = BG[(size_t)(t0 + lane) * 8 + h]; float x = BG[(size_t)(t0 + lane) * 8 + 4 + h];
#pragma unroll
                for (int o = 1; o < 64; o <<= 1) { const float y = __shfl_up(x, o); if (lane >= o) x += y; }
                gcL[lane] = x; betaL[lane] = be;
            }
        }
        __syncthreads();
#pragma unroll
        for (int tt = 0; tt < 2; ++tt) {
            const int tidx = 2 * w + tt, tx = tidx >> 2, ty = tidx & 3, i = 16 * ty + l15, j0 = 16 * tx + 4 * q4;
            const float gi = gcL[i], bi = betaL[i]; const f32x4 gj = *(const LAS f32x4*)(gcL + j0);
            const float gjv[4] = {gj.x, gj.y, gj.z, gj.w};
            const f32x4 zk = mm16<2>(lds, L_KR, L_KR, tx, ty, lane);
            const f32x4 zq = mm16<2>(lds, L_KR, L_QR, tx, ty, lane);
            f32x4 lv, av;
#pragma unroll
            for (int r = 0; r < 4; ++r) { const float dc = __expf(fminf(gi - gjv[r], 0.f)); lv[r] = (j0 + r < i) ? bi * zk[r] * dc : 0.f; av[r] = (j0 + r <= i) ? zq[r] * dc : 0.f; }
            *(LAS f32x4*)(lds + L_LR + (i * 68 + j0) * 4) = lv;
            if (i >= 32 && j0 < 32) *(LAS u32x2*)(lds + L_L21 + ((i - 32) * DL + j0) * 2) = pack4(lv);
            *(LAS u32x2*)(lds + L_AR + (i * DL + j0) * 2) = pack4(av);
        }
        __syncthreads();
        if (w == 0) {
            const int blk = lane >> 5, jp = lane & 31;
            const LAS float* Lb = (const LAS float*)(lds + L_LR) + (32 * blk) * 68 + 32 * blk;
            float x[32];
#pragma unroll
            for (int i = 0; i < 32; ++i) {
                float sacc = (i == jp) ? 1.f : 0.f;
#pragma unroll
                for (int m0 = 0; m0 < i; m0 += 4) {
                    const f32x4 l4 = *(const LAS f32x4*)(Lb + i * 68 + m0);
                    sacc -= l4.x * x[m0];
                    if (m0 + 1 < i) sacc -= l4.y * x[m0 + 1];
                    if (m0 + 2 < i) sacc -= l4.z * x[m0 + 2];
                    if (m0 + 3 < i) sacc -= l4.w * x[m0 + 3];
                }
                x[i] = sacc;
            }
            const int jg = 32 * blk + jp; const float bj = betaL[jg], bej = bj * __expf(gcL[jg]);
            LAS bf16_t* T1 = (LAS bf16_t*)(lds + L_T1); LAS bf16_t* T2 = (LAS bf16_t*)(lds + L_T2);
#pragma unroll
            for (int i = 0; i < 32; ++i) { T1[(32 * blk + i) * DL + jg] = (bf16_t)f2bf(x[i] * bj); T2[(32 * blk + i) * DL + jg] = (bf16_t)f2bf(x[i] * bej); }
            if (blk == 0) {
#pragma unroll
                for (int c = 0; c < 4; ++c) { u32x4 pk; pk.x = cvtpk(x[8 * c], x[8 * c + 1]); pk.y = cvtpk(x[8 * c + 2], x[8 * c + 3]); pk.z = cvtpk(x[8 * c + 4], x[8 * c + 5]); pk.w = cvtpk(x[8 * c + 6], x[8 * c + 7]);
                    *(LAS u32x4*)(lds + L_T11T + (jp * DL + 8 * c) * 2) = pk; }
            } else {
                LAS bf16_t* T22 = (LAS bf16_t*)(lds + L_T22R);
#pragma unroll
                for (int i = 0; i < 32; ++i) T22[i * DL + jp] = (bf16_t)f2bf(x[i]);
            }
        }
        __syncthreads();
        if (w < 4) {
            const int tx = w >> 1, ty = w & 1;
            const f32x4 z = mm16<1>(lds, L_L21, L_T11T, tx, ty, lane);
            *(LAS u32x2*)(lds + L_YT + ((16 * ty + l15) * DL + 16 * tx + 4 * q4) * 2) = pack4(z);
        }
        __syncthreads();
        if (w < 4) {
            const int tx = w >> 1, ty = w & 1, y = 16 * ty + l15, x0 = 16 * tx + 4 * q4;
            const f32x4 z = mm16<1>(lds, L_T22R, L_YT, tx, ty, lane);
            const float bj = betaL[y], bej = bj * __expf(gcL[y]);
            LAS bf16_t* T1 = (LAS bf16_t*)(lds + L_T1); LAS bf16_t* T2 = (LAS bf16_t*)(lds + L_T2);
#pragma unroll
            for (int r = 0; r < 4; ++r) { T1[(32 + x0 + r) * DL + y] = (bf16_t)f2bf(-z[r] * bj); T2[(32 + x0 + r) * DL + y] = (bf16_t)f2bf(-z[r] * bej); }
        }
        __syncthreads();
        const float gl = gcL[63];
#pragma unroll
        for (int tt = 0; tt < 2; ++tt) {
            const int tidx = 2 * w + tt, tx = tidx >> 2, ty = tidx & 3, y = 16 * ty + l15, x0 = 16 * tx + 4 * q4;
            const f32x4 gx = *(const LAS f32x4*)(gcL + x0);
            f32x4 sc; sc.x = __expf(gl - gx.x); sc.y = __expf(gl - gx.y); sc.z = __expf(gl - gx.z); sc.w = __expf(gl - gx.w);
            const f32x4 zu = mm16<2>(lds, L_T1, L_VT, tx, ty, lane);
            const f32x4 zw = mm16<2>(lds, L_T2, L_KT, tx, ty, lane);
            *(LAS u32x2*)(lds + L_UT + (y * DL + x0) * 2) = pack4(zu); *(LAS u32x2*)(lds + L_UPT + (y * DL + x0) * 2) = pack4(zu * sc);
            *(LAS u32x2*)(lds + L_WT + (y * DL + x0) * 2) = pack4(zw); *(LAS u32x2*)(lds + L_WPT + (y * DL + x0) * 2) = pack4(zw * sc);
        }
        __syncthreads();
        {
            const size_t cho = (size_t)unit * 4096;
            const float egl = __expf(gl);
#pragma unroll
            for (int tt = 0; tt < 2; ++tt) {
                const int tidx = 2 * w + tt, tx = tidx >> 2, ty = tidx & 3, y = 16 * ty + l15, x0 = 16 * tx + 4 * q4;
                f32x4 zm = mm16<2>(lds, L_WPT, L_KT, tx, ty, lane);
#pragma unroll
                for (int r = 0; r < 4; ++r) zm[r] = ((x0 + r) == y ? egl : 0.f) - zm[r];
                *(u32x2*)(MR + cho + (ty * 2 + (tx >> 1)) * 512 + lane * 8 + 4 * (tx & 1)) = pack4(zm);
                const f32x4 zb = mm16<2>(lds, L_KT, L_UPT, tx, ty, lane);
                *(u32x2*)(BNT + cho + (ty * 4 + tx) * 256 + lane * 4) = pack4(zb);
                const f32x4 zq = mm16<2>(lds, L_WT, L_AR, tx, ty, lane);
                const u32x2 qv = *(const LAS u32x2*)(lds + L_QR + (y * DL + x0) * 2); const float eg = __expf(gcL[y]);
                f32x4 qp; qp.x = bf2f(qv.x & 0xffffu) * eg - zq.x; qp.y = bf2f(qv.x >> 16) * eg - zq.y; qp.z = bf2f(qv.y & 0xffffu) * eg - zq.z; qp.w = bf2f(qv.y >> 16) * eg - zq.w;
                *(u32x2*)(QP + cho + y * 64 + x0) = pack4(qp);
                const f32x4 zo = mm16<2>(lds, L_AR, L_UT, tx, ty, lane);
                *(u32x2*)(OLT + cho + y * 64 + x0) = pack4(zo);
            }
        }
    }
    __syncthreads();
}
constexpr int SC_SLOT = 10240, SC_DEPTH = 12, SC_AHEAD = 11;
__device__ __forceinline__ void ph_dn_scan(const Args& a, Frame& F) {
    if (F.bid >= NSCAN) return;
    const unsigned char* MRb = (const unsigned char*)(F.ws + WS_DN_MR); const unsigned char* BNb = (const unsigned char*)(F.ws + WS_DN_BNT); bf16_t* ST = (bf16_t*)(F.ws + WS_DN_ST);
    const int lane = F.lane, l15 = lane & 15, q4 = lane >> 4, wq = F.bid & 3;
    const size_t ch0 = (size_t)(F.bid >> 2) * 256;
    LAS unsigned char* lds = F.lds;
    __syncthreads();
    if (F.wave >= 3) {
        const int lw = F.wave - 3;
#define DN_ISSUE(nn) do { const size_t chb_ = (ch0 + (size_t)((nn) < 255 ? (nn) : 255)) * 8192; const int slot_ = ((nn) % SC_DEPTH) * SC_SLOT; \
        _Pragma("unroll") for (int p_ = 0; p_ < 2; ++p_) { const int piece_ = lw * 2 + p_; \
            const unsigned char* src_ = (piece_ < 8 ? MRb + chb_ + piece_ * 1024 : BNb + chb_ + wq * 2048 + (piece_ - 8) * 1024) + lane * 16; \
            __builtin_amdgcn_global_load_lds((const unsigned*)src_, (LAS unsigned*)(lds + slot_ + piece_ * 1024), 16, 0, 0); } } while (0)
        for (int n = 0; n < SC_AHEAD; ++n) DN_ISSUE(n);
        for (int n = 0; n < 256; ++n) {
            asm volatile("s_waitcnt vmcnt(20)" ::: "memory");
            __builtin_amdgcn_s_barrier();
            DN_ISSUE(n + SC_AHEAD);
        }
        asm volatile("s_waitcnt vmcnt(0)" ::: "memory");
#undef DN_ISSUE
    } else if (F.wave == 0) {
        const int dv = 16 * wq + l15;
        f32x4 S[4];
#pragma unroll
        for (int ti = 0; ti < 4; ++ti) S[ti] = (f32x4){0.f, 0.f, 0.f, 0.f};
        for (int n = 0; n < 256; ++n) {
            __builtin_amdgcn_s_barrier();
            const LAS unsigned char* slot = lds + (n % SC_DEPTH) * SC_SLOT;
            bf16x8_t A[4][2]; u32x2 Bc[4];
#pragma unroll
            for (int ti = 0; ti < 4; ++ti) {
#pragma unroll
                for (int ks = 0; ks < 2; ++ks) A[ti][ks] = *(const LAS bf16x8_t*)(slot + (ti * 2 + ks) * 1024 + lane * 16);
                Bc[ti] = *(const LAS u32x2*)(slot + 8192 + ti * 512 + lane * 8);
            }
            u32x2 sp[4];
#pragma unroll
            for (int ti = 0; ti < 4; ++ti) { sp[ti] = pack4(S[ti]); *(u32x2*)(ST + (ch0 + n) * 4096 + dv * 64 + 16 * ti + 4 * q4) = sp[ti]; }
            const bf16x8_t b0 = __builtin_bit_cast(bf16x8_t, (u32x4){sp[0].x, sp[0].y, sp[1].x, sp[1].y});
            const bf16x8_t b1 = __builtin_bit_cast(bf16x8_t, (u32x4){sp[2].x, sp[2].y, sp[3].x, sp[3].y});
#pragma unroll
            for (int ti = 0; ti < 4; ++ti) {
                f32x4 c; c.x = bf2f(Bc[ti].x & 0xffffu); c.y = bf2f(Bc[ti].x >> 16); c.z = bf2f(Bc[ti].y & 0xffffu); c.w = bf2f(Bc[ti].y >> 16);
                c = __builtin_amdgcn_mfma_f32_16x16x32_bf16(A[ti][0], b0, c, 0, 0, 0);
                c = __builtin_amdgcn_mfma_f32_16x16x32_bf16(A[ti][1], b1, c, 0, 0, 0);
                S[ti] = c;
            }
            asm volatile("s_waitcnt lgkmcnt(0)" ::: "memory");
        }
    } else {
        for (int n = 0; n < 256; ++n) __builtin_amdgcn_s_barrier();
    }
    __syncthreads();
}
__device__ __forceinline__ void ph_dn_out(const Args& a, Frame& F, int l) {
    const bf16_t* QP = (const bf16_t*)(F.ws + WS_DN_QP); const bf16_t* OLT = (const bf16_t*)(F.ws + WS_DN_OLT); const bf16_t* ST = (const bf16_t*)(F.ws + WS_DN_ST);
    const bf16_t* P = (const bf16_t*)(F.ws + WS_PROJ); bf16_t* Y = (bf16_t*)(F.ws + WS_YMIX);
    const int lane = F.lane, l15 = lane & 15, q4 = lane >> 4, ti = F.wave & 3;
    for (int pr = F.bid; pr < 1024; pr += F.nb) {
        const int unit = 2 * pr + (F.wave >> 2), n = unit & 255, h = (unit >> 8) & 3, b = unit >> 10;
        const size_t cho = (size_t)unit * 4096;
        bf16x8_t af[2];
#pragma unroll
        for (int ks = 0; ks < 2; ++ks) af[ks] = *(const bf16x8_t*)(QP + cho + (16 * ti + l15) * 64 + 32 * ks + 8 * q4);
        f32x4 acc[4];
#pragma unroll
        for (int tj = 0; tj < 4; ++tj) {
            const u32x2 ov = *(const u32x2*)(OLT + cho + (16 * tj + l15) * 64 + 16 * ti + 4 * q4);
            f32x4 c; c.x = bf2f(ov.x & 0xffffu); c.y = bf2f(ov.x >> 16); c.z = bf2f(ov.y & 0xffffu); c.w = bf2f(ov.y >> 16);
#pragma unroll
            for (int ks = 0; ks < 2; ++ks) { const bf16x8_t bfv = *(const bf16x8_t*)(ST + cho + (16 * tj + l15) * 64 + 32 * ks + 8 * q4); c = __builtin_amdgcn_mfma_f32_16x16x32_bf16(af[ks], bfv, c, 0, 0, 0); }
            acc[tj] = c;
        }
        f32x4 ss = acc[0] * acc[0] + acc[1] * acc[1] + acc[2] * acc[2] + acc[3] * acc[3];
#pragma unroll
        for (int o = 1; o < 16; o <<= 1) { ss.x += __shfl_xor(ss.x, o); ss.y += __shfl_xor(ss.y, o); ss.z += __shfl_xor(ss.z, o); ss.w += __shfl_xor(ss.w, o); }
        const float rs[4] = {rsqrtf(ss.x * (1.f / 64.f) + EPS), rsqrtf(ss.y * (1.f / 64.f) + EPS), rsqrtf(ss.z * (1.f / 64.f) + EPS), rsqrtf(ss.w * (1.f / 64.f) + EPS)};
        const size_t trow0 = (size_t)b * SEQ + n * 64 + 16 * ti + 4 * q4;
#pragma unroll
        for (int tj = 0; tj < 4; ++tj) {
            const int dvv = 16 * tj + l15; const float gn = a.dn_norm_g[l * 64 + dvv];
#pragma unroll
            for (int r = 0; r < 4; ++r) {
                const size_t t = trow0 + r;
                const float z = bf2f(P[t * NP + C_DZ + h * 64 + dvv]);
                Y[t * D + 512 + h * 64 + dvv] = (bf16_t)f2bf(acc[tj][r] * rs[r] * gn * siluf_(z));
            }
        }
    }
}

__device__ __forceinline__ void ph_conv_naive(const Args& a, Frame& F, int l) {
    const bf16_t* P = (const bf16_t*)(F.ws + WS_PROJ); bf16_t* Y = (bf16_t*)(F.ws + WS_YMIX);
    const float* w = a.cv_dw_w + (size_t)l * CV_K * CV_C;
    for (int t = F.gw; t < T; t += F.ngw) {
        const int s = t % SEQ, c0 = 4 * F.lane;
        f32x4 acc = *(const f32x4*)(a.cv_dw_b + l * CV_C + c0);
        for (int k = 0; k < CV_K; ++k) {
            const int sp = s - (CV_K - 1) + k;
            if (sp < 0) continue;
            const size_t tk = (size_t)t - (CV_K - 1) + k;
            const u32x2 ca = *(const u32x2*)(P + tk * NP + C_CA + c0), cb = *(const u32x2*)(P + tk * NP + C_CB + c0);
            const f32x4 w4 = *(const f32x4*)(w + k * CV_C + c0);
            acc.x += w4.x * (bf2f(ca.x & 0xffffu) * sigmoidf_(bf2f(cb.x & 0xffffu)));
            acc.y += w4.y * (bf2f(ca.x >> 16) * sigmoidf_(bf2f(cb.x >> 16)));
            acc.z += w4.z * (bf2f(ca.y & 0xffffu) * sigmoidf_(bf2f(cb.y & 0xffffu)));
            acc.w += w4.w * (bf2f(ca.y >> 16) * sigmoidf_(bf2f(cb.y >> 16)));
        }
        const float mean = wave_sum((acc.x + acc.y) + (acc.z + acc.w)) * (1.0f / CV_C);
        const f32x4 dv = acc - mean;
        const float var = wave_sum((dv.x * dv.x + dv.y * dv.y) + (dv.z * dv.z + dv.w * dv.w)) * (1.0f / CV_C);
        const float rstd = rsqrtf(var + EPS);
        const f32x4 g4 = *(const f32x4*)(a.cv_ln_g + l * CV_C + c0), b4 = *(const f32x4*)(a.cv_ln_b + l * CV_C + c0);
        const f32x4 y = (dv * rstd) * g4 + b4;
        u32x2 o; o.x = pk2(siluf_(y.x), siluf_(y.y)); o.y = pk2(siluf_(y.z), siluf_(y.w));
        *(u32x2*)(Y + (size_t)t * D + 768 + c0) = o;
    }
}

__device__ __forceinline__ void ph_conv_fast(const Args& a, Frame& F, int l) {
    const bf16_t* P = (const bf16_t*)(F.ws + WS_PROJ); bf16_t* Y = (bf16_t*)(F.ws + WS_YMIX);
    LAS float* OUTL = (LAS float*)F.lds;
    const int c = F.tid & 255, rsel = F.tid >> 8;
    float wk[CV_K];
#pragma unroll
    for (int k = 0; k < CV_K; ++k) wk[k] = a.cv_dw_w[((size_t)l * CV_K + k) * CV_C + c];
    const float bias = a.cv_dw_b[l * CV_C + c];
    const int nsc = NSCAN;
    if (F.bid < nsc) return;
    for (int pr = (F.bid - nsc + (F.nb - nsc) / 2) % (F.nb - nsc); pr < T / 128; pr += F.nb - nsc) {
        const int run = 2 * pr + rsel, t0 = run * 64, s0 = t0 % SEQ;
        __syncthreads();
        float win[CV_K];
#pragma unroll
        for (int k = 0; k < CV_K; ++k) win[k] = 0.f;
        for (int cbase = 0; cbase < 94; cbase += CV_K) {
#pragma unroll
            for (int p = 0; p < CV_K; ++p) {
                const int ti = cbase + p;
                if (ti < 94) {
                    float u = 0.f;
                    if (s0 - 30 + ti >= 0) { const size_t tk = (size_t)(t0 - 30 + ti); const float ca = bf2f(P[tk * NP + C_CA + c]), cb = bf2f(P[tk * NP + C_CB + c]); u = ca * sigmoidf_(cb); }
                    win[p] = u;
                    if (ti >= 30) {
                        float acc = bias;
#pragma unroll
                        for (int k = 0; k < CV_K; ++k) acc += wk[k] * win[(p + 1 + k) % CV_K];
                        OUTL[(rsel * 64 + (ti - 30)) * 256 + c] = acc;
                    }
                }
            }
        }
        __syncthreads();
        const f32x4 g4 = *(const f32x4*)(a.cv_ln_g + l * CV_C + 4 * F.lane), b4 = *(const f32x4*)(a.cv_ln_b + l * CV_C + 4 * F.lane);
        for (int j = 0; j < 16; ++j) {
            const int tl = F.wave * 16 + j;
            const f32x4 v = *(const LAS f32x4*)(OUTL + tl * 256 + 4 * F.lane);
            const float mean = wave_sum((v.x + v.y) + (v.z + v.w)) * (1.0f / CV_C);
            const f32x4 dv = v - mean;
            const float var = wave_sum((dv.x * dv.x + dv.y * dv.y) + (dv.z * dv.z + dv.w * dv.w)) * (1.0f / CV_C);
            const float rstd = rsqrtf(var + EPS);
            const f32x4 y = (dv * rstd) * g4 + b4;
            u32x2 o; o.x = cvtpk(siluf_(y.x), siluf_(y.y)); o.y = cvtpk(siluf_(y.z), siluf_(y.w));
            *(u32x2*)(Y + (size_t)(pr * 128 + tl) * D + 768 + 4 * F.lane) = o;
        }
    }
    __syncthreads();
}

__device__ __forceinline__ void moe_bases(Frame& F, int (&base)[9], int (&cnt)[8]) {
    const unsigned* c = (const unsigned*)(F.ws + WS_CTL) + CW_MOECNT;
    int acc = 0;
#pragma unroll
    for (int e = 0; e < 8; ++e) { cnt[e] = (int)__hip_atomic_load(c + 64 * e, __ATOMIC_RELAXED, __HIP_MEMORY_SCOPE_AGENT); base[e] = acc; acc += (cnt[e] + 255) & ~255; }
    base[8] = acc;
}
__device__ __forceinline__ void moe_range(Frame& F, int e, int& lo, int& hi) {
    const unsigned* c = (const unsigned*)(F.ws + WS_CTL) + CW_MOECNT;
    int acc = 0; lo = 0; hi = 0;
#pragma unroll
    for (int k = 0; k < 8; ++k) { const int n = ((int)__hip_atomic_load(c + 64 * k, __ATOMIC_RELAXED, __HIP_MEMORY_SCOPE_AGENT) + 255) & ~255; if (k == e) { lo = acc; hi = acc + n; } acc += n; }
}
__device__ __forceinline__ void ph_moe_list(const Args& a, Frame& F) {
    int base[9], cnt[8]; moe_bases(F, base, cnt);
    int* RM = (int*)(F.ws + WS_RMAP); const int* R = (const int*)(F.ws + WS_ROUTE); const int* Pq = (const int*)(F.ws + WS_POS);
    for (int t = F.bid * NTHREADS + F.tid; t < T; t += F.nb * NTHREADS) {
        const int e0 = R[t * 4], e1 = R[t * 4 + 1];
        int b0 = 0, b1 = 0;
#pragma unroll
        for (int e = 0; e < 8; ++e) { if (e == e0) b0 = base[e]; if (e == e1) b1 = base[e]; }
        RM[b0 + Pq[t * 2]] = t; RM[b1 + Pq[t * 2 + 1]] = t;
    }
    if (F.bid == 0) {
#pragma unroll
        for (int e = 0; e < 8; ++e) { const int lo = base[e] + cnt[e], hi = base[e + 1]; for (int r = lo + F.tid; r < hi; r += NTHREADS) RM[r] = 0; }
    }
}
__device__ __forceinline__ void ph_final(const Args& a, Frame& F) {
    int base[9], cnt[8]; moe_bases(F, base, cnt);
    const float* MOD = (const float*)(F.ws + WS_MOD);
    const bf16_t* YM = (const bf16_t*)(F.ws + WS_YMOE); const int* R = (const int*)(F.ws + WS_ROUTE); const int* Pq = (const int*)(F.ws + WS_POS);
    for (int row = F.gw; row < T; row += F.ngw) {
        const int b = row / SEQ;
        const int e0 = R[row * 4], e1 = R[row * 4 + 1]; const float p0 = ((const float*)R)[row * 4 + 2], p1 = ((const float*)R)[row * 4 + 3];
        int b0 = 0, b1 = 0;
#pragma unroll
        for (int e = 0; e < 8; ++e) { if (e == e0) b0 = base[e]; if (e == e1) b1 = base[e]; }
        const size_t s0 = (size_t)(b0 + Pq[row * 2]), s1 = (size_t)(b1 + Pq[row * 2 + 1]);
        const float* gt2 = MOD + ((size_t)(1 * 2 + 1) * 2 + b) * 3072 + 2048;
        f32x4* xr = (f32x4*)(a.out + (size_t)row * D) + F.lane;
        f32x4 v[4]; float ss = 0.f;
#pragma unroll
        for (int j = 0; j < 4; ++j) {
            const int d = 256 * j + 4 * F.lane;
            const u32x2 y0 = *(const u32x2*)(YM + s0 * D + d), y1 = *(const u32x2*)(YM + s1 * D + d);
            const f32x4 g4 = *(const f32x4*)(gt2 + d);
            f32x4 f; f.x = p0 * bf2f(y0.x & 0xffffu) + p1 * bf2f(y1.x & 0xffffu); f.y = p0 * bf2f(y0.x >> 16) + p1 * bf2f(y1.x >> 16);
            f.z = p0 * bf2f(y0.y & 0xffffu) + p1 * bf2f(y1.y & 0xffffu); f.w = p0 * bf2f(y0.y >> 16) + p1 * bf2f(y1.y >> 16);
            v[j] = xr[64 * j] + g4 * f;
            ss += (v[j].x * v[j].x + v[j].y * v[j].y) + (v[j].z * v[j].z + v[j].w * v[j].w);
        }
        const float rstd = rsqrtf(wave_sum(ss) * (1.0f / D) + EPS);
#pragma unroll
        for (int j = 0; j < 4; ++j) { const f32x4 g4 = *(const f32x4*)(a.final_g + 256 * j + 4 * F.lane); xr[64 * j] = (v[j] * rstd) * g4; }
    }
}


namespace pg8 {
typedef short bf16x8 __attribute__((ext_vector_type(8)));
constexpr int BM = 256, BK = 64, HALF = 128, HTB = HALF * BK * 2, STAGE_BYTES = 8 * HTB;
__device__ __forceinline__ int lds_byte(int r, int c) { const int st = (r >> 4) * 2 + (c >> 5), rr = r & 15, cc = c & 31, ob = rr * 64 + cc * 2; return st * 1024 + (ob ^ (((ob >> 9) & 1) << 5)); }
__device__ __forceinline__ void stage_rc(int b, int& R, int& C) { const int st = b / 1024, sb = b % 1024, swz = sb ^ (((sb >> 9) & 1) << 5); R = (st >> 1) * 16 + swz / 64; C = (st & 1) * 32 + (swz % 64) / 2; }
__device__ __forceinline__ int perm32(int rho) { const int n = rho >> 4, i = rho & 15; return 8 * (i >> 2) + 4 * n + (i & 3); }
struct Unit { int pm, pn; };
struct Gemm { const bf16_t* A; const bf16_t* Bt; int K; };
constexpr int NXCD = 8, WGM = 8;
struct StaticOrder {
    int nM, nN, nwg, G, c;
    __device__ void init(int M, int N, int G_, int c_) { nM = M / BM; nN = N / BM; nwg = nM * nN; G = G_; c = c_; }
    __device__ __forceinline__ bool next(int i, Unit& u) const {
        const long L = (long)i * G + c; if (L >= nwg) return false;
        int wgid = (int)L; { const int q = nwg / NXCD, r = nwg % NXCD, xcd = wgid % NXCD, off = wgid / NXCD; wgid = (xcd < r ? xcd * (q + 1) : r * (q + 1) + (xcd - r) * q) + off; }
        const int nig = WGM * nN, gid = wgid / nig, fm = gid * WGM, gsz = (nM - fm) < WGM ? (nM - fm) : WGM;
        u.pm = fm + ((wgid % nig) % gsz); u.pn = (wgid % nig) / gsz; return true;
    }
};
template <int NT> struct MoeOrder {
    int bt[9]; int G, c;
    __device__ __forceinline__ bool next(int i, Unit& u) const {
        const int L = i * G + c; if (L >= bt[8] * NT) return false;
        const int q = L / NT, tn = L % NT; int e = 0;
#pragma unroll
        for (int k = 1; k < 8; ++k) e += (q >= bt[k]) ? 1 : 0;
        u.pm = q; u.pn = e * NT + tn; return true;
    }
};
__device__ __forceinline__ unsigned cvt_pk_bf16(float lo, float hi) { unsigned r; asm volatile("v_cvt_pk_bf16_f32 %0, %1, %2" : "=v"(r) : "v"(lo), "v"(hi)); return r; }
__device__ __forceinline__ float fast_silu(float x) { return x * __builtin_amdgcn_rcpf(1.0f + __builtin_amdgcn_exp2f(x * -1.4426950408889634f)); }

struct EpiBf16 {
    static constexpr bool PERM = true;
    bf16_t* O; int ldc; int nmod;
    __device__ __forceinline__ void operator()(const f32x4 (&acc)[2][2][4][2], const Unit& u, int wr, int wc, int fr, int fq) const {
        const int row0 = u.pm * BM + wr * 64 + fr, col0 = (u.pn % nmod) * BM + wc * 32 + 8 * fq;
#pragma unroll
        for (int ai = 0; ai < 2; ++ai)
#pragma unroll
            for (int m = 0; m < 4; ++m) { bf16_t* rowp = O + (size_t)(row0 + ai * HALF + m * 16) * ldc + col0;
#pragma unroll
                for (int bj = 0; bj < 2; ++bj) { const f32x4 v0 = acc[ai][bj][m][0], v1 = acc[ai][bj][m][1];
                    u32x4 w; w.x = cvt_pk_bf16(v0[0], v0[1]); w.y = cvt_pk_bf16(v0[2], v0[3]); w.z = cvt_pk_bf16(v1[0], v1[1]); w.w = cvt_pk_bf16(v1[2], v1[3]);
                    *(u32x4*)(rowp + bj * HALF) = w; } }
    }
};
struct EpiSwiGLU {
    static constexpr bool PERM = true;
    bf16_t* O; int ldc; int nmod;
    __device__ __forceinline__ void operator()(const f32x4 (&acc)[2][2][4][2], const Unit& u, int wr, int wc, int fr, int fq) const {
        const int row0 = u.pm * BM + wr * 64 + fr, col0 = (u.pn % nmod) * HALF + wc * 32 + 8 * fq;
#pragma unroll
        for (int ai = 0; ai < 2; ++ai)
#pragma unroll
            for (int m = 0; m < 4; ++m) {
                const f32x4 g0 = acc[ai][0][m][0], g1 = acc[ai][0][m][1], u0 = acc[ai][1][m][0], u1 = acc[ai][1][m][1];
                u32x4 w;
                w.x = cvt_pk_bf16(fast_silu(g0[0]) * u0[0], fast_silu(g0[1]) * u0[1]); w.y = cvt_pk_bf16(fast_silu(g0[2]) * u0[2], fast_silu(g0[3]) * u0[3]);
                w.z = cvt_pk_bf16(fast_silu(g1[0]) * u1[0], fast_silu(g1[1]) * u1[1]); w.w = cvt_pk_bf16(fast_silu(g1[2]) * u1[2], fast_silu(g1[3]) * u1[3]);
                *(u32x4*)(O + (size_t)(row0 + ai * HALF + m * 16) * ldc + col0) = w; }
    }
};
struct EpiResidF32 {
    static constexpr bool PERM = false;
    const float* xin; float* xout; const float* gate;
    __device__ __forceinline__ void operator()(const f32x4 (&acc)[2][2][4][2], const Unit& u, int wr, int wc, int fr, int fq) const {
        const int row0 = u.pm * BM + wr * 64 + fr, col0 = u.pn * BM + wc * 32 + 4 * fq;
        const float* gp = gate + (size_t)((u.pm * BM) / SEQ) * 3072 + col0;
#pragma unroll
        for (int bj = 0; bj < 2; ++bj)
#pragma unroll
            for (int n = 0; n < 2; ++n) { const f32x4 g4 = *(const f32x4*)(gp + bj * HALF + n * 16);
#pragma unroll
                for (int ai = 0; ai < 2; ++ai)
#pragma unroll
                    for (int m = 0; m < 4; ++m) { const size_t off = (size_t)(row0 + ai * HALF + m * 16) * D + col0 + bj * HALF + n * 16;
                        const f32x4 x4 = *(const f32x4*)(xin + off); *(f32x4*)(xout + off) = x4 + g4 * acc[ai][bj][m][n]; } }
    }
};

template <class Epi, class Sched, bool GATHER, bool ALIGN_EPI, bool SP2>
__device__ __forceinline__ void gemm_phase(LAS unsigned char* lds, const LAS int* RI, const Gemm g, const Sched& S, const Epi& E) {
    const int tid = threadIdx.x, wid = __builtin_amdgcn_readfirstlane(tid >> 6), lane = tid & 63, wr = wid >> 2, wc = wid & 3, fr = lane & 15, fq = lane >> 4;
    const int K = g.K, nt = K / BK;
    unsigned voffB[2]; int Ra[2]; unsigned Ca2[2];
#pragma unroll
    for (int i = 0; i < 2; ++i) { int R, C; stage_rc(tid * 16 + i * 8192, R, C); const int Rb = Epi::PERM ? ((R & ~31) + perm32(R & 31)) : R;
        Ra[i] = R; Ca2[i] = (unsigned)C * 2u; voffB[i] = (unsigned)(Rb * K + C) * 2u; }
    const size_t kstep = (size_t)(BK * 2);
    const size_t hstep = (size_t)HALF * K * 2;
    const size_t tstep = 2 * hstep;
    const unsigned rowb = (unsigned)K * 2u;
    const unsigned ldsw = (unsigned)wid * 1024u;
    const int aoff = lds_byte(wr * 64 + fr, fq * 8), boff = lds_byte(wc * 32 + fr, fq * 8);
#define PG8_SA(b, h) (((b) * 2 + (h)) * HTB)
#define PG8_SB(b, h) ((4 + (b) * 2 + (h)) * HTB)
#define PG8_STAGE_B(bufoff, gbase) do { _Pragma("unroll") for (int _i = 0; _i < 2; ++_i) \
        __builtin_amdgcn_global_load_lds((const unsigned*)((const char*)(gbase) + voffB[_i]), (LAS unsigned*)(lds + (bufoff) + ldsw + _i * 8192), 16, 0, 0); } while (0)
#define PG8_STAGE_A(bufoff, kb, off) do { _Pragma("unroll") for (int _i = 0; _i < 2; ++_i) \
        __builtin_amdgcn_global_load_lds((const unsigned*)((const char*)g.A + (size_t)(kb) + (off)[_i]), (LAS unsigned*)(lds + (bufoff) + ldsw + _i * 8192), 16, 0, 0); } while (0)
#define PG8_LDA(dst, b, h) do { _Pragma("unroll") for (int m = 0; m < 4; ++m) _Pragma("unroll") for (int k = 0; k < 2; ++k) dst[m][k] = *(const LAS bf16x8*)(lds + PG8_SA(b, h) + aoff + m * 2048 + k * 1024); } while (0)
#define PG8_LDB(dst, b, h) do { _Pragma("unroll") for (int n = 0; n < 2; ++n) _Pragma("unroll") for (int k = 0; k < 2; ++k) dst[n][k] = *(const LAS bf16x8*)(lds + PG8_SB(b, h) + boff + n * 2048 + k * 1024); } while (0)
#define PG8_MMA(ai, bj, At, Bt) do { __builtin_amdgcn_s_setprio(1); _Pragma("unroll") for (int m = 0; m < 4; ++m) _Pragma("unroll") for (int n = 0; n < 2; ++n) _Pragma("unroll") for (int k = 0; k < 2; ++k) \
        acc[ai][bj][m][n] = __builtin_amdgcn_mfma_f32_16x16x32_bf16(Bt[n][k], At[m][k], acc[ai][bj][m][n], 0, 0, 0); __builtin_amdgcn_s_setprio(0); } while (0)
#define PG8_WAIT_V(n) asm volatile("s_waitcnt vmcnt(" #n ")" ::: "memory")
#define PG8_WAIT_L(n) asm volatile("s_waitcnt lgkmcnt(" #n ")" ::: "memory")
#define PG8_BAR __builtin_amdgcn_s_barrier()
#define PG8_SCHED __builtin_amdgcn_sched_barrier(0)
#define PG8_AOFFS(dst, ui_, un_) do { _Pragma("unroll") for (int _h = 0; _h < 2; ++_h) _Pragma("unroll") for (int _i = 0; _i < 2; ++_i) { \
        const unsigned _row = GATHER ? (unsigned)RI[(ui_) * 256 + _h * HALF + Ra[_i]] : (unsigned)((un_).pm * BM + _h * HALF + Ra[_i]); dst[_h][_i] = _row * rowb + Ca2[_i]; } } while (0)
    Unit cur, nxt; int ui = 0;
    if (!S.next(0, cur)) return;
    f32x4 acc[2][2][4][2];
#pragma unroll
    for (int a = 0; a < 2; ++a)
#pragma unroll
        for (int b = 0; b < 2; ++b)
#pragma unroll
            for (int m = 0; m < 4; ++m)
#pragma unroll
                for (int n = 0; n < 2; ++n) acc[a][b][m][n] = (f32x4){0.f, 0.f, 0.f, 0.f};
    bf16x8 At[4][2], B0[2][2], B1[2][2];
    unsigned cv[2][2], nv[2][2];
    PG8_AOFFS(cv, 0, cur);
    const char* cB = (const char*)g.Bt + (size_t)cur.pn * tstep;
    if constexpr (SP2) {
        PG8_STAGE_B(PG8_SB(0, 0), cB); PG8_STAGE_B(PG8_SB(0, 1), cB + hstep); PG8_STAGE_A(PG8_SA(0, 0), 0, cv[0]); PG8_STAGE_A(PG8_SA(0, 1), 0, cv[1]);
        if (wr == 1) PG8_BAR;
        PG8_WAIT_V(2); PG8_BAR;
        PG8_STAGE_B(PG8_SB(1, 0), cB + kstep); PG8_STAGE_A(PG8_SA(1, 0), kstep, cv[0]); PG8_STAGE_B(PG8_SB(1, 1), cB + hstep + kstep);
        PG8_WAIT_V(6); PG8_BAR;
    } else {
        PG8_STAGE_B(PG8_SB(0, 0), cB); PG8_STAGE_A(PG8_SA(0, 0), 0, cv[0]); PG8_STAGE_B(PG8_SB(0, 1), cB + hstep); PG8_STAGE_A(PG8_SA(0, 1), 0, cv[1]);
        if (wr == 1) PG8_BAR;
        PG8_WAIT_V(4); PG8_BAR;
        PG8_STAGE_B(PG8_SB(1, 0), cB + kstep); PG8_STAGE_A(PG8_SA(1, 0), kstep, cv[0]); PG8_STAGE_B(PG8_SB(1, 1), cB + hstep + kstep);
        PG8_WAIT_V(6); PG8_BAR;
    }
    for (;;) {
        const bool has_next = S.next(ui + 1, nxt);
        const char* nB = has_next ? (const char*)g.Bt + (size_t)nxt.pn * tstep : cB;
        if (has_next) { PG8_AOFFS(nv, ui + 1, nxt); }
        else {
#pragma unroll
            for (int h = 0; h < 2; ++h)
#pragma unroll
                for (int i = 0; i < 2; ++i) nv[h][i] = cv[h][i]; }
        for (int t = 0; t < nt; t += 2) {
            const bool last = (t == nt - 2);
            const size_t kb1 = (size_t)(t + 1) * kstep, kb2 = last ? (size_t)0 : (size_t)(t + 2) * kstep, kb3 = kb2 + kstep;
            const char* b2 = last ? nB : cB + (size_t)(t + 2) * kstep; const char* b3 = b2 + kstep;
            unsigned o2[2][2];
#pragma unroll
            for (int h = 0; h < 2; ++h)
#pragma unroll
                for (int i = 0; i < 2; ++i) o2[h][i] = last ? nv[h][i] : cv[h][i];
            if constexpr (SP2) {
            PG8_LDB(B0, 0, 0); PG8_LDB(B1, 0, 1); PG8_SCHED; PG8_LDA(At, 0, 0); PG8_STAGE_A(PG8_SA(1, 1), kb1, cv[1]);
            PG8_WAIT_V(8); PG8_WAIT_L(0); PG8_BAR; PG8_MMA(0, 0, At, B0); PG8_MMA(0, 1, At, B1); PG8_BAR; PG8_SCHED;
            PG8_LDA(At, 0, 1); PG8_STAGE_B(PG8_SB(0, 0), b2); PG8_STAGE_B(PG8_SB(0, 1), b2 + hstep); PG8_STAGE_A(PG8_SA(0, 0), kb2, o2[0]);
            PG8_WAIT_V(8); PG8_WAIT_L(0); PG8_BAR; PG8_MMA(1, 0, At, B0); PG8_MMA(1, 1, At, B1); PG8_BAR; PG8_SCHED;
            PG8_LDB(B0, 1, 0); PG8_LDB(B1, 1, 1); PG8_SCHED; PG8_LDA(At, 1, 0); PG8_STAGE_A(PG8_SA(0, 1), kb2, o2[1]);
            PG8_WAIT_V(8); PG8_WAIT_L(0); PG8_BAR; PG8_MMA(0, 0, At, B0); PG8_MMA(0, 1, At, B1); PG8_BAR; PG8_SCHED;
            PG8_LDA(At, 1, 1); PG8_STAGE_B(PG8_SB(1, 0), b3); PG8_STAGE_B(PG8_SB(1, 1), b3 + hstep); PG8_STAGE_A(PG8_SA(1, 0), kb3, o2[0]);
            PG8_WAIT_V(8); PG8_WAIT_L(0); PG8_BAR; PG8_MMA(1, 0, At, B0); PG8_MMA(1, 1, At, B1); PG8_BAR; PG8_SCHED;
            } else {
            PG8_LDB(B0, 0, 0); PG8_SCHED; PG8_LDA(At, 0, 0); PG8_STAGE_A(PG8_SA(1, 1), kb1, cv[1]);
            PG8_WAIT_L(8); PG8_BAR; PG8_WAIT_L(0); PG8_MMA(0, 0, At, B0); PG8_BAR; PG8_SCHED;
            PG8_LDB(B1, 0, 1); PG8_STAGE_B(PG8_SB(0, 0), b2);
            PG8_BAR; PG8_WAIT_L(0); PG8_MMA(0, 1, At, B1); PG8_BAR;
            PG8_LDA(At, 0, 1); PG8_STAGE_A(PG8_SA(0, 0), kb2, o2[0]);
            PG8_BAR; PG8_WAIT_L(0); PG8_MMA(1, 0, At, B0); PG8_BAR; PG8_SCHED;
            PG8_STAGE_B(PG8_SB(0, 1), b2 + hstep);
            PG8_WAIT_V(6); PG8_BAR; PG8_MMA(1, 1, At, B1); PG8_BAR;
            PG8_LDB(B0, 1, 0); PG8_SCHED; PG8_LDA(At, 1, 0); PG8_STAGE_A(PG8_SA(0, 1), kb2, o2[1]);
            PG8_WAIT_L(8); PG8_BAR; PG8_WAIT_L(0); PG8_MMA(0, 0, At, B0); PG8_BAR; PG8_SCHED;
            PG8_LDB(B1, 1, 1); PG8_STAGE_B(PG8_SB(1, 0), b3);
            PG8_BAR; PG8_WAIT_L(0); PG8_MMA(0, 1, At, B1); PG8_BAR;
            PG8_LDA(At, 1, 1); PG8_STAGE_A(PG8_SA(1, 0), kb3, o2[0]);
            PG8_BAR; PG8_WAIT_L(0); PG8_MMA(1, 0, At, B0); PG8_BAR; PG8_SCHED;
            PG8_STAGE_B(PG8_SB(1, 1), b3 + hstep);
            PG8_WAIT_V(6); PG8_BAR; PG8_MMA(1, 1, At, B1); PG8_BAR;
            }
        }
        if constexpr (ALIGN_EPI) { if (wr == 0) PG8_BAR; }
        E(acc, cur, wr, wc, fr, fq);
        if (!has_next) break;
#pragma unroll
        for (int a = 0; a < 2; ++a)
#pragma unroll
            for (int b = 0; b < 2; ++b)
#pragma unroll
                for (int m = 0; m < 4; ++m)
#pragma unroll
                    for (int n = 0; n < 2; ++n) acc[a][b][m][n] = (f32x4){0.f, 0.f, 0.f, 0.f};
        cur = nxt; cB = nB; ++ui;
#pragma unroll
        for (int h = 0; h < 2; ++h)
#pragma unroll
            for (int i = 0; i < 2; ++i) cv[h][i] = nv[h][i];
        if constexpr (ALIGN_EPI) { if (wr == 1) PG8_BAR; }
    }
    PG8_WAIT_V(0);
    if constexpr (!ALIGN_EPI) { if (wr == 0) PG8_BAR; }
    PG8_BAR;
#undef PG8_SA
#undef PG8_SB
#undef PG8_STAGE_A
#undef PG8_STAGE_B
#undef PG8_LDA
#undef PG8_LDB
#undef PG8_MMA
#undef PG8_WAIT_V
#undef PG8_WAIT_L
#undef PG8_BAR
#undef PG8_SCHED
#undef PG8_AOFFS
}
}

__device__ __forceinline__ void transpose_item(const float* W, int pitch, int k0, int n0, bf16_t* WT, int Kd, int drow0, LAS float* scr, int lane) {
#pragma unroll 8
    for (int i = 0; i < 32; ++i) { const int kk = 2 * i + (lane >> 5); scr[kk * 33 + (lane & 31)] = W[(size_t)(k0 + kk) * pitch + n0 + (lane & 31)]; }
    asm volatile("s_waitcnt lgkmcnt(0)" ::: "memory");
    const int c = lane & 7;
#pragma unroll
    for (int j = 0; j < 4; ++j) { const int n = (lane >> 3) + 8 * j; const LAS float* s = scr + (8 * c) * 33 + n;
        u32x4 o; o.x = pk2(s[0 * 33], s[1 * 33]); o.y = pk2(s[2 * 33], s[3 * 33]); o.z = pk2(s[4 * 33], s[5 * 33]); o.w = pk2(s[6 * 33], s[7 * 33]);
        *(u32x4*)(WT + (size_t)(drow0 + n) * Kd + k0 + 8 * c) = o; }
    asm volatile("s_waitcnt lgkmcnt(0)" ::: "memory");
}
constexpr size_t WT_WIN = 0, WT_WOUT = WT_WIN + (size_t)2 * NP * D, WT_FGU = WT_WOUT + (size_t)2 * D * D, WT_FD = WT_FGU + (size_t)2 * D_FF * D,
                 WT_MGU = WT_FD + (size_t)D * D_FF, WT_MD = WT_MGU + (size_t)NE * 2 * D_FFE * D, WT_END = WT_MD + (size_t)NE * D * D_FFE;
static_assert(WT_END * 2 <= 80 * MiB, "weight copies fit");
__device__ __forceinline__ void ph_pro_weights(const Args& a, Frame& F) {
    LAS float* scr = (LAS float*)(F.lds + F.wave * 16384);
    bf16_t* WT = (bf16_t*)(F.ws + WS_WT);
    constexpr int I_IN0 = 16 * 48, I_IN1 = 16 * 24, I_OUT = 16 * 32, I_FG = 16 * 88, I_FD = 44 * 32, I_M = 16 * 32;
    constexpr int NITEMS = 2 * (I_IN0 + I_IN1 + I_OUT) + 2 * I_FG + I_FD + 24 * I_M;
    for (int it = F.gw; it < NITEMS; it += F.ngw) {
        int r = it; const float* src; int pitch, k0, n0, Kd, drow0; bf16_t* dst;
        if (r < 2 * I_IN0) { const int l = r / I_IN0; r %= I_IN0; src = a.w_in + (size_t)l * D * N_IN; pitch = N_IN; k0 = (r / 48) * 64; n0 = (r % 48) * 32; dst = WT + WT_WIN + (size_t)l * NP * D; Kd = D; drow0 = n0; }
        else if ((r -= 2 * I_IN0) < 2 * I_IN1) { const int l = r / I_IN1; r %= I_IN1; src = a.w_in + (size_t)l * D * N_IN + 1544; pitch = N_IN; k0 = (r / 24) * 64; n0 = (r % 24) * 32; dst = WT + WT_WIN + (size_t)l * NP * D; Kd = D; drow0 = 1536 + n0; }
        else if ((r -= 2 * I_IN1) < 2 * I_OUT) { const int l = r / I_OUT; r %= I_OUT; src = a.w_out + (size_t)l * D * D; pitch = D; k0 = (r / 32) * 64; n0 = (r % 32) * 32; dst = WT + WT_WOUT + (size_t)l * D * D; Kd = D; drow0 = n0; }
        else if ((r -= 2 * I_OUT) < 2 * I_FG) { const int up = r / I_FG; r %= I_FG; src = up ? a.ffn_wu : a.ffn_wg; pitch = D_FF; k0 = (r / 88) * 64; n0 = (r % 88) * 32; dst = WT + WT_FGU; Kd = D; drow0 = (n0 / 128) * 256 + up * 128 + (n0 % 128); }
        else if ((r -= 2 * I_FG) < I_FD) { src = a.ffn_wd; pitch = D; k0 = (r / 32) * 64; n0 = (r % 32) * 32; dst = WT + WT_FD; Kd = D_FF; drow0 = n0; }
        else if ((r -= I_FD) < 16 * I_M) { const int e = r / (2 * I_M); r %= 2 * I_M; const int up = r / I_M; r %= I_M; src = (up ? a.moe_wu : a.moe_wg) + (size_t)e * D * D_FFE; pitch = D_FFE; k0 = (r / 32) * 64; n0 = (r % 32) * 32;
            dst = WT + WT_MGU + (size_t)e * 2 * D_FFE * D; Kd = D; drow0 = (n0 / 128) * 256 + up * 128 + (n0 % 128); }
        else { r -= 16 * I_M; const int e = r / I_M; r %= I_M; src = a.moe_wd + (size_t)e * D_FFE * D; pitch = D; k0 = (r / 32) * 64; n0 = (r % 32) * 32; dst = WT + WT_MD + (size_t)e * D * D_FFE; Kd = D_FFE; drow0 = n0; }
        transpose_item(src, pitch, k0, n0, dst, Kd, drow0, scr, F.lane);
    }
}

template <int NT> __device__ __forceinline__ void moe_order_init(Frame& F, pg8::MoeOrder<NT>& S) {
    const unsigned* c = (const unsigned*)(F.ws + WS_CTL) + CW_MOECNT;
    int acc = 0;
#pragma unroll
    for (int e = 0; e < 8; ++e) { S.bt[e] = acc; acc += ((int)__hip_atomic_load(c + 64 * e, __ATOMIC_RELAXED, __HIP_MEMORY_SCOPE_AGENT) + 255) >> 8; }
    S.bt[8] = acc; S.G = F.nb; S.c = F.bid;
}
template <int NT> __device__ __forceinline__ void moe_ri_preload(Frame& F, const pg8::MoeOrder<NT>& S) {
    LAS int* RI = (LAS int*)(F.lds + RI_OFF); const int* RM = (const int*)(F.ws + WS_RMAP);
    for (int i = 0; i < 15; ++i) { pg8::Unit u; if (!S.next(i, u)) break; if (F.tid < 256) RI[i * 256 + F.tid] = RM[u.pm * 256 + F.tid]; }
    __syncthreads();
}

__global__ void __launch_bounds__(NTHREADS, 2) fwd(Args a) {
    extern __shared__ __attribute__((aligned(16))) unsigned char lds_raw[];
    Frame F;
    F.lds = (LAS unsigned char*)lds_raw;
    F.tid = threadIdx.x; F.lane = F.tid & 63; F.wave = __builtin_amdgcn_readfirstlane(F.tid >> 6);
    F.bid = blockIdx.x; F.nb = gridDim.x; F.gw = F.bid * NWAVES + F.wave; F.ngw = F.nb * NWAVES; F.ws = (GAS unsigned char*)a.ws;
    volatile LAS unsigned* MISC = (volatile LAS unsigned*)(F.lds + MISC_OFF);
    for (int u = F.tid; u < 32; u += NTHREADS) MISC[u] = 0u;
    __syncthreads();
    unsigned* ctl = (unsigned*)(a.ws + WS_CTL);
    const int lo = a.ph_lo, hi = a.ph_hi;
    const bool multi = (hi - lo) > 1;
    XcdBarrier bar; bar.bar = ctl + CW_BAR; bar.x = 0; bar.st = MISC + 8;
    if (multi) bar = xcd_barrier_post(ctl + CW_BAR, MISC + 8);
#define IN(k) (lo <= (k) && (k) < hi && (frame_refresh(F, a, (LAS unsigned char*)lds_raw), true))
#define SEAM(k) do { if (IN((k) + 1) && IN(k)) xcd_barrier(bar); } while (0)
    float* MOD = (float*)(a.ws + WS_MOD);
    bf16_t* H = (bf16_t*)(a.ws + WS_H); bf16_t* PROJ = (bf16_t*)(a.ws + WS_PROJ); bf16_t* YMIX = (bf16_t*)(a.ws + WS_YMIX);
    bf16_t* WT = (bf16_t*)(a.ws + WS_WT);
    bf16_t* ACT = (bf16_t*)(a.ws + WS_ACT); bf16_t* ACTM = (bf16_t*)(a.ws + WS_ACTM); bf16_t* YMOE = (bf16_t*)(a.ws + WS_YMOE);

    if (IN(PH_PRO)) { REP(1) { ph_pro_naive(a, F); ph_pro_weights(a, F); } SEAM(PH_PRO); }

#define TWICE(bit, stmt) do { stmt; if constexpr ((PROBE_MASK & (bit)) != 0) { stmt; } } while (0)
#define LAYER_BODY(l) {\
        const int pb = PH_LAYER0 + PH_PER_LAYER * l; \
        const float* xin = (l == 0) ? a.x : a.out; \
        const float* mod0 = MOD + (size_t)(l * 2 + 0) * 2 * 3072; const float* mod1 = MOD + (size_t)(l * 2 + 1) * 2 * 3072; \
        if (IN(pb + K_NORM1)) { REP(2) ph_norm<1>(a, F, l, xin, a.nmg + l * D, mod0, a.w_in + (size_t)l * D * N_IN + W_DB, N_IN); SEAM(pb + K_NORM1); } \
        if (IN(pb + K_GEMM_IN)) { \
            TWICE(4, ({ pg8::Gemm g{H, WT + WT_WIN + (size_t)l * NP * D, D}; pg8::StaticOrder S; S.init(T, NP, F.nb, F.bid); pg8::EpiBf16 E{PROJ, NP, 1 << 20}; \
                pg8::gemm_phase<pg8::EpiBf16, pg8::StaticOrder, false, true, true>(F.lds, nullptr, g, S, E); })); \
            SEAM(pb + K_GEMM_IN); \
        } \
        if (IN(pb + K_DN_PREP)) { REP(8) ph_dn_chunk(a, F, l); ph_rope(a, F); SEAM(pb + K_DN_PREP); } \
        if (IN(pb + K_MIX)) { REP(16) ph_dn_scan(a, F); REP(512) ph_attn_mfma(a, F, l); REP(1024) ph_conv_fast(a, F, l); SEAM(pb + K_MIX); } \
        if (IN(pb + K_DN_OUT)) { REP(32) ph_dn_out(a, F, l); SEAM(pb + K_DN_OUT); } \
        if (IN(pb + K_GEMM_OUT)) { \
            TWICE((l == 0) ? 64 : 0, ({ pg8::Gemm g{YMIX, WT + WT_WOUT + (size_t)l * D * D, D}; pg8::StaticOrder S; S.init(T, D, F.nb, F.bid); pg8::EpiResidF32 E{xin, a.out, mod0 + 2048}; \
                pg8::gemm_phase<pg8::EpiResidF32, pg8::StaticOrder, false, true, true>(F.lds, nullptr, g, S, E); })); \
            SEAM(pb + K_GEMM_OUT); \
        } \
        if (l == 0) { \
            if (IN(pb + K_NORM2)) { REP(128) ph_norm<0>(a, F, l, a.out, a.nfg + l * D, mod1, nullptr, 0); SEAM(pb + K_NORM2); } \
            if (IN(pb + K_MOE_LIST)) { SEAM(pb + K_MOE_LIST); } \
            if (IN(pb + K_FFN1)) { \
                TWICE(256, ({ pg8::Gemm g{H, WT + WT_FGU, D}; pg8::StaticOrder S; S.init(T, 2 * D_FF, F.nb, F.bid); pg8::EpiSwiGLU E{ACT, D_FF, 1 << 20}; \
                    pg8::gemm_phase<pg8::EpiSwiGLU, pg8::StaticOrder, false, true, true>(F.lds, nullptr, g, S, E); })); \
                SEAM(pb + K_FFN1); \
            } \
            if (IN(pb + K_FFN2)) { \
                { pg8::Gemm g{ACT, WT + WT_FD, D_FF}; pg8::StaticOrder S; S.init(T, D, F.nb, F.bid); pg8::EpiResidF32 E{a.out, a.out, mod1 + 2048}; \
                    pg8::gemm_phase<pg8::EpiResidF32, pg8::StaticOrder, false, true, true>(F.lds, nullptr, g, S, E); } \
                SEAM(pb + K_FFN2); \
            } \
        } else { \
            if (IN(pb + K_NORM2)) { ph_norm<2>(a, F, l, a.out, a.nfg + l * D, mod1, a.router_w, NE); SEAM(pb + K_NORM2); } \
            if (IN(pb + K_MOE_LIST)) { ph_moe_list(a, F); SEAM(pb + K_MOE_LIST); } \
            if (IN(pb + K_FFN1)) { \
                TWICE(2048, ({ pg8::MoeOrder<8> S; moe_order_init<8>(F, S); moe_ri_preload<8>(F, S); \
                    pg8::Gemm g{H, WT + WT_MGU, D}; pg8::EpiSwiGLU E{ACTM, D_FFE, 8}; \
                    pg8::gemm_phase<pg8::EpiSwiGLU, pg8::MoeOrder<8>, true, true, true>(F.lds, (const LAS int*)(F.lds + RI_OFF), g, S, E); })); \
                SEAM(pb + K_FFN1); \
            } \
            if (IN(pb + K_FFN2)) { \
                TWICE(4096, ({ pg8::MoeOrder<4> S; moe_order_init<4>(F, S); \
                    pg8::Gemm g{ACTM, WT + WT_MD, D_FFE}; pg8::EpiBf16 E{YMOE, D, 4}; \
                    pg8::gemm_phase<pg8::EpiBf16, pg8::MoeOrder<4>, false, true, true>(F.lds, nullptr, g, S, E); })); \
                SEAM(pb + K_FFN2); \
            } \
        } \
    }
    LAYER_BODY(0)
    LAYER_BODY(1)
#undef LAYER_BODY
    if (IN(PH_FINAL)) { ph_final(a, F); }
#undef IN
#undef SEAM
}

extern "C" void kernel_launch(void* const* d_in, const int* in_sizes, int n_in, void* d_out, int out_size, void* d_ws, size_t ws_size, hipStream_t stream) {
    static int grid = 0;
    if (grid == 0) {
        if (n_in != 27 || out_size != T * D || ws_size < WS_END) { fprintf(stderr, "kernel_launch: unexpected shapes n_in %d out %d ws %zu\n", n_in, out_size, ws_size); grid = -1; return; }
        int dev = 0, cus = 0, per_cu = 0;
        if (hipGetDevice(&dev) != hipSuccess || hipDeviceGetAttribute(&cus, hipDeviceAttributeMultiprocessorCount, dev) != hipSuccess) { grid = -1; return; }
        if (hipFuncSetAttribute((const void*)fwd, hipFuncAttributeMaxDynamicSharedMemorySize, LDS_BYTES) != hipSuccess) { fprintf(stderr, "kernel_launch: hipFuncSetAttribute failed\n"); grid = -1; return; }
        if (hipOccupancyMaxActiveBlocksPerMultiprocessor(&per_cu, (const void*)fwd, NTHREADS, LDS_BYTES) != hipSuccess || per_cu < 1) fprintf(stderr, "kernel_launch: occupancy query says %d\n", per_cu);
        (void)hipGetLastError();
        grid = cus;
    }
    if (grid < 0) return;
    (void)hipMemsetAsync((char*)d_ws + WS_CTL, 0, CTL_ZERO_BYTES, stream);
    Args a{};
    const void** pp = (const void**)&a;
    for (int i = 0; i < 27; ++i) pp[i] = d_in[i];
    a.out = (float*)d_out; a.ws = (unsigned char*)d_ws;
#if MK_ONE_LAUNCH
    a.ph_lo = 0; a.ph_hi = NPH;
    hipLaunchKernelGGL(fwd, dim3(grid), dim3(NTHREADS), LDS_BYTES, stream, a);
#else
    static const int phases[] = {0, 1, 2, 3, 4, 5, 6, 7, 9, 10, 11, 12, 13, 14, 15, 16, 17, 18, 19, 20, 21};
    for (int p : phases) { a.ph_lo = p; a.ph_hi = p + 1; hipLaunchKernelGGL(fwd, dim3(grid), dim3(NTHREADS), LDS_BYTES, stream, a); }
#endif
}
```

```cpp
#include <hip/hip_runtime.h>
#include <cstdio>
#include <cstdint>

#define LAS __attribute__((address_space(3)))
#define GAS __attribute__((address_space(1)))
typedef unsigned short bf16_t;
typedef float f32x4 __attribute__((ext_vector_type(4)));
typedef unsigned u32x2 __attribute__((ext_vector_type(2)));
typedef unsigned u32x4 __attribute__((ext_vector_type(4)));

#ifndef GEMM_MASK
#define GEMM_MASK 63
#endif
#ifndef ATTN_MFMA
#define ATTN_MFMA 1
#endif
#ifndef DN_CHUNKED
#define DN_CHUNKED 1
#endif
#ifndef CONV_FAST
#define CONV_FAST 1
#endif
#ifndef PROBE_MASK
#define PROBE_MASK 0
#endif
#define REP(bit) for (int rep_ = 0; rep_ < ((PROBE_MASK & (bit)) ? 2 : 1); ++rep_)
#ifndef MK_ONE_LAUNCH
#define MK_ONE_LAUNCH 1
#endif

constexpr int BATCH = 2, SEQ = 16384, T = BATCH * SEQ, D = 1024, DEPTH = 2;
constexpr int NPW = 2560;
constexpr int N_IN = 2312, NP = 2304;
constexpr int C_AQ = 0, C_AK = 512, C_AV = 640, C_DQ = 768, C_DK = 1024, C_DV = 1280, C_DZ = 1536, C_CA = 1792, C_CB = 2048;
constexpr int W_DB = 1536;
constexpr int D_FF = 2816, NE = 8, D_FFE = 1024;
constexpr int WINDOW = 128, CV_K = 31, CV_C = 256, DN_CONV = 4;
constexpr float EPS = 1e-6f;
constexpr int NSCAN = BATCH * 4 * 4;
constexpr int MOE_CAP = 67584;

constexpr size_t MiB = 1u << 20;
constexpr size_t WS_CTL = 0, CTL_ZERO_BYTES = 1 * MiB;
constexpr size_t WS_MOD = 1 * MiB;
constexpr size_t WS_CS = 2 * MiB;
constexpr size_t WS_BG = 4 * MiB;
constexpr size_t WS_ROUTE = 5 * MiB;
constexpr size_t WS_POS = 6 * MiB;
constexpr size_t WS_RMAP = 7 * MiB;
constexpr size_t WS_WT = 8 * MiB;
constexpr size_t WS_H = 88 * MiB;
constexpr size_t WS_PROJ = 152 * MiB;
constexpr size_t WS_YMIX = 296 * MiB;
constexpr size_t WS_DNQKV = 360 * MiB;
constexpr size_t WS_ODN = 456 * MiB;
constexpr size_t WS_ACT = 152 * MiB;
constexpr size_t WS_ACTM = 152 * MiB;
constexpr size_t WS_YMOE = 284 * MiB;
constexpr size_t WS_X16 = 440 * MiB;
constexpr size_t WS_SSQ = 504 * MiB;
constexpr size_t WS_AV = WS_MOD + 128 * 1024;
constexpr size_t WS_CVF = WS_MOD + 256 * 1024;
constexpr size_t WS_CVI = WS_CVF + 2 * 5632 * 4;
constexpr size_t WS_CVM = WS_CVI + 2 * 2560 * 4;
constexpr size_t WS_CR = WS_CVM + 2 * 16384 * 4;
static_assert(WS_CR + 64 <= WS_CS, "vector area");
constexpr size_t WS_END = 512 * MiB;
constexpr int CW_BAR = 4096;
constexpr int CW_MOECNT = 16384;

constexpr int NWAVES = 8, NTHREADS = 512;
constexpr int LDS_BYTES = 163840;
constexpr int MISC_OFF = 131072 + 320;
constexpr int RI_OFF = 132096;
constexpr int RS_OFF = 147456;

constexpr int PH_PRO = 0, PH_LAYER0 = 1, PH_PER_LAYER = 10, PH_FINAL = 21, NPH = 22;
enum { K_NORM1 = 0, K_GEMM_IN, K_DN_PREP, K_MIX, K_DN_OUT, K_GEMM_OUT, K_NORM2, K_MOE_LIST, K_FFN1, K_FFN2 };

struct Args {
    const float* x; const float* c; const int* pos; const float* ada_w; const float* ada_b; const float* nmg; const float* nfg;
    const float* w_in; const float* sinks; const float* dn_conv_w; const float* dn_a_log; const float* dn_dt_bias; const float* dn_norm_g;
    const float* cv_dw_w; const float* cv_dw_b; const float* cv_ln_g; const float* cv_ln_b; const float* w_out;
    const float* ffn_wg; const float* ffn_wu; const float* ffn_wd; const float* router_w; const float* router_b;
    const float* moe_wg; const float* moe_wu; const float* moe_wd; const float* final_g;
    float* out; unsigned char* ws; int ph_lo, ph_hi;
};

__device__ __forceinline__ float bf2f(unsigned u) { return __uint_as_float(u << 16); }
__device__ __forceinline__ unsigned f2bf(float f) { unsigned u = __float_as_uint(f); return (u + 0x7fffu + ((u >> 16) & 1u)) >> 16; }
__device__ __forceinline__ unsigned pk2(float lo, float hi) { return f2bf(lo) | (f2bf(hi) << 16); }
__device__ __forceinline__ float wave_sum(float v) {
#pragma unroll
    for (int o = 1; o < 64; o <<= 1) v += __shfl_xor(v, o);
    return v;
}
__device__ __forceinline__ float wave_max(float v) {
#pragma unroll
    for (int o = 1; o < 64; o <<= 1) v = fmaxf(v, __shfl_xor(v, o));
    return v;
}
__device__ __forceinline__ float sigmoidf_(float x) { return __builtin_amdgcn_rcpf(1.0f + __builtin_amdgcn_exp2f(x * -1.4426950408889634f)); }
__device__ __forceinline__ float siluf_(float x) { return x * __builtin_amdgcn_rcpf(1.0f + __builtin_amdgcn_exp2f(x * -1.4426950408889634f)); }
__device__ __forceinline__ float softplusf_(float x) { return fmaxf(x, 0.f) + log1pf(__expf(-fabsf(x))); }

#define XB_TMO      128
#define XB_XCNT(j)  (256  + 64 * (j))
#define XB_XSUB(j)  (1280 + 64 * (j))
#define XB_XGEN(j)  (2304 + 64 * (j))
#define XB_TOP      3328
#define XB_TOPGEN   3392
#define XCD_BAR_WORDS 3456
#define XB_SPIN_CAP (1u << 18)

__device__ __forceinline__ unsigned xb_ld(unsigned* p)              { return __hip_atomic_load(p, __ATOMIC_RELAXED, __HIP_MEMORY_SCOPE_AGENT); }
__device__ __forceinline__ unsigned xb_add(unsigned* p, unsigned v) { return __hip_atomic_fetch_add(p, v, __ATOMIC_RELAXED, __HIP_MEMORY_SCOPE_AGENT); }
__device__ __forceinline__ unsigned xb_xcc_id() { return (unsigned)__builtin_amdgcn_s_getreg((3 << 11) | 20) & 0xFu; }
#define XB_SPIN(cond, bar) do { unsigned _sp = 0; while (cond) { __builtin_amdgcn_s_sleep(1); \
    if ((++_sp & 255u) == 0u) { if (xb_ld(&(bar)[XB_TMO])) break; if (_sp > XB_SPIN_CAP) { atomicAdd(&(bar)[XB_TMO], 1u); break; } } } } while (0)

struct XcdBarrier { unsigned* bar; unsigned x; volatile LAS unsigned* st; };

__device__ __forceinline__ XcdBarrier xcd_barrier_post(unsigned* bar, volatile LAS unsigned* st) {
    XcdBarrier b; b.bar = bar; b.x = xb_xcc_id(); b.st = st;
    if (threadIdx.x == 0) (void)xb_add(&bar[XB_XCNT(b.x)], 1u);
    return b;
}
__device__ __forceinline__ void xcd_barrier_complete(unsigned* bar, unsigned x, unsigned& nloc, unsigned& nx) {
    const unsigned G = gridDim.x * gridDim.y * gridDim.z;
    unsigned sum, cnt, mine, sp = 0u;
    for (;;) {
        sum = 0u; cnt = 0u; mine = 0u;
#pragma unroll
        for (unsigned j = 0; j < 16; ++j) { const unsigned c = xb_ld(&bar[XB_XCNT(j)]); sum += c; cnt += (c > 0u) ? 1u : 0u; mine = (j == x) ? c : mine; }
        if (sum == G) break;
        __builtin_amdgcn_s_sleep(1);
        if ((++sp & 255u) == 0u) { if (xb_ld(&bar[XB_TMO])) break; if (sp > XB_SPIN_CAP) { atomicAdd(&bar[XB_TMO], 1u); break; } }
    }
    nloc = mine > 0u ? mine : 1u; nx = cnt > 0u ? cnt : 1u;
}
__device__ __forceinline__ void xcd_barrier(const XcdBarrier& b) {
    asm volatile("s_waitcnt vmcnt(0)" ::: "memory");
    __syncthreads();
    if (threadIdx.x == 0) {
        unsigned* bar = b.bar;
        __builtin_amdgcn_s_waitcnt(0);
        unsigned nloc = b.st[0], nx = b.st[1];
        if (nloc == 0u) { xcd_barrier_complete(bar, b.x, nloc, nx); b.st[0] = nloc; b.st[1] = nx; }
        const unsigned old = xb_add(&bar[XB_XSUB(b.x)], 1u);
        const unsigned gen = old / nloc;
        if (old + 1u == (gen + 1u) * nloc) {
            __builtin_amdgcn_fence(__ATOMIC_RELEASE, "agent");
            asm volatile("s_waitcnt vmcnt(0)" ::: "memory");
            const unsigned og = xb_add(&bar[XB_TOP], 1u);
            const unsigned tg = og / nx;
            if (og + 1u == (tg + 1u) * nx) xb_add(&bar[XB_TOPGEN], 1u);
            else XB_SPIN(xb_ld(&bar[XB_TOPGEN]) == tg, bar);
            __builtin_amdgcn_fence(__ATOMIC_ACQUIRE, "agent");
            xb_add(&bar[XB_XGEN(b.x)], 1u);
            asm volatile("s_waitcnt vmcnt(0)" ::: "memory");
        } else {
            XB_SPIN(xb_ld(&bar[XB_XGEN(b.x)]) == gen, bar);
            __builtin_amdgcn_fence(__ATOMIC_ACQUIRE, "agent");
            asm volatile("s_waitcnt vmcnt(0)" ::: "memory");
        }
    }
    __syncthreads();
}

struct Frame {
    LAS unsigned char* lds;
    int tid, lane, wave, gw, ngw, bid, nb;
    GAS unsigned char* ws;
};

__device__ __forceinline__ void frame_refresh(Frame& F, const Args& a, LAS unsigned char* lds) {
    int tid = threadIdx.x; asm volatile("" : "+v"(tid));
    int bid = blockIdx.x; asm volatile("" : "+s"(bid));
    unsigned char* ws = a.ws; asm volatile("" : "+s"(ws));
    F.lds = lds; F.tid = tid; F.lane = tid & 63; F.wave = __builtin_amdgcn_readfirstlane(tid >> 6);
    F.bid = bid; F.nb = gridDim.x; F.gw = F.bid * NWAVES + F.wave; F.ngw = F.nb * NWAVES; F.ws = (GAS unsigned char*)ws;
}
__device__ __forceinline__ void ph_pro_naive(const Args& a, Frame& F) {
    float* MOD = (float*)(F.ws + WS_MOD);
    LAS float* red = (LAS float*)F.lds;
    for (int it = F.bid; it < 4 * 48; it += F.nb) {
        const int lk = it / 48, cg = it % 48, e = cg * 64 + F.lane;
        const float* W = a.ada_w + (size_t)lk * D * 3072 + e;
        float a0 = 0.f, a1 = 0.f;
        const int d0 = F.wave * 128;
#pragma unroll 8
        for (int d = d0; d < d0 + 128; ++d) {
            const float w = W[(size_t)d * 3072];
            a0 += siluf_(a.c[d]) * w; a1 += siluf_(a.c[D + d]) * w;
        }
        red[(F.wave * 2 + 0) * 64 + F.lane] = a0; red[(F.wave * 2 + 1) * 64 + F.lane] = a1;
        __syncthreads();
        if (F.wave < 2) {
            float s = 0.f;
            for (int w = 0; w < 8; ++w) s += red[(w * 2 + F.wave) * 64 + F.lane];
            MOD[((size_t)lk * 2 + F.wave) * 3072 + e] = s + a.ada_b[lk * 3072 + e];
        }
        __syncthreads();
    }
    float* CS = (float*)(F.ws + WS_CS);
    for (int idx = F.bid * NTHREADS + F.tid; idx < T * 8; idx += F.nb * NTHREADS) {
        const int t = idx >> 3, i = idx & 7;
        const float inv = powf(500000.0f, -(float)(2 * i) / 16.0f);
        const float ang = (float)a.pos[t] * inv;
        CS[t * 16 + i] = cosf(ang); CS[t * 16 + 8 + i] = sinf(ang);
    }
}

template <int MODE>
__device__ __forceinline__ void ph_norm(const Args& a, Frame& F, int l, const float* xin, const float* gain, const float* modk  ,
                                        const float* W8, int pitch) {
    bf16_t* H = (bf16_t*)(F.ws + WS_H);
    LAS float* W8T = (LAS float*)F.lds;
    if (MODE != 0) {
        for (int i = F.tid; i < 8192; i += NTHREADS) { const int d = i >> 3, j = i & 7; W8T[j * 1024 + d] = W8[(size_t)d * pitch + j]; }
        __syncthreads();
    }
    f32x4 vn[4], A4[4], B4[4]; int cur_b = -1;
    if (F.gw < T) {
#pragma unroll
        for (int j = 0; j < 4; ++j) vn[j] = ((const f32x4*)(xin + (size_t)F.gw * D) + F.lane)[64 * j];
    }
    for (int row = F.gw; row < T; row += F.ngw) {
        const int b = row / SEQ;
        f32x4 v[4]; float ss = 0.f;
#pragma unroll
        for (int j = 0; j < 4; ++j) { v[j] = vn[j]; ss += (v[j].x * v[j].x + v[j].y * v[j].y) + (v[j].z * v[j].z + v[j].w * v[j].w); }
        if (row + F.ngw < T) {
#pragma unroll
            for (int j = 0; j < 4; ++j) vn[j] = ((const f32x4*)(xin + (size_t)(row + F.ngw) * D) + F.lane)[64 * j];
        }
        if (b != cur_b) {
            cur_b = b; const float* sh = modk + (size_t)b * 3072; const float* sc = sh + 1024;
#pragma unroll
            for (int j = 0; j < 4; ++j) { const int d = 256 * j + 4 * F.lane; A4[j] = *(const f32x4*)(gain + d) * (*(const f32x4*)(sc + d) + 1.0f); B4[j] = *(const f32x4*)(sh + d); }
        }
        const float rstd = rsqrtf(wave_sum(ss) * (1.0f / D) + EPS);
        float acc[8];
#pragma unroll
        for (int e = 0; e < 8; ++e) acc[e] = 0.f;
#pragma unroll
        for (int j = 0; j < 4; ++j) {
            const int d = 256 * j + 4 * F.lane;
            const f32x4 hv = (v[j] * rstd) * A4[j] + B4[j];
            u32x2 o; o.x = pk2(hv.x, hv.y); o.y = pk2(hv.z, hv.w);
            *(u32x2*)(H + (size_t)row * D + d) = o;
            if (MODE != 0) {
#pragma unroll
                for (int e = 0; e < 8; ++e) { const f32x4 w4 = *(const LAS f32x4*)(W8T + e * 1024 + d); acc[e] += (hv.x * w4.x + hv.y * w4.y) + (hv.z * w4.z + hv.w * w4.w); }
            }
        }
        if (MODE != 0) {
#pragma unroll
            for (int e = 0; e < 8; ++e) acc[e] = wave_sum(acc[e]);
        }
        if (MODE == 1 && F.lane == 0) {
            float* BG = (float*)(F.ws + WS_BG) + (size_t)row * 8;
#pragma unroll
            for (int h = 0; h < 4; ++h) {
                BG[h] = sigmoidf_(acc[h]);
                BG[4 + h] = -__expf(a.dn_a_log[l * 4 + h]) * softplusf_(acc[4 + h] + a.dn_dt_bias[l * 4 + h]);
            }
        }
        if (MODE == 2 && F.lane == 0) {
            float v0 = -INFINITY, v1 = -INFINITY; int e0 = 0, e1 = 0;
#pragma unroll
            for (int e = 0; e < 8; ++e) { const float lg = acc[e] + a.router_b[e]; if (lg > v0) { v1 = v0; e1 = e0; v0 = lg; e0 = e; } else if (lg > v1) { v1 = lg; e1 = e; } }
            const float ex = __expf(v1 - v0), p0 = 1.0f / (1.0f + ex), p1 = ex / (1.0f + ex);
            unsigned* cnt = (unsigned*)(F.ws + WS_CTL) + CW_MOECNT;
            const int q0 = (int)atomicAdd(cnt + 64 * e0, 1u), q1 = (int)atomicAdd(cnt + 64 * e1, 1u);
            int* R = (int*)(F.ws + WS_ROUTE) + (size_t)row * 4; R[0] = e0; R[1] = e1; ((float*)R)[2] = p0; ((float*)R)[3] = p1;
            int* P = (int*)(F.ws + WS_POS) + (size_t)row * 2; P[0] = q0; P[1] = q1;
        }
    }
    if (MODE != 0) __syncthreads();
}

template <bool DUAL, class Epi>
__device__ __forceinline__ void gemm_naive(Frame& F, const bf16_t* A, int lda, const int* rowmap, int m_base, int Mrows, int K,
                                           const float* W0, const float* W1, int ldw, int N, int skip_at, int skip, const Epi& epi) {
    LAS float* As = (LAS float*)F.lds;
    LAS float* Bs = As + 16 * 132;
    LAS float* Bs2 = Bs + 16 * 128;
    const int ntm = Mrows / 128, ntn = N / 128;
    const int ty = F.tid >> 4, tx = F.tid & 15;
    const int ar = F.tid >> 2, ak = (F.tid & 3) * 4;
    const int bk = F.tid >> 5, bc = (F.tid & 31) * 4;
    for (int tile = F.bid; tile < ntm * ntn; tile += F.nb) {
        const int tm = tile / ntn, tn = tile % ntn, m0 = m_base + tm * 128, n0 = tn * 128;
        const int wn0 = (n0 >= skip_at) ? n0 + skip : n0;
        const int arow = rowmap ? rowmap[m0 + ar] : (m0 + ar);
        const bf16_t* ap = A + (size_t)arow * lda + ak;
        float acc0[4][8], acc1[4][8];
#pragma unroll
        for (int i = 0; i < 4; ++i)
#pragma unroll
            for (int j = 0; j < 8; ++j) { acc0[i][j] = 0.f; acc1[i][j] = 0.f; }
        for (int k0 = 0; k0 < K; k0 += 16) {
            const u32x2 av = *(const u32x2*)(ap + k0);
            const f32x4 bv = *(const f32x4*)(W0 + (size_t)(k0 + bk) * ldw + wn0 + bc);
            f32x4 bv2 = (f32x4){0.f, 0.f, 0.f, 0.f};
            if (DUAL) bv2 = *(const f32x4*)(W1 + (size_t)(k0 + bk) * ldw + wn0 + bc);
            __syncthreads();
            As[(ak + 0) * 132 + ar] = bf2f(av.x & 0xffffu); As[(ak + 1) * 132 + ar] = bf2f(av.x >> 16);
            As[(ak + 2) * 132 + ar] = bf2f(av.y & 0xffffu); As[(ak + 3) * 132 + ar] = bf2f(av.y >> 16);
            *(LAS f32x4*)(Bs + bk * 128 + bc) = bv;
            if (DUAL) *(LAS f32x4*)(Bs2 + bk * 128 + bc) = bv2;
            __syncthreads();
#pragma unroll 2
            for (int kk = 0; kk < 16; ++kk) {
                const f32x4 a4 = *(const LAS f32x4*)(As + kk * 132 + ty * 4);
                const f32x4 b0 = *(const LAS f32x4*)(Bs + kk * 128 + tx * 8), b1 = *(const LAS f32x4*)(Bs + kk * 128 + tx * 8 + 4);
                const float av4[4] = {a4.x, a4.y, a4.z, a4.w};
                const float bb[8] = {b0.x, b0.y, b0.z, b0.w, b1.x, b1.y, b1.z, b1.w};
#pragma unroll
                for (int i = 0; i < 4; ++i)
#pragma unroll
                    for (int j = 0; j < 8; ++j) acc0[i][j] += av4[i] * bb[j];
                if (DUAL) {
                    const f32x4 c0 = *(const LAS f32x4*)(Bs2 + kk * 128 + tx * 8), c1 = *(const LAS f32x4*)(Bs2 + kk * 128 + tx * 8 + 4);
                    const float cc[8] = {c0.x, c0.y, c0.z, c0.w, c1.x, c1.y, c1.z, c1.w};
#pragma unroll
                    for (int i = 0; i < 4; ++i)
#pragma unroll
                        for (int j = 0; j < 8; ++j) acc1[i][j] += av4[i] * cc[j];
                }
            }
        }
#pragma unroll
        for (int i = 0; i < 4; ++i)
#pragma unroll
            for (int j = 0; j < 8; ++j) epi(m0 + ty * 4 + i, n0 + tx * 8 + j, acc0[i][j], acc1[i][j]);
    }
    __syncthreads();
}
struct EpiStoreBf16 { bf16_t* C; int ldc; __device__ __forceinline__ void operator()(int m, int n, float a0, float) const { C[(size_t)m * ldc + n] = (bf16_t)f2bf(a0); } };
struct EpiSwiglu { bf16_t* C; int ldc; __device__ __forceinline__ void operator()(int m, int n, float a0, float a1) const { C[(size_t)m * ldc + n] = (bf16_t)f2bf(siluf_(a0) * a1); } };
struct EpiResid { const float* xin; float* xout; const float* gate;   __device__ __forceinline__ void operator()(int m, int n, float a0, float) const {
    const int b = m / SEQ; xout[(size_t)m * D + n] = xin[(size_t)m * D + n] + gate[(size_t)b * 3072 + n] * a0; } };

__device__ __forceinline__ void ph_dn_prep_naive(const Args& a, Frame& F, int l) {
    const bf16_t* P = (const bf16_t*)(F.ws + WS_PROJ);
    float* Q = (float*)(F.ws + WS_DNQKV);
    const float* cw = a.dn_conv_w + (size_t)l * DN_CONV * 768;
    for (int t = F.gw; t < T; t += F.ngw) {
        const int s = t % SEQ;
#pragma unroll
        for (int j = 0; j < 12; ++j) {
            const int c = F.lane + 64 * j;
            float acc = 0.f;
#pragma unroll
            for (int k = 0; k < DN_CONV; ++k) { const int sp = s - (DN_CONV - 1) + k; if (sp >= 0) acc += cw[k * 768 + c] * bf2f(P[(size_t)(t - (DN_CONV - 1) + k) * NP + C_DQ + c]); }
            float val = siluf_(acc);
            if (j < 8) { const float n2 = wave_sum(val * val); val *= rsqrtf(n2 + EPS); if (j < 4) val *= 0.125f; }
            Q[(size_t)t * 768 + c] = val;
        }
    }
}
__device__ __forceinline__ void ph_dn_scan_naive(const Args& a, Frame& F) {
    const float* Q = (const float*)(F.ws + WS_DNQKV); const float* BG = (const float*)(F.ws + WS_BG); float* O = (float*)(F.ws + WS_ODN);
    for (int task = F.gw; task < BATCH * 4 * 64; task += F.ngw) {
        const int col = task & 63, h = (task >> 6) & 3, b = task >> 8;
        float S = 0.f;
        for (int s0 = 0; s0 < SEQ; s0 += 8) {
            float q8[8], k8[8], v8[8], b8[8], g8[8];
#pragma unroll
            for (int i = 0; i < 8; ++i) { const size_t t = (size_t)b * SEQ + s0 + i; q8[i] = Q[t * 768 + h * 64 + F.lane]; k8[i] = Q[t * 768 + 256 + h * 64 + F.lane]; v8[i] = Q[t * 768 + 512 + h * 64 + col];
                b8[i] = BG[t * 8 + h]; g8[i] = BG[t * 8 + 4 + h]; }
#pragma unroll
            for (int i = 0; i < 8; ++i) {
                const float eg = __expf(g8[i]);
                const float kS = wave_sum(k8[i] * S);
                const float dl = b8[i] * (v8[i] - eg * kS);
                S = eg * S + k8[i] * dl;
                const float o = wave_sum(q8[i] * S);
                if (F.lane == 0) O[((size_t)b * SEQ + s0 + i) * 256 + h * 64 + col] = o;
            }
        }
    }
}
__device__ __forceinline__ void ph_dn_out_naive(const Args& a, Frame& F, int l) {
    const float* O = (const float*)(F.ws + WS_ODN); const bf16_t* P = (const bf16_t*)(F.ws + WS_PROJ); bf16_t* Y = (bf16_t*)(F.ws + WS_YMIX);
    for (int task = F.gw; task < T * 4; task += F.ngw) {
        const int t = task >> 2, h = task & 3;
        const float o = O[(size_t)t * 256 + h * 64 + F.lane];
        const float ms = wave_sum(o * o) * (1.0f / 64.0f);
        const float z = bf2f(P[(size_t)t * NP + C_DZ + h * 64 + F.lane]);
        const float y = o * rsqrtf(ms + EPS) * a.dn_norm_g[l * 64 + F.lane] * siluf_(z);
        Y[(size_t)t * D + 512 + h * 64 + F.lane] = (bf16_t)f2bf(y);
    }
}
__device__ __forceinline__ float rope_lane(float x, int lane, const float* cs) {
    const float xp = __shfl(x, lane ^ 8);
    if (lane < 8) return x * cs[lane] - xp * cs[8 + lane];
    if (lane < 16) return x * cs[lane - 8] + xp * cs[lane];
    return x;
}
__device__ __forceinline__ void ph_attn_naive(const Args& a, Frame& F, int l) {
    const bf16_t* P = (const bf16_t*)(F.ws + WS_PROJ); bf16_t* Y = (bf16_t*)(F.ws + WS_YMIX); const float* CS = (const float*)(F.ws + WS_CS);
    for (int task = F.gw; task < T * 8; task += F.ngw) {
        const int t = task >> 3, hq = task & 7, hk = hq >> 2, s = t % SEQ;
        float q = bf2f(P[(size_t)t * NP + C_AQ + hq * 64 + F.lane]);
        if (!ATTN_MFMA) q = rope_lane(q, F.lane, CS + (size_t)t * 16);
        float sc0 = -INFINITY, sc1 = -INFINITY;
        for (int j = 0; j < WINDOW; ++j) {
            const int sp = s - (WINDOW - 1) + j;
            if (sp < 0) continue;
            const size_t tk = (size_t)t - (WINDOW - 1) + j;
            float k = bf2f(P[tk * NP + C_AK + hk * 64 + F.lane]);
            if (!ATTN_MFMA) k = rope_lane(k, F.lane, CS + tk * 16);
            const float sc = wave_sum(q * k) * 0.125f;
            if (F.lane == (j & 63)) { if (j < 64) sc0 = sc; else sc1 = sc; }
        }
        const float sink = a.sinks[l * 8 + hq];
        const float m = fmaxf(wave_max(fmaxf(sc0, sc1)), sink);
        const float p0 = __expf(sc0 - m), p1 = __expf(sc1 - m);
        const float den = wave_sum(p0 + p1) + __expf(sink - m);
        float o = 0.f;
        for (int j = 0; j < WINDOW; ++j) {
            const int sp = s - (WINDOW - 1) + j;
            if (sp < 0) continue;
            const size_t tk = (size_t)t - (WINDOW - 1) + j;
            const float p = __shfl(j < 64 ? p0 : p1, j & 63);
            o += p * bf2f(P[tk * NP + C_AV + hk * 64 + F.lane]);
        }
        Y[(size_t)t * D + hq * 64 + F.lane] = (bf16_t)f2bf(o / den);
    }
}

typedef float f32x16 __attribute__((ext_vector_type(16)));
typedef short s16x4 __attribute__((ext_vector_type(4)));
typedef short bf16x8_t __attribute__((ext_vector_type(8)));
__device__ __forceinline__ unsigned cvtpk(float lo, float hi) { typedef float f2_t __attribute__((ext_vector_type(2))); typedef __bf16 b2_t __attribute__((ext_vector_type(2)));
    f2_t v = {lo, hi}; b2_t b = __builtin_convertvector(v, b2_t); return __builtin_bit_cast(unsigned, b); }
__device__ __forceinline__ void ph_rope(const Args& a, Frame& F) {
    bf16_t* P = (bf16_t*)(F.ws + WS_PROJ); const float* CS = (const float*)(F.ws + WS_CS);
    for (int it = F.bid * NTHREADS + F.tid; it < T * 10; it += F.nb * NTHREADS) {
        const int t = it / 10, hh = it % 10;
        bf16_t* p = P + (size_t)t * NP + hh * 64;
        const u32x4 x1 = *(const u32x4*)p, x2 = *(const u32x4*)(p + 8);
        const f32x4 c0 = *(const f32x4*)(CS + (size_t)t * 16), c1 = *(const f32x4*)(CS + (size_t)t * 16 + 4), s0 = *(const f32x4*)(CS + (size_t)t * 16 + 8), s1 = *(const f32x4*)(CS + (size_t)t * 16 + 12);
        const float cs[8] = {c0.x, c0.y, c0.z, c0.w, c1.x, c1.y, c1.z, c1.w}, sn[8] = {s0.x, s0.y, s0.z, s0.w, s1.x, s1.y, s1.z, s1.w};
        const unsigned xa[4] = {x1.x, x1.y, x1.z, x1.w}, xb[4] = {x2.x, x2.y, x2.z, x2.w};
        unsigned ra[4], rb[4];
#pragma unroll
        for (int i = 0; i < 4; ++i) {
            const float a0 = bf2f(xa[i] & 0xffffu), a1 = bf2f(xa[i] >> 16), b0 = bf2f(xb[i] & 0xffffu), b1 = bf2f(xb[i] >> 16);
            ra[i] = pk2(a0 * cs[2 * i] - b0 * sn[2 * i], a1 * cs[2 * i + 1] - b1 * sn[2 * i + 1]);
            rb[i] = pk2(b0 * cs[2 * i] + a0 * sn[2 * i], b1 * cs[2 * i + 1] + a1 * sn[2 * i + 1]);
        }
        *(u32x4*)p = (u32x4){ra[0], ra[1], ra[2], ra[3]}; *(u32x4*)(p + 8) = (u32x4){rb[0], rb[1], rb[2], rb[3]};
    }
}
constexpr int AT_KROW = 144, AT_VOFF = 256 * AT_KROW;
__device__ __forceinline__ void ph_attn_mfma(const Args& a, Frame& F, int l) {
    const bf16_t* P = (const bf16_t*)(F.ws + WS_PROJ); bf16_t* Y = (bf16_t*)(F.ws + WS_YMIX);
    LAS unsigned char* Kl = F.lds; LAS unsigned char* Vl = F.lds + AT_VOFF;
    const int lane = F.lane, r = lane & 31, h = lane >> 5, g = F.wave >> 1, qh = F.wave & 1;
    const int i16 = lane & 15, tq_ = i16 >> 2, tp_ = i16 & 3, g16 = (lane >> 4) & 1, sw = (tq_ >> 1) & 1;
    const int vlane = (4 * h + tq_) * 128 + (2 * g16 + (tp_ >> 1)) * 16 + (tp_ & 1) * 8;
    const float C = 0.125f * 1.4426950408889634f;
    const int nsc = NSCAN;
    if (F.bid < nsc) return;
    for (int u = F.bid - nsc; u < BATCH * 128 * 2; u += F.nb - nsc) {
        const int hk = u & 1, n = (u >> 1) & 127, b = u >> 8;
        const int tq0 = b * SEQ + n * 128, tk0 = tq0 - 128;
        __syncthreads();
#pragma unroll
        for (int i = 0; i < 4; ++i) {
            const int piece = F.tid + NTHREADS * i, key = piece >> 3, c = piece & 7;
            u32x4 kv = (u32x4){0u, 0u, 0u, 0u}, vv = kv;
            if (n > 0 || key >= 128) { const bf16_t* rowp = P + (size_t)(tk0 + key) * NP; kv = *(const u32x4*)(rowp + C_AK + hk * 64 + c * 8); vv = *(const u32x4*)(rowp + C_AV + hk * 64 + c * 8); }
            *(LAS u32x4*)(Kl + key * AT_KROW + c * 16) = kv;
            *(LAS u32x4*)(Vl + key * 128 + ((c ^ (((key >> 1) & 1) << 2)) * 16)) = vv;
        }
        __syncthreads();
        const int hq = hk * 4 + g;
        const float sinkl = a.sinks[l * 8 + hq] * 1.4426950408889634f;
#pragma unroll 1
        for (int sb = 0; sb < 2; ++sb) {
            const int q0 = qh * 64 + sb * 32, kt0 = qh * 2 + sb;
            const size_t tq = (size_t)(tq0 + q0 + r);
            bf16x8_t qf[4];
#pragma unroll
            for (int ks = 0; ks < 4; ++ks) qf[ks] = *(const bf16x8_t*)(P + tq * NP + hq * 64 + 16 * ks + 8 * h);
            f32x16 S[5];
#pragma unroll
            for (int kr = 0; kr < 5; ++kr) {
                f32x16 acc;
#pragma unroll
                for (int i = 0; i < 16; ++i) acc[i] = 0.f;
#pragma unroll
                for (int ks = 0; ks < 4; ++ks) { const bf16x8_t kf = *(const LAS bf16x8_t*)(Kl + (32 * (kt0 + kr) + r) * AT_KROW + (16 * ks + 8 * h) * 2);
                    acc = __builtin_amdgcn_mfma_f32_32x32x16_bf16(kf, qf[ks], acc, 0, 0, 0); }
                S[kr] = acc;
            }
            float m = sinkl;
#pragma unroll
            for (int kr = 0; kr < 5; ++kr) {
                const bool tile_ok = !(n == 0 && (kt0 + kr) < 4);
#pragma unroll
                for (int i = 0; i < 16; ++i) {
                    const int kl = (i & 3) + 8 * (i >> 2) + 4 * h;
                    bool ok = tile_ok; if (kr == 0) ok = ok && (kl > r); if (kr == 4) ok = ok && (kl <= r);
                    const float sv = ok ? S[kr][i] * C : -INFINITY; S[kr][i] = sv; m = fmaxf(m, sv);
                }
            }
            m = fmaxf(m, __shfl_xor(m, 32));
            float lsum = 0.f;
#pragma unroll
            for (int kr = 0; kr < 5; ++kr)
#pragma unroll
                for (int i = 0; i < 16; ++i) { const float p = __builtin_amdgcn_exp2f(S[kr][i] - m); S[kr][i] = p; lsum += p; }
            lsum += __shfl_xor(lsum, 32); lsum += __builtin_amdgcn_exp2f(sinkl - m);
            f32x16 O0, O1;
#pragma unroll
            for (int i = 0; i < 16; ++i) { O0[i] = 0.f; O1[i] = 0.f; }
#pragma unroll
            for (int kr = 0; kr < 5; ++kr) {
#pragma unroll
                for (int s2 = 0; s2 < 2; ++s2) {
                    u32x4 pw; pw.x = cvtpk(S[kr][8 * s2 + 0], S[kr][8 * s2 + 1]); pw.y = cvtpk(S[kr][8 * s2 + 2], S[kr][8 * s2 + 3]); pw.z = cvtpk(S[kr][8 * s2 + 4], S[kr][8 * s2 + 5]); pw.w = cvtpk(S[kr][8 * s2 + 6], S[kr][8 * s2 + 7]);
                    const bf16x8_t pf = __builtin_bit_cast(bf16x8_t, pw);
                    const int kb = (32 * (kt0 + kr) + 16 * s2) * 128 + vlane;
                    const s16x4 lo0 = __builtin_amdgcn_ds_read_tr16_b64_v4i16((LAS s16x4*)(Vl + kb + (0 ^ sw) * 64));
                    const s16x4 hi0 = __builtin_amdgcn_ds_read_tr16_b64_v4i16((LAS s16x4*)(Vl + kb + 8 * 128 + (0 ^ sw) * 64));
                    const s16x4 lo1 = __builtin_amdgcn_ds_read_tr16_b64_v4i16((LAS s16x4*)(Vl + kb + (1 ^ sw) * 64));
                    const s16x4 hi1 = __builtin_amdgcn_ds_read_tr16_b64_v4i16((LAS s16x4*)(Vl + kb + 8 * 128 + (1 ^ sw) * 64));
                    const bf16x8_t va0 = __builtin_shufflevector(lo0, hi0, 0, 1, 2, 3, 4, 5, 6, 7), va1 = __builtin_shufflevector(lo1, hi1, 0, 1, 2, 3, 4, 5, 6, 7);
                    O0 = __builtin_amdgcn_mfma_f32_32x32x16_bf16(va0, pf, O0, 0, 0, 0);
                    O1 = __builtin_amdgcn_mfma_f32_32x32x16_bf16(va1, pf, O1, 0, 0, 0);
                }
            }
            const float inv = __builtin_amdgcn_rcpf(lsum);
            bf16_t* yp = Y + tq * D + hq * 64 + 4 * h;
#pragma unroll
            for (int gq = 0; gq < 4; ++gq) {
                u32x2 o0; o0.x = cvtpk(O0[4 * gq] * inv, O0[4 * gq + 1] * inv); o0.y = cvtpk(O0[4 * gq + 2] * inv, O0[4 * gq + 3] * inv);
                u32x2 o1; o1.x = cvtpk(O1[4 * gq] * inv, O1[4 * gq + 1] * inv); o1.y = cvtpk(O1[4 * gq + 2] * inv, O1[4 * gq + 3] * inv);
                *(u32x2*)(yp + 8 * gq) = o0; *(u32x2*)(yp + 32 + 8 * gq) = o1;
            }
        }
    }
    __syncthreads();
}


constexpr size_t WS_DN_MR = 360 * MiB, WS_DN_BNT = 376 * MiB, WS_DN_QP = 392 * MiB, WS_DN_OLT = 408 * MiB, WS_DN_ST = 424 * MiB;
constexpr int DL = 72, LB = 9216;
constexpr int L_KR = 0, L_KT = LB, L_QR = 2 * LB, L_VT = 3 * LB, L_AR = 4 * LB, L_T1 = 5 * LB, L_T2 = 6 * LB, L_UT = 7 * LB, L_UPT = 8 * LB, L_WPT = 9 * LB, L_WT = 0;
constexpr int L_LR = 7 * LB, L_L21 = L_LR + 17408, L_T11T = L_L21 + 4608, L_T22R = L_T11T + 4608, L_YT = L_T22R + 4608, L_GC = 100352, L_BETA = L_GC + 256;
static_assert(L_YT + 4608 == L_GC && L_GC + 512 <= 131072, "DeltaNet LDS map");
template <int KS> __device__ __forceinline__ f32x4 mm16(const LAS unsigned char* lds, int offX, int offY, int tx, int ty, int lane) {
    f32x4 acc = (f32x4){0.f, 0.f, 0.f, 0.f};
    const int l15 = lane & 15, q = lane >> 4;
#pragma unroll
    for (int ks = 0; ks < KS; ++ks) {
        const bf16x8_t xa = *(const LAS bf16x8_t*)(lds + offX + ((16 * tx + l15) * DL + 32 * ks + 8 * q) * 2);
        const bf16x8_t yb = *(const LAS bf16x8_t*)(lds + offY + ((16 * ty + l15) * DL + 32 * ks + 8 * q) * 2);
        acc = __builtin_amdgcn_mfma_f32_16x16x32_bf16(xa, yb, acc, 0, 0, 0);
    }
    return acc;
}
__device__ __forceinline__ u32x2 pack4(f32x4 v) { u32x2 o; o.x = cvtpk(v.x, v.y); o.y = cvtpk(v.z, v.w); return o; }

__device__ __forceinline__ void ph_dn_chunk(const Args& a, Frame& F, int l) {
    const bf16_t* P = (const bf16_t*)(F.ws + WS_PROJ); const float* BG = (const float*)(F.ws + WS_BG);
    bf16_t* MR = (bf16_t*)(F.ws + WS_DN_MR); bf16_t* BNT = (bf16_t*)(F.ws + WS_DN_BNT); bf16_t* QP = (bf16_t*)(F.ws + WS_DN_QP); bf16_t* OLT = (bf16_t*)(F.ws + WS_DN_OLT);
    LAS unsigned char* lds = F.lds;
    LAS float* gcL = (LAS float*)(lds + L_GC); LAS float* betaL = (LAS float*)(lds + L_BETA);
    const float* cw = a.dn_conv_w + (size_t)l * DN_CONV * 768;
    const int lane = F.lane, w = F.wave, l15 = lane & 15, q4 = lane >> 4;
    for (int unit = F.bid; unit < BATCH * 4 * 256; unit += F.nb) {
        const int n = unit & 255, h = (unit >> 8) & 3, b = unit >> 10;
        const int t0 = b * SEQ + n * 64;
        __syncthreads();
        REP(16384) {
            const int i = F.tid >> 3, c8 = F.tid & 7, t = t0 + i, sq = n * 64 + i;
#pragma unroll
            for (int kd = 0; kd < 3; ++kd) {
                const int cb = kd * 256 + h * 64 + c8 * 8;
                float acc[8];
#pragma unroll
                for (int e = 0; e < 8; ++e) acc[e] = 0.f;
#pragma unroll
                for (int k = 0; k < DN_CONV; ++k) {
                    if (sq - (DN_CONV - 1) + k >= 0) {
                        const u32x4 xv = *(const u32x4*)(P + (size_t)(t - (DN_CONV - 1) + k) * NP + C_DQ + cb);
                        const f32x4 w0 = *(const f32x4*)(cw + k * 768 + cb), w1 = *(const f32x4*)(cw + k * 768 + cb + 4);
                        acc[0] += w0.x * bf2f(xv.x & 0xffffu); acc[1] += w0.y * bf2f(xv.x >> 16); acc[2] += w0.z * bf2f(xv.y & 0xffffu); acc[3] += w0.w * bf2f(xv.y >> 16);
                        acc[4] += w1.x * bf2f(xv.z & 0xffffu); acc[5] += w1.y * bf2f(xv.z >> 16); acc[6] += w1.z * bf2f(xv.w & 0xffffu); acc[7] += w1.w * bf2f(xv.w >> 16);
                    }
                }
                float ss = 0.f;
#pragma unroll
                for (int e = 0; e < 8; ++e) { acc[e] = siluf_(acc[e]); ss += acc[e] * acc[e]; }
                if (kd < 2) {
                    ss += __shfl_xor(ss, 1); ss += __shfl_xor(ss, 2); ss += __shfl_xor(ss, 4);
                    const float rn = rsqrtf(ss + EPS) * (kd == 0 ? 0.125f : 1.0f);
#pragma unroll
                    for (int e = 0; e < 8; ++e) acc[e] *= rn;
                }
                u32x4 pk; pk.x = cvtpk(acc[0], acc[1]); pk.y = cvtpk(acc[2], acc[3]); pk.z = cvtpk(acc[4], acc[5]); pk.w = cvtpk(acc[6], acc[7]);
                if (kd == 0) *(LAS u32x4*)(lds + L_QR + (i * DL + c8 * 8) * 2) = pk;
                if (kd == 1) *(LAS u32x4*)(lds + L_KR + (i * DL + c8 * 8) * 2) = pk;
                if (kd >= 1) {
                    LAS bf16_t* Tt = (LAS bf16_t*)(lds + (kd == 1 ? L_KT : L_VT));
                    const unsigned pw[4] = {pk.x, pk.y, pk.z, pk.w};
#pragma unroll
                    for (int e = 0; e < 8; ++e) Tt[(c8 * 8 + e) * DL + i] = (bf16_t)((pw[e >> 1] >> (16 * (e & 1))) & 0xffffu);
                }
            }
            for (int idx = F.tid; idx < 2 * LB / 16; idx += NTHREADS) *(LAS u32x4*)(lds + L_T1 + idx * 16) = (u32x4){0u, 0u, 0u, 0u};
            if (w == 0) {
                const float be = BG[(size_t)(t0 + lane) * 8 + h]; float x = BG[(size_t)(t0 + lane) * 8 + 4 + h];
#pragma unroll
                for (int o = 1; o < 64; o <<= 1) { const float y = __shfl_up(x, o); if (lane >= o) x += y; }
                gcL[lane] = x; betaL[lane] = be;
            }
        }
        __syncthreads();
#pragma unroll
        for (int tt = 0; tt < 2; ++tt) {
            const int tidx = 2 * w + tt, tx = tidx >> 2, ty = tidx & 3, i = 16 * ty + l15, j0 = 16 * tx + 4 * q4;
            const float gi = gcL[i], bi = betaL[i]; const f32x4 gj = *(const LAS f32x4*)(gcL + j0);
            const float gjv[4] = {gj.x, gj.y, gj.z, gj.w};
            const f32x4 zk = mm16<2>(lds, L_KR, L_KR, tx, ty, lane);
            const f32x4 zq = mm16<2>(lds, L_KR, L_QR, tx, ty, lane);
            f32x4 lv, av;
#pragma unroll
            for (int r = 0; r < 4; ++r) { const float dc = __expf(fminf(gi - gjv[r], 0.f)); lv[r] = (j0 + r < i) ? bi * zk[r] * dc : 0.f; av[r] = (j0 + r <= i) ? zq[r] * dc : 0.f; }
            *(LAS f32x4*)(lds + L_LR + (i * 68 + j0) * 4) = lv;
            if (i >= 32 && j0 < 32) *(LAS u32x2*)(lds + L_L21 + ((i - 32) * DL + j0) * 2) = pack4(lv);
            *(LAS u32x2*)(lds + L_AR + (i * DL + j0) * 2) = pack4(av);
        }
        __syncthreads();
        REP(32768) {
            const int cg = 8 * w + (lane >> 3), blk = cg >> 5, jp = cg & 31, l8 = lane & 7;
            const LAS float* Lb = (const LAS float*)(lds + L_LR) + (32 * blk) * 68 + 32 * blk + 4 * l8;
            float x0 = 0.f, x1 = 0.f, x2 = 0.f, x3 = 0.f;
#pragma unroll
            for (int i = 0; i < 32; ++i) {
                const f32x4 l4 = *(const LAS f32x4*)(Lb + i * 68);
                float part = (l4.x * x0 + l4.y * x1) + (l4.z * x2 + l4.w * x3);
                part += __shfl_xor(part, 1); part += __shfl_xor(part, 2); part += __shfl_xor(part, 4);
                const float xi = ((i == jp) ? 1.f : 0.f) - part;
                if (l8 == (i >> 2)) { if ((i & 3) == 0) x0 = xi; else if ((i & 3) == 1) x1 = xi; else if ((i & 3) == 2) x2 = xi; else x3 = xi; }
            }
            const int jg = 32 * blk + jp; const float bj = betaL[jg], bej = bj * __expf(gcL[jg]);
            LAS bf16_t* T1 = (LAS bf16_t*)(lds + L_T1); LAS bf16_t* T2 = (LAS bf16_t*)(lds + L_T2);
            const float xs[4] = {x0, x1, x2, x3};
#pragma unroll
            for (int e = 0; e < 4; ++e) { const int rg = 32 * blk + 4 * l8 + e; T1[rg * DL + jg] = (bf16_t)f2bf(xs[e] * bj); T2[rg * DL + jg] = (bf16_t)f2bf(xs[e] * bej); }
            if (blk == 0) { *(LAS u32x2*)(lds + L_T11T + (jp * DL + 4 * l8) * 2) = pack4((f32x4){x0, x1, x2, x3}); }
            else { LAS bf16_t* T22 = (LAS bf16_t*)(lds + L_T22R);
#pragma unroll
                for (int e = 0; e < 4; ++e) T22[(4 * l8 + e) * DL + jp] = (bf16_t)f2bf(xs[e]); }
        }
        __syncthreads();
        if (w < 4) {
            const int tx = w >> 1, ty = w & 1;
            const f32x4 z = mm16<1>(lds, L_L21, L_T11T, tx, ty, lane);
            *(LAS u32x2*)(lds + L_YT + ((16 * ty + l15) * DL + 16 * tx + 4 * q4) * 2) = pack4(z);
        }
        __syncthreads();
        if (w < 4) {
            const int tx = w >> 1, ty = w & 1, y = 16 * ty + l15, x0 = 16 * tx + 4 * q4;
            const f32x4 z = mm16<1>(lds, L_T22R, L_YT, tx, ty, lane);
            const float bj = betaL[y], bej = bj * __expf(gcL[y]);
            LAS bf16_t* T1 = (LAS bf16_t*)(lds + L_T1); LAS bf16_t* T2 = (LAS bf16_t*)(lds + L_T2);
#pragma unroll
            for (int r = 0; r < 4; ++r) { T1[(32 + x0 + r) * DL + y] = (bf16_t)f2bf(-z[r] * bj); T2[(32 + x0 + r) * DL + y] = (bf16_t)f2bf(-z[r] * bej); }
        }
        __syncthreads();
        const float gl = gcL[63];
#pragma unroll
        for (int tt = 0; tt < 2; ++tt) {
            const int tidx = 2 * w + tt, tx = tidx >> 2, ty = tidx & 3, y = 16 * ty + l15, x0 = 16 * tx + 4 * q4;
            const f32x4 gx = *(const LAS f32x4*)(gcL + x0);
            f32x4 sc; sc.x = __expf(gl - gx.x); sc.y = __expf(gl - gx.y); sc.z = __expf(gl - gx.z); sc.w = __expf(gl - gx.w);
            const f32x4 zu = mm16<2>(lds, L_T1, L_VT, tx, ty, lane);
            const f32x4 zw = mm16<2>(lds, L_T2, L_KT, tx, ty, lane);
            *(LAS u32x2*)(lds + L_UT + (y * DL + x0) * 2) = pack4(zu); *(LAS u32x2*)(lds + L_UPT + (y * DL + x0) * 2) = pack4(zu * sc);
            *(LAS u32x2*)(lds + L_WT + (y * DL + x0) * 2) = pack4(zw); *(LAS u32x2*)(lds + L_WPT + (y * DL + x0) * 2) = pack4(zw * sc);
        }
        __syncthreads();
        REP(65536) {
            const size_t cho = (size_t)unit * 4096;
            const float egl = __expf(gl);
#pragma unroll
            for (int tt = 0; tt < 2; ++tt) {
                const int tidx = 2 * w + tt, tx = tidx >> 2, ty = tidx & 3, y = 16 * ty + l15, x0 = 16 * tx + 4 * q4;
                f32x4 zm = mm16<2>(lds, L_WPT, L_KT, tx, ty, lane);
#pragma unroll
                for (int r = 0; r < 4; ++r) zm[r] = ((x0 + r) == y ? egl : 0.f) - zm[r];
                *(u32x2*)(MR + cho + (ty * 2 + (tx >> 1)) * 512 + lane * 8 + 4 * (tx & 1)) = pack4(zm);
                const f32x4 zb = mm16<2>(lds, L_KT, L_UPT, tx, ty, lane);
                *(u32x2*)(BNT + cho + (ty * 4 + tx) * 256 + lane * 4) = pack4(zb);
                const f32x4 zq = mm16<2>(lds, L_WT, L_AR, tx, ty, lane);
                const u32x2 qv = *(const LAS u32x2*)(lds + L_QR + (y * DL + x0) * 2); const float eg = __expf(gcL[y]);
                f32x4 qp; qp.x = bf2f(qv.x & 0xffffu) * eg - zq.x; qp.y = bf2f(qv.x >> 16) * eg - zq.y; qp.z = bf2f(qv.y & 0xffffu) * eg - zq.z; qp.w = bf2f(qv.y >> 16) * eg - zq.w;
                *(u32x2*)(QP + cho + y * 64 + x0) = pack4(qp);
                const f32x4 zo = mm16<2>(lds, L_AR, L_UT, tx, ty, lane);
                *(u32x2*)(OLT + cho + y * 64 + x0) = pack4(zo);
            }
        }
    }
    __syncthreads();
}
constexpr int SC_SLOT = 10240, SC_DEPTH = 12, SC_AHEAD = 11;
__device__ __forceinline__ void ph_dn_scan(const Args& a, Frame& F) {
    if (F.bid >= NSCAN) return;
    const unsigned char* MRb = (const unsigned char*)(F.ws + WS_DN_MR); const unsigned char* BNb = (const unsigned char*)(F.ws + WS_DN_BNT); bf16_t* ST = (bf16_t*)(F.ws + WS_DN_ST);
    const int lane = F.lane, l15 = lane & 15, q4 = lane >> 4, wq = F.bid & 3;
    const size_t ch0 = (size_t)(F.bid >> 2) * 256;
    LAS unsigned char* lds = F.lds;
    __syncthreads();
    if (F.wave >= 3) {
        const int lw = F.wave - 3;
#define DN_ISSUE(nn) do { const size_t chb_ = (ch0 + (size_t)((nn) < 255 ? (nn) : 255)) * 8192; const int slot_ = ((nn) % SC_DEPTH) * SC_SLOT; \
        _Pragma("unroll") for (int p_ = 0; p_ < 2; ++p_) { const int piece_ = lw * 2 + p_; \
            const unsigned char* src_ = (piece_ < 8 ? MRb + chb_ + piece_ * 1024 : BNb + chb_ + wq * 2048 + (piece_ - 8) * 1024) + lane * 16; \
            __builtin_amdgcn_global_load_lds((const unsigned*)src_, (LAS unsigned*)(lds + slot_ + piece_ * 1024), 16, 0, 0); } } while (0)
        for (int n = 0; n < SC_AHEAD; ++n) DN_ISSUE(n);
        for (int n = 0; n < 256; ++n) {
            asm volatile("s_waitcnt vmcnt(20)" ::: "memory");
            __builtin_amdgcn_s_barrier();
            DN_ISSUE(n + SC_AHEAD);
        }
        asm volatile("s_waitcnt vmcnt(0)" ::: "memory");
#undef DN_ISSUE
    } else if (F.wave == 0) {
        const int dv = 16 * wq + l15;
        f32x4 S[4];
#pragma unroll
        for (int ti = 0; ti < 4; ++ti) S[ti] = (f32x4){0.f, 0.f, 0.f, 0.f};
        for (int n = 0; n < 256; ++n) {
            __builtin_amdgcn_s_barrier();
            const LAS unsigned char* slot = lds + (n % SC_DEPTH) * SC_SLOT;
            bf16x8_t A[4][2]; u32x2 Bc[4];
#pragma unroll
            for (int ti = 0; ti < 4; ++ti) {
#pragma unroll
                for (int ks = 0; ks < 2; ++ks) A[ti][ks] = *(const LAS bf16x8_t*)(slot + (ti * 2 + ks) * 1024 + lane * 16);
                Bc[ti] = *(const LAS u32x2*)(slot + 8192 + ti * 512 + lane * 8);
            }
            u32x2 sp[4];
#pragma unroll
            for (int ti = 0; ti < 4; ++ti) { sp[ti] = pack4(S[ti]); *(u32x2*)(ST + (ch0 + n) * 4096 + dv * 64 + 16 * ti + 4 * q4) = sp[ti]; }
            const bf16x8_t b0 = __builtin_bit_cast(bf16x8_t, (u32x4){sp[0].x, sp[0].y, sp[1].x, sp[1].y});
            const bf16x8_t b1 = __builtin_bit_cast(bf16x8_t, (u32x4){sp[2].x, sp[2].y, sp[3].x, sp[3].y});
#pragma unroll
            for (int ti = 0; ti < 4; ++ti) {
                f32x4 c; c.x = bf2f(Bc[ti].x & 0xffffu); c.y = bf2f(Bc[ti].x >> 16); c.z = bf2f(Bc[ti].y & 0xffffu); c.w = bf2f(Bc[ti].y >> 16);
                c = __builtin_amdgcn_mfma_f32_16x16x32_bf16(A[ti][0], b0, c, 0, 0, 0);
                c = __builtin_amdgcn_mfma_f32_16x16x32_bf16(A[ti][1], b1, c, 0, 0, 0);
                S[ti] = c;
            }
            asm volatile("s_waitcnt lgkmcnt(0)" ::: "memory");
        }
    } else {
        for (int n = 0; n < 256; ++n) __builtin_amdgcn_s_barrier();
    }
    __syncthreads();
}
__device__ __forceinline__ void ph_dn_out(const Args& a, Frame& F, int l) {
    const bf16_t* QP = (const bf16_t*)(F.ws + WS_DN_QP); const bf16_t* OLT = (const bf16_t*)(F.ws + WS_DN_OLT); const bf16_t* ST = (const bf16_t*)(F.ws + WS_DN_ST);
    const bf16_t* P = (const bf16_t*)(F.ws + WS_PROJ); bf16_t* Y = (bf16_t*)(F.ws + WS_YMIX);
    const int lane = F.lane, l15 = lane & 15, q4 = lane >> 4, ti = F.wave & 3;
    for (int pr = F.bid; pr < 1024; pr += F.nb) {
        const int unit = 2 * pr + (F.wave >> 2), n = unit & 255, h = (unit >> 8) & 3, b = unit >> 10;
        const size_t cho = (size_t)unit * 4096;
        bf16x8_t af[2];
#pragma unroll
        for (int ks = 0; ks < 2; ++ks) af[ks] = *(const bf16x8_t*)(QP + cho + (16 * ti + l15) * 64 + 32 * ks + 8 * q4);
        f32x4 acc[4];
#pragma unroll
        for (int tj = 0; tj < 4; ++tj) {
            const u32x2 ov = *(const u32x2*)(OLT + cho + (16 * tj + l15) * 64 + 16 * ti + 4 * q4);
            f32x4 c; c.x = bf2f(ov.x & 0xffffu); c.y = bf2f(ov.x >> 16); c.z = bf2f(ov.y & 0xffffu); c.w = bf2f(ov.y >> 16);
#pragma unroll
            for (int ks = 0; ks < 2; ++ks) { const bf16x8_t bfv = *(const bf16x8_t*)(ST + cho + (16 * tj + l15) * 64 + 32 * ks + 8 * q4); c = __builtin_amdgcn_mfma_f32_16x16x32_bf16(af[ks], bfv, c, 0, 0, 0); }
            acc[tj] = c;
        }
        f32x4 ss = acc[0] * acc[0] + acc[1] * acc[1] + acc[2] * acc[2] + acc[3] * acc[3];
#pragma unroll
        for (int o = 1; o < 16; o <<= 1) { ss.x += __shfl_xor(ss.x, o); ss.y += __shfl_xor(ss.y, o); ss.z += __shfl_xor(ss.z, o); ss.w += __shfl_xor(ss.w, o); }
        const float rs[4] = {rsqrtf(ss.x * (1.f / 64.f) + EPS), rsqrtf(ss.y * (1.f / 64.f) + EPS), rsqrtf(ss.z * (1.f / 64.f) + EPS), rsqrtf(ss.w * (1.f / 64.f) + EPS)};
        const size_t trow0 = (size_t)b * SEQ + n * 64 + 16 * ti + 4 * q4;
#pragma unroll
        for (int tj = 0; tj < 4; ++tj) {
            const int dvv = 16 * tj + l15; const float gn = a.dn_norm_g[l * 64 + dvv];
#pragma unroll
            for (int r = 0; r < 4; ++r) {
                const size_t t = trow0 + r;
                const float z = bf2f(P[t * NP + C_DZ + h * 64 + dvv]);
                Y[t * D + 512 + h * 64 + dvv] = (bf16_t)f2bf(acc[tj][r] * rs[r] * gn * siluf_(z));
            }
        }
    }
}

__device__ __forceinline__ void ph_conv_naive(const Args& a, Frame& F, int l) {
    const bf16_t* P = (const bf16_t*)(F.ws + WS_PROJ); bf16_t* Y = (bf16_t*)(F.ws + WS_YMIX);
    const float* w = a.cv_dw_w + (size_t)l * CV_K * CV_C;
    for (int t = F.gw; t < T; t += F.ngw) {
        const int s = t % SEQ, c0 = 4 * F.lane;
        f32x4 acc = *(const f32x4*)(a.cv_dw_b + l * CV_C + c0);
        for (int k = 0; k < CV_K; ++k) {
            const int sp = s - (CV_K - 1) + k;
            if (sp < 0) continue;
            const size_t tk = (size_t)t - (CV_K - 1) + k;
            const u32x2 ca = *(const u32x2*)(P + tk * NP + C_CA + c0), cb = *(const u32x2*)(P + tk * NP + C_CB + c0);
            const f32x4 w4 = *(const f32x4*)(w + k * CV_C + c0);
            acc.x += w4.x * (bf2f(ca.x & 0xffffu) * sigmoidf_(bf2f(cb.x & 0xffffu)));
            acc.y += w4.y * (bf2f(ca.x >> 16) * sigmoidf_(bf2f(cb.x >> 16)));
            acc.z += w4.z * (bf2f(ca.y & 0xffffu) * sigmoidf_(bf2f(cb.y & 0xffffu)));
            acc.w += w4.w * (bf2f(ca.y >> 16) * sigmoidf_(bf2f(cb.y >> 16)));
        }
        const float mean = wave_sum((acc.x + acc.y) + (acc.z + acc.w)) * (1.0f / CV_C);
        const f32x4 dv = acc - mean;
        const float var = wave_sum((dv.x * dv.x + dv.y * dv.y) + (dv.z * dv.z + dv.w * dv.w)) * (1.0f / CV_C);
        const float rstd = rsqrtf(var + EPS);
        const f32x4 g4 = *(const f32x4*)(a.cv_ln_g + l * CV_C + c0), b4 = *(const f32x4*)(a.cv_ln_b + l * CV_C + c0);
        const f32x4 y = (dv * rstd) * g4 + b4;
        u32x2 o; o.x = pk2(siluf_(y.x), siluf_(y.y)); o.y = pk2(siluf_(y.z), siluf_(y.w));
        *(u32x2*)(Y + (size_t)t * D + 768 + c0) = o;
    }
}

__device__ __forceinline__ void ph_conv_fast(const Args& a, Frame& F, int l) {
    const bf16_t* P = (const bf16_t*)(F.ws + WS_PROJ); bf16_t* Y = (bf16_t*)(F.ws + WS_YMIX);
    LAS float* OUTL = (LAS float*)F.lds;
    const int c = F.tid & 255, rsel = F.tid >> 8;
    float wk[CV_K];
#pragma unroll
    for (int k = 0; k < CV_K; ++k) wk[k] = a.cv_dw_w[((size_t)l * CV_K + k) * CV_C + c];
    const float bias = a.cv_dw_b[l * CV_C + c];
    const int nsc = NSCAN;
    if (F.bid < nsc) return;
    for (int pr = (F.bid - nsc + (F.nb - nsc) / 2) % (F.nb - nsc); pr < T / 128; pr += F.nb - nsc) {
        const int run = 2 * pr + rsel, t0 = run * 64, s0 = t0 % SEQ;
        __syncthreads();
        float win[CV_K];
#pragma unroll
        for (int k = 0; k < CV_K; ++k) win[k] = 0.f;
        for (int cbase = 0; cbase < 94; cbase += CV_K) {
#pragma unroll
            for (int p = 0; p < CV_K; ++p) {
                const int ti = cbase + p;
                if (ti < 94) {
                    float u = 0.f;
                    if (s0 - 30 + ti >= 0) { const size_t tk = (size_t)(t0 - 30 + ti); const float ca = bf2f(P[tk * NP + C_CA + c]), cb = bf2f(P[tk * NP + C_CB + c]); u = ca * sigmoidf_(cb); }
                    win[p] = u;
                    if (ti >= 30) {
                        float acc = bias;
#pragma unroll
                        for (int k = 0; k < CV_K; ++k) acc += wk[k] * win[(p + 1 + k) % CV_K];
                        OUTL[(rsel * 64 + (ti - 30)) * 256 + c] = acc;
                    }
                }
            }
        }
        __syncthreads();
        const f32x4 g4 = *(const f32x4*)(a.cv_ln_g + l * CV_C + 4 * F.lane), b4 = *(const f32x4*)(a.cv_ln_b + l * CV_C + 4 * F.lane);
        for (int j = 0; j < 16; ++j) {
            const int tl = F.wave * 16 + j;
            const f32x4 v = *(const LAS f32x4*)(OUTL + tl * 256 + 4 * F.lane);
            const float mean = wave_sum((v.x + v.y) + (v.z + v.w)) * (1.0f / CV_C);
            const f32x4 dv = v - mean;
            const float var = wave_sum((dv.x * dv.x + dv.y * dv.y) + (dv.z * dv.z + dv.w * dv.w)) * (1.0f / CV_C);
            const float rstd = rsqrtf(var + EPS);
            const f32x4 y = (dv * rstd) * g4 + b4;
            u32x2 o; o.x = cvtpk(siluf_(y.x), siluf_(y.y)); o.y = cvtpk(siluf_(y.z), siluf_(y.w));
            *(u32x2*)(Y + (size_t)(pr * 128 + tl) * D + 768 + 4 * F.lane) = o;
        }
    }
    __syncthreads();
}

__device__ __forceinline__ void moe_bases(Frame& F, int (&base)[9], int (&cnt)[8]) {
    const unsigned* c = (const unsigned*)(F.ws + WS_CTL) + CW_MOECNT;
    int acc = 0;
#pragma unroll
    for (int e = 0; e < 8; ++e) { cnt[e] = (int)__hip_atomic_load(c + 64 * e, __ATOMIC_RELAXED, __HIP_MEMORY_SCOPE_AGENT); base[e] = acc; acc += (cnt[e] + 255) & ~255; }
    base[8] = acc;
}
__device__ __forceinline__ void moe_range(Frame& F, int e, int& lo, int& hi) {
    const unsigned* c = (const unsigned*)(F.ws + WS_CTL) + CW_MOECNT;
    int acc = 0; lo = 0; hi = 0;
#pragma unroll
    for (int k = 0; k < 8; ++k) { const int n = ((int)__hip_atomic_load(c + 64 * k, __ATOMIC_RELAXED, __HIP_MEMORY_SCOPE_AGENT) + 255) & ~255; if (k == e) { lo = acc; hi = acc + n; } acc += n; }
}
__device__ __forceinline__ void ph_moe_list(const Args& a, Frame& F) {
    int base[9], cnt[8]; moe_bases(F, base, cnt);
    int* RM = (int*)(F.ws + WS_RMAP); const int* R = (const int*)(F.ws + WS_ROUTE); const int* Pq = (const int*)(F.ws + WS_POS);
    for (int t = F.bid * NTHREADS + F.tid; t < T; t += F.nb * NTHREADS) {
        const int e0 = R[t * 4], e1 = R[t * 4 + 1];
        int b0 = 0, b1 = 0;
#pragma unroll
        for (int e = 0; e < 8; ++e) { if (e == e0) b0 = base[e]; if (e == e1) b1 = base[e]; }
        RM[b0 + Pq[t * 2]] = t; RM[b1 + Pq[t * 2 + 1]] = t;
    }
    if (F.bid == 0) {
#pragma unroll
        for (int e = 0; e < 8; ++e) { const int lo = base[e] + cnt[e], hi = base[e + 1]; for (int r = lo + F.tid; r < hi; r += NTHREADS) RM[r] = 0; }
    }
}
__device__ __forceinline__ void ph_final(const Args& a, Frame& F) {
    int base[9], cnt[8]; moe_bases(F, base, cnt);
    const float* MOD = (const float*)(F.ws + WS_MOD);
    const bf16_t* YM = (const bf16_t*)(F.ws + WS_YMOE); const int* R = (const int*)(F.ws + WS_ROUTE); const int* Pq = (const int*)(F.ws + WS_POS);
    for (int row = F.gw; row < T; row += F.ngw) {
        const int b = row / SEQ;
        const int e0 = R[row * 4], e1 = R[row * 4 + 1]; const float p0 = ((const float*)R)[row * 4 + 2], p1 = ((const float*)R)[row * 4 + 3];
        int b0 = 0, b1 = 0;
#pragma unroll
        for (int e = 0; e < 8; ++e) { if (e == e0) b0 = base[e]; if (e == e1) b1 = base[e]; }
        const size_t s0 = (size_t)(b0 + Pq[row * 2]), s1 = (size_t)(b1 + Pq[row * 2 + 1]);
        const float* gt2 = MOD + ((size_t)(1 * 2 + 1) * 2 + b) * 3072 + 2048;
        f32x4* xr = (f32x4*)(a.out + (size_t)row * D) + F.lane; const bf16_t* x16r = (const bf16_t*)(F.ws + WS_X16) + (size_t)row * D;
        f32x4 v[4]; float ss = 0.f;
#pragma unroll
        for (int j = 0; j < 4; ++j) {
            const int d = 256 * j + 4 * F.lane;
            const u32x2 y0 = *(const u32x2*)(YM + s0 * D + d), y1 = *(const u32x2*)(YM + s1 * D + d);
            const f32x4 g4 = *(const f32x4*)(gt2 + d);
            f32x4 f; f.x = p0 * bf2f(y0.x & 0xffffu) + p1 * bf2f(y1.x & 0xffffu); f.y = p0 * bf2f(y0.x >> 16) + p1 * bf2f(y1.x >> 16);
            f.z = p0 * bf2f(y0.y & 0xffffu) + p1 * bf2f(y1.y & 0xffffu); f.w = p0 * bf2f(y0.y >> 16) + p1 * bf2f(y1.y >> 16);
            const u32x2 xv = *(const u32x2*)(x16r + d); f32x4 xo; xo.x = bf2f(xv.x & 0xffffu); xo.y = bf2f(xv.x >> 16); xo.z = bf2f(xv.y & 0xffffu); xo.w = bf2f(xv.y >> 16);
            v[j] = xo + g4 * f;
            ss += (v[j].x * v[j].x + v[j].y * v[j].y) + (v[j].z * v[j].z + v[j].w * v[j].w);
        }
        const float rstd = rsqrtf(wave_sum(ss) * (1.0f / D) + EPS);
#pragma unroll
        for (int j = 0; j < 4; ++j) { const f32x4 g4 = *(const f32x4*)(a.final_g + 256 * j + 4 * F.lane); xr[64 * j] = (v[j] * rstd) * g4; }
    }
}


namespace pg8 {
typedef short bf16x8 __attribute__((ext_vector_type(8)));
constexpr int BM = 256, BK = 64, HALF = 128, HTB = HALF * BK * 2, STAGE_BYTES = 8 * HTB;
__device__ __forceinline__ int lds_byte(int r, int c) { const int st = (r >> 4) * 2 + (c >> 5), rr = r & 15, cc = c & 31, ob = rr * 64 + cc * 2; return st * 1024 + (ob ^ (((ob >> 9) & 1) << 5)); }
__device__ __forceinline__ void stage_rc(int b, int& R, int& C) { const int st = b / 1024, sb = b % 1024, swz = sb ^ (((sb >> 9) & 1) << 5); R = (st >> 1) * 16 + swz / 64; C = (st & 1) * 32 + (swz % 64) / 2; }
__device__ __forceinline__ int perm32(int rho) { const int n = rho >> 4, i = rho & 15; return 8 * (i >> 2) + 4 * n + (i & 3); }
struct Unit { int pm, pn, ord; };
struct Gemm { const bf16_t* A; const bf16_t* Bt; int K; };
constexpr int NXCD = 8, WGM = 8;
struct StaticOrder {
    int nM, nN, nwg, G, c;
    __device__ void init(int M, int N, int G_, int c_) { nM = M / BM; nN = N / BM; nwg = nM * nN; G = G_; c = c_; }
    __device__ __forceinline__ bool next(int i, Unit& u) const {
        const long L = (long)i * G + c; if (L >= nwg) return false;
        int wgid = (int)L; { const int q = nwg / NXCD, r = nwg % NXCD, xcd = wgid % NXCD, off = wgid / NXCD; wgid = (xcd < r ? xcd * (q + 1) : r * (q + 1) + (xcd - r) * q) + off; }
        const int nig = WGM * nN, gid = wgid / nig, fm = gid * WGM, gsz = (nM - fm) < WGM ? (nM - fm) : WGM;
        u.pm = fm + ((wgid % nig) % gsz); u.pn = (wgid % nig) / gsz; return true;
    }
};
template <int NT> struct MoeOrder {
    int bt[9]; int cnt[8]; int G, c;
    __device__ __forceinline__ bool next(int i, Unit& u) const {
        const int L = i * G + c; if (L >= bt[8] * NT) return false;
        const int q = L / NT, tn = L % NT; int e = 0;
#pragma unroll
        for (int k = 1; k < 8; ++k) e += (q >= bt[k]) ? 1 : 0;
        u.pm = q; u.pn = e * NT + tn; return true;
    }
};
__device__ __forceinline__ unsigned cvt_pk_bf16(float lo, float hi) { unsigned r; asm volatile("v_cvt_pk_bf16_f32 %0, %1, %2" : "=v"(r) : "v"(lo), "v"(hi)); return r; }
__device__ __forceinline__ float fast_silu(float x) { return x * __builtin_amdgcn_rcpf(1.0f + __builtin_amdgcn_exp2f(x * -1.4426950408889634f)); }

struct EpiBf16 {
    static constexpr bool PERM = true;
    bf16_t* O; int ldc; int nmod;
    __device__ __forceinline__ void operator()(const f32x4 (&acc)[2][2][4][2], const Unit& u, int wr, int wc, int fr, int fq) const {
        const int row0 = u.pm * BM + wr * 64 + fr, col0 = (u.pn % nmod) * BM + wc * 32 + 8 * fq;
#pragma unroll
        for (int ai = 0; ai < 2; ++ai)
#pragma unroll
            for (int m = 0; m < 4; ++m) { bf16_t* rowp = O + (size_t)(row0 + ai * HALF + m * 16) * ldc + col0;
#pragma unroll
                for (int bj = 0; bj < 2; ++bj) { const f32x4 v0 = acc[ai][bj][m][0], v1 = acc[ai][bj][m][1];
                    u32x4 w; w.x = cvt_pk_bf16(v0[0], v0[1]); w.y = cvt_pk_bf16(v0[2], v0[3]); w.z = cvt_pk_bf16(v1[0], v1[1]); w.w = cvt_pk_bf16(v1[2], v1[3]);
                    *(u32x4*)(rowp + bj * HALF) = w; } }
    }
};
struct EpiSwiGLU {
    static constexpr bool PERM = true;
    bf16_t* O; int ldc; int nmod;
    __device__ __forceinline__ void operator()(const f32x4 (&acc)[2][2][4][2], const Unit& u, int wr, int wc, int fr, int fq) const {
        const int row0 = u.pm * BM + wr * 64 + fr, col0 = (u.pn % nmod) * HALF + wc * 32 + 8 * fq;
#pragma unroll
        for (int ai = 0; ai < 2; ++ai)
#pragma unroll
            for (int m = 0; m < 4; ++m) {
                const f32x4 g0 = acc[ai][0][m][0], g1 = acc[ai][0][m][1], u0 = acc[ai][1][m][0], u1 = acc[ai][1][m][1];
                u32x4 w;
                w.x = cvt_pk_bf16(fast_silu(g0[0]) * u0[0], fast_silu(g0[1]) * u0[1]); w.y = cvt_pk_bf16(fast_silu(g0[2]) * u0[2], fast_silu(g0[3]) * u0[3]);
                w.z = cvt_pk_bf16(fast_silu(g1[0]) * u1[0], fast_silu(g1[1]) * u1[1]); w.w = cvt_pk_bf16(fast_silu(g1[2]) * u1[2], fast_silu(g1[3]) * u1[3]);
                *(u32x4*)(O + (size_t)(row0 + ai * HALF + m * 16) * ldc + col0) = w; }
    }
};
struct EpiResidF32 {
    static constexpr bool PERM = false;
    const float* xin; float* xout; const float* gate;
    __device__ __forceinline__ void operator()(const f32x4 (&acc)[2][2][4][2], const Unit& u, int wr, int wc, int fr, int fq) const {
        const int row0 = u.pm * BM + wr * 64 + fr, col0 = u.pn * BM + wc * 32 + 4 * fq;
        const float* gp = gate + (size_t)((u.pm * BM) / SEQ) * 3072 + col0;
#pragma unroll
        for (int bj = 0; bj < 2; ++bj)
#pragma unroll
            for (int n = 0; n < 2; ++n) { const f32x4 g4 = *(const f32x4*)(gp + bj * HALF + n * 16);
#pragma unroll
                for (int ai = 0; ai < 2; ++ai)
#pragma unroll
                    for (int m = 0; m < 4; ++m) { const size_t off = (size_t)(row0 + ai * HALF + m * 16) * D + col0 + bj * HALF + n * 16;
                        const f32x4 x4 = *(const f32x4*)(xin + off); *(f32x4*)(xout + off) = x4 + g4 * acc[ai][bj][m][n]; } }
    }
};


template <bool XIN_F32> struct EpiResidNorm {
    static constexpr bool PERM = true;
    const void* xin; bf16_t* x16; const float* gate; const float* av; bf16_t* xa; float* ssqp;
    __device__ __forceinline__ void operator()(const f32x4 (&acc)[2][2][4][2], const Unit& u, int wr, int wc, int fr, int fq) const {
        const int row0 = u.pm * BM + wr * 64 + fr, col0 = u.pn * BM + wc * 32 + 8 * fq, b = (u.pm * BM) / SEQ;
        const float* gp = gate + (size_t)b * 3072 + col0; const float* ap = av + (size_t)b * 1024 + col0;
        float ss[2][4];
#pragma unroll
        for (int ai = 0; ai < 2; ++ai)
#pragma unroll
            for (int m = 0; m < 4; ++m) ss[ai][m] = 0.f;
#pragma unroll
        for (int bj = 0; bj < 2; ++bj) {
            const f32x4 g0 = *(const f32x4*)(gp + bj * HALF), g1 = *(const f32x4*)(gp + bj * HALF + 4), a0 = *(const f32x4*)(ap + bj * HALF), a1 = *(const f32x4*)(ap + bj * HALF + 4);
#pragma unroll
            for (int ai = 0; ai < 2; ++ai)
#pragma unroll
                for (int m = 0; m < 4; ++m) { const size_t off = (size_t)(row0 + ai * HALF + m * 16) * D + col0 + bj * HALF;
                    f32x4 x0, x1;
                    if constexpr (XIN_F32) { x0 = *(const f32x4*)((const float*)xin + off); x1 = *(const f32x4*)((const float*)xin + off + 4); }
                    else { const u32x4 xv = *(const u32x4*)((const bf16_t*)xin + off);
                        x0.x = __uint_as_float(xv.x << 16); x0.y = __uint_as_float(xv.x & 0xffff0000u); x0.z = __uint_as_float(xv.y << 16); x0.w = __uint_as_float(xv.y & 0xffff0000u);
                        x1.x = __uint_as_float(xv.z << 16); x1.y = __uint_as_float(xv.z & 0xffff0000u); x1.z = __uint_as_float(xv.w << 16); x1.w = __uint_as_float(xv.w & 0xffff0000u); }
                    const f32x4 n0 = x0 + g0 * acc[ai][bj][m][0], n1 = x1 + g1 * acc[ai][bj][m][1];
                    ss[ai][m] += ((n0.x * n0.x + n0.y * n0.y) + (n0.z * n0.z + n0.w * n0.w)) + ((n1.x * n1.x + n1.y * n1.y) + (n1.z * n1.z + n1.w * n1.w));
                    u32x4 w1; w1.x = cvt_pk_bf16(n0.x, n0.y); w1.y = cvt_pk_bf16(n0.z, n0.w); w1.z = cvt_pk_bf16(n1.x, n1.y); w1.w = cvt_pk_bf16(n1.z, n1.w); *(u32x4*)(x16 + off) = w1;
                    const f32x4 s0 = n0 * a0, s1 = n1 * a1;
                    u32x4 w2; w2.x = cvt_pk_bf16(s0.x, s0.y); w2.y = cvt_pk_bf16(s0.z, s0.w); w2.z = cvt_pk_bf16(s1.x, s1.y); w2.w = cvt_pk_bf16(s1.z, s1.w); *(u32x4*)(xa + off) = w2; }
        }
#pragma unroll
        for (int ai = 0; ai < 2; ++ai)
#pragma unroll
            for (int m = 0; m < 4; ++m) { float sv = ss[ai][m]; sv += __shfl_xor(sv, 16); sv += __shfl_xor(sv, 32);
                if (fq == 0) ssqp[(size_t)(row0 + ai * HALF + m * 16) * 16 + u.pn * 4 + wc] = sv; }
    }
};
struct EpiProjNorm {
    static constexpr bool PERM = true;
    bf16_t* O; const LAS float* RS; const float* cv; float* BG; const float* a_log; const float* dt_bias;
    __device__ __forceinline__ void operator()(const f32x4 (&acc)[2][2][4][2], const Unit& u, int wr, int wc, int fr, int fq) const {
        const int rl0 = wr * 64 + fr, col0 = u.pn * BM + wc * 32 + 8 * fq, b = (u.pm * BM) / SEQ;
        const float* cp = cv + (size_t)b * NPW + col0;
        if (u.pn < NP / BM) {
            f32x4 c4[2][2];
#pragma unroll
            for (int bj = 0; bj < 2; ++bj)
#pragma unroll
                for (int n = 0; n < 2; ++n) c4[bj][n] = *(const f32x4*)(cp + bj * HALF + 4 * n);
#pragma unroll
            for (int ai = 0; ai < 2; ++ai)
#pragma unroll
                for (int m = 0; m < 4; ++m) { const int rl = rl0 + ai * HALF + m * 16; const float rs = fabsf(RS[u.ord * 256 + rl]);
                    bf16_t* rowp = O + (size_t)(u.pm * BM + rl) * NP + col0;
#pragma unroll
                    for (int bj = 0; bj < 2; ++bj) { const f32x4 v0 = acc[ai][bj][m][0] * rs + c4[bj][0], v1 = acc[ai][bj][m][1] * rs + c4[bj][1];
                        u32x4 w; w.x = cvt_pk_bf16(v0[0], v0[1]); w.y = cvt_pk_bf16(v0[2], v0[3]); w.z = cvt_pk_bf16(v1[0], v1[1]); w.w = cvt_pk_bf16(v1[2], v1[3]);
                        *(u32x4*)(rowp + bj * HALF) = w; } }
        } else if (wc == 0 && fq == 0) {
            const f32x4 c0 = *(const f32x4*)(cp), c1 = *(const f32x4*)(cp + 4);
            const f32x4 al = *(const f32x4*)a_log, db = *(const f32x4*)dt_bias;
#pragma unroll
            for (int ai = 0; ai < 2; ++ai)
#pragma unroll
                for (int m = 0; m < 4; ++m) { const int rl = rl0 + ai * HALF + m * 16; const float rs = fabsf(RS[u.ord * 256 + rl]);
                    const f32x4 vb = acc[ai][0][m][0] * rs + c0, va = acc[ai][0][m][1] * rs + c1;
                    f32x4 be, gg;
#pragma unroll
                    for (int hh = 0; hh < 4; ++hh) { be[hh] = sigmoidf_(vb[hh]); gg[hh] = -__expf(al[hh]) * softplusf_(va[hh] + db[hh]); }
                    float* bg = BG + (size_t)(u.pm * BM + rl) * 8; *(f32x4*)bg = be; *(f32x4*)(bg + 4) = gg; }
        }
    }
};
struct EpiSwiGLUNorm {
    static constexpr bool PERM = true;
    bf16_t* O; int ldc; int nmod; const LAS float* RS; const float* cv; int ncv;
    __device__ __forceinline__ void operator()(const f32x4 (&acc)[2][2][4][2], const Unit& u, int wr, int wc, int fr, int fq) const {
        const int rl0 = wr * 64 + fr, col0 = (u.pn % nmod) * HALF + wc * 32 + 8 * fq;
        const float* cp = cv + (size_t)u.pn * BM + wc * 32 + 8 * fq;
        f32x4 cg[2][2], cu[2][2];
#pragma unroll
        for (int bb = 0; bb < 2; ++bb)
#pragma unroll
            for (int n = 0; n < 2; ++n) { cg[bb][n] = *(const f32x4*)(cp + (size_t)bb * ncv + 4 * n); cu[bb][n] = *(const f32x4*)(cp + (size_t)bb * ncv + HALF + 4 * n); }
#pragma unroll
        for (int ai = 0; ai < 2; ++ai)
#pragma unroll
            for (int m = 0; m < 4; ++m) { const int rl = rl0 + ai * HALF + m * 16; const float rsv = RS[u.ord * 256 + rl], rs = fabsf(rsv); const bool b1 = rsv < 0.f;
                const f32x4 g0 = acc[ai][0][m][0] * rs + (b1 ? cg[1][0] : cg[0][0]), g1 = acc[ai][0][m][1] * rs + (b1 ? cg[1][1] : cg[0][1]);
                const f32x4 u0 = acc[ai][1][m][0] * rs + (b1 ? cu[1][0] : cu[0][0]), u1 = acc[ai][1][m][1] * rs + (b1 ? cu[1][1] : cu[0][1]);
                u32x4 w;
                w.x = cvt_pk_bf16(fast_silu(g0[0]) * u0[0], fast_silu(g0[1]) * u0[1]); w.y = cvt_pk_bf16(fast_silu(g0[2]) * u0[2], fast_silu(g0[3]) * u0[3]);
                w.z = cvt_pk_bf16(fast_silu(g1[0]) * u1[0], fast_silu(g1[1]) * u1[1]); w.w = cvt_pk_bf16(fast_silu(g1[2]) * u1[2], fast_silu(g1[3]) * u1[3]);
                *(u32x4*)(O + (size_t)(u.pm * BM + rl) * ldc + col0) = w; }
    }
};

template <class Epi, class Sched, bool GATHER, bool ALIGN_EPI, bool SP2>
__device__ __forceinline__ void gemm_phase(LAS unsigned char* lds, const LAS int* RI, const Gemm g, const Sched& S, const Epi& E) {
    const int tid = threadIdx.x, wid = __builtin_amdgcn_readfirstlane(tid >> 6), lane = tid & 63, wr = wid >> 2, wc = wid & 3, fr = lane & 15, fq = lane >> 4;
    const int K = g.K, nt = K / BK;
    unsigned voffB[2]; int Ra[2]; unsigned Ca2[2];
#pragma unroll
    for (int i = 0; i < 2; ++i) { int R, C; stage_rc(tid * 16 + i * 8192, R, C); const int Rb = Epi::PERM ? ((R & ~31) + perm32(R & 31)) : R;
        Ra[i] = R; Ca2[i] = (unsigned)C * 2u; voffB[i] = (unsigned)(Rb * K + C) * 2u; }
    const size_t kstep = (size_t)(BK * 2);
    const size_t hstep = (size_t)HALF * K * 2;
    const size_t tstep = 2 * hstep;
    const unsigned rowb = (unsigned)K * 2u;
    const unsigned ldsw = (unsigned)wid * 1024u;
    const int aoff = lds_byte(wr * 64 + fr, fq * 8), boff = lds_byte(wc * 32 + fr, fq * 8);
#define PG8_SA(b, h) (((b) * 2 + (h)) * HTB)
#define PG8_SB(b, h) ((4 + (b) * 2 + (h)) * HTB)
#define PG8_STAGE_B(bufoff, gbase) do { _Pragma("unroll") for (int _i = 0; _i < 2; ++_i) \
        __builtin_amdgcn_global_load_lds((const unsigned*)((const char*)(gbase) + voffB[_i]), (LAS unsigned*)(lds + (bufoff) + ldsw + _i * 8192), 16, 0, 0); } while (0)
#define PG8_STAGE_A(bufoff, kb, off) do { _Pragma("unroll") for (int _i = 0; _i < 2; ++_i) \
        __builtin_amdgcn_global_load_lds((const unsigned*)((const char*)g.A + (size_t)(kb) + (off)[_i]), (LAS unsigned*)(lds + (bufoff) + ldsw + _i * 8192), 16, 0, 0); } while (0)
#define PG8_LDA(dst, b, h) do { _Pragma("unroll") for (int m = 0; m < 4; ++m) _Pragma("unroll") for (int k = 0; k < 2; ++k) dst[m][k] = *(const LAS bf16x8*)(lds + PG8_SA(b, h) + aoff + m * 2048 + k * 1024); } while (0)
#define PG8_LDB(dst, b, h) do { _Pragma("unroll") for (int n = 0; n < 2; ++n) _Pragma("unroll") for (int k = 0; k < 2; ++k) dst[n][k] = *(const LAS bf16x8*)(lds + PG8_SB(b, h) + boff + n * 2048 + k * 1024); } while (0)
#define PG8_MMA(ai, bj, At, Bt) do { __builtin_amdgcn_s_setprio(1); _Pragma("unroll") for (int m = 0; m < 4; ++m) _Pragma("unroll") for (int n = 0; n < 2; ++n) _Pragma("unroll") for (int k = 0; k < 2; ++k) \
        acc[ai][bj][m][n] = __builtin_amdgcn_mfma_f32_16x16x32_bf16(Bt[n][k], At[m][k], acc[ai][bj][m][n], 0, 0, 0); __builtin_amdgcn_s_setprio(0); } while (0)
#define PG8_WAIT_V(n) asm volatile("s_waitcnt vmcnt(" #n ")" ::: "memory")
#define PG8_WAIT_L(n) asm volatile("s_waitcnt lgkmcnt(" #n ")" ::: "memory")
#define PG8_BAR __builtin_amdgcn_s_barrier()
#define PG8_SCHED __builtin_amdgcn_sched_barrier(0)
#define PG8_AOFFS(dst, ui_, un_) do { _Pragma("unroll") for (int _h = 0; _h < 2; ++_h) _Pragma("unroll") for (int _i = 0; _i < 2; ++_i) { \
        const unsigned _row = GATHER ? (unsigned)RI[(ui_) * 256 + _h * HALF + Ra[_i]] : (unsigned)((un_).pm * BM + _h * HALF + Ra[_i]); dst[_h][_i] = _row * rowb + Ca2[_i]; } } while (0)
    Unit cur, nxt; int ui = 0;
    if (!S.next(0, cur)) return;
    cur.ord = 0;
    f32x4 acc[2][2][4][2];
#pragma unroll
    for (int a = 0; a < 2; ++a)
#pragma unroll
        for (int b = 0; b < 2; ++b)
#pragma unroll
            for (int m = 0; m < 4; ++m)
#pragma unroll
                for (int n = 0; n < 2; ++n) acc[a][b][m][n] = (f32x4){0.f, 0.f, 0.f, 0.f};
    bf16x8 At[4][2], B0[2][2], B1[2][2];
    unsigned cv[2][2], nv[2][2];
    PG8_AOFFS(cv, 0, cur);
    const char* cB = (const char*)g.Bt + (size_t)cur.pn * tstep;
    if constexpr (SP2) {
        PG8_STAGE_B(PG8_SB(0, 0), cB); PG8_STAGE_B(PG8_SB(0, 1), cB + hstep); PG8_STAGE_A(PG8_SA(0, 0), 0, cv[0]); PG8_STAGE_A(PG8_SA(0, 1), 0, cv[1]);
        if (wr == 1) PG8_BAR;
        PG8_WAIT_V(2); PG8_BAR;
        PG8_STAGE_B(PG8_SB(1, 0), cB + kstep); PG8_STAGE_A(PG8_SA(1, 0), kstep, cv[0]); PG8_STAGE_B(PG8_SB(1, 1), cB + hstep + kstep);
        PG8_WAIT_V(6); PG8_BAR;
    } else {
        PG8_STAGE_B(PG8_SB(0, 0), cB); PG8_STAGE_A(PG8_SA(0, 0), 0, cv[0]); PG8_STAGE_B(PG8_SB(0, 1), cB + hstep); PG8_STAGE_A(PG8_SA(0, 1), 0, cv[1]);
        if (wr == 1) PG8_BAR;
        PG8_WAIT_V(4); PG8_BAR;
        PG8_STAGE_B(PG8_SB(1, 0), cB + kstep); PG8_STAGE_A(PG8_SA(1, 0), kstep, cv[0]); PG8_STAGE_B(PG8_SB(1, 1), cB + hstep + kstep);
        PG8_WAIT_V(6); PG8_BAR;
    }
    for (;;) {
        const bool has_next = S.next(ui + 1, nxt); nxt.ord = ui + 1;
        const char* nB = has_next ? (const char*)g.Bt + (size_t)nxt.pn * tstep : cB;
        if (has_next) { PG8_AOFFS(nv, ui + 1, nxt); }
        else {
#pragma unroll
            for (int h = 0; h < 2; ++h)
#pragma unroll
                for (int i = 0; i < 2; ++i) nv[h][i] = cv[h][i]; }
        for (int t = 0; t < nt; t += 2) {
            const bool last = (t == nt - 2);
            const size_t kb1 = (size_t)(t + 1) * kstep, kb2 = last ? (size_t)0 : (size_t)(t + 2) * kstep, kb3 = kb2 + kstep;
            const char* b2 = last ? nB : cB + (size_t)(t + 2) * kstep; const char* b3 = b2 + kstep;
            unsigned o2[2][2];
#pragma unroll
            for (int h = 0; h < 2; ++h)
#pragma unroll
                for (int i = 0; i < 2; ++i) o2[h][i] = last ? nv[h][i] : cv[h][i];
            if constexpr (SP2) {
            PG8_LDB(B0, 0, 0); PG8_LDB(B1, 0, 1); PG8_SCHED; PG8_LDA(At, 0, 0); PG8_STAGE_A(PG8_SA(1, 1), kb1, cv[1]);
            PG8_WAIT_V(8); PG8_WAIT_L(0); PG8_BAR; PG8_MMA(0, 0, At, B0); PG8_MMA(0, 1, At, B1); PG8_BAR; PG8_SCHED;
            PG8_LDA(At, 0, 1); PG8_STAGE_B(PG8_SB(0, 0), b2); PG8_STAGE_B(PG8_SB(0, 1), b2 + hstep); PG8_STAGE_A(PG8_SA(0, 0), kb2, o2[0]);
            PG8_WAIT_V(8); PG8_WAIT_L(0); PG8_BAR; PG8_MMA(1, 0, At, B0); PG8_MMA(1, 1, At, B1); PG8_BAR; PG8_SCHED;
            PG8_LDB(B0, 1, 0); PG8_LDB(B1, 1, 1); PG8_SCHED; PG8_LDA(At, 1, 0); PG8_STAGE_A(PG8_SA(0, 1), kb2, o2[1]);
            PG8_WAIT_V(8); PG8_WAIT_L(0); PG8_BAR; PG8_MMA(0, 0, At, B0); PG8_MMA(0, 1, At, B1); PG8_BAR; PG8_SCHED;
            PG8_LDA(At, 1, 1); PG8_STAGE_B(PG8_SB(1, 0), b3); PG8_STAGE_B(PG8_SB(1, 1), b3 + hstep); PG8_STAGE_A(PG8_SA(1, 0), kb3, o2[0]);
            PG8_WAIT_V(8); PG8_WAIT_L(0); PG8_BAR; PG8_MMA(1, 0, At, B0); PG8_MMA(1, 1, At, B1); PG8_BAR; PG8_SCHED;
            } else {
            PG8_LDB(B0, 0, 0); PG8_SCHED; PG8_LDA(At, 0, 0); PG8_STAGE_A(PG8_SA(1, 1), kb1, cv[1]);
            PG8_WAIT_L(8); PG8_BAR; PG8_WAIT_L(0); PG8_MMA(0, 0, At, B0); PG8_BAR; PG8_SCHED;
            PG8_LDB(B1, 0, 1); PG8_STAGE_B(PG8_SB(0, 0), b2);
            PG8_BAR; PG8_WAIT_L(0); PG8_MMA(0, 1, At, B1); PG8_BAR;
            PG8_LDA(At, 0, 1); PG8_STAGE_A(PG8_SA(0, 0), kb2, o2[0]);
            PG8_BAR; PG8_WAIT_L(0); PG8_MMA(1, 0, At, B0); PG8_BAR; PG8_SCHED;
            PG8_STAGE_B(PG8_SB(0, 1), b2 + hstep);
            PG8_WAIT_V(6); PG8_BAR; PG8_MMA(1, 1, At, B1); PG8_BAR;
            PG8_LDB(B0, 1, 0); PG8_SCHED; PG8_LDA(At, 1, 0); PG8_STAGE_A(PG8_SA(0, 1), kb2, o2[1]);
            PG8_WAIT_L(8); PG8_BAR; PG8_WAIT_L(0); PG8_MMA(0, 0, At, B0); PG8_BAR; PG8_SCHED;
            PG8_LDB(B1, 1, 1); PG8_STAGE_B(PG8_SB(1, 0), b3);
            PG8_BAR; PG8_WAIT_L(0); PG8_MMA(0, 1, At, B1); PG8_BAR;
            PG8_LDA(At, 1, 1); PG8_STAGE_A(PG8_SA(1, 0), kb3, o2[0]);
            PG8_BAR; PG8_WAIT_L(0); PG8_MMA(1, 0, At, B0); PG8_BAR; PG8_SCHED;
            PG8_STAGE_B(PG8_SB(1, 1), b3 + hstep);
            PG8_WAIT_V(6); PG8_BAR; PG8_MMA(1, 1, At, B1); PG8_BAR;
            }
        }
        if constexpr (ALIGN_EPI) { if (wr == 0) PG8_BAR; }
        E(acc, cur, wr, wc, fr, fq);
        if (!has_next) break;
#pragma unroll
        for (int a = 0; a < 2; ++a)
#pragma unroll
            for (int b = 0; b < 2; ++b)
#pragma unroll
                for (int m = 0; m < 4; ++m)
#pragma unroll
                    for (int n = 0; n < 2; ++n) acc[a][b][m][n] = (f32x4){0.f, 0.f, 0.f, 0.f};
        cur = nxt; cB = nB; ++ui;
#pragma unroll
        for (int h = 0; h < 2; ++h)
#pragma unroll
            for (int i = 0; i < 2; ++i) cv[h][i] = nv[h][i];
        if constexpr (ALIGN_EPI) { if (wr == 1) PG8_BAR; }
    }
    PG8_WAIT_V(0);
    if constexpr (!ALIGN_EPI) { if (wr == 0) PG8_BAR; }
    PG8_BAR;
#undef PG8_SA
#undef PG8_SB
#undef PG8_STAGE_A
#undef PG8_STAGE_B
#undef PG8_LDA
#undef PG8_LDB
#undef PG8_MMA
#undef PG8_WAIT_V
#undef PG8_WAIT_L
#undef PG8_BAR
#undef PG8_SCHED
#undef PG8_AOFFS
}
}

__device__ __forceinline__ void transpose_item(const float* W, int pitch, int k0, int n0, bf16_t* WT, int Kd, int drow0, LAS float* scr, int lane) {
#pragma unroll 8
    for (int i = 0; i < 32; ++i) { const int kk = 2 * i + (lane >> 5); scr[kk * 33 + (lane & 31)] = W[(size_t)(k0 + kk) * pitch + n0 + (lane & 31)]; }
    asm volatile("s_waitcnt lgkmcnt(0)" ::: "memory");
    const int c = lane & 7;
#pragma unroll
    for (int j = 0; j < 4; ++j) { const int n = (lane >> 3) + 8 * j; const LAS float* s = scr + (8 * c) * 33 + n;
        u32x4 o; o.x = pk2(s[0 * 33], s[1 * 33]); o.y = pk2(s[2 * 33], s[3 * 33]); o.z = pk2(s[4 * 33], s[5 * 33]); o.w = pk2(s[6 * 33], s[7 * 33]);
        *(u32x4*)(WT + (size_t)(drow0 + n) * Kd + k0 + 8 * c) = o; }
    asm volatile("s_waitcnt lgkmcnt(0)" ::: "memory");
}
constexpr size_t WT_WIN = 0, WT_WOUT = WT_WIN + (size_t)2 * NPW * D, WT_FGU = WT_WOUT + (size_t)2 * D * D, WT_FD = WT_FGU + (size_t)2 * D_FF * D,
                 WT_MGU = WT_FD + (size_t)D * D_FF, WT_MD = WT_MGU + (size_t)NE * 2 * D_FFE * D, WT_END = WT_MD + (size_t)NE * D * D_FFE;
static_assert(WT_END * 2 <= 80 * MiB, "weight copies fit");
__device__ __forceinline__ void ph_pro_weights(const Args& a, Frame& F) {
    LAS float* scr = (LAS float*)(F.lds + F.wave * 16384);
    bf16_t* WT = (bf16_t*)(F.ws + WS_WT);
    constexpr int I_IN0 = 16 * 48, I_IN1 = 16 * 24, I_OUT = 16 * 32, I_FG = 16 * 88, I_FD = 44 * 32, I_M = 16 * 32;
    constexpr int NITEMS = 2 * (I_IN0 + I_IN1 + I_OUT) + 2 * I_FG + I_FD + 24 * I_M;
    for (int it = F.gw; it < NITEMS; it += F.ngw) {
        int r = it; const float* src; int pitch, k0, n0, Kd, drow0; bf16_t* dst;
        if (r < 2 * I_IN0) { const int l = r / I_IN0; r %= I_IN0; src = a.w_in + (size_t)l * D * N_IN; pitch = N_IN; k0 = (r / 48) * 64; n0 = (r % 48) * 32; dst = WT + WT_WIN + (size_t)l * NPW * D; Kd = D; drow0 = n0; }
        else if ((r -= 2 * I_IN0) < 2 * I_IN1) { const int l = r / I_IN1; r %= I_IN1; src = a.w_in + (size_t)l * D * N_IN + 1544; pitch = N_IN; k0 = (r / 24) * 64; n0 = (r % 24) * 32; dst = WT + WT_WIN + (size_t)l * NPW * D; Kd = D; drow0 = 1536 + n0; }
        else if ((r -= 2 * I_IN1) < 2 * I_OUT) { const int l = r / I_OUT; r %= I_OUT; src = a.w_out + (size_t)l * D * D; pitch = D; k0 = (r / 32) * 64; n0 = (r % 32) * 32; dst = WT + WT_WOUT + (size_t)l * D * D; Kd = D; drow0 = n0; }
        else if ((r -= 2 * I_OUT) < 2 * I_FG) { const int up = r / I_FG; r %= I_FG; src = up ? a.ffn_wu : a.ffn_wg; pitch = D_FF; k0 = (r / 88) * 64; n0 = (r % 88) * 32; dst = WT + WT_FGU; Kd = D; drow0 = (n0 / 128) * 256 + up * 128 + (n0 % 128); }
        else if ((r -= 2 * I_FG) < I_FD) { src = a.ffn_wd; pitch = D; k0 = (r / 32) * 64; n0 = (r % 32) * 32; dst = WT + WT_FD; Kd = D_FF; drow0 = n0; }
        else if ((r -= I_FD) < 16 * I_M) { const int e = r / (2 * I_M); r %= 2 * I_M; const int up = r / I_M; r %= I_M; src = (up ? a.moe_wu : a.moe_wg) + (size_t)e * D * D_FFE; pitch = D_FFE; k0 = (r / 32) * 64; n0 = (r % 32) * 32;
            dst = WT + WT_MGU + (size_t)e * 2 * D_FFE * D; Kd = D; drow0 = (n0 / 128) * 256 + up * 128 + (n0 % 128); }
        else { r -= 16 * I_M; const int e = r / I_M; r %= I_M; src = a.moe_wd + (size_t)e * D_FFE * D; pitch = D; k0 = (r / 32) * 64; n0 = (r % 32) * 32; dst = WT + WT_MD + (size_t)e * D * D_FFE; Kd = D_FFE; drow0 = n0; }
        transpose_item(src, pitch, k0, n0, dst, Kd, drow0, scr, F.lane);
    }
    for (int idx = F.bid * NTHREADS + F.tid; idx < 2 * 256 * D; idx += F.nb * NTHREADS) {
        const int l = idx / (256 * D), r = (idx / D) % 256, k = idx % D;
        WT[WT_WIN + (size_t)l * NPW * D + (size_t)(2304 + r) * D + k] = (r < 8) ? (bf16_t)f2bf(a.w_in[(size_t)l * D * N_IN + (size_t)k * N_IN + W_DB + r]) : (bf16_t)0;
    }
}

template <int NT> __device__ __forceinline__ void moe_order_init(Frame& F, pg8::MoeOrder<NT>& S) {
    const unsigned* c = (const unsigned*)(F.ws + WS_CTL) + CW_MOECNT;
    int acc = 0;
#pragma unroll
    for (int e = 0; e < 8; ++e) { S.cnt[e] = (int)__hip_atomic_load(c + 64 * e, __ATOMIC_RELAXED, __HIP_MEMORY_SCOPE_AGENT); S.bt[e] = acc; acc += (S.cnt[e] + 255) >> 8; }
    S.bt[8] = acc; S.G = F.nb; S.c = F.bid;
}
template <int NT> __device__ __forceinline__ int moe_ri_one(Frame& F, const pg8::MoeOrder<NT>& S, const int* RM, int o, int t) {
    pg8::Unit u; if (!S.next(o, u)) return -1;
    const int e = u.pn / NT; int bte = 0, cne = 0;
#pragma unroll
    for (int kk = 0; kk < 8; ++kk) { if (kk == e) { bte = S.bt[kk]; cne = S.cnt[kk]; } }
    const int sl = (u.pm - bte) * 256 + t; return (sl < cne) ? RM[(size_t)e * T + sl] : 0;
}
template <int NT> __device__ __forceinline__ void moe_ri_preload(Frame& F, const pg8::MoeOrder<NT>& S) {
    LAS int* RI = (LAS int*)(F.lds + RI_OFF); const int* RM = (const int*)(F.ws + WS_RMAP);
    const int t = F.tid & 255, par = F.tid >> 8;
    const int v0 = moe_ri_one<NT>(F, S, RM, par, t), v1 = moe_ri_one<NT>(F, S, RM, par + 2, t), v2 = moe_ri_one<NT>(F, S, RM, par + 4, t), v3 = moe_ri_one<NT>(F, S, RM, par + 6, t);
    const int v4 = moe_ri_one<NT>(F, S, RM, par + 8, t), v5 = moe_ri_one<NT>(F, S, RM, par + 10, t), v6 = moe_ri_one<NT>(F, S, RM, par + 12, t), v7 = moe_ri_one<NT>(F, S, RM, par + 14, t);
    if (v0 >= 0) RI[(par) * 256 + t] = v0; if (v1 >= 0) RI[(par + 2) * 256 + t] = v1; if (v2 >= 0) RI[(par + 4) * 256 + t] = v2; if (v3 >= 0) RI[(par + 6) * 256 + t] = v3;
    if (v4 >= 0) RI[(par + 8) * 256 + t] = v4; if (v5 >= 0) RI[(par + 10) * 256 + t] = v5; if (v6 >= 0) RI[(par + 12) * 256 + t] = v6;
    if (v7 >= 0 && par + 14 < 15) RI[(par + 14) * 256 + t] = v7;
    __syncthreads();
}

__device__ __forceinline__ void ph_prep_vectors(const Args& a, Frame& F) {
    const float* MOD = (const float*)(F.ws + WS_MOD); float* AV = (float*)(F.ws + WS_AV);
    for (int idx = F.bid * NTHREADS + F.tid; idx < 3 * BATCH * D; idx += F.nb * NTHREADS) {
        const int inst = idx / (BATCH * D), b = (idx / D) % BATCH, d = idx % D;
        const int lk = (inst == 0) ? 1 : (inst == 1 ? 2 : 3);
        const float gn = (inst == 0) ? a.nfg[d] : (inst == 1 ? a.nmg[D + d] : a.nfg[D + d]);
        AV[idx] = gn * (1.0f + MOD[((size_t)lk * 2 + b) * 3072 + 1024 + d]);
    }
    const bf16_t* WT = (const bf16_t*)(F.ws + WS_WT);
    constexpr int NR = 5632 + NPW + 16384;
    int cur = -1; f32x4 B0[4], B1[4];
    for (int row = F.gw; row < NR; row += F.ngw) {
        int which, r; const bf16_t* wrow; float* out; int ncv;
        if (row < 5632) { which = 0; r = row; wrow = WT + WT_FGU + (size_t)r * D; out = (float*)(F.ws + WS_CVF); ncv = 5632; }
        else if (row < 5632 + NPW) { which = 1; r = row - 5632; wrow = WT + WT_WIN + (size_t)NPW * D + (size_t)r * D; out = (float*)(F.ws + WS_CVI); ncv = NPW; }
        else { which = 2; r = row - 5632 - NPW; wrow = WT + WT_MGU + (size_t)r * D; out = (float*)(F.ws + WS_CVM); ncv = 16384; }
        if (which != cur) { cur = which; const int lk = which + 1;
#pragma unroll
            for (int j = 0; j < 4; ++j) { B0[j] = *(const f32x4*)(MOD + ((size_t)lk * 2 + 0) * 3072 + 16 * F.lane + 4 * j); B1[j] = *(const f32x4*)(MOD + ((size_t)lk * 2 + 1) * 3072 + 16 * F.lane + 4 * j); } }
        const u32x4 w0 = *(const u32x4*)(wrow + 16 * F.lane), w1 = *(const u32x4*)(wrow + 16 * F.lane + 8);
        const unsigned ww[8] = {w0.x, w0.y, w0.z, w0.w, w1.x, w1.y, w1.z, w1.w};
        float s0 = 0.f, s1 = 0.f;
#pragma unroll
        for (int j = 0; j < 4; ++j) { const float x0 = bf2f(ww[2 * j] & 0xffffu), x1 = bf2f(ww[2 * j] >> 16), x2 = bf2f(ww[2 * j + 1] & 0xffffu), x3 = bf2f(ww[2 * j + 1] >> 16);
            s0 += (x0 * B0[j].x + x1 * B0[j].y) + (x2 * B0[j].z + x3 * B0[j].w); s1 += (x0 * B1[j].x + x1 * B1[j].y) + (x2 * B1[j].z + x3 * B1[j].w); }
        s0 = wave_sum(s0); s1 = wave_sum(s1);
        if (F.lane == 0) { out[r] = s0; out[ncv + r] = s1; }
    }
    if (F.gw < BATCH * 8) {
        const int b = F.gw >> 3, e = F.gw & 7; float sacc = 0.f;
        for (int d = F.lane; d < D; d += 64) sacc += MOD[((size_t)3 * 2 + b) * 3072 + d] * a.router_w[(size_t)d * NE + e];
        sacc = wave_sum(sacc);
        if (F.lane == 0) ((float*)(F.ws + WS_CR))[b * 8 + e] = sacc;
    }
}
template <class Sched> __device__ __forceinline__ int count_units(const Sched& S) { int n = 0; pg8::Unit u; while (n < 16 && S.next(n, u)) ++n; return n; }
template <class Sched> __device__ __forceinline__ void rstd_preload(Frame& F, const Sched& S, const float* ssqp, const LAS int* RI) {
    LAS float* RS = (LAS float*)(F.lds + RS_OFF);
    const int t = F.tid & 255, par = F.tid >> 8, nu = count_units(S);
#pragma unroll
    for (int k0 = 0; k0 < 8; k0 += 4) {
        f32x4 p0[4], p1[4], p2[4], p3[4]; int r0, r1, r2, r3;
#define RSP_LOAD(k, pk, rk) { const int o = par + 2 * (k0 + k); pg8::Unit u; u.pm = 0; rk = 0; if (o < nu) { S.next(o, u); rk = RI ? RI[o * 256 + t] : u.pm * 256 + t; } \
            const f32x4* q = (const f32x4*)(ssqp + (size_t)rk * 16); pk[0] = q[0]; pk[1] = q[1]; pk[2] = q[2]; pk[3] = q[3]; }
        RSP_LOAD(0, p0, r0) RSP_LOAD(1, p1, r1) RSP_LOAD(2, p2, r2) RSP_LOAD(3, p3, r3)
#undef RSP_LOAD
#define RSP_STORE(k, pk, rk) { const int o = par + 2 * (k0 + k); if (o < nu) { const f32x4 s4 = (pk[0] + pk[1]) + (pk[2] + pk[3]); \
            const float rs = rsqrtf(((s4.x + s4.y) + (s4.z + s4.w)) * (1.0f / D) + EPS); RS[o * 256 + t] = (rk >= SEQ) ? -rs : rs; } }
        RSP_STORE(0, p0, r0) RSP_STORE(1, p1, r1) RSP_STORE(2, p2, r2) RSP_STORE(3, p3, r3)
#undef RSP_STORE
    }
    __syncthreads();
}
__device__ __forceinline__ void ph_router(const Args& a, Frame& F) {
    const bf16_t* XA = (const bf16_t*)(F.ws + WS_H); const float* SSQ = (const float*)(F.ws + WS_SSQ) + (size_t)2 * T * 16; const float* CR = (const float*)(F.ws + WS_CR);
    LAS float* W8T = (LAS float*)F.lds;
    for (int i = F.tid; i < 8192; i += NTHREADS) { const int d = i >> 3, j = i & 7; W8T[j * 1024 + d] = a.router_w[i]; }
    __syncthreads();
    for (int row = F.gw; row < T; row += F.ngw) {
        const int b = row / SEQ;
        float acc[8];
#pragma unroll
        for (int e = 0; e < 8; ++e) acc[e] = 0.f;
#pragma unroll
        for (int jj = 0; jj < 2; ++jj) {
            const int d = 512 * jj + 8 * F.lane;
            const u32x4 xv = *(const u32x4*)(XA + (size_t)row * D + d);
            const float x[8] = {bf2f(xv.x & 0xffffu), bf2f(xv.x >> 16), bf2f(xv.y & 0xffffu), bf2f(xv.y >> 16), bf2f(xv.z & 0xffffu), bf2f(xv.z >> 16), bf2f(xv.w & 0xffffu), bf2f(xv.w >> 16)};
#pragma unroll
            for (int e = 0; e < 8; ++e) { const f32x4 wa = *(const LAS f32x4*)(W8T + e * 1024 + d), wb = *(const LAS f32x4*)(W8T + e * 1024 + d + 4);
                acc[e] += ((x[0] * wa.x + x[1] * wa.y) + (x[2] * wa.z + x[3] * wa.w)) + ((x[4] * wb.x + x[5] * wb.y) + (x[6] * wb.z + x[7] * wb.w)); }
        }
        const float ssq = wave_sum(F.lane < 16 ? SSQ[(size_t)row * 16 + F.lane] : 0.f);
        const float rstd = rsqrtf(ssq * (1.0f / D) + EPS);
#pragma unroll
        for (int e = 0; e < 8; ++e) acc[e] = wave_sum(acc[e]);
        if (F.lane == 0) {
            float v0 = -INFINITY, v1 = -INFINITY; int e0 = 0, e1 = 0;
#pragma unroll
            for (int e = 0; e < 8; ++e) { const float lg = rstd * acc[e] + CR[b * 8 + e] + a.router_b[e]; if (lg > v0) { v1 = v0; e1 = e0; v0 = lg; e0 = e; } else if (lg > v1) { v1 = lg; e1 = e; } }
            const float ex = __expf(v1 - v0), p0 = 1.0f / (1.0f + ex), p1 = ex / (1.0f + ex);
            unsigned* cnt = (unsigned*)(F.ws + WS_CTL) + CW_MOECNT;
            const int q0 = (int)atomicAdd(cnt + 64 * e0, 1u), q1 = (int)atomicAdd(cnt + 64 * e1, 1u);
            int* R = (int*)(F.ws + WS_ROUTE) + (size_t)row * 4; R[0] = e0; R[1] = e1; ((float*)R)[2] = p0; ((float*)R)[3] = p1;
            int* Pq = (int*)(F.ws + WS_POS) + (size_t)row * 2; Pq[0] = q0; Pq[1] = q1;
            int* RM = (int*)(F.ws + WS_RMAP); RM[(size_t)e0 * T + q0] = row; RM[(size_t)e1 * T + q1] = row;
        }
    }
    __syncthreads();
}

__global__ void __launch_bounds__(NTHREADS, 2) fwd(Args a) {
    extern __shared__ __attribute__((aligned(16))) unsigned char lds_raw[];
    Frame F;
    F.lds = (LAS unsigned char*)lds_raw;
    F.tid = threadIdx.x; F.lane = F.tid & 63; F.wave = __builtin_amdgcn_readfirstlane(F.tid >> 6);
    F.bid = blockIdx.x; F.nb = gridDim.x; F.gw = F.bid * NWAVES + F.wave; F.ngw = F.nb * NWAVES; F.ws = (GAS unsigned char*)a.ws;
    volatile LAS unsigned* MISC = (volatile LAS unsigned*)(F.lds + MISC_OFF);
    for (int u = F.tid; u < 32; u += NTHREADS) MISC[u] = 0u;
    __syncthreads();
    unsigned* ctl = (unsigned*)(a.ws + WS_CTL);
    const int lo = a.ph_lo, hi = a.ph_hi;
    const bool multi = (hi - lo) > 1;
    XcdBarrier bar; bar.bar = ctl + CW_BAR; bar.x = 0; bar.st = MISC + 8;
    if (multi) bar = xcd_barrier_post(ctl + CW_BAR, MISC + 8);
#define IN(k) (lo <= (k) && (k) < hi && (frame_refresh(F, a, (LAS unsigned char*)lds_raw), true))
#define SEAM(k) do { if (IN((k) + 1) && IN(k)) xcd_barrier(bar); } while (0)
    float* MOD = (float*)(a.ws + WS_MOD);
    bf16_t* H = (bf16_t*)(a.ws + WS_H); bf16_t* PROJ = (bf16_t*)(a.ws + WS_PROJ); bf16_t* YMIX = (bf16_t*)(a.ws + WS_YMIX);
    bf16_t* WT = (bf16_t*)(a.ws + WS_WT);
    bf16_t* ACT = (bf16_t*)(a.ws + WS_ACT); bf16_t* ACTM = (bf16_t*)(a.ws + WS_ACTM); bf16_t* YMOE = (bf16_t*)(a.ws + WS_YMOE);

    if (IN(PH_PRO)) { REP(1) { ph_pro_naive(a, F); ph_pro_weights(a, F); } SEAM(PH_PRO); }

#define TWICE(bit, stmt) do { stmt; if constexpr ((PROBE_MASK & (bit)) != 0) { stmt; } } while (0)
    float* AV = (float*)(a.ws + WS_AV); float* SSQ = (float*)(a.ws + WS_SSQ); bf16_t* X16 = (bf16_t*)(a.ws + WS_X16);
    const LAS float* RSL = (const LAS float*)(F.lds + RS_OFF);
#define LAYER_BODY(l) {\
        const int pb = PH_LAYER0 + PH_PER_LAYER * l; \
        const float* xin = (l == 0) ? a.x : a.out; \
        const float* mod0 = MOD + (size_t)(l * 2 + 0) * 2 * 3072; const float* mod1 = MOD + (size_t)(l * 2 + 1) * 2 * 3072; \
        if (l == 0) { \
            if (IN(pb + K_NORM1)) { REP(2) ph_norm<1>(a, F, l, xin, a.nmg + l * D, mod0, a.w_in + (size_t)l * D * N_IN + W_DB, N_IN); ph_prep_vectors(a, F); SEAM(pb + K_NORM1); } \
            if (IN(pb + K_GEMM_IN)) { \
                TWICE(4, ({ pg8::Gemm g{H, WT + WT_WIN, D}; pg8::StaticOrder S; S.init(T, NP, F.nb, F.bid); pg8::EpiBf16 E{PROJ, NP, 1 << 20}; \
                    pg8::gemm_phase<pg8::EpiBf16, pg8::StaticOrder, false, true, true>(F.lds, nullptr, g, S, E); })); \
                SEAM(pb + K_GEMM_IN); \
            } \
        } else { \
            if (IN(pb + K_GEMM_IN)) { \
                TWICE(4, ({ pg8::Gemm g{H, WT + WT_WIN + (size_t)NPW * D, D}; pg8::StaticOrder S; S.init(T, NPW, F.nb, F.bid); rstd_preload(F, S, SSQ + (size_t)1 * T * 16, nullptr); \
                    pg8::EpiProjNorm E{PROJ, RSL, (const float*)(a.ws + WS_CVI), (float*)(a.ws + WS_BG), a.dn_a_log + 4, a.dn_dt_bias + 4}; \
                    pg8::gemm_phase<pg8::EpiProjNorm, pg8::StaticOrder, false, true, true>(F.lds, nullptr, g, S, E); })); \
                SEAM(pb + K_GEMM_IN); \
            } \
        } \
        if (IN(pb + K_DN_PREP)) { REP(8) ph_dn_chunk(a, F, l); ph_rope(a, F); SEAM(pb + K_DN_PREP); } \
        if (IN(pb + K_MIX)) { REP(16) ph_dn_scan(a, F); REP(512) ph_attn_mfma(a, F, l); REP(1024) ph_conv_fast(a, F, l); SEAM(pb + K_MIX); } \
        if (IN(pb + K_DN_OUT)) { REP(32) ph_dn_out(a, F, l); SEAM(pb + K_DN_OUT); } \
        if (IN(pb + K_GEMM_OUT)) { \
            TWICE((l == 0) ? 64 : 0, ({ pg8::Gemm g{YMIX, WT + WT_WOUT + (size_t)l * D * D, D}; pg8::StaticOrder S; S.init(T, D, F.nb, F.bid); \
                pg8::EpiResidNorm<(l == 0)> E{(l == 0) ? (const void*)a.x : (const void*)X16, X16, mod0 + 2048, AV + (size_t)(l == 0 ? 0 : 2) * BATCH * D, H, SSQ + (size_t)(l == 0 ? 0 : 2) * T * 16}; \
                pg8::gemm_phase<pg8::EpiResidNorm<(l == 0)>, pg8::StaticOrder, false, true, true>(F.lds, nullptr, g, S, E); })); \
            SEAM(pb + K_GEMM_OUT); \
        } \
        if (l == 0) { \
            if (IN(pb + K_FFN1)) { \
                TWICE(256, ({ pg8::Gemm g{H, WT + WT_FGU, D}; pg8::StaticOrder S; S.init(T, 2 * D_FF, F.nb, F.bid); rstd_preload(F, S, SSQ, nullptr); \
                    pg8::EpiSwiGLUNorm E{ACT, D_FF, 1 << 20, RSL, (const float*)(a.ws + WS_CVF), 5632}; \
                    pg8::gemm_phase<pg8::EpiSwiGLUNorm, pg8::StaticOrder, false, true, true>(F.lds, nullptr, g, S, E); })); \
                SEAM(pb + K_FFN1); \
            } \
            if (IN(pb + K_FFN2)) { \
                { pg8::Gemm g{ACT, WT + WT_FD, D_FF}; pg8::StaticOrder S; S.init(T, D, F.nb, F.bid); \
                    pg8::EpiResidNorm<false> E{(const void*)X16, X16, mod1 + 2048, AV + (size_t)1 * BATCH * D, H, SSQ + (size_t)1 * T * 16}; \
                    pg8::gemm_phase<pg8::EpiResidNorm<false>, pg8::StaticOrder, false, true, true>(F.lds, nullptr, g, S, E); } \
                SEAM(pb + K_FFN2); \
            } \
        } else { \
            if (IN(pb + K_NORM2)) { ph_router(a, F); SEAM(pb + K_NORM2); } \
            if (IN(pb + K_FFN1)) { \
                TWICE(2048, ({ pg8::MoeOrder<8> S; moe_order_init<8>(F, S); moe_ri_preload<8>(F, S); rstd_preload(F, S, SSQ + (size_t)2 * T * 16, (const LAS int*)(F.lds + RI_OFF)); \
                    pg8::Gemm g{H, WT + WT_MGU, D}; pg8::EpiSwiGLUNorm E{ACTM, D_FFE, 8, RSL, (const float*)(a.ws + WS_CVM), 16384}; \
                    pg8::gemm_phase<pg8::EpiSwiGLUNorm, pg8::MoeOrder<8>, true, true, true>(F.lds, (const LAS int*)(F.lds + RI_OFF), g, S, E); })); \
                SEAM(pb + K_FFN1); \
            } \
            if (IN(pb + K_FFN2)) { \
                TWICE(4096, ({ pg8::MoeOrder<4> S; moe_order_init<4>(F, S); \
                    pg8::Gemm g{ACTM, WT + WT_MD, D_FFE}; pg8::EpiBf16 E{YMOE, D, 4}; \
                    pg8::gemm_phase<pg8::EpiBf16, pg8::MoeOrder<4>, false, true, true>(F.lds, nullptr, g, S, E); })); \
                SEAM(pb + K_FFN2); \
            } \
        } \
    }
    LAYER_BODY(0)
    LAYER_BODY(1)
#undef LAYER_BODY
    if (IN(PH_FINAL)) { ph_final(a, F); }
#undef IN
#undef SEAM
}

extern "C" void kernel_launch(void* const* d_in, const int* in_sizes, int n_in, void* d_out, int out_size, void* d_ws, size_t ws_size, hipStream_t stream) {
    static int grid = 0;
    if (grid == 0) {
        if (n_in != 27 || out_size != T * D || ws_size < WS_END) { fprintf(stderr, "kernel_launch: unexpected shapes n_in %d out %d ws %zu\n", n_in, out_size, ws_size); grid = -1; return; }
        int dev = 0, cus = 0, per_cu = 0;
        if (hipGetDevice(&dev) != hipSuccess || hipDeviceGetAttribute(&cus, hipDeviceAttributeMultiprocessorCount, dev) != hipSuccess) { grid = -1; return; }
        if (hipFuncSetAttribute((const void*)fwd, hipFuncAttributeMaxDynamicSharedMemorySize, LDS_BYTES) != hipSuccess) { fprintf(stderr, "kernel_launch: hipFuncSetAttribute failed\n"); grid = -1; return; }
        if (hipOccupancyMaxActiveBlocksPerMultiprocessor(&per_cu, (const void*)fwd, NTHREADS, LDS_BYTES) != hipSuccess || per_cu < 1) fprintf(stderr, "kernel_launch: occupancy query says %d\n", per_cu);
        (void)hipGetLastError();
        grid = cus;
    }
    if (grid < 0) return;
    (void)hipMemsetAsync((char*)d_ws + WS_CTL, 0, CTL_ZERO_BYTES, stream);
    Args a{};
    const void** pp = (const void**)&a;
    for (int i = 0; i < 27; ++i) pp[i] = d_in[i];
    a.out = (float*)d_out; a.ws = (unsigned char*)d_ws;
#if MK_ONE_LAUNCH
    a.ph_lo = 0; a.ph_hi = NPH;
    hipLaunchKernelGGL(fwd, dim3(grid), dim3(NTHREADS), LDS_BYTES, stream, a);
#else
    static const int phases[] = {0, 1, 2, 3, 4, 5, 6, 7, 9, 10, 11, 12, 13, 14, 15, 16, 17, 18, 19, 20, 21};
    for (int p : phases) { a.ph_lo = p; a.ph_hi = p + 1; hipLaunchKernelGGL(fwd, dim3(grid), dim3(NTHREADS), LDS_BYTES, stream, a); }
#endif
}
```

```cpp
#include <hip/hip_runtime.h>
#include <cstdio>
#include <cstdint>

#define LAS __attribute__((address_space(3)))
#define GAS __attribute__((address_space(1)))
typedef unsigned short bf16_t;
typedef float f32x4 __attribute__((ext_vector_type(4)));
typedef unsigned u32x2 __attribute__((ext_vector_type(2)));
typedef unsigned u32x4 __attribute__((ext_vector_type(4)));

#ifndef GEMM_MASK
#define GEMM_MASK 63
#endif
#ifndef ATTN_MFMA
#define ATTN_MFMA 1
#endif
#ifndef DN_CHUNKED
#define DN_CHUNKED 1
#endif
#ifndef CONV_FAST
#define CONV_FAST 1
#endif
#ifndef PROBE_MASK
#define PROBE_MASK 0
#endif
#define REP(bit) for (int rep_ = 0; rep_ < ((PROBE_MASK & (bit)) ? 2 : 1); ++rep_)
#ifndef MK_ONE_LAUNCH
#define MK_ONE_LAUNCH 1
#endif

constexpr int BATCH = 2, SEQ = 16384, T = BATCH * SEQ, D = 1024, DEPTH = 2;
constexpr int NPW = 2560;
constexpr int N_IN = 2312, NP = 2304;
constexpr int C_AQ = 0, C_AK = 512, C_AV = 640, C_DQ = 768, C_DK = 1024, C_DV = 1280, C_DZ = 1536, C_CA = 1792, C_CB = 2048;
constexpr int W_DB = 1536;
constexpr int D_FF = 2816, NE = 8, D_FFE = 1024;
constexpr int WINDOW = 128, CV_K = 31, CV_C = 256, DN_CONV = 4;
constexpr float EPS = 1e-6f;
constexpr int NSCAN = BATCH * 4 * 4;
constexpr int MOE_CAP = 67584;

constexpr size_t MiB = 1u << 20;
constexpr size_t WS_CTL = 0, CTL_ZERO_BYTES = 1 * MiB;
constexpr size_t WS_MOD = 1 * MiB;
constexpr size_t WS_CS = 2 * MiB;
constexpr size_t WS_BG = 4 * MiB;
constexpr size_t WS_ROUTE = 5 * MiB;
constexpr size_t WS_POS = 6 * MiB;
constexpr size_t WS_RMAP = 7 * MiB;
constexpr size_t WS_WT = 8 * MiB;
constexpr size_t WS_H = 88 * MiB;
constexpr size_t WS_PROJ = 152 * MiB;
constexpr size_t WS_YMIX = 296 * MiB;
constexpr size_t WS_DNQKV = 360 * MiB;
constexpr size_t WS_ODN = 456 * MiB;
constexpr size_t WS_ACT = 152 * MiB;
constexpr size_t WS_ACTM = 152 * MiB;
constexpr size_t WS_YMOE = 284 * MiB;
constexpr size_t WS_X16 = 440 * MiB;
constexpr size_t WS_SSQ = 504 * MiB;
constexpr size_t WS_AV = WS_MOD + 128 * 1024;
constexpr size_t WS_CVF = WS_MOD + 256 * 1024;
constexpr size_t WS_CVI = WS_CVF + 2 * 5632 * 4;
constexpr size_t WS_CVM = WS_CVI + 2 * 2560 * 4;
constexpr size_t WS_CR = WS_CVM + 2 * 16384 * 4;
constexpr size_t WS_CVI0 = WS_CR + 64;
static_assert(WS_CVI0 + 2 * 2560 * 4 <= WS_CS, "vector area");
constexpr size_t WS_END = 512 * MiB;
constexpr int CW_BAR = 4096;
constexpr int CW_MOECNT = 16384;

constexpr int NWAVES = 8, NTHREADS = 512;
constexpr int LDS_BYTES = 163840;
constexpr int MISC_OFF = 131072 + 320;
constexpr int RI_OFF = 132096;
constexpr int RS_OFF = 147456;

constexpr int PH_PRO = 0, PH_LAYER0 = 1, PH_PER_LAYER = 10, PH_FINAL = 21, NPH = 22;
enum { K_NORM1 = 0, K_GEMM_IN, K_DN_PREP, K_MIX, K_DN_OUT, K_GEMM_OUT, K_NORM2, K_MOE_LIST, K_FFN1, K_FFN2 };

struct Args {
    const float* x; const float* c; const int* pos; const float* ada_w; const float* ada_b; const float* nmg; const float* nfg;
    const float* w_in; const float* sinks; const float* dn_conv_w; const float* dn_a_log; const float* dn_dt_bias; const float* dn_norm_g;
    const float* cv_dw_w; const float* cv_dw_b; const float* cv_ln_g; const float* cv_ln_b; const float* w_out;
    const float* ffn_wg; const float* ffn_wu; const float* ffn_wd; const float* router_w; const float* router_b;
    const float* moe_wg; const float* moe_wu; const float* moe_wd; const float* final_g;
    float* out; unsigned char* ws; int ph_lo, ph_hi;
};

__device__ __forceinline__ float bf2f(unsigned u) { return __uint_as_float(u << 16); }
__device__ __forceinline__ unsigned f2bf(float f) { unsigned u = __float_as_uint(f); return (u + 0x7fffu + ((u >> 16) & 1u)) >> 16; }
__device__ __forceinline__ unsigned pk2(float lo, float hi) { return f2bf(lo) | (f2bf(hi) << 16); }
__device__ __forceinline__ float wave_sum(float v) {
#pragma unroll
    for (int o = 1; o < 64; o <<= 1) v += __shfl_xor(v, o);
    return v;
}
__device__ __forceinline__ float wave_max(float v) {
#pragma unroll
    for (int o = 1; o < 64; o <<= 1) v = fmaxf(v, __shfl_xor(v, o));
    return v;
}
__device__ __forceinline__ float sigmoidf_(float x) { return __builtin_amdgcn_rcpf(1.0f + __builtin_amdgcn_exp2f(x * -1.4426950408889634f)); }
__device__ __forceinline__ float siluf_(float x) { return x * __builtin_amdgcn_rcpf(1.0f + __builtin_amdgcn_exp2f(x * -1.4426950408889634f)); }
__device__ __forceinline__ float softplusf_(float x) { return fmaxf(x, 0.f) + log1pf(__expf(-fabsf(x))); }

#define XB_TMO      128
#define XB_XCNT(j)  (256  + 64 * (j))
#define XB_XSUB(j)  (1280 + 64 * (j))
#define XB_XGEN(j)  (2304 + 64 * (j))
#define XB_TOP      3328
#define XB_TOPGEN   3392
#define XCD_BAR_WORDS 3456
#define XB_SPIN_CAP (1u << 18)

__device__ __forceinline__ unsigned xb_ld(unsigned* p)              { return __hip_atomic_load(p, __ATOMIC_RELAXED, __HIP_MEMORY_SCOPE_AGENT); }
__device__ __forceinline__ unsigned xb_add(unsigned* p, unsigned v) { return __hip_atomic_fetch_add(p, v, __ATOMIC_RELAXED, __HIP_MEMORY_SCOPE_AGENT); }
__device__ __forceinline__ unsigned xb_xcc_id() { return (unsigned)__builtin_amdgcn_s_getreg((3 << 11) | 20) & 0xFu; }
#define XB_SPIN(cond, bar) do { unsigned _sp = 0; while (cond) { __builtin_amdgcn_s_sleep(1); \
    if ((++_sp & 255u) == 0u) { if (xb_ld(&(bar)[XB_TMO])) break; if (_sp > XB_SPIN_CAP) { atomicAdd(&(bar)[XB_TMO], 1u); break; } } } } while (0)

struct XcdBarrier { unsigned* bar; unsigned x; volatile LAS unsigned* st; };

__device__ __forceinline__ XcdBarrier xcd_barrier_post(unsigned* bar, volatile LAS unsigned* st) {
    XcdBarrier b; b.bar = bar; b.x = xb_xcc_id(); b.st = st;
    if (threadIdx.x == 0) (void)xb_add(&bar[XB_XCNT(b.x)], 1u);
    return b;
}
__device__ __forceinline__ void xcd_barrier_complete(unsigned* bar, unsigned x, unsigned& nloc, unsigned& nx) {
    const unsigned G = gridDim.x * gridDim.y * gridDim.z;
    unsigned sum, cnt, mine, sp = 0u;
    for (;;) {
        sum = 0u; cnt = 0u; mine = 0u;
#pragma unroll
        for (unsigned j = 0; j < 16; ++j) { const unsigned c = xb_ld(&bar[XB_XCNT(j)]); sum += c; cnt += (c > 0u) ? 1u : 0u; mine = (j == x) ? c : mine; }
        if (sum == G) break;
        __builtin_amdgcn_s_sleep(1);
        if ((++sp & 255u) == 0u) { if (xb_ld(&bar[XB_TMO])) break; if (sp > XB_SPIN_CAP) { atomicAdd(&bar[XB_TMO], 1u); break; } }
    }
    nloc = mine > 0u ? mine : 1u; nx = cnt > 0u ? cnt : 1u;
}
__device__ __forceinline__ void xcd_barrier(const XcdBarrier& b) {
    asm volatile("s_waitcnt vmcnt(0)" ::: "memory");
    __syncthreads();
    if (threadIdx.x == 0) {
        unsigned* bar = b.bar;
        __builtin_amdgcn_s_waitcnt(0);
        unsigned nloc = b.st[0], nx = b.st[1];
        if (nloc == 0u) { xcd_barrier_complete(bar, b.x, nloc, nx); b.st[0] = nloc; b.st[1] = nx; }
        const unsigned old = xb_add(&bar[XB_XSUB(b.x)], 1u);
        const unsigned gen = old / nloc;
        if (old + 1u == (gen + 1u) * nloc) {
            __builtin_amdgcn_fence(__ATOMIC_RELEASE, "agent");
            asm volatile("s_waitcnt vmcnt(0)" ::: "memory");
            const unsigned og = xb_add(&bar[XB_TOP], 1u);
            const unsigned tg = og / nx;
            if (og + 1u == (tg + 1u) * nx) xb_add(&bar[XB_TOPGEN], 1u);
            else XB_SPIN(xb_ld(&bar[XB_TOPGEN]) == tg, bar);
            __builtin_amdgcn_fence(__ATOMIC_ACQUIRE, "agent");
            xb_add(&bar[XB_XGEN(b.x)], 1u);
            asm volatile("s_waitcnt vmcnt(0)" ::: "memory");
        } else {
            XB_SPIN(xb_ld(&bar[XB_XGEN(b.x)]) == gen, bar);
            __builtin_amdgcn_fence(__ATOMIC_ACQUIRE, "agent");
            asm volatile("s_waitcnt vmcnt(0)" ::: "memory");
        }
    }
    __syncthreads();
}

struct Frame {
    LAS unsigned char* lds;
    int tid, lane, wave, gw, ngw, bid, nb;
    GAS unsigned char* ws;
};

__device__ __forceinline__ void frame_refresh(Frame& F, const Args& a, LAS unsigned char* lds) {
    int tid = threadIdx.x; asm volatile("" : "+v"(tid));
    int bid = blockIdx.x; asm volatile("" : "+s"(bid));
    unsigned char* ws = a.ws; asm volatile("" : "+s"(ws));
    F.lds = lds; F.tid = tid; F.lane = tid & 63; F.wave = __builtin_amdgcn_readfirstlane(tid >> 6);
    F.bid = bid; F.nb = gridDim.x; F.gw = F.bid * NWAVES + F.wave; F.ngw = F.nb * NWAVES; F.ws = (GAS unsigned char*)ws;
}
__device__ __forceinline__ void ph_pro_naive(const Args& a, Frame& F) {
    float* MOD = (float*)(F.ws + WS_MOD);
    LAS float* red = (LAS float*)F.lds;
    for (int it = F.bid; it < 4 * 48; it += F.nb) {
        const int lk = it / 48, cg = it % 48, e = cg * 64 + F.lane;
        const float* W = a.ada_w + (size_t)lk * D * 3072 + e;
        float a0 = 0.f, a1 = 0.f;
        const int d0 = F.wave * 128;
#pragma unroll 8
        for (int d = d0; d < d0 + 128; ++d) {
            const float w = W[(size_t)d * 3072];
            a0 += siluf_(a.c[d]) * w; a1 += siluf_(a.c[D + d]) * w;
        }
        red[(F.wave * 2 + 0) * 64 + F.lane] = a0; red[(F.wave * 2 + 1) * 64 + F.lane] = a1;
        __syncthreads();
        if (F.wave < 2) {
            float s = 0.f;
            for (int w = 0; w < 8; ++w) s += red[(w * 2 + F.wave) * 64 + F.lane];
            MOD[((size_t)lk * 2 + F.wave) * 3072 + e] = s + a.ada_b[lk * 3072 + e];
        }
        __syncthreads();
    }
    float* CS = (float*)(F.ws + WS_CS);
    for (int idx = F.bid * NTHREADS + F.tid; idx < T * 8; idx += F.nb * NTHREADS) {
        const int t = idx >> 3, i = idx & 7;
        const float inv = powf(500000.0f, -(float)(2 * i) / 16.0f);
        const float ang = (float)a.pos[t] * inv;
        CS[t * 16 + i] = cosf(ang); CS[t * 16 + 8 + i] = sinf(ang);
    }
}

template <int MODE>
__device__ __forceinline__ void ph_norm(const Args& a, Frame& F, int l, const float* xin, const float* gain, const float* modk  ,
                                        const float* W8, int pitch) {
    bf16_t* H = (bf16_t*)(F.ws + WS_H);
    LAS float* W8T = (LAS float*)F.lds;
    if (MODE != 0) {
        for (int i = F.tid; i < 8192; i += NTHREADS) { const int d = i >> 3, j = i & 7; W8T[j * 1024 + d] = W8[(size_t)d * pitch + j]; }
        __syncthreads();
    }
    f32x4 vn[4], A4[4], B4[4]; int cur_b = -1;
    if (F.gw < T) {
#pragma unroll
        for (int j = 0; j < 4; ++j) vn[j] = ((const f32x4*)(xin + (size_t)F.gw * D) + F.lane)[64 * j];
    }
    for (int row = F.gw; row < T; row += F.ngw) {
        const int b = row / SEQ;
        f32x4 v[4]; float ss = 0.f;
#pragma unroll
        for (int j = 0; j < 4; ++j) { v[j] = vn[j]; ss += (v[j].x * v[j].x + v[j].y * v[j].y) + (v[j].z * v[j].z + v[j].w * v[j].w); }
        if (row + F.ngw < T) {
#pragma unroll
            for (int j = 0; j < 4; ++j) vn[j] = ((const f32x4*)(xin + (size_t)(row + F.ngw) * D) + F.lane)[64 * j];
        }
        if (b != cur_b) {
            cur_b = b; const float* sh = modk + (size_t)b * 3072; const float* sc = sh + 1024;
#pragma unroll
            for (int j = 0; j < 4; ++j) { const int d = 256 * j + 4 * F.lane; A4[j] = *(const f32x4*)(gain + d) * (*(const f32x4*)(sc + d) + 1.0f); B4[j] = *(const f32x4*)(sh + d); }
        }
        const float rstd = rsqrtf(wave_sum(ss) * (1.0f / D) + EPS);
        float acc[8];
#pragma unroll
        for (int e = 0; e < 8; ++e) acc[e] = 0.f;
#pragma unroll
        for (int j = 0; j < 4; ++j) {
            const int d = 256 * j + 4 * F.lane;
            const f32x4 hv = (v[j] * rstd) * A4[j] + B4[j];
            u32x2 o; o.x = pk2(hv.x, hv.y); o.y = pk2(hv.z, hv.w);
            *(u32x2*)(H + (size_t)row * D + d) = o;
            if (MODE == 1) { u32x2 xo; xo.x = pk2(v[j].x, v[j].y); xo.y = pk2(v[j].z, v[j].w); *(u32x2*)((bf16_t*)(F.ws + WS_X16) + (size_t)row * D + d) = xo; }
            if (MODE != 0) {
#pragma unroll
                for (int e = 0; e < 8; ++e) { const f32x4 w4 = *(const LAS f32x4*)(W8T + e * 1024 + d); acc[e] += (hv.x * w4.x + hv.y * w4.y) + (hv.z * w4.z + hv.w * w4.w); }
            }
        }
        if (MODE != 0) {
#pragma unroll
            for (int e = 0; e < 8; ++e) acc[e] = wave_sum(acc[e]);
        }
        if (MODE == 1 && F.lane == 0) {
            float* BG = (float*)(F.ws + WS_BG) + (size_t)row * 8;
#pragma unroll
            for (int h = 0; h < 4; ++h) {
                BG[h] = sigmoidf_(acc[h]);
                BG[4 + h] = -__expf(a.dn_a_log[l * 4 + h]) * softplusf_(acc[4 + h] + a.dn_dt_bias[l * 4 + h]);
            }
        }
        if (MODE == 2 && F.lane == 0) {
            float v0 = -INFINITY, v1 = -INFINITY; int e0 = 0, e1 = 0;
#pragma unroll
            for (int e = 0; e < 8; ++e) { const float lg = acc[e] + a.router_b[e]; if (lg > v0) { v1 = v0; e1 = e0; v0 = lg; e0 = e; } else if (lg > v1) { v1 = lg; e1 = e; } }
            const float ex = __expf(v1 - v0), p0 = 1.0f / (1.0f + ex), p1 = ex / (1.0f + ex);
            unsigned* cnt = (unsigned*)(F.ws + WS_CTL) + CW_MOECNT;
            const int q0 = (int)atomicAdd(cnt + 64 * e0, 1u), q1 = (int)atomicAdd(cnt + 64 * e1, 1u);
            int* R = (int*)(F.ws + WS_ROUTE) + (size_t)row * 4; R[0] = e0; R[1] = e1; ((float*)R)[2] = p0; ((float*)R)[3] = p1;
            int* P = (int*)(F.ws + WS_POS) + (size_t)row * 2; P[0] = q0; P[1] = q1;
        }
    }
    if (MODE != 0) __syncthreads();
}

template <bool DUAL, class Epi>
__device__ __forceinline__ void gemm_naive(Frame& F, const bf16_t* A, int lda, const int* rowmap, int m_base, int Mrows, int K,
                                           const float* W0, const float* W1, int ldw, int N, int skip_at, int skip, const Epi& epi) {
    LAS float* As = (LAS float*)F.lds;
    LAS float* Bs = As + 16 * 132;
    LAS float* Bs2 = Bs + 16 * 128;
    const int ntm = Mrows / 128, ntn = N / 128;
    const int ty = F.tid >> 4, tx = F.tid & 15;
    const int ar = F.tid >> 2, ak = (F.tid & 3) * 4;
    const int bk = F.tid >> 5, bc = (F.tid & 31) * 4;
    for (int tile = F.bid; tile < ntm * ntn; tile += F.nb) {
        const int tm = tile / ntn, tn = tile % ntn, m0 = m_base + tm * 128, n0 = tn * 128;
        const int wn0 = (n0 >= skip_at) ? n0 + skip : n0;
        const int arow = rowmap ? rowmap[m0 + ar] : (m0 + ar);
        const bf16_t* ap = A + (size_t)arow * lda + ak;
        float acc0[4][8], acc1[4][8];
#pragma unroll
        for (int i = 0; i < 4; ++i)
#pragma unroll
            for (int j = 0; j < 8; ++j) { acc0[i][j] = 0.f; acc1[i][j] = 0.f; }
        for (int k0 = 0; k0 < K; k0 += 16) {
            const u32x2 av = *(const u32x2*)(ap + k0);
            const f32x4 bv = *(const f32x4*)(W0 + (size_t)(k0 + bk) * ldw + wn0 + bc);
            f32x4 bv2 = (f32x4){0.f, 0.f, 0.f, 0.f};
            if (DUAL) bv2 = *(const f32x4*)(W1 + (size_t)(k0 + bk) * ldw + wn0 + bc);
            __syncthreads();
            As[(ak + 0) * 132 + ar] = bf2f(av.x & 0xffffu); As[(ak + 1) * 132 + ar] = bf2f(av.x >> 16);
            As[(ak + 2) * 132 + ar] = bf2f(av.y & 0xffffu); As[(ak + 3) * 132 + ar] = bf2f(av.y >> 16);
            *(LAS f32x4*)(Bs + bk * 128 + bc) = bv;
            if (DUAL) *(LAS f32x4*)(Bs2 + bk * 128 + bc) = bv2;
            __syncthreads();
#pragma unroll 2
            for (int kk = 0; kk < 16; ++kk) {
                const f32x4 a4 = *(const LAS f32x4*)(As + kk * 132 + ty * 4);
                const f32x4 b0 = *(const LAS f32x4*)(Bs + kk * 128 + tx * 8), b1 = *(const LAS f32x4*)(Bs + kk * 128 + tx * 8 + 4);
                const float av4[4] = {a4.x, a4.y, a4.z, a4.w};
                const float bb[8] = {b0.x, b0.y, b0.z, b0.w, b1.x, b1.y, b1.z, b1.w};
#pragma unroll
                for (int i = 0; i < 4; ++i)
#pragma unroll
                    for (int j = 0; j < 8; ++j) acc0[i][j] += av4[i] * bb[j];
                if (DUAL) {
                    const f32x4 c0 = *(const LAS f32x4*)(Bs2 + kk * 128 + tx * 8), c1 = *(const LAS f32x4*)(Bs2 + kk * 128 + tx * 8 + 4);
                    const float cc[8] = {c0.x, c0.y, c0.z, c0.w, c1.x, c1.y, c1.z, c1.w};
#pragma unroll
                    for (int i = 0; i < 4; ++i)
#pragma unroll
                        for (int j = 0; j < 8; ++j) acc1[i][j] += av4[i] * cc[j];
                }
            }
        }
#pragma unroll
        for (int i = 0; i < 4; ++i)
#pragma unroll
            for (int j = 0; j < 8; ++j) epi(m0 + ty * 4 + i, n0 + tx * 8 + j, acc0[i][j], acc1[i][j]);
    }
    __syncthreads();
}
struct EpiStoreBf16 { bf16_t* C; int ldc; __device__ __forceinline__ void operator()(int m, int n, float a0, float) const { C[(size_t)m * ldc + n] = (bf16_t)f2bf(a0); } };
struct EpiSwiglu { bf16_t* C; int ldc; __device__ __forceinline__ void operator()(int m, int n, float a0, float a1) const { C[(size_t)m * ldc + n] = (bf16_t)f2bf(siluf_(a0) * a1); } };
struct EpiResid { const float* xin; float* xout; const float* gate;   __device__ __forceinline__ void operator()(int m, int n, float a0, float) const {
    const int b = m / SEQ; xout[(size_t)m * D + n] = xin[(size_t)m * D + n] + gate[(size_t)b * 3072 + n] * a0; } };

__device__ __forceinline__ void ph_dn_prep_naive(const Args& a, Frame& F, int l) {
    const bf16_t* P = (const bf16_t*)(F.ws + WS_PROJ);
    float* Q = (float*)(F.ws + WS_DNQKV);
    const float* cw = a.dn_conv_w + (size_t)l * DN_CONV * 768;
    for (int t = F.gw; t < T; t += F.ngw) {
        const int s = t % SEQ;
#pragma unroll
        for (int j = 0; j < 12; ++j) {
            const int c = F.lane + 64 * j;
            float acc = 0.f;
#pragma unroll
            for (int k = 0; k < DN_CONV; ++k) { const int sp = s - (DN_CONV - 1) + k; if (sp >= 0) acc += cw[k * 768 + c] * bf2f(P[(size_t)(t - (DN_CONV - 1) + k) * NP + C_DQ + c]); }
            float val = siluf_(acc);
            if (j < 8) { const float n2 = wave_sum(val * val); val *= rsqrtf(n2 + EPS); if (j < 4) val *= 0.125f; }
            Q[(size_t)t * 768 + c] = val;
        }
    }
}
__device__ __forceinline__ void ph_dn_scan_naive(const Args& a, Frame& F) {
    const float* Q = (const float*)(F.ws + WS_DNQKV); const float* BG = (const float*)(F.ws + WS_BG); float* O = (float*)(F.ws + WS_ODN);
    for (int task = F.gw; task < BATCH * 4 * 64; task += F.ngw) {
        const int col = task & 63, h = (task >> 6) & 3, b = task >> 8;
        float S = 0.f;
        for (int s0 = 0; s0 < SEQ; s0 += 8) {
            float q8[8], k8[8], v8[8], b8[8], g8[8];
#pragma unroll
            for (int i = 0; i < 8; ++i) { const size_t t = (size_t)b * SEQ + s0 + i; q8[i] = Q[t * 768 + h * 64 + F.lane]; k8[i] = Q[t * 768 + 256 + h * 64 + F.lane]; v8[i] = Q[t * 768 + 512 + h * 64 + col];
                b8[i] = BG[t * 8 + h]; g8[i] = BG[t * 8 + 4 + h]; }
#pragma unroll
            for (int i = 0; i < 8; ++i) {
                const float eg = __expf(g8[i]);
                const float kS = wave_sum(k8[i] * S);
                const float dl = b8[i] * (v8[i] - eg * kS);
                S = eg * S + k8[i] * dl;
                const float o = wave_sum(q8[i] * S);
                if (F.lane == 0) O[((size_t)b * SEQ + s0 + i) * 256 + h * 64 + col] = o;
            }
        }
    }
}
__device__ __forceinline__ void ph_dn_out_naive(const Args& a, Frame& F, int l) {
    const float* O = (const float*)(F.ws + WS_ODN); const bf16_t* P = (const bf16_t*)(F.ws + WS_PROJ); bf16_t* Y = (bf16_t*)(F.ws + WS_YMIX);
    for (int task = F.gw; task < T * 4; task += F.ngw) {
        const int t = task >> 2, h = task & 3;
        const float o = O[(size_t)t * 256 + h * 64 + F.lane];
        const float ms = wave_sum(o * o) * (1.0f / 64.0f);
        const float z = bf2f(P[(size_t)t * NP + C_DZ + h * 64 + F.lane]);
        const float y = o * rsqrtf(ms + EPS) * a.dn_norm_g[l * 64 + F.lane] * siluf_(z);
        Y[(size_t)t * D + 512 + h * 64 + F.lane] = (bf16_t)f2bf(y);
    }
}
__device__ __forceinline__ float rope_lane(float x, int lane, const float* cs) {
    const float xp = __shfl(x, lane ^ 8);
    if (lane < 8) return x * cs[lane] - xp * cs[8 + lane];
    if (lane < 16) return x * cs[lane - 8] + xp * cs[lane];
    return x;
}
__device__ __forceinline__ void ph_attn_naive(const Args& a, Frame& F, int l) {
    const bf16_t* P = (const bf16_t*)(F.ws + WS_PROJ); bf16_t* Y = (bf16_t*)(F.ws + WS_YMIX); const float* CS = (const float*)(F.ws + WS_CS);
    for (int task = F.gw; task < T * 8; task += F.ngw) {
        const int t = task >> 3, hq = task & 7, hk = hq >> 2, s = t % SEQ;
        float q = bf2f(P[(size_t)t * NP + C_AQ + hq * 64 + F.lane]);
        if (!ATTN_MFMA) q = rope_lane(q, F.lane, CS + (size_t)t * 16);
        float sc0 = -INFINITY, sc1 = -INFINITY;
        for (int j = 0; j < WINDOW; ++j) {
            const int sp = s - (WINDOW - 1) + j;
            if (sp < 0) continue;
            const size_t tk = (size_t)t - (WINDOW - 1) + j;
            float k = bf2f(P[tk * NP + C_AK + hk * 64 + F.lane]);
            if (!ATTN_MFMA) k = rope_lane(k, F.lane, CS + tk * 16);
            const float sc = wave_sum(q * k) * 0.125f;
            if (F.lane == (j & 63)) { if (j < 64) sc0 = sc; else sc1 = sc; }
        }
        const float sink = a.sinks[l * 8 + hq];
        const float m = fmaxf(wave_max(fmaxf(sc0, sc1)), sink);
        const float p0 = __expf(sc0 - m), p1 = __expf(sc1 - m);
        const float den = wave_sum(p0 + p1) + __expf(sink - m);
        float o = 0.f;
        for (int j = 0; j < WINDOW; ++j) {
            const int sp = s - (WINDOW - 1) + j;
            if (sp < 0) continue;
            const size_t tk = (size_t)t - (WINDOW - 1) + j;
            const float p = __shfl(j < 64 ? p0 : p1, j & 63);
            o += p * bf2f(P[tk * NP + C_AV + hk * 64 + F.lane]);
        }
        Y[(size_t)t * D + hq * 64 + F.lane] = (bf16_t)f2bf(o / den);
    }
}

typedef float f32x16 __attribute__((ext_vector_type(16)));
typedef short s16x4 __attribute__((ext_vector_type(4)));
typedef short bf16x8_t __attribute__((ext_vector_type(8)));
__device__ __forceinline__ unsigned cvtpk(float lo, float hi) { typedef float f2_t __attribute__((ext_vector_type(2))); typedef __bf16 b2_t __attribute__((ext_vector_type(2)));
    f2_t v = {lo, hi}; b2_t b = __builtin_convertvector(v, b2_t); return __builtin_bit_cast(unsigned, b); }
__device__ __forceinline__ void ph_rope(const Args& a, Frame& F) {
    bf16_t* P = (bf16_t*)(F.ws + WS_PROJ); const float* CS = (const float*)(F.ws + WS_CS);
    for (int it = F.bid * NTHREADS + F.tid; it < T * 10; it += F.nb * NTHREADS) {
        const int t = it / 10, hh = it % 10;
        bf16_t* p = P + (size_t)t * NP + hh * 64;
        const u32x4 x1 = *(const u32x4*)p, x2 = *(const u32x4*)(p + 8);
        const f32x4 c0 = *(const f32x4*)(CS + (size_t)t * 16), c1 = *(const f32x4*)(CS + (size_t)t * 16 + 4), s0 = *(const f32x4*)(CS + (size_t)t * 16 + 8), s1 = *(const f32x4*)(CS + (size_t)t * 16 + 12);
        const float cs[8] = {c0.x, c0.y, c0.z, c0.w, c1.x, c1.y, c1.z, c1.w}, sn[8] = {s0.x, s0.y, s0.z, s0.w, s1.x, s1.y, s1.z, s1.w};
        const unsigned xa[4] = {x1.x, x1.y, x1.z, x1.w}, xb[4] = {x2.x, x2.y, x2.z, x2.w};
        unsigned ra[4], rb[4];
#pragma unroll
        for (int i = 0; i < 4; ++i) {
            const float a0 = bf2f(xa[i] & 0xffffu), a1 = bf2f(xa[i] >> 16), b0 = bf2f(xb[i] & 0xffffu), b1 = bf2f(xb[i] >> 16);
            ra[i] = pk2(a0 * cs[2 * i] - b0 * sn[2 * i], a1 * cs[2 * i + 1] - b1 * sn[2 * i + 1]);
            rb[i] = pk2(b0 * cs[2 * i] + a0 * sn[2 * i], b1 * cs[2 * i + 1] + a1 * sn[2 * i + 1]);
        }
        *(u32x4*)p = (u32x4){ra[0], ra[1], ra[2], ra[3]}; *(u32x4*)(p + 8) = (u32x4){rb[0], rb[1], rb[2], rb[3]};
    }
}
constexpr int AT_KROW = 144, AT_VOFF = 256 * AT_KROW;
__device__ __forceinline__ void ph_attn_mfma(const Args& a, Frame& F, int l) {
    const bf16_t* P = (const bf16_t*)(F.ws + WS_PROJ); bf16_t* Y = (bf16_t*)(F.ws + WS_YMIX);
    LAS unsigned char* Kl = F.lds; LAS unsigned char* Vl = F.lds + AT_VOFF;
    const int lane = F.lane, r = lane & 31, h = lane >> 5, g = F.wave >> 1, qh = F.wave & 1;
    const int i16 = lane & 15, tq_ = i16 >> 2, tp_ = i16 & 3, g16 = (lane >> 4) & 1, sw = (tq_ >> 1) & 1;
    const int vlane = (4 * h + tq_) * 128 + (2 * g16 + (tp_ >> 1)) * 16 + (tp_ & 1) * 8;
    const float C = 0.125f * 1.4426950408889634f;
    const int nsc = NSCAN;
    if (F.bid < nsc) return;
    for (int u = F.bid - nsc; u < BATCH * 128 * 2; u += F.nb - nsc) {
        const int hk = u & 1, n = (u >> 1) & 127, b = u >> 8;
        const int tq0 = b * SEQ + n * 128, tk0 = tq0 - 128;
        __syncthreads();
#pragma unroll
        for (int i = 0; i < 4; ++i) {
            const int piece = F.tid + NTHREADS * i, key = piece >> 3, c = piece & 7;
            u32x4 kv = (u32x4){0u, 0u, 0u, 0u}, vv = kv;
            if (n > 0 || key >= 128) { const bf16_t* rowp = P + (size_t)(tk0 + key) * NP; kv = *(const u32x4*)(rowp + C_AK + hk * 64 + c * 8); vv = *(const u32x4*)(rowp + C_AV + hk * 64 + c * 8); }
            *(LAS u32x4*)(Kl + key * AT_KROW + c * 16) = kv;
            *(LAS u32x4*)(Vl + key * 128 + ((c ^ (((key >> 1) & 1) << 2)) * 16)) = vv;
        }
        __syncthreads();
        const int hq = hk * 4 + g;
        const float sinkl = a.sinks[l * 8 + hq] * 1.4426950408889634f;
#pragma unroll 1
        for (int sb = 0; sb < 2; ++sb) {
            const int q0 = qh * 64 + sb * 32, kt0 = qh * 2 + sb;
            const size_t tq = (size_t)(tq0 + q0 + r);
            bf16x8_t qf[4];
#pragma unroll
            for (int ks = 0; ks < 4; ++ks) qf[ks] = *(const bf16x8_t*)(P + tq * NP + hq * 64 + 16 * ks + 8 * h);
            f32x16 S[5];
#pragma unroll
            for (int kr = 0; kr < 5; ++kr) {
                f32x16 acc;
#pragma unroll
                for (int i = 0; i < 16; ++i) acc[i] = 0.f;
#pragma unroll
                for (int ks = 0; ks < 4; ++ks) { const bf16x8_t kf = *(const LAS bf16x8_t*)(Kl + (32 * (kt0 + kr) + r) * AT_KROW + (16 * ks + 8 * h) * 2);
                    acc = __builtin_amdgcn_mfma_f32_32x32x16_bf16(kf, qf[ks], acc, 0, 0, 0); }
                S[kr] = acc;
            }
            float m = sinkl;
#pragma unroll
            for (int kr = 0; kr < 5; ++kr) {
                const bool tile_ok = !(n == 0 && (kt0 + kr) < 4);
#pragma unroll
                for (int i = 0; i < 16; ++i) {
                    const int kl = (i & 3) + 8 * (i >> 2) + 4 * h;
                    bool ok = tile_ok; if (kr == 0) ok = ok && (kl > r); if (kr == 4) ok = ok && (kl <= r);
                    const float sv = ok ? S[kr][i] * C : -INFINITY; S[kr][i] = sv; m = fmaxf(m, sv);
                }
            }
            m = fmaxf(m, __shfl_xor(m, 32));
            float lsum = 0.f;
#pragma unroll
            for (int kr = 0; kr < 5; ++kr)
#pragma unroll
                for (int i = 0; i < 16; ++i) { const float p = __builtin_amdgcn_exp2f(S[kr][i] - m); S[kr][i] = p; lsum += p; }
            lsum += __shfl_xor(lsum, 32); lsum += __builtin_amdgcn_exp2f(sinkl - m);
            f32x16 O0, O1;
#pragma unroll
            for (int i = 0; i < 16; ++i) { O0[i] = 0.f; O1[i] = 0.f; }
#pragma unroll
            for (int kr = 0; kr < 5; ++kr) {
#pragma unroll
                for (int s2 = 0; s2 < 2; ++s2) {
                    u32x4 pw; pw.x = cvtpk(S[kr][8 * s2 + 0], S[kr][8 * s2 + 1]); pw.y = cvtpk(S[kr][8 * s2 + 2], S[kr][8 * s2 + 3]); pw.z = cvtpk(S[kr][8 * s2 + 4], S[kr][8 * s2 + 5]); pw.w = cvtpk(S[kr][8 * s2 + 6], S[kr][8 * s2 + 7]);
                    const bf16x8_t pf = __builtin_bit_cast(bf16x8_t, pw);
                    const int kb = (32 * (kt0 + kr) + 16 * s2) * 128 + vlane;
                    const s16x4 lo0 = __builtin_amdgcn_ds_read_tr16_b64_v4i16((LAS s16x4*)(Vl + kb + (0 ^ sw) * 64));
                    const s16x4 hi0 = __builtin_amdgcn_ds_read_tr16_b64_v4i16((LAS s16x4*)(Vl + kb + 8 * 128 + (0 ^ sw) * 64));
                    const s16x4 lo1 = __builtin_amdgcn_ds_read_tr16_b64_v4i16((LAS s16x4*)(Vl + kb + (1 ^ sw) * 64));
                    const s16x4 hi1 = __builtin_amdgcn_ds_read_tr16_b64_v4i16((LAS s16x4*)(Vl + kb + 8 * 128 + (1 ^ sw) * 64));
                    const bf16x8_t va0 = __builtin_shufflevector(lo0, hi0, 0, 1, 2, 3, 4, 5, 6, 7), va1 = __builtin_shufflevector(lo1, hi1, 0, 1, 2, 3, 4, 5, 6, 7);
                    O0 = __builtin_amdgcn_mfma_f32_32x32x16_bf16(va0, pf, O0, 0, 0, 0);
                    O1 = __builtin_amdgcn_mfma_f32_32x32x16_bf16(va1, pf, O1, 0, 0, 0);
                }
            }
            const float inv = __builtin_amdgcn_rcpf(lsum);
            bf16_t* yp = Y + tq * D + hq * 64 + 4 * h;
#pragma unroll
            for (int gq = 0; gq < 4; ++gq) {
                u32x2 o0; o0.x = cvtpk(O0[4 * gq] * inv, O0[4 * gq + 1] * inv); o0.y = cvtpk(O0[4 * gq + 2] * inv, O0[4 * gq + 3] * inv);
                u32x2 o1; o1.x = cvtpk(O1[4 * gq] * inv, O1[4 * gq + 1] * inv); o1.y = cvtpk(O1[4 * gq + 2] * inv, O1[4 * gq + 3] * inv);
                *(u32x2*)(yp + 8 * gq) = o0; *(u32x2*)(yp + 32 + 8 * gq) = o1;
            }
        }
    }
    __syncthreads();
}


constexpr size_t WS_DN_MR = 360 * MiB, WS_DN_BNT = 376 * MiB, WS_DN_QP = 392 * MiB, WS_DN_OLT = 408 * MiB, WS_DN_ST = 424 * MiB;
constexpr int DL = 72, LB = 9216;
constexpr int L_KR = 0, L_KT = LB, L_QR = 2 * LB, L_VT = 3 * LB, L_AR = 4 * LB, L_T1 = 5 * LB, L_T2 = 6 * LB, L_UT = 7 * LB, L_UPT = 8 * LB, L_WPT = 9 * LB, L_WT = 0;
constexpr int L_LR = 7 * LB, L_L21 = L_LR + 17408, L_T11T = L_L21 + 4608, L_T22R = L_T11T + 4608, L_YT = L_T22R + 4608, L_GC = 100352, L_BETA = L_GC + 256;
static_assert(L_YT + 4608 == L_GC && L_GC + 512 <= 131072, "DeltaNet LDS map");
template <int KS> __device__ __forceinline__ f32x4 mm16(const LAS unsigned char* lds, int offX, int offY, int tx, int ty, int lane) {
    f32x4 acc = (f32x4){0.f, 0.f, 0.f, 0.f};
    const int l15 = lane & 15, q = lane >> 4;
#pragma unroll
    for (int ks = 0; ks < KS; ++ks) {
        const bf16x8_t xa = *(const LAS bf16x8_t*)(lds + offX + ((16 * tx + l15) * DL + 32 * ks + 8 * q) * 2);
        const bf16x8_t yb = *(const LAS bf16x8_t*)(lds + offY + ((16 * ty + l15) * DL + 32 * ks + 8 * q) * 2);
        acc = __builtin_amdgcn_mfma_f32_16x16x32_bf16(xa, yb, acc, 0, 0, 0);
    }
    return acc;
}
__device__ __forceinline__ u32x2 pack4(f32x4 v) { u32x2 o; o.x = cvtpk(v.x, v.y); o.y = cvtpk(v.z, v.w); return o; }

__device__ __forceinline__ void ph_dn_chunk(const Args& a, Frame& F, int l) {
    const bf16_t* P = (const bf16_t*)(F.ws + WS_PROJ); const float* BG = (const float*)(F.ws + WS_BG);
    bf16_t* MR = (bf16_t*)(F.ws + WS_DN_MR); bf16_t* BNT = (bf16_t*)(F.ws + WS_DN_BNT); bf16_t* QP = (bf16_t*)(F.ws + WS_DN_QP); bf16_t* OLT = (bf16_t*)(F.ws + WS_DN_OLT);
    LAS unsigned char* lds = F.lds;
    LAS float* gcL = (LAS float*)(lds + L_GC); LAS float* betaL = (LAS float*)(lds + L_BETA);
    const float* cw = a.dn_conv_w + (size_t)l * DN_CONV * 768;
    const int lane = F.lane, w = F.wave, l15 = lane & 15, q4 = lane >> 4;
    LAS float* cwL = (LAS float*)(lds + L_GC + 512);
    int cur_h = -1;
    const int ci = F.tid >> 3, c8 = F.tid & 7;
    u32x4 xr[3][4]; float bgb = 0.f, bgg = 0.f;
#define CH_LOAD(vu_) { const int n_ = ((vu_) >> 2) & 255, h_ = (vu_) & 3, b_ = (vu_) >> 10; const int t_ = b_ * SEQ + n_ * 64 + ci; \
        _Pragma("unroll") for (int kd = 0; kd < 3; ++kd) _Pragma("unroll") for (int k = 0; k < DN_CONV; ++k) { \
            const int tt_ = (n_ * 64 + ci - (DN_CONV - 1) + k >= 0) ? t_ - (DN_CONV - 1) + k : t_; xr[kd][k] = *(const u32x4*)(P + (size_t)tt_ * NP + C_DQ + kd * 256 + h_ * 64 + c8 * 8); } \
        if (w == 0) { bgb = BG[(size_t)(b_ * SEQ + n_ * 64 + lane) * 8 + h_]; bgg = BG[(size_t)(b_ * SEQ + n_ * 64 + lane) * 8 + 4 + h_]; } }
    if (F.bid < BATCH * 4 * 256) CH_LOAD(F.bid)
    for (int vu = F.bid; vu < BATCH * 4 * 256; vu += F.nb) {
        const int n = (vu >> 2) & 255, h = vu & 3, b = vu >> 10, unit = (b * 4 + h) * 256 + n;
        const int t0 = b * SEQ + n * 64;
        __syncthreads();
        if (h != cur_h) { cur_h = h;
            for (int idx = F.tid; idx < DN_CONV * 3 * 64; idx += NTHREADS) { const int k = idx / 192, kd = (idx / 64) % 3, cc = idx & 63; cwL[idx] = cw[k * 768 + kd * 256 + h * 64 + cc]; }
            __syncthreads(); }
        {
            const int i = ci, sq = n * 64 + i;
#pragma unroll
            for (int kd = 0; kd < 3; ++kd) {
                float acc[8];
#pragma unroll
                for (int e = 0; e < 8; ++e) acc[e] = 0.f;
#pragma unroll
                for (int k = 0; k < DN_CONV; ++k) {
                    const u32x4 xv = xr[kd][k]; const float vm = (sq - (DN_CONV - 1) + k >= 0) ? 1.f : 0.f;
                    const f32x4 w0 = *(const LAS f32x4*)(cwL + (k * 3 + kd) * 64 + c8 * 8) * vm, w1 = *(const LAS f32x4*)(cwL + (k * 3 + kd) * 64 + c8 * 8 + 4) * vm;
                    acc[0] += w0.x * bf2f(xv.x & 0xffffu); acc[1] += w0.y * bf2f(xv.x >> 16); acc[2] += w0.z * bf2f(xv.y & 0xffffu); acc[3] += w0.w * bf2f(xv.y >> 16);
                    acc[4] += w1.x * bf2f(xv.z & 0xffffu); acc[5] += w1.y * bf2f(xv.z >> 16); acc[6] += w1.z * bf2f(xv.w & 0xffffu); acc[7] += w1.w * bf2f(xv.w >> 16);
                }
                float ss = 0.f;
#pragma unroll
                for (int e = 0; e < 8; ++e) { acc[e] = siluf_(acc[e]); ss += acc[e] * acc[e]; }
                if (kd < 2) {
                    ss += __shfl_xor(ss, 1); ss += __shfl_xor(ss, 2); ss += __shfl_xor(ss, 4);
                    const float rn = rsqrtf(ss + EPS) * (kd == 0 ? 0.125f : 1.0f);
#pragma unroll
                    for (int e = 0; e < 8; ++e) acc[e] *= rn;
                }
                u32x4 pk; pk.x = cvtpk(acc[0], acc[1]); pk.y = cvtpk(acc[2], acc[3]); pk.z = cvtpk(acc[4], acc[5]); pk.w = cvtpk(acc[6], acc[7]);
                if (kd == 0) *(LAS u32x4*)(lds + L_QR + (i * DL + c8 * 8) * 2) = pk;
                if (kd == 1) *(LAS u32x4*)(lds + L_KR + (i * DL + c8 * 8) * 2) = pk;
                if (kd >= 1) {
                    LAS bf16_t* Tt = (LAS bf16_t*)(lds + (kd == 1 ? L_KT : L_VT));
                    const unsigned pw[4] = {pk.x, pk.y, pk.z, pk.w};
#pragma unroll
                    for (int e = 0; e < 8; ++e) Tt[(c8 * 8 + e) * DL + i] = (bf16_t)((pw[e >> 1] >> (16 * (e & 1))) & 0xffffu);
                }
            }
            for (int idx = F.tid; idx < 2 * LB / 16; idx += NTHREADS) *(LAS u32x4*)(lds + L_T1 + idx * 16) = (u32x4){0u, 0u, 0u, 0u};
            if (w == 0) {
                float x = bgg;
#pragma unroll
                for (int o = 1; o < 64; o <<= 1) { const float y = __shfl_up(x, o); if (lane >= o) x += y; }
                gcL[lane] = x; betaL[lane] = bgb;
            }
            if (vu + F.nb < BATCH * 4 * 256) CH_LOAD(vu + F.nb)
            asm volatile("" ::: "memory");
        }
        __syncthreads();
#pragma unroll
        for (int tt = 0; tt < 2; ++tt) {
            const int tidx = 2 * w + tt, tx = tidx >> 2, ty = tidx & 3, i = 16 * ty + l15, j0 = 16 * tx + 4 * q4;
            const float gi = gcL[i], bi = betaL[i]; const f32x4 gj = *(const LAS f32x4*)(gcL + j0);
            const float gjv[4] = {gj.x, gj.y, gj.z, gj.w};
            const f32x4 zk = mm16<2>(lds, L_KR, L_KR, tx, ty, lane);
            const f32x4 zq = mm16<2>(lds, L_KR, L_QR, tx, ty, lane);
            f32x4 lv, av;
#pragma unroll
            for (int r = 0; r < 4; ++r) { const float dc = __expf(fminf(gi - gjv[r], 0.f)); lv[r] = (j0 + r < i) ? bi * zk[r] * dc : 0.f; av[r] = (j0 + r <= i) ? zq[r] * dc : 0.f; }
            *(LAS f32x4*)(lds + L_LR + (i * 68 + j0) * 4) = lv;
            if (i >= 32 && j0 < 32) *(LAS u32x2*)(lds + L_L21 + ((i - 32) * DL + j0) * 2) = pack4(lv);
            *(LAS u32x2*)(lds + L_AR + (i * DL + j0) * 2) = pack4(av);
        }
        __syncthreads();
        REP(32768) {
            const int cg = 8 * w + (lane >> 3), blk = cg >> 5, jp = cg & 31, l8 = lane & 7;
            const LAS float* Lb = (const LAS float*)(lds + L_LR) + (32 * blk) * 68 + 32 * blk + 4 * l8;
            float x0 = 0.f, x1 = 0.f, x2 = 0.f, x3 = 0.f;
#pragma unroll
            for (int i = 0; i < 32; ++i) {
                const f32x4 l4 = *(const LAS f32x4*)(Lb + i * 68);
                float part = (l4.x * x0 + l4.y * x1) + (l4.z * x2 + l4.w * x3);
                part += __shfl_xor(part, 1); part += __shfl_xor(part, 2); part += __shfl_xor(part, 4);
                const float xi = ((i == jp) ? 1.f : 0.f) - part;
                if (l8 == (i >> 2)) { if ((i & 3) == 0) x0 = xi; else if ((i & 3) == 1) x1 = xi; else if ((i & 3) == 2) x2 = xi; else x3 = xi; }
            }
            const int jg = 32 * blk + jp; const float bj = betaL[jg], bej = bj * __expf(gcL[jg]);
            LAS bf16_t* T1 = (LAS bf16_t*)(lds + L_T1); LAS bf16_t* T2 = (LAS bf16_t*)(lds + L_T2);
            const float xs[4] = {x0, x1, x2, x3};
#pragma unroll
            for (int e = 0; e < 4; ++e) { const int rg = 32 * blk + 4 * l8 + e; T1[rg * DL + jg] = (bf16_t)f2bf(xs[e] * bj); T2[rg * DL + jg] = (bf16_t)f2bf(xs[e] * bej); }
            if (blk == 0) { *(LAS u32x2*)(lds + L_T11T + (jp * DL + 4 * l8) * 2) = pack4((f32x4){x0, x1, x2, x3}); }
            else { LAS bf16_t* T22 = (LAS bf16_t*)(lds + L_T22R);
#pragma unroll
                for (int e = 0; e < 4; ++e) T22[(4 * l8 + e) * DL + jp] = (bf16_t)f2bf(xs[e]); }
        }
        __syncthreads();
        if (w < 4) {
            const int tx = w >> 1, ty = w & 1;
            const f32x4 z = mm16<1>(lds, L_L21, L_T11T, tx, ty, lane);
            *(LAS u32x2*)(lds + L_YT + ((16 * ty + l15) * DL + 16 * tx + 4 * q4) * 2) = pack4(z);
        }
        __syncthreads();
        if (w < 4) {
            const int tx = w >> 1, ty = w & 1, y = 16 * ty + l15, x0 = 16 * tx + 4 * q4;
            const f32x4 z = mm16<1>(lds, L_T22R, L_YT, tx, ty, lane);
            const float bj = betaL[y], bej = bj * __expf(gcL[y]);
            LAS bf16_t* T1 = (LAS bf16_t*)(lds + L_T1); LAS bf16_t* T2 = (LAS bf16_t*)(lds + L_T2);
#pragma unroll
            for (int r = 0; r < 4; ++r) { T1[(32 + x0 + r) * DL + y] = (bf16_t)f2bf(-z[r] * bj); T2[(32 + x0 + r) * DL + y] = (bf16_t)f2bf(-z[r] * bej); }
        }
        __syncthreads();
        const float gl = gcL[63];
#pragma unroll
        for (int tt = 0; tt < 2; ++tt) {
            const int tidx = 2 * w + tt, tx = tidx >> 2, ty = tidx & 3, y = 16 * ty + l15, x0 = 16 * tx + 4 * q4;
            const f32x4 gx = *(const LAS f32x4*)(gcL + x0);
            f32x4 sc; sc.x = __expf(gl - gx.x); sc.y = __expf(gl - gx.y); sc.z = __expf(gl - gx.z); sc.w = __expf(gl - gx.w);
            const f32x4 zu = mm16<2>(lds, L_T1, L_VT, tx, ty, lane);
            const f32x4 zw = mm16<2>(lds, L_T2, L_KT, tx, ty, lane);
            *(LAS u32x2*)(lds + L_UT + (y * DL + x0) * 2) = pack4(zu); *(LAS u32x2*)(lds + L_UPT + (y * DL + x0) * 2) = pack4(zu * sc);
            *(LAS u32x2*)(lds + L_WT + (y * DL + x0) * 2) = pack4(zw); *(LAS u32x2*)(lds + L_WPT + (y * DL + x0) * 2) = pack4(zw * sc);
        }
        __syncthreads();
        REP(65536) {
            const size_t cho = (size_t)unit * 4096;
            const float egl = __expf(gl);
#pragma unroll
            for (int tt = 0; tt < 2; ++tt) {
                const int tidx = 2 * w + tt, tx = tidx >> 2, ty = tidx & 3, y = 16 * ty + l15, x0 = 16 * tx + 4 * q4;
                f32x4 zm = mm16<2>(lds, L_WPT, L_KT, tx, ty, lane);
#pragma unroll
                for (int r = 0; r < 4; ++r) zm[r] = ((x0 + r) == y ? egl : 0.f) - zm[r];
                *(u32x2*)(MR + cho + (ty * 2 + (tx >> 1)) * 512 + lane * 8 + 4 * (tx & 1)) = pack4(zm);
                const f32x4 zb = mm16<2>(lds, L_KT, L_UPT, tx, ty, lane);
                *(u32x2*)(BNT + cho + (ty * 4 + tx) * 256 + lane * 4) = pack4(zb);
                const f32x4 zq = mm16<2>(lds, L_WT, L_AR, tx, ty, lane);
                const u32x2 qv = *(const LAS u32x2*)(lds + L_QR + (y * DL + x0) * 2); const float eg = __expf(gcL[y]);
                f32x4 qp; qp.x = bf2f(qv.x & 0xffffu) * eg - zq.x; qp.y = bf2f(qv.x >> 16) * eg - zq.y; qp.z = bf2f(qv.y & 0xffffu) * eg - zq.z; qp.w = bf2f(qv.y >> 16) * eg - zq.w;
                *(u32x2*)(QP + cho + y * 64 + x0) = pack4(qp);
                const f32x4 zo = mm16<2>(lds, L_AR, L_UT, tx, ty, lane);
                *(u32x2*)(OLT + cho + y * 64 + x0) = pack4(zo);
            }
        }
    }
    __syncthreads();
}
#undef CH_LOAD
constexpr int SC_SLOT = 10240, SC_DEPTH = 12, SC_AHEAD = 11;
__device__ __forceinline__ void ph_dn_scan(const Args& a, Frame& F) {
    if (F.bid >= NSCAN) return;
    const unsigned char* MRb = (const unsigned char*)(F.ws + WS_DN_MR); const unsigned char* BNb = (const unsigned char*)(F.ws + WS_DN_BNT); bf16_t* ST = (bf16_t*)(F.ws + WS_DN_ST);
    const int lane = F.lane, l15 = lane & 15, q4 = lane >> 4, wq = F.bid >> 3;
    const size_t ch0 = (size_t)(F.bid & 7) * 256;
    LAS unsigned char* lds = F.lds;
    __syncthreads();
    if (F.wave >= 3) {
        const int lw = F.wave - 3;
#define DN_ISSUE(nn) do { const size_t chb_ = (ch0 + (size_t)((nn) < 255 ? (nn) : 255)) * 8192; const int slot_ = ((nn) % SC_DEPTH) * SC_SLOT; \
        _Pragma("unroll") for (int p_ = 0; p_ < 2; ++p_) { const int piece_ = lw * 2 + p_; \
            const unsigned char* src_ = (piece_ < 8 ? MRb + chb_ + piece_ * 1024 : BNb + chb_ + wq * 2048 + (piece_ - 8) * 1024) + lane * 16; \
            __builtin_amdgcn_global_load_lds((const unsigned*)src_, (LAS unsigned*)(lds + slot_ + piece_ * 1024), 16, 0, 0); } } while (0)
        for (int n = 0; n < SC_AHEAD; ++n) DN_ISSUE(n);
        for (int n = 0; n < 256; ++n) {
            asm volatile("s_waitcnt vmcnt(20)" ::: "memory");
            __builtin_amdgcn_s_barrier();
            DN_ISSUE(n + SC_AHEAD);
        }
        asm volatile("s_waitcnt vmcnt(0)" ::: "memory");
#undef DN_ISSUE
    } else if (F.wave == 0) {
        const int dv = 16 * wq + l15;
        f32x4 S[4];
#pragma unroll
        for (int ti = 0; ti < 4; ++ti) S[ti] = (f32x4){0.f, 0.f, 0.f, 0.f};
        for (int n = 0; n < 256; ++n) {
            __builtin_amdgcn_s_barrier();
            const LAS unsigned char* slot = lds + (n % SC_DEPTH) * SC_SLOT;
            bf16x8_t A[4][2]; u32x2 Bc[4];
#pragma unroll
            for (int ti = 0; ti < 4; ++ti) {
#pragma unroll
                for (int ks = 0; ks < 2; ++ks) A[ti][ks] = *(const LAS bf16x8_t*)(slot + (ti * 2 + ks) * 1024 + lane * 16);
                Bc[ti] = *(const LAS u32x2*)(slot + 8192 + ti * 512 + lane * 8);
            }
            u32x2 sp[4];
#pragma unroll
            for (int ti = 0; ti < 4; ++ti) { sp[ti] = pack4(S[ti]); *(u32x2*)(ST + (ch0 + n) * 4096 + dv * 64 + 16 * ti + 4 * q4) = sp[ti]; }
            const bf16x8_t b0 = __builtin_bit_cast(bf16x8_t, (u32x4){sp[0].x, sp[0].y, sp[1].x, sp[1].y});
            const bf16x8_t b1 = __builtin_bit_cast(bf16x8_t, (u32x4){sp[2].x, sp[2].y, sp[3].x, sp[3].y});
#pragma unroll
            for (int ti = 0; ti < 4; ++ti) {
                f32x4 c; c.x = bf2f(Bc[ti].x & 0xffffu); c.y = bf2f(Bc[ti].x >> 16); c.z = bf2f(Bc[ti].y & 0xffffu); c.w = bf2f(Bc[ti].y >> 16);
                c = __builtin_amdgcn_mfma_f32_16x16x32_bf16(A[ti][0], b0, c, 0, 0, 0);
                c = __builtin_amdgcn_mfma_f32_16x16x32_bf16(A[ti][1], b1, c, 0, 0, 0);
                S[ti] = c;
            }
            asm volatile("s_waitcnt lgkmcnt(0)" ::: "memory");
        }
    } else {
        for (int n = 0; n < 256; ++n) __builtin_amdgcn_s_barrier();
    }
    __syncthreads();
}
__device__ __forceinline__ void ph_dn_out(const Args& a, Frame& F, int l) {
    const bf16_t* QP = (const bf16_t*)(F.ws + WS_DN_QP); const bf16_t* OLT = (const bf16_t*)(F.ws + WS_DN_OLT); const bf16_t* ST = (const bf16_t*)(F.ws + WS_DN_ST);
    const bf16_t* P = (const bf16_t*)(F.ws + WS_PROJ); bf16_t* Y = (bf16_t*)(F.ws + WS_YMIX);
    const int lane = F.lane, l15 = lane & 15, q4 = lane >> 4, ti = F.wave & 3;
    LAS bf16_t* TL = (LAS bf16_t*)(F.lds + F.wave * 2560);
    const int er = lane >> 2, ec = (lane & 3) * 16;
    f32x4 gnv[4];
#pragma unroll
    for (int j = 0; j < 4; ++j) gnv[j] = *(const f32x4*)(a.dn_norm_g + l * 64 + ec + 4 * j);
    bf16x8_t af[2], bfv[4][2]; u32x2 ov[4];
#define DNO_LOAD(prv) { const int unit_ = 2 * (prv) + (F.wave >> 2); const size_t cho_ = (size_t)unit_ * 4096; \
        _Pragma("unroll") for (int ks = 0; ks < 2; ++ks) af[ks] = *(const bf16x8_t*)(QP + cho_ + (16 * ti + l15) * 64 + 32 * ks + 8 * q4); \
        _Pragma("unroll") for (int tj = 0; tj < 4; ++tj) { ov[tj] = *(const u32x2*)(OLT + cho_ + (16 * tj + l15) * 64 + 16 * ti + 4 * q4); \
            _Pragma("unroll") for (int ks = 0; ks < 2; ++ks) bfv[tj][ks] = *(const bf16x8_t*)(ST + cho_ + (16 * tj + l15) * 64 + 32 * ks + 8 * q4); } }
    if (F.bid < 1024) DNO_LOAD(F.bid)
    for (int pr = F.bid; pr < 1024; pr += F.nb) {
        const int unit = 2 * pr + (F.wave >> 2), n = unit & 255, h = (unit >> 8) & 3, b = unit >> 10;
        f32x4 acc[4];
#pragma unroll
        for (int tj = 0; tj < 4; ++tj) {
            f32x4 c; c.x = bf2f(ov[tj].x & 0xffffu); c.y = bf2f(ov[tj].x >> 16); c.z = bf2f(ov[tj].y & 0xffffu); c.w = bf2f(ov[tj].y >> 16);
#pragma unroll
            for (int ks = 0; ks < 2; ++ks) c = __builtin_amdgcn_mfma_f32_16x16x32_bf16(af[ks], bfv[tj][ks], c, 0, 0, 0);
            acc[tj] = c;
        }
        const size_t trow = (size_t)b * SEQ + n * 64 + 16 * ti + er;
        const u32x4 z0 = *(const u32x4*)(P + trow * NP + C_DZ + h * 64 + ec), z1 = *(const u32x4*)(P + trow * NP + C_DZ + h * 64 + ec + 8);
        if (pr + F.nb < 1024) DNO_LOAD(pr + F.nb)
        f32x4 ss = acc[0] * acc[0] + acc[1] * acc[1] + acc[2] * acc[2] + acc[3] * acc[3];
#pragma unroll
        for (int o = 1; o < 16; o <<= 1) { ss.x += __shfl_xor(ss.x, o); ss.y += __shfl_xor(ss.y, o); ss.z += __shfl_xor(ss.z, o); ss.w += __shfl_xor(ss.w, o); }
        const float rs[4] = {rsqrtf(ss.x * (1.f / 64.f) + EPS), rsqrtf(ss.y * (1.f / 64.f) + EPS), rsqrtf(ss.z * (1.f / 64.f) + EPS), rsqrtf(ss.w * (1.f / 64.f) + EPS)};
#pragma unroll
        for (int tj = 0; tj < 4; ++tj)
#pragma unroll
            for (int r = 0; r < 4; ++r) TL[(4 * q4 + r) * 80 + 16 * tj + l15] = (bf16_t)f2bf(acc[tj][r] * rs[r]);
        const u32x4 t0 = *(const LAS u32x4*)(TL + er * 80 + ec), t1 = *(const LAS u32x4*)(TL + er * 80 + ec + 8);
        const unsigned tw[8] = {t0.x, t0.y, t0.z, t0.w, t1.x, t1.y, t1.z, t1.w}, zw[8] = {z0.x, z0.y, z0.z, z0.w, z1.x, z1.y, z1.z, z1.w};
        unsigned yw[8];
#pragma unroll
        for (int j = 0; j < 8; ++j) {
            const float g0 = gnv[j >> 1][(2 * j) & 3], g1 = gnv[j >> 1][(2 * j + 1) & 3];
            yw[j] = cvtpk(bf2f(tw[j] & 0xffffu) * g0 * siluf_(bf2f(zw[j] & 0xffffu)), bf2f(tw[j] >> 16) * g1 * siluf_(bf2f(zw[j] >> 16)));
        }
        bf16_t* yp = Y + trow * D + 512 + h * 64 + ec;
        *(u32x4*)yp = (u32x4){yw[0], yw[1], yw[2], yw[3]}; *(u32x4*)(yp + 8) = (u32x4){yw[4], yw[5], yw[6], yw[7]};
    }
#undef DNO_LOAD
}

__device__ __forceinline__ void ph_conv_naive(const Args& a, Frame& F, int l) {
    const bf16_t* P = (const bf16_t*)(F.ws + WS_PROJ); bf16_t* Y = (bf16_t*)(F.ws + WS_YMIX);
    const float* w = a.cv_dw_w + (size_t)l * CV_K * CV_C;
    for (int t = F.gw; t < T; t += F.ngw) {
        const int s = t % SEQ, c0 = 4 * F.lane;
        f32x4 acc = *(const f32x4*)(a.cv_dw_b + l * CV_C + c0);
        for (int k = 0; k < CV_K; ++k) {
            const int sp = s - (CV_K - 1) + k;
            if (sp < 0) continue;
            const size_t tk = (size_t)t - (CV_K - 1) + k;
            const u32x2 ca = *(const u32x2*)(P + tk * NP + C_CA + c0), cb = *(const u32x2*)(P + tk * NP + C_CB + c0);
            const f32x4 w4 = *(const f32x4*)(w + k * CV_C + c0);
            acc.x += w4.x * (bf2f(ca.x & 0xffffu) * sigmoidf_(bf2f(cb.x & 0xffffu)));
            acc.y += w4.y * (bf2f(ca.x >> 16) * sigmoidf_(bf2f(cb.x >> 16)));
            acc.z += w4.z * (bf2f(ca.y & 0xffffu) * sigmoidf_(bf2f(cb.y & 0xffffu)));
            acc.w += w4.w * (bf2f(ca.y >> 16) * sigmoidf_(bf2f(cb.y >> 16)));
        }
        const float mean = wave_sum((acc.x + acc.y) + (acc.z + acc.w)) * (1.0f / CV_C);
        const f32x4 dv = acc - mean;
        const float var = wave_sum((dv.x * dv.x + dv.y * dv.y) + (dv.z * dv.z + dv.w * dv.w)) * (1.0f / CV_C);
        const float rstd = rsqrtf(var + EPS);
        const f32x4 g4 = *(const f32x4*)(a.cv_ln_g + l * CV_C + c0), b4 = *(const f32x4*)(a.cv_ln_b + l * CV_C + c0);
        const f32x4 y = (dv * rstd) * g4 + b4;
        u32x2 o; o.x = pk2(siluf_(y.x), siluf_(y.y)); o.y = pk2(siluf_(y.z), siluf_(y.w));
        *(u32x2*)(Y + (size_t)t * D + 768 + c0) = o;
    }
}

__device__ __forceinline__ void ph_conv_fast(const Args& a, Frame& F, int l) {
    const bf16_t* P = (const bf16_t*)(F.ws + WS_PROJ); bf16_t* Y = (bf16_t*)(F.ws + WS_YMIX);
    LAS float* OUTL = (LAS float*)F.lds;
    const int c = F.tid & 255, rsel = F.tid >> 8;
    float wk[CV_K];
#pragma unroll
    for (int k = 0; k < CV_K; ++k) wk[k] = a.cv_dw_w[((size_t)l * CV_K + k) * CV_C + c];
    const float bias = a.cv_dw_b[l * CV_C + c];
    const int nsc = NSCAN;
    if (F.bid < nsc) return;
    for (int pr = (F.bid - nsc + (F.nb - nsc) / 2) % (F.nb - nsc); pr < T / 128; pr += F.nb - nsc) {
        const int run = 2 * pr + rsel, t0 = run * 64, s0 = t0 % SEQ;
        __syncthreads();
        float win[CV_K];
        const bf16_t* pc = P + (size_t)(t0 - 30) * NP + C_CA + c;
        const bool first = (s0 == 0);
        LAS float* outp = OUTL + (rsel * 64) * 256 + c;
#define CV_U(ti_, dst) { const bool ok_ = !(first && (ti_) < 30); const bf16_t* q_ = ok_ ? pc + (size_t)(ti_) * NP : pc + (size_t)30 * NP; \
            const float ca_ = bf2f(q_[0]), cb_ = bf2f(q_[256]); dst = ok_ ? ca_ * sigmoidf_(cb_) : 0.f; }
#pragma unroll
        for (int p = 0; p < CV_K; ++p) CV_U(p, win[p])
        { float acc = bias;
#pragma unroll
            for (int k = 0; k < CV_K; ++k) acc += wk[k] * win[(30 + 1 + k) % CV_K];
            outp[0] = acc; }
        for (int cb3 = 1; cb3 < 3; ++cb3) {
            float un[CV_K];
#pragma unroll
            for (int p = 0; p < CV_K; ++p) CV_U(cb3 * CV_K + p, un[p])
#pragma unroll
            for (int p = 0; p < CV_K; ++p) {
                win[p] = un[p];
                float acc = bias;
#pragma unroll
                for (int k = 0; k < CV_K; ++k) acc += wk[k] * win[(p + 1 + k) % CV_K];
                outp[(cb3 * CV_K + p - 30) * 256] = acc;
            }
        }
        { float u93; CV_U(93, u93) win[0] = u93; float acc = bias;
#pragma unroll
            for (int k = 0; k < CV_K; ++k) acc += wk[k] * win[(0 + 1 + k) % CV_K];
            outp[63 * 256] = acc; }
#undef CV_U
        __syncthreads();
        const f32x4 g4 = *(const f32x4*)(a.cv_ln_g + l * CV_C + 4 * F.lane), b4 = *(const f32x4*)(a.cv_ln_b + l * CV_C + 4 * F.lane);
        for (int j = 0; j < 16; ++j) {
            const int tl = F.wave * 16 + j;
            const f32x4 v = *(const LAS f32x4*)(OUTL + tl * 256 + 4 * F.lane);
            const float mean = wave_sum((v.x + v.y) + (v.z + v.w)) * (1.0f / CV_C);
            const f32x4 dv = v - mean;
            const float var = wave_sum((dv.x * dv.x + dv.y * dv.y) + (dv.z * dv.z + dv.w * dv.w)) * (1.0f / CV_C);
            const float rstd = rsqrtf(var + EPS);
            const f32x4 y = (dv * rstd) * g4 + b4;
            u32x2 o; o.x = cvtpk(siluf_(y.x), siluf_(y.y)); o.y = cvtpk(siluf_(y.z), siluf_(y.w));
            *(u32x2*)(Y + (size_t)(pr * 128 + tl) * D + 768 + 4 * F.lane) = o;
        }
    }
    __syncthreads();
}

__device__ __forceinline__ void moe_bases(Frame& F, int (&base)[9], int (&cnt)[8]) {
    const unsigned* c = (const unsigned*)(F.ws + WS_CTL) + CW_MOECNT;
    int acc = 0;
#pragma unroll
    for (int e = 0; e < 8; ++e) { cnt[e] = (int)__hip_atomic_load(c + 64 * e, __ATOMIC_RELAXED, __HIP_MEMORY_SCOPE_AGENT); base[e] = acc; acc += (cnt[e] + 255) & ~255; }
    base[8] = acc;
}
__device__ __forceinline__ void moe_range(Frame& F, int e, int& lo, int& hi) {
    const unsigned* c = (const unsigned*)(F.ws + WS_CTL) + CW_MOECNT;
    int acc = 0; lo = 0; hi = 0;
#pragma unroll
    for (int k = 0; k < 8; ++k) { const int n = ((int)__hip_atomic_load(c + 64 * k, __ATOMIC_RELAXED, __HIP_MEMORY_SCOPE_AGENT) + 255) & ~255; if (k == e) { lo = acc; hi = acc + n; } acc += n; }
}
__device__ __forceinline__ void ph_moe_list(const Args& a, Frame& F) {
    int base[9], cnt[8]; moe_bases(F, base, cnt);
    int* RM = (int*)(F.ws + WS_RMAP); const int* R = (const int*)(F.ws + WS_ROUTE); const int* Pq = (const int*)(F.ws + WS_POS);
    for (int t = F.bid * NTHREADS + F.tid; t < T; t += F.nb * NTHREADS) {
        const int e0 = R[t * 4], e1 = R[t * 4 + 1];
        int b0 = 0, b1 = 0;
#pragma unroll
        for (int e = 0; e < 8; ++e) { if (e == e0) b0 = base[e]; if (e == e1) b1 = base[e]; }
        RM[b0 + Pq[t * 2]] = t; RM[b1 + Pq[t * 2 + 1]] = t;
    }
    if (F.bid == 0) {
#pragma unroll
        for (int e = 0; e < 8; ++e) { const int lo = base[e] + cnt[e], hi = base[e + 1]; for (int r = lo + F.tid; r < hi; r += NTHREADS) RM[r] = 0; }
    }
}
__device__ __forceinline__ void ph_final(const Args& a, Frame& F) {
    int base[9], cnt[8]; moe_bases(F, base, cnt);
    const float* MOD = (const float*)(F.ws + WS_MOD);
    const bf16_t* YM = (const bf16_t*)(F.ws + WS_YMOE); const int* R = (const int*)(F.ws + WS_ROUTE); const int* Pq = (const int*)(F.ws + WS_POS);
    for (int row = F.gw; row < T; row += F.ngw) {
        const int b = row / SEQ;
        const int e0 = R[row * 4], e1 = R[row * 4 + 1]; const float p0 = ((const float*)R)[row * 4 + 2], p1 = ((const float*)R)[row * 4 + 3];
        int b0 = 0, b1 = 0;
#pragma unroll
        for (int e = 0; e < 8; ++e) { if (e == e0) b0 = base[e]; if (e == e1) b1 = base[e]; }
        const size_t s0 = (size_t)(b0 + Pq[row * 2]), s1 = (size_t)(b1 + Pq[row * 2 + 1]);
        const float* gt2 = MOD + ((size_t)(1 * 2 + 1) * 2 + b) * 3072 + 2048;
        f32x4* xr = (f32x4*)(a.out + (size_t)row * D) + F.lane; const bf16_t* x16r = (const bf16_t*)(F.ws + WS_X16) + (size_t)row * D;
        f32x4 v[4]; float ss = 0.f;
#pragma unroll
        for (int j = 0; j < 4; ++j) {
            const int d = 256 * j + 4 * F.lane;
            const u32x2 y0 = *(const u32x2*)(YM + s0 * D + d), y1 = *(const u32x2*)(YM + s1 * D + d);
            const f32x4 g4 = *(const f32x4*)(gt2 + d);
            f32x4 f; f.x = p0 * bf2f(y0.x & 0xffffu) + p1 * bf2f(y1.x & 0xffffu); f.y = p0 * bf2f(y0.x >> 16) + p1 * bf2f(y1.x >> 16);
            f.z = p0 * bf2f(y0.y & 0xffffu) + p1 * bf2f(y1.y & 0xffffu); f.w = p0 * bf2f(y0.y >> 16) + p1 * bf2f(y1.y >> 16);
            const u32x2 xv = *(const u32x2*)(x16r + d); f32x4 xo; xo.x = bf2f(xv.x & 0xffffu); xo.y = bf2f(xv.x >> 16); xo.z = bf2f(xv.y & 0xffffu); xo.w = bf2f(xv.y >> 16);
            v[j] = xo + g4 * f;
            ss += (v[j].x * v[j].x + v[j].y * v[j].y) + (v[j].z * v[j].z + v[j].w * v[j].w);
        }
        const float rstd = rsqrtf(wave_sum(ss) * (1.0f / D) + EPS);
#pragma unroll
        for (int j = 0; j < 4; ++j) { const f32x4 g4 = *(const f32x4*)(a.final_g + 256 * j + 4 * F.lane); xr[64 * j] = (v[j] * rstd) * g4; }
    }
}


namespace pg8 {
typedef short bf16x8 __attribute__((ext_vector_type(8)));
constexpr int BM = 256, BK = 64, HALF = 128, HTB = HALF * BK * 2, STAGE_BYTES = 8 * HTB;
__device__ __forceinline__ int lds_byte(int r, int c) { const int st = (r >> 4) * 2 + (c >> 5), rr = r & 15, cc = c & 31, ob = rr * 64 + cc * 2; return st * 1024 + (ob ^ (((ob >> 9) & 1) << 5)); }
__device__ __forceinline__ void stage_rc(int b, int& R, int& C) { const int st = b / 1024, sb = b % 1024, swz = sb ^ (((sb >> 9) & 1) << 5); R = (st >> 1) * 16 + swz / 64; C = (st & 1) * 32 + (swz % 64) / 2; }
__device__ __forceinline__ int perm32(int rho) { const int n = rho >> 4, i = rho & 15; return 8 * (i >> 2) + 4 * n + (i & 3); }
struct Unit { int pm, pn, ord; };
struct Gemm { const bf16_t* A; const bf16_t* Bt; int K; };
constexpr int NXCD = 8, WGM = 8;
struct StaticOrder {
    int nM, nN, nwg, G, c;
    __device__ void init(int M, int N, int G_, int c_) { nM = M / BM; nN = N / BM; nwg = nM * nN; G = G_; c = c_; }
    __device__ __forceinline__ bool next(int i, Unit& u) const {
        const long L = (long)i * G + c; if (L >= nwg) return false;
        int wgid = (int)L; { const int q = nwg / NXCD, r = nwg % NXCD, xcd = wgid % NXCD, off = wgid / NXCD; wgid = (xcd < r ? xcd * (q + 1) : r * (q + 1) + (xcd - r) * q) + off; }
        const int nig = WGM * nN, gid = wgid / nig, fm = gid * WGM, gsz = (nM - fm) < WGM ? (nM - fm) : WGM;
        u.pm = fm + ((wgid % nig) % gsz); u.pn = (wgid % nig) / gsz; return true;
    }
};
template <int NT> struct MoeOrder {
    int bt[9]; int cnt[8]; int G, c;
    __device__ __forceinline__ bool next(int i, Unit& u) const {
        const int L = i * G + c; if (L >= bt[8] * NT) return false;
        const int q = L / NT, tn = L % NT; int e = 0;
#pragma unroll
        for (int k = 1; k < 8; ++k) e += (q >= bt[k]) ? 1 : 0;
        u.pm = q; u.pn = e * NT + tn; return true;
    }
};
__device__ __forceinline__ unsigned cvt_pk_bf16(float lo, float hi) { unsigned r; asm volatile("v_cvt_pk_bf16_f32 %0, %1, %2" : "=v"(r) : "v"(lo), "v"(hi)); return r; }
__device__ __forceinline__ float fast_silu(float x) { return x * __builtin_amdgcn_rcpf(1.0f + __builtin_amdgcn_exp2f(x * -1.4426950408889634f)); }

struct EpiBf16 {
    static constexpr bool PERM = true;
    bf16_t* O; int ldc; int nmod;
    __device__ __forceinline__ void operator()(const f32x4 (&acc)[2][2][4][2], const Unit& u, int wr, int wc, int fr, int fq) const {
        const int row0 = u.pm * BM + wr * 64 + fr, col0 = (u.pn % nmod) * BM + wc * 32 + 8 * fq;
#pragma unroll
        for (int ai = 0; ai < 2; ++ai)
#pragma unroll
            for (int m = 0; m < 4; ++m) { bf16_t* rowp = O + (size_t)(row0 + ai * HALF + m * 16) * ldc + col0;
#pragma unroll
                for (int bj = 0; bj < 2; ++bj) { const f32x4 v0 = acc[ai][bj][m][0], v1 = acc[ai][bj][m][1];
                    u32x4 w; w.x = cvt_pk_bf16(v0[0], v0[1]); w.y = cvt_pk_bf16(v0[2], v0[3]); w.z = cvt_pk_bf16(v1[0], v1[1]); w.w = cvt_pk_bf16(v1[2], v1[3]);
                    *(u32x4*)(rowp + bj * HALF) = w; } }
    }
};
struct EpiSwiGLU {
    static constexpr bool PERM = true;
    bf16_t* O; int ldc; int nmod;
    __device__ __forceinline__ void operator()(const f32x4 (&acc)[2][2][4][2], const Unit& u, int wr, int wc, int fr, int fq) const {
        const int row0 = u.pm * BM + wr * 64 + fr, col0 = (u.pn % nmod) * HALF + wc * 32 + 8 * fq;
#pragma unroll
        for (int ai = 0; ai < 2; ++ai)
#pragma unroll
            for (int m = 0; m < 4; ++m) {
                const f32x4 g0 = acc[ai][0][m][0], g1 = acc[ai][0][m][1], u0 = acc[ai][1][m][0], u1 = acc[ai][1][m][1];
                u32x4 w;
                w.x = cvt_pk_bf16(fast_silu(g0[0]) * u0[0], fast_silu(g0[1]) * u0[1]); w.y = cvt_pk_bf16(fast_silu(g0[2]) * u0[2], fast_silu(g0[3]) * u0[3]);
                w.z = cvt_pk_bf16(fast_silu(g1[0]) * u1[0], fast_silu(g1[1]) * u1[1]); w.w = cvt_pk_bf16(fast_silu(g1[2]) * u1[2], fast_silu(g1[3]) * u1[3]);
                *(u32x4*)(O + (size_t)(row0 + ai * HALF + m * 16) * ldc + col0) = w; }
    }
};
struct EpiResidF32 {
    static constexpr bool PERM = false;
    const float* xin; float* xout; const float* gate;
    __device__ __forceinline__ void operator()(const f32x4 (&acc)[2][2][4][2], const Unit& u, int wr, int wc, int fr, int fq) const {
        const int row0 = u.pm * BM + wr * 64 + fr, col0 = u.pn * BM + wc * 32 + 4 * fq;
        const float* gp = gate + (size_t)((u.pm * BM) / SEQ) * 3072 + col0;
#pragma unroll
        for (int bj = 0; bj < 2; ++bj)
#pragma unroll
            for (int n = 0; n < 2; ++n) { const f32x4 g4 = *(const f32x4*)(gp + bj * HALF + n * 16);
#pragma unroll
                for (int ai = 0; ai < 2; ++ai)
#pragma unroll
                    for (int m = 0; m < 4; ++m) { const size_t off = (size_t)(row0 + ai * HALF + m * 16) * D + col0 + bj * HALF + n * 16;
                        const f32x4 x4 = *(const f32x4*)(xin + off); *(f32x4*)(xout + off) = x4 + g4 * acc[ai][bj][m][n]; } }
    }
};


struct EpiResidNorm {
    static constexpr bool PERM = true;
    const bf16_t* xin; bf16_t* x16; const float* gate; const float* av; bf16_t* xa; float* ssqp;
    __device__ __forceinline__ void operator()(const f32x4 (&acc)[2][2][4][2], const Unit& u, int wr, int wc, int fr, int fq) const {
        const int row0 = u.pm * BM + wr * 64 + fr, col0 = u.pn * BM + wc * 32 + 8 * fq, b = (u.pm * BM) / SEQ;
        const float* gp = gate + (size_t)b * 3072 + col0; const float* ap = av + (size_t)b * 1024 + col0;
        float ss[2][4];
#pragma unroll
        for (int ai = 0; ai < 2; ++ai)
#pragma unroll
            for (int m = 0; m < 4; ++m) ss[ai][m] = 0.f;
        f32x4 gv[2][2], avv[2][2];
#define ERN_VEC(bj) { gv[bj][0] = *(const f32x4*)(gp + (bj) * HALF); gv[bj][1] = *(const f32x4*)(gp + (bj) * HALF + 4); avv[bj][0] = *(const f32x4*)(ap + (bj) * HALF); avv[bj][1] = *(const f32x4*)(ap + (bj) * HALF + 4); }
        ERN_VEC(0)
        u32x4 xb[4][4];
#define ERN_LOAD(k) { _Pragma("unroll") for (int m = 0; m < 4; ++m) xb[k][m] = *(const u32x4*)(xin + (size_t)(row0 + ((k) & 1) * HALF + m * 16) * D + col0 + ((k) >> 1) * HALF); }
        ERN_LOAD(0)
#pragma unroll
        for (int k = 0; k < 4; ++k) {
            const int bj = k >> 1, ai = k & 1;
            if (k == 0) ERN_LOAD(1) else if (k == 1) { ERN_LOAD(2) ERN_VEC(1) } else if (k == 2) ERN_LOAD(3)
            asm volatile("" ::: "memory");
            const f32x4 g0 = gv[bj][0], g1 = gv[bj][1], a0 = avv[bj][0], a1 = avv[bj][1];
#pragma unroll
            for (int m = 0; m < 4; ++m) { const size_t off = (size_t)(row0 + ai * HALF + m * 16) * D + col0 + bj * HALF;
                const u32x4 xv = xb[k][m]; f32x4 x0, x1;
                x0.x = __uint_as_float(xv.x << 16); x0.y = __uint_as_float(xv.x & 0xffff0000u); x0.z = __uint_as_float(xv.y << 16); x0.w = __uint_as_float(xv.y & 0xffff0000u);
                x1.x = __uint_as_float(xv.z << 16); x1.y = __uint_as_float(xv.z & 0xffff0000u); x1.z = __uint_as_float(xv.w << 16); x1.w = __uint_as_float(xv.w & 0xffff0000u);
                const f32x4 n0 = x0 + g0 * acc[ai][bj][m][0], n1 = x1 + g1 * acc[ai][bj][m][1];
                ss[ai][m] += ((n0.x * n0.x + n0.y * n0.y) + (n0.z * n0.z + n0.w * n0.w)) + ((n1.x * n1.x + n1.y * n1.y) + (n1.z * n1.z + n1.w * n1.w));
                u32x4 w1; w1.x = cvt_pk_bf16(n0.x, n0.y); w1.y = cvt_pk_bf16(n0.z, n0.w); w1.z = cvt_pk_bf16(n1.x, n1.y); w1.w = cvt_pk_bf16(n1.z, n1.w); *(u32x4*)(x16 + off) = w1;
                const f32x4 s0 = n0 * a0, s1 = n1 * a1;
                u32x4 w2; w2.x = cvt_pk_bf16(s0.x, s0.y); w2.y = cvt_pk_bf16(s0.z, s0.w); w2.z = cvt_pk_bf16(s1.x, s1.y); w2.w = cvt_pk_bf16(s1.z, s1.w); *(u32x4*)(xa + off) = w2; }
        }
#undef ERN_LOAD
#undef ERN_VEC
#pragma unroll
        for (int ai = 0; ai < 2; ++ai)
#pragma unroll
            for (int m = 0; m < 4; ++m) { float sv = ss[ai][m]; sv += __shfl_xor(sv, 16); sv += __shfl_xor(sv, 32);
                if (fq == 0) ssqp[(size_t)(row0 + ai * HALF + m * 16) * 16 + u.pn * 4 + wc] = sv; }
    }
};

struct EpiNull {
    static constexpr bool PERM = true;
    __device__ __forceinline__ void operator()(const f32x4 (&acc)[2][2][4][2], const Unit& u, int wr, int wc, int fr, int fq) const {
#pragma unroll
        for (int ai = 0; ai < 2; ++ai)
#pragma unroll
            for (int bj = 0; bj < 2; ++bj)
#pragma unroll
                for (int m = 0; m < 4; ++m)
#pragma unroll
                    for (int n = 0; n < 2; ++n) asm volatile("" :: "v"(acc[ai][bj][m][n]));
    }
};
struct EpiProjNorm {
    static constexpr bool PERM = true;
    bf16_t* O; const LAS float* RS; const float* cv; float* BG; const float* a_log; const float* dt_bias;
    __device__ __forceinline__ void operator()(const f32x4 (&acc)[2][2][4][2], const Unit& u, int wr, int wc, int fr, int fq) const {
        const int rl0 = wr * 64 + fr, col0 = u.pn * BM + wc * 32 + 8 * fq, b = (u.pm * BM) / SEQ;
        const float* cp = cv + (size_t)b * NPW + col0;
        if (u.pn < NP / BM) {
            f32x4 c4[2][2];
#pragma unroll
            for (int bj = 0; bj < 2; ++bj)
#pragma unroll
                for (int n = 0; n < 2; ++n) c4[bj][n] = *(const f32x4*)(cp + bj * HALF + 4 * n);
#pragma unroll
            for (int ai = 0; ai < 2; ++ai)
#pragma unroll
                for (int m = 0; m < 4; ++m) { const int rl = rl0 + ai * HALF + m * 16; const float rs = fabsf(RS[u.ord * 256 + rl]);
                    bf16_t* rowp = O + (size_t)(u.pm * BM + rl) * NP + col0;
#pragma unroll
                    for (int bj = 0; bj < 2; ++bj) { const f32x4 v0 = acc[ai][bj][m][0] * rs + c4[bj][0], v1 = acc[ai][bj][m][1] * rs + c4[bj][1];
                        u32x4 w; w.x = cvt_pk_bf16(v0[0], v0[1]); w.y = cvt_pk_bf16(v0[2], v0[3]); w.z = cvt_pk_bf16(v1[0], v1[1]); w.w = cvt_pk_bf16(v1[2], v1[3]);
                        *(u32x4*)(rowp + bj * HALF) = w; } }
        } else if (wc == 0 && fq == 0) {
            const f32x4 c0 = *(const f32x4*)(cp), c1 = *(const f32x4*)(cp + 4);
            const f32x4 al = *(const f32x4*)a_log, db = *(const f32x4*)dt_bias;
#pragma unroll
            for (int ai = 0; ai < 2; ++ai)
#pragma unroll
                for (int m = 0; m < 4; ++m) { const int rl = rl0 + ai * HALF + m * 16; const float rs = fabsf(RS[u.ord * 256 + rl]);
                    const f32x4 vb = acc[ai][0][m][0] * rs + c0, va = acc[ai][0][m][1] * rs + c1;
                    f32x4 be, gg;
#pragma unroll
                    for (int hh = 0; hh < 4; ++hh) { be[hh] = sigmoidf_(vb[hh]); gg[hh] = -__expf(al[hh]) * softplusf_(va[hh] + db[hh]); }
                    float* bg = BG + (size_t)(u.pm * BM + rl) * 8; *(f32x4*)bg = be; *(f32x4*)(bg + 4) = gg; }
        }
    }
};
struct EpiSwiGLUNorm {
    static constexpr bool PERM = true;
    bf16_t* O; int ldc; int nmod; const LAS float* RS; const float* cv; int ncv;
    __device__ __forceinline__ void operator()(const f32x4 (&acc)[2][2][4][2], const Unit& u, int wr, int wc, int fr, int fq) const {
        const int rl0 = wr * 64 + fr, col0 = (u.pn % nmod) * HALF + wc * 32 + 8 * fq;
        const float* cp = cv + (size_t)u.pn * BM + wc * 32 + 8 * fq;
        f32x4 cg[2][2], cu[2][2];
#pragma unroll
        for (int bb = 0; bb < 2; ++bb)
#pragma unroll
            for (int n = 0; n < 2; ++n) { cg[bb][n] = *(const f32x4*)(cp + (size_t)bb * ncv + 4 * n); cu[bb][n] = *(const f32x4*)(cp + (size_t)bb * ncv + HALF + 4 * n); }
#pragma unroll
        for (int ai = 0; ai < 2; ++ai)
#pragma unroll
            for (int m = 0; m < 4; ++m) { const int rl = rl0 + ai * HALF + m * 16; const float rsv = RS[u.ord * 256 + rl], rs = fabsf(rsv); const bool b1 = rsv < 0.f;
                const f32x4 g0 = acc[ai][0][m][0] * rs + (b1 ? cg[1][0] : cg[0][0]), g1 = acc[ai][0][m][1] * rs + (b1 ? cg[1][1] : cg[0][1]);
                const f32x4 u0 = acc[ai][1][m][0] * rs + (b1 ? cu[1][0] : cu[0][0]), u1 = acc[ai][1][m][1] * rs + (b1 ? cu[1][1] : cu[0][1]);
                u32x4 w;
                w.x = cvt_pk_bf16(fast_silu(g0[0]) * u0[0], fast_silu(g0[1]) * u0[1]); w.y = cvt_pk_bf16(fast_silu(g0[2]) * u0[2], fast_silu(g0[3]) * u0[3]);
                w.z = cvt_pk_bf16(fast_silu(g1[0]) * u1[0], fast_silu(g1[1]) * u1[1]); w.w = cvt_pk_bf16(fast_silu(g1[2]) * u1[2], fast_silu(g1[3]) * u1[3]);
                *(u32x4*)(O + (size_t)(u.pm * BM + rl) * ldc + col0) = w; }
    }
};

template <class Epi, class Sched, bool GATHER, bool ALIGN_EPI, bool SP2>
__device__ __forceinline__ void gemm_phase(LAS unsigned char* lds, const LAS int* RI, const Gemm g, const Sched& S, const Epi& E) {
    const int tid = threadIdx.x, wid = __builtin_amdgcn_readfirstlane(tid >> 6), lane = tid & 63, wr = wid >> 2, wc = wid & 3, fr = lane & 15, fq = lane >> 4;
    const int K = g.K, nt = K / BK;
    unsigned voffB[2]; int Ra[2]; unsigned Ca2[2];
#pragma unroll
    for (int i = 0; i < 2; ++i) { int R, C; stage_rc(tid * 16 + i * 8192, R, C); const int Rb = Epi::PERM ? ((R & ~31) + perm32(R & 31)) : R;
        Ra[i] = R; Ca2[i] = (unsigned)C * 2u; voffB[i] = (unsigned)(Rb * K + C) * 2u; }
    const size_t kstep = (size_t)(BK * 2);
    const size_t hstep = (size_t)HALF * K * 2;
    const size_t tstep = 2 * hstep;
    const unsigned rowb = (unsigned)K * 2u;
    const unsigned ldsw = (unsigned)wid * 1024u;
    const int aoff = lds_byte(wr * 64 + fr, fq * 8), boff = lds_byte(wc * 32 + fr, fq * 8);
#define PG8_SA(b, h) (((b) * 2 + (h)) * HTB)
#define PG8_SB(b, h) ((4 + (b) * 2 + (h)) * HTB)
#define PG8_STAGE_B(bufoff, gbase) do { _Pragma("unroll") for (int _i = 0; _i < 2; ++_i) \
        __builtin_amdgcn_global_load_lds((const unsigned*)((const char*)(gbase) + voffB[_i]), (LAS unsigned*)(lds + (bufoff) + ldsw + _i * 8192), 16, 0, 0); } while (0)
#define PG8_STAGE_A(bufoff, kb, off) do { _Pragma("unroll") for (int _i = 0; _i < 2; ++_i) \
        __builtin_amdgcn_global_load_lds((const unsigned*)((const char*)g.A + (size_t)(kb) + (off)[_i]), (LAS unsigned*)(lds + (bufoff) + ldsw + _i * 8192), 16, 0, 0); } while (0)
#define PG8_LDA(dst, b, h) do { _Pragma("unroll") for (int m = 0; m < 4; ++m) _Pragma("unroll") for (int k = 0; k < 2; ++k) dst[m][k] = *(const LAS bf16x8*)(lds + PG8_SA(b, h) + aoff + m * 2048 + k * 1024); } while (0)
#define PG8_LDB(dst, b, h) do { _Pragma("unroll") for (int n = 0; n < 2; ++n) _Pragma("unroll") for (int k = 0; k < 2; ++k) dst[n][k] = *(const LAS bf16x8*)(lds + PG8_SB(b, h) + boff + n * 2048 + k * 1024); } while (0)
#define PG8_MMA(ai, bj, At, Bt) do { __builtin_amdgcn_s_setprio(1); _Pragma("unroll") for (int m = 0; m < 4; ++m) _Pragma("unroll") for (int n = 0; n < 2; ++n) _Pragma("unroll") for (int k = 0; k < 2; ++k) \
        acc[ai][bj][m][n] = __builtin_amdgcn_mfma_f32_16x16x32_bf16(Bt[n][k], At[m][k], acc[ai][bj][m][n], 0, 0, 0); __builtin_amdgcn_s_setprio(0); } while (0)
#define PG8_WAIT_V(n) asm volatile("s_waitcnt vmcnt(" #n ")" ::: "memory")
#define PG8_WAIT_L(n) asm volatile("s_waitcnt lgkmcnt(" #n ")" ::: "memory")
#define PG8_BAR __builtin_amdgcn_s_barrier()
#define PG8_SCHED __builtin_amdgcn_sched_barrier(0)
#define PG8_AOFFS(dst, ui_, un_) do { _Pragma("unroll") for (int _h = 0; _h < 2; ++_h) _Pragma("unroll") for (int _i = 0; _i < 2; ++_i) { \
        const unsigned _row = GATHER ? (unsigned)RI[(ui_) * 256 + _h * HALF + Ra[_i]] : (unsigned)((un_).pm * BM + _h * HALF + Ra[_i]); dst[_h][_i] = _row * rowb + Ca2[_i]; } } while (0)
    Unit cur, nxt; int ui = 0;
    if (!S.next(0, cur)) return;
    cur.ord = 0;
    f32x4 acc[2][2][4][2];
#pragma unroll
    for (int a = 0; a < 2; ++a)
#pragma unroll
        for (int b = 0; b < 2; ++b)
#pragma unroll
            for (int m = 0; m < 4; ++m)
#pragma unroll
                for (int n = 0; n < 2; ++n) acc[a][b][m][n] = (f32x4){0.f, 0.f, 0.f, 0.f};
    bf16x8 At[4][2], B0[2][2], B1[2][2];
    unsigned cv[2][2], nv[2][2];
    PG8_AOFFS(cv, 0, cur);
    const char* cB = (const char*)g.Bt + (size_t)cur.pn * tstep;
    if constexpr (SP2) {
        PG8_STAGE_B(PG8_SB(0, 0), cB); PG8_STAGE_B(PG8_SB(0, 1), cB + hstep); PG8_STAGE_A(PG8_SA(0, 0), 0, cv[0]); PG8_STAGE_A(PG8_SA(0, 1), 0, cv[1]);
        if (wr == 1) PG8_BAR;
        PG8_WAIT_V(2); PG8_BAR;
        PG8_STAGE_B(PG8_SB(1, 0), cB + kstep); PG8_STAGE_A(PG8_SA(1, 0), kstep, cv[0]); PG8_STAGE_B(PG8_SB(1, 1), cB + hstep + kstep);
        PG8_WAIT_V(6); PG8_BAR;
    } else {
        PG8_STAGE_B(PG8_SB(0, 0), cB); PG8_STAGE_A(PG8_SA(0, 0), 0, cv[0]); PG8_STAGE_B(PG8_SB(0, 1), cB + hstep); PG8_STAGE_A(PG8_SA(0, 1), 0, cv[1]);
        if (wr == 1) PG8_BAR;
        PG8_WAIT_V(4); PG8_BAR;
        PG8_STAGE_B(PG8_SB(1, 0), cB + kstep); PG8_STAGE_A(PG8_SA(1, 0), kstep, cv[0]); PG8_STAGE_B(PG8_SB(1, 1), cB + hstep + kstep);
        PG8_WAIT_V(6); PG8_BAR;
    }
    for (;;) {
        const bool has_next = S.next(ui + 1, nxt); nxt.ord = ui + 1;
        const char* nB = has_next ? (const char*)g.Bt + (size_t)nxt.pn * tstep : cB;
        if (has_next) { PG8_AOFFS(nv, ui + 1, nxt); }
        else {
#pragma unroll
            for (int h = 0; h < 2; ++h)
#pragma unroll
                for (int i = 0; i < 2; ++i) nv[h][i] = cv[h][i]; }
        for (int t = 0; t < nt; t += 2) {
            const bool last = (t == nt - 2);
            const size_t kb1 = (size_t)(t + 1) * kstep, kb2 = last ? (size_t)0 : (size_t)(t + 2) * kstep, kb3 = kb2 + kstep;
            const char* b2 = last ? nB : cB + (size_t)(t + 2) * kstep; const char* b3 = b2 + kstep;
            unsigned o2[2][2];
#pragma unroll
            for (int h = 0; h < 2; ++h)
#pragma unroll
                for (int i = 0; i < 2; ++i) o2[h][i] = last ? nv[h][i] : cv[h][i];
            if constexpr (SP2) {
            PG8_LDB(B0, 0, 0); PG8_LDB(B1, 0, 1); PG8_SCHED; PG8_LDA(At, 0, 0); PG8_STAGE_A(PG8_SA(1, 1), kb1, cv[1]);
            PG8_WAIT_V(8); PG8_WAIT_L(0); PG8_BAR; PG8_MMA(0, 0, At, B0); PG8_MMA(0, 1, At, B1); PG8_BAR; PG8_SCHED;
            PG8_LDA(At, 0, 1); PG8_STAGE_B(PG8_SB(0, 0), b2); PG8_STAGE_B(PG8_SB(0, 1), b2 + hstep); PG8_STAGE_A(PG8_SA(0, 0), kb2, o2[0]);
            PG8_WAIT_V(8); PG8_WAIT_L(0); PG8_BAR; PG8_MMA(1, 0, At, B0); PG8_MMA(1, 1, At, B1); PG8_BAR; PG8_SCHED;
            PG8_LDB(B0, 1, 0); PG8_LDB(B1, 1, 1); PG8_SCHED; PG8_LDA(At, 1, 0); PG8_STAGE_A(PG8_SA(0, 1), kb2, o2[1]);
            PG8_WAIT_V(8); PG8_WAIT_L(0); PG8_BAR; PG8_MMA(0, 0, At, B0); PG8_MMA(0, 1, At, B1); PG8_BAR; PG8_SCHED;
            PG8_LDA(At, 1, 1); PG8_STAGE_B(PG8_SB(1, 0), b3); PG8_STAGE_B(PG8_SB(1, 1), b3 + hstep); PG8_STAGE_A(PG8_SA(1, 0), kb3, o2[0]);
            PG8_WAIT_V(8); PG8_WAIT_L(0); PG8_BAR; PG8_MMA(1, 0, At, B0); PG8_MMA(1, 1, At, B1); PG8_BAR; PG8_SCHED;
            } else {
            PG8_LDB(B0, 0, 0); PG8_SCHED; PG8_LDA(At, 0, 0); PG8_STAGE_A(PG8_SA(1, 1), kb1, cv[1]);
            PG8_WAIT_L(8); PG8_BAR; PG8_WAIT_L(0); PG8_MMA(0, 0, At, B0); PG8_BAR; PG8_SCHED;
            PG8_LDB(B1, 0, 1); PG8_STAGE_B(PG8_SB(0, 0), b2);
            PG8_BAR; PG8_WAIT_L(0); PG8_MMA(0, 1, At, B1); PG8_BAR;
            PG8_LDA(At, 0, 1); PG8_STAGE_A(PG8_SA(0, 0), kb2, o2[0]);
            PG8_BAR; PG8_WAIT_L(0); PG8_MMA(1, 0, At, B0); PG8_BAR; PG8_SCHED;
            PG8_STAGE_B(PG8_SB(0, 1), b2 + hstep);
            PG8_WAIT_V(6); PG8_BAR; PG8_MMA(1, 1, At, B1); PG8_BAR;
            PG8_LDB(B0, 1, 0); PG8_SCHED; PG8_LDA(At, 1, 0); PG8_STAGE_A(PG8_SA(0, 1), kb2, o2[1]);
            PG8_WAIT_L(8); PG8_BAR; PG8_WAIT_L(0); PG8_MMA(0, 0, At, B0); PG8_BAR; PG8_SCHED;
            PG8_LDB(B1, 1, 1); PG8_STAGE_B(PG8_SB(1, 0), b3);
            PG8_BAR; PG8_WAIT_L(0); PG8_MMA(0, 1, At, B1); PG8_BAR;
            PG8_LDA(At, 1, 1); PG8_STAGE_A(PG8_SA(1, 0), kb3, o2[0]);
            PG8_BAR; PG8_WAIT_L(0); PG8_MMA(1, 0, At, B0); PG8_BAR; PG8_SCHED;
            PG8_STAGE_B(PG8_SB(1, 1), b3 + hstep);
            PG8_WAIT_V(6); PG8_BAR; PG8_MMA(1, 1, At, B1); PG8_BAR;
            }
        }
        if constexpr (ALIGN_EPI) { if (wr == 0) PG8_BAR; }
        E(acc, cur, wr, wc, fr, fq);
        if (!has_next) break;
#pragma unroll
        for (int a = 0; a < 2; ++a)
#pragma unroll
            for (int b = 0; b < 2; ++b)
#pragma unroll
                for (int m = 0; m < 4; ++m)
#pragma unroll
                    for (int n = 0; n < 2; ++n) acc[a][b][m][n] = (f32x4){0.f, 0.f, 0.f, 0.f};
        cur = nxt; cB = nB; ++ui;
#pragma unroll
        for (int h = 0; h < 2; ++h)
#pragma unroll
            for (int i = 0; i < 2; ++i) cv[h][i] = nv[h][i];
        if constexpr (ALIGN_EPI) { if (wr == 1) PG8_BAR; }
    }
    PG8_WAIT_V(0);
    if constexpr (!ALIGN_EPI) { if (wr == 0) PG8_BAR; }
    PG8_BAR;
#undef PG8_SA
#undef PG8_SB
#undef PG8_STAGE_A
#undef PG8_STAGE_B
#undef PG8_LDA
#undef PG8_LDB
#undef PG8_MMA
#undef PG8_WAIT_V
#undef PG8_WAIT_L
#undef PG8_BAR
#undef PG8_SCHED
#undef PG8_AOFFS
}
}

__device__ __forceinline__ void transpose_item(const float* W, int pitch, int k0, int n0, bf16_t* WT, int Kd, int drow0, LAS float* scr, int lane) {
#pragma unroll 8
    for (int i = 0; i < 32; ++i) { const int kk = 2 * i + (lane >> 5); scr[kk * 33 + (lane & 31)] = W[(size_t)(k0 + kk) * pitch + n0 + (lane & 31)]; }
    asm volatile("s_waitcnt lgkmcnt(0)" ::: "memory");
    const int c = lane & 7;
#pragma unroll
    for (int j = 0; j < 4; ++j) { const int n = (lane >> 3) + 8 * j; const LAS float* s = scr + (8 * c) * 33 + n;
        u32x4 o; o.x = pk2(s[0 * 33], s[1 * 33]); o.y = pk2(s[2 * 33], s[3 * 33]); o.z = pk2(s[4 * 33], s[5 * 33]); o.w = pk2(s[6 * 33], s[7 * 33]);
        *(u32x4*)(WT + (size_t)(drow0 + n) * Kd + k0 + 8 * c) = o; }
    asm volatile("s_waitcnt lgkmcnt(0)" ::: "memory");
}
constexpr size_t WT_WIN = 0, WT_WOUT = WT_WIN + (size_t)2 * NPW * D, WT_FGU = WT_WOUT + (size_t)2 * D * D, WT_FD = WT_FGU + (size_t)2 * D_FF * D,
                 WT_MGU = WT_FD + (size_t)D * D_FF, WT_MD = WT_MGU + (size_t)NE * 2 * D_FFE * D, WT_END = WT_MD + (size_t)NE * D * D_FFE;
static_assert(WT_END * 2 <= 80 * MiB, "weight copies fit");
__device__ __forceinline__ void ph_pro_weights(const Args& a, Frame& F) {
    LAS float* scr = (LAS float*)(F.lds + F.wave * 16384);
    bf16_t* WT = (bf16_t*)(F.ws + WS_WT);
    constexpr int I_IN0 = 16 * 48, I_IN1 = 16 * 24, I_OUT = 16 * 32, I_FG = 16 * 88, I_FD = 44 * 32, I_M = 16 * 32;
    constexpr int NITEMS = 2 * (I_IN0 + I_IN1 + I_OUT) + 2 * I_FG + I_FD + 24 * I_M;
    for (int it = F.gw; it < NITEMS; it += F.ngw) {
        int r = it; const float* src; int pitch, k0, n0, Kd, drow0; bf16_t* dst;
        if (r < 2 * I_IN0) { const int l = r / I_IN0; r %= I_IN0; src = a.w_in + (size_t)l * D * N_IN; pitch = N_IN; k0 = (r / 48) * 64; n0 = (r % 48) * 32; dst = WT + WT_WIN + (size_t)l * NPW * D; Kd = D; drow0 = n0; }
        else if ((r -= 2 * I_IN0) < 2 * I_IN1) { const int l = r / I_IN1; r %= I_IN1; src = a.w_in + (size_t)l * D * N_IN + 1544; pitch = N_IN; k0 = (r / 24) * 64; n0 = (r % 24) * 32; dst = WT + WT_WIN + (size_t)l * NPW * D; Kd = D; drow0 = 1536 + n0; }
        else if ((r -= 2 * I_IN1) < 2 * I_OUT) { const int l = r / I_OUT; r %= I_OUT; src = a.w_out + (size_t)l * D * D; pitch = D; k0 = (r / 32) * 64; n0 = (r % 32) * 32; dst = WT + WT_WOUT + (size_t)l * D * D; Kd = D; drow0 = n0; }
        else if ((r -= 2 * I_OUT) < 2 * I_FG) { const int up = r / I_FG; r %= I_FG; src = up ? a.ffn_wu : a.ffn_wg; pitch = D_FF; k0 = (r / 88) * 64; n0 = (r % 88) * 32; dst = WT + WT_FGU; Kd = D; drow0 = (n0 / 128) * 256 + up * 128 + (n0 % 128); }
        else if ((r -= 2 * I_FG) < I_FD) { src = a.ffn_wd; pitch = D; k0 = (r / 32) * 64; n0 = (r % 32) * 32; dst = WT + WT_FD; Kd = D_FF; drow0 = n0; }
        else if ((r -= I_FD) < 16 * I_M) { const int e = r / (2 * I_M); r %= 2 * I_M; const int up = r / I_M; r %= I_M; src = (up ? a.moe_wu : a.moe_wg) + (size_t)e * D * D_FFE; pitch = D_FFE; k0 = (r / 32) * 64; n0 = (r % 32) * 32;
            dst = WT + WT_MGU + (size_t)e * 2 * D_FFE * D; Kd = D; drow0 = (n0 / 128) * 256 + up * 128 + (n0 % 128); }
        else { r -= 16 * I_M; const int e = r / I_M; r %= I_M; src = a.moe_wd + (size_t)e * D_FFE * D; pitch = D; k0 = (r / 32) * 64; n0 = (r % 32) * 32; dst = WT + WT_MD + (size_t)e * D * D_FFE; Kd = D_FFE; drow0 = n0; }
        transpose_item(src, pitch, k0, n0, dst, Kd, drow0, scr, F.lane);
    }
    for (int idx = F.bid * NTHREADS + F.tid; idx < 2 * 256 * D; idx += F.nb * NTHREADS) {
        const int l = idx / (256 * D), r = (idx / D) % 256, k = idx % D;
        WT[WT_WIN + (size_t)l * NPW * D + (size_t)(2304 + r) * D + k] = (r < 8) ? (bf16_t)f2bf(a.w_in[(size_t)l * D * N_IN + (size_t)k * N_IN + W_DB + r]) : (bf16_t)0;
    }
}

template <int NT> __device__ __forceinline__ void moe_order_init(Frame& F, pg8::MoeOrder<NT>& S) {
    const unsigned* c = (const unsigned*)(F.ws + WS_CTL) + CW_MOECNT;
    int acc = 0;
#pragma unroll
    for (int e = 0; e < 8; ++e) { S.cnt[e] = (int)__hip_atomic_load(c + 64 * e, __ATOMIC_RELAXED, __HIP_MEMORY_SCOPE_AGENT); S.bt[e] = acc; acc += (S.cnt[e] + 255) >> 8; }
    S.bt[8] = acc; S.G = F.nb; S.c = F.bid;
}
template <int NT> __device__ __forceinline__ int moe_ri_one(Frame& F, const pg8::MoeOrder<NT>& S, const int* RM, int o, int t) {
    pg8::Unit u; if (!S.next(o, u)) return -1;
    const int e = u.pn / NT; int bte = 0, cne = 0;
#pragma unroll
    for (int kk = 0; kk < 8; ++kk) { if (kk == e) { bte = S.bt[kk]; cne = S.cnt[kk]; } }
    const int sl = (u.pm - bte) * 256 + t; return (sl < cne) ? RM[(size_t)e * T + sl] : 0;
}
template <int NT> __device__ __forceinline__ void moe_ri_preload(Frame& F, const pg8::MoeOrder<NT>& S) {
    LAS int* RI = (LAS int*)(F.lds + RI_OFF); const int* RM = (const int*)(F.ws + WS_RMAP);
    const int t = F.tid & 255, par = F.tid >> 8;
    const int v0 = moe_ri_one<NT>(F, S, RM, par, t), v1 = moe_ri_one<NT>(F, S, RM, par + 2, t), v2 = moe_ri_one<NT>(F, S, RM, par + 4, t), v3 = moe_ri_one<NT>(F, S, RM, par + 6, t);
    const int v4 = moe_ri_one<NT>(F, S, RM, par + 8, t), v5 = moe_ri_one<NT>(F, S, RM, par + 10, t), v6 = moe_ri_one<NT>(F, S, RM, par + 12, t), v7 = moe_ri_one<NT>(F, S, RM, par + 14, t);
    if (v0 >= 0) RI[(par) * 256 + t] = v0; if (v1 >= 0) RI[(par + 2) * 256 + t] = v1; if (v2 >= 0) RI[(par + 4) * 256 + t] = v2; if (v3 >= 0) RI[(par + 6) * 256 + t] = v3;
    if (v4 >= 0) RI[(par + 8) * 256 + t] = v4; if (v5 >= 0) RI[(par + 10) * 256 + t] = v5; if (v6 >= 0) RI[(par + 12) * 256 + t] = v6;
    if (v7 >= 0 && par + 14 < 15) RI[(par + 14) * 256 + t] = v7;
    __syncthreads();
}

__device__ __forceinline__ void ph_norm0(const Args& a, Frame& F) {
    const float* MOD = (const float*)(F.ws + WS_MOD);
    bf16_t* XA = (bf16_t*)(F.ws + WS_H); bf16_t* X16 = (bf16_t*)(F.ws + WS_X16); float* SSQ = (float*)(F.ws + WS_SSQ) + (size_t)3 * T * 16;
    f32x4 vn[4], A4[4]; int cur_b = -1;
    if (F.gw < T) {
#pragma unroll
        for (int j = 0; j < 4; ++j) vn[j] = ((const f32x4*)(a.x + (size_t)F.gw * D) + F.lane)[64 * j];
    }
    for (int row = F.gw; row < T; row += F.ngw) {
        const int b = row / SEQ;
        f32x4 v[4]; float ss = 0.f;
#pragma unroll
        for (int j = 0; j < 4; ++j) { v[j] = vn[j]; ss += (v[j].x * v[j].x + v[j].y * v[j].y) + (v[j].z * v[j].z + v[j].w * v[j].w); }
        if (row + F.ngw < T) {
#pragma unroll
            for (int j = 0; j < 4; ++j) vn[j] = ((const f32x4*)(a.x + (size_t)(row + F.ngw) * D) + F.lane)[64 * j];
        }
        if (b != cur_b) { cur_b = b;
#pragma unroll
            for (int j = 0; j < 4; ++j) { const int d = 256 * j + 4 * F.lane; A4[j] = *(const f32x4*)(a.nmg + d) * (*(const f32x4*)(MOD + (size_t)b * 3072 + 1024 + d) + 1.0f); } }
#pragma unroll
        for (int j = 0; j < 4; ++j) {
            const int d = 256 * j + 4 * F.lane; const f32x4 xs = v[j] * A4[j];
            u32x2 o; o.x = pk2(v[j].x, v[j].y); o.y = pk2(v[j].z, v[j].w); *(u32x2*)(X16 + (size_t)row * D + d) = o;
            u32x2 p; p.x = pk2(xs.x, xs.y); p.y = pk2(xs.z, xs.w); *(u32x2*)(XA + (size_t)row * D + d) = p;
        }
        ss = wave_sum(ss);
        if (F.lane < 16) SSQ[(size_t)row * 16 + F.lane] = (F.lane == 0) ? ss : 0.f;
    }
}
__device__ __forceinline__ void ph_prep_vectors(const Args& a, Frame& F) {
    const float* MOD = (const float*)(F.ws + WS_MOD); float* AV = (float*)(F.ws + WS_AV);
    for (int idx = F.bid * NTHREADS + F.tid; idx < 3 * BATCH * D; idx += F.nb * NTHREADS) {
        const int inst = idx / (BATCH * D), b = (idx / D) % BATCH, d = idx % D;
        const int lk = (inst == 0) ? 1 : (inst == 1 ? 2 : 3);
        const float gn = (inst == 0) ? a.nfg[d] : (inst == 1 ? a.nmg[D + d] : a.nfg[D + d]);
        AV[idx] = gn * (1.0f + MOD[((size_t)lk * 2 + b) * 3072 + 1024 + d]);
    }
    const bf16_t* WT = (const bf16_t*)(F.ws + WS_WT);
    constexpr int NR = 5632 + NPW + 16384 + NPW;
    LAS float* SH = (LAS float*)F.lds;
    for (int i = F.tid; i < 4 * BATCH * D; i += NTHREADS) { const int which = i / (BATCH * D), b = (i / D) % BATCH, d = i % D; SH[i] = MOD[((size_t)((which + 1) & 3) * 2 + b) * 3072 + d]; }
    __syncthreads();
    for (int g8 = F.gw; g8 < NR / 8; g8 += F.ngw) {
        const int row = g8 * 8 + (F.lane >> 3), part = F.lane & 7;
        int which, r; const bf16_t* wrow; float* out; int ncv;
        if (row < 5632) { which = 0; r = row; wrow = WT + WT_FGU + (size_t)r * D; out = (float*)(F.ws + WS_CVF); ncv = 5632; }
        else if (row < 5632 + NPW) { which = 1; r = row - 5632; wrow = WT + WT_WIN + (size_t)NPW * D + (size_t)r * D; out = (float*)(F.ws + WS_CVI); ncv = NPW; }
        else if (row < 5632 + NPW + 16384) { which = 2; r = row - 5632 - NPW; wrow = WT + WT_MGU + (size_t)r * D; out = (float*)(F.ws + WS_CVM); ncv = 16384; }
        else { which = 3; r = row - 5632 - NPW - 16384; wrow = WT + WT_WIN + (size_t)r * D; out = (float*)(F.ws + WS_CVI0); ncv = NPW; }
        u32x4 wv[16];
#pragma unroll
        for (int j = 0; j < 16; ++j) wv[j] = *(const u32x4*)(wrow + 128 * part + 8 * j);
        const LAS float* s0p = SH + (which * 2 + 0) * 1024 + 128 * part; const LAS float* s1p = s0p + 1024;
        float s0 = 0.f, s1 = 0.f;
#pragma unroll
        for (int j = 0; j < 16; ++j) {
            const f32x4 a0 = *(const LAS f32x4*)(s0p + 8 * j), a1 = *(const LAS f32x4*)(s0p + 8 * j + 4), b0 = *(const LAS f32x4*)(s1p + 8 * j), b1 = *(const LAS f32x4*)(s1p + 8 * j + 4);
            const float x0 = bf2f(wv[j].x & 0xffffu), x1 = bf2f(wv[j].x >> 16), x2 = bf2f(wv[j].y & 0xffffu), x3 = bf2f(wv[j].y >> 16), x4 = bf2f(wv[j].z & 0xffffu), x5 = bf2f(wv[j].z >> 16), x6 = bf2f(wv[j].w & 0xffffu), x7 = bf2f(wv[j].w >> 16);
            s0 += ((x0 * a0.x + x1 * a0.y) + (x2 * a0.z + x3 * a0.w)) + ((x4 * a1.x + x5 * a1.y) + (x6 * a1.z + x7 * a1.w));
            s1 += ((x0 * b0.x + x1 * b0.y) + (x2 * b0.z + x3 * b0.w)) + ((x4 * b1.x + x5 * b1.y) + (x6 * b1.z + x7 * b1.w));
        }
        s0 += __shfl_xor(s0, 1); s0 += __shfl_xor(s0, 2); s0 += __shfl_xor(s0, 4);
        s1 += __shfl_xor(s1, 1); s1 += __shfl_xor(s1, 2); s1 += __shfl_xor(s1, 4);
        if (part == 0) { out[r] = s0; out[ncv + r] = s1; }
    }
    __syncthreads();
    if (F.gw < BATCH * 8) {
        const int b = F.gw >> 3, e = F.gw & 7; float sacc = 0.f;
        for (int d = F.lane; d < D; d += 64) sacc += MOD[((size_t)3 * 2 + b) * 3072 + d] * a.router_w[(size_t)d * NE + e];
        sacc = wave_sum(sacc);
        if (F.lane == 0) ((float*)(F.ws + WS_CR))[b * 8 + e] = sacc;
    }
}
template <class Sched> __device__ __forceinline__ int count_units(const Sched& S) { int n = 0; pg8::Unit u; while (n < 16 && S.next(n, u)) ++n; return n; }
template <class Sched> __device__ __forceinline__ void rstd_preload(Frame& F, const Sched& S, const float* ssqp, const LAS int* RI) {
    LAS float* RS = (LAS float*)(F.lds + RS_OFF);
    const int t = F.tid & 255, par = F.tid >> 8, nu = count_units(S);
#pragma unroll
    for (int k0 = 0; k0 < 8; k0 += 4) {
        f32x4 p0[4], p1[4], p2[4], p3[4]; int r0, r1, r2, r3;
#define RSP_LOAD(k, pk, rk) { const int o = par + 2 * (k0 + k); pg8::Unit u; u.pm = 0; rk = 0; if (o < nu) { S.next(o, u); rk = RI ? RI[o * 256 + t] : u.pm * 256 + t; } \
            const f32x4* q = (const f32x4*)(ssqp + (size_t)rk * 16); pk[0] = q[0]; pk[1] = q[1]; pk[2] = q[2]; pk[3] = q[3]; }
        RSP_LOAD(0, p0, r0) RSP_LOAD(1, p1, r1) RSP_LOAD(2, p2, r2) RSP_LOAD(3, p3, r3)
#undef RSP_LOAD
#define RSP_STORE(k, pk, rk) { const int o = par + 2 * (k0 + k); if (o < nu) { const f32x4 s4 = (pk[0] + pk[1]) + (pk[2] + pk[3]); \
            const float rs = rsqrtf(((s4.x + s4.y) + (s4.z + s4.w)) * (1.0f / D) + EPS); RS[o * 256 + t] = (rk >= SEQ) ? -rs : rs; } }
        RSP_STORE(0, p0, r0) RSP_STORE(1, p1, r1) RSP_STORE(2, p2, r2) RSP_STORE(3, p3, r3)
#undef RSP_STORE
    }
    __syncthreads();
}
__device__ __forceinline__ void ph_router(const Args& a, Frame& F) {
    const bf16_t* XA = (const bf16_t*)(F.ws + WS_H); const float* SSQ = (const float*)(F.ws + WS_SSQ) + (size_t)2 * T * 16; const float* CR = (const float*)(F.ws + WS_CR);
    LAS float* W8T = (LAS float*)F.lds;
    for (int i = F.tid; i < 8192; i += NTHREADS) { const int d = i >> 3, j = i & 7; W8T[j * 1024 + d] = a.router_w[i]; }
    __syncthreads();
    for (int row = F.gw; row < T; row += F.ngw) {
        const int b = row / SEQ;
        float acc[8];
#pragma unroll
        for (int e = 0; e < 8; ++e) acc[e] = 0.f;
#pragma unroll
        for (int jj = 0; jj < 2; ++jj) {
            const int d = 512 * jj + 8 * F.lane;
            const u32x4 xv = *(const u32x4*)(XA + (size_t)row * D + d);
            const float x[8] = {bf2f(xv.x & 0xffffu), bf2f(xv.x >> 16), bf2f(xv.y & 0xffffu), bf2f(xv.y >> 16), bf2f(xv.z & 0xffffu), bf2f(xv.z >> 16), bf2f(xv.w & 0xffffu), bf2f(xv.w >> 16)};
#pragma unroll
            for (int e = 0; e < 8; ++e) { const f32x4 wa = *(const LAS f32x4*)(W8T + e * 1024 + d), wb = *(const LAS f32x4*)(W8T + e * 1024 + d + 4);
                acc[e] += ((x[0] * wa.x + x[1] * wa.y) + (x[2] * wa.z + x[3] * wa.w)) + ((x[4] * wb.x + x[5] * wb.y) + (x[6] * wb.z + x[7] * wb.w)); }
        }
        const float ssq = wave_sum(F.lane < 16 ? SSQ[(size_t)row * 16 + F.lane] : 0.f);
        const float rstd = rsqrtf(ssq * (1.0f / D) + EPS);
#pragma unroll
        for (int e = 0; e < 8; ++e) acc[e] = wave_sum(acc[e]);
        if (F.lane == 0) {
            float v0 = -INFINITY, v1 = -INFINITY; int e0 = 0, e1 = 0;
#pragma unroll
            for (int e = 0; e < 8; ++e) { const float lg = rstd * acc[e] + CR[b * 8 + e] + a.router_b[e]; if (lg > v0) { v1 = v0; e1 = e0; v0 = lg; e0 = e; } else if (lg > v1) { v1 = lg; e1 = e; } }
            const float ex = __expf(v1 - v0), p0 = 1.0f / (1.0f + ex), p1 = ex / (1.0f + ex);
            unsigned* cnt = (unsigned*)(F.ws + WS_CTL) + CW_MOECNT;
            const int q0 = (int)atomicAdd(cnt + 64 * e0, 1u), q1 = (int)atomicAdd(cnt + 64 * e1, 1u);
            int* R = (int*)(F.ws + WS_ROUTE) + (size_t)row * 4; R[0] = e0; R[1] = e1; ((float*)R)[2] = p0; ((float*)R)[3] = p1;
            int* Pq = (int*)(F.ws + WS_POS) + (size_t)row * 2; Pq[0] = q0; Pq[1] = q1;
            int* RM = (int*)(F.ws + WS_RMAP); RM[(size_t)e0 * T + q0] = row; RM[(size_t)e1 * T + q1] = row;
        }
    }
    __syncthreads();
}

__global__ void __launch_bounds__(NTHREADS, 2) fwd(Args a) {
    extern __shared__ __attribute__((aligned(16))) unsigned char lds_raw[];
    Frame F;
    F.lds = (LAS unsigned char*)lds_raw;
    F.tid = threadIdx.x; F.lane = F.tid & 63; F.wave = __builtin_amdgcn_readfirstlane(F.tid >> 6);
    F.bid = blockIdx.x; F.nb = gridDim.x; F.gw = F.bid * NWAVES + F.wave; F.ngw = F.nb * NWAVES; F.ws = (GAS unsigned char*)a.ws;
    volatile LAS unsigned* MISC = (volatile LAS unsigned*)(F.lds + MISC_OFF);
    for (int u = F.tid; u < 32; u += NTHREADS) MISC[u] = 0u;
    __syncthreads();
    unsigned* ctl = (unsigned*)(a.ws + WS_CTL);
    const int lo = a.ph_lo, hi = a.ph_hi;
    const bool multi = (hi - lo) > 1;
    XcdBarrier bar; bar.bar = ctl + CW_BAR; bar.x = 0; bar.st = MISC + 8;
    if (multi) bar = xcd_barrier_post(ctl + CW_BAR, MISC + 8);
#define IN(k) (lo <= (k) && (k) < hi && (frame_refresh(F, a, (LAS unsigned char*)lds_raw), true))
#define SEAM(k) do { if (hi > (k) + 1 && lo <= (k)) { xcd_barrier(bar); if constexpr ((PROBE_MASK & 4194304) != 0) xcd_barrier(bar); } } while (0)
    float* MOD = (float*)(a.ws + WS_MOD);
    bf16_t* H = (bf16_t*)(a.ws + WS_H); bf16_t* PROJ = (bf16_t*)(a.ws + WS_PROJ); bf16_t* YMIX = (bf16_t*)(a.ws + WS_YMIX);
    bf16_t* WT = (bf16_t*)(a.ws + WS_WT);
    bf16_t* ACT = (bf16_t*)(a.ws + WS_ACT); bf16_t* ACTM = (bf16_t*)(a.ws + WS_ACTM); bf16_t* YMOE = (bf16_t*)(a.ws + WS_YMOE);

    if (IN(PH_PRO)) { REP(1) { ph_pro_naive(a, F); ph_pro_weights(a, F); } SEAM(PH_PRO); }

#define TWICE(bit, stmt) do { stmt; if constexpr ((PROBE_MASK & (bit)) != 0) { stmt; } } while (0)
    float* AV = (float*)(a.ws + WS_AV); float* SSQ = (float*)(a.ws + WS_SSQ); bf16_t* X16 = (bf16_t*)(a.ws + WS_X16);
    const LAS float* RSL = (const LAS float*)(F.lds + RS_OFF);
#define LAYER_BODY(l) {\
        const int pb = PH_LAYER0 + PH_PER_LAYER * l; \
        const float* xin = (l == 0) ? a.x : a.out; \
        const float* mod0 = MOD + (size_t)(l * 2 + 0) * 2 * 3072; const float* mod1 = MOD + (size_t)(l * 2 + 1) * 2 * 3072; \
        if (l == 0) { if (IN(pb + K_NORM1)) { REP(2) ph_norm0(a, F); ph_prep_vectors(a, F); SEAM(pb + K_NORM1); } } \
        if (IN(pb + K_GEMM_IN)) { \
            TWICE(4, ({ pg8::Gemm g{H, WT + WT_WIN + (size_t)l * NPW * D, D}; pg8::StaticOrder S; S.init(T, NPW, F.nb, F.bid); rstd_preload(F, S, SSQ + (size_t)(l == 0 ? 3 : 1) * T * 16, nullptr); \
                pg8::EpiProjNorm E{PROJ, RSL, (const float*)(a.ws + (l == 0 ? WS_CVI0 : WS_CVI)), (float*)(a.ws + WS_BG), a.dn_a_log + 4 * l, a.dn_dt_bias + 4 * l}; \
                pg8::gemm_phase<pg8::EpiProjNorm, pg8::StaticOrder, false, true, true>(F.lds, nullptr, g, S, E); })); \
            SEAM(pb + K_GEMM_IN); \
        } \
        if (IN(pb + K_DN_PREP)) { REP(8) ph_dn_chunk(a, F, l); ph_rope(a, F); SEAM(pb + K_DN_PREP); } \
        if (IN(pb + K_MIX)) { REP(16) ph_dn_scan(a, F); REP(512) ph_attn_mfma(a, F, l); REP(1024) ph_conv_fast(a, F, l); SEAM(pb + K_MIX); } \
        if (IN(pb + K_DN_OUT)) { REP(32) ph_dn_out(a, F, l); SEAM(pb + K_DN_OUT); } \
        if (IN(pb + K_GEMM_OUT)) { \
            TWICE(0, ({ pg8::Gemm g{YMIX, WT + WT_WOUT + (size_t)l * D * D, D}; pg8::StaticOrder S; S.init(T, D, F.nb, F.bid); \
                pg8::EpiResidNorm E{X16, X16, mod0 + 2048, AV + (size_t)(l == 0 ? 0 : 2) * BATCH * D, H, SSQ + (size_t)(l == 0 ? 0 : 2) * T * 16}; \
                pg8::gemm_phase<pg8::EpiResidNorm, pg8::StaticOrder, false, true, true>(F.lds, nullptr, g, S, E); })); \
            if constexpr ((PROBE_MASK & 8388608) != 0 && l == 0) { pg8::Gemm g{YMIX, WT + WT_WOUT + (size_t)l * D * D, D}; pg8::StaticOrder S; S.init(T, D, F.nb, F.bid); pg8::EpiBf16 E{(bf16_t*)(a.ws + WS_DN_MR), D, 1 << 20}; \
                pg8::gemm_phase<pg8::EpiBf16, pg8::StaticOrder, false, true, true>(F.lds, nullptr, g, S, E); } \
            if constexpr ((PROBE_MASK & 16777216) != 0 && l == 0) { pg8::Gemm g{YMIX, WT + WT_WOUT + (size_t)l * D * D, D}; pg8::StaticOrder S; S.init(T, D, F.nb, F.bid); \
                pg8::EpiResidNorm E{X16, (bf16_t*)(a.ws + WS_DN_MR), mod0 + 2048, AV, (bf16_t*)(a.ws + WS_DN_MR), (float*)(a.ws + WS_DN_ST)}; \
                pg8::gemm_phase<pg8::EpiResidNorm, pg8::StaticOrder, false, true, true>(F.lds, nullptr, g, S, E); } \
            if constexpr ((PROBE_MASK & 131072) != 0 && l == 0) { pg8::Gemm g{YMIX, WT + WT_WOUT + (size_t)l * D * D, D}; pg8::StaticOrder S; S.init(T, D, F.nb, F.bid); pg8::EpiNull E{}; \
                pg8::gemm_phase<pg8::EpiNull, pg8::StaticOrder, false, true, true>(F.lds, nullptr, g, S, E); } \
            SEAM(pb + K_GEMM_OUT); \
        } \
        if (l == 0) { \
            if (IN(pb + K_FFN1)) { \
                TWICE(256, ({ pg8::Gemm g{H, WT + WT_FGU, D}; pg8::StaticOrder S; S.init(T, 2 * D_FF, F.nb, F.bid); rstd_preload(F, S, SSQ, nullptr); \
                    pg8::EpiSwiGLUNorm E{ACT, D_FF, 1 << 20, RSL, (const float*)(a.ws + WS_CVF), 5632}; \
                    pg8::gemm_phase<pg8::EpiSwiGLUNorm, pg8::StaticOrder, false, true, true>(F.lds, nullptr, g, S, E); })); \
                SEAM(pb + K_FFN1); \
            } \
            if (IN(pb + K_FFN2)) { \
                { pg8::Gemm g{ACT, WT + WT_FD, D_FF}; pg8::StaticOrder S; S.init(T, D, F.nb, F.bid); \
                    pg8::EpiResidNorm E{X16, X16, mod1 + 2048, AV + (size_t)1 * BATCH * D, H, SSQ + (size_t)1 * T * 16}; \
                    pg8::gemm_phase<pg8::EpiResidNorm, pg8::StaticOrder, false, true, true>(F.lds, nullptr, g, S, E); } \
                SEAM(pb + K_FFN2); \
            } \
        } else { \
            if (IN(pb + K_NORM2)) { ph_router(a, F); SEAM(pb + K_NORM2); } \
            if (IN(pb + K_FFN1)) { \
                TWICE(2048, ({ pg8::MoeOrder<8> S; moe_order_init<8>(F, S); moe_ri_preload<8>(F, S); rstd_preload(F, S, SSQ + (size_t)2 * T * 16, (const LAS int*)(F.lds + RI_OFF)); \
                    pg8::Gemm g{H, WT + WT_MGU, D}; pg8::EpiSwiGLUNorm E{ACTM, D_FFE, 8, RSL, (const float*)(a.ws + WS_CVM), 16384}; \
                    pg8::gemm_phase<pg8::EpiSwiGLUNorm, pg8::MoeOrder<8>, true, true, true>(F.lds, (const LAS int*)(F.lds + RI_OFF), g, S, E); })); \
                SEAM(pb + K_FFN1); \
            } \
            if (IN(pb + K_FFN2)) { \
                TWICE(4096, ({ pg8::MoeOrder<4> S; moe_order_init<4>(F, S); \
                    pg8::Gemm g{ACTM, WT + WT_MD, D_FFE}; pg8::EpiBf16 E{YMOE, D, 4}; \
                    pg8::gemm_phase<pg8::EpiBf16, pg8::MoeOrder<4>, false, true, true>(F.lds, nullptr, g, S, E); })); \
                SEAM(pb + K_FFN2); \
            } \
        } \
    }
    LAYER_BODY(0)
    LAYER_BODY(1)
#undef LAYER_BODY
    if (IN(PH_FINAL)) { ph_final(a, F); }
#undef IN
#undef SEAM
}

extern "C" void kernel_launch(void* const* d_in, const int* in_sizes, int n_in, void* d_out, int out_size, void* d_ws, size_t ws_size, hipStream_t stream) {
    static int grid = 0;
    if (grid == 0) {
        if (n_in != 27 || out_size != T * D || ws_size < WS_END) { fprintf(stderr, "kernel_launch: unexpected shapes n_in %d out %d ws %zu\n", n_in, out_size, ws_size); grid = -1; return; }
        int dev = 0, cus = 0, per_cu = 0;
        if (hipGetDevice(&dev) != hipSuccess || hipDeviceGetAttribute(&cus, hipDeviceAttributeMultiprocessorCount, dev) != hipSuccess) { grid = -1; return; }
        if (hipFuncSetAttribute((const void*)fwd, hipFuncAttributeMaxDynamicSharedMemorySize, LDS_BYTES) != hipSuccess) { fprintf(stderr, "kernel_launch: hipFuncSetAttribute failed\n"); grid = -1; return; }
        if (hipOccupancyMaxActiveBlocksPerMultiprocessor(&per_cu, (const void*)fwd, NTHREADS, LDS_BYTES) != hipSuccess || per_cu < 1) fprintf(stderr, "kernel_launch: occupancy query says %d\n", per_cu);
        (void)hipGetLastError();
        grid = cus;
    }
    if (grid < 0) return;
    (void)hipMemsetAsync((char*)d_ws + WS_CTL, 0, CTL_ZERO_BYTES, stream);
    Args a{};
    const void** pp = (const void**)&a;
    for (int i = 0; i < 27; ++i) pp[i] = d_in[i];
    a.out = (float*)d_out; a.ws = (unsigned char*)d_ws;
#if MK_ONE_LAUNCH
    a.ph_lo = 0; a.ph_hi = NPH;
    hipLaunchKernelGGL(fwd, dim3(grid), dim3(NTHREADS), LDS_BYTES, stream, a);
#else
    static const int phases[] = {0, 1, 2, 3, 4, 5, 6, 7, 9, 10, 11, 12, 13, 14, 15, 16, 17, 18, 19, 20, 21};
    for (int p : phases) { a.ph_lo = p; a.ph_hi = p + 1; hipLaunchKernelGGL(fwd, dim3(grid), dim3(NTHREADS), LDS_BYTES, stream, a); }
#endif
}
```

```cpp
#include <hip/hip_runtime.h>
#include <cstdio>
#include <cstdint>

#define LAS __attribute__((address_space(3)))
#define GAS __attribute__((address_space(1)))
typedef unsigned short bf16_t;
typedef float f32x4 __attribute__((ext_vector_type(4)));
typedef unsigned u32x2 __attribute__((ext_vector_type(2)));
typedef unsigned u32x4 __attribute__((ext_vector_type(4)));

#ifndef GEMM_MASK
#define GEMM_MASK 63
#endif
#ifndef ATTN_MFMA
#define ATTN_MFMA 1
#endif
#ifndef DN_CHUNKED
#define DN_CHUNKED 1
#endif
#ifndef CONV_FAST
#define CONV_FAST 1
#endif
#ifndef PROBE_MASK
#define PROBE_MASK 0
#endif
#define REP(bit) for (int rep_ = 0; rep_ < ((PROBE_MASK & (bit)) ? 2 : 1); ++rep_)
#ifndef MK_ONE_LAUNCH
#define MK_ONE_LAUNCH 1
#endif

constexpr int BATCH = 2, SEQ = 16384, T = BATCH * SEQ, D = 1024, DEPTH = 2;
constexpr int NPW = 2560;
constexpr int N_IN = 2312, NP = 2304;
constexpr int C_AQ = 0, C_AK = 512, C_AV = 640, C_DQ = 768, C_DK = 1024, C_DV = 1280, C_DZ = 1536, C_CA = 1792, C_CB = 2048;
constexpr int W_DB = 1536;
constexpr int D_FF = 2816, NE = 8, D_FFE = 1024;
constexpr int WINDOW = 128, CV_K = 31, CV_C = 256, DN_CONV = 4;
constexpr float EPS = 1e-6f;
constexpr int NSCAN = BATCH * 4 * 4;
constexpr int MOE_CAP = 67584;

constexpr size_t MiB = 1u << 20;
constexpr size_t WS_CTL = 0, CTL_ZERO_BYTES = 1 * MiB;
constexpr size_t WS_MOD = 1 * MiB;
constexpr size_t WS_CS = 2 * MiB;
constexpr size_t WS_BG = 4 * MiB;
constexpr size_t WS_ROUTE = 5 * MiB;
constexpr size_t WS_POS = 6 * MiB;
constexpr size_t WS_RMAP = 7 * MiB;
constexpr size_t WS_WT = 8 * MiB;
constexpr size_t WS_H = 88 * MiB;
constexpr size_t WS_PROJ = 152 * MiB;
constexpr size_t WS_YMIX = 296 * MiB;
constexpr size_t WS_DNQKV = 360 * MiB;
constexpr size_t WS_ODN = 456 * MiB;
constexpr size_t WS_ACT = 152 * MiB;
constexpr size_t WS_ACTM = 152 * MiB;
constexpr size_t WS_YMOE = 284 * MiB;
constexpr size_t WS_X16 = 440 * MiB;
constexpr size_t WS_SSQ = 504 * MiB;
constexpr size_t WS_AV = WS_MOD + 128 * 1024;
constexpr size_t WS_CVF = WS_MOD + 256 * 1024;
constexpr size_t WS_CVI = WS_CVF + 2 * 5632 * 4;
constexpr size_t WS_CVM = WS_CVI + 2 * 2560 * 4;
constexpr size_t WS_CR = WS_CVM + 2 * 16384 * 4;
constexpr size_t WS_CVI0 = WS_CR + 64;
static_assert(WS_CVI0 + 2 * 2560 * 4 <= WS_CS, "vector area");
constexpr size_t WS_END = 512 * MiB;
constexpr int CW_BAR = 4096;
constexpr int CW_MOECNT = 16384;

constexpr int NWAVES = 8, NTHREADS = 512;
constexpr int LDS_BYTES = 163840;
constexpr int MISC_OFF = 131072 + 320;
constexpr int RI_OFF = 132096;
constexpr int RS_OFF = 147456;

constexpr int PH_PRO = 0, PH_LAYER0 = 1, PH_PER_LAYER = 10, PH_FINAL = 21, NPH = 22;
enum { K_NORM1 = 0, K_GEMM_IN, K_DN_PREP, K_MIX, K_DN_OUT, K_GEMM_OUT, K_NORM2, K_MOE_LIST, K_FFN1, K_FFN2 };

struct Args {
    const float* x; const float* c; const int* pos; const float* ada_w; const float* ada_b; const float* nmg; const float* nfg;
    const float* w_in; const float* sinks; const float* dn_conv_w; const float* dn_a_log; const float* dn_dt_bias; const float* dn_norm_g;
    const float* cv_dw_w; const float* cv_dw_b; const float* cv_ln_g; const float* cv_ln_b; const float* w_out;
    const float* ffn_wg; const float* ffn_wu; const float* ffn_wd; const float* router_w; const float* router_b;
    const float* moe_wg; const float* moe_wu; const float* moe_wd; const float* final_g;
    float* out; unsigned char* ws; int ph_lo, ph_hi;
};

__device__ __forceinline__ float bf2f(unsigned u) { return __uint_as_float(u << 16); }
__device__ __forceinline__ unsigned f2bf(float f) { unsigned u = __float_as_uint(f); return (u + 0x7fffu + ((u >> 16) & 1u)) >> 16; }
__device__ __forceinline__ unsigned pk2(float lo, float hi) { return f2bf(lo) | (f2bf(hi) << 16); }
__device__ __forceinline__ float wave_sum(float v) {
#pragma unroll
    for (int o = 1; o < 64; o <<= 1) v += __shfl_xor(v, o);
    return v;
}
__device__ __forceinline__ float wave_max(float v) {
#pragma unroll
    for (int o = 1; o < 64; o <<= 1) v = fmaxf(v, __shfl_xor(v, o));
    return v;
}
__device__ __forceinline__ float sigmoidf_(float x) { return __builtin_amdgcn_rcpf(1.0f + __builtin_amdgcn_exp2f(x * -1.4426950408889634f)); }
__device__ __forceinline__ float siluf_(float x) { return x * __builtin_amdgcn_rcpf(1.0f + __builtin_amdgcn_exp2f(x * -1.4426950408889634f)); }
__device__ __forceinline__ float softplusf_(float x) { return fmaxf(x, 0.f) + log1pf(__expf(-fabsf(x))); }

#define XB_TMO      128
#define XB_XCNT(j)  (256  + 64 * (j))
#define XB_XSUB(j)  (1280 + 64 * (j))
#define XB_XGEN(j)  (2304 + 64 * (j))
#define XB_TOP      3328
#define XB_TOPGEN   3392
#define XCD_BAR_WORDS 3456
#define XB_SPIN_CAP (1u << 18)

__device__ __forceinline__ unsigned xb_ld(unsigned* p)              { return __hip_atomic_load(p, __ATOMIC_RELAXED, __HIP_MEMORY_SCOPE_AGENT); }
__device__ __forceinline__ unsigned xb_add(unsigned* p, unsigned v) { return __hip_atomic_fetch_add(p, v, __ATOMIC_RELAXED, __HIP_MEMORY_SCOPE_AGENT); }
__device__ __forceinline__ unsigned xb_xcc_id() { return (unsigned)__builtin_amdgcn_s_getreg((3 << 11) | 20) & 0xFu; }
#define XB_SPIN(cond, bar) do { unsigned _sp = 0; while (cond) { __builtin_amdgcn_s_sleep(1); \
    if ((++_sp & 255u) == 0u) { if (xb_ld(&(bar)[XB_TMO])) break; if (_sp > XB_SPIN_CAP) { atomicAdd(&(bar)[XB_TMO], 1u); break; } } } } while (0)

struct XcdBarrier { unsigned* bar; unsigned x; volatile LAS unsigned* st; };

__device__ __forceinline__ XcdBarrier xcd_barrier_post(unsigned* bar, volatile LAS unsigned* st) {
    XcdBarrier b; b.bar = bar; b.x = xb_xcc_id(); b.st = st;
    if (threadIdx.x == 0) (void)xb_add(&bar[XB_XCNT(b.x)], 1u);
    return b;
}
__device__ __forceinline__ void xcd_barrier_complete(unsigned* bar, unsigned x, unsigned& nloc, unsigned& nx) {
    const unsigned G = gridDim.x * gridDim.y * gridDim.z;
    unsigned sum, cnt, mine, sp = 0u;
    for (;;) {
        sum = 0u; cnt = 0u; mine = 0u;
#pragma unroll
        for (unsigned j = 0; j < 16; ++j) { const unsigned c = xb_ld(&bar[XB_XCNT(j)]); sum += c; cnt += (c > 0u) ? 1u : 0u; mine = (j == x) ? c : mine; }
        if (sum == G) break;
        __builtin_amdgcn_s_sleep(1);
        if ((++sp & 255u) == 0u) { if (xb_ld(&bar[XB_TMO])) break; if (sp > XB_SPIN_CAP) { atomicAdd(&bar[XB_TMO], 1u); break; } }
    }
    nloc = mine > 0u ? mine : 1u; nx = cnt > 0u ? cnt : 1u;
}
__device__ __forceinline__ void xcd_barrier(const XcdBarrier& b) {
    asm volatile("s_waitcnt vmcnt(0)" ::: "memory");
    __syncthreads();
    if (threadIdx.x == 0) {
        unsigned* bar = b.bar;
        __builtin_amdgcn_s_waitcnt(0);
        unsigned nloc = b.st[0], nx = b.st[1];
        if (nloc == 0u) { xcd_barrier_complete(bar, b.x, nloc, nx); b.st[0] = nloc; b.st[1] = nx; }
        const unsigned old = xb_add(&bar[XB_XSUB(b.x)], 1u);
        const unsigned gen = old / nloc;
        if (old + 1u == (gen + 1u) * nloc) {
            __builtin_amdgcn_fence(__ATOMIC_RELEASE, "agent");
            asm volatile("s_waitcnt vmcnt(0)" ::: "memory");
            const unsigned og = xb_add(&bar[XB_TOP], 1u);
            const unsigned tg = og / nx;
            if (og + 1u == (tg + 1u) * nx) xb_add(&bar[XB_TOPGEN], 1u);
            else XB_SPIN(xb_ld(&bar[XB_TOPGEN]) == tg, bar);
            __builtin_amdgcn_fence(__ATOMIC_ACQUIRE, "agent");
            xb_add(&bar[XB_XGEN(b.x)], 1u);
            asm volatile("s_waitcnt vmcnt(0)" ::: "memory");
        } else {
            XB_SPIN(xb_ld(&bar[XB_XGEN(b.x)]) == gen, bar);
            __builtin_amdgcn_fence(__ATOMIC_ACQUIRE, "agent");
            asm volatile("s_waitcnt vmcnt(0)" ::: "memory");
        }
    }
    __syncthreads();
}

struct Frame {
    LAS unsigned char* lds;
    int tid, lane, wave, gw, ngw, bid, nb;
    GAS unsigned char* ws;
};

__device__ __forceinline__ void frame_refresh(Frame& F, const Args& a, LAS unsigned char* lds) {
    int tid = threadIdx.x; asm volatile("" : "+v"(tid));
    int bid = blockIdx.x; asm volatile("" : "+s"(bid));
    unsigned char* ws = a.ws; asm volatile("" : "+s"(ws));
    F.lds = lds; F.tid = tid; F.lane = tid & 63; F.wave = __builtin_amdgcn_readfirstlane(tid >> 6);
    F.bid = bid; F.nb = gridDim.x; F.gw = F.bid * NWAVES + F.wave; F.ngw = F.nb * NWAVES; F.ws = (GAS unsigned char*)ws;
}
__device__ __forceinline__ void ph_pro_vectors(const Args& a, Frame& F) {
    float* MOD = (float*)(F.ws + WS_MOD);
    LAS float* red = (LAS float*)F.lds;
    for (int it = F.bid; it < 4 * 48; it += F.nb) {
        const int lk = it / 48, cg = it % 48, e = cg * 64 + F.lane;
        const float* W = a.ada_w + (size_t)lk * D * 3072 + e;
        float a0 = 0.f, a1 = 0.f;
        const int d0 = F.wave * 128;
#pragma unroll 8
        for (int d = d0; d < d0 + 128; ++d) {
            const float w = W[(size_t)d * 3072];
            a0 += siluf_(a.c[d]) * w; a1 += siluf_(a.c[D + d]) * w;
        }
        red[(F.wave * 2 + 0) * 64 + F.lane] = a0; red[(F.wave * 2 + 1) * 64 + F.lane] = a1;
        __syncthreads();
        if (F.wave < 2) {
            float s = 0.f;
            for (int w = 0; w < 8; ++w) s += red[(w * 2 + F.wave) * 64 + F.lane];
            MOD[((size_t)lk * 2 + F.wave) * 3072 + e] = s + a.ada_b[lk * 3072 + e];
        }
        __syncthreads();
    }
    float* CS = (float*)(F.ws + WS_CS);
    for (int idx = F.bid * NTHREADS + F.tid; idx < T * 8; idx += F.nb * NTHREADS) {
        const int t = idx >> 3, i = idx & 7;
        const float inv = powf(500000.0f, -(float)(2 * i) / 16.0f);
        const float ang = (float)a.pos[t] * inv;
        CS[t * 16 + i] = cosf(ang); CS[t * 16 + 8 + i] = sinf(ang);
    }
}

template <int MODE>
__device__ __forceinline__ void ph_norm(const Args& a, Frame& F, int l, const float* xin, const float* gain, const float* modk  ,
                                        const float* W8, int pitch) {
    bf16_t* H = (bf16_t*)(F.ws + WS_H);
    LAS float* W8T = (LAS float*)F.lds;
    if (MODE != 0) {
        for (int i = F.tid; i < 8192; i += NTHREADS) { const int d = i >> 3, j = i & 7; W8T[j * 1024 + d] = W8[(size_t)d * pitch + j]; }
        __syncthreads();
    }
    f32x4 vn[4], A4[4], B4[4]; int cur_b = -1;
    if (F.gw < T) {
#pragma unroll
        for (int j = 0; j < 4; ++j) vn[j] = ((const f32x4*)(xin + (size_t)F.gw * D) + F.lane)[64 * j];
    }
    for (int row = F.gw; row < T; row += F.ngw) {
        const int b = row / SEQ;
        f32x4 v[4]; float ss = 0.f;
#pragma unroll
        for (int j = 0; j < 4; ++j) { v[j] = vn[j]; ss += (v[j].x * v[j].x + v[j].y * v[j].y) + (v[j].z * v[j].z + v[j].w * v[j].w); }
        if (row + F.ngw < T) {
#pragma unroll
            for (int j = 0; j < 4; ++j) vn[j] = ((const f32x4*)(xin + (size_t)(row + F.ngw) * D) + F.lane)[64 * j];
        }
        if (b != cur_b) {
            cur_b = b; const float* sh = modk + (size_t)b * 3072; const float* sc = sh + 1024;
#pragma unroll
            for (int j = 0; j < 4; ++j) { const int d = 256 * j + 4 * F.lane; A4[j] = *(const f32x4*)(gain + d) * (*(const f32x4*)(sc + d) + 1.0f); B4[j] = *(const f32x4*)(sh + d); }
        }
        const float rstd = rsqrtf(wave_sum(ss) * (1.0f / D) + EPS);
        float acc[8];
#pragma unroll
        for (int e = 0; e < 8; ++e) acc[e] = 0.f;
#pragma unroll
        for (int j = 0; j < 4; ++j) {
            const int d = 256 * j + 4 * F.lane;
            const f32x4 hv = (v[j] * rstd) * A4[j] + B4[j];
            u32x2 o; o.x = pk2(hv.x, hv.y); o.y = pk2(hv.z, hv.w);
            *(u32x2*)(H + (size_t)row * D + d) = o;
            if (MODE == 1) { u32x2 xo; xo.x = pk2(v[j].x, v[j].y); xo.y = pk2(v[j].z, v[j].w); *(u32x2*)((bf16_t*)(F.ws + WS_X16) + (size_t)row * D + d) = xo; }
            if (MODE != 0) {
#pragma unroll
                for (int e = 0; e < 8; ++e) { const f32x4 w4 = *(const LAS f32x4*)(W8T + e * 1024 + d); acc[e] += (hv.x * w4.x + hv.y * w4.y) + (hv.z * w4.z + hv.w * w4.w); }
            }
        }
        if (MODE != 0) {
#pragma unroll
            for (int e = 0; e < 8; ++e) acc[e] = wave_sum(acc[e]);
        }
        if (MODE == 1 && F.lane == 0) {
            float* BG = (float*)(F.ws + WS_BG) + (size_t)row * 8;
#pragma unroll
            for (int h = 0; h < 4; ++h) {
                BG[h] = sigmoidf_(acc[h]);
                BG[4 + h] = -__expf(a.dn_a_log[l * 4 + h]) * softplusf_(acc[4 + h] + a.dn_dt_bias[l * 4 + h]);
            }
        }
        if (MODE == 2 && F.lane == 0) {
            float v0 = -INFINITY, v1 = -INFINITY; int e0 = 0, e1 = 0;
#pragma unroll
            for (int e = 0; e < 8; ++e) { const float lg = acc[e] + a.router_b[e]; if (lg > v0) { v1 = v0; e1 = e0; v0 = lg; e0 = e; } else if (lg > v1) { v1 = lg; e1 = e; } }
            const float ex = __expf(v1 - v0), p0 = 1.0f / (1.0f + ex), p1 = ex / (1.0f + ex);
            unsigned* cnt = (unsigned*)(F.ws + WS_CTL) + CW_MOECNT;
            const int q0 = (int)atomicAdd(cnt + 64 * e0, 1u), q1 = (int)atomicAdd(cnt + 64 * e1, 1u);
            int* R = (int*)(F.ws + WS_ROUTE) + (size_t)row * 4; R[0] = e0; R[1] = e1; ((float*)R)[2] = p0; ((float*)R)[3] = p1;
            int* P = (int*)(F.ws + WS_POS) + (size_t)row * 2; P[0] = q0; P[1] = q1;
        }
    }
    if (MODE != 0) __syncthreads();
}

typedef float f32x16 __attribute__((ext_vector_type(16)));
typedef short s16x4 __attribute__((ext_vector_type(4)));
typedef short bf16x8_t __attribute__((ext_vector_type(8)));
__device__ __forceinline__ unsigned cvtpk(float lo, float hi) { typedef float f2_t __attribute__((ext_vector_type(2))); typedef __bf16 b2_t __attribute__((ext_vector_type(2)));
    f2_t v = {lo, hi}; b2_t b = __builtin_convertvector(v, b2_t); return __builtin_bit_cast(unsigned, b); }
__device__ __forceinline__ void ph_rope(const Args& a, Frame& F) {
    bf16_t* P = (bf16_t*)(F.ws + WS_PROJ); const float* CS = (const float*)(F.ws + WS_CS);
    for (int it = F.bid * NTHREADS + F.tid; it < T * 10; it += F.nb * NTHREADS) {
        const int t = it / 10, hh = it % 10;
        bf16_t* p = P + (size_t)t * NP + hh * 64;
        const u32x4 x1 = *(const u32x4*)p, x2 = *(const u32x4*)(p + 8);
        const f32x4 c0 = *(const f32x4*)(CS + (size_t)t * 16), c1 = *(const f32x4*)(CS + (size_t)t * 16 + 4), s0 = *(const f32x4*)(CS + (size_t)t * 16 + 8), s1 = *(const f32x4*)(CS + (size_t)t * 16 + 12);
        const float cs[8] = {c0.x, c0.y, c0.z, c0.w, c1.x, c1.y, c1.z, c1.w}, sn[8] = {s0.x, s0.y, s0.z, s0.w, s1.x, s1.y, s1.z, s1.w};
        const unsigned xa[4] = {x1.x, x1.y, x1.z, x1.w}, xb[4] = {x2.x, x2.y, x2.z, x2.w};
        unsigned ra[4], rb[4];
#pragma unroll
        for (int i = 0; i < 4; ++i) {
            const float a0 = bf2f(xa[i] & 0xffffu), a1 = bf2f(xa[i] >> 16), b0 = bf2f(xb[i] & 0xffffu), b1 = bf2f(xb[i] >> 16);
            ra[i] = pk2(a0 * cs[2 * i] - b0 * sn[2 * i], a1 * cs[2 * i + 1] - b1 * sn[2 * i + 1]);
            rb[i] = pk2(b0 * cs[2 * i] + a0 * sn[2 * i], b1 * cs[2 * i + 1] + a1 * sn[2 * i + 1]);
        }
        *(u32x4*)p = (u32x4){ra[0], ra[1], ra[2], ra[3]}; *(u32x4*)(p + 8) = (u32x4){rb[0], rb[1], rb[2], rb[3]};
    }
}
constexpr int AT_KROW = 144, AT_VOFF = 256 * AT_KROW;
__device__ __forceinline__ void ph_attn_mfma(const Args& a, Frame& F, int l) {
    const bf16_t* P = (const bf16_t*)(F.ws + WS_PROJ); bf16_t* Y = (bf16_t*)(F.ws + WS_YMIX);
    LAS unsigned char* Kl = F.lds; LAS unsigned char* Vl = F.lds + AT_VOFF;
    const int lane = F.lane, r = lane & 31, h = lane >> 5, g = F.wave >> 1, qh = F.wave & 1;
    const int i16 = lane & 15, tq_ = i16 >> 2, tp_ = i16 & 3, g16 = (lane >> 4) & 1, sw = (tq_ >> 1) & 1;
    const int vlane = (4 * h + tq_) * 128 + (2 * g16 + (tp_ >> 1)) * 16 + (tp_ & 1) * 8;
    const float C = 0.125f * 1.4426950408889634f;
    const int nsc = NSCAN;
    if (F.bid < nsc) return;
    u32x4 kreg[4], vreg[4];
#define AT_LOAD(uu) { const int hk_ = (uu) & 1, n_ = ((uu) >> 1) & 127, b_ = (uu) >> 8, tk0_ = b_ * SEQ + n_ * 128 - 128; \
        _Pragma("unroll") for (int i = 0; i < 4; ++i) { const int piece = F.tid + NTHREADS * i, key = piece >> 3, c = piece & 7; \
            const bf16_t* rowp = P + (size_t)(tk0_ + ((n_ > 0 || key >= 128) ? key : key + 128)) * NP; \
            kreg[i] = *(const u32x4*)(rowp + C_AK + hk_ * 64 + c * 8); vreg[i] = *(const u32x4*)(rowp + C_AV + hk_ * 64 + c * 8); } }
    if (F.bid - nsc < BATCH * 128 * 2) AT_LOAD(F.bid - nsc)
    for (int u = F.bid - nsc; u < BATCH * 128 * 2; u += F.nb - nsc) {
        const int hk = u & 1, n = (u >> 1) & 127, b = u >> 8;
        const int tq0 = b * SEQ + n * 128;
        __syncthreads();
#pragma unroll
        for (int i = 0; i < 4; ++i) {
            const int piece = F.tid + NTHREADS * i, key = piece >> 3, c = piece & 7;
            const bool ok = (n > 0 || key >= 128);
            const u32x4 z4 = (u32x4){0u, 0u, 0u, 0u};
            *(LAS u32x4*)(Kl + key * AT_KROW + c * 16) = ok ? kreg[i] : z4;
            *(LAS u32x4*)(Vl + key * 128 + ((c ^ (((key >> 1) & 1) << 2)) * 16)) = ok ? vreg[i] : z4;
        }
        __syncthreads();
        if (u + (F.nb - nsc) < BATCH * 128 * 2) AT_LOAD(u + (F.nb - nsc))
        asm volatile("" ::: "memory");
        const int hq = hk * 4 + g;
        const float sinkl = a.sinks[l * 8 + hq] * 1.4426950408889634f;
#pragma unroll 1
        for (int sb = 0; sb < 2; ++sb) {
            const int q0 = qh * 64 + sb * 32, kt0 = qh * 2 + sb;
            const size_t tq = (size_t)(tq0 + q0 + r);
            bf16x8_t qf[4];
#pragma unroll
            for (int ks = 0; ks < 4; ++ks) qf[ks] = *(const bf16x8_t*)(P + tq * NP + hq * 64 + 16 * ks + 8 * h);
            f32x16 S[5];
#pragma unroll
            for (int kr = 0; kr < 5; ++kr) {
                f32x16 acc;
#pragma unroll
                for (int i = 0; i < 16; ++i) acc[i] = 0.f;
#pragma unroll
                for (int ks = 0; ks < 4; ++ks) { const bf16x8_t kf = *(const LAS bf16x8_t*)(Kl + (32 * (kt0 + kr) + r) * AT_KROW + (16 * ks + 8 * h) * 2);
                    acc = __builtin_amdgcn_mfma_f32_32x32x16_bf16(kf, qf[ks], acc, 0, 0, 0); }
                S[kr] = acc;
            }
            float m = sinkl;
#pragma unroll
            for (int kr = 0; kr < 5; ++kr) {
                const bool tile_ok = !(n == 0 && (kt0 + kr) < 4);
#pragma unroll
                for (int i = 0; i < 16; ++i) {
                    const int kl = (i & 3) + 8 * (i >> 2) + 4 * h;
                    bool ok = tile_ok; if (kr == 0) ok = ok && (kl > r); if (kr == 4) ok = ok && (kl <= r);
                    const float sv = ok ? S[kr][i] * C : -INFINITY; S[kr][i] = sv; m = fmaxf(m, sv);
                }
            }
            m = fmaxf(m, __shfl_xor(m, 32));
            float lsum = 0.f;
#pragma unroll
            for (int kr = 0; kr < 5; ++kr)
#pragma unroll
                for (int i = 0; i < 16; ++i) { const float p = __builtin_amdgcn_exp2f(S[kr][i] - m); S[kr][i] = p; lsum += p; }
            lsum += __shfl_xor(lsum, 32); lsum += __builtin_amdgcn_exp2f(sinkl - m);
            f32x16 O0, O1;
#pragma unroll
            for (int i = 0; i < 16; ++i) { O0[i] = 0.f; O1[i] = 0.f; }
#pragma unroll
            for (int kr = 0; kr < 5; ++kr) {
#pragma unroll
                for (int s2 = 0; s2 < 2; ++s2) {
                    u32x4 pw; pw.x = cvtpk(S[kr][8 * s2 + 0], S[kr][8 * s2 + 1]); pw.y = cvtpk(S[kr][8 * s2 + 2], S[kr][8 * s2 + 3]); pw.z = cvtpk(S[kr][8 * s2 + 4], S[kr][8 * s2 + 5]); pw.w = cvtpk(S[kr][8 * s2 + 6], S[kr][8 * s2 + 7]);
                    const bf16x8_t pf = __builtin_bit_cast(bf16x8_t, pw);
                    const int kb = (32 * (kt0 + kr) + 16 * s2) * 128 + vlane;
                    const s16x4 lo0 = __builtin_amdgcn_ds_read_tr16_b64_v4i16((LAS s16x4*)(Vl + kb + (0 ^ sw) * 64));
                    const s16x4 hi0 = __builtin_amdgcn_ds_read_tr16_b64_v4i16((LAS s16x4*)(Vl + kb + 8 * 128 + (0 ^ sw) * 64));
                    const s16x4 lo1 = __builtin_amdgcn_ds_read_tr16_b64_v4i16((LAS s16x4*)(Vl + kb + (1 ^ sw) * 64));
                    const s16x4 hi1 = __builtin_amdgcn_ds_read_tr16_b64_v4i16((LAS s16x4*)(Vl + kb + 8 * 128 + (1 ^ sw) * 64));
                    const bf16x8_t va0 = __builtin_shufflevector(lo0, hi0, 0, 1, 2, 3, 4, 5, 6, 7), va1 = __builtin_shufflevector(lo1, hi1, 0, 1, 2, 3, 4, 5, 6, 7);
                    O0 = __builtin_amdgcn_mfma_f32_32x32x16_bf16(va0, pf, O0, 0, 0, 0);
                    O1 = __builtin_amdgcn_mfma_f32_32x32x16_bf16(va1, pf, O1, 0, 0, 0);
                }
            }
            const float inv = __builtin_amdgcn_rcpf(lsum);
            bf16_t* yp = Y + tq * D + hq * 64 + 4 * h;
#pragma unroll
            for (int gq = 0; gq < 4; ++gq) {
                u32x2 o0; o0.x = cvtpk(O0[4 * gq] * inv, O0[4 * gq + 1] * inv); o0.y = cvtpk(O0[4 * gq + 2] * inv, O0[4 * gq + 3] * inv);
                u32x2 o1; o1.x = cvtpk(O1[4 * gq] * inv, O1[4 * gq + 1] * inv); o1.y = cvtpk(O1[4 * gq + 2] * inv, O1[4 * gq + 3] * inv);
                *(u32x2*)(yp + 8 * gq) = o0; *(u32x2*)(yp + 32 + 8 * gq) = o1;
            }
        }
    }
    __syncthreads();
}


#undef AT_LOAD
constexpr size_t WS_DN_MR = 360 * MiB, WS_DN_BNT = 376 * MiB, WS_DN_QP = 392 * MiB, WS_DN_OLT = 408 * MiB, WS_DN_ST = 424 * MiB;
constexpr int DL = 72, LB = 9216;
constexpr int L_KR = 0, L_KT = LB, L_QR = 2 * LB, L_VT = 3 * LB, L_AR = 4 * LB, L_T1 = 5 * LB, L_T2 = 6 * LB, L_UT = 7 * LB, L_UPT = 8 * LB, L_WPT = 9 * LB, L_WT = 0;
constexpr int L_LR = 7 * LB, L_L21 = L_LR + 17408, L_T11T = L_L21 + 4608, L_T22R = L_T11T + 4608, L_YT = L_T22R + 4608, L_GC = 100352, L_BETA = L_GC + 256;
static_assert(L_YT + 4608 == L_GC && L_GC + 512 <= 131072, "DeltaNet LDS map");
template <int KS> __device__ __forceinline__ f32x4 mm16(const LAS unsigned char* lds, int offX, int offY, int tx, int ty, int lane) {
    f32x4 acc = (f32x4){0.f, 0.f, 0.f, 0.f};
    const int l15 = lane & 15, q = lane >> 4;
#pragma unroll
    for (int ks = 0; ks < KS; ++ks) {
        const bf16x8_t xa = *(const LAS bf16x8_t*)(lds + offX + ((16 * tx + l15) * DL + 32 * ks + 8 * q) * 2);
        const bf16x8_t yb = *(const LAS bf16x8_t*)(lds + offY + ((16 * ty + l15) * DL + 32 * ks + 8 * q) * 2);
        acc = __builtin_amdgcn_mfma_f32_16x16x32_bf16(xa, yb, acc, 0, 0, 0);
    }
    return acc;
}
__device__ __forceinline__ u32x2 pack4(f32x4 v) { u32x2 o; o.x = cvtpk(v.x, v.y); o.y = cvtpk(v.z, v.w); return o; }

__device__ __forceinline__ void ph_dn_chunk(const Args& a, Frame& F, int l) {
    const bf16_t* P = (const bf16_t*)(F.ws + WS_PROJ); const float* BG = (const float*)(F.ws + WS_BG);
    bf16_t* MR = (bf16_t*)(F.ws + WS_DN_MR); bf16_t* BNT = (bf16_t*)(F.ws + WS_DN_BNT); bf16_t* QP = (bf16_t*)(F.ws + WS_DN_QP); bf16_t* OLT = (bf16_t*)(F.ws + WS_DN_OLT);
    LAS unsigned char* lds = F.lds;
    LAS float* gcL = (LAS float*)(lds + L_GC); LAS float* betaL = (LAS float*)(lds + L_BETA);
    const float* cw = a.dn_conv_w + (size_t)l * DN_CONV * 768;
    const int lane = F.lane, w = F.wave, l15 = lane & 15, q4 = lane >> 4;
    LAS float* cwL = (LAS float*)(lds + L_GC + 512);
    int cur_h = -1;
    const int ci = F.tid >> 3, c8 = F.tid & 7;
    u32x4 xr[3][4]; float bgb = 0.f, bgg = 0.f;
#define CH_LOAD(vu_) { const int n_ = ((vu_) >> 2) & 255, h_ = (vu_) & 3, b_ = (vu_) >> 10; const int t_ = b_ * SEQ + n_ * 64 + ci; \
        _Pragma("unroll") for (int kd = 0; kd < 3; ++kd) _Pragma("unroll") for (int k = 0; k < DN_CONV; ++k) { \
            const int tt_ = (n_ * 64 + ci - (DN_CONV - 1) + k >= 0) ? t_ - (DN_CONV - 1) + k : t_; xr[kd][k] = *(const u32x4*)(P + (size_t)tt_ * NP + C_DQ + kd * 256 + h_ * 64 + c8 * 8); } \
        if (w == 0) { bgb = BG[(size_t)(b_ * SEQ + n_ * 64 + lane) * 8 + h_]; bgg = BG[(size_t)(b_ * SEQ + n_ * 64 + lane) * 8 + 4 + h_]; } }
    if (F.bid < BATCH * 4 * 256) CH_LOAD(F.bid)
    for (int vu = F.bid; vu < BATCH * 4 * 256; vu += F.nb) {
        const int n = (vu >> 2) & 255, h = vu & 3, b = vu >> 10, unit = (b * 4 + h) * 256 + n;
        const int t0 = b * SEQ + n * 64;
        __syncthreads();
        if (h != cur_h) { cur_h = h;
            for (int idx = F.tid; idx < DN_CONV * 3 * 64; idx += NTHREADS) { const int k = idx / 192, kd = (idx / 64) % 3, cc = idx & 63; cwL[idx] = cw[k * 768 + kd * 256 + h * 64 + cc]; }
            __syncthreads(); }
        {
            const int i = ci, sq = n * 64 + i;
#pragma unroll
            for (int kd = 0; kd < 3; ++kd) {
                float acc[8];
#pragma unroll
                for (int e = 0; e < 8; ++e) acc[e] = 0.f;
#pragma unroll
                for (int k = 0; k < DN_CONV; ++k) {
                    const u32x4 xv = xr[kd][k]; const float vm = (sq - (DN_CONV - 1) + k >= 0) ? 1.f : 0.f;
                    const f32x4 w0 = *(const LAS f32x4*)(cwL + (k * 3 + kd) * 64 + c8 * 8) * vm, w1 = *(const LAS f32x4*)(cwL + (k * 3 + kd) * 64 + c8 * 8 + 4) * vm;
                    acc[0] += w0.x * bf2f(xv.x & 0xffffu); acc[1] += w0.y * bf2f(xv.x >> 16); acc[2] += w0.z * bf2f(xv.y & 0xffffu); acc[3] += w0.w * bf2f(xv.y >> 16);
                    acc[4] += w1.x * bf2f(xv.z & 0xffffu); acc[5] += w1.y * bf2f(xv.z >> 16); acc[6] += w1.z * bf2f(xv.w & 0xffffu); acc[7] += w1.w * bf2f(xv.w >> 16);
                }
                float ss = 0.f;
#pragma unroll
                for (int e = 0; e < 8; ++e) { acc[e] = siluf_(acc[e]); ss += acc[e] * acc[e]; }
                if (kd < 2) {
                    ss += __shfl_xor(ss, 1); ss += __shfl_xor(ss, 2); ss += __shfl_xor(ss, 4);
                    const float rn = rsqrtf(ss + EPS) * (kd == 0 ? 0.125f : 1.0f);
#pragma unroll
                    for (int e = 0; e < 8; ++e) acc[e] *= rn;
                }
                u32x4 pk; pk.x = cvtpk(acc[0], acc[1]); pk.y = cvtpk(acc[2], acc[3]); pk.z = cvtpk(acc[4], acc[5]); pk.w = cvtpk(acc[6], acc[7]);
                if (kd == 0) *(LAS u32x4*)(lds + L_QR + (i * DL + c8 * 8) * 2) = pk;
                if (kd == 1) *(LAS u32x4*)(lds + L_KR + (i * DL + c8 * 8) * 2) = pk;
                if (kd >= 1) {
                    LAS bf16_t* Tt = (LAS bf16_t*)(lds + (kd == 1 ? L_KT : L_VT));
                    const unsigned pw[4] = {pk.x, pk.y, pk.z, pk.w};
#pragma unroll
                    for (int e = 0; e < 8; ++e) Tt[(c8 * 8 + e) * DL + i] = (bf16_t)((pw[e >> 1] >> (16 * (e & 1))) & 0xffffu);
                }
            }
            for (int idx = F.tid; idx < 2 * LB / 16; idx += NTHREADS) *(LAS u32x4*)(lds + L_T1 + idx * 16) = (u32x4){0u, 0u, 0u, 0u};
            if (w == 0) {
                float x = bgg;
#pragma unroll
                for (int o = 1; o < 64; o <<= 1) { const float y = __shfl_up(x, o); if (lane >= o) x += y; }
                gcL[lane] = x; betaL[lane] = bgb;
            }
            if (vu + F.nb < BATCH * 4 * 256) CH_LOAD(vu + F.nb)
            asm volatile("" ::: "memory");
        }
        __syncthreads();
#pragma unroll
        for (int tt = 0; tt < 2; ++tt) {
            const int tidx = 2 * w + tt, tx = tidx >> 2, ty = tidx & 3, i = 16 * ty + l15, j0 = 16 * tx + 4 * q4;
            const float gi = gcL[i], bi = betaL[i]; const f32x4 gj = *(const LAS f32x4*)(gcL + j0);
            const float gjv[4] = {gj.x, gj.y, gj.z, gj.w};
            const f32x4 zk = mm16<2>(lds, L_KR, L_KR, tx, ty, lane);
            const f32x4 zq = mm16<2>(lds, L_KR, L_QR, tx, ty, lane);
            f32x4 lv, av;
#pragma unroll
            for (int r = 0; r < 4; ++r) { const float dc = __expf(fminf(gi - gjv[r], 0.f)); lv[r] = (j0 + r < i) ? bi * zk[r] * dc : 0.f; av[r] = (j0 + r <= i) ? zq[r] * dc : 0.f; }
            *(LAS f32x4*)(lds + L_LR + (i * 68 + j0) * 4) = lv;
            if (i >= 32 && j0 < 32) *(LAS u32x2*)(lds + L_L21 + ((i - 32) * DL + j0) * 2) = pack4(lv);
            *(LAS u32x2*)(lds + L_AR + (i * DL + j0) * 2) = pack4(av);
        }
        __syncthreads();
        REP(32768) {
            const int cg = 8 * w + (lane >> 3), blk = cg >> 5, jp = cg & 31, l8 = lane & 7;
            const LAS float* Lb = (const LAS float*)(lds + L_LR) + (32 * blk) * 68 + 32 * blk + 4 * l8;
            float x0 = 0.f, x1 = 0.f, x2 = 0.f, x3 = 0.f;
#pragma unroll
            for (int i = 0; i < 32; ++i) {
                const f32x4 l4 = *(const LAS f32x4*)(Lb + i * 68);
                float part = (l4.x * x0 + l4.y * x1) + (l4.z * x2 + l4.w * x3);
                part += __shfl_xor(part, 1); part += __shfl_xor(part, 2); part += __shfl_xor(part, 4);
                const float xi = ((i == jp) ? 1.f : 0.f) - part;
                if (l8 == (i >> 2)) { if ((i & 3) == 0) x0 = xi; else if ((i & 3) == 1) x1 = xi; else if ((i & 3) == 2) x2 = xi; else x3 = xi; }
            }
            const int jg = 32 * blk + jp; const float bj = betaL[jg], bej = bj * __expf(gcL[jg]);
            LAS bf16_t* T1 = (LAS bf16_t*)(lds + L_T1); LAS bf16_t* T2 = (LAS bf16_t*)(lds + L_T2);
            const float xs[4] = {x0, x1, x2, x3};
#pragma unroll
            for (int e = 0; e < 4; ++e) { const int rg = 32 * blk + 4 * l8 + e; T1[rg * DL + jg] = (bf16_t)f2bf(xs[e] * bj); T2[rg * DL + jg] = (bf16_t)f2bf(xs[e] * bej); }
            if (blk == 0) { *(LAS u32x2*)(lds + L_T11T + (jp * DL + 4 * l8) * 2) = pack4((f32x4){x0, x1, x2, x3}); }
            else { LAS bf16_t* T22 = (LAS bf16_t*)(lds + L_T22R);
#pragma unroll
                for (int e = 0; e < 4; ++e) T22[(4 * l8 + e) * DL + jp] = (bf16_t)f2bf(xs[e]); }
        }
        __syncthreads();
        if (w < 4) {
            const int tx = w >> 1, ty = w & 1;
            const f32x4 z = mm16<1>(lds, L_L21, L_T11T, tx, ty, lane);
            *(LAS u32x2*)(lds + L_YT + ((16 * ty + l15) * DL + 16 * tx + 4 * q4) * 2) = pack4(z);
        }
        __syncthreads();
        if (w < 4) {
            const int tx = w >> 1, ty = w & 1, y = 16 * ty + l15, x0 = 16 * tx + 4 * q4;
            const f32x4 z = mm16<1>(lds, L_T22R, L_YT, tx, ty, lane);
            const float bj = betaL[y], bej = bj * __expf(gcL[y]);
            LAS bf16_t* T1 = (LAS bf16_t*)(lds + L_T1); LAS bf16_t* T2 = (LAS bf16_t*)(lds + L_T2);
#pragma unroll
            for (int r = 0; r < 4; ++r) { T1[(32 + x0 + r) * DL + y] = (bf16_t)f2bf(-z[r] * bj); T2[(32 + x0 + r) * DL + y] = (bf16_t)f2bf(-z[r] * bej); }
        }
        __syncthreads();
        const float gl = gcL[63];
#pragma unroll
        for (int tt = 0; tt < 2; ++tt) {
            const int tidx = 2 * w + tt, tx = tidx >> 2, ty = tidx & 3, y = 16 * ty + l15, x0 = 16 * tx + 4 * q4;
            const f32x4 gx = *(const LAS f32x4*)(gcL + x0);
            f32x4 sc; sc.x = __expf(gl - gx.x); sc.y = __expf(gl - gx.y); sc.z = __expf(gl - gx.z); sc.w = __expf(gl - gx.w);
            const f32x4 zu = mm16<2>(lds, L_T1, L_VT, tx, ty, lane);
            const f32x4 zw = mm16<2>(lds, L_T2, L_KT, tx, ty, lane);
            *(LAS u32x2*)(lds + L_UT + (y * DL + x0) * 2) = pack4(zu); *(LAS u32x2*)(lds + L_UPT + (y * DL + x0) * 2) = pack4(zu * sc);
            *(LAS u32x2*)(lds + L_WT + (y * DL + x0) * 2) = pack4(zw); *(LAS u32x2*)(lds + L_WPT + (y * DL + x0) * 2) = pack4(zw * sc);
        }
        __syncthreads();
        REP(65536) {
            const size_t cho = (size_t)unit * 4096;
            const float egl = __expf(gl);
#pragma unroll
            for (int tt = 0; tt < 2; ++tt) {
                const int tidx = 2 * w + tt, tx = tidx >> 2, ty = tidx & 3, y = 16 * ty + l15, x0 = 16 * tx + 4 * q4;
                f32x4 zm = mm16<2>(lds, L_WPT, L_KT, tx, ty, lane);
#pragma unroll
                for (int r = 0; r < 4; ++r) zm[r] = ((x0 + r) == y ? egl : 0.f) - zm[r];
                *(u32x2*)(MR + cho + (ty * 2 + (tx >> 1)) * 512 + lane * 8 + 4 * (tx & 1)) = pack4(zm);
                const f32x4 zb = mm16<2>(lds, L_KT, L_UPT, tx, ty, lane);
                *(u32x2*)(BNT + cho + (ty * 4 + tx) * 256 + lane * 4) = pack4(zb);
                const f32x4 zq = mm16<2>(lds, L_WT, L_AR, tx, ty, lane);
                const u32x2 qv = *(const LAS u32x2*)(lds + L_QR + (y * DL + x0) * 2); const float eg = __expf(gcL[y]);
                f32x4 qp; qp.x = bf2f(qv.x & 0xffffu) * eg - zq.x; qp.y = bf2f(qv.x >> 16) * eg - zq.y; qp.z = bf2f(qv.y & 0xffffu) * eg - zq.z; qp.w = bf2f(qv.y >> 16) * eg - zq.w;
                *(u32x2*)(QP + cho + y * 64 + x0) = pack4(qp);
                const f32x4 zo = mm16<2>(lds, L_AR, L_UT, tx, ty, lane);
                *(u32x2*)(OLT + cho + y * 64 + x0) = pack4(zo);
            }
        }
    }
    __syncthreads();
}
#undef CH_LOAD
constexpr int SC_SLOT = 10240, SC_DEPTH = 12, SC_AHEAD = 11;
__device__ __forceinline__ void ph_dn_scan(const Args& a, Frame& F) {
    if (F.bid >= NSCAN) return;
    const unsigned char* MRb = (const unsigned char*)(F.ws + WS_DN_MR); const unsigned char* BNb = (const unsigned char*)(F.ws + WS_DN_BNT); bf16_t* ST = (bf16_t*)(F.ws + WS_DN_ST);
    const int lane = F.lane, l15 = lane & 15, q4 = lane >> 4, wq = F.bid >> 3;
    const size_t ch0 = (size_t)(F.bid & 7) * 256;
    LAS unsigned char* lds = F.lds;
    __syncthreads();
    if (F.wave >= 3) {
        const int lw = F.wave - 3;
#define DN_ISSUE(nn) do { const size_t chb_ = (ch0 + (size_t)((nn) < 255 ? (nn) : 255)) * 8192; const int slot_ = ((nn) % SC_DEPTH) * SC_SLOT; \
        _Pragma("unroll") for (int p_ = 0; p_ < 2; ++p_) { const int piece_ = lw * 2 + p_; \
            const unsigned char* src_ = (piece_ < 8 ? MRb + chb_ + piece_ * 1024 : BNb + chb_ + wq * 2048 + (piece_ - 8) * 1024) + lane * 16; \
            __builtin_amdgcn_global_load_lds((const unsigned*)src_, (LAS unsigned*)(lds + slot_ + piece_ * 1024), 16, 0, 0); } } while (0)
        for (int n = 0; n < SC_AHEAD; ++n) DN_ISSUE(n);
        for (int n = 0; n < 256; ++n) {
            asm volatile("s_waitcnt vmcnt(20)" ::: "memory");
            __builtin_amdgcn_s_barrier();
            DN_ISSUE(n + SC_AHEAD);
        }
        asm volatile("s_waitcnt vmcnt(0)" ::: "memory");
#undef DN_ISSUE
    } else if (F.wave == 0) {
        const int dv = 16 * wq + l15;
        f32x4 S[4];
#pragma unroll
        for (int ti = 0; ti < 4; ++ti) S[ti] = (f32x4){0.f, 0.f, 0.f, 0.f};
        for (int n = 0; n < 256; ++n) {
            __builtin_amdgcn_s_barrier();
            const LAS unsigned char* slot = lds + (n % SC_DEPTH) * SC_SLOT;
            bf16x8_t A[4][2]; u32x2 Bc[4];
#pragma unroll
            for (int ti = 0; ti < 4; ++ti) {
#pragma unroll
                for (int ks = 0; ks < 2; ++ks) A[ti][ks] = *(const LAS bf16x8_t*)(slot + (ti * 2 + ks) * 1024 + lane * 16);
                Bc[ti] = *(const LAS u32x2*)(slot + 8192 + ti * 512 + lane * 8);
            }
            u32x2 sp[4];
#pragma unroll
            for (int ti = 0; ti < 4; ++ti) { sp[ti] = pack4(S[ti]); *(u32x2*)(ST + (ch0 + n) * 4096 + dv * 64 + 16 * ti + 4 * q4) = sp[ti]; }
            const bf16x8_t b0 = __builtin_bit_cast(bf16x8_t, (u32x4){sp[0].x, sp[0].y, sp[1].x, sp[1].y});
            const bf16x8_t b1 = __builtin_bit_cast(bf16x8_t, (u32x4){sp[2].x, sp[2].y, sp[3].x, sp[3].y});
#pragma unroll
            for (int ti = 0; ti < 4; ++ti) {
                f32x4 c; c.x = bf2f(Bc[ti].x & 0xffffu); c.y = bf2f(Bc[ti].x >> 16); c.z = bf2f(Bc[ti].y & 0xffffu); c.w = bf2f(Bc[ti].y >> 16);
                c = __builtin_amdgcn_mfma_f32_16x16x32_bf16(A[ti][0], b0, c, 0, 0, 0);
                c = __builtin_amdgcn_mfma_f32_16x16x32_bf16(A[ti][1], b1, c, 0, 0, 0);
                S[ti] = c;
            }
            asm volatile("s_waitcnt lgkmcnt(0)" ::: "memory");
        }
    } else {
        for (int n = 0; n < 256; ++n) __builtin_amdgcn_s_barrier();
    }
    __syncthreads();
}
__device__ __forceinline__ void ph_dn_out(const Args& a, Frame& F, int l) {
    const bf16_t* QP = (const bf16_t*)(F.ws + WS_DN_QP); const bf16_t* OLT = (const bf16_t*)(F.ws + WS_DN_OLT); const bf16_t* ST = (const bf16_t*)(F.ws + WS_DN_ST);
    const bf16_t* P = (const bf16_t*)(F.ws + WS_PROJ); bf16_t* Y = (bf16_t*)(F.ws + WS_YMIX);
    const int lane = F.lane, l15 = lane & 15, q4 = lane >> 4, ti = F.wave & 3;
    LAS bf16_t* TL = (LAS bf16_t*)(F.lds + F.wave * 2560);
    const int er = lane >> 2, ec = (lane & 3) * 16;
    f32x4 gnv[4];
#pragma unroll
    for (int j = 0; j < 4; ++j) gnv[j] = *(const f32x4*)(a.dn_norm_g + l * 64 + ec + 4 * j);
    bf16x8_t af[2], bfv[4][2]; u32x2 ov[4];
#define DNO_LOAD(prv) { const int unit_ = 2 * (prv) + (F.wave >> 2); const size_t cho_ = (size_t)unit_ * 4096; \
        _Pragma("unroll") for (int ks = 0; ks < 2; ++ks) af[ks] = *(const bf16x8_t*)(QP + cho_ + (16 * ti + l15) * 64 + 32 * ks + 8 * q4); \
        _Pragma("unroll") for (int tj = 0; tj < 4; ++tj) { ov[tj] = *(const u32x2*)(OLT + cho_ + (16 * tj + l15) * 64 + 16 * ti + 4 * q4); \
            _Pragma("unroll") for (int ks = 0; ks < 2; ++ks) bfv[tj][ks] = *(const bf16x8_t*)(ST + cho_ + (16 * tj + l15) * 64 + 32 * ks + 8 * q4); } }
    if (F.bid < 1024) DNO_LOAD(F.bid)
    for (int pr = F.bid; pr < 1024; pr += F.nb) {
        const int unit = 2 * pr + (F.wave >> 2), n = unit & 255, h = (unit >> 8) & 3, b = unit >> 10;
        f32x4 acc[4];
#pragma unroll
        for (int tj = 0; tj < 4; ++tj) {
            f32x4 c; c.x = bf2f(ov[tj].x & 0xffffu); c.y = bf2f(ov[tj].x >> 16); c.z = bf2f(ov[tj].y & 0xffffu); c.w = bf2f(ov[tj].y >> 16);
#pragma unroll
            for (int ks = 0; ks < 2; ++ks) c = __builtin_amdgcn_mfma_f32_16x16x32_bf16(af[ks], bfv[tj][ks], c, 0, 0, 0);
            acc[tj] = c;
        }
        const size_t trow = (size_t)b * SEQ + n * 64 + 16 * ti + er;
        const u32x4 z0 = *(const u32x4*)(P + trow * NP + C_DZ + h * 64 + ec), z1 = *(const u32x4*)(P + trow * NP + C_DZ + h * 64 + ec + 8);
        if (pr + F.nb < 1024) DNO_LOAD(pr + F.nb)
        f32x4 ss = acc[0] * acc[0] + acc[1] * acc[1] + acc[2] * acc[2] + acc[3] * acc[3];
#pragma unroll
        for (int o = 1; o < 16; o <<= 1) { ss.x += __shfl_xor(ss.x, o); ss.y += __shfl_xor(ss.y, o); ss.z += __shfl_xor(ss.z, o); ss.w += __shfl_xor(ss.w, o); }
        const float rs[4] = {rsqrtf(ss.x * (1.f / 64.f) + EPS), rsqrtf(ss.y * (1.f / 64.f) + EPS), rsqrtf(ss.z * (1.f / 64.f) + EPS), rsqrtf(ss.w * (1.f / 64.f) + EPS)};
#pragma unroll
        for (int tj = 0; tj < 4; ++tj)
#pragma unroll
            for (int r = 0; r < 4; ++r) TL[(4 * q4 + r) * 80 + 16 * tj + l15] = (bf16_t)f2bf(acc[tj][r] * rs[r]);
        const u32x4 t0 = *(const LAS u32x4*)(TL + er * 80 + ec), t1 = *(const LAS u32x4*)(TL + er * 80 + ec + 8);
        const unsigned tw[8] = {t0.x, t0.y, t0.z, t0.w, t1.x, t1.y, t1.z, t1.w}, zw[8] = {z0.x, z0.y, z0.z, z0.w, z1.x, z1.y, z1.z, z1.w};
        unsigned yw[8];
#pragma unroll
        for (int j = 0; j < 8; ++j) {
            const float g0 = gnv[j >> 1][(2 * j) & 3], g1 = gnv[j >> 1][(2 * j + 1) & 3];
            yw[j] = cvtpk(bf2f(tw[j] & 0xffffu) * g0 * siluf_(bf2f(zw[j] & 0xffffu)), bf2f(tw[j] >> 16) * g1 * siluf_(bf2f(zw[j] >> 16)));
        }
        bf16_t* yp = Y + trow * D + 512 + h * 64 + ec;
        *(u32x4*)yp = (u32x4){yw[0], yw[1], yw[2], yw[3]}; *(u32x4*)(yp + 8) = (u32x4){yw[4], yw[5], yw[6], yw[7]};
    }
#undef DNO_LOAD
}

__device__ __forceinline__ void ph_conv_fast(const Args& a, Frame& F, int l) {
    const bf16_t* P = (const bf16_t*)(F.ws + WS_PROJ); bf16_t* Y = (bf16_t*)(F.ws + WS_YMIX);
    LAS float* OUTL = (LAS float*)F.lds;
    const int c = F.tid & 255, rsel = F.tid >> 8;
    float wk[CV_K];
#pragma unroll
    for (int k = 0; k < CV_K; ++k) wk[k] = a.cv_dw_w[((size_t)l * CV_K + k) * CV_C + c];
    const float bias = a.cv_dw_b[l * CV_C + c];
    const int nsc = NSCAN;
    if (F.bid < nsc) return;
    for (int pr = (F.bid - nsc + (F.nb - nsc) / 2) % (F.nb - nsc); pr < T / 128; pr += F.nb - nsc) {
        const int run = 2 * pr + rsel, t0 = run * 64, s0 = t0 % SEQ;
        __syncthreads();
        float win[CV_K];
        const bf16_t* pc = P + (size_t)(t0 - 30) * NP + C_CA + c;
        const bool first = (s0 == 0);
        LAS float* outp = OUTL + (rsel * 64) * 256 + c;
#define CV_U(ti_, dst) { const bool ok_ = !(first && (ti_) < 30); const bf16_t* q_ = ok_ ? pc + (size_t)(ti_) * NP : pc + (size_t)30 * NP; \
            const float ca_ = bf2f(q_[0]), cb_ = bf2f(q_[256]); dst = ok_ ? ca_ * sigmoidf_(cb_) : 0.f; }
#pragma unroll
        for (int p = 0; p < CV_K; ++p) CV_U(p, win[p])
        { float acc = bias;
#pragma unroll
            for (int k = 0; k < CV_K; ++k) acc += wk[k] * win[(30 + 1 + k) % CV_K];
            outp[0] = acc; }
        for (int cb3 = 1; cb3 < 3; ++cb3) {
            float un[CV_K];
#pragma unroll
            for (int p = 0; p < CV_K; ++p) CV_U(cb3 * CV_K + p, un[p])
#pragma unroll
            for (int p = 0; p < CV_K; ++p) {
                win[p] = un[p];
                float acc = bias;
#pragma unroll
                for (int k = 0; k < CV_K; ++k) acc += wk[k] * win[(p + 1 + k) % CV_K];
                outp[(cb3 * CV_K + p - 30) * 256] = acc;
            }
        }
        { float u93; CV_U(93, u93) win[0] = u93; float acc = bias;
#pragma unroll
            for (int k = 0; k < CV_K; ++k) acc += wk[k] * win[(0 + 1 + k) % CV_K];
            outp[63 * 256] = acc; }
#undef CV_U
        __syncthreads();
        const f32x4 g4 = *(const f32x4*)(a.cv_ln_g + l * CV_C + 4 * F.lane), b4 = *(const f32x4*)(a.cv_ln_b + l * CV_C + 4 * F.lane);
        for (int j = 0; j < 16; ++j) {
            const int tl = F.wave * 16 + j;
            const f32x4 v = *(const LAS f32x4*)(OUTL + tl * 256 + 4 * F.lane);
            const float mean = wave_sum((v.x + v.y) + (v.z + v.w)) * (1.0f / CV_C);
            const f32x4 dv = v - mean;
            const float var = wave_sum((dv.x * dv.x + dv.y * dv.y) + (dv.z * dv.z + dv.w * dv.w)) * (1.0f / CV_C);
            const float rstd = rsqrtf(var + EPS);
            const f32x4 y = (dv * rstd) * g4 + b4;
            u32x2 o; o.x = cvtpk(siluf_(y.x), siluf_(y.y)); o.y = cvtpk(siluf_(y.z), siluf_(y.w));
            *(u32x2*)(Y + (size_t)(pr * 128 + tl) * D + 768 + 4 * F.lane) = o;
        }
    }
    __syncthreads();
}

__device__ __forceinline__ void moe_bases(Frame& F, int (&base)[9], int (&cnt)[8]) {
    const unsigned* c = (const unsigned*)(F.ws + WS_CTL) + CW_MOECNT;
    int acc = 0;
#pragma unroll
    for (int e = 0; e < 8; ++e) { cnt[e] = (int)__hip_atomic_load(c + 64 * e, __ATOMIC_RELAXED, __HIP_MEMORY_SCOPE_AGENT); base[e] = acc; acc += (cnt[e] + 255) & ~255; }
    base[8] = acc;
}
__device__ __forceinline__ void moe_range(Frame& F, int e, int& lo, int& hi) {
    const unsigned* c = (const unsigned*)(F.ws + WS_CTL) + CW_MOECNT;
    int acc = 0; lo = 0; hi = 0;
#pragma unroll
    for (int k = 0; k < 8; ++k) { const int n = ((int)__hip_atomic_load(c + 64 * k, __ATOMIC_RELAXED, __HIP_MEMORY_SCOPE_AGENT) + 255) & ~255; if (k == e) { lo = acc; hi = acc + n; } acc += n; }
}
__device__ __forceinline__ void ph_moe_list(const Args& a, Frame& F) {
    int base[9], cnt[8]; moe_bases(F, base, cnt);
    int* RM = (int*)(F.ws + WS_RMAP); const int* R = (const int*)(F.ws + WS_ROUTE); const int* Pq = (const int*)(F.ws + WS_POS);
    for (int t = F.bid * NTHREADS + F.tid; t < T; t += F.nb * NTHREADS) {
        const int e0 = R[t * 4], e1 = R[t * 4 + 1];
        int b0 = 0, b1 = 0;
#pragma unroll
        for (int e = 0; e < 8; ++e) { if (e == e0) b0 = base[e]; if (e == e1) b1 = base[e]; }
        RM[b0 + Pq[t * 2]] = t; RM[b1 + Pq[t * 2 + 1]] = t;
    }
    if (F.bid == 0) {
#pragma unroll
        for (int e = 0; e < 8; ++e) { const int lo = base[e] + cnt[e], hi = base[e + 1]; for (int r = lo + F.tid; r < hi; r += NTHREADS) RM[r] = 0; }
    }
}
__device__ __forceinline__ void ph_final(const Args& a, Frame& F) {
    int base[9], cnt[8]; moe_bases(F, base, cnt);
    const float* MOD = (const float*)(F.ws + WS_MOD);
    const bf16_t* YM = (const bf16_t*)(F.ws + WS_YMOE); const int* R = (const int*)(F.ws + WS_ROUTE); const int* Pq = (const int*)(F.ws + WS_POS); const bf16_t* X16 = (const bf16_t*)(F.ws + WS_X16);
    const int c0 = 8 * F.lane;
    f32x4 fg[4], gt[4]; int cur_b = -1;
#pragma unroll
    for (int j = 0; j < 4; ++j) fg[j] = *(const f32x4*)(a.final_g + 512 * (j >> 1) + c0 + 4 * (j & 1));
    u32x4 rt_n; u32x2 pq_n;
    u32x4 dx[2], dy0[2], dy1[2]; float p0c = 0.f, p1c = 0.f;
#define FIN_ROUTE(row_, rt_, pq_) { rt_ = *(const u32x4*)(R + (size_t)(row_) * 4); pq_ = *(const u32x2*)(Pq + (size_t)(row_) * 2); }
#define FIN_DATA(row_, rt_, pq_) { int b0_ = 0, b1_ = 0; _Pragma("unroll") for (int e = 0; e < 8; ++e) { if (e == (int)rt_.x) b0_ = base[e]; if (e == (int)rt_.y) b1_ = base[e]; } \
        const size_t s0_ = (size_t)(b0_ + (int)pq_.x), s1_ = (size_t)(b1_ + (int)pq_.y); p0c = __uint_as_float(rt_.z); p1c = __uint_as_float(rt_.w); \
        _Pragma("unroll") for (int jj = 0; jj < 2; ++jj) { dx[jj] = *(const u32x4*)(X16 + (size_t)(row_) * D + 512 * jj + c0); dy0[jj] = *(const u32x4*)(YM + s0_ * D + 512 * jj + c0); dy1[jj] = *(const u32x4*)(YM + s1_ * D + 512 * jj + c0); } }
    if (F.gw < T) { u32x4 rt0; u32x2 pq0; FIN_ROUTE(F.gw, rt0, pq0) FIN_DATA(F.gw, rt0, pq0) }
    if (F.gw + F.ngw < T) FIN_ROUTE(F.gw + F.ngw, rt_n, pq_n)
    for (int row = F.gw; row < T; row += F.ngw) {
        const int b = row / SEQ;
        if (b != cur_b) { cur_b = b; const float* gt2 = MOD + ((size_t)(1 * 2 + 1) * 2 + b) * 3072 + 2048;
#pragma unroll
            for (int j = 0; j < 4; ++j) gt[j] = *(const f32x4*)(gt2 + 512 * (j >> 1) + c0 + 4 * (j & 1)); }
        f32x4 v[4]; float ss = 0.f; const float p0 = p0c, p1 = p1c;
#pragma unroll
        for (int jj = 0; jj < 2; ++jj) {
            const unsigned xw[4] = {dx[jj].x, dx[jj].y, dx[jj].z, dx[jj].w}, y0w[4] = {dy0[jj].x, dy0[jj].y, dy0[jj].z, dy0[jj].w}, y1w[4] = {dy1[jj].x, dy1[jj].y, dy1[jj].z, dy1[jj].w};
#pragma unroll
            for (int hf = 0; hf < 2; ++hf) {
                f32x4 f, xo;
                f.x = p0 * bf2f(y0w[2 * hf] & 0xffffu) + p1 * bf2f(y1w[2 * hf] & 0xffffu); f.y = p0 * bf2f(y0w[2 * hf] >> 16) + p1 * bf2f(y1w[2 * hf] >> 16);
                f.z = p0 * bf2f(y0w[2 * hf + 1] & 0xffffu) + p1 * bf2f(y1w[2 * hf + 1] & 0xffffu); f.w = p0 * bf2f(y0w[2 * hf + 1] >> 16) + p1 * bf2f(y1w[2 * hf + 1] >> 16);
                xo.x = bf2f(xw[2 * hf] & 0xffffu); xo.y = bf2f(xw[2 * hf] >> 16); xo.z = bf2f(xw[2 * hf + 1] & 0xffffu); xo.w = bf2f(xw[2 * hf + 1] >> 16);
                const f32x4 vv = xo + gt[2 * jj + hf] * f; v[2 * jj + hf] = vv;
                ss += (vv.x * vv.x + vv.y * vv.y) + (vv.z * vv.z + vv.w * vv.w);
            }
        }
        if (row + F.ngw < T) { FIN_DATA(row + F.ngw, rt_n, pq_n) }
        if (row + 2 * F.ngw < T) FIN_ROUTE(row + 2 * F.ngw, rt_n, pq_n)
        const float rstd = rsqrtf(wave_sum(ss) * (1.0f / D) + EPS);
        float* op = a.out + (size_t)row * D + c0;
#pragma unroll
        for (int j = 0; j < 4; ++j) *(f32x4*)(op + 512 * (j >> 1) + 4 * (j & 1)) = (v[j] * rstd) * fg[j];
    }
#undef FIN_ROUTE
#undef FIN_DATA
}


namespace pg8 {
typedef short bf16x8 __attribute__((ext_vector_type(8)));
constexpr int BM = 256, BK = 64, HALF = 128, HTB = HALF * BK * 2, STAGE_BYTES = 8 * HTB;
__device__ __forceinline__ int lds_byte(int r, int c) { const int st = (r >> 4) * 2 + (c >> 5), rr = r & 15, cc = c & 31, ob = rr * 64 + cc * 2; return st * 1024 + (ob ^ (((ob >> 9) & 1) << 5)); }
__device__ __forceinline__ void stage_rc(int b, int& R, int& C) { const int st = b / 1024, sb = b % 1024, swz = sb ^ (((sb >> 9) & 1) << 5); R = (st >> 1) * 16 + swz / 64; C = (st & 1) * 32 + (swz % 64) / 2; }
__device__ __forceinline__ int perm32(int rho) { const int n = rho >> 4, i = rho & 15; return 8 * (i >> 2) + 4 * n + (i & 3); }
struct Unit { int pm, pn, ord; };
struct Gemm { const bf16_t* A; const bf16_t* Bt; int K; };
constexpr int NXCD = 8, WGM = 8;
struct StaticOrder {
    int nM, nN, nwg, G, c;
    __device__ void init(int M, int N, int G_, int c_) { nM = M / BM; nN = N / BM; nwg = nM * nN; G = G_; c = c_; }
    __device__ __forceinline__ bool next(int i, Unit& u) const {
        const long L = (long)i * G + c; if (L >= nwg) return false;
        int wgid = (int)L; { const int q = nwg / NXCD, r = nwg % NXCD, xcd = wgid % NXCD, off = wgid / NXCD; wgid = (xcd < r ? xcd * (q + 1) : r * (q + 1) + (xcd - r) * q) + off; }
        const int nig = WGM * nN, gid = wgid / nig, fm = gid * WGM, gsz = (nM - fm) < WGM ? (nM - fm) : WGM;
        u.pm = fm + ((wgid % nig) % gsz); u.pn = (wgid % nig) / gsz; return true;
    }
};
template <int NT> struct MoeOrder {
    int bt[9]; int cnt[8]; int G, c;
    __device__ __forceinline__ bool next(int i, Unit& u) const {
        const int L = i * G + c; if (L >= bt[8] * NT) return false;
        const int q = L / NT, tn = L % NT; int e = 0;
#pragma unroll
        for (int k = 1; k < 8; ++k) e += (q >= bt[k]) ? 1 : 0;
        u.pm = q; u.pn = e * NT + tn; return true;
    }
};
__device__ __forceinline__ unsigned cvt_pk_bf16(float lo, float hi) { unsigned r; asm volatile("v_cvt_pk_bf16_f32 %0, %1, %2" : "=v"(r) : "v"(lo), "v"(hi)); return r; }
__device__ __forceinline__ float fast_silu(float x) { return x * __builtin_amdgcn_rcpf(1.0f + __builtin_amdgcn_exp2f(x * -1.4426950408889634f)); }

struct EpiBf16 {
    static constexpr bool PERM = true, WIDE = false;
    bf16_t* O; int ldc; int nmod;
    __device__ __forceinline__ void operator()(const f32x4 (&acc)[2][2][4][2], const Unit& u, int wr, int wc, int fr, int fq) const {
        const int row0 = u.pm * BM + wr * 64 + fr, col0 = (u.pn % nmod) * BM + wc * 32 + 8 * fq;
#pragma unroll
        for (int ai = 0; ai < 2; ++ai)
#pragma unroll
            for (int m = 0; m < 4; ++m) { bf16_t* rowp = O + (size_t)(row0 + ai * HALF + m * 16) * ldc + col0;
#pragma unroll
                for (int bj = 0; bj < 2; ++bj) { const f32x4 v0 = acc[ai][bj][m][0], v1 = acc[ai][bj][m][1];
                    u32x4 w; w.x = cvt_pk_bf16(v0[0], v0[1]); w.y = cvt_pk_bf16(v0[2], v0[3]); w.z = cvt_pk_bf16(v1[0], v1[1]); w.w = cvt_pk_bf16(v1[2], v1[3]);
                    *(u32x4*)(rowp + bj * HALF) = w; } }
    }
};
struct EpiSwiGLU {
    static constexpr bool PERM = true, WIDE = false;
    bf16_t* O; int ldc; int nmod;
    __device__ __forceinline__ void operator()(const f32x4 (&acc)[2][2][4][2], const Unit& u, int wr, int wc, int fr, int fq) const {
        const int row0 = u.pm * BM + wr * 64 + fr, col0 = (u.pn % nmod) * HALF + wc * 32 + 8 * fq;
#pragma unroll
        for (int ai = 0; ai < 2; ++ai)
#pragma unroll
            for (int m = 0; m < 4; ++m) {
                const f32x4 g0 = acc[ai][0][m][0], g1 = acc[ai][0][m][1], u0 = acc[ai][1][m][0], u1 = acc[ai][1][m][1];
                u32x4 w;
                w.x = cvt_pk_bf16(fast_silu(g0[0]) * u0[0], fast_silu(g0[1]) * u0[1]); w.y = cvt_pk_bf16(fast_silu(g0[2]) * u0[2], fast_silu(g0[3]) * u0[3]);
                w.z = cvt_pk_bf16(fast_silu(g1[0]) * u1[0], fast_silu(g1[1]) * u1[1]); w.w = cvt_pk_bf16(fast_silu(g1[2]) * u1[2], fast_silu(g1[3]) * u1[3]);
                *(u32x4*)(O + (size_t)(row0 + ai * HALF + m * 16) * ldc + col0) = w; }
    }
};
struct EpiResidF32 {
    static constexpr bool PERM = false, WIDE = false;
    const float* xin; float* xout; const float* gate;
    __device__ __forceinline__ void operator()(const f32x4 (&acc)[2][2][4][2], const Unit& u, int wr, int wc, int fr, int fq) const {
        const int row0 = u.pm * BM + wr * 64 + fr, col0 = u.pn * BM + wc * 32 + 4 * fq;
        const float* gp = gate + (size_t)((u.pm * BM) / SEQ) * 3072 + col0;
#pragma unroll
        for (int bj = 0; bj < 2; ++bj)
#pragma unroll
            for (int n = 0; n < 2; ++n) { const f32x4 g4 = *(const f32x4*)(gp + bj * HALF + n * 16);
#pragma unroll
                for (int ai = 0; ai < 2; ++ai)
#pragma unroll
                    for (int m = 0; m < 4; ++m) { const size_t off = (size_t)(row0 + ai * HALF + m * 16) * D + col0 + bj * HALF + n * 16;
                        const f32x4 x4 = *(const f32x4*)(xin + off); *(f32x4*)(xout + off) = x4 + g4 * acc[ai][bj][m][n]; } }
    }
};


__device__ __forceinline__ u32x4 xchg8(u32x4 v) { u32x4 r;
    r.x = (unsigned)__builtin_amdgcn_update_dpp(0, (int)v.x, 0x128, 0xf, 0xf, false); r.y = (unsigned)__builtin_amdgcn_update_dpp(0, (int)v.y, 0x128, 0xf, 0xf, false);
    r.z = (unsigned)__builtin_amdgcn_update_dpp(0, (int)v.z, 0x128, 0xf, 0xf, false); r.w = (unsigned)__builtin_amdgcn_update_dpp(0, (int)v.w, 0x128, 0xf, 0xf, false); return r; }
__device__ __forceinline__ u32x4 pack8(f32x4 v0, f32x4 v1) { u32x4 w; w.x = cvt_pk_bf16(v0[0], v0[1]); w.y = cvt_pk_bf16(v0[2], v0[3]); w.z = cvt_pk_bf16(v1[0], v1[1]); w.w = cvt_pk_bf16(v1[2], v1[3]); return w; }
__device__ __forceinline__ void store_wide(bf16_t* p, int ld, int fr, int fq, u32x4 pk0, u32x4 pk1) {
    const bool lo = fr < 8; const u32x4 rcv = xchg8(lo ? pk1 : pk0);
    bf16_t* q = p + (size_t)(fr & 7) * ld + 8 * fq + (lo ? 0 : 32);
    *(u32x4*)q = lo ? pk0 : rcv; *(u32x4*)(q + (size_t)8 * ld) = lo ? rcv : pk1;
}
struct EpiBf16W {
    static constexpr bool PERM = true, WIDE = true;
    bf16_t* O; int ldc; int nmod;
    __device__ __forceinline__ void operator()(const f32x4 (&acc)[2][2][4][2], const Unit& u, int wr, int wc, int fr, int fq) const {
        bf16_t* base = O + (size_t)(u.pm * BM + wr * 64) * ldc + (u.pn % nmod) * BM + wc * 64;
#pragma unroll
        for (int ai = 0; ai < 2; ++ai)
#pragma unroll
            for (int m = 0; m < 4; ++m) store_wide(base + (size_t)(ai * HALF + m * 16) * ldc, ldc, fr, fq, pack8(acc[ai][0][m][0], acc[ai][0][m][1]), pack8(acc[ai][1][m][0], acc[ai][1][m][1]));
    }
};
struct EpiResidNorm {
    static constexpr bool PERM = true, WIDE = true;
    const bf16_t* xin; bf16_t* x16; const float* gate; const float* av; bf16_t* xa; float* ssqp;
    __device__ __forceinline__ void operator()(const f32x4 (&acc)[2][2][4][2], const Unit& u, int wr, int wc, int fr, int fq) const {
        const int rowb = u.pm * BM + wr * 64, colw = u.pn * BM + wc * 64, b = (u.pm * BM) / SEQ;
        const bool lo = fr < 8;
        const size_t lane_off = (size_t)(fr & 7) * D + colw + 8 * fq + (lo ? 0 : 32);
        f32x4 gv[2][2], avv[2][2];
#pragma unroll
        for (int bj = 0; bj < 2; ++bj)
#pragma unroll
            for (int n = 0; n < 2; ++n) { gv[bj][n] = *(const f32x4*)(gate + (size_t)b * 3072 + colw + 32 * bj + 8 * fq + 4 * n); avv[bj][n] = *(const f32x4*)(av + (size_t)b * 1024 + colw + 32 * bj + 8 * fq + 4 * n); }
        u32x4 la[4][2], lb[4][2];
#define ERN_LOAD(k_) { _Pragma("unroll") for (int mm = 0; mm < 2; ++mm) { const bf16_t* q = xin + (size_t)(rowb + ((k_) >> 1) * HALF + (2 * ((k_) & 1) + mm) * 16) * D + lane_off; la[k_][mm] = *(const u32x4*)q; lb[k_][mm] = *(const u32x4*)(q + (size_t)8 * D); } }
        ERN_LOAD(0)
#pragma unroll
        for (int k = 0; k < 4; ++k) {
            const int ai = k >> 1;
            if (k == 0) ERN_LOAD(1) else if (k == 1) ERN_LOAD(2) else if (k == 2) ERN_LOAD(3)
            asm volatile("" ::: "memory");
#pragma unroll
            for (int mm = 0; mm < 2; ++mm) {
                const int m = 2 * (k & 1) + mm;
                const u32x4 rcv = xchg8(lo ? lb[k][mm] : la[k][mm]);
                const u32x4 xb0 = lo ? la[k][mm] : rcv, xb1 = lo ? rcv : lb[k][mm];
                f32x4 x00, x01, x10, x11;
                x00.x = __uint_as_float(xb0.x << 16); x00.y = __uint_as_float(xb0.x & 0xffff0000u); x00.z = __uint_as_float(xb0.y << 16); x00.w = __uint_as_float(xb0.y & 0xffff0000u);
                x01.x = __uint_as_float(xb0.z << 16); x01.y = __uint_as_float(xb0.z & 0xffff0000u); x01.z = __uint_as_float(xb0.w << 16); x01.w = __uint_as_float(xb0.w & 0xffff0000u);
                x10.x = __uint_as_float(xb1.x << 16); x10.y = __uint_as_float(xb1.x & 0xffff0000u); x10.z = __uint_as_float(xb1.y << 16); x10.w = __uint_as_float(xb1.y & 0xffff0000u);
                x11.x = __uint_as_float(xb1.z << 16); x11.y = __uint_as_float(xb1.z & 0xffff0000u); x11.z = __uint_as_float(xb1.w << 16); x11.w = __uint_as_float(xb1.w & 0xffff0000u);
                const f32x4 n00 = x00 + gv[0][0] * acc[ai][0][m][0], n01 = x01 + gv[0][1] * acc[ai][0][m][1], n10 = x10 + gv[1][0] * acc[ai][1][m][0], n11 = x11 + gv[1][1] * acc[ai][1][m][1];
                float sv = (((n00.x * n00.x + n00.y * n00.y) + (n00.z * n00.z + n00.w * n00.w)) + ((n01.x * n01.x + n01.y * n01.y) + (n01.z * n01.z + n01.w * n01.w)))
                         + (((n10.x * n10.x + n10.y * n10.y) + (n10.z * n10.z + n10.w * n10.w)) + ((n11.x * n11.x + n11.y * n11.y) + (n11.z * n11.z + n11.w * n11.w)));
                const size_t ro = (size_t)(rowb + ai * HALF + m * 16) * D + colw;
                store_wide(x16 + ro, D, fr, fq, pack8(n00, n01), pack8(n10, n11));
                store_wide(xa + ro, D, fr, fq, pack8(n00 * avv[0][0], n01 * avv[0][1]), pack8(n10 * avv[1][0], n11 * avv[1][1]));
                sv += __shfl_xor(sv, 16); sv += __shfl_xor(sv, 32);
                if (fq == 0) ssqp[(size_t)(rowb + ai * HALF + m * 16 + fr) * 16 + u.pn * 4 + wc] = sv;
            }
        }
#undef ERN_LOAD
    }
};
struct EpiProjNorm {
    static constexpr bool PERM = true, WIDE = true;
    bf16_t* O; const LAS float* RS; const float* cv; float* BG; const float* a_log; const float* dt_bias;
    __device__ __forceinline__ void operator()(const f32x4 (&acc)[2][2][4][2], const Unit& u, int wr, int wc, int fr, int fq) const {
        const int rl0 = wr * 64 + fr, colw = u.pn * BM + wc * 64, b = (u.pm * BM) / SEQ;
        const float* cp = cv + (size_t)b * NPW + colw + 8 * fq;
        if (u.pn < NP / BM) {
            f32x4 c4[2][2];
#pragma unroll
            for (int bj = 0; bj < 2; ++bj)
#pragma unroll
                for (int n = 0; n < 2; ++n) c4[bj][n] = *(const f32x4*)(cp + 32 * bj + 4 * n);
            bf16_t* base = O + (size_t)(u.pm * BM + wr * 64) * NP + colw;
#pragma unroll
            for (int ai = 0; ai < 2; ++ai)
#pragma unroll
                for (int m = 0; m < 4; ++m) { const float rs = fabsf(RS[u.ord * 256 + rl0 + ai * HALF + m * 16]);
                    store_wide(base + (size_t)(ai * HALF + m * 16) * NP, NP, fr, fq, pack8(acc[ai][0][m][0] * rs + c4[0][0], acc[ai][0][m][1] * rs + c4[0][1]), pack8(acc[ai][1][m][0] * rs + c4[1][0], acc[ai][1][m][1] * rs + c4[1][1])); }
        } else if (wc == 0 && fq == 0) {
            const f32x4 c0 = *(const f32x4*)(cp), c1 = *(const f32x4*)(cp + 4);
            const f32x4 al = *(const f32x4*)a_log, db = *(const f32x4*)dt_bias;
#pragma unroll
            for (int ai = 0; ai < 2; ++ai)
#pragma unroll
                for (int m = 0; m < 4; ++m) { const int rl = rl0 + ai * HALF + m * 16; const float rs = fabsf(RS[u.ord * 256 + rl]);
                    const f32x4 vb = acc[ai][0][m][0] * rs + c0, va = acc[ai][0][m][1] * rs + c1;
                    f32x4 be, gg;
#pragma unroll
                    for (int hh = 0; hh < 4; ++hh) { be[hh] = sigmoidf_(vb[hh]); gg[hh] = -__expf(al[hh]) * softplusf_(va[hh] + db[hh]); }
                    float* bg = BG + (size_t)(u.pm * BM + rl) * 8; *(f32x4*)bg = be; *(f32x4*)(bg + 4) = gg; }
        }
    }
};
struct EpiNull {
    static constexpr bool PERM = true, WIDE = false;
    __device__ __forceinline__ void operator()(const f32x4 (&acc)[2][2][4][2], const Unit& u, int wr, int wc, int fr, int fq) const {
#pragma unroll
        for (int ai = 0; ai < 2; ++ai)
#pragma unroll
            for (int bj = 0; bj < 2; ++bj)
#pragma unroll
                for (int m = 0; m < 4; ++m)
#pragma unroll
                    for (int n = 0; n < 2; ++n) asm volatile("" :: "v"(acc[ai][bj][m][n]));
    }
};
struct EpiSwiGLUNorm {
    static constexpr bool PERM = true, WIDE = false;
    bf16_t* O; int ldc; int nmod; const LAS float* RS; const float* cv; int ncv;
    __device__ __forceinline__ void operator()(const f32x4 (&acc)[2][2][4][2], const Unit& u, int wr, int wc, int fr, int fq) const {
        const int rl0 = wr * 64 + fr, col0 = (u.pn % nmod) * HALF + wc * 32 + 8 * fq;
        const float* cp = cv + (size_t)u.pn * BM + wc * 32 + 8 * fq;
        f32x4 cg[2][2], cu[2][2];
#pragma unroll
        for (int bb = 0; bb < 2; ++bb)
#pragma unroll
            for (int n = 0; n < 2; ++n) { cg[bb][n] = *(const f32x4*)(cp + (size_t)bb * ncv + 4 * n); cu[bb][n] = *(const f32x4*)(cp + (size_t)bb * ncv + HALF + 4 * n); }
#pragma unroll
        for (int ai = 0; ai < 2; ++ai)
#pragma unroll
            for (int m = 0; m < 4; ++m) { const int rl = rl0 + ai * HALF + m * 16; const float rsv = RS[u.ord * 256 + rl], rs = fabsf(rsv); const bool b1 = rsv < 0.f;
                const f32x4 g0 = acc[ai][0][m][0] * rs + (b1 ? cg[1][0] : cg[0][0]), g1 = acc[ai][0][m][1] * rs + (b1 ? cg[1][1] : cg[0][1]);
                const f32x4 u0 = acc[ai][1][m][0] * rs + (b1 ? cu[1][0] : cu[0][0]), u1 = acc[ai][1][m][1] * rs + (b1 ? cu[1][1] : cu[0][1]);
                u32x4 w;
                w.x = cvt_pk_bf16(fast_silu(g0[0]) * u0[0], fast_silu(g0[1]) * u0[1]); w.y = cvt_pk_bf16(fast_silu(g0[2]) * u0[2], fast_silu(g0[3]) * u0[3]);
                w.z = cvt_pk_bf16(fast_silu(g1[0]) * u1[0], fast_silu(g1[1]) * u1[1]); w.w = cvt_pk_bf16(fast_silu(g1[2]) * u1[2], fast_silu(g1[3]) * u1[3]);
                *(u32x4*)(O + (size_t)(u.pm * BM + rl) * ldc + col0) = w; }
    }
};

template <class Epi, class Sched, bool GATHER, bool ALIGN_EPI, bool SP2>
__device__ __forceinline__ void gemm_phase(LAS unsigned char* lds, const LAS int* RI, const Gemm g, const Sched& S, const Epi& E) {
    const int tid = threadIdx.x, wid = __builtin_amdgcn_readfirstlane(tid >> 6), lane = tid & 63, wr = wid >> 2, wc = wid & 3, fr = lane & 15, fq = lane >> 4;
    const int K = g.K, nt = K / BK;
    unsigned voffB[2]; int Ra[2]; unsigned Ca2[2];
#pragma unroll
    for (int i = 0; i < 2; ++i) { int R, C; stage_rc(tid * 16 + i * 8192, R, C); const int Rb = Epi::WIDE ? ((R >> 5) * 64 + perm32(R & 31)) : (Epi::PERM ? ((R & ~31) + perm32(R & 31)) : R);
        Ra[i] = R; Ca2[i] = (unsigned)C * 2u; voffB[i] = (unsigned)(Rb * K + C) * 2u; }
    const size_t kstep = (size_t)(BK * 2);
    const size_t hstep = (size_t)HALF * K * 2;
    const size_t tstep = 2 * hstep;
    const size_t hstepB = Epi::WIDE ? (size_t)32 * K * 2 : hstep;
    const unsigned rowb = (unsigned)K * 2u;
    const unsigned ldsw = (unsigned)wid * 1024u;
    const int aoff = lds_byte(wr * 64 + fr, fq * 8), boff = lds_byte(wc * 32 + fr, fq * 8);
#define PG8_SA(b, h) (((b) * 2 + (h)) * HTB)
#define PG8_SB(b, h) ((4 + (b) * 2 + (h)) * HTB)
#define PG8_STAGE_B(bufoff, gbase) do { _Pragma("unroll") for (int _i = 0; _i < 2; ++_i) \
        __builtin_amdgcn_global_load_lds((const unsigned*)((const char*)(gbase) + voffB[_i]), (LAS unsigned*)(lds + (bufoff) + ldsw + _i * 8192), 16, 0, 0); } while (0)
#define PG8_STAGE_A(bufoff, kb, off) do { _Pragma("unroll") for (int _i = 0; _i < 2; ++_i) \
        __builtin_amdgcn_global_load_lds((const unsigned*)((const char*)g.A + (size_t)(kb) + (off)[_i]), (LAS unsigned*)(lds + (bufoff) + ldsw + _i * 8192), 16, 0, 0); } while (0)
#define PG8_LDA(dst, b, h) do { _Pragma("unroll") for (int m = 0; m < 4; ++m) _Pragma("unroll") for (int k = 0; k < 2; ++k) dst[m][k] = *(const LAS bf16x8*)(lds + PG8_SA(b, h) + aoff + m * 2048 + k * 1024); } while (0)
#define PG8_LDB(dst, b, h) do { _Pragma("unroll") for (int n = 0; n < 2; ++n) _Pragma("unroll") for (int k = 0; k < 2; ++k) dst[n][k] = *(const LAS bf16x8*)(lds + PG8_SB(b, h) + boff + n * 2048 + k * 1024); } while (0)
#define PG8_MMA(ai, bj, At, Bt) do { __builtin_amdgcn_s_setprio(1); _Pragma("unroll") for (int m = 0; m < 4; ++m) _Pragma("unroll") for (int n = 0; n < 2; ++n) _Pragma("unroll") for (int k = 0; k < 2; ++k) \
        acc[ai][bj][m][n] = __builtin_amdgcn_mfma_f32_16x16x32_bf16(Bt[n][k], At[m][k], acc[ai][bj][m][n], 0, 0, 0); __builtin_amdgcn_s_setprio(0); } while (0)
#define PG8_WAIT_V(n) asm volatile("s_waitcnt vmcnt(" #n ")" ::: "memory")
#define PG8_WAIT_L(n) asm volatile("s_waitcnt lgkmcnt(" #n ")" ::: "memory")
#define PG8_BAR __builtin_amdgcn_s_barrier()
#define PG8_SCHED __builtin_amdgcn_sched_barrier(0)
#define PG8_AOFFS(dst, ui_, un_) do { _Pragma("unroll") for (int _h = 0; _h < 2; ++_h) _Pragma("unroll") for (int _i = 0; _i < 2; ++_i) { \
        const unsigned _row = GATHER ? (unsigned)RI[(ui_) * 256 + _h * HALF + Ra[_i]] : (unsigned)((un_).pm * BM + _h * HALF + Ra[_i]); dst[_h][_i] = _row * rowb + Ca2[_i]; } } while (0)
    Unit cur, nxt; int ui = 0;
    if (!S.next(0, cur)) return;
    cur.ord = 0;
    f32x4 acc[2][2][4][2];
#pragma unroll
    for (int a = 0; a < 2; ++a)
#pragma unroll
        for (int b = 0; b < 2; ++b)
#pragma unroll
            for (int m = 0; m < 4; ++m)
#pragma unroll
                for (int n = 0; n < 2; ++n) acc[a][b][m][n] = (f32x4){0.f, 0.f, 0.f, 0.f};
    bf16x8 At[4][2], B0[2][2], B1[2][2];
    unsigned cv[2][2], nv[2][2];
    PG8_AOFFS(cv, 0, cur);
    const char* cB = (const char*)g.Bt + (size_t)cur.pn * tstep;
    if constexpr (SP2) {
        PG8_STAGE_B(PG8_SB(0, 0), cB); PG8_STAGE_B(PG8_SB(0, 1), cB + hstepB); PG8_STAGE_A(PG8_SA(0, 0), 0, cv[0]); PG8_STAGE_A(PG8_SA(0, 1), 0, cv[1]);
        if (wr == 1) PG8_BAR;
        PG8_WAIT_V(2); PG8_BAR;
        PG8_STAGE_B(PG8_SB(1, 0), cB + kstep); PG8_STAGE_A(PG8_SA(1, 0), kstep, cv[0]); PG8_STAGE_B(PG8_SB(1, 1), cB + hstepB + kstep);
        PG8_WAIT_V(6); PG8_BAR;
    } else {
        PG8_STAGE_B(PG8_SB(0, 0), cB); PG8_STAGE_A(PG8_SA(0, 0), 0, cv[0]); PG8_STAGE_B(PG8_SB(0, 1), cB + hstepB); PG8_STAGE_A(PG8_SA(0, 1), 0, cv[1]);
        if (wr == 1) PG8_BAR;
        PG8_WAIT_V(4); PG8_BAR;
        PG8_STAGE_B(PG8_SB(1, 0), cB + kstep); PG8_STAGE_A(PG8_SA(1, 0), kstep, cv[0]); PG8_STAGE_B(PG8_SB(1, 1), cB + hstepB + kstep);
        PG8_WAIT_V(6); PG8_BAR;
    }
    for (;;) {
        const bool has_next = S.next(ui + 1, nxt); nxt.ord = ui + 1;
        const char* nB = has_next ? (const char*)g.Bt + (size_t)nxt.pn * tstep : cB;
        if (has_next) { PG8_AOFFS(nv, ui + 1, nxt); }
        else {
#pragma unroll
            for (int h = 0; h < 2; ++h)
#pragma unroll
                for (int i = 0; i < 2; ++i) nv[h][i] = cv[h][i]; }
        for (int t = 0; t < nt; t += 2) {
            const bool last = (t == nt - 2);
            const size_t kb1 = (size_t)(t + 1) * kstep, kb2 = last ? (size_t)0 : (size_t)(t + 2) * kstep, kb3 = kb2 + kstep;
            const char* b2 = last ? nB : cB + (size_t)(t + 2) * kstep; const char* b3 = b2 + kstep;
            unsigned o2[2][2];
#pragma unroll
            for (int h = 0; h < 2; ++h)
#pragma unroll
                for (int i = 0; i < 2; ++i) o2[h][i] = last ? nv[h][i] : cv[h][i];
            if constexpr (SP2) {
            PG8_LDB(B0, 0, 0); PG8_LDB(B1, 0, 1); PG8_SCHED; PG8_LDA(At, 0, 0); PG8_STAGE_A(PG8_SA(1, 1), kb1, cv[1]);
            PG8_WAIT_V(8); PG8_WAIT_L(0); PG8_BAR; PG8_MMA(0, 0, At, B0); PG8_MMA(0, 1, At, B1); PG8_BAR; PG8_SCHED;
            PG8_LDA(At, 0, 1); PG8_STAGE_B(PG8_SB(0, 0), b2); PG8_STAGE_B(PG8_SB(0, 1), b2 + hstepB); PG8_STAGE_A(PG8_SA(0, 0), kb2, o2[0]);
            PG8_WAIT_V(8); PG8_WAIT_L(0); PG8_BAR; PG8_MMA(1, 0, At, B0); PG8_MMA(1, 1, At, B1); PG8_BAR; PG8_SCHED;
            PG8_LDB(B0, 1, 0); PG8_LDB(B1, 1, 1); PG8_SCHED; PG8_LDA(At, 1, 0); PG8_STAGE_A(PG8_SA(0, 1), kb2, o2[1]);
            PG8_WAIT_V(8); PG8_WAIT_L(0); PG8_BAR; PG8_MMA(0, 0, At, B0); PG8_MMA(0, 1, At, B1); PG8_BAR; PG8_SCHED;
            PG8_LDA(At, 1, 1); PG8_STAGE_B(PG8_SB(1, 0), b3); PG8_STAGE_B(PG8_SB(1, 1), b3 + hstepB); PG8_STAGE_A(PG8_SA(1, 0), kb3, o2[0]);
            PG8_WAIT_V(8); PG8_WAIT_L(0); PG8_BAR; PG8_MMA(1, 0, At, B0); PG8_MMA(1, 1, At, B1); PG8_BAR; PG8_SCHED;
            } else {
            PG8_LDB(B0, 0, 0); PG8_SCHED; PG8_LDA(At, 0, 0); PG8_STAGE_A(PG8_SA(1, 1), kb1, cv[1]);
            PG8_WAIT_L(8); PG8_BAR; PG8_WAIT_L(0); PG8_MMA(0, 0, At, B0); PG8_BAR; PG8_SCHED;
            PG8_LDB(B1, 0, 1); PG8_STAGE_B(PG8_SB(0, 0), b2);
            PG8_BAR; PG8_WAIT_L(0); PG8_MMA(0, 1, At, B1); PG8_BAR;
            PG8_LDA(At, 0, 1); PG8_STAGE_A(PG8_SA(0, 0), kb2, o2[0]);
            PG8_BAR; PG8_WAIT_L(0); PG8_MMA(1, 0, At, B0); PG8_BAR; PG8_SCHED;
            PG8_STAGE_B(PG8_SB(0, 1), b2 + hstepB);
            PG8_WAIT_V(6); PG8_BAR; PG8_MMA(1, 1, At, B1); PG8_BAR;
            PG8_LDB(B0, 1, 0); PG8_SCHED; PG8_LDA(At, 1, 0); PG8_STAGE_A(PG8_SA(0, 1), kb2, o2[1]);
            PG8_WAIT_L(8); PG8_BAR; PG8_WAIT_L(0); PG8_MMA(0, 0, At, B0); PG8_BAR; PG8_SCHED;
            PG8_LDB(B1, 1, 1); PG8_STAGE_B(PG8_SB(1, 0), b3);
            PG8_BAR; PG8_WAIT_L(0); PG8_MMA(0, 1, At, B1); PG8_BAR;
            PG8_LDA(At, 1, 1); PG8_STAGE_A(PG8_SA(1, 0), kb3, o2[0]);
            PG8_BAR; PG8_WAIT_L(0); PG8_MMA(1, 0, At, B0); PG8_BAR; PG8_SCHED;
            PG8_STAGE_B(PG8_SB(1, 1), b3 + hstepB);
            PG8_WAIT_V(6); PG8_BAR; PG8_MMA(1, 1, At, B1); PG8_BAR;
            }
        }
        if constexpr (ALIGN_EPI) { if (wr == 0) PG8_BAR; }
        E(acc, cur, wr, wc, fr, fq);
        if (!has_next) break;
#pragma unroll
        for (int a = 0; a < 2; ++a)
#pragma unroll
            for (int b = 0; b < 2; ++b)
#pragma unroll
                for (int m = 0; m < 4; ++m)
#pragma unroll
                    for (int n = 0; n < 2; ++n) acc[a][b][m][n] = (f32x4){0.f, 0.f, 0.f, 0.f};
        cur = nxt; cB = nB; ++ui;
#pragma unroll
        for (int h = 0; h < 2; ++h)
#pragma unroll
            for (int i = 0; i < 2; ++i) cv[h][i] = nv[h][i];
        if constexpr (ALIGN_EPI) { if (wr == 1) PG8_BAR; }
    }
    PG8_WAIT_V(0);
    if constexpr (!ALIGN_EPI) { if (wr == 0) PG8_BAR; }
    PG8_BAR;
#undef PG8_SA
#undef PG8_SB
#undef PG8_STAGE_A
#undef PG8_STAGE_B
#undef PG8_LDA
#undef PG8_LDB
#undef PG8_MMA
#undef PG8_WAIT_V
#undef PG8_WAIT_L
#undef PG8_BAR
#undef PG8_SCHED
#undef PG8_AOFFS
}
}

__device__ __forceinline__ void transpose_item(const float* W, int pitch, int k0, int n0, bf16_t* WT, int Kd, int drow0, LAS float* scr, int lane) {
#pragma unroll 8
    for (int i = 0; i < 32; ++i) { const int kk = 2 * i + (lane >> 5); scr[kk * 33 + (lane & 31)] = W[(size_t)(k0 + kk) * pitch + n0 + (lane & 31)]; }
    asm volatile("s_waitcnt lgkmcnt(0)" ::: "memory");
    const int c = lane & 7;
#pragma unroll
    for (int j = 0; j < 4; ++j) { const int n = (lane >> 3) + 8 * j; const LAS float* s = scr + (8 * c) * 33 + n;
        u32x4 o; o.x = pk2(s[0 * 33], s[1 * 33]); o.y = pk2(s[2 * 33], s[3 * 33]); o.z = pk2(s[4 * 33], s[5 * 33]); o.w = pk2(s[6 * 33], s[7 * 33]);
        *(u32x4*)(WT + (size_t)(drow0 + n) * Kd + k0 + 8 * c) = o; }
    asm volatile("s_waitcnt lgkmcnt(0)" ::: "memory");
}
constexpr size_t WT_WIN = 0, WT_WOUT = WT_WIN + (size_t)2 * NPW * D, WT_FGU = WT_WOUT + (size_t)2 * D * D, WT_FD = WT_FGU + (size_t)2 * D_FF * D,
                 WT_MGU = WT_FD + (size_t)D * D_FF, WT_MD = WT_MGU + (size_t)NE * 2 * D_FFE * D, WT_END = WT_MD + (size_t)NE * D * D_FFE;
static_assert(WT_END * 2 <= 80 * MiB, "weight copies fit");
__device__ __forceinline__ void ph_pro_weights(const Args& a, Frame& F) {
    LAS float* scr = (LAS float*)(F.lds + F.wave * 16384);
    bf16_t* WT = (bf16_t*)(F.ws + WS_WT);
    constexpr int I_IN0 = 16 * 48, I_IN1 = 16 * 24, I_OUT = 16 * 32, I_FG = 16 * 88, I_FD = 44 * 32, I_M = 16 * 32;
    constexpr int NITEMS = 2 * (I_IN0 + I_IN1 + I_OUT) + 2 * I_FG + I_FD + 24 * I_M;
    for (int it = F.gw; it < NITEMS; it += F.ngw) {
        int r = it; const float* src; int pitch, k0, n0, Kd, drow0; bf16_t* dst;
        if (r < 2 * I_IN0) { const int l = r / I_IN0; r %= I_IN0; src = a.w_in + (size_t)l * D * N_IN; pitch = N_IN; k0 = (r / 48) * 64; n0 = (r % 48) * 32; dst = WT + WT_WIN + (size_t)l * NPW * D; Kd = D; drow0 = n0; }
        else if ((r -= 2 * I_IN0) < 2 * I_IN1) { const int l = r / I_IN1; r %= I_IN1; src = a.w_in + (size_t)l * D * N_IN + 1544; pitch = N_IN; k0 = (r / 24) * 64; n0 = (r % 24) * 32; dst = WT + WT_WIN + (size_t)l * NPW * D; Kd = D; drow0 = 1536 + n0; }
        else if ((r -= 2 * I_IN1) < 2 * I_OUT) { const int l = r / I_OUT; r %= I_OUT; src = a.w_out + (size_t)l * D * D; pitch = D; k0 = (r / 32) * 64; n0 = (r % 32) * 32; dst = WT + WT_WOUT + (size_t)l * D * D; Kd = D; drow0 = n0; }
        else if ((r -= 2 * I_OUT) < 2 * I_FG) { const int up = r / I_FG; r %= I_FG; src = up ? a.ffn_wu : a.ffn_wg; pitch = D_FF; k0 = (r / 88) * 64; n0 = (r % 88) * 32; dst = WT + WT_FGU; Kd = D; drow0 = (n0 / 128) * 256 + up * 128 + (n0 % 128); }
        else if ((r -= 2 * I_FG) < I_FD) { src = a.ffn_wd; pitch = D; k0 = (r / 32) * 64; n0 = (r % 32) * 32; dst = WT + WT_FD; Kd = D_FF; drow0 = n0; }
        else if ((r -= I_FD) < 16 * I_M) { const int e = r / (2 * I_M); r %= 2 * I_M; const int up = r / I_M; r %= I_M; src = (up ? a.moe_wu : a.moe_wg) + (size_t)e * D * D_FFE; pitch = D_FFE; k0 = (r / 32) * 64; n0 = (r % 32) * 32;
            dst = WT + WT_MGU + (size_t)e * 2 * D_FFE * D; Kd = D; drow0 = (n0 / 128) * 256 + up * 128 + (n0 % 128); }
        else { r -= 16 * I_M; const int e = r / I_M; r %= I_M; src = a.moe_wd + (size_t)e * D_FFE * D; pitch = D; k0 = (r / 32) * 64; n0 = (r % 32) * 32; dst = WT + WT_MD + (size_t)e * D * D_FFE; Kd = D_FFE; drow0 = n0; }
        transpose_item(src, pitch, k0, n0, dst, Kd, drow0, scr, F.lane);
    }
    for (int idx = F.bid * NTHREADS + F.tid; idx < 2 * 256 * D; idx += F.nb * NTHREADS) {
        const int l = idx / (256 * D), r = (idx / D) % 256, k = idx % D;
        WT[WT_WIN + (size_t)l * NPW * D + (size_t)(2304 + r) * D + k] = (r < 8) ? (bf16_t)f2bf(a.w_in[(size_t)l * D * N_IN + (size_t)k * N_IN + W_DB + r]) : (bf16_t)0;
    }
}

template <int NT> __device__ __forceinline__ void moe_order_init(Frame& F, pg8::MoeOrder<NT>& S) {
    const unsigned* c = (const unsigned*)(F.ws + WS_CTL) + CW_MOECNT;
    int acc = 0;
#pragma unroll
    for (int e = 0; e < 8; ++e) { S.cnt[e] = (int)__hip_atomic_load(c + 64 * e, __ATOMIC_RELAXED, __HIP_MEMORY_SCOPE_AGENT); S.bt[e] = acc; acc += (S.cnt[e] + 255) >> 8; }
    S.bt[8] = acc; S.G = F.nb; S.c = F.bid;
}
template <int NT> __device__ __forceinline__ int moe_ri_one(Frame& F, const pg8::MoeOrder<NT>& S, const int* RM, int o, int t) {
    pg8::Unit u; if (!S.next(o, u)) return -1;
    const int e = u.pn / NT; int bte = 0, cne = 0;
#pragma unroll
    for (int kk = 0; kk < 8; ++kk) { if (kk == e) { bte = S.bt[kk]; cne = S.cnt[kk]; } }
    const int sl = (u.pm - bte) * 256 + t; return (sl < cne) ? RM[(size_t)e * T + sl] : 0;
}
template <int NT> __device__ __forceinline__ void moe_ri_preload(Frame& F, const pg8::MoeOrder<NT>& S) {
    LAS int* RI = (LAS int*)(F.lds + RI_OFF); const int* RM = (const int*)(F.ws + WS_RMAP);
    const int t = F.tid & 255, par = F.tid >> 8;
    const int v0 = moe_ri_one<NT>(F, S, RM, par, t), v1 = moe_ri_one<NT>(F, S, RM, par + 2, t), v2 = moe_ri_one<NT>(F, S, RM, par + 4, t), v3 = moe_ri_one<NT>(F, S, RM, par + 6, t);
    const int v4 = moe_ri_one<NT>(F, S, RM, par + 8, t), v5 = moe_ri_one<NT>(F, S, RM, par + 10, t), v6 = moe_ri_one<NT>(F, S, RM, par + 12, t), v7 = moe_ri_one<NT>(F, S, RM, par + 14, t);
    if (v0 >= 0) RI[(par) * 256 + t] = v0; if (v1 >= 0) RI[(par + 2) * 256 + t] = v1; if (v2 >= 0) RI[(par + 4) * 256 + t] = v2; if (v3 >= 0) RI[(par + 6) * 256 + t] = v3;
    if (v4 >= 0) RI[(par + 8) * 256 + t] = v4; if (v5 >= 0) RI[(par + 10) * 256 + t] = v5; if (v6 >= 0) RI[(par + 12) * 256 + t] = v6;
    if (v7 >= 0 && par + 14 < 15) RI[(par + 14) * 256 + t] = v7;
    __syncthreads();
}

__device__ __forceinline__ void ph_norm0(const Args& a, Frame& F) {
    const float* MOD = (const float*)(F.ws + WS_MOD);
    bf16_t* XA = (bf16_t*)(F.ws + WS_H); bf16_t* X16 = (bf16_t*)(F.ws + WS_X16); float* SSQ = (float*)(F.ws + WS_SSQ) + (size_t)3 * T * 16;
    f32x4 vn[4], A4[4]; int cur_b = -1;
#define N0_LOAD(row_) { const f32x4* p_ = (const f32x4*)(a.x + (size_t)(row_) * D) + 2 * F.lane; vn[0] = p_[0]; vn[1] = p_[1]; vn[2] = p_[128]; vn[3] = p_[129]; }
    if (F.gw < T) N0_LOAD(F.gw)
    for (int row = F.gw; row < T; row += F.ngw) {
        const int b = row / SEQ;
        f32x4 v[4]; float ss = 0.f;
#pragma unroll
        for (int j = 0; j < 4; ++j) { v[j] = vn[j]; ss += (v[j].x * v[j].x + v[j].y * v[j].y) + (v[j].z * v[j].z + v[j].w * v[j].w); }
        if (row + F.ngw < T) N0_LOAD(row + F.ngw)
        if (b != cur_b) { cur_b = b;
#pragma unroll
            for (int j = 0; j < 4; ++j) { const int d = 512 * (j >> 1) + 8 * F.lane + 4 * (j & 1); A4[j] = *(const f32x4*)(a.nmg + d) * (*(const f32x4*)(MOD + (size_t)b * 3072 + 1024 + d) + 1.0f); } }
#pragma unroll
        for (int jj = 0; jj < 2; ++jj) {
            const int d = 512 * jj + 8 * F.lane; const f32x4 v0 = v[2 * jj], v1 = v[2 * jj + 1], s0 = v0 * A4[2 * jj], s1 = v1 * A4[2 * jj + 1];
            u32x4 o; o.x = pk2(v0.x, v0.y); o.y = pk2(v0.z, v0.w); o.z = pk2(v1.x, v1.y); o.w = pk2(v1.z, v1.w); *(u32x4*)(X16 + (size_t)row * D + d) = o;
            u32x4 p; p.x = pk2(s0.x, s0.y); p.y = pk2(s0.z, s0.w); p.z = pk2(s1.x, s1.y); p.w = pk2(s1.z, s1.w); *(u32x4*)(XA + (size_t)row * D + d) = p;
        }
        ss = wave_sum(ss);
        if (F.lane < 16) SSQ[(size_t)row * 16 + F.lane] = (F.lane == 0) ? ss : 0.f;
    }
#undef N0_LOAD
}
__device__ __forceinline__ void ph_prep_vectors(const Args& a, Frame& F) {
    const float* MOD = (const float*)(F.ws + WS_MOD); float* AV = (float*)(F.ws + WS_AV);
    for (int idx = F.bid * NTHREADS + F.tid; idx < 3 * BATCH * D; idx += F.nb * NTHREADS) {
        const int inst = idx / (BATCH * D), b = (idx / D) % BATCH, d = idx % D;
        const int lk = (inst == 0) ? 1 : (inst == 1 ? 2 : 3);
        const float gn = (inst == 0) ? a.nfg[d] : (inst == 1 ? a.nmg[D + d] : a.nfg[D + d]);
        AV[idx] = gn * (1.0f + MOD[((size_t)lk * 2 + b) * 3072 + 1024 + d]);
    }
    const bf16_t* WT = (const bf16_t*)(F.ws + WS_WT);
    constexpr int NR = 5632 + NPW + 16384 + NPW;
    LAS float* SH = (LAS float*)F.lds;
    for (int i = F.tid; i < 4 * BATCH * D; i += NTHREADS) { const int which = i / (BATCH * D), b = (i / D) % BATCH, d = i % D; SH[i] = MOD[((size_t)((which + 1) & 3) * 2 + b) * 3072 + d]; }
    __syncthreads();
    for (int g8 = F.gw; g8 < NR / 8; g8 += F.ngw) {
        const int row = g8 * 8 + (F.lane >> 3), part = F.lane & 7;
        int which, r; const bf16_t* wrow; float* out; int ncv;
        if (row < 5632) { which = 0; r = row; wrow = WT + WT_FGU + (size_t)r * D; out = (float*)(F.ws + WS_CVF); ncv = 5632; }
        else if (row < 5632 + NPW) { which = 1; r = row - 5632; wrow = WT + WT_WIN + (size_t)NPW * D + (size_t)r * D; out = (float*)(F.ws + WS_CVI); ncv = NPW; }
        else if (row < 5632 + NPW + 16384) { which = 2; r = row - 5632 - NPW; wrow = WT + WT_MGU + (size_t)r * D; out = (float*)(F.ws + WS_CVM); ncv = 16384; }
        else { which = 3; r = row - 5632 - NPW - 16384; wrow = WT + WT_WIN + (size_t)r * D; out = (float*)(F.ws + WS_CVI0); ncv = NPW; }
        u32x4 wv[16];
#pragma unroll
        for (int j = 0; j < 16; ++j) wv[j] = *(const u32x4*)(wrow + 128 * part + 8 * j);
        const LAS float* s0p = SH + (which * 2 + 0) * 1024 + 128 * part; const LAS float* s1p = s0p + 1024;
        float s0 = 0.f, s1 = 0.f;
#pragma unroll
        for (int j = 0; j < 16; ++j) {
            const f32x4 a0 = *(const LAS f32x4*)(s0p + 8 * j), a1 = *(const LAS f32x4*)(s0p + 8 * j + 4), b0 = *(const LAS f32x4*)(s1p + 8 * j), b1 = *(const LAS f32x4*)(s1p + 8 * j + 4);
            const float x0 = bf2f(wv[j].x & 0xffffu), x1 = bf2f(wv[j].x >> 16), x2 = bf2f(wv[j].y & 0xffffu), x3 = bf2f(wv[j].y >> 16), x4 = bf2f(wv[j].z & 0xffffu), x5 = bf2f(wv[j].z >> 16), x6 = bf2f(wv[j].w & 0xffffu), x7 = bf2f(wv[j].w >> 16);
            s0 += ((x0 * a0.x + x1 * a0.y) + (x2 * a0.z + x3 * a0.w)) + ((x4 * a1.x + x5 * a1.y) + (x6 * a1.z + x7 * a1.w));
            s1 += ((x0 * b0.x + x1 * b0.y) + (x2 * b0.z + x3 * b0.w)) + ((x4 * b1.x + x5 * b1.y) + (x6 * b1.z + x7 * b1.w));
        }
        s0 += __shfl_xor(s0, 1); s0 += __shfl_xor(s0, 2); s0 += __shfl_xor(s0, 4);
        s1 += __shfl_xor(s1, 1); s1 += __shfl_xor(s1, 2); s1 += __shfl_xor(s1, 4);
        if (part == 0) { out[r] = s0; out[ncv + r] = s1; }
    }
    __syncthreads();
    if (F.gw < BATCH * 8) {
        const int b = F.gw >> 3, e = F.gw & 7; float sacc = 0.f;
        for (int d = F.lane; d < D; d += 64) sacc += MOD[((size_t)3 * 2 + b) * 3072 + d] * a.router_w[(size_t)d * NE + e];
        sacc = wave_sum(sacc);
        if (F.lane == 0) ((float*)(F.ws + WS_CR))[b * 8 + e] = sacc;
    }
}
template <class Sched> __device__ __forceinline__ int count_units(const Sched& S) { int n = 0; pg8::Unit u; while (n < 16 && S.next(n, u)) ++n; return n; }
template <class Sched> __device__ __forceinline__ void rstd_preload(Frame& F, const Sched& S, const float* ssqp, const LAS int* RI) {
    LAS float* RS = (LAS float*)(F.lds + RS_OFF);
    const int t = F.tid & 255, par = F.tid >> 8, nu = count_units(S);
#pragma unroll
    for (int k0 = 0; k0 < 8; k0 += 4) {
        f32x4 p0[4], p1[4], p2[4], p3[4]; int r0, r1, r2, r3;
#define RSP_LOAD(k, pk, rk) { const int o = par + 2 * (k0 + k); pg8::Unit u; u.pm = 0; rk = 0; if (o < nu) { S.next(o, u); rk = RI ? RI[o * 256 + t] : u.pm * 256 + t; } \
            const f32x4* q = (const f32x4*)(ssqp + (size_t)rk * 16); pk[0] = q[0]; pk[1] = q[1]; pk[2] = q[2]; pk[3] = q[3]; }
        RSP_LOAD(0, p0, r0) RSP_LOAD(1, p1, r1) RSP_LOAD(2, p2, r2) RSP_LOAD(3, p3, r3)
#undef RSP_LOAD
#define RSP_STORE(k, pk, rk) { const int o = par + 2 * (k0 + k); if (o < nu) { const f32x4 s4 = (pk[0] + pk[1]) + (pk[2] + pk[3]); \
            const float rs = rsqrtf(((s4.x + s4.y) + (s4.z + s4.w)) * (1.0f / D) + EPS); RS[o * 256 + t] = (rk >= SEQ) ? -rs : rs; } }
        RSP_STORE(0, p0, r0) RSP_STORE(1, p1, r1) RSP_STORE(2, p2, r2) RSP_STORE(3, p3, r3)
#undef RSP_STORE
    }
    __syncthreads();
}
__device__ __forceinline__ void ph_router(const Args& a, Frame& F) {
    const bf16_t* XA = (const bf16_t*)(F.ws + WS_H); const float* SSQ = (const float*)(F.ws + WS_SSQ) + (size_t)2 * T * 16; const float* CR = (const float*)(F.ws + WS_CR);
    LAS float* W8T = (LAS float*)F.lds;
    for (int i = F.tid; i < 8192; i += NTHREADS) { const int d = i >> 3, j = i & 7; W8T[j * 1024 + d] = a.router_w[i]; }
    __syncthreads();
    for (int row = F.gw; row < T; row += F.ngw) {
        const int b = row / SEQ;
        float acc[8];
#pragma unroll
        for (int e = 0; e < 8; ++e) acc[e] = 0.f;
#pragma unroll
        for (int jj = 0; jj < 2; ++jj) {
            const int d = 512 * jj + 8 * F.lane;
            const u32x4 xv = *(const u32x4*)(XA + (size_t)row * D + d);
            const float x[8] = {bf2f(xv.x & 0xffffu), bf2f(xv.x >> 16), bf2f(xv.y & 0xffffu), bf2f(xv.y >> 16), bf2f(xv.z & 0xffffu), bf2f(xv.z >> 16), bf2f(xv.w & 0xffffu), bf2f(xv.w >> 16)};
#pragma unroll
            for (int e = 0; e < 8; ++e) { const f32x4 wa = *(const LAS f32x4*)(W8T + e * 1024 + d), wb = *(const LAS f32x4*)(W8T + e * 1024 + d + 4);
                acc[e] += ((x[0] * wa.x + x[1] * wa.y) + (x[2] * wa.z + x[3] * wa.w)) + ((x[4] * wb.x + x[5] * wb.y) + (x[6] * wb.z + x[7] * wb.w)); }
        }
        const float ssq = wave_sum(F.lane < 16 ? SSQ[(size_t)row * 16 + F.lane] : 0.f);
        const float rstd = rsqrtf(ssq * (1.0f / D) + EPS);
#pragma unroll
        for (int e = 0; e < 8; ++e) acc[e] = wave_sum(acc[e]);
        if (F.lane == 0) {
            float v0 = -INFINITY, v1 = -INFINITY; int e0 = 0, e1 = 0;
#pragma unroll
            for (int e = 0; e < 8; ++e) { const float lg = rstd * acc[e] + CR[b * 8 + e] + a.router_b[e]; if (lg > v0) { v1 = v0; e1 = e0; v0 = lg; e0 = e; } else if (lg > v1) { v1 = lg; e1 = e; } }
            const float ex = __expf(v1 - v0), p0 = 1.0f / (1.0f + ex), p1 = ex / (1.0f + ex);
            unsigned* cnt = (unsigned*)(F.ws + WS_CTL) + CW_MOECNT;
            const int q0 = (int)atomicAdd(cnt + 64 * e0, 1u), q1 = (int)atomicAdd(cnt + 64 * e1, 1u);
            int* R = (int*)(F.ws + WS_ROUTE) + (size_t)row * 4; R[0] = e0; R[1] = e1; ((float*)R)[2] = p0; ((float*)R)[3] = p1;
            int* Pq = (int*)(F.ws + WS_POS) + (size_t)row * 2; Pq[0] = q0; Pq[1] = q1;
            int* RM = (int*)(F.ws + WS_RMAP); RM[(size_t)e0 * T + q0] = row; RM[(size_t)e1 * T + q1] = row;
        }
    }
    __syncthreads();
}

__global__ void __launch_bounds__(NTHREADS, 2) fwd(Args a) {
    extern __shared__ __attribute__((aligned(16))) unsigned char lds_raw[];
    Frame F;
    F.lds = (LAS unsigned char*)lds_raw;
    F.tid = threadIdx.x; F.lane = F.tid & 63; F.wave = __builtin_amdgcn_readfirstlane(F.tid >> 6);
    F.bid = blockIdx.x; F.nb = gridDim.x; F.gw = F.bid * NWAVES + F.wave; F.ngw = F.nb * NWAVES; F.ws = (GAS unsigned char*)a.ws;
    volatile LAS unsigned* MISC = (volatile LAS unsigned*)(F.lds + MISC_OFF);
    for (int u = F.tid; u < 32; u += NTHREADS) MISC[u] = 0u;
    __syncthreads();
    unsigned* ctl = (unsigned*)(a.ws + WS_CTL);
    const int lo = a.ph_lo, hi = a.ph_hi;
    const bool multi = (hi - lo) > 1;
    XcdBarrier bar; bar.bar = ctl + CW_BAR; bar.x = 0; bar.st = MISC + 8;
    if (multi) bar = xcd_barrier_post(ctl + CW_BAR, MISC + 8);
#define IN(k) (lo <= (k) && (k) < hi && (frame_refresh(F, a, (LAS unsigned char*)lds_raw), true))
#define SEAM(k) do { if (hi > (k) + 1 && lo <= (k)) { xcd_barrier(bar); if constexpr ((PROBE_MASK & 4194304) != 0) xcd_barrier(bar); } } while (0)
    float* MOD = (float*)(a.ws + WS_MOD);
    bf16_t* H = (bf16_t*)(a.ws + WS_H); bf16_t* PROJ = (bf16_t*)(a.ws + WS_PROJ); bf16_t* YMIX = (bf16_t*)(a.ws + WS_YMIX);
    bf16_t* WT = (bf16_t*)(a.ws + WS_WT);
    bf16_t* ACT = (bf16_t*)(a.ws + WS_ACT); bf16_t* ACTM = (bf16_t*)(a.ws + WS_ACTM); bf16_t* YMOE = (bf16_t*)(a.ws + WS_YMOE);

    if (IN(PH_PRO)) { REP(1) { ph_pro_vectors(a, F); ph_pro_weights(a, F); } SEAM(PH_PRO); }

#define TWICE(bit, stmt) do { stmt; if constexpr ((PROBE_MASK & (bit)) != 0) { stmt; } } while (0)
    float* AV = (float*)(a.ws + WS_AV); float* SSQ = (float*)(a.ws + WS_SSQ); bf16_t* X16 = (bf16_t*)(a.ws + WS_X16);
    const LAS float* RSL = (const LAS float*)(F.lds + RS_OFF);
#define LAYER_BODY(l) {\
        const int pb = PH_LAYER0 + PH_PER_LAYER * l; \
        const float* xin = (l == 0) ? a.x : a.out; \
        const float* mod0 = MOD + (size_t)(l * 2 + 0) * 2 * 3072; const float* mod1 = MOD + (size_t)(l * 2 + 1) * 2 * 3072; \
        if (l == 0) { if (IN(pb + K_NORM1)) { REP(2) ph_norm0(a, F); ph_prep_vectors(a, F); SEAM(pb + K_NORM1); } } \
        if (IN(pb + K_GEMM_IN)) { \
            TWICE(4, ({ pg8::Gemm g{H, WT + WT_WIN + (size_t)l * NPW * D, D}; pg8::StaticOrder S; S.init(T, NPW, F.nb, F.bid); rstd_preload(F, S, SSQ + (size_t)(l == 0 ? 3 : 1) * T * 16, nullptr); \
                pg8::EpiProjNorm E{PROJ, RSL, (const float*)(a.ws + (l == 0 ? WS_CVI0 : WS_CVI)), (float*)(a.ws + WS_BG), a.dn_a_log + 4 * l, a.dn_dt_bias + 4 * l}; \
                pg8::gemm_phase<pg8::EpiProjNorm, pg8::StaticOrder, false, true, true>(F.lds, nullptr, g, S, E); })); \
            SEAM(pb + K_GEMM_IN); \
        } \
        if (IN(pb + K_DN_PREP)) { REP(8) ph_dn_chunk(a, F, l); ph_rope(a, F); SEAM(pb + K_DN_PREP); } \
        if (IN(pb + K_MIX)) { REP(16) ph_dn_scan(a, F); REP(512) ph_attn_mfma(a, F, l); REP(1024) ph_conv_fast(a, F, l); SEAM(pb + K_MIX); } \
        if (IN(pb + K_DN_OUT)) { REP(32) ph_dn_out(a, F, l); SEAM(pb + K_DN_OUT); } \
        if (IN(pb + K_GEMM_OUT)) { \
            TWICE(0, ({ pg8::Gemm g{YMIX, WT + WT_WOUT + (size_t)l * D * D, D}; pg8::StaticOrder S; S.init(T, D, F.nb, F.bid); \
                pg8::EpiResidNorm E{X16, X16, mod0 + 2048, AV + (size_t)(l == 0 ? 0 : 2) * BATCH * D, H, SSQ + (size_t)(l == 0 ? 0 : 2) * T * 16}; \
                pg8::gemm_phase<pg8::EpiResidNorm, pg8::StaticOrder, false, true, true>(F.lds, nullptr, g, S, E); })); \
            if constexpr ((PROBE_MASK & 8388608) != 0 && l == 0) { pg8::Gemm g{YMIX, WT + WT_WOUT + (size_t)l * D * D, D}; pg8::StaticOrder S; S.init(T, D, F.nb, F.bid); pg8::EpiBf16 E{(bf16_t*)(a.ws + WS_DN_MR), D, 1 << 20}; \
                pg8::gemm_phase<pg8::EpiBf16, pg8::StaticOrder, false, true, true>(F.lds, nullptr, g, S, E); } \
            if constexpr ((PROBE_MASK & 16777216) != 0 && l == 0) { pg8::Gemm g{YMIX, WT + WT_WOUT + (size_t)l * D * D, D}; pg8::StaticOrder S; S.init(T, D, F.nb, F.bid); \
                pg8::EpiResidNorm E{X16, (bf16_t*)(a.ws + WS_DN_MR), mod0 + 2048, AV, (bf16_t*)(a.ws + WS_DN_MR), (float*)(a.ws + WS_DN_ST)}; \
                pg8::gemm_phase<pg8::EpiResidNorm, pg8::StaticOrder, false, true, true>(F.lds, nullptr, g, S, E); } \
            if constexpr ((PROBE_MASK & 131072) != 0 && l == 0) { pg8::Gemm g{YMIX, WT + WT_WOUT + (size_t)l * D * D, D}; pg8::StaticOrder S; S.init(T, D, F.nb, F.bid); pg8::EpiNull E{}; \
                pg8::gemm_phase<pg8::EpiNull, pg8::StaticOrder, false, true, true>(F.lds, nullptr, g, S, E); } \
            SEAM(pb + K_GEMM_OUT); \
        } \
        if (l == 0) { \
            if (IN(pb + K_FFN1)) { \
                TWICE(256, ({ pg8::Gemm g{H, WT + WT_FGU, D}; pg8::StaticOrder S; S.init(T, 2 * D_FF, F.nb, F.bid); rstd_preload(F, S, SSQ, nullptr); \
                    pg8::EpiSwiGLUNorm E{ACT, D_FF, 1 << 20, RSL, (const float*)(a.ws + WS_CVF), 5632}; \
                    pg8::gemm_phase<pg8::EpiSwiGLUNorm, pg8::StaticOrder, false, true, true>(F.lds, nullptr, g, S, E); })); \
                SEAM(pb + K_FFN1); \
            } \
            if (IN(pb + K_FFN2)) { \
                { pg8::Gemm g{ACT, WT + WT_FD, D_FF}; pg8::StaticOrder S; S.init(T, D, F.nb, F.bid); \
                    pg8::EpiResidNorm E{X16, X16, mod1 + 2048, AV + (size_t)1 * BATCH * D, H, SSQ + (size_t)1 * T * 16}; \
                    pg8::gemm_phase<pg8::EpiResidNorm, pg8::StaticOrder, false, true, true>(F.lds, nullptr, g, S, E); } \
                SEAM(pb + K_FFN2); \
            } \
        } else { \
            if (IN(pb + K_NORM2)) { ph_router(a, F); SEAM(pb + K_NORM2); } \
            if (IN(pb + K_FFN1)) { \
                TWICE(2048, ({ pg8::MoeOrder<8> S; moe_order_init<8>(F, S); moe_ri_preload<8>(F, S); rstd_preload(F, S, SSQ + (size_t)2 * T * 16, (const LAS int*)(F.lds + RI_OFF)); \
                    pg8::Gemm g{H, WT + WT_MGU, D}; pg8::EpiSwiGLUNorm E{ACTM, D_FFE, 8, RSL, (const float*)(a.ws + WS_CVM), 16384}; \
                    pg8::gemm_phase<pg8::EpiSwiGLUNorm, pg8::MoeOrder<8>, true, true, true>(F.lds, (const LAS int*)(F.lds + RI_OFF), g, S, E); })); \
                SEAM(pb + K_FFN1); \
            } \
            if (IN(pb + K_FFN2)) { \
                TWICE(4096, ({ pg8::MoeOrder<4> S; moe_order_init<4>(F, S); \
                    pg8::Gemm g{ACTM, WT + WT_MD, D_FFE}; pg8::EpiBf16W E{YMOE, D, 4}; \
                    pg8::gemm_phase<pg8::EpiBf16W, pg8::MoeOrder<4>, false, true, true>(F.lds, nullptr, g, S, E); })); \
                SEAM(pb + K_FFN2); \
            } \
        } \
    }
    LAYER_BODY(0)
    LAYER_BODY(1)
#undef LAYER_BODY
    if (IN(PH_FINAL)) { ph_final(a, F); }
#undef IN
#undef SEAM
}

extern "C" void kernel_launch(void* const* d_in, const int* in_sizes, int n_in, void* d_out, int out_size, void* d_ws, size_t ws_size, hipStream_t stream) {
    static int grid = 0;
    if (grid == 0) {
        if (n_in != 27 || out_size != T * D || ws_size < WS_END) { fprintf(stderr, "kernel_launch: unexpected shapes n_in %d out %d ws %zu\n", n_in, out_size, ws_size); grid = -1; return; }
        int dev = 0, cus = 0, per_cu = 0;
        if (hipGetDevice(&dev) != hipSuccess || hipDeviceGetAttribute(&cus, hipDeviceAttributeMultiprocessorCount, dev) != hipSuccess) { grid = -1; return; }
        if (hipFuncSetAttribute((const void*)fwd, hipFuncAttributeMaxDynamicSharedMemorySize, LDS_BYTES) != hipSuccess) { fprintf(stderr, "kernel_launch: hipFuncSetAttribute failed\n"); grid = -1; return; }
        if (hipOccupancyMaxActiveBlocksPerMultiprocessor(&per_cu, (const void*)fwd, NTHREADS, LDS_BYTES) != hipSuccess || per_cu < 1) fprintf(stderr, "kernel_launch: occupancy query says %d\n", per_cu);
        (void)hipGetLastError();
        grid = cus;
    }
    if (grid < 0) return;
    (void)hipMemsetAsync((char*)d_ws + WS_CTL, 0, CTL_ZERO_BYTES, stream);
    Args a{};
    const void** pp = (const void**)&a;
    for (int i = 0; i < 27; ++i) pp[i] = d_in[i];
    a.out = (float*)d_out; a.ws = (unsigned char*)d_ws;
#if MK_ONE_LAUNCH
    a.ph_lo = 0; a.ph_hi = NPH;
    hipLaunchKernelGGL(fwd, dim3(grid), dim3(NTHREADS), LDS_BYTES, stream, a);
#else
    static const int phases[] = {0, 1, 2, 3, 4, 5, 6, 7, 9, 10, 11, 12, 13, 14, 15, 16, 17, 18, 19, 20, 21};
    for (int p : phases) { a.ph_lo = p; a.ph_hi = p + 1; hipLaunchKernelGGL(fwd, dim3(grid), dim3(NTHREADS), LDS_BYTES, stream, a); }
#endif
}
```

```cpp
#include <hip/hip_runtime.h>
#include <cstdio>
#include <cstdint>

#define LAS __attribute__((address_space(3)))
#define GAS __attribute__((address_space(1)))
typedef unsigned short bf16_t;
typedef float f32x4 __attribute__((ext_vector_type(4)));
typedef unsigned u32x2 __attribute__((ext_vector_type(2)));
typedef unsigned u32x4 __attribute__((ext_vector_type(4)));

#ifndef GEMM_MASK
#define GEMM_MASK 63
#endif
#ifndef ATTN_MFMA
#define ATTN_MFMA 1
#endif
#ifndef DN_CHUNKED
#define DN_CHUNKED 1
#endif
#ifndef CONV_FAST
#define CONV_FAST 1
#endif
#ifndef PROBE_MASK
#define PROBE_MASK 0
#endif
#define REP(bit) for (int rep_ = 0; rep_ < ((PROBE_MASK & (bit)) ? 2 : 1); ++rep_)
#ifndef MK_ONE_LAUNCH
#define MK_ONE_LAUNCH 1
#endif

constexpr int BATCH = 2, SEQ = 16384, T = BATCH * SEQ, D = 1024, DEPTH = 2;
constexpr int NPW = 2560;
constexpr int N_IN = 2312, NP = 2304;
constexpr int C_AQ = 0, C_AK = 512, C_AV = 640, C_DQ = 768, C_DK = 1024, C_DV = 1280, C_DZ = 1536, C_CA = 1792, C_CB = 2048;
constexpr int W_DB = 1536;
constexpr int D_FF = 2816, NE = 8, D_FFE = 1024;
constexpr int WINDOW = 128, CV_K = 31, CV_C = 256, DN_CONV = 4;
constexpr float EPS = 1e-6f;
constexpr int NSCAN = BATCH * 4 * 4;
constexpr int MOE_CAP = 67584;

constexpr size_t MiB = 1u << 20;
constexpr size_t WS_CTL = 0, CTL_ZERO_BYTES = 1 * MiB;
constexpr size_t WS_MOD = 1 * MiB;
constexpr size_t WS_CS = 2 * MiB;
constexpr size_t WS_BG = 4 * MiB;
constexpr size_t WS_ROUTE = 5 * MiB;
constexpr size_t WS_POS = 6 * MiB;
constexpr size_t WS_RMAP = 7 * MiB;
constexpr size_t WS_WT = 8 * MiB;
constexpr size_t WS_H = 88 * MiB;
constexpr size_t WS_PROJ = 152 * MiB;
constexpr size_t WS_YMIX = 296 * MiB;
constexpr size_t WS_DNQKV = 360 * MiB;
constexpr size_t WS_ODN = 456 * MiB;
constexpr size_t WS_ACT = 152 * MiB;
constexpr size_t WS_ACTM = 152 * MiB;
constexpr size_t WS_YMOE = 284 * MiB;
constexpr size_t WS_X16 = 440 * MiB;
constexpr size_t WS_SSQ = 504 * MiB;
constexpr size_t WS_AV = WS_MOD + 128 * 1024;
constexpr size_t WS_CVF = WS_MOD + 256 * 1024;
constexpr size_t WS_CVI = WS_CVF + 2 * 5632 * 4;
constexpr size_t WS_CVM = WS_CVI + 2 * 2560 * 4;
constexpr size_t WS_CR = WS_CVM + 2 * 16384 * 4;
constexpr size_t WS_CVI0 = WS_CR + 64;
static_assert(WS_CVI0 + 2 * 2560 * 4 <= WS_CS, "vector area");
constexpr size_t WS_END = 512 * MiB;
constexpr int CW_BAR = 4096;
constexpr int CW_MOECNT = 16384;

constexpr int NWAVES = 8, NTHREADS = 512;
constexpr int LDS_BYTES = 163840;
constexpr int MISC_OFF = 131072 + 320;
constexpr int RI_OFF = 132096;
constexpr int RS_OFF = 147456;

constexpr int PH_PRO = 0, PH_LAYER0 = 1, PH_PER_LAYER = 10, PH_FINAL = 21, NPH = 22;
enum { K_NORM1 = 0, K_GEMM_IN, K_DN_PREP, K_MIX, K_DN_OUT, K_GEMM_OUT, K_NORM2, K_MOE_LIST, K_FFN1, K_FFN2 };

struct Args {
    const float* x; const float* c; const int* pos; const float* ada_w; const float* ada_b; const float* nmg; const float* nfg;
    const float* w_in; const float* sinks; const float* dn_conv_w; const float* dn_a_log; const float* dn_dt_bias; const float* dn_norm_g;
    const float* cv_dw_w; const float* cv_dw_b; const float* cv_ln_g; const float* cv_ln_b; const float* w_out;
    const float* ffn_wg; const float* ffn_wu; const float* ffn_wd; const float* router_w; const float* router_b;
    const float* moe_wg; const float* moe_wu; const float* moe_wd; const float* final_g;
    float* out; unsigned char* ws; int ph_lo, ph_hi;
};

__device__ __forceinline__ float bf2f(unsigned u) { return __uint_as_float(u << 16); }
__device__ __forceinline__ unsigned f2bf(float f) { unsigned u = __float_as_uint(f); return (u + 0x7fffu + ((u >> 16) & 1u)) >> 16; }
__device__ __forceinline__ unsigned pk2(float lo, float hi) { return f2bf(lo) | (f2bf(hi) << 16); }
__device__ __forceinline__ float wave_sum(float v) {
#pragma unroll
    for (int o = 1; o < 64; o <<= 1) v += __shfl_xor(v, o);
    return v;
}
__device__ __forceinline__ float wave_max(float v) {
#pragma unroll
    for (int o = 1; o < 64; o <<= 1) v = fmaxf(v, __shfl_xor(v, o));
    return v;
}
__device__ __forceinline__ float sigmoidf_(float x) { return __builtin_amdgcn_rcpf(1.0f + __builtin_amdgcn_exp2f(x * -1.4426950408889634f)); }
__device__ __forceinline__ float siluf_(float x) { return x * __builtin_amdgcn_rcpf(1.0f + __builtin_amdgcn_exp2f(x * -1.4426950408889634f)); }
__device__ __forceinline__ float softplusf_(float x) { return fmaxf(x, 0.f) + log1pf(__expf(-fabsf(x))); }

#define XB_TMO      128
#define XB_XCNT(j)  (256  + 64 * (j))
#define XB_XSUB(j)  (1280 + 64 * (j))
#define XB_XGEN(j)  (2304 + 64 * (j))
#define XB_TOP      3328
#define XB_TOPGEN   3392
#define XCD_BAR_WORDS 3456
#define XB_SPIN_CAP (1u << 18)

__device__ __forceinline__ unsigned xb_ld(unsigned* p)              { return __hip_atomic_load(p, __ATOMIC_RELAXED, __HIP_MEMORY_SCOPE_AGENT); }
__device__ __forceinline__ unsigned xb_add(unsigned* p, unsigned v) { return __hip_atomic_fetch_add(p, v, __ATOMIC_RELAXED, __HIP_MEMORY_SCOPE_AGENT); }
__device__ __forceinline__ unsigned xb_xcc_id() { return (unsigned)__builtin_amdgcn_s_getreg((3 << 11) | 20) & 0xFu; }
#define XB_SPIN(cond, bar) do { unsigned _sp = 0; while (cond) { __builtin_amdgcn_s_sleep(1); \
    if ((++_sp & 255u) == 0u) { if (xb_ld(&(bar)[XB_TMO])) break; if (_sp > XB_SPIN_CAP) { atomicAdd(&(bar)[XB_TMO], 1u); break; } } } } while (0)

struct XcdBarrier { unsigned* bar; unsigned x; volatile LAS unsigned* st; };

__device__ __forceinline__ XcdBarrier xcd_barrier_post(unsigned* bar, volatile LAS unsigned* st) {
    XcdBarrier b; b.bar = bar; b.x = xb_xcc_id(); b.st = st;
    if (threadIdx.x == 0) (void)xb_add(&bar[XB_XCNT(b.x)], 1u);
    return b;
}
__device__ __forceinline__ void xcd_barrier_complete(unsigned* bar, unsigned x, unsigned& nloc, unsigned& nx) {
    const unsigned G = gridDim.x * gridDim.y * gridDim.z;
    unsigned sum, cnt, mine, sp = 0u;
    for (;;) {
        sum = 0u; cnt = 0u; mine = 0u;
#pragma unroll
        for (unsigned j = 0; j < 16; ++j) { const unsigned c = xb_ld(&bar[XB_XCNT(j)]); sum += c; cnt += (c > 0u) ? 1u : 0u; mine = (j == x) ? c : mine; }
        if (sum == G) break;
        __builtin_amdgcn_s_sleep(1);
        if ((++sp & 255u) == 0u) { if (xb_ld(&bar[XB_TMO])) break; if (sp > XB_SPIN_CAP) { atomicAdd(&bar[XB_TMO], 1u); break; } }
    }
    nloc = mine > 0u ? mine : 1u; nx = cnt > 0u ? cnt : 1u;
}
__device__ __forceinline__ void xcd_barrier(const XcdBarrier& b) {
    asm volatile("s_waitcnt vmcnt(0)" ::: "memory");
    __syncthreads();
    if (threadIdx.x == 0) {
        unsigned* bar = b.bar;
        __builtin_amdgcn_s_waitcnt(0);
        unsigned nloc = b.st[0], nx = b.st[1];
        if (nloc == 0u) { xcd_barrier_complete(bar, b.x, nloc, nx); b.st[0] = nloc; b.st[1] = nx; }
        const unsigned old = xb_add(&bar[XB_XSUB(b.x)], 1u);
        const unsigned gen = old / nloc;
        if (old + 1u == (gen + 1u) * nloc) {
            __builtin_amdgcn_fence(__ATOMIC_RELEASE, "agent");
            asm volatile("s_waitcnt vmcnt(0)" ::: "memory");
            const unsigned og = xb_add(&bar[XB_TOP], 1u);
            const unsigned tg = og / nx;
            if (og + 1u == (tg + 1u) * nx) xb_add(&bar[XB_TOPGEN], 1u);
            else XB_SPIN(xb_ld(&bar[XB_TOPGEN]) == tg, bar);
            __builtin_amdgcn_fence(__ATOMIC_ACQUIRE, "agent");
            xb_add(&bar[XB_XGEN(b.x)], 1u);
            asm volatile("s_waitcnt vmcnt(0)" ::: "memory");
        } else {
            XB_SPIN(xb_ld(&bar[XB_XGEN(b.x)]) == gen, bar);
            __builtin_amdgcn_fence(__ATOMIC_ACQUIRE, "agent");
            asm volatile("s_waitcnt vmcnt(0)" ::: "memory");
        }
    }
    __syncthreads();
}

struct Frame {
    LAS unsigned char* lds;
    int tid, lane, wave, gw, ngw, bid, nb;
    GAS unsigned char* ws;
};

__device__ __forceinline__ void frame_refresh(Frame& F, const Args& a, LAS unsigned char* lds) {
    int tid = threadIdx.x; asm volatile("" : "+v"(tid));
    int bid = blockIdx.x; asm volatile("" : "+s"(bid));
    unsigned char* ws = a.ws; asm volatile("" : "+s"(ws));
    F.lds = lds; F.tid = tid; F.lane = tid & 63; F.wave = __builtin_amdgcn_readfirstlane(tid >> 6);
    F.bid = bid; F.nb = gridDim.x; F.gw = F.bid * NWAVES + F.wave; F.ngw = F.nb * NWAVES; F.ws = (GAS unsigned char*)ws;
}
__device__ __forceinline__ void ph_pro_vectors(const Args& a, Frame& F) {
    float* MOD = (float*)(F.ws + WS_MOD);
    LAS float* red = (LAS float*)F.lds;
    for (int it = F.bid; it < 4 * 48; it += F.nb) {
        const int lk = it / 48, cg = it % 48, e = cg * 64 + F.lane;
        const float* W = a.ada_w + (size_t)lk * D * 3072 + e;
        float a0 = 0.f, a1 = 0.f;
        const int d0 = F.wave * 128;
#pragma unroll 8
        for (int d = d0; d < d0 + 128; ++d) {
            const float w = __builtin_nontemporal_load(W + (size_t)d * 3072);
            a0 += siluf_(a.c[d]) * w; a1 += siluf_(a.c[D + d]) * w;
        }
        red[(F.wave * 2 + 0) * 64 + F.lane] = a0; red[(F.wave * 2 + 1) * 64 + F.lane] = a1;
        __syncthreads();
        if (F.wave < 2) {
            float s = 0.f;
            for (int w = 0; w < 8; ++w) s += red[(w * 2 + F.wave) * 64 + F.lane];
            MOD[((size_t)lk * 2 + F.wave) * 3072 + e] = s + a.ada_b[lk * 3072 + e];
        }
        __syncthreads();
    }
    float* CS = (float*)(F.ws + WS_CS);
    for (int idx = F.bid * NTHREADS + F.tid; idx < T * 8; idx += F.nb * NTHREADS) {
        const int t = idx >> 3, i = idx & 7;
        const float inv = powf(500000.0f, -(float)(2 * i) / 16.0f);
        const float ang = (float)a.pos[t] * inv;
        CS[t * 16 + i] = cosf(ang); CS[t * 16 + 8 + i] = sinf(ang);
    }
}

template <int MODE>
__device__ __forceinline__ void ph_norm(const Args& a, Frame& F, int l, const float* xin, const float* gain, const float* modk  ,
                                        const float* W8, int pitch) {
    bf16_t* H = (bf16_t*)(F.ws + WS_H);
    LAS float* W8T = (LAS float*)F.lds;
    if (MODE != 0) {
        for (int i = F.tid; i < 8192; i += NTHREADS) { const int d = i >> 3, j = i & 7; W8T[j * 1024 + d] = W8[(size_t)d * pitch + j]; }
        __syncthreads();
    }
    f32x4 vn[4], A4[4], B4[4]; int cur_b = -1;
    if (F.gw < T) {
#pragma unroll
        for (int j = 0; j < 4; ++j) vn[j] = ((const f32x4*)(xin + (size_t)F.gw * D) + F.lane)[64 * j];
    }
    for (int row = F.gw; row < T; row += F.ngw) {
        const int b = row / SEQ;
        f32x4 v[4]; float ss = 0.f;
#pragma unroll
        for (int j = 0; j < 4; ++j) { v[j] = vn[j]; ss += (v[j].x * v[j].x + v[j].y * v[j].y) + (v[j].z * v[j].z + v[j].w * v[j].w); }
        if (row + F.ngw < T) {
#pragma unroll
            for (int j = 0; j < 4; ++j) vn[j] = ((const f32x4*)(xin + (size_t)(row + F.ngw) * D) + F.lane)[64 * j];
        }
        if (b != cur_b) {
            cur_b = b; const float* sh = modk + (size_t)b * 3072; const float* sc = sh + 1024;
#pragma unroll
            for (int j = 0; j < 4; ++j) { const int d = 256 * j + 4 * F.lane; A4[j] = *(const f32x4*)(gain + d) * (*(const f32x4*)(sc + d) + 1.0f); B4[j] = *(const f32x4*)(sh + d); }
        }
        const float rstd = rsqrtf(wave_sum(ss) * (1.0f / D) + EPS);
        float acc[8];
#pragma unroll
        for (int e = 0; e < 8; ++e) acc[e] = 0.f;
#pragma unroll
        for (int j = 0; j < 4; ++j) {
            const int d = 256 * j + 4 * F.lane;
            const f32x4 hv = (v[j] * rstd) * A4[j] + B4[j];
            u32x2 o; o.x = pk2(hv.x, hv.y); o.y = pk2(hv.z, hv.w);
            *(u32x2*)(H + (size_t)row * D + d) = o;
            if (MODE == 1) { u32x2 xo; xo.x = pk2(v[j].x, v[j].y); xo.y = pk2(v[j].z, v[j].w); *(u32x2*)((bf16_t*)(F.ws + WS_X16) + (size_t)row * D + d) = xo; }
            if (MODE != 0) {
#pragma unroll
                for (int e = 0; e < 8; ++e) { const f32x4 w4 = *(const LAS f32x4*)(W8T + e * 1024 + d); acc[e] += (hv.x * w4.x + hv.y * w4.y) + (hv.z * w4.z + hv.w * w4.w); }
            }
        }
        if (MODE != 0) {
#pragma unroll
            for (int e = 0; e < 8; ++e) acc[e] = wave_sum(acc[e]);
        }
        if (MODE == 1 && F.lane == 0) {
            float* BG = (float*)(F.ws + WS_BG) + (size_t)row * 8;
#pragma unroll
            for (int h = 0; h < 4; ++h) {
                BG[h] = sigmoidf_(acc[h]);
                BG[4 + h] = -__expf(a.dn_a_log[l * 4 + h]) * softplusf_(acc[4 + h] + a.dn_dt_bias[l * 4 + h]);
            }
        }
        if (MODE == 2 && F.lane == 0) {
            float v0 = -INFINITY, v1 = -INFINITY; int e0 = 0, e1 = 0;
#pragma unroll
            for (int e = 0; e < 8; ++e) { const float lg = acc[e] + a.router_b[e]; if (lg > v0) { v1 = v0; e1 = e0; v0 = lg; e0 = e; } else if (lg > v1) { v1 = lg; e1 = e; } }
            const float ex = __expf(v1 - v0), p0 = 1.0f / (1.0f + ex), p1 = ex / (1.0f + ex);
            unsigned* cnt = (unsigned*)(F.ws + WS_CTL) + CW_MOECNT;
            const int q0 = (int)atomicAdd(cnt + 64 * e0, 1u), q1 = (int)atomicAdd(cnt + 64 * e1, 1u);
            int* R = (int*)(F.ws + WS_ROUTE) + (size_t)row * 4; R[0] = e0; R[1] = e1; ((float*)R)[2] = p0; ((float*)R)[3] = p1;
            int* P = (int*)(F.ws + WS_POS) + (size_t)row * 2; P[0] = q0; P[1] = q1;
        }
    }
    if (MODE != 0) __syncthreads();
}

typedef float f32x16 __attribute__((ext_vector_type(16)));
typedef short s16x4 __attribute__((ext_vector_type(4)));
typedef short bf16x8_t __attribute__((ext_vector_type(8)));
__device__ __forceinline__ unsigned cvtpk(float lo, float hi) { typedef float f2_t __attribute__((ext_vector_type(2))); typedef __bf16 b2_t __attribute__((ext_vector_type(2)));
    f2_t v = {lo, hi}; b2_t b = __builtin_convertvector(v, b2_t); return __builtin_bit_cast(unsigned, b); }
__device__ __forceinline__ void ph_rope(const Args& a, Frame& F) {
    bf16_t* P = (bf16_t*)(F.ws + WS_PROJ); const float* CS = (const float*)(F.ws + WS_CS);
    for (int it = F.bid * NTHREADS + F.tid; it < T * 10; it += F.nb * NTHREADS) {
        const int t = it / 10, hh = it % 10;
        bf16_t* p = P + (size_t)t * NP + hh * 64;
        const u32x4 x1 = *(const u32x4*)p, x2 = *(const u32x4*)(p + 8);
        const f32x4 c0 = *(const f32x4*)(CS + (size_t)t * 16), c1 = *(const f32x4*)(CS + (size_t)t * 16 + 4), s0 = *(const f32x4*)(CS + (size_t)t * 16 + 8), s1 = *(const f32x4*)(CS + (size_t)t * 16 + 12);
        const float cs[8] = {c0.x, c0.y, c0.z, c0.w, c1.x, c1.y, c1.z, c1.w}, sn[8] = {s0.x, s0.y, s0.z, s0.w, s1.x, s1.y, s1.z, s1.w};
        const unsigned xa[4] = {x1.x, x1.y, x1.z, x1.w}, xb[4] = {x2.x, x2.y, x2.z, x2.w};
        unsigned ra[4], rb[4];
#pragma unroll
        for (int i = 0; i < 4; ++i) {
            const float a0 = bf2f(xa[i] & 0xffffu), a1 = bf2f(xa[i] >> 16), b0 = bf2f(xb[i] & 0xffffu), b1 = bf2f(xb[i] >> 16);
            ra[i] = pk2(a0 * cs[2 * i] - b0 * sn[2 * i], a1 * cs[2 * i + 1] - b1 * sn[2 * i + 1]);
            rb[i] = pk2(b0 * cs[2 * i] + a0 * sn[2 * i], b1 * cs[2 * i + 1] + a1 * sn[2 * i + 1]);
        }
        *(u32x4*)p = (u32x4){ra[0], ra[1], ra[2], ra[3]}; *(u32x4*)(p + 8) = (u32x4){rb[0], rb[1], rb[2], rb[3]};
    }
}
constexpr int AT_KROW = 144, AT_VOFF = 256 * AT_KROW;
__device__ __forceinline__ void ph_attn_mfma(const Args& a, Frame& F, int l) {
    const bf16_t* P = (const bf16_t*)(F.ws + WS_PROJ); bf16_t* Y = (bf16_t*)(F.ws + WS_YMIX);
    LAS unsigned char* Kl = F.lds; LAS unsigned char* Vl = F.lds + AT_VOFF;
    const int lane = F.lane, r = lane & 31, h = lane >> 5, g = F.wave >> 1, qh = F.wave & 1;
    const int i16 = lane & 15, tq_ = i16 >> 2, tp_ = i16 & 3, g16 = (lane >> 4) & 1, sw = (tq_ >> 1) & 1;
    const int vlane = (4 * h + tq_) * 128 + (2 * g16 + (tp_ >> 1)) * 16 + (tp_ & 1) * 8;
    const float C = 0.125f * 1.4426950408889634f;
    const int nsc = NSCAN;
    if (F.bid < nsc) return;
    u32x4 kreg[4], vreg[4];
#define AT_LOAD(uu) { const int hk_ = (uu) & 1, n_ = ((uu) >> 1) & 127, b_ = (uu) >> 8, tk0_ = b_ * SEQ + n_ * 128 - 128; \
        _Pragma("unroll") for (int i = 0; i < 4; ++i) { const int piece = F.tid + NTHREADS * i, key = piece >> 3, c = piece & 7; \
            const bf16_t* rowp = P + (size_t)(tk0_ + ((n_ > 0 || key >= 128) ? key : key + 128)) * NP; \
            kreg[i] = *(const u32x4*)(rowp + C_AK + hk_ * 64 + c * 8); vreg[i] = *(const u32x4*)(rowp + C_AV + hk_ * 64 + c * 8); } }
    if (F.bid - nsc < BATCH * 128 * 2) AT_LOAD(F.bid - nsc)
    for (int u = F.bid - nsc; u < BATCH * 128 * 2; u += F.nb - nsc) {
        const int hk = u & 1, n = (u >> 1) & 127, b = u >> 8;
        const int tq0 = b * SEQ + n * 128;
        __syncthreads();
#pragma unroll
        for (int i = 0; i < 4; ++i) {
            const int piece = F.tid + NTHREADS * i, key = piece >> 3, c = piece & 7;
            const bool ok = (n > 0 || key >= 128);
            const u32x4 z4 = (u32x4){0u, 0u, 0u, 0u};
            *(LAS u32x4*)(Kl + key * AT_KROW + c * 16) = ok ? kreg[i] : z4;
            *(LAS u32x4*)(Vl + key * 128 + ((c ^ (((key >> 1) & 1) << 2)) * 16)) = ok ? vreg[i] : z4;
        }
        __syncthreads();
        if (u + (F.nb - nsc) < BATCH * 128 * 2) AT_LOAD(u + (F.nb - nsc))
        asm volatile("" ::: "memory");
        const int hq = hk * 4 + g;
        const float sinkl = a.sinks[l * 8 + hq] * 1.4426950408889634f;
#pragma unroll 1
        for (int sb = 0; sb < 2; ++sb) {
            const int q0 = qh * 64 + sb * 32, kt0 = qh * 2 + sb;
            const size_t tq = (size_t)(tq0 + q0 + r);
            bf16x8_t qf[4];
#pragma unroll
            for (int ks = 0; ks < 4; ++ks) qf[ks] = *(const bf16x8_t*)(P + tq * NP + hq * 64 + 16 * ks + 8 * h);
            f32x16 S[5];
#pragma unroll
            for (int kr = 0; kr < 5; ++kr) {
                f32x16 acc;
#pragma unroll
                for (int i = 0; i < 16; ++i) acc[i] = 0.f;
#pragma unroll
                for (int ks = 0; ks < 4; ++ks) { const bf16x8_t kf = *(const LAS bf16x8_t*)(Kl + (32 * (kt0 + kr) + r) * AT_KROW + (16 * ks + 8 * h) * 2);
                    acc = __builtin_amdgcn_mfma_f32_32x32x16_bf16(kf, qf[ks], acc, 0, 0, 0); }
                S[kr] = acc;
            }
            float m = sinkl;
#pragma unroll
            for (int kr = 0; kr < 5; ++kr) {
                const bool tile_ok = !(n == 0 && (kt0 + kr) < 4);
#pragma unroll
                for (int i = 0; i < 16; ++i) {
                    const int kl = (i & 3) + 8 * (i >> 2) + 4 * h;
                    bool ok = tile_ok; if (kr == 0) ok = ok && (kl > r); if (kr == 4) ok = ok && (kl <= r);
                    const float sv = ok ? S[kr][i] * C : -INFINITY; S[kr][i] = sv; m = fmaxf(m, sv);
                }
            }
            m = fmaxf(m, __shfl_xor(m, 32));
            float lsum = 0.f;
#pragma unroll
            for (int kr = 0; kr < 5; ++kr)
#pragma unroll
                for (int i = 0; i < 16; ++i) { const float p = __builtin_amdgcn_exp2f(S[kr][i] - m); S[kr][i] = p; lsum += p; }
            lsum += __shfl_xor(lsum, 32); lsum += __builtin_amdgcn_exp2f(sinkl - m);
            f32x16 O0, O1;
#pragma unroll
            for (int i = 0; i < 16; ++i) { O0[i] = 0.f; O1[i] = 0.f; }
#pragma unroll
            for (int kr = 0; kr < 5; ++kr) {
#pragma unroll
                for (int s2 = 0; s2 < 2; ++s2) {
                    u32x4 pw; pw.x = cvtpk(S[kr][8 * s2 + 0], S[kr][8 * s2 + 1]); pw.y = cvtpk(S[kr][8 * s2 + 2], S[kr][8 * s2 + 3]); pw.z = cvtpk(S[kr][8 * s2 + 4], S[kr][8 * s2 + 5]); pw.w = cvtpk(S[kr][8 * s2 + 6], S[kr][8 * s2 + 7]);
                    const bf16x8_t pf = __builtin_bit_cast(bf16x8_t, pw);
                    const int kb = (32 * (kt0 + kr) + 16 * s2) * 128 + vlane;
                    const s16x4 lo0 = __builtin_amdgcn_ds_read_tr16_b64_v4i16((LAS s16x4*)(Vl + kb + (0 ^ sw) * 64));
                    const s16x4 hi0 = __builtin_amdgcn_ds_read_tr16_b64_v4i16((LAS s16x4*)(Vl + kb + 8 * 128 + (0 ^ sw) * 64));
                    const s16x4 lo1 = __builtin_amdgcn_ds_read_tr16_b64_v4i16((LAS s16x4*)(Vl + kb + (1 ^ sw) * 64));
                    const s16x4 hi1 = __builtin_amdgcn_ds_read_tr16_b64_v4i16((LAS s16x4*)(Vl + kb + 8 * 128 + (1 ^ sw) * 64));
                    const bf16x8_t va0 = __builtin_shufflevector(lo0, hi0, 0, 1, 2, 3, 4, 5, 6, 7), va1 = __builtin_shufflevector(lo1, hi1, 0, 1, 2, 3, 4, 5, 6, 7);
                    O0 = __builtin_amdgcn_mfma_f32_32x32x16_bf16(va0, pf, O0, 0, 0, 0);
                    O1 = __builtin_amdgcn_mfma_f32_32x32x16_bf16(va1, pf, O1, 0, 0, 0);
                }
            }
            const float inv = __builtin_amdgcn_rcpf(lsum);
            bf16_t* yp = Y + tq * D + hq * 64 + 4 * h;
#pragma unroll
            for (int gq = 0; gq < 4; ++gq) {
                u32x2 o0; o0.x = cvtpk(O0[4 * gq] * inv, O0[4 * gq + 1] * inv); o0.y = cvtpk(O0[4 * gq + 2] * inv, O0[4 * gq + 3] * inv);
                u32x2 o1; o1.x = cvtpk(O1[4 * gq] * inv, O1[4 * gq + 1] * inv); o1.y = cvtpk(O1[4 * gq + 2] * inv, O1[4 * gq + 3] * inv);
                *(u32x2*)(yp + 8 * gq) = o0; *(u32x2*)(yp + 32 + 8 * gq) = o1;
            }
        }
    }
    __syncthreads();
}


#undef AT_LOAD
constexpr size_t WS_DN_MR = 360 * MiB, WS_DN_BNT = 376 * MiB, WS_DN_QP = 392 * MiB, WS_DN_OLT = 408 * MiB, WS_DN_ST = 424 * MiB;
constexpr int DL = 72, LB = 9216;
constexpr int L_KR = 0, L_KT = LB, L_QR = 2 * LB, L_VT = 3 * LB, L_AR = 4 * LB, L_T1 = 5 * LB, L_T2 = 6 * LB, L_UT = 7 * LB, L_UPT = 8 * LB, L_WPT = 9 * LB, L_WT = 0;
constexpr int L_LR = 7 * LB, L_L21 = L_LR + 17408, L_T11T = L_L21 + 4608, L_T22R = L_T11T + 4608, L_YT = L_T22R + 4608, L_GC = 100352, L_BETA = L_GC + 256;
static_assert(L_YT + 4608 == L_GC && L_GC + 512 <= 131072, "DeltaNet LDS map");
template <int KS> __device__ __forceinline__ f32x4 mm16(const LAS unsigned char* lds, int offX, int offY, int tx, int ty, int lane) {
    f32x4 acc = (f32x4){0.f, 0.f, 0.f, 0.f};
    const int l15 = lane & 15, q = lane >> 4;
#pragma unroll
    for (int ks = 0; ks < KS; ++ks) {
        const bf16x8_t xa = *(const LAS bf16x8_t*)(lds + offX + ((16 * tx + l15) * DL + 32 * ks + 8 * q) * 2);
        const bf16x8_t yb = *(const LAS bf16x8_t*)(lds + offY + ((16 * ty + l15) * DL + 32 * ks + 8 * q) * 2);
        acc = __builtin_amdgcn_mfma_f32_16x16x32_bf16(xa, yb, acc, 0, 0, 0);
    }
    return acc;
}
__device__ __forceinline__ u32x2 pack4(f32x4 v) { u32x2 o; o.x = cvtpk(v.x, v.y); o.y = cvtpk(v.z, v.w); return o; }

__device__ __forceinline__ void ph_dn_chunk(const Args& a, Frame& F, int l) {
    const bf16_t* P = (const bf16_t*)(F.ws + WS_PROJ); const float* BG = (const float*)(F.ws + WS_BG);
    bf16_t* MR = (bf16_t*)(F.ws + WS_DN_MR); bf16_t* BNT = (bf16_t*)(F.ws + WS_DN_BNT); bf16_t* QP = (bf16_t*)(F.ws + WS_DN_QP); bf16_t* OLT = (bf16_t*)(F.ws + WS_DN_OLT);
    LAS unsigned char* lds = F.lds;
    LAS float* gcL = (LAS float*)(lds + L_GC); LAS float* betaL = (LAS float*)(lds + L_BETA);
    const float* cw = a.dn_conv_w + (size_t)l * DN_CONV * 768;
    const int lane = F.lane, w = F.wave, l15 = lane & 15, q4 = lane >> 4;
    LAS float* cwL = (LAS float*)(lds + L_GC + 512);
    int cur_h = -1;
    const int ci = F.tid >> 3, c8 = F.tid & 7;
    u32x4 xr[3][4]; float bgb = 0.f, bgg = 0.f;
#define CH_LOAD(vu_) { const int n_ = ((vu_) >> 2) & 255, h_ = (vu_) & 3, b_ = (vu_) >> 10; const int t_ = b_ * SEQ + n_ * 64 + ci; \
        _Pragma("unroll") for (int kd = 0; kd < 3; ++kd) _Pragma("unroll") for (int k = 0; k < DN_CONV; ++k) { \
            const int tt_ = (n_ * 64 + ci - (DN_CONV - 1) + k >= 0) ? t_ - (DN_CONV - 1) + k : t_; xr[kd][k] = *(const u32x4*)(P + (size_t)tt_ * NP + C_DQ + kd * 256 + h_ * 64 + c8 * 8); } \
        if (w == 0) { bgb = BG[(size_t)(b_ * SEQ + n_ * 64 + lane) * 8 + h_]; bgg = BG[(size_t)(b_ * SEQ + n_ * 64 + lane) * 8 + 4 + h_]; } }
    if (F.bid < BATCH * 4 * 256) CH_LOAD(F.bid)
    for (int vu = F.bid; vu < BATCH * 4 * 256; vu += F.nb) {
        const int n = (vu >> 2) & 255, h = vu & 3, b = vu >> 10, unit = (b * 4 + h) * 256 + n;
        const int t0 = b * SEQ + n * 64;
        __syncthreads();
        if (h != cur_h) { cur_h = h;
            for (int idx = F.tid; idx < DN_CONV * 3 * 64; idx += NTHREADS) { const int k = idx / 192, kd = (idx / 64) % 3, cc = idx & 63; cwL[idx] = cw[k * 768 + kd * 256 + h * 64 + cc]; }
            __syncthreads(); }
        {
            const int i = ci, sq = n * 64 + i;
#pragma unroll
            for (int kd = 0; kd < 3; ++kd) {
                float acc[8];
#pragma unroll
                for (int e = 0; e < 8; ++e) acc[e] = 0.f;
#pragma unroll
                for (int k = 0; k < DN_CONV; ++k) {
                    const u32x4 xv = xr[kd][k]; const float vm = (sq - (DN_CONV - 1) + k >= 0) ? 1.f : 0.f;
                    const f32x4 w0 = *(const LAS f32x4*)(cwL + (k * 3 + kd) * 64 + c8 * 8) * vm, w1 = *(const LAS f32x4*)(cwL + (k * 3 + kd) * 64 + c8 * 8 + 4) * vm;
                    acc[0] += w0.x * bf2f(xv.x & 0xffffu); acc[1] += w0.y * bf2f(xv.x >> 16); acc[2] += w0.z * bf2f(xv.y & 0xffffu); acc[3] += w0.w * bf2f(xv.y >> 16);
                    acc[4] += w1.x * bf2f(xv.z & 0xffffu); acc[5] += w1.y * bf2f(xv.z >> 16); acc[6] += w1.z * bf2f(xv.w & 0xffffu); acc[7] += w1.w * bf2f(xv.w >> 16);
                }
                float ss = 0.f;
#pragma unroll
                for (int e = 0; e < 8; ++e) { acc[e] = siluf_(acc[e]); ss += acc[e] * acc[e]; }
                if (kd < 2) {
                    ss += __shfl_xor(ss, 1); ss += __shfl_xor(ss, 2); ss += __shfl_xor(ss, 4);
                    const float rn = rsqrtf(ss + EPS) * (kd == 0 ? 0.125f : 1.0f);
#pragma unroll
                    for (int e = 0; e < 8; ++e) acc[e] *= rn;
                }
                u32x4 pk; pk.x = cvtpk(acc[0], acc[1]); pk.y = cvtpk(acc[2], acc[3]); pk.z = cvtpk(acc[4], acc[5]); pk.w = cvtpk(acc[6], acc[7]);
                if (kd == 0) *(LAS u32x4*)(lds + L_QR + (i * DL + c8 * 8) * 2) = pk;
                if (kd == 1) *(LAS u32x4*)(lds + L_KR + (i * DL + c8 * 8) * 2) = pk;
                if (kd >= 1) {
                    LAS bf16_t* Tt = (LAS bf16_t*)(lds + (kd == 1 ? L_KT : L_VT));
                    const unsigned pw[4] = {pk.x, pk.y, pk.z, pk.w};
#pragma unroll
                    for (int e = 0; e < 8; ++e) Tt[(c8 * 8 + e) * DL + i] = (bf16_t)((pw[e >> 1] >> (16 * (e & 1))) & 0xffffu);
                }
            }
            for (int idx = F.tid; idx < 2 * LB / 16; idx += NTHREADS) *(LAS u32x4*)(lds + L_T1 + idx * 16) = (u32x4){0u, 0u, 0u, 0u};
            if (w == 0) {
                float x = bgg;
#pragma unroll
                for (int o = 1; o < 64; o <<= 1) { const float y = __shfl_up(x, o); if (lane >= o) x += y; }
                gcL[lane] = x; betaL[lane] = bgb;
            }
            if (vu + F.nb < BATCH * 4 * 256) CH_LOAD(vu + F.nb)
            asm volatile("" ::: "memory");
        }
        __syncthreads();
#pragma unroll
        for (int tt = 0; tt < 2; ++tt) {
            const int tidx = 2 * w + tt, tx = tidx >> 2, ty = tidx & 3, i = 16 * ty + l15, j0 = 16 * tx + 4 * q4;
            const float gi = gcL[i], bi = betaL[i]; const f32x4 gj = *(const LAS f32x4*)(gcL + j0);
            const float gjv[4] = {gj.x, gj.y, gj.z, gj.w};
            const f32x4 zk = mm16<2>(lds, L_KR, L_KR, tx, ty, lane);
            const f32x4 zq = mm16<2>(lds, L_KR, L_QR, tx, ty, lane);
            f32x4 lv, av;
#pragma unroll
            for (int r = 0; r < 4; ++r) { const float dc = __expf(fminf(gi - gjv[r], 0.f)); lv[r] = (j0 + r < i) ? bi * zk[r] * dc : 0.f; av[r] = (j0 + r <= i) ? zq[r] * dc : 0.f; }
            *(LAS f32x4*)(lds + L_LR + (i * 68 + j0) * 4) = lv;
            if (i >= 32 && j0 < 32) *(LAS u32x2*)(lds + L_L21 + ((i - 32) * DL + j0) * 2) = pack4(lv);
            *(LAS u32x2*)(lds + L_AR + (i * DL + j0) * 2) = pack4(av);
        }
        __syncthreads();
        REP(32768) {
            const int cg = 8 * w + (lane >> 3), blk = cg >> 5, jp = cg & 31, l8 = lane & 7;
            const LAS float* Lb = (const LAS float*)(lds + L_LR) + (32 * blk) * 68 + 32 * blk + 4 * l8;
            float x0 = 0.f, x1 = 0.f, x2 = 0.f, x3 = 0.f;
#pragma unroll
            for (int i = 0; i < 32; ++i) {
                const f32x4 l4 = *(const LAS f32x4*)(Lb + i * 68);
                float part = (l4.x * x0 + l4.y * x1) + (l4.z * x2 + l4.w * x3);
                part += __shfl_xor(part, 1); part += __shfl_xor(part, 2); part += __shfl_xor(part, 4);
                const float xi = ((i == jp) ? 1.f : 0.f) - part;
                if (l8 == (i >> 2)) { if ((i & 3) == 0) x0 = xi; else if ((i & 3) == 1) x1 = xi; else if ((i & 3) == 2) x2 = xi; else x3 = xi; }
            }
            const int jg = 32 * blk + jp; const float bj = betaL[jg], bej = bj * __expf(gcL[jg]);
            LAS bf16_t* T1 = (LAS bf16_t*)(lds + L_T1); LAS bf16_t* T2 = (LAS bf16_t*)(lds + L_T2);
            const float xs[4] = {x0, x1, x2, x3};
#pragma unroll
            for (int e = 0; e < 4; ++e) { const int rg = 32 * blk + 4 * l8 + e; T1[rg * DL + jg] = (bf16_t)f2bf(xs[e] * bj); T2[rg * DL + jg] = (bf16_t)f2bf(xs[e] * bej); }
            if (blk == 0) { *(LAS u32x2*)(lds + L_T11T + (jp * DL + 4 * l8) * 2) = pack4((f32x4){x0, x1, x2, x3}); }
            else { LAS bf16_t* T22 = (LAS bf16_t*)(lds + L_T22R);
#pragma unroll
                for (int e = 0; e < 4; ++e) T22[(4 * l8 + e) * DL + jp] = (bf16_t)f2bf(xs[e]); }
        }
        __syncthreads();
        if (w < 4) {
            const int tx = w >> 1, ty = w & 1;
            const f32x4 z = mm16<1>(lds, L_L21, L_T11T, tx, ty, lane);
            *(LAS u32x2*)(lds + L_YT + ((16 * ty + l15) * DL + 16 * tx + 4 * q4) * 2) = pack4(z);
        }
        __syncthreads();
        if (w < 4) {
            const int tx = w >> 1, ty = w & 1, y = 16 * ty + l15, x0 = 16 * tx + 4 * q4;
            const f32x4 z = mm16<1>(lds, L_T22R, L_YT, tx, ty, lane);
            const float bj = betaL[y], bej = bj * __expf(gcL[y]);
            LAS bf16_t* T1 = (LAS bf16_t*)(lds + L_T1); LAS bf16_t* T2 = (LAS bf16_t*)(lds + L_T2);
#pragma unroll
            for (int r = 0; r < 4; ++r) { T1[(32 + x0 + r) * DL + y] = (bf16_t)f2bf(-z[r] * bj); T2[(32 + x0 + r) * DL + y] = (bf16_t)f2bf(-z[r] * bej); }
        }
        __syncthreads();
        const float gl = gcL[63];
#pragma unroll
        for (int tt = 0; tt < 2; ++tt) {
            const int tidx = 2 * w + tt, tx = tidx >> 2, ty = tidx & 3, y = 16 * ty + l15, x0 = 16 * tx + 4 * q4;
            const f32x4 gx = *(const LAS f32x4*)(gcL + x0);
            f32x4 sc; sc.x = __expf(gl - gx.x); sc.y = __expf(gl - gx.y); sc.z = __expf(gl - gx.z); sc.w = __expf(gl - gx.w);
            const f32x4 zu = mm16<2>(lds, L_T1, L_VT, tx, ty, lane);
            const f32x4 zw = mm16<2>(lds, L_T2, L_KT, tx, ty, lane);
            *(LAS u32x2*)(lds + L_UT + (y * DL + x0) * 2) = pack4(zu); *(LAS u32x2*)(lds + L_UPT + (y * DL + x0) * 2) = pack4(zu * sc);
            *(LAS u32x2*)(lds + L_WT + (y * DL + x0) * 2) = pack4(zw); *(LAS u32x2*)(lds + L_WPT + (y * DL + x0) * 2) = pack4(zw * sc);
        }
        __syncthreads();
        REP(65536) {
            const size_t cho = (size_t)unit * 4096;
            const float egl = __expf(gl);
#pragma unroll
            for (int tt = 0; tt < 2; ++tt) {
                const int tidx = 2 * w + tt, tx = tidx >> 2, ty = tidx & 3, y = 16 * ty + l15, x0 = 16 * tx + 4 * q4;
                f32x4 zm = mm16<2>(lds, L_WPT, L_KT, tx, ty, lane);
#pragma unroll
                for (int r = 0; r < 4; ++r) zm[r] = ((x0 + r) == y ? egl : 0.f) - zm[r];
                *(u32x2*)(MR + cho + (ty * 2 + (tx >> 1)) * 512 + lane * 8 + 4 * (tx & 1)) = pack4(zm);
                const f32x4 zb = mm16<2>(lds, L_KT, L_UPT, tx, ty, lane);
                *(u32x2*)(BNT + cho + (ty * 4 + tx) * 256 + lane * 4) = pack4(zb);
                const f32x4 zq = mm16<2>(lds, L_WT, L_AR, tx, ty, lane);
                const u32x2 qv = *(const LAS u32x2*)(lds + L_QR + (y * DL + x0) * 2); const float eg = __expf(gcL[y]);
                f32x4 qp; qp.x = bf2f(qv.x & 0xffffu) * eg - zq.x; qp.y = bf2f(qv.x >> 16) * eg - zq.y; qp.z = bf2f(qv.y & 0xffffu) * eg - zq.z; qp.w = bf2f(qv.y >> 16) * eg - zq.w;
                *(u32x2*)(QP + cho + y * 64 + x0) = pack4(qp);
                const f32x4 zo = mm16<2>(lds, L_AR, L_UT, tx, ty, lane);
                *(u32x2*)(OLT + cho + y * 64 + x0) = pack4(zo);
            }
        }
    }
    __syncthreads();
}
#undef CH_LOAD
constexpr int SC_SLOT = 10240, SC_DEPTH = 12, SC_AHEAD = 11;
__device__ __forceinline__ void ph_dn_scan(const Args& a, Frame& F) {
    if (F.bid >= NSCAN) return;
    const unsigned char* MRb = (const unsigned char*)(F.ws + WS_DN_MR); const unsigned char* BNb = (const unsigned char*)(F.ws + WS_DN_BNT); bf16_t* ST = (bf16_t*)(F.ws + WS_DN_ST);
    const int lane = F.lane, l15 = lane & 15, q4 = lane >> 4, wq = F.bid >> 3;
    const size_t ch0 = (size_t)(F.bid & 7) * 256;
    LAS unsigned char* lds = F.lds;
    __syncthreads();
    if (F.wave >= 3) {
        const int lw = F.wave - 3;
#define DN_ISSUE(nn) do { const size_t chb_ = (ch0 + (size_t)((nn) < 255 ? (nn) : 255)) * 8192; const int slot_ = ((nn) % SC_DEPTH) * SC_SLOT; \
        _Pragma("unroll") for (int p_ = 0; p_ < 2; ++p_) { const int piece_ = lw * 2 + p_; \
            const unsigned char* src_ = (piece_ < 8 ? MRb + chb_ + piece_ * 1024 : BNb + chb_ + wq * 2048 + (piece_ - 8) * 1024) + lane * 16; \
            __builtin_amdgcn_global_load_lds((const unsigned*)src_, (LAS unsigned*)(lds + slot_ + piece_ * 1024), 16, 0, 0); } } while (0)
        for (int n = 0; n < SC_AHEAD; ++n) DN_ISSUE(n);
        for (int n = 0; n < 256; ++n) {
            asm volatile("s_waitcnt vmcnt(20)" ::: "memory");
            __builtin_amdgcn_s_barrier();
            DN_ISSUE(n + SC_AHEAD);
        }
        asm volatile("s_waitcnt vmcnt(0)" ::: "memory");
#undef DN_ISSUE
    } else if (F.wave == 0) {
        const int dv = 16 * wq + l15;
        f32x4 S[4];
#pragma unroll
        for (int ti = 0; ti < 4; ++ti) S[ti] = (f32x4){0.f, 0.f, 0.f, 0.f};
        for (int n = 0; n < 256; ++n) {
            __builtin_amdgcn_s_barrier();
            const LAS unsigned char* slot = lds + (n % SC_DEPTH) * SC_SLOT;
            bf16x8_t A[4][2]; u32x2 Bc[4];
#pragma unroll
            for (int ti = 0; ti < 4; ++ti) {
#pragma unroll
                for (int ks = 0; ks < 2; ++ks) A[ti][ks] = *(const LAS bf16x8_t*)(slot + (ti * 2 + ks) * 1024 + lane * 16);
                Bc[ti] = *(const LAS u32x2*)(slot + 8192 + ti * 512 + lane * 8);
            }
            u32x2 sp[4];
#pragma unroll
            for (int ti = 0; ti < 4; ++ti) { sp[ti] = pack4(S[ti]); *(u32x2*)(ST + (ch0 + n) * 4096 + dv * 64 + 16 * ti + 4 * q4) = sp[ti]; }
            const bf16x8_t b0 = __builtin_bit_cast(bf16x8_t, (u32x4){sp[0].x, sp[0].y, sp[1].x, sp[1].y});
            const bf16x8_t b1 = __builtin_bit_cast(bf16x8_t, (u32x4){sp[2].x, sp[2].y, sp[3].x, sp[3].y});
#pragma unroll
            for (int ti = 0; ti < 4; ++ti) {
                f32x4 c; c.x = bf2f(Bc[ti].x & 0xffffu); c.y = bf2f(Bc[ti].x >> 16); c.z = bf2f(Bc[ti].y & 0xffffu); c.w = bf2f(Bc[ti].y >> 16);
                c = __builtin_amdgcn_mfma_f32_16x16x32_bf16(A[ti][0], b0, c, 0, 0, 0);
                c = __builtin_amdgcn_mfma_f32_16x16x32_bf16(A[ti][1], b1, c, 0, 0, 0);
                S[ti] = c;
            }
            asm volatile("s_waitcnt lgkmcnt(0)" ::: "memory");
        }
    } else {
        for (int n = 0; n < 256; ++n) __builtin_amdgcn_s_barrier();
    }
    __syncthreads();
}
__device__ __forceinline__ void ph_dn_out(const Args& a, Frame& F, int l) {
    const bf16_t* QP = (const bf16_t*)(F.ws + WS_DN_QP); const bf16_t* OLT = (const bf16_t*)(F.ws + WS_DN_OLT); const bf16_t* ST = (const bf16_t*)(F.ws + WS_DN_ST);
    const bf16_t* P = (const bf16_t*)(F.ws + WS_PROJ); bf16_t* Y = (bf16_t*)(F.ws + WS_YMIX);
    const int lane = F.lane, l15 = lane & 15, q4 = lane >> 4, ti = F.wave & 3;
    LAS bf16_t* TL = (LAS bf16_t*)(F.lds + F.wave * 2560);
    const int er = lane >> 2, ec = (lane & 3) * 16;
    f32x4 gnv[4];
#pragma unroll
    for (int j = 0; j < 4; ++j) gnv[j] = *(const f32x4*)(a.dn_norm_g + l * 64 + ec + 4 * j);
    bf16x8_t af[2], bfv[4][2]; u32x2 ov[4];
#define DNO_LOAD(prv) { const int unit_ = 2 * (prv) + (F.wave >> 2); const size_t cho_ = (size_t)unit_ * 4096; \
        _Pragma("unroll") for (int ks = 0; ks < 2; ++ks) af[ks] = *(const bf16x8_t*)(QP + cho_ + (16 * ti + l15) * 64 + 32 * ks + 8 * q4); \
        _Pragma("unroll") for (int tj = 0; tj < 4; ++tj) { ov[tj] = *(const u32x2*)(OLT + cho_ + (16 * tj + l15) * 64 + 16 * ti + 4 * q4); \
            _Pragma("unroll") for (int ks = 0; ks < 2; ++ks) bfv[tj][ks] = *(const bf16x8_t*)(ST + cho_ + (16 * tj + l15) * 64 + 32 * ks + 8 * q4); } }
    if (F.bid < 1024) DNO_LOAD(F.bid)
    for (int pr = F.bid; pr < 1024; pr += F.nb) {
        const int unit = 2 * pr + (F.wave >> 2), n = unit & 255, h = (unit >> 8) & 3, b = unit >> 10;
        f32x4 acc[4];
#pragma unroll
        for (int tj = 0; tj < 4; ++tj) {
            f32x4 c; c.x = bf2f(ov[tj].x & 0xffffu); c.y = bf2f(ov[tj].x >> 16); c.z = bf2f(ov[tj].y & 0xffffu); c.w = bf2f(ov[tj].y >> 16);
#pragma unroll
            for (int ks = 0; ks < 2; ++ks) c = __builtin_amdgcn_mfma_f32_16x16x32_bf16(af[ks], bfv[tj][ks], c, 0, 0, 0);
            acc[tj] = c;
        }
        const size_t trow = (size_t)b * SEQ + n * 64 + 16 * ti + er;
        const u32x4 z0 = *(const u32x4*)(P + trow * NP + C_DZ + h * 64 + ec), z1 = *(const u32x4*)(P + trow * NP + C_DZ + h * 64 + ec + 8);
        if (pr + F.nb < 1024) DNO_LOAD(pr + F.nb)
        f32x4 ss = acc[0] * acc[0] + acc[1] * acc[1] + acc[2] * acc[2] + acc[3] * acc[3];
#pragma unroll
        for (int o = 1; o < 16; o <<= 1) { ss.x += __shfl_xor(ss.x, o); ss.y += __shfl_xor(ss.y, o); ss.z += __shfl_xor(ss.z, o); ss.w += __shfl_xor(ss.w, o); }
        const float rs[4] = {rsqrtf(ss.x * (1.f / 64.f) + EPS), rsqrtf(ss.y * (1.f / 64.f) + EPS), rsqrtf(ss.z * (1.f / 64.f) + EPS), rsqrtf(ss.w * (1.f / 64.f) + EPS)};
#pragma unroll
        for (int tj = 0; tj < 4; ++tj)
#pragma unroll
            for (int r = 0; r < 4; ++r) TL[(4 * q4 + r) * 80 + 16 * tj + l15] = (bf16_t)f2bf(acc[tj][r] * rs[r]);
        const u32x4 t0 = *(const LAS u32x4*)(TL + er * 80 + ec), t1 = *(const LAS u32x4*)(TL + er * 80 + ec + 8);
        const unsigned tw[8] = {t0.x, t0.y, t0.z, t0.w, t1.x, t1.y, t1.z, t1.w}, zw[8] = {z0.x, z0.y, z0.z, z0.w, z1.x, z1.y, z1.z, z1.w};
        unsigned yw[8];
#pragma unroll
        for (int j = 0; j < 8; ++j) {
            const float g0 = gnv[j >> 1][(2 * j) & 3], g1 = gnv[j >> 1][(2 * j + 1) & 3];
            yw[j] = cvtpk(bf2f(tw[j] & 0xffffu) * g0 * siluf_(bf2f(zw[j] & 0xffffu)), bf2f(tw[j] >> 16) * g1 * siluf_(bf2f(zw[j] >> 16)));
        }
        bf16_t* yp = Y + trow * D + 512 + h * 64 + ec;
        *(u32x4*)yp = (u32x4){yw[0], yw[1], yw[2], yw[3]}; *(u32x4*)(yp + 8) = (u32x4){yw[4], yw[5], yw[6], yw[7]};
    }
#undef DNO_LOAD
}

__device__ __forceinline__ void ph_conv_fast(const Args& a, Frame& F, int l) {
    const bf16_t* P = (const bf16_t*)(F.ws + WS_PROJ); bf16_t* Y = (bf16_t*)(F.ws + WS_YMIX);
    LAS float* OUTL = (LAS float*)F.lds;
    const int c = F.tid & 255, rsel = F.tid >> 8;
    float wk[CV_K];
#pragma unroll
    for (int k = 0; k < CV_K; ++k) wk[k] = a.cv_dw_w[((size_t)l * CV_K + k) * CV_C + c];
    const float bias = a.cv_dw_b[l * CV_C + c];
    const int nsc = NSCAN;
    if (F.bid < nsc) return;
    for (int pr = (F.bid - nsc + (F.nb - nsc) / 2) % (F.nb - nsc); pr < T / 128; pr += F.nb - nsc) {
        const int run = 2 * pr + rsel, t0 = run * 64, s0 = t0 % SEQ;
        __syncthreads();
        float win[CV_K];
        const bf16_t* pc = P + (size_t)(t0 - 30) * NP + C_CA + c;
        const bool first = (s0 == 0);
        LAS float* outp = OUTL + (rsel * 64) * 256 + c;
#define CV_U(ti_, dst) { const bool ok_ = !(first && (ti_) < 30); const bf16_t* q_ = ok_ ? pc + (size_t)(ti_) * NP : pc + (size_t)30 * NP; \
            const float ca_ = bf2f(q_[0]), cb_ = bf2f(q_[256]); dst = ok_ ? ca_ * sigmoidf_(cb_) : 0.f; }
#pragma unroll
        for (int p = 0; p < CV_K; ++p) CV_U(p, win[p])
        { float acc = bias;
#pragma unroll
            for (int k = 0; k < CV_K; ++k) acc += wk[k] * win[(30 + 1 + k) % CV_K];
            outp[0] = acc; }
        for (int cb3 = 1; cb3 < 3; ++cb3) {
            float un[CV_K];
#pragma unroll
            for (int p = 0; p < CV_K; ++p) CV_U(cb3 * CV_K + p, un[p])
#pragma unroll
            for (int p = 0; p < CV_K; ++p) {
                win[p] = un[p];
                float acc = bias;
#pragma unroll
                for (int k = 0; k < CV_K; ++k) acc += wk[k] * win[(p + 1 + k) % CV_K];
                outp[(cb3 * CV_K + p - 30) * 256] = acc;
            }
        }
        { float u93; CV_U(93, u93) win[0] = u93; float acc = bias;
#pragma unroll
            for (int k = 0; k < CV_K; ++k) acc += wk[k] * win[(0 + 1 + k) % CV_K];
            outp[63 * 256] = acc; }
#undef CV_U
        __syncthreads();
        const f32x4 g4 = *(const f32x4*)(a.cv_ln_g + l * CV_C + 4 * F.lane), b4 = *(const f32x4*)(a.cv_ln_b + l * CV_C + 4 * F.lane);
        for (int j = 0; j < 16; ++j) {
            const int tl = F.wave * 16 + j;
            const f32x4 v = *(const LAS f32x4*)(OUTL + tl * 256 + 4 * F.lane);
            const float mean = wave_sum((v.x + v.y) + (v.z + v.w)) * (1.0f / CV_C);
            const f32x4 dv = v - mean;
            const float var = wave_sum((dv.x * dv.x + dv.y * dv.y) + (dv.z * dv.z + dv.w * dv.w)) * (1.0f / CV_C);
            const float rstd = rsqrtf(var + EPS);
            const f32x4 y = (dv * rstd) * g4 + b4;
            u32x2 o; o.x = cvtpk(siluf_(y.x), siluf_(y.y)); o.y = cvtpk(siluf_(y.z), siluf_(y.w));
            *(u32x2*)(Y + (size_t)(pr * 128 + tl) * D + 768 + 4 * F.lane) = o;
        }
    }
    __syncthreads();
}

__device__ __forceinline__ void moe_bases(Frame& F, int (&base)[9], int (&cnt)[8]) {
    const unsigned* c = (const unsigned*)(F.ws + WS_CTL) + CW_MOECNT;
    int acc = 0;
#pragma unroll
    for (int e = 0; e < 8; ++e) { cnt[e] = (int)__hip_atomic_load(c + 64 * e, __ATOMIC_RELAXED, __HIP_MEMORY_SCOPE_AGENT); base[e] = acc; acc += (cnt[e] + 255) & ~255; }
    base[8] = acc;
}
__device__ __forceinline__ void moe_range(Frame& F, int e, int& lo, int& hi) {
    const unsigned* c = (const unsigned*)(F.ws + WS_CTL) + CW_MOECNT;
    int acc = 0; lo = 0; hi = 0;
#pragma unroll
    for (int k = 0; k < 8; ++k) { const int n = ((int)__hip_atomic_load(c + 64 * k, __ATOMIC_RELAXED, __HIP_MEMORY_SCOPE_AGENT) + 255) & ~255; if (k == e) { lo = acc; hi = acc + n; } acc += n; }
}
__device__ __forceinline__ void ph_moe_list(const Args& a, Frame& F) {
    int base[9], cnt[8]; moe_bases(F, base, cnt);
    int* RM = (int*)(F.ws + WS_RMAP); const int* R = (const int*)(F.ws + WS_ROUTE); const int* Pq = (const int*)(F.ws + WS_POS);
    for (int t = F.bid * NTHREADS + F.tid; t < T; t += F.nb * NTHREADS) {
        const int e0 = R[t * 4], e1 = R[t * 4 + 1];
        int b0 = 0, b1 = 0;
#pragma unroll
        for (int e = 0; e < 8; ++e) { if (e == e0) b0 = base[e]; if (e == e1) b1 = base[e]; }
        RM[b0 + Pq[t * 2]] = t; RM[b1 + Pq[t * 2 + 1]] = t;
    }
    if (F.bid == 0) {
#pragma unroll
        for (int e = 0; e < 8; ++e) { const int lo = base[e] + cnt[e], hi = base[e + 1]; for (int r = lo + F.tid; r < hi; r += NTHREADS) RM[r] = 0; }
    }
}
__device__ __forceinline__ void ph_final(const Args& a, Frame& F) {
    int base[9], cnt[8]; moe_bases(F, base, cnt);
    const float* MOD = (const float*)(F.ws + WS_MOD);
    const bf16_t* YM = (const bf16_t*)(F.ws + WS_YMOE); const int* R = (const int*)(F.ws + WS_ROUTE); const int* Pq = (const int*)(F.ws + WS_POS); const bf16_t* X16 = (const bf16_t*)(F.ws + WS_X16);
    const int c0 = 8 * F.lane;
    f32x4 fg[4], gt[4]; int cur_b = -1;
#pragma unroll
    for (int j = 0; j < 4; ++j) fg[j] = *(const f32x4*)(a.final_g + 512 * (j >> 1) + c0 + 4 * (j & 1));
    u32x4 rt_n; u32x2 pq_n;
    u32x4 dx[2], dy0[2], dy1[2]; float p0c = 0.f, p1c = 0.f;
#define FIN_ROUTE(row_, rt_, pq_) { rt_ = *(const u32x4*)(R + (size_t)(row_) * 4); pq_ = *(const u32x2*)(Pq + (size_t)(row_) * 2); }
#define FIN_DATA(row_, rt_, pq_) { int b0_ = 0, b1_ = 0; _Pragma("unroll") for (int e = 0; e < 8; ++e) { if (e == (int)rt_.x) b0_ = base[e]; if (e == (int)rt_.y) b1_ = base[e]; } \
        const size_t s0_ = (size_t)(b0_ + (int)pq_.x), s1_ = (size_t)(b1_ + (int)pq_.y); p0c = __uint_as_float(rt_.z); p1c = __uint_as_float(rt_.w); \
        _Pragma("unroll") for (int jj = 0; jj < 2; ++jj) { dx[jj] = __builtin_nontemporal_load((const u32x4*)(X16 + (size_t)(row_) * D + 512 * jj + c0)); dy0[jj] = __builtin_nontemporal_load((const u32x4*)(YM + s0_ * D + 512 * jj + c0)); dy1[jj] = __builtin_nontemporal_load((const u32x4*)(YM + s1_ * D + 512 * jj + c0)); } }
    if (F.gw < T) { u32x4 rt0; u32x2 pq0; FIN_ROUTE(F.gw, rt0, pq0) FIN_DATA(F.gw, rt0, pq0) }
    if (F.gw + F.ngw < T) FIN_ROUTE(F.gw + F.ngw, rt_n, pq_n)
    for (int row = F.gw; row < T; row += F.ngw) {
        const int b = row / SEQ;
        if (b != cur_b) { cur_b = b; const float* gt2 = MOD + ((size_t)(1 * 2 + 1) * 2 + b) * 3072 + 2048;
#pragma unroll
            for (int j = 0; j < 4; ++j) gt[j] = *(const f32x4*)(gt2 + 512 * (j >> 1) + c0 + 4 * (j & 1)); }
        f32x4 v[4]; float ss = 0.f; const float p0 = p0c, p1 = p1c;
#pragma unroll
        for (int jj = 0; jj < 2; ++jj) {
            const unsigned xw[4] = {dx[jj].x, dx[jj].y, dx[jj].z, dx[jj].w}, y0w[4] = {dy0[jj].x, dy0[jj].y, dy0[jj].z, dy0[jj].w}, y1w[4] = {dy1[jj].x, dy1[jj].y, dy1[jj].z, dy1[jj].w};
#pragma unroll
            for (int hf = 0; hf < 2; ++hf) {
                f32x4 f, xo;
                f.x = p0 * bf2f(y0w[2 * hf] & 0xffffu) + p1 * bf2f(y1w[2 * hf] & 0xffffu); f.y = p0 * bf2f(y0w[2 * hf] >> 16) + p1 * bf2f(y1w[2 * hf] >> 16);
                f.z = p0 * bf2f(y0w[2 * hf + 1] & 0xffffu) + p1 * bf2f(y1w[2 * hf + 1] & 0xffffu); f.w = p0 * bf2f(y0w[2 * hf + 1] >> 16) + p1 * bf2f(y1w[2 * hf + 1] >> 16);
                xo.x = bf2f(xw[2 * hf] & 0xffffu); xo.y = bf2f(xw[2 * hf] >> 16); xo.z = bf2f(xw[2 * hf + 1] & 0xffffu); xo.w = bf2f(xw[2 * hf + 1] >> 16);
                const f32x4 vv = xo + gt[2 * jj + hf] * f; v[2 * jj + hf] = vv;
                ss += (vv.x * vv.x + vv.y * vv.y) + (vv.z * vv.z + vv.w * vv.w);
            }
        }
        if (row + F.ngw < T) { FIN_DATA(row + F.ngw, rt_n, pq_n) }
        if (row + 2 * F.ngw < T) FIN_ROUTE(row + 2 * F.ngw, rt_n, pq_n)
        const float rstd = rsqrtf(wave_sum(ss) * (1.0f / D) + EPS);
        float* op = a.out + (size_t)row * D + c0;
#pragma unroll
        for (int j = 0; j < 4; ++j) __builtin_nontemporal_store((v[j] * rstd) * fg[j], (f32x4*)(op + 512 * (j >> 1) + 4 * (j & 1)));
    }
#undef FIN_ROUTE
#undef FIN_DATA
}


namespace pg8 {
typedef short bf16x8 __attribute__((ext_vector_type(8)));
constexpr int BM = 256, BK = 64, HALF = 128, HTB = HALF * BK * 2, STAGE_BYTES = 8 * HTB;
__device__ __forceinline__ int lds_byte(int r, int c) { const int st = (r >> 4) * 2 + (c >> 5), rr = r & 15, cc = c & 31, ob = rr * 64 + cc * 2; return st * 1024 + (ob ^ (((ob >> 9) & 1) << 5)); }
__device__ __forceinline__ void stage_rc(int b, int& R, int& C) { const int st = b / 1024, sb = b % 1024, swz = sb ^ (((sb >> 9) & 1) << 5); R = (st >> 1) * 16 + swz / 64; C = (st & 1) * 32 + (swz % 64) / 2; }
__device__ __forceinline__ int perm32(int rho) { const int n = rho >> 4, i = rho & 15; return 8 * (i >> 2) + 4 * n + (i & 3); }
struct Unit { int pm, pn, ord; };
struct Gemm { const bf16_t* A; const bf16_t* Bt; int K; };
constexpr int NXCD = 8, WGM = 8;
struct StaticOrder {
    int nM, nN, nwg, G, c;
    __device__ void init(int M, int N, int G_, int c_) { nM = M / BM; nN = N / BM; nwg = nM * nN; G = G_; c = c_; }
    __device__ __forceinline__ bool next(int i, Unit& u) const {
        const long L = (long)i * G + c; if (L >= nwg) return false;
        int wgid = (int)L; { const int q = nwg / NXCD, r = nwg % NXCD, xcd = wgid % NXCD, off = wgid / NXCD; wgid = (xcd < r ? xcd * (q + 1) : r * (q + 1) + (xcd - r) * q) + off; }
        const int nig = WGM * nN, gid = wgid / nig, fm = gid * WGM, gsz = (nM - fm) < WGM ? (nM - fm) : WGM;
        u.pm = fm + ((wgid % nig) % gsz); u.pn = (wgid % nig) / gsz; return true;
    }
};
template <int NT> struct MoeOrder {
    int bt[9]; int cnt[8]; int G, c;
    __device__ __forceinline__ bool next(int i, Unit& u) const {
        int q, tn;
        if ((G & 7) == 0) { const int x = c & 7, Ll = i * (G >> 3) + (c >> 3); q = (Ll / NT) * 8 + x; tn = Ll % NT; if (q >= bt[8]) return false; }
        else { const int L = i * G + c; if (L >= bt[8] * NT) return false; q = L / NT; tn = L % NT; }
        int e = 0;
#pragma unroll
        for (int k = 1; k < 8; ++k) e += (q >= bt[k]) ? 1 : 0;
        u.pm = q; u.pn = e * NT + tn; return true;
    }
};
__device__ __forceinline__ unsigned cvt_pk_bf16(float lo, float hi) { unsigned r; asm volatile("v_cvt_pk_bf16_f32 %0, %1, %2" : "=v"(r) : "v"(lo), "v"(hi)); return r; }
__device__ __forceinline__ float fast_silu(float x) { return x * __builtin_amdgcn_rcpf(1.0f + __builtin_amdgcn_exp2f(x * -1.4426950408889634f)); }

struct EpiBf16 {
    static constexpr bool PERM = true, WIDE = false;
    bf16_t* O; int ldc; int nmod;
    __device__ __forceinline__ void operator()(const f32x4 (&acc)[2][2][4][2], const Unit& u, int wr, int wc, int fr, int fq) const {
        const int row0 = u.pm * BM + wr * 64 + fr, col0 = (u.pn % nmod) * BM + wc * 32 + 8 * fq;
#pragma unroll
        for (int ai = 0; ai < 2; ++ai)
#pragma unroll
            for (int m = 0; m < 4; ++m) { bf16_t* rowp = O + (size_t)(row0 + ai * HALF + m * 16) * ldc + col0;
#pragma unroll
                for (int bj = 0; bj < 2; ++bj) { const f32x4 v0 = acc[ai][bj][m][0], v1 = acc[ai][bj][m][1];
                    u32x4 w; w.x = cvt_pk_bf16(v0[0], v0[1]); w.y = cvt_pk_bf16(v0[2], v0[3]); w.z = cvt_pk_bf16(v1[0], v1[1]); w.w = cvt_pk_bf16(v1[2], v1[3]);
                    *(u32x4*)(rowp + bj * HALF) = w; } }
    }
};
struct EpiSwiGLU {
    static constexpr bool PERM = true, WIDE = false;
    bf16_t* O; int ldc; int nmod;
    __device__ __forceinline__ void operator()(const f32x4 (&acc)[2][2][4][2], const Unit& u, int wr, int wc, int fr, int fq) const {
        const int row0 = u.pm * BM + wr * 64 + fr, col0 = (u.pn % nmod) * HALF + wc * 32 + 8 * fq;
#pragma unroll
        for (int ai = 0; ai < 2; ++ai)
#pragma unroll
            for (int m = 0; m < 4; ++m) {
                const f32x4 g0 = acc[ai][0][m][0], g1 = acc[ai][0][m][1], u0 = acc[ai][1][m][0], u1 = acc[ai][1][m][1];
                u32x4 w;
                w.x = cvt_pk_bf16(fast_silu(g0[0]) * u0[0], fast_silu(g0[1]) * u0[1]); w.y = cvt_pk_bf16(fast_silu(g0[2]) * u0[2], fast_silu(g0[3]) * u0[3]);
                w.z = cvt_pk_bf16(fast_silu(g1[0]) * u1[0], fast_silu(g1[1]) * u1[1]); w.w = cvt_pk_bf16(fast_silu(g1[2]) * u1[2], fast_silu(g1[3]) * u1[3]);
                *(u32x4*)(O + (size_t)(row0 + ai * HALF + m * 16) * ldc + col0) = w; }
    }
};
struct EpiResidF32 {
    static constexpr bool PERM = false, WIDE = false;
    const float* xin; float* xout; const float* gate;
    __device__ __forceinline__ void operator()(const f32x4 (&acc)[2][2][4][2], const Unit& u, int wr, int wc, int fr, int fq) const {
        const int row0 = u.pm * BM + wr * 64 + fr, col0 = u.pn * BM + wc * 32 + 4 * fq;
        const float* gp = gate + (size_t)((u.pm * BM) / SEQ) * 3072 + col0;
#pragma unroll
        for (int bj = 0; bj < 2; ++bj)
#pragma unroll
            for (int n = 0; n < 2; ++n) { const f32x4 g4 = *(const f32x4*)(gp + bj * HALF + n * 16);
#pragma unroll
                for (int ai = 0; ai < 2; ++ai)
#pragma unroll
                    for (int m = 0; m < 4; ++m) { const size_t off = (size_t)(row0 + ai * HALF + m * 16) * D + col0 + bj * HALF + n * 16;
                        const f32x4 x4 = *(const f32x4*)(xin + off); *(f32x4*)(xout + off) = x4 + g4 * acc[ai][bj][m][n]; } }
    }
};


__device__ __forceinline__ u32x4 xchg8(u32x4 v) { u32x4 r;
    r.x = (unsigned)__builtin_amdgcn_update_dpp(0, (int)v.x, 0x128, 0xf, 0xf, false); r.y = (unsigned)__builtin_amdgcn_update_dpp(0, (int)v.y, 0x128, 0xf, 0xf, false);
    r.z = (unsigned)__builtin_amdgcn_update_dpp(0, (int)v.z, 0x128, 0xf, 0xf, false); r.w = (unsigned)__builtin_amdgcn_update_dpp(0, (int)v.w, 0x128, 0xf, 0xf, false); return r; }
__device__ __forceinline__ u32x4 pack8(f32x4 v0, f32x4 v1) { u32x4 w; w.x = cvt_pk_bf16(v0[0], v0[1]); w.y = cvt_pk_bf16(v0[2], v0[3]); w.z = cvt_pk_bf16(v1[0], v1[1]); w.w = cvt_pk_bf16(v1[2], v1[3]); return w; }
template <bool NT = true> __device__ __forceinline__ void store_wide(bf16_t* p, int ld, int fr, int fq, u32x4 pk0, u32x4 pk1) {
    const bool lo = fr < 8; const u32x4 rcv = xchg8(lo ? pk1 : pk0);
    bf16_t* q = p + (size_t)(fr & 7) * ld + 8 * fq + (lo ? 0 : 32);
    if constexpr (NT) { __builtin_nontemporal_store(lo ? pk0 : rcv, (u32x4*)q); __builtin_nontemporal_store(lo ? rcv : pk1, (u32x4*)(q + (size_t)8 * ld)); }
    else { *(u32x4*)q = lo ? pk0 : rcv; *(u32x4*)(q + (size_t)8 * ld) = lo ? rcv : pk1; }
}
struct EpiBf16W {
    static constexpr bool PERM = true, WIDE = true;
    bf16_t* O; int ldc; int nmod;
    __device__ __forceinline__ void operator()(const f32x4 (&acc)[2][2][4][2], const Unit& u, int wr, int wc, int fr, int fq) const {
        bf16_t* base = O + (size_t)(u.pm * BM + wr * 64) * ldc + (u.pn % nmod) * BM + wc * 64;
#pragma unroll
        for (int ai = 0; ai < 2; ++ai)
#pragma unroll
            for (int m = 0; m < 4; ++m) store_wide(base + (size_t)(ai * HALF + m * 16) * ldc, ldc, fr, fq, pack8(acc[ai][0][m][0], acc[ai][0][m][1]), pack8(acc[ai][1][m][0], acc[ai][1][m][1]));
    }
};
struct EpiResidNorm {
    static constexpr bool PERM = true, WIDE = true;
    const bf16_t* xin; bf16_t* x16; const float* gate; const float* av; bf16_t* xa; float* ssqp;
    __device__ __forceinline__ void operator()(const f32x4 (&acc)[2][2][4][2], const Unit& u, int wr, int wc, int fr, int fq) const {
        const int rowb = u.pm * BM + wr * 64, colw = u.pn * BM + wc * 64, b = (u.pm * BM) / SEQ;
        const bool lo = fr < 8;
        const size_t lane_off = (size_t)(fr & 7) * D + colw + 8 * fq + (lo ? 0 : 32);
        f32x4 gv[2][2], avv[2][2];
#pragma unroll
        for (int bj = 0; bj < 2; ++bj)
#pragma unroll
            for (int n = 0; n < 2; ++n) { gv[bj][n] = *(const f32x4*)(gate + (size_t)b * 3072 + colw + 32 * bj + 8 * fq + 4 * n); avv[bj][n] = *(const f32x4*)(av + (size_t)b * 1024 + colw + 32 * bj + 8 * fq + 4 * n); }
        u32x4 la[4][2], lb[4][2];
#define ERN_LOAD(k_) { _Pragma("unroll") for (int mm = 0; mm < 2; ++mm) { const bf16_t* q = xin + (size_t)(rowb + ((k_) >> 1) * HALF + (2 * ((k_) & 1) + mm) * 16) * D + lane_off; la[k_][mm] = __builtin_nontemporal_load((const u32x4*)q); lb[k_][mm] = __builtin_nontemporal_load((const u32x4*)(q + (size_t)8 * D)); } }
        ERN_LOAD(0)
#pragma unroll
        for (int k = 0; k < 4; ++k) {
            const int ai = k >> 1;
            if (k == 0) ERN_LOAD(1) else if (k == 1) ERN_LOAD(2) else if (k == 2) ERN_LOAD(3)
            asm volatile("" ::: "memory");
#pragma unroll
            for (int mm = 0; mm < 2; ++mm) {
                const int m = 2 * (k & 1) + mm;
                const u32x4 rcv = xchg8(lo ? lb[k][mm] : la[k][mm]);
                const u32x4 xb0 = lo ? la[k][mm] : rcv, xb1 = lo ? rcv : lb[k][mm];
                f32x4 x00, x01, x10, x11;
                x00.x = __uint_as_float(xb0.x << 16); x00.y = __uint_as_float(xb0.x & 0xffff0000u); x00.z = __uint_as_float(xb0.y << 16); x00.w = __uint_as_float(xb0.y & 0xffff0000u);
                x01.x = __uint_as_float(xb0.z << 16); x01.y = __uint_as_float(xb0.z & 0xffff0000u); x01.z = __uint_as_float(xb0.w << 16); x01.w = __uint_as_float(xb0.w & 0xffff0000u);
                x10.x = __uint_as_float(xb1.x << 16); x10.y = __uint_as_float(xb1.x & 0xffff0000u); x10.z = __uint_as_float(xb1.y << 16); x10.w = __uint_as_float(xb1.y & 0xffff0000u);
                x11.x = __uint_as_float(xb1.z << 16); x11.y = __uint_as_float(xb1.z & 0xffff0000u); x11.z = __uint_as_float(xb1.w << 16); x11.w = __uint_as_float(xb1.w & 0xffff0000u);
                const f32x4 n00 = x00 + gv[0][0] * acc[ai][0][m][0], n01 = x01 + gv[0][1] * acc[ai][0][m][1], n10 = x10 + gv[1][0] * acc[ai][1][m][0], n11 = x11 + gv[1][1] * acc[ai][1][m][1];
                float sv = (((n00.x * n00.x + n00.y * n00.y) + (n00.z * n00.z + n00.w * n00.w)) + ((n01.x * n01.x + n01.y * n01.y) + (n01.z * n01.z + n01.w * n01.w)))
                         + (((n10.x * n10.x + n10.y * n10.y) + (n10.z * n10.z + n10.w * n10.w)) + ((n11.x * n11.x + n11.y * n11.y) + (n11.z * n11.z + n11.w * n11.w)));
                const size_t ro = (size_t)(rowb + ai * HALF + m * 16) * D + colw;
                store_wide<false>(x16 + ro, D, fr, fq, pack8(n00, n01), pack8(n10, n11));
                store_wide<false>(xa + ro, D, fr, fq, pack8(n00 * avv[0][0], n01 * avv[0][1]), pack8(n10 * avv[1][0], n11 * avv[1][1]));
                sv += __shfl_xor(sv, 16); sv += __shfl_xor(sv, 32);
                if (fq == 0) ssqp[(size_t)(rowb + ai * HALF + m * 16 + fr) * 16 + u.pn * 4 + wc] = sv;
            }
        }
#undef ERN_LOAD
    }
};
struct EpiProjNorm {
    static constexpr bool PERM = true, WIDE = true;
    bf16_t* O; const LAS float* RS; const float* cv; float* BG; const float* a_log; const float* dt_bias;
    __device__ __forceinline__ void operator()(const f32x4 (&acc)[2][2][4][2], const Unit& u, int wr, int wc, int fr, int fq) const {
        const int rl0 = wr * 64 + fr, colw = u.pn * BM + wc * 64, b = (u.pm * BM) / SEQ;
        const float* cp = cv + (size_t)b * NPW + colw + 8 * fq;
        if (u.pn < NP / BM) {
            f32x4 c4[2][2];
#pragma unroll
            for (int bj = 0; bj < 2; ++bj)
#pragma unroll
                for (int n = 0; n < 2; ++n) c4[bj][n] = *(const f32x4*)(cp + 32 * bj + 4 * n);
            bf16_t* base = O + (size_t)(u.pm * BM + wr * 64) * NP + colw;
#pragma unroll
            for (int ai = 0; ai < 2; ++ai)
#pragma unroll
                for (int m = 0; m < 4; ++m) { const float rs = fabsf(RS[u.ord * 256 + rl0 + ai * HALF + m * 16]);
                    store_wide(base + (size_t)(ai * HALF + m * 16) * NP, NP, fr, fq, pack8(acc[ai][0][m][0] * rs + c4[0][0], acc[ai][0][m][1] * rs + c4[0][1]), pack8(acc[ai][1][m][0] * rs + c4[1][0], acc[ai][1][m][1] * rs + c4[1][1])); }
        } else if (wc == 0 && fq == 0) {
            const f32x4 c0 = *(const f32x4*)(cp), c1 = *(const f32x4*)(cp + 4);
            const f32x4 al = *(const f32x4*)a_log, db = *(const f32x4*)dt_bias;
#pragma unroll
            for (int ai = 0; ai < 2; ++ai)
#pragma unroll
                for (int m = 0; m < 4; ++m) { const int rl = rl0 + ai * HALF + m * 16; const float rs = fabsf(RS[u.ord * 256 + rl]);
                    const f32x4 vb = acc[ai][0][m][0] * rs + c0, va = acc[ai][0][m][1] * rs + c1;
                    f32x4 be, gg;
#pragma unroll
                    for (int hh = 0; hh < 4; ++hh) { be[hh] = sigmoidf_(vb[hh]); gg[hh] = -__expf(al[hh]) * softplusf_(va[hh] + db[hh]); }
                    float* bg = BG + (size_t)(u.pm * BM + rl) * 8; *(f32x4*)bg = be; *(f32x4*)(bg + 4) = gg; }
        }
    }
};
struct EpiNull {
    static constexpr bool PERM = true, WIDE = false;
    __device__ __forceinline__ void operator()(const f32x4 (&acc)[2][2][4][2], const Unit& u, int wr, int wc, int fr, int fq) const {
#pragma unroll
        for (int ai = 0; ai < 2; ++ai)
#pragma unroll
            for (int bj = 0; bj < 2; ++bj)
#pragma unroll
                for (int m = 0; m < 4; ++m)
#pragma unroll
                    for (int n = 0; n < 2; ++n) asm volatile("" :: "v"(acc[ai][bj][m][n]));
    }
};
struct EpiSwiGLUNorm {
    static constexpr bool PERM = true, WIDE = false;
    bf16_t* O; int ldc; int nmod; const LAS float* RS; const float* cv; int ncv;
    __device__ __forceinline__ void operator()(const f32x4 (&acc)[2][2][4][2], const Unit& u, int wr, int wc, int fr, int fq) const {
        const int rl0 = wr * 64 + fr, col0 = (u.pn % nmod) * HALF + wc * 32 + 8 * fq;
        const float* cp = cv + (size_t)u.pn * BM + wc * 32 + 8 * fq;
        f32x4 cg[2][2], cu[2][2];
#pragma unroll
        for (int bb = 0; bb < 2; ++bb)
#pragma unroll
            for (int n = 0; n < 2; ++n) { cg[bb][n] = *(const f32x4*)(cp + (size_t)bb * ncv + 4 * n); cu[bb][n] = *(const f32x4*)(cp + (size_t)bb * ncv + HALF + 4 * n); }
#pragma unroll
        for (int ai = 0; ai < 2; ++ai)
#pragma unroll
            for (int m = 0; m < 4; ++m) { const int rl = rl0 + ai * HALF + m * 16; const float rsv = RS[u.ord * 256 + rl], rs = fabsf(rsv); const bool b1 = rsv < 0.f;
                const f32x4 g0 = acc[ai][0][m][0] * rs + (b1 ? cg[1][0] : cg[0][0]), g1 = acc[ai][0][m][1] * rs + (b1 ? cg[1][1] : cg[0][1]);
                const f32x4 u0 = acc[ai][1][m][0] * rs + (b1 ? cu[1][0] : cu[0][0]), u1 = acc[ai][1][m][1] * rs + (b1 ? cu[1][1] : cu[0][1]);
                u32x4 w;
                w.x = cvt_pk_bf16(fast_silu(g0[0]) * u0[0], fast_silu(g0[1]) * u0[1]); w.y = cvt_pk_bf16(fast_silu(g0[2]) * u0[2], fast_silu(g0[3]) * u0[3]);
                w.z = cvt_pk_bf16(fast_silu(g1[0]) * u1[0], fast_silu(g1[1]) * u1[1]); w.w = cvt_pk_bf16(fast_silu(g1[2]) * u1[2], fast_silu(g1[3]) * u1[3]);
                __builtin_nontemporal_store(w, (u32x4*)(O + (size_t)(u.pm * BM + rl) * ldc + col0)); }
    }
};

template <class Epi, class Sched, bool GATHER, bool ALIGN_EPI, bool SP2>
__device__ __forceinline__ void gemm_phase(LAS unsigned char* lds, const LAS int* RI, const Gemm g, const Sched& S, const Epi& E) {
    const int tid = threadIdx.x, wid = __builtin_amdgcn_readfirstlane(tid >> 6), lane = tid & 63, wr = wid >> 2, wc = wid & 3, fr = lane & 15, fq = lane >> 4;
    const int K = g.K, nt = K / BK;
    unsigned voffB[2]; int Ra[2]; unsigned Ca2[2];
#pragma unroll
    for (int i = 0; i < 2; ++i) { int R, C; stage_rc(tid * 16 + i * 8192, R, C); const int Rb = Epi::WIDE ? ((R >> 5) * 64 + perm32(R & 31)) : (Epi::PERM ? ((R & ~31) + perm32(R & 31)) : R);
        Ra[i] = R; Ca2[i] = (unsigned)C * 2u; voffB[i] = (unsigned)(Rb * K + C) * 2u; }
    const size_t kstep = (size_t)(BK * 2);
    const size_t hstep = (size_t)HALF * K * 2;
    const size_t tstep = 2 * hstep;
    const size_t hstepB = Epi::WIDE ? (size_t)32 * K * 2 : hstep;
    const unsigned rowb = (unsigned)K * 2u;
    const unsigned ldsw = (unsigned)wid * 1024u;
    const int aoff = lds_byte(wr * 64 + fr, fq * 8), boff = lds_byte(wc * 32 + fr, fq * 8);
#define PG8_SA(b, h) (((b) * 2 + (h)) * HTB)
#define PG8_SB(b, h) ((4 + (b) * 2 + (h)) * HTB)
#define PG8_STAGE_B(bufoff, gbase) do { _Pragma("unroll") for (int _i = 0; _i < 2; ++_i) \
        __builtin_amdgcn_global_load_lds((const unsigned*)((const char*)(gbase) + voffB[_i]), (LAS unsigned*)(lds + (bufoff) + ldsw + _i * 8192), 16, 0, 0); } while (0)
#define PG8_STAGE_A(bufoff, kb, off) do { _Pragma("unroll") for (int _i = 0; _i < 2; ++_i) \
        __builtin_amdgcn_global_load_lds((const unsigned*)((const char*)g.A + (size_t)(kb) + (off)[_i]), (LAS unsigned*)(lds + (bufoff) + ldsw + _i * 8192), 16, 0, 0); } while (0)
#define PG8_LDA(dst, b, h) do { _Pragma("unroll") for (int m = 0; m < 4; ++m) _Pragma("unroll") for (int k = 0; k < 2; ++k) dst[m][k] = *(const LAS bf16x8*)(lds + PG8_SA(b, h) + aoff + m * 2048 + k * 1024); } while (0)
#define PG8_LDB(dst, b, h) do { _Pragma("unroll") for (int n = 0; n < 2; ++n) _Pragma("unroll") for (int k = 0; k < 2; ++k) dst[n][k] = *(const LAS bf16x8*)(lds + PG8_SB(b, h) + boff + n * 2048 + k * 1024); } while (0)
#define PG8_MMA(ai, bj, At, Bt) do { __builtin_amdgcn_s_setprio(1); _Pragma("unroll") for (int m = 0; m < 4; ++m) _Pragma("unroll") for (int n = 0; n < 2; ++n) _Pragma("unroll") for (int k = 0; k < 2; ++k) \
        acc[ai][bj][m][n] = __builtin_amdgcn_mfma_f32_16x16x32_bf16(Bt[n][k], At[m][k], acc[ai][bj][m][n], 0, 0, 0); __builtin_amdgcn_s_setprio(0); } while (0)
#define PG8_WAIT_V(n) asm volatile("s_waitcnt vmcnt(" #n ")" ::: "memory")
#define PG8_WAIT_L(n) asm volatile("s_waitcnt lgkmcnt(" #n ")" ::: "memory")
#define PG8_BAR __builtin_amdgcn_s_barrier()
#define PG8_SCHED __builtin_amdgcn_sched_barrier(0)
#define PG8_AOFFS(dst, ui_, un_) do { _Pragma("unroll") for (int _h = 0; _h < 2; ++_h) _Pragma("unroll") for (int _i = 0; _i < 2; ++_i) { \
        const unsigned _row = GATHER ? (unsigned)RI[(ui_) * 256 + _h * HALF + Ra[_i]] : (unsigned)((un_).pm * BM + _h * HALF + Ra[_i]); dst[_h][_i] = _row * rowb + Ca2[_i]; } } while (0)
    Unit cur, nxt; int ui = 0;
    if (!S.next(0, cur)) return;
    cur.ord = 0;
    f32x4 acc[2][2][4][2];
#pragma unroll
    for (int a = 0; a < 2; ++a)
#pragma unroll
        for (int b = 0; b < 2; ++b)
#pragma unroll
            for (int m = 0; m < 4; ++m)
#pragma unroll
                for (int n = 0; n < 2; ++n) acc[a][b][m][n] = (f32x4){0.f, 0.f, 0.f, 0.f};
    bf16x8 At[4][2], B0[2][2], B1[2][2];
    unsigned cv[2][2], nv[2][2];
    PG8_AOFFS(cv, 0, cur);
    const char* cB = (const char*)g.Bt + (size_t)cur.pn * tstep;
    if constexpr (SP2) {
        PG8_STAGE_B(PG8_SB(0, 0), cB); PG8_STAGE_B(PG8_SB(0, 1), cB + hstepB); PG8_STAGE_A(PG8_SA(0, 0), 0, cv[0]); PG8_STAGE_A(PG8_SA(0, 1), 0, cv[1]);
        if (wr == 1) PG8_BAR;
        PG8_WAIT_V(2); PG8_BAR;
        PG8_STAGE_B(PG8_SB(1, 0), cB + kstep); PG8_STAGE_A(PG8_SA(1, 0), kstep, cv[0]); PG8_STAGE_B(PG8_SB(1, 1), cB + hstepB + kstep);
        PG8_WAIT_V(6); PG8_BAR;
    } else {
        PG8_STAGE_B(PG8_SB(0, 0), cB); PG8_STAGE_A(PG8_SA(0, 0), 0, cv[0]); PG8_STAGE_B(PG8_SB(0, 1), cB + hstepB); PG8_STAGE_A(PG8_SA(0, 1), 0, cv[1]);
        if (wr == 1) PG8_BAR;
        PG8_WAIT_V(4); PG8_BAR;
        PG8_STAGE_B(PG8_SB(1, 0), cB + kstep); PG8_STAGE_A(PG8_SA(1, 0), kstep, cv[0]); PG8_STAGE_B(PG8_SB(1, 1), cB + hstepB + kstep);
        PG8_WAIT_V(6); PG8_BAR;
    }
    for (;;) {
        const bool has_next = S.next(ui + 1, nxt); nxt.ord = ui + 1;
        const char* nB = has_next ? (const char*)g.Bt + (size_t)nxt.pn * tstep : cB;
        if (has_next) { PG8_AOFFS(nv, ui + 1, nxt); }
        else {
#pragma unroll
            for (int h = 0; h < 2; ++h)
#pragma unroll
                for (int i = 0; i < 2; ++i) nv[h][i] = cv[h][i]; }
        for (int t = 0; t < nt; t += 2) {
            const bool last = (t == nt - 2);
            const size_t kb1 = (size_t)(t + 1) * kstep, kb2 = last ? (size_t)0 : (size_t)(t + 2) * kstep, kb3 = kb2 + kstep;
            const char* b2 = last ? nB : cB + (size_t)(t + 2) * kstep; const char* b3 = b2 + kstep;
            unsigned o2[2][2];
#pragma unroll
            for (int h = 0; h < 2; ++h)
#pragma unroll
                for (int i = 0; i < 2; ++i) o2[h][i] = last ? nv[h][i] : cv[h][i];
            if constexpr (SP2) {
            PG8_LDB(B0, 0, 0); PG8_LDB(B1, 0, 1); PG8_SCHED; PG8_LDA(At, 0, 0); PG8_STAGE_A(PG8_SA(1, 1), kb1, cv[1]);
            PG8_WAIT_V(8); PG8_WAIT_L(0); PG8_BAR; PG8_MMA(0, 0, At, B0); PG8_MMA(0, 1, At, B1); PG8_BAR; PG8_SCHED;
            PG8_LDA(At, 0, 1); PG8_STAGE_B(PG8_SB(0, 0), b2); PG8_STAGE_B(PG8_SB(0, 1), b2 + hstepB); PG8_STAGE_A(PG8_SA(0, 0), kb2, o2[0]);
            PG8_WAIT_V(8); PG8_WAIT_L(0); PG8_BAR; PG8_MMA(1, 0, At, B0); PG8_MMA(1, 1, At, B1); PG8_BAR; PG8_SCHED;
            PG8_LDB(B0, 1, 0); PG8_LDB(B1, 1, 1); PG8_SCHED; PG8_LDA(At, 1, 0); PG8_STAGE_A(PG8_SA(0, 1), kb2, o2[1]);
            PG8_WAIT_V(8); PG8_WAIT_L(0); PG8_BAR; PG8_MMA(0, 0, At, B0); PG8_MMA(0, 1, At, B1); PG8_BAR; PG8_SCHED;
            PG8_LDA(At, 1, 1); PG8_STAGE_B(PG8_SB(1, 0), b3); PG8_STAGE_B(PG8_SB(1, 1), b3 + hstepB); PG8_STAGE_A(PG8_SA(1, 0), kb3, o2[0]);
            PG8_WAIT_V(8); PG8_WAIT_L(0); PG8_BAR; PG8_MMA(1, 0, At, B0); PG8_MMA(1, 1, At, B1); PG8_BAR; PG8_SCHED;
            } else {
            PG8_LDB(B0, 0, 0); PG8_SCHED; PG8_LDA(At, 0, 0); PG8_STAGE_A(PG8_SA(1, 1), kb1, cv[1]);
            PG8_WAIT_L(8); PG8_BAR; PG8_WAIT_L(0); PG8_MMA(0, 0, At, B0); PG8_BAR; PG8_SCHED;
            PG8_LDB(B1, 0, 1); PG8_STAGE_B(PG8_SB(0, 0), b2);
            PG8_BAR; PG8_WAIT_L(0); PG8_MMA(0, 1, At, B1); PG8_BAR;
            PG8_LDA(At, 0, 1); PG8_STAGE_A(PG8_SA(0, 0), kb2, o2[0]);
            PG8_BAR; PG8_WAIT_L(0); PG8_MMA(1, 0, At, B0); PG8_BAR; PG8_SCHED;
            PG8_STAGE_B(PG8_SB(0, 1), b2 + hstepB);
            PG8_WAIT_V(6); PG8_BAR; PG8_MMA(1, 1, At, B1); PG8_BAR;
            PG8_LDB(B0, 1, 0); PG8_SCHED; PG8_LDA(At, 1, 0); PG8_STAGE_A(PG8_SA(0, 1), kb2, o2[1]);
            PG8_WAIT_L(8); PG8_BAR; PG8_WAIT_L(0); PG8_MMA(0, 0, At, B0); PG8_BAR; PG8_SCHED;
            PG8_LDB(B1, 1, 1); PG8_STAGE_B(PG8_SB(1, 0), b3);
            PG8_BAR; PG8_WAIT_L(0); PG8_MMA(0, 1, At, B1); PG8_BAR;
            PG8_LDA(At, 1, 1); PG8_STAGE_A(PG8_SA(1, 0), kb3, o2[0]);
            PG8_BAR; PG8_WAIT_L(0); PG8_MMA(1, 0, At, B0); PG8_BAR; PG8_SCHED;
            PG8_STAGE_B(PG8_SB(1, 1), b3 + hstepB);
            PG8_WAIT_V(6); PG8_BAR; PG8_MMA(1, 1, At, B1); PG8_BAR;
            }
        }
        if constexpr (ALIGN_EPI) { if (wr == 0) PG8_BAR; }
        E(acc, cur, wr, wc, fr, fq);
        if (!has_next) break;
#pragma unroll
        for (int a = 0; a < 2; ++a)
#pragma unroll
            for (int b = 0; b < 2; ++b)
#pragma unroll
                for (int m = 0; m < 4; ++m)
#pragma unroll
                    for (int n = 0; n < 2; ++n) acc[a][b][m][n] = (f32x4){0.f, 0.f, 0.f, 0.f};
        cur = nxt; cB = nB; ++ui;
#pragma unroll
        for (int h = 0; h < 2; ++h)
#pragma unroll
            for (int i = 0; i < 2; ++i) cv[h][i] = nv[h][i];
        if constexpr (ALIGN_EPI) { if (wr == 1) PG8_BAR; }
    }
    PG8_WAIT_V(0);
    if constexpr (!ALIGN_EPI) { if (wr == 0) PG8_BAR; }
    PG8_BAR;
#undef PG8_SA
#undef PG8_SB
#undef PG8_STAGE_A
#undef PG8_STAGE_B
#undef PG8_LDA
#undef PG8_LDB
#undef PG8_MMA
#undef PG8_WAIT_V
#undef PG8_WAIT_L
#undef PG8_BAR
#undef PG8_SCHED
#undef PG8_AOFFS
}
}

__device__ __forceinline__ void transpose_item(const float* W, int pitch, int k0, int n0, bf16_t* WT, int Kd, int drow0, LAS float* scr, int lane) {
#pragma unroll 8
    for (int i = 0; i < 32; ++i) { const int kk = 2 * i + (lane >> 5); scr[kk * 33 + (lane & 31)] = __builtin_nontemporal_load(W + (size_t)(k0 + kk) * pitch + n0 + (lane & 31)); }
    asm volatile("s_waitcnt lgkmcnt(0)" ::: "memory");
    const int c = lane & 7;
#pragma unroll
    for (int j = 0; j < 4; ++j) { const int n = (lane >> 3) + 8 * j; const LAS float* s = scr + (8 * c) * 33 + n;
        u32x4 o; o.x = pk2(s[0 * 33], s[1 * 33]); o.y = pk2(s[2 * 33], s[3 * 33]); o.z = pk2(s[4 * 33], s[5 * 33]); o.w = pk2(s[6 * 33], s[7 * 33]);
        *(u32x4*)(WT + (size_t)(drow0 + n) * Kd + k0 + 8 * c) = o; }
    asm volatile("s_waitcnt lgkmcnt(0)" ::: "memory");
}
constexpr size_t WT_WIN = 0, WT_WOUT = WT_WIN + (size_t)2 * NPW * D, WT_FGU = WT_WOUT + (size_t)2 * D * D, WT_FD = WT_FGU + (size_t)2 * D_FF * D,
                 WT_MGU = WT_FD + (size_t)D * D_FF, WT_MD = WT_MGU + (size_t)NE * 2 * D_FFE * D, WT_END = WT_MD + (size_t)NE * D * D_FFE;
static_assert(WT_END * 2 <= 80 * MiB, "weight copies fit");
__device__ __forceinline__ void ph_pro_weights(const Args& a, Frame& F) {
    LAS float* scr = (LAS float*)(F.lds + F.wave * 16384);
    bf16_t* WT = (bf16_t*)(F.ws + WS_WT);
    constexpr int I_IN0 = 16 * 48, I_IN1 = 16 * 24, I_OUT = 16 * 32, I_FG = 16 * 88, I_FD = 44 * 32, I_M = 16 * 32;
    constexpr int NITEMS = 2 * (I_IN0 + I_IN1 + I_OUT) + 2 * I_FG + I_FD + 24 * I_M;
    for (int it = F.gw; it < NITEMS; it += F.ngw) {
        int r = it; const float* src; int pitch, k0, n0, Kd, drow0; bf16_t* dst;
        if (r < 2 * I_IN0) { const int l = r / I_IN0; r %= I_IN0; src = a.w_in + (size_t)l * D * N_IN; pitch = N_IN; k0 = (r / 48) * 64; n0 = (r % 48) * 32; dst = WT + WT_WIN + (size_t)l * NPW * D; Kd = D; drow0 = n0; }
        else if ((r -= 2 * I_IN0) < 2 * I_IN1) { const int l = r / I_IN1; r %= I_IN1; src = a.w_in + (size_t)l * D * N_IN + 1544; pitch = N_IN; k0 = (r / 24) * 64; n0 = (r % 24) * 32; dst = WT + WT_WIN + (size_t)l * NPW * D; Kd = D; drow0 = 1536 + n0; }
        else if ((r -= 2 * I_IN1) < 2 * I_OUT) { const int l = r / I_OUT; r %= I_OUT; src = a.w_out + (size_t)l * D * D; pitch = D; k0 = (r / 32) * 64; n0 = (r % 32) * 32; dst = WT + WT_WOUT + (size_t)l * D * D; Kd = D; drow0 = n0; }
        else if ((r -= 2 * I_OUT) < 2 * I_FG) { const int up = r / I_FG; r %= I_FG; src = up ? a.ffn_wu : a.ffn_wg; pitch = D_FF; k0 = (r / 88) * 64; n0 = (r % 88) * 32; dst = WT + WT_FGU; Kd = D; drow0 = (n0 / 128) * 256 + up * 128 + (n0 % 128); }
        else if ((r -= 2 * I_FG) < I_FD) { src = a.ffn_wd; pitch = D; k0 = (r / 32) * 64; n0 = (r % 32) * 32; dst = WT + WT_FD; Kd = D_FF; drow0 = n0; }
        else if ((r -= I_FD) < 16 * I_M) { const int e = r / (2 * I_M); r %= 2 * I_M; const int up = r / I_M; r %= I_M; src = (up ? a.moe_wu : a.moe_wg) + (size_t)e * D * D_FFE; pitch = D_FFE; k0 = (r / 32) * 64; n0 = (r % 32) * 32;
            dst = WT + WT_MGU + (size_t)e * 2 * D_FFE * D; Kd = D; drow0 = (n0 / 128) * 256 + up * 128 + (n0 % 128); }
        else { r -= 16 * I_M; const int e = r / I_M; r %= I_M; src = a.moe_wd + (size_t)e * D_FFE * D; pitch = D; k0 = (r / 32) * 64; n0 = (r % 32) * 32; dst = WT + WT_MD + (size_t)e * D * D_FFE; Kd = D_FFE; drow0 = n0; }
        transpose_item(src, pitch, k0, n0, dst, Kd, drow0, scr, F.lane);
    }
    for (int idx = F.bid * NTHREADS + F.tid; idx < 2 * 256 * D; idx += F.nb * NTHREADS) {
        const int l = idx / (256 * D), r = (idx / D) % 256, k = idx % D;
        WT[WT_WIN + (size_t)l * NPW * D + (size_t)(2304 + r) * D + k] = (r < 8) ? (bf16_t)f2bf(a.w_in[(size_t)l * D * N_IN + (size_t)k * N_IN + W_DB + r]) : (bf16_t)0;
    }
}

template <int NT> __device__ __forceinline__ void moe_order_init(Frame& F, pg8::MoeOrder<NT>& S) {
    const unsigned* c = (const unsigned*)(F.ws + WS_CTL) + CW_MOECNT;
    int acc = 0;
#pragma unroll
    for (int e = 0; e < 8; ++e) { S.cnt[e] = (int)__hip_atomic_load(c + 64 * e, __ATOMIC_RELAXED, __HIP_MEMORY_SCOPE_AGENT); S.bt[e] = acc; acc += (S.cnt[e] + 255) >> 8; }
    S.bt[8] = acc; S.G = F.nb; S.c = F.bid;
}
template <int NT> __device__ __forceinline__ int moe_ri_one(Frame& F, const pg8::MoeOrder<NT>& S, const int* RM, int o, int t) {
    pg8::Unit u; if (!S.next(o, u)) return -1;
    const int e = u.pn / NT; int bte = 0, cne = 0;
#pragma unroll
    for (int kk = 0; kk < 8; ++kk) { if (kk == e) { bte = S.bt[kk]; cne = S.cnt[kk]; } }
    const int sl = (u.pm - bte) * 256 + t; return (sl < cne) ? RM[(size_t)e * T + sl] : 0;
}
template <int NT> __device__ __forceinline__ void moe_ri_preload(Frame& F, const pg8::MoeOrder<NT>& S) {
    LAS int* RI = (LAS int*)(F.lds + RI_OFF); const int* RM = (const int*)(F.ws + WS_RMAP);
    const int t = F.tid & 255, par = F.tid >> 8;
    const int v0 = moe_ri_one<NT>(F, S, RM, par, t), v1 = moe_ri_one<NT>(F, S, RM, par + 2, t), v2 = moe_ri_one<NT>(F, S, RM, par + 4, t), v3 = moe_ri_one<NT>(F, S, RM, par + 6, t);
    const int v4 = moe_ri_one<NT>(F, S, RM, par + 8, t), v5 = moe_ri_one<NT>(F, S, RM, par + 10, t), v6 = moe_ri_one<NT>(F, S, RM, par + 12, t), v7 = moe_ri_one<NT>(F, S, RM, par + 14, t);
    if (v0 >= 0) RI[(par) * 256 + t] = v0; if (v1 >= 0) RI[(par + 2) * 256 + t] = v1; if (v2 >= 0) RI[(par + 4) * 256 + t] = v2; if (v3 >= 0) RI[(par + 6) * 256 + t] = v3;
    if (v4 >= 0) RI[(par + 8) * 256 + t] = v4; if (v5 >= 0) RI[(par + 10) * 256 + t] = v5; if (v6 >= 0) RI[(par + 12) * 256 + t] = v6;
    if (v7 >= 0 && par + 14 < 15) RI[(par + 14) * 256 + t] = v7;
    __syncthreads();
}

__device__ __forceinline__ void ph_norm0(const Args& a, Frame& F) {
    const float* MOD = (const float*)(F.ws + WS_MOD);
    bf16_t* XA = (bf16_t*)(F.ws + WS_H); bf16_t* X16 = (bf16_t*)(F.ws + WS_X16); float* SSQ = (float*)(F.ws + WS_SSQ) + (size_t)3 * T * 16;
    f32x4 vn[4], A4[4]; int cur_b = -1;
#define N0_LOAD(row_) { const f32x4* p_ = (const f32x4*)(a.x + (size_t)(row_) * D) + 2 * F.lane; vn[0] = __builtin_nontemporal_load(p_); vn[1] = __builtin_nontemporal_load(p_ + 1); vn[2] = __builtin_nontemporal_load(p_ + 128); vn[3] = __builtin_nontemporal_load(p_ + 129); }
    if (F.gw < T) N0_LOAD(F.gw)
    for (int row = F.gw; row < T; row += F.ngw) {
        const int b = row / SEQ;
        f32x4 v[4]; float ss = 0.f;
#pragma unroll
        for (int j = 0; j < 4; ++j) { v[j] = vn[j]; ss += (v[j].x * v[j].x + v[j].y * v[j].y) + (v[j].z * v[j].z + v[j].w * v[j].w); }
        if (row + F.ngw < T) N0_LOAD(row + F.ngw)
        if (b != cur_b) { cur_b = b;
#pragma unroll
            for (int j = 0; j < 4; ++j) { const int d = 512 * (j >> 1) + 8 * F.lane + 4 * (j & 1); A4[j] = *(const f32x4*)(a.nmg + d) * (*(const f32x4*)(MOD + (size_t)b * 3072 + 1024 + d) + 1.0f); } }
#pragma unroll
        for (int jj = 0; jj < 2; ++jj) {
            const int d = 512 * jj + 8 * F.lane; const f32x4 v0 = v[2 * jj], v1 = v[2 * jj + 1], s0 = v0 * A4[2 * jj], s1 = v1 * A4[2 * jj + 1];
            u32x4 o; o.x = pk2(v0.x, v0.y); o.y = pk2(v0.z, v0.w); o.z = pk2(v1.x, v1.y); o.w = pk2(v1.z, v1.w); *(u32x4*)(X16 + (size_t)row * D + d) = o;
            u32x4 p; p.x = pk2(s0.x, s0.y); p.y = pk2(s0.z, s0.w); p.z = pk2(s1.x, s1.y); p.w = pk2(s1.z, s1.w); *(u32x4*)(XA + (size_t)row * D + d) = p;
        }
        ss = wave_sum(ss);
        if (F.lane < 16) SSQ[(size_t)row * 16 + F.lane] = (F.lane == 0) ? ss : 0.f;
    }
#undef N0_LOAD
}
__device__ __forceinline__ void ph_prep_vectors(const Args& a, Frame& F) {
    const float* MOD = (const float*)(F.ws + WS_MOD); float* AV = (float*)(F.ws + WS_AV);
    for (int idx = F.bid * NTHREADS + F.tid; idx < 3 * BATCH * D; idx += F.nb * NTHREADS) {
        const int inst = idx / (BATCH * D), b = (idx / D) % BATCH, d = idx % D;
        const int lk = (inst == 0) ? 1 : (inst == 1 ? 2 : 3);
        const float gn = (inst == 0) ? a.nfg[d] : (inst == 1 ? a.nmg[D + d] : a.nfg[D + d]);
        AV[idx] = gn * (1.0f + MOD[((size_t)lk * 2 + b) * 3072 + 1024 + d]);
    }
    const bf16_t* WT = (const bf16_t*)(F.ws + WS_WT);
    constexpr int NR = 5632 + NPW + 16384 + NPW;
    LAS float* SH = (LAS float*)F.lds;
    for (int i = F.tid; i < 4 * BATCH * D; i += NTHREADS) { const int which = i / (BATCH * D), b = (i / D) % BATCH, d = i % D; SH[i] = MOD[((size_t)((which + 1) & 3) * 2 + b) * 3072 + d]; }
    __syncthreads();
    for (int g8 = F.gw; g8 < NR / 8; g8 += F.ngw) {
        const int row = g8 * 8 + (F.lane >> 3), part = F.lane & 7;
        int which, r; const bf16_t* wrow; float* out; int ncv;
        if (row < 5632) { which = 0; r = row; wrow = WT + WT_FGU + (size_t)r * D; out = (float*)(F.ws + WS_CVF); ncv = 5632; }
        else if (row < 5632 + NPW) { which = 1; r = row - 5632; wrow = WT + WT_WIN + (size_t)NPW * D + (size_t)r * D; out = (float*)(F.ws + WS_CVI); ncv = NPW; }
        else if (row < 5632 + NPW + 16384) { which = 2; r = row - 5632 - NPW; wrow = WT + WT_MGU + (size_t)r * D; out = (float*)(F.ws + WS_CVM); ncv = 16384; }
        else { which = 3; r = row - 5632 - NPW - 16384; wrow = WT + WT_WIN + (size_t)r * D; out = (float*)(F.ws + WS_CVI0); ncv = NPW; }
        u32x4 wv[16];
#pragma unroll
        for (int j = 0; j < 16; ++j) wv[j] = *(const u32x4*)(wrow + 128 * part + 8 * j);
        const LAS float* s0p = SH + (which * 2 + 0) * 1024 + 128 * part; const LAS float* s1p = s0p + 1024;
        float s0 = 0.f, s1 = 0.f;
#pragma unroll
        for (int j = 0; j < 16; ++j) {
            const f32x4 a0 = *(const LAS f32x4*)(s0p + 8 * j), a1 = *(const LAS f32x4*)(s0p + 8 * j + 4), b0 = *(const LAS f32x4*)(s1p + 8 * j), b1 = *(const LAS f32x4*)(s1p + 8 * j + 4);
            const float x0 = bf2f(wv[j].x & 0xffffu), x1 = bf2f(wv[j].x >> 16), x2 = bf2f(wv[j].y & 0xffffu), x3 = bf2f(wv[j].y >> 16), x4 = bf2f(wv[j].z & 0xffffu), x5 = bf2f(wv[j].z >> 16), x6 = bf2f(wv[j].w & 0xffffu), x7 = bf2f(wv[j].w >> 16);
            s0 += ((x0 * a0.x + x1 * a0.y) + (x2 * a0.z + x3 * a0.w)) + ((x4 * a1.x + x5 * a1.y) + (x6 * a1.z + x7 * a1.w));
            s1 += ((x0 * b0.x + x1 * b0.y) + (x2 * b0.z + x3 * b0.w)) + ((x4 * b1.x + x5 * b1.y) + (x6 * b1.z + x7 * b1.w));
        }
        s0 += __shfl_xor(s0, 1); s0 += __shfl_xor(s0, 2); s0 += __shfl_xor(s0, 4);
        s1 += __shfl_xor(s1, 1); s1 += __shfl_xor(s1, 2); s1 += __shfl_xor(s1, 4);
        if (part == 0) { out[r] = s0; out[ncv + r] = s1; }
    }
    __syncthreads();
    if (F.gw < BATCH * 8) {
        const int b = F.gw >> 3, e = F.gw & 7; float sacc = 0.f;
        for (int d = F.lane; d < D; d += 64) sacc += MOD[((size_t)3 * 2 + b) * 3072 + d] * a.router_w[(size_t)d * NE + e];
        sacc = wave_sum(sacc);
        if (F.lane == 0) ((float*)(F.ws + WS_CR))[b * 8 + e] = sacc;
    }
}
template <class Sched> __device__ __forceinline__ int count_units(const Sched& S) { int n = 0; pg8::Unit u; while (n < 16 && S.next(n, u)) ++n; return n; }
template <class Sched> __device__ __forceinline__ void rstd_preload(Frame& F, const Sched& S, const float* ssqp, const LAS int* RI) {
    LAS float* RS = (LAS float*)(F.lds + RS_OFF);
    const int t = F.tid & 255, par = F.tid >> 8, nu = count_units(S);
#pragma unroll
    for (int k0 = 0; k0 < 8; k0 += 4) {
        f32x4 p0[4], p1[4], p2[4], p3[4]; int r0, r1, r2, r3;
#define RSP_LOAD(k, pk, rk) { const int o = par + 2 * (k0 + k); pg8::Unit u; u.pm = 0; rk = 0; if (o < nu) { S.next(o, u); rk = RI ? RI[o * 256 + t] : u.pm * 256 + t; } \
            const f32x4* q = (const f32x4*)(ssqp + (size_t)rk * 16); pk[0] = q[0]; pk[1] = q[1]; pk[2] = q[2]; pk[3] = q[3]; }
        RSP_LOAD(0, p0, r0) RSP_LOAD(1, p1, r1) RSP_LOAD(2, p2, r2) RSP_LOAD(3, p3, r3)
#undef RSP_LOAD
#define RSP_STORE(k, pk, rk) { const int o = par + 2 * (k0 + k); if (o < nu) { const f32x4 s4 = (pk[0] + pk[1]) + (pk[2] + pk[3]); \
            const float rs = rsqrtf(((s4.x + s4.y) + (s4.z + s4.w)) * (1.0f / D) + EPS); RS[o * 256 + t] = (rk >= SEQ) ? -rs : rs; } }
        RSP_STORE(0, p0, r0) RSP_STORE(1, p1, r1) RSP_STORE(2, p2, r2) RSP_STORE(3, p3, r3)
#undef RSP_STORE
    }
    __syncthreads();
}
__device__ __forceinline__ void ph_router(const Args& a, Frame& F) {
    const bf16_t* XA = (const bf16_t*)(F.ws + WS_H); const float* SSQ = (const float*)(F.ws + WS_SSQ) + (size_t)2 * T * 16; const float* CR = (const float*)(F.ws + WS_CR);
    LAS float* W8T = (LAS float*)F.lds;
    for (int i = F.tid; i < 8192; i += NTHREADS) { const int d = i >> 3, j = i & 7; W8T[j * 1024 + d] = a.router_w[i]; }
    __syncthreads();
    for (int row = F.gw; row < T; row += F.ngw) {
        const int b = row / SEQ;
        float acc[8];
#pragma unroll
        for (int e = 0; e < 8; ++e) acc[e] = 0.f;
#pragma unroll
        for (int jj = 0; jj < 2; ++jj) {
            const int d = 512 * jj + 8 * F.lane;
            const u32x4 xv = *(const u32x4*)(XA + (size_t)row * D + d);
            const float x[8] = {bf2f(xv.x & 0xffffu), bf2f(xv.x >> 16), bf2f(xv.y & 0xffffu), bf2f(xv.y >> 16), bf2f(xv.z & 0xffffu), bf2f(xv.z >> 16), bf2f(xv.w & 0xffffu), bf2f(xv.w >> 16)};
#pragma unroll
            for (int e = 0; e < 8; ++e) { const f32x4 wa = *(const LAS f32x4*)(W8T + e * 1024 + d), wb = *(const LAS f32x4*)(W8T + e * 1024 + d + 4);
                acc[e] += ((x[0] * wa.x + x[1] * wa.y) + (x[2] * wa.z + x[3] * wa.w)) + ((x[4] * wb.x + x[5] * wb.y) + (x[6] * wb.z + x[7] * wb.w)); }
        }
        const float ssq = wave_sum(F.lane < 16 ? SSQ[(size_t)row * 16 + F.lane] : 0.f);
        const float rstd = rsqrtf(ssq * (1.0f / D) + EPS);
#pragma unroll
        for (int e = 0; e < 8; ++e) acc[e] = wave_sum(acc[e]);
        if (F.lane == 0) {
            float v0 = -INFINITY, v1 = -INFINITY; int e0 = 0, e1 = 0;
#pragma unroll
            for (int e = 0; e < 8; ++e) { const float lg = rstd * acc[e] + CR[b * 8 + e] + a.router_b[e]; if (lg > v0) { v1 = v0; e1 = e0; v0 = lg; e0 = e; } else if (lg > v1) { v1 = lg; e1 = e; } }
            const float ex = __expf(v1 - v0), p0 = 1.0f / (1.0f + ex), p1 = ex / (1.0f + ex);
            unsigned* cnt = (unsigned*)(F.ws + WS_CTL) + CW_MOECNT;
            const int q0 = (int)atomicAdd(cnt + 64 * e0, 1u), q1 = (int)atomicAdd(cnt + 64 * e1, 1u);
            int* R = (int*)(F.ws + WS_ROUTE) + (size_t)row * 4; R[0] = e0; R[1] = e1; ((float*)R)[2] = p0; ((float*)R)[3] = p1;
            int* Pq = (int*)(F.ws + WS_POS) + (size_t)row * 2; Pq[0] = q0; Pq[1] = q1;
            int* RM = (int*)(F.ws + WS_RMAP); RM[(size_t)e0 * T + q0] = row; RM[(size_t)e1 * T + q1] = row;
        }
    }
    __syncthreads();
}

__global__ void __launch_bounds__(NTHREADS, 2) fwd(Args a) {
    extern __shared__ __attribute__((aligned(16))) unsigned char lds_raw[];
    Frame F;
    F.lds = (LAS unsigned char*)lds_raw;
    F.tid = threadIdx.x; F.lane = F.tid & 63; F.wave = __builtin_amdgcn_readfirstlane(F.tid >> 6);
    F.bid = blockIdx.x; F.nb = gridDim.x; F.gw = F.bid * NWAVES + F.wave; F.ngw = F.nb * NWAVES; F.ws = (GAS unsigned char*)a.ws;
    volatile LAS unsigned* MISC = (volatile LAS unsigned*)(F.lds + MISC_OFF);
    for (int u = F.tid; u < 32; u += NTHREADS) MISC[u] = 0u;
    __syncthreads();
    unsigned* ctl = (unsigned*)(a.ws + WS_CTL);
    const int lo = a.ph_lo, hi = a.ph_hi;
    const bool multi = (hi - lo) > 1;
    XcdBarrier bar; bar.bar = ctl + CW_BAR; bar.x = 0; bar.st = MISC + 8;
    if (multi) bar = xcd_barrier_post(ctl + CW_BAR, MISC + 8);
#define IN(k) (lo <= (k) && (k) < hi && (frame_refresh(F, a, (LAS unsigned char*)lds_raw), true))
#define SEAM(k) do { if (hi > (k) + 1 && lo <= (k)) { xcd_barrier(bar); if constexpr ((PROBE_MASK & 4194304) != 0) xcd_barrier(bar); } } while (0)
    float* MOD = (float*)(a.ws + WS_MOD);
    bf16_t* H = (bf16_t*)(a.ws + WS_H); bf16_t* PROJ = (bf16_t*)(a.ws + WS_PROJ); bf16_t* YMIX = (bf16_t*)(a.ws + WS_YMIX);
    bf16_t* WT = (bf16_t*)(a.ws + WS_WT);
    bf16_t* ACT = (bf16_t*)(a.ws + WS_ACT); bf16_t* ACTM = (bf16_t*)(a.ws + WS_ACTM); bf16_t* YMOE = (bf16_t*)(a.ws + WS_YMOE);

    if (IN(PH_PRO)) { REP(1) { ph_pro_vectors(a, F); ph_pro_weights(a, F); } SEAM(PH_PRO); }

#define TWICE(bit, stmt) do { stmt; if constexpr ((PROBE_MASK & (bit)) != 0) { stmt; } } while (0)
    float* AV = (float*)(a.ws + WS_AV); float* SSQ = (float*)(a.ws + WS_SSQ); bf16_t* X16 = (bf16_t*)(a.ws + WS_X16);
    const LAS float* RSL = (const LAS float*)(F.lds + RS_OFF);
#define LAYER_BODY(l) {\
        const int pb = PH_LAYER0 + PH_PER_LAYER * l; \
        const float* xin = (l == 0) ? a.x : a.out; \
        const float* mod0 = MOD + (size_t)(l * 2 + 0) * 2 * 3072; const float* mod1 = MOD + (size_t)(l * 2 + 1) * 2 * 3072; \
        if (l == 0) { if (IN(pb + K_NORM1)) { REP(2) ph_norm0(a, F); ph_prep_vectors(a, F); SEAM(pb + K_NORM1); } } \
        if (IN(pb + K_GEMM_IN)) { \
            TWICE(4, ({ pg8::Gemm g{H, WT + WT_WIN + (size_t)l * NPW * D, D}; pg8::StaticOrder S; S.init(T, NPW, F.nb, F.bid); rstd_preload(F, S, SSQ + (size_t)(l == 0 ? 3 : 1) * T * 16, nullptr); \
                pg8::EpiProjNorm E{PROJ, RSL, (const float*)(a.ws + (l == 0 ? WS_CVI0 : WS_CVI)), (float*)(a.ws + WS_BG), a.dn_a_log + 4 * l, a.dn_dt_bias + 4 * l}; \
                pg8::gemm_phase<pg8::EpiProjNorm, pg8::StaticOrder, false, true, true>(F.lds, nullptr, g, S, E); })); \
            SEAM(pb + K_GEMM_IN); \
        } \
        if (IN(pb + K_DN_PREP)) { REP(8) ph_dn_chunk(a, F, l); ph_rope(a, F); SEAM(pb + K_DN_PREP); } \
        if (IN(pb + K_MIX)) { REP(16) ph_dn_scan(a, F); REP(512) ph_attn_mfma(a, F, l); REP(1024) ph_conv_fast(a, F, l); SEAM(pb + K_MIX); } \
        if (IN(pb + K_DN_OUT)) { REP(32) ph_dn_out(a, F, l); SEAM(pb + K_DN_OUT); } \
        if (IN(pb + K_GEMM_OUT)) { \
            TWICE(0, ({ pg8::Gemm g{YMIX, WT + WT_WOUT + (size_t)l * D * D, D}; pg8::StaticOrder S; S.init(T, D, F.nb, F.bid); \
                pg8::EpiResidNorm E{X16, X16, mod0 + 2048, AV + (size_t)(l == 0 ? 0 : 2) * BATCH * D, H, SSQ + (size_t)(l == 0 ? 0 : 2) * T * 16}; \
                pg8::gemm_phase<pg8::EpiResidNorm, pg8::StaticOrder, false, true, true>(F.lds, nullptr, g, S, E); })); \
            if constexpr ((PROBE_MASK & 8388608) != 0 && l == 0) { pg8::Gemm g{YMIX, WT + WT_WOUT + (size_t)l * D * D, D}; pg8::StaticOrder S; S.init(T, D, F.nb, F.bid); pg8::EpiBf16 E{(bf16_t*)(a.ws + WS_DN_MR), D, 1 << 20}; \
                pg8::gemm_phase<pg8::EpiBf16, pg8::StaticOrder, false, true, true>(F.lds, nullptr, g, S, E); } \
            if constexpr ((PROBE_MASK & 16777216) != 0 && l == 0) { pg8::Gemm g{YMIX, WT + WT_WOUT + (size_t)l * D * D, D}; pg8::StaticOrder S; S.init(T, D, F.nb, F.bid); \
                pg8::EpiResidNorm E{X16, (bf16_t*)(a.ws + WS_DN_MR), mod0 + 2048, AV, (bf16_t*)(a.ws + WS_DN_MR), (float*)(a.ws + WS_DN_ST)}; \
                pg8::gemm_phase<pg8::EpiResidNorm, pg8::StaticOrder, false, true, true>(F.lds, nullptr, g, S, E); } \
            if constexpr ((PROBE_MASK & 131072) != 0 && l == 0) { pg8::Gemm g{YMIX, WT + WT_WOUT + (size_t)l * D * D, D}; pg8::StaticOrder S; S.init(T, D, F.nb, F.bid); pg8::EpiNull E{}; \
                pg8::gemm_phase<pg8::EpiNull, pg8::StaticOrder, false, true, true>(F.lds, nullptr, g, S, E); } \
            SEAM(pb + K_GEMM_OUT); \
        } \
        if (l == 0) { \
            if (IN(pb + K_FFN1)) { \
                TWICE(256, ({ pg8::Gemm g{H, WT + WT_FGU, D}; pg8::StaticOrder S; S.init(T, 2 * D_FF, F.nb, F.bid); rstd_preload(F, S, SSQ, nullptr); \
                    pg8::EpiSwiGLUNorm E{ACT, D_FF, 1 << 20, RSL, (const float*)(a.ws + WS_CVF), 5632}; \
                    pg8::gemm_phase<pg8::EpiSwiGLUNorm, pg8::StaticOrder, false, true, true>(F.lds, nullptr, g, S, E); })); \
                SEAM(pb + K_FFN1); \
            } \
            if (IN(pb + K_FFN2)) { \
                { pg8::Gemm g{ACT, WT + WT_FD, D_FF}; pg8::StaticOrder S; S.init(T, D, F.nb, F.bid); \
                    pg8::EpiResidNorm E{X16, X16, mod1 + 2048, AV + (size_t)1 * BATCH * D, H, SSQ + (size_t)1 * T * 16}; \
                    pg8::gemm_phase<pg8::EpiResidNorm, pg8::StaticOrder, false, true, true>(F.lds, nullptr, g, S, E); } \
                SEAM(pb + K_FFN2); \
            } \
        } else { \
            if (IN(pb + K_NORM2)) { ph_router(a, F); SEAM(pb + K_NORM2); } \
            if (IN(pb + K_FFN1)) { \
                TWICE(2048, ({ pg8::MoeOrder<8> S; moe_order_init<8>(F, S); moe_ri_preload<8>(F, S); rstd_preload(F, S, SSQ + (size_t)2 * T * 16, (const LAS int*)(F.lds + RI_OFF)); \
                    pg8::Gemm g{H, WT + WT_MGU, D}; pg8::EpiSwiGLUNorm E{ACTM, D_FFE, 8, RSL, (const float*)(a.ws + WS_CVM), 16384}; \
                    pg8::gemm_phase<pg8::EpiSwiGLUNorm, pg8::MoeOrder<8>, true, true, true>(F.lds, (const LAS int*)(F.lds + RI_OFF), g, S, E); })); \
                SEAM(pb + K_FFN1); \
            } \
            if (IN(pb + K_FFN2)) { \
                TWICE(4096, ({ pg8::MoeOrder<4> S; moe_order_init<4>(F, S); \
                    pg8::Gemm g{ACTM, WT + WT_MD, D_FFE}; pg8::EpiBf16W E{YMOE, D, 4}; \
                    pg8::gemm_phase<pg8::EpiBf16W, pg8::MoeOrder<4>, false, true, true>(F.lds, nullptr, g, S, E); })); \
                SEAM(pb + K_FFN2); \
            } \
        } \
    }
    LAYER_BODY(0)
    LAYER_BODY(1)
#undef LAYER_BODY
    if (IN(PH_FINAL)) { ph_final(a, F); }
#undef IN
#undef SEAM
}

extern "C" void kernel_launch(void* const* d_in, const int* in_sizes, int n_in, void* d_out, int out_size, void* d_ws, size_t ws_size, hipStream_t stream) {
    static int grid = 0;
    if (grid == 0) {
        if (n_in != 27 || out_size != T * D || ws_size < WS_END) { fprintf(stderr, "kernel_launch: unexpected shapes n_in %d out %d ws %zu\n", n_in, out_size, ws_size); grid = -1; return; }
        int dev = 0, cus = 0, per_cu = 0;
        if (hipGetDevice(&dev) != hipSuccess || hipDeviceGetAttribute(&cus, hipDeviceAttributeMultiprocessorCount, dev) != hipSuccess) { grid = -1; return; }
        if (hipFuncSetAttribute((const void*)fwd, hipFuncAttributeMaxDynamicSharedMemorySize, LDS_BYTES) != hipSuccess) { fprintf(stderr, "kernel_launch: hipFuncSetAttribute failed\n"); grid = -1; return; }
        if (hipOccupancyMaxActiveBlocksPerMultiprocessor(&per_cu, (const void*)fwd, NTHREADS, LDS_BYTES) != hipSuccess || per_cu < 1) fprintf(stderr, "kernel_launch: occupancy query says %d\n", per_cu);
        (void)hipGetLastError();
        grid = cus;
    }
    if (grid < 0) return;
    (void)hipMemsetAsync((char*)d_ws + WS_CTL, 0, CTL_ZERO_BYTES, stream);
    Args a{};
    const void** pp = (const void**)&a;
    for (int i = 0; i < 27; ++i) pp[i] = d_in[i];
    a.out = (float*)d_out; a.ws = (unsigned char*)d_ws;
#if MK_ONE_LAUNCH
    a.ph_lo = 0; a.ph_hi = NPH;
    hipLaunchKernelGGL(fwd, dim3(grid), dim3(NTHREADS), LDS_BYTES, stream, a);
#else
    static const int phases[] = {0, 1, 2, 3, 4, 5, 6, 7, 9, 10, 11, 12, 13, 14, 15, 16, 17, 18, 19, 20, 21};
    for (int p : phases) { a.ph_lo = p; a.ph_hi = p + 1; hipLaunchKernelGGL(fwd, dim3(grid), dim3(NTHREADS), LDS_BYTES, stream, a); }
#endif
}
```

```cpp
#include <hip/hip_runtime.h>
#include <cstdio>
#include <cstdint>

#define LAS __attribute__((address_space(3)))
#define GAS __attribute__((address_space(1)))
typedef unsigned short bf16_t;
typedef float f32x4 __attribute__((ext_vector_type(4)));
typedef unsigned u32x2 __attribute__((ext_vector_type(2)));
typedef unsigned u32x4 __attribute__((ext_vector_type(4)));

#ifndef GEMM_MASK
#define GEMM_MASK 63
#endif
#ifndef ATTN_MFMA
#define ATTN_MFMA 1
#endif
#ifndef DN_CHUNKED
#define DN_CHUNKED 1
#endif
#ifndef CONV_FAST
#define CONV_FAST 1
#endif
#ifndef PROBE_MASK
#define PROBE_MASK 0
#endif
#define REP(bit) for (int rep_ = 0; rep_ < ((PROBE_MASK & (bit)) ? 2 : 1); ++rep_)
#ifndef MK_ONE_LAUNCH
#define MK_ONE_LAUNCH 1
#endif

constexpr int BATCH = 2, SEQ = 16384, T = BATCH * SEQ, D = 1024, DEPTH = 2;
constexpr int NPW = 2560;
constexpr int N_IN = 2312, NP = 2304;
constexpr int C_AQ = 0, C_AK = 512, C_AV = 640, C_DQ = 768, C_DK = 1024, C_DV = 1280, C_DZ = 1536, C_CA = 1792, C_CB = 2048;
constexpr int W_DB = 1536;
constexpr int D_FF = 2816, NE = 8, D_FFE = 1024;
constexpr int WINDOW = 128, CV_K = 31, CV_C = 256, DN_CONV = 4;
constexpr float EPS = 1e-6f;
constexpr int NSCAN = BATCH * 4 * 4;
constexpr int MOE_CAP = 67584;

constexpr size_t MiB = 1u << 20;
constexpr size_t WS_CTL = 0, CTL_ZERO_BYTES = 1 * MiB;
constexpr size_t WS_MOD = 1 * MiB;
constexpr size_t WS_CS = 2 * MiB;
constexpr size_t WS_BG = 4 * MiB;
constexpr size_t WS_ROUTE = 5 * MiB;
constexpr size_t WS_POS = 6 * MiB;
constexpr size_t WS_RMAP = 7 * MiB;
constexpr size_t WS_WT = 8 * MiB;
constexpr size_t WS_H = 88 * MiB;
constexpr size_t WS_PROJ = 152 * MiB;
constexpr size_t WS_YMIX = 296 * MiB;
constexpr size_t WS_DNQKV = 360 * MiB;
constexpr size_t WS_ODN = 456 * MiB;
constexpr size_t WS_ACT = 152 * MiB;
constexpr size_t WS_ACTM = 152 * MiB;
constexpr size_t WS_YMOE = 284 * MiB;
constexpr size_t WS_X16 = 440 * MiB;
constexpr size_t WS_SSQ = 504 * MiB;
constexpr size_t WS_AV = WS_MOD + 128 * 1024;
constexpr size_t WS_CVF = WS_MOD + 256 * 1024;
constexpr size_t WS_CVI = WS_CVF + 2 * 5632 * 4;
constexpr size_t WS_CVM = WS_CVI + 2 * 2560 * 4;
constexpr size_t WS_CR = WS_CVM + 2 * 16384 * 4;
constexpr size_t WS_CVI0 = WS_CR + 64;
static_assert(WS_CVI0 + 2 * 2560 * 4 <= WS_CS, "vector area");
constexpr size_t WS_END = 512 * MiB;
constexpr int CW_BAR = 4096;
constexpr int CW_MOECNT = 16384;

constexpr int NWAVES = 8, NTHREADS = 512;
constexpr int LDS_BYTES = 163840;
constexpr int MISC_OFF = 131072 + 320;
constexpr int RI_OFF = 132096;
constexpr int RS_OFF = 147456;

constexpr int PH_PRO = 0, PH_LAYER0 = 1, PH_PER_LAYER = 10, PH_FINAL = 21, NPH = 22;
enum { K_NORM1 = 0, K_GEMM_IN, K_DN_PREP, K_MIX, K_DN_OUT, K_GEMM_OUT, K_NORM2, K_MOE_LIST, K_FFN1, K_FFN2 };

struct Args {
    const float* x; const float* c; const int* pos; const float* ada_w; const float* ada_b; const float* nmg; const float* nfg;
    const float* w_in; const float* sinks; const float* dn_conv_w; const float* dn_a_log; const float* dn_dt_bias; const float* dn_norm_g;
    const float* cv_dw_w; const float* cv_dw_b; const float* cv_ln_g; const float* cv_ln_b; const float* w_out;
    const float* ffn_wg; const float* ffn_wu; const float* ffn_wd; const float* router_w; const float* router_b;
    const float* moe_wg; const float* moe_wu; const float* moe_wd; const float* final_g;
    float* out; unsigned char* ws; int ph_lo, ph_hi;
};

__device__ __forceinline__ float bf2f(unsigned u) { return __uint_as_float(u << 16); }
__device__ __forceinline__ unsigned f2bf(float f) { unsigned u = __float_as_uint(f); return (u + 0x7fffu + ((u >> 16) & 1u)) >> 16; }
__device__ __forceinline__ unsigned pk2(float lo, float hi) { return f2bf(lo) | (f2bf(hi) << 16); }
__device__ __forceinline__ float wave_sum(float v) {
#pragma unroll
    for (int o = 1; o < 64; o <<= 1) v += __shfl_xor(v, o);
    return v;
}
__device__ __forceinline__ float wave_max(float v) {
#pragma unroll
    for (int o = 1; o < 64; o <<= 1) v = fmaxf(v, __shfl_xor(v, o));
    return v;
}
__device__ __forceinline__ float sigmoidf_(float x) { return __builtin_amdgcn_rcpf(1.0f + __builtin_amdgcn_exp2f(x * -1.4426950408889634f)); }
__device__ __forceinline__ float siluf_(float x) { return x * __builtin_amdgcn_rcpf(1.0f + __builtin_amdgcn_exp2f(x * -1.4426950408889634f)); }
__device__ __forceinline__ float softplusf_(float x) { return fmaxf(x, 0.f) + log1pf(__expf(-fabsf(x))); }

#define XB_TMO      128
#define XB_XCNT(j)  (256  + 64 * (j))
#define XB_XSUB(j)  (1280 + 64 * (j))
#define XB_XGEN(j)  (2304 + 64 * (j))
#define XB_TOP      3328
#define XB_TOPGEN   3392
#define XCD_BAR_WORDS 3456
#define XB_SPIN_CAP (1u << 18)

__device__ __forceinline__ unsigned xb_ld(unsigned* p)              { return __hip_atomic_load(p, __ATOMIC_RELAXED, __HIP_MEMORY_SCOPE_AGENT); }
__device__ __forceinline__ unsigned xb_add(unsigned* p, unsigned v) { return __hip_atomic_fetch_add(p, v, __ATOMIC_RELAXED, __HIP_MEMORY_SCOPE_AGENT); }
__device__ __forceinline__ unsigned xb_xcc_id() { return (unsigned)__builtin_amdgcn_s_getreg((3 << 11) | 20) & 0xFu; }
#define XB_SPIN(cond, bar) do { unsigned _sp = 0; while (cond) { __builtin_amdgcn_s_sleep(1); \
    if ((++_sp & 255u) == 0u) { if (xb_ld(&(bar)[XB_TMO])) break; if (_sp > XB_SPIN_CAP) { atomicAdd(&(bar)[XB_TMO], 1u); break; } } } } while (0)

struct XcdBarrier { unsigned* bar; unsigned x; volatile LAS unsigned* st; };

__device__ __forceinline__ XcdBarrier xcd_barrier_post(unsigned* bar, volatile LAS unsigned* st) {
    XcdBarrier b; b.bar = bar; b.x = xb_xcc_id(); b.st = st;
    if (threadIdx.x == 0) (void)xb_add(&bar[XB_XCNT(b.x)], 1u);
    return b;
}
__device__ __forceinline__ void xcd_barrier_complete(unsigned* bar, unsigned x, unsigned& nloc, unsigned& nx) {
    const unsigned G = gridDim.x * gridDim.y * gridDim.z;
    unsigned sum, cnt, mine, sp = 0u;
    for (;;) {
        sum = 0u; cnt = 0u; mine = 0u;
#pragma unroll
        for (unsigned j = 0; j < 16; ++j) { const unsigned c = xb_ld(&bar[XB_XCNT(j)]); sum += c; cnt += (c > 0u) ? 1u : 0u; mine = (j == x) ? c : mine; }
        if (sum == G) break;
        __builtin_amdgcn_s_sleep(1);
        if ((++sp & 255u) == 0u) { if (xb_ld(&bar[XB_TMO])) break; if (sp > XB_SPIN_CAP) { atomicAdd(&bar[XB_TMO], 1u); break; } }
    }
    nloc = mine > 0u ? mine : 1u; nx = cnt > 0u ? cnt : 1u;
}
__device__ __forceinline__ void xcd_barrier(const XcdBarrier& b) {
    asm volatile("s_waitcnt vmcnt(0)" ::: "memory");
    __syncthreads();
    if (threadIdx.x == 0) {
        unsigned* bar = b.bar;
        __builtin_amdgcn_s_waitcnt(0);
        unsigned nloc = b.st[0], nx = b.st[1];
        if (nloc == 0u) { xcd_barrier_complete(bar, b.x, nloc, nx); b.st[0] = nloc; b.st[1] = nx; }
        const unsigned old = xb_add(&bar[XB_XSUB(b.x)], 1u);
        const unsigned gen = old / nloc;
        if (old + 1u == (gen + 1u) * nloc) {
            __builtin_amdgcn_fence(__ATOMIC_RELEASE, "agent");
            asm volatile("s_waitcnt vmcnt(0)" ::: "memory");
            const unsigned og = xb_add(&bar[XB_TOP], 1u);
            const unsigned tg = og / nx;
            if (og + 1u == (tg + 1u) * nx) xb_add(&bar[XB_TOPGEN], 1u);
            else XB_SPIN(xb_ld(&bar[XB_TOPGEN]) == tg, bar);
            __builtin_amdgcn_fence(__ATOMIC_ACQUIRE, "agent");
            xb_add(&bar[XB_XGEN(b.x)], 1u);
            asm volatile("s_waitcnt vmcnt(0)" ::: "memory");
        } else {
            XB_SPIN(xb_ld(&bar[XB_XGEN(b.x)]) == gen, bar);
            __builtin_amdgcn_fence(__ATOMIC_ACQUIRE, "agent");
            asm volatile("s_waitcnt vmcnt(0)" ::: "memory");
        }
    }
    __syncthreads();
}

struct Frame {
    LAS unsigned char* lds;
    int tid, lane, wave, gw, ngw, bid, nb;
    GAS unsigned char* ws;
};

__device__ __forceinline__ void frame_refresh(Frame& F, const Args& a, LAS unsigned char* lds) {
    int tid = threadIdx.x; asm volatile("" : "+v"(tid));
    int bid = blockIdx.x; asm volatile("" : "+s"(bid));
    unsigned char* ws = a.ws; asm volatile("" : "+s"(ws));
    F.lds = lds; F.tid = tid; F.lane = tid & 63; F.wave = __builtin_amdgcn_readfirstlane(tid >> 6);
    F.bid = bid; F.nb = gridDim.x; F.gw = F.bid * NWAVES + F.wave; F.ngw = F.nb * NWAVES; F.ws = (GAS unsigned char*)ws;
}
__device__ __forceinline__ void ph_pro_vectors(const Args& a, Frame& F) {
    float* MOD = (float*)(F.ws + WS_MOD);
    LAS float* red = (LAS float*)F.lds;
    for (int it = F.bid; it < 4 * 48; it += F.nb) {
        const int lk = it / 48, cg = it % 48, e = cg * 64 + F.lane;
        const float* W = a.ada_w + (size_t)lk * D * 3072 + e;
        float a0 = 0.f, a1 = 0.f;
        const int d0 = F.wave * 128;
#pragma unroll 8
        for (int d = d0; d < d0 + 128; ++d) {
            const float w = __builtin_nontemporal_load(W + (size_t)d * 3072);
            a0 += siluf_(a.c[d]) * w; a1 += siluf_(a.c[D + d]) * w;
        }
        red[(F.wave * 2 + 0) * 64 + F.lane] = a0; red[(F.wave * 2 + 1) * 64 + F.lane] = a1;
        __syncthreads();
        if (F.wave < 2) {
            float s = 0.f;
            for (int w = 0; w < 8; ++w) s += red[(w * 2 + F.wave) * 64 + F.lane];
            MOD[((size_t)lk * 2 + F.wave) * 3072 + e] = s + a.ada_b[lk * 3072 + e];
        }
        __syncthreads();
    }
    float* CS = (float*)(F.ws + WS_CS);
    for (int idx = F.bid * NTHREADS + F.tid; idx < T * 8; idx += F.nb * NTHREADS) {
        const int t = idx >> 3, i = idx & 7;
        const float inv = powf(500000.0f, -(float)(2 * i) / 16.0f);
        const float ang = (float)a.pos[t] * inv;
        CS[t * 16 + i] = cosf(ang); CS[t * 16 + 8 + i] = sinf(ang);
    }
}

template <int MODE>
__device__ __forceinline__ void ph_norm(const Args& a, Frame& F, int l, const float* xin, const float* gain, const float* modk  ,
                                        const float* W8, int pitch) {
    bf16_t* H = (bf16_t*)(F.ws + WS_H);
    LAS float* W8T = (LAS float*)F.lds;
    if (MODE != 0) {
        for (int i = F.tid; i < 8192; i += NTHREADS) { const int d = i >> 3, j = i & 7; W8T[j * 1024 + d] = W8[(size_t)d * pitch + j]; }
        __syncthreads();
    }
    f32x4 vn[4], A4[4], B4[4]; int cur_b = -1;
    if (F.gw < T) {
#pragma unroll
        for (int j = 0; j < 4; ++j) vn[j] = ((const f32x4*)(xin + (size_t)F.gw * D) + F.lane)[64 * j];
    }
    for (int row = F.gw; row < T; row += F.ngw) {
        const int b = row / SEQ;
        f32x4 v[4]; float ss = 0.f;
#pragma unroll
        for (int j = 0; j < 4; ++j) { v[j] = vn[j]; ss += (v[j].x * v[j].x + v[j].y * v[j].y) + (v[j].z * v[j].z + v[j].w * v[j].w); }
        if (row + F.ngw < T) {
#pragma unroll
            for (int j = 0; j < 4; ++j) vn[j] = ((const f32x4*)(xin + (size_t)(row + F.ngw) * D) + F.lane)[64 * j];
        }
        if (b != cur_b) {
            cur_b = b; const float* sh = modk + (size_t)b * 3072; const float* sc = sh + 1024;
#pragma unroll
            for (int j = 0; j < 4; ++j) { const int d = 256 * j + 4 * F.lane; A4[j] = *(const f32x4*)(gain + d) * (*(const f32x4*)(sc + d) + 1.0f); B4[j] = *(const f32x4*)(sh + d); }
        }
        const float rstd = rsqrtf(wave_sum(ss) * (1.0f / D) + EPS);
        float acc[8];
#pragma unroll
        for (int e = 0; e < 8; ++e) acc[e] = 0.f;
#pragma unroll
        for (int j = 0; j < 4; ++j) {
            const int d = 256 * j + 4 * F.lane;
            const f32x4 hv = (v[j] * rstd) * A4[j] + B4[j];
            u32x2 o; o.x = pk2(hv.x, hv.y); o.y = pk2(hv.z, hv.w);
            *(u32x2*)(H + (size_t)row * D + d) = o;
            if (MODE == 1) { u32x2 xo; xo.x = pk2(v[j].x, v[j].y); xo.y = pk2(v[j].z, v[j].w); *(u32x2*)((bf16_t*)(F.ws + WS_X16) + (size_t)row * D + d) = xo; }
            if (MODE != 0) {
#pragma unroll
                for (int e = 0; e < 8; ++e) { const f32x4 w4 = *(const LAS f32x4*)(W8T + e * 1024 + d); acc[e] += (hv.x * w4.x + hv.y * w4.y) + (hv.z * w4.z + hv.w * w4.w); }
            }
        }
        if (MODE != 0) {
#pragma unroll
            for (int e = 0; e < 8; ++e) acc[e] = wave_sum(acc[e]);
        }
        if (MODE == 1 && F.lane == 0) {
            float* BG = (float*)(F.ws + WS_BG) + (size_t)row * 8;
#pragma unroll
            for (int h = 0; h < 4; ++h) {
                BG[h] = sigmoidf_(acc[h]);
                BG[4 + h] = -__expf(a.dn_a_log[l * 4 + h]) * softplusf_(acc[4 + h] + a.dn_dt_bias[l * 4 + h]);
            }
        }
        if (MODE == 2 && F.lane == 0) {
            float v0 = -INFINITY, v1 = -INFINITY; int e0 = 0, e1 = 0;
#pragma unroll
            for (int e = 0; e < 8; ++e) { const float lg = acc[e] + a.router_b[e]; if (lg > v0) { v1 = v0; e1 = e0; v0 = lg; e0 = e; } else if (lg > v1) { v1 = lg; e1 = e; } }
            const float ex = __expf(v1 - v0), p0 = 1.0f / (1.0f + ex), p1 = ex / (1.0f + ex);
            unsigned* cnt = (unsigned*)(F.ws + WS_CTL) + CW_MOECNT;
            const int q0 = (int)atomicAdd(cnt + 64 * e0, 1u), q1 = (int)atomicAdd(cnt + 64 * e1, 1u);
            int* R = (int*)(F.ws + WS_ROUTE) + (size_t)row * 4; R[0] = e0; R[1] = e1; ((float*)R)[2] = p0; ((float*)R)[3] = p1;
            int* P = (int*)(F.ws + WS_POS) + (size_t)row * 2; P[0] = q0; P[1] = q1;
        }
    }
    if (MODE != 0) __syncthreads();
}

typedef float f32x16 __attribute__((ext_vector_type(16)));
typedef short s16x4 __attribute__((ext_vector_type(4)));
typedef short bf16x8_t __attribute__((ext_vector_type(8)));
__device__ __forceinline__ unsigned cvtpk(float lo, float hi) { typedef float f2_t __attribute__((ext_vector_type(2))); typedef __bf16 b2_t __attribute__((ext_vector_type(2)));
    f2_t v = {lo, hi}; b2_t b = __builtin_convertvector(v, b2_t); return __builtin_bit_cast(unsigned, b); }
__device__ __forceinline__ void ph_rope(const Args& a, Frame& F) {
    bf16_t* P = (bf16_t*)(F.ws + WS_PROJ); const float* CS = (const float*)(F.ws + WS_CS);
    for (int it = F.bid * NTHREADS + F.tid; it < T * 10; it += F.nb * NTHREADS) {
        const int t = it / 10, hh = it % 10;
        bf16_t* p = P + (size_t)t * NP + hh * 64;
        const u32x4 x1 = *(const u32x4*)p, x2 = *(const u32x4*)(p + 8);
        const f32x4 c0 = *(const f32x4*)(CS + (size_t)t * 16), c1 = *(const f32x4*)(CS + (size_t)t * 16 + 4), s0 = *(const f32x4*)(CS + (size_t)t * 16 + 8), s1 = *(const f32x4*)(CS + (size_t)t * 16 + 12);
        const float cs[8] = {c0.x, c0.y, c0.z, c0.w, c1.x, c1.y, c1.z, c1.w}, sn[8] = {s0.x, s0.y, s0.z, s0.w, s1.x, s1.y, s1.z, s1.w};
        const unsigned xa[4] = {x1.x, x1.y, x1.z, x1.w}, xb[4] = {x2.x, x2.y, x2.z, x2.w};
        unsigned ra[4], rb[4];
#pragma unroll
        for (int i = 0; i < 4; ++i) {
            const float a0 = bf2f(xa[i] & 0xffffu), a1 = bf2f(xa[i] >> 16), b0 = bf2f(xb[i] & 0xffffu), b1 = bf2f(xb[i] >> 16);
            ra[i] = pk2(a0 * cs[2 * i] - b0 * sn[2 * i], a1 * cs[2 * i + 1] - b1 * sn[2 * i + 1]);
            rb[i] = pk2(b0 * cs[2 * i] + a0 * sn[2 * i], b1 * cs[2 * i + 1] + a1 * sn[2 * i + 1]);
        }
        *(u32x4*)p = (u32x4){ra[0], ra[1], ra[2], ra[3]}; *(u32x4*)(p + 8) = (u32x4){rb[0], rb[1], rb[2], rb[3]};
    }
}
constexpr int AT_KROW = 144, AT_VOFF = 256 * AT_KROW;
__device__ __forceinline__ void ph_attn_mfma(const Args& a, Frame& F, int l) {
    const bf16_t* P = (const bf16_t*)(F.ws + WS_PROJ); bf16_t* Y = (bf16_t*)(F.ws + WS_YMIX);
    LAS unsigned char* Kl = F.lds; LAS unsigned char* Vl = F.lds + AT_VOFF;
    const int lane = F.lane, r = lane & 31, h = lane >> 5, g = F.wave >> 1, qh = F.wave & 1;
    const int i16 = lane & 15, tq_ = i16 >> 2, tp_ = i16 & 3, g16 = (lane >> 4) & 1, sw = (tq_ >> 1) & 1;
    const int vlane = (4 * h + tq_) * 128 + (2 * g16 + (tp_ >> 1)) * 16 + (tp_ & 1) * 8;
    const float C = 0.125f * 1.4426950408889634f;
    const int nsc = NSCAN;
    if (F.bid < nsc) return;
    u32x4 kreg[4], vreg[4];
#define AT_LOAD(uu) { const int hk_ = (uu) & 1, n_ = ((uu) >> 1) & 127, b_ = (uu) >> 8, tk0_ = b_ * SEQ + n_ * 128 - 128; \
        _Pragma("unroll") for (int i = 0; i < 4; ++i) { const int piece = F.tid + NTHREADS * i, key = piece >> 3, c = piece & 7; \
            const bf16_t* rowp = P + (size_t)(tk0_ + ((n_ > 0 || key >= 128) ? key : key + 128)) * NP; \
            kreg[i] = *(const u32x4*)(rowp + C_AK + hk_ * 64 + c * 8); vreg[i] = *(const u32x4*)(rowp + C_AV + hk_ * 64 + c * 8); } }
    if (F.bid - nsc < BATCH * 128 * 2) AT_LOAD(F.bid - nsc)
    for (int u = F.bid - nsc; u < BATCH * 128 * 2; u += F.nb - nsc) {
        const int hk = u & 1, n = (u >> 1) & 127, b = u >> 8;
        const int tq0 = b * SEQ + n * 128;
        __syncthreads();
#pragma unroll
        for (int i = 0; i < 4; ++i) {
            const int piece = F.tid + NTHREADS * i, key = piece >> 3, c = piece & 7;
            const bool ok = (n > 0 || key >= 128);
            const u32x4 z4 = (u32x4){0u, 0u, 0u, 0u};
            *(LAS u32x4*)(Kl + key * AT_KROW + c * 16) = ok ? kreg[i] : z4;
            *(LAS u32x4*)(Vl + key * 128 + ((c ^ (((key >> 1) & 1) << 2)) * 16)) = ok ? vreg[i] : z4;
        }
        __syncthreads();
        if (u + (F.nb - nsc) < BATCH * 128 * 2) AT_LOAD(u + (F.nb - nsc))
        asm volatile("" ::: "memory");
        const int hq = hk * 4 + g;
        const float sinkl = a.sinks[l * 8 + hq] * 1.4426950408889634f;
#pragma unroll 1
        for (int sb = 0; sb < 2; ++sb) {
            const int q0 = qh * 64 + sb * 32, kt0 = qh * 2 + sb;
            const size_t tq = (size_t)(tq0 + q0 + r);
            bf16x8_t qf[4];
#pragma unroll
            for (int ks = 0; ks < 4; ++ks) qf[ks] = *(const bf16x8_t*)(P + tq * NP + hq * 64 + 16 * ks + 8 * h);
            f32x16 S[5];
#pragma unroll
            for (int kr = 0; kr < 5; ++kr) {
                f32x16 acc;
#pragma unroll
                for (int i = 0; i < 16; ++i) acc[i] = 0.f;
#pragma unroll
                for (int ks = 0; ks < 4; ++ks) { const bf16x8_t kf = *(const LAS bf16x8_t*)(Kl + (32 * (kt0 + kr) + r) * AT_KROW + (16 * ks + 8 * h) * 2);
                    acc = __builtin_amdgcn_mfma_f32_32x32x16_bf16(kf, qf[ks], acc, 0, 0, 0); }
                S[kr] = acc;
            }
            float m = sinkl;
#pragma unroll
            for (int kr = 0; kr < 5; ++kr) {
                const bool tile_ok = !(n == 0 && (kt0 + kr) < 4);
#pragma unroll
                for (int i = 0; i < 16; ++i) {
                    const int kl = (i & 3) + 8 * (i >> 2) + 4 * h;
                    bool ok = tile_ok; if (kr == 0) ok = ok && (kl > r); if (kr == 4) ok = ok && (kl <= r);
                    const float sv = ok ? S[kr][i] * C : -INFINITY; S[kr][i] = sv; m = fmaxf(m, sv);
                }
            }
            m = fmaxf(m, __shfl_xor(m, 32));
            float lsum = 0.f;
#pragma unroll
            for (int kr = 0; kr < 5; ++kr)
#pragma unroll
                for (int i = 0; i < 16; ++i) { const float p = __builtin_amdgcn_exp2f(S[kr][i] - m); S[kr][i] = p; lsum += p; }
            lsum += __shfl_xor(lsum, 32); lsum += __builtin_amdgcn_exp2f(sinkl - m);
            f32x16 O0, O1;
#pragma unroll
            for (int i = 0; i < 16; ++i) { O0[i] = 0.f; O1[i] = 0.f; }
#pragma unroll
            for (int kr = 0; kr < 5; ++kr) {
#pragma unroll
                for (int s2 = 0; s2 < 2; ++s2) {
                    u32x4 pw; pw.x = cvtpk(S[kr][8 * s2 + 0], S[kr][8 * s2 + 1]); pw.y = cvtpk(S[kr][8 * s2 + 2], S[kr][8 * s2 + 3]); pw.z = cvtpk(S[kr][8 * s2 + 4], S[kr][8 * s2 + 5]); pw.w = cvtpk(S[kr][8 * s2 + 6], S[kr][8 * s2 + 7]);
                    const bf16x8_t pf = __builtin_bit_cast(bf16x8_t, pw);
                    const int kb = (32 * (kt0 + kr) + 16 * s2) * 128 + vlane;
                    const s16x4 lo0 = __builtin_amdgcn_ds_read_tr16_b64_v4i16((LAS s16x4*)(Vl + kb + (0 ^ sw) * 64));
                    const s16x4 hi0 = __builtin_amdgcn_ds_read_tr16_b64_v4i16((LAS s16x4*)(Vl + kb + 8 * 128 + (0 ^ sw) * 64));
                    const s16x4 lo1 = __builtin_amdgcn_ds_read_tr16_b64_v4i16((LAS s16x4*)(Vl + kb + (1 ^ sw) * 64));
                    const s16x4 hi1 = __builtin_amdgcn_ds_read_tr16_b64_v4i16((LAS s16x4*)(Vl + kb + 8 * 128 + (1 ^ sw) * 64));
                    const bf16x8_t va0 = __builtin_shufflevector(lo0, hi0, 0, 1, 2, 3, 4, 5, 6, 7), va1 = __builtin_shufflevector(lo1, hi1, 0, 1, 2, 3, 4, 5, 6, 7);
                    O0 = __builtin_amdgcn_mfma_f32_32x32x16_bf16(va0, pf, O0, 0, 0, 0);
                    O1 = __builtin_amdgcn_mfma_f32_32x32x16_bf16(va1, pf, O1, 0, 0, 0);
                }
            }
            const float inv = __builtin_amdgcn_rcpf(lsum);
            bf16_t* yp = Y + tq * D + hq * 64 + 4 * h;
#pragma unroll
            for (int gq = 0; gq < 4; ++gq) {
                u32x2 o0; o0.x = cvtpk(O0[4 * gq] * inv, O0[4 * gq + 1] * inv); o0.y = cvtpk(O0[4 * gq + 2] * inv, O0[4 * gq + 3] * inv);
                u32x2 o1; o1.x = cvtpk(O1[4 * gq] * inv, O1[4 * gq + 1] * inv); o1.y = cvtpk(O1[4 * gq + 2] * inv, O1[4 * gq + 3] * inv);
                *(u32x2*)(yp + 8 * gq) = o0; *(u32x2*)(yp + 32 + 8 * gq) = o1;
            }
        }
    }
    __syncthreads();
}


#undef AT_LOAD
constexpr size_t WS_DN_MR = 360 * MiB, WS_DN_BNT = 376 * MiB, WS_DN_QP = 392 * MiB, WS_DN_OLT = 408 * MiB, WS_DN_ST = 424 * MiB;
constexpr int DL = 72, LB = 9216;
constexpr int L_KR = 0, L_KT = LB, L_QR = 2 * LB, L_VT = 3 * LB, L_AR = 4 * LB, L_T1 = 5 * LB, L_T2 = 6 * LB, L_UT = 7 * LB, L_UPT = 8 * LB, L_WPT = 9 * LB, L_WT = 0;
constexpr int L_LR = 7 * LB, L_L21 = L_LR + 17408, L_T11T = L_L21 + 4608, L_T22R = L_T11T + 4608, L_YT = L_T22R + 4608, L_GC = 100352, L_BETA = L_GC + 256;
static_assert(L_YT + 4608 == L_GC && L_GC + 512 <= 131072, "DeltaNet LDS map");
template <int KS> __device__ __forceinline__ f32x4 mm16(const LAS unsigned char* lds, int offX, int offY, int tx, int ty, int lane) {
    f32x4 acc = (f32x4){0.f, 0.f, 0.f, 0.f};
    const int l15 = lane & 15, q = lane >> 4;
#pragma unroll
    for (int ks = 0; ks < KS; ++ks) {
        const bf16x8_t xa = *(const LAS bf16x8_t*)(lds + offX + ((16 * tx + l15) * DL + 32 * ks + 8 * q) * 2);
        const bf16x8_t yb = *(const LAS bf16x8_t*)(lds + offY + ((16 * ty + l15) * DL + 32 * ks + 8 * q) * 2);
        acc = __builtin_amdgcn_mfma_f32_16x16x32_bf16(xa, yb, acc, 0, 0, 0);
    }
    return acc;
}
__device__ __forceinline__ u32x2 pack4(f32x4 v) { u32x2 o; o.x = cvtpk(v.x, v.y); o.y = cvtpk(v.z, v.w); return o; }

__device__ __forceinline__ void ph_dn_chunk(const Args& a, Frame& F, int l) {
    const bf16_t* P = (const bf16_t*)(F.ws + WS_PROJ); const float* BG = (const float*)(F.ws + WS_BG);
    bf16_t* MR = (bf16_t*)(F.ws + WS_DN_MR); bf16_t* BNT = (bf16_t*)(F.ws + WS_DN_BNT); bf16_t* QP = (bf16_t*)(F.ws + WS_DN_QP); bf16_t* OLT = (bf16_t*)(F.ws + WS_DN_OLT);
    LAS unsigned char* lds = F.lds;
    LAS float* gcL = (LAS float*)(lds + L_GC); LAS float* betaL = (LAS float*)(lds + L_BETA);
    const float* cw = a.dn_conv_w + (size_t)l * DN_CONV * 768;
    const int lane = F.lane, w = F.wave, l15 = lane & 15, q4 = lane >> 4;
    LAS float* cwL = (LAS float*)(lds + L_GC + 512);
    int cur_h = -1;
    const int ci = F.tid >> 3, c8 = F.tid & 7;
    u32x4 xr[3][4]; float bgb = 0.f, bgg = 0.f;
#define CH_LOAD(vu_) { const int n_ = ((vu_) >> 2) & 255, h_ = (vu_) & 3, b_ = (vu_) >> 10; const int t_ = b_ * SEQ + n_ * 64 + ci; \
        _Pragma("unroll") for (int kd = 0; kd < 3; ++kd) _Pragma("unroll") for (int k = 0; k < DN_CONV; ++k) { \
            const int tt_ = (n_ * 64 + ci - (DN_CONV - 1) + k >= 0) ? t_ - (DN_CONV - 1) + k : t_; xr[kd][k] = *(const u32x4*)(P + (size_t)tt_ * NP + C_DQ + kd * 256 + h_ * 64 + c8 * 8); } \
        if (w == 0) { bgb = BG[(size_t)(b_ * SEQ + n_ * 64 + lane) * 8 + h_]; bgg = BG[(size_t)(b_ * SEQ + n_ * 64 + lane) * 8 + 4 + h_]; } }
    if (F.bid < BATCH * 4 * 256) CH_LOAD(F.bid)
    for (int vu = F.bid; vu < BATCH * 4 * 256; vu += F.nb) {
        const int n = (vu >> 2) & 255, h = vu & 3, b = vu >> 10, unit = (b * 4 + h) * 256 + n;
        const int t0 = b * SEQ + n * 64;
        __syncthreads();
        if (h != cur_h) { cur_h = h;
            for (int idx = F.tid; idx < DN_CONV * 3 * 64; idx += NTHREADS) { const int k = idx / 192, kd = (idx / 64) % 3, cc = idx & 63; cwL[idx] = cw[k * 768 + kd * 256 + h * 64 + cc]; }
            __syncthreads(); }
        {
            const int i = ci, sq = n * 64 + i;
#pragma unroll
            for (int kd = 0; kd < 3; ++kd) {
                float acc[8];
#pragma unroll
                for (int e = 0; e < 8; ++e) acc[e] = 0.f;
#pragma unroll
                for (int k = 0; k < DN_CONV; ++k) {
                    const u32x4 xv = xr[kd][k]; const float vm = (sq - (DN_CONV - 1) + k >= 0) ? 1.f : 0.f;
                    const f32x4 w0 = *(const LAS f32x4*)(cwL + (k * 3 + kd) * 64 + c8 * 8) * vm, w1 = *(const LAS f32x4*)(cwL + (k * 3 + kd) * 64 + c8 * 8 + 4) * vm;
                    acc[0] += w0.x * bf2f(xv.x & 0xffffu); acc[1] += w0.y * bf2f(xv.x >> 16); acc[2] += w0.z * bf2f(xv.y & 0xffffu); acc[3] += w0.w * bf2f(xv.y >> 16);
                    acc[4] += w1.x * bf2f(xv.z & 0xffffu); acc[5] += w1.y * bf2f(xv.z >> 16); acc[6] += w1.z * bf2f(xv.w & 0xffffu); acc[7] += w1.w * bf2f(xv.w >> 16);
                }
                float ss = 0.f;
#pragma unroll
                for (int e = 0; e < 8; ++e) { acc[e] = siluf_(acc[e]); ss += acc[e] * acc[e]; }
                if (kd < 2) {
                    ss += __shfl_xor(ss, 1); ss += __shfl_xor(ss, 2); ss += __shfl_xor(ss, 4);
                    const float rn = rsqrtf(ss + EPS) * (kd == 0 ? 0.125f : 1.0f);
#pragma unroll
                    for (int e = 0; e < 8; ++e) acc[e] *= rn;
                }
                u32x4 pk; pk.x = cvtpk(acc[0], acc[1]); pk.y = cvtpk(acc[2], acc[3]); pk.z = cvtpk(acc[4], acc[5]); pk.w = cvtpk(acc[6], acc[7]);
                if (kd == 0) *(LAS u32x4*)(lds + L_QR + (i * DL + c8 * 8) * 2) = pk;
                if (kd == 1) *(LAS u32x4*)(lds + L_KR + (i * DL + c8 * 8) * 2) = pk;
                if (kd >= 1) {
                    LAS bf16_t* Tt = (LAS bf16_t*)(lds + (kd == 1 ? L_KT : L_VT));
                    const unsigned pw[4] = {pk.x, pk.y, pk.z, pk.w};
#pragma unroll
                    for (int e = 0; e < 8; ++e) Tt[(c8 * 8 + e) * DL + i] = (bf16_t)((pw[e >> 1] >> (16 * (e & 1))) & 0xffffu);
                }
            }
            for (int idx = F.tid; idx < 2 * LB / 16; idx += NTHREADS) *(LAS u32x4*)(lds + L_T1 + idx * 16) = (u32x4){0u, 0u, 0u, 0u};
            if (w == 0) {
                float x = bgg;
#pragma unroll
                for (int o = 1; o < 64; o <<= 1) { const float y = __shfl_up(x, o); if (lane >= o) x += y; }
                gcL[lane] = x; betaL[lane] = bgb;
            }
            if (vu + F.nb < BATCH * 4 * 256) CH_LOAD(vu + F.nb)
            asm volatile("" ::: "memory");
        }
        __syncthreads();
#pragma unroll
        for (int tt = 0; tt < 2; ++tt) {
            const int tidx = 2 * w + tt, tx = tidx >> 2, ty = tidx & 3, i = 16 * ty + l15, j0 = 16 * tx + 4 * q4;
            const float gi = gcL[i], bi = betaL[i]; const f32x4 gj = *(const LAS f32x4*)(gcL + j0);
            const float gjv[4] = {gj.x, gj.y, gj.z, gj.w};
            const f32x4 zk = mm16<2>(lds, L_KR, L_KR, tx, ty, lane);
            const f32x4 zq = mm16<2>(lds, L_KR, L_QR, tx, ty, lane);
            f32x4 lv, av;
#pragma unroll
            for (int r = 0; r < 4; ++r) { const float dc = __expf(fminf(gi - gjv[r], 0.f)); lv[r] = (j0 + r < i) ? bi * zk[r] * dc : 0.f; av[r] = (j0 + r <= i) ? zq[r] * dc : 0.f; }
            *(LAS f32x4*)(lds + L_LR + (i * 68 + j0) * 4) = lv;
            if (i >= 32 && j0 < 32) *(LAS u32x2*)(lds + L_L21 + ((i - 32) * DL + j0) * 2) = pack4(lv);
            *(LAS u32x2*)(lds + L_AR + (i * DL + j0) * 2) = pack4(av);
        }
        __syncthreads();
        REP(32768) {
            const int cg = 8 * w + (lane >> 3), blk = cg >> 5, jp = cg & 31, l8 = lane & 7;
            const LAS float* Lb = (const LAS float*)(lds + L_LR) + (32 * blk) * 68 + 32 * blk + 4 * l8;
            float x0 = 0.f, x1 = 0.f, x2 = 0.f, x3 = 0.f;
#pragma unroll
            for (int i = 0; i < 32; ++i) {
                const f32x4 l4 = *(const LAS f32x4*)(Lb + i * 68);
                float part = (l4.x * x0 + l4.y * x1) + (l4.z * x2 + l4.w * x3);
                part += __shfl_xor(part, 1); part += __shfl_xor(part, 2); part += __shfl_xor(part, 4);
                const float xi = ((i == jp) ? 1.f : 0.f) - part;
                if (l8 == (i >> 2)) { if ((i & 3) == 0) x0 = xi; else if ((i & 3) == 1) x1 = xi; else if ((i & 3) == 2) x2 = xi; else x3 = xi; }
            }
            const int jg = 32 * blk + jp; const float bj = betaL[jg], bej = bj * __expf(gcL[jg]);
            LAS bf16_t* T1 = (LAS bf16_t*)(lds + L_T1); LAS bf16_t* T2 = (LAS bf16_t*)(lds + L_T2);
            const float xs[4] = {x0, x1, x2, x3};
#pragma unroll
            for (int e = 0; e < 4; ++e) { const int rg = 32 * blk + 4 * l8 + e; T1[rg * DL + jg] = (bf16_t)f2bf(xs[e] * bj); T2[rg * DL + jg] = (bf16_t)f2bf(xs[e] * bej); }
            if (blk == 0) { *(LAS u32x2*)(lds + L_T11T + (jp * DL + 4 * l8) * 2) = pack4((f32x4){x0, x1, x2, x3}); }
            else { LAS bf16_t* T22 = (LAS bf16_t*)(lds + L_T22R);
#pragma unroll
                for (int e = 0; e < 4; ++e) T22[(4 * l8 + e) * DL + jp] = (bf16_t)f2bf(xs[e]); }
        }
        __syncthreads();
        if (w < 4) {
            const int tx = w >> 1, ty = w & 1;
            const f32x4 z = mm16<1>(lds, L_L21, L_T11T, tx, ty, lane);
            *(LAS u32x2*)(lds + L_YT + ((16 * ty + l15) * DL + 16 * tx + 4 * q4) * 2) = pack4(z);
        }
        __syncthreads();
        if (w < 4) {
            const int tx = w >> 1, ty = w & 1, y = 16 * ty + l15, x0 = 16 * tx + 4 * q4;
            const f32x4 z = mm16<1>(lds, L_T22R, L_YT, tx, ty, lane);
            const float bj = betaL[y], bej = bj * __expf(gcL[y]);
            LAS bf16_t* T1 = (LAS bf16_t*)(lds + L_T1); LAS bf16_t* T2 = (LAS bf16_t*)(lds + L_T2);
#pragma unroll
            for (int r = 0; r < 4; ++r) { T1[(32 + x0 + r) * DL + y] = (bf16_t)f2bf(-z[r] * bj); T2[(32 + x0 + r) * DL + y] = (bf16_t)f2bf(-z[r] * bej); }
        }
        __syncthreads();
        const float gl = gcL[63];
#pragma unroll
        for (int tt = 0; tt < 2; ++tt) {
            const int tidx = 2 * w + tt, tx = tidx >> 2, ty = tidx & 3, y = 16 * ty + l15, x0 = 16 * tx + 4 * q4;
            const f32x4 gx = *(const LAS f32x4*)(gcL + x0);
            f32x4 sc; sc.x = __expf(gl - gx.x); sc.y = __expf(gl - gx.y); sc.z = __expf(gl - gx.z); sc.w = __expf(gl - gx.w);
            const f32x4 zu = mm16<2>(lds, L_T1, L_VT, tx, ty, lane);
            const f32x4 zw = mm16<2>(lds, L_T2, L_KT, tx, ty, lane);
            *(LAS u32x2*)(lds + L_UT + (y * DL + x0) * 2) = pack4(zu); *(LAS u32x2*)(lds + L_UPT + (y * DL + x0) * 2) = pack4(zu * sc);
            *(LAS u32x2*)(lds + L_WT + (y * DL + x0) * 2) = pack4(zw); *(LAS u32x2*)(lds + L_WPT + (y * DL + x0) * 2) = pack4(zw * sc);
        }
        __syncthreads();
        REP(65536) {
            const size_t cho = (size_t)unit * 4096;
            const float egl = __expf(gl);
#pragma unroll
            for (int tt = 0; tt < 2; ++tt) {
                const int tidx = 2 * w + tt, tx = tidx >> 2, ty = tidx & 3, y = 16 * ty + l15, x0 = 16 * tx + 4 * q4;
                f32x4 zm = mm16<2>(lds, L_WPT, L_KT, tx, ty, lane);
#pragma unroll
                for (int r = 0; r < 4; ++r) zm[r] = ((x0 + r) == y ? egl : 0.f) - zm[r];
                *(u32x2*)(MR + cho + (ty * 2 + (tx >> 1)) * 512 + lane * 8 + 4 * (tx & 1)) = pack4(zm);
                const f32x4 zb = mm16<2>(lds, L_KT, L_UPT, tx, ty, lane);
                *(u32x2*)(BNT + cho + (ty * 4 + tx) * 256 + lane * 4) = pack4(zb);
                const f32x4 zq = mm16<2>(lds, L_WT, L_AR, tx, ty, lane);
                const u32x2 qv = *(const LAS u32x2*)(lds + L_QR + (y * DL + x0) * 2); const float eg = __expf(gcL[y]);
                f32x4 qp; qp.x = bf2f(qv.x & 0xffffu) * eg - zq.x; qp.y = bf2f(qv.x >> 16) * eg - zq.y; qp.z = bf2f(qv.y & 0xffffu) * eg - zq.z; qp.w = bf2f(qv.y >> 16) * eg - zq.w;
                *(u32x2*)(QP + cho + y * 64 + x0) = pack4(qp);
                const f32x4 zo = mm16<2>(lds, L_AR, L_UT, tx, ty, lane);
                *(u32x2*)(OLT + cho + y * 64 + x0) = pack4(zo);
            }
        }
    }
    __syncthreads();
}
#undef CH_LOAD
constexpr int SC_SLOT = 10240, SC_DEPTH = 12, SC_AHEAD = 11;
__device__ __forceinline__ void ph_dn_scan(const Args& a, Frame& F) {
    if (F.bid >= NSCAN) return;
    const unsigned char* MRb = (const unsigned char*)(F.ws + WS_DN_MR); const unsigned char* BNb = (const unsigned char*)(F.ws + WS_DN_BNT); bf16_t* ST = (bf16_t*)(F.ws + WS_DN_ST);
    const int lane = F.lane, l15 = lane & 15, q4 = lane >> 4, wq = F.bid >> 3;
    const size_t ch0 = (size_t)(F.bid & 7) * 256;
    LAS unsigned char* lds = F.lds;
    __syncthreads();
    if (F.wave >= 3) {
        const int lw = F.wave - 3;
#define DN_ISSUE(nn) do { const size_t chb_ = (ch0 + (size_t)((nn) < 255 ? (nn) : 255)) * 8192; const int slot_ = ((nn) % SC_DEPTH) * SC_SLOT; \
        _Pragma("unroll") for (int p_ = 0; p_ < 2; ++p_) { const int piece_ = lw * 2 + p_; \
            const unsigned char* src_ = (piece_ < 8 ? MRb + chb_ + piece_ * 1024 : BNb + chb_ + wq * 2048 + (piece_ - 8) * 1024) + lane * 16; \
            __builtin_amdgcn_global_load_lds((const unsigned*)src_, (LAS unsigned*)(lds + slot_ + piece_ * 1024), 16, 0, 2); } } while (0)
        for (int n = 0; n < SC_AHEAD; ++n) DN_ISSUE(n);
        for (int n = 0; n < 256; ++n) {
            asm volatile("s_waitcnt vmcnt(20)" ::: "memory");
            __builtin_amdgcn_s_barrier();
            DN_ISSUE(n + SC_AHEAD);
        }
        asm volatile("s_waitcnt vmcnt(0)" ::: "memory");
#undef DN_ISSUE
    } else if (F.wave == 0) {
        const int dv = 16 * wq + l15;
        f32x4 S[4];
#pragma unroll
        for (int ti = 0; ti < 4; ++ti) S[ti] = (f32x4){0.f, 0.f, 0.f, 0.f};
        for (int n = 0; n < 256; ++n) {
            __builtin_amdgcn_s_barrier();
            const LAS unsigned char* slot = lds + (n % SC_DEPTH) * SC_SLOT;
            bf16x8_t A[4][2]; u32x2 Bc[4];
#pragma unroll
            for (int ti = 0; ti < 4; ++ti) {
#pragma unroll
                for (int ks = 0; ks < 2; ++ks) A[ti][ks] = *(const LAS bf16x8_t*)(slot + (ti * 2 + ks) * 1024 + lane * 16);
                Bc[ti] = *(const LAS u32x2*)(slot + 8192 + ti * 512 + lane * 8);
            }
            u32x2 sp[4];
#pragma unroll
            for (int ti = 0; ti < 4; ++ti) { sp[ti] = pack4(S[ti]); *(u32x2*)(ST + (ch0 + n) * 4096 + dv * 64 + 16 * ti + 4 * q4) = sp[ti]; }
            const bf16x8_t b0 = __builtin_bit_cast(bf16x8_t, (u32x4){sp[0].x, sp[0].y, sp[1].x, sp[1].y});
            const bf16x8_t b1 = __builtin_bit_cast(bf16x8_t, (u32x4){sp[2].x, sp[2].y, sp[3].x, sp[3].y});
#pragma unroll
            for (int ti = 0; ti < 4; ++ti) {
                f32x4 c; c.x = bf2f(Bc[ti].x & 0xffffu); c.y = bf2f(Bc[ti].x >> 16); c.z = bf2f(Bc[ti].y & 0xffffu); c.w = bf2f(Bc[ti].y >> 16);
                c = __builtin_amdgcn_mfma_f32_16x16x32_bf16(A[ti][0], b0, c, 0, 0, 0);
                c = __builtin_amdgcn_mfma_f32_16x16x32_bf16(A[ti][1], b1, c, 0, 0, 0);
                S[ti] = c;
            }
            asm volatile("s_waitcnt lgkmcnt(0)" ::: "memory");
        }
    } else {
        for (int n = 0; n < 256; ++n) __builtin_amdgcn_s_barrier();
    }
    __syncthreads();
}
__device__ __forceinline__ void ph_dn_out(const Args& a, Frame& F, int l) {
    const bf16_t* QP = (const bf16_t*)(F.ws + WS_DN_QP); const bf16_t* OLT = (const bf16_t*)(F.ws + WS_DN_OLT); const bf16_t* ST = (const bf16_t*)(F.ws + WS_DN_ST);
    const bf16_t* P = (const bf16_t*)(F.ws + WS_PROJ); bf16_t* Y = (bf16_t*)(F.ws + WS_YMIX);
    const int lane = F.lane, l15 = lane & 15, q4 = lane >> 4, ti = F.wave & 3;
    LAS bf16_t* TL = (LAS bf16_t*)(F.lds + F.wave * 2560);
    const int er = lane >> 2, ec = (lane & 3) * 16;
    f32x4 gnv[4];
#pragma unroll
    for (int j = 0; j < 4; ++j) gnv[j] = *(const f32x4*)(a.dn_norm_g + l * 64 + ec + 4 * j);
    bf16x8_t af[2], bfv[4][2]; u32x2 ov[4];
#define DNO_LOAD(prv) { const int unit_ = 2 * (prv) + (F.wave >> 2); const size_t cho_ = (size_t)unit_ * 4096; \
        _Pragma("unroll") for (int ks = 0; ks < 2; ++ks) af[ks] = *(const bf16x8_t*)(QP + cho_ + (16 * ti + l15) * 64 + 32 * ks + 8 * q4); \
        _Pragma("unroll") for (int tj = 0; tj < 4; ++tj) { ov[tj] = *(const u32x2*)(OLT + cho_ + (16 * tj + l15) * 64 + 16 * ti + 4 * q4); \
            _Pragma("unroll") for (int ks = 0; ks < 2; ++ks) bfv[tj][ks] = *(const bf16x8_t*)(ST + cho_ + (16 * tj + l15) * 64 + 32 * ks + 8 * q4); } }
    if (F.bid < 1024) DNO_LOAD(F.bid)
    for (int pr = F.bid; pr < 1024; pr += F.nb) {
        const int unit = 2 * pr + (F.wave >> 2), n = unit & 255, h = (unit >> 8) & 3, b = unit >> 10;
        f32x4 acc[4];
#pragma unroll
        for (int tj = 0; tj < 4; ++tj) {
            f32x4 c; c.x = bf2f(ov[tj].x & 0xffffu); c.y = bf2f(ov[tj].x >> 16); c.z = bf2f(ov[tj].y & 0xffffu); c.w = bf2f(ov[tj].y >> 16);
#pragma unroll
            for (int ks = 0; ks < 2; ++ks) c = __builtin_amdgcn_mfma_f32_16x16x32_bf16(af[ks], bfv[tj][ks], c, 0, 0, 0);
            acc[tj] = c;
        }
        const size_t trow = (size_t)b * SEQ + n * 64 + 16 * ti + er;
        const u32x4 z0 = *(const u32x4*)(P + trow * NP + C_DZ + h * 64 + ec), z1 = *(const u32x4*)(P + trow * NP + C_DZ + h * 64 + ec + 8);
        if (pr + F.nb < 1024) DNO_LOAD(pr + F.nb)
        f32x4 ss = acc[0] * acc[0] + acc[1] * acc[1] + acc[2] * acc[2] + acc[3] * acc[3];
#pragma unroll
        for (int o = 1; o < 16; o <<= 1) { ss.x += __shfl_xor(ss.x, o); ss.y += __shfl_xor(ss.y, o); ss.z += __shfl_xor(ss.z, o); ss.w += __shfl_xor(ss.w, o); }
        const float rs[4] = {rsqrtf(ss.x * (1.f / 64.f) + EPS), rsqrtf(ss.y * (1.f / 64.f) + EPS), rsqrtf(ss.z * (1.f / 64.f) + EPS), rsqrtf(ss.w * (1.f / 64.f) + EPS)};
#pragma unroll
        for (int tj = 0; tj < 4; ++tj)
#pragma unroll
            for (int r = 0; r < 4; ++r) TL[(4 * q4 + r) * 80 + 16 * tj + l15] = (bf16_t)f2bf(acc[tj][r] * rs[r]);
        const u32x4 t0 = *(const LAS u32x4*)(TL + er * 80 + ec), t1 = *(const LAS u32x4*)(TL + er * 80 + ec + 8);
        const unsigned tw[8] = {t0.x, t0.y, t0.z, t0.w, t1.x, t1.y, t1.z, t1.w}, zw[8] = {z0.x, z0.y, z0.z, z0.w, z1.x, z1.y, z1.z, z1.w};
        unsigned yw[8];
#pragma unroll
        for (int j = 0; j < 8; ++j) {
            const float g0 = gnv[j >> 1][(2 * j) & 3], g1 = gnv[j >> 1][(2 * j + 1) & 3];
            yw[j] = cvtpk(bf2f(tw[j] & 0xffffu) * g0 * siluf_(bf2f(zw[j] & 0xffffu)), bf2f(tw[j] >> 16) * g1 * siluf_(bf2f(zw[j] >> 16)));
        }
        bf16_t* yp = Y + trow * D + 512 + h * 64 + ec;
        *(u32x4*)yp = (u32x4){yw[0], yw[1], yw[2], yw[3]}; *(u32x4*)(yp + 8) = (u32x4){yw[4], yw[5], yw[6], yw[7]};
    }
#undef DNO_LOAD
}

__device__ __forceinline__ void ph_conv_fast(const Args& a, Frame& F, int l) {
    const bf16_t* P = (const bf16_t*)(F.ws + WS_PROJ); bf16_t* Y = (bf16_t*)(F.ws + WS_YMIX);
    LAS float* OUTL = (LAS float*)F.lds;
    const int c = F.tid & 255, rsel = F.tid >> 8;
    float wk[CV_K];
#pragma unroll
    for (int k = 0; k < CV_K; ++k) wk[k] = a.cv_dw_w[((size_t)l * CV_K + k) * CV_C + c];
    const float bias = a.cv_dw_b[l * CV_C + c];
    const int nsc = NSCAN;
    if (F.bid < nsc) return;
    for (int pr = (F.bid - nsc + (F.nb - nsc) / 2) % (F.nb - nsc); pr < T / 128; pr += F.nb - nsc) {
        const int run = 2 * pr + rsel, t0 = run * 64, s0 = t0 % SEQ;
        __syncthreads();
        float win[CV_K];
        const bf16_t* pc = P + (size_t)(t0 - 30) * NP + C_CA + c;
        const bool first = (s0 == 0);
        LAS float* outp = OUTL + (rsel * 64) * 256 + c;
#define CV_U(ti_, dst) { const bool ok_ = !(first && (ti_) < 30); const bf16_t* q_ = ok_ ? pc + (size_t)(ti_) * NP : pc + (size_t)30 * NP; \
            const float ca_ = bf2f(q_[0]), cb_ = bf2f(q_[256]); dst = ok_ ? ca_ * sigmoidf_(cb_) : 0.f; }
#pragma unroll
        for (int p = 0; p < CV_K; ++p) CV_U(p, win[p])
        { float acc = bias;
#pragma unroll
            for (int k = 0; k < CV_K; ++k) acc += wk[k] * win[(30 + 1 + k) % CV_K];
            outp[0] = acc; }
        for (int cb3 = 1; cb3 < 3; ++cb3) {
            float un[CV_K];
#pragma unroll
            for (int p = 0; p < CV_K; ++p) CV_U(cb3 * CV_K + p, un[p])
#pragma unroll
            for (int p = 0; p < CV_K; ++p) {
                win[p] = un[p];
                float acc = bias;
#pragma unroll
                for (int k = 0; k < CV_K; ++k) acc += wk[k] * win[(p + 1 + k) % CV_K];
                outp[(cb3 * CV_K + p - 30) * 256] = acc;
            }
        }
        { float u93; CV_U(93, u93) win[0] = u93; float acc = bias;
#pragma unroll
            for (int k = 0; k < CV_K; ++k) acc += wk[k] * win[(0 + 1 + k) % CV_K];
            outp[63 * 256] = acc; }
#undef CV_U
        __syncthreads();
        const f32x4 g4 = *(const f32x4*)(a.cv_ln_g + l * CV_C + 4 * F.lane), b4 = *(const f32x4*)(a.cv_ln_b + l * CV_C + 4 * F.lane);
        for (int j = 0; j < 16; ++j) {
            const int tl = F.wave * 16 + j;
            const f32x4 v = *(const LAS f32x4*)(OUTL + tl * 256 + 4 * F.lane);
            const float mean = wave_sum((v.x + v.y) + (v.z + v.w)) * (1.0f / CV_C);
            const f32x4 dv = v - mean;
            const float var = wave_sum((dv.x * dv.x + dv.y * dv.y) + (dv.z * dv.z + dv.w * dv.w)) * (1.0f / CV_C);
            const float rstd = rsqrtf(var + EPS);
            const f32x4 y = (dv * rstd) * g4 + b4;
            u32x2 o; o.x = cvtpk(siluf_(y.x), siluf_(y.y)); o.y = cvtpk(siluf_(y.z), siluf_(y.w));
            *(u32x2*)(Y + (size_t)(pr * 128 + tl) * D + 768 + 4 * F.lane) = o;
        }
    }
    __syncthreads();
}

__device__ __forceinline__ void moe_bases(Frame& F, int (&base)[9], int (&cnt)[8]) {
    const unsigned* c = (const unsigned*)(F.ws + WS_CTL) + CW_MOECNT;
    int acc = 0;
#pragma unroll
    for (int e = 0; e < 8; ++e) { cnt[e] = (int)__hip_atomic_load(c + 64 * e, __ATOMIC_RELAXED, __HIP_MEMORY_SCOPE_AGENT); base[e] = acc; acc += (cnt[e] + 255) & ~255; }
    base[8] = acc;
}
__device__ __forceinline__ void moe_range(Frame& F, int e, int& lo, int& hi) {
    const unsigned* c = (const unsigned*)(F.ws + WS_CTL) + CW_MOECNT;
    int acc = 0; lo = 0; hi = 0;
#pragma unroll
    for (int k = 0; k < 8; ++k) { const int n = ((int)__hip_atomic_load(c + 64 * k, __ATOMIC_RELAXED, __HIP_MEMORY_SCOPE_AGENT) + 255) & ~255; if (k == e) { lo = acc; hi = acc + n; } acc += n; }
}
__device__ __forceinline__ void ph_moe_list(const Args& a, Frame& F) {
    int base[9], cnt[8]; moe_bases(F, base, cnt);
    int* RM = (int*)(F.ws + WS_RMAP); const int* R = (const int*)(F.ws + WS_ROUTE); const int* Pq = (const int*)(F.ws + WS_POS);
    for (int t = F.bid * NTHREADS + F.tid; t < T; t += F.nb * NTHREADS) {
        const int e0 = R[t * 4], e1 = R[t * 4 + 1];
        int b0 = 0, b1 = 0;
#pragma unroll
        for (int e = 0; e < 8; ++e) { if (e == e0) b0 = base[e]; if (e == e1) b1 = base[e]; }
        RM[b0 + Pq[t * 2]] = t; RM[b1 + Pq[t * 2 + 1]] = t;
    }
    if (F.bid == 0) {
#pragma unroll
        for (int e = 0; e < 8; ++e) { const int lo = base[e] + cnt[e], hi = base[e + 1]; for (int r = lo + F.tid; r < hi; r += NTHREADS) RM[r] = 0; }
    }
}
__device__ __forceinline__ void ph_final(const Args& a, Frame& F) {
    int base[9], cnt[8]; moe_bases(F, base, cnt);
    const float* MOD = (const float*)(F.ws + WS_MOD);
    const bf16_t* YM = (const bf16_t*)(F.ws + WS_YMOE); const int* R = (const int*)(F.ws + WS_ROUTE); const int* Pq = (const int*)(F.ws + WS_POS); const bf16_t* X16 = (const bf16_t*)(F.ws + WS_X16);
    const int c0 = 8 * F.lane;
    f32x4 fg[4], gt[4]; int cur_b = -1;
#pragma unroll
    for (int j = 0; j < 4; ++j) fg[j] = *(const f32x4*)(a.final_g + 512 * (j >> 1) + c0 + 4 * (j & 1));
    u32x4 rt_n; u32x2 pq_n;
    u32x4 dx[2], dy0[2], dy1[2]; float p0c = 0.f, p1c = 0.f;
#define FIN_ROUTE(row_, rt_, pq_) { rt_ = *(const u32x4*)(R + (size_t)(row_) * 4); pq_ = *(const u32x2*)(Pq + (size_t)(row_) * 2); }
#define FIN_DATA(row_, rt_, pq_) { int b0_ = 0, b1_ = 0; _Pragma("unroll") for (int e = 0; e < 8; ++e) { if (e == (int)rt_.x) b0_ = base[e]; if (e == (int)rt_.y) b1_ = base[e]; } \
        const size_t s0_ = (size_t)(b0_ + (int)pq_.x), s1_ = (size_t)(b1_ + (int)pq_.y); p0c = __uint_as_float(rt_.z); p1c = __uint_as_float(rt_.w); \
        _Pragma("unroll") for (int jj = 0; jj < 2; ++jj) { dx[jj] = __builtin_nontemporal_load((const u32x4*)(X16 + (size_t)(row_) * D + 512 * jj + c0)); dy0[jj] = __builtin_nontemporal_load((const u32x4*)(YM + s0_ * D + 512 * jj + c0)); dy1[jj] = __builtin_nontemporal_load((const u32x4*)(YM + s1_ * D + 512 * jj + c0)); } }
    if (F.gw < T) { u32x4 rt0; u32x2 pq0; FIN_ROUTE(F.gw, rt0, pq0) FIN_DATA(F.gw, rt0, pq0) }
    if (F.gw + F.ngw < T) FIN_ROUTE(F.gw + F.ngw, rt_n, pq_n)
    for (int row = F.gw; row < T; row += F.ngw) {
        const int b = row / SEQ;
        if (b != cur_b) { cur_b = b; const float* gt2 = MOD + ((size_t)(1 * 2 + 1) * 2 + b) * 3072 + 2048;
#pragma unroll
            for (int j = 0; j < 4; ++j) gt[j] = *(const f32x4*)(gt2 + 512 * (j >> 1) + c0 + 4 * (j & 1)); }
        f32x4 v[4]; float ss = 0.f; const float p0 = p0c, p1 = p1c;
#pragma unroll
        for (int jj = 0; jj < 2; ++jj) {
            const unsigned xw[4] = {dx[jj].x, dx[jj].y, dx[jj].z, dx[jj].w}, y0w[4] = {dy0[jj].x, dy0[jj].y, dy0[jj].z, dy0[jj].w}, y1w[4] = {dy1[jj].x, dy1[jj].y, dy1[jj].z, dy1[jj].w};
#pragma unroll
            for (int hf = 0; hf < 2; ++hf) {
                f32x4 f, xo;
                f.x = p0 * bf2f(y0w[2 * hf] & 0xffffu) + p1 * bf2f(y1w[2 * hf] & 0xffffu); f.y = p0 * bf2f(y0w[2 * hf] >> 16) + p1 * bf2f(y1w[2 * hf] >> 16);
                f.z = p0 * bf2f(y0w[2 * hf + 1] & 0xffffu) + p1 * bf2f(y1w[2 * hf + 1] & 0xffffu); f.w = p0 * bf2f(y0w[2 * hf + 1] >> 16) + p1 * bf2f(y1w[2 * hf + 1] >> 16);
                xo.x = bf2f(xw[2 * hf] & 0xffffu); xo.y = bf2f(xw[2 * hf] >> 16); xo.z = bf2f(xw[2 * hf + 1] & 0xffffu); xo.w = bf2f(xw[2 * hf + 1] >> 16);
                const f32x4 vv = xo + gt[2 * jj + hf] * f; v[2 * jj + hf] = vv;
                ss += (vv.x * vv.x + vv.y * vv.y) + (vv.z * vv.z + vv.w * vv.w);
            }
        }
        if (row + F.ngw < T) { FIN_DATA(row + F.ngw, rt_n, pq_n) }
        if (row + 2 * F.ngw < T) FIN_ROUTE(row + 2 * F.ngw, rt_n, pq_n)
        const float rstd = rsqrtf(wave_sum(ss) * (1.0f / D) + EPS);
        float* op = a.out + (size_t)row * D + c0;
#pragma unroll
        for (int j = 0; j < 4; ++j) __builtin_nontemporal_store((v[j] * rstd) * fg[j], (f32x4*)(op + 512 * (j >> 1) + 4 * (j & 1)));
    }
#undef FIN_ROUTE
#undef FIN_DATA
}


namespace pg8 {
typedef short bf16x8 __attribute__((ext_vector_type(8)));
constexpr int BM = 256, BK = 64, HALF = 128, HTB = HALF * BK * 2, STAGE_BYTES = 8 * HTB;
__device__ __forceinline__ int lds_byte(int r, int c) { const int st = (r >> 4) * 2 + (c >> 5), rr = r & 15, cc = c & 31, ob = rr * 64 + cc * 2; return st * 1024 + (ob ^ (((ob >> 9) & 1) << 5)); }
__device__ __forceinline__ void stage_rc(int b, int& R, int& C) { const int st = b / 1024, sb = b % 1024, swz = sb ^ (((sb >> 9) & 1) << 5); R = (st >> 1) * 16 + swz / 64; C = (st & 1) * 32 + (swz % 64) / 2; }
__device__ __forceinline__ int perm32(int rho) { const int n = rho >> 4, i = rho & 15; return 8 * (i >> 2) + 4 * n + (i & 3); }
struct Unit { int pm, pn, ord; };
struct Gemm { const bf16_t* A; const bf16_t* Bt; int K; };
constexpr int NXCD = 8, WGM = 8;
struct StaticOrder {
    int nM, nN, nwg, G, c;
    __device__ void init(int M, int N, int G_, int c_) { nM = M / BM; nN = N / BM; nwg = nM * nN; G = G_; c = c_; }
    __device__ __forceinline__ bool next(int i, Unit& u) const {
        const long L = (long)i * G + c; if (L >= nwg) return false;
        int wgid = (int)L; { const int q = nwg / NXCD, r = nwg % NXCD, xcd = wgid % NXCD, off = wgid / NXCD; wgid = (xcd < r ? xcd * (q + 1) : r * (q + 1) + (xcd - r) * q) + off; }
        const int nig = WGM * nN, gid = wgid / nig, fm = gid * WGM, gsz = (nM - fm) < WGM ? (nM - fm) : WGM;
        u.pm = fm + ((wgid % nig) % gsz); u.pn = (wgid % nig) / gsz; return true;
    }
};
template <int NT> struct MoeOrder {
    int bt[9]; int cnt[8]; int G, c;
    __device__ __forceinline__ bool next(int i, Unit& u) const {
        int q, tn;
        if ((G & 7) == 0) { const int x = c & 7, Ll = i * (G >> 3) + (c >> 3); q = (Ll / NT) * 8 + x; tn = Ll % NT; if (q >= bt[8]) return false; }
        else { const int L = i * G + c; if (L >= bt[8] * NT) return false; q = L / NT; tn = L % NT; }
        int e = 0;
#pragma unroll
        for (int k = 1; k < 8; ++k) e += (q >= bt[k]) ? 1 : 0;
        u.pm = q; u.pn = e * NT + tn; return true;
    }
};
__device__ __forceinline__ unsigned cvt_pk_bf16(float lo, float hi) { unsigned r; asm volatile("v_cvt_pk_bf16_f32 %0, %1, %2" : "=v"(r) : "v"(lo), "v"(hi)); return r; }
__device__ __forceinline__ float fast_silu(float x) { return x * __builtin_amdgcn_rcpf(1.0f + __builtin_amdgcn_exp2f(x * -1.4426950408889634f)); }

struct EpiBf16 {
    static constexpr bool PERM = true, WIDE = false;
    bf16_t* O; int ldc; int nmod;
    __device__ __forceinline__ void operator()(const f32x4 (&acc)[2][2][4][2], const Unit& u, int wr, int wc, int fr, int fq) const {
        const int row0 = u.pm * BM + wr * 64 + fr, col0 = (u.pn % nmod) * BM + wc * 32 + 8 * fq;
#pragma unroll
        for (int ai = 0; ai < 2; ++ai)
#pragma unroll
            for (int m = 0; m < 4; ++m) { bf16_t* rowp = O + (size_t)(row0 + ai * HALF + m * 16) * ldc + col0;
#pragma unroll
                for (int bj = 0; bj < 2; ++bj) { const f32x4 v0 = acc[ai][bj][m][0], v1 = acc[ai][bj][m][1];
                    u32x4 w; w.x = cvt_pk_bf16(v0[0], v0[1]); w.y = cvt_pk_bf16(v0[2], v0[3]); w.z = cvt_pk_bf16(v1[0], v1[1]); w.w = cvt_pk_bf16(v1[2], v1[3]);
                    *(u32x4*)(rowp + bj * HALF) = w; } }
    }
};
struct EpiSwiGLU {
    static constexpr bool PERM = true, WIDE = false;
    bf16_t* O; int ldc; int nmod;
    __device__ __forceinline__ void operator()(const f32x4 (&acc)[2][2][4][2], const Unit& u, int wr, int wc, int fr, int fq) const {
        const int row0 = u.pm * BM + wr * 64 + fr, col0 = (u.pn % nmod) * HALF + wc * 32 + 8 * fq;
#pragma unroll
        for (int ai = 0; ai < 2; ++ai)
#pragma unroll
            for (int m = 0; m < 4; ++m) {
                const f32x4 g0 = acc[ai][0][m][0], g1 = acc[ai][0][m][1], u0 = acc[ai][1][m][0], u1 = acc[ai][1][m][1];
                u32x4 w;
                w.x = cvt_pk_bf16(fast_silu(g0[0]) * u0[0], fast_silu(g0[1]) * u0[1]); w.y = cvt_pk_bf16(fast_silu(g0[2]) * u0[2], fast_silu(g0[3]) * u0[3]);
                w.z = cvt_pk_bf16(fast_silu(g1[0]) * u1[0], fast_silu(g1[1]) * u1[1]); w.w = cvt_pk_bf16(fast_silu(g1[2]) * u1[2], fast_silu(g1[3]) * u1[3]);
                *(u32x4*)(O + (size_t)(row0 + ai * HALF + m * 16) * ldc + col0) = w; }
    }
};
struct EpiResidF32 {
    static constexpr bool PERM = false, WIDE = false;
    const float* xin; float* xout; const float* gate;
    __device__ __forceinline__ void operator()(const f32x4 (&acc)[2][2][4][2], const Unit& u, int wr, int wc, int fr, int fq) const {
        const int row0 = u.pm * BM + wr * 64 + fr, col0 = u.pn * BM + wc * 32 + 4 * fq;
        const float* gp = gate + (size_t)((u.pm * BM) / SEQ) * 3072 + col0;
#pragma unroll
        for (int bj = 0; bj < 2; ++bj)
#pragma unroll
            for (int n = 0; n < 2; ++n) { const f32x4 g4 = *(const f32x4*)(gp + bj * HALF + n * 16);
#pragma unroll
                for (int ai = 0; ai < 2; ++ai)
#pragma unroll
                    for (int m = 0; m < 4; ++m) { const size_t off = (size_t)(row0 + ai * HALF + m * 16) * D + col0 + bj * HALF + n * 16;
                        const f32x4 x4 = *(const f32x4*)(xin + off); *(f32x4*)(xout + off) = x4 + g4 * acc[ai][bj][m][n]; } }
    }
};


__device__ __forceinline__ u32x4 xchg8(u32x4 v) { u32x4 r;
    r.x = (unsigned)__builtin_amdgcn_update_dpp(0, (int)v.x, 0x128, 0xf, 0xf, false); r.y = (unsigned)__builtin_amdgcn_update_dpp(0, (int)v.y, 0x128, 0xf, 0xf, false);
    r.z = (unsigned)__builtin_amdgcn_update_dpp(0, (int)v.z, 0x128, 0xf, 0xf, false); r.w = (unsigned)__builtin_amdgcn_update_dpp(0, (int)v.w, 0x128, 0xf, 0xf, false); return r; }
__device__ __forceinline__ u32x4 pack8(f32x4 v0, f32x4 v1) { u32x4 w; w.x = cvt_pk_bf16(v0[0], v0[1]); w.y = cvt_pk_bf16(v0[2], v0[3]); w.z = cvt_pk_bf16(v1[0], v1[1]); w.w = cvt_pk_bf16(v1[2], v1[3]); return w; }
template <bool NT = true> __device__ __forceinline__ void store_wide(bf16_t* p, int ld, int fr, int fq, u32x4 pk0, u32x4 pk1) {
    const bool lo = fr < 8; const u32x4 rcv = xchg8(lo ? pk1 : pk0);
    bf16_t* q = p + (size_t)(fr & 7) * ld + 8 * fq + (lo ? 0 : 32);
    if constexpr (NT) { __builtin_nontemporal_store(lo ? pk0 : rcv, (u32x4*)q); __builtin_nontemporal_store(lo ? rcv : pk1, (u32x4*)(q + (size_t)8 * ld)); }
    else { *(u32x4*)q = lo ? pk0 : rcv; *(u32x4*)(q + (size_t)8 * ld) = lo ? rcv : pk1; }
}
struct EpiBf16W {
    static constexpr bool PERM = true, WIDE = true;
    bf16_t* O; int ldc; int nmod;
    __device__ __forceinline__ void operator()(const f32x4 (&acc)[2][2][4][2], const Unit& u, int wr, int wc, int fr, int fq) const {
        bf16_t* base = O + (size_t)(u.pm * BM + wr * 64) * ldc + (u.pn % nmod) * BM + wc * 64;
#pragma unroll
        for (int ai = 0; ai < 2; ++ai)
#pragma unroll
            for (int m = 0; m < 4; ++m) store_wide(base + (size_t)(ai * HALF + m * 16) * ldc, ldc, fr, fq, pack8(acc[ai][0][m][0], acc[ai][0][m][1]), pack8(acc[ai][1][m][0], acc[ai][1][m][1]));
    }
};
struct EpiResidNorm {
    static constexpr bool PERM = true, WIDE = true;
    const bf16_t* xin; bf16_t* x16; const float* gate; const float* av; bf16_t* xa; float* ssqp;
    __device__ __forceinline__ void operator()(const f32x4 (&acc)[2][2][4][2], const Unit& u, int wr, int wc, int fr, int fq) const {
        const int rowb = u.pm * BM + wr * 64, colw = u.pn * BM + wc * 64, b = (u.pm * BM) / SEQ;
        const bool lo = fr < 8;
        const size_t lane_off = (size_t)(fr & 7) * D + colw + 8 * fq + (lo ? 0 : 32);
        f32x4 gv[2][2], avv[2][2];
#pragma unroll
        for (int bj = 0; bj < 2; ++bj)
#pragma unroll
            for (int n = 0; n < 2; ++n) { gv[bj][n] = *(const f32x4*)(gate + (size_t)b * 3072 + colw + 32 * bj + 8 * fq + 4 * n); avv[bj][n] = *(const f32x4*)(av + (size_t)b * 1024 + colw + 32 * bj + 8 * fq + 4 * n); }
        u32x4 la[4][2], lb[4][2];
#define ERN_LOAD(k_) { _Pragma("unroll") for (int mm = 0; mm < 2; ++mm) { const bf16_t* q = xin + (size_t)(rowb + ((k_) >> 1) * HALF + (2 * ((k_) & 1) + mm) * 16) * D + lane_off; la[k_][mm] = __builtin_nontemporal_load((const u32x4*)q); lb[k_][mm] = __builtin_nontemporal_load((const u32x4*)(q + (size_t)8 * D)); } }
        ERN_LOAD(0)
#pragma unroll
        for (int k = 0; k < 4; ++k) {
            const int ai = k >> 1;
            if (k == 0) ERN_LOAD(1) else if (k == 1) ERN_LOAD(2) else if (k == 2) ERN_LOAD(3)
            asm volatile("" ::: "memory");
#pragma unroll
            for (int mm = 0; mm < 2; ++mm) {
                const int m = 2 * (k & 1) + mm;
                const u32x4 rcv = xchg8(lo ? lb[k][mm] : la[k][mm]);
                const u32x4 xb0 = lo ? la[k][mm] : rcv, xb1 = lo ? rcv : lb[k][mm];
                f32x4 x00, x01, x10, x11;
                x00.x = __uint_as_float(xb0.x << 16); x00.y = __uint_as_float(xb0.x & 0xffff0000u); x00.z = __uint_as_float(xb0.y << 16); x00.w = __uint_as_float(xb0.y & 0xffff0000u);
                x01.x = __uint_as_float(xb0.z << 16); x01.y = __uint_as_float(xb0.z & 0xffff0000u); x01.z = __uint_as_float(xb0.w << 16); x01.w = __uint_as_float(xb0.w & 0xffff0000u);
                x10.x = __uint_as_float(xb1.x << 16); x10.y = __uint_as_float(xb1.x & 0xffff0000u); x10.z = __uint_as_float(xb1.y << 16); x10.w = __uint_as_float(xb1.y & 0xffff0000u);
                x11.x = __uint_as_float(xb1.z << 16); x11.y = __uint_as_float(xb1.z & 0xffff0000u); x11.z = __uint_as_float(xb1.w << 16); x11.w = __uint_as_float(xb1.w & 0xffff0000u);
                const f32x4 n00 = x00 + gv[0][0] * acc[ai][0][m][0], n01 = x01 + gv[0][1] * acc[ai][0][m][1], n10 = x10 + gv[1][0] * acc[ai][1][m][0], n11 = x11 + gv[1][1] * acc[ai][1][m][1];
                float sv = (((n00.x * n00.x + n00.y * n00.y) + (n00.z * n00.z + n00.w * n00.w)) + ((n01.x * n01.x + n01.y * n01.y) + (n01.z * n01.z + n01.w * n01.w)))
                         + (((n10.x * n10.x + n10.y * n10.y) + (n10.z * n10.z + n10.w * n10.w)) + ((n11.x * n11.x + n11.y * n11.y) + (n11.z * n11.z + n11.w * n11.w)));
                const size_t ro = (size_t)(rowb + ai * HALF + m * 16) * D + colw;
                store_wide<false>(x16 + ro, D, fr, fq, pack8(n00, n01), pack8(n10, n11));
                store_wide<false>(xa + ro, D, fr, fq, pack8(n00 * avv[0][0], n01 * avv[0][1]), pack8(n10 * avv[1][0], n11 * avv[1][1]));
                sv += __shfl_xor(sv, 16); sv += __shfl_xor(sv, 32);
                if (fq == 0) ssqp[(size_t)(rowb + ai * HALF + m * 16 + fr) * 16 + u.pn * 4 + wc] = sv;
            }
        }
#undef ERN_LOAD
    }
};
struct EpiProjNorm {
    static constexpr bool PERM = true, WIDE = true;
    bf16_t* O; const LAS float* RS; const float* cv; float* BG; const float* a_log; const float* dt_bias;
    __device__ __forceinline__ void operator()(const f32x4 (&acc)[2][2][4][2], const Unit& u, int wr, int wc, int fr, int fq) const {
        const int rl0 = wr * 64 + fr, colw = u.pn * BM + wc * 64, b = (u.pm * BM) / SEQ;
        const float* cp = cv + (size_t)b * NPW + colw + 8 * fq;
        if (u.pn < NP / BM) {
            f32x4 c4[2][2];
#pragma unroll
            for (int bj = 0; bj < 2; ++bj)
#pragma unroll
                for (int n = 0; n < 2; ++n) c4[bj][n] = *(const f32x4*)(cp + 32 * bj + 4 * n);
            bf16_t* base = O + (size_t)(u.pm * BM + wr * 64) * NP + colw;
#pragma unroll
            for (int ai = 0; ai < 2; ++ai)
#pragma unroll
                for (int m = 0; m < 4; ++m) { const float rs = fabsf(RS[u.ord * 256 + rl0 + ai * HALF + m * 16]);
                    store_wide(base + (size_t)(ai * HALF + m * 16) * NP, NP, fr, fq, pack8(acc[ai][0][m][0] * rs + c4[0][0], acc[ai][0][m][1] * rs + c4[0][1]), pack8(acc[ai][1][m][0] * rs + c4[1][0], acc[ai][1][m][1] * rs + c4[1][1])); }
        } else if (wc == 0 && fq == 0) {
            const f32x4 c0 = *(const f32x4*)(cp), c1 = *(const f32x4*)(cp + 4);
            const f32x4 al = *(const f32x4*)a_log, db = *(const f32x4*)dt_bias;
#pragma unroll
            for (int ai = 0; ai < 2; ++ai)
#pragma unroll
                for (int m = 0; m < 4; ++m) { const int rl = rl0 + ai * HALF + m * 16; const float rs = fabsf(RS[u.ord * 256 + rl]);
                    const f32x4 vb = acc[ai][0][m][0] * rs + c0, va = acc[ai][0][m][1] * rs + c1;
                    f32x4 be, gg;
#pragma unroll
                    for (int hh = 0; hh < 4; ++hh) { be[hh] = sigmoidf_(vb[hh]); gg[hh] = -__expf(al[hh]) * softplusf_(va[hh] + db[hh]); }
                    float* bg = BG + (size_t)(u.pm * BM + rl) * 8; *(f32x4*)bg = be; *(f32x4*)(bg + 4) = gg; }
        }
    }
};
struct EpiNull {
    static constexpr bool PERM = true, WIDE = false;
    __device__ __forceinline__ void operator()(const f32x4 (&acc)[2][2][4][2], const Unit& u, int wr, int wc, int fr, int fq) const {
#pragma unroll
        for (int ai = 0; ai < 2; ++ai)
#pragma unroll
            for (int bj = 0; bj < 2; ++bj)
#pragma unroll
                for (int m = 0; m < 4; ++m)
#pragma unroll
                    for (int n = 0; n < 2; ++n) asm volatile("" :: "v"(acc[ai][bj][m][n]));
    }
};
struct EpiSwiGLUNorm {
    static constexpr bool PERM = true, WIDE = false;
    bf16_t* O; int ldc; int nmod; const LAS float* RS; const float* cv; int ncv;
    __device__ __forceinline__ void operator()(const f32x4 (&acc)[2][2][4][2], const Unit& u, int wr, int wc, int fr, int fq) const {
        const int rl0 = wr * 64 + fr, col0 = (u.pn % nmod) * HALF + wc * 32 + 8 * fq;
        const float* cp = cv + (size_t)u.pn * BM + wc * 32 + 8 * fq;
        f32x4 cg[2][2], cu[2][2];
#pragma unroll
        for (int bb = 0; bb < 2; ++bb)
#pragma unroll
            for (int n = 0; n < 2; ++n) { cg[bb][n] = *(const f32x4*)(cp + (size_t)bb * ncv + 4 * n); cu[bb][n] = *(const f32x4*)(cp + (size_t)bb * ncv + HALF + 4 * n); }
#pragma unroll
        for (int ai = 0; ai < 2; ++ai)
#pragma unroll
            for (int m = 0; m < 4; ++m) { const int rl = rl0 + ai * HALF + m * 16; const float rsv = RS[u.ord * 256 + rl], rs = fabsf(rsv); const bool b1 = rsv < 0.f;
                const f32x4 g0 = acc[ai][0][m][0] * rs + (b1 ? cg[1][0] : cg[0][0]), g1 = acc[ai][0][m][1] * rs + (b1 ? cg[1][1] : cg[0][1]);
                const f32x4 u0 = acc[ai][1][m][0] * rs + (b1 ? cu[1][0] : cu[0][0]), u1 = acc[ai][1][m][1] * rs + (b1 ? cu[1][1] : cu[0][1]);
                u32x4 w;
                w.x = cvt_pk_bf16(fast_silu(g0[0]) * u0[0], fast_silu(g0[1]) * u0[1]); w.y = cvt_pk_bf16(fast_silu(g0[2]) * u0[2], fast_silu(g0[3]) * u0[3]);
                w.z = cvt_pk_bf16(fast_silu(g1[0]) * u1[0], fast_silu(g1[1]) * u1[1]); w.w = cvt_pk_bf16(fast_silu(g1[2]) * u1[2], fast_silu(g1[3]) * u1[3]);
                __builtin_nontemporal_store(w, (u32x4*)(O + (size_t)(u.pm * BM + rl) * ldc + col0)); }
    }
};

template <class Epi, class Sched, bool GATHER, bool ALIGN_EPI, bool SP2>
__device__ __forceinline__ void gemm_phase(LAS unsigned char* lds, const LAS int* RI, const Gemm g, const Sched& S, const Epi& E) {
    const int tid = threadIdx.x, wid = __builtin_amdgcn_readfirstlane(tid >> 6), lane = tid & 63, wr = wid >> 2, wc = wid & 3, fr = lane & 15, fq = lane >> 4;
    const int K = g.K, nt = K / BK;
    unsigned voffB[2]; int Ra[2]; unsigned Ca2[2];
#pragma unroll
    for (int i = 0; i < 2; ++i) { int R, C; stage_rc(tid * 16 + i * 8192, R, C); const int Rb = Epi::WIDE ? ((R >> 5) * 64 + perm32(R & 31)) : (Epi::PERM ? ((R & ~31) + perm32(R & 31)) : R);
        Ra[i] = R; Ca2[i] = (unsigned)C * 2u; voffB[i] = (unsigned)(Rb * K + C) * 2u; }
    const size_t kstep = (size_t)(BK * 2);
    const size_t hstep = (size_t)HALF * K * 2;
    const size_t tstep = 2 * hstep;
    const size_t hstepB = Epi::WIDE ? (size_t)32 * K * 2 : hstep;
    const unsigned rowb = (unsigned)K * 2u;
    const unsigned ldsw = (unsigned)wid * 1024u;
    const int aoff = lds_byte(wr * 64 + fr, fq * 8), boff = lds_byte(wc * 32 + fr, fq * 8);
#define PG8_SA(b, h) (((b) * 2 + (h)) * HTB)
#define PG8_SB(b, h) ((4 + (b) * 2 + (h)) * HTB)
#define PG8_STAGE_B(bufoff, gbase) do { _Pragma("unroll") for (int _i = 0; _i < 2; ++_i) \
        __builtin_amdgcn_global_load_lds((const unsigned*)((const char*)(gbase) + voffB[_i]), (LAS unsigned*)(lds + (bufoff) + ldsw + _i * 8192), 16, 0, 0); } while (0)
#define PG8_STAGE_A(bufoff, kb, off) do { _Pragma("unroll") for (int _i = 0; _i < 2; ++_i) \
        __builtin_amdgcn_global_load_lds((const unsigned*)((const char*)g.A + (size_t)(kb) + (off)[_i]), (LAS unsigned*)(lds + (bufoff) + ldsw + _i * 8192), 16, 0, 0); } while (0)
#define PG8_LDA(dst, b, h) do { _Pragma("unroll") for (int m = 0; m < 4; ++m) _Pragma("unroll") for (int k = 0; k < 2; ++k) dst[m][k] = *(const LAS bf16x8*)(lds + PG8_SA(b, h) + aoff + m * 2048 + k * 1024); } while (0)
#define PG8_LDB(dst, b, h) do { _Pragma("unroll") for (int n = 0; n < 2; ++n) _Pragma("unroll") for (int k = 0; k < 2; ++k) dst[n][k] = *(const LAS bf16x8*)(lds + PG8_SB(b, h) + boff + n * 2048 + k * 1024); } while (0)
#define PG8_MMA(ai, bj, At, Bt) do { __builtin_amdgcn_s_setprio(1); _Pragma("unroll") for (int m = 0; m < 4; ++m) _Pragma("unroll") for (int n = 0; n < 2; ++n) _Pragma("unroll") for (int k = 0; k < 2; ++k) \
        acc[ai][bj][m][n] = __builtin_amdgcn_mfma_f32_16x16x32_bf16(Bt[n][k], At[m][k], acc[ai][bj][m][n], 0, 0, 0); __builtin_amdgcn_s_setprio(0); } while (0)
#define PG8_WAIT_V(n) asm volatile("s_waitcnt vmcnt(" #n ")" ::: "memory")
#define PG8_WAIT_L(n) asm volatile("s_waitcnt lgkmcnt(" #n ")" ::: "memory")
#define PG8_BAR __builtin_amdgcn_s_barrier()
#define PG8_SCHED __builtin_amdgcn_sched_barrier(0)
#define PG8_AOFFS(dst, ui_, un_) do { _Pragma("unroll") for (int _h = 0; _h < 2; ++_h) _Pragma("unroll") for (int _i = 0; _i < 2; ++_i) { \
        const unsigned _row = GATHER ? (unsigned)RI[(ui_) * 256 + _h * HALF + Ra[_i]] : (unsigned)((un_).pm * BM + _h * HALF + Ra[_i]); dst[_h][_i] = _row * rowb + Ca2[_i]; } } while (0)
    Unit cur, nxt; int ui = 0;
    if (!S.next(0, cur)) return;
    cur.ord = 0;
    f32x4 acc[2][2][4][2];
#pragma unroll
    for (int a = 0; a < 2; ++a)
#pragma unroll
        for (int b = 0; b < 2; ++b)
#pragma unroll
            for (int m = 0; m < 4; ++m)
#pragma unroll
                for (int n = 0; n < 2; ++n) acc[a][b][m][n] = (f32x4){0.f, 0.f, 0.f, 0.f};
    bf16x8 At[4][2], B0[2][2], B1[2][2];
    unsigned cv[2][2], nv[2][2];
    PG8_AOFFS(cv, 0, cur);
    const char* cB = (const char*)g.Bt + (size_t)cur.pn * tstep;
    if constexpr (SP2) {
        PG8_STAGE_B(PG8_SB(0, 0), cB); PG8_STAGE_B(PG8_SB(0, 1), cB + hstepB); PG8_STAGE_A(PG8_SA(0, 0), 0, cv[0]); PG8_STAGE_A(PG8_SA(0, 1), 0, cv[1]);
        if (wr == 1) PG8_BAR;
        PG8_WAIT_V(2); PG8_BAR;
        PG8_STAGE_B(PG8_SB(1, 0), cB + kstep); PG8_STAGE_A(PG8_SA(1, 0), kstep, cv[0]); PG8_STAGE_B(PG8_SB(1, 1), cB + hstepB + kstep);
        PG8_WAIT_V(6); PG8_BAR;
    } else {
        PG8_STAGE_B(PG8_SB(0, 0), cB); PG8_STAGE_A(PG8_SA(0, 0), 0, cv[0]); PG8_STAGE_B(PG8_SB(0, 1), cB + hstepB); PG8_STAGE_A(PG8_SA(0, 1), 0, cv[1]);
        if (wr == 1) PG8_BAR;
        PG8_WAIT_V(4); PG8_BAR;
        PG8_STAGE_B(PG8_SB(1, 0), cB + kstep); PG8_STAGE_A(PG8_SA(1, 0), kstep, cv[0]); PG8_STAGE_B(PG8_SB(1, 1), cB + hstepB + kstep);
        PG8_WAIT_V(6); PG8_BAR;
    }
    for (;;) {
        const bool has_next = S.next(ui + 1, nxt); nxt.ord = ui + 1;
        const char* nB = has_next ? (const char*)g.Bt + (size_t)nxt.pn * tstep : cB;
        if (has_next) { PG8_AOFFS(nv, ui + 1, nxt); }
        else {
#pragma unroll
            for (int h = 0; h < 2; ++h)
#pragma unroll
                for (int i = 0; i < 2; ++i) nv[h][i] = cv[h][i]; }
        for (int t = 0; t < nt; t += 2) {
            const bool last = (t == nt - 2);
            const size_t kb1 = (size_t)(t + 1) * kstep, kb2 = last ? (size_t)0 : (size_t)(t + 2) * kstep, kb3 = kb2 + kstep;
            const char* b2 = last ? nB : cB + (size_t)(t + 2) * kstep; const char* b3 = b2 + kstep;
            unsigned o2[2][2];
#pragma unroll
            for (int h = 0; h < 2; ++h)
#pragma unroll
                for (int i = 0; i < 2; ++i) o2[h][i] = last ? nv[h][i] : cv[h][i];
            if constexpr (SP2) {
            PG8_LDB(B0, 0, 0); PG8_LDB(B1, 0, 1); PG8_SCHED; PG8_LDA(At, 0, 0); PG8_STAGE_A(PG8_SA(1, 1), kb1, cv[1]);
            PG8_WAIT_V(8); PG8_WAIT_L(0); PG8_BAR; PG8_MMA(0, 0, At, B0); PG8_MMA(0, 1, At, B1); PG8_BAR; PG8_SCHED;
            PG8_LDA(At, 0, 1); PG8_STAGE_B(PG8_SB(0, 0), b2); PG8_STAGE_B(PG8_SB(0, 1), b2 + hstepB); PG8_STAGE_A(PG8_SA(0, 0), kb2, o2[0]);
            PG8_WAIT_V(8); PG8_WAIT_L(0); PG8_BAR; PG8_MMA(1, 0, At, B0); PG8_MMA(1, 1, At, B1); PG8_BAR; PG8_SCHED;
            PG8_LDB(B0, 1, 0); PG8_LDB(B1, 1, 1); PG8_SCHED; PG8_LDA(At, 1, 0); PG8_STAGE_A(PG8_SA(0, 1), kb2, o2[1]);
            PG8_WAIT_V(8); PG8_WAIT_L(0); PG8_BAR; PG8_MMA(0, 0, At, B0); PG8_MMA(0, 1, At, B1); PG8_BAR; PG8_SCHED;
            PG8_LDA(At, 1, 1); PG8_STAGE_B(PG8_SB(1, 0), b3); PG8_STAGE_B(PG8_SB(1, 1), b3 + hstepB); PG8_STAGE_A(PG8_SA(1, 0), kb3, o2[0]);
            PG8_WAIT_V(8); PG8_WAIT_L(0); PG8_BAR; PG8_MMA(1, 0, At, B0); PG8_MMA(1, 1, At, B1); PG8_BAR; PG8_SCHED;
            } else {
            PG8_LDB(B0, 0, 0); PG8_SCHED; PG8_LDA(At, 0, 0); PG8_STAGE_A(PG8_SA(1, 1), kb1, cv[1]);
            PG8_WAIT_L(8); PG8_BAR; PG8_WAIT_L(0); PG8_MMA(0, 0, At, B0); PG8_BAR; PG8_SCHED;
            PG8_LDB(B1, 0, 1); PG8_STAGE_B(PG8_SB(0, 0), b2);
            PG8_BAR; PG8_WAIT_L(0); PG8_MMA(0, 1, At, B1); PG8_BAR;
            PG8_LDA(At, 0, 1); PG8_STAGE_A(PG8_SA(0, 0), kb2, o2[0]);
            PG8_BAR; PG8_WAIT_L(0); PG8_MMA(1, 0, At, B0); PG8_BAR; PG8_SCHED;
            PG8_STAGE_B(PG8_SB(0, 1), b2 + hstepB);
            PG8_WAIT_V(6); PG8_BAR; PG8_MMA(1, 1, At, B1); PG8_BAR;
            PG8_LDB(B0, 1, 0); PG8_SCHED; PG8_LDA(At, 1, 0); PG8_STAGE_A(PG8_SA(0, 1), kb2, o2[1]);
            PG8_WAIT_L(8); PG8_BAR; PG8_WAIT_L(0); PG8_MMA(0, 0, At, B0); PG8_BAR; PG8_SCHED;
            PG8_LDB(B1, 1, 1); PG8_STAGE_B(PG8_SB(1, 0), b3);
            PG8_BAR; PG8_WAIT_L(0); PG8_MMA(0, 1, At, B1); PG8_BAR;
            PG8_LDA(At, 1, 1); PG8_STAGE_A(PG8_SA(1, 0), kb3, o2[0]);
            PG8_BAR; PG8_WAIT_L(0); PG8_MMA(1, 0, At, B0); PG8_BAR; PG8_SCHED;
            PG8_STAGE_B(PG8_SB(1, 1), b3 + hstepB);
            PG8_WAIT_V(6); PG8_BAR; PG8_MMA(1, 1, At, B1); PG8_BAR;
            }
        }
        if constexpr (ALIGN_EPI) { if (wr == 0) PG8_BAR; }
        E(acc, cur, wr, wc, fr, fq);
        if (!has_next) break;
#pragma unroll
        for (int a = 0; a < 2; ++a)
#pragma unroll
            for (int b = 0; b < 2; ++b)
#pragma unroll
                for (int m = 0; m < 4; ++m)
#pragma unroll
                    for (int n = 0; n < 2; ++n) acc[a][b][m][n] = (f32x4){0.f, 0.f, 0.f, 0.f};
        cur = nxt; cB = nB; ++ui;
#pragma unroll
        for (int h = 0; h < 2; ++h)
#pragma unroll
            for (int i = 0; i < 2; ++i) cv[h][i] = nv[h][i];
        if constexpr (ALIGN_EPI) { if (wr == 1) PG8_BAR; }
    }
    PG8_WAIT_V(0);
    if constexpr (!ALIGN_EPI) { if (wr == 0) PG8_BAR; }
    PG8_BAR;
#undef PG8_SA
#undef PG8_SB
#undef PG8_STAGE_A
#undef PG8_STAGE_B
#undef PG8_LDA
#undef PG8_LDB
#undef PG8_MMA
#undef PG8_WAIT_V
#undef PG8_WAIT_L
#undef PG8_BAR
#undef PG8_SCHED
#undef PG8_AOFFS
}
}

__device__ __forceinline__ void transpose_item(const float* W, int pitch, int k0, int n0, bf16_t* WT, int Kd, int drow0, LAS float* scr, int lane) {
#pragma unroll 8
    for (int i = 0; i < 32; ++i) { const int kk = 2 * i + (lane >> 5); scr[kk * 33 + (lane & 31)] = __builtin_nontemporal_load(W + (size_t)(k0 + kk) * pitch + n0 + (lane & 31)); }
    asm volatile("s_waitcnt lgkmcnt(0)" ::: "memory");
    const int c = lane & 7;
#pragma unroll
    for (int j = 0; j < 4; ++j) { const int n = (lane >> 3) + 8 * j; const LAS float* s = scr + (8 * c) * 33 + n;
        u32x4 o; o.x = pk2(s[0 * 33], s[1 * 33]); o.y = pk2(s[2 * 33], s[3 * 33]); o.z = pk2(s[4 * 33], s[5 * 33]); o.w = pk2(s[6 * 33], s[7 * 33]);
        *(u32x4*)(WT + (size_t)(drow0 + n) * Kd + k0 + 8 * c) = o; }
    asm volatile("s_waitcnt lgkmcnt(0)" ::: "memory");
}
constexpr size_t WT_WIN = 0, WT_WOUT = WT_WIN + (size_t)2 * NPW * D, WT_FGU = WT_WOUT + (size_t)2 * D * D, WT_FD = WT_FGU + (size_t)2 * D_FF * D,
                 WT_MGU = WT_FD + (size_t)D * D_FF, WT_MD = WT_MGU + (size_t)NE * 2 * D_FFE * D, WT_END = WT_MD + (size_t)NE * D * D_FFE;
static_assert(WT_END * 2 <= 80 * MiB, "weight copies fit");
__device__ __forceinline__ void ph_pro_weights(const Args& a, Frame& F) {
    LAS float* scr = (LAS float*)(F.lds + F.wave * 16384);
    bf16_t* WT = (bf16_t*)(F.ws + WS_WT);
    constexpr int I_IN0 = 16 * 48, I_IN1 = 16 * 24, I_OUT = 16 * 32, I_FG = 16 * 88, I_FD = 44 * 32, I_M = 16 * 32;
    constexpr int NITEMS = 2 * (I_IN0 + I_IN1 + I_OUT) + 2 * I_FG + I_FD + 24 * I_M;
    for (int it = F.gw; it < NITEMS; it += F.ngw) {
        int r = it; const float* src; int pitch, k0, n0, Kd, drow0; bf16_t* dst;
        if (r < 2 * I_IN0) { const int l = r / I_IN0; r %= I_IN0; src = a.w_in + (size_t)l * D * N_IN; pitch = N_IN; k0 = (r / 48) * 64; n0 = (r % 48) * 32; dst = WT + WT_WIN + (size_t)l * NPW * D; Kd = D; drow0 = n0; }
        else if ((r -= 2 * I_IN0) < 2 * I_IN1) { const int l = r / I_IN1; r %= I_IN1; src = a.w_in + (size_t)l * D * N_IN + 1544; pitch = N_IN; k0 = (r / 24) * 64; n0 = (r % 24) * 32; dst = WT + WT_WIN + (size_t)l * NPW * D; Kd = D; drow0 = 1536 + n0; }
        else if ((r -= 2 * I_IN1) < 2 * I_OUT) { const int l = r / I_OUT; r %= I_OUT; src = a.w_out + (size_t)l * D * D; pitch = D; k0 = (r / 32) * 64; n0 = (r % 32) * 32; dst = WT + WT_WOUT + (size_t)l * D * D; Kd = D; drow0 = n0; }
        else if ((r -= 2 * I_OUT) < 2 * I_FG) { const int up = r / I_FG; r %= I_FG; src = up ? a.ffn_wu : a.ffn_wg; pitch = D_FF; k0 = (r / 88) * 64; n0 = (r % 88) * 32; dst = WT + WT_FGU; Kd = D; drow0 = (n0 / 128) * 256 + up * 128 + (n0 % 128); }
        else if ((r -= 2 * I_FG) < I_FD) { src = a.ffn_wd; pitch = D; k0 = (r / 32) * 64; n0 = (r % 32) * 32; dst = WT + WT_FD; Kd = D_FF; drow0 = n0; }
        else if ((r -= I_FD) < 16 * I_M) { const int e = r / (2 * I_M); r %= 2 * I_M; const int up = r / I_M; r %= I_M; src = (up ? a.moe_wu : a.moe_wg) + (size_t)e * D * D_FFE; pitch = D_FFE; k0 = (r / 32) * 64; n0 = (r % 32) * 32;
            dst = WT + WT_MGU + (size_t)e * 2 * D_FFE * D; Kd = D; drow0 = (n0 / 128) * 256 + up * 128 + (n0 % 128); }
        else { r -= 16 * I_M; const int e = r / I_M; r %= I_M; src = a.moe_wd + (size_t)e * D_FFE * D; pitch = D; k0 = (r / 32) * 64; n0 = (r % 32) * 32; dst = WT + WT_MD + (size_t)e * D * D_FFE; Kd = D_FFE; drow0 = n0; }
        transpose_item(src, pitch, k0, n0, dst, Kd, drow0, scr, F.lane);
    }
    for (int idx = F.bid * NTHREADS + F.tid; idx < 2 * 256 * D; idx += F.nb * NTHREADS) {
        const int l = idx / (256 * D), r = (idx / D) % 256, k = idx % D;
        WT[WT_WIN + (size_t)l * NPW * D + (size_t)(2304 + r) * D + k] = (r < 8) ? (bf16_t)f2bf(a.w_in[(size_t)l * D * N_IN + (size_t)k * N_IN + W_DB + r]) : (bf16_t)0;
    }
}

template <int NT> __device__ __forceinline__ void moe_order_init(Frame& F, pg8::MoeOrder<NT>& S) {
    const unsigned* c = (const unsigned*)(F.ws + WS_CTL) + CW_MOECNT;
    int acc = 0;
#pragma unroll
    for (int e = 0; e < 8; ++e) { S.cnt[e] = (int)__hip_atomic_load(c + 64 * e, __ATOMIC_RELAXED, __HIP_MEMORY_SCOPE_AGENT); S.bt[e] = acc; acc += (S.cnt[e] + 255) >> 8; }
    S.bt[8] = acc; S.G = F.nb; S.c = F.bid;
}
template <int NT> __device__ __forceinline__ int moe_ri_one(Frame& F, const pg8::MoeOrder<NT>& S, const int* RM, int o, int t) {
    pg8::Unit u; if (!S.next(o, u)) return -1;
    const int e = u.pn / NT; int bte = 0, cne = 0;
#pragma unroll
    for (int kk = 0; kk < 8; ++kk) { if (kk == e) { bte = S.bt[kk]; cne = S.cnt[kk]; } }
    const int sl = (u.pm - bte) * 256 + t; return (sl < cne) ? RM[(size_t)e * T + sl] : 0;
}
template <int NT> __device__ __forceinline__ void moe_ri_preload(Frame& F, const pg8::MoeOrder<NT>& S) {
    LAS int* RI = (LAS int*)(F.lds + RI_OFF); const int* RM = (const int*)(F.ws + WS_RMAP);
    const int t = F.tid & 255, par = F.tid >> 8;
    const int v0 = moe_ri_one<NT>(F, S, RM, par, t), v1 = moe_ri_one<NT>(F, S, RM, par + 2, t), v2 = moe_ri_one<NT>(F, S, RM, par + 4, t), v3 = moe_ri_one<NT>(F, S, RM, par + 6, t);
    const int v4 = moe_ri_one<NT>(F, S, RM, par + 8, t), v5 = moe_ri_one<NT>(F, S, RM, par + 10, t), v6 = moe_ri_one<NT>(F, S, RM, par + 12, t), v7 = moe_ri_one<NT>(F, S, RM, par + 14, t);
    if (v0 >= 0) RI[(par) * 256 + t] = v0; if (v1 >= 0) RI[(par + 2) * 256 + t] = v1; if (v2 >= 0) RI[(par + 4) * 256 + t] = v2; if (v3 >= 0) RI[(par + 6) * 256 + t] = v3;
    if (v4 >= 0) RI[(par + 8) * 256 + t] = v4; if (v5 >= 0) RI[(par + 10) * 256 + t] = v5; if (v6 >= 0) RI[(par + 12) * 256 + t] = v6;
    if (v7 >= 0 && par + 14 < 15) RI[(par + 14) * 256 + t] = v7;
    __syncthreads();
}

__device__ __forceinline__ void ph_norm0(const Args& a, Frame& F) {
    const float* MOD = (const float*)(F.ws + WS_MOD);
    bf16_t* XA = (bf16_t*)(F.ws + WS_H); bf16_t* X16 = (bf16_t*)(F.ws + WS_X16); float* SSQ = (float*)(F.ws + WS_SSQ) + (size_t)3 * T * 16;
    f32x4 vn[4], A4[4]; int cur_b = -1;
#define N0_LOAD(row_) { const f32x4* p_ = (const f32x4*)(a.x + (size_t)(row_) * D) + 2 * F.lane; vn[0] = __builtin_nontemporal_load(p_); vn[1] = __builtin_nontemporal_load(p_ + 1); vn[2] = __builtin_nontemporal_load(p_ + 128); vn[3] = __builtin_nontemporal_load(p_ + 129); }
    if (F.gw < T) N0_LOAD(F.gw)
    for (int row = F.gw; row < T; row += F.ngw) {
        const int b = row / SEQ;
        f32x4 v[4]; float ss = 0.f;
#pragma unroll
        for (int j = 0; j < 4; ++j) { v[j] = vn[j]; ss += (v[j].x * v[j].x + v[j].y * v[j].y) + (v[j].z * v[j].z + v[j].w * v[j].w); }
        if (row + F.ngw < T) N0_LOAD(row + F.ngw)
        if (b != cur_b) { cur_b = b;
#pragma unroll
            for (int j = 0; j < 4; ++j) { const int d = 512 * (j >> 1) + 8 * F.lane + 4 * (j & 1); A4[j] = *(const f32x4*)(a.nmg + d) * (*(const f32x4*)(MOD + (size_t)b * 3072 + 1024 + d) + 1.0f); } }
#pragma unroll
        for (int jj = 0; jj < 2; ++jj) {
            const int d = 512 * jj + 8 * F.lane; const f32x4 v0 = v[2 * jj], v1 = v[2 * jj + 1], s0 = v0 * A4[2 * jj], s1 = v1 * A4[2 * jj + 1];
            u32x4 o; o.x = pk2(v0.x, v0.y); o.y = pk2(v0.z, v0.w); o.z = pk2(v1.x, v1.y); o.w = pk2(v1.z, v1.w); *(u32x4*)(X16 + (size_t)row * D + d) = o;
            u32x4 p; p.x = pk2(s0.x, s0.y); p.y = pk2(s0.z, s0.w); p.z = pk2(s1.x, s1.y); p.w = pk2(s1.z, s1.w); *(u32x4*)(XA + (size_t)row * D + d) = p;
        }
        ss = wave_sum(ss);
        if (F.lane < 16) SSQ[(size_t)row * 16 + F.lane] = (F.lane == 0) ? ss : 0.f;
    }
#undef N0_LOAD
}
__device__ __forceinline__ void ph_prep_vectors(const Args& a, Frame& F) {
    const float* MOD = (const float*)(F.ws + WS_MOD); float* AV = (float*)(F.ws + WS_AV);
    for (int idx = F.bid * NTHREADS + F.tid; idx < 3 * BATCH * D; idx += F.nb * NTHREADS) {
        const int inst = idx / (BATCH * D), b = (idx / D) % BATCH, d = idx % D;
        const int lk = (inst == 0) ? 1 : (inst == 1 ? 2 : 3);
        const float gn = (inst == 0) ? a.nfg[d] : (inst == 1 ? a.nmg[D + d] : a.nfg[D + d]);
        AV[idx] = gn * (1.0f + MOD[((size_t)lk * 2 + b) * 3072 + 1024 + d]);
    }
    const bf16_t* WT = (const bf16_t*)(F.ws + WS_WT);
    constexpr int NR = 5632 + NPW + 16384 + NPW;
    LAS float* SH = (LAS float*)F.lds;
    for (int i = F.tid; i < 4 * BATCH * D; i += NTHREADS) { const int which = i / (BATCH * D), b = (i / D) % BATCH, d = i % D; SH[i] = MOD[((size_t)((which + 1) & 3) * 2 + b) * 3072 + d]; }
    __syncthreads();
    for (int g8 = F.gw; g8 < NR / 8; g8 += F.ngw) {
        const int row = g8 * 8 + (F.lane >> 3), part = F.lane & 7;
        int which, r; const bf16_t* wrow; float* out; int ncv;
        if (row < 5632) { which = 0; r = row; wrow = WT + WT_FGU + (size_t)r * D; out = (float*)(F.ws + WS_CVF); ncv = 5632; }
        else if (row < 5632 + NPW) { which = 1; r = row - 5632; wrow = WT + WT_WIN + (size_t)NPW * D + (size_t)r * D; out = (float*)(F.ws + WS_CVI); ncv = NPW; }
        else if (row < 5632 + NPW + 16384) { which = 2; r = row - 5632 - NPW; wrow = WT + WT_MGU + (size_t)r * D; out = (float*)(F.ws + WS_CVM); ncv = 16384; }
        else { which = 3; r = row - 5632 - NPW - 16384; wrow = WT + WT_WIN + (size_t)r * D; out = (float*)(F.ws + WS_CVI0); ncv = NPW; }
        u32x4 wv[16];
#pragma unroll
        for (int j = 0; j < 16; ++j) wv[j] = *(const u32x4*)(wrow + 128 * part + 8 * j);
        const LAS float* s0p = SH + (which * 2 + 0) * 1024 + 128 * part; const LAS float* s1p = s0p + 1024;
        float s0 = 0.f, s1 = 0.f;
#pragma unroll
        for (int j = 0; j < 16; ++j) {
            const f32x4 a0 = *(const LAS f32x4*)(s0p + 8 * j), a1 = *(const LAS f32x4*)(s0p + 8 * j + 4), b0 = *(const LAS f32x4*)(s1p + 8 * j), b1 = *(const LAS f32x4*)(s1p + 8 * j + 4);
            const float x0 = bf2f(wv[j].x & 0xffffu), x1 = bf2f(wv[j].x >> 16), x2 = bf2f(wv[j].y & 0xffffu), x3 = bf2f(wv[j].y >> 16), x4 = bf2f(wv[j].z & 0xffffu), x5 = bf2f(wv[j].z >> 16), x6 = bf2f(wv[j].w & 0xffffu), x7 = bf2f(wv[j].w >> 16);
            s0 += ((x0 * a0.x + x1 * a0.y) + (x2 * a0.z + x3 * a0.w)) + ((x4 * a1.x + x5 * a1.y) + (x6 * a1.z + x7 * a1.w));
            s1 += ((x0 * b0.x + x1 * b0.y) + (x2 * b0.z + x3 * b0.w)) + ((x4 * b1.x + x5 * b1.y) + (x6 * b1.z + x7 * b1.w));
        }
        s0 += __shfl_xor(s0, 1); s0 += __shfl_xor(s0, 2); s0 += __shfl_xor(s0, 4);
        s1 += __shfl_xor(s1, 1); s1 += __shfl_xor(s1, 2); s1 += __shfl_xor(s1, 4);
        if (part == 0) { out[r] = s0; out[ncv + r] = s1; }
    }
    __syncthreads();
    if (F.gw < BATCH * 8) {
        const int b = F.gw >> 3, e = F.gw & 7; float sacc = 0.f;
        for (int d = F.lane; d < D; d += 64) sacc += MOD[((size_t)3 * 2 + b) * 3072 + d] * a.router_w[(size_t)d * NE + e];
        sacc = wave_sum(sacc);
        if (F.lane == 0) ((float*)(F.ws + WS_CR))[b * 8 + e] = sacc;
    }
}
template <class Sched> __device__ __forceinline__ int count_units(const Sched& S) { int n = 0; pg8::Unit u; while (n < 16 && S.next(n, u)) ++n; return n; }
template <class Sched> __device__ __forceinline__ void rstd_preload(Frame& F, const Sched& S, const float* ssqp, const LAS int* RI) {
    LAS float* RS = (LAS float*)(F.lds + RS_OFF);
    const int t = F.tid & 255, par = F.tid >> 8, nu = count_units(S);
#pragma unroll
    for (int k0 = 0; k0 < 8; k0 += 4) {
        f32x4 p0[4], p1[4], p2[4], p3[4]; int r0, r1, r2, r3;
#define RSP_LOAD(k, pk, rk) { const int o = par + 2 * (k0 + k); pg8::Unit u; u.pm = 0; rk = 0; if (o < nu) { S.next(o, u); rk = RI ? RI[o * 256 + t] : u.pm * 256 + t; } \
            const f32x4* q = (const f32x4*)(ssqp + (size_t)rk * 16); pk[0] = q[0]; pk[1] = q[1]; pk[2] = q[2]; pk[3] = q[3]; }
        RSP_LOAD(0, p0, r0) RSP_LOAD(1, p1, r1) RSP_LOAD(2, p2, r2) RSP_LOAD(3, p3, r3)
#undef RSP_LOAD
#define RSP_STORE(k, pk, rk) { const int o = par + 2 * (k0 + k); if (o < nu) { const f32x4 s4 = (pk[0] + pk[1]) + (pk[2] + pk[3]); \
            const float rs = rsqrtf(((s4.x + s4.y) + (s4.z + s4.w)) * (1.0f / D) + EPS); RS[o * 256 + t] = (rk >= SEQ) ? -rs : rs; } }
        RSP_STORE(0, p0, r0) RSP_STORE(1, p1, r1) RSP_STORE(2, p2, r2) RSP_STORE(3, p3, r3)
#undef RSP_STORE
    }
    __syncthreads();
}
__device__ __forceinline__ void ph_router(const Args& a, Frame& F) {
    const bf16_t* XA = (const bf16_t*)(F.ws + WS_H); const float* SSQ = (const float*)(F.ws + WS_SSQ) + (size_t)2 * T * 16; const float* CR = (const float*)(F.ws + WS_CR);
    LAS float* W8T = (LAS float*)F.lds;
    for (int i = F.tid; i < 8192; i += NTHREADS) { const int d = i >> 3, j = i & 7; W8T[j * 1024 + d] = a.router_w[i]; }
    __syncthreads();
    for (int row = F.gw; row < T; row += F.ngw) {
        const int b = row / SEQ;
        float acc[8];
#pragma unroll
        for (int e = 0; e < 8; ++e) acc[e] = 0.f;
#pragma unroll
        for (int jj = 0; jj < 2; ++jj) {
            const int d = 512 * jj + 8 * F.lane;
            const u32x4 xv = *(const u32x4*)(XA + (size_t)row * D + d);
            const float x[8] = {bf2f(xv.x & 0xffffu), bf2f(xv.x >> 16), bf2f(xv.y & 0xffffu), bf2f(xv.y >> 16), bf2f(xv.z & 0xffffu), bf2f(xv.z >> 16), bf2f(xv.w & 0xffffu), bf2f(xv.w >> 16)};
#pragma unroll
            for (int e = 0; e < 8; ++e) { const f32x4 wa = *(const LAS f32x4*)(W8T + e * 1024 + d), wb = *(const LAS f32x4*)(W8T + e * 1024 + d + 4);
                acc[e] += ((x[0] * wa.x + x[1] * wa.y) + (x[2] * wa.z + x[3] * wa.w)) + ((x[4] * wb.x + x[5] * wb.y) + (x[6] * wb.z + x[7] * wb.w)); }
        }
        const float ssq = wave_sum(F.lane < 16 ? SSQ[(size_t)row * 16 + F.lane] : 0.f);
        const float rstd = rsqrtf(ssq * (1.0f / D) + EPS);
#pragma unroll
        for (int e = 0; e < 8; ++e) acc[e] = wave_sum(acc[e]);
        if (F.lane == 0) {
            float v0 = -INFINITY, v1 = -INFINITY; int e0 = 0, e1 = 0;
#pragma unroll
            for (int e = 0; e < 8; ++e) { const float lg = rstd * acc[e] + CR[b * 8 + e] + a.router_b[e]; if (lg > v0) { v1 = v0; e1 = e0; v0 = lg; e0 = e; } else if (lg > v1) { v1 = lg; e1 = e; } }
            const float ex = __expf(v1 - v0), p0 = 1.0f / (1.0f + ex), p1 = ex / (1.0f + ex);
            unsigned* cnt = (unsigned*)(F.ws + WS_CTL) + CW_MOECNT;
            const int q0 = (int)atomicAdd(cnt + 64 * e0, 1u), q1 = (int)atomicAdd(cnt + 64 * e1, 1u);
            int* R = (int*)(F.ws + WS_ROUTE) + (size_t)row * 4; R[0] = e0; R[1] = e1; ((float*)R)[2] = p0; ((float*)R)[3] = p1;
            int* Pq = (int*)(F.ws + WS_POS) + (size_t)row * 2; Pq[0] = q0; Pq[1] = q1;
            int* RM = (int*)(F.ws + WS_RMAP); RM[(size_t)e0 * T + q0] = row; RM[(size_t)e1 * T + q1] = row;
        }
    }
    __syncthreads();
}

__global__ void __launch_bounds__(NTHREADS, 2) fwd(Args a) {
    extern __shared__ __attribute__((aligned(16))) unsigned char lds_raw[];
    Frame F;
    F.lds = (LAS unsigned char*)lds_raw;
    F.tid = threadIdx.x; F.lane = F.tid & 63; F.wave = __builtin_amdgcn_readfirstlane(F.tid >> 6);
    F.bid = blockIdx.x; F.nb = gridDim.x; F.gw = F.bid * NWAVES + F.wave; F.ngw = F.nb * NWAVES; F.ws = (GAS unsigned char*)a.ws;
    volatile LAS unsigned* MISC = (volatile LAS unsigned*)(F.lds + MISC_OFF);
    for (int u = F.tid; u < 32; u += NTHREADS) MISC[u] = 0u;
    __syncthreads();
    unsigned* ctl = (unsigned*)(a.ws + WS_CTL);
    const int lo = a.ph_lo, hi = a.ph_hi;
    const bool multi = (hi - lo) > 1;
    XcdBarrier bar; bar.bar = ctl + CW_BAR; bar.x = 0; bar.st = MISC + 8;
    if (multi) bar = xcd_barrier_post(ctl + CW_BAR, MISC + 8);
#define IN(k) (lo <= (k) && (k) < hi && (frame_refresh(F, a, (LAS unsigned char*)lds_raw), true))
#define SEAM(k) do { if (hi > (k) + 1 && lo <= (k)) { xcd_barrier(bar); if constexpr ((PROBE_MASK & 4194304) != 0) xcd_barrier(bar); } } while (0)
    float* MOD = (float*)(a.ws + WS_MOD);
    bf16_t* H = (bf16_t*)(a.ws + WS_H); bf16_t* PROJ = (bf16_t*)(a.ws + WS_PROJ); bf16_t* YMIX = (bf16_t*)(a.ws + WS_YMIX);
    bf16_t* WT = (bf16_t*)(a.ws + WS_WT);
    bf16_t* ACT = (bf16_t*)(a.ws + WS_ACT); bf16_t* ACTM = (bf16_t*)(a.ws + WS_ACTM); bf16_t* YMOE = (bf16_t*)(a.ws + WS_YMOE);

    if (IN(PH_PRO)) { REP(1) { ph_pro_vectors(a, F); ph_pro_weights(a, F); } SEAM(PH_PRO); }

#define TWICE(bit, stmt) do { stmt; if constexpr ((PROBE_MASK & (bit)) != 0) { stmt; } } while (0)
    float* AV = (float*)(a.ws + WS_AV); float* SSQ = (float*)(a.ws + WS_SSQ); bf16_t* X16 = (bf16_t*)(a.ws + WS_X16);
    const LAS float* RSL = (const LAS float*)(F.lds + RS_OFF);
#define LAYER_BODY(l) {\
        const int pb = PH_LAYER0 + PH_PER_LAYER * l; \
        const float* xin = (l == 0) ? a.x : a.out; \
        const float* mod0 = MOD + (size_t)(l * 2 + 0) * 2 * 3072; const float* mod1 = MOD + (size_t)(l * 2 + 1) * 2 * 3072; \
        if (l == 0) { if (IN(pb + K_NORM1)) { REP(2) ph_norm0(a, F); ph_prep_vectors(a, F); SEAM(pb + K_NORM1); } } \
        if (IN(pb + K_GEMM_IN)) { \
            TWICE(4, ({ pg8::Gemm g{H, WT + WT_WIN + (size_t)l * NPW * D, D}; pg8::StaticOrder S; S.init(T, NPW, F.nb, F.bid); rstd_preload(F, S, SSQ + (size_t)(l == 0 ? 3 : 1) * T * 16, nullptr); \
                pg8::EpiProjNorm E{PROJ, RSL, (const float*)(a.ws + (l == 0 ? WS_CVI0 : WS_CVI)), (float*)(a.ws + WS_BG), a.dn_a_log + 4 * l, a.dn_dt_bias + 4 * l}; \
                pg8::gemm_phase<pg8::EpiProjNorm, pg8::StaticOrder, false, true, true>(F.lds, nullptr, g, S, E); })); \
            SEAM(pb + K_GEMM_IN); \
        } \
        if (IN(pb + K_DN_PREP)) { REP(8) ph_dn_chunk(a, F, l); ph_rope(a, F); SEAM(pb + K_DN_PREP); } \
        if (IN(pb + K_MIX)) { REP(16) ph_dn_scan(a, F); REP(512) ph_attn_mfma(a, F, l); REP(1024) ph_conv_fast(a, F, l); SEAM(pb + K_MIX); } \
        if (IN(pb + K_DN_OUT)) { REP(32) ph_dn_out(a, F, l); SEAM(pb + K_DN_OUT); } \
        if (IN(pb + K_GEMM_OUT)) { \
            TWICE(0, ({ pg8::Gemm g{YMIX, WT + WT_WOUT + (size_t)l * D * D, D}; pg8::StaticOrder S; S.init(T, D, F.nb, F.bid); \
                pg8::EpiResidNorm E{X16, X16, mod0 + 2048, AV + (size_t)(l == 0 ? 0 : 2) * BATCH * D, H, SSQ + (size_t)(l == 0 ? 0 : 2) * T * 16}; \
                pg8::gemm_phase<pg8::EpiResidNorm, pg8::StaticOrder, false, true, true>(F.lds, nullptr, g, S, E); })); \
            if constexpr ((PROBE_MASK & 8388608) != 0 && l == 0) { pg8::Gemm g{YMIX, WT + WT_WOUT + (size_t)l * D * D, D}; pg8::StaticOrder S; S.init(T, D, F.nb, F.bid); pg8::EpiBf16 E{(bf16_t*)(a.ws + WS_DN_MR), D, 1 << 20}; \
                pg8::gemm_phase<pg8::EpiBf16, pg8::StaticOrder, false, true, true>(F.lds, nullptr, g, S, E); } \
            if constexpr ((PROBE_MASK & 16777216) != 0 && l == 0) { pg8::Gemm g{YMIX, WT + WT_WOUT + (size_t)l * D * D, D}; pg8::StaticOrder S; S.init(T, D, F.nb, F.bid); \
                pg8::EpiResidNorm E{X16, (bf16_t*)(a.ws + WS_DN_MR), mod0 + 2048, AV, (bf16_t*)(a.ws + WS_DN_MR), (float*)(a.ws + WS_DN_ST)}; \
                pg8::gemm_phase<pg8::EpiResidNorm, pg8::StaticOrder, false, true, true>(F.lds, nullptr, g, S, E); } \
            if constexpr ((PROBE_MASK & 131072) != 0 && l == 0) { pg8::Gemm g{YMIX, WT + WT_WOUT + (size_t)l * D * D, D}; pg8::StaticOrder S; S.init(T, D, F.nb, F.bid); pg8::EpiNull E{}; \
                pg8::gemm_phase<pg8::EpiNull, pg8::StaticOrder, false, true, true>(F.lds, nullptr, g, S, E); } \
            SEAM(pb + K_GEMM_OUT); \
        } \
        if (l == 0) { \
            if (IN(pb + K_FFN1)) { \
                TWICE(256, ({ pg8::Gemm g{H, WT + WT_FGU, D}; pg8::StaticOrder S; S.init(T, 2 * D_FF, F.nb, F.bid); rstd_preload(F, S, SSQ, nullptr); \
                    pg8::EpiSwiGLUNorm E{ACT, D_FF, 1 << 20, RSL, (const float*)(a.ws + WS_CVF), 5632}; \
                    pg8::gemm_phase<pg8::EpiSwiGLUNorm, pg8::StaticOrder, false, true, true>(F.lds, nullptr, g, S, E); })); \
                SEAM(pb + K_FFN1); \
            } \
            if (IN(pb + K_FFN2)) { \
                { pg8::Gemm g{ACT, WT + WT_FD, D_FF}; pg8::StaticOrder S; S.init(T, D, F.nb, F.bid); \
                    pg8::EpiResidNorm E{X16, X16, mod1 + 2048, AV + (size_t)1 * BATCH * D, H, SSQ + (size_t)1 * T * 16}; \
                    pg8::gemm_phase<pg8::EpiResidNorm, pg8::StaticOrder, false, true, true>(F.lds, nullptr, g, S, E); } \
                SEAM(pb + K_FFN2); \
            } \
        } else { \
            if (IN(pb + K_NORM2)) { ph_router(a, F); SEAM(pb + K_NORM2); } \
            if (IN(pb + K_FFN1)) { \
                TWICE(2048, ({ pg8::MoeOrder<8> S; moe_order_init<8>(F, S); moe_ri_preload<8>(F, S); rstd_preload(F, S, SSQ + (size_t)2 * T * 16, (const LAS int*)(F.lds + RI_OFF)); \
                    pg8::Gemm g{H, WT + WT_MGU, D}; pg8::EpiSwiGLUNorm E{ACTM, D_FFE, 8, RSL, (const float*)(a.ws + WS_CVM), 16384}; \
                    pg8::gemm_phase<pg8::EpiSwiGLUNorm, pg8::MoeOrder<8>, true, true, true>(F.lds, (const LAS int*)(F.lds + RI_OFF), g, S, E); })); \
                SEAM(pb + K_FFN1); \
            } \
            if (IN(pb + K_FFN2)) { \
                TWICE(4096, ({ pg8::MoeOrder<4> S; moe_order_init<4>(F, S); \
                    pg8::Gemm g{ACTM, WT + WT_MD, D_FFE}; pg8::EpiBf16W E{YMOE, D, 4}; \
                    pg8::gemm_phase<pg8::EpiBf16W, pg8::MoeOrder<4>, false, true, true>(F.lds, nullptr, g, S, E); })); \
                SEAM(pb + K_FFN2); \
            } \
        } \
    }
    LAYER_BODY(0)
    LAYER_BODY(1)
#undef LAYER_BODY
    if (IN(PH_FINAL)) { ph_final(a, F); }
#undef IN
#undef SEAM
}

extern "C" void kernel_launch(void* const* d_in, const int* in_sizes, int n_in, void* d_out, int out_size, void* d_ws, size_t ws_size, hipStream_t stream) {
    static int grid = 0;
    if (grid == 0) {
        if (n_in != 27 || out_size != T * D || ws_size < WS_END) { fprintf(stderr, "kernel_launch: unexpected shapes n_in %d out %d ws %zu\n", n_in, out_size, ws_size); grid = -1; return; }
        int dev = 0, cus = 0, per_cu = 0;
        if (hipGetDevice(&dev) != hipSuccess || hipDeviceGetAttribute(&cus, hipDeviceAttributeMultiprocessorCount, dev) != hipSuccess) { grid = -1; return; }
        if (hipFuncSetAttribute((const void*)fwd, hipFuncAttributeMaxDynamicSharedMemorySize, LDS_BYTES) != hipSuccess) { fprintf(stderr, "kernel_launch: hipFuncSetAttribute failed\n"); grid = -1; return; }
        if (hipOccupancyMaxActiveBlocksPerMultiprocessor(&per_cu, (const void*)fwd, NTHREADS, LDS_BYTES) != hipSuccess || per_cu < 1) fprintf(stderr, "kernel_launch: occupancy query says %d\n", per_cu);
        (void)hipGetLastError();
        grid = cus;
    }
    if (grid < 0) return;
    (void)hipMemsetAsync((char*)d_ws + WS_CTL, 0, CTL_ZERO_BYTES, stream);
    Args a{};
    const void** pp = (const void**)&a;
    for (int i = 0; i < 27; ++i) pp[i] = d_in[i];
    a.out = (float*)d_out; a.ws = (unsigned char*)d_ws;
#if MK_ONE_LAUNCH
    a.ph_lo = 0; a.ph_hi = NPH;
    hipLaunchKernelGGL(fwd, dim3(grid), dim3(NTHREADS), LDS_BYTES, stream, a);
#else
    static const int phases[] = {0, 1, 2, 3, 4, 5, 6, 7, 9, 10, 11, 12, 13, 14, 15, 16, 17, 18, 19, 20, 21};
    for (int p : phases) { a.ph_lo = p; a.ph_hi = p + 1; hipLaunchKernelGGL(fwd, dim3(grid), dim3(NTHREADS), LDS_BYTES, stream, a); }
#endif
}
```

```cpp
#include <hip/hip_runtime.h>
#include <cstdio>
#include <cstdint>

#define LAS __attribute__((address_space(3)))
#define GAS __attribute__((address_space(1)))
typedef unsigned short bf16_t;
typedef float f32x4 __attribute__((ext_vector_type(4)));
typedef unsigned u32x2 __attribute__((ext_vector_type(2)));
typedef unsigned u32x4 __attribute__((ext_vector_type(4)));

#ifndef GEMM_MASK
#define GEMM_MASK 63
#endif
#ifndef ATTN_MFMA
#define ATTN_MFMA 1
#endif
#ifndef DN_CHUNKED
#define DN_CHUNKED 1
#endif
#ifndef CONV_FAST
#define CONV_FAST 1
#endif
#ifndef PROBE_MASK
#define PROBE_MASK 0
#endif
#define REP(bit) for (int rep_ = 0; rep_ < ((PROBE_MASK & (bit)) ? 2 : 1); ++rep_)
#ifndef MK_ONE_LAUNCH
#define MK_ONE_LAUNCH 1
#endif

constexpr int BATCH = 2, SEQ = 16384, T = BATCH * SEQ, D = 1024, DEPTH = 2;
constexpr int NPW = 2560;
constexpr int N_IN = 2312, NP = 2304;
constexpr int C_AQ = 0, C_AK = 512, C_AV = 640, C_DQ = 768, C_DK = 1024, C_DV = 1280, C_DZ = 1536, C_CA = 1792, C_CB = 2048;
constexpr int W_DB = 1536;
constexpr int D_FF = 2816, NE = 8, D_FFE = 1024;
constexpr int WINDOW = 128, CV_K = 31, CV_C = 256, DN_CONV = 4;
constexpr float EPS = 1e-6f;
constexpr int NSCAN = BATCH * 4 * 4;
constexpr int MOE_CAP = 67584;

constexpr size_t MiB = 1u << 20;
constexpr size_t WS_CTL = 0, CTL_ZERO_BYTES = 1 * MiB;
constexpr size_t WS_MOD = 1 * MiB;
constexpr size_t WS_CS = 2 * MiB;
constexpr size_t WS_BG = 4 * MiB;
constexpr size_t WS_ROUTE = 5 * MiB;
constexpr size_t WS_POS = 6 * MiB;
constexpr size_t WS_RMAP = 7 * MiB;
constexpr size_t WS_WT = 8 * MiB;
constexpr size_t WS_H = 88 * MiB;
constexpr size_t WS_PROJ = 152 * MiB;
constexpr size_t WS_YMIX = 296 * MiB;
constexpr size_t WS_DNQKV = 360 * MiB;
constexpr size_t WS_ODN = 456 * MiB;
constexpr size_t WS_ACT = 152 * MiB;
constexpr size_t WS_ACTM = 152 * MiB;
constexpr size_t WS_YMOE = 284 * MiB;
constexpr size_t WS_X16 = 440 * MiB;
constexpr size_t WS_SSQ = 504 * MiB;
constexpr size_t WS_AV = WS_MOD + 128 * 1024;
constexpr size_t WS_CVF = WS_MOD + 256 * 1024;
constexpr size_t WS_CVI = WS_CVF + 2 * 5632 * 4;
constexpr size_t WS_CVM = WS_CVI + 2 * 2560 * 4;
constexpr size_t WS_CR = WS_CVM + 2 * 16384 * 4;
constexpr size_t WS_CVI0 = WS_CR + 64;
static_assert(WS_CVI0 + 2 * 2560 * 4 <= WS_CS, "vector area");
constexpr size_t WS_END = 512 * MiB;
constexpr int CW_BAR = 4096;
constexpr int CW_MOECNT = 16384;

constexpr int NWAVES = 8, NTHREADS = 512;
constexpr int LDS_BYTES = 163840;
constexpr int MISC_OFF = 131072 + 320;
constexpr int RI_OFF = 132096;
constexpr int RS_OFF = 147456;

constexpr int PH_PRO = 0, PH_LAYER0 = 1, PH_PER_LAYER = 10, PH_FINAL = 21, NPH = 22;
enum { K_NORM1 = 0, K_GEMM_IN, K_DN_PREP, K_MIX, K_DN_OUT, K_GEMM_OUT, K_NORM2, K_MOE_LIST, K_FFN1, K_FFN2 };

struct Args {
    const float* x; const float* c; const int* pos; const float* ada_w; const float* ada_b; const float* nmg; const float* nfg;
    const float* w_in; const float* sinks; const float* dn_conv_w; const float* dn_a_log; const float* dn_dt_bias; const float* dn_norm_g;
    const float* cv_dw_w; const float* cv_dw_b; const float* cv_ln_g; const float* cv_ln_b; const float* w_out;
    const float* ffn_wg; const float* ffn_wu; const float* ffn_wd; const float* router_w; const float* router_b;
    const float* moe_wg; const float* moe_wu; const float* moe_wd; const float* final_g;
    float* out; unsigned char* ws; int ph_lo, ph_hi;
};

__device__ __forceinline__ float bf2f(unsigned u) { return __uint_as_float(u << 16); }
__device__ __forceinline__ unsigned f2bf(float f) { unsigned u = __float_as_uint(f); return (u + 0x7fffu + ((u >> 16) & 1u)) >> 16; }
__device__ __forceinline__ unsigned pk2(float lo, float hi) { return f2bf(lo) | (f2bf(hi) << 16); }
#define DPP_MOV(v, ctrl) __int_as_float(__builtin_amdgcn_update_dpp(0, __float_as_int(v), (ctrl), 0xf, 0xf, false))
__device__ __forceinline__ float row16_sum(float v) { v += DPP_MOV(v, 0xB1); v += DPP_MOV(v, 0x4E); v += DPP_MOV(v, 0x141); v += DPP_MOV(v, 0x140); return v; }
__device__ __forceinline__ float wave_sum(float v) {
    v = row16_sum(v);
    const int vi = __float_as_int(v);
    return (__int_as_float(__builtin_amdgcn_readlane(vi, 0)) + __int_as_float(__builtin_amdgcn_readlane(vi, 16))) + (__int_as_float(__builtin_amdgcn_readlane(vi, 32)) + __int_as_float(__builtin_amdgcn_readlane(vi, 48)));
}
__device__ __forceinline__ float xor32_sum(float v) { const auto r = __builtin_amdgcn_permlane32_swap(__float_as_uint(v), __float_as_uint(v), false, false); return __uint_as_float(r[0]) + __uint_as_float(r[1]); }
__device__ __forceinline__ float xor32_max(float v) { const auto r = __builtin_amdgcn_permlane32_swap(__float_as_uint(v), __float_as_uint(v), false, false); return fmaxf(__uint_as_float(r[0]), __uint_as_float(r[1])); }
__device__ __forceinline__ float xor16_sum(float v) { const auto r = __builtin_amdgcn_permlane16_swap(__float_as_uint(v), __float_as_uint(v), false, false); return __uint_as_float(r[0]) + __uint_as_float(r[1]); }
__device__ __forceinline__ float group8_sum(float v) { v += DPP_MOV(v, 0xB1); v += DPP_MOV(v, 0x4E); v += DPP_MOV(v, 0x141); return v; }
__device__ __forceinline__ float wave_max(float v) {
#pragma unroll
    for (int o = 1; o < 64; o <<= 1) v = fmaxf(v, __shfl_xor(v, o));
    return v;
}
__device__ __forceinline__ float sigmoidf_(float x) { return __builtin_amdgcn_rcpf(1.0f + __builtin_amdgcn_exp2f(x * -1.4426950408889634f)); }
__device__ __forceinline__ float siluf_(float x) { return x * __builtin_amdgcn_rcpf(1.0f + __builtin_amdgcn_exp2f(x * -1.4426950408889634f)); }
__device__ __forceinline__ float softplusf_(float x) { return fmaxf(x, 0.f) + log1pf(__expf(-fabsf(x))); }

#define XB_TMO      128
#define XB_XCNT(j)  (256  + 64 * (j))
#define XB_XSUB(j)  (1280 + 64 * (j))
#define XB_XGEN(j)  (2304 + 64 * (j))
#define XB_TOP      3328
#define XB_TOPGEN   3392
#define XCD_BAR_WORDS 3456
#define XB_SPIN_CAP (1u << 18)

__device__ __forceinline__ unsigned xb_ld(unsigned* p)              { return __hip_atomic_load(p, __ATOMIC_RELAXED, __HIP_MEMORY_SCOPE_AGENT); }
__device__ __forceinline__ unsigned xb_add(unsigned* p, unsigned v) { return __hip_atomic_fetch_add(p, v, __ATOMIC_RELAXED, __HIP_MEMORY_SCOPE_AGENT); }
__device__ __forceinline__ unsigned xb_xcc_id() { return (unsigned)__builtin_amdgcn_s_getreg((3 << 11) | 20) & 0xFu; }
#define XB_SPIN(cond, bar) do { unsigned _sp = 0; while (cond) { __builtin_amdgcn_s_sleep(1); \
    if ((++_sp & 255u) == 0u) { if (xb_ld(&(bar)[XB_TMO])) break; if (_sp > XB_SPIN_CAP) { atomicAdd(&(bar)[XB_TMO], 1u); break; } } } } while (0)

struct XcdBarrier { unsigned* bar; unsigned x; volatile LAS unsigned* st; };

__device__ __forceinline__ XcdBarrier xcd_barrier_post(unsigned* bar, volatile LAS unsigned* st) {
    XcdBarrier b; b.bar = bar; b.x = xb_xcc_id(); b.st = st;
    if (threadIdx.x == 0) (void)xb_add(&bar[XB_XCNT(b.x)], 1u);
    return b;
}
__device__ __forceinline__ void xcd_barrier_complete(unsigned* bar, unsigned x, unsigned& nloc, unsigned& nx) {
    const unsigned G = gridDim.x * gridDim.y * gridDim.z;
    unsigned sum, cnt, mine, sp = 0u;
    for (;;) {
        sum = 0u; cnt = 0u; mine = 0u;
#pragma unroll
        for (unsigned j = 0; j < 16; ++j) { const unsigned c = xb_ld(&bar[XB_XCNT(j)]); sum += c; cnt += (c > 0u) ? 1u : 0u; mine = (j == x) ? c : mine; }
        if (sum == G) break;
        __builtin_amdgcn_s_sleep(1);
        if ((++sp & 255u) == 0u) { if (xb_ld(&bar[XB_TMO])) break; if (sp > XB_SPIN_CAP) { atomicAdd(&bar[XB_TMO], 1u); break; } }
    }
    nloc = mine > 0u ? mine : 1u; nx = cnt > 0u ? cnt : 1u;
}
__device__ __forceinline__ void xcd_barrier(const XcdBarrier& b) {
    asm volatile("s_waitcnt vmcnt(0)" ::: "memory");
    __syncthreads();
    if (threadIdx.x == 0) {
        unsigned* bar = b.bar;
        __builtin_amdgcn_s_waitcnt(0);
        unsigned nloc = b.st[0], nx = b.st[1];
        if (nloc == 0u) { xcd_barrier_complete(bar, b.x, nloc, nx); b.st[0] = nloc; b.st[1] = nx; }
        const unsigned old = xb_add(&bar[XB_XSUB(b.x)], 1u);
        const unsigned gen = old / nloc;
        if (old + 1u == (gen + 1u) * nloc) {
            __builtin_amdgcn_fence(__ATOMIC_RELEASE, "agent");
            asm volatile("s_waitcnt vmcnt(0)" ::: "memory");
            const unsigned og = xb_add(&bar[XB_TOP], 1u);
            const unsigned tg = og / nx;
            if (og + 1u == (tg + 1u) * nx) xb_add(&bar[XB_TOPGEN], 1u);
            else XB_SPIN(xb_ld(&bar[XB_TOPGEN]) == tg, bar);
            __builtin_amdgcn_fence(__ATOMIC_ACQUIRE, "agent");
            xb_add(&bar[XB_XGEN(b.x)], 1u);
            asm volatile("s_waitcnt vmcnt(0)" ::: "memory");
        } else {
            XB_SPIN(xb_ld(&bar[XB_XGEN(b.x)]) == gen, bar);
            __builtin_amdgcn_fence(__ATOMIC_ACQUIRE, "agent");
            asm volatile("s_waitcnt vmcnt(0)" ::: "memory");
        }
    }
    __syncthreads();
}

struct Frame {
    LAS unsigned char* lds;
    int tid, lane, wave, gw, ngw, bid, nb;
    GAS unsigned char* ws;
};

__device__ __forceinline__ void frame_refresh(Frame& F, const Args& a, LAS unsigned char* lds) {
    int tid = threadIdx.x; asm volatile("" : "+v"(tid));
    int bid = blockIdx.x; asm volatile("" : "+s"(bid));
    unsigned char* ws = a.ws; asm volatile("" : "+s"(ws));
    F.lds = lds; F.tid = tid; F.lane = tid & 63; F.wave = __builtin_amdgcn_readfirstlane(tid >> 6);
    F.bid = bid; F.nb = gridDim.x; F.gw = F.bid * NWAVES + F.wave; F.ngw = F.nb * NWAVES; F.ws = (GAS unsigned char*)ws;
}
__device__ __forceinline__ void ph_pro_vectors(const Args& a, Frame& F) {
    float* MOD = (float*)(F.ws + WS_MOD);
    LAS float* red = (LAS float*)F.lds;
    for (int it = F.bid; it < 4 * 48; it += F.nb) {
        const int lk = it / 48, cg = it % 48, e = cg * 64 + F.lane;
        const float* W = a.ada_w + (size_t)lk * D * 3072 + e;
        float a0 = 0.f, a1 = 0.f;
        const int d0 = F.wave * 128;
#pragma unroll 8
        for (int d = d0; d < d0 + 128; ++d) {
            const float w = __builtin_nontemporal_load(W + (size_t)d * 3072);
            a0 += siluf_(a.c[d]) * w; a1 += siluf_(a.c[D + d]) * w;
        }
        red[(F.wave * 2 + 0) * 64 + F.lane] = a0; red[(F.wave * 2 + 1) * 64 + F.lane] = a1;
        __syncthreads();
        if (F.wave < 2) {
            float s = 0.f;
            for (int w = 0; w < 8; ++w) s += red[(w * 2 + F.wave) * 64 + F.lane];
            MOD[((size_t)lk * 2 + F.wave) * 3072 + e] = s + a.ada_b[lk * 3072 + e];
        }
        __syncthreads();
    }
    float* CS = (float*)(F.ws + WS_CS);
    for (int idx = F.bid * NTHREADS + F.tid; idx < T * 8; idx += F.nb * NTHREADS) {
        const int t = idx >> 3, i = idx & 7;
        const float inv = powf(500000.0f, -(float)(2 * i) / 16.0f);
        const float ang = (float)a.pos[t] * inv;
        CS[t * 16 + i] = cosf(ang); CS[t * 16 + 8 + i] = sinf(ang);
    }
}

template <int MODE>
__device__ __forceinline__ void ph_norm(const Args& a, Frame& F, int l, const float* xin, const float* gain, const float* modk  ,
                                        const float* W8, int pitch) {
    bf16_t* H = (bf16_t*)(F.ws + WS_H);
    LAS float* W8T = (LAS float*)F.lds;
    if (MODE != 0) {
        for (int i = F.tid; i < 8192; i += NTHREADS) { const int d = i >> 3, j = i & 7; W8T[j * 1024 + d] = W8[(size_t)d * pitch + j]; }
        __syncthreads();
    }
    f32x4 vn[4], A4[4], B4[4]; int cur_b = -1;
    if (F.gw < T) {
#pragma unroll
        for (int j = 0; j < 4; ++j) vn[j] = ((const f32x4*)(xin + (size_t)F.gw * D) + F.lane)[64 * j];
    }
    for (int row = F.gw; row < T; row += F.ngw) {
        const int b = row / SEQ;
        f32x4 v[4]; float ss = 0.f;
#pragma unroll
        for (int j = 0; j < 4; ++j) { v[j] = vn[j]; ss += (v[j].x * v[j].x + v[j].y * v[j].y) + (v[j].z * v[j].z + v[j].w * v[j].w); }
        if (row + F.ngw < T) {
#pragma unroll
            for (int j = 0; j < 4; ++j) vn[j] = ((const f32x4*)(xin + (size_t)(row + F.ngw) * D) + F.lane)[64 * j];
        }
        if (b != cur_b) {
            cur_b = b; const float* sh = modk + (size_t)b * 3072; const float* sc = sh + 1024;
#pragma unroll
            for (int j = 0; j < 4; ++j) { const int d = 256 * j + 4 * F.lane; A4[j] = *(const f32x4*)(gain + d) * (*(const f32x4*)(sc + d) + 1.0f); B4[j] = *(const f32x4*)(sh + d); }
        }
        const float rstd = rsqrtf(wave_sum(ss) * (1.0f / D) + EPS);
        float acc[8];
#pragma unroll
        for (int e = 0; e < 8; ++e) acc[e] = 0.f;
#pragma unroll
        for (int j = 0; j < 4; ++j) {
            const int d = 256 * j + 4 * F.lane;
            const f32x4 hv = (v[j] * rstd) * A4[j] + B4[j];
            u32x2 o; o.x = pk2(hv.x, hv.y); o.y = pk2(hv.z, hv.w);
            *(u32x2*)(H + (size_t)row * D + d) = o;
            if (MODE == 1) { u32x2 xo; xo.x = pk2(v[j].x, v[j].y); xo.y = pk2(v[j].z, v[j].w); *(u32x2*)((bf16_t*)(F.ws + WS_X16) + (size_t)row * D + d) = xo; }
            if (MODE != 0) {
#pragma unroll
                for (int e = 0; e < 8; ++e) { const f32x4 w4 = *(const LAS f32x4*)(W8T + e * 1024 + d); acc[e] += (hv.x * w4.x + hv.y * w4.y) + (hv.z * w4.z + hv.w * w4.w); }
            }
        }
        if (MODE != 0) {
#pragma unroll
            for (int e = 0; e < 8; ++e) acc[e] = wave_sum(acc[e]);
        }
        if (MODE == 1 && F.lane == 0) {
            float* BG = (float*)(F.ws + WS_BG) + (size_t)row * 8;
#pragma unroll
            for (int h = 0; h < 4; ++h) {
                BG[h] = sigmoidf_(acc[h]);
                BG[4 + h] = -__expf(a.dn_a_log[l * 4 + h]) * softplusf_(acc[4 + h] + a.dn_dt_bias[l * 4 + h]);
            }
        }
        if (MODE == 2 && F.lane == 0) {
            float v0 = -INFINITY, v1 = -INFINITY; int e0 = 0, e1 = 0;
#pragma unroll
            for (int e = 0; e < 8; ++e) { const float lg = acc[e] + a.router_b[e]; if (lg > v0) { v1 = v0; e1 = e0; v0 = lg; e0 = e; } else if (lg > v1) { v1 = lg; e1 = e; } }
            const float ex = __expf(v1 - v0), p0 = 1.0f / (1.0f + ex), p1 = ex / (1.0f + ex);
            unsigned* cnt = (unsigned*)(F.ws + WS_CTL) + CW_MOECNT;
            const int q0 = (int)atomicAdd(cnt + 64 * e0, 1u), q1 = (int)atomicAdd(cnt + 64 * e1, 1u);
            int* R = (int*)(F.ws + WS_ROUTE) + (size_t)row * 4; R[0] = e0; R[1] = e1; ((float*)R)[2] = p0; ((float*)R)[3] = p1;
            int* P = (int*)(F.ws + WS_POS) + (size_t)row * 2; P[0] = q0; P[1] = q1;
        }
    }
    if (MODE != 0) __syncthreads();
}

typedef float f32x16 __attribute__((ext_vector_type(16)));
typedef short s16x4 __attribute__((ext_vector_type(4)));
typedef short bf16x8_t __attribute__((ext_vector_type(8)));
__device__ __forceinline__ unsigned cvtpk(float lo, float hi) { typedef float f2_t __attribute__((ext_vector_type(2))); typedef __bf16 b2_t __attribute__((ext_vector_type(2)));
    f2_t v = {lo, hi}; b2_t b = __builtin_convertvector(v, b2_t); return __builtin_bit_cast(unsigned, b); }
__device__ __forceinline__ void ph_rope(const Args& a, Frame& F) {
    bf16_t* P = (bf16_t*)(F.ws + WS_PROJ); const float* CS = (const float*)(F.ws + WS_CS);
    for (int it = F.bid * NTHREADS + F.tid; it < T * 10; it += F.nb * NTHREADS) {
        const int t = it / 10, hh = it % 10;
        bf16_t* p = P + (size_t)t * NP + hh * 64;
        const u32x4 x1 = *(const u32x4*)p, x2 = *(const u32x4*)(p + 8);
        const f32x4 c0 = *(const f32x4*)(CS + (size_t)t * 16), c1 = *(const f32x4*)(CS + (size_t)t * 16 + 4), s0 = *(const f32x4*)(CS + (size_t)t * 16 + 8), s1 = *(const f32x4*)(CS + (size_t)t * 16 + 12);
        const float cs[8] = {c0.x, c0.y, c0.z, c0.w, c1.x, c1.y, c1.z, c1.w}, sn[8] = {s0.x, s0.y, s0.z, s0.w, s1.x, s1.y, s1.z, s1.w};
        const unsigned xa[4] = {x1.x, x1.y, x1.z, x1.w}, xb[4] = {x2.x, x2.y, x2.z, x2.w};
        unsigned ra[4], rb[4];
#pragma unroll
        for (int i = 0; i < 4; ++i) {
            const float a0 = bf2f(xa[i] & 0xffffu), a1 = bf2f(xa[i] >> 16), b0 = bf2f(xb[i] & 0xffffu), b1 = bf2f(xb[i] >> 16);
            ra[i] = pk2(a0 * cs[2 * i] - b0 * sn[2 * i], a1 * cs[2 * i + 1] - b1 * sn[2 * i + 1]);
            rb[i] = pk2(b0 * cs[2 * i] + a0 * sn[2 * i], b1 * cs[2 * i + 1] + a1 * sn[2 * i + 1]);
        }
        *(u32x4*)p = (u32x4){ra[0], ra[1], ra[2], ra[3]}; *(u32x4*)(p + 8) = (u32x4){rb[0], rb[1], rb[2], rb[3]};
    }
}
constexpr int AT_KROW = 144, AT_VOFF = 256 * AT_KROW;
__device__ __forceinline__ void ph_attn_mfma(const Args& a, Frame& F, int l) {
    const bf16_t* P = (const bf16_t*)(F.ws + WS_PROJ); bf16_t* Y = (bf16_t*)(F.ws + WS_YMIX);
    LAS unsigned char* Kl = F.lds; LAS unsigned char* Vl = F.lds + AT_VOFF;
    const int lane = F.lane, r = lane & 31, h = lane >> 5, g = F.wave >> 1, qh = F.wave & 1;
    const int i16 = lane & 15, tq_ = i16 >> 2, tp_ = i16 & 3, g16 = (lane >> 4) & 1, sw = (tq_ >> 1) & 1;
    const int vlane = (4 * h + tq_) * 128 + (2 * g16 + (tp_ >> 1)) * 16 + (tp_ & 1) * 8;
    const float C = 0.125f * 1.4426950408889634f;
    const int nsc = NSCAN;
    if (F.bid < nsc) return;
    u32x4 kreg[4], vreg[4];
#define AT_LOAD(uu) { const int hk_ = (uu) & 1, n_ = ((uu) >> 1) & 127, b_ = (uu) >> 8, tk0_ = b_ * SEQ + n_ * 128 - 128; \
        _Pragma("unroll") for (int i = 0; i < 4; ++i) { const int piece = F.tid + NTHREADS * i, key = piece >> 3, c = piece & 7; \
            const bf16_t* rowp = P + (size_t)(tk0_ + ((n_ > 0 || key >= 128) ? key : key + 128)) * NP; \
            kreg[i] = *(const u32x4*)(rowp + C_AK + hk_ * 64 + c * 8); vreg[i] = *(const u32x4*)(rowp + C_AV + hk_ * 64 + c * 8); } }
    if (F.bid - nsc < BATCH * 128 * 2) AT_LOAD(F.bid - nsc)
    for (int u = F.bid - nsc; u < BATCH * 128 * 2; u += F.nb - nsc) {
        const int hk = u & 1, n = (u >> 1) & 127, b = u >> 8;
        const int tq0 = b * SEQ + n * 128;
        __syncthreads();
#pragma unroll
        for (int i = 0; i < 4; ++i) {
            const int piece = F.tid + NTHREADS * i, key = piece >> 3, c = piece & 7;
            const bool ok = (n > 0 || key >= 128);
            const u32x4 z4 = (u32x4){0u, 0u, 0u, 0u};
            *(LAS u32x4*)(Kl + key * AT_KROW + c * 16) = ok ? kreg[i] : z4;
            *(LAS u32x4*)(Vl + key * 128 + ((c ^ (((key >> 1) & 1) << 2)) * 16)) = ok ? vreg[i] : z4;
        }
        __syncthreads();
        if (u + (F.nb - nsc) < BATCH * 128 * 2) AT_LOAD(u + (F.nb - nsc))
        asm volatile("" ::: "memory");
        const int hq = hk * 4 + g;
        const float sinkl = a.sinks[l * 8 + hq] * 1.4426950408889634f;
#pragma unroll 1
        for (int sb = 0; sb < 2; ++sb) {
            const int q0 = qh * 64 + sb * 32, kt0 = qh * 2 + sb;
            const size_t tq = (size_t)(tq0 + q0 + r);
            bf16x8_t qf[4];
#pragma unroll
            for (int ks = 0; ks < 4; ++ks) qf[ks] = *(const bf16x8_t*)(P + tq * NP + hq * 64 + 16 * ks + 8 * h);
            f32x16 S[5];
#pragma unroll
            for (int kr = 0; kr < 5; ++kr) {
                f32x16 acc;
#pragma unroll
                for (int i = 0; i < 16; ++i) acc[i] = 0.f;
#pragma unroll
                for (int ks = 0; ks < 4; ++ks) { const bf16x8_t kf = *(const LAS bf16x8_t*)(Kl + (32 * (kt0 + kr) + r) * AT_KROW + (16 * ks + 8 * h) * 2);
                    acc = __builtin_amdgcn_mfma_f32_32x32x16_bf16(kf, qf[ks], acc, 0, 0, 0); }
                S[kr] = acc;
            }
            float m = sinkl;
#pragma unroll
            for (int kr = 0; kr < 5; ++kr) {
                const bool tile_ok = !(n == 0 && (kt0 + kr) < 4);
#pragma unroll
                for (int i = 0; i < 16; ++i) {
                    const int kl = (i & 3) + 8 * (i >> 2) + 4 * h;
                    bool ok = tile_ok; if (kr == 0) ok = ok && (kl > r); if (kr == 4) ok = ok && (kl <= r);
                    const float sv = ok ? S[kr][i] * C : -INFINITY; S[kr][i] = sv; m = fmaxf(m, sv);
                }
            }
            m = xor32_max(m);
            float lsum = 0.f;
#pragma unroll
            for (int kr = 0; kr < 5; ++kr)
#pragma unroll
                for (int i = 0; i < 16; ++i) { const float p = __builtin_amdgcn_exp2f(S[kr][i] - m); S[kr][i] = p; lsum += p; }
            lsum = xor32_sum(lsum); lsum += __builtin_amdgcn_exp2f(sinkl - m);
            f32x16 O0, O1;
#pragma unroll
            for (int i = 0; i < 16; ++i) { O0[i] = 0.f; O1[i] = 0.f; }
#pragma unroll
            for (int kr = 0; kr < 5; ++kr) {
#pragma unroll
                for (int s2 = 0; s2 < 2; ++s2) {
                    u32x4 pw; pw.x = cvtpk(S[kr][8 * s2 + 0], S[kr][8 * s2 + 1]); pw.y = cvtpk(S[kr][8 * s2 + 2], S[kr][8 * s2 + 3]); pw.z = cvtpk(S[kr][8 * s2 + 4], S[kr][8 * s2 + 5]); pw.w = cvtpk(S[kr][8 * s2 + 6], S[kr][8 * s2 + 7]);
                    const bf16x8_t pf = __builtin_bit_cast(bf16x8_t, pw);
                    const int kb = (32 * (kt0 + kr) + 16 * s2) * 128 + vlane;
                    const s16x4 lo0 = __builtin_amdgcn_ds_read_tr16_b64_v4i16((LAS s16x4*)(Vl + kb + (0 ^ sw) * 64));
                    const s16x4 hi0 = __builtin_amdgcn_ds_read_tr16_b64_v4i16((LAS s16x4*)(Vl + kb + 8 * 128 + (0 ^ sw) * 64));
                    const s16x4 lo1 = __builtin_amdgcn_ds_read_tr16_b64_v4i16((LAS s16x4*)(Vl + kb + (1 ^ sw) * 64));
                    const s16x4 hi1 = __builtin_amdgcn_ds_read_tr16_b64_v4i16((LAS s16x4*)(Vl + kb + 8 * 128 + (1 ^ sw) * 64));
                    const bf16x8_t va0 = __builtin_shufflevector(lo0, hi0, 0, 1, 2, 3, 4, 5, 6, 7), va1 = __builtin_shufflevector(lo1, hi1, 0, 1, 2, 3, 4, 5, 6, 7);
                    O0 = __builtin_amdgcn_mfma_f32_32x32x16_bf16(va0, pf, O0, 0, 0, 0);
                    O1 = __builtin_amdgcn_mfma_f32_32x32x16_bf16(va1, pf, O1, 0, 0, 0);
                }
            }
            const float inv = __builtin_amdgcn_rcpf(lsum);
            bf16_t* yp = Y + tq * D + hq * 64 + 4 * h;
#pragma unroll
            for (int gq = 0; gq < 4; ++gq) {
                u32x2 o0; o0.x = cvtpk(O0[4 * gq] * inv, O0[4 * gq + 1] * inv); o0.y = cvtpk(O0[4 * gq + 2] * inv, O0[4 * gq + 3] * inv);
                u32x2 o1; o1.x = cvtpk(O1[4 * gq] * inv, O1[4 * gq + 1] * inv); o1.y = cvtpk(O1[4 * gq + 2] * inv, O1[4 * gq + 3] * inv);
                *(u32x2*)(yp + 8 * gq) = o0; *(u32x2*)(yp + 32 + 8 * gq) = o1;
            }
        }
    }
    __syncthreads();
}


#undef AT_LOAD
constexpr size_t WS_DN_MR = 360 * MiB, WS_DN_BNT = 376 * MiB, WS_DN_QP = 392 * MiB, WS_DN_OLT = 408 * MiB, WS_DN_ST = 424 * MiB;
constexpr int DL = 72, LB = 9216;
constexpr int L_KR = 0, L_KT = LB, L_QR = 2 * LB, L_VT = 3 * LB, L_AR = 4 * LB, L_T1 = 5 * LB, L_T2 = 6 * LB, L_UT = 7 * LB, L_UPT = 8 * LB, L_WPT = 9 * LB, L_WT = 0;
constexpr int L_LR = 7 * LB, L_L21 = L_LR + 17408, L_T11T = L_L21 + 4608, L_T22R = L_T11T + 4608, L_YT = L_T22R + 4608, L_GC = 100352, L_BETA = L_GC + 256;
static_assert(L_YT + 4608 == L_GC && L_GC + 512 <= 131072, "DeltaNet LDS map");
template <int KS> __device__ __forceinline__ f32x4 mm16(const LAS unsigned char* lds, int offX, int offY, int tx, int ty, int lane) {
    f32x4 acc = (f32x4){0.f, 0.f, 0.f, 0.f};
    const int l15 = lane & 15, q = lane >> 4;
#pragma unroll
    for (int ks = 0; ks < KS; ++ks) {
        const bf16x8_t xa = *(const LAS bf16x8_t*)(lds + offX + ((16 * tx + l15) * DL + 32 * ks + 8 * q) * 2);
        const bf16x8_t yb = *(const LAS bf16x8_t*)(lds + offY + ((16 * ty + l15) * DL + 32 * ks + 8 * q) * 2);
        acc = __builtin_amdgcn_mfma_f32_16x16x32_bf16(xa, yb, acc, 0, 0, 0);
    }
    return acc;
}
__device__ __forceinline__ u32x2 pack4(f32x4 v) { u32x2 o; o.x = cvtpk(v.x, v.y); o.y = cvtpk(v.z, v.w); return o; }

__device__ __forceinline__ void ph_dn_chunk(const Args& a, Frame& F, int l) {
    const bf16_t* P = (const bf16_t*)(F.ws + WS_PROJ); const float* BG = (const float*)(F.ws + WS_BG);
    bf16_t* MR = (bf16_t*)(F.ws + WS_DN_MR); bf16_t* BNT = (bf16_t*)(F.ws + WS_DN_BNT); bf16_t* QP = (bf16_t*)(F.ws + WS_DN_QP); bf16_t* OLT = (bf16_t*)(F.ws + WS_DN_OLT);
    LAS unsigned char* lds = F.lds;
    LAS float* gcL = (LAS float*)(lds + L_GC); LAS float* betaL = (LAS float*)(lds + L_BETA);
    const float* cw = a.dn_conv_w + (size_t)l * DN_CONV * 768;
    const int lane = F.lane, w = F.wave, l15 = lane & 15, q4 = lane >> 4;
    LAS float* cwL = (LAS float*)(lds + L_GC + 512);
    int cur_h = -1;
    const int ci = F.tid >> 3, c8 = F.tid & 7;
    u32x4 xr[3][4]; float bgb = 0.f, bgg = 0.f;
#define CH_LOAD(vu_) { const int n_ = ((vu_) >> 2) & 255, h_ = (vu_) & 3, b_ = (vu_) >> 10; const int t_ = b_ * SEQ + n_ * 64 + ci; \
        _Pragma("unroll") for (int kd = 0; kd < 3; ++kd) _Pragma("unroll") for (int k = 0; k < DN_CONV; ++k) { \
            const int tt_ = (n_ * 64 + ci - (DN_CONV - 1) + k >= 0) ? t_ - (DN_CONV - 1) + k : t_; xr[kd][k] = *(const u32x4*)(P + (size_t)tt_ * NP + C_DQ + kd * 256 + h_ * 64 + c8 * 8); } \
        if (w == 0) { bgb = BG[(size_t)(b_ * SEQ + n_ * 64 + lane) * 8 + h_]; bgg = BG[(size_t)(b_ * SEQ + n_ * 64 + lane) * 8 + 4 + h_]; } }
    if (F.bid < BATCH * 4 * 256) CH_LOAD(F.bid)
    for (int vu = F.bid; vu < BATCH * 4 * 256; vu += F.nb) {
        const int n = (vu >> 2) & 255, h = vu & 3, b = vu >> 10, unit = (b * 4 + h) * 256 + n;
        const int t0 = b * SEQ + n * 64;
        __syncthreads();
        if (h != cur_h) { cur_h = h;
            for (int idx = F.tid; idx < DN_CONV * 3 * 64; idx += NTHREADS) { const int k = idx / 192, kd = (idx / 64) % 3, cc = idx & 63; cwL[idx] = cw[k * 768 + kd * 256 + h * 64 + cc]; }
            __syncthreads(); }
        {
            const int i = ci, sq = n * 64 + i;
#pragma unroll
            for (int kd = 0; kd < 3; ++kd) {
                float acc[8];
#pragma unroll
                for (int e = 0; e < 8; ++e) acc[e] = 0.f;
#pragma unroll
                for (int k = 0; k < DN_CONV; ++k) {
                    const u32x4 xv = xr[kd][k]; const float vm = (sq - (DN_CONV - 1) + k >= 0) ? 1.f : 0.f;
                    const f32x4 w0 = *(const LAS f32x4*)(cwL + (k * 3 + kd) * 64 + c8 * 8) * vm, w1 = *(const LAS f32x4*)(cwL + (k * 3 + kd) * 64 + c8 * 8 + 4) * vm;
                    acc[0] += w0.x * bf2f(xv.x & 0xffffu); acc[1] += w0.y * bf2f(xv.x >> 16); acc[2] += w0.z * bf2f(xv.y & 0xffffu); acc[3] += w0.w * bf2f(xv.y >> 16);
                    acc[4] += w1.x * bf2f(xv.z & 0xffffu); acc[5] += w1.y * bf2f(xv.z >> 16); acc[6] += w1.z * bf2f(xv.w & 0xffffu); acc[7] += w1.w * bf2f(xv.w >> 16);
                }
                float ss = 0.f;
#pragma unroll
                for (int e = 0; e < 8; ++e) { acc[e] = siluf_(acc[e]); ss += acc[e] * acc[e]; }
                if (kd < 2) {
                    ss = group8_sum(ss);
                    const float rn = rsqrtf(ss + EPS) * (kd == 0 ? 0.125f : 1.0f);
#pragma unroll
                    for (int e = 0; e < 8; ++e) acc[e] *= rn;
                }
                u32x4 pk; pk.x = cvtpk(acc[0], acc[1]); pk.y = cvtpk(acc[2], acc[3]); pk.z = cvtpk(acc[4], acc[5]); pk.w = cvtpk(acc[6], acc[7]);
                if (kd == 0) *(LAS u32x4*)(lds + L_QR + (i * DL + c8 * 8) * 2) = pk;
                if (kd == 1) *(LAS u32x4*)(lds + L_KR + (i * DL + c8 * 8) * 2) = pk;
                if (kd >= 1) {
                    LAS bf16_t* Tt = (LAS bf16_t*)(lds + (kd == 1 ? L_KT : L_VT));
                    const unsigned pw[4] = {pk.x, pk.y, pk.z, pk.w};
#pragma unroll
                    for (int e = 0; e < 8; ++e) Tt[(c8 * 8 + e) * DL + i] = (bf16_t)((pw[e >> 1] >> (16 * (e & 1))) & 0xffffu);
                }
            }
            for (int idx = F.tid; idx < 2 * LB / 16; idx += NTHREADS) *(LAS u32x4*)(lds + L_T1 + idx * 16) = (u32x4){0u, 0u, 0u, 0u};
            if (w == 0) {
                float x = bgg;
#pragma unroll
                for (int o = 1; o < 64; o <<= 1) { const float y = __shfl_up(x, o); if (lane >= o) x += y; }
                gcL[lane] = x; betaL[lane] = bgb;
            }
            if (vu + F.nb < BATCH * 4 * 256) CH_LOAD(vu + F.nb)
            asm volatile("" ::: "memory");
        }
        __syncthreads();
        REP(134217728)
#pragma unroll
        for (int tt = 0; tt < 2; ++tt) {
            const int tidx = 2 * w + tt, tx = tidx >> 2, ty = tidx & 3, i = 16 * ty + l15, j0 = 16 * tx + 4 * q4;
            const float gi = gcL[i], bi = betaL[i]; const f32x4 gj = *(const LAS f32x4*)(gcL + j0);
            const float gjv[4] = {gj.x, gj.y, gj.z, gj.w};
            const f32x4 zk = mm16<2>(lds, L_KR, L_KR, tx, ty, lane);
            const f32x4 zq = mm16<2>(lds, L_KR, L_QR, tx, ty, lane);
            f32x4 lv, av;
#pragma unroll
            for (int r = 0; r < 4; ++r) { const float dc = __expf(fminf(gi - gjv[r], 0.f)); lv[r] = (j0 + r < i) ? bi * zk[r] * dc : 0.f; av[r] = (j0 + r <= i) ? zq[r] * dc : 0.f; }
            *(LAS f32x4*)(lds + L_LR + (i * 68 + j0) * 4) = lv;
            if (i >= 32 && j0 < 32) *(LAS u32x2*)(lds + L_L21 + ((i - 32) * DL + j0) * 2) = pack4(lv);
            *(LAS u32x2*)(lds + L_AR + (i * DL + j0) * 2) = pack4(av);
        }
        __syncthreads();
        REP(32768) {
            const int cg = 8 * w + (lane >> 3), blk = cg >> 5, jp = cg & 31, l8 = lane & 7;
            const LAS float* Lb = (const LAS float*)(lds + L_LR) + (32 * blk) * 68 + 32 * blk + 4 * l8;
            float x0 = 0.f, x1 = 0.f, x2 = 0.f, x3 = 0.f;
#pragma unroll
            for (int i = 0; i < 32; ++i) {
                const f32x4 l4 = *(const LAS f32x4*)(Lb + i * 68);
                float part = (l4.x * x0 + l4.y * x1) + (l4.z * x2 + l4.w * x3);
                part = group8_sum(part);
                const float xi = ((i == jp) ? 1.f : 0.f) - part;
                if (l8 == (i >> 2)) { if ((i & 3) == 0) x0 = xi; else if ((i & 3) == 1) x1 = xi; else if ((i & 3) == 2) x2 = xi; else x3 = xi; }
            }
            const int jg = 32 * blk + jp; const float bj = betaL[jg], bej = bj * __expf(gcL[jg]);
            LAS bf16_t* T1 = (LAS bf16_t*)(lds + L_T1); LAS bf16_t* T2 = (LAS bf16_t*)(lds + L_T2);
            const float xs[4] = {x0, x1, x2, x3};
#pragma unroll
            for (int e = 0; e < 4; ++e) { const int rg = 32 * blk + 4 * l8 + e; T1[rg * DL + jg] = (bf16_t)f2bf(xs[e] * bj); T2[rg * DL + jg] = (bf16_t)f2bf(xs[e] * bej); }
            if (blk == 0) { *(LAS u32x2*)(lds + L_T11T + (jp * DL + 4 * l8) * 2) = pack4((f32x4){x0, x1, x2, x3}); }
            else { LAS bf16_t* T22 = (LAS bf16_t*)(lds + L_T22R);
#pragma unroll
                for (int e = 0; e < 4; ++e) T22[(4 * l8 + e) * DL + jp] = (bf16_t)f2bf(xs[e]); }
        }
        __syncthreads();
        if (w < 4) {
            const int tx = w >> 1, ty = w & 1;
            const f32x4 z = mm16<1>(lds, L_L21, L_T11T, tx, ty, lane);
            *(LAS u32x2*)(lds + L_YT + ((16 * ty + l15) * DL + 16 * tx + 4 * q4) * 2) = pack4(z);
        }
        __syncthreads();
        if (w < 4) {
            const int tx = w >> 1, ty = w & 1, y = 16 * ty + l15, x0 = 16 * tx + 4 * q4;
            const f32x4 z = mm16<1>(lds, L_T22R, L_YT, tx, ty, lane);
            const float bj = betaL[y], bej = bj * __expf(gcL[y]);
            LAS bf16_t* T1 = (LAS bf16_t*)(lds + L_T1); LAS bf16_t* T2 = (LAS bf16_t*)(lds + L_T2);
#pragma unroll
            for (int r = 0; r < 4; ++r) { T1[(32 + x0 + r) * DL + y] = (bf16_t)f2bf(-z[r] * bj); T2[(32 + x0 + r) * DL + y] = (bf16_t)f2bf(-z[r] * bej); }
        }
        __syncthreads();
        const float gl = gcL[63];
        REP(268435456)
#pragma unroll
        for (int tt = 0; tt < 2; ++tt) {
            const int tidx = 2 * w + tt, tx = tidx >> 2, ty = tidx & 3, y = 16 * ty + l15, x0 = 16 * tx + 4 * q4;
            const f32x4 gx = *(const LAS f32x4*)(gcL + x0);
            f32x4 sc; sc.x = __expf(gl - gx.x); sc.y = __expf(gl - gx.y); sc.z = __expf(gl - gx.z); sc.w = __expf(gl - gx.w);
            const f32x4 zu = mm16<2>(lds, L_T1, L_VT, tx, ty, lane);
            const f32x4 zw = mm16<2>(lds, L_T2, L_KT, tx, ty, lane);
            *(LAS u32x2*)(lds + L_UT + (y * DL + x0) * 2) = pack4(zu); *(LAS u32x2*)(lds + L_UPT + (y * DL + x0) * 2) = pack4(zu * sc);
            *(LAS u32x2*)(lds + L_WT + (y * DL + x0) * 2) = pack4(zw); *(LAS u32x2*)(lds + L_WPT + (y * DL + x0) * 2) = pack4(zw * sc);
        }
        __syncthreads();
        REP(65536) {
            const size_t cho = (size_t)unit * 4096;
            const float egl = __expf(gl);
#pragma unroll
            for (int tt = 0; tt < 2; ++tt) {
                const int tidx = 2 * w + tt, tx = tidx >> 2, ty = tidx & 3, y = 16 * ty + l15, x0 = 16 * tx + 4 * q4;
                f32x4 zm = mm16<2>(lds, L_WPT, L_KT, tx, ty, lane);
#pragma unroll
                for (int r = 0; r < 4; ++r) zm[r] = ((x0 + r) == y ? egl : 0.f) - zm[r];
                *(u32x2*)(MR + cho + (ty * 2 + (tx >> 1)) * 512 + lane * 8 + 4 * (tx & 1)) = pack4(zm);
                const f32x4 zb = mm16<2>(lds, L_KT, L_UPT, tx, ty, lane);
                *(u32x2*)(BNT + cho + (ty * 4 + tx) * 256 + lane * 4) = pack4(zb);
                const f32x4 zq = mm16<2>(lds, L_WT, L_AR, tx, ty, lane);
                const u32x2 qv = *(const LAS u32x2*)(lds + L_QR + (y * DL + x0) * 2); const float eg = __expf(gcL[y]);
                f32x4 qp; qp.x = bf2f(qv.x & 0xffffu) * eg - zq.x; qp.y = bf2f(qv.x >> 16) * eg - zq.y; qp.z = bf2f(qv.y & 0xffffu) * eg - zq.z; qp.w = bf2f(qv.y >> 16) * eg - zq.w;
                *(u32x2*)(QP + cho + y * 64 + x0) = pack4(qp);
                const f32x4 zo = mm16<2>(lds, L_AR, L_UT, tx, ty, lane);
                *(u32x2*)(OLT + cho + y * 64 + x0) = pack4(zo);
            }
        }
    }
    __syncthreads();
}
#undef CH_LOAD
constexpr int SC_SLOT = 10240, SC_DEPTH = 12, SC_AHEAD = 11;
__device__ __forceinline__ void ph_dn_scan(const Args& a, Frame& F) {
    if (F.bid >= NSCAN) return;
    const unsigned char* MRb = (const unsigned char*)(F.ws + WS_DN_MR); const unsigned char* BNb = (const unsigned char*)(F.ws + WS_DN_BNT); bf16_t* ST = (bf16_t*)(F.ws + WS_DN_ST);
    const int lane = F.lane, l15 = lane & 15, q4 = lane >> 4, wq = F.bid >> 3;
    const size_t ch0 = (size_t)(F.bid & 7) * 256;
    LAS unsigned char* lds = F.lds;
    __syncthreads();
    if (F.wave >= 3) {
        const int lw = F.wave - 3;
#define DN_ISSUE(nn) do { const size_t chb_ = (ch0 + (size_t)((nn) < 255 ? (nn) : 255)) * 8192; const int slot_ = ((nn) % SC_DEPTH) * SC_SLOT; \
        _Pragma("unroll") for (int p_ = 0; p_ < 2; ++p_) { const int piece_ = lw * 2 + p_; \
            const unsigned char* src_ = (piece_ < 8 ? MRb + chb_ + piece_ * 1024 : BNb + chb_ + wq * 2048 + (piece_ - 8) * 1024) + lane * 16; \
            __builtin_amdgcn_global_load_lds((const unsigned*)src_, (LAS unsigned*)(lds + slot_ + piece_ * 1024), 16, 0, 2); } } while (0)
        for (int n = 0; n < SC_AHEAD; ++n) DN_ISSUE(n);
        for (int n = 0; n < 256; ++n) {
            asm volatile("s_waitcnt vmcnt(20)" ::: "memory");
            __builtin_amdgcn_s_barrier();
            DN_ISSUE(n + SC_AHEAD);
        }
        asm volatile("s_waitcnt vmcnt(0)" ::: "memory");
#undef DN_ISSUE
    } else if (F.wave == 0) {
        const int dv = 16 * wq + l15;
        f32x4 S[4];
#pragma unroll
        for (int ti = 0; ti < 4; ++ti) S[ti] = (f32x4){0.f, 0.f, 0.f, 0.f};
        for (int n = 0; n < 256; ++n) {
            __builtin_amdgcn_s_barrier();
            const LAS unsigned char* slot = lds + (n % SC_DEPTH) * SC_SLOT;
            bf16x8_t A[4][2]; u32x2 Bc[4];
#pragma unroll
            for (int ti = 0; ti < 4; ++ti) {
#pragma unroll
                for (int ks = 0; ks < 2; ++ks) A[ti][ks] = *(const LAS bf16x8_t*)(slot + (ti * 2 + ks) * 1024 + lane * 16);
                Bc[ti] = *(const LAS u32x2*)(slot + 8192 + ti * 512 + lane * 8);
            }
            u32x2 sp[4];
#pragma unroll
            for (int ti = 0; ti < 4; ++ti) { sp[ti] = pack4(S[ti]); *(u32x2*)(ST + (ch0 + n) * 4096 + dv * 64 + 16 * ti + 4 * q4) = sp[ti]; }
            const bf16x8_t b0 = __builtin_bit_cast(bf16x8_t, (u32x4){sp[0].x, sp[0].y, sp[1].x, sp[1].y});
            const bf16x8_t b1 = __builtin_bit_cast(bf16x8_t, (u32x4){sp[2].x, sp[2].y, sp[3].x, sp[3].y});
#pragma unroll
            for (int ti = 0; ti < 4; ++ti) {
                f32x4 c; c.x = bf2f(Bc[ti].x & 0xffffu); c.y = bf2f(Bc[ti].x >> 16); c.z = bf2f(Bc[ti].y & 0xffffu); c.w = bf2f(Bc[ti].y >> 16);
                c = __builtin_amdgcn_mfma_f32_16x16x32_bf16(A[ti][0], b0, c, 0, 0, 0);
                c = __builtin_amdgcn_mfma_f32_16x16x32_bf16(A[ti][1], b1, c, 0, 0, 0);
                S[ti] = c;
            }
            asm volatile("s_waitcnt lgkmcnt(0)" ::: "memory");
        }
    } else {
        for (int n = 0; n < 256; ++n) __builtin_amdgcn_s_barrier();
    }
    __syncthreads();
}
__device__ __forceinline__ void ph_dn_out(const Args& a, Frame& F, int l) {
    const bf16_t* QP = (const bf16_t*)(F.ws + WS_DN_QP); const bf16_t* OLT = (const bf16_t*)(F.ws + WS_DN_OLT); const bf16_t* ST = (const bf16_t*)(F.ws + WS_DN_ST);
    const bf16_t* P = (const bf16_t*)(F.ws + WS_PROJ); bf16_t* Y = (bf16_t*)(F.ws + WS_YMIX);
    const int lane = F.lane, l15 = lane & 15, q4 = lane >> 4, ti = F.wave & 3;
    LAS bf16_t* TL = (LAS bf16_t*)(F.lds + F.wave * 2560);
    const int er = lane >> 2, ec = (lane & 3) * 16;
    f32x4 gnv[4];
#pragma unroll
    for (int j = 0; j < 4; ++j) gnv[j] = *(const f32x4*)(a.dn_norm_g + l * 64 + ec + 4 * j);
    bf16x8_t af[2], bfv[4][2]; u32x2 ov[4];
#define DNO_LOAD(prv) { const int unit_ = 2 * (prv) + (F.wave >> 2); const size_t cho_ = (size_t)unit_ * 4096; \
        _Pragma("unroll") for (int ks = 0; ks < 2; ++ks) af[ks] = *(const bf16x8_t*)(QP + cho_ + (16 * ti + l15) * 64 + 32 * ks + 8 * q4); \
        _Pragma("unroll") for (int tj = 0; tj < 4; ++tj) { ov[tj] = *(const u32x2*)(OLT + cho_ + (16 * tj + l15) * 64 + 16 * ti + 4 * q4); \
            _Pragma("unroll") for (int ks = 0; ks < 2; ++ks) bfv[tj][ks] = *(const bf16x8_t*)(ST + cho_ + (16 * tj + l15) * 64 + 32 * ks + 8 * q4); } }
    if (F.bid < 1024) DNO_LOAD(F.bid)
    for (int pr = F.bid; pr < 1024; pr += F.nb) {
        const int unit = 2 * pr + (F.wave >> 2), n = unit & 255, h = (unit >> 8) & 3, b = unit >> 10;
        f32x4 acc[4];
#pragma unroll
        for (int tj = 0; tj < 4; ++tj) {
            f32x4 c; c.x = bf2f(ov[tj].x & 0xffffu); c.y = bf2f(ov[tj].x >> 16); c.z = bf2f(ov[tj].y & 0xffffu); c.w = bf2f(ov[tj].y >> 16);
#pragma unroll
            for (int ks = 0; ks < 2; ++ks) c = __builtin_amdgcn_mfma_f32_16x16x32_bf16(af[ks], bfv[tj][ks], c, 0, 0, 0);
            acc[tj] = c;
        }
        const size_t trow = (size_t)b * SEQ + n * 64 + 16 * ti + er;
        const u32x4 z0 = *(const u32x4*)(P + trow * NP + C_DZ + h * 64 + ec), z1 = *(const u32x4*)(P + trow * NP + C_DZ + h * 64 + ec + 8);
        if (pr + F.nb < 1024) DNO_LOAD(pr + F.nb)
        f32x4 ss = acc[0] * acc[0] + acc[1] * acc[1] + acc[2] * acc[2] + acc[3] * acc[3];
        ss.x = row16_sum(ss.x); ss.y = row16_sum(ss.y); ss.z = row16_sum(ss.z); ss.w = row16_sum(ss.w);
        const float rs[4] = {rsqrtf(ss.x * (1.f / 64.f) + EPS), rsqrtf(ss.y * (1.f / 64.f) + EPS), rsqrtf(ss.z * (1.f / 64.f) + EPS), rsqrtf(ss.w * (1.f / 64.f) + EPS)};
#pragma unroll
        for (int tj = 0; tj < 4; ++tj)
#pragma unroll
            for (int r = 0; r < 4; ++r) TL[(4 * q4 + r) * 80 + 16 * tj + l15] = (bf16_t)f2bf(acc[tj][r] * rs[r]);
        const u32x4 t0 = *(const LAS u32x4*)(TL + er * 80 + ec), t1 = *(const LAS u32x4*)(TL + er * 80 + ec + 8);
        const unsigned tw[8] = {t0.x, t0.y, t0.z, t0.w, t1.x, t1.y, t1.z, t1.w}, zw[8] = {z0.x, z0.y, z0.z, z0.w, z1.x, z1.y, z1.z, z1.w};
        unsigned yw[8];
#pragma unroll
        for (int j = 0; j < 8; ++j) {
            const float g0 = gnv[j >> 1][(2 * j) & 3], g1 = gnv[j >> 1][(2 * j + 1) & 3];
            yw[j] = cvtpk(bf2f(tw[j] & 0xffffu) * g0 * siluf_(bf2f(zw[j] & 0xffffu)), bf2f(tw[j] >> 16) * g1 * siluf_(bf2f(zw[j] >> 16)));
        }
        bf16_t* yp = Y + trow * D + 512 + h * 64 + ec;
        *(u32x4*)yp = (u32x4){yw[0], yw[1], yw[2], yw[3]}; *(u32x4*)(yp + 8) = (u32x4){yw[4], yw[5], yw[6], yw[7]};
    }
#undef DNO_LOAD
}

__device__ __forceinline__ void ph_conv_fast(const Args& a, Frame& F, int l) {
    const bf16_t* P = (const bf16_t*)(F.ws + WS_PROJ); bf16_t* Y = (bf16_t*)(F.ws + WS_YMIX);
    LAS float* OUTL = (LAS float*)F.lds;
    const int c = F.tid & 255, rsel = F.tid >> 8;
    float wk[CV_K];
#pragma unroll
    for (int k = 0; k < CV_K; ++k) wk[k] = a.cv_dw_w[((size_t)l * CV_K + k) * CV_C + c];
    const float bias = a.cv_dw_b[l * CV_C + c];
    const int nsc = NSCAN;
    if (F.bid < nsc) return;
    for (int pr = (F.bid - nsc + (F.nb - nsc) / 2) % (F.nb - nsc); pr < T / 128; pr += F.nb - nsc) {
        const int run = 2 * pr + rsel, t0 = run * 64, s0 = t0 % SEQ;
        __syncthreads();
        float win[CV_K];
        const bf16_t* pc = P + (size_t)(t0 - 30) * NP + C_CA + c;
        const bool first = (s0 == 0);
        LAS float* outp = OUTL + (rsel * 64) * 256 + c;
#define CV_U(ti_, dst) { const bool ok_ = !(first && (ti_) < 30); const bf16_t* q_ = ok_ ? pc + (size_t)(ti_) * NP : pc + (size_t)30 * NP; \
            const float ca_ = bf2f(q_[0]), cb_ = bf2f(q_[256]); dst = ok_ ? ca_ * sigmoidf_(cb_) : 0.f; }
#pragma unroll
        for (int p = 0; p < CV_K; ++p) CV_U(p, win[p])
        { float acc = bias;
#pragma unroll
            for (int k = 0; k < CV_K; ++k) acc += wk[k] * win[(30 + 1 + k) % CV_K];
            outp[0] = acc; }
        for (int cb3 = 1; cb3 < 3; ++cb3) {
            float un[CV_K];
#pragma unroll
            for (int p = 0; p < CV_K; ++p) CV_U(cb3 * CV_K + p, un[p])
#pragma unroll
            for (int p = 0; p < CV_K; ++p) {
                win[p] = un[p];
                float acc = bias;
#pragma unroll
                for (int k = 0; k < CV_K; ++k) acc += wk[k] * win[(p + 1 + k) % CV_K];
                outp[(cb3 * CV_K + p - 30) * 256] = acc;
            }
        }
        { float u93; CV_U(93, u93) win[0] = u93; float acc = bias;
#pragma unroll
            for (int k = 0; k < CV_K; ++k) acc += wk[k] * win[(0 + 1 + k) % CV_K];
            outp[63 * 256] = acc; }
#undef CV_U
        __syncthreads();
        const f32x4 g4 = *(const f32x4*)(a.cv_ln_g + l * CV_C + 4 * F.lane), b4 = *(const f32x4*)(a.cv_ln_b + l * CV_C + 4 * F.lane);
        for (int j = 0; j < 16; ++j) {
            const int tl = F.wave * 16 + j;
            const f32x4 v = *(const LAS f32x4*)(OUTL + tl * 256 + 4 * F.lane);
            const float mean = wave_sum((v.x + v.y) + (v.z + v.w)) * (1.0f / CV_C);
            const f32x4 dv = v - mean;
            const float var = wave_sum((dv.x * dv.x + dv.y * dv.y) + (dv.z * dv.z + dv.w * dv.w)) * (1.0f / CV_C);
            const float rstd = rsqrtf(var + EPS);
            const f32x4 y = (dv * rstd) * g4 + b4;
            u32x2 o; o.x = cvtpk(siluf_(y.x), siluf_(y.y)); o.y = cvtpk(siluf_(y.z), siluf_(y.w));
            *(u32x2*)(Y + (size_t)(pr * 128 + tl) * D + 768 + 4 * F.lane) = o;
        }
    }
    __syncthreads();
}

__device__ __forceinline__ void moe_bases(Frame& F, int (&base)[9], int (&cnt)[8]) {
    const unsigned* c = (const unsigned*)(F.ws + WS_CTL) + CW_MOECNT;
    int acc = 0;
#pragma unroll
    for (int e = 0; e < 8; ++e) { cnt[e] = (int)__hip_atomic_load(c + 64 * e, __ATOMIC_RELAXED, __HIP_MEMORY_SCOPE_AGENT); base[e] = acc; acc += (cnt[e] + 255) & ~255; }
    base[8] = acc;
}
__device__ __forceinline__ void moe_range(Frame& F, int e, int& lo, int& hi) {
    const unsigned* c = (const unsigned*)(F.ws + WS_CTL) + CW_MOECNT;
    int acc = 0; lo = 0; hi = 0;
#pragma unroll
    for (int k = 0; k < 8; ++k) { const int n = ((int)__hip_atomic_load(c + 64 * k, __ATOMIC_RELAXED, __HIP_MEMORY_SCOPE_AGENT) + 255) & ~255; if (k == e) { lo = acc; hi = acc + n; } acc += n; }
}
__device__ __forceinline__ void ph_moe_list(const Args& a, Frame& F) {
    int base[9], cnt[8]; moe_bases(F, base, cnt);
    int* RM = (int*)(F.ws + WS_RMAP); const int* R = (const int*)(F.ws + WS_ROUTE); const int* Pq = (const int*)(F.ws + WS_POS);
    for (int t = F.bid * NTHREADS + F.tid; t < T; t += F.nb * NTHREADS) {
        const int e0 = R[t * 4], e1 = R[t * 4 + 1];
        int b0 = 0, b1 = 0;
#pragma unroll
        for (int e = 0; e < 8; ++e) { if (e == e0) b0 = base[e]; if (e == e1) b1 = base[e]; }
        RM[b0 + Pq[t * 2]] = t; RM[b1 + Pq[t * 2 + 1]] = t;
    }
    if (F.bid == 0) {
#pragma unroll
        for (int e = 0; e < 8; ++e) { const int lo = base[e] + cnt[e], hi = base[e + 1]; for (int r = lo + F.tid; r < hi; r += NTHREADS) RM[r] = 0; }
    }
}
__device__ __forceinline__ void ph_final(const Args& a, Frame& F) {
    int base[9], cnt[8]; moe_bases(F, base, cnt);
    const float* MOD = (const float*)(F.ws + WS_MOD);
    const bf16_t* YM = (const bf16_t*)(F.ws + WS_YMOE); const int* R = (const int*)(F.ws + WS_ROUTE); const int* Pq = (const int*)(F.ws + WS_POS); const bf16_t* X16 = (const bf16_t*)(F.ws + WS_X16);
    const int c0 = 8 * F.lane;
    f32x4 fg[4], gt[4]; int cur_b = -1;
#pragma unroll
    for (int j = 0; j < 4; ++j) fg[j] = *(const f32x4*)(a.final_g + 512 * (j >> 1) + c0 + 4 * (j & 1));
    u32x4 rt_n; u32x2 pq_n;
    u32x4 dx[2], dy0[2], dy1[2]; float p0c = 0.f, p1c = 0.f;
#define FIN_ROUTE(row_, rt_, pq_) { rt_ = *(const u32x4*)(R + (size_t)(row_) * 4); pq_ = *(const u32x2*)(Pq + (size_t)(row_) * 2); }
#define FIN_DATA(row_, rt_, pq_) { int b0_ = 0, b1_ = 0; _Pragma("unroll") for (int e = 0; e < 8; ++e) { if (e == (int)rt_.x) b0_ = base[e]; if (e == (int)rt_.y) b1_ = base[e]; } \
        const size_t s0_ = (size_t)(b0_ + (int)pq_.x), s1_ = (size_t)(b1_ + (int)pq_.y); p0c = __uint_as_float(rt_.z); p1c = __uint_as_float(rt_.w); \
        _Pragma("unroll") for (int jj = 0; jj < 2; ++jj) { dx[jj] = __builtin_nontemporal_load((const u32x4*)(X16 + (size_t)(row_) * D + 512 * jj + c0)); dy0[jj] = __builtin_nontemporal_load((const u32x4*)(YM + s0_ * D + 512 * jj + c0)); dy1[jj] = __builtin_nontemporal_load((const u32x4*)(YM + s1_ * D + 512 * jj + c0)); } }
    if (F.gw < T) { u32x4 rt0; u32x2 pq0; FIN_ROUTE(F.gw, rt0, pq0) FIN_DATA(F.gw, rt0, pq0) }
    if (F.gw + F.ngw < T) FIN_ROUTE(F.gw + F.ngw, rt_n, pq_n)
    for (int row = F.gw; row < T; row += F.ngw) {
        const int b = row / SEQ;
        if (b != cur_b) { cur_b = b; const float* gt2 = MOD + ((size_t)(1 * 2 + 1) * 2 + b) * 3072 + 2048;
#pragma unroll
            for (int j = 0; j < 4; ++j) gt[j] = *(const f32x4*)(gt2 + 512 * (j >> 1) + c0 + 4 * (j & 1)); }
        f32x4 v[4]; float ss = 0.f; const float p0 = p0c, p1 = p1c;
#pragma unroll
        for (int jj = 0; jj < 2; ++jj) {
            const unsigned xw[4] = {dx[jj].x, dx[jj].y, dx[jj].z, dx[jj].w}, y0w[4] = {dy0[jj].x, dy0[jj].y, dy0[jj].z, dy0[jj].w}, y1w[4] = {dy1[jj].x, dy1[jj].y, dy1[jj].z, dy1[jj].w};
#pragma unroll
            for (int hf = 0; hf < 2; ++hf) {
                f32x4 f, xo;
                f.x = p0 * bf2f(y0w[2 * hf] & 0xffffu) + p1 * bf2f(y1w[2 * hf] & 0xffffu); f.y = p0 * bf2f(y0w[2 * hf] >> 16) + p1 * bf2f(y1w[2 * hf] >> 16);
                f.z = p0 * bf2f(y0w[2 * hf + 1] & 0xffffu) + p1 * bf2f(y1w[2 * hf + 1] & 0xffffu); f.w = p0 * bf2f(y0w[2 * hf + 1] >> 16) + p1 * bf2f(y1w[2 * hf + 1] >> 16);
                xo.x = bf2f(xw[2 * hf] & 0xffffu); xo.y = bf2f(xw[2 * hf] >> 16); xo.z = bf2f(xw[2 * hf + 1] & 0xffffu); xo.w = bf2f(xw[2 * hf + 1] >> 16);
                const f32x4 vv = xo + gt[2 * jj + hf] * f; v[2 * jj + hf] = vv;
                ss += (vv.x * vv.x + vv.y * vv.y) + (vv.z * vv.z + vv.w * vv.w);
            }
        }
        if (row + F.ngw < T) { FIN_DATA(row + F.ngw, rt_n, pq_n) }
        if (row + 2 * F.ngw < T) FIN_ROUTE(row + 2 * F.ngw, rt_n, pq_n)
        const float rstd = rsqrtf(wave_sum(ss) * (1.0f / D) + EPS);
        float* op = a.out + (size_t)row * D + c0;
#pragma unroll
        for (int j = 0; j < 4; ++j) __builtin_nontemporal_store((v[j] * rstd) * fg[j], (f32x4*)(op + 512 * (j >> 1) + 4 * (j & 1)));
    }
#undef FIN_ROUTE
#undef FIN_DATA
}


namespace pg8 {
typedef short bf16x8 __attribute__((ext_vector_type(8)));
constexpr int BM = 256, BK = 64, HALF = 128, HTB = HALF * BK * 2, STAGE_BYTES = 8 * HTB;
__device__ __forceinline__ int lds_byte(int r, int c) { const int st = (r >> 4) * 2 + (c >> 5), rr = r & 15, cc = c & 31, ob = rr * 64 + cc * 2; return st * 1024 + (ob ^ (((ob >> 9) & 1) << 5)); }
__device__ __forceinline__ void stage_rc(int b, int& R, int& C) { const int st = b / 1024, sb = b % 1024, swz = sb ^ (((sb >> 9) & 1) << 5); R = (st >> 1) * 16 + swz / 64; C = (st & 1) * 32 + (swz % 64) / 2; }
__device__ __forceinline__ int perm32(int rho) { const int n = rho >> 4, i = rho & 15; return 8 * (i >> 2) + 4 * n + (i & 3); }
struct Unit { int pm, pn, ord; };
struct Gemm { const bf16_t* A; const bf16_t* Bt; int K; };
constexpr int NXCD = 8, WGM = 8;
struct StaticOrder {
    int nM, nN, nwg, G, c;
    __device__ void init(int M, int N, int G_, int c_) { nM = M / BM; nN = N / BM; nwg = nM * nN; G = G_; c = c_; }
    __device__ __forceinline__ bool next(int i, Unit& u) const {
        const long L = (long)i * G + c; if (L >= nwg) return false;
        int wgid = (int)L; { const int q = nwg / NXCD, r = nwg % NXCD, xcd = wgid % NXCD, off = wgid / NXCD; wgid = (xcd < r ? xcd * (q + 1) : r * (q + 1) + (xcd - r) * q) + off; }
        const int nig = WGM * nN, gid = wgid / nig, fm = gid * WGM, gsz = (nM - fm) < WGM ? (nM - fm) : WGM;
        u.pm = fm + ((wgid % nig) % gsz); u.pn = (wgid % nig) / gsz; return true;
    }
};
template <int NT> struct MoeOrder {
    int bt[9]; int cnt[8]; int G, c;
    __device__ __forceinline__ bool next(int i, Unit& u) const {
        int q, tn;
        if ((G & 7) == 0) { const int x = c & 7, Ll = i * (G >> 3) + (c >> 3); q = (Ll / NT) * 8 + x; tn = Ll % NT; if (q >= bt[8]) return false; }
        else { const int L = i * G + c; if (L >= bt[8] * NT) return false; q = L / NT; tn = L % NT; }
        int e = 0;
#pragma unroll
        for (int k = 1; k < 8; ++k) e += (q >= bt[k]) ? 1 : 0;
        u.pm = q; u.pn = e * NT + tn; return true;
    }
};
__device__ __forceinline__ unsigned cvt_pk_bf16(float lo, float hi) { unsigned r; asm volatile("v_cvt_pk_bf16_f32 %0, %1, %2" : "=v"(r) : "v"(lo), "v"(hi)); return r; }
__device__ __forceinline__ float fast_silu(float x) { return x * __builtin_amdgcn_rcpf(1.0f + __builtin_amdgcn_exp2f(x * -1.4426950408889634f)); }

struct EpiBf16 {
    static constexpr bool PERM = true, WIDE = false;
    bf16_t* O; int ldc; int nmod;
    __device__ __forceinline__ void operator()(const f32x4 (&acc)[2][2][4][2], const Unit& u, int wr, int wc, int fr, int fq) const {
        const int row0 = u.pm * BM + wr * 64 + fr, col0 = (u.pn % nmod) * BM + wc * 32 + 8 * fq;
#pragma unroll
        for (int ai = 0; ai < 2; ++ai)
#pragma unroll
            for (int m = 0; m < 4; ++m) { bf16_t* rowp = O + (size_t)(row0 + ai * HALF + m * 16) * ldc + col0;
#pragma unroll
                for (int bj = 0; bj < 2; ++bj) { const f32x4 v0 = acc[ai][bj][m][0], v1 = acc[ai][bj][m][1];
                    u32x4 w; w.x = cvt_pk_bf16(v0[0], v0[1]); w.y = cvt_pk_bf16(v0[2], v0[3]); w.z = cvt_pk_bf16(v1[0], v1[1]); w.w = cvt_pk_bf16(v1[2], v1[3]);
                    *(u32x4*)(rowp + bj * HALF) = w; } }
    }
};
struct EpiSwiGLU {
    static constexpr bool PERM = true, WIDE = false;
    bf16_t* O; int ldc; int nmod;
    __device__ __forceinline__ void operator()(const f32x4 (&acc)[2][2][4][2], const Unit& u, int wr, int wc, int fr, int fq) const {
        const int row0 = u.pm * BM + wr * 64 + fr, col0 = (u.pn % nmod) * HALF + wc * 32 + 8 * fq;
#pragma unroll
        for (int ai = 0; ai < 2; ++ai)
#pragma unroll
            for (int m = 0; m < 4; ++m) {
                const f32x4 g0 = acc[ai][0][m][0], g1 = acc[ai][0][m][1], u0 = acc[ai][1][m][0], u1 = acc[ai][1][m][1];
                u32x4 w;
                w.x = cvt_pk_bf16(fast_silu(g0[0]) * u0[0], fast_silu(g0[1]) * u0[1]); w.y = cvt_pk_bf16(fast_silu(g0[2]) * u0[2], fast_silu(g0[3]) * u0[3]);
                w.z = cvt_pk_bf16(fast_silu(g1[0]) * u1[0], fast_silu(g1[1]) * u1[1]); w.w = cvt_pk_bf16(fast_silu(g1[2]) * u1[2], fast_silu(g1[3]) * u1[3]);
                *(u32x4*)(O + (size_t)(row0 + ai * HALF + m * 16) * ldc + col0) = w; }
    }
};
struct EpiResidF32 {
    static constexpr bool PERM = false, WIDE = false;
    const float* xin; float* xout; const float* gate;
    __device__ __forceinline__ void operator()(const f32x4 (&acc)[2][2][4][2], const Unit& u, int wr, int wc, int fr, int fq) const {
        const int row0 = u.pm * BM + wr * 64 + fr, col0 = u.pn * BM + wc * 32 + 4 * fq;
        const float* gp = gate + (size_t)((u.pm * BM) / SEQ) * 3072 + col0;
#pragma unroll
        for (int bj = 0; bj < 2; ++bj)
#pragma unroll
            for (int n = 0; n < 2; ++n) { const f32x4 g4 = *(const f32x4*)(gp + bj * HALF + n * 16);
#pragma unroll
                for (int ai = 0; ai < 2; ++ai)
#pragma unroll
                    for (int m = 0; m < 4; ++m) { const size_t off = (size_t)(row0 + ai * HALF + m * 16) * D + col0 + bj * HALF + n * 16;
                        const f32x4 x4 = *(const f32x4*)(xin + off); *(f32x4*)(xout + off) = x4 + g4 * acc[ai][bj][m][n]; } }
    }
};


__device__ __forceinline__ u32x4 xchg8(u32x4 v) { u32x4 r;
    r.x = (unsigned)__builtin_amdgcn_update_dpp(0, (int)v.x, 0x128, 0xf, 0xf, false); r.y = (unsigned)__builtin_amdgcn_update_dpp(0, (int)v.y, 0x128, 0xf, 0xf, false);
    r.z = (unsigned)__builtin_amdgcn_update_dpp(0, (int)v.z, 0x128, 0xf, 0xf, false); r.w = (unsigned)__builtin_amdgcn_update_dpp(0, (int)v.w, 0x128, 0xf, 0xf, false); return r; }
__device__ __forceinline__ u32x4 pack8(f32x4 v0, f32x4 v1) { u32x4 w; w.x = cvt_pk_bf16(v0[0], v0[1]); w.y = cvt_pk_bf16(v0[2], v0[3]); w.z = cvt_pk_bf16(v1[0], v1[1]); w.w = cvt_pk_bf16(v1[2], v1[3]); return w; }
template <bool NT = true> __device__ __forceinline__ void store_wide(bf16_t* p, int ld, int fr, int fq, u32x4 pk0, u32x4 pk1) {
    const bool lo = fr < 8; const u32x4 rcv = xchg8(lo ? pk1 : pk0);
    bf16_t* q = p + (size_t)(fr & 7) * ld + 8 * fq + (lo ? 0 : 32);
    if constexpr (NT) { __builtin_nontemporal_store(lo ? pk0 : rcv, (u32x4*)q); __builtin_nontemporal_store(lo ? rcv : pk1, (u32x4*)(q + (size_t)8 * ld)); }
    else { *(u32x4*)q = lo ? pk0 : rcv; *(u32x4*)(q + (size_t)8 * ld) = lo ? rcv : pk1; }
}
struct EpiBf16W {
    static constexpr bool PERM = true, WIDE = true;
    bf16_t* O; int ldc; int nmod;
    __device__ __forceinline__ void operator()(const f32x4 (&acc)[2][2][4][2], const Unit& u, int wr, int wc, int fr, int fq) const {
        bf16_t* base = O + (size_t)(u.pm * BM + wr * 64) * ldc + (u.pn % nmod) * BM + wc * 64;
#pragma unroll
        for (int ai = 0; ai < 2; ++ai)
#pragma unroll
            for (int m = 0; m < 4; ++m) store_wide(base + (size_t)(ai * HALF + m * 16) * ldc, ldc, fr, fq, pack8(acc[ai][0][m][0], acc[ai][0][m][1]), pack8(acc[ai][1][m][0], acc[ai][1][m][1]));
    }
};
struct EpiResidNorm {
    static constexpr bool PERM = true, WIDE = true;
    const bf16_t* xin; bf16_t* x16; const float* gate; const float* av; bf16_t* xa; float* ssqp;
    __device__ __forceinline__ void operator()(const f32x4 (&acc)[2][2][4][2], const Unit& u, int wr, int wc, int fr, int fq) const {
        const int rowb = u.pm * BM + wr * 64, colw = u.pn * BM + wc * 64, b = (u.pm * BM) / SEQ;
        const bool lo = fr < 8;
        const size_t lane_off = (size_t)(fr & 7) * D + colw + 8 * fq + (lo ? 0 : 32);
        f32x4 gv[2][2], avv[2][2];
#pragma unroll
        for (int bj = 0; bj < 2; ++bj)
#pragma unroll
            for (int n = 0; n < 2; ++n) { gv[bj][n] = *(const f32x4*)(gate + (size_t)b * 3072 + colw + 32 * bj + 8 * fq + 4 * n); avv[bj][n] = *(const f32x4*)(av + (size_t)b * 1024 + colw + 32 * bj + 8 * fq + 4 * n); }
        u32x4 la[4][2], lb[4][2];
#define ERN_LOAD(k_) { _Pragma("unroll") for (int mm = 0; mm < 2; ++mm) { const bf16_t* q = xin + (size_t)(rowb + ((k_) >> 1) * HALF + (2 * ((k_) & 1) + mm) * 16) * D + lane_off; la[k_][mm] = __builtin_nontemporal_load((const u32x4*)q); lb[k_][mm] = __builtin_nontemporal_load((const u32x4*)(q + (size_t)8 * D)); } }
        ERN_LOAD(0)
#pragma unroll
        for (int k = 0; k < 4; ++k) {
            const int ai = k >> 1;
            if (k == 0) ERN_LOAD(1) else if (k == 1) ERN_LOAD(2) else if (k == 2) ERN_LOAD(3)
            asm volatile("" ::: "memory");
#pragma unroll
            for (int mm = 0; mm < 2; ++mm) {
                const int m = 2 * (k & 1) + mm;
                const u32x4 rcv = xchg8(lo ? lb[k][mm] : la[k][mm]);
                const u32x4 xb0 = lo ? la[k][mm] : rcv, xb1 = lo ? rcv : lb[k][mm];
                f32x4 x00, x01, x10, x11;
                x00.x = __uint_as_float(xb0.x << 16); x00.y = __uint_as_float(xb0.x & 0xffff0000u); x00.z = __uint_as_float(xb0.y << 16); x00.w = __uint_as_float(xb0.y & 0xffff0000u);
                x01.x = __uint_as_float(xb0.z << 16); x01.y = __uint_as_float(xb0.z & 0xffff0000u); x01.z = __uint_as_float(xb0.w << 16); x01.w = __uint_as_float(xb0.w & 0xffff0000u);
                x10.x = __uint_as_float(xb1.x << 16); x10.y = __uint_as_float(xb1.x & 0xffff0000u); x10.z = __uint_as_float(xb1.y << 16); x10.w = __uint_as_float(xb1.y & 0xffff0000u);
                x11.x = __uint_as_float(xb1.z << 16); x11.y = __uint_as_float(xb1.z & 0xffff0000u); x11.z = __uint_as_float(xb1.w << 16); x11.w = __uint_as_float(xb1.w & 0xffff0000u);
                const f32x4 n00 = x00 + gv[0][0] * acc[ai][0][m][0], n01 = x01 + gv[0][1] * acc[ai][0][m][1], n10 = x10 + gv[1][0] * acc[ai][1][m][0], n11 = x11 + gv[1][1] * acc[ai][1][m][1];
                float sv = (((n00.x * n00.x + n00.y * n00.y) + (n00.z * n00.z + n00.w * n00.w)) + ((n01.x * n01.x + n01.y * n01.y) + (n01.z * n01.z + n01.w * n01.w)))
                         + (((n10.x * n10.x + n10.y * n10.y) + (n10.z * n10.z + n10.w * n10.w)) + ((n11.x * n11.x + n11.y * n11.y) + (n11.z * n11.z + n11.w * n11.w)));
                const size_t ro = (size_t)(rowb + ai * HALF + m * 16) * D + colw;
                store_wide<false>(x16 + ro, D, fr, fq, pack8(n00, n01), pack8(n10, n11));
                store_wide<false>(xa + ro, D, fr, fq, pack8(n00 * avv[0][0], n01 * avv[0][1]), pack8(n10 * avv[1][0], n11 * avv[1][1]));
                sv = xor32_sum(xor16_sum(sv));
                if (fq == 0) ssqp[(size_t)(rowb + ai * HALF + m * 16 + fr) * 16 + u.pn * 4 + wc] = sv;
            }
        }
#undef ERN_LOAD
    }
};
struct EpiProjNorm {
    static constexpr bool PERM = true, WIDE = true;
    bf16_t* O; const LAS float* RS; const float* cv; float* BG; const float* a_log; const float* dt_bias;
    __device__ __forceinline__ void operator()(const f32x4 (&acc)[2][2][4][2], const Unit& u, int wr, int wc, int fr, int fq) const {
        const int rl0 = wr * 64 + fr, colw = u.pn * BM + wc * 64, b = (u.pm * BM) / SEQ;
        const float* cp = cv + (size_t)b * NPW + colw + 8 * fq;
        if (u.pn < NP / BM) {
            f32x4 c4[2][2];
#pragma unroll
            for (int bj = 0; bj < 2; ++bj)
#pragma unroll
                for (int n = 0; n < 2; ++n) c4[bj][n] = *(const f32x4*)(cp + 32 * bj + 4 * n);
            bf16_t* base = O + (size_t)(u.pm * BM + wr * 64) * NP + colw;
#pragma unroll
            for (int ai = 0; ai < 2; ++ai)
#pragma unroll
                for (int m = 0; m < 4; ++m) { const float rs = fabsf(RS[u.ord * 256 + rl0 + ai * HALF + m * 16]);
                    store_wide(base + (size_t)(ai * HALF + m * 16) * NP, NP, fr, fq, pack8(acc[ai][0][m][0] * rs + c4[0][0], acc[ai][0][m][1] * rs + c4[0][1]), pack8(acc[ai][1][m][0] * rs + c4[1][0], acc[ai][1][m][1] * rs + c4[1][1])); }
        } else if (wc == 0 && fq == 0) {
            const f32x4 c0 = *(const f32x4*)(cp), c1 = *(const f32x4*)(cp + 4);
            const f32x4 al = *(const f32x4*)a_log, db = *(const f32x4*)dt_bias;
#pragma unroll
            for (int ai = 0; ai < 2; ++ai)
#pragma unroll
                for (int m = 0; m < 4; ++m) { const int rl = rl0 + ai * HALF + m * 16; const float rs = fabsf(RS[u.ord * 256 + rl]);
                    const f32x4 vb = acc[ai][0][m][0] * rs + c0, va = acc[ai][0][m][1] * rs + c1;
                    f32x4 be, gg;
#pragma unroll
                    for (int hh = 0; hh < 4; ++hh) { be[hh] = sigmoidf_(vb[hh]); gg[hh] = -__expf(al[hh]) * softplusf_(va[hh] + db[hh]); }
                    float* bg = BG + (size_t)(u.pm * BM + rl) * 8; *(f32x4*)bg = be; *(f32x4*)(bg + 4) = gg; }
        }
    }
};
struct EpiNull {
    static constexpr bool PERM = true, WIDE = false;
    __device__ __forceinline__ void operator()(const f32x4 (&acc)[2][2][4][2], const Unit& u, int wr, int wc, int fr, int fq) const {
#pragma unroll
        for (int ai = 0; ai < 2; ++ai)
#pragma unroll
            for (int bj = 0; bj < 2; ++bj)
#pragma unroll
                for (int m = 0; m < 4; ++m)
#pragma unroll
                    for (int n = 0; n < 2; ++n) asm volatile("" :: "v"(acc[ai][bj][m][n]));
    }
};
struct EpiSwiGLUNorm {
    static constexpr bool PERM = true, WIDE = false;
    bf16_t* O; int ldc; int nmod; const LAS float* RS; const float* cv; int ncv;
    __device__ __forceinline__ void operator()(const f32x4 (&acc)[2][2][4][2], const Unit& u, int wr, int wc, int fr, int fq) const {
        const int rl0 = wr * 64 + fr, col0 = (u.pn % nmod) * HALF + wc * 32 + 8 * fq;
        const float* cp = cv + (size_t)u.pn * BM + wc * 32 + 8 * fq;
        f32x4 cg[2][2], cu[2][2];
#pragma unroll
        for (int bb = 0; bb < 2; ++bb)
#pragma unroll
            for (int n = 0; n < 2; ++n) { cg[bb][n] = *(const f32x4*)(cp + (size_t)bb * ncv + 4 * n); cu[bb][n] = *(const f32x4*)(cp + (size_t)bb * ncv + HALF + 4 * n); }
#pragma unroll
        for (int ai = 0; ai < 2; ++ai)
#pragma unroll
            for (int m = 0; m < 4; ++m) { const int rl = rl0 + ai * HALF + m * 16; const float rsv = RS[u.ord * 256 + rl], rs = fabsf(rsv); const bool b1 = rsv < 0.f;
                const f32x4 g0 = acc[ai][0][m][0] * rs + (b1 ? cg[1][0] : cg[0][0]), g1 = acc[ai][0][m][1] * rs + (b1 ? cg[1][1] : cg[0][1]);
                const f32x4 u0 = acc[ai][1][m][0] * rs + (b1 ? cu[1][0] : cu[0][0]), u1 = acc[ai][1][m][1] * rs + (b1 ? cu[1][1] : cu[0][1]);
                u32x4 w;
                w.x = cvt_pk_bf16(fast_silu(g0[0]) * u0[0], fast_silu(g0[1]) * u0[1]); w.y = cvt_pk_bf16(fast_silu(g0[2]) * u0[2], fast_silu(g0[3]) * u0[3]);
                w.z = cvt_pk_bf16(fast_silu(g1[0]) * u1[0], fast_silu(g1[1]) * u1[1]); w.w = cvt_pk_bf16(fast_silu(g1[2]) * u1[2], fast_silu(g1[3]) * u1[3]);
                __builtin_nontemporal_store(w, (u32x4*)(O + (size_t)(u.pm * BM + rl) * ldc + col0)); }
    }
};

template <class Epi, class Sched, bool GATHER, bool ALIGN_EPI, bool SP2>
__device__ __forceinline__ void gemm_phase(LAS unsigned char* lds, const LAS int* RI, const Gemm g, const Sched& S, const Epi& E) {
    const int tid = threadIdx.x, wid = __builtin_amdgcn_readfirstlane(tid >> 6), lane = tid & 63, wr = wid >> 2, wc = wid & 3, fr = lane & 15, fq = lane >> 4;
    const int K = g.K, nt = K / BK;
    unsigned voffB[2]; int Ra[2]; unsigned Ca2[2];
#pragma unroll
    for (int i = 0; i < 2; ++i) { int R, C; stage_rc(tid * 16 + i * 8192, R, C); const int Rb = Epi::WIDE ? ((R >> 5) * 64 + perm32(R & 31)) : (Epi::PERM ? ((R & ~31) + perm32(R & 31)) : R);
        Ra[i] = R; Ca2[i] = (unsigned)C * 2u; voffB[i] = (unsigned)(Rb * K + C) * 2u; }
    const size_t kstep = (size_t)(BK * 2);
    const size_t hstep = (size_t)HALF * K * 2;
    const size_t tstep = 2 * hstep;
    const size_t hstepB = Epi::WIDE ? (size_t)32 * K * 2 : hstep;
    const unsigned rowb = (unsigned)K * 2u;
    const unsigned ldsw = (unsigned)wid * 1024u;
    const int aoff = lds_byte(wr * 64 + fr, fq * 8), boff = lds_byte(wc * 32 + fr, fq * 8);
#define PG8_SA(b, h) (((b) * 2 + (h)) * HTB)
#define PG8_SB(b, h) ((4 + (b) * 2 + (h)) * HTB)
#define PG8_STAGE_B(bufoff, gbase) do { _Pragma("unroll") for (int _i = 0; _i < 2; ++_i) \
        __builtin_amdgcn_global_load_lds((const unsigned*)((const char*)(gbase) + voffB[_i]), (LAS unsigned*)(lds + (bufoff) + ldsw + _i * 8192), 16, 0, 0); } while (0)
#define PG8_STAGE_A(bufoff, kb, off) do { _Pragma("unroll") for (int _i = 0; _i < 2; ++_i) \
        __builtin_amdgcn_global_load_lds((const unsigned*)((const char*)g.A + (size_t)(kb) + (off)[_i]), (LAS unsigned*)(lds + (bufoff) + ldsw + _i * 8192), 16, 0, 0); } while (0)
#define PG8_LDA(dst, b, h) do { _Pragma("unroll") for (int m = 0; m < 4; ++m) _Pragma("unroll") for (int k = 0; k < 2; ++k) dst[m][k] = *(const LAS bf16x8*)(lds + PG8_SA(b, h) + aoff + m * 2048 + k * 1024); } while (0)
#define PG8_LDB(dst, b, h) do { _Pragma("unroll") for (int n = 0; n < 2; ++n) _Pragma("unroll") for (int k = 0; k < 2; ++k) dst[n][k] = *(const LAS bf16x8*)(lds + PG8_SB(b, h) + boff + n * 2048 + k * 1024); } while (0)
#define PG8_MMA(ai, bj, At, Bt) do { __builtin_amdgcn_s_setprio(1); _Pragma("unroll") for (int m = 0; m < 4; ++m) _Pragma("unroll") for (int n = 0; n < 2; ++n) _Pragma("unroll") for (int k = 0; k < 2; ++k) \
        acc[ai][bj][m][n] = __builtin_amdgcn_mfma_f32_16x16x32_bf16(Bt[n][k], At[m][k], acc[ai][bj][m][n], 0, 0, 0); __builtin_amdgcn_s_setprio(0); } while (0)
#define PG8_WAIT_V(n) asm volatile("s_waitcnt vmcnt(" #n ")" ::: "memory")
#define PG8_WAIT_L(n) asm volatile("s_waitcnt lgkmcnt(" #n ")" ::: "memory")
#define PG8_BAR __builtin_amdgcn_s_barrier()
#define PG8_SCHED __builtin_amdgcn_sched_barrier(0)
#define PG8_AOFFS(dst, ui_, un_) do { _Pragma("unroll") for (int _h = 0; _h < 2; ++_h) _Pragma("unroll") for (int _i = 0; _i < 2; ++_i) { \
        const unsigned _row = GATHER ? (unsigned)RI[(ui_) * 256 + _h * HALF + Ra[_i]] : (unsigned)((un_).pm * BM + _h * HALF + Ra[_i]); dst[_h][_i] = _row * rowb + Ca2[_i]; } } while (0)
    Unit cur, nxt; int ui = 0;
    if (!S.next(0, cur)) return;
    cur.ord = 0;
    f32x4 acc[2][2][4][2];
#pragma unroll
    for (int a = 0; a < 2; ++a)
#pragma unroll
        for (int b = 0; b < 2; ++b)
#pragma unroll
            for (int m = 0; m < 4; ++m)
#pragma unroll
                for (int n = 0; n < 2; ++n) acc[a][b][m][n] = (f32x4){0.f, 0.f, 0.f, 0.f};
    bf16x8 At[4][2], B0[2][2], B1[2][2];
    unsigned cv[2][2], nv[2][2];
    PG8_AOFFS(cv, 0, cur);
    const char* cB = (const char*)g.Bt + (size_t)cur.pn * tstep;
    if constexpr (SP2) {
        PG8_STAGE_B(PG8_SB(0, 0), cB); PG8_STAGE_B(PG8_SB(0, 1), cB + hstepB); PG8_STAGE_A(PG8_SA(0, 0), 0, cv[0]); PG8_STAGE_A(PG8_SA(0, 1), 0, cv[1]);
        if (wr == 1) PG8_BAR;
        PG8_WAIT_V(2); PG8_BAR;
        PG8_STAGE_B(PG8_SB(1, 0), cB + kstep); PG8_STAGE_A(PG8_SA(1, 0), kstep, cv[0]); PG8_STAGE_B(PG8_SB(1, 1), cB + hstepB + kstep);
        PG8_WAIT_V(6); PG8_BAR;
    } else {
        PG8_STAGE_B(PG8_SB(0, 0), cB); PG8_STAGE_A(PG8_SA(0, 0), 0, cv[0]); PG8_STAGE_B(PG8_SB(0, 1), cB + hstepB); PG8_STAGE_A(PG8_SA(0, 1), 0, cv[1]);
        if (wr == 1) PG8_BAR;
        PG8_WAIT_V(4); PG8_BAR;
        PG8_STAGE_B(PG8_SB(1, 0), cB + kstep); PG8_STAGE_A(PG8_SA(1, 0), kstep, cv[0]); PG8_STAGE_B(PG8_SB(1, 1), cB + hstepB + kstep);
        PG8_WAIT_V(6); PG8_BAR;
    }
    for (;;) {
        const bool has_next = S.next(ui + 1, nxt); nxt.ord = ui + 1;
        const char* nB = has_next ? (const char*)g.Bt + (size_t)nxt.pn * tstep : cB;
        if (has_next) { PG8_AOFFS(nv, ui + 1, nxt); }
        else {
#pragma unroll
            for (int h = 0; h < 2; ++h)
#pragma unroll
                for (int i = 0; i < 2; ++i) nv[h][i] = cv[h][i]; }
        for (int t = 0; t < nt; t += 2) {
            const bool last = (t == nt - 2);
            const size_t kb1 = (size_t)(t + 1) * kstep, kb2 = last ? (size_t)0 : (size_t)(t + 2) * kstep, kb3 = kb2 + kstep;
            const char* b2 = last ? nB : cB + (size_t)(t + 2) * kstep; const char* b3 = b2 + kstep;
            unsigned o2[2][2];
#pragma unroll
            for (int h = 0; h < 2; ++h)
#pragma unroll
                for (int i = 0; i < 2; ++i) o2[h][i] = last ? nv[h][i] : cv[h][i];
            if constexpr (SP2) {
            PG8_LDB(B0, 0, 0); PG8_LDB(B1, 0, 1); PG8_SCHED; PG8_LDA(At, 0, 0); PG8_STAGE_A(PG8_SA(1, 1), kb1, cv[1]);
            PG8_WAIT_V(8); PG8_WAIT_L(0); PG8_BAR; PG8_MMA(0, 0, At, B0); PG8_MMA(0, 1, At, B1); PG8_BAR; PG8_SCHED;
            PG8_LDA(At, 0, 1); PG8_STAGE_B(PG8_SB(0, 0), b2); PG8_STAGE_B(PG8_SB(0, 1), b2 + hstepB); PG8_STAGE_A(PG8_SA(0, 0), kb2, o2[0]);
            PG8_WAIT_V(8); PG8_WAIT_L(0); PG8_BAR; PG8_MMA(1, 0, At, B0); PG8_MMA(1, 1, At, B1); PG8_BAR; PG8_SCHED;
            PG8_LDB(B0, 1, 0); PG8_LDB(B1, 1, 1); PG8_SCHED; PG8_LDA(At, 1, 0); PG8_STAGE_A(PG8_SA(0, 1), kb2, o2[1]);
            PG8_WAIT_V(8); PG8_WAIT_L(0); PG8_BAR; PG8_MMA(0, 0, At, B0); PG8_MMA(0, 1, At, B1); PG8_BAR; PG8_SCHED;
            PG8_LDA(At, 1, 1); PG8_STAGE_B(PG8_SB(1, 0), b3); PG8_STAGE_B(PG8_SB(1, 1), b3 + hstepB); PG8_STAGE_A(PG8_SA(1, 0), kb3, o2[0]);
            PG8_WAIT_V(8); PG8_WAIT_L(0); PG8_BAR; PG8_MMA(1, 0, At, B0); PG8_MMA(1, 1, At, B1); PG8_BAR; PG8_SCHED;
            } else {
            PG8_LDB(B0, 0, 0); PG8_SCHED; PG8_LDA(At, 0, 0); PG8_STAGE_A(PG8_SA(1, 1), kb1, cv[1]);
            PG8_WAIT_L(8); PG8_BAR; PG8_WAIT_L(0); PG8_MMA(0, 0, At, B0); PG8_BAR; PG8_SCHED;
            PG8_LDB(B1, 0, 1); PG8_STAGE_B(PG8_SB(0, 0), b2);
            PG8_BAR; PG8_WAIT_L(0); PG8_MMA(0, 1, At, B1); PG8_BAR;
            PG8_LDA(At, 0, 1); PG8_STAGE_A(PG8_SA(0, 0), kb2, o2[0]);
            PG8_BAR; PG8_WAIT_L(0); PG8_MMA(1, 0, At, B0); PG8_BAR; PG8_SCHED;
            PG8_STAGE_B(PG8_SB(0, 1), b2 + hstepB);
            PG8_WAIT_V(6); PG8_BAR; PG8_MMA(1, 1, At, B1); PG8_BAR;
            PG8_LDB(B0, 1, 0); PG8_SCHED; PG8_LDA(At, 1, 0); PG8_STAGE_A(PG8_SA(0, 1), kb2, o2[1]);
            PG8_WAIT_L(8); PG8_BAR; PG8_WAIT_L(0); PG8_MMA(0, 0, At, B0); PG8_BAR; PG8_SCHED;
            PG8_LDB(B1, 1, 1); PG8_STAGE_B(PG8_SB(1, 0), b3);
            PG8_BAR; PG8_WAIT_L(0); PG8_MMA(0, 1, At, B1); PG8_BAR;
            PG8_LDA(At, 1, 1); PG8_STAGE_A(PG8_SA(1, 0), kb3, o2[0]);
            PG8_BAR; PG8_WAIT_L(0); PG8_MMA(1, 0, At, B0); PG8_BAR; PG8_SCHED;
            PG8_STAGE_B(PG8_SB(1, 1), b3 + hstepB);
            PG8_WAIT_V(6); PG8_BAR; PG8_MMA(1, 1, At, B1); PG8_BAR;
            }
        }
        if constexpr (ALIGN_EPI) { if (wr == 0) PG8_BAR; }
        E(acc, cur, wr, wc, fr, fq);
        if (!has_next) break;
#pragma unroll
        for (int a = 0; a < 2; ++a)
#pragma unroll
            for (int b = 0; b < 2; ++b)
#pragma unroll
                for (int m = 0; m < 4; ++m)
#pragma unroll
                    for (int n = 0; n < 2; ++n) acc[a][b][m][n] = (f32x4){0.f, 0.f, 0.f, 0.f};
        cur = nxt; cB = nB; ++ui;
#pragma unroll
        for (int h = 0; h < 2; ++h)
#pragma unroll
            for (int i = 0; i < 2; ++i) cv[h][i] = nv[h][i];
        if constexpr (ALIGN_EPI) { if (wr == 1) PG8_BAR; }
    }
    PG8_WAIT_V(0);
    if constexpr (!ALIGN_EPI) { if (wr == 0) PG8_BAR; }
    PG8_BAR;
#undef PG8_SA
#undef PG8_SB
#undef PG8_STAGE_A
#undef PG8_STAGE_B
#undef PG8_LDA
#undef PG8_LDB
#undef PG8_MMA
#undef PG8_WAIT_V
#undef PG8_WAIT_L
#undef PG8_BAR
#undef PG8_SCHED
#undef PG8_AOFFS
}
}

__device__ __forceinline__ void transpose_item(const float* W, int pitch, int k0, int n0, bf16_t* WT, int Kd, int drow0, LAS float* scr, int lane) {
#pragma unroll 8
    for (int i = 0; i < 32; ++i) { const int kk = 2 * i + (lane >> 5); scr[kk * 33 + (lane & 31)] = __builtin_nontemporal_load(W + (size_t)(k0 + kk) * pitch + n0 + (lane & 31)); }
    asm volatile("s_waitcnt lgkmcnt(0)" ::: "memory");
    const int c = lane & 7;
#pragma unroll
    for (int j = 0; j < 4; ++j) { const int n = (lane >> 3) + 8 * j; const LAS float* s = scr + (8 * c) * 33 + n;
        u32x4 o; o.x = pk2(s[0 * 33], s[1 * 33]); o.y = pk2(s[2 * 33], s[3 * 33]); o.z = pk2(s[4 * 33], s[5 * 33]); o.w = pk2(s[6 * 33], s[7 * 33]);
        *(u32x4*)(WT + (size_t)(drow0 + n) * Kd + k0 + 8 * c) = o; }
    asm volatile("s_waitcnt lgkmcnt(0)" ::: "memory");
}
constexpr size_t WT_WIN = 0, WT_WOUT = WT_WIN + (size_t)2 * NPW * D, WT_FGU = WT_WOUT + (size_t)2 * D * D, WT_FD = WT_FGU + (size_t)2 * D_FF * D,
                 WT_MGU = WT_FD + (size_t)D * D_FF, WT_MD = WT_MGU + (size_t)NE * 2 * D_FFE * D, WT_END = WT_MD + (size_t)NE * D * D_FFE;
static_assert(WT_END * 2 <= 80 * MiB, "weight copies fit");
__device__ __forceinline__ void ph_pro_weights(const Args& a, Frame& F) {
    LAS float* scr = (LAS float*)(F.lds + F.wave * 16384);
    bf16_t* WT = (bf16_t*)(F.ws + WS_WT);
    constexpr int I_IN0 = 16 * 48, I_IN1 = 16 * 24, I_OUT = 16 * 32, I_FG = 16 * 88, I_FD = 44 * 32, I_M = 16 * 32;
    constexpr int NITEMS = 2 * (I_IN0 + I_IN1 + I_OUT) + 2 * I_FG + I_FD + 24 * I_M;
    for (int it = F.gw; it < NITEMS; it += F.ngw) {
        int r = it; const float* src; int pitch, k0, n0, Kd, drow0; bf16_t* dst;
        if (r < 2 * I_IN0) { const int l = r / I_IN0; r %= I_IN0; src = a.w_in + (size_t)l * D * N_IN; pitch = N_IN; k0 = (r / 48) * 64; n0 = (r % 48) * 32; dst = WT + WT_WIN + (size_t)l * NPW * D; Kd = D; drow0 = n0; }
        else if ((r -= 2 * I_IN0) < 2 * I_IN1) { const int l = r / I_IN1; r %= I_IN1; src = a.w_in + (size_t)l * D * N_IN + 1544; pitch = N_IN; k0 = (r / 24) * 64; n0 = (r % 24) * 32; dst = WT + WT_WIN + (size_t)l * NPW * D; Kd = D; drow0 = 1536 + n0; }
        else if ((r -= 2 * I_IN1) < 2 * I_OUT) { const int l = r / I_OUT; r %= I_OUT; src = a.w_out + (size_t)l * D * D; pitch = D; k0 = (r / 32) * 64; n0 = (r % 32) * 32; dst = WT + WT_WOUT + (size_t)l * D * D; Kd = D; drow0 = n0; }
        else if ((r -= 2 * I_OUT) < 2 * I_FG) { const int up = r / I_FG; r %= I_FG; src = up ? a.ffn_wu : a.ffn_wg; pitch = D_FF; k0 = (r / 88) * 64; n0 = (r % 88) * 32; dst = WT + WT_FGU; Kd = D; drow0 = (n0 / 128) * 256 + up * 128 + (n0 % 128); }
        else if ((r -= 2 * I_FG) < I_FD) { src = a.ffn_wd; pitch = D; k0 = (r / 32) * 64; n0 = (r % 32) * 32; dst = WT + WT_FD; Kd = D_FF; drow0 = n0; }
        else if ((r -= I_FD) < 16 * I_M) { const int e = r / (2 * I_M); r %= 2 * I_M; const int up = r / I_M; r %= I_M; src = (up ? a.moe_wu : a.moe_wg) + (size_t)e * D * D_FFE; pitch = D_FFE; k0 = (r / 32) * 64; n0 = (r % 32) * 32;
            dst = WT + WT_MGU + (size_t)e * 2 * D_FFE * D; Kd = D; drow0 = (n0 / 128) * 256 + up * 128 + (n0 % 128); }
        else { r -= 16 * I_M; const int e = r / I_M; r %= I_M; src = a.moe_wd + (size_t)e * D_FFE * D; pitch = D; k0 = (r / 32) * 64; n0 = (r % 32) * 32; dst = WT + WT_MD + (size_t)e * D * D_FFE; Kd = D_FFE; drow0 = n0; }
        transpose_item(src, pitch, k0, n0, dst, Kd, drow0, scr, F.lane);
    }
    for (int idx = F.bid * NTHREADS + F.tid; idx < 2 * 256 * D; idx += F.nb * NTHREADS) {
        const int l = idx / (256 * D), r = (idx / D) % 256, k = idx % D;
        WT[WT_WIN + (size_t)l * NPW * D + (size_t)(2304 + r) * D + k] = (r < 8) ? (bf16_t)f2bf(a.w_in[(size_t)l * D * N_IN + (size_t)k * N_IN + W_DB + r]) : (bf16_t)0;
    }
}

template <int NT> __device__ __forceinline__ void moe_order_init(Frame& F, pg8::MoeOrder<NT>& S) {
    const unsigned* c = (const unsigned*)(F.ws + WS_CTL) + CW_MOECNT;
    int acc = 0;
#pragma unroll
    for (int e = 0; e < 8; ++e) { S.cnt[e] = (int)__hip_atomic_load(c + 64 * e, __ATOMIC_RELAXED, __HIP_MEMORY_SCOPE_AGENT); S.bt[e] = acc; acc += (S.cnt[e] + 255) >> 8; }
    S.bt[8] = acc; S.G = F.nb; S.c = F.bid;
}
template <int NT> __device__ __forceinline__ int moe_ri_one(Frame& F, const pg8::MoeOrder<NT>& S, const int* RM, int o, int t) {
    pg8::Unit u; if (!S.next(o, u)) return -1;
    const int e = u.pn / NT; int bte = 0, cne = 0;
#pragma unroll
    for (int kk = 0; kk < 8; ++kk) { if (kk == e) { bte = S.bt[kk]; cne = S.cnt[kk]; } }
    const int sl = (u.pm - bte) * 256 + t; return (sl < cne) ? RM[(size_t)e * T + sl] : 0;
}
template <int NT> __device__ __forceinline__ void moe_ri_preload(Frame& F, const pg8::MoeOrder<NT>& S) {
    LAS int* RI = (LAS int*)(F.lds + RI_OFF); const int* RM = (const int*)(F.ws + WS_RMAP);
    const int t = F.tid & 255, par = F.tid >> 8;
    const int v0 = moe_ri_one<NT>(F, S, RM, par, t), v1 = moe_ri_one<NT>(F, S, RM, par + 2, t), v2 = moe_ri_one<NT>(F, S, RM, par + 4, t), v3 = moe_ri_one<NT>(F, S, RM, par + 6, t);
    const int v4 = moe_ri_one<NT>(F, S, RM, par + 8, t), v5 = moe_ri_one<NT>(F, S, RM, par + 10, t), v6 = moe_ri_one<NT>(F, S, RM, par + 12, t), v7 = moe_ri_one<NT>(F, S, RM, par + 14, t);
    if (v0 >= 0) RI[(par) * 256 + t] = v0; if (v1 >= 0) RI[(par + 2) * 256 + t] = v1; if (v2 >= 0) RI[(par + 4) * 256 + t] = v2; if (v3 >= 0) RI[(par + 6) * 256 + t] = v3;
    if (v4 >= 0) RI[(par + 8) * 256 + t] = v4; if (v5 >= 0) RI[(par + 10) * 256 + t] = v5; if (v6 >= 0) RI[(par + 12) * 256 + t] = v6;
    if (v7 >= 0 && par + 14 < 15) RI[(par + 14) * 256 + t] = v7;
    __syncthreads();
}

__device__ __forceinline__ void ph_norm0(const Args& a, Frame& F) {
    const float* MOD = (const float*)(F.ws + WS_MOD);
    bf16_t* XA = (bf16_t*)(F.ws + WS_H); bf16_t* X16 = (bf16_t*)(F.ws + WS_X16); float* SSQ = (float*)(F.ws + WS_SSQ) + (size_t)3 * T * 16;
    f32x4 vn[4], A4[4]; int cur_b = -1;
#define N0_LOAD(row_) { const f32x4* p_ = (const f32x4*)(a.x + (size_t)(row_) * D) + 2 * F.lane; vn[0] = __builtin_nontemporal_load(p_); vn[1] = __builtin_nontemporal_load(p_ + 1); vn[2] = __builtin_nontemporal_load(p_ + 128); vn[3] = __builtin_nontemporal_load(p_ + 129); }
    if (F.gw < T) N0_LOAD(F.gw)
    for (int row = F.gw; row < T; row += F.ngw) {
        const int b = row / SEQ;
        f32x4 v[4]; float ss = 0.f;
#pragma unroll
        for (int j = 0; j < 4; ++j) { v[j] = vn[j]; ss += (v[j].x * v[j].x + v[j].y * v[j].y) + (v[j].z * v[j].z + v[j].w * v[j].w); }
        if (row + F.ngw < T) N0_LOAD(row + F.ngw)
        if (b != cur_b) { cur_b = b;
#pragma unroll
            for (int j = 0; j < 4; ++j) { const int d = 512 * (j >> 1) + 8 * F.lane + 4 * (j & 1); A4[j] = *(const f32x4*)(a.nmg + d) * (*(const f32x4*)(MOD + (size_t)b * 3072 + 1024 + d) + 1.0f); } }
#pragma unroll
        for (int jj = 0; jj < 2; ++jj) {
            const int d = 512 * jj + 8 * F.lane; const f32x4 v0 = v[2 * jj], v1 = v[2 * jj + 1], s0 = v0 * A4[2 * jj], s1 = v1 * A4[2 * jj + 1];
            u32x4 o; o.x = pk2(v0.x, v0.y); o.y = pk2(v0.z, v0.w); o.z = pk2(v1.x, v1.y); o.w = pk2(v1.z, v1.w); *(u32x4*)(X16 + (size_t)row * D + d) = o;
            u32x4 p; p.x = pk2(s0.x, s0.y); p.y = pk2(s0.z, s0.w); p.z = pk2(s1.x, s1.y); p.w = pk2(s1.z, s1.w); *(u32x4*)(XA + (size_t)row * D + d) = p;
        }
        ss = wave_sum(ss);
        if (F.lane < 16) SSQ[(size_t)row * 16 + F.lane] = (F.lane == 0) ? ss : 0.f;
    }
#undef N0_LOAD
}
__device__ __forceinline__ void ph_prep_vectors(const Args& a, Frame& F) {
    const float* MOD = (const float*)(F.ws + WS_MOD); float* AV = (float*)(F.ws + WS_AV);
    for (int idx = F.bid * NTHREADS + F.tid; idx < 3 * BATCH * D; idx += F.nb * NTHREADS) {
        const int inst = idx / (BATCH * D), b = (idx / D) % BATCH, d = idx % D;
        const int lk = (inst == 0) ? 1 : (inst == 1 ? 2 : 3);
        const float gn = (inst == 0) ? a.nfg[d] : (inst == 1 ? a.nmg[D + d] : a.nfg[D + d]);
        AV[idx] = gn * (1.0f + MOD[((size_t)lk * 2 + b) * 3072 + 1024 + d]);
    }
    const bf16_t* WT = (const bf16_t*)(F.ws + WS_WT);
    constexpr int NR = 5632 + NPW + 16384 + NPW;
    LAS float* SH = (LAS float*)F.lds;
    for (int i = F.tid; i < 4 * BATCH * D; i += NTHREADS) { const int which = i / (BATCH * D), b = (i / D) % BATCH, d = i % D; SH[i] = MOD[((size_t)((which + 1) & 3) * 2 + b) * 3072 + d]; }
    __syncthreads();
    for (int g8 = F.gw; g8 < NR / 8; g8 += F.ngw) {
        const int row = g8 * 8 + (F.lane >> 3), part = F.lane & 7;
        int which, r; const bf16_t* wrow; float* out; int ncv;
        if (row < 5632) { which = 0; r = row; wrow = WT + WT_FGU + (size_t)r * D; out = (float*)(F.ws + WS_CVF); ncv = 5632; }
        else if (row < 5632 + NPW) { which = 1; r = row - 5632; wrow = WT + WT_WIN + (size_t)NPW * D + (size_t)r * D; out = (float*)(F.ws + WS_CVI); ncv = NPW; }
        else if (row < 5632 + NPW + 16384) { which = 2; r = row - 5632 - NPW; wrow = WT + WT_MGU + (size_t)r * D; out = (float*)(F.ws + WS_CVM); ncv = 16384; }
        else { which = 3; r = row - 5632 - NPW - 16384; wrow = WT + WT_WIN + (size_t)r * D; out = (float*)(F.ws + WS_CVI0); ncv = NPW; }
        u32x4 wv[16];
#pragma unroll
        for (int j = 0; j < 16; ++j) wv[j] = *(const u32x4*)(wrow + 128 * part + 8 * j);
        const LAS float* s0p = SH + (which * 2 + 0) * 1024 + 128 * part; const LAS float* s1p = s0p + 1024;
        float s0 = 0.f, s1 = 0.f;
#pragma unroll
        for (int j = 0; j < 16; ++j) {
            const f32x4 a0 = *(const LAS f32x4*)(s0p + 8 * j), a1 = *(const LAS f32x4*)(s0p + 8 * j + 4), b0 = *(const LAS f32x4*)(s1p + 8 * j), b1 = *(const LAS f32x4*)(s1p + 8 * j + 4);
            const float x0 = bf2f(wv[j].x & 0xffffu), x1 = bf2f(wv[j].x >> 16), x2 = bf2f(wv[j].y & 0xffffu), x3 = bf2f(wv[j].y >> 16), x4 = bf2f(wv[j].z & 0xffffu), x5 = bf2f(wv[j].z >> 16), x6 = bf2f(wv[j].w & 0xffffu), x7 = bf2f(wv[j].w >> 16);
            s0 += ((x0 * a0.x + x1 * a0.y) + (x2 * a0.z + x3 * a0.w)) + ((x4 * a1.x + x5 * a1.y) + (x6 * a1.z + x7 * a1.w));
            s1 += ((x0 * b0.x + x1 * b0.y) + (x2 * b0.z + x3 * b0.w)) + ((x4 * b1.x + x5 * b1.y) + (x6 * b1.z + x7 * b1.w));
        }
        s0 += __shfl_xor(s0, 1); s0 += __shfl_xor(s0, 2); s0 += __shfl_xor(s0, 4);
        s1 += __shfl_xor(s1, 1); s1 += __shfl_xor(s1, 2); s1 += __shfl_xor(s1, 4);
        if (part == 0) { out[r] = s0; out[ncv + r] = s1; }
    }
    __syncthreads();
    if (F.gw < BATCH * 8) {
        const int b = F.gw >> 3, e = F.gw & 7; float sacc = 0.f;
        for (int d = F.lane; d < D; d += 64) sacc += MOD[((size_t)3 * 2 + b) * 3072 + d] * a.router_w[(size_t)d * NE + e];
        sacc = wave_sum(sacc);
        if (F.lane == 0) ((float*)(F.ws + WS_CR))[b * 8 + e] = sacc;
    }
}
template <class Sched> __device__ __forceinline__ int count_units(const Sched& S) { int n = 0; pg8::Unit u; while (n < 16 && S.next(n, u)) ++n; return n; }
template <class Sched> __device__ __forceinline__ void rstd_preload(Frame& F, const Sched& S, const float* ssqp, const LAS int* RI) {
    LAS float* RS = (LAS float*)(F.lds + RS_OFF);
    const int t = F.tid & 255, par = F.tid >> 8, nu = count_units(S);
#pragma unroll
    for (int k0 = 0; k0 < 8; k0 += 4) {
        f32x4 p0[4], p1[4], p2[4], p3[4]; int r0, r1, r2, r3;
#define RSP_LOAD(k, pk, rk) { const int o = par + 2 * (k0 + k); pg8::Unit u; u.pm = 0; rk = 0; if (o < nu) { S.next(o, u); rk = RI ? RI[o * 256 + t] : u.pm * 256 + t; } \
            const f32x4* q = (const f32x4*)(ssqp + (size_t)rk * 16); pk[0] = q[0]; pk[1] = q[1]; pk[2] = q[2]; pk[3] = q[3]; }
        RSP_LOAD(0, p0, r0) RSP_LOAD(1, p1, r1) RSP_LOAD(2, p2, r2) RSP_LOAD(3, p3, r3)
#undef RSP_LOAD
#define RSP_STORE(k, pk, rk) { const int o = par + 2 * (k0 + k); if (o < nu) { const f32x4 s4 = (pk[0] + pk[1]) + (pk[2] + pk[3]); \
            const float rs = rsqrtf(((s4.x + s4.y) + (s4.z + s4.w)) * (1.0f / D) + EPS); RS[o * 256 + t] = (rk >= SEQ) ? -rs : rs; } }
        RSP_STORE(0, p0, r0) RSP_STORE(1, p1, r1) RSP_STORE(2, p2, r2) RSP_STORE(3, p3, r3)
#undef RSP_STORE
    }
    __syncthreads();
}
__device__ __forceinline__ void ph_router(const Args& a, Frame& F) {
    const bf16_t* XA = (const bf16_t*)(F.ws + WS_H); const float* SSQ = (const float*)(F.ws + WS_SSQ) + (size_t)2 * T * 16; const float* CR = (const float*)(F.ws + WS_CR);
    LAS float* W8T = (LAS float*)F.lds;
    for (int i = F.tid; i < 8192; i += NTHREADS) { const int d = i >> 3, j = i & 7; W8T[j * 1024 + d] = a.router_w[i]; }
    __syncthreads();
    for (int row = F.gw; row < T; row += F.ngw) {
        const int b = row / SEQ;
        float acc[8];
#pragma unroll
        for (int e = 0; e < 8; ++e) acc[e] = 0.f;
#pragma unroll
        for (int jj = 0; jj < 2; ++jj) {
            const int d = 512 * jj + 8 * F.lane;
            const u32x4 xv = *(const u32x4*)(XA + (size_t)row * D + d);
            const float x[8] = {bf2f(xv.x & 0xffffu), bf2f(xv.x >> 16), bf2f(xv.y & 0xffffu), bf2f(xv.y >> 16), bf2f(xv.z & 0xffffu), bf2f(xv.z >> 16), bf2f(xv.w & 0xffffu), bf2f(xv.w >> 16)};
#pragma unroll
            for (int e = 0; e < 8; ++e) { const f32x4 wa = *(const LAS f32x4*)(W8T + e * 1024 + d), wb = *(const LAS f32x4*)(W8T + e * 1024 + d + 4);
                acc[e] += ((x[0] * wa.x + x[1] * wa.y) + (x[2] * wa.z + x[3] * wa.w)) + ((x[4] * wb.x + x[5] * wb.y) + (x[6] * wb.z + x[7] * wb.w)); }
        }
        const float ssq = wave_sum(F.lane < 16 ? SSQ[(size_t)row * 16 + F.lane] : 0.f);
        const float rstd = rsqrtf(ssq * (1.0f / D) + EPS);
#pragma unroll
        for (int e = 0; e < 8; ++e) acc[e] = wave_sum(acc[e]);
        if (F.lane == 0) {
            float v0 = -INFINITY, v1 = -INFINITY; int e0 = 0, e1 = 0;
#pragma unroll
            for (int e = 0; e < 8; ++e) { const float lg = rstd * acc[e] + CR[b * 8 + e] + a.router_b[e]; if (lg > v0) { v1 = v0; e1 = e0; v0 = lg; e0 = e; } else if (lg > v1) { v1 = lg; e1 = e; } }
            const float ex = __expf(v1 - v0), p0 = 1.0f / (1.0f + ex), p1 = ex / (1.0f + ex);
            unsigned* cnt = (unsigned*)(F.ws + WS_CTL) + CW_MOECNT;
            const int q0 = (int)atomicAdd(cnt + 64 * e0, 1u), q1 = (int)atomicAdd(cnt + 64 * e1, 1u);
            int* R = (int*)(F.ws + WS_ROUTE) + (size_t)row * 4; R[0] = e0; R[1] = e1; ((float*)R)[2] = p0; ((float*)R)[3] = p1;
            int* Pq = (int*)(F.ws + WS_POS) + (size_t)row * 2; Pq[0] = q0; Pq[1] = q1;
            int* RM = (int*)(F.ws + WS_RMAP); RM[(size_t)e0 * T + q0] = row; RM[(size_t)e1 * T + q1] = row;
        }
    }
    __syncthreads();
}

__global__ void __launch_bounds__(NTHREADS, 2) fwd(Args a) {
    extern __shared__ __attribute__((aligned(16))) unsigned char lds_raw[];
    Frame F;
    F.lds = (LAS unsigned char*)lds_raw;
    F.tid = threadIdx.x; F.lane = F.tid & 63; F.wave = __builtin_amdgcn_readfirstlane(F.tid >> 6);
    F.bid = blockIdx.x; F.nb = gridDim.x; F.gw = F.bid * NWAVES + F.wave; F.ngw = F.nb * NWAVES; F.ws = (GAS unsigned char*)a.ws;
    volatile LAS unsigned* MISC = (volatile LAS unsigned*)(F.lds + MISC_OFF);
    for (int u = F.tid; u < 32; u += NTHREADS) MISC[u] = 0u;
    __syncthreads();
    unsigned* ctl = (unsigned*)(a.ws + WS_CTL);
    const int lo = a.ph_lo, hi = a.ph_hi;
    const bool multi = (hi - lo) > 1;
    XcdBarrier bar; bar.bar = ctl + CW_BAR; bar.x = 0; bar.st = MISC + 8;
    if (multi) bar = xcd_barrier_post(ctl + CW_BAR, MISC + 8);
#define IN(k) (lo <= (k) && (k) < hi && (frame_refresh(F, a, (LAS unsigned char*)lds_raw), true))
#define SEAM(k) do { if (hi > (k) + 1 && lo <= (k)) { xcd_barrier(bar); if constexpr ((PROBE_MASK & 4194304) != 0) xcd_barrier(bar); } } while (0)
    float* MOD = (float*)(a.ws + WS_MOD);
    bf16_t* H = (bf16_t*)(a.ws + WS_H); bf16_t* PROJ = (bf16_t*)(a.ws + WS_PROJ); bf16_t* YMIX = (bf16_t*)(a.ws + WS_YMIX);
    bf16_t* WT = (bf16_t*)(a.ws + WS_WT);
    bf16_t* ACT = (bf16_t*)(a.ws + WS_ACT); bf16_t* ACTM = (bf16_t*)(a.ws + WS_ACTM); bf16_t* YMOE = (bf16_t*)(a.ws + WS_YMOE);

    if (IN(PH_PRO)) { REP(1) { ph_pro_vectors(a, F); ph_pro_weights(a, F); } SEAM(PH_PRO); }

#define TWICE(bit, stmt) do { stmt; if constexpr ((PROBE_MASK & (bit)) != 0) { stmt; } } while (0)
    float* AV = (float*)(a.ws + WS_AV); float* SSQ = (float*)(a.ws + WS_SSQ); bf16_t* X16 = (bf16_t*)(a.ws + WS_X16);
    const LAS float* RSL = (const LAS float*)(F.lds + RS_OFF);
#define LAYER_BODY(l) {\
        const int pb = PH_LAYER0 + PH_PER_LAYER * l; \
        const float* xin = (l == 0) ? a.x : a.out; \
        const float* mod0 = MOD + (size_t)(l * 2 + 0) * 2 * 3072; const float* mod1 = MOD + (size_t)(l * 2 + 1) * 2 * 3072; \
        if (l == 0) { if (IN(pb + K_NORM1)) { REP(2) ph_norm0(a, F); ph_prep_vectors(a, F); SEAM(pb + K_NORM1); } } \
        if (IN(pb + K_GEMM_IN)) { \
            TWICE(4, ({ pg8::Gemm g{H, WT + WT_WIN + (size_t)l * NPW * D, D}; pg8::StaticOrder S; S.init(T, NPW, F.nb, F.bid); rstd_preload(F, S, SSQ + (size_t)(l == 0 ? 3 : 1) * T * 16, nullptr); \
                pg8::EpiProjNorm E{PROJ, RSL, (const float*)(a.ws + (l == 0 ? WS_CVI0 : WS_CVI)), (float*)(a.ws + WS_BG), a.dn_a_log + 4 * l, a.dn_dt_bias + 4 * l}; \
                pg8::gemm_phase<pg8::EpiProjNorm, pg8::StaticOrder, false, true, true>(F.lds, nullptr, g, S, E); })); \
            SEAM(pb + K_GEMM_IN); \
        } \
        if (IN(pb + K_DN_PREP)) { REP(8) ph_dn_chunk(a, F, l); ph_rope(a, F); SEAM(pb + K_DN_PREP); } \
        if (IN(pb + K_MIX)) { REP(16) ph_dn_scan(a, F); REP(512) ph_attn_mfma(a, F, l); REP(1024) ph_conv_fast(a, F, l); SEAM(pb + K_MIX); } \
        if (IN(pb + K_DN_OUT)) { REP(32) ph_dn_out(a, F, l); SEAM(pb + K_DN_OUT); } \
        if (IN(pb + K_GEMM_OUT)) { \
            TWICE(0, ({ pg8::Gemm g{YMIX, WT + WT_WOUT + (size_t)l * D * D, D}; pg8::StaticOrder S; S.init(T, D, F.nb, F.bid); \
                pg8::EpiResidNorm E{X16, X16, mod0 + 2048, AV + (size_t)(l == 0 ? 0 : 2) * BATCH * D, H, SSQ + (size_t)(l == 0 ? 0 : 2) * T * 16}; \
                pg8::gemm_phase<pg8::EpiResidNorm, pg8::StaticOrder, false, true, true>(F.lds, nullptr, g, S, E); })); \
            if constexpr ((PROBE_MASK & 8388608) != 0 && l == 0) { pg8::Gemm g{YMIX, WT + WT_WOUT + (size_t)l * D * D, D}; pg8::StaticOrder S; S.init(T, D, F.nb, F.bid); pg8::EpiBf16 E{(bf16_t*)(a.ws + WS_DN_MR), D, 1 << 20}; \
                pg8::gemm_phase<pg8::EpiBf16, pg8::StaticOrder, false, true, true>(F.lds, nullptr, g, S, E); } \
            if constexpr ((PROBE_MASK & 16777216) != 0 && l == 0) { pg8::Gemm g{YMIX, WT + WT_WOUT + (size_t)l * D * D, D}; pg8::StaticOrder S; S.init(T, D, F.nb, F.bid); \
                pg8::EpiResidNorm E{X16, (bf16_t*)(a.ws + WS_DN_MR), mod0 + 2048, AV, (bf16_t*)(a.ws + WS_DN_MR), (float*)(a.ws + WS_DN_ST)}; \
                pg8::gemm_phase<pg8::EpiResidNorm, pg8::StaticOrder, false, true, true>(F.lds, nullptr, g, S, E); } \
            if constexpr ((PROBE_MASK & 131072) != 0 && l == 0) { pg8::Gemm g{YMIX, WT + WT_WOUT + (size_t)l * D * D, D}; pg8::StaticOrder S; S.init(T, D, F.nb, F.bid); pg8::EpiNull E{}; \
                pg8::gemm_phase<pg8::EpiNull, pg8::StaticOrder, false, true, true>(F.lds, nullptr, g, S, E); } \
            SEAM(pb + K_GEMM_OUT); \
        } \
        if (l == 0) { \
            if (IN(pb + K_FFN1)) { \
                TWICE(256, ({ pg8::Gemm g{H, WT + WT_FGU, D}; pg8::StaticOrder S; S.init(T, 2 * D_FF, F.nb, F.bid); rstd_preload(F, S, SSQ, nullptr); \
                    pg8::EpiSwiGLUNorm E{ACT, D_FF, 1 << 20, RSL, (const float*)(a.ws + WS_CVF), 5632}; \
                    pg8::gemm_phase<pg8::EpiSwiGLUNorm, pg8::StaticOrder, false, true, true>(F.lds, nullptr, g, S, E); })); \
                SEAM(pb + K_FFN1); \
            } \
            if (IN(pb + K_FFN2)) { \
                { pg8::Gemm g{ACT, WT + WT_FD, D_FF}; pg8::StaticOrder S; S.init(T, D, F.nb, F.bid); \
                    pg8::EpiResidNorm E{X16, X16, mod1 + 2048, AV + (size_t)1 * BATCH * D, H, SSQ + (size_t)1 * T * 16}; \
                    pg8::gemm_phase<pg8::EpiResidNorm, pg8::StaticOrder, false, true, true>(F.lds, nullptr, g, S, E); } \
                SEAM(pb + K_FFN2); \
            } \
        } else { \
            if (IN(pb + K_NORM2)) { ph_router(a, F); SEAM(pb + K_NORM2); } \
            if (IN(pb + K_FFN1)) { \
                TWICE(2048, ({ pg8::MoeOrder<8> S; moe_order_init<8>(F, S); moe_ri_preload<8>(F, S); rstd_preload(F, S, SSQ + (size_t)2 * T * 16, (const LAS int*)(F.lds + RI_OFF)); \
                    pg8::Gemm g{H, WT + WT_MGU, D}; pg8::EpiSwiGLUNorm E{ACTM, D_FFE, 8, RSL, (const float*)(a.ws + WS_CVM), 16384}; \
                    pg8::gemm_phase<pg8::EpiSwiGLUNorm, pg8::MoeOrder<8>, true, true, true>(F.lds, (const LAS int*)(F.lds + RI_OFF), g, S, E); })); \
                SEAM(pb + K_FFN1); \
            } \
            if (IN(pb + K_FFN2)) { \
                TWICE(4096, ({ pg8::MoeOrder<4> S; moe_order_init<4>(F, S); \
                    pg8::Gemm g{ACTM, WT + WT_MD, D_FFE}; pg8::EpiBf16W E{YMOE, D, 4}; \
                    pg8::gemm_phase<pg8::EpiBf16W, pg8::MoeOrder<4>, false, true, true>(F.lds, nullptr, g, S, E); })); \
                SEAM(pb + K_FFN2); \
            } \
        } \
    }
    LAYER_BODY(0)
    LAYER_BODY(1)
#undef LAYER_BODY
    if (IN(PH_FINAL)) { ph_final(a, F); }
#undef IN
#undef SEAM
}

extern "C" void kernel_launch(void* const* d_in, const int* in_sizes, int n_in, void* d_out, int out_size, void* d_ws, size_t ws_size, hipStream_t stream) {
    static int grid = 0;
    if (grid == 0) {
        if (n_in != 27 || out_size != T * D || ws_size < WS_END) { fprintf(stderr, "kernel_launch: unexpected shapes n_in %d out %d ws %zu\n", n_in, out_size, ws_size); grid = -1; return; }
        int dev = 0, cus = 0, per_cu = 0;
        if (hipGetDevice(&dev) != hipSuccess || hipDeviceGetAttribute(&cus, hipDeviceAttributeMultiprocessorCount, dev) != hipSuccess) { grid = -1; return; }
        if (hipFuncSetAttribute((const void*)fwd, hipFuncAttributeMaxDynamicSharedMemorySize, LDS_BYTES) != hipSuccess) { fprintf(stderr, "kernel_launch: hipFuncSetAttribute failed\n"); grid = -1; return; }
        if (hipOccupancyMaxActiveBlocksPerMultiprocessor(&per_cu, (const void*)fwd, NTHREADS, LDS_BYTES) != hipSuccess || per_cu < 1) fprintf(stderr, "kernel_launch: occupancy query says %d\n", per_cu);
        (void)hipGetLastError();
        grid = cus;
    }
    if (grid < 0) return;
    (void)hipMemsetAsync((char*)d_ws + WS_CTL, 0, CTL_ZERO_BYTES, stream);
    Args a{};
    const void** pp = (const void**)&a;
    for (int i = 0; i < 27; ++i) pp[i] = d_in[i];
    a.out = (float*)d_out; a.ws = (unsigned char*)d_ws;
#if MK_ONE_LAUNCH
    a.ph_lo = 0; a.ph_hi = NPH;
    hipLaunchKernelGGL(fwd, dim3(grid), dim3(NTHREADS), LDS_BYTES, stream, a);
#else
    static const int phases[] = {0, 1, 2, 3, 4, 5, 6, 7, 9, 10, 11, 12, 13, 14, 15, 16, 17, 18, 19, 20, 21};
    for (int p : phases) { a.ph_lo = p; a.ph_hi = p + 1; hipLaunchKernelGGL(fwd, dim3(grid), dim3(NTHREADS), LDS_BYTES, stream, a); }
#endif
}
```

```cpp
#include <hip/hip_runtime.h>
#include <cstdio>
#include <cstdint>

#define LAS __attribute__((address_space(3)))
#define GAS __attribute__((address_space(1)))
typedef unsigned short bf16_t;
typedef float f32x4 __attribute__((ext_vector_type(4)));
typedef unsigned u32x2 __attribute__((ext_vector_type(2)));
typedef unsigned u32x4 __attribute__((ext_vector_type(4)));

#ifndef GEMM_MASK
#define GEMM_MASK 63
#endif
#ifndef ATTN_MFMA
#define ATTN_MFMA 1
#endif
#ifndef DN_CHUNKED
#define DN_CHUNKED 1
#endif
#ifndef CONV_FAST
#define CONV_FAST 1
#endif
#ifndef PROBE_MASK
#define PROBE_MASK 0
#endif
#define REP(bit) for (int rep_ = 0; rep_ < ((PROBE_MASK & (bit)) ? 2 : 1); ++rep_)
#ifndef MK_ONE_LAUNCH
#define MK_ONE_LAUNCH 1
#endif

constexpr int BATCH = 2, SEQ = 16384, T = BATCH * SEQ, D = 1024, DEPTH = 2;
constexpr int NPW = 2560;
constexpr int N_IN = 2312, NP = 2304;
constexpr int C_AQ = 0, C_AK = 512, C_AV = 640, C_DQ = 768, C_DK = 1024, C_DV = 1280, C_DZ = 1536, C_CA = 1792, C_CB = 2048;
constexpr int W_DB = 1536;
constexpr int D_FF = 2816, NE = 8, D_FFE = 1024;
constexpr int WINDOW = 128, CV_K = 31, CV_C = 256, DN_CONV = 4;
constexpr float EPS = 1e-6f;
constexpr int NSCAN = BATCH * 4 * 4;
constexpr int MOE_CAP = 67584;

constexpr size_t MiB = 1u << 20;
constexpr size_t WS_CTL = 0, CTL_ZERO_BYTES = 1 * MiB;
constexpr size_t WS_MOD = 1 * MiB;
constexpr size_t WS_CS = 2 * MiB;
constexpr size_t WS_BG = 4 * MiB;
constexpr size_t WS_ROUTE = 5 * MiB;
constexpr size_t WS_POS = 6 * MiB;
constexpr size_t WS_RMAP = 7 * MiB;
constexpr size_t WS_WT = 8 * MiB;
constexpr size_t WS_H = 88 * MiB;
constexpr size_t WS_PROJ = 152 * MiB;
constexpr size_t WS_YMIX = 296 * MiB;
constexpr size_t WS_DNQKV = 360 * MiB;
constexpr size_t WS_ODN = 456 * MiB;
constexpr size_t WS_ACT = 152 * MiB;
constexpr size_t WS_ACTM = 152 * MiB;
constexpr size_t WS_YMOE = 284 * MiB;
constexpr size_t WS_X16 = 440 * MiB;
constexpr size_t WS_SSQ = 504 * MiB;
constexpr size_t WS_AV = WS_MOD + 128 * 1024;
constexpr size_t WS_CVF = WS_MOD + 256 * 1024;
constexpr size_t WS_CVI = WS_CVF + 2 * 5632 * 4;
constexpr size_t WS_CVM = WS_CVI + 2 * 2560 * 4;
constexpr size_t WS_CR = WS_CVM + 2 * 16384 * 4;
constexpr size_t WS_CVI0 = WS_CR + 64;
static_assert(WS_CVI0 + 2 * 2560 * 4 <= WS_CS, "vector area");
constexpr size_t WS_END = 512 * MiB;
constexpr int CW_BAR = 4096;
constexpr int CW_MOECNT = 16384;

constexpr int NWAVES = 8, NTHREADS = 512;
constexpr int LDS_BYTES = 163840;
constexpr int MISC_OFF = 131072 + 320;
constexpr int RI_OFF = 132096;
constexpr int RS_OFF = 147456;

constexpr int PH_PRO = 0, PH_LAYER0 = 1, PH_PER_LAYER = 10, PH_FINAL = 21, NPH = 22;
enum { K_NORM1 = 0, K_GEMM_IN, K_DN_PREP, K_MIX, K_DN_OUT, K_GEMM_OUT, K_NORM2, K_MOE_LIST, K_FFN1, K_FFN2 };

struct Args {
    const float* x; const float* c; const int* pos; const float* ada_w; const float* ada_b; const float* nmg; const float* nfg;
    const float* w_in; const float* sinks; const float* dn_conv_w; const float* dn_a_log; const float* dn_dt_bias; const float* dn_norm_g;
    const float* cv_dw_w; const float* cv_dw_b; const float* cv_ln_g; const float* cv_ln_b; const float* w_out;
    const float* ffn_wg; const float* ffn_wu; const float* ffn_wd; const float* router_w; const float* router_b;
    const float* moe_wg; const float* moe_wu; const float* moe_wd; const float* final_g;
    float* out; unsigned char* ws; int ph_lo, ph_hi;
};

__device__ __forceinline__ float bf2f(unsigned u) { return __uint_as_float(u << 16); }
__device__ __forceinline__ unsigned f2bf(float f) { unsigned u = __float_as_uint(f); return (u + 0x7fffu + ((u >> 16) & 1u)) >> 16; }
__device__ __forceinline__ unsigned pk2(float lo, float hi) { return f2bf(lo) | (f2bf(hi) << 16); }
#define DPP_MOV(v, ctrl) __int_as_float(__builtin_amdgcn_update_dpp(0, __float_as_int(v), (ctrl), 0xf, 0xf, false))
__device__ __forceinline__ float row16_sum(float v) { v += DPP_MOV(v, 0xB1); v += DPP_MOV(v, 0x4E); v += DPP_MOV(v, 0x141); v += DPP_MOV(v, 0x140); return v; }
__device__ __forceinline__ float wave_sum(float v) {
    v = row16_sum(v);
    const int vi = __float_as_int(v);
    return (__int_as_float(__builtin_amdgcn_readlane(vi, 0)) + __int_as_float(__builtin_amdgcn_readlane(vi, 16))) + (__int_as_float(__builtin_amdgcn_readlane(vi, 32)) + __int_as_float(__builtin_amdgcn_readlane(vi, 48)));
}
__device__ __forceinline__ float xor32_sum(float v) { const auto r = __builtin_amdgcn_permlane32_swap(__float_as_uint(v), __float_as_uint(v), false, false); return __uint_as_float(r[0]) + __uint_as_float(r[1]); }
__device__ __forceinline__ float xor32_max(float v) { const auto r = __builtin_amdgcn_permlane32_swap(__float_as_uint(v), __float_as_uint(v), false, false); return fmaxf(__uint_as_float(r[0]), __uint_as_float(r[1])); }
__device__ __forceinline__ float xor16_sum(float v) { const auto r = __builtin_amdgcn_permlane16_swap(__float_as_uint(v), __float_as_uint(v), false, false); return __uint_as_float(r[0]) + __uint_as_float(r[1]); }
__device__ __forceinline__ float group8_sum(float v) { v += DPP_MOV(v, 0xB1); v += DPP_MOV(v, 0x4E); v += DPP_MOV(v, 0x141); return v; }
__device__ __forceinline__ float wave_max(float v) {
#pragma unroll
    for (int o = 1; o < 64; o <<= 1) v = fmaxf(v, __shfl_xor(v, o));
    return v;
}
__device__ __forceinline__ float sigmoidf_(float x) { return __builtin_amdgcn_rcpf(1.0f + __builtin_amdgcn_exp2f(x * -1.4426950408889634f)); }
__device__ __forceinline__ float siluf_(float x) { return x * __builtin_amdgcn_rcpf(1.0f + __builtin_amdgcn_exp2f(x * -1.4426950408889634f)); }
__device__ __forceinline__ float softplusf_(float x) { return fmaxf(x, 0.f) + log1pf(__expf(-fabsf(x))); }

#define XB_TMO      128
#define XB_XCNT(j)  (256  + 64 * (j))
#define XB_XSUB(j)  (1280 + 64 * (j))
#define XB_XGEN(j)  (2304 + 64 * (j))
#define XB_TOP      3328
#define XB_TOPGEN   3392
#define XCD_BAR_WORDS 3456
#define XB_SPIN_CAP (1u << 18)

__device__ __forceinline__ unsigned xb_ld(unsigned* p)              { return __hip_atomic_load(p, __ATOMIC_RELAXED, __HIP_MEMORY_SCOPE_AGENT); }
__device__ __forceinline__ unsigned xb_add(unsigned* p, unsigned v) { return __hip_atomic_fetch_add(p, v, __ATOMIC_RELAXED, __HIP_MEMORY_SCOPE_AGENT); }
__device__ __forceinline__ unsigned xb_xcc_id() { return (unsigned)__builtin_amdgcn_s_getreg((3 << 11) | 20) & 0xFu; }
#define XB_SPIN(cond, bar) do { unsigned _sp = 0; while (cond) { __builtin_amdgcn_s_sleep(1); \
    if ((++_sp & 255u) == 0u) { if (xb_ld(&(bar)[XB_TMO])) break; if (_sp > XB_SPIN_CAP) { atomicAdd(&(bar)[XB_TMO], 1u); break; } } } } while (0)

struct XcdBarrier { unsigned* bar; unsigned x; volatile LAS unsigned* st; };

__device__ __forceinline__ XcdBarrier xcd_barrier_post(unsigned* bar, volatile LAS unsigned* st) {
    XcdBarrier b; b.bar = bar; b.x = xb_xcc_id(); b.st = st;
    if (threadIdx.x == 0) (void)xb_add(&bar[XB_XCNT(b.x)], 1u);
    return b;
}
__device__ __forceinline__ void xcd_barrier_complete(unsigned* bar, unsigned x, unsigned& nloc, unsigned& nx) {
    const unsigned G = gridDim.x * gridDim.y * gridDim.z;
    unsigned sum, cnt, mine, sp = 0u;
    for (;;) {
        sum = 0u; cnt = 0u; mine = 0u;
#pragma unroll
        for (unsigned j = 0; j < 16; ++j) { const unsigned c = xb_ld(&bar[XB_XCNT(j)]); sum += c; cnt += (c > 0u) ? 1u : 0u; mine = (j == x) ? c : mine; }
        if (sum == G) break;
        __builtin_amdgcn_s_sleep(1);
        if ((++sp & 255u) == 0u) { if (xb_ld(&bar[XB_TMO])) break; if (sp > XB_SPIN_CAP) { atomicAdd(&bar[XB_TMO], 1u); break; } }
    }
    nloc = mine > 0u ? mine : 1u; nx = cnt > 0u ? cnt : 1u;
}
__device__ __forceinline__ void xcd_barrier(const XcdBarrier& b) {
    asm volatile("s_waitcnt vmcnt(0)" ::: "memory");
    __syncthreads();
    if (threadIdx.x == 0) {
        unsigned* bar = b.bar;
        __builtin_amdgcn_s_waitcnt(0);
        unsigned nloc = b.st[0], nx = b.st[1];
        if (nloc == 0u) { xcd_barrier_complete(bar, b.x, nloc, nx); b.st[0] = nloc; b.st[1] = nx; }
        const unsigned old = xb_add(&bar[XB_XSUB(b.x)], 1u);
        const unsigned gen = old / nloc;
        if (old + 1u == (gen + 1u) * nloc) {
            __builtin_amdgcn_fence(__ATOMIC_RELEASE, "agent");
            asm volatile("s_waitcnt vmcnt(0)" ::: "memory");
            const unsigned og = xb_add(&bar[XB_TOP], 1u);
            const unsigned tg = og / nx;
            if (og + 1u == (tg + 1u) * nx) xb_add(&bar[XB_TOPGEN], 1u);
            else XB_SPIN(xb_ld(&bar[XB_TOPGEN]) == tg, bar);
            __builtin_amdgcn_fence(__ATOMIC_ACQUIRE, "agent");
            xb_add(&bar[XB_XGEN(b.x)], 1u);
            asm volatile("s_waitcnt vmcnt(0)" ::: "memory");
        } else {
            XB_SPIN(xb_ld(&bar[XB_XGEN(b.x)]) == gen, bar);
            __builtin_amdgcn_fence(__ATOMIC_ACQUIRE, "agent");
            asm volatile("s_waitcnt vmcnt(0)" ::: "memory");
        }
    }
    __syncthreads();
}

struct Frame {
    LAS unsigned char* lds;
    int tid, lane, wave, gw, ngw, bid, nb;
    GAS unsigned char* ws;
};

__device__ __forceinline__ void frame_refresh(Frame& F, const Args& a, LAS unsigned char* lds) {
    int tid = threadIdx.x; asm volatile("" : "+v"(tid));
    int bid = blockIdx.x; asm volatile("" : "+s"(bid));
    unsigned char* ws = a.ws; asm volatile("" : "+s"(ws));
    F.lds = lds; F.tid = tid; F.lane = tid & 63; F.wave = __builtin_amdgcn_readfirstlane(tid >> 6);
    F.bid = bid; F.nb = gridDim.x; F.gw = F.bid * NWAVES + F.wave; F.ngw = F.nb * NWAVES; F.ws = (GAS unsigned char*)ws;
}
__device__ __forceinline__ void ph_pro_vectors(const Args& a, Frame& F) {
    float* MOD = (float*)(F.ws + WS_MOD);
    LAS float* red = (LAS float*)F.lds;
    for (int it = F.bid; it < 4 * 48; it += F.nb) {
        const int lk = it / 48, cg = it % 48, e = cg * 64 + F.lane;
        const float* W = a.ada_w + (size_t)lk * D * 3072 + e;
        float a0 = 0.f, a1 = 0.f;
        const int d0 = F.wave * 128;
#pragma unroll 8
        for (int d = d0; d < d0 + 128; ++d) {
            const float w = __builtin_nontemporal_load(W + (size_t)d * 3072);
            a0 += siluf_(a.c[d]) * w; a1 += siluf_(a.c[D + d]) * w;
        }
        red[(F.wave * 2 + 0) * 64 + F.lane] = a0; red[(F.wave * 2 + 1) * 64 + F.lane] = a1;
        __syncthreads();
        if (F.wave < 2) {
            float s = 0.f;
            for (int w = 0; w < 8; ++w) s += red[(w * 2 + F.wave) * 64 + F.lane];
            MOD[((size_t)lk * 2 + F.wave) * 3072 + e] = s + a.ada_b[lk * 3072 + e];
        }
        __syncthreads();
    }
    float* CS = (float*)(F.ws + WS_CS);
    for (int idx = F.bid * NTHREADS + F.tid; idx < T * 8; idx += F.nb * NTHREADS) {
        const int t = idx >> 3, i = idx & 7;
        const float inv = powf(500000.0f, -(float)(2 * i) / 16.0f);
        const float ang = (float)a.pos[t] * inv;
        CS[t * 16 + i] = cosf(ang); CS[t * 16 + 8 + i] = sinf(ang);
    }
}

template <int MODE>
__device__ __forceinline__ void ph_norm(const Args& a, Frame& F, int l, const float* xin, const float* gain, const float* modk  ,
                                        const float* W8, int pitch) {
    bf16_t* H = (bf16_t*)(F.ws + WS_H);
    LAS float* W8T = (LAS float*)F.lds;
    if (MODE != 0) {
        for (int i = F.tid; i < 8192; i += NTHREADS) { const int d = i >> 3, j = i & 7; W8T[j * 1024 + d] = W8[(size_t)d * pitch + j]; }
        __syncthreads();
    }
    f32x4 vn[4], A4[4], B4[4]; int cur_b = -1;
    if (F.gw < T) {
#pragma unroll
        for (int j = 0; j < 4; ++j) vn[j] = ((const f32x4*)(xin + (size_t)F.gw * D) + F.lane)[64 * j];
    }
    for (int row = F.gw; row < T; row += F.ngw) {
        const int b = row / SEQ;
        f32x4 v[4]; float ss = 0.f;
#pragma unroll
        for (int j = 0; j < 4; ++j) { v[j] = vn[j]; ss += (v[j].x * v[j].x + v[j].y * v[j].y) + (v[j].z * v[j].z + v[j].w * v[j].w); }
        if (row + F.ngw < T) {
#pragma unroll
            for (int j = 0; j < 4; ++j) vn[j] = ((const f32x4*)(xin + (size_t)(row + F.ngw) * D) + F.lane)[64 * j];
        }
        if (b != cur_b) {
            cur_b = b; const float* sh = modk + (size_t)b * 3072; const float* sc = sh + 1024;
#pragma unroll
            for (int j = 0; j < 4; ++j) { const int d = 256 * j + 4 * F.lane; A4[j] = *(const f32x4*)(gain + d) * (*(const f32x4*)(sc + d) + 1.0f); B4[j] = *(const f32x4*)(sh + d); }
        }
        const float rstd = rsqrtf(wave_sum(ss) * (1.0f / D) + EPS);
        float acc[8];
#pragma unroll
        for (int e = 0; e < 8; ++e) acc[e] = 0.f;
#pragma unroll
        for (int j = 0; j < 4; ++j) {
            const int d = 256 * j + 4 * F.lane;
            const f32x4 hv = (v[j] * rstd) * A4[j] + B4[j];
            u32x2 o; o.x = pk2(hv.x, hv.y); o.y = pk2(hv.z, hv.w);
            *(u32x2*)(H + (size_t)row * D + d) = o;
            if (MODE == 1) { u32x2 xo; xo.x = pk2(v[j].x, v[j].y); xo.y = pk2(v[j].z, v[j].w); *(u32x2*)((bf16_t*)(F.ws + WS_X16) + (size_t)row * D + d) = xo; }
            if (MODE != 0) {
#pragma unroll
                for (int e = 0; e < 8; ++e) { const f32x4 w4 = *(const LAS f32x4*)(W8T + e * 1024 + d); acc[e] += (hv.x * w4.x + hv.y * w4.y) + (hv.z * w4.z + hv.w * w4.w); }
            }
        }
        if (MODE != 0) {
#pragma unroll
            for (int e = 0; e < 8; ++e) acc[e] = wave_sum(acc[e]);
        }
        if (MODE == 1 && F.lane == 0) {
            float* BG = (float*)(F.ws + WS_BG) + (size_t)row * 8;
#pragma unroll
            for (int h = 0; h < 4; ++h) {
                BG[h] = sigmoidf_(acc[h]);
                BG[4 + h] = -__expf(a.dn_a_log[l * 4 + h]) * softplusf_(acc[4 + h] + a.dn_dt_bias[l * 4 + h]);
            }
        }
        if (MODE == 2 && F.lane == 0) {
            float v0 = -INFINITY, v1 = -INFINITY; int e0 = 0, e1 = 0;
#pragma unroll
            for (int e = 0; e < 8; ++e) { const float lg = acc[e] + a.router_b[e]; if (lg > v0) { v1 = v0; e1 = e0; v0 = lg; e0 = e; } else if (lg > v1) { v1 = lg; e1 = e; } }
            const float ex = __expf(v1 - v0), p0 = 1.0f / (1.0f + ex), p1 = ex / (1.0f + ex);
            unsigned* cnt = (unsigned*)(F.ws + WS_CTL) + CW_MOECNT;
            const int q0 = (int)atomicAdd(cnt + 64 * e0, 1u), q1 = (int)atomicAdd(cnt + 64 * e1, 1u);
            int* R = (int*)(F.ws + WS_ROUTE) + (size_t)row * 4; R[0] = e0; R[1] = e1; ((float*)R)[2] = p0; ((float*)R)[3] = p1;
            int* P = (int*)(F.ws + WS_POS) + (size_t)row * 2; P[0] = q0; P[1] = q1;
        }
    }
    if (MODE != 0) __syncthreads();
}

typedef float f32x16 __attribute__((ext_vector_type(16)));
typedef short s16x4 __attribute__((ext_vector_type(4)));
typedef short bf16x8_t __attribute__((ext_vector_type(8)));
__device__ __forceinline__ unsigned cvtpk(float lo, float hi) { typedef float f2_t __attribute__((ext_vector_type(2))); typedef __bf16 b2_t __attribute__((ext_vector_type(2)));
    f2_t v = {lo, hi}; b2_t b = __builtin_convertvector(v, b2_t); return __builtin_bit_cast(unsigned, b); }
__device__ __forceinline__ void ph_rope(const Args& a, Frame& F) {
    bf16_t* P = (bf16_t*)(F.ws + WS_PROJ); const float* CS = (const float*)(F.ws + WS_CS);
    for (int it = F.bid * NTHREADS + F.tid; it < T * 10; it += F.nb * NTHREADS) {
        const int t = it / 10, hh = it % 10;
        bf16_t* p = P + (size_t)t * NP + hh * 64;
        const u32x4 x1 = *(const u32x4*)p, x2 = *(const u32x4*)(p + 8);
        const f32x4 c0 = *(const f32x4*)(CS + (size_t)t * 16), c1 = *(const f32x4*)(CS + (size_t)t * 16 + 4), s0 = *(const f32x4*)(CS + (size_t)t * 16 + 8), s1 = *(const f32x4*)(CS + (size_t)t * 16 + 12);
        const float cs[8] = {c0.x, c0.y, c0.z, c0.w, c1.x, c1.y, c1.z, c1.w}, sn[8] = {s0.x, s0.y, s0.z, s0.w, s1.x, s1.y, s1.z, s1.w};
        const unsigned xa[4] = {x1.x, x1.y, x1.z, x1.w}, xb[4] = {x2.x, x2.y, x2.z, x2.w};
        unsigned ra[4], rb[4];
#pragma unroll
        for (int i = 0; i < 4; ++i) {
            const float a0 = bf2f(xa[i] & 0xffffu), a1 = bf2f(xa[i] >> 16), b0 = bf2f(xb[i] & 0xffffu), b1 = bf2f(xb[i] >> 16);
            ra[i] = pk2(a0 * cs[2 * i] - b0 * sn[2 * i], a1 * cs[2 * i + 1] - b1 * sn[2 * i + 1]);
            rb[i] = pk2(b0 * cs[2 * i] + a0 * sn[2 * i], b1 * cs[2 * i + 1] + a1 * sn[2 * i + 1]);
        }
        *(u32x4*)p = (u32x4){ra[0], ra[1], ra[2], ra[3]}; *(u32x4*)(p + 8) = (u32x4){rb[0], rb[1], rb[2], rb[3]};
    }
}
constexpr int AT_KROW = 144, AT_VOFF = 256 * AT_KROW;
__device__ __forceinline__ void ph_attn_mfma(const Args& a, Frame& F, int l) {
    const bf16_t* P = (const bf16_t*)(F.ws + WS_PROJ); bf16_t* Y = (bf16_t*)(F.ws + WS_YMIX);
    LAS unsigned char* Kl = F.lds; LAS unsigned char* Vl = F.lds + AT_VOFF;
    const int lane = F.lane, r = lane & 31, h = lane >> 5, g = F.wave >> 1, qh = F.wave & 1;
    const int i16 = lane & 15, tq_ = i16 >> 2, tp_ = i16 & 3, g16 = (lane >> 4) & 1, sw = (tq_ >> 1) & 1;
    const int vlane = (4 * h + tq_) * 128 + (2 * g16 + (tp_ >> 1)) * 16 + (tp_ & 1) * 8;
    const float C = 0.125f * 1.4426950408889634f;
    const int nsc = NSCAN;
    if (F.bid < nsc) return;
    u32x4 kreg[4], vreg[4];
#define AT_LOAD(uu) { const int hk_ = (uu) & 1, n_ = ((uu) >> 1) & 127, b_ = (uu) >> 8, tk0_ = b_ * SEQ + n_ * 128 - 128; \
        _Pragma("unroll") for (int i = 0; i < 4; ++i) { const int piece = F.tid + NTHREADS * i, key = piece >> 3, c = piece & 7; \
            const bf16_t* rowp = P + (size_t)(tk0_ + ((n_ > 0 || key >= 128) ? key : key + 128)) * NP; \
            kreg[i] = *(const u32x4*)(rowp + C_AK + hk_ * 64 + c * 8); vreg[i] = *(const u32x4*)(rowp + C_AV + hk_ * 64 + c * 8); } }
    const int V = F.nb - nsc, nheavy = (T / 128 > V && T / 128 < 2 * V) ? T / 128 - V : 0, va = F.bid - nsc - nheavy, Va = V - nheavy;
    if (va < 0) return;
    if (va < BATCH * 128 * 2) AT_LOAD(va)
    for (int u = va; u < BATCH * 128 * 2; u += Va) {
        const int hk = u & 1, n = (u >> 1) & 127, b = u >> 8;
        const int tq0 = b * SEQ + n * 128;
        __syncthreads();
#pragma unroll
        for (int i = 0; i < 4; ++i) {
            const int piece = F.tid + NTHREADS * i, key = piece >> 3, c = piece & 7;
            const bool ok = (n > 0 || key >= 128);
            const u32x4 z4 = (u32x4){0u, 0u, 0u, 0u};
            *(LAS u32x4*)(Kl + key * AT_KROW + c * 16) = ok ? kreg[i] : z4;
            *(LAS u32x4*)(Vl + key * 128 + ((c ^ (((key >> 1) & 1) << 2)) * 16)) = ok ? vreg[i] : z4;
        }
        __syncthreads();
        if (u + Va < BATCH * 128 * 2) AT_LOAD(u + Va)
        asm volatile("" ::: "memory");
        const int hq = hk * 4 + g;
        const float sinkl = a.sinks[l * 8 + hq] * 1.4426950408889634f;
#pragma unroll 1
        for (int sb = 0; sb < 2; ++sb) {
            const int q0 = qh * 64 + sb * 32, kt0 = qh * 2 + sb;
            const size_t tq = (size_t)(tq0 + q0 + r);
            bf16x8_t qf[4];
#pragma unroll
            for (int ks = 0; ks < 4; ++ks) qf[ks] = *(const bf16x8_t*)(P + tq * NP + hq * 64 + 16 * ks + 8 * h);
            f32x16 S[5];
#pragma unroll
            for (int kr = 0; kr < 5; ++kr) {
                f32x16 acc;
#pragma unroll
                for (int i = 0; i < 16; ++i) acc[i] = 0.f;
#pragma unroll
                for (int ks = 0; ks < 4; ++ks) { const bf16x8_t kf = *(const LAS bf16x8_t*)(Kl + (32 * (kt0 + kr) + r) * AT_KROW + (16 * ks + 8 * h) * 2);
                    acc = __builtin_amdgcn_mfma_f32_32x32x16_bf16(kf, qf[ks], acc, 0, 0, 0); }
                S[kr] = acc;
            }
            float m = sinkl;
#pragma unroll
            for (int kr = 0; kr < 5; ++kr) {
                const bool tile_ok = !(n == 0 && (kt0 + kr) < 4);
#pragma unroll
                for (int i = 0; i < 16; ++i) {
                    const int kl = (i & 3) + 8 * (i >> 2) + 4 * h;
                    bool ok = tile_ok; if (kr == 0) ok = ok && (kl > r); if (kr == 4) ok = ok && (kl <= r);
                    const float sv = ok ? S[kr][i] * C : -INFINITY; S[kr][i] = sv; m = fmaxf(m, sv);
                }
            }
            m = xor32_max(m);
            float lsum = 0.f;
#pragma unroll
            for (int kr = 0; kr < 5; ++kr)
#pragma unroll
                for (int i = 0; i < 16; ++i) { const float p = __builtin_amdgcn_exp2f(S[kr][i] - m); S[kr][i] = p; lsum += p; }
            lsum = xor32_sum(lsum); lsum += __builtin_amdgcn_exp2f(sinkl - m);
            f32x16 O0, O1;
#pragma unroll
            for (int i = 0; i < 16; ++i) { O0[i] = 0.f; O1[i] = 0.f; }
#pragma unroll
            for (int kr = 0; kr < 5; ++kr) {
#pragma unroll
                for (int s2 = 0; s2 < 2; ++s2) {
                    u32x4 pw; pw.x = cvtpk(S[kr][8 * s2 + 0], S[kr][8 * s2 + 1]); pw.y = cvtpk(S[kr][8 * s2 + 2], S[kr][8 * s2 + 3]); pw.z = cvtpk(S[kr][8 * s2 + 4], S[kr][8 * s2 + 5]); pw.w = cvtpk(S[kr][8 * s2 + 6], S[kr][8 * s2 + 7]);
                    const bf16x8_t pf = __builtin_bit_cast(bf16x8_t, pw);
                    const int kb = (32 * (kt0 + kr) + 16 * s2) * 128 + vlane;
                    const s16x4 lo0 = __builtin_amdgcn_ds_read_tr16_b64_v4i16((LAS s16x4*)(Vl + kb + (0 ^ sw) * 64));
                    const s16x4 hi0 = __builtin_amdgcn_ds_read_tr16_b64_v4i16((LAS s16x4*)(Vl + kb + 8 * 128 + (0 ^ sw) * 64));
                    const s16x4 lo1 = __builtin_amdgcn_ds_read_tr16_b64_v4i16((LAS s16x4*)(Vl + kb + (1 ^ sw) * 64));
                    const s16x4 hi1 = __builtin_amdgcn_ds_read_tr16_b64_v4i16((LAS s16x4*)(Vl + kb + 8 * 128 + (1 ^ sw) * 64));
                    const bf16x8_t va0 = __builtin_shufflevector(lo0, hi0, 0, 1, 2, 3, 4, 5, 6, 7), va1 = __builtin_shufflevector(lo1, hi1, 0, 1, 2, 3, 4, 5, 6, 7);
                    O0 = __builtin_amdgcn_mfma_f32_32x32x16_bf16(va0, pf, O0, 0, 0, 0);
                    O1 = __builtin_amdgcn_mfma_f32_32x32x16_bf16(va1, pf, O1, 0, 0, 0);
                }
            }
            const float inv = __builtin_amdgcn_rcpf(lsum);
            bf16_t* yp = Y + tq * D + hq * 64 + 4 * h;
#pragma unroll
            for (int gq = 0; gq < 4; ++gq) {
                u32x2 o0; o0.x = cvtpk(O0[4 * gq] * inv, O0[4 * gq + 1] * inv); o0.y = cvtpk(O0[4 * gq + 2] * inv, O0[4 * gq + 3] * inv);
                u32x2 o1; o1.x = cvtpk(O1[4 * gq] * inv, O1[4 * gq + 1] * inv); o1.y = cvtpk(O1[4 * gq + 2] * inv, O1[4 * gq + 3] * inv);
                *(u32x2*)(yp + 8 * gq) = o0; *(u32x2*)(yp + 32 + 8 * gq) = o1;
            }
        }
    }
    __syncthreads();
}


#undef AT_LOAD
constexpr size_t WS_DN_MR = 360 * MiB, WS_DN_BNT = 376 * MiB, WS_DN_QP = 392 * MiB, WS_DN_OLT = 408 * MiB, WS_DN_ST = 424 * MiB;
constexpr int DL = 72, LB = 9216;
constexpr int L_KR = 0, L_KT = LB, L_QR = 2 * LB, L_VT = 3 * LB, L_AR = 4 * LB, L_T1 = 5 * LB, L_T2 = 6 * LB, L_UT = 7 * LB, L_UPT = 8 * LB, L_WPT = 9 * LB, L_WT = 0;
constexpr int L_LR = 7 * LB, L_L21 = L_LR + 17408, L_T11T = L_L21 + 4608, L_T22R = L_T11T + 4608, L_YT = L_T22R + 4608, L_GC = 100352, L_BETA = L_GC + 256;
static_assert(L_YT + 4608 == L_GC && L_GC + 512 <= 131072, "DeltaNet LDS map");
template <int KS> __device__ __forceinline__ f32x4 mm16(const LAS unsigned char* lds, int offX, int offY, int tx, int ty, int lane) {
    f32x4 acc = (f32x4){0.f, 0.f, 0.f, 0.f};
    const int l15 = lane & 15, q = lane >> 4;
#pragma unroll
    for (int ks = 0; ks < KS; ++ks) {
        const bf16x8_t xa = *(const LAS bf16x8_t*)(lds + offX + ((16 * tx + l15) * DL + 32 * ks + 8 * q) * 2);
        const bf16x8_t yb = *(const LAS bf16x8_t*)(lds + offY + ((16 * ty + l15) * DL + 32 * ks + 8 * q) * 2);
        acc = __builtin_amdgcn_mfma_f32_16x16x32_bf16(xa, yb, acc, 0, 0, 0);
    }
    return acc;
}
__device__ __forceinline__ u32x2 pack4(f32x4 v) { u32x2 o; o.x = cvtpk(v.x, v.y); o.y = cvtpk(v.z, v.w); return o; }

__device__ __forceinline__ void ph_dn_chunk(const Args& a, Frame& F, int l) {
    const bf16_t* P = (const bf16_t*)(F.ws + WS_PROJ); const float* BG = (const float*)(F.ws + WS_BG);
    bf16_t* MR = (bf16_t*)(F.ws + WS_DN_MR); bf16_t* BNT = (bf16_t*)(F.ws + WS_DN_BNT); bf16_t* QP = (bf16_t*)(F.ws + WS_DN_QP); bf16_t* OLT = (bf16_t*)(F.ws + WS_DN_OLT);
    LAS unsigned char* lds = F.lds;
    LAS float* gcL = (LAS float*)(lds + L_GC); LAS float* betaL = (LAS float*)(lds + L_BETA);
    const float* cw = a.dn_conv_w + (size_t)l * DN_CONV * 768;
    const int lane = F.lane, w = F.wave, l15 = lane & 15, q4 = lane >> 4;
    LAS float* cwL = (LAS float*)(lds + L_GC + 512);
    int cur_h = -1;
    const int ci = F.tid >> 3, c8 = F.tid & 7;
    u32x4 xr[3][4]; float bgb = 0.f, bgg = 0.f;
#define CH_LOAD(vu_) { const int n_ = ((vu_) >> 2) & 255, h_ = (vu_) & 3, b_ = (vu_) >> 10; const int t_ = b_ * SEQ + n_ * 64 + ci; \
        _Pragma("unroll") for (int kd = 0; kd < 3; ++kd) _Pragma("unroll") for (int k = 0; k < DN_CONV; ++k) { \
            const int tt_ = (n_ * 64 + ci - (DN_CONV - 1) + k >= 0) ? t_ - (DN_CONV - 1) + k : t_; xr[kd][k] = *(const u32x4*)(P + (size_t)tt_ * NP + C_DQ + kd * 256 + h_ * 64 + c8 * 8); } \
        if (w == 0) { bgb = BG[(size_t)(b_ * SEQ + n_ * 64 + lane) * 8 + h_]; bgg = BG[(size_t)(b_ * SEQ + n_ * 64 + lane) * 8 + 4 + h_]; } }
    if (F.bid < BATCH * 4 * 256) CH_LOAD(F.bid)
    for (int vu = F.bid; vu < BATCH * 4 * 256; vu += F.nb) {
        const int n = (vu >> 2) & 255, h = vu & 3, b = vu >> 10, unit = (b * 4 + h) * 256 + n;
        const int t0 = b * SEQ + n * 64;
        __syncthreads();
        if (h != cur_h) { cur_h = h;
            for (int idx = F.tid; idx < DN_CONV * 3 * 64; idx += NTHREADS) { const int k = idx / 192, kd = (idx / 64) % 3, cc = idx & 63; cwL[idx] = cw[k * 768 + kd * 256 + h * 64 + cc]; }
            __syncthreads(); }
        {
            const int i = ci, sq = n * 64 + i;
#pragma unroll
            for (int kd = 0; kd < 3; ++kd) {
                float acc[8];
#pragma unroll
                for (int e = 0; e < 8; ++e) acc[e] = 0.f;
#pragma unroll
                for (int k = 0; k < DN_CONV; ++k) {
                    const u32x4 xv = xr[kd][k]; const float vm = (sq - (DN_CONV - 1) + k >= 0) ? 1.f : 0.f;
                    const f32x4 w0 = *(const LAS f32x4*)(cwL + (k * 3 + kd) * 64 + c8 * 8) * vm, w1 = *(const LAS f32x4*)(cwL + (k * 3 + kd) * 64 + c8 * 8 + 4) * vm;
                    acc[0] += w0.x * bf2f(xv.x & 0xffffu); acc[1] += w0.y * bf2f(xv.x >> 16); acc[2] += w0.z * bf2f(xv.y & 0xffffu); acc[3] += w0.w * bf2f(xv.y >> 16);
                    acc[4] += w1.x * bf2f(xv.z & 0xffffu); acc[5] += w1.y * bf2f(xv.z >> 16); acc[6] += w1.z * bf2f(xv.w & 0xffffu); acc[7] += w1.w * bf2f(xv.w >> 16);
                }
                float ss = 0.f;
#pragma unroll
                for (int e = 0; e < 8; ++e) { acc[e] = siluf_(acc[e]); ss += acc[e] * acc[e]; }
                if (kd < 2) {
                    ss = group8_sum(ss);
                    const float rn = rsqrtf(ss + EPS) * (kd == 0 ? 0.125f : 1.0f);
#pragma unroll
                    for (int e = 0; e < 8; ++e) acc[e] *= rn;
                }
                u32x4 pk; pk.x = cvtpk(acc[0], acc[1]); pk.y = cvtpk(acc[2], acc[3]); pk.z = cvtpk(acc[4], acc[5]); pk.w = cvtpk(acc[6], acc[7]);
                if (kd == 0) *(LAS u32x4*)(lds + L_QR + (i * DL + c8 * 8) * 2) = pk;
                if (kd == 1) *(LAS u32x4*)(lds + L_KR + (i * DL + c8 * 8) * 2) = pk;
                if (kd >= 1) {
                    LAS bf16_t* Tt = (LAS bf16_t*)(lds + (kd == 1 ? L_KT : L_VT));
                    const unsigned pw[4] = {pk.x, pk.y, pk.z, pk.w};
#pragma unroll
                    for (int e = 0; e < 8; ++e) Tt[(c8 * 8 + e) * DL + i] = (bf16_t)((pw[e >> 1] >> (16 * (e & 1))) & 0xffffu);
                }
            }
            for (int idx = F.tid; idx < 2 * LB / 16; idx += NTHREADS) *(LAS u32x4*)(lds + L_T1 + idx * 16) = (u32x4){0u, 0u, 0u, 0u};
            if (w == 0) {
                float x = bgg;
#pragma unroll
                for (int o = 1; o < 64; o <<= 1) { const float y = __shfl_up(x, o); if (lane >= o) x += y; }
                gcL[lane] = x; betaL[lane] = bgb;
            }
            if (vu + F.nb < BATCH * 4 * 256) CH_LOAD(vu + F.nb)
            asm volatile("" ::: "memory");
        }
        __syncthreads();
        REP(134217728)
#pragma unroll
        for (int tt = 0; tt < 2; ++tt) {
            const int tidx = 2 * w + tt, tx = tidx >> 2, ty = tidx & 3, i = 16 * ty + l15, j0 = 16 * tx + 4 * q4;
            const float gi = gcL[i], bi = betaL[i]; const f32x4 gj = *(const LAS f32x4*)(gcL + j0);
            const float gjv[4] = {gj.x, gj.y, gj.z, gj.w};
            const f32x4 zk = mm16<2>(lds, L_KR, L_KR, tx, ty, lane);
            const f32x4 zq = mm16<2>(lds, L_KR, L_QR, tx, ty, lane);
            f32x4 lv, av;
#pragma unroll
            for (int r = 0; r < 4; ++r) { const float dc = __expf(fminf(gi - gjv[r], 0.f)); lv[r] = (j0 + r < i) ? bi * zk[r] * dc : 0.f; av[r] = (j0 + r <= i) ? zq[r] * dc : 0.f; }
            *(LAS f32x4*)(lds + L_LR + (i * 68 + j0) * 4) = lv;
            if (i >= 32 && j0 < 32) *(LAS u32x2*)(lds + L_L21 + ((i - 32) * DL + j0) * 2) = pack4(lv);
            *(LAS u32x2*)(lds + L_AR + (i * DL + j0) * 2) = pack4(av);
        }
        __syncthreads();
        REP(32768) {
            const int cg = 8 * w + (lane >> 3), blk = cg >> 5, jp = cg & 31, l8 = lane & 7;
            const LAS float* Lb = (const LAS float*)(lds + L_LR) + (32 * blk) * 68 + 32 * blk + 4 * l8;
            float x0 = 0.f, x1 = 0.f, x2 = 0.f, x3 = 0.f;
#pragma unroll
            for (int i = 0; i < 32; ++i) {
                const f32x4 l4 = *(const LAS f32x4*)(Lb + i * 68);
                float part = (l4.x * x0 + l4.y * x1) + (l4.z * x2 + l4.w * x3);
                part = group8_sum(part);
                const float xi = ((i == jp) ? 1.f : 0.f) - part;
                if (l8 == (i >> 2)) { if ((i & 3) == 0) x0 = xi; else if ((i & 3) == 1) x1 = xi; else if ((i & 3) == 2) x2 = xi; else x3 = xi; }
            }
            const int jg = 32 * blk + jp; const float bj = betaL[jg], bej = bj * __expf(gcL[jg]);
            LAS bf16_t* T1 = (LAS bf16_t*)(lds + L_T1); LAS bf16_t* T2 = (LAS bf16_t*)(lds + L_T2);
            const float xs[4] = {x0, x1, x2, x3};
#pragma unroll
            for (int e = 0; e < 4; ++e) { const int rg = 32 * blk + 4 * l8 + e; T1[rg * DL + jg] = (bf16_t)f2bf(xs[e] * bj); T2[rg * DL + jg] = (bf16_t)f2bf(xs[e] * bej); }
            if (blk == 0) { *(LAS u32x2*)(lds + L_T11T + (jp * DL + 4 * l8) * 2) = pack4((f32x4){x0, x1, x2, x3}); }
            else { LAS bf16_t* T22 = (LAS bf16_t*)(lds + L_T22R);
#pragma unroll
                for (int e = 0; e < 4; ++e) T22[(4 * l8 + e) * DL + jp] = (bf16_t)f2bf(xs[e]); }
        }
        __syncthreads();
        if (w < 4) {
            const int tx = w >> 1, ty = w & 1;
            const f32x4 z = mm16<1>(lds, L_L21, L_T11T, tx, ty, lane);
            *(LAS u32x2*)(lds + L_YT + ((16 * ty + l15) * DL + 16 * tx + 4 * q4) * 2) = pack4(z);
        }
        __syncthreads();
        if (w < 4) {
            const int tx = w >> 1, ty = w & 1, y = 16 * ty + l15, x0 = 16 * tx + 4 * q4;
            const f32x4 z = mm16<1>(lds, L_T22R, L_YT, tx, ty, lane);
            const float bj = betaL[y], bej = bj * __expf(gcL[y]);
            LAS bf16_t* T1 = (LAS bf16_t*)(lds + L_T1); LAS bf16_t* T2 = (LAS bf16_t*)(lds + L_T2);
#pragma unroll
            for (int r = 0; r < 4; ++r) { T1[(32 + x0 + r) * DL + y] = (bf16_t)f2bf(-z[r] * bj); T2[(32 + x0 + r) * DL + y] = (bf16_t)f2bf(-z[r] * bej); }
        }
        __syncthreads();
        const float gl = gcL[63];
        REP(268435456)
#pragma unroll
        for (int tt = 0; tt < 2; ++tt) {
            const int tidx = 2 * w + tt, tx = tidx >> 2, ty = tidx & 3, y = 16 * ty + l15, x0 = 16 * tx + 4 * q4;
            const f32x4 gx = *(const LAS f32x4*)(gcL + x0);
            f32x4 sc; sc.x = __expf(gl - gx.x); sc.y = __expf(gl - gx.y); sc.z = __expf(gl - gx.z); sc.w = __expf(gl - gx.w);
            const f32x4 zu = mm16<2>(lds, L_T1, L_VT, tx, ty, lane);
            const f32x4 zw = mm16<2>(lds, L_T2, L_KT, tx, ty, lane);
            *(LAS u32x2*)(lds + L_UT + (y * DL + x0) * 2) = pack4(zu); *(LAS u32x2*)(lds + L_UPT + (y * DL + x0) * 2) = pack4(zu * sc);
            *(LAS u32x2*)(lds + L_WT + (y * DL + x0) * 2) = pack4(zw); *(LAS u32x2*)(lds + L_WPT + (y * DL + x0) * 2) = pack4(zw * sc);
        }
        __syncthreads();
        REP(65536) {
            const size_t cho = (size_t)unit * 4096;
            const float egl = __expf(gl);
#pragma unroll
            for (int tt = 0; tt < 2; ++tt) {
                const int tidx = 2 * w + tt, tx = tidx >> 2, ty = tidx & 3, y = 16 * ty + l15, x0 = 16 * tx + 4 * q4;
                f32x4 zm = mm16<2>(lds, L_WPT, L_KT, tx, ty, lane);
#pragma unroll
                for (int r = 0; r < 4; ++r) zm[r] = ((x0 + r) == y ? egl : 0.f) - zm[r];
                *(u32x2*)(MR + cho + (ty * 2 + (tx >> 1)) * 512 + lane * 8 + 4 * (tx & 1)) = pack4(zm);
                const f32x4 zb = mm16<2>(lds, L_KT, L_UPT, tx, ty, lane);
                *(u32x2*)(BNT + cho + (ty * 4 + tx) * 256 + lane * 4) = pack4(zb);
                const f32x4 zq = mm16<2>(lds, L_WT, L_AR, tx, ty, lane);
                const u32x2 qv = *(const LAS u32x2*)(lds + L_QR + (y * DL + x0) * 2); const float eg = __expf(gcL[y]);
                f32x4 qp; qp.x = bf2f(qv.x & 0xffffu) * eg - zq.x; qp.y = bf2f(qv.x >> 16) * eg - zq.y; qp.z = bf2f(qv.y & 0xffffu) * eg - zq.z; qp.w = bf2f(qv.y >> 16) * eg - zq.w;
                *(u32x2*)(QP + cho + y * 64 + x0) = pack4(qp);
                const f32x4 zo = mm16<2>(lds, L_AR, L_UT, tx, ty, lane);
                *(u32x2*)(OLT + cho + y * 64 + x0) = pack4(zo);
            }
        }
    }
    __syncthreads();
}
#undef CH_LOAD
constexpr int SC_SLOT = 10240, SC_DEPTH = 12, SC_AHEAD = 10;
__device__ __forceinline__ void ph_dn_scan(const Args& a, Frame& F) {
    if (F.bid >= NSCAN) return;
    const unsigned char* MRb = (const unsigned char*)(F.ws + WS_DN_MR); const unsigned char* BNb = (const unsigned char*)(F.ws + WS_DN_BNT); bf16_t* ST = (bf16_t*)(F.ws + WS_DN_ST);
    const int lane = F.lane, l15 = lane & 15, q4 = lane >> 4, wq = F.bid >> 3;
    const size_t ch0 = (size_t)(F.bid & 7) * 256;
    LAS unsigned char* lds = F.lds;
    __syncthreads();
    if (F.wave >= 3) {
        const int lw = F.wave - 3;
#define DN_ISSUE(nn) do { const size_t chb_ = (ch0 + (size_t)((nn) < 255 ? (nn) : 255)) * 8192; const int slot_ = ((nn) % SC_DEPTH) * SC_SLOT; \
        _Pragma("unroll") for (int p_ = 0; p_ < 2; ++p_) { const int piece_ = lw * 2 + p_; \
            const unsigned char* src_ = (piece_ < 8 ? MRb + chb_ + piece_ * 1024 : BNb + chb_ + wq * 2048 + (piece_ - 8) * 1024) + lane * 16; \
            __builtin_amdgcn_global_load_lds((const unsigned*)src_, (LAS unsigned*)(lds + slot_ + piece_ * 1024), 16, 0, 2); } } while (0)
        for (int n = 0; n < SC_AHEAD; ++n) DN_ISSUE(n);
        for (int n = 0; n < 256; n += 2) {
            asm volatile("s_waitcnt vmcnt(16)" ::: "memory");
            __builtin_amdgcn_s_barrier();
            DN_ISSUE(n + SC_AHEAD); DN_ISSUE(n + SC_AHEAD + 1);
        }
        asm volatile("s_waitcnt vmcnt(0)" ::: "memory");
#undef DN_ISSUE
    } else if (F.wave == 0) {
        const int dv = 16 * wq + l15;
        f32x4 S[4];
#pragma unroll
        for (int ti = 0; ti < 4; ++ti) S[ti] = (f32x4){0.f, 0.f, 0.f, 0.f};
        for (int n0 = 0; n0 < 256; n0 += 2) {
            __builtin_amdgcn_s_barrier();
            bf16x8_t A[2][4][2]; u32x2 Bc[2][4];
#pragma unroll
            for (int e = 0; e < 2; ++e) { const LAS unsigned char* slot = lds + ((n0 + e) % SC_DEPTH) * SC_SLOT;
#pragma unroll
                for (int ti = 0; ti < 4; ++ti) {
#pragma unroll
                    for (int ks = 0; ks < 2; ++ks) A[e][ti][ks] = *(const LAS bf16x8_t*)(slot + (ti * 2 + ks) * 1024 + lane * 16);
                    Bc[e][ti] = *(const LAS u32x2*)(slot + 8192 + ti * 512 + lane * 8);
                } }
#pragma unroll
            for (int e = 0; e < 2; ++e) {
                const int n = n0 + e;
                u32x2 sp[4];
#pragma unroll
                for (int ti = 0; ti < 4; ++ti) { sp[ti] = pack4(S[ti]); *(u32x2*)(ST + (ch0 + n) * 4096 + dv * 64 + 16 * ti + 4 * q4) = sp[ti]; }
                const bf16x8_t b0 = __builtin_bit_cast(bf16x8_t, (u32x4){sp[0].x, sp[0].y, sp[1].x, sp[1].y});
                const bf16x8_t b1 = __builtin_bit_cast(bf16x8_t, (u32x4){sp[2].x, sp[2].y, sp[3].x, sp[3].y});
#pragma unroll
                for (int ti = 0; ti < 4; ++ti) {
                    f32x4 c; c.x = bf2f(Bc[e][ti].x & 0xffffu); c.y = bf2f(Bc[e][ti].x >> 16); c.z = bf2f(Bc[e][ti].y & 0xffffu); c.w = bf2f(Bc[e][ti].y >> 16);
                    c = __builtin_amdgcn_mfma_f32_16x16x32_bf16(A[e][ti][0], b0, c, 0, 0, 0);
                    c = __builtin_amdgcn_mfma_f32_16x16x32_bf16(A[e][ti][1], b1, c, 0, 0, 0);
                    S[ti] = c;
                }
            }
            asm volatile("s_waitcnt lgkmcnt(0)" ::: "memory");
        }
    } else {
        for (int n = 0; n < 256; n += 2) __builtin_amdgcn_s_barrier();
    }
    __syncthreads();
}
__device__ __forceinline__ void ph_dn_out(const Args& a, Frame& F, int l) {
    const bf16_t* QP = (const bf16_t*)(F.ws + WS_DN_QP); const bf16_t* OLT = (const bf16_t*)(F.ws + WS_DN_OLT); const bf16_t* ST = (const bf16_t*)(F.ws + WS_DN_ST);
    const bf16_t* P = (const bf16_t*)(F.ws + WS_PROJ); bf16_t* Y = (bf16_t*)(F.ws + WS_YMIX);
    const int lane = F.lane, l15 = lane & 15, q4 = lane >> 4, ti = F.wave & 3;
    LAS bf16_t* TL = (LAS bf16_t*)(F.lds + F.wave * 2560);
    const int er = lane >> 2, ec = (lane & 3) * 16;
    f32x4 gnv[4];
#pragma unroll
    for (int j = 0; j < 4; ++j) gnv[j] = *(const f32x4*)(a.dn_norm_g + l * 64 + ec + 4 * j);
    bf16x8_t af[2], bfv[4][2]; u32x2 ov[4];
#define DNO_LOAD(prv) { const int unit_ = 2 * (prv) + (F.wave >> 2); const size_t cho_ = (size_t)unit_ * 4096; \
        _Pragma("unroll") for (int ks = 0; ks < 2; ++ks) af[ks] = *(const bf16x8_t*)(QP + cho_ + (16 * ti + l15) * 64 + 32 * ks + 8 * q4); \
        _Pragma("unroll") for (int tj = 0; tj < 4; ++tj) { ov[tj] = *(const u32x2*)(OLT + cho_ + (16 * tj + l15) * 64 + 16 * ti + 4 * q4); \
            _Pragma("unroll") for (int ks = 0; ks < 2; ++ks) bfv[tj][ks] = *(const bf16x8_t*)(ST + cho_ + (16 * tj + l15) * 64 + 32 * ks + 8 * q4); } }
    if (F.bid < 1024) DNO_LOAD(F.bid)
    for (int pr = F.bid; pr < 1024; pr += F.nb) {
        const int unit = 2 * pr + (F.wave >> 2), n = unit & 255, h = (unit >> 8) & 3, b = unit >> 10;
        f32x4 acc[4];
#pragma unroll
        for (int tj = 0; tj < 4; ++tj) {
            f32x4 c; c.x = bf2f(ov[tj].x & 0xffffu); c.y = bf2f(ov[tj].x >> 16); c.z = bf2f(ov[tj].y & 0xffffu); c.w = bf2f(ov[tj].y >> 16);
#pragma unroll
            for (int ks = 0; ks < 2; ++ks) c = __builtin_amdgcn_mfma_f32_16x16x32_bf16(af[ks], bfv[tj][ks], c, 0, 0, 0);
            acc[tj] = c;
        }
        const size_t trow = (size_t)b * SEQ + n * 64 + 16 * ti + er;
        const u32x4 z0 = *(const u32x4*)(P + trow * NP + C_DZ + h * 64 + ec), z1 = *(const u32x4*)(P + trow * NP + C_DZ + h * 64 + ec + 8);
        if (pr + F.nb < 1024) DNO_LOAD(pr + F.nb)
        f32x4 ss = acc[0] * acc[0] + acc[1] * acc[1] + acc[2] * acc[2] + acc[3] * acc[3];
        ss.x = row16_sum(ss.x); ss.y = row16_sum(ss.y); ss.z = row16_sum(ss.z); ss.w = row16_sum(ss.w);
        const float rs[4] = {rsqrtf(ss.x * (1.f / 64.f) + EPS), rsqrtf(ss.y * (1.f / 64.f) + EPS), rsqrtf(ss.z * (1.f / 64.f) + EPS), rsqrtf(ss.w * (1.f / 64.f) + EPS)};
#pragma unroll
        for (int tj = 0; tj < 4; ++tj)
#pragma unroll
            for (int r = 0; r < 4; ++r) TL[(4 * q4 + r) * 80 + 16 * tj + l15] = (bf16_t)f2bf(acc[tj][r] * rs[r]);
        const u32x4 t0 = *(const LAS u32x4*)(TL + er * 80 + ec), t1 = *(const LAS u32x4*)(TL + er * 80 + ec + 8);
        const unsigned tw[8] = {t0.x, t0.y, t0.z, t0.w, t1.x, t1.y, t1.z, t1.w}, zw[8] = {z0.x, z0.y, z0.z, z0.w, z1.x, z1.y, z1.z, z1.w};
        unsigned yw[8];
#pragma unroll
        for (int j = 0; j < 8; ++j) {
            const float g0 = gnv[j >> 1][(2 * j) & 3], g1 = gnv[j >> 1][(2 * j + 1) & 3];
            yw[j] = cvtpk(bf2f(tw[j] & 0xffffu) * g0 * siluf_(bf2f(zw[j] & 0xffffu)), bf2f(tw[j] >> 16) * g1 * siluf_(bf2f(zw[j] >> 16)));
        }
        bf16_t* yp = Y + trow * D + 512 + h * 64 + ec;
        *(u32x4*)yp = (u32x4){yw[0], yw[1], yw[2], yw[3]}; *(u32x4*)(yp + 8) = (u32x4){yw[4], yw[5], yw[6], yw[7]};
    }
#undef DNO_LOAD
}

__device__ __forceinline__ void ph_conv_fast(const Args& a, Frame& F, int l) {
    const bf16_t* P = (const bf16_t*)(F.ws + WS_PROJ); bf16_t* Y = (bf16_t*)(F.ws + WS_YMIX);
    LAS float* OUTL = (LAS float*)F.lds;
    const int c = F.tid & 255, rsel = F.tid >> 8;
    float wk[CV_K];
#pragma unroll
    for (int k = 0; k < CV_K; ++k) wk[k] = a.cv_dw_w[((size_t)l * CV_K + k) * CV_C + c];
    const float bias = a.cv_dw_b[l * CV_C + c];
    const int nsc = NSCAN;
    if (F.bid < nsc) return;
    for (int pr = F.bid - nsc; pr < T / 128; pr += F.nb - nsc) {
        const int run = 2 * pr + rsel, t0 = run * 64, s0 = t0 % SEQ;
        __syncthreads();
        float win[CV_K];
        const bf16_t* pc = P + (size_t)(t0 - 30) * NP + C_CA + c;
        const bool first = (s0 == 0);
        LAS float* outp = OUTL + (rsel * 64) * 256 + c;
#define CV_U(ti_, dst) { const bool ok_ = !(first && (ti_) < 30); const bf16_t* q_ = ok_ ? pc + (size_t)(ti_) * NP : pc + (size_t)30 * NP; \
            const float ca_ = bf2f(q_[0]), cb_ = bf2f(q_[256]); dst = ok_ ? ca_ * sigmoidf_(cb_) : 0.f; }
#pragma unroll
        for (int p = 0; p < CV_K; ++p) CV_U(p, win[p])
        { float acc = bias;
#pragma unroll
            for (int k = 0; k < CV_K; ++k) acc += wk[k] * win[(30 + 1 + k) % CV_K];
            outp[0] = acc; }
        for (int cb3 = 1; cb3 < 3; ++cb3) {
            float un[CV_K];
#pragma unroll
            for (int p = 0; p < CV_K; ++p) CV_U(cb3 * CV_K + p, un[p])
#pragma unroll
            for (int p = 0; p < CV_K; ++p) {
                win[p] = un[p];
                float acc = bias;
#pragma unroll
                for (int k = 0; k < CV_K; ++k) acc += wk[k] * win[(p + 1 + k) % CV_K];
                outp[(cb3 * CV_K + p - 30) * 256] = acc;
            }
        }
        { float u93; CV_U(93, u93) win[0] = u93; float acc = bias;
#pragma unroll
            for (int k = 0; k < CV_K; ++k) acc += wk[k] * win[(0 + 1 + k) % CV_K];
            outp[63 * 256] = acc; }
#undef CV_U
        __syncthreads();
        const f32x4 g4 = *(const f32x4*)(a.cv_ln_g + l * CV_C + 4 * F.lane), b4 = *(const f32x4*)(a.cv_ln_b + l * CV_C + 4 * F.lane);
        for (int j = 0; j < 16; ++j) {
            const int tl = F.wave * 16 + j;
            const f32x4 v = *(const LAS f32x4*)(OUTL + tl * 256 + 4 * F.lane);
            const float mean = wave_sum((v.x + v.y) + (v.z + v.w)) * (1.0f / CV_C);
            const f32x4 dv = v - mean;
            const float var = wave_sum((dv.x * dv.x + dv.y * dv.y) + (dv.z * dv.z + dv.w * dv.w)) * (1.0f / CV_C);
            const float rstd = rsqrtf(var + EPS);
            const f32x4 y = (dv * rstd) * g4 + b4;
            u32x2 o; o.x = cvtpk(siluf_(y.x), siluf_(y.y)); o.y = cvtpk(siluf_(y.z), siluf_(y.w));
            *(u32x2*)(Y + (size_t)(pr * 128 + tl) * D + 768 + 4 * F.lane) = o;
        }
    }
    __syncthreads();
}

__device__ __forceinline__ void moe_bases(Frame& F, int (&base)[9], int (&cnt)[8]) {
    const unsigned* c = (const unsigned*)(F.ws + WS_CTL) + CW_MOECNT;
    int acc = 0;
#pragma unroll
    for (int e = 0; e < 8; ++e) { cnt[e] = (int)__hip_atomic_load(c + 64 * e, __ATOMIC_RELAXED, __HIP_MEMORY_SCOPE_AGENT); base[e] = acc; acc += (cnt[e] + 255) & ~255; }
    base[8] = acc;
}
__device__ __forceinline__ void moe_range(Frame& F, int e, int& lo, int& hi) {
    const unsigned* c = (const unsigned*)(F.ws + WS_CTL) + CW_MOECNT;
    int acc = 0; lo = 0; hi = 0;
#pragma unroll
    for (int k = 0; k < 8; ++k) { const int n = ((int)__hip_atomic_load(c + 64 * k, __ATOMIC_RELAXED, __HIP_MEMORY_SCOPE_AGENT) + 255) & ~255; if (k == e) { lo = acc; hi = acc + n; } acc += n; }
}
__device__ __forceinline__ void ph_moe_list(const Args& a, Frame& F) {
    int base[9], cnt[8]; moe_bases(F, base, cnt);
    int* RM = (int*)(F.ws + WS_RMAP); const int* R = (const int*)(F.ws + WS_ROUTE); const int* Pq = (const int*)(F.ws + WS_POS);
    for (int t = F.bid * NTHREADS + F.tid; t < T; t += F.nb * NTHREADS) {
        const int e0 = R[t * 4], e1 = R[t * 4 + 1];
        int b0 = 0, b1 = 0;
#pragma unroll
        for (int e = 0; e < 8; ++e) { if (e == e0) b0 = base[e]; if (e == e1) b1 = base[e]; }
        RM[b0 + Pq[t * 2]] = t; RM[b1 + Pq[t * 2 + 1]] = t;
    }
    if (F.bid == 0) {
#pragma unroll
        for (int e = 0; e < 8; ++e) { const int lo = base[e] + cnt[e], hi = base[e + 1]; for (int r = lo + F.tid; r < hi; r += NTHREADS) RM[r] = 0; }
    }
}
__device__ __forceinline__ void ph_final(const Args& a, Frame& F) {
    int base[9], cnt[8]; moe_bases(F, base, cnt);
    const float* MOD = (const float*)(F.ws + WS_MOD);
    const bf16_t* YM = (const bf16_t*)(F.ws + WS_YMOE); const int* R = (const int*)(F.ws + WS_ROUTE); const int* Pq = (const int*)(F.ws + WS_POS); const bf16_t* X16 = (const bf16_t*)(F.ws + WS_X16);
    const int c0 = 8 * F.lane;
    f32x4 fg[4], gt[4]; int cur_b = -1;
#pragma unroll
    for (int j = 0; j < 4; ++j) fg[j] = *(const f32x4*)(a.final_g + 512 * (j >> 1) + c0 + 4 * (j & 1));
    u32x4 rt_n; u32x2 pq_n;
    u32x4 dx[2], dy0[2], dy1[2]; float p0c = 0.f, p1c = 0.f;
#define FIN_ROUTE(row_, rt_, pq_) { rt_ = *(const u32x4*)(R + (size_t)(row_) * 4); pq_ = *(const u32x2*)(Pq + (size_t)(row_) * 2); }
#define FIN_DATA(row_, rt_, pq_) { int b0_ = 0, b1_ = 0; _Pragma("unroll") for (int e = 0; e < 8; ++e) { if (e == (int)rt_.x) b0_ = base[e]; if (e == (int)rt_.y) b1_ = base[e]; } \
        const size_t s0_ = (size_t)(b0_ + (int)pq_.x), s1_ = (size_t)(b1_ + (int)pq_.y); p0c = __uint_as_float(rt_.z); p1c = __uint_as_float(rt_.w); \
        _Pragma("unroll") for (int jj = 0; jj < 2; ++jj) { dx[jj] = __builtin_nontemporal_load((const u32x4*)(X16 + (size_t)(row_) * D + 512 * jj + c0)); dy0[jj] = __builtin_nontemporal_load((const u32x4*)(YM + s0_ * D + 512 * jj + c0)); dy1[jj] = __builtin_nontemporal_load((const u32x4*)(YM + s1_ * D + 512 * jj + c0)); } }
    if (F.gw < T) { u32x4 rt0; u32x2 pq0; FIN_ROUTE(F.gw, rt0, pq0) FIN_DATA(F.gw, rt0, pq0) }
    if (F.gw + F.ngw < T) FIN_ROUTE(F.gw + F.ngw, rt_n, pq_n)
    for (int row = F.gw; row < T; row += F.ngw) {
        const int b = row / SEQ;
        if (b != cur_b) { cur_b = b; const float* gt2 = MOD + ((size_t)(1 * 2 + 1) * 2 + b) * 3072 + 2048;
#pragma unroll
            for (int j = 0; j < 4; ++j) gt[j] = *(const f32x4*)(gt2 + 512 * (j >> 1) + c0 + 4 * (j & 1)); }
        f32x4 v[4]; float ss = 0.f; const float p0 = p0c, p1 = p1c;
#pragma unroll
        for (int jj = 0; jj < 2; ++jj) {
            const unsigned xw[4] = {dx[jj].x, dx[jj].y, dx[jj].z, dx[jj].w}, y0w[4] = {dy0[jj].x, dy0[jj].y, dy0[jj].z, dy0[jj].w}, y1w[4] = {dy1[jj].x, dy1[jj].y, dy1[jj].z, dy1[jj].w};
#pragma unroll
            for (int hf = 0; hf < 2; ++hf) {
                f32x4 f, xo;
                f.x = p0 * bf2f(y0w[2 * hf] & 0xffffu) + p1 * bf2f(y1w[2 * hf] & 0xffffu); f.y = p0 * bf2f(y0w[2 * hf] >> 16) + p1 * bf2f(y1w[2 * hf] >> 16);
                f.z = p0 * bf2f(y0w[2 * hf + 1] & 0xffffu) + p1 * bf2f(y1w[2 * hf + 1] & 0xffffu); f.w = p0 * bf2f(y0w[2 * hf + 1] >> 16) + p1 * bf2f(y1w[2 * hf + 1] >> 16);
                xo.x = bf2f(xw[2 * hf] & 0xffffu); xo.y = bf2f(xw[2 * hf] >> 16); xo.z = bf2f(xw[2 * hf + 1] & 0xffffu); xo.w = bf2f(xw[2 * hf + 1] >> 16);
                const f32x4 vv = xo + gt[2 * jj + hf] * f; v[2 * jj + hf] = vv;
                ss += (vv.x * vv.x + vv.y * vv.y) + (vv.z * vv.z + vv.w * vv.w);
            }
        }
        if (row + F.ngw < T) { FIN_DATA(row + F.ngw, rt_n, pq_n) }
        if (row + 2 * F.ngw < T) FIN_ROUTE(row + 2 * F.ngw, rt_n, pq_n)
        const float rstd = rsqrtf(wave_sum(ss) * (1.0f / D) + EPS);
        float* op = a.out + (size_t)row * D + c0;
#pragma unroll
        for (int j = 0; j < 4; ++j) __builtin_nontemporal_store((v[j] * rstd) * fg[j], (f32x4*)(op + 512 * (j >> 1) + 4 * (j & 1)));
    }
#undef FIN_ROUTE
#undef FIN_DATA
}


namespace pg8 {
typedef short bf16x8 __attribute__((ext_vector_type(8)));
constexpr int BM = 256, BK = 64, HALF = 128, HTB = HALF * BK * 2, STAGE_BYTES = 8 * HTB;
__device__ __forceinline__ int lds_byte(int r, int c) { const int st = (r >> 4) * 2 + (c >> 5), rr = r & 15, cc = c & 31, ob = rr * 64 + cc * 2; return st * 1024 + (ob ^ (((ob >> 9) & 1) << 5)); }
__device__ __forceinline__ void stage_rc(int b, int& R, int& C) { const int st = b / 1024, sb = b % 1024, swz = sb ^ (((sb >> 9) & 1) << 5); R = (st >> 1) * 16 + swz / 64; C = (st & 1) * 32 + (swz % 64) / 2; }
__device__ __forceinline__ int perm32(int rho) { const int n = rho >> 4, i = rho & 15; return 8 * (i >> 2) + 4 * n + (i & 3); }
struct Unit { int pm, pn, ord; };
struct Gemm { const bf16_t* A; const bf16_t* Bt; int K; };
constexpr int NXCD = 8, WGM = 8;
struct StaticOrder {
    int nM, nN, nwg, G, c;
    __device__ void init(int M, int N, int G_, int c_) { nM = M / BM; nN = N / BM; nwg = nM * nN; G = G_; c = c_; }
    __device__ __forceinline__ bool next(int i, Unit& u) const {
        const long L = (long)i * G + c; if (L >= nwg) return false;
        int wgid = (int)L; { const int q = nwg / NXCD, r = nwg % NXCD, xcd = wgid % NXCD, off = wgid / NXCD; wgid = (xcd < r ? xcd * (q + 1) : r * (q + 1) + (xcd - r) * q) + off; }
        const int nig = WGM * nN, gid = wgid / nig, fm = gid * WGM, gsz = (nM - fm) < WGM ? (nM - fm) : WGM;
        u.pm = fm + ((wgid % nig) % gsz); u.pn = (wgid % nig) / gsz; return true;
    }
};
template <int NT> struct MoeOrder {
    int bt[9]; int cnt[8]; int G, c;
    __device__ __forceinline__ bool next(int i, Unit& u) const {
        int q, tn;
        if ((G & 7) == 0) { const int x = c & 7, Ll = i * (G >> 3) + (c >> 3); q = (Ll / NT) * 8 + x; tn = Ll % NT; if (q >= bt[8]) return false; }
        else { const int L = i * G + c; if (L >= bt[8] * NT) return false; q = L / NT; tn = L % NT; }
        int e = 0;
#pragma unroll
        for (int k = 1; k < 8; ++k) e += (q >= bt[k]) ? 1 : 0;
        u.pm = q; u.pn = e * NT + tn; return true;
    }
};
__device__ __forceinline__ unsigned cvt_pk_bf16(float lo, float hi) { unsigned r; asm volatile("v_cvt_pk_bf16_f32 %0, %1, %2" : "=v"(r) : "v"(lo), "v"(hi)); return r; }
__device__ __forceinline__ float fast_silu(float x) { return x * __builtin_amdgcn_rcpf(1.0f + __builtin_amdgcn_exp2f(x * -1.4426950408889634f)); }

struct EpiBf16 {
    static constexpr bool PERM = true, WIDE = false;
    bf16_t* O; int ldc; int nmod;
    __device__ __forceinline__ void operator()(const f32x4 (&acc)[2][2][4][2], const Unit& u, int wr, int wc, int fr, int fq) const {
        const int row0 = u.pm * BM + wr * 64 + fr, col0 = (u.pn % nmod) * BM + wc * 32 + 8 * fq;
#pragma unroll
        for (int ai = 0; ai < 2; ++ai)
#pragma unroll
            for (int m = 0; m < 4; ++m) { bf16_t* rowp = O + (size_t)(row0 + ai * HALF + m * 16) * ldc + col0;
#pragma unroll
                for (int bj = 0; bj < 2; ++bj) { const f32x4 v0 = acc[ai][bj][m][0], v1 = acc[ai][bj][m][1];
                    u32x4 w; w.x = cvt_pk_bf16(v0[0], v0[1]); w.y = cvt_pk_bf16(v0[2], v0[3]); w.z = cvt_pk_bf16(v1[0], v1[1]); w.w = cvt_pk_bf16(v1[2], v1[3]);
                    *(u32x4*)(rowp + bj * HALF) = w; } }
    }
};
struct EpiSwiGLU {
    static constexpr bool PERM = true, WIDE = false;
    bf16_t* O; int ldc; int nmod;
    __device__ __forceinline__ void operator()(const f32x4 (&acc)[2][2][4][2], const Unit& u, int wr, int wc, int fr, int fq) const {
        const int row0 = u.pm * BM + wr * 64 + fr, col0 = (u.pn % nmod) * HALF + wc * 32 + 8 * fq;
#pragma unroll
        for (int ai = 0; ai < 2; ++ai)
#pragma unroll
            for (int m = 0; m < 4; ++m) {
                const f32x4 g0 = acc[ai][0][m][0], g1 = acc[ai][0][m][1], u0 = acc[ai][1][m][0], u1 = acc[ai][1][m][1];
                u32x4 w;
                w.x = cvt_pk_bf16(fast_silu(g0[0]) * u0[0], fast_silu(g0[1]) * u0[1]); w.y = cvt_pk_bf16(fast_silu(g0[2]) * u0[2], fast_silu(g0[3]) * u0[3]);
                w.z = cvt_pk_bf16(fast_silu(g1[0]) * u1[0], fast_silu(g1[1]) * u1[1]); w.w = cvt_pk_bf16(fast_silu(g1[2]) * u1[2], fast_silu(g1[3]) * u1[3]);
                *(u32x4*)(O + (size_t)(row0 + ai * HALF + m * 16) * ldc + col0) = w; }
    }
};
struct EpiResidF32 {
    static constexpr bool PERM = false, WIDE = false;
    const float* xin; float* xout; const float* gate;
    __device__ __forceinline__ void operator()(const f32x4 (&acc)[2][2][4][2], const Unit& u, int wr, int wc, int fr, int fq) const {
        const int row0 = u.pm * BM + wr * 64 + fr, col0 = u.pn * BM + wc * 32 + 4 * fq;
        const float* gp = gate + (size_t)((u.pm * BM) / SEQ) * 3072 + col0;
#pragma unroll
        for (int bj = 0; bj < 2; ++bj)
#pragma unroll
            for (int n = 0; n < 2; ++n) { const f32x4 g4 = *(const f32x4*)(gp + bj * HALF + n * 16);
#pragma unroll
                for (int ai = 0; ai < 2; ++ai)
#pragma unroll
                    for (int m = 0; m < 4; ++m) { const size_t off = (size_t)(row0 + ai * HALF + m * 16) * D + col0 + bj * HALF + n * 16;
                        const f32x4 x4 = *(const f32x4*)(xin + off); *(f32x4*)(xout + off) = x4 + g4 * acc[ai][bj][m][n]; } }
    }
};


__device__ __forceinline__ u32x4 xchg8(u32x4 v) { u32x4 r;
    r.x = (unsigned)__builtin_amdgcn_update_dpp(0, (int)v.x, 0x128, 0xf, 0xf, false); r.y = (unsigned)__builtin_amdgcn_update_dpp(0, (int)v.y, 0x128, 0xf, 0xf, false);
    r.z = (unsigned)__builtin_amdgcn_update_dpp(0, (int)v.z, 0x128, 0xf, 0xf, false); r.w = (unsigned)__builtin_amdgcn_update_dpp(0, (int)v.w, 0x128, 0xf, 0xf, false); return r; }
__device__ __forceinline__ u32x4 pack8(f32x4 v0, f32x4 v1) { u32x4 w; w.x = cvt_pk_bf16(v0[0], v0[1]); w.y = cvt_pk_bf16(v0[2], v0[3]); w.z = cvt_pk_bf16(v1[0], v1[1]); w.w = cvt_pk_bf16(v1[2], v1[3]); return w; }
template <bool NT = true> __device__ __forceinline__ void store_wide(bf16_t* p, int ld, int fr, int fq, u32x4 pk0, u32x4 pk1) {
    const bool lo = fr < 8; const u32x4 rcv = xchg8(lo ? pk1 : pk0);
    bf16_t* q = p + (size_t)(fr & 7) * ld + 8 * fq + (lo ? 0 : 32);
    if constexpr (NT) { __builtin_nontemporal_store(lo ? pk0 : rcv, (u32x4*)q); __builtin_nontemporal_store(lo ? rcv : pk1, (u32x4*)(q + (size_t)8 * ld)); }
    else { *(u32x4*)q = lo ? pk0 : rcv; *(u32x4*)(q + (size_t)8 * ld) = lo ? rcv : pk1; }
}
struct EpiBf16W {
    static constexpr bool PERM = true, WIDE = true;
    bf16_t* O; int ldc; int nmod;
    __device__ __forceinline__ void operator()(const f32x4 (&acc)[2][2][4][2], const Unit& u, int wr, int wc, int fr, int fq) const {
        bf16_t* base = O + (size_t)(u.pm * BM + wr * 64) * ldc + (u.pn % nmod) * BM + wc * 64;
#pragma unroll
        for (int ai = 0; ai < 2; ++ai)
#pragma unroll
            for (int m = 0; m < 4; ++m) store_wide(base + (size_t)(ai * HALF + m * 16) * ldc, ldc, fr, fq, pack8(acc[ai][0][m][0], acc[ai][0][m][1]), pack8(acc[ai][1][m][0], acc[ai][1][m][1]));
    }
};
struct EpiResidNorm {
    static constexpr bool PERM = true, WIDE = true;
    const bf16_t* xin; bf16_t* x16; const float* gate; const float* av; bf16_t* xa; float* ssqp;
    __device__ __forceinline__ void operator()(const f32x4 (&acc)[2][2][4][2], const Unit& u, int wr, int wc, int fr, int fq) const {
        const int rowb = u.pm * BM + wr * 64, colw = u.pn * BM + wc * 64, b = (u.pm * BM) / SEQ;
        const bool lo = fr < 8;
        const size_t lane_off = (size_t)(fr & 7) * D + colw + 8 * fq + (lo ? 0 : 32);
        f32x4 gv[2][2], avv[2][2];
#pragma unroll
        for (int bj = 0; bj < 2; ++bj)
#pragma unroll
            for (int n = 0; n < 2; ++n) { gv[bj][n] = *(const f32x4*)(gate + (size_t)b * 3072 + colw + 32 * bj + 8 * fq + 4 * n); avv[bj][n] = *(const f32x4*)(av + (size_t)b * 1024 + colw + 32 * bj + 8 * fq + 4 * n); }
        u32x4 la[4][2], lb[4][2];
#define ERN_LOAD(k_) { _Pragma("unroll") for (int mm = 0; mm < 2; ++mm) { const bf16_t* q = xin + (size_t)(rowb + ((k_) >> 1) * HALF + (2 * ((k_) & 1) + mm) * 16) * D + lane_off; la[k_][mm] = __builtin_nontemporal_load((const u32x4*)q); lb[k_][mm] = __builtin_nontemporal_load((const u32x4*)(q + (size_t)8 * D)); } }
        ERN_LOAD(0)
#pragma unroll
        for (int k = 0; k < 4; ++k) {
            const int ai = k >> 1;
            if (k == 0) ERN_LOAD(1) else if (k == 1) ERN_LOAD(2) else if (k == 2) ERN_LOAD(3)
            asm volatile("" ::: "memory");
#pragma unroll
            for (int mm = 0; mm < 2; ++mm) {
                const int m = 2 * (k & 1) + mm;
                const u32x4 rcv = xchg8(lo ? lb[k][mm] : la[k][mm]);
                const u32x4 xb0 = lo ? la[k][mm] : rcv, xb1 = lo ? rcv : lb[k][mm];
                f32x4 x00, x01, x10, x11;
                x00.x = __uint_as_float(xb0.x << 16); x00.y = __uint_as_float(xb0.x & 0xffff0000u); x00.z = __uint_as_float(xb0.y << 16); x00.w = __uint_as_float(xb0.y & 0xffff0000u);
                x01.x = __uint_as_float(xb0.z << 16); x01.y = __uint_as_float(xb0.z & 0xffff0000u); x01.z = __uint_as_float(xb0.w << 16); x01.w = __uint_as_float(xb0.w & 0xffff0000u);
                x10.x = __uint_as_float(xb1.x << 16); x10.y = __uint_as_float(xb1.x & 0xffff0000u); x10.z = __uint_as_float(xb1.y << 16); x10.w = __uint_as_float(xb1.y & 0xffff0000u);
                x11.x = __uint_as_float(xb1.z << 16); x11.y = __uint_as_float(xb1.z & 0xffff0000u); x11.z = __uint_as_float(xb1.w << 16); x11.w = __uint_as_float(xb1.w & 0xffff0000u);
                const f32x4 n00 = x00 + gv[0][0] * acc[ai][0][m][0], n01 = x01 + gv[0][1] * acc[ai][0][m][1], n10 = x10 + gv[1][0] * acc[ai][1][m][0], n11 = x11 + gv[1][1] * acc[ai][1][m][1];
                float sv = (((n00.x * n00.x + n00.y * n00.y) + (n00.z * n00.z + n00.w * n00.w)) + ((n01.x * n01.x + n01.y * n01.y) + (n01.z * n01.z + n01.w * n01.w)))
                         + (((n10.x * n10.x + n10.y * n10.y) + (n10.z * n10.z + n10.w * n10.w)) + ((n11.x * n11.x + n11.y * n11.y) + (n11.z * n11.z + n11.w * n11.w)));
                const size_t ro = (size_t)(rowb + ai * HALF + m * 16) * D + colw;
                store_wide<false>(x16 + ro, D, fr, fq, pack8(n00, n01), pack8(n10, n11));
                store_wide<false>(xa + ro, D, fr, fq, pack8(n00 * avv[0][0], n01 * avv[0][1]), pack8(n10 * avv[1][0], n11 * avv[1][1]));
                sv = xor32_sum(xor16_sum(sv));
                if (fq == 0) ssqp[(size_t)(rowb + ai * HALF + m * 16 + fr) * 16 + u.pn * 4 + wc] = sv;
            }
        }
#undef ERN_LOAD
    }
};
struct EpiProjNorm {
    static constexpr bool PERM = true, WIDE = true;
    bf16_t* O; const LAS float* RS; const float* cv; float* BG; const float* a_log; const float* dt_bias;
    __device__ __forceinline__ void operator()(const f32x4 (&acc)[2][2][4][2], const Unit& u, int wr, int wc, int fr, int fq) const {
        const int rl0 = wr * 64 + fr, colw = u.pn * BM + wc * 64, b = (u.pm * BM) / SEQ;
        const float* cp = cv + (size_t)b * NPW + colw + 8 * fq;
        if (u.pn < NP / BM) {
            f32x4 c4[2][2];
#pragma unroll
            for (int bj = 0; bj < 2; ++bj)
#pragma unroll
                for (int n = 0; n < 2; ++n) c4[bj][n] = *(const f32x4*)(cp + 32 * bj + 4 * n);
            bf16_t* base = O + (size_t)(u.pm * BM + wr * 64) * NP + colw;
#pragma unroll
            for (int ai = 0; ai < 2; ++ai)
#pragma unroll
                for (int m = 0; m < 4; ++m) { const float rs = fabsf(RS[u.ord * 256 + rl0 + ai * HALF + m * 16]);
                    store_wide(base + (size_t)(ai * HALF + m * 16) * NP, NP, fr, fq, pack8(acc[ai][0][m][0] * rs + c4[0][0], acc[ai][0][m][1] * rs + c4[0][1]), pack8(acc[ai][1][m][0] * rs + c4[1][0], acc[ai][1][m][1] * rs + c4[1][1])); }
        } else if (wc == 0 && fq == 0) {
            const f32x4 c0 = *(const f32x4*)(cp), c1 = *(const f32x4*)(cp + 4);
            const f32x4 al = *(const f32x4*)a_log, db = *(const f32x4*)dt_bias;
#pragma unroll
            for (int ai = 0; ai < 2; ++ai)
#pragma unroll
                for (int m = 0; m < 4; ++m) { const int rl = rl0 + ai * HALF + m * 16; const float rs = fabsf(RS[u.ord * 256 + rl]);
                    const f32x4 vb = acc[ai][0][m][0] * rs + c0, va = acc[ai][0][m][1] * rs + c1;
                    f32x4 be, gg;
#pragma unroll
                    for (int hh = 0; hh < 4; ++hh) { be[hh] = sigmoidf_(vb[hh]); gg[hh] = -__expf(al[hh]) * softplusf_(va[hh] + db[hh]); }
                    float* bg = BG + (size_t)(u.pm * BM + rl) * 8; *(f32x4*)bg = be; *(f32x4*)(bg + 4) = gg; }
        }
    }
};
struct EpiNull {
    static constexpr bool PERM = true, WIDE = false;
    __device__ __forceinline__ void operator()(const f32x4 (&acc)[2][2][4][2], const Unit& u, int wr, int wc, int fr, int fq) const {
#pragma unroll
        for (int ai = 0; ai < 2; ++ai)
#pragma unroll
            for (int bj = 0; bj < 2; ++bj)
#pragma unroll
                for (int m = 0; m < 4; ++m)
#pragma unroll
                    for (int n = 0; n < 2; ++n) asm volatile("" :: "v"(acc[ai][bj][m][n]));
    }
};
struct EpiSwiGLUNorm {
    static constexpr bool PERM = true, WIDE = false;
    bf16_t* O; int ldc; int nmod; const LAS float* RS; const float* cv; int ncv;
    __device__ __forceinline__ void operator()(const f32x4 (&acc)[2][2][4][2], const Unit& u, int wr, int wc, int fr, int fq) const {
        const int rl0 = wr * 64 + fr, col0 = (u.pn % nmod) * HALF + wc * 32 + 8 * fq;
        const float* cp = cv + (size_t)u.pn * BM + wc * 32 + 8 * fq;
        f32x4 cg[2][2], cu[2][2];
#pragma unroll
        for (int bb = 0; bb < 2; ++bb)
#pragma unroll
            for (int n = 0; n < 2; ++n) { cg[bb][n] = *(const f32x4*)(cp + (size_t)bb * ncv + 4 * n); cu[bb][n] = *(const f32x4*)(cp + (size_t)bb * ncv + HALF + 4 * n); }
#pragma unroll
        for (int ai = 0; ai < 2; ++ai)
#pragma unroll
            for (int m = 0; m < 4; ++m) { const int rl = rl0 + ai * HALF + m * 16; const float rsv = RS[u.ord * 256 + rl], rs = fabsf(rsv); const bool b1 = rsv < 0.f;
                const f32x4 g0 = acc[ai][0][m][0] * rs + (b1 ? cg[1][0] : cg[0][0]), g1 = acc[ai][0][m][1] * rs + (b1 ? cg[1][1] : cg[0][1]);
                const f32x4 u0 = acc[ai][1][m][0] * rs + (b1 ? cu[1][0] : cu[0][0]), u1 = acc[ai][1][m][1] * rs + (b1 ? cu[1][1] : cu[0][1]);
                u32x4 w;
                w.x = cvt_pk_bf16(fast_silu(g0[0]) * u0[0], fast_silu(g0[1]) * u0[1]); w.y = cvt_pk_bf16(fast_silu(g0[2]) * u0[2], fast_silu(g0[3]) * u0[3]);
                w.z = cvt_pk_bf16(fast_silu(g1[0]) * u1[0], fast_silu(g1[1]) * u1[1]); w.w = cvt_pk_bf16(fast_silu(g1[2]) * u1[2], fast_silu(g1[3]) * u1[3]);
                __builtin_nontemporal_store(w, (u32x4*)(O + (size_t)(u.pm * BM + rl) * ldc + col0)); }
    }
};

template <class Epi, class Sched, bool GATHER, bool ALIGN_EPI, bool SP2>
__device__ __forceinline__ void gemm_phase(LAS unsigned char* lds, const LAS int* RI, const Gemm g, const Sched& S, const Epi& E) {
    const int tid = threadIdx.x, wid = __builtin_amdgcn_readfirstlane(tid >> 6), lane = tid & 63, wr = wid >> 2, wc = wid & 3, fr = lane & 15, fq = lane >> 4;
    const int K = g.K, nt = K / BK;
    unsigned voffB[2]; int Ra[2]; unsigned Ca2[2];
#pragma unroll
    for (int i = 0; i < 2; ++i) { int R, C; stage_rc(tid * 16 + i * 8192, R, C); const int Rb = Epi::WIDE ? ((R >> 5) * 64 + perm32(R & 31)) : (Epi::PERM ? ((R & ~31) + perm32(R & 31)) : R);
        Ra[i] = R; Ca2[i] = (unsigned)C * 2u; voffB[i] = (unsigned)(Rb * K + C) * 2u; }
    const size_t kstep = (size_t)(BK * 2);
    const size_t hstep = (size_t)HALF * K * 2;
    const size_t tstep = 2 * hstep;
    const size_t hstepB = Epi::WIDE ? (size_t)32 * K * 2 : hstep;
    const unsigned rowb = (unsigned)K * 2u;
    const unsigned ldsw = (unsigned)wid * 1024u;
    const int aoff = lds_byte(wr * 64 + fr, fq * 8), boff = lds_byte(wc * 32 + fr, fq * 8);
#define PG8_SA(b, h) (((b) * 2 + (h)) * HTB)
#define PG8_SB(b, h) ((4 + (b) * 2 + (h)) * HTB)
#define PG8_STAGE_B(bufoff, gbase) do { _Pragma("unroll") for (int _i = 0; _i < 2; ++_i) \
        __builtin_amdgcn_global_load_lds((const unsigned*)((const char*)(gbase) + voffB[_i]), (LAS unsigned*)(lds + (bufoff) + ldsw + _i * 8192), 16, 0, 0); } while (0)
#define PG8_STAGE_A(bufoff, kb, off) do { _Pragma("unroll") for (int _i = 0; _i < 2; ++_i) \
        __builtin_amdgcn_global_load_lds((const unsigned*)((const char*)g.A + (size_t)(kb) + (off)[_i]), (LAS unsigned*)(lds + (bufoff) + ldsw + _i * 8192), 16, 0, 0); } while (0)
#define PG8_LDA(dst, b, h) do { _Pragma("unroll") for (int m = 0; m < 4; ++m) _Pragma("unroll") for (int k = 0; k < 2; ++k) dst[m][k] = *(const LAS bf16x8*)(lds + PG8_SA(b, h) + aoff + m * 2048 + k * 1024); } while (0)
#define PG8_LDB(dst, b, h) do { _Pragma("unroll") for (int n = 0; n < 2; ++n) _Pragma("unroll") for (int k = 0; k < 2; ++k) dst[n][k] = *(const LAS bf16x8*)(lds + PG8_SB(b, h) + boff + n * 2048 + k * 1024); } while (0)
#define PG8_MMA(ai, bj, At, Bt) do { __builtin_amdgcn_s_setprio(1); _Pragma("unroll") for (int m = 0; m < 4; ++m) _Pragma("unroll") for (int n = 0; n < 2; ++n) _Pragma("unroll") for (int k = 0; k < 2; ++k) \
        acc[ai][bj][m][n] = __builtin_amdgcn_mfma_f32_16x16x32_bf16(Bt[n][k], At[m][k], acc[ai][bj][m][n], 0, 0, 0); __builtin_amdgcn_s_setprio(0); } while (0)
#define PG8_WAIT_V(n) asm volatile("s_waitcnt vmcnt(" #n ")" ::: "memory")
#define PG8_WAIT_L(n) asm volatile("s_waitcnt lgkmcnt(" #n ")" ::: "memory")
#define PG8_BAR __builtin_amdgcn_s_barrier()
#define PG8_SCHED __builtin_amdgcn_sched_barrier(0)
#define PG8_AOFFS(dst, ui_, un_) do { _Pragma("unroll") for (int _h = 0; _h < 2; ++_h) _Pragma("unroll") for (int _i = 0; _i < 2; ++_i) { \
        const unsigned _row = GATHER ? (unsigned)RI[(ui_) * 256 + _h * HALF + Ra[_i]] : (unsigned)((un_).pm * BM + _h * HALF + Ra[_i]); dst[_h][_i] = _row * rowb + Ca2[_i]; } } while (0)
    Unit cur, nxt; int ui = 0;
    if (!S.next(0, cur)) return;
    cur.ord = 0;
    f32x4 acc[2][2][4][2];
#pragma unroll
    for (int a = 0; a < 2; ++a)
#pragma unroll
        for (int b = 0; b < 2; ++b)
#pragma unroll
            for (int m = 0; m < 4; ++m)
#pragma unroll
                for (int n = 0; n < 2; ++n) acc[a][b][m][n] = (f32x4){0.f, 0.f, 0.f, 0.f};
    bf16x8 At[4][2], B0[2][2], B1[2][2];
    unsigned cv[2][2], nv[2][2];
    PG8_AOFFS(cv, 0, cur);
    const char* cB = (const char*)g.Bt + (size_t)cur.pn * tstep;
    if constexpr (SP2) {
        PG8_STAGE_B(PG8_SB(0, 0), cB); PG8_STAGE_B(PG8_SB(0, 1), cB + hstepB); PG8_STAGE_A(PG8_SA(0, 0), 0, cv[0]); PG8_STAGE_A(PG8_SA(0, 1), 0, cv[1]);
        if (wr == 1) PG8_BAR;
        PG8_WAIT_V(2); PG8_BAR;
        PG8_STAGE_B(PG8_SB(1, 0), cB + kstep); PG8_STAGE_A(PG8_SA(1, 0), kstep, cv[0]); PG8_STAGE_B(PG8_SB(1, 1), cB + hstepB + kstep);
        PG8_WAIT_V(6); PG8_BAR;
    } else {
        PG8_STAGE_B(PG8_SB(0, 0), cB); PG8_STAGE_A(PG8_SA(0, 0), 0, cv[0]); PG8_STAGE_B(PG8_SB(0, 1), cB + hstepB); PG8_STAGE_A(PG8_SA(0, 1), 0, cv[1]);
        if (wr == 1) PG8_BAR;
        PG8_WAIT_V(4); PG8_BAR;
        PG8_STAGE_B(PG8_SB(1, 0), cB + kstep); PG8_STAGE_A(PG8_SA(1, 0), kstep, cv[0]); PG8_STAGE_B(PG8_SB(1, 1), cB + hstepB + kstep);
        PG8_WAIT_V(6); PG8_BAR;
    }
    for (;;) {
        const bool has_next = S.next(ui + 1, nxt); nxt.ord = ui + 1;
        const char* nB = has_next ? (const char*)g.Bt + (size_t)nxt.pn * tstep : cB;
        if (has_next) { PG8_AOFFS(nv, ui + 1, nxt); }
        else {
#pragma unroll
            for (int h = 0; h < 2; ++h)
#pragma unroll
                for (int i = 0; i < 2; ++i) nv[h][i] = cv[h][i]; }
        for (int t = 0; t < nt; t += 2) {
            const bool last = (t == nt - 2);
            const size_t kb1 = (size_t)(t + 1) * kstep, kb2 = last ? (size_t)0 : (size_t)(t + 2) * kstep, kb3 = kb2 + kstep;
            const char* b2 = last ? nB : cB + (size_t)(t + 2) * kstep; const char* b3 = b2 + kstep;
            unsigned o2[2][2];
#pragma unroll
            for (int h = 0; h < 2; ++h)
#pragma unroll
                for (int i = 0; i < 2; ++i) o2[h][i] = last ? nv[h][i] : cv[h][i];
            if constexpr (SP2) {
            PG8_LDB(B0, 0, 0); PG8_LDB(B1, 0, 1); PG8_SCHED; PG8_LDA(At, 0, 0); PG8_STAGE_A(PG8_SA(1, 1), kb1, cv[1]);
            PG8_WAIT_V(8); PG8_WAIT_L(0); PG8_BAR; PG8_MMA(0, 0, At, B0); PG8_MMA(0, 1, At, B1); PG8_BAR; PG8_SCHED;
            PG8_LDA(At, 0, 1); PG8_STAGE_B(PG8_SB(0, 0), b2); PG8_STAGE_B(PG8_SB(0, 1), b2 + hstepB); PG8_STAGE_A(PG8_SA(0, 0), kb2, o2[0]);
            PG8_WAIT_V(8); PG8_WAIT_L(0); PG8_BAR; PG8_MMA(1, 0, At, B0); PG8_MMA(1, 1, At, B1); PG8_BAR; PG8_SCHED;
            PG8_LDB(B0, 1, 0); PG8_LDB(B1, 1, 1); PG8_SCHED; PG8_LDA(At, 1, 0); PG8_STAGE_A(PG8_SA(0, 1), kb2, o2[1]);
            PG8_WAIT_V(8); PG8_WAIT_L(0); PG8_BAR; PG8_MMA(0, 0, At, B0); PG8_MMA(0, 1, At, B1); PG8_BAR; PG8_SCHED;
            PG8_LDA(At, 1, 1); PG8_STAGE_B(PG8_SB(1, 0), b3); PG8_STAGE_B(PG8_SB(1, 1), b3 + hstepB); PG8_STAGE_A(PG8_SA(1, 0), kb3, o2[0]);
            PG8_WAIT_V(8); PG8_WAIT_L(0); PG8_BAR; PG8_MMA(1, 0, At, B0); PG8_MMA(1, 1, At, B1); PG8_BAR; PG8_SCHED;
            } else {
            PG8_LDB(B0, 0, 0); PG8_SCHED; PG8_LDA(At, 0, 0); PG8_STAGE_A(PG8_SA(1, 1), kb1, cv[1]);
            PG8_WAIT_L(8); PG8_BAR; PG8_WAIT_L(0); PG8_MMA(0, 0, At, B0); PG8_BAR; PG8_SCHED;
            PG8_LDB(B1, 0, 1); PG8_STAGE_B(PG8_SB(0, 0), b2);
            PG8_BAR; PG8_WAIT_L(0); PG8_MMA(0, 1, At, B1); PG8_BAR;
            PG8_LDA(At, 0, 1); PG8_STAGE_A(PG8_SA(0, 0), kb2, o2[0]);
            PG8_BAR; PG8_WAIT_L(0); PG8_MMA(1, 0, At, B0); PG8_BAR; PG8_SCHED;
            PG8_STAGE_B(PG8_SB(0, 1), b2 + hstepB);
            PG8_WAIT_V(6); PG8_BAR; PG8_MMA(1, 1, At, B1); PG8_BAR;
            PG8_LDB(B0, 1, 0); PG8_SCHED; PG8_LDA(At, 1, 0); PG8_STAGE_A(PG8_SA(0, 1), kb2, o2[1]);
            PG8_WAIT_L(8); PG8_BAR; PG8_WAIT_L(0); PG8_MMA(0, 0, At, B0); PG8_BAR; PG8_SCHED;
            PG8_LDB(B1, 1, 1); PG8_STAGE_B(PG8_SB(1, 0), b3);
            PG8_BAR; PG8_WAIT_L(0); PG8_MMA(0, 1, At, B1); PG8_BAR;
            PG8_LDA(At, 1, 1); PG8_STAGE_A(PG8_SA(1, 0), kb3, o2[0]);
            PG8_BAR; PG8_WAIT_L(0); PG8_MMA(1, 0, At, B0); PG8_BAR; PG8_SCHED;
            PG8_STAGE_B(PG8_SB(1, 1), b3 + hstepB);
            PG8_WAIT_V(6); PG8_BAR; PG8_MMA(1, 1, At, B1); PG8_BAR;
            }
        }
        if constexpr (ALIGN_EPI) { if (wr == 0) PG8_BAR; }
        E(acc, cur, wr, wc, fr, fq);
        if (!has_next) break;
#pragma unroll
        for (int a = 0; a < 2; ++a)
#pragma unroll
            for (int b = 0; b < 2; ++b)
#pragma unroll
                for (int m = 0; m < 4; ++m)
#pragma unroll
                    for (int n = 0; n < 2; ++n) acc[a][b][m][n] = (f32x4){0.f, 0.f, 0.f, 0.f};
        cur = nxt; cB = nB; ++ui;
#pragma unroll
        for (int h = 0; h < 2; ++h)
#pragma unroll
            for (int i = 0; i < 2; ++i) cv[h][i] = nv[h][i];
        if constexpr (ALIGN_EPI) { if (wr == 1) PG8_BAR; }
    }
    PG8_WAIT_V(0);
    if constexpr (!ALIGN_EPI) { if (wr == 0) PG8_BAR; }
    PG8_BAR;
#undef PG8_SA
#undef PG8_SB
#undef PG8_STAGE_A
#undef PG8_STAGE_B
#undef PG8_LDA
#undef PG8_LDB
#undef PG8_MMA
#undef PG8_WAIT_V
#undef PG8_WAIT_L
#undef PG8_BAR
#undef PG8_SCHED
#undef PG8_AOFFS
}
}

__device__ __forceinline__ void transpose_item(const float* W, int pitch, int k0, int n0, bf16_t* WT, int Kd, int drow0, LAS float* scr, int lane) {
#pragma unroll 8
    for (int i = 0; i < 32; ++i) { const int kk = 2 * i + (lane >> 5); scr[kk * 33 + (lane & 31)] = __builtin_nontemporal_load(W + (size_t)(k0 + kk) * pitch + n0 + (lane & 31)); }
    asm volatile("s_waitcnt lgkmcnt(0)" ::: "memory");
    const int c = lane & 7;
#pragma unroll
    for (int j = 0; j < 4; ++j) { const int n = (lane >> 3) + 8 * j; const LAS float* s = scr + (8 * c) * 33 + n;
        u32x4 o; o.x = pk2(s[0 * 33], s[1 * 33]); o.y = pk2(s[2 * 33], s[3 * 33]); o.z = pk2(s[4 * 33], s[5 * 33]); o.w = pk2(s[6 * 33], s[7 * 33]);
        *(u32x4*)(WT + (size_t)(drow0 + n) * Kd + k0 + 8 * c) = o; }
    asm volatile("s_waitcnt lgkmcnt(0)" ::: "memory");
}
constexpr size_t WT_WIN = 0, WT_WOUT = WT_WIN + (size_t)2 * NPW * D, WT_FGU = WT_WOUT + (size_t)2 * D * D, WT_FD = WT_FGU + (size_t)2 * D_FF * D,
                 WT_MGU = WT_FD + (size_t)D * D_FF, WT_MD = WT_MGU + (size_t)NE * 2 * D_FFE * D, WT_END = WT_MD + (size_t)NE * D * D_FFE;
static_assert(WT_END * 2 <= 80 * MiB, "weight copies fit");
__device__ __forceinline__ void ph_pro_weights(const Args& a, Frame& F) {
    LAS float* scr = (LAS float*)(F.lds + F.wave * 16384);
    bf16_t* WT = (bf16_t*)(F.ws + WS_WT);
    constexpr int I_IN0 = 16 * 48, I_IN1 = 16 * 24, I_OUT = 16 * 32, I_FG = 16 * 88, I_FD = 44 * 32, I_M = 16 * 32;
    constexpr int NITEMS = 2 * (I_IN0 + I_IN1 + I_OUT) + 2 * I_FG + I_FD + 24 * I_M;
    for (int it = F.gw; it < NITEMS; it += F.ngw) {
        int r = it; const float* src; int pitch, k0, n0, Kd, drow0; bf16_t* dst;
        if (r < 2 * I_IN0) { const int l = r / I_IN0; r %= I_IN0; src = a.w_in + (size_t)l * D * N_IN; pitch = N_IN; k0 = (r / 48) * 64; n0 = (r % 48) * 32; dst = WT + WT_WIN + (size_t)l * NPW * D; Kd = D; drow0 = n0; }
        else if ((r -= 2 * I_IN0) < 2 * I_IN1) { const int l = r / I_IN1; r %= I_IN1; src = a.w_in + (size_t)l * D * N_IN + 1544; pitch = N_IN; k0 = (r / 24) * 64; n0 = (r % 24) * 32; dst = WT + WT_WIN + (size_t)l * NPW * D; Kd = D; drow0 = 1536 + n0; }
        else if ((r -= 2 * I_IN1) < 2 * I_OUT) { const int l = r / I_OUT; r %= I_OUT; src = a.w_out + (size_t)l * D * D; pitch = D; k0 = (r / 32) * 64; n0 = (r % 32) * 32; dst = WT + WT_WOUT + (size_t)l * D * D; Kd = D; drow0 = n0; }
        else if ((r -= 2 * I_OUT) < 2 * I_FG) { const int up = r / I_FG; r %= I_FG; src = up ? a.ffn_wu : a.ffn_wg; pitch = D_FF; k0 = (r / 88) * 64; n0 = (r % 88) * 32; dst = WT + WT_FGU; Kd = D; drow0 = (n0 / 128) * 256 + up * 128 + (n0 % 128); }
        else if ((r -= 2 * I_FG) < I_FD) { src = a.ffn_wd; pitch = D; k0 = (r / 32) * 64; n0 = (r % 32) * 32; dst = WT + WT_FD; Kd = D_FF; drow0 = n0; }
        else if ((r -= I_FD) < 16 * I_M) { const int e = r / (2 * I_M); r %= 2 * I_M; const int up = r / I_M; r %= I_M; src = (up ? a.moe_wu : a.moe_wg) + (size_t)e * D * D_FFE; pitch = D_FFE; k0 = (r / 32) * 64; n0 = (r % 32) * 32;
            dst = WT + WT_MGU + (size_t)e * 2 * D_FFE * D; Kd = D; drow0 = (n0 / 128) * 256 + up * 128 + (n0 % 128); }
        else { r -= 16 * I_M; const int e = r / I_M; r %= I_M; src = a.moe_wd + (size_t)e * D_FFE * D; pitch = D; k0 = (r / 32) * 64; n0 = (r % 32) * 32; dst = WT + WT_MD + (size_t)e * D * D_FFE; Kd = D_FFE; drow0 = n0; }
        transpose_item(src, pitch, k0, n0, dst, Kd, drow0, scr, F.lane);
    }
    for (int idx = F.bid * NTHREADS + F.tid; idx < 2 * 256 * D; idx += F.nb * NTHREADS) {
        const int l = idx / (256 * D), r = (idx / D) % 256, k = idx % D;
        WT[WT_WIN + (size_t)l * NPW * D + (size_t)(2304 + r) * D + k] = (r < 8) ? (bf16_t)f2bf(a.w_in[(size_t)l * D * N_IN + (size_t)k * N_IN + W_DB + r]) : (bf16_t)0;
    }
}

template <int NT> __device__ __forceinline__ void moe_order_init(Frame& F, pg8::MoeOrder<NT>& S) {
    const unsigned* c = (const unsigned*)(F.ws + WS_CTL) + CW_MOECNT;
    int acc = 0;
#pragma unroll
    for (int e = 0; e < 8; ++e) { S.cnt[e] = (int)__hip_atomic_load(c + 64 * e, __ATOMIC_RELAXED, __HIP_MEMORY_SCOPE_AGENT); S.bt[e] = acc; acc += (S.cnt[e] + 255) >> 8; }
    S.bt[8] = acc; S.G = F.nb; S.c = F.bid;
}
template <int NT> __device__ __forceinline__ int moe_ri_one(Frame& F, const pg8::MoeOrder<NT>& S, const int* RM, int o, int t) {
    pg8::Unit u; if (!S.next(o, u)) return -1;
    const int e = u.pn / NT; int bte = 0, cne = 0;
#pragma unroll
    for (int kk = 0; kk < 8; ++kk) { if (kk == e) { bte = S.bt[kk]; cne = S.cnt[kk]; } }
    const int sl = (u.pm - bte) * 256 + t; return (sl < cne) ? RM[(size_t)e * T + sl] : 0;
}
template <int NT> __device__ __forceinline__ void moe_ri_preload(Frame& F, const pg8::MoeOrder<NT>& S) {
    LAS int* RI = (LAS int*)(F.lds + RI_OFF); const int* RM = (const int*)(F.ws + WS_RMAP);
    const int t = F.tid & 255, par = F.tid >> 8;
    const int v0 = moe_ri_one<NT>(F, S, RM, par, t), v1 = moe_ri_one<NT>(F, S, RM, par + 2, t), v2 = moe_ri_one<NT>(F, S, RM, par + 4, t), v3 = moe_ri_one<NT>(F, S, RM, par + 6, t);
    const int v4 = moe_ri_one<NT>(F, S, RM, par + 8, t), v5 = moe_ri_one<NT>(F, S, RM, par + 10, t), v6 = moe_ri_one<NT>(F, S, RM, par + 12, t), v7 = moe_ri_one<NT>(F, S, RM, par + 14, t);
    if (v0 >= 0) RI[(par) * 256 + t] = v0; if (v1 >= 0) RI[(par + 2) * 256 + t] = v1; if (v2 >= 0) RI[(par + 4) * 256 + t] = v2; if (v3 >= 0) RI[(par + 6) * 256 + t] = v3;
    if (v4 >= 0) RI[(par + 8) * 256 + t] = v4; if (v5 >= 0) RI[(par + 10) * 256 + t] = v5; if (v6 >= 0) RI[(par + 12) * 256 + t] = v6;
    if (v7 >= 0 && par + 14 < 15) RI[(par + 14) * 256 + t] = v7;
    __syncthreads();
}

__device__ __forceinline__ void ph_norm0(const Args& a, Frame& F) {
    const float* MOD = (const float*)(F.ws + WS_MOD);
    bf16_t* XA = (bf16_t*)(F.ws + WS_H); bf16_t* X16 = (bf16_t*)(F.ws + WS_X16); float* SSQ = (float*)(F.ws + WS_SSQ) + (size_t)3 * T * 16;
    f32x4 vn[4], A4[4]; int cur_b = -1;
#define N0_LOAD(row_) { const f32x4* p_ = (const f32x4*)(a.x + (size_t)(row_) * D) + 2 * F.lane; vn[0] = __builtin_nontemporal_load(p_); vn[1] = __builtin_nontemporal_load(p_ + 1); vn[2] = __builtin_nontemporal_load(p_ + 128); vn[3] = __builtin_nontemporal_load(p_ + 129); }
    if (F.gw < T) N0_LOAD(F.gw)
    for (int row = F.gw; row < T; row += F.ngw) {
        const int b = row / SEQ;
        f32x4 v[4]; float ss = 0.f;
#pragma unroll
        for (int j = 0; j < 4; ++j) { v[j] = vn[j]; ss += (v[j].x * v[j].x + v[j].y * v[j].y) + (v[j].z * v[j].z + v[j].w * v[j].w); }
        if (row + F.ngw < T) N0_LOAD(row + F.ngw)
        if (b != cur_b) { cur_b = b;
#pragma unroll
            for (int j = 0; j < 4; ++j) { const int d = 512 * (j >> 1) + 8 * F.lane + 4 * (j & 1); A4[j] = *(const f32x4*)(a.nmg + d) * (*(const f32x4*)(MOD + (size_t)b * 3072 + 1024 + d) + 1.0f); } }
#pragma unroll
        for (int jj = 0; jj < 2; ++jj) {
            const int d = 512 * jj + 8 * F.lane; const f32x4 v0 = v[2 * jj], v1 = v[2 * jj + 1], s0 = v0 * A4[2 * jj], s1 = v1 * A4[2 * jj + 1];
            u32x4 o; o.x = pk2(v0.x, v0.y); o.y = pk2(v0.z, v0.w); o.z = pk2(v1.x, v1.y); o.w = pk2(v1.z, v1.w); *(u32x4*)(X16 + (size_t)row * D + d) = o;
            u32x4 p; p.x = pk2(s0.x, s0.y); p.y = pk2(s0.z, s0.w); p.z = pk2(s1.x, s1.y); p.w = pk2(s1.z, s1.w); *(u32x4*)(XA + (size_t)row * D + d) = p;
        }
        ss = wave_sum(ss);
        if (F.lane < 16) SSQ[(size_t)row * 16 + F.lane] = (F.lane == 0) ? ss : 0.f;
    }
#undef N0_LOAD
}
__device__ __forceinline__ void ph_prep_vectors(const Args& a, Frame& F) {
    const float* MOD = (const float*)(F.ws + WS_MOD); float* AV = (float*)(F.ws + WS_AV);
    for (int idx = F.bid * NTHREADS + F.tid; idx < 3 * BATCH * D; idx += F.nb * NTHREADS) {
        const int inst = idx / (BATCH * D), b = (idx / D) % BATCH, d = idx % D;
        const int lk = (inst == 0) ? 1 : (inst == 1 ? 2 : 3);
        const float gn = (inst == 0) ? a.nfg[d] : (inst == 1 ? a.nmg[D + d] : a.nfg[D + d]);
        AV[idx] = gn * (1.0f + MOD[((size_t)lk * 2 + b) * 3072 + 1024 + d]);
    }
    const bf16_t* WT = (const bf16_t*)(F.ws + WS_WT);
    constexpr int NR = 5632 + NPW + 16384 + NPW;
    LAS float* SH = (LAS float*)F.lds;
    for (int i = F.tid; i < 4 * BATCH * D; i += NTHREADS) { const int which = i / (BATCH * D), b = (i / D) % BATCH, d = i % D; SH[i] = MOD[((size_t)((which + 1) & 3) * 2 + b) * 3072 + d]; }
    __syncthreads();
    for (int g8 = F.gw; g8 < NR / 8; g8 += F.ngw) {
        const int row = g8 * 8 + (F.lane >> 3), part = F.lane & 7;
        int which, r; const bf16_t* wrow; float* out; int ncv;
        if (row < 5632) { which = 0; r = row; wrow = WT + WT_FGU + (size_t)r * D; out = (float*)(F.ws + WS_CVF); ncv = 5632; }
        else if (row < 5632 + NPW) { which = 1; r = row - 5632; wrow = WT + WT_WIN + (size_t)NPW * D + (size_t)r * D; out = (float*)(F.ws + WS_CVI); ncv = NPW; }
        else if (row < 5632 + NPW + 16384) { which = 2; r = row - 5632 - NPW; wrow = WT + WT_MGU + (size_t)r * D; out = (float*)(F.ws + WS_CVM); ncv = 16384; }
        else { which = 3; r = row - 5632 - NPW - 16384; wrow = WT + WT_WIN + (size_t)r * D; out = (float*)(F.ws + WS_CVI0); ncv = NPW; }
        u32x4 wv[16];
#pragma unroll
        for (int j = 0; j < 16; ++j) wv[j] = *(const u32x4*)(wrow + 128 * part + 8 * j);
        const LAS float* s0p = SH + (which * 2 + 0) * 1024 + 128 * part; const LAS float* s1p = s0p + 1024;
        float s0 = 0.f, s1 = 0.f;
#pragma unroll
        for (int j = 0; j < 16; ++j) {
            const f32x4 a0 = *(const LAS f32x4*)(s0p + 8 * j), a1 = *(const LAS f32x4*)(s0p + 8 * j + 4), b0 = *(const LAS f32x4*)(s1p + 8 * j), b1 = *(const LAS f32x4*)(s1p + 8 * j + 4);
            const float x0 = bf2f(wv[j].x & 0xffffu), x1 = bf2f(wv[j].x >> 16), x2 = bf2f(wv[j].y & 0xffffu), x3 = bf2f(wv[j].y >> 16), x4 = bf2f(wv[j].z & 0xffffu), x5 = bf2f(wv[j].z >> 16), x6 = bf2f(wv[j].w & 0xffffu), x7 = bf2f(wv[j].w >> 16);
            s0 += ((x0 * a0.x + x1 * a0.y) + (x2 * a0.z + x3 * a0.w)) + ((x4 * a1.x + x5 * a1.y) + (x6 * a1.z + x7 * a1.w));
            s1 += ((x0 * b0.x + x1 * b0.y) + (x2 * b0.z + x3 * b0.w)) + ((x4 * b1.x + x5 * b1.y) + (x6 * b1.z + x7 * b1.w));
        }
        s0 += __shfl_xor(s0, 1); s0 += __shfl_xor(s0, 2); s0 += __shfl_xor(s0, 4);
        s1 += __shfl_xor(s1, 1); s1 += __shfl_xor(s1, 2); s1 += __shfl_xor(s1, 4);
        if (part == 0) { out[r] = s0; out[ncv + r] = s1; }
    }
    __syncthreads();
    if (F.gw < BATCH * 8) {
        const int b = F.gw >> 3, e = F.gw & 7; float sacc = 0.f;
        for (int d = F.lane; d < D; d += 64) sacc += MOD[((size_t)3 * 2 + b) * 3072 + d] * a.router_w[(size_t)d * NE + e];
        sacc = wave_sum(sacc);
        if (F.lane == 0) ((float*)(F.ws + WS_CR))[b * 8 + e] = sacc;
    }
}
template <class Sched> __device__ __forceinline__ int count_units(const Sched& S) { int n = 0; pg8::Unit u; while (n < 16 && S.next(n, u)) ++n; return n; }
template <class Sched> __device__ __forceinline__ void rstd_preload(Frame& F, const Sched& S, const float* ssqp, const LAS int* RI) {
    LAS float* RS = (LAS float*)(F.lds + RS_OFF);
    const int t = F.tid & 255, par = F.tid >> 8, nu = count_units(S);
#pragma unroll
    for (int k0 = 0; k0 < 8; k0 += 4) {
        f32x4 p0[4], p1[4], p2[4], p3[4]; int r0, r1, r2, r3;
#define RSP_LOAD(k, pk, rk) { const int o = par + 2 * (k0 + k); pg8::Unit u; u.pm = 0; rk = 0; if (o < nu) { S.next(o, u); rk = RI ? RI[o * 256 + t] : u.pm * 256 + t; } \
            const f32x4* q = (const f32x4*)(ssqp + (size_t)rk * 16); pk[0] = q[0]; pk[1] = q[1]; pk[2] = q[2]; pk[3] = q[3]; }
        RSP_LOAD(0, p0, r0) RSP_LOAD(1, p1, r1) RSP_LOAD(2, p2, r2) RSP_LOAD(3, p3, r3)
#undef RSP_LOAD
#define RSP_STORE(k, pk, rk) { const int o = par + 2 * (k0 + k); if (o < nu) { const f32x4 s4 = (pk[0] + pk[1]) + (pk[2] + pk[3]); \
            const float rs = rsqrtf(((s4.x + s4.y) + (s4.z + s4.w)) * (1.0f / D) + EPS); RS[o * 256 + t] = (rk >= SEQ) ? -rs : rs; } }
        RSP_STORE(0, p0, r0) RSP_STORE(1, p1, r1) RSP_STORE(2, p2, r2) RSP_STORE(3, p3, r3)
#undef RSP_STORE
    }
    __syncthreads();
}
__device__ __forceinline__ void ph_router(const Args& a, Frame& F) {
    const bf16_t* XA = (const bf16_t*)(F.ws + WS_H); const float* SSQ = (const float*)(F.ws + WS_SSQ) + (size_t)2 * T * 16; const float* CR = (const float*)(F.ws + WS_CR);
    LAS float* W8T = (LAS float*)F.lds;
    for (int i = F.tid; i < 8192; i += NTHREADS) { const int d = i >> 3, j = i & 7; W8T[j * 1024 + d] = a.router_w[i]; }
    __syncthreads();
    for (int row = F.gw; row < T; row += F.ngw) {
        const int b = row / SEQ;
        float acc[8];
#pragma unroll
        for (int e = 0; e < 8; ++e) acc[e] = 0.f;
#pragma unroll
        for (int jj = 0; jj < 2; ++jj) {
            const int d = 512 * jj + 8 * F.lane;
            const u32x4 xv = *(const u32x4*)(XA + (size_t)row * D + d);
            const float x[8] = {bf2f(xv.x & 0xffffu), bf2f(xv.x >> 16), bf2f(xv.y & 0xffffu), bf2f(xv.y >> 16), bf2f(xv.z & 0xffffu), bf2f(xv.z >> 16), bf2f(xv.w & 0xffffu), bf2f(xv.w >> 16)};
#pragma unroll
            for (int e = 0; e < 8; ++e) { const f32x4 wa = *(const LAS f32x4*)(W8T + e * 1024 + d), wb = *(const LAS f32x4*)(W8T + e * 1024 + d + 4);
                acc[e] += ((x[0] * wa.x + x[1] * wa.y) + (x[2] * wa.z + x[3] * wa.w)) + ((x[4] * wb.x + x[5] * wb.y) + (x[6] * wb.z + x[7] * wb.w)); }
        }
        const float ssq = wave_sum(F.lane < 16 ? SSQ[(size_t)row * 16 + F.lane] : 0.f);
        const float rstd = rsqrtf(ssq * (1.0f / D) + EPS);
#pragma unroll
        for (int e = 0; e < 8; ++e) acc[e] = wave_sum(acc[e]);
        if (F.lane == 0) {
            float v0 = -INFINITY, v1 = -INFINITY; int e0 = 0, e1 = 0;
#pragma unroll
            for (int e = 0; e < 8; ++e) { const float lg = rstd * acc[e] + CR[b * 8 + e] + a.router_b[e]; if (lg > v0) { v1 = v0; e1 = e0; v0 = lg; e0 = e; } else if (lg > v1) { v1 = lg; e1 = e; } }
            const float ex = __expf(v1 - v0), p0 = 1.0f / (1.0f + ex), p1 = ex / (1.0f + ex);
            unsigned* cnt = (unsigned*)(F.ws + WS_CTL) + CW_MOECNT;
            const int q0 = (int)atomicAdd(cnt + 64 * e0, 1u), q1 = (int)atomicAdd(cnt + 64 * e1, 1u);
            int* R = (int*)(F.ws + WS_ROUTE) + (size_t)row * 4; R[0] = e0; R[1] = e1; ((float*)R)[2] = p0; ((float*)R)[3] = p1;
            int* Pq = (int*)(F.ws + WS_POS) + (size_t)row * 2; Pq[0] = q0; Pq[1] = q1;
            int* RM = (int*)(F.ws + WS_RMAP); RM[(size_t)e0 * T + q0] = row; RM[(size_t)e1 * T + q1] = row;
        }
    }
    __syncthreads();
}

__global__ void __launch_bounds__(NTHREADS, 2) fwd(Args a) {
    extern __shared__ __attribute__((aligned(16))) unsigned char lds_raw[];
    Frame F;
    F.lds = (LAS unsigned char*)lds_raw;
    F.tid = threadIdx.x; F.lane = F.tid & 63; F.wave = __builtin_amdgcn_readfirstlane(F.tid >> 6);
    F.bid = blockIdx.x; F.nb = gridDim.x; F.gw = F.bid * NWAVES + F.wave; F.ngw = F.nb * NWAVES; F.ws = (GAS unsigned char*)a.ws;
    volatile LAS unsigned* MISC = (volatile LAS unsigned*)(F.lds + MISC_OFF);
    for (int u = F.tid; u < 32; u += NTHREADS) MISC[u] = 0u;
    __syncthreads();
    unsigned* ctl = (unsigned*)(a.ws + WS_CTL);
    const int lo = a.ph_lo, hi = a.ph_hi;
    const bool multi = (hi - lo) > 1;
    XcdBarrier bar; bar.bar = ctl + CW_BAR; bar.x = 0; bar.st = MISC + 8;
    if (multi) bar = xcd_barrier_post(ctl + CW_BAR, MISC + 8);
#define IN(k) (lo <= (k) && (k) < hi && (frame_refresh(F, a, (LAS unsigned char*)lds_raw), true))
#define SEAM(k) do { if (hi > (k) + 1 && lo <= (k)) { xcd_barrier(bar); if constexpr ((PROBE_MASK & 4194304) != 0) xcd_barrier(bar); } } while (0)
    float* MOD = (float*)(a.ws + WS_MOD);
    bf16_t* H = (bf16_t*)(a.ws + WS_H); bf16_t* PROJ = (bf16_t*)(a.ws + WS_PROJ); bf16_t* YMIX = (bf16_t*)(a.ws + WS_YMIX);
    bf16_t* WT = (bf16_t*)(a.ws + WS_WT);
    bf16_t* ACT = (bf16_t*)(a.ws + WS_ACT); bf16_t* ACTM = (bf16_t*)(a.ws + WS_ACTM); bf16_t* YMOE = (bf16_t*)(a.ws + WS_YMOE);

    if (IN(PH_PRO)) { REP(1) { ph_pro_vectors(a, F); ph_pro_weights(a, F); } SEAM(PH_PRO); }

#define TWICE(bit, stmt) do { stmt; if constexpr ((PROBE_MASK & (bit)) != 0) { stmt; } } while (0)
    float* AV = (float*)(a.ws + WS_AV); float* SSQ = (float*)(a.ws + WS_SSQ); bf16_t* X16 = (bf16_t*)(a.ws + WS_X16);
    const LAS float* RSL = (const LAS float*)(F.lds + RS_OFF);
#define LAYER_BODY(l) {\
        const int pb = PH_LAYER0 + PH_PER_LAYER * l; \
        const float* xin = (l == 0) ? a.x : a.out; \
        const float* mod0 = MOD + (size_t)(l * 2 + 0) * 2 * 3072; const float* mod1 = MOD + (size_t)(l * 2 + 1) * 2 * 3072; \
        if (l == 0) { if (IN(pb + K_NORM1)) { REP(2) ph_norm0(a, F); ph_prep_vectors(a, F); SEAM(pb + K_NORM1); } } \
        if (IN(pb + K_GEMM_IN)) { \
            TWICE(4, ({ pg8::Gemm g{H, WT + WT_WIN + (size_t)l * NPW * D, D}; pg8::StaticOrder S; S.init(T, NPW, F.nb, F.bid); rstd_preload(F, S, SSQ + (size_t)(l == 0 ? 3 : 1) * T * 16, nullptr); \
                pg8::EpiProjNorm E{PROJ, RSL, (const float*)(a.ws + (l == 0 ? WS_CVI0 : WS_CVI)), (float*)(a.ws + WS_BG), a.dn_a_log + 4 * l, a.dn_dt_bias + 4 * l}; \
                pg8::gemm_phase<pg8::EpiProjNorm, pg8::StaticOrder, false, true, true>(F.lds, nullptr, g, S, E); })); \
            SEAM(pb + K_GEMM_IN); \
        } \
        if (IN(pb + K_DN_PREP)) { REP(8) ph_dn_chunk(a, F, l); ph_rope(a, F); SEAM(pb + K_DN_PREP); } \
        if (IN(pb + K_MIX)) { REP(16) ph_dn_scan(a, F); REP(512) ph_attn_mfma(a, F, l); REP(1024) ph_conv_fast(a, F, l); SEAM(pb + K_MIX); } \
        if (IN(pb + K_DN_OUT)) { REP(32) ph_dn_out(a, F, l); SEAM(pb + K_DN_OUT); } \
        if (IN(pb + K_GEMM_OUT)) { \
            TWICE(0, ({ pg8::Gemm g{YMIX, WT + WT_WOUT + (size_t)l * D * D, D}; pg8::StaticOrder S; S.init(T, D, F.nb, F.bid); \
                pg8::EpiResidNorm E{X16, X16, mod0 + 2048, AV + (size_t)(l == 0 ? 0 : 2) * BATCH * D, H, SSQ + (size_t)(l == 0 ? 0 : 2) * T * 16}; \
                pg8::gemm_phase<pg8::EpiResidNorm, pg8::StaticOrder, false, true, true>(F.lds, nullptr, g, S, E); })); \
            if constexpr ((PROBE_MASK & 8388608) != 0 && l == 0) { pg8::Gemm g{YMIX, WT + WT_WOUT + (size_t)l * D * D, D}; pg8::StaticOrder S; S.init(T, D, F.nb, F.bid); pg8::EpiBf16 E{(bf16_t*)(a.ws + WS_DN_MR), D, 1 << 20}; \
                pg8::gemm_phase<pg8::EpiBf16, pg8::StaticOrder, false, true, true>(F.lds, nullptr, g, S, E); } \
            if constexpr ((PROBE_MASK & 16777216) != 0 && l == 0) { pg8::Gemm g{YMIX, WT + WT_WOUT + (size_t)l * D * D, D}; pg8::StaticOrder S; S.init(T, D, F.nb, F.bid); \
                pg8::EpiResidNorm E{X16, (bf16_t*)(a.ws + WS_DN_MR), mod0 + 2048, AV, (bf16_t*)(a.ws + WS_DN_MR), (float*)(a.ws + WS_DN_ST)}; \
                pg8::gemm_phase<pg8::EpiResidNorm, pg8::StaticOrder, false, true, true>(F.lds, nullptr, g, S, E); } \
            if constexpr ((PROBE_MASK & 131072) != 0 && l == 0) { pg8::Gemm g{YMIX, WT + WT_WOUT + (size_t)l * D * D, D}; pg8::StaticOrder S; S.init(T, D, F.nb, F.bid); pg8::EpiNull E{}; \
                pg8::gemm_phase<pg8::EpiNull, pg8::StaticOrder, false, true, true>(F.lds, nullptr, g, S, E); } \
            SEAM(pb + K_GEMM_OUT); \
        } \
        if (l == 0) { \
            if (IN(pb + K_FFN1)) { \
                TWICE(256, ({ pg8::Gemm g{H, WT + WT_FGU, D}; pg8::StaticOrder S; S.init(T, 2 * D_FF, F.nb, F.bid); rstd_preload(F, S, SSQ, nullptr); \
                    pg8::EpiSwiGLUNorm E{ACT, D_FF, 1 << 20, RSL, (const float*)(a.ws + WS_CVF), 5632}; \
                    pg8::gemm_phase<pg8::EpiSwiGLUNorm, pg8::StaticOrder, false, true, true>(F.lds, nullptr, g, S, E); })); \
                SEAM(pb + K_FFN1); \
            } \
            if (IN(pb + K_FFN2)) { \
                { pg8::Gemm g{ACT, WT + WT_FD, D_FF}; pg8::StaticOrder S; S.init(T, D, F.nb, F.bid); \
                    pg8::EpiResidNorm E{X16, X16, mod1 + 2048, AV + (size_t)1 * BATCH * D, H, SSQ + (size_t)1 * T * 16}; \
                    pg8::gemm_phase<pg8::EpiResidNorm, pg8::StaticOrder, false, true, true>(F.lds, nullptr, g, S, E); } \
                SEAM(pb + K_FFN2); \
            } \
        } else { \
            if (IN(pb + K_NORM2)) { ph_router(a, F); SEAM(pb + K_NORM2); } \
            if (IN(pb + K_FFN1)) { \
                TWICE(2048, ({ pg8::MoeOrder<8> S; moe_order_init<8>(F, S); moe_ri_preload<8>(F, S); rstd_preload(F, S, SSQ + (size_t)2 * T * 16, (const LAS int*)(F.lds + RI_OFF)); \
                    pg8::Gemm g{H, WT + WT_MGU, D}; pg8::EpiSwiGLUNorm E{ACTM, D_FFE, 8, RSL, (const float*)(a.ws + WS_CVM), 16384}; \
                    pg8::gemm_phase<pg8::EpiSwiGLUNorm, pg8::MoeOrder<8>, true, true, true>(F.lds, (const LAS int*)(F.lds + RI_OFF), g, S, E); })); \
                SEAM(pb + K_FFN1); \
            } \
            if (IN(pb + K_FFN2)) { \
                TWICE(4096, ({ pg8::MoeOrder<4> S; moe_order_init<4>(F, S); \
                    pg8::Gemm g{ACTM, WT + WT_MD, D_FFE}; pg8::EpiBf16W E{YMOE, D, 4}; \
                    pg8::gemm_phase<pg8::EpiBf16W, pg8::MoeOrder<4>, false, true, true>(F.lds, nullptr, g, S, E); })); \
                SEAM(pb + K_FFN2); \
            } \
        } \
    }
    LAYER_BODY(0)
    LAYER_BODY(1)
#undef LAYER_BODY
    if (IN(PH_FINAL)) { ph_final(a, F); }
#undef IN
#undef SEAM
}

extern "C" void kernel_launch(void* const* d_in, const int* in_sizes, int n_in, void* d_out, int out_size, void* d_ws, size_t ws_size, hipStream_t stream) {
    static int grid = 0;
    if (grid == 0) {
        if (n_in != 27 || out_size != T * D || ws_size < WS_END) { fprintf(stderr, "kernel_launch: unexpected shapes n_in %d out %d ws %zu\n", n_in, out_size, ws_size); grid = -1; return; }
        int dev = 0, cus = 0, per_cu = 0;
        if (hipGetDevice(&dev) != hipSuccess || hipDeviceGetAttribute(&cus, hipDeviceAttributeMultiprocessorCount, dev) != hipSuccess) { grid = -1; return; }
        if (hipFuncSetAttribute((const void*)fwd, hipFuncAttributeMaxDynamicSharedMemorySize, LDS_BYTES) != hipSuccess) { fprintf(stderr, "kernel_launch: hipFuncSetAttribute failed\n"); grid = -1; return; }
        if (hipOccupancyMaxActiveBlocksPerMultiprocessor(&per_cu, (const void*)fwd, NTHREADS, LDS_BYTES) != hipSuccess || per_cu < 1) fprintf(stderr, "kernel_launch: occupancy query says %d\n", per_cu);
        (void)hipGetLastError();
        grid = cus;
    }
    if (grid < 0) return;
    (void)hipMemsetAsync((char*)d_ws + WS_CTL, 0, CTL_ZERO_BYTES, stream);
    Args a{};
    const void** pp = (const void**)&a;
    for (int i = 0; i < 27; ++i) pp[i] = d_in[i];
    a.out = (float*)d_out; a.ws = (unsigned char*)d_ws;
#if MK_ONE_LAUNCH
    a.ph_lo = 0; a.ph_hi = NPH;
    hipLaunchKernelGGL(fwd, dim3(grid), dim3(NTHREADS), LDS_BYTES, stream, a);
#else
    static const int phases[] = {0, 1, 2, 3, 4, 5, 6, 7, 9, 10, 11, 12, 13, 14, 15, 16, 17, 18, 19, 20, 21};
    for (int p : phases) { a.ph_lo = p; a.ph_hi = p + 1; hipLaunchKernelGGL(fwd, dim3(grid), dim3(NTHREADS), LDS_BYTES, stream, a); }
#endif
}
```

```cpp
#include <hip/hip_runtime.h>
#include <cstdio>
#include <cstdint>

#define LAS __attribute__((address_space(3)))
#define GAS __attribute__((address_space(1)))
typedef unsigned short bf16_t;
typedef float f32x4 __attribute__((ext_vector_type(4)));
typedef unsigned u32x2 __attribute__((ext_vector_type(2)));
typedef unsigned u32x4 __attribute__((ext_vector_type(4)));

#ifndef GEMM_MASK
#define GEMM_MASK 63
#endif
#ifndef ATTN_MFMA
#define ATTN_MFMA 1
#endif
#ifndef DN_CHUNKED
#define DN_CHUNKED 1
#endif
#ifndef CONV_FAST
#define CONV_FAST 1
#endif
#ifndef PROBE_MASK
#define PROBE_MASK 0
#endif
#define REP(bit) for (int rep_ = 0; rep_ < ((PROBE_MASK & (bit)) ? 2 : 1); ++rep_)
#ifndef MK_ONE_LAUNCH
#define MK_ONE_LAUNCH 1
#endif

constexpr int BATCH = 2, SEQ = 16384, T = BATCH * SEQ, D = 1024, DEPTH = 2;
constexpr int NPW = 2560;
constexpr int N_IN = 2312, NP = 2304;
constexpr int C_AQ = 0, C_AK = 512, C_AV = 640, C_DQ = 768, C_DK = 1024, C_DV = 1280, C_DZ = 1536, C_CA = 1792, C_CB = 2048;
constexpr int W_DB = 1536;
constexpr int D_FF = 2816, NE = 8, D_FFE = 1024;
constexpr int WINDOW = 128, CV_K = 31, CV_C = 256, DN_CONV = 4;
constexpr float EPS = 1e-6f;
constexpr int NSCAN = BATCH * 4 * 4;
constexpr int MOE_CAP = 67584;

constexpr size_t MiB = 1u << 20;
constexpr size_t WS_CTL = 0, CTL_ZERO_BYTES = 1 * MiB;
constexpr size_t WS_MOD = 1 * MiB;
constexpr size_t WS_CS = 2 * MiB;
constexpr size_t WS_BG = 4 * MiB;
constexpr size_t WS_ROUTE = 5 * MiB;
constexpr size_t WS_POS = 6 * MiB;
constexpr size_t WS_RMAP = 7 * MiB;
constexpr size_t WS_WT = 8 * MiB;
constexpr size_t WS_H = 88 * MiB;
constexpr size_t WS_PROJ = 152 * MiB;
constexpr size_t WS_YMIX = 296 * MiB;
constexpr size_t WS_DNQKV = 360 * MiB;
constexpr size_t WS_ODN = 456 * MiB;
constexpr size_t WS_ACT = 152 * MiB;
constexpr size_t WS_ACTM = 152 * MiB;
constexpr size_t WS_YMOE = 284 * MiB;
constexpr size_t WS_X16 = 440 * MiB;
constexpr size_t WS_SSQ = 504 * MiB;
constexpr size_t WS_AV = WS_MOD + 128 * 1024;
constexpr size_t WS_CVF = WS_MOD + 256 * 1024;
constexpr size_t WS_CVI = WS_CVF + 2 * 5632 * 4;
constexpr size_t WS_CVM = WS_CVI + 2 * 2560 * 4;
constexpr size_t WS_CR = WS_CVM + 2 * 16384 * 4;
constexpr size_t WS_CVI0 = WS_CR + 64;
static_assert(WS_CVI0 + 2 * 2560 * 4 <= WS_CS, "vector area");
constexpr size_t WS_END = 512 * MiB;
constexpr int CW_BAR = 4096;
constexpr int CW_MOECNT = 16384;

constexpr int NWAVES = 8, NTHREADS = 512;
constexpr int LDS_BYTES = 163840;
constexpr int MISC_OFF = 131072 + 320;
constexpr int RI_OFF = 132096;
constexpr int RS_OFF = 147456;

constexpr int PH_PRO = 0, PH_LAYER0 = 1, PH_PER_LAYER = 10, PH_FINAL = 21, NPH = 22;
enum { K_NORM1 = 0, K_GEMM_IN, K_DN_PREP, K_MIX, K_DN_OUT, K_GEMM_OUT, K_NORM2, K_MOE_LIST, K_FFN1, K_FFN2 };

struct Args {
    const float* x; const float* c; const int* pos; const float* ada_w; const float* ada_b; const float* nmg; const float* nfg;
    const float* w_in; const float* sinks; const float* dn_conv_w; const float* dn_a_log; const float* dn_dt_bias; const float* dn_norm_g;
    const float* cv_dw_w; const float* cv_dw_b; const float* cv_ln_g; const float* cv_ln_b; const float* w_out;
    const float* ffn_wg; const float* ffn_wu; const float* ffn_wd; const float* router_w; const float* router_b;
    const float* moe_wg; const float* moe_wu; const float* moe_wd; const float* final_g;
    float* out; unsigned char* ws; int ph_lo, ph_hi;
};

__device__ __forceinline__ float bf2f(unsigned u) { return __uint_as_float(u << 16); }
__device__ __forceinline__ unsigned f2bf(float f) { unsigned u = __float_as_uint(f); return (u + 0x7fffu + ((u >> 16) & 1u)) >> 16; }
__device__ __forceinline__ unsigned pk2(float lo, float hi) { return f2bf(lo) | (f2bf(hi) << 16); }
#define DPP_MOV(v, ctrl) __int_as_float(__builtin_amdgcn_update_dpp(0, __float_as_int(v), (ctrl), 0xf, 0xf, false))
__device__ __forceinline__ float row16_sum(float v) { v += DPP_MOV(v, 0xB1); v += DPP_MOV(v, 0x4E); v += DPP_MOV(v, 0x141); v += DPP_MOV(v, 0x140); return v; }
__device__ __forceinline__ float wave_sum(float v) {
    v = row16_sum(v);
    const int vi = __float_as_int(v);
    return (__int_as_float(__builtin_amdgcn_readlane(vi, 0)) + __int_as_float(__builtin_amdgcn_readlane(vi, 16))) + (__int_as_float(__builtin_amdgcn_readlane(vi, 32)) + __int_as_float(__builtin_amdgcn_readlane(vi, 48)));
}
__device__ __forceinline__ float xor32_sum(float v) { const auto r = __builtin_amdgcn_permlane32_swap(__float_as_uint(v), __float_as_uint(v), false, false); return __uint_as_float(r[0]) + __uint_as_float(r[1]); }
__device__ __forceinline__ float xor32_max(float v) { const auto r = __builtin_amdgcn_permlane32_swap(__float_as_uint(v), __float_as_uint(v), false, false); return fmaxf(__uint_as_float(r[0]), __uint_as_float(r[1])); }
__device__ __forceinline__ float xor16_sum(float v) { const auto r = __builtin_amdgcn_permlane16_swap(__float_as_uint(v), __float_as_uint(v), false, false); return __uint_as_float(r[0]) + __uint_as_float(r[1]); }
__device__ __forceinline__ float group8_sum(float v) { v += DPP_MOV(v, 0xB1); v += DPP_MOV(v, 0x4E); v += DPP_MOV(v, 0x141); return v; }
__device__ __forceinline__ float wave_max(float v) {
#pragma unroll
    for (int o = 1; o < 64; o <<= 1) v = fmaxf(v, __shfl_xor(v, o));
    return v;
}
__device__ __forceinline__ float sigmoidf_(float x) { return __builtin_amdgcn_rcpf(1.0f + __builtin_amdgcn_exp2f(x * -1.4426950408889634f)); }
__device__ __forceinline__ float siluf_(float x) { return x * __builtin_amdgcn_rcpf(1.0f + __builtin_amdgcn_exp2f(x * -1.4426950408889634f)); }
__device__ __forceinline__ float softplusf_(float x) { return fmaxf(x, 0.f) + log1pf(__expf(-fabsf(x))); }

#define XB_TMO      128
#define XB_XCNT(j)  (256  + 64 * (j))
#define XB_XSUB(j)  (1280 + 64 * (j))
#define XB_XGEN(j)  (2304 + 64 * (j))
#define XB_TOP      3328
#define XB_TOPGEN   3392
#define XCD_BAR_WORDS 3456
#define XB_SPIN_CAP (1u << 18)

__device__ __forceinline__ unsigned xb_ld(unsigned* p)              { return __hip_atomic_load(p, __ATOMIC_RELAXED, __HIP_MEMORY_SCOPE_AGENT); }
__device__ __forceinline__ unsigned xb_add(unsigned* p, unsigned v) { return __hip_atomic_fetch_add(p, v, __ATOMIC_RELAXED, __HIP_MEMORY_SCOPE_AGENT); }
__device__ __forceinline__ unsigned xb_xcc_id() { return (unsigned)__builtin_amdgcn_s_getreg((3 << 11) | 20) & 0xFu; }
#define XB_SPIN(cond, bar) do { unsigned _sp = 0; while (cond) { __builtin_amdgcn_s_sleep(1); \
    if ((++_sp & 255u) == 0u) { if (xb_ld(&(bar)[XB_TMO])) break; if (_sp > XB_SPIN_CAP) { atomicAdd(&(bar)[XB_TMO], 1u); break; } } } } while (0)

struct XcdBarrier { unsigned* bar; unsigned x; volatile LAS unsigned* st; };

__device__ __forceinline__ XcdBarrier xcd_barrier_post(unsigned* bar, volatile LAS unsigned* st) {
    XcdBarrier b; b.bar = bar; b.x = xb_xcc_id(); b.st = st;
    if (threadIdx.x == 0) (void)xb_add(&bar[XB_XCNT(b.x)], 1u);
    return b;
}
__device__ __forceinline__ void xcd_barrier_complete(unsigned* bar, unsigned x, unsigned& nloc, unsigned& nx) {
    const unsigned G = gridDim.x * gridDim.y * gridDim.z;
    unsigned sum, cnt, mine, sp = 0u;
    for (;;) {
        sum = 0u; cnt = 0u; mine = 0u;
#pragma unroll
        for (unsigned j = 0; j < 16; ++j) { const unsigned c = xb_ld(&bar[XB_XCNT(j)]); sum += c; cnt += (c > 0u) ? 1u : 0u; mine = (j == x) ? c : mine; }
        if (sum == G) break;
        __builtin_amdgcn_s_sleep(1);
        if ((++sp & 255u) == 0u) { if (xb_ld(&bar[XB_TMO])) break; if (sp > XB_SPIN_CAP) { atomicAdd(&bar[XB_TMO], 1u); break; } }
    }
    nloc = mine > 0u ? mine : 1u; nx = cnt > 0u ? cnt : 1u;
}
__device__ __forceinline__ void xcd_barrier(const XcdBarrier& b) {
    asm volatile("s_waitcnt vmcnt(0)" ::: "memory");
    __syncthreads();
    if (threadIdx.x == 0) {
        unsigned* bar = b.bar;
        __builtin_amdgcn_s_waitcnt(0);
        unsigned nloc = b.st[0], nx = b.st[1];
        if (nloc == 0u) { xcd_barrier_complete(bar, b.x, nloc, nx); b.st[0] = nloc; b.st[1] = nx; }
        const unsigned old = xb_add(&bar[XB_XSUB(b.x)], 1u);
        const unsigned gen = old / nloc;
        if (old + 1u == (gen + 1u) * nloc) {
            __builtin_amdgcn_fence(__ATOMIC_RELEASE, "agent");
            asm volatile("s_waitcnt vmcnt(0)" ::: "memory");
            const unsigned og = xb_add(&bar[XB_TOP], 1u);
            const unsigned tg = og / nx;
            if (og + 1u == (tg + 1u) * nx) xb_add(&bar[XB_TOPGEN], 1u);
            else XB_SPIN(xb_ld(&bar[XB_TOPGEN]) == tg, bar);
            __builtin_amdgcn_fence(__ATOMIC_ACQUIRE, "agent");
            xb_add(&bar[XB_XGEN(b.x)], 1u);
            asm volatile("s_waitcnt vmcnt(0)" ::: "memory");
        } else {
            XB_SPIN(xb_ld(&bar[XB_XGEN(b.x)]) == gen, bar);
            __builtin_amdgcn_fence(__ATOMIC_ACQUIRE, "agent");
            asm volatile("s_waitcnt vmcnt(0)" ::: "memory");
        }
    }
    __syncthreads();
}

struct Frame {
    LAS unsigned char* lds;
    int tid, lane, wave, gw, ngw, bid, nb;
    GAS unsigned char* ws;
};

__device__ __forceinline__ void frame_refresh(Frame& F, const Args& a, LAS unsigned char* lds) {
    int tid = threadIdx.x; asm volatile("" : "+v"(tid));
    int bid = blockIdx.x; asm volatile("" : "+s"(bid));
    unsigned char* ws = a.ws; asm volatile("" : "+s"(ws));
    F.lds = lds; F.tid = tid; F.lane = tid & 63; F.wave = __builtin_amdgcn_readfirstlane(tid >> 6);
    F.bid = bid; F.nb = gridDim.x; F.gw = F.bid * NWAVES + F.wave; F.ngw = F.nb * NWAVES; F.ws = (GAS unsigned char*)ws;
}
__device__ __forceinline__ void ph_pro_vectors(const Args& a, Frame& F) {
    float* MOD = (float*)(F.ws + WS_MOD);
    LAS float* red = (LAS float*)F.lds;
    for (int it = F.bid; it < 4 * 48; it += F.nb) {
        const int lk = it / 48, cg = it % 48, e = cg * 64 + F.lane;
        const float* W = a.ada_w + (size_t)lk * D * 3072 + e;
        float a0 = 0.f, a1 = 0.f;
        const int d0 = F.wave * 128;
#pragma unroll 8
        for (int d = d0; d < d0 + 128; ++d) {
            const float w = __builtin_nontemporal_load(W + (size_t)d * 3072);
            a0 += siluf_(a.c[d]) * w; a1 += siluf_(a.c[D + d]) * w;
        }
        red[(F.wave * 2 + 0) * 64 + F.lane] = a0; red[(F.wave * 2 + 1) * 64 + F.lane] = a1;
        __syncthreads();
        if (F.wave < 2) {
            float s = 0.f;
            for (int w = 0; w < 8; ++w) s += red[(w * 2 + F.wave) * 64 + F.lane];
            MOD[((size_t)lk * 2 + F.wave) * 3072 + e] = s + a.ada_b[lk * 3072 + e];
        }
        __syncthreads();
    }
    float* CS = (float*)(F.ws + WS_CS);
    for (int idx = F.bid * NTHREADS + F.tid; idx < T * 8; idx += F.nb * NTHREADS) {
        const int t = idx >> 3, i = idx & 7;
        const float inv = powf(500000.0f, -(float)(2 * i) / 16.0f);
        const float ang = (float)a.pos[t] * inv;
        CS[t * 16 + i] = cosf(ang); CS[t * 16 + 8 + i] = sinf(ang);
    }
}

template <int MODE>
__device__ __forceinline__ void ph_norm(const Args& a, Frame& F, int l, const float* xin, const float* gain, const float* modk  ,
                                        const float* W8, int pitch) {
    bf16_t* H = (bf16_t*)(F.ws + WS_H);
    LAS float* W8T = (LAS float*)F.lds;
    if (MODE != 0) {
        for (int i = F.tid; i < 8192; i += NTHREADS) { const int d = i >> 3, j = i & 7; W8T[j * 1024 + d] = W8[(size_t)d * pitch + j]; }
        __syncthreads();
    }
    f32x4 vn[4], A4[4], B4[4]; int cur_b = -1;
    if (F.gw < T) {
#pragma unroll
        for (int j = 0; j < 4; ++j) vn[j] = ((const f32x4*)(xin + (size_t)F.gw * D) + F.lane)[64 * j];
    }
    for (int row = F.gw; row < T; row += F.ngw) {
        const int b = row / SEQ;
        f32x4 v[4]; float ss = 0.f;
#pragma unroll
        for (int j = 0; j < 4; ++j) { v[j] = vn[j]; ss += (v[j].x * v[j].x + v[j].y * v[j].y) + (v[j].z * v[j].z + v[j].w * v[j].w); }
        if (row + F.ngw < T) {
#pragma unroll
            for (int j = 0; j < 4; ++j) vn[j] = ((const f32x4*)(xin + (size_t)(row + F.ngw) * D) + F.lane)[64 * j];
        }
        if (b != cur_b) {
            cur_b = b; const float* sh = modk + (size_t)b * 3072; const float* sc = sh + 1024;
#pragma unroll
            for (int j = 0; j < 4; ++j) { const int d = 256 * j + 4 * F.lane; A4[j] = *(const f32x4*)(gain + d) * (*(const f32x4*)(sc + d) + 1.0f); B4[j] = *(const f32x4*)(sh + d); }
        }
        const float rstd = rsqrtf(wave_sum(ss) * (1.0f / D) + EPS);
        float acc[8];
#pragma unroll
        for (int e = 0; e < 8; ++e) acc[e] = 0.f;
#pragma unroll
        for (int j = 0; j < 4; ++j) {
            const int d = 256 * j + 4 * F.lane;
            const f32x4 hv = (v[j] * rstd) * A4[j] + B4[j];
            u32x2 o; o.x = pk2(hv.x, hv.y); o.y = pk2(hv.z, hv.w);
            *(u32x2*)(H + (size_t)row * D + d) = o;
            if (MODE == 1) { u32x2 xo; xo.x = pk2(v[j].x, v[j].y); xo.y = pk2(v[j].z, v[j].w); *(u32x2*)((bf16_t*)(F.ws + WS_X16) + (size_t)row * D + d) = xo; }
            if (MODE != 0) {
#pragma unroll
                for (int e = 0; e < 8; ++e) { const f32x4 w4 = *(const LAS f32x4*)(W8T + e * 1024 + d); acc[e] += (hv.x * w4.x + hv.y * w4.y) + (hv.z * w4.z + hv.w * w4.w); }
            }
        }
        if (MODE != 0) {
#pragma unroll
            for (int e = 0; e < 8; ++e) acc[e] = wave_sum(acc[e]);
        }
        if (MODE == 1 && F.lane == 0) {
            float* BG = (float*)(F.ws + WS_BG) + (size_t)row * 8;
#pragma unroll
            for (int h = 0; h < 4; ++h) {
                BG[h] = sigmoidf_(acc[h]);
                BG[4 + h] = -__expf(a.dn_a_log[l * 4 + h]) * softplusf_(acc[4 + h] + a.dn_dt_bias[l * 4 + h]);
            }
        }
        if (MODE == 2 && F.lane == 0) {
            float v0 = -INFINITY, v1 = -INFINITY; int e0 = 0, e1 = 0;
#pragma unroll
            for (int e = 0; e < 8; ++e) { const float lg = acc[e] + a.router_b[e]; if (lg > v0) { v1 = v0; e1 = e0; v0 = lg; e0 = e; } else if (lg > v1) { v1 = lg; e1 = e; } }
            const float ex = __expf(v1 - v0), p0 = 1.0f / (1.0f + ex), p1 = ex / (1.0f + ex);
            unsigned* cnt = (unsigned*)(F.ws + WS_CTL) + CW_MOECNT;
            const int q0 = (int)atomicAdd(cnt + 64 * e0, 1u), q1 = (int)atomicAdd(cnt + 64 * e1, 1u);
            int* R = (int*)(F.ws + WS_ROUTE) + (size_t)row * 4; R[0] = e0; R[1] = e1; ((float*)R)[2] = p0; ((float*)R)[3] = p1;
            int* P = (int*)(F.ws + WS_POS) + (size_t)row * 2; P[0] = q0; P[1] = q1;
        }
    }
    if (MODE != 0) __syncthreads();
}

typedef float f32x16 __attribute__((ext_vector_type(16)));
typedef short s16x4 __attribute__((ext_vector_type(4)));
typedef short bf16x8_t __attribute__((ext_vector_type(8)));
__device__ __forceinline__ unsigned cvtpk(float lo, float hi) { typedef float f2_t __attribute__((ext_vector_type(2))); typedef __bf16 b2_t __attribute__((ext_vector_type(2)));
    f2_t v = {lo, hi}; b2_t b = __builtin_convertvector(v, b2_t); return __builtin_bit_cast(unsigned, b); }
__device__ __forceinline__ void ph_rope(const Args& a, Frame& F) {
    bf16_t* P = (bf16_t*)(F.ws + WS_PROJ); const float* CS = (const float*)(F.ws + WS_CS);
    for (int it = F.bid * NTHREADS + F.tid; it < T * 10; it += F.nb * NTHREADS) {
        const int t = it / 10, hh = it % 10;
        bf16_t* p = P + (size_t)t * NP + hh * 64;
        const u32x4 x1 = *(const u32x4*)p, x2 = *(const u32x4*)(p + 8);
        const f32x4 c0 = *(const f32x4*)(CS + (size_t)t * 16), c1 = *(const f32x4*)(CS + (size_t)t * 16 + 4), s0 = *(const f32x4*)(CS + (size_t)t * 16 + 8), s1 = *(const f32x4*)(CS + (size_t)t * 16 + 12);
        const float cs[8] = {c0.x, c0.y, c0.z, c0.w, c1.x, c1.y, c1.z, c1.w}, sn[8] = {s0.x, s0.y, s0.z, s0.w, s1.x, s1.y, s1.z, s1.w};
        const unsigned xa[4] = {x1.x, x1.y, x1.z, x1.w}, xb[4] = {x2.x, x2.y, x2.z, x2.w};
        unsigned ra[4], rb[4];
#pragma unroll
        for (int i = 0; i < 4; ++i) {
            const float a0 = bf2f(xa[i] & 0xffffu), a1 = bf2f(xa[i] >> 16), b0 = bf2f(xb[i] & 0xffffu), b1 = bf2f(xb[i] >> 16);
            ra[i] = pk2(a0 * cs[2 * i] - b0 * sn[2 * i], a1 * cs[2 * i + 1] - b1 * sn[2 * i + 1]);
            rb[i] = pk2(b0 * cs[2 * i] + a0 * sn[2 * i], b1 * cs[2 * i + 1] + a1 * sn[2 * i + 1]);
        }
        *(u32x4*)p = (u32x4){ra[0], ra[1], ra[2], ra[3]}; *(u32x4*)(p + 8) = (u32x4){rb[0], rb[1], rb[2], rb[3]};
    }
}
constexpr int AT_KROW = 144, AT_VOFF = 256 * AT_KROW;
__device__ __forceinline__ void ph_attn_mfma(const Args& a, Frame& F, int l) {
    const bf16_t* P = (const bf16_t*)(F.ws + WS_PROJ); bf16_t* Y = (bf16_t*)(F.ws + WS_YMIX);
    LAS unsigned char* Kl = F.lds; LAS unsigned char* Vl = F.lds + AT_VOFF;
    const int lane = F.lane, r = lane & 31, h = lane >> 5, g = F.wave >> 1, qh = F.wave & 1;
    const int i16 = lane & 15, tq_ = i16 >> 2, tp_ = i16 & 3, g16 = (lane >> 4) & 1, sw = (tq_ >> 1) & 1;
    const int vlane = (4 * h + tq_) * 128 + (2 * g16 + (tp_ >> 1)) * 16 + (tp_ & 1) * 8;
    const float C = 0.125f * 1.4426950408889634f;
    const int nsc = NSCAN;
    if (F.bid < nsc) return;
    u32x4 kreg[4], vreg[4];
#define AT_LOAD(uu) { const int hk_ = (uu) & 1, n_ = ((uu) >> 1) & 127, b_ = (uu) >> 8, tk0_ = b_ * SEQ + n_ * 128 - 128; \
        _Pragma("unroll") for (int i = 0; i < 4; ++i) { const int piece = F.tid + NTHREADS * i, key = piece >> 3, c = piece & 7; \
            const bf16_t* rowp = P + (size_t)(tk0_ + ((n_ > 0 || key >= 128) ? key : key + 128)) * NP; \
            kreg[i] = *(const u32x4*)(rowp + C_AK + hk_ * 64 + c * 8); vreg[i] = *(const u32x4*)(rowp + C_AV + hk_ * 64 + c * 8); } }
    const int V = F.nb - nsc, nheavy = (T / 128 > V && T / 128 < 2 * V) ? T / 128 - V : 0, va = F.bid - nsc - nheavy, Va = V - nheavy;
    if (va < 0) return;
    if (va < BATCH * 128 * 2) AT_LOAD(va)
    for (int u = va; u < BATCH * 128 * 2; u += Va) {
        const int hk = u & 1, n = (u >> 1) & 127, b = u >> 8;
        const int tq0 = b * SEQ + n * 128;
        __syncthreads();
#pragma unroll
        for (int i = 0; i < 4; ++i) {
            const int piece = F.tid + NTHREADS * i, key = piece >> 3, c = piece & 7;
            const bool ok = (n > 0 || key >= 128);
            const u32x4 z4 = (u32x4){0u, 0u, 0u, 0u};
            *(LAS u32x4*)(Kl + key * AT_KROW + c * 16) = ok ? kreg[i] : z4;
            *(LAS u32x4*)(Vl + key * 128 + ((c ^ (((key >> 1) & 1) << 2)) * 16)) = ok ? vreg[i] : z4;
        }
        __syncthreads();
        if (u + Va < BATCH * 128 * 2) AT_LOAD(u + Va)
        asm volatile("" ::: "memory");
        const int hq = hk * 4 + g;
        const float sinkl = a.sinks[l * 8 + hq] * 1.4426950408889634f;
#pragma unroll 1
        for (int sb = 0; sb < 2; ++sb) {
            const int q0 = qh * 64 + sb * 32, kt0 = qh * 2 + sb;
            const size_t tq = (size_t)(tq0 + q0 + r);
            bf16x8_t qf[4];
#pragma unroll
            for (int ks = 0; ks < 4; ++ks) qf[ks] = *(const bf16x8_t*)(P + tq * NP + hq * 64 + 16 * ks + 8 * h);
            f32x16 S[5];
#pragma unroll
            for (int kr = 0; kr < 5; ++kr) {
                f32x16 acc;
#pragma unroll
                for (int i = 0; i < 16; ++i) acc[i] = 0.f;
#pragma unroll
                for (int ks = 0; ks < 4; ++ks) { const bf16x8_t kf = *(const LAS bf16x8_t*)(Kl + (32 * (kt0 + kr) + r) * AT_KROW + (16 * ks + 8 * h) * 2);
                    acc = __builtin_amdgcn_mfma_f32_32x32x16_bf16(kf, qf[ks], acc, 0, 0, 0); }
                S[kr] = acc;
            }
            float m = sinkl;
#pragma unroll
            for (int kr = 0; kr < 5; ++kr) {
                const bool tile_ok = !(n == 0 && (kt0 + kr) < 4);
#pragma unroll
                for (int i = 0; i < 16; ++i) {
                    const int kl = (i & 3) + 8 * (i >> 2) + 4 * h;
                    bool ok = tile_ok; if (kr == 0) ok = ok && (kl > r); if (kr == 4) ok = ok && (kl <= r);
                    const float sv = ok ? S[kr][i] * C : -INFINITY; S[kr][i] = sv; m = fmaxf(m, sv);
                }
            }
            m = xor32_max(m);
            float lsum = 0.f;
#pragma unroll
            for (int kr = 0; kr < 5; ++kr)
#pragma unroll
                for (int i = 0; i < 16; ++i) { const float p = __builtin_amdgcn_exp2f(S[kr][i] - m); S[kr][i] = p; lsum += p; }
            lsum = xor32_sum(lsum); lsum += __builtin_amdgcn_exp2f(sinkl - m);
            f32x16 O0, O1;
#pragma unroll
            for (int i = 0; i < 16; ++i) { O0[i] = 0.f; O1[i] = 0.f; }
#pragma unroll
            for (int kr = 0; kr < 5; ++kr) {
#pragma unroll
                for (int s2 = 0; s2 < 2; ++s2) {
                    u32x4 pw; pw.x = cvtpk(S[kr][8 * s2 + 0], S[kr][8 * s2 + 1]); pw.y = cvtpk(S[kr][8 * s2 + 2], S[kr][8 * s2 + 3]); pw.z = cvtpk(S[kr][8 * s2 + 4], S[kr][8 * s2 + 5]); pw.w = cvtpk(S[kr][8 * s2 + 6], S[kr][8 * s2 + 7]);
                    const bf16x8_t pf = __builtin_bit_cast(bf16x8_t, pw);
                    const int kb = (32 * (kt0 + kr) + 16 * s2) * 128 + vlane;
                    const s16x4 lo0 = __builtin_amdgcn_ds_read_tr16_b64_v4i16((LAS s16x4*)(Vl + kb + (0 ^ sw) * 64));
                    const s16x4 hi0 = __builtin_amdgcn_ds_read_tr16_b64_v4i16((LAS s16x4*)(Vl + kb + 8 * 128 + (0 ^ sw) * 64));
                    const s16x4 lo1 = __builtin_amdgcn_ds_read_tr16_b64_v4i16((LAS s16x4*)(Vl + kb + (1 ^ sw) * 64));
                    const s16x4 hi1 = __builtin_amdgcn_ds_read_tr16_b64_v4i16((LAS s16x4*)(Vl + kb + 8 * 128 + (1 ^ sw) * 64));
                    const bf16x8_t va0 = __builtin_shufflevector(lo0, hi0, 0, 1, 2, 3, 4, 5, 6, 7), va1 = __builtin_shufflevector(lo1, hi1, 0, 1, 2, 3, 4, 5, 6, 7);
                    O0 = __builtin_amdgcn_mfma_f32_32x32x16_bf16(va0, pf, O0, 0, 0, 0);
                    O1 = __builtin_amdgcn_mfma_f32_32x32x16_bf16(va1, pf, O1, 0, 0, 0);
                }
            }
            const float inv = __builtin_amdgcn_rcpf(lsum);
            bf16_t* yp = Y + tq * D + hq * 64 + 4 * h;
#pragma unroll
            for (int gq = 0; gq < 4; ++gq) {
                u32x2 o0; o0.x = cvtpk(O0[4 * gq] * inv, O0[4 * gq + 1] * inv); o0.y = cvtpk(O0[4 * gq + 2] * inv, O0[4 * gq + 3] * inv);
                u32x2 o1; o1.x = cvtpk(O1[4 * gq] * inv, O1[4 * gq + 1] * inv); o1.y = cvtpk(O1[4 * gq + 2] * inv, O1[4 * gq + 3] * inv);
                *(u32x2*)(yp + 8 * gq) = o0; *(u32x2*)(yp + 32 + 8 * gq) = o1;
            }
        }
    }
    __syncthreads();
}


#undef AT_LOAD
constexpr size_t WS_DN_MR = 360 * MiB, WS_DN_BNT = 376 * MiB, WS_DN_QP = 392 * MiB, WS_DN_OLT = 408 * MiB, WS_DN_ST = 424 * MiB;
constexpr int DL = 72, LB = 9216;
constexpr int L_KR = 0, L_KT = LB, L_QR = 2 * LB, L_VT = 3 * LB, L_AR = 4 * LB, L_T1 = 5 * LB, L_T2 = 6 * LB, L_UT = 7 * LB, L_UPT = 8 * LB, L_WPT = 9 * LB, L_WT = 0;
constexpr int L_LR = 7 * LB, L_L21 = L_LR + 17408, L_T11T = L_L21 + 4608, L_T22R = L_T11T + 4608, L_YT = L_T22R + 4608, L_GC = 100352, L_BETA = L_GC + 256;
static_assert(L_YT + 4608 == L_GC && L_GC + 512 <= 131072, "DeltaNet LDS map");
template <int KS> __device__ __forceinline__ f32x4 mm16(const LAS unsigned char* lds, int offX, int offY, int tx, int ty, int lane) {
    f32x4 acc = (f32x4){0.f, 0.f, 0.f, 0.f};
    const int l15 = lane & 15, q = lane >> 4;
#pragma unroll
    for (int ks = 0; ks < KS; ++ks) {
        const bf16x8_t xa = *(const LAS bf16x8_t*)(lds + offX + ((16 * tx + l15) * DL + 32 * ks + 8 * q) * 2);
        const bf16x8_t yb = *(const LAS bf16x8_t*)(lds + offY + ((16 * ty + l15) * DL + 32 * ks + 8 * q) * 2);
        acc = __builtin_amdgcn_mfma_f32_16x16x32_bf16(xa, yb, acc, 0, 0, 0);
    }
    return acc;
}
__device__ __forceinline__ u32x2 pack4(f32x4 v) { u32x2 o; o.x = cvtpk(v.x, v.y); o.y = cvtpk(v.z, v.w); return o; }

__device__ __forceinline__ void ph_dn_chunk(const Args& a, Frame& F, int l) {
    const bf16_t* P = (const bf16_t*)(F.ws + WS_PROJ); const float* BG = (const float*)(F.ws + WS_BG);
    bf16_t* MR = (bf16_t*)(F.ws + WS_DN_MR); bf16_t* BNT = (bf16_t*)(F.ws + WS_DN_BNT); bf16_t* QP = (bf16_t*)(F.ws + WS_DN_QP); bf16_t* OLT = (bf16_t*)(F.ws + WS_DN_OLT);
    LAS unsigned char* lds = F.lds;
    LAS float* gcL = (LAS float*)(lds + L_GC); LAS float* betaL = (LAS float*)(lds + L_BETA);
    const float* cw = a.dn_conv_w + (size_t)l * DN_CONV * 768;
    const int lane = F.lane, w = F.wave, l15 = lane & 15, q4 = lane >> 4;
    LAS float* cwL = (LAS float*)(lds + L_GC + 512);
    int cur_h = -1;
    const int ci = F.tid >> 3, c8 = F.tid & 7;
    u32x4 xr[3][4]; float bgb = 0.f, bgg = 0.f;
#define CH_LOAD(vu_) { const int n_ = ((vu_) >> 2) & 255, h_ = (vu_) & 3, b_ = (vu_) >> 10; const int t_ = b_ * SEQ + n_ * 64 + ci; \
        _Pragma("unroll") for (int kd = 0; kd < 3; ++kd) _Pragma("unroll") for (int k = 0; k < DN_CONV; ++k) { \
            const int tt_ = (n_ * 64 + ci - (DN_CONV - 1) + k >= 0) ? t_ - (DN_CONV - 1) + k : t_; xr[kd][k] = *(const u32x4*)(P + (size_t)tt_ * NP + C_DQ + kd * 256 + h_ * 64 + c8 * 8); } \
        if (w == 0) { bgb = BG[(size_t)(b_ * SEQ + n_ * 64 + lane) * 8 + h_]; bgg = BG[(size_t)(b_ * SEQ + n_ * 64 + lane) * 8 + 4 + h_]; } }
    if (F.bid < BATCH * 4 * 256) CH_LOAD(F.bid)
    for (int vu = F.bid; vu < BATCH * 4 * 256; vu += F.nb) {
        const int n = (vu >> 2) & 255, h = vu & 3, b = vu >> 10, unit = (b * 4 + h) * 256 + n;
        const int t0 = b * SEQ + n * 64;
        __syncthreads();
        if (h != cur_h) { cur_h = h;
            for (int idx = F.tid; idx < DN_CONV * 3 * 64; idx += NTHREADS) { const int k = idx / 192, kd = (idx / 64) % 3, cc = idx & 63; cwL[idx] = cw[k * 768 + kd * 256 + h * 64 + cc]; }
            __syncthreads(); }
        {
            const int i = ci, sq = n * 64 + i;
#pragma unroll
            for (int kd = 0; kd < 3; ++kd) {
                float acc[8];
#pragma unroll
                for (int e = 0; e < 8; ++e) acc[e] = 0.f;
#pragma unroll
                for (int k = 0; k < DN_CONV; ++k) {
                    const u32x4 xv = xr[kd][k]; const float vm = (sq - (DN_CONV - 1) + k >= 0) ? 1.f : 0.f;
                    const f32x4 w0 = *(const LAS f32x4*)(cwL + (k * 3 + kd) * 64 + c8 * 8) * vm, w1 = *(const LAS f32x4*)(cwL + (k * 3 + kd) * 64 + c8 * 8 + 4) * vm;
                    acc[0] += w0.x * bf2f(xv.x & 0xffffu); acc[1] += w0.y * bf2f(xv.x >> 16); acc[2] += w0.z * bf2f(xv.y & 0xffffu); acc[3] += w0.w * bf2f(xv.y >> 16);
                    acc[4] += w1.x * bf2f(xv.z & 0xffffu); acc[5] += w1.y * bf2f(xv.z >> 16); acc[6] += w1.z * bf2f(xv.w & 0xffffu); acc[7] += w1.w * bf2f(xv.w >> 16);
                }
                float ss = 0.f;
#pragma unroll
                for (int e = 0; e < 8; ++e) { acc[e] = siluf_(acc[e]); ss += acc[e] * acc[e]; }
                if (kd < 2) {
                    ss = group8_sum(ss);
                    const float rn = rsqrtf(ss + EPS) * (kd == 0 ? 0.125f : 1.0f);
#pragma unroll
                    for (int e = 0; e < 8; ++e) acc[e] *= rn;
                }
                u32x4 pk; pk.x = cvtpk(acc[0], acc[1]); pk.y = cvtpk(acc[2], acc[3]); pk.z = cvtpk(acc[4], acc[5]); pk.w = cvtpk(acc[6], acc[7]);
                if (kd == 0) *(LAS u32x4*)(lds + L_QR + (i * DL + c8 * 8) * 2) = pk;
                if (kd == 1) *(LAS u32x4*)(lds + L_KR + (i * DL + c8 * 8) * 2) = pk;
                if (kd >= 1) {
                    LAS bf16_t* Tt = (LAS bf16_t*)(lds + (kd == 1 ? L_KT : L_VT));
                    const unsigned pw[4] = {pk.x, pk.y, pk.z, pk.w};
#pragma unroll
                    for (int e = 0; e < 8; ++e) Tt[(c8 * 8 + e) * DL + i] = (bf16_t)((pw[e >> 1] >> (16 * (e & 1))) & 0xffffu);
                }
            }
            for (int idx = F.tid; idx < 2 * LB / 16; idx += NTHREADS) *(LAS u32x4*)(lds + L_T1 + idx * 16) = (u32x4){0u, 0u, 0u, 0u};
            if (w == 0) {
                float x = bgg;
#pragma unroll
                for (int o = 1; o < 64; o <<= 1) { const float y = __shfl_up(x, o); if (lane >= o) x += y; }
                gcL[lane] = x; betaL[lane] = bgb;
            }
            if (vu + F.nb < BATCH * 4 * 256) CH_LOAD(vu + F.nb)
            asm volatile("" ::: "memory");
        }
        __syncthreads();
        REP(134217728)
#pragma unroll
        for (int tt = 0; tt < 2; ++tt) {
            const int tidx = 2 * w + tt, tx = tidx >> 2, ty = tidx & 3, i = 16 * ty + l15, j0 = 16 * tx + 4 * q4;
            const float gi = gcL[i], bi = betaL[i]; const f32x4 gj = *(const LAS f32x4*)(gcL + j0);
            const float gjv[4] = {gj.x, gj.y, gj.z, gj.w};
            const f32x4 zk = mm16<2>(lds, L_KR, L_KR, tx, ty, lane);
            const f32x4 zq = mm16<2>(lds, L_KR, L_QR, tx, ty, lane);
            f32x4 lv, av;
#pragma unroll
            for (int r = 0; r < 4; ++r) { const float dc = __expf(fminf(gi - gjv[r], 0.f)); lv[r] = (j0 + r < i) ? bi * zk[r] * dc : 0.f; av[r] = (j0 + r <= i) ? zq[r] * dc : 0.f; }
            *(LAS f32x4*)(lds + L_LR + (i * 68 + j0) * 4) = lv;
            if (i >= 32 && j0 < 32) *(LAS u32x2*)(lds + L_L21 + ((i - 32) * DL + j0) * 2) = pack4(lv);
            *(LAS u32x2*)(lds + L_AR + (i * DL + j0) * 2) = pack4(av);
        }
        __syncthreads();
        REP(32768) {
            const int cg = 8 * w + (lane >> 3), blk = cg >> 5, jp = cg & 31, l8 = lane & 7;
            const LAS float* Lb = (const LAS float*)(lds + L_LR) + (32 * blk) * 68 + 32 * blk + 4 * l8;
            float x0 = 0.f, x1 = 0.f, x2 = 0.f, x3 = 0.f;
#pragma unroll
            for (int i = 0; i < 32; ++i) {
                const f32x4 l4 = *(const LAS f32x4*)(Lb + i * 68);
                float part = (l4.x * x0 + l4.y * x1) + (l4.z * x2 + l4.w * x3);
                part = group8_sum(part);
                const float xi = ((i == jp) ? 1.f : 0.f) - part;
                if (l8 == (i >> 2)) { if ((i & 3) == 0) x0 = xi; else if ((i & 3) == 1) x1 = xi; else if ((i & 3) == 2) x2 = xi; else x3 = xi; }
            }
            const int jg = 32 * blk + jp; const float bj = betaL[jg], bej = bj * __expf(gcL[jg]);
            LAS bf16_t* T1 = (LAS bf16_t*)(lds + L_T1); LAS bf16_t* T2 = (LAS bf16_t*)(lds + L_T2);
            const float xs[4] = {x0, x1, x2, x3};
#pragma unroll
            for (int e = 0; e < 4; ++e) { const int rg = 32 * blk + 4 * l8 + e; T1[rg * DL + jg] = (bf16_t)f2bf(xs[e] * bj); T2[rg * DL + jg] = (bf16_t)f2bf(xs[e] * bej); }
            if (blk == 0) { *(LAS u32x2*)(lds + L_T11T + (jp * DL + 4 * l8) * 2) = pack4((f32x4){x0, x1, x2, x3}); }
            else { LAS bf16_t* T22 = (LAS bf16_t*)(lds + L_T22R);
#pragma unroll
                for (int e = 0; e < 4; ++e) T22[(4 * l8 + e) * DL + jp] = (bf16_t)f2bf(xs[e]); }
        }
        __syncthreads();
        if (w < 4) {
            const int tx = w >> 1, ty = w & 1;
            const f32x4 z = mm16<1>(lds, L_L21, L_T11T, tx, ty, lane);
            *(LAS u32x2*)(lds + L_YT + ((16 * ty + l15) * DL + 16 * tx + 4 * q4) * 2) = pack4(z);
        }
        __syncthreads();
        if (w < 4) {
            const int tx = w >> 1, ty = w & 1, y = 16 * ty + l15, x0 = 16 * tx + 4 * q4;
            const f32x4 z = mm16<1>(lds, L_T22R, L_YT, tx, ty, lane);
            const float bj = betaL[y], bej = bj * __expf(gcL[y]);
            LAS bf16_t* T1 = (LAS bf16_t*)(lds + L_T1); LAS bf16_t* T2 = (LAS bf16_t*)(lds + L_T2);
#pragma unroll
            for (int r = 0; r < 4; ++r) { T1[(32 + x0 + r) * DL + y] = (bf16_t)f2bf(-z[r] * bj); T2[(32 + x0 + r) * DL + y] = (bf16_t)f2bf(-z[r] * bej); }
        }
        __syncthreads();
        const float gl = gcL[63];
        REP(268435456)
#pragma unroll
        for (int tt = 0; tt < 2; ++tt) {
            const int tidx = 2 * w + tt, tx = tidx >> 2, ty = tidx & 3, y = 16 * ty + l15, x0 = 16 * tx + 4 * q4;
            const f32x4 gx = *(const LAS f32x4*)(gcL + x0);
            f32x4 sc; sc.x = __expf(gl - gx.x); sc.y = __expf(gl - gx.y); sc.z = __expf(gl - gx.z); sc.w = __expf(gl - gx.w);
            const f32x4 zu = mm16<2>(lds, L_T1, L_VT, tx, ty, lane);
            const f32x4 zw = mm16<2>(lds, L_T2, L_KT, tx, ty, lane);
            *(LAS u32x2*)(lds + L_UT + (y * DL + x0) * 2) = pack4(zu); *(LAS u32x2*)(lds + L_UPT + (y * DL + x0) * 2) = pack4(zu * sc);
            *(LAS u32x2*)(lds + L_WT + (y * DL + x0) * 2) = pack4(zw); *(LAS u32x2*)(lds + L_WPT + (y * DL + x0) * 2) = pack4(zw * sc);
        }
        __syncthreads();
        REP(65536) {
            const size_t cho = (size_t)unit * 4096;
            const float egl = __expf(gl);
#pragma unroll
            for (int tt = 0; tt < 2; ++tt) {
                const int tidx = 2 * w + tt, tx = tidx >> 2, ty = tidx & 3, y = 16 * ty + l15, x0 = 16 * tx + 4 * q4;
                f32x4 zm = mm16<2>(lds, L_WPT, L_KT, tx, ty, lane);
#pragma unroll
                for (int r = 0; r < 4; ++r) zm[r] = ((x0 + r) == y ? egl : 0.f) - zm[r];
                *(u32x2*)(MR + cho + (ty * 2 + (tx >> 1)) * 512 + lane * 8 + 4 * (tx & 1)) = pack4(zm);
                const f32x4 zb = mm16<2>(lds, L_KT, L_UPT, tx, ty, lane);
                *(u32x2*)(BNT + cho + (ty * 4 + tx) * 256 + lane * 4) = pack4(zb);
                const f32x4 zq = mm16<2>(lds, L_WT, L_AR, tx, ty, lane);
                const u32x2 qv = *(const LAS u32x2*)(lds + L_QR + (y * DL + x0) * 2); const float eg = __expf(gcL[y]);
                f32x4 qp; qp.x = bf2f(qv.x & 0xffffu) * eg - zq.x; qp.y = bf2f(qv.x >> 16) * eg - zq.y; qp.z = bf2f(qv.y & 0xffffu) * eg - zq.z; qp.w = bf2f(qv.y >> 16) * eg - zq.w;
                *(u32x2*)(QP + cho + y * 64 + x0) = pack4(qp);
                const f32x4 zo = mm16<2>(lds, L_AR, L_UT, tx, ty, lane);
                *(u32x2*)(OLT + cho + y * 64 + x0) = pack4(zo);
            }
        }
    }
    __syncthreads();
}
#undef CH_LOAD
constexpr int SC_SLOT = 10240, SC_DEPTH = 12, SC_AHEAD = 10;
__device__ __forceinline__ void ph_dn_scan(const Args& a, Frame& F) {
    if (F.bid >= NSCAN) return;
    const unsigned char* MRb = (const unsigned char*)(F.ws + WS_DN_MR); const unsigned char* BNb = (const unsigned char*)(F.ws + WS_DN_BNT); bf16_t* ST = (bf16_t*)(F.ws + WS_DN_ST);
    const int lane = F.lane, l15 = lane & 15, q4 = lane >> 4, wq = F.bid >> 3;
    const size_t ch0 = (size_t)(F.bid & 7) * 256;
    LAS unsigned char* lds = F.lds;
    __syncthreads();
    if (F.wave >= 3) {
        const int lw = F.wave - 3;
#define DN_ISSUE(nn) do { const size_t chb_ = (ch0 + (size_t)((nn) < 255 ? (nn) : 255)) * 8192; const int slot_ = ((nn) % SC_DEPTH) * SC_SLOT; \
        _Pragma("unroll") for (int p_ = 0; p_ < 2; ++p_) { const int piece_ = lw * 2 + p_; \
            const unsigned char* src_ = (piece_ < 8 ? MRb + chb_ + piece_ * 1024 : BNb + chb_ + wq * 2048 + (piece_ - 8) * 1024) + lane * 16; \
            __builtin_amdgcn_global_load_lds((const unsigned*)src_, (LAS unsigned*)(lds + slot_ + piece_ * 1024), 16, 0, 2); } } while (0)
        for (int n = 0; n < SC_AHEAD; ++n) DN_ISSUE(n);
        for (int n = 0; n < 256; n += 2) {
            asm volatile("s_waitcnt vmcnt(16)" ::: "memory");
            __builtin_amdgcn_s_barrier();
            DN_ISSUE(n + SC_AHEAD); DN_ISSUE(n + SC_AHEAD + 1);
        }
        asm volatile("s_waitcnt vmcnt(0)" ::: "memory");
#undef DN_ISSUE
    } else if (F.wave == 0) {
        const int dv = 16 * wq + l15;
        f32x4 S[4];
#pragma unroll
        for (int ti = 0; ti < 4; ++ti) S[ti] = (f32x4){0.f, 0.f, 0.f, 0.f};
        for (int n0 = 0; n0 < 256; n0 += 2) {
            __builtin_amdgcn_s_barrier();
            bf16x8_t A[2][4][2]; u32x2 Bc[2][4];
#pragma unroll
            for (int e = 0; e < 2; ++e) { const LAS unsigned char* slot = lds + ((n0 + e) % SC_DEPTH) * SC_SLOT;
#pragma unroll
                for (int ti = 0; ti < 4; ++ti) {
#pragma unroll
                    for (int ks = 0; ks < 2; ++ks) A[e][ti][ks] = *(const LAS bf16x8_t*)(slot + (ti * 2 + ks) * 1024 + lane * 16);
                    Bc[e][ti] = *(const LAS u32x2*)(slot + 8192 + ti * 512 + lane * 8);
                } }
#pragma unroll
            for (int e = 0; e < 2; ++e) {
                const int n = n0 + e;
                u32x2 sp[4];
#pragma unroll
                for (int ti = 0; ti < 4; ++ti) { sp[ti] = pack4(S[ti]); *(u32x2*)(ST + (ch0 + n) * 4096 + dv * 64 + 16 * ti + 4 * q4) = sp[ti]; }
                const bf16x8_t b0 = __builtin_bit_cast(bf16x8_t, (u32x4){sp[0].x, sp[0].y, sp[1].x, sp[1].y});
                const bf16x8_t b1 = __builtin_bit_cast(bf16x8_t, (u32x4){sp[2].x, sp[2].y, sp[3].x, sp[3].y});
#pragma unroll
                for (int ti = 0; ti < 4; ++ti) {
                    f32x4 c; c.x = bf2f(Bc[e][ti].x & 0xffffu); c.y = bf2f(Bc[e][ti].x >> 16); c.z = bf2f(Bc[e][ti].y & 0xffffu); c.w = bf2f(Bc[e][ti].y >> 16);
                    c = __builtin_amdgcn_mfma_f32_16x16x32_bf16(A[e][ti][0], b0, c, 0, 0, 0);
                    c = __builtin_amdgcn_mfma_f32_16x16x32_bf16(A[e][ti][1], b1, c, 0, 0, 0);
                    S[ti] = c;
                }
            }
            asm volatile("s_waitcnt lgkmcnt(0)" ::: "memory");
        }
    } else {
        for (int n = 0; n < 256; n += 2) __builtin_amdgcn_s_barrier();
    }
    __syncthreads();
}
__device__ __forceinline__ void ph_dn_out(const Args& a, Frame& F, int l) {
    const bf16_t* QP = (const bf16_t*)(F.ws + WS_DN_QP); const bf16_t* OLT = (const bf16_t*)(F.ws + WS_DN_OLT); const bf16_t* ST = (const bf16_t*)(F.ws + WS_DN_ST);
    const bf16_t* P = (const bf16_t*)(F.ws + WS_PROJ); bf16_t* Y = (bf16_t*)(F.ws + WS_YMIX);
    const int lane = F.lane, l15 = lane & 15, q4 = lane >> 4, ti = F.wave & 3;
    LAS bf16_t* TL = (LAS bf16_t*)(F.lds + F.wave * 2560);
    const int er = lane >> 2, ec = (lane & 3) * 16;
    f32x4 gnv[4];
#pragma unroll
    for (int j = 0; j < 4; ++j) gnv[j] = *(const f32x4*)(a.dn_norm_g + l * 64 + ec + 4 * j);
    bf16x8_t af[2], bfv[4][2]; u32x2 ov[4];
#define DNO_LOAD(prv) { const int unit_ = 2 * (prv) + (F.wave >> 2); const size_t cho_ = (size_t)unit_ * 4096; \
        _Pragma("unroll") for (int ks = 0; ks < 2; ++ks) af[ks] = *(const bf16x8_t*)(QP + cho_ + (16 * ti + l15) * 64 + 32 * ks + 8 * q4); \
        _Pragma("unroll") for (int tj = 0; tj < 4; ++tj) { ov[tj] = *(const u32x2*)(OLT + cho_ + (16 * tj + l15) * 64 + 16 * ti + 4 * q4); \
            _Pragma("unroll") for (int ks = 0; ks < 2; ++ks) bfv[tj][ks] = *(const bf16x8_t*)(ST + cho_ + (16 * tj + l15) * 64 + 32 * ks + 8 * q4); } }
    if (F.bid < 1024) DNO_LOAD(F.bid)
    for (int pr = F.bid; pr < 1024; pr += F.nb) {
        const int unit = 2 * pr + (F.wave >> 2), n = unit & 255, h = (unit >> 8) & 3, b = unit >> 10;
        f32x4 acc[4];
#pragma unroll
        for (int tj = 0; tj < 4; ++tj) {
            f32x4 c; c.x = bf2f(ov[tj].x & 0xffffu); c.y = bf2f(ov[tj].x >> 16); c.z = bf2f(ov[tj].y & 0xffffu); c.w = bf2f(ov[tj].y >> 16);
#pragma unroll
            for (int ks = 0; ks < 2; ++ks) c = __builtin_amdgcn_mfma_f32_16x16x32_bf16(af[ks], bfv[tj][ks], c, 0, 0, 0);
            acc[tj] = c;
        }
        const size_t trow = (size_t)b * SEQ + n * 64 + 16 * ti + er;
        const u32x4 z0 = *(const u32x4*)(P + trow * NP + C_DZ + h * 64 + ec), z1 = *(const u32x4*)(P + trow * NP + C_DZ + h * 64 + ec + 8);
        if (pr + F.nb < 1024) DNO_LOAD(pr + F.nb)
        f32x4 ss = acc[0] * acc[0] + acc[1] * acc[1] + acc[2] * acc[2] + acc[3] * acc[3];
        ss.x = row16_sum(ss.x); ss.y = row16_sum(ss.y); ss.z = row16_sum(ss.z); ss.w = row16_sum(ss.w);
        const float rs[4] = {rsqrtf(ss.x * (1.f / 64.f) + EPS), rsqrtf(ss.y * (1.f / 64.f) + EPS), rsqrtf(ss.z * (1.f / 64.f) + EPS), rsqrtf(ss.w * (1.f / 64.f) + EPS)};
#pragma unroll
        for (int tj = 0; tj < 4; ++tj)
#pragma unroll
            for (int r = 0; r < 4; ++r) TL[(4 * q4 + r) * 80 + 16 * tj + l15] = (bf16_t)f2bf(acc[tj][r] * rs[r]);
        const u32x4 t0 = *(const LAS u32x4*)(TL + er * 80 + ec), t1 = *(const LAS u32x4*)(TL + er * 80 + ec + 8);
        const unsigned tw[8] = {t0.x, t0.y, t0.z, t0.w, t1.x, t1.y, t1.z, t1.w}, zw[8] = {z0.x, z0.y, z0.z, z0.w, z1.x, z1.y, z1.z, z1.w};
        unsigned yw[8];
#pragma unroll
        for (int j = 0; j < 8; ++j) {
            const float g0 = gnv[j >> 1][(2 * j) & 3], g1 = gnv[j >> 1][(2 * j + 1) & 3];
            yw[j] = cvtpk(bf2f(tw[j] & 0xffffu) * g0 * siluf_(bf2f(zw[j] & 0xffffu)), bf2f(tw[j] >> 16) * g1 * siluf_(bf2f(zw[j] >> 16)));
        }
        bf16_t* yp = Y + trow * D + 512 + h * 64 + ec;
        *(u32x4*)yp = (u32x4){yw[0], yw[1], yw[2], yw[3]}; *(u32x4*)(yp + 8) = (u32x4){yw[4], yw[5], yw[6], yw[7]};
    }
#undef DNO_LOAD
}

__device__ __forceinline__ void ph_conv_fast(const Args& a, Frame& F, int l) {
    const bf16_t* P = (const bf16_t*)(F.ws + WS_PROJ); bf16_t* Y = (bf16_t*)(F.ws + WS_YMIX);
    LAS float* OUTL = (LAS float*)F.lds;
    const int c = F.tid & 255, rsel = F.tid >> 8;
    float wk[CV_K];
#pragma unroll
    for (int k = 0; k < CV_K; ++k) wk[k] = a.cv_dw_w[((size_t)l * CV_K + k) * CV_C + c];
    const float bias = a.cv_dw_b[l * CV_C + c];
    const int nsc = NSCAN;
    if (F.bid < nsc) return;
    for (int pr = F.bid - nsc; pr < T / 128; pr += F.nb - nsc) {
        const int run = 2 * pr + rsel, t0 = run * 64, s0 = t0 % SEQ;
        __syncthreads();
        float win[CV_K];
        const bf16_t* pc = P + (size_t)(t0 - 30) * NP + C_CA + c;
        const bool first = (s0 == 0);
        LAS float* outp = OUTL + (rsel * 64) * 256 + c;
#define CV_U(ti_, dst) { const bool ok_ = !(first && (ti_) < 30); const bf16_t* q_ = ok_ ? pc + (size_t)(ti_) * NP : pc + (size_t)30 * NP; \
            const float ca_ = bf2f(q_[0]), cb_ = bf2f(q_[256]); dst = ok_ ? ca_ * sigmoidf_(cb_) : 0.f; }
#pragma unroll
        for (int p = 0; p < CV_K; ++p) CV_U(p, win[p])
        { float acc = bias;
#pragma unroll
            for (int k = 0; k < CV_K; ++k) acc += wk[k] * win[(30 + 1 + k) % CV_K];
            outp[0] = acc; }
        for (int cb3 = 1; cb3 < 3; ++cb3) {
            float un[CV_K];
#pragma unroll
            for (int p = 0; p < CV_K; ++p) CV_U(cb3 * CV_K + p, un[p])
#pragma unroll
            for (int p = 0; p < CV_K; ++p) {
                win[p] = un[p];
                float acc = bias;
#pragma unroll
                for (int k = 0; k < CV_K; ++k) acc += wk[k] * win[(p + 1 + k) % CV_K];
                outp[(cb3 * CV_K + p - 30) * 256] = acc;
            }
        }
        { float u93; CV_U(93, u93) win[0] = u93; float acc = bias;
#pragma unroll
            for (int k = 0; k < CV_K; ++k) acc += wk[k] * win[(0 + 1 + k) % CV_K];
            outp[63 * 256] = acc; }
#undef CV_U
        __syncthreads();
        const f32x4 g4 = *(const f32x4*)(a.cv_ln_g + l * CV_C + 4 * F.lane), b4 = *(const f32x4*)(a.cv_ln_b + l * CV_C + 4 * F.lane);
        for (int j = 0; j < 16; ++j) {
            const int tl = F.wave * 16 + j;
            const f32x4 v = *(const LAS f32x4*)(OUTL + tl * 256 + 4 * F.lane);
            const float mean = wave_sum((v.x + v.y) + (v.z + v.w)) * (1.0f / CV_C);
            const f32x4 dv = v - mean;
            const float var = wave_sum((dv.x * dv.x + dv.y * dv.y) + (dv.z * dv.z + dv.w * dv.w)) * (1.0f / CV_C);
            const float rstd = rsqrtf(var + EPS);
            const f32x4 y = (dv * rstd) * g4 + b4;
            u32x2 o; o.x = cvtpk(siluf_(y.x), siluf_(y.y)); o.y = cvtpk(siluf_(y.z), siluf_(y.w));
            *(u32x2*)(Y + (size_t)(pr * 128 + tl) * D + 768 + 4 * F.lane) = o;
        }
    }
    __syncthreads();
}

__device__ __forceinline__ void moe_bases(Frame& F, int (&base)[9], int (&cnt)[8]) {
    const unsigned* c = (const unsigned*)(F.ws + WS_CTL) + CW_MOECNT;
    int acc = 0;
#pragma unroll
    for (int e = 0; e < 8; ++e) { cnt[e] = (int)__hip_atomic_load(c + 64 * e, __ATOMIC_RELAXED, __HIP_MEMORY_SCOPE_AGENT); base[e] = acc; acc += (cnt[e] + 255) & ~255; }
    base[8] = acc;
}
__device__ __forceinline__ void moe_range(Frame& F, int e, int& lo, int& hi) {
    const unsigned* c = (const unsigned*)(F.ws + WS_CTL) + CW_MOECNT;
    int acc = 0; lo = 0; hi = 0;
#pragma unroll
    for (int k = 0; k < 8; ++k) { const int n = ((int)__hip_atomic_load(c + 64 * k, __ATOMIC_RELAXED, __HIP_MEMORY_SCOPE_AGENT) + 255) & ~255; if (k == e) { lo = acc; hi = acc + n; } acc += n; }
}
__device__ __forceinline__ void ph_moe_list(const Args& a, Frame& F) {
    int base[9], cnt[8]; moe_bases(F, base, cnt);
    int* RM = (int*)(F.ws + WS_RMAP); const int* R = (const int*)(F.ws + WS_ROUTE); const int* Pq = (const int*)(F.ws + WS_POS);
    for (int t = F.bid * NTHREADS + F.tid; t < T; t += F.nb * NTHREADS) {
        const int e0 = R[t * 4], e1 = R[t * 4 + 1];
        int b0 = 0, b1 = 0;
#pragma unroll
        for (int e = 0; e < 8; ++e) { if (e == e0) b0 = base[e]; if (e == e1) b1 = base[e]; }
        RM[b0 + Pq[t * 2]] = t; RM[b1 + Pq[t * 2 + 1]] = t;
    }
    if (F.bid == 0) {
#pragma unroll
        for (int e = 0; e < 8; ++e) { const int lo = base[e] + cnt[e], hi = base[e + 1]; for (int r = lo + F.tid; r < hi; r += NTHREADS) RM[r] = 0; }
    }
}
__device__ __forceinline__ void ph_final(const Args& a, Frame& F) {
    int base[9], cnt[8]; moe_bases(F, base, cnt);
    const float* MOD = (const float*)(F.ws + WS_MOD);
    const bf16_t* YM = (const bf16_t*)(F.ws + WS_YMOE); const int* R = (const int*)(F.ws + WS_ROUTE); const int* Pq = (const int*)(F.ws + WS_POS); const bf16_t* X16 = (const bf16_t*)(F.ws + WS_X16);
    const int c0 = 8 * F.lane;
    f32x4 fg[4], gt[4]; int cur_b = -1;
#pragma unroll
    for (int j = 0; j < 4; ++j) fg[j] = *(const f32x4*)(a.final_g + 512 * (j >> 1) + c0 + 4 * (j & 1));
    u32x4 rt_n; u32x2 pq_n;
    u32x4 dx[2], dy0[2], dy1[2]; float p0c = 0.f, p1c = 0.f;
#define FIN_ROUTE(row_, rt_, pq_) { rt_ = *(const u32x4*)(R + (size_t)(row_) * 4); pq_ = *(const u32x2*)(Pq + (size_t)(row_) * 2); }
#define FIN_DATA(row_, rt_, pq_) { int b0_ = 0, b1_ = 0; _Pragma("unroll") for (int e = 0; e < 8; ++e) { if (e == (int)rt_.x) b0_ = base[e]; if (e == (int)rt_.y) b1_ = base[e]; } \
        const size_t s0_ = (size_t)(b0_ + (int)pq_.x), s1_ = (size_t)(b1_ + (int)pq_.y); p0c = __uint_as_float(rt_.z); p1c = __uint_as_float(rt_.w); \
        _Pragma("unroll") for (int jj = 0; jj < 2; ++jj) { dx[jj] = __builtin_nontemporal_load((const u32x4*)(X16 + (size_t)(row_) * D + 512 * jj + c0)); dy0[jj] = __builtin_nontemporal_load((const u32x4*)(YM + s0_ * D + 512 * jj + c0)); dy1[jj] = __builtin_nontemporal_load((const u32x4*)(YM + s1_ * D + 512 * jj + c0)); } }
    if (F.gw < T) { u32x4 rt0; u32x2 pq0; FIN_ROUTE(F.gw, rt0, pq0) FIN_DATA(F.gw, rt0, pq0) }
    if (F.gw + F.ngw < T) FIN_ROUTE(F.gw + F.ngw, rt_n, pq_n)
    for (int row = F.gw; row < T; row += F.ngw) {
        const int b = row / SEQ;
        if (b != cur_b) { cur_b = b; const float* gt2 = MOD + ((size_t)(1 * 2 + 1) * 2 + b) * 3072 + 2048;
#pragma unroll
            for (int j = 0; j < 4; ++j) gt[j] = *(const f32x4*)(gt2 + 512 * (j >> 1) + c0 + 4 * (j & 1)); }
        f32x4 v[4]; float ss = 0.f; const float p0 = p0c, p1 = p1c;
#pragma unroll
        for (int jj = 0; jj < 2; ++jj) {
            const unsigned xw[4] = {dx[jj].x, dx[jj].y, dx[jj].z, dx[jj].w}, y0w[4] = {dy0[jj].x, dy0[jj].y, dy0[jj].z, dy0[jj].w}, y1w[4] = {dy1[jj].x, dy1[jj].y, dy1[jj].z, dy1[jj].w};
#pragma unroll
            for (int hf = 0; hf < 2; ++hf) {
                f32x4 f, xo;
                f.x = p0 * bf2f(y0w[2 * hf] & 0xffffu) + p1 * bf2f(y1w[2 * hf] & 0xffffu); f.y = p0 * bf2f(y0w[2 * hf] >> 16) + p1 * bf2f(y1w[2 * hf] >> 16);
                f.z = p0 * bf2f(y0w[2 * hf + 1] & 0xffffu) + p1 * bf2f(y1w[2 * hf + 1] & 0xffffu); f.w = p0 * bf2f(y0w[2 * hf + 1] >> 16) + p1 * bf2f(y1w[2 * hf + 1] >> 16);
                xo.x = bf2f(xw[2 * hf] & 0xffffu); xo.y = bf2f(xw[2 * hf] >> 16); xo.z = bf2f(xw[2 * hf + 1] & 0xffffu); xo.w = bf2f(xw[2 * hf + 1] >> 16);
                const f32x4 vv = xo + gt[2 * jj + hf] * f; v[2 * jj + hf] = vv;
                ss += (vv.x * vv.x + vv.y * vv.y) + (vv.z * vv.z + vv.w * vv.w);
            }
        }
        if (row + F.ngw < T) { FIN_DATA(row + F.ngw, rt_n, pq_n) }
        if (row + 2 * F.ngw < T) FIN_ROUTE(row + 2 * F.ngw, rt_n, pq_n)
        const float rstd = rsqrtf(wave_sum(ss) * (1.0f / D) + EPS);
        float* op = a.out + (size_t)row * D + c0;
#pragma unroll
        for (int j = 0; j < 4; ++j) __builtin_nontemporal_store((v[j] * rstd) * fg[j], (f32x4*)(op + 512 * (j >> 1) + 4 * (j & 1)));
    }
#undef FIN_ROUTE
#undef FIN_DATA
}


namespace pg8 {
typedef short bf16x8 __attribute__((ext_vector_type(8)));
constexpr int BM = 256, BK = 64, HALF = 128, HTB = HALF * BK * 2, STAGE_BYTES = 8 * HTB;
__device__ __forceinline__ int lds_byte(int r, int c) { const int st = (r >> 4) * 2 + (c >> 5), rr = r & 15, cc = c & 31, ob = rr * 64 + cc * 2; return st * 1024 + (ob ^ (((ob >> 9) & 1) << 5)); }
__device__ __forceinline__ void stage_rc(int b, int& R, int& C) { const int st = b / 1024, sb = b % 1024, swz = sb ^ (((sb >> 9) & 1) << 5); R = (st >> 1) * 16 + swz / 64; C = (st & 1) * 32 + (swz % 64) / 2; }
__device__ __forceinline__ int perm32(int rho) { const int n = rho >> 4, i = rho & 15; return 8 * (i >> 2) + 4 * n + (i & 3); }
struct Unit { int pm, pn, ord; };
struct Gemm { const bf16_t* A; const bf16_t* Bt; int K; };
constexpr int NXCD = 8, WGM = 8;
struct StaticOrder {
    int nM, nN, nwg, G, c;
    __device__ void init(int M, int N, int G_, int c_) { nM = M / BM; nN = N / BM; nwg = nM * nN; G = G_; c = c_; }
    __device__ __forceinline__ bool next(int i, Unit& u) const {
        const long L = (long)i * G + c; if (L >= nwg) return false;
        int wgid = (int)L; { const int q = nwg / NXCD, r = nwg % NXCD, xcd = wgid % NXCD, off = wgid / NXCD; wgid = (xcd < r ? xcd * (q + 1) : r * (q + 1) + (xcd - r) * q) + off; }
        const int nig = WGM * nN, gid = wgid / nig, fm = gid * WGM, gsz = (nM - fm) < WGM ? (nM - fm) : WGM;
        u.pm = fm + ((wgid % nig) % gsz); u.pn = (wgid % nig) / gsz; return true;
    }
};
template <int NT> struct MoeOrder {
    int bt[9]; int cnt[8]; int G, c;
    __device__ __forceinline__ bool next(int i, Unit& u) const {
        int q, tn;
        if ((G & 7) == 0) { const int x = c & 7, Ll = i * (G >> 3) + (c >> 3); q = (Ll / NT) * 8 + x; tn = Ll % NT; if (q >= bt[8]) return false; }
        else { const int L = i * G + c; if (L >= bt[8] * NT) return false; q = L / NT; tn = L % NT; }
        int e = 0;
#pragma unroll
        for (int k = 1; k < 8; ++k) e += (q >= bt[k]) ? 1 : 0;
        u.pm = q; u.pn = e * NT + tn; return true;
    }
};
__device__ __forceinline__ unsigned cvt_pk_bf16(float lo, float hi) { unsigned r; asm volatile("v_cvt_pk_bf16_f32 %0, %1, %2" : "=v"(r) : "v"(lo), "v"(hi)); return r; }
__device__ __forceinline__ float fast_silu(float x) { return x * __builtin_amdgcn_rcpf(1.0f + __builtin_amdgcn_exp2f(x * -1.4426950408889634f)); }

struct EpiBf16 {
    static constexpr bool PERM = true, WIDE = false;
    bf16_t* O; int ldc; int nmod;
    __device__ __forceinline__ void operator()(const f32x4 (&acc)[2][2][4][2], const Unit& u, int wr, int wc, int fr, int fq) const {
        const int row0 = u.pm * BM + wr * 64 + fr, col0 = (u.pn % nmod) * BM + wc * 32 + 8 * fq;
#pragma unroll
        for (int ai = 0; ai < 2; ++ai)
#pragma unroll
            for (int m = 0; m < 4; ++m) { bf16_t* rowp = O + (size_t)(row0 + ai * HALF + m * 16) * ldc + col0;
#pragma unroll
                for (int bj = 0; bj < 2; ++bj) { const f32x4 v0 = acc[ai][bj][m][0], v1 = acc[ai][bj][m][1];
                    u32x4 w; w.x = cvt_pk_bf16(v0[0], v0[1]); w.y = cvt_pk_bf16(v0[2], v0[3]); w.z = cvt_pk_bf16(v1[0], v1[1]); w.w = cvt_pk_bf16(v1[2], v1[3]);
                    *(u32x4*)(rowp + bj * HALF) = w; } }
    }
};
struct EpiSwiGLU {
    static constexpr bool PERM = true, WIDE = false;
    bf16_t* O; int ldc; int nmod;
    __device__ __forceinline__ void operator()(const f32x4 (&acc)[2][2][4][2], const Unit& u, int wr, int wc, int fr, int fq) const {
        const int row0 = u.pm * BM + wr * 64 + fr, col0 = (u.pn % nmod) * HALF + wc * 32 + 8 * fq;
#pragma unroll
        for (int ai = 0; ai < 2; ++ai)
#pragma unroll
            for (int m = 0; m < 4; ++m) {
                const f32x4 g0 = acc[ai][0][m][0], g1 = acc[ai][0][m][1], u0 = acc[ai][1][m][0], u1 = acc[ai][1][m][1];
                u32x4 w;
                w.x = cvt_pk_bf16(fast_silu(g0[0]) * u0[0], fast_silu(g0[1]) * u0[1]); w.y = cvt_pk_bf16(fast_silu(g0[2]) * u0[2], fast_silu(g0[3]) * u0[3]);
                w.z = cvt_pk_bf16(fast_silu(g1[0]) * u1[0], fast_silu(g1[1]) * u1[1]); w.w = cvt_pk_bf16(fast_silu(g1[2]) * u1[2], fast_silu(g1[3]) * u1[3]);
                *(u32x4*)(O + (size_t)(row0 + ai * HALF + m * 16) * ldc + col0) = w; }
    }
};
struct EpiResidF32 {
    static constexpr bool PERM = false, WIDE = false;
    const float* xin; float* xout; const float* gate;
    __device__ __forceinline__ void operator()(const f32x4 (&acc)[2][2][4][2], const Unit& u, int wr, int wc, int fr, int fq) const {
        const int row0 = u.pm * BM + wr * 64 + fr, col0 = u.pn * BM + wc * 32 + 4 * fq;
        const float* gp = gate + (size_t)((u.pm * BM) / SEQ) * 3072 + col0;
#pragma unroll
        for (int bj = 0; bj < 2; ++bj)
#pragma unroll
            for (int n = 0; n < 2; ++n) { const f32x4 g4 = *(const f32x4*)(gp + bj * HALF + n * 16);
#pragma unroll
                for (int ai = 0; ai < 2; ++ai)
#pragma unroll
                    for (int m = 0; m < 4; ++m) { const size_t off = (size_t)(row0 + ai * HALF + m * 16) * D + col0 + bj * HALF + n * 16;
                        const f32x4 x4 = *(const f32x4*)(xin + off); *(f32x4*)(xout + off) = x4 + g4 * acc[ai][bj][m][n]; } }
    }
};


__device__ __forceinline__ u32x4 xchg8(u32x4 v) { u32x4 r;
    r.x = (unsigned)__builtin_amdgcn_update_dpp(0, (int)v.x, 0x128, 0xf, 0xf, false); r.y = (unsigned)__builtin_amdgcn_update_dpp(0, (int)v.y, 0x128, 0xf, 0xf, false);
    r.z = (unsigned)__builtin_amdgcn_update_dpp(0, (int)v.z, 0x128, 0xf, 0xf, false); r.w = (unsigned)__builtin_amdgcn_update_dpp(0, (int)v.w, 0x128, 0xf, 0xf, false); return r; }
__device__ __forceinline__ u32x4 pack8(f32x4 v0, f32x4 v1) { u32x4 w; w.x = cvt_pk_bf16(v0[0], v0[1]); w.y = cvt_pk_bf16(v0[2], v0[3]); w.z = cvt_pk_bf16(v1[0], v1[1]); w.w = cvt_pk_bf16(v1[2], v1[3]); return w; }
template <bool NT = true> __device__ __forceinline__ void store_wide(bf16_t* p, int ld, int fr, int fq, u32x4 pk0, u32x4 pk1) {
    const bool lo = fr < 8; const u32x4 rcv = xchg8(lo ? pk1 : pk0);
    bf16_t* q = p + (size_t)(fr & 7) * ld + 8 * fq + (lo ? 0 : 32);
    if constexpr (NT) { __builtin_nontemporal_store(lo ? pk0 : rcv, (u32x4*)q); __builtin_nontemporal_store(lo ? rcv : pk1, (u32x4*)(q + (size_t)8 * ld)); }
    else { *(u32x4*)q = lo ? pk0 : rcv; *(u32x4*)(q + (size_t)8 * ld) = lo ? rcv : pk1; }
}
struct EpiBf16W {
    static constexpr bool PERM = true, WIDE = true;
    bf16_t* O; int ldc; int nmod;
    __device__ __forceinline__ void operator()(const f32x4 (&acc)[2][2][4][2], const Unit& u, int wr, int wc, int fr, int fq) const {
        bf16_t* base = O + (size_t)(u.pm * BM + wr * 64) * ldc + (u.pn % nmod) * BM + wc * 64;
#pragma unroll
        for (int ai = 0; ai < 2; ++ai)
#pragma unroll
            for (int m = 0; m < 4; ++m) store_wide(base + (size_t)(ai * HALF + m * 16) * ldc, ldc, fr, fq, pack8(acc[ai][0][m][0], acc[ai][0][m][1]), pack8(acc[ai][1][m][0], acc[ai][1][m][1]));
    }
};
struct EpiResidNorm {
    static constexpr bool PERM = true, WIDE = true;
    const bf16_t* xin; bf16_t* x16; const float* gate; const float* av; bf16_t* xa; float* ssqp;
    __device__ __forceinline__ void operator()(const f32x4 (&acc)[2][2][4][2], const Unit& u, int wr, int wc, int fr, int fq) const {
        const int rowb = u.pm * BM + wr * 64, colw = u.pn * BM + wc * 64, b = (u.pm * BM) / SEQ;
        const bool lo = fr < 8;
        const size_t lane_off = (size_t)(fr & 7) * D + colw + 8 * fq + (lo ? 0 : 32);
        f32x4 gv[2][2], avv[2][2];
#pragma unroll
        for (int bj = 0; bj < 2; ++bj)
#pragma unroll
            for (int n = 0; n < 2; ++n) { gv[bj][n] = *(const f32x4*)(gate + (size_t)b * 3072 + colw + 32 * bj + 8 * fq + 4 * n); avv[bj][n] = *(const f32x4*)(av + (size_t)b * 1024 + colw + 32 * bj + 8 * fq + 4 * n); }
        u32x4 la[4][2], lb[4][2];
#define ERN_LOAD(k_) { _Pragma("unroll") for (int mm = 0; mm < 2; ++mm) { const bf16_t* q = xin + (size_t)(rowb + ((k_) >> 1) * HALF + (2 * ((k_) & 1) + mm) * 16) * D + lane_off; la[k_][mm] = __builtin_nontemporal_load((const u32x4*)q); lb[k_][mm] = __builtin_nontemporal_load((const u32x4*)(q + (size_t)8 * D)); } }
        ERN_LOAD(0)
#pragma unroll
        for (int k = 0; k < 4; ++k) {
            const int ai = k >> 1;
            if (k == 0) ERN_LOAD(1) else if (k == 1) ERN_LOAD(2) else if (k == 2) ERN_LOAD(3)
            asm volatile("" ::: "memory");
#pragma unroll
            for (int mm = 0; mm < 2; ++mm) {
                const int m = 2 * (k & 1) + mm;
                const u32x4 rcv = xchg8(lo ? lb[k][mm] : la[k][mm]);
                const u32x4 xb0 = lo ? la[k][mm] : rcv, xb1 = lo ? rcv : lb[k][mm];
                f32x4 x00, x01, x10, x11;
                x00.x = __uint_as_float(xb0.x << 16); x00.y = __uint_as_float(xb0.x & 0xffff0000u); x00.z = __uint_as_float(xb0.y << 16); x00.w = __uint_as_float(xb0.y & 0xffff0000u);
                x01.x = __uint_as_float(xb0.z << 16); x01.y = __uint_as_float(xb0.z & 0xffff0000u); x01.z = __uint_as_float(xb0.w << 16); x01.w = __uint_as_float(xb0.w & 0xffff0000u);
                x10.x = __uint_as_float(xb1.x << 16); x10.y = __uint_as_float(xb1.x & 0xffff0000u); x10.z = __uint_as_float(xb1.y << 16); x10.w = __uint_as_float(xb1.y & 0xffff0000u);
                x11.x = __uint_as_float(xb1.z << 16); x11.y = __uint_as_float(xb1.z & 0xffff0000u); x11.z = __uint_as_float(xb1.w << 16); x11.w = __uint_as_float(xb1.w & 0xffff0000u);
                const f32x4 n00 = x00 + gv[0][0] * acc[ai][0][m][0], n01 = x01 + gv[0][1] * acc[ai][0][m][1], n10 = x10 + gv[1][0] * acc[ai][1][m][0], n11 = x11 + gv[1][1] * acc[ai][1][m][1];
                float sv = (((n00.x * n00.x + n00.y * n00.y) + (n00.z * n00.z + n00.w * n00.w)) + ((n01.x * n01.x + n01.y * n01.y) + (n01.z * n01.z + n01.w * n01.w)))
                         + (((n10.x * n10.x + n10.y * n10.y) + (n10.z * n10.z + n10.w * n10.w)) + ((n11.x * n11.x + n11.y * n11.y) + (n11.z * n11.z + n11.w * n11.w)));
                const size_t ro = (size_t)(rowb + ai * HALF + m * 16) * D + colw;
                store_wide<false>(x16 + ro, D, fr, fq, pack8(n00, n01), pack8(n10, n11));
                store_wide<false>(xa + ro, D, fr, fq, pack8(n00 * avv[0][0], n01 * avv[0][1]), pack8(n10 * avv[1][0], n11 * avv[1][1]));
                sv = xor32_sum(xor16_sum(sv));
                if (fq == 0) ssqp[(size_t)(rowb + ai * HALF + m * 16 + fr) * 16 + u.pn * 4 + wc] = sv;
            }
        }
#undef ERN_LOAD
    }
};
struct EpiProjNorm {
    static constexpr bool PERM = true, WIDE = true;
    bf16_t* O; const LAS float* RS; const float* cv; float* BG; const float* a_log; const float* dt_bias;
    __device__ __forceinline__ void operator()(const f32x4 (&acc)[2][2][4][2], const Unit& u, int wr, int wc, int fr, int fq) const {
        const int rl0 = wr * 64 + fr, colw = u.pn * BM + wc * 64, b = (u.pm * BM) / SEQ;
        const float* cp = cv + (size_t)b * NPW + colw + 8 * fq;
        if (u.pn < NP / BM) {
            f32x4 c4[2][2];
#pragma unroll
            for (int bj = 0; bj < 2; ++bj)
#pragma unroll
                for (int n = 0; n < 2; ++n) c4[bj][n] = *(const f32x4*)(cp + 32 * bj + 4 * n);
            bf16_t* base = O + (size_t)(u.pm * BM + wr * 64) * NP + colw;
#pragma unroll
            for (int ai = 0; ai < 2; ++ai)
#pragma unroll
                for (int m = 0; m < 4; ++m) { const float rs = fabsf(RS[u.ord * 256 + rl0 + ai * HALF + m * 16]);
                    store_wide(base + (size_t)(ai * HALF + m * 16) * NP, NP, fr, fq, pack8(acc[ai][0][m][0] * rs + c4[0][0], acc[ai][0][m][1] * rs + c4[0][1]), pack8(acc[ai][1][m][0] * rs + c4[1][0], acc[ai][1][m][1] * rs + c4[1][1])); }
        } else if (wc == 0 && fq == 0) {
            const f32x4 c0 = *(const f32x4*)(cp), c1 = *(const f32x4*)(cp + 4);
            const f32x4 al = *(const f32x4*)a_log, db = *(const f32x4*)dt_bias;
#pragma unroll
            for (int ai = 0; ai < 2; ++ai)
#pragma unroll
                for (int m = 0; m < 4; ++m) { const int rl = rl0 + ai * HALF + m * 16; const float rs = fabsf(RS[u.ord * 256 + rl]);
                    const f32x4 vb = acc[ai][0][m][0] * rs + c0, va = acc[ai][0][m][1] * rs + c1;
                    f32x4 be, gg;
#pragma unroll
                    for (int hh = 0; hh < 4; ++hh) { be[hh] = sigmoidf_(vb[hh]); gg[hh] = -__expf(al[hh]) * softplusf_(va[hh] + db[hh]); }
                    float* bg = BG + (size_t)(u.pm * BM + rl) * 8; *(f32x4*)bg = be; *(f32x4*)(bg + 4) = gg; }
        }
    }
};
struct EpiNull {
    static constexpr bool PERM = true, WIDE = false;
    __device__ __forceinline__ void operator()(const f32x4 (&acc)[2][2][4][2], const Unit& u, int wr, int wc, int fr, int fq) const {
#pragma unroll
        for (int ai = 0; ai < 2; ++ai)
#pragma unroll
            for (int bj = 0; bj < 2; ++bj)
#pragma unroll
                for (int m = 0; m < 4; ++m)
#pragma unroll
                    for (int n = 0; n < 2; ++n) asm volatile("" :: "v"(acc[ai][bj][m][n]));
    }
};
struct EpiSwiGLUNorm {
    static constexpr bool PERM = true, WIDE = false;
    bf16_t* O; int ldc; int nmod; const LAS float* RS; const float* cv; int ncv;
    __device__ __forceinline__ void operator()(const f32x4 (&acc)[2][2][4][2], const Unit& u, int wr, int wc, int fr, int fq) const {
        const int rl0 = wr * 64 + fr, col0 = (u.pn % nmod) * HALF + wc * 32 + 8 * fq;
        const float* cp = cv + (size_t)u.pn * BM + wc * 32 + 8 * fq;
        f32x4 cg[2][2], cu[2][2];
#pragma unroll
        for (int bb = 0; bb < 2; ++bb)
#pragma unroll
            for (int n = 0; n < 2; ++n) { cg[bb][n] = *(const f32x4*)(cp + (size_t)bb * ncv + 4 * n); cu[bb][n] = *(const f32x4*)(cp + (size_t)bb * ncv + HALF + 4 * n); }
#pragma unroll
        for (int ai = 0; ai < 2; ++ai)
#pragma unroll
            for (int m = 0; m < 4; ++m) { const int rl = rl0 + ai * HALF + m * 16; const float rsv = RS[u.ord * 256 + rl], rs = fabsf(rsv); const bool b1 = rsv < 0.f;
                const f32x4 g0 = acc[ai][0][m][0] * rs + (b1 ? cg[1][0] : cg[0][0]), g1 = acc[ai][0][m][1] * rs + (b1 ? cg[1][1] : cg[0][1]);
                const f32x4 u0 = acc[ai][1][m][0] * rs + (b1 ? cu[1][0] : cu[0][0]), u1 = acc[ai][1][m][1] * rs + (b1 ? cu[1][1] : cu[0][1]);
                u32x4 w;
                w.x = cvt_pk_bf16(fast_silu(g0[0]) * u0[0], fast_silu(g0[1]) * u0[1]); w.y = cvt_pk_bf16(fast_silu(g0[2]) * u0[2], fast_silu(g0[3]) * u0[3]);
                w.z = cvt_pk_bf16(fast_silu(g1[0]) * u1[0], fast_silu(g1[1]) * u1[1]); w.w = cvt_pk_bf16(fast_silu(g1[2]) * u1[2], fast_silu(g1[3]) * u1[3]);
                __builtin_nontemporal_store(w, (u32x4*)(O + (size_t)(u.pm * BM + rl) * ldc + col0)); }
    }
};

template <class Epi, class Sched, bool GATHER, bool ALIGN_EPI, bool SP2>
__device__ __forceinline__ void gemm_phase(LAS unsigned char* lds, const LAS int* RI, const Gemm g, const Sched& S, const Epi& E) {
    const int tid = threadIdx.x, wid = __builtin_amdgcn_readfirstlane(tid >> 6), lane = tid & 63, wr = wid >> 2, wc = wid & 3, fr = lane & 15, fq = lane >> 4;
    const int K = g.K, nt = K / BK;
    unsigned voffB[2]; int Ra[2]; unsigned Ca2[2];
#pragma unroll
    for (int i = 0; i < 2; ++i) { int R, C; stage_rc(tid * 16 + i * 8192, R, C); const int Rb = Epi::WIDE ? ((R >> 5) * 64 + perm32(R & 31)) : (Epi::PERM ? ((R & ~31) + perm32(R & 31)) : R);
        Ra[i] = R; Ca2[i] = (unsigned)C * 2u; voffB[i] = (unsigned)(Rb * K + C) * 2u; }
    const size_t kstep = (size_t)(BK * 2);
    const size_t hstep = (size_t)HALF * K * 2;
    const size_t tstep = 2 * hstep;
    const size_t hstepB = Epi::WIDE ? (size_t)32 * K * 2 : hstep;
    const unsigned rowb = (unsigned)K * 2u;
    const unsigned ldsw = (unsigned)wid * 1024u;
    const int aoff = lds_byte(wr * 64 + fr, fq * 8), boff = lds_byte(wc * 32 + fr, fq * 8);
#define PG8_SA(b, h) (((b) * 2 + (h)) * HTB)
#define PG8_SB(b, h) ((4 + (b) * 2 + (h)) * HTB)
#define PG8_STAGE_B(bufoff, gbase) do { _Pragma("unroll") for (int _i = 0; _i < 2; ++_i) \
        __builtin_amdgcn_global_load_lds((const unsigned*)((const char*)(gbase) + voffB[_i]), (LAS unsigned*)(lds + (bufoff) + ldsw + _i * 8192), 16, 0, 0); } while (0)
#define PG8_STAGE_A(bufoff, kb, off) do { _Pragma("unroll") for (int _i = 0; _i < 2; ++_i) \
        __builtin_amdgcn_global_load_lds((const unsigned*)((const char*)g.A + (size_t)(kb) + (off)[_i]), (LAS unsigned*)(lds + (bufoff) + ldsw + _i * 8192), 16, 0, 0); } while (0)
#define PG8_LDA(dst, b, h) do { _Pragma("unroll") for (int m = 0; m < 4; ++m) _Pragma("unroll") for (int k = 0; k < 2; ++k) dst[m][k] = *(const LAS bf16x8*)(lds + PG8_SA(b, h) + aoff + m * 2048 + k * 1024); } while (0)
#define PG8_LDB(dst, b, h) do { _Pragma("unroll") for (int n = 0; n < 2; ++n) _Pragma("unroll") for (int k = 0; k < 2; ++k) dst[n][k] = *(const LAS bf16x8*)(lds + PG8_SB(b, h) + boff + n * 2048 + k * 1024); } while (0)
#define PG8_MMA(ai, bj, At, Bt) do { __builtin_amdgcn_s_setprio(1); _Pragma("unroll") for (int m = 0; m < 4; ++m) _Pragma("unroll") for (int n = 0; n < 2; ++n) _Pragma("unroll") for (int k = 0; k < 2; ++k) \
        acc[ai][bj][m][n] = __builtin_amdgcn_mfma_f32_16x16x32_bf16(Bt[n][k], At[m][k], acc[ai][bj][m][n], 0, 0, 0); __builtin_amdgcn_s_setprio(0); } while (0)
#define PG8_WAIT_V(n) asm volatile("s_waitcnt vmcnt(" #n ")" ::: "memory")
#define PG8_WAIT_L(n) asm volatile("s_waitcnt lgkmcnt(" #n ")" ::: "memory")
#define PG8_BAR __builtin_amdgcn_s_barrier()
#define PG8_SCHED __builtin_amdgcn_sched_barrier(0)
#define PG8_AOFFS(dst, ui_, un_) do { _Pragma("unroll") for (int _h = 0; _h < 2; ++_h) _Pragma("unroll") for (int _i = 0; _i < 2; ++_i) { \
        const unsigned _row = GATHER ? (unsigned)RI[(ui_) * 256 + _h * HALF + Ra[_i]] : (unsigned)((un_).pm * BM + _h * HALF + Ra[_i]); dst[_h][_i] = _row * rowb + Ca2[_i]; } } while (0)
    Unit cur, nxt; int ui = 0;
    if (!S.next(0, cur)) return;
    cur.ord = 0;
    f32x4 acc[2][2][4][2];
#pragma unroll
    for (int a = 0; a < 2; ++a)
#pragma unroll
        for (int b = 0; b < 2; ++b)
#pragma unroll
            for (int m = 0; m < 4; ++m)
#pragma unroll
                for (int n = 0; n < 2; ++n) acc[a][b][m][n] = (f32x4){0.f, 0.f, 0.f, 0.f};
    bf16x8 At[4][2], B0[2][2], B1[2][2];
    unsigned cv[2][2], nv[2][2];
    PG8_AOFFS(cv, 0, cur);
    const char* cB = (const char*)g.Bt + (size_t)cur.pn * tstep;
    if constexpr (SP2) {
        PG8_STAGE_B(PG8_SB(0, 0), cB); PG8_STAGE_B(PG8_SB(0, 1), cB + hstepB); PG8_STAGE_A(PG8_SA(0, 0), 0, cv[0]); PG8_STAGE_A(PG8_SA(0, 1), 0, cv[1]);
        if (wr == 1) PG8_BAR;
        PG8_WAIT_V(2); PG8_BAR;
        PG8_STAGE_B(PG8_SB(1, 0), cB + kstep); PG8_STAGE_A(PG8_SA(1, 0), kstep, cv[0]); PG8_STAGE_B(PG8_SB(1, 1), cB + hstepB + kstep);
        PG8_WAIT_V(6); PG8_BAR;
    } else {
        PG8_STAGE_B(PG8_SB(0, 0), cB); PG8_STAGE_A(PG8_SA(0, 0), 0, cv[0]); PG8_STAGE_B(PG8_SB(0, 1), cB + hstepB); PG8_STAGE_A(PG8_SA(0, 1), 0, cv[1]);
        if (wr == 1) PG8_BAR;
        PG8_WAIT_V(4); PG8_BAR;
        PG8_STAGE_B(PG8_SB(1, 0), cB + kstep); PG8_STAGE_A(PG8_SA(1, 0), kstep, cv[0]); PG8_STAGE_B(PG8_SB(1, 1), cB + hstepB + kstep);
        PG8_WAIT_V(6); PG8_BAR;
    }
    for (;;) {
        const bool has_next = S.next(ui + 1, nxt); nxt.ord = ui + 1;
        const char* nB = has_next ? (const char*)g.Bt + (size_t)nxt.pn * tstep : cB;
        if (has_next) { PG8_AOFFS(nv, ui + 1, nxt); }
        else {
#pragma unroll
            for (int h = 0; h < 2; ++h)
#pragma unroll
                for (int i = 0; i < 2; ++i) nv[h][i] = cv[h][i]; }
        for (int t = 0; t < nt; t += 2) {
            const bool last = (t == nt - 2);
            const size_t kb1 = (size_t)(t + 1) * kstep, kb2 = last ? (size_t)0 : (size_t)(t + 2) * kstep, kb3 = kb2 + kstep;
            const char* b2 = last ? nB : cB + (size_t)(t + 2) * kstep; const char* b3 = b2 + kstep;
            unsigned o2[2][2];
#pragma unroll
            for (int h = 0; h < 2; ++h)
#pragma unroll
                for (int i = 0; i < 2; ++i) o2[h][i] = last ? nv[h][i] : cv[h][i];
            if constexpr (SP2) {
            PG8_LDB(B0, 0, 0); PG8_LDB(B1, 0, 1); PG8_SCHED; PG8_LDA(At, 0, 0); PG8_STAGE_A(PG8_SA(1, 1), kb1, cv[1]);
            PG8_WAIT_V(8); PG8_WAIT_L(0); PG8_BAR; PG8_MMA(0, 0, At, B0); PG8_MMA(0, 1, At, B1); PG8_BAR; PG8_SCHED;
            PG8_LDA(At, 0, 1); PG8_STAGE_B(PG8_SB(0, 0), b2); PG8_STAGE_B(PG8_SB(0, 1), b2 + hstepB); PG8_STAGE_A(PG8_SA(0, 0), kb2, o2[0]);
            PG8_WAIT_V(8); PG8_WAIT_L(0); PG8_BAR; PG8_MMA(1, 0, At, B0); PG8_MMA(1, 1, At, B1); PG8_BAR; PG8_SCHED;
            PG8_LDB(B0, 1, 0); PG8_LDB(B1, 1, 1); PG8_SCHED; PG8_LDA(At, 1, 0); PG8_STAGE_A(PG8_SA(0, 1), kb2, o2[1]);
            PG8_WAIT_V(8); PG8_WAIT_L(0); PG8_BAR; PG8_MMA(0, 0, At, B0); PG8_MMA(0, 1, At, B1); PG8_BAR; PG8_SCHED;
            PG8_LDA(At, 1, 1); PG8_STAGE_B(PG8_SB(1, 0), b3); PG8_STAGE_B(PG8_SB(1, 1), b3 + hstepB); PG8_STAGE_A(PG8_SA(1, 0), kb3, o2[0]);
            PG8_WAIT_V(8); PG8_WAIT_L(0); PG8_BAR; PG8_MMA(1, 0, At, B0); PG8_MMA(1, 1, At, B1); PG8_BAR; PG8_SCHED;
            } else {
            PG8_LDB(B0, 0, 0); PG8_SCHED; PG8_LDA(At, 0, 0); PG8_STAGE_A(PG8_SA(1, 1), kb1, cv[1]);
            PG8_WAIT_L(8); PG8_BAR; PG8_WAIT_L(0); PG8_MMA(0, 0, At, B0); PG8_BAR; PG8_SCHED;
            PG8_LDB(B1, 0, 1); PG8_STAGE_B(PG8_SB(0, 0), b2);
            PG8_BAR; PG8_WAIT_L(0); PG8_MMA(0, 1, At, B1); PG8_BAR;
            PG8_LDA(At, 0, 1); PG8_STAGE_A(PG8_SA(0, 0), kb2, o2[0]);
            PG8_BAR; PG8_WAIT_L(0); PG8_MMA(1, 0, At, B0); PG8_BAR; PG8_SCHED;
            PG8_STAGE_B(PG8_SB(0, 1), b2 + hstepB);
            PG8_WAIT_V(6); PG8_BAR; PG8_MMA(1, 1, At, B1); PG8_BAR;
            PG8_LDB(B0, 1, 0); PG8_SCHED; PG8_LDA(At, 1, 0); PG8_STAGE_A(PG8_SA(0, 1), kb2, o2[1]);
            PG8_WAIT_L(8); PG8_BAR; PG8_WAIT_L(0); PG8_MMA(0, 0, At, B0); PG8_BAR; PG8_SCHED;
            PG8_LDB(B1, 1, 1); PG8_STAGE_B(PG8_SB(1, 0), b3);
            PG8_BAR; PG8_WAIT_L(0); PG8_MMA(0, 1, At, B1); PG8_BAR;
            PG8_LDA(At, 1, 1); PG8_STAGE_A(PG8_SA(1, 0), kb3, o2[0]);
            PG8_BAR; PG8_WAIT_L(0); PG8_MMA(1, 0, At, B0); PG8_BAR; PG8_SCHED;
            PG8_STAGE_B(PG8_SB(1, 1), b3 + hstepB);
            PG8_WAIT_V(6); PG8_BAR; PG8_MMA(1, 1, At, B1); PG8_BAR;
            }
        }
        if constexpr (ALIGN_EPI) { if (wr == 0) PG8_BAR; }
        E(acc, cur, wr, wc, fr, fq);
        if (!has_next) break;
#pragma unroll
        for (int a = 0; a < 2; ++a)
#pragma unroll
            for (int b = 0; b < 2; ++b)
#pragma unroll
                for (int m = 0; m < 4; ++m)
#pragma unroll
                    for (int n = 0; n < 2; ++n) acc[a][b][m][n] = (f32x4){0.f, 0.f, 0.f, 0.f};
        cur = nxt; cB = nB; ++ui;
#pragma unroll
        for (int h = 0; h < 2; ++h)
#pragma unroll
            for (int i = 0; i < 2; ++i) cv[h][i] = nv[h][i];
        if constexpr (ALIGN_EPI) { if (wr == 1) PG8_BAR; }
    }
    PG8_WAIT_V(0);
    if constexpr (!ALIGN_EPI) { if (wr == 0) PG8_BAR; }
    PG8_BAR;
#undef PG8_SA
#undef PG8_SB
#undef PG8_STAGE_A
#undef PG8_STAGE_B
#undef PG8_LDA
#undef PG8_LDB
#undef PG8_MMA
#undef PG8_WAIT_V
#undef PG8_WAIT_L
#undef PG8_BAR
#undef PG8_SCHED
#undef PG8_AOFFS
}
}

__device__ __forceinline__ void transpose_item(const float* W, int pitch, int k0, int n0, bf16_t* WT, int Kd, int drow0, LAS float* scr, int lane) {
#pragma unroll 8
    for (int i = 0; i < 32; ++i) { const int kk = 2 * i + (lane >> 5); scr[kk * 33 + (lane & 31)] = __builtin_nontemporal_load(W + (size_t)(k0 + kk) * pitch + n0 + (lane & 31)); }
    asm volatile("s_waitcnt lgkmcnt(0)" ::: "memory");
    const int c = lane & 7;
#pragma unroll
    for (int j = 0; j < 4; ++j) { const int n = (lane >> 3) + 8 * j; const LAS float* s = scr + (8 * c) * 33 + n;
        u32x4 o; o.x = pk2(s[0 * 33], s[1 * 33]); o.y = pk2(s[2 * 33], s[3 * 33]); o.z = pk2(s[4 * 33], s[5 * 33]); o.w = pk2(s[6 * 33], s[7 * 33]);
        *(u32x4*)(WT + (size_t)(drow0 + n) * Kd + k0 + 8 * c) = o; }
    asm volatile("s_waitcnt lgkmcnt(0)" ::: "memory");
}
constexpr size_t WT_WIN = 0, WT_WOUT = WT_WIN + (size_t)2 * NPW * D, WT_FGU = WT_WOUT + (size_t)2 * D * D, WT_FD = WT_FGU + (size_t)2 * D_FF * D,
                 WT_MGU = WT_FD + (size_t)D * D_FF, WT_MD = WT_MGU + (size_t)NE * 2 * D_FFE * D, WT_END = WT_MD + (size_t)NE * D * D_FFE;
static_assert(WT_END * 2 <= 80 * MiB, "weight copies fit");
__device__ __forceinline__ void ph_pro_weights(const Args& a, Frame& F) {
    LAS float* scr = (LAS float*)(F.lds + F.wave * 16384);
    bf16_t* WT = (bf16_t*)(F.ws + WS_WT);
    constexpr int I_IN0 = 16 * 48, I_IN1 = 16 * 24, I_OUT = 16 * 32, I_FG = 16 * 88, I_FD = 44 * 32, I_M = 16 * 32;
    constexpr int NITEMS = 2 * (I_IN0 + I_IN1 + I_OUT) + 2 * I_FG + I_FD + 24 * I_M;
    for (int it = F.gw; it < NITEMS; it += F.ngw) {
        int r = it; const float* src; int pitch, k0, n0, Kd, drow0; bf16_t* dst;
        if (r < 2 * I_IN0) { const int l = r / I_IN0; r %= I_IN0; src = a.w_in + (size_t)l * D * N_IN; pitch = N_IN; k0 = (r / 48) * 64; n0 = (r % 48) * 32; dst = WT + WT_WIN + (size_t)l * NPW * D; Kd = D; drow0 = n0; }
        else if ((r -= 2 * I_IN0) < 2 * I_IN1) { const int l = r / I_IN1; r %= I_IN1; src = a.w_in + (size_t)l * D * N_IN + 1544; pitch = N_IN; k0 = (r / 24) * 64; n0 = (r % 24) * 32; dst = WT + WT_WIN + (size_t)l * NPW * D; Kd = D; drow0 = 1536 + n0; }
        else if ((r -= 2 * I_IN1) < 2 * I_OUT) { const int l = r / I_OUT; r %= I_OUT; src = a.w_out + (size_t)l * D * D; pitch = D; k0 = (r / 32) * 64; n0 = (r % 32) * 32; dst = WT + WT_WOUT + (size_t)l * D * D; Kd = D; drow0 = n0; }
        else if ((r -= 2 * I_OUT) < 2 * I_FG) { const int up = r / I_FG; r %= I_FG; src = up ? a.ffn_wu : a.ffn_wg; pitch = D_FF; k0 = (r / 88) * 64; n0 = (r % 88) * 32; dst = WT + WT_FGU; Kd = D; drow0 = (n0 / 128) * 256 + up * 128 + (n0 % 128); }
        else if ((r -= 2 * I_FG) < I_FD) { src = a.ffn_wd; pitch = D; k0 = (r / 32) * 64; n0 = (r % 32) * 32; dst = WT + WT_FD; Kd = D_FF; drow0 = n0; }
        else if ((r -= I_FD) < 16 * I_M) { const int e = r / (2 * I_M); r %= 2 * I_M; const int up = r / I_M; r %= I_M; src = (up ? a.moe_wu : a.moe_wg) + (size_t)e * D * D_FFE; pitch = D_FFE; k0 = (r / 32) * 64; n0 = (r % 32) * 32;
            dst = WT + WT_MGU + (size_t)e * 2 * D_FFE * D; Kd = D; drow0 = (n0 / 128) * 256 + up * 128 + (n0 % 128); }
        else { r -= 16 * I_M; const int e = r / I_M; r %= I_M; src = a.moe_wd + (size_t)e * D_FFE * D; pitch = D; k0 = (r / 32) * 64; n0 = (r % 32) * 32; dst = WT + WT_MD + (size_t)e * D * D_FFE; Kd = D_FFE; drow0 = n0; }
        transpose_item(src, pitch, k0, n0, dst, Kd, drow0, scr, F.lane);
    }
    for (int idx = F.bid * NTHREADS + F.tid; idx < 2 * 256 * D; idx += F.nb * NTHREADS) {
        const int l = idx / (256 * D), r = (idx / D) % 256, k = idx % D;
        WT[WT_WIN + (size_t)l * NPW * D + (size_t)(2304 + r) * D + k] = (r < 8) ? (bf16_t)f2bf(a.w_in[(size_t)l * D * N_IN + (size_t)k * N_IN + W_DB + r]) : (bf16_t)0;
    }
}

template <int NT> __device__ __forceinline__ void moe_order_init(Frame& F, pg8::MoeOrder<NT>& S) {
    const unsigned* c = (const unsigned*)(F.ws + WS_CTL) + CW_MOECNT;
    int acc = 0;
#pragma unroll
    for (int e = 0; e < 8; ++e) { S.cnt[e] = (int)__hip_atomic_load(c + 64 * e, __ATOMIC_RELAXED, __HIP_MEMORY_SCOPE_AGENT); S.bt[e] = acc; acc += (S.cnt[e] + 255) >> 8; }
    S.bt[8] = acc; S.G = F.nb; S.c = F.bid;
}
template <int NT> __device__ __forceinline__ int moe_ri_one(Frame& F, const pg8::MoeOrder<NT>& S, const int* RM, int o, int t) {
    pg8::Unit u; if (!S.next(o, u)) return -1;
    const int e = u.pn / NT; int bte = 0, cne = 0;
#pragma unroll
    for (int kk = 0; kk < 8; ++kk) { if (kk == e) { bte = S.bt[kk]; cne = S.cnt[kk]; } }
    const int sl = (u.pm - bte) * 256 + t; return (sl < cne) ? RM[(size_t)e * T + sl] : 0;
}
template <int NT> __device__ __forceinline__ void moe_ri_preload(Frame& F, const pg8::MoeOrder<NT>& S) {
    LAS int* RI = (LAS int*)(F.lds + RI_OFF); const int* RM = (const int*)(F.ws + WS_RMAP);
    const int t = F.tid & 255, par = F.tid >> 8;
    const int v0 = moe_ri_one<NT>(F, S, RM, par, t), v1 = moe_ri_one<NT>(F, S, RM, par + 2, t), v2 = moe_ri_one<NT>(F, S, RM, par + 4, t), v3 = moe_ri_one<NT>(F, S, RM, par + 6, t);
    const int v4 = moe_ri_one<NT>(F, S, RM, par + 8, t), v5 = moe_ri_one<NT>(F, S, RM, par + 10, t), v6 = moe_ri_one<NT>(F, S, RM, par + 12, t), v7 = moe_ri_one<NT>(F, S, RM, par + 14, t);
    if (v0 >= 0) RI[(par) * 256 + t] = v0; if (v1 >= 0) RI[(par + 2) * 256 + t] = v1; if (v2 >= 0) RI[(par + 4) * 256 + t] = v2; if (v3 >= 0) RI[(par + 6) * 256 + t] = v3;
    if (v4 >= 0) RI[(par + 8) * 256 + t] = v4; if (v5 >= 0) RI[(par + 10) * 256 + t] = v5; if (v6 >= 0) RI[(par + 12) * 256 + t] = v6;
    if (v7 >= 0 && par + 14 < 15) RI[(par + 14) * 256 + t] = v7;
    __syncthreads();
}

__device__ __forceinline__ void ph_norm0(const Args& a, Frame& F) {
    const float* MOD = (const float*)(F.ws + WS_MOD);
    bf16_t* XA = (bf16_t*)(F.ws + WS_H); bf16_t* X16 = (bf16_t*)(F.ws + WS_X16); float* SSQ = (float*)(F.ws + WS_SSQ) + (size_t)3 * T * 16;
    f32x4 vn[4], A4[4]; int cur_b = -1;
#define N0_LOAD(row_) { const f32x4* p_ = (const f32x4*)(a.x + (size_t)(row_) * D) + 2 * F.lane; vn[0] = __builtin_nontemporal_load(p_); vn[1] = __builtin_nontemporal_load(p_ + 1); vn[2] = __builtin_nontemporal_load(p_ + 128); vn[3] = __builtin_nontemporal_load(p_ + 129); }
    if (F.gw < T) N0_LOAD(F.gw)
    for (int row = F.gw; row < T; row += F.ngw) {
        const int b = row / SEQ;
        f32x4 v[4]; float ss = 0.f;
#pragma unroll
        for (int j = 0; j < 4; ++j) { v[j] = vn[j]; ss += (v[j].x * v[j].x + v[j].y * v[j].y) + (v[j].z * v[j].z + v[j].w * v[j].w); }
        if (row + F.ngw < T) N0_LOAD(row + F.ngw)
        if (b != cur_b) { cur_b = b;
#pragma unroll
            for (int j = 0; j < 4; ++j) { const int d = 512 * (j >> 1) + 8 * F.lane + 4 * (j & 1); A4[j] = *(const f32x4*)(a.nmg + d) * (*(const f32x4*)(MOD + (size_t)b * 3072 + 1024 + d) + 1.0f); } }
#pragma unroll
        for (int jj = 0; jj < 2; ++jj) {
            const int d = 512 * jj + 8 * F.lane; const f32x4 v0 = v[2 * jj], v1 = v[2 * jj + 1], s0 = v0 * A4[2 * jj], s1 = v1 * A4[2 * jj + 1];
            u32x4 o; o.x = pk2(v0.x, v0.y); o.y = pk2(v0.z, v0.w); o.z = pk2(v1.x, v1.y); o.w = pk2(v1.z, v1.w); *(u32x4*)(X16 + (size_t)row * D + d) = o;
            u32x4 p; p.x = pk2(s0.x, s0.y); p.y = pk2(s0.z, s0.w); p.z = pk2(s1.x, s1.y); p.w = pk2(s1.z, s1.w); *(u32x4*)(XA + (size_t)row * D + d) = p;
        }
        ss = wave_sum(ss);
        if (F.lane < 16) SSQ[(size_t)row * 16 + F.lane] = (F.lane == 0) ? ss : 0.f;
    }
#undef N0_LOAD
}
__device__ __forceinline__ void ph_prep_vectors(const Args& a, Frame& F) {
    const float* MOD = (const float*)(F.ws + WS_MOD); float* AV = (float*)(F.ws + WS_AV);
    for (int idx = F.bid * NTHREADS + F.tid; idx < 3 * BATCH * D; idx += F.nb * NTHREADS) {
        const int inst = idx / (BATCH * D), b = (idx / D) % BATCH, d = idx % D;
        const int lk = (inst == 0) ? 1 : (inst == 1 ? 2 : 3);
        const float gn = (inst == 0) ? a.nfg[d] : (inst == 1 ? a.nmg[D + d] : a.nfg[D + d]);
        AV[idx] = gn * (1.0f + MOD[((size_t)lk * 2 + b) * 3072 + 1024 + d]);
    }
    const bf16_t* WT = (const bf16_t*)(F.ws + WS_WT);
    constexpr int NR = 5632 + NPW + 16384 + NPW;
    LAS float* SH = (LAS float*)F.lds;
    for (int i = F.tid; i < 4 * BATCH * D; i += NTHREADS) { const int which = i / (BATCH * D), b = (i / D) % BATCH, d = i % D; SH[i] = MOD[((size_t)((which + 1) & 3) * 2 + b) * 3072 + d]; }
    __syncthreads();
    for (int g8 = F.gw; g8 < NR / 8; g8 += F.ngw) {
        const int row = g8 * 8 + (F.lane >> 3), part = F.lane & 7;
        int which, r; const bf16_t* wrow; float* out; int ncv;
        if (row < 5632) { which = 0; r = row; wrow = WT + WT_FGU + (size_t)r * D; out = (float*)(F.ws + WS_CVF); ncv = 5632; }
        else if (row < 5632 + NPW) { which = 1; r = row - 5632; wrow = WT + WT_WIN + (size_t)NPW * D + (size_t)r * D; out = (float*)(F.ws + WS_CVI); ncv = NPW; }
        else if (row < 5632 + NPW + 16384) { which = 2; r = row - 5632 - NPW; wrow = WT + WT_MGU + (size_t)r * D; out = (float*)(F.ws + WS_CVM); ncv = 16384; }
        else { which = 3; r = row - 5632 - NPW - 16384; wrow = WT + WT_WIN + (size_t)r * D; out = (float*)(F.ws + WS_CVI0); ncv = NPW; }
        u32x4 wv[16];
#pragma unroll
        for (int j = 0; j < 16; ++j) wv[j] = *(const u32x4*)(wrow + 128 * part + 8 * j);
        const LAS float* s0p = SH + (which * 2 + 0) * 1024 + 128 * part; const LAS float* s1p = s0p + 1024;
        float s0 = 0.f, s1 = 0.f;
#pragma unroll
        for (int j = 0; j < 16; ++j) {
            const f32x4 a0 = *(const LAS f32x4*)(s0p + 8 * j), a1 = *(const LAS f32x4*)(s0p + 8 * j + 4), b0 = *(const LAS f32x4*)(s1p + 8 * j), b1 = *(const LAS f32x4*)(s1p + 8 * j + 4);
            const float x0 = bf2f(wv[j].x & 0xffffu), x1 = bf2f(wv[j].x >> 16), x2 = bf2f(wv[j].y & 0xffffu), x3 = bf2f(wv[j].y >> 16), x4 = bf2f(wv[j].z & 0xffffu), x5 = bf2f(wv[j].z >> 16), x6 = bf2f(wv[j].w & 0xffffu), x7 = bf2f(wv[j].w >> 16);
            s0 += ((x0 * a0.x + x1 * a0.y) + (x2 * a0.z + x3 * a0.w)) + ((x4 * a1.x + x5 * a1.y) + (x6 * a1.z + x7 * a1.w));
            s1 += ((x0 * b0.x + x1 * b0.y) + (x2 * b0.z + x3 * b0.w)) + ((x4 * b1.x + x5 * b1.y) + (x6 * b1.z + x7 * b1.w));
        }
        s0 += __shfl_xor(s0, 1); s0 += __shfl_xor(s0, 2); s0 += __shfl_xor(s0, 4);
        s1 += __shfl_xor(s1, 1); s1 += __shfl_xor(s1, 2); s1 += __shfl_xor(s1, 4);
        if (part == 0) { out[r] = s0; out[ncv + r] = s1; }
    }
    __syncthreads();
    if (F.gw < BATCH * 8) {
        const int b = F.gw >> 3, e = F.gw & 7; float sacc = 0.f;
        for (int d = F.lane; d < D; d += 64) sacc += MOD[((size_t)3 * 2 + b) * 3072 + d] * a.router_w[(size_t)d * NE + e];
        sacc = wave_sum(sacc);
        if (F.lane == 0) ((float*)(F.ws + WS_CR))[b * 8 + e] = sacc;
    }
}
template <class Sched> __device__ __forceinline__ int count_units(const Sched& S) { int n = 0; pg8::Unit u; while (n < 16 && S.next(n, u)) ++n; return n; }
template <class Sched> __device__ __forceinline__ void rstd_preload(Frame& F, const Sched& S, const float* ssqp, const LAS int* RI) {
    LAS float* RS = (LAS float*)(F.lds + RS_OFF);
    const int t = F.tid & 255, par = F.tid >> 8, nu = count_units(S);
#pragma unroll
    for (int k0 = 0; k0 < 8; k0 += 4) {
        f32x4 p0[4], p1[4], p2[4], p3[4]; int r0, r1, r2, r3;
#define RSP_LOAD(k, pk, rk) { const int o = par + 2 * (k0 + k); pg8::Unit u; u.pm = 0; rk = 0; if (o < nu) { S.next(o, u); rk = RI ? RI[o * 256 + t] : u.pm * 256 + t; } \
            const f32x4* q = (const f32x4*)(ssqp + (size_t)rk * 16); pk[0] = q[0]; pk[1] = q[1]; pk[2] = q[2]; pk[3] = q[3]; }
        RSP_LOAD(0, p0, r0) RSP_LOAD(1, p1, r1) RSP_LOAD(2, p2, r2) RSP_LOAD(3, p3, r3)
#undef RSP_LOAD
#define RSP_STORE(k, pk, rk) { const int o = par + 2 * (k0 + k); if (o < nu) { const f32x4 s4 = (pk[0] + pk[1]) + (pk[2] + pk[3]); \
            const float rs = rsqrtf(((s4.x + s4.y) + (s4.z + s4.w)) * (1.0f / D) + EPS); RS[o * 256 + t] = (rk >= SEQ) ? -rs : rs; } }
        RSP_STORE(0, p0, r0) RSP_STORE(1, p1, r1) RSP_STORE(2, p2, r2) RSP_STORE(3, p3, r3)
#undef RSP_STORE
    }
    __syncthreads();
}
__device__ __forceinline__ void ph_router(const Args& a, Frame& F) {
    const bf16_t* XA = (const bf16_t*)(F.ws + WS_H); const float* SSQ = (const float*)(F.ws + WS_SSQ) + (size_t)2 * T * 16; const float* CR = (const float*)(F.ws + WS_CR);
    constexpr int RW = 1032;
    LAS bf16_t* WH = (LAS bf16_t*)F.lds; LAS bf16_t* WL = WH + 16 * RW; LAS float* LG = (LAS float*)(F.lds + 2 * 16 * RW * 2) + F.wave * 256;
    for (int i = F.tid; i < 16 * 1024; i += NTHREADS) { const int e = i >> 10, d = i & 1023;
        const float w = (e < 8) ? a.router_w[(size_t)d * NE + e] : 0.f; const unsigned hi = f2bf(w); const float lo = w - bf2f(hi);
        WH[e * RW + d] = (bf16_t)hi; WL[e * RW + d] = (bf16_t)f2bf(lo); }
    __syncthreads();
    const int l15 = F.lane & 15, q4 = F.lane >> 4;
    for (int r0 = F.gw * 16; r0 < T; r0 += F.ngw * 16) {
        const bf16_t* xrow = XA + (size_t)(r0 + l15) * D + 8 * q4;
        f32x4 acc = (f32x4){0.f, 0.f, 0.f, 0.f};
#pragma unroll
        for (int kb = 0; kb < 32; kb += 8) {
            bf16x8_t av[8];
#pragma unroll
            for (int k = 0; k < 8; ++k) av[k] = *(const bf16x8_t*)(xrow + 32 * (kb + k));
#pragma unroll
            for (int k = 0; k < 8; ++k) {
                const bf16x8_t bh = *(const LAS bf16x8_t*)(WH + l15 * RW + 32 * (kb + k) + 8 * q4), bl = *(const LAS bf16x8_t*)(WL + l15 * RW + 32 * (kb + k) + 8 * q4);
                acc = __builtin_amdgcn_mfma_f32_16x16x32_bf16(av[k], bh, acc, 0, 0, 0);
                acc = __builtin_amdgcn_mfma_f32_16x16x32_bf16(av[k], bl, acc, 0, 0, 0);
            }
        }
#pragma unroll
        for (int r = 0; r < 4; ++r) LG[(4 * q4 + r) * 16 + l15] = acc[r];
        if (F.lane < 16) {
            const int row = r0 + F.lane, b = row / SEQ;
            const f32x4* sp = (const f32x4*)(SSQ + (size_t)row * 16); const f32x4 s4 = (sp[0] + sp[1]) + (sp[2] + sp[3]);
            const float rstd = rsqrtf(((s4.x + s4.y) + (s4.z + s4.w)) * (1.0f / D) + EPS);
            const f32x4 l0 = *(const LAS f32x4*)(LG + F.lane * 16), l1 = *(const LAS f32x4*)(LG + F.lane * 16 + 4);
            const float dots[8] = {l0.x, l0.y, l0.z, l0.w, l1.x, l1.y, l1.z, l1.w};
            float v0 = -INFINITY, v1 = -INFINITY; int e0 = 0, e1 = 0;
#pragma unroll
            for (int e = 0; e < 8; ++e) { const float lg = rstd * dots[e] + CR[b * 8 + e] + a.router_b[e]; if (lg > v0) { v1 = v0; e1 = e0; v0 = lg; e0 = e; } else if (lg > v1) { v1 = lg; e1 = e; } }
            const float ex = __expf(v1 - v0), p0 = 1.0f / (1.0f + ex), p1 = ex / (1.0f + ex);
            unsigned* cnt = (unsigned*)(F.ws + WS_CTL) + CW_MOECNT;
            const int q0 = (int)atomicAdd(cnt + 64 * e0, 1u), q1 = (int)atomicAdd(cnt + 64 * e1, 1u);
            int* R = (int*)(F.ws + WS_ROUTE) + (size_t)row * 4; R[0] = e0; R[1] = e1; ((float*)R)[2] = p0; ((float*)R)[3] = p1;
            int* Pq = (int*)(F.ws + WS_POS) + (size_t)row * 2; Pq[0] = q0; Pq[1] = q1;
            int* RM = (int*)(F.ws + WS_RMAP); RM[(size_t)e0 * T + q0] = row; RM[(size_t)e1 * T + q1] = row;
        }
    }
    __syncthreads();
}

__global__ void __launch_bounds__(NTHREADS, 2) fwd(Args a) {
    extern __shared__ __attribute__((aligned(16))) unsigned char lds_raw[];
    Frame F;
    F.lds = (LAS unsigned char*)lds_raw;
    F.tid = threadIdx.x; F.lane = F.tid & 63; F.wave = __builtin_amdgcn_readfirstlane(F.tid >> 6);
    F.bid = blockIdx.x; F.nb = gridDim.x; F.gw = F.bid * NWAVES + F.wave; F.ngw = F.nb * NWAVES; F.ws = (GAS unsigned char*)a.ws;
    volatile LAS unsigned* MISC = (volatile LAS unsigned*)(F.lds + MISC_OFF);
    for (int u = F.tid; u < 32; u += NTHREADS) MISC[u] = 0u;
    __syncthreads();
    unsigned* ctl = (unsigned*)(a.ws + WS_CTL);
    const int lo = a.ph_lo, hi = a.ph_hi;
    const bool multi = (hi - lo) > 1;
    XcdBarrier bar; bar.bar = ctl + CW_BAR; bar.x = 0; bar.st = MISC + 8;
    if (multi) bar = xcd_barrier_post(ctl + CW_BAR, MISC + 8);
#define IN(k) (lo <= (k) && (k) < hi && (frame_refresh(F, a, (LAS unsigned char*)lds_raw), true))
#define SEAM(k) do { if (hi > (k) + 1 && lo <= (k)) { xcd_barrier(bar); if constexpr ((PROBE_MASK & 4194304) != 0) xcd_barrier(bar); } } while (0)
    float* MOD = (float*)(a.ws + WS_MOD);
    bf16_t* H = (bf16_t*)(a.ws + WS_H); bf16_t* PROJ = (bf16_t*)(a.ws + WS_PROJ); bf16_t* YMIX = (bf16_t*)(a.ws + WS_YMIX);
    bf16_t* WT = (bf16_t*)(a.ws + WS_WT);
    bf16_t* ACT = (bf16_t*)(a.ws + WS_ACT); bf16_t* ACTM = (bf16_t*)(a.ws + WS_ACTM); bf16_t* YMOE = (bf16_t*)(a.ws + WS_YMOE);

    if (IN(PH_PRO)) { REP(1) { ph_pro_vectors(a, F); ph_pro_weights(a, F); } SEAM(PH_PRO); }

#define TWICE(bit, stmt) do { stmt; if constexpr ((PROBE_MASK & (bit)) != 0) { stmt; } } while (0)
    float* AV = (float*)(a.ws + WS_AV); float* SSQ = (float*)(a.ws + WS_SSQ); bf16_t* X16 = (bf16_t*)(a.ws + WS_X16);
    const LAS float* RSL = (const LAS float*)(F.lds + RS_OFF);
#define LAYER_BODY(l) {\
        const int pb = PH_LAYER0 + PH_PER_LAYER * l; \
        const float* xin = (l == 0) ? a.x : a.out; \
        const float* mod0 = MOD + (size_t)(l * 2 + 0) * 2 * 3072; const float* mod1 = MOD + (size_t)(l * 2 + 1) * 2 * 3072; \
        if (l == 0) { if (IN(pb + K_NORM1)) { REP(2) ph_norm0(a, F); ph_prep_vectors(a, F); SEAM(pb + K_NORM1); } } \
        if (IN(pb + K_GEMM_IN)) { \
            TWICE(4, ({ pg8::Gemm g{H, WT + WT_WIN + (size_t)l * NPW * D, D}; pg8::StaticOrder S; S.init(T, NPW, F.nb, F.bid); rstd_preload(F, S, SSQ + (size_t)(l == 0 ? 3 : 1) * T * 16, nullptr); \
                pg8::EpiProjNorm E{PROJ, RSL, (const float*)(a.ws + (l == 0 ? WS_CVI0 : WS_CVI)), (float*)(a.ws + WS_BG), a.dn_a_log + 4 * l, a.dn_dt_bias + 4 * l}; \
                pg8::gemm_phase<pg8::EpiProjNorm, pg8::StaticOrder, false, true, true>(F.lds, nullptr, g, S, E); })); \
            SEAM(pb + K_GEMM_IN); \
        } \
        if (IN(pb + K_DN_PREP)) { REP(8) ph_dn_chunk(a, F, l); ph_rope(a, F); SEAM(pb + K_DN_PREP); } \
        if (IN(pb + K_MIX)) { REP(16) ph_dn_scan(a, F); REP(512) ph_attn_mfma(a, F, l); REP(1024) ph_conv_fast(a, F, l); SEAM(pb + K_MIX); } \
        if (IN(pb + K_DN_OUT)) { REP(32) ph_dn_out(a, F, l); SEAM(pb + K_DN_OUT); } \
        if (IN(pb + K_GEMM_OUT)) { \
            TWICE(0, ({ pg8::Gemm g{YMIX, WT + WT_WOUT + (size_t)l * D * D, D}; pg8::StaticOrder S; S.init(T, D, F.nb, F.bid); \
                pg8::EpiResidNorm E{X16, X16, mod0 + 2048, AV + (size_t)(l == 0 ? 0 : 2) * BATCH * D, H, SSQ + (size_t)(l == 0 ? 0 : 2) * T * 16}; \
                pg8::gemm_phase<pg8::EpiResidNorm, pg8::StaticOrder, false, true, true>(F.lds, nullptr, g, S, E); })); \
            if constexpr ((PROBE_MASK & 8388608) != 0 && l == 0) { pg8::Gemm g{YMIX, WT + WT_WOUT + (size_t)l * D * D, D}; pg8::StaticOrder S; S.init(T, D, F.nb, F.bid); pg8::EpiBf16 E{(bf16_t*)(a.ws + WS_DN_MR), D, 1 << 20}; \
                pg8::gemm_phase<pg8::EpiBf16, pg8::StaticOrder, false, true, true>(F.lds, nullptr, g, S, E); } \
            if constexpr ((PROBE_MASK & 16777216) != 0 && l == 0) { pg8::Gemm g{YMIX, WT + WT_WOUT + (size_t)l * D * D, D}; pg8::StaticOrder S; S.init(T, D, F.nb, F.bid); \
                pg8::EpiResidNorm E{X16, (bf16_t*)(a.ws + WS_DN_MR), mod0 + 2048, AV, (bf16_t*)(a.ws + WS_DN_MR), (float*)(a.ws + WS_DN_ST)}; \
                pg8::gemm_phase<pg8::EpiResidNorm, pg8::StaticOrder, false, true, true>(F.lds, nullptr, g, S, E); } \
            if constexpr ((PROBE_MASK & 131072) != 0 && l == 0) { pg8::Gemm g{YMIX, WT + WT_WOUT + (size_t)l * D * D, D}; pg8::StaticOrder S; S.init(T, D, F.nb, F.bid); pg8::EpiNull E{}; \
                pg8::gemm_phase<pg8::EpiNull, pg8::StaticOrder, false, true, true>(F.lds, nullptr, g, S, E); } \
            SEAM(pb + K_GEMM_OUT); \
        } \
        if (l == 0) { \
            if (IN(pb + K_FFN1)) { \
                TWICE(256, ({ pg8::Gemm g{H, WT + WT_FGU, D}; pg8::StaticOrder S; S.init(T, 2 * D_FF, F.nb, F.bid); rstd_preload(F, S, SSQ, nullptr); \
                    pg8::EpiSwiGLUNorm E{ACT, D_FF, 1 << 20, RSL, (const float*)(a.ws + WS_CVF), 5632}; \
                    pg8::gemm_phase<pg8::EpiSwiGLUNorm, pg8::StaticOrder, false, true, true>(F.lds, nullptr, g, S, E); })); \
                SEAM(pb + K_FFN1); \
            } \
            if (IN(pb + K_FFN2)) { \
                { pg8::Gemm g{ACT, WT + WT_FD, D_FF}; pg8::StaticOrder S; S.init(T, D, F.nb, F.bid); \
                    pg8::EpiResidNorm E{X16, X16, mod1 + 2048, AV + (size_t)1 * BATCH * D, H, SSQ + (size_t)1 * T * 16}; \
                    pg8::gemm_phase<pg8::EpiResidNorm, pg8::StaticOrder, false, true, true>(F.lds, nullptr, g, S, E); } \
                SEAM(pb + K_FFN2); \
            } \
        } else { \
            if (IN(pb + K_NORM2)) { ph_router(a, F); SEAM(pb + K_NORM2); } \
            if (IN(pb + K_FFN1)) { \
                TWICE(2048, ({ pg8::MoeOrder<8> S; moe_order_init<8>(F, S); moe_ri_preload<8>(F, S); rstd_preload(F, S, SSQ + (size_t)2 * T * 16, (const LAS int*)(F.lds + RI_OFF)); \
                    pg8::Gemm g{H, WT + WT_MGU, D}; pg8::EpiSwiGLUNorm E{ACTM, D_FFE, 8, RSL, (const float*)(a.ws + WS_CVM), 16384}; \
                    pg8::gemm_phase<pg8::EpiSwiGLUNorm, pg8::MoeOrder<8>, true, true, true>(F.lds, (const LAS int*)(F.lds + RI_OFF), g, S, E); })); \
                SEAM(pb + K_FFN1); \
            } \
            if (IN(pb + K_FFN2)) { \
                TWICE(4096, ({ pg8::MoeOrder<4> S; moe_order_init<4>(F, S); \
                    pg8::Gemm g{ACTM, WT + WT_MD, D_FFE}; pg8::EpiBf16W E{YMOE, D, 4}; \
                    pg8::gemm_phase<pg8::EpiBf16W, pg8::MoeOrder<4>, false, true, true>(F.lds, nullptr, g, S, E); })); \
                SEAM(pb + K_FFN2); \
            } \
        } \
    }
    LAYER_BODY(0)
    LAYER_BODY(1)
#undef LAYER_BODY
    if (IN(PH_FINAL)) { ph_final(a, F); }
#undef IN
#undef SEAM
}

extern "C" void kernel_launch(void* const* d_in, const int* in_sizes, int n_in, void* d_out, int out_size, void* d_ws, size_t ws_size, hipStream_t stream) {
    static int grid = 0;
    if (grid == 0) {
        if (n_in != 27 || out_size != T * D || ws_size < WS_END) { fprintf(stderr, "kernel_launch: unexpected shapes n_in %d out %d ws %zu\n", n_in, out_size, ws_size); grid = -1; return; }
        int dev = 0, cus = 0, per_cu = 0;
        if (hipGetDevice(&dev) != hipSuccess || hipDeviceGetAttribute(&cus, hipDeviceAttributeMultiprocessorCount, dev) != hipSuccess) { grid = -1; return; }
        if (hipFuncSetAttribute((const void*)fwd, hipFuncAttributeMaxDynamicSharedMemorySize, LDS_BYTES) != hipSuccess) { fprintf(stderr, "kernel_launch: hipFuncSetAttribute failed\n"); grid = -1; return; }
        if (hipOccupancyMaxActiveBlocksPerMultiprocessor(&per_cu, (const void*)fwd, NTHREADS, LDS_BYTES) != hipSuccess || per_cu < 1) fprintf(stderr, "kernel_launch: occupancy query says %d\n", per_cu);
        (void)hipGetLastError();
        grid = cus;
    }
    if (grid < 0) return;
    (void)hipMemsetAsync((char*)d_ws + WS_CTL, 0, CTL_ZERO_BYTES, stream);
    Args a{};
    const void** pp = (const void**)&a;
    for (int i = 0; i < 27; ++i) pp[i] = d_in[i];
    a.out = (float*)d_out; a.ws = (unsigned char*)d_ws;
#if MK_ONE_LAUNCH
    a.ph_lo = 0; a.ph_hi = NPH;
    hipLaunchKernelGGL(fwd, dim3(grid), dim3(NTHREADS), LDS_BYTES, stream, a);
#else
    static const int phases[] = {0, 1, 2, 3, 4, 5, 6, 7, 9, 10, 11, 12, 13, 14, 15, 16, 17, 18, 19, 20, 21};
    for (int p : phases) { a.ph_lo = p; a.ph_hi = p + 1; hipLaunchKernelGGL(fwd, dim3(grid), dim3(NTHREADS), LDS_BYTES, stream, a); }
#endif
}
```

```cpp
#include <hip/hip_runtime.h>
#include <cstdio>
#include <cstdint>

#define LAS __attribute__((address_space(3)))
#define GAS __attribute__((address_space(1)))
typedef unsigned short bf16_t;
typedef float f32x4 __attribute__((ext_vector_type(4)));
typedef unsigned u32x2 __attribute__((ext_vector_type(2)));
typedef unsigned u32x4 __attribute__((ext_vector_type(4)));

#ifndef GEMM_MASK
#define GEMM_MASK 63
#endif
#ifndef ATTN_MFMA
#define ATTN_MFMA 1
#endif
#ifndef DN_CHUNKED
#define DN_CHUNKED 1
#endif
#ifndef CONV_FAST
#define CONV_FAST 1
#endif
#ifndef PROBE_MASK
#define PROBE_MASK 0
#endif
#define REP(bit) for (int rep_ = 0; rep_ < ((PROBE_MASK & (bit)) ? 2 : 1); ++rep_)
#ifndef MK_ONE_LAUNCH
#define MK_ONE_LAUNCH 1
#endif

constexpr int BATCH = 2, SEQ = 16384, T = BATCH * SEQ, D = 1024, DEPTH = 2;
constexpr int NPW = 2560;
constexpr int N_IN = 2312, NP = 2304;
constexpr int C_AQ = 0, C_AK = 512, C_AV = 640, C_DQ = 768, C_DK = 1024, C_DV = 1280, C_DZ = 1536, C_CA = 1792, C_CB = 2048;
constexpr int W_DB = 1536;
constexpr int D_FF = 2816, NE = 8, D_FFE = 1024;
constexpr int WINDOW = 128, CV_K = 31, CV_C = 256, DN_CONV = 4;
constexpr float EPS = 1e-6f;
constexpr int NSCAN = BATCH * 4 * 4;
constexpr int MOE_CAP = 67584;

constexpr size_t MiB = 1u << 20;
constexpr size_t WS_CTL = 0, CTL_ZERO_BYTES = 1 * MiB;
constexpr size_t WS_MOD = 1 * MiB;
constexpr size_t WS_CS = 2 * MiB;
constexpr size_t WS_BG = 4 * MiB;
constexpr size_t WS_ROUTE = 5 * MiB;
constexpr size_t WS_POS = 6 * MiB;
constexpr size_t WS_RMAP = 7 * MiB;
constexpr size_t WS_WT = 8 * MiB;
constexpr size_t WS_H = 88 * MiB;
constexpr size_t WS_PROJ = 152 * MiB;
constexpr size_t WS_YMIX = 296 * MiB;
constexpr size_t WS_DNQKV = 360 * MiB;
constexpr size_t WS_ODN = 456 * MiB;
constexpr size_t WS_ACT = 152 * MiB;
constexpr size_t WS_ACTM = 152 * MiB;
constexpr size_t WS_YMOE = 284 * MiB;
constexpr size_t WS_X16 = 440 * MiB;
constexpr size_t WS_SSQ = 504 * MiB;
constexpr size_t WS_AV = WS_MOD + 128 * 1024;
constexpr size_t WS_CVF = WS_MOD + 256 * 1024;
constexpr size_t WS_CVI = WS_CVF + 2 * 5632 * 4;
constexpr size_t WS_CVM = WS_CVI + 2 * 2560 * 4;
constexpr size_t WS_CR = WS_CVM + 2 * 16384 * 4;
constexpr size_t WS_CVI0 = WS_CR + 64;
static_assert(WS_CVI0 + 2 * 2560 * 4 <= WS_CS, "vector area");
constexpr size_t WS_END = 512 * MiB;
constexpr int CW_BAR = 4096;
constexpr int CW_MOECNT = 16384;
constexpr int CW_SCANP = 20480;

constexpr int NWAVES = 8, NTHREADS = 512;
constexpr int LDS_BYTES = 163840;
constexpr int MISC_OFF = 131072 + 320;
constexpr int RI_OFF = 132096;
constexpr int RS_OFF = 147456;

constexpr int PH_PRO = 0, PH_LAYER0 = 1, PH_PER_LAYER = 10, PH_FINAL = 21, NPH = 22;
enum { K_NORM1 = 0, K_GEMM_IN, K_DN_PREP, K_MIX, K_DN_OUT, K_GEMM_OUT, K_NORM2, K_MOE_LIST, K_FFN1, K_FFN2 };

struct Args {
    const float* x; const float* c; const int* pos; const float* ada_w; const float* ada_b; const float* nmg; const float* nfg;
    const float* w_in; const float* sinks; const float* dn_conv_w; const float* dn_a_log; const float* dn_dt_bias; const float* dn_norm_g;
    const float* cv_dw_w; const float* cv_dw_b; const float* cv_ln_g; const float* cv_ln_b; const float* w_out;
    const float* ffn_wg; const float* ffn_wu; const float* ffn_wd; const float* router_w; const float* router_b;
    const float* moe_wg; const float* moe_wu; const float* moe_wd; const float* final_g;
    float* out; unsigned char* ws; int ph_lo, ph_hi;
};

__device__ __forceinline__ float bf2f(unsigned u) { return __uint_as_float(u << 16); }
__device__ __forceinline__ unsigned f2bf(float f) { unsigned u = __float_as_uint(f); return (u + 0x7fffu + ((u >> 16) & 1u)) >> 16; }
__device__ __forceinline__ unsigned pk2(float lo, float hi) { return f2bf(lo) | (f2bf(hi) << 16); }
#define DPP_MOV(v, ctrl) __int_as_float(__builtin_amdgcn_update_dpp(0, __float_as_int(v), (ctrl), 0xf, 0xf, false))
__device__ __forceinline__ float row16_sum(float v) { v += DPP_MOV(v, 0xB1); v += DPP_MOV(v, 0x4E); v += DPP_MOV(v, 0x141); v += DPP_MOV(v, 0x140); return v; }
__device__ __forceinline__ float wave_sum(float v) {
    v = row16_sum(v);
    const int vi = __float_as_int(v);
    return (__int_as_float(__builtin_amdgcn_readlane(vi, 0)) + __int_as_float(__builtin_amdgcn_readlane(vi, 16))) + (__int_as_float(__builtin_amdgcn_readlane(vi, 32)) + __int_as_float(__builtin_amdgcn_readlane(vi, 48)));
}
__device__ __forceinline__ float xor32_sum(float v) { const auto r = __builtin_amdgcn_permlane32_swap(__float_as_uint(v), __float_as_uint(v), false, false); return __uint_as_float(r[0]) + __uint_as_float(r[1]); }
__device__ __forceinline__ float xor32_max(float v) { const auto r = __builtin_amdgcn_permlane32_swap(__float_as_uint(v), __float_as_uint(v), false, false); return fmaxf(__uint_as_float(r[0]), __uint_as_float(r[1])); }
__device__ __forceinline__ float xor16_sum(float v) { const auto r = __builtin_amdgcn_permlane16_swap(__float_as_uint(v), __float_as_uint(v), false, false); return __uint_as_float(r[0]) + __uint_as_float(r[1]); }
__device__ __forceinline__ float group8_sum(float v) { v += DPP_MOV(v, 0xB1); v += DPP_MOV(v, 0x4E); v += DPP_MOV(v, 0x141); return v; }
__device__ __forceinline__ float wave_max(float v) {
#pragma unroll
    for (int o = 1; o < 64; o <<= 1) v = fmaxf(v, __shfl_xor(v, o));
    return v;
}
__device__ __forceinline__ float sigmoidf_(float x) { return __builtin_amdgcn_rcpf(1.0f + __builtin_amdgcn_exp2f(x * -1.4426950408889634f)); }
__device__ __forceinline__ float siluf_(float x) { return x * __builtin_amdgcn_rcpf(1.0f + __builtin_amdgcn_exp2f(x * -1.4426950408889634f)); }
__device__ __forceinline__ float softplusf_(float x) { return fmaxf(x, 0.f) + log1pf(__expf(-fabsf(x))); }

#define XB_TMO      128
#define XB_XCNT(j)  (256  + 64 * (j))
#define XB_XSUB(j)  (1280 + 64 * (j))
#define XB_XGEN(j)  (2304 + 64 * (j))
#define XB_TOP      3328
#define XB_TOPGEN   3392
#define XCD_BAR_WORDS 3456
#define XB_SPIN_CAP (1u << 18)

__device__ __forceinline__ unsigned xb_ld(unsigned* p)              { return __hip_atomic_load(p, __ATOMIC_RELAXED, __HIP_MEMORY_SCOPE_AGENT); }
__device__ __forceinline__ unsigned xb_add(unsigned* p, unsigned v) { return __hip_atomic_fetch_add(p, v, __ATOMIC_RELAXED, __HIP_MEMORY_SCOPE_AGENT); }
__device__ __forceinline__ unsigned xb_xcc_id() { return (unsigned)__builtin_amdgcn_s_getreg((3 << 11) | 20) & 0xFu; }
#define XB_SPIN(cond, bar) do { unsigned _sp = 0; while (cond) { __builtin_amdgcn_s_sleep(1); \
    if ((++_sp & 255u) == 0u) { if (xb_ld(&(bar)[XB_TMO])) break; if (_sp > XB_SPIN_CAP) { atomicAdd(&(bar)[XB_TMO], 1u); break; } } } } while (0)

struct XcdBarrier { unsigned* bar; unsigned x; volatile LAS unsigned* st; };

__device__ __forceinline__ XcdBarrier xcd_barrier_post(unsigned* bar, volatile LAS unsigned* st) {
    XcdBarrier b; b.bar = bar; b.x = xb_xcc_id(); b.st = st;
    if (threadIdx.x == 0) (void)xb_add(&bar[XB_XCNT(b.x)], 1u);
    return b;
}
__device__ __forceinline__ void xcd_barrier_complete(unsigned* bar, unsigned x, unsigned& nloc, unsigned& nx) {
    const unsigned G = gridDim.x * gridDim.y * gridDim.z;
    unsigned sum, cnt, mine, sp = 0u;
    for (;;) {
        sum = 0u; cnt = 0u; mine = 0u;
#pragma unroll
        for (unsigned j = 0; j < 16; ++j) { const unsigned c = xb_ld(&bar[XB_XCNT(j)]); sum += c; cnt += (c > 0u) ? 1u : 0u; mine = (j == x) ? c : mine; }
        if (sum == G) break;
        __builtin_amdgcn_s_sleep(1);
        if ((++sp & 255u) == 0u) { if (xb_ld(&bar[XB_TMO])) break; if (sp > XB_SPIN_CAP) { atomicAdd(&bar[XB_TMO], 1u); break; } }
    }
    nloc = mine > 0u ? mine : 1u; nx = cnt > 0u ? cnt : 1u;
}
__device__ __forceinline__ void xcd_barrier(const XcdBarrier& b) {
    asm volatile("s_waitcnt vmcnt(0)" ::: "memory");
    __syncthreads();
    if (threadIdx.x == 0) {
        unsigned* bar = b.bar;
        __builtin_amdgcn_s_waitcnt(0);
        unsigned nloc = b.st[0], nx = b.st[1];
        if (nloc == 0u) { xcd_barrier_complete(bar, b.x, nloc, nx); b.st[0] = nloc; b.st[1] = nx; }
        const unsigned old = xb_add(&bar[XB_XSUB(b.x)], 1u);
        const unsigned gen = old / nloc;
        if (old + 1u == (gen + 1u) * nloc) {
            __builtin_amdgcn_fence(__ATOMIC_RELEASE, "agent");
            asm volatile("s_waitcnt vmcnt(0)" ::: "memory");
            const unsigned og = xb_add(&bar[XB_TOP], 1u);
            const unsigned tg = og / nx;
            if (og + 1u == (tg + 1u) * nx) xb_add(&bar[XB_TOPGEN], 1u);
            else XB_SPIN(xb_ld(&bar[XB_TOPGEN]) == tg, bar);
            __builtin_amdgcn_fence(__ATOMIC_ACQUIRE, "agent");
            xb_add(&bar[XB_XGEN(b.x)], 1u);
            asm volatile("s_waitcnt vmcnt(0)" ::: "memory");
        } else {
            XB_SPIN(xb_ld(&bar[XB_XGEN(b.x)]) == gen, bar);
            __builtin_amdgcn_fence(__ATOMIC_ACQUIRE, "agent");
            asm volatile("s_waitcnt vmcnt(0)" ::: "memory");
        }
    }
    __syncthreads();
}

struct Frame {
    LAS unsigned char* lds;
    int tid, lane, wave, gw, ngw, bid, nb;
    GAS unsigned char* ws;
};

__device__ __forceinline__ void frame_refresh(Frame& F, const Args& a, LAS unsigned char* lds) {
    int tid = threadIdx.x; asm volatile("" : "+v"(tid));
    int bid = blockIdx.x; asm volatile("" : "+s"(bid));
    unsigned char* ws = a.ws; asm volatile("" : "+s"(ws));
    F.lds = lds; F.tid = tid; F.lane = tid & 63; F.wave = __builtin_amdgcn_readfirstlane(tid >> 6);
    F.bid = bid; F.nb = gridDim.x; F.gw = F.bid * NWAVES + F.wave; F.ngw = F.nb * NWAVES; F.ws = (GAS unsigned char*)ws;
}
__device__ __forceinline__ void ph_pro_vectors(const Args& a, Frame& F) {
    float* MOD = (float*)(F.ws + WS_MOD);
    LAS float* red = (LAS float*)F.lds;
    for (int it = F.bid; it < 4 * 48; it += F.nb) {
        const int lk = it / 48, cg = it % 48, e = cg * 64 + F.lane;
        const float* W = a.ada_w + (size_t)lk * D * 3072 + e;
        float a0 = 0.f, a1 = 0.f;
        const int d0 = F.wave * 128;
#pragma unroll 8
        for (int d = d0; d < d0 + 128; ++d) {
            const float w = __builtin_nontemporal_load(W + (size_t)d * 3072);
            a0 += siluf_(a.c[d]) * w; a1 += siluf_(a.c[D + d]) * w;
        }
        red[(F.wave * 2 + 0) * 64 + F.lane] = a0; red[(F.wave * 2 + 1) * 64 + F.lane] = a1;
        __syncthreads();
        if (F.wave < 2) {
            float s = 0.f;
            for (int w = 0; w < 8; ++w) s += red[(w * 2 + F.wave) * 64 + F.lane];
            MOD[((size_t)lk * 2 + F.wave) * 3072 + e] = s + a.ada_b[lk * 3072 + e];
        }
        __syncthreads();
    }
    float* CS = (float*)(F.ws + WS_CS);
    for (int idx = F.bid * NTHREADS + F.tid; idx < T * 8; idx += F.nb * NTHREADS) {
        const int t = idx >> 3, i = idx & 7;
        const float inv = powf(500000.0f, -(float)(2 * i) / 16.0f);
        const float ang = (float)a.pos[t] * inv;
        CS[t * 16 + i] = cosf(ang); CS[t * 16 + 8 + i] = sinf(ang);
    }
}

template <int MODE>
__device__ __forceinline__ void ph_norm(const Args& a, Frame& F, int l, const float* xin, const float* gain, const float* modk  ,
                                        const float* W8, int pitch) {
    bf16_t* H = (bf16_t*)(F.ws + WS_H);
    LAS float* W8T = (LAS float*)F.lds;
    if (MODE != 0) {
        for (int i = F.tid; i < 8192; i += NTHREADS) { const int d = i >> 3, j = i & 7; W8T[j * 1024 + d] = W8[(size_t)d * pitch + j]; }
        __syncthreads();
    }
    f32x4 vn[4], A4[4], B4[4]; int cur_b = -1;
    if (F.gw < T) {
#pragma unroll
        for (int j = 0; j < 4; ++j) vn[j] = ((const f32x4*)(xin + (size_t)F.gw * D) + F.lane)[64 * j];
    }
    for (int row = F.gw; row < T; row += F.ngw) {
        const int b = row / SEQ;
        f32x4 v[4]; float ss = 0.f;
#pragma unroll
        for (int j = 0; j < 4; ++j) { v[j] = vn[j]; ss += (v[j].x * v[j].x + v[j].y * v[j].y) + (v[j].z * v[j].z + v[j].w * v[j].w); }
        if (row + F.ngw < T) {
#pragma unroll
            for (int j = 0; j < 4; ++j) vn[j] = ((const f32x4*)(xin + (size_t)(row + F.ngw) * D) + F.lane)[64 * j];
        }
        if (b != cur_b) {
            cur_b = b; const float* sh = modk + (size_t)b * 3072; const float* sc = sh + 1024;
#pragma unroll
            for (int j = 0; j < 4; ++j) { const int d = 256 * j + 4 * F.lane; A4[j] = *(const f32x4*)(gain + d) * (*(const f32x4*)(sc + d) + 1.0f); B4[j] = *(const f32x4*)(sh + d); }
        }
        const float rstd = rsqrtf(wave_sum(ss) * (1.0f / D) + EPS);
        float acc[8];
#pragma unroll
        for (int e = 0; e < 8; ++e) acc[e] = 0.f;
#pragma unroll
        for (int j = 0; j < 4; ++j) {
            const int d = 256 * j + 4 * F.lane;
            const f32x4 hv = (v[j] * rstd) * A4[j] + B4[j];
            u32x2 o; o.x = pk2(hv.x, hv.y); o.y = pk2(hv.z, hv.w);
            *(u32x2*)(H + (size_t)row * D + d) = o;
            if (MODE == 1) { u32x2 xo; xo.x = pk2(v[j].x, v[j].y); xo.y = pk2(v[j].z, v[j].w); *(u32x2*)((bf16_t*)(F.ws + WS_X16) + (size_t)row * D + d) = xo; }
            if (MODE != 0) {
#pragma unroll
                for (int e = 0; e < 8; ++e) { const f32x4 w4 = *(const LAS f32x4*)(W8T + e * 1024 + d); acc[e] += (hv.x * w4.x + hv.y * w4.y) + (hv.z * w4.z + hv.w * w4.w); }
            }
        }
        if (MODE != 0) {
#pragma unroll
            for (int e = 0; e < 8; ++e) acc[e] = wave_sum(acc[e]);
        }
        if (MODE == 1 && F.lane == 0) {
            float* BG = (float*)(F.ws + WS_BG) + (size_t)row * 8;
#pragma unroll
            for (int h = 0; h < 4; ++h) {
                BG[h] = sigmoidf_(acc[h]);
                BG[4 + h] = -__expf(a.dn_a_log[l * 4 + h]) * softplusf_(acc[4 + h] + a.dn_dt_bias[l * 4 + h]);
            }
        }
        if (MODE == 2 && F.lane == 0) {
            float v0 = -INFINITY, v1 = -INFINITY; int e0 = 0, e1 = 0;
#pragma unroll
            for (int e = 0; e < 8; ++e) { const float lg = acc[e] + a.router_b[e]; if (lg > v0) { v1 = v0; e1 = e0; v0 = lg; e0 = e; } else if (lg > v1) { v1 = lg; e1 = e; } }
            const float ex = __expf(v1 - v0), p0 = 1.0f / (1.0f + ex), p1 = ex / (1.0f + ex);
            unsigned* cnt = (unsigned*)(F.ws + WS_CTL) + CW_MOECNT;
            const int q0 = (int)atomicAdd(cnt + 64 * e0, 1u), q1 = (int)atomicAdd(cnt + 64 * e1, 1u);
            int* R = (int*)(F.ws + WS_ROUTE) + (size_t)row * 4; R[0] = e0; R[1] = e1; ((float*)R)[2] = p0; ((float*)R)[3] = p1;
            int* P = (int*)(F.ws + WS_POS) + (size_t)row * 2; P[0] = q0; P[1] = q1;
        }
    }
    if (MODE != 0) __syncthreads();
}

typedef float f32x16 __attribute__((ext_vector_type(16)));
typedef short s16x4 __attribute__((ext_vector_type(4)));
typedef short bf16x8_t __attribute__((ext_vector_type(8)));
__device__ __forceinline__ unsigned cvtpk(float lo, float hi) { typedef float f2_t __attribute__((ext_vector_type(2))); typedef __bf16 b2_t __attribute__((ext_vector_type(2)));
    f2_t v = {lo, hi}; b2_t b = __builtin_convertvector(v, b2_t); return __builtin_bit_cast(unsigned, b); }
__device__ __forceinline__ void ph_rope(const Args& a, Frame& F) {
    bf16_t* P = (bf16_t*)(F.ws + WS_PROJ); const float* CS = (const float*)(F.ws + WS_CS);
    for (int it = F.bid * NTHREADS + F.tid; it < T * 10; it += F.nb * NTHREADS) {
        const int t = it / 10, hh = it % 10;
        bf16_t* p = P + (size_t)t * NP + hh * 64;
        const u32x4 x1 = *(const u32x4*)p, x2 = *(const u32x4*)(p + 8);
        const f32x4 c0 = *(const f32x4*)(CS + (size_t)t * 16), c1 = *(const f32x4*)(CS + (size_t)t * 16 + 4), s0 = *(const f32x4*)(CS + (size_t)t * 16 + 8), s1 = *(const f32x4*)(CS + (size_t)t * 16 + 12);
        const float cs[8] = {c0.x, c0.y, c0.z, c0.w, c1.x, c1.y, c1.z, c1.w}, sn[8] = {s0.x, s0.y, s0.z, s0.w, s1.x, s1.y, s1.z, s1.w};
        const unsigned xa[4] = {x1.x, x1.y, x1.z, x1.w}, xb[4] = {x2.x, x2.y, x2.z, x2.w};
        unsigned ra[4], rb[4];
#pragma unroll
        for (int i = 0; i < 4; ++i) {
            const float a0 = bf2f(xa[i] & 0xffffu), a1 = bf2f(xa[i] >> 16), b0 = bf2f(xb[i] & 0xffffu), b1 = bf2f(xb[i] >> 16);
            ra[i] = pk2(a0 * cs[2 * i] - b0 * sn[2 * i], a1 * cs[2 * i + 1] - b1 * sn[2 * i + 1]);
            rb[i] = pk2(b0 * cs[2 * i] + a0 * sn[2 * i], b1 * cs[2 * i + 1] + a1 * sn[2 * i + 1]);
        }
        *(u32x4*)p = (u32x4){ra[0], ra[1], ra[2], ra[3]}; *(u32x4*)(p + 8) = (u32x4){rb[0], rb[1], rb[2], rb[3]};
    }
}
constexpr int AT_KROW = 144, AT_VOFF = 256 * AT_KROW;
__device__ __forceinline__ void ph_attn_mfma(const Args& a, Frame& F, int l) {
    const bf16_t* P = (const bf16_t*)(F.ws + WS_PROJ); bf16_t* Y = (bf16_t*)(F.ws + WS_YMIX);
    LAS unsigned char* Kl = F.lds; LAS unsigned char* Vl = F.lds + AT_VOFF;
    const int lane = F.lane, r = lane & 31, h = lane >> 5, g = F.wave >> 1, qh = F.wave & 1;
    const int i16 = lane & 15, tq_ = i16 >> 2, tp_ = i16 & 3, g16 = (lane >> 4) & 1, sw = (tq_ >> 1) & 1;
    const int vlane = (4 * h + tq_) * 128 + (2 * g16 + (tp_ >> 1)) * 16 + (tp_ & 1) * 8;
    const float C = 0.125f * 1.4426950408889634f;
    const int nsc = NSCAN;
    if (F.bid < nsc) return;
    u32x4 kreg[4], vreg[4];
#define AT_LOAD(uu) { const int hk_ = (uu) & 1, n_ = ((uu) >> 1) & 127, b_ = (uu) >> 8, tk0_ = b_ * SEQ + n_ * 128 - 128; \
        _Pragma("unroll") for (int i = 0; i < 4; ++i) { const int piece = F.tid + NTHREADS * i, key = piece >> 3, c = piece & 7; \
            const bf16_t* rowp = P + (size_t)(tk0_ + ((n_ > 0 || key >= 128) ? key : key + 128)) * NP; \
            kreg[i] = *(const u32x4*)(rowp + C_AK + hk_ * 64 + c * 8); vreg[i] = *(const u32x4*)(rowp + C_AV + hk_ * 64 + c * 8); } }
    const int V = F.nb - nsc, nheavy = (T / 128 > V && T / 128 < 2 * V) ? T / 128 - V : 0, va = F.bid - nsc - nheavy, Va = V - nheavy;
    if (va < 0) return;
    if (va < BATCH * 128 * 2) AT_LOAD(va)
    for (int u = va; u < BATCH * 128 * 2; u += Va) {
        const int hk = u & 1, n = (u >> 1) & 127, b = u >> 8;
        const int tq0 = b * SEQ + n * 128;
        __syncthreads();
#pragma unroll
        for (int i = 0; i < 4; ++i) {
            const int piece = F.tid + NTHREADS * i, key = piece >> 3, c = piece & 7;
            const bool ok = (n > 0 || key >= 128);
            const u32x4 z4 = (u32x4){0u, 0u, 0u, 0u};
            *(LAS u32x4*)(Kl + key * AT_KROW + c * 16) = ok ? kreg[i] : z4;
            *(LAS u32x4*)(Vl + key * 128 + ((c ^ (((key >> 1) & 1) << 2)) * 16)) = ok ? vreg[i] : z4;
        }
        __syncthreads();
        if (u + Va < BATCH * 128 * 2) AT_LOAD(u + Va)
        asm volatile("" ::: "memory");
        const int hq = hk * 4 + g;
        const float sinkl = a.sinks[l * 8 + hq] * 1.4426950408889634f;
#pragma unroll 1
        for (int sb = 0; sb < 2; ++sb) {
            const int q0 = qh * 64 + sb * 32, kt0 = qh * 2 + sb;
            const size_t tq = (size_t)(tq0 + q0 + r);
            bf16x8_t qf[4];
#pragma unroll
            for (int ks = 0; ks < 4; ++ks) qf[ks] = *(const bf16x8_t*)(P + tq * NP + hq * 64 + 16 * ks + 8 * h);
            f32x16 S[5];
#pragma unroll
            for (int kr = 0; kr < 5; ++kr) {
                f32x16 acc;
#pragma unroll
                for (int i = 0; i < 16; ++i) acc[i] = 0.f;
#pragma unroll
                for (int ks = 0; ks < 4; ++ks) { const bf16x8_t kf = *(const LAS bf16x8_t*)(Kl + (32 * (kt0 + kr) + r) * AT_KROW + (16 * ks + 8 * h) * 2);
                    acc = __builtin_amdgcn_mfma_f32_32x32x16_bf16(kf, qf[ks], acc, 0, 0, 0); }
                S[kr] = acc;
            }
            float m = sinkl;
#pragma unroll
            for (int kr = 0; kr < 5; ++kr) {
                const bool tile_ok = !(n == 0 && (kt0 + kr) < 4);
#pragma unroll
                for (int i = 0; i < 16; ++i) {
                    const int kl = (i & 3) + 8 * (i >> 2) + 4 * h;
                    bool ok = tile_ok; if (kr == 0) ok = ok && (kl > r); if (kr == 4) ok = ok && (kl <= r);
                    const float sv = ok ? S[kr][i] * C : -INFINITY; S[kr][i] = sv; m = fmaxf(m, sv);
                }
            }
            m = xor32_max(m);
            float lsum = 0.f;
#pragma unroll
            for (int kr = 0; kr < 5; ++kr)
#pragma unroll
                for (int i = 0; i < 16; ++i) { const float p = __builtin_amdgcn_exp2f(S[kr][i] - m); S[kr][i] = p; lsum += p; }
            lsum = xor32_sum(lsum); lsum += __builtin_amdgcn_exp2f(sinkl - m);
            f32x16 O0, O1;
#pragma unroll
            for (int i = 0; i < 16; ++i) { O0[i] = 0.f; O1[i] = 0.f; }
#pragma unroll
            for (int kr = 0; kr < 5; ++kr) {
#pragma unroll
                for (int s2 = 0; s2 < 2; ++s2) {
                    u32x4 pw; pw.x = cvtpk(S[kr][8 * s2 + 0], S[kr][8 * s2 + 1]); pw.y = cvtpk(S[kr][8 * s2 + 2], S[kr][8 * s2 + 3]); pw.z = cvtpk(S[kr][8 * s2 + 4], S[kr][8 * s2 + 5]); pw.w = cvtpk(S[kr][8 * s2 + 6], S[kr][8 * s2 + 7]);
                    const bf16x8_t pf = __builtin_bit_cast(bf16x8_t, pw);
                    const int kb = (32 * (kt0 + kr) + 16 * s2) * 128 + vlane;
                    const s16x4 lo0 = __builtin_amdgcn_ds_read_tr16_b64_v4i16((LAS s16x4*)(Vl + kb + (0 ^ sw) * 64));
                    const s16x4 hi0 = __builtin_amdgcn_ds_read_tr16_b64_v4i16((LAS s16x4*)(Vl + kb + 8 * 128 + (0 ^ sw) * 64));
                    const s16x4 lo1 = __builtin_amdgcn_ds_read_tr16_b64_v4i16((LAS s16x4*)(Vl + kb + (1 ^ sw) * 64));
                    const s16x4 hi1 = __builtin_amdgcn_ds_read_tr16_b64_v4i16((LAS s16x4*)(Vl + kb + 8 * 128 + (1 ^ sw) * 64));
                    const bf16x8_t va0 = __builtin_shufflevector(lo0, hi0, 0, 1, 2, 3, 4, 5, 6, 7), va1 = __builtin_shufflevector(lo1, hi1, 0, 1, 2, 3, 4, 5, 6, 7);
                    O0 = __builtin_amdgcn_mfma_f32_32x32x16_bf16(va0, pf, O0, 0, 0, 0);
                    O1 = __builtin_amdgcn_mfma_f32_32x32x16_bf16(va1, pf, O1, 0, 0, 0);
                }
            }
            const float inv = __builtin_amdgcn_rcpf(lsum);
            bf16_t* yp = Y + tq * D + hq * 64 + 4 * h;
#pragma unroll
            for (int gq = 0; gq < 4; ++gq) {
                u32x2 o0; o0.x = cvtpk(O0[4 * gq] * inv, O0[4 * gq + 1] * inv); o0.y = cvtpk(O0[4 * gq + 2] * inv, O0[4 * gq + 3] * inv);
                u32x2 o1; o1.x = cvtpk(O1[4 * gq] * inv, O1[4 * gq + 1] * inv); o1.y = cvtpk(O1[4 * gq + 2] * inv, O1[4 * gq + 3] * inv);
                *(u32x2*)(yp + 8 * gq) = o0; *(u32x2*)(yp + 32 + 8 * gq) = o1;
            }
        }
    }
    __syncthreads();
}


#undef AT_LOAD
constexpr size_t WS_DN_MR = 360 * MiB, WS_DN_BNT = 376 * MiB, WS_DN_QP = 392 * MiB, WS_DN_OLT = 408 * MiB, WS_DN_ST = 424 * MiB;
constexpr int DL = 72, LB = 9216;
constexpr int L_KR = 0, L_KT = LB, L_QR = 2 * LB, L_VT = 3 * LB, L_AR = 4 * LB, L_T1 = 5 * LB, L_T2 = 6 * LB, L_UT = 7 * LB, L_UPT = 8 * LB, L_WPT = 9 * LB, L_WT = 0;
constexpr int L_LR = 7 * LB, L_L21 = L_LR + 17408, L_T11T = L_L21 + 4608, L_T22R = L_T11T + 4608, L_YT = L_T22R + 4608, L_GC = 100352, L_BETA = L_GC + 256;
static_assert(L_YT + 4608 == L_GC && L_GC + 512 <= 131072, "DeltaNet LDS map");
template <int KS> __device__ __forceinline__ f32x4 mm16(const LAS unsigned char* lds, int offX, int offY, int tx, int ty, int lane) {
    f32x4 acc = (f32x4){0.f, 0.f, 0.f, 0.f};
    const int l15 = lane & 15, q = lane >> 4;
#pragma unroll
    for (int ks = 0; ks < KS; ++ks) {
        const bf16x8_t xa = *(const LAS bf16x8_t*)(lds + offX + ((16 * tx + l15) * DL + 32 * ks + 8 * q) * 2);
        const bf16x8_t yb = *(const LAS bf16x8_t*)(lds + offY + ((16 * ty + l15) * DL + 32 * ks + 8 * q) * 2);
        acc = __builtin_amdgcn_mfma_f32_16x16x32_bf16(xa, yb, acc, 0, 0, 0);
    }
    return acc;
}
__device__ __forceinline__ u32x2 pack4(f32x4 v) { u32x2 o; o.x = cvtpk(v.x, v.y); o.y = cvtpk(v.z, v.w); return o; }

__device__ __forceinline__ void ph_dn_chunk(const Args& a, Frame& F, int l) {
    const bf16_t* P = (const bf16_t*)(F.ws + WS_PROJ); const float* BG = (const float*)(F.ws + WS_BG);
    bf16_t* MR = (bf16_t*)(F.ws + WS_DN_MR); bf16_t* BNT = (bf16_t*)(F.ws + WS_DN_BNT); bf16_t* QP = (bf16_t*)(F.ws + WS_DN_QP); bf16_t* OLT = (bf16_t*)(F.ws + WS_DN_OLT);
    LAS unsigned char* lds = F.lds;
    LAS float* gcL = (LAS float*)(lds + L_GC); LAS float* betaL = (LAS float*)(lds + L_BETA);
    const float* cw = a.dn_conv_w + (size_t)l * DN_CONV * 768;
    const int lane = F.lane, w = F.wave, l15 = lane & 15, q4 = lane >> 4;
    LAS float* cwL = (LAS float*)(lds + L_GC + 512);
    int cur_h = -1;
    const int ci = F.tid >> 3, c8 = F.tid & 7;
    u32x4 xr[3][4]; float bgb = 0.f, bgg = 0.f;
#define CH_LOAD(vu_) { const int n_ = ((vu_) >> 2) & 255, h_ = (vu_) & 3, b_ = (vu_) >> 10; const int t_ = b_ * SEQ + n_ * 64 + ci; \
        _Pragma("unroll") for (int kd = 0; kd < 3; ++kd) _Pragma("unroll") for (int k = 0; k < DN_CONV; ++k) { \
            const int tt_ = (n_ * 64 + ci - (DN_CONV - 1) + k >= 0) ? t_ - (DN_CONV - 1) + k : t_; xr[kd][k] = *(const u32x4*)(P + (size_t)tt_ * NP + C_DQ + kd * 256 + h_ * 64 + c8 * 8); } \
        if (w == 0) { bgb = BG[(size_t)(b_ * SEQ + n_ * 64 + lane) * 8 + h_]; bgg = BG[(size_t)(b_ * SEQ + n_ * 64 + lane) * 8 + 4 + h_]; } }
    if (F.bid < BATCH * 4 * 256) CH_LOAD(F.bid)
    for (int vu = F.bid; vu < BATCH * 4 * 256; vu += F.nb) {
        const int n = (vu >> 2) & 255, h = vu & 3, b = vu >> 10, unit = (b * 4 + h) * 256 + n;
        const int t0 = b * SEQ + n * 64;
        __syncthreads();
        if (h != cur_h) { cur_h = h;
            for (int idx = F.tid; idx < DN_CONV * 3 * 64; idx += NTHREADS) { const int k = idx / 192, kd = (idx / 64) % 3, cc = idx & 63; cwL[idx] = cw[k * 768 + kd * 256 + h * 64 + cc]; }
            __syncthreads(); }
        {
            const int i = ci, sq = n * 64 + i;
#pragma unroll
            for (int kd = 0; kd < 3; ++kd) {
                float acc[8];
#pragma unroll
                for (int e = 0; e < 8; ++e) acc[e] = 0.f;
#pragma unroll
                for (int k = 0; k < DN_CONV; ++k) {
                    const u32x4 xv = xr[kd][k]; const float vm = (sq - (DN_CONV - 1) + k >= 0) ? 1.f : 0.f;
                    const f32x4 w0 = *(const LAS f32x4*)(cwL + (k * 3 + kd) * 64 + c8 * 8) * vm, w1 = *(const LAS f32x4*)(cwL + (k * 3 + kd) * 64 + c8 * 8 + 4) * vm;
                    acc[0] += w0.x * bf2f(xv.x & 0xffffu); acc[1] += w0.y * bf2f(xv.x >> 16); acc[2] += w0.z * bf2f(xv.y & 0xffffu); acc[3] += w0.w * bf2f(xv.y >> 16);
                    acc[4] += w1.x * bf2f(xv.z & 0xffffu); acc[5] += w1.y * bf2f(xv.z >> 16); acc[6] += w1.z * bf2f(xv.w & 0xffffu); acc[7] += w1.w * bf2f(xv.w >> 16);
                }
                float ss = 0.f;
#pragma unroll
                for (int e = 0; e < 8; ++e) { acc[e] = siluf_(acc[e]); ss += acc[e] * acc[e]; }
                if (kd < 2) {
                    ss = group8_sum(ss);
                    const float rn = rsqrtf(ss + EPS) * (kd == 0 ? 0.125f : 1.0f);
#pragma unroll
                    for (int e = 0; e < 8; ++e) acc[e] *= rn;
                }
                u32x4 pk; pk.x = cvtpk(acc[0], acc[1]); pk.y = cvtpk(acc[2], acc[3]); pk.z = cvtpk(acc[4], acc[5]); pk.w = cvtpk(acc[6], acc[7]);
                if (kd == 0) *(LAS u32x4*)(lds + L_QR + (i * DL + c8 * 8) * 2) = pk;
                if (kd == 1) *(LAS u32x4*)(lds + L_KR + (i * DL + c8 * 8) * 2) = pk;
                if (kd >= 1) {
                    LAS bf16_t* Tt = (LAS bf16_t*)(lds + (kd == 1 ? L_KT : L_VT));
                    const unsigned pw[4] = {pk.x, pk.y, pk.z, pk.w};
#pragma unroll
                    for (int e = 0; e < 8; ++e) Tt[(c8 * 8 + e) * DL + i] = (bf16_t)((pw[e >> 1] >> (16 * (e & 1))) & 0xffffu);
                }
            }
            for (int idx = F.tid; idx < 2 * LB / 16; idx += NTHREADS) *(LAS u32x4*)(lds + L_T1 + idx * 16) = (u32x4){0u, 0u, 0u, 0u};
            if (w == 0) {
                float x = bgg;
#pragma unroll
                for (int o = 1; o < 64; o <<= 1) { const float y = __shfl_up(x, o); if (lane >= o) x += y; }
                gcL[lane] = x; betaL[lane] = bgb;
            }
            if (vu + F.nb < BATCH * 4 * 256) CH_LOAD(vu + F.nb)
            asm volatile("" ::: "memory");
        }
        __syncthreads();
        REP(134217728)
#pragma unroll
        for (int tt = 0; tt < 2; ++tt) {
            const int tidx = 2 * w + tt, tx = tidx >> 2, ty = tidx & 3, i = 16 * ty + l15, j0 = 16 * tx + 4 * q4;
            const float gi = gcL[i], bi = betaL[i]; const f32x4 gj = *(const LAS f32x4*)(gcL + j0);
            const float gjv[4] = {gj.x, gj.y, gj.z, gj.w};
            const f32x4 zk = mm16<2>(lds, L_KR, L_KR, tx, ty, lane);
            const f32x4 zq = mm16<2>(lds, L_KR, L_QR, tx, ty, lane);
            f32x4 lv, av;
#pragma unroll
            for (int r = 0; r < 4; ++r) { const float dc = __expf(fminf(gi - gjv[r], 0.f)); lv[r] = (j0 + r < i) ? bi * zk[r] * dc : 0.f; av[r] = (j0 + r <= i) ? zq[r] * dc : 0.f; }
            *(LAS f32x4*)(lds + L_LR + (i * 68 + j0) * 4) = lv;
            if (i >= 32 && j0 < 32) *(LAS u32x2*)(lds + L_L21 + ((i - 32) * DL + j0) * 2) = pack4(lv);
            *(LAS u32x2*)(lds + L_AR + (i * DL + j0) * 2) = pack4(av);
        }
        __syncthreads();
        REP(32768) {
            const int cg = 8 * w + (lane >> 3), blk = cg >> 5, jp = cg & 31, l8 = lane & 7;
            const LAS float* Lb = (const LAS float*)(lds + L_LR) + (32 * blk) * 68 + 32 * blk + 4 * l8;
            float x0 = 0.f, x1 = 0.f, x2 = 0.f, x3 = 0.f;
#pragma unroll
            for (int i = 0; i < 32; ++i) {
                const f32x4 l4 = *(const LAS f32x4*)(Lb + i * 68);
                float part = (l4.x * x0 + l4.y * x1) + (l4.z * x2 + l4.w * x3);
                part = group8_sum(part);
                const float xi = ((i == jp) ? 1.f : 0.f) - part;
                if (l8 == (i >> 2)) { if ((i & 3) == 0) x0 = xi; else if ((i & 3) == 1) x1 = xi; else if ((i & 3) == 2) x2 = xi; else x3 = xi; }
            }
            const int jg = 32 * blk + jp; const float bj = betaL[jg], bej = bj * __expf(gcL[jg]);
            LAS bf16_t* T1 = (LAS bf16_t*)(lds + L_T1); LAS bf16_t* T2 = (LAS bf16_t*)(lds + L_T2);
            const float xs[4] = {x0, x1, x2, x3};
#pragma unroll
            for (int e = 0; e < 4; ++e) { const int rg = 32 * blk + 4 * l8 + e; T1[rg * DL + jg] = (bf16_t)f2bf(xs[e] * bj); T2[rg * DL + jg] = (bf16_t)f2bf(xs[e] * bej); }
            if (blk == 0) { *(LAS u32x2*)(lds + L_T11T + (jp * DL + 4 * l8) * 2) = pack4((f32x4){x0, x1, x2, x3}); }
            else { LAS bf16_t* T22 = (LAS bf16_t*)(lds + L_T22R);
#pragma unroll
                for (int e = 0; e < 4; ++e) T22[(4 * l8 + e) * DL + jp] = (bf16_t)f2bf(xs[e]); }
        }
        __syncthreads();
        if (w < 4) {
            const int tx = w >> 1, ty = w & 1;
            const f32x4 z = mm16<1>(lds, L_L21, L_T11T, tx, ty, lane);
            *(LAS u32x2*)(lds + L_YT + ((16 * ty + l15) * DL + 16 * tx + 4 * q4) * 2) = pack4(z);
        }
        __syncthreads();
        if (w < 4) {
            const int tx = w >> 1, ty = w & 1, y = 16 * ty + l15, x0 = 16 * tx + 4 * q4;
            const f32x4 z = mm16<1>(lds, L_T22R, L_YT, tx, ty, lane);
            const float bj = betaL[y], bej = bj * __expf(gcL[y]);
            LAS bf16_t* T1 = (LAS bf16_t*)(lds + L_T1); LAS bf16_t* T2 = (LAS bf16_t*)(lds + L_T2);
#pragma unroll
            for (int r = 0; r < 4; ++r) { T1[(32 + x0 + r) * DL + y] = (bf16_t)f2bf(-z[r] * bj); T2[(32 + x0 + r) * DL + y] = (bf16_t)f2bf(-z[r] * bej); }
        }
        __syncthreads();
        const float gl = gcL[63];
        REP(268435456)
#pragma unroll
        for (int tt = 0; tt < 2; ++tt) {
            const int tidx = 2 * w + tt, tx = tidx >> 2, ty = tidx & 3, y = 16 * ty + l15, x0 = 16 * tx + 4 * q4;
            const f32x4 gx = *(const LAS f32x4*)(gcL + x0);
            f32x4 sc; sc.x = __expf(gl - gx.x); sc.y = __expf(gl - gx.y); sc.z = __expf(gl - gx.z); sc.w = __expf(gl - gx.w);
            const f32x4 zu = mm16<2>(lds, L_T1, L_VT, tx, ty, lane);
            const f32x4 zw = mm16<2>(lds, L_T2, L_KT, tx, ty, lane);
            *(LAS u32x2*)(lds + L_UT + (y * DL + x0) * 2) = pack4(zu); *(LAS u32x2*)(lds + L_UPT + (y * DL + x0) * 2) = pack4(zu * sc);
            *(LAS u32x2*)(lds + L_WT + (y * DL + x0) * 2) = pack4(zw); *(LAS u32x2*)(lds + L_WPT + (y * DL + x0) * 2) = pack4(zw * sc);
        }
        __syncthreads();
        REP(65536) {
            const size_t cho = (size_t)unit * 4096;
            const float egl = __expf(gl);
#pragma unroll
            for (int tt = 0; tt < 2; ++tt) {
                const int tidx = 2 * w + tt, tx = tidx >> 2, ty = tidx & 3, y = 16 * ty + l15, x0 = 16 * tx + 4 * q4;
                f32x4 zm = mm16<2>(lds, L_WPT, L_KT, tx, ty, lane);
#pragma unroll
                for (int r = 0; r < 4; ++r) zm[r] = ((x0 + r) == y ? egl : 0.f) - zm[r];
                *(u32x2*)(MR + cho + (ty * 2 + (tx >> 1)) * 512 + lane * 8 + 4 * (tx & 1)) = pack4(zm);
                const f32x4 zb = mm16<2>(lds, L_KT, L_UPT, tx, ty, lane);
                *(u32x2*)(BNT + cho + (ty * 4 + tx) * 256 + lane * 4) = pack4(zb);
                const f32x4 zq = mm16<2>(lds, L_WT, L_AR, tx, ty, lane);
                const u32x2 qv = *(const LAS u32x2*)(lds + L_QR + (y * DL + x0) * 2); const float eg = __expf(gcL[y]);
                f32x4 qp; qp.x = bf2f(qv.x & 0xffffu) * eg - zq.x; qp.y = bf2f(qv.x >> 16) * eg - zq.y; qp.z = bf2f(qv.y & 0xffffu) * eg - zq.z; qp.w = bf2f(qv.y >> 16) * eg - zq.w;
                *(u32x2*)(QP + cho + y * 64 + x0) = pack4(qp);
                const f32x4 zo = mm16<2>(lds, L_AR, L_UT, tx, ty, lane);
                *(u32x2*)(OLT + cho + y * 64 + x0) = pack4(zo);
            }
        }
    }
    __syncthreads();
}
#undef CH_LOAD
constexpr int SC_SLOT = 10240, SC_DEPTH = 12, SC_AHEAD = 10, SC_STS = 2 * 16 * 144;
__device__ __forceinline__ void ph_dn_scan(const Args& a, Frame& F, int l) {
    if (F.bid >= NSCAN) return;
    GAS unsigned* prog = (GAS unsigned*)(F.ws + WS_CTL) + CW_SCANP + l * 4096 + 64 * F.bid;
    const unsigned char* MRb = (const unsigned char*)(F.ws + WS_DN_MR); const unsigned char* BNb = (const unsigned char*)(F.ws + WS_DN_BNT); GAS bf16_t* ST = (GAS bf16_t*)(F.ws + WS_DN_ST);
    const int lane = F.lane, l15 = lane & 15, q4 = lane >> 4, wq = F.bid >> 3;
    const size_t ch0 = (size_t)(F.bid & 7) * 256;
    LAS unsigned char* lds = F.lds; LAS unsigned char* stl = F.lds + RI_OFF;
    __syncthreads();
    if (F.wave >= 3) {
        const int lw = F.wave - 3;
#define DN_ISSUE(nn) do { const size_t chb_ = (ch0 + (size_t)((nn) < 255 ? (nn) : 255)) * 8192; const int slot_ = ((nn) % SC_DEPTH) * SC_SLOT; \
        _Pragma("unroll") for (int p_ = 0; p_ < 2; ++p_) { const int piece_ = lw * 2 + p_; \
            const unsigned char* src_ = (piece_ < 8 ? MRb + chb_ + piece_ * 1024 : BNb + chb_ + wq * 2048 + (piece_ - 8) * 1024) + lane * 16; \
            __builtin_amdgcn_global_load_lds((const unsigned*)src_, (LAS unsigned*)(lds + slot_ + piece_ * 1024), 16, 0, 2); } } while (0)
        for (int n = 0; n < SC_AHEAD; ++n) DN_ISSUE(n);
        for (int n = 0; n < 256; n += 2) {
            asm volatile("s_waitcnt vmcnt(16)" ::: "memory");
            __builtin_amdgcn_s_barrier();
            DN_ISSUE(n + SC_AHEAD); DN_ISSUE(n + SC_AHEAD + 1);
        }
        asm volatile("s_waitcnt vmcnt(0)" ::: "memory");
        __builtin_amdgcn_s_barrier();
#undef DN_ISSUE
    } else if (F.wave == 0) {
        const int dv = 16 * wq + l15;
        f32x4 S[4];
#pragma unroll
        for (int ti = 0; ti < 4; ++ti) S[ti] = (f32x4){0.f, 0.f, 0.f, 0.f};
        for (int n0 = 0; n0 < 256; n0 += 2) {
            __builtin_amdgcn_s_barrier();
            bf16x8_t A[2][4][2]; u32x2 Bc[2][4];
#pragma unroll
            for (int e = 0; e < 2; ++e) { const LAS unsigned char* slot = lds + ((n0 + e) % SC_DEPTH) * SC_SLOT;
#pragma unroll
                for (int ti = 0; ti < 4; ++ti) {
#pragma unroll
                    for (int ks = 0; ks < 2; ++ks) A[e][ti][ks] = *(const LAS bf16x8_t*)(slot + (ti * 2 + ks) * 1024 + lane * 16);
                    Bc[e][ti] = *(const LAS u32x2*)(slot + 8192 + ti * 512 + lane * 8);
                } }
#pragma unroll
            for (int e = 0; e < 2; ++e) {
                const int n = n0 + e;
                u32x2 sp[4];
#pragma unroll
                for (int ti = 0; ti < 4; ++ti) { sp[ti] = pack4(S[ti]); *(LAS u32x2*)(stl + ((n0 >> 1) & 1) * SC_STS + e * (SC_STS / 2) + l15 * 144 + (16 * ti + 4 * q4) * 2) = sp[ti]; }
                const bf16x8_t b0 = __builtin_bit_cast(bf16x8_t, (u32x4){sp[0].x, sp[0].y, sp[1].x, sp[1].y});
                const bf16x8_t b1 = __builtin_bit_cast(bf16x8_t, (u32x4){sp[2].x, sp[2].y, sp[3].x, sp[3].y});
#pragma unroll
                for (int ti = 0; ti < 4; ++ti) {
                    f32x4 c; c.x = bf2f(Bc[e][ti].x & 0xffffu); c.y = bf2f(Bc[e][ti].x >> 16); c.z = bf2f(Bc[e][ti].y & 0xffffu); c.w = bf2f(Bc[e][ti].y >> 16);
                    c = __builtin_amdgcn_mfma_f32_16x16x32_bf16(A[e][ti][0], b0, c, 0, 0, 0);
                    c = __builtin_amdgcn_mfma_f32_16x16x32_bf16(A[e][ti][1], b1, c, 0, 0, 0);
                    S[ti] = c;
                }
            }
            asm volatile("s_waitcnt lgkmcnt(0)" ::: "memory");
        }
        __builtin_amdgcn_s_barrier();
    } else if (F.wave == 1) {
        GAS unsigned char* stg = (GAS unsigned char*)(ST + ch0 * 4096 + (size_t)(16 * wq) * 64);
        for (int n0 = 0; n0 <= 256; n0 += 2) {
            __builtin_amdgcn_s_barrier();
            if (n0 >= 2) {
                const LAS unsigned char* slot = stl + (((n0 - 2) >> 1) & 1) * SC_STS;
#pragma unroll
                for (int e = 0; e < 2; ++e)
#pragma unroll
                    for (int i = 0; i < 2; ++i) { const int pc = i * 64 + lane; const u32x4 v = *(const LAS u32x4*)(slot + e * (SC_STS / 2) + (pc >> 3) * 144 + (pc & 7) * 16);
                        const unsigned long long gp = (unsigned long long)(stg + (size_t)(n0 - 2 + e) * 8192 + pc * 16);
                        asm volatile("global_store_dwordx4 %0, %1, off sc1" :: "v"(gp), "v"(v) : "memory"); }
                asm volatile("s_waitcnt vmcnt(40)" ::: "memory");
                if (lane == 0) __hip_atomic_store(prog, (unsigned)(n0 >= 16 ? n0 - 16 : 0), __ATOMIC_RELAXED, __HIP_MEMORY_SCOPE_AGENT);
            }
        }
        asm volatile("s_waitcnt vmcnt(0)" ::: "memory");
        if (lane == 0) __hip_atomic_store(prog, 256u, __ATOMIC_RELAXED, __HIP_MEMORY_SCOPE_AGENT);
    } else {
        for (int n = 0; n <= 256; n += 2) __builtin_amdgcn_s_barrier();
    }
    __syncthreads();
}
__device__ __forceinline__ void ph_dn_out(const Args& a, Frame& F, int l) {
    const bf16_t* QP = (const bf16_t*)(F.ws + WS_DN_QP); const bf16_t* OLT = (const bf16_t*)(F.ws + WS_DN_OLT); const bf16_t* ST = (const bf16_t*)(F.ws + WS_DN_ST);
    const bf16_t* P = (const bf16_t*)(F.ws + WS_PROJ); bf16_t* Y = (bf16_t*)(F.ws + WS_YMIX);
    const int lane = F.lane, l15 = lane & 15, q4 = lane >> 4, ti = F.wave & 3;
    LAS bf16_t* TL = (LAS bf16_t*)(F.lds + F.wave * 2560);
    const int er = lane >> 2, ec = (lane & 3) * 16;
    f32x4 gnv[4];
#pragma unroll
    for (int j = 0; j < 4; ++j) gnv[j] = *(const f32x4*)(a.dn_norm_g + l * 64 + ec + 4 * j);
    bf16x8_t af[2], bfv[4][2]; u32x2 ov[4];
    if (F.bid < NSCAN) return;
    GAS unsigned* prog = (GAS unsigned*)(F.ws + WS_CTL) + CW_SCANP + l * 4096; unsigned* tmo = (unsigned*)(F.ws + WS_CTL) + CW_BAR + XB_TMO;
    unsigned seen = 0;
    volatile LAS unsigned* seenl = (volatile LAS unsigned*)(F.lds + MISC_OFF) + 16;
#define DNO_WAIT(prv) { const unsigned need_ = 2u * (unsigned)((prv) >> 3) + 2u; const int bh_ = (prv) & 7; if ((prs & 7) != 0) seen = 0; if (seen < need_) {   \
        if (F.wave == 0) { unsigned sp_ = 0, m_; \
            for (;;) { unsigned v_ = lane < 4 ? __hip_atomic_load(prog + 64 * (bh_ + 8 * lane), __ATOMIC_RELAXED, __HIP_MEMORY_SCOPE_AGENT) : 0xffffffffu; \
                _Pragma("unroll") for (int o_ = 2; o_ >= 1; o_ >>= 1) { const unsigned w_ = (unsigned)__shfl_xor((int)v_, o_); v_ = w_ < v_ ? w_ : v_; } \
                m_ = (unsigned)__builtin_amdgcn_readfirstlane((int)v_); if (m_ >= need_) break; \
                __builtin_amdgcn_s_sleep(8); \
                if ((++sp_ & 63u) == 0u) { if (xb_ld(tmo)) break; if (sp_ > (1u << 16)) { atomicAdd(tmo, 1u); break; } } } \
            __builtin_amdgcn_fence(__ATOMIC_ACQUIRE, "agent"); asm volatile("s_waitcnt vmcnt(0)" ::: "memory"); \
            if (lane == 0) *seenl = m_; } \
        __syncthreads(); seen = *seenl; __syncthreads(); } }
#define DNO_LOAD(prv) { const int unit_ = (((prv) & 7) << 8) + 2 * ((prv) >> 3) + (F.wave >> 2); const size_t cho_ = (size_t)unit_ * 4096; \
        _Pragma("unroll") for (int ks = 0; ks < 2; ++ks) af[ks] = *(const bf16x8_t*)(QP + cho_ + (16 * ti + l15) * 64 + 32 * ks + 8 * q4); \
        _Pragma("unroll") for (int tj = 0; tj < 4; ++tj) { ov[tj] = *(const u32x2*)(OLT + cho_ + (16 * tj + l15) * 64 + 16 * ti + 4 * q4); \
            _Pragma("unroll") for (int ks = 0; ks < 2; ++ks) bfv[tj][ks] = *(const bf16x8_t*)(ST + cho_ + (16 * tj + l15) * 64 + 32 * ks + 8 * q4); } }
    const int pr0 = F.bid - NSCAN, prs = F.nb - NSCAN;
    if (pr0 < 1024) { DNO_WAIT(pr0) DNO_LOAD(pr0) }
    for (int pr = pr0; pr < 1024; pr += prs) {
        const int unit = ((pr & 7) << 8) + 2 * (pr >> 3) + (F.wave >> 2), n = unit & 255, h = (unit >> 8) & 3, b = unit >> 10;
        f32x4 acc[4];
#pragma unroll
        for (int tj = 0; tj < 4; ++tj) {
            f32x4 c; c.x = bf2f(ov[tj].x & 0xffffu); c.y = bf2f(ov[tj].x >> 16); c.z = bf2f(ov[tj].y & 0xffffu); c.w = bf2f(ov[tj].y >> 16);
#pragma unroll
            for (int ks = 0; ks < 2; ++ks) c = __builtin_amdgcn_mfma_f32_16x16x32_bf16(af[ks], bfv[tj][ks], c, 0, 0, 0);
            acc[tj] = c;
        }
        const size_t trow = (size_t)b * SEQ + n * 64 + 16 * ti + er;
        const u32x4 z0 = *(const u32x4*)(P + trow * NP + C_DZ + h * 64 + ec), z1 = *(const u32x4*)(P + trow * NP + C_DZ + h * 64 + ec + 8);
        if (pr + prs < 1024) { DNO_WAIT(pr + prs) DNO_LOAD(pr + prs) }
        f32x4 ss = acc[0] * acc[0] + acc[1] * acc[1] + acc[2] * acc[2] + acc[3] * acc[3];
        ss.x = row16_sum(ss.x); ss.y = row16_sum(ss.y); ss.z = row16_sum(ss.z); ss.w = row16_sum(ss.w);
        const float rs[4] = {rsqrtf(ss.x * (1.f / 64.f) + EPS), rsqrtf(ss.y * (1.f / 64.f) + EPS), rsqrtf(ss.z * (1.f / 64.f) + EPS), rsqrtf(ss.w * (1.f / 64.f) + EPS)};
#pragma unroll
        for (int tj = 0; tj < 4; ++tj)
#pragma unroll
            for (int r = 0; r < 4; ++r) TL[(4 * q4 + r) * 80 + 16 * tj + l15] = (bf16_t)f2bf(acc[tj][r] * rs[r]);
        const u32x4 t0 = *(const LAS u32x4*)(TL + er * 80 + ec), t1 = *(const LAS u32x4*)(TL + er * 80 + ec + 8);
        const unsigned tw[8] = {t0.x, t0.y, t0.z, t0.w, t1.x, t1.y, t1.z, t1.w}, zw[8] = {z0.x, z0.y, z0.z, z0.w, z1.x, z1.y, z1.z, z1.w};
        unsigned yw[8];
#pragma unroll
        for (int j = 0; j < 8; ++j) {
            const float g0 = gnv[j >> 1][(2 * j) & 3], g1 = gnv[j >> 1][(2 * j + 1) & 3];
            yw[j] = cvtpk(bf2f(tw[j] & 0xffffu) * g0 * siluf_(bf2f(zw[j] & 0xffffu)), bf2f(tw[j] >> 16) * g1 * siluf_(bf2f(zw[j] >> 16)));
        }
        bf16_t* yp = Y + trow * D + 512 + h * 64 + ec;
        *(u32x4*)yp = (u32x4){yw[0], yw[1], yw[2], yw[3]}; *(u32x4*)(yp + 8) = (u32x4){yw[4], yw[5], yw[6], yw[7]};
    }
#undef DNO_LOAD
#undef DNO_WAIT
}

__device__ __forceinline__ void ph_conv_fast(const Args& a, Frame& F, int l) {
    const bf16_t* P = (const bf16_t*)(F.ws + WS_PROJ); bf16_t* Y = (bf16_t*)(F.ws + WS_YMIX);
    LAS float* OUTL = (LAS float*)F.lds;
    const int c = F.tid & 255, rsel = F.tid >> 8;
    float wk[CV_K];
#pragma unroll
    for (int k = 0; k < CV_K; ++k) wk[k] = a.cv_dw_w[((size_t)l * CV_K + k) * CV_C + c];
    const float bias = a.cv_dw_b[l * CV_C + c];
    const int nsc = NSCAN;
    if (F.bid < nsc) return;
    for (int pr = F.bid - nsc; pr < T / 128; pr += F.nb - nsc) {
        const int run = 2 * pr + rsel, t0 = run * 64, s0 = t0 % SEQ;
        __syncthreads();
        float win[CV_K];
        const bf16_t* pc = P + (size_t)(t0 - 30) * NP + C_CA + c;
        const bool first = (s0 == 0);
        LAS float* outp = OUTL + (rsel * 64) * 256 + c;
#define CV_U(ti_, dst) { const bool ok_ = !(first && (ti_) < 30); const bf16_t* q_ = ok_ ? pc + (size_t)(ti_) * NP : pc + (size_t)30 * NP; \
            const float ca_ = bf2f(q_[0]), cb_ = bf2f(q_[256]); dst = ok_ ? ca_ * sigmoidf_(cb_) : 0.f; }
#pragma unroll
        for (int p = 0; p < CV_K; ++p) CV_U(p, win[p])
        { float acc = bias;
#pragma unroll
            for (int k = 0; k < CV_K; ++k) acc += wk[k] * win[(30 + 1 + k) % CV_K];
            outp[0] = acc; }
        for (int cb3 = 1; cb3 < 3; ++cb3) {
            float un[CV_K];
#pragma unroll
            for (int p = 0; p < CV_K; ++p) CV_U(cb3 * CV_K + p, un[p])
#pragma unroll
            for (int p = 0; p < CV_K; ++p) {
                win[p] = un[p];
                float acc = bias;
#pragma unroll
                for (int k = 0; k < CV_K; ++k) acc += wk[k] * win[(p + 1 + k) % CV_K];
                outp[(cb3 * CV_K + p - 30) * 256] = acc;
            }
        }
        { float u93; CV_U(93, u93) win[0] = u93; float acc = bias;
#pragma unroll
            for (int k = 0; k < CV_K; ++k) acc += wk[k] * win[(0 + 1 + k) % CV_K];
            outp[63 * 256] = acc; }
#undef CV_U
        __syncthreads();
        const f32x4 g4 = *(const f32x4*)(a.cv_ln_g + l * CV_C + 4 * F.lane), b4 = *(const f32x4*)(a.cv_ln_b + l * CV_C + 4 * F.lane);
        for (int j = 0; j < 16; ++j) {
            const int tl = F.wave * 16 + j;
            const f32x4 v = *(const LAS f32x4*)(OUTL + tl * 256 + 4 * F.lane);
            const float mean = wave_sum((v.x + v.y) + (v.z + v.w)) * (1.0f / CV_C);
            const f32x4 dv = v - mean;
            const float var = wave_sum((dv.x * dv.x + dv.y * dv.y) + (dv.z * dv.z + dv.w * dv.w)) * (1.0f / CV_C);
            const float rstd = rsqrtf(var + EPS);
            const f32x4 y = (dv * rstd) * g4 + b4;
            u32x2 o; o.x = cvtpk(siluf_(y.x), siluf_(y.y)); o.y = cvtpk(siluf_(y.z), siluf_(y.w));
            *(u32x2*)(Y + (size_t)(pr * 128 + tl) * D + 768 + 4 * F.lane) = o;
        }
    }
    __syncthreads();
}

__device__ __forceinline__ void moe_bases(Frame& F, int (&base)[9], int (&cnt)[8]) {
    const unsigned* c = (const unsigned*)(F.ws + WS_CTL) + CW_MOECNT;
    int acc = 0;
#pragma unroll
    for (int e = 0; e < 8; ++e) { cnt[e] = (int)__hip_atomic_load(c + 64 * e, __ATOMIC_RELAXED, __HIP_MEMORY_SCOPE_AGENT); base[e] = acc; acc += (cnt[e] + 255) & ~255; }
    base[8] = acc;
}
__device__ __forceinline__ void moe_range(Frame& F, int e, int& lo, int& hi) {
    const unsigned* c = (const unsigned*)(F.ws + WS_CTL) + CW_MOECNT;
    int acc = 0; lo = 0; hi = 0;
#pragma unroll
    for (int k = 0; k < 8; ++k) { const int n = ((int)__hip_atomic_load(c + 64 * k, __ATOMIC_RELAXED, __HIP_MEMORY_SCOPE_AGENT) + 255) & ~255; if (k == e) { lo = acc; hi = acc + n; } acc += n; }
}
__device__ __forceinline__ void ph_moe_list(const Args& a, Frame& F) {
    int base[9], cnt[8]; moe_bases(F, base, cnt);
    int* RM = (int*)(F.ws + WS_RMAP); const int* R = (const int*)(F.ws + WS_ROUTE); const int* Pq = (const int*)(F.ws + WS_POS);
    for (int t = F.bid * NTHREADS + F.tid; t < T; t += F.nb * NTHREADS) {
        const int e0 = R[t * 4], e1 = R[t * 4 + 1];
        int b0 = 0, b1 = 0;
#pragma unroll
        for (int e = 0; e < 8; ++e) { if (e == e0) b0 = base[e]; if (e == e1) b1 = base[e]; }
        RM[b0 + Pq[t * 2]] = t; RM[b1 + Pq[t * 2 + 1]] = t;
    }
    if (F.bid == 0) {
#pragma unroll
        for (int e = 0; e < 8; ++e) { const int lo = base[e] + cnt[e], hi = base[e + 1]; for (int r = lo + F.tid; r < hi; r += NTHREADS) RM[r] = 0; }
    }
}
__device__ __forceinline__ void ph_final(const Args& a, Frame& F) {
    int base[9], cnt[8]; moe_bases(F, base, cnt);
    const float* MOD = (const float*)(F.ws + WS_MOD);
    const bf16_t* YM = (const bf16_t*)(F.ws + WS_YMOE); const int* R = (const int*)(F.ws + WS_ROUTE); const int* Pq = (const int*)(F.ws + WS_POS); const bf16_t* X16 = (const bf16_t*)(F.ws + WS_X16);
    const int c0 = 8 * F.lane;
    f32x4 fg[4], gt[4]; int cur_b = -1;
#pragma unroll
    for (int j = 0; j < 4; ++j) fg[j] = *(const f32x4*)(a.final_g + 512 * (j >> 1) + c0 + 4 * (j & 1));
    u32x4 rt_n; u32x2 pq_n;
    u32x4 dx[2], dy0[2], dy1[2]; float p0c = 0.f, p1c = 0.f;
#define FIN_ROUTE(row_, rt_, pq_) { rt_ = *(const u32x4*)(R + (size_t)(row_) * 4); pq_ = *(const u32x2*)(Pq + (size_t)(row_) * 2); }
#define FIN_DATA(row_, rt_, pq_) { int b0_ = 0, b1_ = 0; _Pragma("unroll") for (int e = 0; e < 8; ++e) { if (e == (int)rt_.x) b0_ = base[e]; if (e == (int)rt_.y) b1_ = base[e]; } \
        const size_t s0_ = (size_t)(b0_ + (int)pq_.x), s1_ = (size_t)(b1_ + (int)pq_.y); p0c = __uint_as_float(rt_.z); p1c = __uint_as_float(rt_.w); \
        _Pragma("unroll") for (int jj = 0; jj < 2; ++jj) { dx[jj] = __builtin_nontemporal_load((const u32x4*)(X16 + (size_t)(row_) * D + 512 * jj + c0)); dy0[jj] = __builtin_nontemporal_load((const u32x4*)(YM + s0_ * D + 512 * jj + c0)); dy1[jj] = __builtin_nontemporal_load((const u32x4*)(YM + s1_ * D + 512 * jj + c0)); } }
    if (F.gw < T) { u32x4 rt0; u32x2 pq0; FIN_ROUTE(F.gw, rt0, pq0) FIN_DATA(F.gw, rt0, pq0) }
    if (F.gw + F.ngw < T) FIN_ROUTE(F.gw + F.ngw, rt_n, pq_n)
    for (int row = F.gw; row < T; row += F.ngw) {
        const int b = row / SEQ;
        if (b != cur_b) { cur_b = b; const float* gt2 = MOD + ((size_t)(1 * 2 + 1) * 2 + b) * 3072 + 2048;
#pragma unroll
            for (int j = 0; j < 4; ++j) gt[j] = *(const f32x4*)(gt2 + 512 * (j >> 1) + c0 + 4 * (j & 1)); }
        f32x4 v[4]; float ss = 0.f; const float p0 = p0c, p1 = p1c;
#pragma unroll
        for (int jj = 0; jj < 2; ++jj) {
            const unsigned xw[4] = {dx[jj].x, dx[jj].y, dx[jj].z, dx[jj].w}, y0w[4] = {dy0[jj].x, dy0[jj].y, dy0[jj].z, dy0[jj].w}, y1w[4] = {dy1[jj].x, dy1[jj].y, dy1[jj].z, dy1[jj].w};
#pragma unroll
            for (int hf = 0; hf < 2; ++hf) {
                f32x4 f, xo;
                f.x = p0 * bf2f(y0w[2 * hf] & 0xffffu) + p1 * bf2f(y1w[2 * hf] & 0xffffu); f.y = p0 * bf2f(y0w[2 * hf] >> 16) + p1 * bf2f(y1w[2 * hf] >> 16);
                f.z = p0 * bf2f(y0w[2 * hf + 1] & 0xffffu) + p1 * bf2f(y1w[2 * hf + 1] & 0xffffu); f.w = p0 * bf2f(y0w[2 * hf + 1] >> 16) + p1 * bf2f(y1w[2 * hf + 1] >> 16);
                xo.x = bf2f(xw[2 * hf] & 0xffffu); xo.y = bf2f(xw[2 * hf] >> 16); xo.z = bf2f(xw[2 * hf + 1] & 0xffffu); xo.w = bf2f(xw[2 * hf + 1] >> 16);
                const f32x4 vv = xo + gt[2 * jj + hf] * f; v[2 * jj + hf] = vv;
                ss += (vv.x * vv.x + vv.y * vv.y) + (vv.z * vv.z + vv.w * vv.w);
            }
        }
        if (row + F.ngw < T) { FIN_DATA(row + F.ngw, rt_n, pq_n) }
        if (row + 2 * F.ngw < T) FIN_ROUTE(row + 2 * F.ngw, rt_n, pq_n)
        const float rstd = rsqrtf(wave_sum(ss) * (1.0f / D) + EPS);
        float* op = a.out + (size_t)row * D + c0;
#pragma unroll
        for (int j = 0; j < 4; ++j) __builtin_nontemporal_store((v[j] * rstd) * fg[j], (f32x4*)(op + 512 * (j >> 1) + 4 * (j & 1)));
    }
#undef FIN_ROUTE
#undef FIN_DATA
}


namespace pg8 {
typedef short bf16x8 __attribute__((ext_vector_type(8)));
constexpr int BM = 256, BK = 64, HALF = 128, HTB = HALF * BK * 2, STAGE_BYTES = 8 * HTB;
__device__ __forceinline__ int lds_byte(int r, int c) { const int st = (r >> 4) * 2 + (c >> 5), rr = r & 15, cc = c & 31, ob = rr * 64 + cc * 2; return st * 1024 + (ob ^ (((ob >> 9) & 1) << 5)); }
__device__ __forceinline__ void stage_rc(int b, int& R, int& C) { const int st = b / 1024, sb = b % 1024, swz = sb ^ (((sb >> 9) & 1) << 5); R = (st >> 1) * 16 + swz / 64; C = (st & 1) * 32 + (swz % 64) / 2; }
__device__ __forceinline__ int perm32(int rho) { const int n = rho >> 4, i = rho & 15; return 8 * (i >> 2) + 4 * n + (i & 3); }
struct Unit { int pm, pn, ord; };
struct Gemm { const bf16_t* A; const bf16_t* Bt; int K; };
constexpr int NXCD = 8, WGM = 8;
struct StaticOrder {
    int nM, nN, nwg, G, c;
    __device__ void init(int M, int N, int G_, int c_) { nM = M / BM; nN = N / BM; nwg = nM * nN; G = G_; c = c_; }
    __device__ __forceinline__ bool next(int i, Unit& u) const {
        const long L = (long)i * G + c; if (L >= nwg) return false;
        int wgid = (int)L; { const int q = nwg / NXCD, r = nwg % NXCD, xcd = wgid % NXCD, off = wgid / NXCD; wgid = (xcd < r ? xcd * (q + 1) : r * (q + 1) + (xcd - r) * q) + off; }
        const int nig = WGM * nN, gid = wgid / nig, fm = gid * WGM, gsz = (nM - fm) < WGM ? (nM - fm) : WGM;
        u.pm = fm + ((wgid % nig) % gsz); u.pn = (wgid % nig) / gsz; return true;
    }
};
template <int NT> struct MoeOrder {
    int bt[9]; int cnt[8]; int G, c;
    __device__ __forceinline__ bool next(int i, Unit& u) const {
        int q, tn;
        if ((G & 7) == 0) { const int x = c & 7, Ll = i * (G >> 3) + (c >> 3); q = (Ll / NT) * 8 + x; tn = Ll % NT; if (q >= bt[8]) return false; }
        else { const int L = i * G + c; if (L >= bt[8] * NT) return false; q = L / NT; tn = L % NT; }
        int e = 0;
#pragma unroll
        for (int k = 1; k < 8; ++k) e += (q >= bt[k]) ? 1 : 0;
        u.pm = q; u.pn = e * NT + tn; return true;
    }
};
__device__ __forceinline__ unsigned cvt_pk_bf16(float lo, float hi) { unsigned r; asm volatile("v_cvt_pk_bf16_f32 %0, %1, %2" : "=v"(r) : "v"(lo), "v"(hi)); return r; }
__device__ __forceinline__ float fast_silu(float x) { return x * __builtin_amdgcn_rcpf(1.0f + __builtin_amdgcn_exp2f(x * -1.4426950408889634f)); }

struct EpiBf16 {
    static constexpr bool PERM = true, WIDE = false;
    bf16_t* O; int ldc; int nmod;
    __device__ __forceinline__ void operator()(const f32x4 (&acc)[2][2][4][2], const Unit& u, int wr, int wc, int fr, int fq) const {
        const int row0 = u.pm * BM + wr * 64 + fr, col0 = (u.pn % nmod) * BM + wc * 32 + 8 * fq;
#pragma unroll
        for (int ai = 0; ai < 2; ++ai)
#pragma unroll
            for (int m = 0; m < 4; ++m) { bf16_t* rowp = O + (size_t)(row0 + ai * HALF + m * 16) * ldc + col0;
#pragma unroll
                for (int bj = 0; bj < 2; ++bj) { const f32x4 v0 = acc[ai][bj][m][0], v1 = acc[ai][bj][m][1];
                    u32x4 w; w.x = cvt_pk_bf16(v0[0], v0[1]); w.y = cvt_pk_bf16(v0[2], v0[3]); w.z = cvt_pk_bf16(v1[0], v1[1]); w.w = cvt_pk_bf16(v1[2], v1[3]);
                    *(u32x4*)(rowp + bj * HALF) = w; } }
    }
};
struct EpiSwiGLU {
    static constexpr bool PERM = true, WIDE = false;
    bf16_t* O; int ldc; int nmod;
    __device__ __forceinline__ void operator()(const f32x4 (&acc)[2][2][4][2], const Unit& u, int wr, int wc, int fr, int fq) const {
        const int row0 = u.pm * BM + wr * 64 + fr, col0 = (u.pn % nmod) * HALF + wc * 32 + 8 * fq;
#pragma unroll
        for (int ai = 0; ai < 2; ++ai)
#pragma unroll
            for (int m = 0; m < 4; ++m) {
                const f32x4 g0 = acc[ai][0][m][0], g1 = acc[ai][0][m][1], u0 = acc[ai][1][m][0], u1 = acc[ai][1][m][1];
                u32x4 w;
                w.x = cvt_pk_bf16(fast_silu(g0[0]) * u0[0], fast_silu(g0[1]) * u0[1]); w.y = cvt_pk_bf16(fast_silu(g0[2]) * u0[2], fast_silu(g0[3]) * u0[3]);
                w.z = cvt_pk_bf16(fast_silu(g1[0]) * u1[0], fast_silu(g1[1]) * u1[1]); w.w = cvt_pk_bf16(fast_silu(g1[2]) * u1[2], fast_silu(g1[3]) * u1[3]);
                *(u32x4*)(O + (size_t)(row0 + ai * HALF + m * 16) * ldc + col0) = w; }
    }
};
struct EpiResidF32 {
    static constexpr bool PERM = false, WIDE = false;
    const float* xin; float* xout; const float* gate;
    __device__ __forceinline__ void operator()(const f32x4 (&acc)[2][2][4][2], const Unit& u, int wr, int wc, int fr, int fq) const {
        const int row0 = u.pm * BM + wr * 64 + fr, col0 = u.pn * BM + wc * 32 + 4 * fq;
        const float* gp = gate + (size_t)((u.pm * BM) / SEQ) * 3072 + col0;
#pragma unroll
        for (int bj = 0; bj < 2; ++bj)
#pragma unroll
            for (int n = 0; n < 2; ++n) { const f32x4 g4 = *(const f32x4*)(gp + bj * HALF + n * 16);
#pragma unroll
                for (int ai = 0; ai < 2; ++ai)
#pragma unroll
                    for (int m = 0; m < 4; ++m) { const size_t off = (size_t)(row0 + ai * HALF + m * 16) * D + col0 + bj * HALF + n * 16;
                        const f32x4 x4 = *(const f32x4*)(xin + off); *(f32x4*)(xout + off) = x4 + g4 * acc[ai][bj][m][n]; } }
    }
};


__device__ __forceinline__ u32x4 xchg8(u32x4 v) { u32x4 r;
    r.x = (unsigned)__builtin_amdgcn_update_dpp(0, (int)v.x, 0x128, 0xf, 0xf, false); r.y = (unsigned)__builtin_amdgcn_update_dpp(0, (int)v.y, 0x128, 0xf, 0xf, false);
    r.z = (unsigned)__builtin_amdgcn_update_dpp(0, (int)v.z, 0x128, 0xf, 0xf, false); r.w = (unsigned)__builtin_amdgcn_update_dpp(0, (int)v.w, 0x128, 0xf, 0xf, false); return r; }
__device__ __forceinline__ u32x4 pack8(f32x4 v0, f32x4 v1) { u32x4 w; w.x = cvt_pk_bf16(v0[0], v0[1]); w.y = cvt_pk_bf16(v0[2], v0[3]); w.z = cvt_pk_bf16(v1[0], v1[1]); w.w = cvt_pk_bf16(v1[2], v1[3]); return w; }
template <bool NT = true> __device__ __forceinline__ void store_wide(bf16_t* p, int ld, int fr, int fq, u32x4 pk0, u32x4 pk1) {
    const bool lo = fr < 8; const u32x4 rcv = xchg8(lo ? pk1 : pk0);
    bf16_t* q = p + (size_t)(fr & 7) * ld + 8 * fq + (lo ? 0 : 32);
    if constexpr (NT) { __builtin_nontemporal_store(lo ? pk0 : rcv, (u32x4*)q); __builtin_nontemporal_store(lo ? rcv : pk1, (u32x4*)(q + (size_t)8 * ld)); }
    else { *(u32x4*)q = lo ? pk0 : rcv; *(u32x4*)(q + (size_t)8 * ld) = lo ? rcv : pk1; }
}
struct EpiBf16W {
    static constexpr bool PERM = true, WIDE = true;
    bf16_t* O; int ldc; int nmod;
    __device__ __forceinline__ void operator()(const f32x4 (&acc)[2][2][4][2], const Unit& u, int wr, int wc, int fr, int fq) const {
        bf16_t* base = O + (size_t)(u.pm * BM + wr * 64) * ldc + (u.pn % nmod) * BM + wc * 64;
#pragma unroll
        for (int ai = 0; ai < 2; ++ai)
#pragma unroll
            for (int m = 0; m < 4; ++m) store_wide(base + (size_t)(ai * HALF + m * 16) * ldc, ldc, fr, fq, pack8(acc[ai][0][m][0], acc[ai][0][m][1]), pack8(acc[ai][1][m][0], acc[ai][1][m][1]));
    }
};
struct EpiResidNorm {
    static constexpr bool PERM = true, WIDE = true;
    const bf16_t* xin; bf16_t* x16; const float* gate; const float* av; bf16_t* xa; float* ssqp;
    __device__ __forceinline__ void operator()(const f32x4 (&acc)[2][2][4][2], const Unit& u, int wr, int wc, int fr, int fq) const {
        const int rowb = u.pm * BM + wr * 64, colw = u.pn * BM + wc * 64, b = (u.pm * BM) / SEQ;
        const bool lo = fr < 8;
        const size_t lane_off = (size_t)(fr & 7) * D + colw + 8 * fq + (lo ? 0 : 32);
        f32x4 gv[2][2], avv[2][2];
#pragma unroll
        for (int bj = 0; bj < 2; ++bj)
#pragma unroll
            for (int n = 0; n < 2; ++n) { gv[bj][n] = *(const f32x4*)(gate + (size_t)b * 3072 + colw + 32 * bj + 8 * fq + 4 * n); avv[bj][n] = *(const f32x4*)(av + (size_t)b * 1024 + colw + 32 * bj + 8 * fq + 4 * n); }
        u32x4 la[4][2], lb[4][2];
#define ERN_LOAD(k_) { _Pragma("unroll") for (int mm = 0; mm < 2; ++mm) { const bf16_t* q = xin + (size_t)(rowb + ((k_) >> 1) * HALF + (2 * ((k_) & 1) + mm) * 16) * D + lane_off; la[k_][mm] = __builtin_nontemporal_load((const u32x4*)q); lb[k_][mm] = __builtin_nontemporal_load((const u32x4*)(q + (size_t)8 * D)); } }
        ERN_LOAD(0)
#pragma unroll
        for (int k = 0; k < 4; ++k) {
            const int ai = k >> 1;
            if (k == 0) ERN_LOAD(1) else if (k == 1) ERN_LOAD(2) else if (k == 2) ERN_LOAD(3)
            asm volatile("" ::: "memory");
#pragma unroll
            for (int mm = 0; mm < 2; ++mm) {
                const int m = 2 * (k & 1) + mm;
                const u32x4 rcv = xchg8(lo ? lb[k][mm] : la[k][mm]);
                const u32x4 xb0 = lo ? la[k][mm] : rcv, xb1 = lo ? rcv : lb[k][mm];
                f32x4 x00, x01, x10, x11;
                x00.x = __uint_as_float(xb0.x << 16); x00.y = __uint_as_float(xb0.x & 0xffff0000u); x00.z = __uint_as_float(xb0.y << 16); x00.w = __uint_as_float(xb0.y & 0xffff0000u);
                x01.x = __uint_as_float(xb0.z << 16); x01.y = __uint_as_float(xb0.z & 0xffff0000u); x01.z = __uint_as_float(xb0.w << 16); x01.w = __uint_as_float(xb0.w & 0xffff0000u);
                x10.x = __uint_as_float(xb1.x << 16); x10.y = __uint_as_float(xb1.x & 0xffff0000u); x10.z = __uint_as_float(xb1.y << 16); x10.w = __uint_as_float(xb1.y & 0xffff0000u);
                x11.x = __uint_as_float(xb1.z << 16); x11.y = __uint_as_float(xb1.z & 0xffff0000u); x11.z = __uint_as_float(xb1.w << 16); x11.w = __uint_as_float(xb1.w & 0xffff0000u);
                const f32x4 n00 = x00 + gv[0][0] * acc[ai][0][m][0], n01 = x01 + gv[0][1] * acc[ai][0][m][1], n10 = x10 + gv[1][0] * acc[ai][1][m][0], n11 = x11 + gv[1][1] * acc[ai][1][m][1];
                float sv = (((n00.x * n00.x + n00.y * n00.y) + (n00.z * n00.z + n00.w * n00.w)) + ((n01.x * n01.x + n01.y * n01.y) + (n01.z * n01.z + n01.w * n01.w)))
                         + (((n10.x * n10.x + n10.y * n10.y) + (n10.z * n10.z + n10.w * n10.w)) + ((n11.x * n11.x + n11.y * n11.y) + (n11.z * n11.z + n11.w * n11.w)));
                const size_t ro = (size_t)(rowb + ai * HALF + m * 16) * D + colw;
                store_wide<false>(x16 + ro, D, fr, fq, pack8(n00, n01), pack8(n10, n11));
                store_wide<false>(xa + ro, D, fr, fq, pack8(n00 * avv[0][0], n01 * avv[0][1]), pack8(n10 * avv[1][0], n11 * avv[1][1]));
                sv = xor32_sum(xor16_sum(sv));
                if (fq == 0) ssqp[(size_t)(rowb + ai * HALF + m * 16 + fr) * 16 + u.pn * 4 + wc] = sv;
            }
        }
#undef ERN_LOAD
    }
};
struct EpiProjNorm {
    static constexpr bool PERM = true, WIDE = true;
    bf16_t* O; const LAS float* RS; const float* cv; float* BG; const float* a_log; const float* dt_bias;
    __device__ __forceinline__ void operator()(const f32x4 (&acc)[2][2][4][2], const Unit& u, int wr, int wc, int fr, int fq) const {
        const int rl0 = wr * 64 + fr, colw = u.pn * BM + wc * 64, b = (u.pm * BM) / SEQ;
        const float* cp = cv + (size_t)b * NPW + colw + 8 * fq;
        if (u.pn < NP / BM) {
            f32x4 c4[2][2];
#pragma unroll
            for (int bj = 0; bj < 2; ++bj)
#pragma unroll
                for (int n = 0; n < 2; ++n) c4[bj][n] = *(const f32x4*)(cp + 32 * bj + 4 * n);
            bf16_t* base = O + (size_t)(u.pm * BM + wr * 64) * NP + colw;
#pragma unroll
            for (int ai = 0; ai < 2; ++ai)
#pragma unroll
                for (int m = 0; m < 4; ++m) { const float rs = fabsf(RS[u.ord * 256 + rl0 + ai * HALF + m * 16]);
                    store_wide(base + (size_t)(ai * HALF + m * 16) * NP, NP, fr, fq, pack8(acc[ai][0][m][0] * rs + c4[0][0], acc[ai][0][m][1] * rs + c4[0][1]), pack8(acc[ai][1][m][0] * rs + c4[1][0], acc[ai][1][m][1] * rs + c4[1][1])); }
        } else if (wc == 0 && fq == 0) {
            const f32x4 c0 = *(const f32x4*)(cp), c1 = *(const f32x4*)(cp + 4);
            const f32x4 al = *(const f32x4*)a_log, db = *(const f32x4*)dt_bias;
#pragma unroll
            for (int ai = 0; ai < 2; ++ai)
#pragma unroll
                for (int m = 0; m < 4; ++m) { const int rl = rl0 + ai * HALF + m * 16; const float rs = fabsf(RS[u.ord * 256 + rl]);
                    const f32x4 vb = acc[ai][0][m][0] * rs + c0, va = acc[ai][0][m][1] * rs + c1;
                    f32x4 be, gg;
#pragma unroll
                    for (int hh = 0; hh < 4; ++hh) { be[hh] = sigmoidf_(vb[hh]); gg[hh] = -__expf(al[hh]) * softplusf_(va[hh] + db[hh]); }
                    float* bg = BG + (size_t)(u.pm * BM + rl) * 8; *(f32x4*)bg = be; *(f32x4*)(bg + 4) = gg; }
        }
    }
};
struct EpiNull {
    static constexpr bool PERM = true, WIDE = false;
    __device__ __forceinline__ void operator()(const f32x4 (&acc)[2][2][4][2], const Unit& u, int wr, int wc, int fr, int fq) const {
#pragma unroll
        for (int ai = 0; ai < 2; ++ai)
#pragma unroll
            for (int bj = 0; bj < 2; ++bj)
#pragma unroll
                for (int m = 0; m < 4; ++m)
#pragma unroll
                    for (int n = 0; n < 2; ++n) asm volatile("" :: "v"(acc[ai][bj][m][n]));
    }
};
struct EpiSwiGLUNorm {
    static constexpr bool PERM = true, WIDE = false;
    bf16_t* O; int ldc; int nmod; const LAS float* RS; const float* cv; int ncv;
    __device__ __forceinline__ void operator()(const f32x4 (&acc)[2][2][4][2], const Unit& u, int wr, int wc, int fr, int fq) const {
        const int rl0 = wr * 64 + fr, col0 = (u.pn % nmod) * HALF + wc * 32 + 8 * fq;
        const float* cp = cv + (size_t)u.pn * BM + wc * 32 + 8 * fq;
        f32x4 cg[2][2], cu[2][2];
#pragma unroll
        for (int bb = 0; bb < 2; ++bb)
#pragma unroll
            for (int n = 0; n < 2; ++n) { cg[bb][n] = *(const f32x4*)(cp + (size_t)bb * ncv + 4 * n); cu[bb][n] = *(const f32x4*)(cp + (size_t)bb * ncv + HALF + 4 * n); }
#pragma unroll
        for (int ai = 0; ai < 2; ++ai)
#pragma unroll
            for (int m = 0; m < 4; ++m) { const int rl = rl0 + ai * HALF + m * 16; const float rsv = RS[u.ord * 256 + rl], rs = fabsf(rsv); const bool b1 = rsv < 0.f;
                const f32x4 g0 = acc[ai][0][m][0] * rs + (b1 ? cg[1][0] : cg[0][0]), g1 = acc[ai][0][m][1] * rs + (b1 ? cg[1][1] : cg[0][1]);
                const f32x4 u0 = acc[ai][1][m][0] * rs + (b1 ? cu[1][0] : cu[0][0]), u1 = acc[ai][1][m][1] * rs + (b1 ? cu[1][1] : cu[0][1]);
                u32x4 w;
                w.x = cvt_pk_bf16(fast_silu(g0[0]) * u0[0], fast_silu(g0[1]) * u0[1]); w.y = cvt_pk_bf16(fast_silu(g0[2]) * u0[2], fast_silu(g0[3]) * u0[3]);
                w.z = cvt_pk_bf16(fast_silu(g1[0]) * u1[0], fast_silu(g1[1]) * u1[1]); w.w = cvt_pk_bf16(fast_silu(g1[2]) * u1[2], fast_silu(g1[3]) * u1[3]);
                __builtin_nontemporal_store(w, (u32x4*)(O + (size_t)(u.pm * BM + rl) * ldc + col0)); }
    }
};

template <class Epi, class Sched, bool GATHER, bool ALIGN_EPI, bool SP2>
__device__ __forceinline__ void gemm_phase(LAS unsigned char* lds, const LAS int* RI, const Gemm g, const Sched& S, const Epi& E) {
    const int tid = threadIdx.x, wid = __builtin_amdgcn_readfirstlane(tid >> 6), lane = tid & 63, wr = wid >> 2, wc = wid & 3, fr = lane & 15, fq = lane >> 4;
    const int K = g.K, nt = K / BK;
    unsigned voffB[2]; int Ra[2]; unsigned Ca2[2];
#pragma unroll
    for (int i = 0; i < 2; ++i) { int R, C; stage_rc(tid * 16 + i * 8192, R, C); const int Rb = Epi::WIDE ? ((R >> 5) * 64 + perm32(R & 31)) : (Epi::PERM ? ((R & ~31) + perm32(R & 31)) : R);
        Ra[i] = R; Ca2[i] = (unsigned)C * 2u; voffB[i] = (unsigned)(Rb * K + C) * 2u; }
    const size_t kstep = (size_t)(BK * 2);
    const size_t hstep = (size_t)HALF * K * 2;
    const size_t tstep = 2 * hstep;
    const size_t hstepB = Epi::WIDE ? (size_t)32 * K * 2 : hstep;
    const unsigned rowb = (unsigned)K * 2u;
    const unsigned ldsw = (unsigned)wid * 1024u;
    const int aoff = lds_byte(wr * 64 + fr, fq * 8), boff = lds_byte(wc * 32 + fr, fq * 8);
#define PG8_SA(b, h) (((b) * 2 + (h)) * HTB)
#define PG8_SB(b, h) ((4 + (b) * 2 + (h)) * HTB)
#define PG8_STAGE_B(bufoff, gbase) do { _Pragma("unroll") for (int _i = 0; _i < 2; ++_i) \
        __builtin_amdgcn_global_load_lds((const unsigned*)((const char*)(gbase) + voffB[_i]), (LAS unsigned*)(lds + (bufoff) + ldsw + _i * 8192), 16, 0, 0); } while (0)
#define PG8_STAGE_A(bufoff, kb, off) do { _Pragma("unroll") for (int _i = 0; _i < 2; ++_i) \
        __builtin_amdgcn_global_load_lds((const unsigned*)((const char*)g.A + (size_t)(kb) + (off)[_i]), (LAS unsigned*)(lds + (bufoff) + ldsw + _i * 8192), 16, 0, 0); } while (0)
#define PG8_LDA(dst, b, h) do { _Pragma("unroll") for (int m = 0; m < 4; ++m) _Pragma("unroll") for (int k = 0; k < 2; ++k) dst[m][k] = *(const LAS bf16x8*)(lds + PG8_SA(b, h) + aoff + m * 2048 + k * 1024); } while (0)
#define PG8_LDB(dst, b, h) do { _Pragma("unroll") for (int n = 0; n < 2; ++n) _Pragma("unroll") for (int k = 0; k < 2; ++k) dst[n][k] = *(const LAS bf16x8*)(lds + PG8_SB(b, h) + boff + n * 2048 + k * 1024); } while (0)
#define PG8_MMA(ai, bj, At, Bt) do { __builtin_amdgcn_s_setprio(1); _Pragma("unroll") for (int m = 0; m < 4; ++m) _Pragma("unroll") for (int n = 0; n < 2; ++n) _Pragma("unroll") for (int k = 0; k < 2; ++k) \
        acc[ai][bj][m][n] = __builtin_amdgcn_mfma_f32_16x16x32_bf16(Bt[n][k], At[m][k], acc[ai][bj][m][n], 0, 0, 0); __builtin_amdgcn_s_setprio(0); } while (0)
#define PG8_WAIT_V(n) asm volatile("s_waitcnt vmcnt(" #n ")" ::: "memory")
#define PG8_WAIT_L(n) asm volatile("s_waitcnt lgkmcnt(" #n ")" ::: "memory")
#define PG8_BAR __builtin_amdgcn_s_barrier()
#define PG8_SCHED __builtin_amdgcn_sched_barrier(0)
#define PG8_AOFFS(dst, ui_, un_) do { _Pragma("unroll") for (int _h = 0; _h < 2; ++_h) _Pragma("unroll") for (int _i = 0; _i < 2; ++_i) { \
        const unsigned _row = GATHER ? (unsigned)RI[(ui_) * 256 + _h * HALF + Ra[_i]] : (unsigned)((un_).pm * BM + _h * HALF + Ra[_i]); dst[_h][_i] = _row * rowb + Ca2[_i]; } } while (0)
    Unit cur, nxt; int ui = 0;
    if (!S.next(0, cur)) return;
    cur.ord = 0;
    f32x4 acc[2][2][4][2];
#pragma unroll
    for (int a = 0; a < 2; ++a)
#pragma unroll
        for (int b = 0; b < 2; ++b)
#pragma unroll
            for (int m = 0; m < 4; ++m)
#pragma unroll
                for (int n = 0; n < 2; ++n) acc[a][b][m][n] = (f32x4){0.f, 0.f, 0.f, 0.f};
    bf16x8 At[4][2], B0[2][2], B1[2][2];
    unsigned cv[2][2], nv[2][2];
    PG8_AOFFS(cv, 0, cur);
    const char* cB = (const char*)g.Bt + (size_t)cur.pn * tstep;
    if constexpr (SP2) {
        PG8_STAGE_B(PG8_SB(0, 0), cB); PG8_STAGE_B(PG8_SB(0, 1), cB + hstepB); PG8_STAGE_A(PG8_SA(0, 0), 0, cv[0]); PG8_STAGE_A(PG8_SA(0, 1), 0, cv[1]);
        if (wr == 1) PG8_BAR;
        PG8_WAIT_V(2); PG8_BAR;
        PG8_STAGE_B(PG8_SB(1, 0), cB + kstep); PG8_STAGE_A(PG8_SA(1, 0), kstep, cv[0]); PG8_STAGE_B(PG8_SB(1, 1), cB + hstepB + kstep);
        PG8_WAIT_V(6); PG8_BAR;
    } else {
        PG8_STAGE_B(PG8_SB(0, 0), cB); PG8_STAGE_A(PG8_SA(0, 0), 0, cv[0]); PG8_STAGE_B(PG8_SB(0, 1), cB + hstepB); PG8_STAGE_A(PG8_SA(0, 1), 0, cv[1]);
        if (wr == 1) PG8_BAR;
        PG8_WAIT_V(4); PG8_BAR;
        PG8_STAGE_B(PG8_SB(1, 0), cB + kstep); PG8_STAGE_A(PG8_SA(1, 0), kstep, cv[0]); PG8_STAGE_B(PG8_SB(1, 1), cB + hstepB + kstep);
        PG8_WAIT_V(6); PG8_BAR;
    }
    for (;;) {
        const bool has_next = S.next(ui + 1, nxt); nxt.ord = ui + 1;
        const char* nB = has_next ? (const char*)g.Bt + (size_t)nxt.pn * tstep : cB;
        if (has_next) { PG8_AOFFS(nv, ui + 1, nxt); }
        else {
#pragma unroll
            for (int h = 0; h < 2; ++h)
#pragma unroll
                for (int i = 0; i < 2; ++i) nv[h][i] = cv[h][i]; }
        for (int t = 0; t < nt; t += 2) {
            const bool last = (t == nt - 2);
            const size_t kb1 = (size_t)(t + 1) * kstep, kb2 = last ? (size_t)0 : (size_t)(t + 2) * kstep, kb3 = kb2 + kstep;
            const char* b2 = last ? nB : cB + (size_t)(t + 2) * kstep; const char* b3 = b2 + kstep;
            unsigned o2[2][2];
#pragma unroll
            for (int h = 0; h < 2; ++h)
#pragma unroll
                for (int i = 0; i < 2; ++i) o2[h][i] = last ? nv[h][i] : cv[h][i];
            if constexpr (SP2) {
            PG8_LDB(B0, 0, 0); PG8_LDB(B1, 0, 1); PG8_SCHED; PG8_LDA(At, 0, 0); PG8_STAGE_A(PG8_SA(1, 1), kb1, cv[1]);
            PG8_WAIT_V(8); PG8_WAIT_L(0); PG8_BAR; PG8_MMA(0, 0, At, B0); PG8_MMA(0, 1, At, B1); PG8_BAR; PG8_SCHED;
            PG8_LDA(At, 0, 1); PG8_STAGE_B(PG8_SB(0, 0), b2); PG8_STAGE_B(PG8_SB(0, 1), b2 + hstepB); PG8_STAGE_A(PG8_SA(0, 0), kb2, o2[0]);
            PG8_WAIT_V(8); PG8_WAIT_L(0); PG8_BAR; PG8_MMA(1, 0, At, B0); PG8_MMA(1, 1, At, B1); PG8_BAR; PG8_SCHED;
            PG8_LDB(B0, 1, 0); PG8_LDB(B1, 1, 1); PG8_SCHED; PG8_LDA(At, 1, 0); PG8_STAGE_A(PG8_SA(0, 1), kb2, o2[1]);
            PG8_WAIT_V(8); PG8_WAIT_L(0); PG8_BAR; PG8_MMA(0, 0, At, B0); PG8_MMA(0, 1, At, B1); PG8_BAR; PG8_SCHED;
            PG8_LDA(At, 1, 1); PG8_STAGE_B(PG8_SB(1, 0), b3); PG8_STAGE_B(PG8_SB(1, 1), b3 + hstepB); PG8_STAGE_A(PG8_SA(1, 0), kb3, o2[0]);
            PG8_WAIT_V(8); PG8_WAIT_L(0); PG8_BAR; PG8_MMA(1, 0, At, B0); PG8_MMA(1, 1, At, B1); PG8_BAR; PG8_SCHED;
            } else {
            PG8_LDB(B0, 0, 0); PG8_SCHED; PG8_LDA(At, 0, 0); PG8_STAGE_A(PG8_SA(1, 1), kb1, cv[1]);
            PG8_WAIT_L(8); PG8_BAR; PG8_WAIT_L(0); PG8_MMA(0, 0, At, B0); PG8_BAR; PG8_SCHED;
            PG8_LDB(B1, 0, 1); PG8_STAGE_B(PG8_SB(0, 0), b2);
            PG8_BAR; PG8_WAIT_L(0); PG8_MMA(0, 1, At, B1); PG8_BAR;
            PG8_LDA(At, 0, 1); PG8_STAGE_A(PG8_SA(0, 0), kb2, o2[0]);
            PG8_BAR; PG8_WAIT_L(0); PG8_MMA(1, 0, At, B0); PG8_BAR; PG8_SCHED;
            PG8_STAGE_B(PG8_SB(0, 1), b2 + hstepB);
            PG8_WAIT_V(6); PG8_BAR; PG8_MMA(1, 1, At, B1); PG8_BAR;
            PG8_LDB(B0, 1, 0); PG8_SCHED; PG8_LDA(At, 1, 0); PG8_STAGE_A(PG8_SA(0, 1), kb2, o2[1]);
            PG8_WAIT_L(8); PG8_BAR; PG8_WAIT_L(0); PG8_MMA(0, 0, At, B0); PG8_BAR; PG8_SCHED;
            PG8_LDB(B1, 1, 1); PG8_STAGE_B(PG8_SB(1, 0), b3);
            PG8_BAR; PG8_WAIT_L(0); PG8_MMA(0, 1, At, B1); PG8_BAR;
            PG8_LDA(At, 1, 1); PG8_STAGE_A(PG8_SA(1, 0), kb3, o2[0]);
            PG8_BAR; PG8_WAIT_L(0); PG8_MMA(1, 0, At, B0); PG8_BAR; PG8_SCHED;
            PG8_STAGE_B(PG8_SB(1, 1), b3 + hstepB);
            PG8_WAIT_V(6); PG8_BAR; PG8_MMA(1, 1, At, B1); PG8_BAR;
            }
        }
        if constexpr (ALIGN_EPI) { if (wr == 0) PG8_BAR; }
        E(acc, cur, wr, wc, fr, fq);
        if (!has_next) break;
#pragma unroll
        for (int a = 0; a < 2; ++a)
#pragma unroll
            for (int b = 0; b < 2; ++b)
#pragma unroll
                for (int m = 0; m < 4; ++m)
#pragma unroll
                    for (int n = 0; n < 2; ++n) acc[a][b][m][n] = (f32x4){0.f, 0.f, 0.f, 0.f};
        cur = nxt; cB = nB; ++ui;
#pragma unroll
        for (int h = 0; h < 2; ++h)
#pragma unroll
            for (int i = 0; i < 2; ++i) cv[h][i] = nv[h][i];
        if constexpr (ALIGN_EPI) { if (wr == 1) PG8_BAR; }
    }
    PG8_WAIT_V(0);
    if constexpr (!ALIGN_EPI) { if (wr == 0) PG8_BAR; }
    PG8_BAR;
#undef PG8_SA
#undef PG8_SB
#undef PG8_STAGE_A
#undef PG8_STAGE_B
#undef PG8_LDA
#undef PG8_LDB
#undef PG8_MMA
#undef PG8_WAIT_V
#undef PG8_WAIT_L
#undef PG8_BAR
#undef PG8_SCHED
#undef PG8_AOFFS
}
}

__device__ __forceinline__ void transpose_item(const float* W, int pitch, int k0, int n0, bf16_t* WT, int Kd, int drow0, LAS float* scr, int lane) {
#pragma unroll 8
    for (int i = 0; i < 32; ++i) { const int kk = 2 * i + (lane >> 5); scr[kk * 33 + (lane & 31)] = __builtin_nontemporal_load(W + (size_t)(k0 + kk) * pitch + n0 + (lane & 31)); }
    asm volatile("s_waitcnt lgkmcnt(0)" ::: "memory");
    const int c = lane & 7;
#pragma unroll
    for (int j = 0; j < 4; ++j) { const int n = (lane >> 3) + 8 * j; const LAS float* s = scr + (8 * c) * 33 + n;
        u32x4 o; o.x = pk2(s[0 * 33], s[1 * 33]); o.y = pk2(s[2 * 33], s[3 * 33]); o.z = pk2(s[4 * 33], s[5 * 33]); o.w = pk2(s[6 * 33], s[7 * 33]);
        *(u32x4*)(WT + (size_t)(drow0 + n) * Kd + k0 + 8 * c) = o; }
    asm volatile("s_waitcnt lgkmcnt(0)" ::: "memory");
}
constexpr size_t WT_WIN = 0, WT_WOUT = WT_WIN + (size_t)2 * NPW * D, WT_FGU = WT_WOUT + (size_t)2 * D * D, WT_FD = WT_FGU + (size_t)2 * D_FF * D,
                 WT_MGU = WT_FD + (size_t)D * D_FF, WT_MD = WT_MGU + (size_t)NE * 2 * D_FFE * D, WT_END = WT_MD + (size_t)NE * D * D_FFE;
static_assert(WT_END * 2 <= 80 * MiB, "weight copies fit");
__device__ __forceinline__ void ph_pro_weights(const Args& a, Frame& F) {
    LAS float* scr = (LAS float*)(F.lds + F.wave * 16384);
    bf16_t* WT = (bf16_t*)(F.ws + WS_WT);
    constexpr int I_IN0 = 16 * 48, I_IN1 = 16 * 24, I_OUT = 16 * 32, I_FG = 16 * 88, I_FD = 44 * 32, I_M = 16 * 32;
    constexpr int NITEMS = 2 * (I_IN0 + I_IN1 + I_OUT) + 2 * I_FG + I_FD + 24 * I_M;
    for (int it = F.gw; it < NITEMS; it += F.ngw) {
        int r = it; const float* src; int pitch, k0, n0, Kd, drow0; bf16_t* dst;
        if (r < 2 * I_IN0) { const int l = r / I_IN0; r %= I_IN0; src = a.w_in + (size_t)l * D * N_IN; pitch = N_IN; k0 = (r / 48) * 64; n0 = (r % 48) * 32; dst = WT + WT_WIN + (size_t)l * NPW * D; Kd = D; drow0 = n0; }
        else if ((r -= 2 * I_IN0) < 2 * I_IN1) { const int l = r / I_IN1; r %= I_IN1; src = a.w_in + (size_t)l * D * N_IN + 1544; pitch = N_IN; k0 = (r / 24) * 64; n0 = (r % 24) * 32; dst = WT + WT_WIN + (size_t)l * NPW * D; Kd = D; drow0 = 1536 + n0; }
        else if ((r -= 2 * I_IN1) < 2 * I_OUT) { const int l = r / I_OUT; r %= I_OUT; src = a.w_out + (size_t)l * D * D; pitch = D; k0 = (r / 32) * 64; n0 = (r % 32) * 32; dst = WT + WT_WOUT + (size_t)l * D * D; Kd = D; drow0 = n0; }
        else if ((r -= 2 * I_OUT) < 2 * I_FG) { const int up = r / I_FG; r %= I_FG; src = up ? a.ffn_wu : a.ffn_wg; pitch = D_FF; k0 = (r / 88) * 64; n0 = (r % 88) * 32; dst = WT + WT_FGU; Kd = D; drow0 = (n0 / 128) * 256 + up * 128 + (n0 % 128); }
        else if ((r -= 2 * I_FG) < I_FD) { src = a.ffn_wd; pitch = D; k0 = (r / 32) * 64; n0 = (r % 32) * 32; dst = WT + WT_FD; Kd = D_FF; drow0 = n0; }
        else if ((r -= I_FD) < 16 * I_M) { const int e = r / (2 * I_M); r %= 2 * I_M; const int up = r / I_M; r %= I_M; src = (up ? a.moe_wu : a.moe_wg) + (size_t)e * D * D_FFE; pitch = D_FFE; k0 = (r / 32) * 64; n0 = (r % 32) * 32;
            dst = WT + WT_MGU + (size_t)e * 2 * D_FFE * D; Kd = D; drow0 = (n0 / 128) * 256 + up * 128 + (n0 % 128); }
        else { r -= 16 * I_M; const int e = r / I_M; r %= I_M; src = a.moe_wd + (size_t)e * D_FFE * D; pitch = D; k0 = (r / 32) * 64; n0 = (r % 32) * 32; dst = WT + WT_MD + (size_t)e * D * D_FFE; Kd = D_FFE; drow0 = n0; }
        transpose_item(src, pitch, k0, n0, dst, Kd, drow0, scr, F.lane);
    }
    for (int idx = F.bid * NTHREADS + F.tid; idx < 2 * 256 * D; idx += F.nb * NTHREADS) {
        const int l = idx / (256 * D), r = (idx / D) % 256, k = idx % D;
        WT[WT_WIN + (size_t)l * NPW * D + (size_t)(2304 + r) * D + k] = (r < 8) ? (bf16_t)f2bf(a.w_in[(size_t)l * D * N_IN + (size_t)k * N_IN + W_DB + r]) : (bf16_t)0;
    }
}

template <int NT> __device__ __forceinline__ void moe_order_init(Frame& F, pg8::MoeOrder<NT>& S) {
    const unsigned* c = (const unsigned*)(F.ws + WS_CTL) + CW_MOECNT;
    int acc = 0;
#pragma unroll
    for (int e = 0; e < 8; ++e) { S.cnt[e] = (int)__hip_atomic_load(c + 64 * e, __ATOMIC_RELAXED, __HIP_MEMORY_SCOPE_AGENT); S.bt[e] = acc; acc += (S.cnt[e] + 255) >> 8; }
    S.bt[8] = acc; S.G = F.nb; S.c = F.bid;
}
template <int NT> __device__ __forceinline__ int moe_ri_one(Frame& F, const pg8::MoeOrder<NT>& S, const int* RM, int o, int t) {
    pg8::Unit u; if (!S.next(o, u)) return -1;
    const int e = u.pn / NT; int bte = 0, cne = 0;
#pragma unroll
    for (int kk = 0; kk < 8; ++kk) { if (kk == e) { bte = S.bt[kk]; cne = S.cnt[kk]; } }
    const int sl = (u.pm - bte) * 256 + t; return (sl < cne) ? RM[(size_t)e * T + sl] : 0;
}
template <int NT> __device__ __forceinline__ void moe_ri_preload(Frame& F, const pg8::MoeOrder<NT>& S) {
    LAS int* RI = (LAS int*)(F.lds + RI_OFF); const int* RM = (const int*)(F.ws + WS_RMAP);
    const int t = F.tid & 255, par = F.tid >> 8;
    const int v0 = moe_ri_one<NT>(F, S, RM, par, t), v1 = moe_ri_one<NT>(F, S, RM, par + 2, t), v2 = moe_ri_one<NT>(F, S, RM, par + 4, t), v3 = moe_ri_one<NT>(F, S, RM, par + 6, t);
    const int v4 = moe_ri_one<NT>(F, S, RM, par + 8, t), v5 = moe_ri_one<NT>(F, S, RM, par + 10, t), v6 = moe_ri_one<NT>(F, S, RM, par + 12, t), v7 = moe_ri_one<NT>(F, S, RM, par + 14, t);
    if (v0 >= 0) RI[(par) * 256 + t] = v0; if (v1 >= 0) RI[(par + 2) * 256 + t] = v1; if (v2 >= 0) RI[(par + 4) * 256 + t] = v2; if (v3 >= 0) RI[(par + 6) * 256 + t] = v3;
    if (v4 >= 0) RI[(par + 8) * 256 + t] = v4; if (v5 >= 0) RI[(par + 10) * 256 + t] = v5; if (v6 >= 0) RI[(par + 12) * 256 + t] = v6;
    if (v7 >= 0 && par + 14 < 15) RI[(par + 14) * 256 + t] = v7;
    __syncthreads();
}

__device__ __forceinline__ void ph_norm0(const Args& a, Frame& F) {
    const float* MOD = (const float*)(F.ws + WS_MOD);
    bf16_t* XA = (bf16_t*)(F.ws + WS_H); bf16_t* X16 = (bf16_t*)(F.ws + WS_X16); float* SSQ = (float*)(F.ws + WS_SSQ) + (size_t)3 * T * 16;
    f32x4 vn[4], A4[4]; int cur_b = -1;
#define N0_LOAD(row_) { const f32x4* p_ = (const f32x4*)(a.x + (size_t)(row_) * D) + 2 * F.lane; vn[0] = __builtin_nontemporal_load(p_); vn[1] = __builtin_nontemporal_load(p_ + 1); vn[2] = __builtin_nontemporal_load(p_ + 128); vn[3] = __builtin_nontemporal_load(p_ + 129); }
    if (F.gw < T) N0_LOAD(F.gw)
    for (int row = F.gw; row < T; row += F.ngw) {
        const int b = row / SEQ;
        f32x4 v[4]; float ss = 0.f;
#pragma unroll
        for (int j = 0; j < 4; ++j) { v[j] = vn[j]; ss += (v[j].x * v[j].x + v[j].y * v[j].y) + (v[j].z * v[j].z + v[j].w * v[j].w); }
        if (row + F.ngw < T) N0_LOAD(row + F.ngw)
        if (b != cur_b) { cur_b = b;
#pragma unroll
            for (int j = 0; j < 4; ++j) { const int d = 512 * (j >> 1) + 8 * F.lane + 4 * (j & 1); A4[j] = *(const f32x4*)(a.nmg + d) * (*(const f32x4*)(MOD + (size_t)b * 3072 + 1024 + d) + 1.0f); } }
#pragma unroll
        for (int jj = 0; jj < 2; ++jj) {
            const int d = 512 * jj + 8 * F.lane; const f32x4 v0 = v[2 * jj], v1 = v[2 * jj + 1], s0 = v0 * A4[2 * jj], s1 = v1 * A4[2 * jj + 1];
            u32x4 o; o.x = pk2(v0.x, v0.y); o.y = pk2(v0.z, v0.w); o.z = pk2(v1.x, v1.y); o.w = pk2(v1.z, v1.w); *(u32x4*)(X16 + (size_t)row * D + d) = o;
            u32x4 p; p.x = pk2(s0.x, s0.y); p.y = pk2(s0.z, s0.w); p.z = pk2(s1.x, s1.y); p.w = pk2(s1.z, s1.w); *(u32x4*)(XA + (size_t)row * D + d) = p;
        }
        ss = wave_sum(ss);
        if (F.lane < 16) SSQ[(size_t)row * 16 + F.lane] = (F.lane == 0) ? ss : 0.f;
    }
#undef N0_LOAD
}
__device__ __forceinline__ void ph_prep_vectors(const Args& a, Frame& F) {
    const float* MOD = (const float*)(F.ws + WS_MOD); float* AV = (float*)(F.ws + WS_AV);
    for (int idx = F.bid * NTHREADS + F.tid; idx < 3 * BATCH * D; idx += F.nb * NTHREADS) {
        const int inst = idx / (BATCH * D), b = (idx / D) % BATCH, d = idx % D;
        const int lk = (inst == 0) ? 1 : (inst == 1 ? 2 : 3);
        const float gn = (inst == 0) ? a.nfg[d] : (inst == 1 ? a.nmg[D + d] : a.nfg[D + d]);
        AV[idx] = gn * (1.0f + MOD[((size_t)lk * 2 + b) * 3072 + 1024 + d]);
    }
    const bf16_t* WT = (const bf16_t*)(F.ws + WS_WT);
    constexpr int NR = 5632 + NPW + 16384 + NPW;
    LAS float* SH = (LAS float*)F.lds;
    for (int i = F.tid; i < 4 * BATCH * D; i += NTHREADS) { const int which = i / (BATCH * D), b = (i / D) % BATCH, d = i % D; SH[i] = MOD[((size_t)((which + 1) & 3) * 2 + b) * 3072 + d]; }
    __syncthreads();
    for (int g8 = F.gw; g8 < NR / 8; g8 += F.ngw) {
        const int row = g8 * 8 + (F.lane >> 3), part = F.lane & 7;
        int which, r; const bf16_t* wrow; float* out; int ncv;
        if (row < 5632) { which = 0; r = row; wrow = WT + WT_FGU + (size_t)r * D; out = (float*)(F.ws + WS_CVF); ncv = 5632; }
        else if (row < 5632 + NPW) { which = 1; r = row - 5632; wrow = WT + WT_WIN + (size_t)NPW * D + (size_t)r * D; out = (float*)(F.ws + WS_CVI); ncv = NPW; }
        else if (row < 5632 + NPW + 16384) { which = 2; r = row - 5632 - NPW; wrow = WT + WT_MGU + (size_t)r * D; out = (float*)(F.ws + WS_CVM); ncv = 16384; }
        else { which = 3; r = row - 5632 - NPW - 16384; wrow = WT + WT_WIN + (size_t)r * D; out = (float*)(F.ws + WS_CVI0); ncv = NPW; }
        u32x4 wv[16];
#pragma unroll
        for (int j = 0; j < 16; ++j) wv[j] = *(const u32x4*)(wrow + 128 * part + 8 * j);
        const LAS float* s0p = SH + (which * 2 + 0) * 1024 + 128 * part; const LAS float* s1p = s0p + 1024;
        float s0 = 0.f, s1 = 0.f;
#pragma unroll
        for (int j = 0; j < 16; ++j) {
            const f32x4 a0 = *(const LAS f32x4*)(s0p + 8 * j), a1 = *(const LAS f32x4*)(s0p + 8 * j + 4), b0 = *(const LAS f32x4*)(s1p + 8 * j), b1 = *(const LAS f32x4*)(s1p + 8 * j + 4);
            const float x0 = bf2f(wv[j].x & 0xffffu), x1 = bf2f(wv[j].x >> 16), x2 = bf2f(wv[j].y & 0xffffu), x3 = bf2f(wv[j].y >> 16), x4 = bf2f(wv[j].z & 0xffffu), x5 = bf2f(wv[j].z >> 16), x6 = bf2f(wv[j].w & 0xffffu), x7 = bf2f(wv[j].w >> 16);
            s0 += ((x0 * a0.x + x1 * a0.y) + (x2 * a0.z + x3 * a0.w)) + ((x4 * a1.x + x5 * a1.y) + (x6 * a1.z + x7 * a1.w));
            s1 += ((x0 * b0.x + x1 * b0.y) + (x2 * b0.z + x3 * b0.w)) + ((x4 * b1.x + x5 * b1.y) + (x6 * b1.z + x7 * b1.w));
        }
        s0 += __shfl_xor(s0, 1); s0 += __shfl_xor(s0, 2); s0 += __shfl_xor(s0, 4);
        s1 += __shfl_xor(s1, 1); s1 += __shfl_xor(s1, 2); s1 += __shfl_xor(s1, 4);
        if (part == 0) { out[r] = s0; out[ncv + r] = s1; }
    }
    __syncthreads();
    if (F.gw < BATCH * 8) {
        const int b = F.gw >> 3, e = F.gw & 7; float sacc = 0.f;
        for (int d = F.lane; d < D; d += 64) sacc += MOD[((size_t)3 * 2 + b) * 3072 + d] * a.router_w[(size_t)d * NE + e];
        sacc = wave_sum(sacc);
        if (F.lane == 0) ((float*)(F.ws + WS_CR))[b * 8 + e] = sacc;
    }
}
template <class Sched> __device__ __forceinline__ int count_units(const Sched& S) { int n = 0; pg8::Unit u; while (n < 16 && S.next(n, u)) ++n; return n; }
template <class Sched> __device__ __forceinline__ void rstd_preload(Frame& F, const Sched& S, const float* ssqp, const LAS int* RI) {
    LAS float* RS = (LAS float*)(F.lds + RS_OFF);
    const int t = F.tid & 255, par = F.tid >> 8, nu = count_units(S);
#pragma unroll
    for (int k0 = 0; k0 < 8; k0 += 4) {
        f32x4 p0[4], p1[4], p2[4], p3[4]; int r0, r1, r2, r3;
#define RSP_LOAD(k, pk, rk) { const int o = par + 2 * (k0 + k); pg8::Unit u; u.pm = 0; rk = 0; if (o < nu) { S.next(o, u); rk = RI ? RI[o * 256 + t] : u.pm * 256 + t; } \
            const f32x4* q = (const f32x4*)(ssqp + (size_t)rk * 16); pk[0] = q[0]; pk[1] = q[1]; pk[2] = q[2]; pk[3] = q[3]; }
        RSP_LOAD(0, p0, r0) RSP_LOAD(1, p1, r1) RSP_LOAD(2, p2, r2) RSP_LOAD(3, p3, r3)
#undef RSP_LOAD
#define RSP_STORE(k, pk, rk) { const int o = par + 2 * (k0 + k); if (o < nu) { const f32x4 s4 = (pk[0] + pk[1]) + (pk[2] + pk[3]); \
            const float rs = rsqrtf(((s4.x + s4.y) + (s4.z + s4.w)) * (1.0f / D) + EPS); RS[o * 256 + t] = (rk >= SEQ) ? -rs : rs; } }
        RSP_STORE(0, p0, r0) RSP_STORE(1, p1, r1) RSP_STORE(2, p2, r2) RSP_STORE(3, p3, r3)
#undef RSP_STORE
    }
    __syncthreads();
}
__device__ __forceinline__ void ph_router(const Args& a, Frame& F) {
    const bf16_t* XA = (const bf16_t*)(F.ws + WS_H); const float* SSQ = (const float*)(F.ws + WS_SSQ) + (size_t)2 * T * 16; const float* CR = (const float*)(F.ws + WS_CR);
    constexpr int RW = 1032;
    LAS bf16_t* WH = (LAS bf16_t*)F.lds; LAS bf16_t* WL = WH + 16 * RW; LAS float* LG = (LAS float*)(F.lds + 2 * 16 * RW * 2) + F.wave * 256;
    for (int i = F.tid; i < 16 * 1024; i += NTHREADS) { const int e = i >> 10, d = i & 1023;
        const float w = (e < 8) ? a.router_w[(size_t)d * NE + e] : 0.f; const unsigned hi = f2bf(w); const float lo = w - bf2f(hi);
        WH[e * RW + d] = (bf16_t)hi; WL[e * RW + d] = (bf16_t)f2bf(lo); }
    __syncthreads();
    const int l15 = F.lane & 15, q4 = F.lane >> 4;
    for (int r0 = F.gw * 16; r0 < T; r0 += F.ngw * 16) {
        const bf16_t* xrow = XA + (size_t)(r0 + l15) * D + 8 * q4;
        f32x4 acc = (f32x4){0.f, 0.f, 0.f, 0.f};
#pragma unroll
        for (int kb = 0; kb < 32; kb += 8) {
            bf16x8_t av[8];
#pragma unroll
            for (int k = 0; k < 8; ++k) av[k] = *(const bf16x8_t*)(xrow + 32 * (kb + k));
#pragma unroll
            for (int k = 0; k < 8; ++k) {
                const bf16x8_t bh = *(const LAS bf16x8_t*)(WH + l15 * RW + 32 * (kb + k) + 8 * q4), bl = *(const LAS bf16x8_t*)(WL + l15 * RW + 32 * (kb + k) + 8 * q4);
                acc = __builtin_amdgcn_mfma_f32_16x16x32_bf16(av[k], bh, acc, 0, 0, 0);
                acc = __builtin_amdgcn_mfma_f32_16x16x32_bf16(av[k], bl, acc, 0, 0, 0);
            }
        }
#pragma unroll
        for (int r = 0; r < 4; ++r) LG[(4 * q4 + r) * 16 + l15] = acc[r];
        if (F.lane < 16) {
            const int row = r0 + F.lane, b = row / SEQ;
            const f32x4* sp = (const f32x4*)(SSQ + (size_t)row * 16); const f32x4 s4 = (sp[0] + sp[1]) + (sp[2] + sp[3]);
            const float rstd = rsqrtf(((s4.x + s4.y) + (s4.z + s4.w)) * (1.0f / D) + EPS);
            const f32x4 l0 = *(const LAS f32x4*)(LG + F.lane * 16), l1 = *(const LAS f32x4*)(LG + F.lane * 16 + 4);
            const float dots[8] = {l0.x, l0.y, l0.z, l0.w, l1.x, l1.y, l1.z, l1.w};
            float v0 = -INFINITY, v1 = -INFINITY; int e0 = 0, e1 = 0;
#pragma unroll
            for (int e = 0; e < 8; ++e) { const float lg = rstd * dots[e] + CR[b * 8 + e] + a.router_b[e]; if (lg > v0) { v1 = v0; e1 = e0; v0 = lg; e0 = e; } else if (lg > v1) { v1 = lg; e1 = e; } }
            const float ex = __expf(v1 - v0), p0 = 1.0f / (1.0f + ex), p1 = ex / (1.0f + ex);
            unsigned* cnt = (unsigned*)(F.ws + WS_CTL) + CW_MOECNT;
            const int q0 = (int)atomicAdd(cnt + 64 * e0, 1u), q1 = (int)atomicAdd(cnt + 64 * e1, 1u);
            int* R = (int*)(F.ws + WS_ROUTE) + (size_t)row * 4; R[0] = e0; R[1] = e1; ((float*)R)[2] = p0; ((float*)R)[3] = p1;
            int* Pq = (int*)(F.ws + WS_POS) + (size_t)row * 2; Pq[0] = q0; Pq[1] = q1;
            int* RM = (int*)(F.ws + WS_RMAP); RM[(size_t)e0 * T + q0] = row; RM[(size_t)e1 * T + q1] = row;
        }
    }
    __syncthreads();
}

__global__ void __launch_bounds__(NTHREADS, 2) fwd(Args a) {
    extern __shared__ __attribute__((aligned(16))) unsigned char lds_raw[];
    Frame F;
    F.lds = (LAS unsigned char*)lds_raw;
    F.tid = threadIdx.x; F.lane = F.tid & 63; F.wave = __builtin_amdgcn_readfirstlane(F.tid >> 6);
    F.bid = blockIdx.x; F.nb = gridDim.x; F.gw = F.bid * NWAVES + F.wave; F.ngw = F.nb * NWAVES; F.ws = (GAS unsigned char*)a.ws;
    volatile LAS unsigned* MISC = (volatile LAS unsigned*)(F.lds + MISC_OFF);
    for (int u = F.tid; u < 32; u += NTHREADS) MISC[u] = 0u;
    __syncthreads();
    unsigned* ctl = (unsigned*)(a.ws + WS_CTL);
    const int lo = a.ph_lo, hi = a.ph_hi;
    const bool multi = (hi - lo) > 1;
    XcdBarrier bar; bar.bar = ctl + CW_BAR; bar.x = 0; bar.st = MISC + 8;
    if (multi) bar = xcd_barrier_post(ctl + CW_BAR, MISC + 8);
#define IN(k) (lo <= (k) && (k) < hi && (frame_refresh(F, a, (LAS unsigned char*)lds_raw), true))
#define SEAM(k) do { if (hi > (k) + 1 && lo <= (k)) { xcd_barrier(bar); if constexpr ((PROBE_MASK & 4194304) != 0) xcd_barrier(bar); } } while (0)
    float* MOD = (float*)(a.ws + WS_MOD);
    bf16_t* H = (bf16_t*)(a.ws + WS_H); bf16_t* PROJ = (bf16_t*)(a.ws + WS_PROJ); bf16_t* YMIX = (bf16_t*)(a.ws + WS_YMIX);
    bf16_t* WT = (bf16_t*)(a.ws + WS_WT);
    bf16_t* ACT = (bf16_t*)(a.ws + WS_ACT); bf16_t* ACTM = (bf16_t*)(a.ws + WS_ACTM); bf16_t* YMOE = (bf16_t*)(a.ws + WS_YMOE);

    if (IN(PH_PRO)) { REP(1) { ph_pro_vectors(a, F); ph_pro_weights(a, F); } SEAM(PH_PRO); }

#define TWICE(bit, stmt) do { stmt; if constexpr ((PROBE_MASK & (bit)) != 0) { stmt; } } while (0)
    float* AV = (float*)(a.ws + WS_AV); float* SSQ = (float*)(a.ws + WS_SSQ); bf16_t* X16 = (bf16_t*)(a.ws + WS_X16);
    const LAS float* RSL = (const LAS float*)(F.lds + RS_OFF);
#define LAYER_BODY(l) {\
        const int pb = PH_LAYER0 + PH_PER_LAYER * l; \
        const float* xin = (l == 0) ? a.x : a.out; \
        const float* mod0 = MOD + (size_t)(l * 2 + 0) * 2 * 3072; const float* mod1 = MOD + (size_t)(l * 2 + 1) * 2 * 3072; \
        if (l == 0) { if (IN(pb + K_NORM1)) { REP(2) ph_norm0(a, F); ph_prep_vectors(a, F); SEAM(pb + K_NORM1); } } \
        if (IN(pb + K_GEMM_IN)) { \
            TWICE(4, ({ pg8::Gemm g{H, WT + WT_WIN + (size_t)l * NPW * D, D}; pg8::StaticOrder S; S.init(T, NPW, F.nb, F.bid); rstd_preload(F, S, SSQ + (size_t)(l == 0 ? 3 : 1) * T * 16, nullptr); \
                pg8::EpiProjNorm E{PROJ, RSL, (const float*)(a.ws + (l == 0 ? WS_CVI0 : WS_CVI)), (float*)(a.ws + WS_BG), a.dn_a_log + 4 * l, a.dn_dt_bias + 4 * l}; \
                pg8::gemm_phase<pg8::EpiProjNorm, pg8::StaticOrder, false, true, true>(F.lds, nullptr, g, S, E); })); \
            SEAM(pb + K_GEMM_IN); \
        } \
        if (IN(pb + K_DN_PREP)) { REP(8) ph_dn_chunk(a, F, l); ph_rope(a, F); SEAM(pb + K_DN_PREP); } \
        if (IN(pb + K_MIX)) { ph_dn_scan(a, F, l); REP(512) ph_attn_mfma(a, F, l); REP(1024) ph_conv_fast(a, F, l); __syncthreads(); REP(32) ph_dn_out(a, F, l); SEAM(pb + K_MIX); } \
        if (IN(pb + K_GEMM_OUT)) { \
            TWICE(0, ({ pg8::Gemm g{YMIX, WT + WT_WOUT + (size_t)l * D * D, D}; pg8::StaticOrder S; S.init(T, D, F.nb, F.bid); \
                pg8::EpiResidNorm E{X16, X16, mod0 + 2048, AV + (size_t)(l == 0 ? 0 : 2) * BATCH * D, H, SSQ + (size_t)(l == 0 ? 0 : 2) * T * 16}; \
                pg8::gemm_phase<pg8::EpiResidNorm, pg8::StaticOrder, false, true, true>(F.lds, nullptr, g, S, E); })); \
            if constexpr ((PROBE_MASK & 8388608) != 0 && l == 0) { pg8::Gemm g{YMIX, WT + WT_WOUT + (size_t)l * D * D, D}; pg8::StaticOrder S; S.init(T, D, F.nb, F.bid); pg8::EpiBf16 E{(bf16_t*)(a.ws + WS_DN_MR), D, 1 << 20}; \
                pg8::gemm_phase<pg8::EpiBf16, pg8::StaticOrder, false, true, true>(F.lds, nullptr, g, S, E); } \
            if constexpr ((PROBE_MASK & 16777216) != 0 && l == 0) { pg8::Gemm g{YMIX, WT + WT_WOUT + (size_t)l * D * D, D}; pg8::StaticOrder S; S.init(T, D, F.nb, F.bid); \
                pg8::EpiResidNorm E{X16, (bf16_t*)(a.ws + WS_DN_MR), mod0 + 2048, AV, (bf16_t*)(a.ws + WS_DN_MR), (float*)(a.ws + WS_DN_ST)}; \
                pg8::gemm_phase<pg8::EpiResidNorm, pg8::StaticOrder, false, true, true>(F.lds, nullptr, g, S, E); } \
            if constexpr ((PROBE_MASK & 131072) != 0 && l == 0) { pg8::Gemm g{YMIX, WT + WT_WOUT + (size_t)l * D * D, D}; pg8::StaticOrder S; S.init(T, D, F.nb, F.bid); pg8::EpiNull E{}; \
                pg8::gemm_phase<pg8::EpiNull, pg8::StaticOrder, false, true, true>(F.lds, nullptr, g, S, E); } \
            SEAM(pb + K_GEMM_OUT); \
        } \
        if (l == 0) { \
            if (IN(pb + K_FFN1)) { \
                TWICE(256, ({ pg8::Gemm g{H, WT + WT_FGU, D}; pg8::StaticOrder S; S.init(T, 2 * D_FF, F.nb, F.bid); rstd_preload(F, S, SSQ, nullptr); \
                    pg8::EpiSwiGLUNorm E{ACT, D_FF, 1 << 20, RSL, (const float*)(a.ws + WS_CVF), 5632}; \
                    pg8::gemm_phase<pg8::EpiSwiGLUNorm, pg8::StaticOrder, false, true, true>(F.lds, nullptr, g, S, E); })); \
                SEAM(pb + K_FFN1); \
            } \
            if (IN(pb + K_FFN2)) { \
                { pg8::Gemm g{ACT, WT + WT_FD, D_FF}; pg8::StaticOrder S; S.init(T, D, F.nb, F.bid); \
                    pg8::EpiResidNorm E{X16, X16, mod1 + 2048, AV + (size_t)1 * BATCH * D, H, SSQ + (size_t)1 * T * 16}; \
                    pg8::gemm_phase<pg8::EpiResidNorm, pg8::StaticOrder, false, true, true>(F.lds, nullptr, g, S, E); } \
                SEAM(pb + K_FFN2); \
            } \
        } else { \
            if (IN(pb + K_NORM2)) { ph_router(a, F); SEAM(pb + K_NORM2); } \
            if (IN(pb + K_FFN1)) { \
                TWICE(2048, ({ pg8::MoeOrder<8> S; moe_order_init<8>(F, S); moe_ri_preload<8>(F, S); rstd_preload(F, S, SSQ + (size_t)2 * T * 16, (const LAS int*)(F.lds + RI_OFF)); \
                    pg8::Gemm g{H, WT + WT_MGU, D}; pg8::EpiSwiGLUNorm E{ACTM, D_FFE, 8, RSL, (const float*)(a.ws + WS_CVM), 16384}; \
                    pg8::gemm_phase<pg8::EpiSwiGLUNorm, pg8::MoeOrder<8>, true, true, true>(F.lds, (const LAS int*)(F.lds + RI_OFF), g, S, E); })); \
                SEAM(pb + K_FFN1); \
            } \
            if (IN(pb + K_FFN2)) { \
                TWICE(4096, ({ pg8::MoeOrder<4> S; moe_order_init<4>(F, S); \
                    pg8::Gemm g{ACTM, WT + WT_MD, D_FFE}; pg8::EpiBf16W E{YMOE, D, 4}; \
                    pg8::gemm_phase<pg8::EpiBf16W, pg8::MoeOrder<4>, false, true, true>(F.lds, nullptr, g, S, E); })); \
                SEAM(pb + K_FFN2); \
            } \
        } \
    }
    LAYER_BODY(0)
    LAYER_BODY(1)
#undef LAYER_BODY
    if (IN(PH_FINAL)) { ph_final(a, F); }
#undef IN
#undef SEAM
}

extern "C" void kernel_launch(void* const* d_in, const int* in_sizes, int n_in, void* d_out, int out_size, void* d_ws, size_t ws_size, hipStream_t stream) {
    static int grid = 0;
    if (grid == 0) {
        if (n_in != 27 || out_size != T * D || ws_size < WS_END) { fprintf(stderr, "kernel_launch: unexpected shapes n_in %d out %d ws %zu\n", n_in, out_size, ws_size); grid = -1; return; }
        int dev = 0, cus = 0, per_cu = 0;
        if (hipGetDevice(&dev) != hipSuccess || hipDeviceGetAttribute(&cus, hipDeviceAttributeMultiprocessorCount, dev) != hipSuccess) { grid = -1; return; }
        if (hipFuncSetAttribute((const void*)fwd, hipFuncAttributeMaxDynamicSharedMemorySize, LDS_BYTES) != hipSuccess) { fprintf(stderr, "kernel_launch: hipFuncSetAttribute failed\n"); grid = -1; return; }
        if (hipOccupancyMaxActiveBlocksPerMultiprocessor(&per_cu, (const void*)fwd, NTHREADS, LDS_BYTES) != hipSuccess || per_cu < 1) fprintf(stderr, "kernel_launch: occupancy query says %d\n", per_cu);
        (void)hipGetLastError();
        grid = cus;
    }
    if (grid < 0) return;
    (void)hipMemsetAsync((char*)d_ws + WS_CTL, 0, CTL_ZERO_BYTES, stream);
    Args a{};
    const void** pp = (const void**)&a;
    for (int i = 0; i < 27; ++i) pp[i] = d_in[i];
    a.out = (float*)d_out; a.ws = (unsigned char*)d_ws;
#if MK_ONE_LAUNCH
    a.ph_lo = 0; a.ph_hi = NPH;
    hipLaunchKernelGGL(fwd, dim3(grid), dim3(NTHREADS), LDS_BYTES, stream, a);
#else
    static const int phases[] = {0, 1, 2, 3, 4, 5, 6, 7, 9, 10, 11, 12, 13, 14, 15, 16, 17, 18, 19, 20, 21};
    for (int p : phases) { a.ph_lo = p; a.ph_hi = p + 1; hipLaunchKernelGGL(fwd, dim3(grid), dim3(NTHREADS), LDS_BYTES, stream, a); }
#endif
}
```

```cpp
#include <hip/hip_runtime.h>
#include <cstdio>
#include <cstdint>

#define LAS __attribute__((address_space(3)))
#define GAS __attribute__((address_space(1)))
typedef unsigned short bf16_t;
typedef float f32x4 __attribute__((ext_vector_type(4)));
typedef unsigned u32x2 __attribute__((ext_vector_type(2)));
typedef unsigned u32x4 __attribute__((ext_vector_type(4)));

#ifndef GEMM_MASK
#define GEMM_MASK 63
#endif
#ifndef ATTN_MFMA
#define ATTN_MFMA 1
#endif
#ifndef DN_CHUNKED
#define DN_CHUNKED 1
#endif
#ifndef CONV_FAST
#define CONV_FAST 1
#endif
#ifndef PROBE_MASK
#define PROBE_MASK 0
#endif
#define REP(bit) for (int rep_ = 0; rep_ < ((PROBE_MASK & (bit)) ? 2 : 1); ++rep_)
#ifndef MK_ONE_LAUNCH
#define MK_ONE_LAUNCH 1
#endif

constexpr int BATCH = 2, SEQ = 16384, T = BATCH * SEQ, D = 1024, DEPTH = 2;
constexpr int NPW = 2560;
constexpr int N_IN = 2312, NP = 2304;
constexpr int C_AQ = 0, C_AK = 512, C_AV = 640, C_DQ = 768, C_DK = 1024, C_DV = 1280, C_DZ = 1536, C_CA = 1792, C_CB = 2048;
constexpr int W_DB = 1536;
constexpr int D_FF = 2816, NE = 8, D_FFE = 1024;
constexpr int WINDOW = 128, CV_K = 31, CV_C = 256, DN_CONV = 4;
constexpr float EPS = 1e-6f;
constexpr int NSCAN = BATCH * 4 * 4;
constexpr int MOE_CAP = 67584;

constexpr size_t MiB = 1u << 20;
constexpr size_t WS_CTL = 0, CTL_ZERO_BYTES = 1 * MiB;
constexpr size_t WS_MOD = 1 * MiB;
constexpr size_t WS_CS = 2 * MiB;
constexpr size_t WS_BG = 4 * MiB;
constexpr size_t WS_ROUTE = 5 * MiB;
constexpr size_t WS_POS = 6 * MiB;
constexpr size_t WS_RMAP = 7 * MiB;
constexpr size_t WS_WT = 8 * MiB;
constexpr size_t WS_H = 88 * MiB;
constexpr size_t WS_PROJ = 152 * MiB;
constexpr size_t WS_YMIX = 296 * MiB;
constexpr size_t WS_DNQKV = 360 * MiB;
constexpr size_t WS_ODN = 456 * MiB;
constexpr size_t WS_ACT = 152 * MiB;
constexpr size_t WS_ACTM = 152 * MiB;
constexpr size_t WS_YMOE = 284 * MiB;
constexpr size_t WS_X16 = 440 * MiB;
constexpr size_t WS_SSQ = 504 * MiB;
constexpr size_t WS_AV = WS_MOD + 128 * 1024;
constexpr size_t WS_CVF = WS_MOD + 256 * 1024;
constexpr size_t WS_CVI = WS_CVF + 2 * 5632 * 4;
constexpr size_t WS_CVM = WS_CVI + 2 * 2560 * 4;
constexpr size_t WS_CR = WS_CVM + 2 * 16384 * 4;
constexpr size_t WS_CVI0 = WS_CR + 64;
static_assert(WS_CVI0 + 2 * 2560 * 4 <= WS_CS, "vector area");
constexpr size_t WS_END = 512 * MiB;
constexpr int CW_BAR = 4096;
constexpr int CW_MOECNT = 16384;
constexpr int CW_SCANP = 20480;

constexpr int NWAVES = 8, NTHREADS = 512;
constexpr int LDS_BYTES = 163840;
constexpr int MISC_OFF = 131072 + 320;
constexpr int RI_OFF = 132096;
constexpr int RS_OFF = 147456;

constexpr int PH_PRO = 0, PH_LAYER0 = 1, PH_PER_LAYER = 10, PH_FINAL = 21, NPH = 22;
enum { K_NORM1 = 0, K_GEMM_IN, K_DN_PREP, K_MIX, K_DN_OUT, K_GEMM_OUT, K_NORM2, K_MOE_LIST, K_FFN1, K_FFN2 };

struct Args {
    const float* x; const float* c; const int* pos; const float* ada_w; const float* ada_b; const float* nmg; const float* nfg;
    const float* w_in; const float* sinks; const float* dn_conv_w; const float* dn_a_log; const float* dn_dt_bias; const float* dn_norm_g;
    const float* cv_dw_w; const float* cv_dw_b; const float* cv_ln_g; const float* cv_ln_b; const float* w_out;
    const float* ffn_wg; const float* ffn_wu; const float* ffn_wd; const float* router_w; const float* router_b;
    const float* moe_wg; const float* moe_wu; const float* moe_wd; const float* final_g;
    float* out; unsigned char* ws; int ph_lo, ph_hi;
};

__device__ __forceinline__ float bf2f(unsigned u) { return __uint_as_float(u << 16); }
__device__ __forceinline__ unsigned f2bf(float f) { unsigned u = __float_as_uint(f); return (u + 0x7fffu + ((u >> 16) & 1u)) >> 16; }
__device__ __forceinline__ unsigned pk2(float lo, float hi) { return f2bf(lo) | (f2bf(hi) << 16); }
#define DPP_MOV(v, ctrl) __int_as_float(__builtin_amdgcn_update_dpp(0, __float_as_int(v), (ctrl), 0xf, 0xf, false))
__device__ __forceinline__ float row16_sum(float v) { v += DPP_MOV(v, 0xB1); v += DPP_MOV(v, 0x4E); v += DPP_MOV(v, 0x141); v += DPP_MOV(v, 0x140); return v; }
__device__ __forceinline__ float wave_sum(float v) {
    v = row16_sum(v);
    const int vi = __float_as_int(v);
    return (__int_as_float(__builtin_amdgcn_readlane(vi, 0)) + __int_as_float(__builtin_amdgcn_readlane(vi, 16))) + (__int_as_float(__builtin_amdgcn_readlane(vi, 32)) + __int_as_float(__builtin_amdgcn_readlane(vi, 48)));
}
__device__ __forceinline__ float xor32_sum(float v) { const auto r = __builtin_amdgcn_permlane32_swap(__float_as_uint(v), __float_as_uint(v), false, false); return __uint_as_float(r[0]) + __uint_as_float(r[1]); }
__device__ __forceinline__ float xor32_max(float v) { const auto r = __builtin_amdgcn_permlane32_swap(__float_as_uint(v), __float_as_uint(v), false, false); return fmaxf(__uint_as_float(r[0]), __uint_as_float(r[1])); }
__device__ __forceinline__ float xor16_sum(float v) { const auto r = __builtin_amdgcn_permlane16_swap(__float_as_uint(v), __float_as_uint(v), false, false); return __uint_as_float(r[0]) + __uint_as_float(r[1]); }
__device__ __forceinline__ float group8_sum(float v) { v += DPP_MOV(v, 0xB1); v += DPP_MOV(v, 0x4E); v += DPP_MOV(v, 0x141); return v; }
__device__ __forceinline__ float wave_max(float v) {
#pragma unroll
    for (int o = 1; o < 64; o <<= 1) v = fmaxf(v, __shfl_xor(v, o));
    return v;
}
__device__ __forceinline__ float sigmoidf_(float x) { return __builtin_amdgcn_rcpf(1.0f + __builtin_amdgcn_exp2f(x * -1.4426950408889634f)); }
__device__ __forceinline__ float siluf_(float x) { return x * __builtin_amdgcn_rcpf(1.0f + __builtin_amdgcn_exp2f(x * -1.4426950408889634f)); }
__device__ __forceinline__ float softplusf_(float x) { return fmaxf(x, 0.f) + log1pf(__expf(-fabsf(x))); }

#define XB_TMO      128
#define XB_XCNT(j)  (256  + 64 * (j))
#define XB_XSUB(j)  (1280 + 64 * (j))
#define XB_XGEN(j)  (2304 + 64 * (j))
#define XB_TOP      3328
#define XB_TOPGEN   3392
#define XCD_BAR_WORDS 3456
#define XB_SPIN_CAP (1u << 18)

__device__ __forceinline__ unsigned xb_ld(unsigned* p)              { return __hip_atomic_load(p, __ATOMIC_RELAXED, __HIP_MEMORY_SCOPE_AGENT); }
__device__ __forceinline__ unsigned xb_add(unsigned* p, unsigned v) { return __hip_atomic_fetch_add(p, v, __ATOMIC_RELAXED, __HIP_MEMORY_SCOPE_AGENT); }
__device__ __forceinline__ unsigned xb_xcc_id() { return (unsigned)__builtin_amdgcn_s_getreg((3 << 11) | 20) & 0xFu; }
#define XB_SPIN(cond, bar) do { unsigned _sp = 0; while (cond) { __builtin_amdgcn_s_sleep(1); \
    if ((++_sp & 255u) == 0u) { if (xb_ld(&(bar)[XB_TMO])) break; if (_sp > XB_SPIN_CAP) { atomicAdd(&(bar)[XB_TMO], 1u); break; } } } } while (0)

struct XcdBarrier { unsigned* bar; unsigned x; volatile LAS unsigned* st; };

__device__ __forceinline__ XcdBarrier xcd_barrier_post(unsigned* bar, volatile LAS unsigned* st) {
    XcdBarrier b; b.bar = bar; b.x = xb_xcc_id(); b.st = st;
    if (threadIdx.x == 0) (void)xb_add(&bar[XB_XCNT(b.x)], 1u);
    return b;
}
__device__ __forceinline__ void xcd_barrier_complete(unsigned* bar, unsigned x, unsigned& nloc, unsigned& nx) {
    const unsigned G = gridDim.x * gridDim.y * gridDim.z;
    unsigned sum, cnt, mine, sp = 0u;
    for (;;) {
        sum = 0u; cnt = 0u; mine = 0u;
#pragma unroll
        for (unsigned j = 0; j < 16; ++j) { const unsigned c = xb_ld(&bar[XB_XCNT(j)]); sum += c; cnt += (c > 0u) ? 1u : 0u; mine = (j == x) ? c : mine; }
        if (sum == G) break;
        __builtin_amdgcn_s_sleep(1);
        if ((++sp & 255u) == 0u) { if (xb_ld(&bar[XB_TMO])) break; if (sp > XB_SPIN_CAP) { atomicAdd(&bar[XB_TMO], 1u); break; } }
    }
    nloc = mine > 0u ? mine : 1u; nx = cnt > 0u ? cnt : 1u;
}
__device__ __forceinline__ void xcd_barrier(const XcdBarrier& b) {
    asm volatile("s_waitcnt vmcnt(0)" ::: "memory");
    __syncthreads();
    if (threadIdx.x == 0) {
        unsigned* bar = b.bar;
        __builtin_amdgcn_s_waitcnt(0);
        unsigned nloc = b.st[0], nx = b.st[1];
        if (nloc == 0u) { xcd_barrier_complete(bar, b.x, nloc, nx); b.st[0] = nloc; b.st[1] = nx; }
        const unsigned old = xb_add(&bar[XB_XSUB(b.x)], 1u);
        const unsigned gen = old / nloc;
        if (old + 1u == (gen + 1u) * nloc) {
            __builtin_amdgcn_fence(__ATOMIC_RELEASE, "agent");
            asm volatile("s_waitcnt vmcnt(0)" ::: "memory");
            const unsigned og = xb_add(&bar[XB_TOP], 1u);
            const unsigned tg = og / nx;
            if (og + 1u == (tg + 1u) * nx) xb_add(&bar[XB_TOPGEN], 1u);
            else XB_SPIN(xb_ld(&bar[XB_TOPGEN]) == tg, bar);
            __builtin_amdgcn_fence(__ATOMIC_ACQUIRE, "agent");
            xb_add(&bar[XB_XGEN(b.x)], 1u);
            asm volatile("s_waitcnt vmcnt(0)" ::: "memory");
        } else {
            XB_SPIN(xb_ld(&bar[XB_XGEN(b.x)]) == gen, bar);
            __builtin_amdgcn_fence(__ATOMIC_ACQUIRE, "agent");
            asm volatile("s_waitcnt vmcnt(0)" ::: "memory");
        }
    }
    __syncthreads();
}

struct Frame {
    LAS unsigned char* lds;
    int tid, lane, wave, gw, ngw, bid, nb;
    GAS unsigned char* ws;
};

__device__ __forceinline__ void frame_refresh(Frame& F, const Args& a, LAS unsigned char* lds) {
    int tid = threadIdx.x; asm volatile("" : "+v"(tid));
    int bid = blockIdx.x; asm volatile("" : "+s"(bid));
    unsigned char* ws = a.ws; asm volatile("" : "+s"(ws));
    F.lds = lds; F.tid = tid; F.lane = tid & 63; F.wave = __builtin_amdgcn_readfirstlane(tid >> 6);
    F.bid = bid; F.nb = gridDim.x; F.gw = F.bid * NWAVES + F.wave; F.ngw = F.nb * NWAVES; F.ws = (GAS unsigned char*)ws;
}
__device__ __forceinline__ void ph_pro_vectors(const Args& a, Frame& F) {
    float* MOD = (float*)(F.ws + WS_MOD);
    LAS float* red = (LAS float*)F.lds;
    for (int it = F.bid; it < 4 * 48; it += F.nb) {
        const int lk = it / 48, cg = it % 48, e = cg * 64 + F.lane;
        const float* W = a.ada_w + (size_t)lk * D * 3072 + e;
        float a0 = 0.f, a1 = 0.f;
        const int d0 = F.wave * 128;
#pragma unroll 8
        for (int d = d0; d < d0 + 128; ++d) {
            const float w = __builtin_nontemporal_load(W + (size_t)d * 3072);
            a0 += siluf_(a.c[d]) * w; a1 += siluf_(a.c[D + d]) * w;
        }
        red[(F.wave * 2 + 0) * 64 + F.lane] = a0; red[(F.wave * 2 + 1) * 64 + F.lane] = a1;
        __syncthreads();
        if (F.wave < 2) {
            float s = 0.f;
            for (int w = 0; w < 8; ++w) s += red[(w * 2 + F.wave) * 64 + F.lane];
            MOD[((size_t)lk * 2 + F.wave) * 3072 + e] = s + a.ada_b[lk * 3072 + e];
        }
        __syncthreads();
    }
    float* CS = (float*)(F.ws + WS_CS);
    for (int idx = F.bid * NTHREADS + F.tid; idx < T * 8; idx += F.nb * NTHREADS) {
        const int t = idx >> 3, i = idx & 7;
        const float inv = powf(500000.0f, -(float)(2 * i) / 16.0f);
        const float ang = (float)a.pos[t] * inv;
        CS[t * 16 + i] = cosf(ang); CS[t * 16 + 8 + i] = sinf(ang);
    }
}

template <int MODE>
__device__ __forceinline__ void ph_norm(const Args& a, Frame& F, int l, const float* xin, const float* gain, const float* modk  ,
                                        const float* W8, int pitch) {
    bf16_t* H = (bf16_t*)(F.ws + WS_H);
    LAS float* W8T = (LAS float*)F.lds;
    if (MODE != 0) {
        for (int i = F.tid; i < 8192; i += NTHREADS) { const int d = i >> 3, j = i & 7; W8T[j * 1024 + d] = W8[(size_t)d * pitch + j]; }
        __syncthreads();
    }
    f32x4 vn[4], A4[4], B4[4]; int cur_b = -1;
    if (F.gw < T) {
#pragma unroll
        for (int j = 0; j < 4; ++j) vn[j] = ((const f32x4*)(xin + (size_t)F.gw * D) + F.lane)[64 * j];
    }
    for (int row = F.gw; row < T; row += F.ngw) {
        const int b = row / SEQ;
        f32x4 v[4]; float ss = 0.f;
#pragma unroll
        for (int j = 0; j < 4; ++j) { v[j] = vn[j]; ss += (v[j].x * v[j].x + v[j].y * v[j].y) + (v[j].z * v[j].z + v[j].w * v[j].w); }
        if (row + F.ngw < T) {
#pragma unroll
            for (int j = 0; j < 4; ++j) vn[j] = ((const f32x4*)(xin + (size_t)(row + F.ngw) * D) + F.lane)[64 * j];
        }
        if (b != cur_b) {
            cur_b = b; const float* sh = modk + (size_t)b * 3072; const float* sc = sh + 1024;
#pragma unroll
            for (int j = 0; j < 4; ++j) { const int d = 256 * j + 4 * F.lane; A4[j] = *(const f32x4*)(gain + d) * (*(const f32x4*)(sc + d) + 1.0f); B4[j] = *(const f32x4*)(sh + d); }
        }
        const float rstd = rsqrtf(wave_sum(ss) * (1.0f / D) + EPS);
        float acc[8];
#pragma unroll
        for (int e = 0; e < 8; ++e) acc[e] = 0.f;
#pragma unroll
        for (int j = 0; j < 4; ++j) {
            const int d = 256 * j + 4 * F.lane;
            const f32x4 hv = (v[j] * rstd) * A4[j] + B4[j];
            u32x2 o; o.x = pk2(hv.x, hv.y); o.y = pk2(hv.z, hv.w);
            *(u32x2*)(H + (size_t)row * D + d) = o;
            if (MODE == 1) { u32x2 xo; xo.x = pk2(v[j].x, v[j].y); xo.y = pk2(v[j].z, v[j].w); *(u32x2*)((bf16_t*)(F.ws + WS_X16) + (size_t)row * D + d) = xo; }
            if (MODE != 0) {
#pragma unroll
                for (int e = 0; e < 8; ++e) { const f32x4 w4 = *(const LAS f32x4*)(W8T + e * 1024 + d); acc[e] += (hv.x * w4.x + hv.y * w4.y) + (hv.z * w4.z + hv.w * w4.w); }
            }
        }
        if (MODE != 0) {
#pragma unroll
            for (int e = 0; e < 8; ++e) acc[e] = wave_sum(acc[e]);
        }
        if (MODE == 1 && F.lane == 0) {
            float* BG = (float*)(F.ws + WS_BG) + (size_t)row * 8;
#pragma unroll
            for (int h = 0; h < 4; ++h) {
                BG[h] = sigmoidf_(acc[h]);
                BG[4 + h] = -__expf(a.dn_a_log[l * 4 + h]) * softplusf_(acc[4 + h] + a.dn_dt_bias[l * 4 + h]);
            }
        }
        if (MODE == 2 && F.lane == 0) {
            float v0 = -INFINITY, v1 = -INFINITY; int e0 = 0, e1 = 0;
#pragma unroll
            for (int e = 0; e < 8; ++e) { const float lg = acc[e] + a.router_b[e]; if (lg > v0) { v1 = v0; e1 = e0; v0 = lg; e0 = e; } else if (lg > v1) { v1 = lg; e1 = e; } }
            const float ex = __expf(v1 - v0), p0 = 1.0f / (1.0f + ex), p1 = ex / (1.0f + ex);
            unsigned* cnt = (unsigned*)(F.ws + WS_CTL) + CW_MOECNT;
            const int q0 = (int)atomicAdd(cnt + 64 * e0, 1u), q1 = (int)atomicAdd(cnt + 64 * e1, 1u);
            int* R = (int*)(F.ws + WS_ROUTE) + (size_t)row * 4; R[0] = e0; R[1] = e1; ((float*)R)[2] = p0; ((float*)R)[3] = p1;
            int* P = (int*)(F.ws + WS_POS) + (size_t)row * 2; P[0] = q0; P[1] = q1;
        }
    }
    if (MODE != 0) __syncthreads();
}

typedef float f32x16 __attribute__((ext_vector_type(16)));
typedef short s16x4 __attribute__((ext_vector_type(4)));
typedef short bf16x8_t __attribute__((ext_vector_type(8)));
__device__ __forceinline__ unsigned cvtpk(float lo, float hi) { typedef float f2_t __attribute__((ext_vector_type(2))); typedef __bf16 b2_t __attribute__((ext_vector_type(2)));
    f2_t v = {lo, hi}; b2_t b = __builtin_convertvector(v, b2_t); return __builtin_bit_cast(unsigned, b); }
__device__ __forceinline__ void ph_rope(const Args& a, Frame& F) {
    bf16_t* P = (bf16_t*)(F.ws + WS_PROJ); const float* CS = (const float*)(F.ws + WS_CS);
    for (int it = F.bid * NTHREADS + F.tid; it < T * 10; it += F.nb * NTHREADS) {
        const int t = it / 10, hh = it % 10;
        bf16_t* p = P + (size_t)t * NP + hh * 64;
        const u32x4 x1 = *(const u32x4*)p, x2 = *(const u32x4*)(p + 8);
        const f32x4 c0 = *(const f32x4*)(CS + (size_t)t * 16), c1 = *(const f32x4*)(CS + (size_t)t * 16 + 4), s0 = *(const f32x4*)(CS + (size_t)t * 16 + 8), s1 = *(const f32x4*)(CS + (size_t)t * 16 + 12);
        const float cs[8] = {c0.x, c0.y, c0.z, c0.w, c1.x, c1.y, c1.z, c1.w}, sn[8] = {s0.x, s0.y, s0.z, s0.w, s1.x, s1.y, s1.z, s1.w};
        const unsigned xa[4] = {x1.x, x1.y, x1.z, x1.w}, xb[4] = {x2.x, x2.y, x2.z, x2.w};
        unsigned ra[4], rb[4];
#pragma unroll
        for (int i = 0; i < 4; ++i) {
            const float a0 = bf2f(xa[i] & 0xffffu), a1 = bf2f(xa[i] >> 16), b0 = bf2f(xb[i] & 0xffffu), b1 = bf2f(xb[i] >> 16);
            ra[i] = pk2(a0 * cs[2 * i] - b0 * sn[2 * i], a1 * cs[2 * i + 1] - b1 * sn[2 * i + 1]);
            rb[i] = pk2(b0 * cs[2 * i] + a0 * sn[2 * i], b1 * cs[2 * i + 1] + a1 * sn[2 * i + 1]);
        }
        *(u32x4*)p = (u32x4){ra[0], ra[1], ra[2], ra[3]}; *(u32x4*)(p + 8) = (u32x4){rb[0], rb[1], rb[2], rb[3]};
    }
}
constexpr int AT_KROW = 144, AT_VOFF = 256 * AT_KROW;
__device__ __forceinline__ void ph_attn_mfma(const Args& a, Frame& F, int l) {
    const bf16_t* P = (const bf16_t*)(F.ws + WS_PROJ); bf16_t* Y = (bf16_t*)(F.ws + WS_YMIX);
    LAS unsigned char* Kl = F.lds; LAS unsigned char* Vl = F.lds + AT_VOFF;
    const int lane = F.lane, r = lane & 31, h = lane >> 5, g = F.wave >> 1, qh = F.wave & 1;
    const int i16 = lane & 15, tq_ = i16 >> 2, tp_ = i16 & 3, g16 = (lane >> 4) & 1, sw = (tq_ >> 1) & 1;
    const int vlane = (4 * h + tq_) * 128 + (2 * g16 + (tp_ >> 1)) * 16 + (tp_ & 1) * 8;
    const float C = 0.125f * 1.4426950408889634f;
    const int nsc = NSCAN;
    if (F.bid < nsc) return;
    u32x4 kreg[4], vreg[4];
#define AT_LOAD(uu) { const int hk_ = (uu) & 1, n_ = ((uu) >> 1) & 127, b_ = (uu) >> 8, tk0_ = b_ * SEQ + n_ * 128 - 128; \
        _Pragma("unroll") for (int i = 0; i < 4; ++i) { const int piece = F.tid + NTHREADS * i, key = piece >> 3, c = piece & 7; \
            const bf16_t* rowp = P + (size_t)(tk0_ + ((n_ > 0 || key >= 128) ? key : key + 128)) * NP; \
            kreg[i] = *(const u32x4*)(rowp + C_AK + hk_ * 64 + c * 8); vreg[i] = *(const u32x4*)(rowp + C_AV + hk_ * 64 + c * 8); } }
    const int V = F.nb - nsc, nheavy = (T / 128 > V && T / 128 < 2 * V) ? T / 128 - V : 0, va = F.bid - nsc - nheavy, Va = V - nheavy;
    if (va < 0) return;
    if (va < BATCH * 128 * 2) AT_LOAD(va)
    for (int u = va; u < BATCH * 128 * 2; u += Va) {
        const int hk = u & 1, n = (u >> 1) & 127, b = u >> 8;
        const int tq0 = b * SEQ + n * 128;
        __syncthreads();
#pragma unroll
        for (int i = 0; i < 4; ++i) {
            const int piece = F.tid + NTHREADS * i, key = piece >> 3, c = piece & 7;
            const bool ok = (n > 0 || key >= 128);
            const u32x4 z4 = (u32x4){0u, 0u, 0u, 0u};
            *(LAS u32x4*)(Kl + key * AT_KROW + c * 16) = ok ? kreg[i] : z4;
            *(LAS u32x4*)(Vl + key * 128 + ((c ^ (((key >> 1) & 1) << 2)) * 16)) = ok ? vreg[i] : z4;
        }
        __syncthreads();
        if (u + Va < BATCH * 128 * 2) AT_LOAD(u + Va)
        asm volatile("" ::: "memory");
        const int hq = hk * 4 + g;
        const float sinkl = a.sinks[l * 8 + hq] * 1.4426950408889634f;
#pragma unroll 1
        for (int sb = 0; sb < 2; ++sb) {
            const int q0 = qh * 64 + sb * 32, kt0 = qh * 2 + sb;
            const size_t tq = (size_t)(tq0 + q0 + r);
            bf16x8_t qf[4];
#pragma unroll
            for (int ks = 0; ks < 4; ++ks) qf[ks] = *(const bf16x8_t*)(P + tq * NP + hq * 64 + 16 * ks + 8 * h);
            f32x16 S[5];
#pragma unroll
            for (int kr = 0; kr < 5; ++kr) {
                f32x16 acc;
#pragma unroll
                for (int i = 0; i < 16; ++i) acc[i] = 0.f;
#pragma unroll
                for (int ks = 0; ks < 4; ++ks) { const bf16x8_t kf = *(const LAS bf16x8_t*)(Kl + (32 * (kt0 + kr) + r) * AT_KROW + (16 * ks + 8 * h) * 2);
                    acc = __builtin_amdgcn_mfma_f32_32x32x16_bf16(kf, qf[ks], acc, 0, 0, 0); }
                S[kr] = acc;
            }
            float m = sinkl;
#pragma unroll
            for (int kr = 0; kr < 5; ++kr) {
                const bool tile_ok = !(n == 0 && (kt0 + kr) < 4);
#pragma unroll
                for (int i = 0; i < 16; ++i) {
                    const int kl = (i & 3) + 8 * (i >> 2) + 4 * h;
                    bool ok = tile_ok; if (kr == 0) ok = ok && (kl > r); if (kr == 4) ok = ok && (kl <= r);
                    const float sv = ok ? S[kr][i] * C : -INFINITY; S[kr][i] = sv; m = fmaxf(m, sv);
                }
            }
            m = xor32_max(m);
            float lsum = 0.f;
#pragma unroll
            for (int kr = 0; kr < 5; ++kr)
#pragma unroll
                for (int i = 0; i < 16; ++i) { const float p = __builtin_amdgcn_exp2f(S[kr][i] - m); S[kr][i] = p; lsum += p; }
            lsum = xor32_sum(lsum); lsum += __builtin_amdgcn_exp2f(sinkl - m);
            f32x16 O0, O1;
#pragma unroll
            for (int i = 0; i < 16; ++i) { O0[i] = 0.f; O1[i] = 0.f; }
#pragma unroll
            for (int kr = 0; kr < 5; ++kr) {
#pragma unroll
                for (int s2 = 0; s2 < 2; ++s2) {
                    u32x4 pw; pw.x = cvtpk(S[kr][8 * s2 + 0], S[kr][8 * s2 + 1]); pw.y = cvtpk(S[kr][8 * s2 + 2], S[kr][8 * s2 + 3]); pw.z = cvtpk(S[kr][8 * s2 + 4], S[kr][8 * s2 + 5]); pw.w = cvtpk(S[kr][8 * s2 + 6], S[kr][8 * s2 + 7]);
                    const bf16x8_t pf = __builtin_bit_cast(bf16x8_t, pw);
                    const int kb = (32 * (kt0 + kr) + 16 * s2) * 128 + vlane;
                    const s16x4 lo0 = __builtin_amdgcn_ds_read_tr16_b64_v4i16((LAS s16x4*)(Vl + kb + (0 ^ sw) * 64));
                    const s16x4 hi0 = __builtin_amdgcn_ds_read_tr16_b64_v4i16((LAS s16x4*)(Vl + kb + 8 * 128 + (0 ^ sw) * 64));
                    const s16x4 lo1 = __builtin_amdgcn_ds_read_tr16_b64_v4i16((LAS s16x4*)(Vl + kb + (1 ^ sw) * 64));
                    const s16x4 hi1 = __builtin_amdgcn_ds_read_tr16_b64_v4i16((LAS s16x4*)(Vl + kb + 8 * 128 + (1 ^ sw) * 64));
                    const bf16x8_t va0 = __builtin_shufflevector(lo0, hi0, 0, 1, 2, 3, 4, 5, 6, 7), va1 = __builtin_shufflevector(lo1, hi1, 0, 1, 2, 3, 4, 5, 6, 7);
                    O0 = __builtin_amdgcn_mfma_f32_32x32x16_bf16(va0, pf, O0, 0, 0, 0);
                    O1 = __builtin_amdgcn_mfma_f32_32x32x16_bf16(va1, pf, O1, 0, 0, 0);
                }
            }
            const float inv = __builtin_amdgcn_rcpf(lsum);
            bf16_t* yp = Y + tq * D + hq * 64 + 4 * h;
#pragma unroll
            for (int gq = 0; gq < 4; ++gq) {
                u32x2 o0; o0.x = cvtpk(O0[4 * gq] * inv, O0[4 * gq + 1] * inv); o0.y = cvtpk(O0[4 * gq + 2] * inv, O0[4 * gq + 3] * inv);
                u32x2 o1; o1.x = cvtpk(O1[4 * gq] * inv, O1[4 * gq + 1] * inv); o1.y = cvtpk(O1[4 * gq + 2] * inv, O1[4 * gq + 3] * inv);
                *(u32x2*)(yp + 8 * gq) = o0; *(u32x2*)(yp + 32 + 8 * gq) = o1;
            }
        }
    }
    __syncthreads();
}


#undef AT_LOAD
constexpr size_t WS_DN_MR = 360 * MiB, WS_DN_BNT = 376 * MiB, WS_DN_QP = 392 * MiB, WS_DN_OLT = 408 * MiB, WS_DN_ST = 424 * MiB;
constexpr int DL = 72, LB = 9216;
constexpr int L_KR = 0, L_KT = LB, L_QR = 2 * LB, L_VT = 3 * LB, L_AR = 4 * LB, L_T1 = 5 * LB, L_T2 = 6 * LB, L_UT = 7 * LB, L_UPT = 8 * LB, L_WPT = 9 * LB, L_WT = 0;
constexpr int L_LR = 7 * LB, L_L21 = L_LR + 17408, L_T11T = L_L21 + 4608, L_T22R = L_T11T + 4608, L_YT = L_T22R + 4608, L_GC = 100352, L_BETA = L_GC + 256;
static_assert(L_YT + 4608 == L_GC && L_GC + 512 <= 131072, "DeltaNet LDS map");
template <int KS> __device__ __forceinline__ f32x4 mm16(const LAS unsigned char* lds, int offX, int offY, int tx, int ty, int lane) {
    f32x4 acc = (f32x4){0.f, 0.f, 0.f, 0.f};
    const int l15 = lane & 15, q = lane >> 4;
#pragma unroll
    for (int ks = 0; ks < KS; ++ks) {
        const bf16x8_t xa = *(const LAS bf16x8_t*)(lds + offX + ((16 * tx + l15) * DL + 32 * ks + 8 * q) * 2);
        const bf16x8_t yb = *(const LAS bf16x8_t*)(lds + offY + ((16 * ty + l15) * DL + 32 * ks + 8 * q) * 2);
        acc = __builtin_amdgcn_mfma_f32_16x16x32_bf16(xa, yb, acc, 0, 0, 0);
    }
    return acc;
}
__device__ __forceinline__ u32x2 pack4(f32x4 v) { u32x2 o; o.x = cvtpk(v.x, v.y); o.y = cvtpk(v.z, v.w); return o; }

__device__ __forceinline__ void ph_dn_chunk(const Args& a, Frame& F, int l) {
    const bf16_t* P = (const bf16_t*)(F.ws + WS_PROJ); const float* BG = (const float*)(F.ws + WS_BG);
    bf16_t* MR = (bf16_t*)(F.ws + WS_DN_MR); bf16_t* BNT = (bf16_t*)(F.ws + WS_DN_BNT); bf16_t* QP = (bf16_t*)(F.ws + WS_DN_QP); bf16_t* OLT = (bf16_t*)(F.ws + WS_DN_OLT);
    LAS unsigned char* lds = F.lds;
    LAS float* gcL = (LAS float*)(lds + L_GC); LAS float* betaL = (LAS float*)(lds + L_BETA);
    const float* cw = a.dn_conv_w + (size_t)l * DN_CONV * 768;
    const int lane = F.lane, w = F.wave, l15 = lane & 15, q4 = lane >> 4;
    LAS float* cwL = (LAS float*)(lds + L_GC + 512);
    int cur_h = -1;
    const int ci = F.tid >> 3, c8 = F.tid & 7;
    u32x4 xr[3][4]; float bgb = 0.f, bgg = 0.f;
#define CH_LOAD(vu_) { const int n_ = ((vu_) >> 2) & 255, h_ = (vu_) & 3, b_ = (vu_) >> 10; const int t_ = b_ * SEQ + n_ * 64 + ci; \
        _Pragma("unroll") for (int kd = 0; kd < 3; ++kd) _Pragma("unroll") for (int k = 0; k < DN_CONV; ++k) { \
            const int tt_ = (n_ * 64 + ci - (DN_CONV - 1) + k >= 0) ? t_ - (DN_CONV - 1) + k : t_; xr[kd][k] = *(const u32x4*)(P + (size_t)tt_ * NP + C_DQ + kd * 256 + h_ * 64 + c8 * 8); } \
        if (w == 0) { bgb = BG[(size_t)(b_ * SEQ + n_ * 64 + lane) * 8 + h_]; bgg = BG[(size_t)(b_ * SEQ + n_ * 64 + lane) * 8 + 4 + h_]; } }
    if (F.bid < BATCH * 4 * 256) CH_LOAD(F.bid)
    for (int vu = F.bid; vu < BATCH * 4 * 256; vu += F.nb) {
        const int n = (vu >> 2) & 255, h = vu & 3, b = vu >> 10, unit = (b * 4 + h) * 256 + n;
        const int t0 = b * SEQ + n * 64;
        __syncthreads();
        if (h != cur_h) { cur_h = h;
            for (int idx = F.tid; idx < DN_CONV * 3 * 64; idx += NTHREADS) { const int k = idx / 192, kd = (idx / 64) % 3, cc = idx & 63; cwL[idx] = cw[k * 768 + kd * 256 + h * 64 + cc]; }
            __syncthreads(); }
        {
            const int i = ci, sq = n * 64 + i;
#pragma unroll
            for (int kd = 0; kd < 3; ++kd) {
                float acc[8];
#pragma unroll
                for (int e = 0; e < 8; ++e) acc[e] = 0.f;
#pragma unroll
                for (int k = 0; k < DN_CONV; ++k) {
                    const u32x4 xv = xr[kd][k]; const float vm = (sq - (DN_CONV - 1) + k >= 0) ? 1.f : 0.f;
                    const f32x4 w0 = *(const LAS f32x4*)(cwL + (k * 3 + kd) * 64 + c8 * 8) * vm, w1 = *(const LAS f32x4*)(cwL + (k * 3 + kd) * 64 + c8 * 8 + 4) * vm;
                    acc[0] += w0.x * bf2f(xv.x & 0xffffu); acc[1] += w0.y * bf2f(xv.x >> 16); acc[2] += w0.z * bf2f(xv.y & 0xffffu); acc[3] += w0.w * bf2f(xv.y >> 16);
                    acc[4] += w1.x * bf2f(xv.z & 0xffffu); acc[5] += w1.y * bf2f(xv.z >> 16); acc[6] += w1.z * bf2f(xv.w & 0xffffu); acc[7] += w1.w * bf2f(xv.w >> 16);
                }
                float ss = 0.f;
#pragma unroll
                for (int e = 0; e < 8; ++e) { acc[e] = siluf_(acc[e]); ss += acc[e] * acc[e]; }
                if (kd < 2) {
                    ss = group8_sum(ss);
                    const float rn = rsqrtf(ss + EPS) * (kd == 0 ? 0.125f : 1.0f);
#pragma unroll
                    for (int e = 0; e < 8; ++e) acc[e] *= rn;
                }
                u32x4 pk; pk.x = cvtpk(acc[0], acc[1]); pk.y = cvtpk(acc[2], acc[3]); pk.z = cvtpk(acc[4], acc[5]); pk.w = cvtpk(acc[6], acc[7]);
                if (kd == 0) *(LAS u32x4*)(lds + L_QR + (i * DL + c8 * 8) * 2) = pk;
                if (kd == 1) *(LAS u32x4*)(lds + L_KR + (i * DL + c8 * 8) * 2) = pk;
                if (kd >= 1) {
                    LAS bf16_t* Tt = (LAS bf16_t*)(lds + (kd == 1 ? L_KT : L_VT));
                    const unsigned pw[4] = {pk.x, pk.y, pk.z, pk.w};
#pragma unroll
                    for (int e = 0; e < 8; ++e) Tt[(c8 * 8 + e) * DL + i] = (bf16_t)((pw[e >> 1] >> (16 * (e & 1))) & 0xffffu);
                }
            }
            for (int idx = F.tid; idx < 2 * LB / 16; idx += NTHREADS) *(LAS u32x4*)(lds + L_T1 + idx * 16) = (u32x4){0u, 0u, 0u, 0u};
            if (w == 0) {
                float x = bgg;
#pragma unroll
                for (int o = 1; o < 64; o <<= 1) { const float y = __shfl_up(x, o); if (lane >= o) x += y; }
                gcL[lane] = x; betaL[lane] = bgb;
            }
            if (vu + F.nb < BATCH * 4 * 256) CH_LOAD(vu + F.nb)
            asm volatile("" ::: "memory");
        }
        __syncthreads();
        REP(134217728)
#pragma unroll
        for (int tt = 0; tt < 2; ++tt) {
            const int tidx = 2 * w + tt, tx = tidx >> 2, ty = tidx & 3, i = 16 * ty + l15, j0 = 16 * tx + 4 * q4;
            const float gi = gcL[i], bi = betaL[i]; const f32x4 gj = *(const LAS f32x4*)(gcL + j0);
            const float gjv[4] = {gj.x, gj.y, gj.z, gj.w};
            const f32x4 zk = mm16<2>(lds, L_KR, L_KR, tx, ty, lane);
            const f32x4 zq = mm16<2>(lds, L_KR, L_QR, tx, ty, lane);
            f32x4 lv, av;
#pragma unroll
            for (int r = 0; r < 4; ++r) { const float dc = __expf(fminf(gi - gjv[r], 0.f)); lv[r] = (j0 + r < i) ? bi * zk[r] * dc : 0.f; av[r] = (j0 + r <= i) ? zq[r] * dc : 0.f; }
            *(LAS f32x4*)(lds + L_LR + (i * 68 + j0) * 4) = lv;
            if (i >= 32 && j0 < 32) *(LAS u32x2*)(lds + L_L21 + ((i - 32) * DL + j0) * 2) = pack4(lv);
            *(LAS u32x2*)(lds + L_AR + (i * DL + j0) * 2) = pack4(av);
        }
        __syncthreads();
        REP(32768) {
            const int cg = 8 * w + (lane >> 3), blk = cg >> 5, jp = cg & 31, l8 = lane & 7;
            const LAS float* Lb = (const LAS float*)(lds + L_LR) + (32 * blk) * 68 + 32 * blk + 4 * l8;
            float x0 = 0.f, x1 = 0.f, x2 = 0.f, x3 = 0.f;
#pragma unroll
            for (int i = 0; i < 32; ++i) {
                const f32x4 l4 = *(const LAS f32x4*)(Lb + i * 68);
                float part = (l4.x * x0 + l4.y * x1) + (l4.z * x2 + l4.w * x3);
                part = group8_sum(part);
                const float xi = ((i == jp) ? 1.f : 0.f) - part;
                if (l8 == (i >> 2)) { if ((i & 3) == 0) x0 = xi; else if ((i & 3) == 1) x1 = xi; else if ((i & 3) == 2) x2 = xi; else x3 = xi; }
            }
            const int jg = 32 * blk + jp; const float bj = betaL[jg], bej = bj * __expf(gcL[jg]);
            LAS bf16_t* T1 = (LAS bf16_t*)(lds + L_T1); LAS bf16_t* T2 = (LAS bf16_t*)(lds + L_T2);
            const float xs[4] = {x0, x1, x2, x3};
#pragma unroll
            for (int e = 0; e < 4; ++e) { const int rg = 32 * blk + 4 * l8 + e; T1[rg * DL + jg] = (bf16_t)f2bf(xs[e] * bj); T2[rg * DL + jg] = (bf16_t)f2bf(xs[e] * bej); }
            if (blk == 0) { *(LAS u32x2*)(lds + L_T11T + (jp * DL + 4 * l8) * 2) = pack4((f32x4){x0, x1, x2, x3}); }
            else { LAS bf16_t* T22 = (LAS bf16_t*)(lds + L_T22R);
#pragma unroll
                for (int e = 0; e < 4; ++e) T22[(4 * l8 + e) * DL + jp] = (bf16_t)f2bf(xs[e]); }
        }
        __syncthreads();
        if (w < 4) {
            const int tx = w >> 1, ty = w & 1;
            const f32x4 z = mm16<1>(lds, L_L21, L_T11T, tx, ty, lane);
            *(LAS u32x2*)(lds + L_YT + ((16 * ty + l15) * DL + 16 * tx + 4 * q4) * 2) = pack4(z);
        }
        __syncthreads();
        if (w < 4) {
            const int tx = w >> 1, ty = w & 1, y = 16 * ty + l15, x0 = 16 * tx + 4 * q4;
            const f32x4 z = mm16<1>(lds, L_T22R, L_YT, tx, ty, lane);
            const float bj = betaL[y], bej = bj * __expf(gcL[y]);
            LAS bf16_t* T1 = (LAS bf16_t*)(lds + L_T1); LAS bf16_t* T2 = (LAS bf16_t*)(lds + L_T2);
#pragma unroll
            for (int r = 0; r < 4; ++r) { T1[(32 + x0 + r) * DL + y] = (bf16_t)f2bf(-z[r] * bj); T2[(32 + x0 + r) * DL + y] = (bf16_t)f2bf(-z[r] * bej); }
        }
        __syncthreads();
        const float gl = gcL[63];
        REP(268435456)
#pragma unroll
        for (int tt = 0; tt < 2; ++tt) {
            const int tidx = 2 * w + tt, tx = tidx >> 2, ty = tidx & 3, y = 16 * ty + l15, x0 = 16 * tx + 4 * q4;
            const f32x4 gx = *(const LAS f32x4*)(gcL + x0);
            f32x4 sc; sc.x = __expf(gl - gx.x); sc.y = __expf(gl - gx.y); sc.z = __expf(gl - gx.z); sc.w = __expf(gl - gx.w);
            const f32x4 zu = mm16<2>(lds, L_T1, L_VT, tx, ty, lane);
            const f32x4 zw = mm16<2>(lds, L_T2, L_KT, tx, ty, lane);
            *(LAS u32x2*)(lds + L_UT + (y * DL + x0) * 2) = pack4(zu); *(LAS u32x2*)(lds + L_UPT + (y * DL + x0) * 2) = pack4(zu * sc);
            *(LAS u32x2*)(lds + L_WT + (y * DL + x0) * 2) = pack4(zw); *(LAS u32x2*)(lds + L_WPT + (y * DL + x0) * 2) = pack4(zw * sc);
        }
        __syncthreads();
        REP(65536) {
            const size_t cho = (size_t)unit * 4096;
            const float egl = __expf(gl);
#pragma unroll
            for (int tt = 0; tt < 2; ++tt) {
                const int tidx = 2 * w + tt, tx = tidx >> 2, ty = tidx & 3, y = 16 * ty + l15, x0 = 16 * tx + 4 * q4;
                f32x4 zm = mm16<2>(lds, L_WPT, L_KT, tx, ty, lane);
#pragma unroll
                for (int r = 0; r < 4; ++r) zm[r] = ((x0 + r) == y ? egl : 0.f) - zm[r];
                *(u32x2*)(MR + cho + (ty * 2 + (tx >> 1)) * 512 + lane * 8 + 4 * (tx & 1)) = pack4(zm);
                const f32x4 zb = mm16<2>(lds, L_KT, L_UPT, tx, ty, lane);
                *(u32x2*)(BNT + cho + (ty * 4 + tx) * 256 + lane * 4) = pack4(zb);
                const f32x4 zq = mm16<2>(lds, L_WT, L_AR, tx, ty, lane);
                const u32x2 qv = *(const LAS u32x2*)(lds + L_QR + (y * DL + x0) * 2); const float eg = __expf(gcL[y]);
                f32x4 qp; qp.x = bf2f(qv.x & 0xffffu) * eg - zq.x; qp.y = bf2f(qv.x >> 16) * eg - zq.y; qp.z = bf2f(qv.y & 0xffffu) * eg - zq.z; qp.w = bf2f(qv.y >> 16) * eg - zq.w;
                *(u32x2*)(QP + cho + y * 64 + x0) = pack4(qp);
                const f32x4 zo = mm16<2>(lds, L_AR, L_UT, tx, ty, lane);
                *(u32x2*)(OLT + cho + y * 64 + x0) = pack4(zo);
            }
        }
    }
    __syncthreads();
}
#undef CH_LOAD
constexpr int SC_SLOT = 10240, SC_DEPTH = 12, SC_AHEAD = 10, SC_STS = 2 * 16 * 144;
__device__ __forceinline__ void ph_dn_scan(const Args& a, Frame& F, int l) {
    if (F.bid >= NSCAN) return;
    GAS unsigned* prog = (GAS unsigned*)(F.ws + WS_CTL) + CW_SCANP + l * 4096 + 64 * F.bid;
    const unsigned char* MRb = (const unsigned char*)(F.ws + WS_DN_MR); const unsigned char* BNb = (const unsigned char*)(F.ws + WS_DN_BNT); GAS bf16_t* ST = (GAS bf16_t*)(F.ws + WS_DN_ST);
    const int lane = F.lane, l15 = lane & 15, q4 = lane >> 4, wq = F.bid >> 3;
    const size_t ch0 = (size_t)(F.bid & 7) * 256;
    LAS unsigned char* lds = F.lds; LAS unsigned char* stl = F.lds + RI_OFF;
    __syncthreads();
    if (F.wave >= 3) {
        const int lw = F.wave - 3;
#define DN_ISSUE(nn) do { const size_t chb_ = (ch0 + (size_t)((nn) < 255 ? (nn) : 255)) * 8192; const int slot_ = ((nn) % SC_DEPTH) * SC_SLOT; \
        _Pragma("unroll") for (int p_ = 0; p_ < 2; ++p_) { const int piece_ = lw * 2 + p_; \
            const unsigned char* src_ = (piece_ < 8 ? MRb + chb_ + piece_ * 1024 : BNb + chb_ + wq * 2048 + (piece_ - 8) * 1024) + lane * 16; \
            __builtin_amdgcn_global_load_lds((const unsigned*)src_, (LAS unsigned*)(lds + slot_ + piece_ * 1024), 16, 0, 2); } } while (0)
        for (int n = 0; n < SC_AHEAD; ++n) DN_ISSUE(n);
        for (int n = 0; n < 256; n += 2) {
            asm volatile("s_waitcnt vmcnt(16)" ::: "memory");
            __builtin_amdgcn_s_barrier();
            DN_ISSUE(n + SC_AHEAD); DN_ISSUE(n + SC_AHEAD + 1);
        }
        asm volatile("s_waitcnt vmcnt(0)" ::: "memory");
        __builtin_amdgcn_s_barrier();
#undef DN_ISSUE
    } else if (F.wave == 0) {
        const int dv = 16 * wq + l15;
        f32x4 S[4];
#pragma unroll
        for (int ti = 0; ti < 4; ++ti) S[ti] = (f32x4){0.f, 0.f, 0.f, 0.f};
        for (int n0 = 0; n0 < 256; n0 += 2) {
            __builtin_amdgcn_s_barrier();
            bf16x8_t A[2][4][2]; u32x2 Bc[2][4];
#pragma unroll
            for (int e = 0; e < 2; ++e) { const LAS unsigned char* slot = lds + ((n0 + e) % SC_DEPTH) * SC_SLOT;
#pragma unroll
                for (int ti = 0; ti < 4; ++ti) {
#pragma unroll
                    for (int ks = 0; ks < 2; ++ks) A[e][ti][ks] = *(const LAS bf16x8_t*)(slot + (ti * 2 + ks) * 1024 + lane * 16);
                    Bc[e][ti] = *(const LAS u32x2*)(slot + 8192 + ti * 512 + lane * 8);
                } }
#pragma unroll
            for (int e = 0; e < 2; ++e) {
                const int n = n0 + e;
                u32x2 sp[4];
#pragma unroll
                for (int ti = 0; ti < 4; ++ti) { sp[ti] = pack4(S[ti]); *(LAS u32x2*)(stl + ((n0 >> 1) & 1) * SC_STS + e * (SC_STS / 2) + l15 * 144 + (16 * ti + 4 * q4) * 2) = sp[ti]; }
                const bf16x8_t b0 = __builtin_bit_cast(bf16x8_t, (u32x4){sp[0].x, sp[0].y, sp[1].x, sp[1].y});
                const bf16x8_t b1 = __builtin_bit_cast(bf16x8_t, (u32x4){sp[2].x, sp[2].y, sp[3].x, sp[3].y});
#pragma unroll
                for (int ti = 0; ti < 4; ++ti) {
                    f32x4 c; c.x = bf2f(Bc[e][ti].x & 0xffffu); c.y = bf2f(Bc[e][ti].x >> 16); c.z = bf2f(Bc[e][ti].y & 0xffffu); c.w = bf2f(Bc[e][ti].y >> 16);
                    c = __builtin_amdgcn_mfma_f32_16x16x32_bf16(A[e][ti][0], b0, c, 0, 0, 0);
                    c = __builtin_amdgcn_mfma_f32_16x16x32_bf16(A[e][ti][1], b1, c, 0, 0, 0);
                    S[ti] = c;
                }
            }
            asm volatile("s_waitcnt lgkmcnt(0)" ::: "memory");
        }
        __builtin_amdgcn_s_barrier();
    } else if (F.wave == 1) {
        GAS unsigned char* stg = (GAS unsigned char*)(ST + ch0 * 4096 + (size_t)(16 * wq) * 64);
        for (int n0 = 0; n0 <= 256; n0 += 2) {
            __builtin_amdgcn_s_barrier();
            if (n0 >= 2) {
                const LAS unsigned char* slot = stl + (((n0 - 2) >> 1) & 1) * SC_STS;
#pragma unroll
                for (int e = 0; e < 2; ++e)
#pragma unroll
                    for (int i = 0; i < 2; ++i) { const int pc = i * 64 + lane; const u32x4 v = *(const LAS u32x4*)(slot + e * (SC_STS / 2) + (pc >> 3) * 144 + (pc & 7) * 16);
                        const unsigned long long gp = (unsigned long long)(stg + (size_t)(n0 - 2 + e) * 8192 + pc * 16);
                        asm volatile("global_store_dwordx4 %0, %1, off sc1" :: "v"(gp), "v"(v) : "memory"); }
                asm volatile("s_waitcnt vmcnt(40)" ::: "memory");
                if (lane == 0) __hip_atomic_store(prog, (unsigned)(n0 >= 16 ? n0 - 16 : 0), __ATOMIC_RELAXED, __HIP_MEMORY_SCOPE_AGENT);
            }
        }
        asm volatile("s_waitcnt vmcnt(0)" ::: "memory");
        if (lane == 0) __hip_atomic_store(prog, 256u, __ATOMIC_RELAXED, __HIP_MEMORY_SCOPE_AGENT);
    } else {
        for (int n = 0; n <= 256; n += 2) __builtin_amdgcn_s_barrier();
    }
    __syncthreads();
}
__device__ __forceinline__ void ph_dn_out(const Args& a, Frame& F, int l) {
    const bf16_t* QP = (const bf16_t*)(F.ws + WS_DN_QP); const bf16_t* OLT = (const bf16_t*)(F.ws + WS_DN_OLT); const bf16_t* ST = (const bf16_t*)(F.ws + WS_DN_ST);
    const bf16_t* P = (const bf16_t*)(F.ws + WS_PROJ); bf16_t* Y = (bf16_t*)(F.ws + WS_YMIX);
    const int lane = F.lane, l15 = lane & 15, q4 = lane >> 4, ti = F.wave & 3;
    LAS bf16_t* TL = (LAS bf16_t*)(F.lds + F.wave * 2560);
    const int er = lane >> 2, ec = (lane & 3) * 16;
    f32x4 gnv[4];
#pragma unroll
    for (int j = 0; j < 4; ++j) gnv[j] = *(const f32x4*)(a.dn_norm_g + l * 64 + ec + 4 * j);
    bf16x8_t af[2], bfv[4][2]; u32x2 ov[4];
    int pr0, prs, pre;
    if (F.nb == 256 && NSCAN == 32) { const int v = F.bid - NSCAN;
        if (v >= 32) { pr0 = v - 32; prs = 192; pre = 960; } else if (v >= 0) { pr0 = 960 + v; prs = 1024; pre = 1024; } else { pr0 = 992 + F.bid; prs = 1024; pre = 1024; } }
    else { if (F.bid < NSCAN) return; pr0 = F.bid - NSCAN; prs = F.nb - NSCAN; pre = 1024; }
    GAS unsigned* prog = (GAS unsigned*)(F.ws + WS_CTL) + CW_SCANP + l * 4096; unsigned* tmo = (unsigned*)(F.ws + WS_CTL) + CW_BAR + XB_TMO;
    unsigned seen = 0;
    volatile LAS unsigned* seenl = (volatile LAS unsigned*)(F.lds + MISC_OFF) + 16;
#define DNO_WAIT(prv) { const unsigned need_ = 2u * (unsigned)((prv) >> 3) + 2u; const int bh_ = (prv) & 7; if ((prs & 7) != 0) seen = 0; if (seen < need_) {   \
        if (F.wave == 0) { unsigned sp_ = 0, m_; \
            for (;;) { unsigned v_ = lane < 4 ? __hip_atomic_load(prog + 64 * (bh_ + 8 * lane), __ATOMIC_RELAXED, __HIP_MEMORY_SCOPE_AGENT) : 0xffffffffu; \
                _Pragma("unroll") for (int o_ = 2; o_ >= 1; o_ >>= 1) { const unsigned w_ = (unsigned)__shfl_xor((int)v_, o_); v_ = w_ < v_ ? w_ : v_; } \
                m_ = (unsigned)__builtin_amdgcn_readfirstlane((int)v_); if (m_ >= need_) break; \
                __builtin_amdgcn_s_sleep(8); \
                if ((++sp_ & 63u) == 0u) { if (xb_ld(tmo)) break; if (sp_ > (1u << 16)) { atomicAdd(tmo, 1u); break; } } } \
            __builtin_amdgcn_fence(__ATOMIC_ACQUIRE, "agent"); asm volatile("s_waitcnt vmcnt(0)" ::: "memory"); \
            if (lane == 0) *seenl = m_; } \
        __syncthreads(); seen = *seenl; __syncthreads(); } }
#define DNO_LOAD(prv) { const int unit_ = (((prv) & 7) << 8) + 2 * ((prv) >> 3) + (F.wave >> 2); const size_t cho_ = (size_t)unit_ * 4096; \
        _Pragma("unroll") for (int ks = 0; ks < 2; ++ks) af[ks] = *(const bf16x8_t*)(QP + cho_ + (16 * ti + l15) * 64 + 32 * ks + 8 * q4); \
        _Pragma("unroll") for (int tj = 0; tj < 4; ++tj) { ov[tj] = *(const u32x2*)(OLT + cho_ + (16 * tj + l15) * 64 + 16 * ti + 4 * q4); \
            _Pragma("unroll") for (int ks = 0; ks < 2; ++ks) bfv[tj][ks] = *(const bf16x8_t*)(ST + cho_ + (16 * tj + l15) * 64 + 32 * ks + 8 * q4); } }
    if (pr0 < pre) { DNO_WAIT(pr0) DNO_LOAD(pr0) }
    for (int pr = pr0; pr < pre; pr += prs) {
        const int unit = ((pr & 7) << 8) + 2 * (pr >> 3) + (F.wave >> 2), n = unit & 255, h = (unit >> 8) & 3, b = unit >> 10;
        f32x4 acc[4];
#pragma unroll
        for (int tj = 0; tj < 4; ++tj) {
            f32x4 c; c.x = bf2f(ov[tj].x & 0xffffu); c.y = bf2f(ov[tj].x >> 16); c.z = bf2f(ov[tj].y & 0xffffu); c.w = bf2f(ov[tj].y >> 16);
#pragma unroll
            for (int ks = 0; ks < 2; ++ks) c = __builtin_amdgcn_mfma_f32_16x16x32_bf16(af[ks], bfv[tj][ks], c, 0, 0, 0);
            acc[tj] = c;
        }
        const size_t trow = (size_t)b * SEQ + n * 64 + 16 * ti + er;
        const u32x4 z0 = *(const u32x4*)(P + trow * NP + C_DZ + h * 64 + ec), z1 = *(const u32x4*)(P + trow * NP + C_DZ + h * 64 + ec + 8);
        if (pr + prs < pre) { DNO_WAIT(pr + prs) DNO_LOAD(pr + prs) }
        f32x4 ss = acc[0] * acc[0] + acc[1] * acc[1] + acc[2] * acc[2] + acc[3] * acc[3];
        ss.x = row16_sum(ss.x); ss.y = row16_sum(ss.y); ss.z = row16_sum(ss.z); ss.w = row16_sum(ss.w);
        const float rs[4] = {rsqrtf(ss.x * (1.f / 64.f) + EPS), rsqrtf(ss.y * (1.f / 64.f) + EPS), rsqrtf(ss.z * (1.f / 64.f) + EPS), rsqrtf(ss.w * (1.f / 64.f) + EPS)};
#pragma unroll
        for (int tj = 0; tj < 4; ++tj)
#pragma unroll
            for (int r = 0; r < 4; ++r) TL[(4 * q4 + r) * 80 + 16 * tj + l15] = (bf16_t)f2bf(acc[tj][r] * rs[r]);
        const u32x4 t0 = *(const LAS u32x4*)(TL + er * 80 + ec), t1 = *(const LAS u32x4*)(TL + er * 80 + ec + 8);
        const unsigned tw[8] = {t0.x, t0.y, t0.z, t0.w, t1.x, t1.y, t1.z, t1.w}, zw[8] = {z0.x, z0.y, z0.z, z0.w, z1.x, z1.y, z1.z, z1.w};
        unsigned yw[8];
#pragma unroll
        for (int j = 0; j < 8; ++j) {
            const float g0 = gnv[j >> 1][(2 * j) & 3], g1 = gnv[j >> 1][(2 * j + 1) & 3];
            yw[j] = cvtpk(bf2f(tw[j] & 0xffffu) * g0 * siluf_(bf2f(zw[j] & 0xffffu)), bf2f(tw[j] >> 16) * g1 * siluf_(bf2f(zw[j] >> 16)));
        }
        bf16_t* yp = Y + trow * D + 512 + h * 64 + ec;
        *(u32x4*)yp = (u32x4){yw[0], yw[1], yw[2], yw[3]}; *(u32x4*)(yp + 8) = (u32x4){yw[4], yw[5], yw[6], yw[7]};
    }
#undef DNO_LOAD
#undef DNO_WAIT
}

__device__ __forceinline__ void ph_conv_fast(const Args& a, Frame& F, int l) {
    const bf16_t* P = (const bf16_t*)(F.ws + WS_PROJ); bf16_t* Y = (bf16_t*)(F.ws + WS_YMIX);
    LAS float* OUTL = (LAS float*)F.lds;
    const int c = F.tid & 255, rsel = F.tid >> 8;
    float wk[CV_K];
#pragma unroll
    for (int k = 0; k < CV_K; ++k) wk[k] = a.cv_dw_w[((size_t)l * CV_K + k) * CV_C + c];
    const float bias = a.cv_dw_b[l * CV_C + c];
    const int nsc = NSCAN;
    if (F.bid < nsc) return;
    for (int pr = F.bid - nsc; pr < T / 128; pr += F.nb - nsc) {
        const int run = 2 * pr + rsel, t0 = run * 64, s0 = t0 % SEQ;
        __syncthreads();
        float win[CV_K];
        const bf16_t* pc = P + (size_t)(t0 - 30) * NP + C_CA + c;
        const bool first = (s0 == 0);
        LAS float* outp = OUTL + (rsel * 64) * 256 + c;
#define CV_U(ti_, dst) { const bool ok_ = !(first && (ti_) < 30); const bf16_t* q_ = ok_ ? pc + (size_t)(ti_) * NP : pc + (size_t)30 * NP; \
            const float ca_ = bf2f(q_[0]), cb_ = bf2f(q_[256]); dst = ok_ ? ca_ * sigmoidf_(cb_) : 0.f; }
#pragma unroll
        for (int p = 0; p < CV_K; ++p) CV_U(p, win[p])
        { float acc = bias;
#pragma unroll
            for (int k = 0; k < CV_K; ++k) acc += wk[k] * win[(30 + 1 + k) % CV_K];
            outp[0] = acc; }
        for (int cb3 = 1; cb3 < 3; ++cb3) {
            float un[CV_K];
#pragma unroll
            for (int p = 0; p < CV_K; ++p) CV_U(cb3 * CV_K + p, un[p])
#pragma unroll
            for (int p = 0; p < CV_K; ++p) {
                win[p] = un[p];
                float acc = bias;
#pragma unroll
                for (int k = 0; k < CV_K; ++k) acc += wk[k] * win[(p + 1 + k) % CV_K];
                outp[(cb3 * CV_K + p - 30) * 256] = acc;
            }
        }
        { float u93; CV_U(93, u93) win[0] = u93; float acc = bias;
#pragma unroll
            for (int k = 0; k < CV_K; ++k) acc += wk[k] * win[(0 + 1 + k) % CV_K];
            outp[63 * 256] = acc; }
#undef CV_U
        __syncthreads();
        const f32x4 g4 = *(const f32x4*)(a.cv_ln_g + l * CV_C + 4 * F.lane), b4 = *(const f32x4*)(a.cv_ln_b + l * CV_C + 4 * F.lane);
        for (int j = 0; j < 16; ++j) {
            const int tl = F.wave * 16 + j;
            const f32x4 v = *(const LAS f32x4*)(OUTL + tl * 256 + 4 * F.lane);
            const float mean = wave_sum((v.x + v.y) + (v.z + v.w)) * (1.0f / CV_C);
            const f32x4 dv = v - mean;
            const float var = wave_sum((dv.x * dv.x + dv.y * dv.y) + (dv.z * dv.z + dv.w * dv.w)) * (1.0f / CV_C);
            const float rstd = rsqrtf(var + EPS);
            const f32x4 y = (dv * rstd) * g4 + b4;
            u32x2 o; o.x = cvtpk(siluf_(y.x), siluf_(y.y)); o.y = cvtpk(siluf_(y.z), siluf_(y.w));
            *(u32x2*)(Y + (size_t)(pr * 128 + tl) * D + 768 + 4 * F.lane) = o;
        }
    }
    __syncthreads();
}

__device__ __forceinline__ void moe_bases(Frame& F, int (&base)[9], int (&cnt)[8]) {
    const unsigned* c = (const unsigned*)(F.ws + WS_CTL) + CW_MOECNT;
    int acc = 0;
#pragma unroll
    for (int e = 0; e < 8; ++e) { cnt[e] = (int)__hip_atomic_load(c + 64 * e, __ATOMIC_RELAXED, __HIP_MEMORY_SCOPE_AGENT); base[e] = acc; acc += (cnt[e] + 255) & ~255; }
    base[8] = acc;
}
__device__ __forceinline__ void moe_range(Frame& F, int e, int& lo, int& hi) {
    const unsigned* c = (const unsigned*)(F.ws + WS_CTL) + CW_MOECNT;
    int acc = 0; lo = 0; hi = 0;
#pragma unroll
    for (int k = 0; k < 8; ++k) { const int n = ((int)__hip_atomic_load(c + 64 * k, __ATOMIC_RELAXED, __HIP_MEMORY_SCOPE_AGENT) + 255) & ~255; if (k == e) { lo = acc; hi = acc + n; } acc += n; }
}
__device__ __forceinline__ void ph_moe_list(const Args& a, Frame& F) {
    int base[9], cnt[8]; moe_bases(F, base, cnt);
    int* RM = (int*)(F.ws + WS_RMAP); const int* R = (const int*)(F.ws + WS_ROUTE); const int* Pq = (const int*)(F.ws + WS_POS);
    for (int t = F.bid * NTHREADS + F.tid; t < T; t += F.nb * NTHREADS) {
        const int e0 = R[t * 4], e1 = R[t * 4 + 1];
        int b0 = 0, b1 = 0;
#pragma unroll
        for (int e = 0; e < 8; ++e) { if (e == e0) b0 = base[e]; if (e == e1) b1 = base[e]; }
        RM[b0 + Pq[t * 2]] = t; RM[b1 + Pq[t * 2 + 1]] = t;
    }
    if (F.bid == 0) {
#pragma unroll
        for (int e = 0; e < 8; ++e) { const int lo = base[e] + cnt[e], hi = base[e + 1]; for (int r = lo + F.tid; r < hi; r += NTHREADS) RM[r] = 0; }
    }
}
__device__ __forceinline__ void ph_final(const Args& a, Frame& F) {
    int base[9], cnt[8]; moe_bases(F, base, cnt);
    const float* MOD = (const float*)(F.ws + WS_MOD);
    const bf16_t* YM = (const bf16_t*)(F.ws + WS_YMOE); const int* R = (const int*)(F.ws + WS_ROUTE); const int* Pq = (const int*)(F.ws + WS_POS); const bf16_t* X16 = (const bf16_t*)(F.ws + WS_X16);
    const int c0 = 8 * F.lane;
    f32x4 fg[4], gt[4]; int cur_b = -1;
#pragma unroll
    for (int j = 0; j < 4; ++j) fg[j] = *(const f32x4*)(a.final_g + 512 * (j >> 1) + c0 + 4 * (j & 1));
    u32x4 rt_n; u32x2 pq_n;
    u32x4 dx[2], dy0[2], dy1[2]; float p0c = 0.f, p1c = 0.f;
#define FIN_ROUTE(row_, rt_, pq_) { rt_ = *(const u32x4*)(R + (size_t)(row_) * 4); pq_ = *(const u32x2*)(Pq + (size_t)(row_) * 2); }
#define FIN_DATA(row_, rt_, pq_) { int b0_ = 0, b1_ = 0; _Pragma("unroll") for (int e = 0; e < 8; ++e) { if (e == (int)rt_.x) b0_ = base[e]; if (e == (int)rt_.y) b1_ = base[e]; } \
        const size_t s0_ = (size_t)(b0_ + (int)pq_.x), s1_ = (size_t)(b1_ + (int)pq_.y); p0c = __uint_as_float(rt_.z); p1c = __uint_as_float(rt_.w); \
        _Pragma("unroll") for (int jj = 0; jj < 2; ++jj) { dx[jj] = __builtin_nontemporal_load((const u32x4*)(X16 + (size_t)(row_) * D + 512 * jj + c0)); dy0[jj] = __builtin_nontemporal_load((const u32x4*)(YM + s0_ * D + 512 * jj + c0)); dy1[jj] = __builtin_nontemporal_load((const u32x4*)(YM + s1_ * D + 512 * jj + c0)); } }
    if (F.gw < T) { u32x4 rt0; u32x2 pq0; FIN_ROUTE(F.gw, rt0, pq0) FIN_DATA(F.gw, rt0, pq0) }
    if (F.gw + F.ngw < T) FIN_ROUTE(F.gw + F.ngw, rt_n, pq_n)
    for (int row = F.gw; row < T; row += F.ngw) {
        const int b = row / SEQ;
        if (b != cur_b) { cur_b = b; const float* gt2 = MOD + ((size_t)(1 * 2 + 1) * 2 + b) * 3072 + 2048;
#pragma unroll
            for (int j = 0; j < 4; ++j) gt[j] = *(const f32x4*)(gt2 + 512 * (j >> 1) + c0 + 4 * (j & 1)); }
        f32x4 v[4]; float ss = 0.f; const float p0 = p0c, p1 = p1c;
#pragma unroll
        for (int jj = 0; jj < 2; ++jj) {
            const unsigned xw[4] = {dx[jj].x, dx[jj].y, dx[jj].z, dx[jj].w}, y0w[4] = {dy0[jj].x, dy0[jj].y, dy0[jj].z, dy0[jj].w}, y1w[4] = {dy1[jj].x, dy1[jj].y, dy1[jj].z, dy1[jj].w};
#pragma unroll
            for (int hf = 0; hf < 2; ++hf) {
                f32x4 f, xo;
                f.x = p0 * bf2f(y0w[2 * hf] & 0xffffu) + p1 * bf2f(y1w[2 * hf] & 0xffffu); f.y = p0 * bf2f(y0w[2 * hf] >> 16) + p1 * bf2f(y1w[2 * hf] >> 16);
                f.z = p0 * bf2f(y0w[2 * hf + 1] & 0xffffu) + p1 * bf2f(y1w[2 * hf + 1] & 0xffffu); f.w = p0 * bf2f(y0w[2 * hf + 1] >> 16) + p1 * bf2f(y1w[2 * hf + 1] >> 16);
                xo.x = bf2f(xw[2 * hf] & 0xffffu); xo.y = bf2f(xw[2 * hf] >> 16); xo.z = bf2f(xw[2 * hf + 1] & 0xffffu); xo.w = bf2f(xw[2 * hf + 1] >> 16);
                const f32x4 vv = xo + gt[2 * jj + hf] * f; v[2 * jj + hf] = vv;
                ss += (vv.x * vv.x + vv.y * vv.y) + (vv.z * vv.z + vv.w * vv.w);
            }
        }
        if (row + F.ngw < T) { FIN_DATA(row + F.ngw, rt_n, pq_n) }
        if (row + 2 * F.ngw < T) FIN_ROUTE(row + 2 * F.ngw, rt_n, pq_n)
        const float rstd = rsqrtf(wave_sum(ss) * (1.0f / D) + EPS);
        float* op = a.out + (size_t)row * D + c0;
#pragma unroll
        for (int j = 0; j < 4; ++j) __builtin_nontemporal_store((v[j] * rstd) * fg[j], (f32x4*)(op + 512 * (j >> 1) + 4 * (j & 1)));
    }
#undef FIN_ROUTE
#undef FIN_DATA
}


namespace pg8 {
typedef short bf16x8 __attribute__((ext_vector_type(8)));
constexpr int BM = 256, BK = 64, HALF = 128, HTB = HALF * BK * 2, STAGE_BYTES = 8 * HTB;
__device__ __forceinline__ int lds_byte(int r, int c) { const int st = (r >> 4) * 2 + (c >> 5), rr = r & 15, cc = c & 31, ob = rr * 64 + cc * 2; return st * 1024 + (ob ^ (((ob >> 9) & 1) << 5)); }
__device__ __forceinline__ void stage_rc(int b, int& R, int& C) { const int st = b / 1024, sb = b % 1024, swz = sb ^ (((sb >> 9) & 1) << 5); R = (st >> 1) * 16 + swz / 64; C = (st & 1) * 32 + (swz % 64) / 2; }
__device__ __forceinline__ int perm32(int rho) { const int n = rho >> 4, i = rho & 15; return 8 * (i >> 2) + 4 * n + (i & 3); }
struct Unit { int pm, pn, ord; };
struct Gemm { const bf16_t* A; const bf16_t* Bt; int K; };
constexpr int NXCD = 8, WGM = 8;
struct StaticOrder {
    int nM, nN, nwg, G, c;
    __device__ void init(int M, int N, int G_, int c_) { nM = M / BM; nN = N / BM; nwg = nM * nN; G = G_; c = c_; }
    __device__ __forceinline__ bool next(int i, Unit& u) const {
        const long L = (long)i * G + c; if (L >= nwg) return false;
        int wgid = (int)L; { const int q = nwg / NXCD, r = nwg % NXCD, xcd = wgid % NXCD, off = wgid / NXCD; wgid = (xcd < r ? xcd * (q + 1) : r * (q + 1) + (xcd - r) * q) + off; }
        const int nig = WGM * nN, gid = wgid / nig, fm = gid * WGM, gsz = (nM - fm) < WGM ? (nM - fm) : WGM;
        u.pm = fm + ((wgid % nig) % gsz); u.pn = (wgid % nig) / gsz; return true;
    }
};
template <int NT> struct MoeOrder {
    int bt[9]; int cnt[8]; int G, c;
    __device__ __forceinline__ bool next(int i, Unit& u) const {
        int q, tn;
        if ((G & 7) == 0) { const int x = c & 7, Ll = i * (G >> 3) + (c >> 3); q = (Ll / NT) * 8 + x; tn = Ll % NT; if (q >= bt[8]) return false; }
        else { const int L = i * G + c; if (L >= bt[8] * NT) return false; q = L / NT; tn = L % NT; }
        int e = 0;
#pragma unroll
        for (int k = 1; k < 8; ++k) e += (q >= bt[k]) ? 1 : 0;
        u.pm = q; u.pn = e * NT + tn; return true;
    }
};
__device__ __forceinline__ unsigned cvt_pk_bf16(float lo, float hi) { unsigned r; asm volatile("v_cvt_pk_bf16_f32 %0, %1, %2" : "=v"(r) : "v"(lo), "v"(hi)); return r; }
__device__ __forceinline__ float fast_silu(float x) { return x * __builtin_amdgcn_rcpf(1.0f + __builtin_amdgcn_exp2f(x * -1.4426950408889634f)); }

struct EpiBf16 {
    static constexpr bool PERM = true, WIDE = false;
    bf16_t* O; int ldc; int nmod;
    __device__ __forceinline__ void operator()(const f32x4 (&acc)[2][2][4][2], const Unit& u, int wr, int wc, int fr, int fq) const {
        const int row0 = u.pm * BM + wr * 64 + fr, col0 = (u.pn % nmod) * BM + wc * 32 + 8 * fq;
#pragma unroll
        for (int ai = 0; ai < 2; ++ai)
#pragma unroll
            for (int m = 0; m < 4; ++m) { bf16_t* rowp = O + (size_t)(row0 + ai * HALF + m * 16) * ldc + col0;
#pragma unroll
                for (int bj = 0; bj < 2; ++bj) { const f32x4 v0 = acc[ai][bj][m][0], v1 = acc[ai][bj][m][1];
                    u32x4 w; w.x = cvt_pk_bf16(v0[0], v0[1]); w.y = cvt_pk_bf16(v0[2], v0[3]); w.z = cvt_pk_bf16(v1[0], v1[1]); w.w = cvt_pk_bf16(v1[2], v1[3]);
                    *(u32x4*)(rowp + bj * HALF) = w; } }
    }
};
struct EpiSwiGLU {
    static constexpr bool PERM = true, WIDE = false;
    bf16_t* O; int ldc; int nmod;
    __device__ __forceinline__ void operator()(const f32x4 (&acc)[2][2][4][2], const Unit& u, int wr, int wc, int fr, int fq) const {
        const int row0 = u.pm * BM + wr * 64 + fr, col0 = (u.pn % nmod) * HALF + wc * 32 + 8 * fq;
#pragma unroll
        for (int ai = 0; ai < 2; ++ai)
#pragma unroll
            for (int m = 0; m < 4; ++m) {
                const f32x4 g0 = acc[ai][0][m][0], g1 = acc[ai][0][m][1], u0 = acc[ai][1][m][0], u1 = acc[ai][1][m][1];
                u32x4 w;
                w.x = cvt_pk_bf16(fast_silu(g0[0]) * u0[0], fast_silu(g0[1]) * u0[1]); w.y = cvt_pk_bf16(fast_silu(g0[2]) * u0[2], fast_silu(g0[3]) * u0[3]);
                w.z = cvt_pk_bf16(fast_silu(g1[0]) * u1[0], fast_silu(g1[1]) * u1[1]); w.w = cvt_pk_bf16(fast_silu(g1[2]) * u1[2], fast_silu(g1[3]) * u1[3]);
                *(u32x4*)(O + (size_t)(row0 + ai * HALF + m * 16) * ldc + col0) = w; }
    }
};
struct EpiResidF32 {
    static constexpr bool PERM = false, WIDE = false;
    const float* xin; float* xout; const float* gate;
    __device__ __forceinline__ void operator()(const f32x4 (&acc)[2][2][4][2], const Unit& u, int wr, int wc, int fr, int fq) const {
        const int row0 = u.pm * BM + wr * 64 + fr, col0 = u.pn * BM + wc * 32 + 4 * fq;
        const float* gp = gate + (size_t)((u.pm * BM) / SEQ) * 3072 + col0;
#pragma unroll
        for (int bj = 0; bj < 2; ++bj)
#pragma unroll
            for (int n = 0; n < 2; ++n) { const f32x4 g4 = *(const f32x4*)(gp + bj * HALF + n * 16);
#pragma unroll
                for (int ai = 0; ai < 2; ++ai)
#pragma unroll
                    for (int m = 0; m < 4; ++m) { const size_t off = (size_t)(row0 + ai * HALF + m * 16) * D + col0 + bj * HALF + n * 16;
                        const f32x4 x4 = *(const f32x4*)(xin + off); *(f32x4*)(xout + off) = x4 + g4 * acc[ai][bj][m][n]; } }
    }
};


__device__ __forceinline__ u32x4 xchg8(u32x4 v) { u32x4 r;
    r.x = (unsigned)__builtin_amdgcn_update_dpp(0, (int)v.x, 0x128, 0xf, 0xf, false); r.y = (unsigned)__builtin_amdgcn_update_dpp(0, (int)v.y, 0x128, 0xf, 0xf, false);
    r.z = (unsigned)__builtin_amdgcn_update_dpp(0, (int)v.z, 0x128, 0xf, 0xf, false); r.w = (unsigned)__builtin_amdgcn_update_dpp(0, (int)v.w, 0x128, 0xf, 0xf, false); return r; }
__device__ __forceinline__ u32x4 pack8(f32x4 v0, f32x4 v1) { u32x4 w; w.x = cvt_pk_bf16(v0[0], v0[1]); w.y = cvt_pk_bf16(v0[2], v0[3]); w.z = cvt_pk_bf16(v1[0], v1[1]); w.w = cvt_pk_bf16(v1[2], v1[3]); return w; }
template <bool NT = true> __device__ __forceinline__ void store_wide(bf16_t* p, int ld, int fr, int fq, u32x4 pk0, u32x4 pk1) {
    const bool lo = fr < 8; const u32x4 rcv = xchg8(lo ? pk1 : pk0);
    bf16_t* q = p + (size_t)(fr & 7) * ld + 8 * fq + (lo ? 0 : 32);
    if constexpr (NT) { __builtin_nontemporal_store(lo ? pk0 : rcv, (u32x4*)q); __builtin_nontemporal_store(lo ? rcv : pk1, (u32x4*)(q + (size_t)8 * ld)); }
    else { *(u32x4*)q = lo ? pk0 : rcv; *(u32x4*)(q + (size_t)8 * ld) = lo ? rcv : pk1; }
}
struct EpiBf16W {
    static constexpr bool PERM = true, WIDE = true;
    bf16_t* O; int ldc; int nmod;
    __device__ __forceinline__ void operator()(const f32x4 (&acc)[2][2][4][2], const Unit& u, int wr, int wc, int fr, int fq) const {
        bf16_t* base = O + (size_t)(u.pm * BM + wr * 64) * ldc + (u.pn % nmod) * BM + wc * 64;
#pragma unroll
        for (int ai = 0; ai < 2; ++ai)
#pragma unroll
            for (int m = 0; m < 4; ++m) store_wide(base + (size_t)(ai * HALF + m * 16) * ldc, ldc, fr, fq, pack8(acc[ai][0][m][0], acc[ai][0][m][1]), pack8(acc[ai][1][m][0], acc[ai][1][m][1]));
    }
};
struct EpiResidNorm {
    static constexpr bool PERM = true, WIDE = true;
    const bf16_t* xin; bf16_t* x16; const float* gate; const float* av; bf16_t* xa; float* ssqp;
    __device__ __forceinline__ void operator()(const f32x4 (&acc)[2][2][4][2], const Unit& u, int wr, int wc, int fr, int fq) const {
        const int rowb = u.pm * BM + wr * 64, colw = u.pn * BM + wc * 64, b = (u.pm * BM) / SEQ;
        const bool lo = fr < 8;
        const size_t lane_off = (size_t)(fr & 7) * D + colw + 8 * fq + (lo ? 0 : 32);
        f32x4 gv[2][2], avv[2][2];
#pragma unroll
        for (int bj = 0; bj < 2; ++bj)
#pragma unroll
            for (int n = 0; n < 2; ++n) { gv[bj][n] = *(const f32x4*)(gate + (size_t)b * 3072 + colw + 32 * bj + 8 * fq + 4 * n); avv[bj][n] = *(const f32x4*)(av + (size_t)b * 1024 + colw + 32 * bj + 8 * fq + 4 * n); }
        u32x4 la[4][2], lb[4][2];
#define ERN_LOAD(k_) { _Pragma("unroll") for (int mm = 0; mm < 2; ++mm) { const bf16_t* q = xin + (size_t)(rowb + ((k_) >> 1) * HALF + (2 * ((k_) & 1) + mm) * 16) * D + lane_off; la[k_][mm] = __builtin_nontemporal_load((const u32x4*)q); lb[k_][mm] = __builtin_nontemporal_load((const u32x4*)(q + (size_t)8 * D)); } }
        ERN_LOAD(0)
#pragma unroll
        for (int k = 0; k < 4; ++k) {
            const int ai = k >> 1;
            if (k == 0) ERN_LOAD(1) else if (k == 1) ERN_LOAD(2) else if (k == 2) ERN_LOAD(3)
            asm volatile("" ::: "memory");
#pragma unroll
            for (int mm = 0; mm < 2; ++mm) {
                const int m = 2 * (k & 1) + mm;
                const u32x4 rcv = xchg8(lo ? lb[k][mm] : la[k][mm]);
                const u32x4 xb0 = lo ? la[k][mm] : rcv, xb1 = lo ? rcv : lb[k][mm];
                f32x4 x00, x01, x10, x11;
                x00.x = __uint_as_float(xb0.x << 16); x00.y = __uint_as_float(xb0.x & 0xffff0000u); x00.z = __uint_as_float(xb0.y << 16); x00.w = __uint_as_float(xb0.y & 0xffff0000u);
                x01.x = __uint_as_float(xb0.z << 16); x01.y = __uint_as_float(xb0.z & 0xffff0000u); x01.z = __uint_as_float(xb0.w << 16); x01.w = __uint_as_float(xb0.w & 0xffff0000u);
                x10.x = __uint_as_float(xb1.x << 16); x10.y = __uint_as_float(xb1.x & 0xffff0000u); x10.z = __uint_as_float(xb1.y << 16); x10.w = __uint_as_float(xb1.y & 0xffff0000u);
                x11.x = __uint_as_float(xb1.z << 16); x11.y = __uint_as_float(xb1.z & 0xffff0000u); x11.z = __uint_as_float(xb1.w << 16); x11.w = __uint_as_float(xb1.w & 0xffff0000u);
                const f32x4 n00 = x00 + gv[0][0] * acc[ai][0][m][0], n01 = x01 + gv[0][1] * acc[ai][0][m][1], n10 = x10 + gv[1][0] * acc[ai][1][m][0], n11 = x11 + gv[1][1] * acc[ai][1][m][1];
                float sv = (((n00.x * n00.x + n00.y * n00.y) + (n00.z * n00.z + n00.w * n00.w)) + ((n01.x * n01.x + n01.y * n01.y) + (n01.z * n01.z + n01.w * n01.w)))
                         + (((n10.x * n10.x + n10.y * n10.y) + (n10.z * n10.z + n10.w * n10.w)) + ((n11.x * n11.x + n11.y * n11.y) + (n11.z * n11.z + n11.w * n11.w)));
                const size_t ro = (size_t)(rowb + ai * HALF + m * 16) * D + colw;
                store_wide<false>(x16 + ro, D, fr, fq, pack8(n00, n01), pack8(n10, n11));
                store_wide<false>(xa + ro, D, fr, fq, pack8(n00 * avv[0][0], n01 * avv[0][1]), pack8(n10 * avv[1][0], n11 * avv[1][1]));
                sv = xor32_sum(xor16_sum(sv));
                if (fq == 0) ssqp[(size_t)(rowb + ai * HALF + m * 16 + fr) * 16 + u.pn * 4 + wc] = sv;
            }
        }
#undef ERN_LOAD
    }
};
struct EpiProjNorm {
    static constexpr bool PERM = true, WIDE = true;
    bf16_t* O; const LAS float* RS; const float* cv; float* BG; const float* a_log; const float* dt_bias;
    __device__ __forceinline__ void operator()(const f32x4 (&acc)[2][2][4][2], const Unit& u, int wr, int wc, int fr, int fq) const {
        const int rl0 = wr * 64 + fr, colw = u.pn * BM + wc * 64, b = (u.pm * BM) / SEQ;
        const float* cp = cv + (size_t)b * NPW + colw + 8 * fq;
        if (u.pn < NP / BM) {
            f32x4 c4[2][2];
#pragma unroll
            for (int bj = 0; bj < 2; ++bj)
#pragma unroll
                for (int n = 0; n < 2; ++n) c4[bj][n] = *(const f32x4*)(cp + 32 * bj + 4 * n);
            bf16_t* base = O + (size_t)(u.pm * BM + wr * 64) * NP + colw;
#pragma unroll
            for (int ai = 0; ai < 2; ++ai)
#pragma unroll
                for (int m = 0; m < 4; ++m) { const float rs = fabsf(RS[u.ord * 256 + rl0 + ai * HALF + m * 16]);
                    store_wide(base + (size_t)(ai * HALF + m * 16) * NP, NP, fr, fq, pack8(acc[ai][0][m][0] * rs + c4[0][0], acc[ai][0][m][1] * rs + c4[0][1]), pack8(acc[ai][1][m][0] * rs + c4[1][0], acc[ai][1][m][1] * rs + c4[1][1])); }
        } else if (wc == 0 && fq == 0) {
            const f32x4 c0 = *(const f32x4*)(cp), c1 = *(const f32x4*)(cp + 4);
            const f32x4 al = *(const f32x4*)a_log, db = *(const f32x4*)dt_bias;
#pragma unroll
            for (int ai = 0; ai < 2; ++ai)
#pragma unroll
                for (int m = 0; m < 4; ++m) { const int rl = rl0 + ai * HALF + m * 16; const float rs = fabsf(RS[u.ord * 256 + rl]);
                    const f32x4 vb = acc[ai][0][m][0] * rs + c0, va = acc[ai][0][m][1] * rs + c1;
                    f32x4 be, gg;
#pragma unroll
                    for (int hh = 0; hh < 4; ++hh) { be[hh] = sigmoidf_(vb[hh]); gg[hh] = -__expf(al[hh]) * softplusf_(va[hh] + db[hh]); }
                    float* bg = BG + (size_t)(u.pm * BM + rl) * 8; *(f32x4*)bg = be; *(f32x4*)(bg + 4) = gg; }
        }
    }
};
struct EpiNull {
    static constexpr bool PERM = true, WIDE = false;
    __device__ __forceinline__ void operator()(const f32x4 (&acc)[2][2][4][2], const Unit& u, int wr, int wc, int fr, int fq) const {
#pragma unroll
        for (int ai = 0; ai < 2; ++ai)
#pragma unroll
            for (int bj = 0; bj < 2; ++bj)
#pragma unroll
                for (int m = 0; m < 4; ++m)
#pragma unroll
                    for (int n = 0; n < 2; ++n) asm volatile("" :: "v"(acc[ai][bj][m][n]));
    }
};
struct EpiSwiGLUNorm {
    static constexpr bool PERM = true, WIDE = false;
    bf16_t* O; int ldc; int nmod; const LAS float* RS; const float* cv; int ncv;
    __device__ __forceinline__ void operator()(const f32x4 (&acc)[2][2][4][2], const Unit& u, int wr, int wc, int fr, int fq) const {
        const int rl0 = wr * 64 + fr, col0 = (u.pn % nmod) * HALF + wc * 32 + 8 * fq;
        const float* cp = cv + (size_t)u.pn * BM + wc * 32 + 8 * fq;
        f32x4 cg[2][2], cu[2][2];
#pragma unroll
        for (int bb = 0; bb < 2; ++bb)
#pragma unroll
            for (int n = 0; n < 2; ++n) { cg[bb][n] = *(const f32x4*)(cp + (size_t)bb * ncv + 4 * n); cu[bb][n] = *(const f32x4*)(cp + (size_t)bb * ncv + HALF + 4 * n); }
#pragma unroll
        for (int ai = 0; ai < 2; ++ai)
#pragma unroll
            for (int m = 0; m < 4; ++m) { const int rl = rl0 + ai * HALF + m * 16; const float rsv = RS[u.ord * 256 + rl], rs = fabsf(rsv); const bool b1 = rsv < 0.f;
                const f32x4 g0 = acc[ai][0][m][0] * rs + (b1 ? cg[1][0] : cg[0][0]), g1 = acc[ai][0][m][1] * rs + (b1 ? cg[1][1] : cg[0][1]);
                const f32x4 u0 = acc[ai][1][m][0] * rs + (b1 ? cu[1][0] : cu[0][0]), u1 = acc[ai][1][m][1] * rs + (b1 ? cu[1][1] : cu[0][1]);
                u32x4 w;
                w.x = cvt_pk_bf16(fast_silu(g0[0]) * u0[0], fast_silu(g0[1]) * u0[1]); w.y = cvt_pk_bf16(fast_silu(g0[2]) * u0[2], fast_silu(g0[3]) * u0[3]);
                w.z = cvt_pk_bf16(fast_silu(g1[0]) * u1[0], fast_silu(g1[1]) * u1[1]); w.w = cvt_pk_bf16(fast_silu(g1[2]) * u1[2], fast_silu(g1[3]) * u1[3]);
                __builtin_nontemporal_store(w, (u32x4*)(O + (size_t)(u.pm * BM + rl) * ldc + col0)); }
    }
};

template <class Epi, class Sched, bool GATHER, bool ALIGN_EPI, bool SP2>
__device__ __forceinline__ void gemm_phase(LAS unsigned char* lds, const LAS int* RI, const Gemm g, const Sched& S, const Epi& E) {
    const int tid = threadIdx.x, wid = __builtin_amdgcn_readfirstlane(tid >> 6), lane = tid & 63, wr = wid >> 2, wc = wid & 3, fr = lane & 15, fq = lane >> 4;
    const int K = g.K, nt = K / BK;
    unsigned voffB[2]; int Ra[2]; unsigned Ca2[2];
#pragma unroll
    for (int i = 0; i < 2; ++i) { int R, C; stage_rc(tid * 16 + i * 8192, R, C); const int Rb = Epi::WIDE ? ((R >> 5) * 64 + perm32(R & 31)) : (Epi::PERM ? ((R & ~31) + perm32(R & 31)) : R);
        Ra[i] = R; Ca2[i] = (unsigned)C * 2u; voffB[i] = (unsigned)(Rb * K + C) * 2u; }
    const size_t kstep = (size_t)(BK * 2);
    const size_t hstep = (size_t)HALF * K * 2;
    const size_t tstep = 2 * hstep;
    const size_t hstepB = Epi::WIDE ? (size_t)32 * K * 2 : hstep;
    const unsigned rowb = (unsigned)K * 2u;
    const unsigned ldsw = (unsigned)wid * 1024u;
    const int aoff = lds_byte(wr * 64 + fr, fq * 8), boff = lds_byte(wc * 32 + fr, fq * 8);
#define PG8_SA(b, h) (((b) * 2 + (h)) * HTB)
#define PG8_SB(b, h) ((4 + (b) * 2 + (h)) * HTB)
#define PG8_STAGE_B(bufoff, gbase) do { _Pragma("unroll") for (int _i = 0; _i < 2; ++_i) \
        __builtin_amdgcn_global_load_lds((const unsigned*)((const char*)(gbase) + voffB[_i]), (LAS unsigned*)(lds + (bufoff) + ldsw + _i * 8192), 16, 0, 0); } while (0)
#define PG8_STAGE_A(bufoff, kb, off) do { _Pragma("unroll") for (int _i = 0; _i < 2; ++_i) \
        __builtin_amdgcn_global_load_lds((const unsigned*)((const char*)g.A + (size_t)(kb) + (off)[_i]), (LAS unsigned*)(lds + (bufoff) + ldsw + _i * 8192), 16, 0, 0); } while (0)
#define PG8_LDA(dst, b, h) do { _Pragma("unroll") for (int m = 0; m < 4; ++m) _Pragma("unroll") for (int k = 0; k < 2; ++k) dst[m][k] = *(const LAS bf16x8*)(lds + PG8_SA(b, h) + aoff + m * 2048 + k * 1024); } while (0)
#define PG8_LDB(dst, b, h) do { _Pragma("unroll") for (int n = 0; n < 2; ++n) _Pragma("unroll") for (int k = 0; k < 2; ++k) dst[n][k] = *(const LAS bf16x8*)(lds + PG8_SB(b, h) + boff + n * 2048 + k * 1024); } while (0)
#define PG8_MMA(ai, bj, At, Bt) do { __builtin_amdgcn_s_setprio(1); _Pragma("unroll") for (int m = 0; m < 4; ++m) _Pragma("unroll") for (int n = 0; n < 2; ++n) _Pragma("unroll") for (int k = 0; k < 2; ++k) \
        acc[ai][bj][m][n] = __builtin_amdgcn_mfma_f32_16x16x32_bf16(Bt[n][k], At[m][k], acc[ai][bj][m][n], 0, 0, 0); __builtin_amdgcn_s_setprio(0); } while (0)
#define PG8_WAIT_V(n) asm volatile("s_waitcnt vmcnt(" #n ")" ::: "memory")
#define PG8_WAIT_L(n) asm volatile("s_waitcnt lgkmcnt(" #n ")" ::: "memory")
#define PG8_BAR __builtin_amdgcn_s_barrier()
#define PG8_SCHED __builtin_amdgcn_sched_barrier(0)
#define PG8_AOFFS(dst, ui_, un_) do { _Pragma("unroll") for (int _h = 0; _h < 2; ++_h) _Pragma("unroll") for (int _i = 0; _i < 2; ++_i) { \
        const unsigned _row = GATHER ? (unsigned)RI[(ui_) * 256 + _h * HALF + Ra[_i]] : (unsigned)((un_).pm * BM + _h * HALF + Ra[_i]); dst[_h][_i] = _row * rowb + Ca2[_i]; } } while (0)
    Unit cur, nxt; int ui = 0;
    if (!S.next(0, cur)) return;
    cur.ord = 0;
    f32x4 acc[2][2][4][2];
#pragma unroll
    for (int a = 0; a < 2; ++a)
#pragma unroll
        for (int b = 0; b < 2; ++b)
#pragma unroll
            for (int m = 0; m < 4; ++m)
#pragma unroll
                for (int n = 0; n < 2; ++n) acc[a][b][m][n] = (f32x4){0.f, 0.f, 0.f, 0.f};
    bf16x8 At[4][2], B0[2][2], B1[2][2];
    unsigned cv[2][2], nv[2][2];
    PG8_AOFFS(cv, 0, cur);
    const char* cB = (const char*)g.Bt + (size_t)cur.pn * tstep;
    if constexpr (SP2) {
        PG8_STAGE_B(PG8_SB(0, 0), cB); PG8_STAGE_B(PG8_SB(0, 1), cB + hstepB); PG8_STAGE_A(PG8_SA(0, 0), 0, cv[0]); PG8_STAGE_A(PG8_SA(0, 1), 0, cv[1]);
        if (wr == 1) PG8_BAR;
        PG8_WAIT_V(2); PG8_BAR;
        PG8_STAGE_B(PG8_SB(1, 0), cB + kstep); PG8_STAGE_A(PG8_SA(1, 0), kstep, cv[0]); PG8_STAGE_B(PG8_SB(1, 1), cB + hstepB + kstep);
        PG8_WAIT_V(6); PG8_BAR;
    } else {
        PG8_STAGE_B(PG8_SB(0, 0), cB); PG8_STAGE_A(PG8_SA(0, 0), 0, cv[0]); PG8_STAGE_B(PG8_SB(0, 1), cB + hstepB); PG8_STAGE_A(PG8_SA(0, 1), 0, cv[1]);
        if (wr == 1) PG8_BAR;
        PG8_WAIT_V(4); PG8_BAR;
        PG8_STAGE_B(PG8_SB(1, 0), cB + kstep); PG8_STAGE_A(PG8_SA(1, 0), kstep, cv[0]); PG8_STAGE_B(PG8_SB(1, 1), cB + hstepB + kstep);
        PG8_WAIT_V(6); PG8_BAR;
    }
    for (;;) {
        const bool has_next = S.next(ui + 1, nxt); nxt.ord = ui + 1;
        const char* nB = has_next ? (const char*)g.Bt + (size_t)nxt.pn * tstep : cB;
        if (has_next) { PG8_AOFFS(nv, ui + 1, nxt); }
        else {
#pragma unroll
            for (int h = 0; h < 2; ++h)
#pragma unroll
                for (int i = 0; i < 2; ++i) nv[h][i] = cv[h][i]; }
        for (int t = 0; t < nt; t += 2) {
            const bool last = (t == nt - 2);
            const size_t kb1 = (size_t)(t + 1) * kstep, kb2 = last ? (size_t)0 : (size_t)(t + 2) * kstep, kb3 = kb2 + kstep;
            const char* b2 = last ? nB : cB + (size_t)(t + 2) * kstep; const char* b3 = b2 + kstep;
            unsigned o2[2][2];
#pragma unroll
            for (int h = 0; h < 2; ++h)
#pragma unroll
                for (int i = 0; i < 2; ++i) o2[h][i] = last ? nv[h][i] : cv[h][i];
            if constexpr (SP2) {
            PG8_LDB(B0, 0, 0); PG8_LDB(B1, 0, 1); PG8_SCHED; PG8_LDA(At, 0, 0); PG8_STAGE_A(PG8_SA(1, 1), kb1, cv[1]);
            PG8_WAIT_V(8); PG8_WAIT_L(0); PG8_BAR; PG8_MMA(0, 0, At, B0); PG8_MMA(0, 1, At, B1); PG8_BAR; PG8_SCHED;
            PG8_LDA(At, 0, 1); PG8_STAGE_B(PG8_SB(0, 0), b2); PG8_STAGE_B(PG8_SB(0, 1), b2 + hstepB); PG8_STAGE_A(PG8_SA(0, 0), kb2, o2[0]);
            PG8_WAIT_V(8); PG8_WAIT_L(0); PG8_BAR; PG8_MMA(1, 0, At, B0); PG8_MMA(1, 1, At, B1); PG8_BAR; PG8_SCHED;
            PG8_LDB(B0, 1, 0); PG8_LDB(B1, 1, 1); PG8_SCHED; PG8_LDA(At, 1, 0); PG8_STAGE_A(PG8_SA(0, 1), kb2, o2[1]);
            PG8_WAIT_V(8); PG8_WAIT_L(0); PG8_BAR; PG8_MMA(0, 0, At, B0); PG8_MMA(0, 1, At, B1); PG8_BAR; PG8_SCHED;
            PG8_LDA(At, 1, 1); PG8_STAGE_B(PG8_SB(1, 0), b3); PG8_STAGE_B(PG8_SB(1, 1), b3 + hstepB); PG8_STAGE_A(PG8_SA(1, 0), kb3, o2[0]);
            PG8_WAIT_V(8); PG8_WAIT_L(0); PG8_BAR; PG8_MMA(1, 0, At, B0); PG8_MMA(1, 1, At, B1); PG8_BAR; PG8_SCHED;
            } else {
            PG8_LDB(B0, 0, 0); PG8_SCHED; PG8_LDA(At, 0, 0); PG8_STAGE_A(PG8_SA(1, 1), kb1, cv[1]);
            PG8_WAIT_L(8); PG8_BAR; PG8_WAIT_L(0); PG8_MMA(0, 0, At, B0); PG8_BAR; PG8_SCHED;
            PG8_LDB(B1, 0, 1); PG8_STAGE_B(PG8_SB(0, 0), b2);
            PG8_BAR; PG8_WAIT_L(0); PG8_MMA(0, 1, At, B1); PG8_BAR;
            PG8_LDA(At, 0, 1); PG8_STAGE_A(PG8_SA(0, 0), kb2, o2[0]);
            PG8_BAR; PG8_WAIT_L(0); PG8_MMA(1, 0, At, B0); PG8_BAR; PG8_SCHED;
            PG8_STAGE_B(PG8_SB(0, 1), b2 + hstepB);
            PG8_WAIT_V(6); PG8_BAR; PG8_MMA(1, 1, At, B1); PG8_BAR;
            PG8_LDB(B0, 1, 0); PG8_SCHED; PG8_LDA(At, 1, 0); PG8_STAGE_A(PG8_SA(0, 1), kb2, o2[1]);
            PG8_WAIT_L(8); PG8_BAR; PG8_WAIT_L(0); PG8_MMA(0, 0, At, B0); PG8_BAR; PG8_SCHED;
            PG8_LDB(B1, 1, 1); PG8_STAGE_B(PG8_SB(1, 0), b3);
            PG8_BAR; PG8_WAIT_L(0); PG8_MMA(0, 1, At, B1); PG8_BAR;
            PG8_LDA(At, 1, 1); PG8_STAGE_A(PG8_SA(1, 0), kb3, o2[0]);
            PG8_BAR; PG8_WAIT_L(0); PG8_MMA(1, 0, At, B0); PG8_BAR; PG8_SCHED;
            PG8_STAGE_B(PG8_SB(1, 1), b3 + hstepB);
            PG8_WAIT_V(6); PG8_BAR; PG8_MMA(1, 1, At, B1); PG8_BAR;
            }
        }
        if constexpr (ALIGN_EPI) { if (wr == 0) PG8_BAR; }
        E(acc, cur, wr, wc, fr, fq);
        if (!has_next) break;
#pragma unroll
        for (int a = 0; a < 2; ++a)
#pragma unroll
            for (int b = 0; b < 2; ++b)
#pragma unroll
                for (int m = 0; m < 4; ++m)
#pragma unroll
                    for (int n = 0; n < 2; ++n) acc[a][b][m][n] = (f32x4){0.f, 0.f, 0.f, 0.f};
        cur = nxt; cB = nB; ++ui;
#pragma unroll
        for (int h = 0; h < 2; ++h)
#pragma unroll
            for (int i = 0; i < 2; ++i) cv[h][i] = nv[h][i];
        if constexpr (ALIGN_EPI) { if (wr == 1) PG8_BAR; }
    }
    PG8_WAIT_V(0);
    if constexpr (!ALIGN_EPI) { if (wr == 0) PG8_BAR; }
    PG8_BAR;
#undef PG8_SA
#undef PG8_SB
#undef PG8_STAGE_A
#undef PG8_STAGE_B
#undef PG8_LDA
#undef PG8_LDB
#undef PG8_MMA
#undef PG8_WAIT_V
#undef PG8_WAIT_L
#undef PG8_BAR
#undef PG8_SCHED
#undef PG8_AOFFS
}
}

__device__ __forceinline__ void transpose_item(const float* W, int pitch, int k0, int n0, bf16_t* WT, int Kd, int drow0, LAS float* scr, int lane) {
#pragma unroll 8
    for (int i = 0; i < 32; ++i) { const int kk = 2 * i + (lane >> 5); scr[kk * 33 + (lane & 31)] = __builtin_nontemporal_load(W + (size_t)(k0 + kk) * pitch + n0 + (lane & 31)); }
    asm volatile("s_waitcnt lgkmcnt(0)" ::: "memory");
    const int c = lane & 7;
#pragma unroll
    for (int j = 0; j < 4; ++j) { const int n = (lane >> 3) + 8 * j; const LAS float* s = scr + (8 * c) * 33 + n;
        u32x4 o; o.x = pk2(s[0 * 33], s[1 * 33]); o.y = pk2(s[2 * 33], s[3 * 33]); o.z = pk2(s[4 * 33], s[5 * 33]); o.w = pk2(s[6 * 33], s[7 * 33]);
        *(u32x4*)(WT + (size_t)(drow0 + n) * Kd + k0 + 8 * c) = o; }
    asm volatile("s_waitcnt lgkmcnt(0)" ::: "memory");
}
constexpr size_t WT_WIN = 0, WT_WOUT = WT_WIN + (size_t)2 * NPW * D, WT_FGU = WT_WOUT + (size_t)2 * D * D, WT_FD = WT_FGU + (size_t)2 * D_FF * D,
                 WT_MGU = WT_FD + (size_t)D * D_FF, WT_MD = WT_MGU + (size_t)NE * 2 * D_FFE * D, WT_END = WT_MD + (size_t)NE * D * D_FFE;
static_assert(WT_END * 2 <= 80 * MiB, "weight copies fit");
__device__ __forceinline__ void ph_pro_weights(const Args& a, Frame& F) {
    LAS float* scr = (LAS float*)(F.lds + F.wave * 16384);
    bf16_t* WT = (bf16_t*)(F.ws + WS_WT);
    constexpr int I_IN0 = 16 * 48, I_IN1 = 16 * 24, I_OUT = 16 * 32, I_FG = 16 * 88, I_FD = 44 * 32, I_M = 16 * 32;
    constexpr int NITEMS = 2 * (I_IN0 + I_IN1 + I_OUT) + 2 * I_FG + I_FD + 24 * I_M;
    for (int it = F.gw; it < NITEMS; it += F.ngw) {
        int r = it; const float* src; int pitch, k0, n0, Kd, drow0; bf16_t* dst;
        if (r < 2 * I_IN0) { const int l = r / I_IN0; r %= I_IN0; src = a.w_in + (size_t)l * D * N_IN; pitch = N_IN; k0 = (r / 48) * 64; n0 = (r % 48) * 32; dst = WT + WT_WIN + (size_t)l * NPW * D; Kd = D; drow0 = n0; }
        else if ((r -= 2 * I_IN0) < 2 * I_IN1) { const int l = r / I_IN1; r %= I_IN1; src = a.w_in + (size_t)l * D * N_IN + 1544; pitch = N_IN; k0 = (r / 24) * 64; n0 = (r % 24) * 32; dst = WT + WT_WIN + (size_t)l * NPW * D; Kd = D; drow0 = 1536 + n0; }
        else if ((r -= 2 * I_IN1) < 2 * I_OUT) { const int l = r / I_OUT; r %= I_OUT; src = a.w_out + (size_t)l * D * D; pitch = D; k0 = (r / 32) * 64; n0 = (r % 32) * 32; dst = WT + WT_WOUT + (size_t)l * D * D; Kd = D; drow0 = n0; }
        else if ((r -= 2 * I_OUT) < 2 * I_FG) { const int up = r / I_FG; r %= I_FG; src = up ? a.ffn_wu : a.ffn_wg; pitch = D_FF; k0 = (r / 88) * 64; n0 = (r % 88) * 32; dst = WT + WT_FGU; Kd = D; drow0 = (n0 / 128) * 256 + up * 128 + (n0 % 128); }
        else if ((r -= 2 * I_FG) < I_FD) { src = a.ffn_wd; pitch = D; k0 = (r / 32) * 64; n0 = (r % 32) * 32; dst = WT + WT_FD; Kd = D_FF; drow0 = n0; }
        else if ((r -= I_FD) < 16 * I_M) { const int e = r / (2 * I_M); r %= 2 * I_M; const int up = r / I_M; r %= I_M; src = (up ? a.moe_wu : a.moe_wg) + (size_t)e * D * D_FFE; pitch = D_FFE; k0 = (r / 32) * 64; n0 = (r % 32) * 32;
            dst = WT + WT_MGU + (size_t)e * 2 * D_FFE * D; Kd = D; drow0 = (n0 / 128) * 256 + up * 128 + (n0 % 128); }
        else { r -= 16 * I_M; const int e = r / I_M; r %= I_M; src = a.moe_wd + (size_t)e * D_FFE * D; pitch = D; k0 = (r / 32) * 64; n0 = (r % 32) * 32; dst = WT + WT_MD + (size_t)e * D * D_FFE; Kd = D_FFE; drow0 = n0; }
        transpose_item(src, pitch, k0, n0, dst, Kd, drow0, scr, F.lane);
    }
    for (int idx = F.bid * NTHREADS + F.tid; idx < 2 * 256 * D; idx += F.nb * NTHREADS) {
        const int l = idx / (256 * D), r = (idx / D) % 256, k = idx % D;
        WT[WT_WIN + (size_t)l * NPW * D + (size_t)(2304 + r) * D + k] = (r < 8) ? (bf16_t)f2bf(a.w_in[(size_t)l * D * N_IN + (size_t)k * N_IN + W_DB + r]) : (bf16_t)0;
    }
}

template <int NT> __device__ __forceinline__ void moe_order_init(Frame& F, pg8::MoeOrder<NT>& S) {
    const unsigned* c = (const unsigned*)(F.ws + WS_CTL) + CW_MOECNT;
    int acc = 0;
#pragma unroll
    for (int e = 0; e < 8; ++e) { S.cnt[e] = (int)__hip_atomic_load(c + 64 * e, __ATOMIC_RELAXED, __HIP_MEMORY_SCOPE_AGENT); S.bt[e] = acc; acc += (S.cnt[e] + 255) >> 8; }
    S.bt[8] = acc; S.G = F.nb; S.c = F.bid;
}
template <int NT> __device__ __forceinline__ int moe_ri_one(Frame& F, const pg8::MoeOrder<NT>& S, const int* RM, int o, int t) {
    pg8::Unit u; if (!S.next(o, u)) return -1;
    const int e = u.pn / NT; int bte = 0, cne = 0;
#pragma unroll
    for (int kk = 0; kk < 8; ++kk) { if (kk == e) { bte = S.bt[kk]; cne = S.cnt[kk]; } }
    const int sl = (u.pm - bte) * 256 + t; return (sl < cne) ? RM[(size_t)e * T + sl] : 0;
}
template <int NT> __device__ __forceinline__ void moe_ri_preload(Frame& F, const pg8::MoeOrder<NT>& S) {
    LAS int* RI = (LAS int*)(F.lds + RI_OFF); const int* RM = (const int*)(F.ws + WS_RMAP);
    const int t = F.tid & 255, par = F.tid >> 8;
    const int v0 = moe_ri_one<NT>(F, S, RM, par, t), v1 = moe_ri_one<NT>(F, S, RM, par + 2, t), v2 = moe_ri_one<NT>(F, S, RM, par + 4, t), v3 = moe_ri_one<NT>(F, S, RM, par + 6, t);
    const int v4 = moe_ri_one<NT>(F, S, RM, par + 8, t), v5 = moe_ri_one<NT>(F, S, RM, par + 10, t), v6 = moe_ri_one<NT>(F, S, RM, par + 12, t), v7 = moe_ri_one<NT>(F, S, RM, par + 14, t);
    if (v0 >= 0) RI[(par) * 256 + t] = v0; if (v1 >= 0) RI[(par + 2) * 256 + t] = v1; if (v2 >= 0) RI[(par + 4) * 256 + t] = v2; if (v3 >= 0) RI[(par + 6) * 256 + t] = v3;
    if (v4 >= 0) RI[(par + 8) * 256 + t] = v4; if (v5 >= 0) RI[(par + 10) * 256 + t] = v5; if (v6 >= 0) RI[(par + 12) * 256 + t] = v6;
    if (v7 >= 0 && par + 14 < 15) RI[(par + 14) * 256 + t] = v7;
    __syncthreads();
}

__device__ __forceinline__ void ph_norm0(const Args& a, Frame& F) {
    const float* MOD = (const float*)(F.ws + WS_MOD);
    bf16_t* XA = (bf16_t*)(F.ws + WS_H); bf16_t* X16 = (bf16_t*)(F.ws + WS_X16); float* SSQ = (float*)(F.ws + WS_SSQ) + (size_t)3 * T * 16;
    f32x4 vn[4], A4[4]; int cur_b = -1;
#define N0_LOAD(row_) { const f32x4* p_ = (const f32x4*)(a.x + (size_t)(row_) * D) + 2 * F.lane; vn[0] = __builtin_nontemporal_load(p_); vn[1] = __builtin_nontemporal_load(p_ + 1); vn[2] = __builtin_nontemporal_load(p_ + 128); vn[3] = __builtin_nontemporal_load(p_ + 129); }
    if (F.gw < T) N0_LOAD(F.gw)
    for (int row = F.gw; row < T; row += F.ngw) {
        const int b = row / SEQ;
        f32x4 v[4]; float ss = 0.f;
#pragma unroll
        for (int j = 0; j < 4; ++j) { v[j] = vn[j]; ss += (v[j].x * v[j].x + v[j].y * v[j].y) + (v[j].z * v[j].z + v[j].w * v[j].w); }
        if (row + F.ngw < T) N0_LOAD(row + F.ngw)
        if (b != cur_b) { cur_b = b;
#pragma unroll
            for (int j = 0; j < 4; ++j) { const int d = 512 * (j >> 1) + 8 * F.lane + 4 * (j & 1); A4[j] = *(const f32x4*)(a.nmg + d) * (*(const f32x4*)(MOD + (size_t)b * 3072 + 1024 + d) + 1.0f); } }
#pragma unroll
        for (int jj = 0; jj < 2; ++jj) {
            const int d = 512 * jj + 8 * F.lane; const f32x4 v0 = v[2 * jj], v1 = v[2 * jj + 1], s0 = v0 * A4[2 * jj], s1 = v1 * A4[2 * jj + 1];
            u32x4 o; o.x = pk2(v0.x, v0.y); o.y = pk2(v0.z, v0.w); o.z = pk2(v1.x, v1.y); o.w = pk2(v1.z, v1.w); *(u32x4*)(X16 + (size_t)row * D + d) = o;
            u32x4 p; p.x = pk2(s0.x, s0.y); p.y = pk2(s0.z, s0.w); p.z = pk2(s1.x, s1.y); p.w = pk2(s1.z, s1.w); *(u32x4*)(XA + (size_t)row * D + d) = p;
        }
        ss = wave_sum(ss);
        if (F.lane < 16) SSQ[(size_t)row * 16 + F.lane] = (F.lane == 0) ? ss : 0.f;
    }
#undef N0_LOAD
}
__device__ __forceinline__ void ph_prep_vectors(const Args& a, Frame& F) {
    const float* MOD = (const float*)(F.ws + WS_MOD); float* AV = (float*)(F.ws + WS_AV);
    for (int idx = F.bid * NTHREADS + F.tid; idx < 3 * BATCH * D; idx += F.nb * NTHREADS) {
        const int inst = idx / (BATCH * D), b = (idx / D) % BATCH, d = idx % D;
        const int lk = (inst == 0) ? 1 : (inst == 1 ? 2 : 3);
        const float gn = (inst == 0) ? a.nfg[d] : (inst == 1 ? a.nmg[D + d] : a.nfg[D + d]);
        AV[idx] = gn * (1.0f + MOD[((size_t)lk * 2 + b) * 3072 + 1024 + d]);
    }
    const bf16_t* WT = (const bf16_t*)(F.ws + WS_WT);
    constexpr int NR = 5632 + NPW + 16384 + NPW;
    LAS float* SH = (LAS float*)F.lds;
    for (int i = F.tid; i < 4 * BATCH * D; i += NTHREADS) { const int which = i / (BATCH * D), b = (i / D) % BATCH, d = i % D; SH[i] = MOD[((size_t)((which + 1) & 3) * 2 + b) * 3072 + d]; }
    __syncthreads();
    for (int g8 = F.gw; g8 < NR / 8; g8 += F.ngw) {
        const int row = g8 * 8 + (F.lane >> 3), part = F.lane & 7;
        int which, r; const bf16_t* wrow; float* out; int ncv;
        if (row < 5632) { which = 0; r = row; wrow = WT + WT_FGU + (size_t)r * D; out = (float*)(F.ws + WS_CVF); ncv = 5632; }
        else if (row < 5632 + NPW) { which = 1; r = row - 5632; wrow = WT + WT_WIN + (size_t)NPW * D + (size_t)r * D; out = (float*)(F.ws + WS_CVI); ncv = NPW; }
        else if (row < 5632 + NPW + 16384) { which = 2; r = row - 5632 - NPW; wrow = WT + WT_MGU + (size_t)r * D; out = (float*)(F.ws + WS_CVM); ncv = 16384; }
        else { which = 3; r = row - 5632 - NPW - 16384; wrow = WT + WT_WIN + (size_t)r * D; out = (float*)(F.ws + WS_CVI0); ncv = NPW; }
        u32x4 wv[16];
#pragma unroll
        for (int j = 0; j < 16; ++j) wv[j] = *(const u32x4*)(wrow + 128 * part + 8 * j);
        const LAS float* s0p = SH + (which * 2 + 0) * 1024 + 128 * part; const LAS float* s1p = s0p + 1024;
        float s0 = 0.f, s1 = 0.f;
#pragma unroll
        for (int j = 0; j < 16; ++j) {
            const f32x4 a0 = *(const LAS f32x4*)(s0p + 8 * j), a1 = *(const LAS f32x4*)(s0p + 8 * j + 4), b0 = *(const LAS f32x4*)(s1p + 8 * j), b1 = *(const LAS f32x4*)(s1p + 8 * j + 4);
            const float x0 = bf2f(wv[j].x & 0xffffu), x1 = bf2f(wv[j].x >> 16), x2 = bf2f(wv[j].y & 0xffffu), x3 = bf2f(wv[j].y >> 16), x4 = bf2f(wv[j].z & 0xffffu), x5 = bf2f(wv[j].z >> 16), x6 = bf2f(wv[j].w & 0xffffu), x7 = bf2f(wv[j].w >> 16);
            s0 += ((x0 * a0.x + x1 * a0.y) + (x2 * a0.z + x3 * a0.w)) + ((x4 * a1.x + x5 * a1.y) + (x6 * a1.z + x7 * a1.w));
            s1 += ((x0 * b0.x + x1 * b0.y) + (x2 * b0.z + x3 * b0.w)) + ((x4 * b1.x + x5 * b1.y) + (x6 * b1.z + x7 * b1.w));
        }
        s0 += __shfl_xor(s0, 1); s0 += __shfl_xor(s0, 2); s0 += __shfl_xor(s0, 4);
        s1 += __shfl_xor(s1, 1); s1 += __shfl_xor(s1, 2); s1 += __shfl_xor(s1, 4);
        if (part == 0) { out[r] = s0; out[ncv + r] = s1; }
    }
    __syncthreads();
    if (F.gw < BATCH * 8) {
        const int b = F.gw >> 3, e = F.gw & 7; float sacc = 0.f;
        for (int d = F.lane; d < D; d += 64) sacc += MOD[((size_t)3 * 2 + b) * 3072 + d] * a.router_w[(size_t)d * NE + e];
        sacc = wave_sum(sacc);
        if (F.lane == 0) ((float*)(F.ws + WS_CR))[b * 8 + e] = sacc;
    }
}
template <class Sched> __device__ __forceinline__ int count_units(const Sched& S) { int n = 0; pg8::Unit u; while (n < 16 && S.next(n, u)) ++n; return n; }
template <class Sched> __device__ __forceinline__ void rstd_preload(Frame& F, const Sched& S, const float* ssqp, const LAS int* RI) {
    LAS float* RS = (LAS float*)(F.lds + RS_OFF);
    const int t = F.tid & 255, par = F.tid >> 8, nu = count_units(S);
#pragma unroll
    for (int k0 = 0; k0 < 8; k0 += 4) {
        f32x4 p0[4], p1[4], p2[4], p3[4]; int r0, r1, r2, r3;
#define RSP_LOAD(k, pk, rk) { const int o = par + 2 * (k0 + k); pg8::Unit u; u.pm = 0; rk = 0; if (o < nu) { S.next(o, u); rk = RI ? RI[o * 256 + t] : u.pm * 256 + t; } \
            const f32x4* q = (const f32x4*)(ssqp + (size_t)rk * 16); pk[0] = q[0]; pk[1] = q[1]; pk[2] = q[2]; pk[3] = q[3]; }
        RSP_LOAD(0, p0, r0) RSP_LOAD(1, p1, r1) RSP_LOAD(2, p2, r2) RSP_LOAD(3, p3, r3)
#undef RSP_LOAD
#define RSP_STORE(k, pk, rk) { const int o = par + 2 * (k0 + k); if (o < nu) { const f32x4 s4 = (pk[0] + pk[1]) + (pk[2] + pk[3]); \
            const float rs = rsqrtf(((s4.x + s4.y) + (s4.z + s4.w)) * (1.0f / D) + EPS); RS[o * 256 + t] = (rk >= SEQ) ? -rs : rs; } }
        RSP_STORE(0, p0, r0) RSP_STORE(1, p1, r1) RSP_STORE(2, p2, r2) RSP_STORE(3, p3, r3)
#undef RSP_STORE
    }
    __syncthreads();
}
__device__ __forceinline__ void ph_router(const Args& a, Frame& F) {
    const bf16_t* XA = (const bf16_t*)(F.ws + WS_H); const float* SSQ = (const float*)(F.ws + WS_SSQ) + (size_t)2 * T * 16; const float* CR = (const float*)(F.ws + WS_CR);
    constexpr int RW = 1032;
    LAS bf16_t* WH = (LAS bf16_t*)F.lds; LAS bf16_t* WL = WH + 16 * RW; LAS float* LG = (LAS float*)(F.lds + 2 * 16 * RW * 2) + F.wave * 256;
    for (int i = F.tid; i < 16 * 1024; i += NTHREADS) { const int e = i >> 10, d = i & 1023;
        const float w = (e < 8) ? a.router_w[(size_t)d * NE + e] : 0.f; const unsigned hi = f2bf(w); const float lo = w - bf2f(hi);
        WH[e * RW + d] = (bf16_t)hi; WL[e * RW + d] = (bf16_t)f2bf(lo); }
    __syncthreads();
    const int l15 = F.lane & 15, q4 = F.lane >> 4;
    for (int r0 = F.gw * 16; r0 < T; r0 += F.ngw * 16) {
        const bf16_t* xrow = XA + (size_t)(r0 + l15) * D + 8 * q4;
        f32x4 acc = (f32x4){0.f, 0.f, 0.f, 0.f};
#pragma unroll
        for (int kb = 0; kb < 32; kb += 8) {
            bf16x8_t av[8];
#pragma unroll
            for (int k = 0; k < 8; ++k) av[k] = *(const bf16x8_t*)(xrow + 32 * (kb + k));
#pragma unroll
            for (int k = 0; k < 8; ++k) {
                const bf16x8_t bh = *(const LAS bf16x8_t*)(WH + l15 * RW + 32 * (kb + k) + 8 * q4), bl = *(const LAS bf16x8_t*)(WL + l15 * RW + 32 * (kb + k) + 8 * q4);
                acc = __builtin_amdgcn_mfma_f32_16x16x32_bf16(av[k], bh, acc, 0, 0, 0);
                acc = __builtin_amdgcn_mfma_f32_16x16x32_bf16(av[k], bl, acc, 0, 0, 0);
            }
        }
#pragma unroll
        for (int r = 0; r < 4; ++r) LG[(4 * q4 + r) * 16 + l15] = acc[r];
        if (F.lane < 16) {
            const int row = r0 + F.lane, b = row / SEQ;
            const f32x4* sp = (const f32x4*)(SSQ + (size_t)row * 16); const f32x4 s4 = (sp[0] + sp[1]) + (sp[2] + sp[3]);
            const float rstd = rsqrtf(((s4.x + s4.y) + (s4.z + s4.w)) * (1.0f / D) + EPS);
            const f32x4 l0 = *(const LAS f32x4*)(LG + F.lane * 16), l1 = *(const LAS f32x4*)(LG + F.lane * 16 + 4);
            const float dots[8] = {l0.x, l0.y, l0.z, l0.w, l1.x, l1.y, l1.z, l1.w};
            float v0 = -INFINITY, v1 = -INFINITY; int e0 = 0, e1 = 0;
#pragma unroll
            for (int e = 0; e < 8; ++e) { const float lg = rstd * dots[e] + CR[b * 8 + e] + a.router_b[e]; if (lg > v0) { v1 = v0; e1 = e0; v0 = lg; e0 = e; } else if (lg > v1) { v1 = lg; e1 = e; } }
            const float ex = __expf(v1 - v0), p0 = 1.0f / (1.0f + ex), p1 = ex / (1.0f + ex);
            unsigned* cnt = (unsigned*)(F.ws + WS_CTL) + CW_MOECNT;
            const int q0 = (int)atomicAdd(cnt + 64 * e0, 1u), q1 = (int)atomicAdd(cnt + 64 * e1, 1u);
            int* R = (int*)(F.ws + WS_ROUTE) + (size_t)row * 4; R[0] = e0; R[1] = e1; ((float*)R)[2] = p0; ((float*)R)[3] = p1;
            int* Pq = (int*)(F.ws + WS_POS) + (size_t)row * 2; Pq[0] = q0; Pq[1] = q1;
            int* RM = (int*)(F.ws + WS_RMAP); RM[(size_t)e0 * T + q0] = row; RM[(size_t)e1 * T + q1] = row;
        }
    }
    __syncthreads();
}

__global__ void __launch_bounds__(NTHREADS, 2) fwd(Args a) {
    extern __shared__ __attribute__((aligned(16))) unsigned char lds_raw[];
    Frame F;
    F.lds = (LAS unsigned char*)lds_raw;
    F.tid = threadIdx.x; F.lane = F.tid & 63; F.wave = __builtin_amdgcn_readfirstlane(F.tid >> 6);
    F.bid = blockIdx.x; F.nb = gridDim.x; F.gw = F.bid * NWAVES + F.wave; F.ngw = F.nb * NWAVES; F.ws = (GAS unsigned char*)a.ws;
    volatile LAS unsigned* MISC = (volatile LAS unsigned*)(F.lds + MISC_OFF);
    for (int u = F.tid; u < 32; u += NTHREADS) MISC[u] = 0u;
    __syncthreads();
    unsigned* ctl = (unsigned*)(a.ws + WS_CTL);
    const int lo = a.ph_lo, hi = a.ph_hi;
    const bool multi = (hi - lo) > 1;
    XcdBarrier bar; bar.bar = ctl + CW_BAR; bar.x = 0; bar.st = MISC + 8;
    if (multi) bar = xcd_barrier_post(ctl + CW_BAR, MISC + 8);
#define IN(k) (lo <= (k) && (k) < hi && (frame_refresh(F, a, (LAS unsigned char*)lds_raw), true))
#define SEAM(k) do { if (hi > (k) + 1 && lo <= (k)) { xcd_barrier(bar); if constexpr ((PROBE_MASK & 4194304) != 0) xcd_barrier(bar); } } while (0)
    float* MOD = (float*)(a.ws + WS_MOD);
    bf16_t* H = (bf16_t*)(a.ws + WS_H); bf16_t* PROJ = (bf16_t*)(a.ws + WS_PROJ); bf16_t* YMIX = (bf16_t*)(a.ws + WS_YMIX);
    bf16_t* WT = (bf16_t*)(a.ws + WS_WT);
    bf16_t* ACT = (bf16_t*)(a.ws + WS_ACT); bf16_t* ACTM = (bf16_t*)(a.ws + WS_ACTM); bf16_t* YMOE = (bf16_t*)(a.ws + WS_YMOE);

    if (IN(PH_PRO)) { REP(1) { ph_pro_vectors(a, F); ph_pro_weights(a, F); } SEAM(PH_PRO); }

#define TWICE(bit, stmt) do { stmt; if constexpr ((PROBE_MASK & (bit)) != 0) { stmt; } } while (0)
    float* AV = (float*)(a.ws + WS_AV); float* SSQ = (float*)(a.ws + WS_SSQ); bf16_t* X16 = (bf16_t*)(a.ws + WS_X16);
    const LAS float* RSL = (const LAS float*)(F.lds + RS_OFF);
#define LAYER_BODY(l) {\
        const int pb = PH_LAYER0 + PH_PER_LAYER * l; \
        const float* xin = (l == 0) ? a.x : a.out; \
        const float* mod0 = MOD + (size_t)(l * 2 + 0) * 2 * 3072; const float* mod1 = MOD + (size_t)(l * 2 + 1) * 2 * 3072; \
        if (l == 0) { if (IN(pb + K_NORM1)) { REP(2) ph_norm0(a, F); ph_prep_vectors(a, F); SEAM(pb + K_NORM1); } } \
        if (IN(pb + K_GEMM_IN)) { \
            TWICE(4, ({ pg8::Gemm g{H, WT + WT_WIN + (size_t)l * NPW * D, D}; pg8::StaticOrder S; S.init(T, NPW, F.nb, F.bid); rstd_preload(F, S, SSQ + (size_t)(l == 0 ? 3 : 1) * T * 16, nullptr); \
                pg8::EpiProjNorm E{PROJ, RSL, (const float*)(a.ws + (l == 0 ? WS_CVI0 : WS_CVI)), (float*)(a.ws + WS_BG), a.dn_a_log + 4 * l, a.dn_dt_bias + 4 * l}; \
                pg8::gemm_phase<pg8::EpiProjNorm, pg8::StaticOrder, false, true, true>(F.lds, nullptr, g, S, E); })); \
            SEAM(pb + K_GEMM_IN); \
        } \
        if (IN(pb + K_DN_PREP)) { REP(8) ph_dn_chunk(a, F, l); ph_rope(a, F); SEAM(pb + K_DN_PREP); } \
        if (IN(pb + K_MIX)) { ph_dn_scan(a, F, l); REP(512) ph_attn_mfma(a, F, l); REP(1024) ph_conv_fast(a, F, l); __syncthreads(); REP(32) ph_dn_out(a, F, l); SEAM(pb + K_MIX); } \
        if (IN(pb + K_GEMM_OUT)) { \
            TWICE(0, ({ pg8::Gemm g{YMIX, WT + WT_WOUT + (size_t)l * D * D, D}; pg8::StaticOrder S; S.init(T, D, F.nb, F.bid); \
                pg8::EpiResidNorm E{X16, X16, mod0 + 2048, AV + (size_t)(l == 0 ? 0 : 2) * BATCH * D, H, SSQ + (size_t)(l == 0 ? 0 : 2) * T * 16}; \
                pg8::gemm_phase<pg8::EpiResidNorm, pg8::StaticOrder, false, true, true>(F.lds, nullptr, g, S, E); })); \
            if constexpr ((PROBE_MASK & 8388608) != 0 && l == 0) { pg8::Gemm g{YMIX, WT + WT_WOUT + (size_t)l * D * D, D}; pg8::StaticOrder S; S.init(T, D, F.nb, F.bid); pg8::EpiBf16 E{(bf16_t*)(a.ws + WS_DN_MR), D, 1 << 20}; \
                pg8::gemm_phase<pg8::EpiBf16, pg8::StaticOrder, false, true, true>(F.lds, nullptr, g, S, E); } \
            if constexpr ((PROBE_MASK & 16777216) != 0 && l == 0) { pg8::Gemm g{YMIX, WT + WT_WOUT + (size_t)l * D * D, D}; pg8::StaticOrder S; S.init(T, D, F.nb, F.bid); \
                pg8::EpiResidNorm E{X16, (bf16_t*)(a.ws + WS_DN_MR), mod0 + 2048, AV, (bf16_t*)(a.ws + WS_DN_MR), (float*)(a.ws + WS_DN_ST)}; \
                pg8::gemm_phase<pg8::EpiResidNorm, pg8::StaticOrder, false, true, true>(F.lds, nullptr, g, S, E); } \
            if constexpr ((PROBE_MASK & 131072) != 0 && l == 0) { pg8::Gemm g{YMIX, WT + WT_WOUT + (size_t)l * D * D, D}; pg8::StaticOrder S; S.init(T, D, F.nb, F.bid); pg8::EpiNull E{}; \
                pg8::gemm_phase<pg8::EpiNull, pg8::StaticOrder, false, true, true>(F.lds, nullptr, g, S, E); } \
            SEAM(pb + K_GEMM_OUT); \
        } \
        if (l == 0) { \
            if (IN(pb + K_FFN1)) { \
                TWICE(256, ({ pg8::Gemm g{H, WT + WT_FGU, D}; pg8::StaticOrder S; S.init(T, 2 * D_FF, F.nb, F.bid); rstd_preload(F, S, SSQ, nullptr); \
                    pg8::EpiSwiGLUNorm E{ACT, D_FF, 1 << 20, RSL, (const float*)(a.ws + WS_CVF), 5632}; \
                    pg8::gemm_phase<pg8::EpiSwiGLUNorm, pg8::StaticOrder, false, true, true>(F.lds, nullptr, g, S, E); })); \
                SEAM(pb + K_FFN1); \
            } \
            if (IN(pb + K_FFN2)) { \
                { pg8::Gemm g{ACT, WT + WT_FD, D_FF}; pg8::StaticOrder S; S.init(T, D, F.nb, F.bid); \
                    pg8::EpiResidNorm E{X16, X16, mod1 + 2048, AV + (size_t)1 * BATCH * D, H, SSQ + (size_t)1 * T * 16}; \
                    pg8::gemm_phase<pg8::EpiResidNorm, pg8::StaticOrder, false, true, true>(F.lds, nullptr, g, S, E); } \
                SEAM(pb + K_FFN2); \
            } \
        } else { \
            if (IN(pb + K_NORM2)) { ph_router(a, F); SEAM(pb + K_NORM2); } \
            if (IN(pb + K_FFN1)) { \
                TWICE(2048, ({ pg8::MoeOrder<8> S; moe_order_init<8>(F, S); moe_ri_preload<8>(F, S); rstd_preload(F, S, SSQ + (size_t)2 * T * 16, (const LAS int*)(F.lds + RI_OFF)); \
                    pg8::Gemm g{H, WT + WT_MGU, D}; pg8::EpiSwiGLUNorm E{ACTM, D_FFE, 8, RSL, (const float*)(a.ws + WS_CVM), 16384}; \
                    pg8::gemm_phase<pg8::EpiSwiGLUNorm, pg8::MoeOrder<8>, true, true, true>(F.lds, (const LAS int*)(F.lds + RI_OFF), g, S, E); })); \
                SEAM(pb + K_FFN1); \
            } \
            if (IN(pb + K_FFN2)) { \
                TWICE(4096, ({ pg8::MoeOrder<4> S; moe_order_init<4>(F, S); \
                    pg8::Gemm g{ACTM, WT + WT_MD, D_FFE}; pg8::EpiBf16W E{YMOE, D, 4}; \
                    pg8::gemm_phase<pg8::EpiBf16W, pg8::MoeOrder<4>, false, true, true>(F.lds, nullptr, g, S, E); })); \
                SEAM(pb + K_FFN2); \
            } \
        } \
    }
    LAYER_BODY(0)
    LAYER_BODY(1)
#undef LAYER_BODY
    if (IN(PH_FINAL)) { ph_final(a, F); }
#undef IN
#undef SEAM
}

extern "C" void kernel_launch(void* const* d_in, const int* in_sizes, int n_in, void* d_out, int out_size, void* d_ws, size_t ws_size, hipStream_t stream) {
    static int grid = 0;
    if (grid == 0) {
        if (n_in != 27 || out_size != T * D || ws_size < WS_END) { fprintf(stderr, "kernel_launch: unexpected shapes n_in %d out %d ws %zu\n", n_in, out_size, ws_size); grid = -1; return; }
        int dev = 0, cus = 0, per_cu = 0;
        if (hipGetDevice(&dev) != hipSuccess || hipDeviceGetAttribute(&cus, hipDeviceAttributeMultiprocessorCount, dev) != hipSuccess) { grid = -1; return; }
        if (hipFuncSetAttribute((const void*)fwd, hipFuncAttributeMaxDynamicSharedMemorySize, LDS_BYTES) != hipSuccess) { fprintf(stderr, "kernel_launch: hipFuncSetAttribute failed\n"); grid = -1; return; }
        if (hipOccupancyMaxActiveBlocksPerMultiprocessor(&per_cu, (const void*)fwd, NTHREADS, LDS_BYTES) != hipSuccess || per_cu < 1) fprintf(stderr, "kernel_launch: occupancy query says %d\n", per_cu);
        (void)hipGetLastError();
        grid = cus;
    }
    if (grid < 0) return;
    (void)hipMemsetAsync((char*)d_ws + WS_CTL, 0, CTL_ZERO_BYTES, stream);
    Args a{};
    const void** pp = (const void**)&a;
    for (int i = 0; i < 27; ++i) pp[i] = d_in[i];
    a.out = (float*)d_out; a.ws = (unsigned char*)d_ws;
#if MK_ONE_LAUNCH
    a.ph_lo = 0; a.ph_hi = NPH;
    hipLaunchKernelGGL(fwd, dim3(grid), dim3(NTHREADS), LDS_BYTES, stream, a);
#else
    static const int phases[] = {0, 1, 2, 3, 4, 5, 6, 7, 9, 10, 11, 12, 13, 14, 15, 16, 17, 18, 19, 20, 21};
    for (int p : phases) { a.ph_lo = p; a.ph_hi = p + 1; hipLaunchKernelGGL(fwd, dim3(grid), dim3(NTHREADS), LDS_BYTES, stream, a); }
#endif
}
```

```cpp
#include <hip/hip_runtime.h>
#include <cstdio>
#include <cstdint>

#define LAS __attribute__((address_space(3)))
#define GAS __attribute__((address_space(1)))
typedef unsigned short bf16_t;
typedef float f32x4 __attribute__((ext_vector_type(4)));
typedef float f32x2 __attribute__((ext_vector_type(2)));
typedef unsigned u32x2 __attribute__((ext_vector_type(2)));
typedef unsigned u32x4 __attribute__((ext_vector_type(4)));

#ifndef GEMM_MASK
#define GEMM_MASK 63
#endif
#ifndef ATTN_MFMA
#define ATTN_MFMA 1
#endif
#ifndef DN_CHUNKED
#define DN_CHUNKED 1
#endif
#ifndef CONV_FAST
#define CONV_FAST 1
#endif
#ifndef PROBE_MASK
#define PROBE_MASK 0
#endif
#define REP(bit) for (int rep_ = 0; rep_ < ((PROBE_MASK & (bit)) ? 2 : 1); ++rep_)
#ifndef MK_ONE_LAUNCH
#define MK_ONE_LAUNCH 1
#endif

constexpr int BATCH = 2, SEQ = 16384, T = BATCH * SEQ, D = 1024, DEPTH = 2;
constexpr int NPW = 2560;
constexpr int N_IN = 2312, NP = 2304;
constexpr int C_AQ = 0, C_AK = 512, C_AV = 640, C_DQ = 768, C_DK = 1024, C_DV = 1280, C_DZ = 1536, C_CA = 1792, C_CB = 2048;
constexpr int W_DB = 1536;
constexpr int D_FF = 2816, NE = 8, D_FFE = 1024;
constexpr int WINDOW = 128, CV_K = 31, CV_C = 256, DN_CONV = 4;
constexpr float EPS = 1e-6f;
constexpr int NSCAN = BATCH * 4 * 4;
constexpr int MOE_CAP = 67584;

constexpr size_t MiB = 1u << 20;
constexpr size_t WS_CTL = 0, CTL_ZERO_BYTES = 1 * MiB;
constexpr size_t WS_MOD = 1 * MiB;
constexpr size_t WS_CS = 2 * MiB;
constexpr size_t WS_BG = 4 * MiB;
constexpr size_t WS_ROUTE = 5 * MiB;
constexpr size_t WS_POS = 6 * MiB;
constexpr size_t WS_RMAP = 7 * MiB;
constexpr size_t WS_WT = 8 * MiB;
constexpr size_t WS_H = 88 * MiB;
constexpr size_t WS_PROJ = 152 * MiB;
constexpr size_t WS_YMIX = 296 * MiB;
constexpr size_t WS_DNQKV = 360 * MiB;
constexpr size_t WS_ODN = 456 * MiB;
constexpr size_t WS_ACT = 152 * MiB;
constexpr size_t WS_ACTM = 152 * MiB;
constexpr size_t WS_YMOE = 284 * MiB;
constexpr size_t WS_X16 = 440 * MiB;
constexpr size_t WS_SSQ = 504 * MiB;
constexpr size_t WS_AV = WS_MOD + 128 * 1024;
constexpr size_t WS_CVF = WS_MOD + 256 * 1024;
constexpr size_t WS_CVI = WS_CVF + 2 * 5632 * 4;
constexpr size_t WS_CVM = WS_CVI + 2 * 2560 * 4;
constexpr size_t WS_CR = WS_CVM + 2 * 16384 * 4;
constexpr size_t WS_CVI0 = WS_CR + 64;
static_assert(WS_CVI0 + 2 * 2560 * 4 <= WS_CS, "vector area");
constexpr size_t WS_END = 512 * MiB;
constexpr int CW_BAR = 4096;
constexpr int CW_MOECNT = 16384;
constexpr int CW_SCANP = 20480;

constexpr int NWAVES = 8, NTHREADS = 512;
constexpr int LDS_BYTES = 163840;
constexpr int MISC_OFF = 131072 + 320;
constexpr int RI_OFF = 132096;
constexpr int RS_OFF = 147456;

constexpr int PH_PRO = 0, PH_LAYER0 = 1, PH_PER_LAYER = 10, PH_FINAL = 21, NPH = 22;
enum { K_NORM1 = 0, K_GEMM_IN, K_DN_PREP, K_MIX, K_DN_OUT, K_GEMM_OUT, K_NORM2, K_MOE_LIST, K_FFN1, K_FFN2 };

struct Args {
    const float* x; const float* c; const int* pos; const float* ada_w; const float* ada_b; const float* nmg; const float* nfg;
    const float* w_in; const float* sinks; const float* dn_conv_w; const float* dn_a_log; const float* dn_dt_bias; const float* dn_norm_g;
    const float* cv_dw_w; const float* cv_dw_b; const float* cv_ln_g; const float* cv_ln_b; const float* w_out;
    const float* ffn_wg; const float* ffn_wu; const float* ffn_wd; const float* router_w; const float* router_b;
    const float* moe_wg; const float* moe_wu; const float* moe_wd; const float* final_g;
    float* out; unsigned char* ws; int ph_lo, ph_hi;
};

__device__ __forceinline__ float bf2f(unsigned u) { return __uint_as_float(u << 16); }
__device__ __forceinline__ unsigned f2bf(float f) { unsigned u = __float_as_uint(f); return (u + 0x7fffu + ((u >> 16) & 1u)) >> 16; }
__device__ __forceinline__ unsigned pk2(float lo, float hi) { return f2bf(lo) | (f2bf(hi) << 16); }
#define DPP_MOV(v, ctrl) __int_as_float(__builtin_amdgcn_update_dpp(0, __float_as_int(v), (ctrl), 0xf, 0xf, false))
__device__ __forceinline__ float row16_sum(float v) { v += DPP_MOV(v, 0xB1); v += DPP_MOV(v, 0x4E); v += DPP_MOV(v, 0x141); v += DPP_MOV(v, 0x140); return v; }
__device__ __forceinline__ float wave_sum(float v) {
    v = row16_sum(v);
    const int vi = __float_as_int(v);
    return (__int_as_float(__builtin_amdgcn_readlane(vi, 0)) + __int_as_float(__builtin_amdgcn_readlane(vi, 16))) + (__int_as_float(__builtin_amdgcn_readlane(vi, 32)) + __int_as_float(__builtin_amdgcn_readlane(vi, 48)));
}
__device__ __forceinline__ float xor32_sum(float v) { const auto r = __builtin_amdgcn_permlane32_swap(__float_as_uint(v), __float_as_uint(v), false, false); return __uint_as_float(r[0]) + __uint_as_float(r[1]); }
__device__ __forceinline__ float xor32_max(float v) { const auto r = __builtin_amdgcn_permlane32_swap(__float_as_uint(v), __float_as_uint(v), false, false); return fmaxf(__uint_as_float(r[0]), __uint_as_float(r[1])); }
__device__ __forceinline__ float xor16_sum(float v) { const auto r = __builtin_amdgcn_permlane16_swap(__float_as_uint(v), __float_as_uint(v), false, false); return __uint_as_float(r[0]) + __uint_as_float(r[1]); }
__device__ __forceinline__ float group8_sum(float v) { v += DPP_MOV(v, 0xB1); v += DPP_MOV(v, 0x4E); v += DPP_MOV(v, 0x141); return v; }
__device__ __forceinline__ float wave_max(float v) {
#pragma unroll
    for (int o = 1; o < 64; o <<= 1) v = fmaxf(v, __shfl_xor(v, o));
    return v;
}
__device__ __forceinline__ float sigmoidf_(float x) { return __builtin_amdgcn_rcpf(1.0f + __builtin_amdgcn_exp2f(x * -1.4426950408889634f)); }
__device__ __forceinline__ float siluf_(float x) { return x * __builtin_amdgcn_rcpf(1.0f + __builtin_amdgcn_exp2f(x * -1.4426950408889634f)); }
__device__ __forceinline__ float softplusf_(float x) { return fmaxf(x, 0.f) + log1pf(__expf(-fabsf(x))); }

#define XB_TMO      128
#define XB_XCNT(j)  (256  + 64 * (j))
#define XB_XSUB(j)  (1280 + 64 * (j))
#define XB_XGEN(j)  (2304 + 64 * (j))
#define XB_TOP      3328
#define XB_TOPGEN   3392
#define XCD_BAR_WORDS 3456
#define XB_SPIN_CAP (1u << 18)

__device__ __forceinline__ unsigned xb_ld(unsigned* p)              { return __hip_atomic_load(p, __ATOMIC_RELAXED, __HIP_MEMORY_SCOPE_AGENT); }
__device__ __forceinline__ unsigned xb_add(unsigned* p, unsigned v) { return __hip_atomic_fetch_add(p, v, __ATOMIC_RELAXED, __HIP_MEMORY_SCOPE_AGENT); }
__device__ __forceinline__ unsigned xb_xcc_id() { return (unsigned)__builtin_amdgcn_s_getreg((3 << 11) | 20) & 0xFu; }
#define XB_SPIN(cond, bar) do { unsigned _sp = 0; while (cond) { __builtin_amdgcn_s_sleep(1); \
    if ((++_sp & 255u) == 0u) { if (xb_ld(&(bar)[XB_TMO])) break; if (_sp > XB_SPIN_CAP) { atomicAdd(&(bar)[XB_TMO], 1u); break; } } } } while (0)

struct XcdBarrier { unsigned* bar; unsigned x; volatile LAS unsigned* st; };

__device__ __forceinline__ XcdBarrier xcd_barrier_post(unsigned* bar, volatile LAS unsigned* st) {
    XcdBarrier b; b.bar = bar; b.x = xb_xcc_id(); b.st = st;
    if (threadIdx.x == 0) (void)xb_add(&bar[XB_XCNT(b.x)], 1u);
    return b;
}
__device__ __forceinline__ void xcd_barrier_complete(unsigned* bar, unsigned x, unsigned& nloc, unsigned& nx) {
    const unsigned G = gridDim.x * gridDim.y * gridDim.z;
    unsigned sum, cnt, mine, sp = 0u;
    for (;;) {
        sum = 0u; cnt = 0u; mine = 0u;
#pragma unroll
        for (unsigned j = 0; j < 16; ++j) { const unsigned c = xb_ld(&bar[XB_XCNT(j)]); sum += c; cnt += (c > 0u) ? 1u : 0u; mine = (j == x) ? c : mine; }
        if (sum == G) break;
        __builtin_amdgcn_s_sleep(1);
        if ((++sp & 255u) == 0u) { if (xb_ld(&bar[XB_TMO])) break; if (sp > XB_SPIN_CAP) { atomicAdd(&bar[XB_TMO], 1u); break; } }
    }
    nloc = mine > 0u ? mine : 1u; nx = cnt > 0u ? cnt : 1u;
}
__device__ __forceinline__ void xcd_barrier(const XcdBarrier& b) {
    asm volatile("s_waitcnt vmcnt(0)" ::: "memory");
    __syncthreads();
    if (threadIdx.x == 0) {
        unsigned* bar = b.bar;
        __builtin_amdgcn_s_waitcnt(0);
        unsigned nloc = b.st[0], nx = b.st[1];
        if (nloc == 0u) { xcd_barrier_complete(bar, b.x, nloc, nx); b.st[0] = nloc; b.st[1] = nx; }
        const unsigned old = xb_add(&bar[XB_XSUB(b.x)], 1u);
        const unsigned gen = old / nloc;
        if (old + 1u == (gen + 1u) * nloc) {
            __builtin_amdgcn_fence(__ATOMIC_RELEASE, "agent");
            asm volatile("s_waitcnt vmcnt(0)" ::: "memory");
            const unsigned og = xb_add(&bar[XB_TOP], 1u);
            const unsigned tg = og / nx;
            if (og + 1u == (tg + 1u) * nx) xb_add(&bar[XB_TOPGEN], 1u);
            else XB_SPIN(xb_ld(&bar[XB_TOPGEN]) == tg, bar);
            __builtin_amdgcn_fence(__ATOMIC_ACQUIRE, "agent");
            xb_add(&bar[XB_XGEN(b.x)], 1u);
            asm volatile("s_waitcnt vmcnt(0)" ::: "memory");
        } else {
            XB_SPIN(xb_ld(&bar[XB_XGEN(b.x)]) == gen, bar);
            __builtin_amdgcn_fence(__ATOMIC_ACQUIRE, "agent");
            asm volatile("s_waitcnt vmcnt(0)" ::: "memory");
        }
    }
    __syncthreads();
}

struct Frame {
    LAS unsigned char* lds;
    int tid, lane, wave, gw, ngw, bid, nb;
    GAS unsigned char* ws;
};

__device__ __forceinline__ void frame_refresh(Frame& F, const Args& a, LAS unsigned char* lds) {
    int tid = threadIdx.x; asm volatile("" : "+v"(tid));
    int bid = blockIdx.x; asm volatile("" : "+s"(bid));
    unsigned char* ws = a.ws; asm volatile("" : "+s"(ws));
    F.lds = lds; F.tid = tid; F.lane = tid & 63; F.wave = __builtin_amdgcn_readfirstlane(tid >> 6);
    F.bid = bid; F.nb = gridDim.x; F.gw = F.bid * NWAVES + F.wave; F.ngw = F.nb * NWAVES; F.ws = (GAS unsigned char*)ws;
}
__device__ __forceinline__ void ph_pro_vectors(const Args& a, Frame& F) {
    float* MOD = (float*)(F.ws + WS_MOD);
    LAS float* red = (LAS float*)F.lds;
    for (int it = F.bid; it < 4 * 48; it += F.nb) {
        const int lk = it / 48, cg = it % 48, e = cg * 64 + F.lane;
        const float* W = a.ada_w + (size_t)lk * D * 3072 + e;
        float a0 = 0.f, a1 = 0.f;
        const int d0 = F.wave * 128;
#pragma unroll 8
        for (int d = d0; d < d0 + 128; ++d) {
            const float w = __builtin_nontemporal_load(W + (size_t)d * 3072);
            a0 += siluf_(a.c[d]) * w; a1 += siluf_(a.c[D + d]) * w;
        }
        red[(F.wave * 2 + 0) * 64 + F.lane] = a0; red[(F.wave * 2 + 1) * 64 + F.lane] = a1;
        __syncthreads();
        if (F.wave < 2) {
            float s = 0.f;
            for (int w = 0; w < 8; ++w) s += red[(w * 2 + F.wave) * 64 + F.lane];
            MOD[((size_t)lk * 2 + F.wave) * 3072 + e] = s + a.ada_b[lk * 3072 + e];
        }
        __syncthreads();
    }
    float* CS = (float*)(F.ws + WS_CS);
    for (int idx = F.bid * NTHREADS + F.tid; idx < T * 8; idx += F.nb * NTHREADS) {
        const int t = idx >> 3, i = idx & 7;
        const float inv = powf(500000.0f, -(float)(2 * i) / 16.0f);
        const float ang = (float)a.pos[t] * inv;
        CS[t * 16 + i] = cosf(ang); CS[t * 16 + 8 + i] = sinf(ang);
    }
}

template <int MODE>
__device__ __forceinline__ void ph_norm(const Args& a, Frame& F, int l, const float* xin, const float* gain, const float* modk  ,
                                        const float* W8, int pitch) {
    bf16_t* H = (bf16_t*)(F.ws + WS_H);
    LAS float* W8T = (LAS float*)F.lds;
    if (MODE != 0) {
        for (int i = F.tid; i < 8192; i += NTHREADS) { const int d = i >> 3, j = i & 7; W8T[j * 1024 + d] = W8[(size_t)d * pitch + j]; }
        __syncthreads();
    }
    f32x4 vn[4], A4[4], B4[4]; int cur_b = -1;
    if (F.gw < T) {
#pragma unroll
        for (int j = 0; j < 4; ++j) vn[j] = ((const f32x4*)(xin + (size_t)F.gw * D) + F.lane)[64 * j];
    }
    for (int row = F.gw; row < T; row += F.ngw) {
        const int b = row / SEQ;
        f32x4 v[4]; float ss = 0.f;
#pragma unroll
        for (int j = 0; j < 4; ++j) { v[j] = vn[j]; ss += (v[j].x * v[j].x + v[j].y * v[j].y) + (v[j].z * v[j].z + v[j].w * v[j].w); }
        if (row + F.ngw < T) {
#pragma unroll
            for (int j = 0; j < 4; ++j) vn[j] = ((const f32x4*)(xin + (size_t)(row + F.ngw) * D) + F.lane)[64 * j];
        }
        if (b != cur_b) {
            cur_b = b; const float* sh = modk + (size_t)b * 3072; const float* sc = sh + 1024;
#pragma unroll
            for (int j = 0; j < 4; ++j) { const int d = 256 * j + 4 * F.lane; A4[j] = *(const f32x4*)(gain + d) * (*(const f32x4*)(sc + d) + 1.0f); B4[j] = *(const f32x4*)(sh + d); }
        }
        const float rstd = rsqrtf(wave_sum(ss) * (1.0f / D) + EPS);
        float acc[8];
#pragma unroll
        for (int e = 0; e < 8; ++e) acc[e] = 0.f;
#pragma unroll
        for (int j = 0; j < 4; ++j) {
            const int d = 256 * j + 4 * F.lane;
            const f32x4 hv = (v[j] * rstd) * A4[j] + B4[j];
            u32x2 o; o.x = pk2(hv.x, hv.y); o.y = pk2(hv.z, hv.w);
            *(u32x2*)(H + (size_t)row * D + d) = o;
            if (MODE == 1) { u32x2 xo; xo.x = pk2(v[j].x, v[j].y); xo.y = pk2(v[j].z, v[j].w); *(u32x2*)((bf16_t*)(F.ws + WS_X16) + (size_t)row * D + d) = xo; }
            if (MODE != 0) {
#pragma unroll
                for (int e = 0; e < 8; ++e) { const f32x4 w4 = *(const LAS f32x4*)(W8T + e * 1024 + d); acc[e] += (hv.x * w4.x + hv.y * w4.y) + (hv.z * w4.z + hv.w * w4.w); }
            }
        }
        if (MODE != 0) {
#pragma unroll
            for (int e = 0; e < 8; ++e) acc[e] = wave_sum(acc[e]);
        }
        if (MODE == 1 && F.lane == 0) {
            float* BG = (float*)(F.ws + WS_BG) + (size_t)row * 8;
#pragma unroll
            for (int h = 0; h < 4; ++h) {
                BG[h] = sigmoidf_(acc[h]);
                BG[4 + h] = -__expf(a.dn_a_log[l * 4 + h]) * softplusf_(acc[4 + h] + a.dn_dt_bias[l * 4 + h]);
            }
        }
        if (MODE == 2 && F.lane == 0) {
            float v0 = -INFINITY, v1 = -INFINITY; int e0 = 0, e1 = 0;
#pragma unroll
            for (int e = 0; e < 8; ++e) { const float lg = acc[e] + a.router_b[e]; if (lg > v0) { v1 = v0; e1 = e0; v0 = lg; e0 = e; } else if (lg > v1) { v1 = lg; e1 = e; } }
            const float ex = __expf(v1 - v0), p0 = 1.0f / (1.0f + ex), p1 = ex / (1.0f + ex);
            unsigned* cnt = (unsigned*)(F.ws + WS_CTL) + CW_MOECNT;
            const int q0 = (int)atomicAdd(cnt + 64 * e0, 1u), q1 = (int)atomicAdd(cnt + 64 * e1, 1u);
            int* R = (int*)(F.ws + WS_ROUTE) + (size_t)row * 4; R[0] = e0; R[1] = e1; ((float*)R)[2] = p0; ((float*)R)[3] = p1;
            int* P = (int*)(F.ws + WS_POS) + (size_t)row * 2; P[0] = q0; P[1] = q1;
        }
    }
    if (MODE != 0) __syncthreads();
}

typedef float f32x16 __attribute__((ext_vector_type(16)));
typedef short s16x4 __attribute__((ext_vector_type(4)));
typedef short bf16x8_t __attribute__((ext_vector_type(8)));
__device__ __forceinline__ unsigned cvtpk(float lo, float hi) { typedef float f2_t __attribute__((ext_vector_type(2))); typedef __bf16 b2_t __attribute__((ext_vector_type(2)));
    f2_t v = {lo, hi}; b2_t b = __builtin_convertvector(v, b2_t); return __builtin_bit_cast(unsigned, b); }
__device__ __forceinline__ void ph_rope(const Args& a, Frame& F) {
    bf16_t* P = (bf16_t*)(F.ws + WS_PROJ); const float* CS = (const float*)(F.ws + WS_CS);
    for (int it = F.bid * NTHREADS + F.tid; it < T * 10; it += F.nb * NTHREADS) {
        const int t = it / 10, hh = it % 10;
        bf16_t* p = P + (size_t)t * NP + hh * 64;
        const u32x4 x1 = *(const u32x4*)p, x2 = *(const u32x4*)(p + 8);
        const f32x4 c0 = *(const f32x4*)(CS + (size_t)t * 16), c1 = *(const f32x4*)(CS + (size_t)t * 16 + 4), s0 = *(const f32x4*)(CS + (size_t)t * 16 + 8), s1 = *(const f32x4*)(CS + (size_t)t * 16 + 12);
        const float cs[8] = {c0.x, c0.y, c0.z, c0.w, c1.x, c1.y, c1.z, c1.w}, sn[8] = {s0.x, s0.y, s0.z, s0.w, s1.x, s1.y, s1.z, s1.w};
        const unsigned xa[4] = {x1.x, x1.y, x1.z, x1.w}, xb[4] = {x2.x, x2.y, x2.z, x2.w};
        unsigned ra[4], rb[4];
#pragma unroll
        for (int i = 0; i < 4; ++i) {
            const float a0 = bf2f(xa[i] & 0xffffu), a1 = bf2f(xa[i] >> 16), b0 = bf2f(xb[i] & 0xffffu), b1 = bf2f(xb[i] >> 16);
            ra[i] = pk2(a0 * cs[2 * i] - b0 * sn[2 * i], a1 * cs[2 * i + 1] - b1 * sn[2 * i + 1]);
            rb[i] = pk2(b0 * cs[2 * i] + a0 * sn[2 * i], b1 * cs[2 * i + 1] + a1 * sn[2 * i + 1]);
        }
        *(u32x4*)p = (u32x4){ra[0], ra[1], ra[2], ra[3]}; *(u32x4*)(p + 8) = (u32x4){rb[0], rb[1], rb[2], rb[3]};
    }
}
constexpr int AT_KROW = 144, AT_VOFF = 256 * AT_KROW;
__device__ __forceinline__ void ph_attn_mfma(const Args& a, Frame& F, int l) {
    const bf16_t* P = (const bf16_t*)(F.ws + WS_PROJ); bf16_t* Y = (bf16_t*)(F.ws + WS_YMIX);
    LAS unsigned char* Kl = F.lds; LAS unsigned char* Vl = F.lds + AT_VOFF;
    const int lane = F.lane, r = lane & 31, h = lane >> 5, g = F.wave >> 1, qh = F.wave & 1;
    const int i16 = lane & 15, tq_ = i16 >> 2, tp_ = i16 & 3, g16 = (lane >> 4) & 1, sw = (tq_ >> 1) & 1;
    const int vlane = (4 * h + tq_) * 128 + (2 * g16 + (tp_ >> 1)) * 16 + (tp_ & 1) * 8;
    const float C = 0.125f * 1.4426950408889634f;
    const int nsc = NSCAN;
    if (F.bid < nsc) return;
    u32x4 kreg[4], vreg[4];
#define AT_LOAD(uu) { const int hk_ = (uu) & 1, n_ = ((uu) >> 1) & 127, b_ = (uu) >> 8, tk0_ = b_ * SEQ + n_ * 128 - 128; \
        _Pragma("unroll") for (int i = 0; i < 4; ++i) { const int piece = F.tid + NTHREADS * i, key = piece >> 3, c = piece & 7; \
            const bf16_t* rowp = P + (size_t)(tk0_ + ((n_ > 0 || key >= 128) ? key : key + 128)) * NP; \
            kreg[i] = *(const u32x4*)(rowp + C_AK + hk_ * 64 + c * 8); vreg[i] = *(const u32x4*)(rowp + C_AV + hk_ * 64 + c * 8); } }
    const int V = F.nb - nsc, nheavy = (T / 128 > V && T / 128 < 2 * V) ? T / 128 - V : 0, va = F.bid - nsc - nheavy, Va = V - nheavy;
    if (va < 0) return;
    if (va < BATCH * 128 * 2) AT_LOAD(va)
    for (int u = va; u < BATCH * 128 * 2; u += Va) {
        const int hk = u & 1, n = (u >> 1) & 127, b = u >> 8;
        const int tq0 = b * SEQ + n * 128;
        __syncthreads();
#pragma unroll
        for (int i = 0; i < 4; ++i) {
            const int piece = F.tid + NTHREADS * i, key = piece >> 3, c = piece & 7;
            const bool ok = (n > 0 || key >= 128);
            const u32x4 z4 = (u32x4){0u, 0u, 0u, 0u};
            *(LAS u32x4*)(Kl + key * AT_KROW + c * 16) = ok ? kreg[i] : z4;
            *(LAS u32x4*)(Vl + key * 128 + ((c ^ (((key >> 1) & 1) << 2)) * 16)) = ok ? vreg[i] : z4;
        }
        __syncthreads();
        if (u + Va < BATCH * 128 * 2) AT_LOAD(u + Va)
        asm volatile("" ::: "memory");
        const int hq = hk * 4 + g;
        const float sinkl = a.sinks[l * 8 + hq] * 1.4426950408889634f;
#pragma unroll 1
        for (int sb = 0; sb < 2; ++sb) {
            const int q0 = qh * 64 + sb * 32, kt0 = qh * 2 + sb;
            const size_t tq = (size_t)(tq0 + q0 + r);
            bf16x8_t qf[4];
#pragma unroll
            for (int ks = 0; ks < 4; ++ks) qf[ks] = *(const bf16x8_t*)(P + tq * NP + hq * 64 + 16 * ks + 8 * h);
            f32x16 S[5];
#pragma unroll
            for (int kr = 0; kr < 5; ++kr) {
                f32x16 acc;
#pragma unroll
                for (int i = 0; i < 16; ++i) acc[i] = 0.f;
#pragma unroll
                for (int ks = 0; ks < 4; ++ks) { const bf16x8_t kf = *(const LAS bf16x8_t*)(Kl + (32 * (kt0 + kr) + r) * AT_KROW + (16 * ks + 8 * h) * 2);
                    acc = __builtin_amdgcn_mfma_f32_32x32x16_bf16(kf, qf[ks], acc, 0, 0, 0); }
                S[kr] = acc;
            }
            float m = sinkl;
#pragma unroll
            for (int kr = 0; kr < 5; ++kr) {
                const bool tile_ok = !(n == 0 && (kt0 + kr) < 4);
#pragma unroll
                for (int i = 0; i < 16; ++i) {
                    const int kl = (i & 3) + 8 * (i >> 2) + 4 * h;
                    bool ok = tile_ok; if (kr == 0) ok = ok && (kl > r); if (kr == 4) ok = ok && (kl <= r);
                    const float sv = ok ? S[kr][i] * C : -INFINITY; S[kr][i] = sv; m = fmaxf(m, sv);
                }
            }
            m = xor32_max(m);
            float lsum = 0.f;
#pragma unroll
            for (int kr = 0; kr < 5; ++kr)
#pragma unroll
                for (int i = 0; i < 16; ++i) { const float p = __builtin_amdgcn_exp2f(S[kr][i] - m); S[kr][i] = p; lsum += p; }
            lsum = xor32_sum(lsum); lsum += __builtin_amdgcn_exp2f(sinkl - m);
            f32x16 O0, O1;
#pragma unroll
            for (int i = 0; i < 16; ++i) { O0[i] = 0.f; O1[i] = 0.f; }
#pragma unroll
            for (int kr = 0; kr < 5; ++kr) {
#pragma unroll
                for (int s2 = 0; s2 < 2; ++s2) {
                    u32x4 pw; pw.x = cvtpk(S[kr][8 * s2 + 0], S[kr][8 * s2 + 1]); pw.y = cvtpk(S[kr][8 * s2 + 2], S[kr][8 * s2 + 3]); pw.z = cvtpk(S[kr][8 * s2 + 4], S[kr][8 * s2 + 5]); pw.w = cvtpk(S[kr][8 * s2 + 6], S[kr][8 * s2 + 7]);
                    const bf16x8_t pf = __builtin_bit_cast(bf16x8_t, pw);
                    const int kb = (32 * (kt0 + kr) + 16 * s2) * 128 + vlane;
                    const s16x4 lo0 = __builtin_amdgcn_ds_read_tr16_b64_v4i16((LAS s16x4*)(Vl + kb + (0 ^ sw) * 64));
                    const s16x4 hi0 = __builtin_amdgcn_ds_read_tr16_b64_v4i16((LAS s16x4*)(Vl + kb + 8 * 128 + (0 ^ sw) * 64));
                    const s16x4 lo1 = __builtin_amdgcn_ds_read_tr16_b64_v4i16((LAS s16x4*)(Vl + kb + (1 ^ sw) * 64));
                    const s16x4 hi1 = __builtin_amdgcn_ds_read_tr16_b64_v4i16((LAS s16x4*)(Vl + kb + 8 * 128 + (1 ^ sw) * 64));
                    const bf16x8_t va0 = __builtin_shufflevector(lo0, hi0, 0, 1, 2, 3, 4, 5, 6, 7), va1 = __builtin_shufflevector(lo1, hi1, 0, 1, 2, 3, 4, 5, 6, 7);
                    O0 = __builtin_amdgcn_mfma_f32_32x32x16_bf16(va0, pf, O0, 0, 0, 0);
                    O1 = __builtin_amdgcn_mfma_f32_32x32x16_bf16(va1, pf, O1, 0, 0, 0);
                }
            }
            const float inv = __builtin_amdgcn_rcpf(lsum);
            bf16_t* yp = Y + tq * D + hq * 64 + 4 * h;
#pragma unroll
            for (int gq = 0; gq < 4; ++gq) {
                u32x2 o0; o0.x = cvtpk(O0[4 * gq] * inv, O0[4 * gq + 1] * inv); o0.y = cvtpk(O0[4 * gq + 2] * inv, O0[4 * gq + 3] * inv);
                u32x2 o1; o1.x = cvtpk(O1[4 * gq] * inv, O1[4 * gq + 1] * inv); o1.y = cvtpk(O1[4 * gq + 2] * inv, O1[4 * gq + 3] * inv);
                *(u32x2*)(yp + 8 * gq) = o0; *(u32x2*)(yp + 32 + 8 * gq) = o1;
            }
        }
    }
    __syncthreads();
}


#undef AT_LOAD
constexpr size_t WS_DN_MR = 360 * MiB, WS_DN_BNT = 376 * MiB, WS_DN_QP = 392 * MiB, WS_DN_OLT = 408 * MiB, WS_DN_ST = 424 * MiB;
constexpr int DL = 72, LB = 9216;
constexpr int L_KR = 0, L_KT = LB, L_QR = 2 * LB, L_VT = 3 * LB, L_AR = 4 * LB, L_T1 = 5 * LB, L_T2 = 6 * LB, L_UT = 7 * LB, L_UPT = 8 * LB, L_WPT = 9 * LB, L_WT = 0;
constexpr int L_LR = 7 * LB, L_L21 = L_LR + 17408, L_T11T = L_L21 + 4608, L_T22R = L_T11T + 4608, L_YT = L_T22R + 4608, L_GC = 100352, L_BETA = L_GC + 256;
static_assert(L_YT + 4608 == L_GC && L_GC + 512 <= 131072, "DeltaNet LDS map");
template <int KS> __device__ __forceinline__ f32x4 mm16(const LAS unsigned char* lds, int offX, int offY, int tx, int ty, int lane) {
    f32x4 acc = (f32x4){0.f, 0.f, 0.f, 0.f};
    const int l15 = lane & 15, q = lane >> 4;
#pragma unroll
    for (int ks = 0; ks < KS; ++ks) {
        const bf16x8_t xa = *(const LAS bf16x8_t*)(lds + offX + ((16 * tx + l15) * DL + 32 * ks + 8 * q) * 2);
        const bf16x8_t yb = *(const LAS bf16x8_t*)(lds + offY + ((16 * ty + l15) * DL + 32 * ks + 8 * q) * 2);
        acc = __builtin_amdgcn_mfma_f32_16x16x32_bf16(xa, yb, acc, 0, 0, 0);
    }
    return acc;
}
__device__ __forceinline__ u32x2 pack4(f32x4 v) { u32x2 o; o.x = cvtpk(v.x, v.y); o.y = cvtpk(v.z, v.w); return o; }

__device__ __forceinline__ void ph_dn_chunk(const Args& a, Frame& F, int l) {
    const bf16_t* P = (const bf16_t*)(F.ws + WS_PROJ); const float* BG = (const float*)(F.ws + WS_BG);
    bf16_t* MR = (bf16_t*)(F.ws + WS_DN_MR); bf16_t* BNT = (bf16_t*)(F.ws + WS_DN_BNT); bf16_t* QP = (bf16_t*)(F.ws + WS_DN_QP); bf16_t* OLT = (bf16_t*)(F.ws + WS_DN_OLT);
    LAS unsigned char* lds = F.lds;
    LAS float* gcL = (LAS float*)(lds + L_GC); LAS float* betaL = (LAS float*)(lds + L_BETA);
    const float* cw = a.dn_conv_w + (size_t)l * DN_CONV * 768;
    const int lane = F.lane, w = F.wave, l15 = lane & 15, q4 = lane >> 4;
    LAS float* cwL = (LAS float*)(lds + L_GC + 512);
    int cur_h = -1;
    const int ci = F.tid >> 3, c8 = F.tid & 7;
    u32x4 xr[3][4]; float bgb = 0.f, bgg = 0.f;
#define CH_LOAD(vu_) { const int n_ = ((vu_) >> 2) & 255, h_ = (vu_) & 3, b_ = (vu_) >> 10; const int t_ = b_ * SEQ + n_ * 64 + ci; \
        _Pragma("unroll") for (int kd = 0; kd < 3; ++kd) _Pragma("unroll") for (int k = 0; k < DN_CONV; ++k) { \
            const int tt_ = (n_ * 64 + ci - (DN_CONV - 1) + k >= 0) ? t_ - (DN_CONV - 1) + k : t_; xr[kd][k] = *(const u32x4*)(P + (size_t)tt_ * NP + C_DQ + kd * 256 + h_ * 64 + c8 * 8); } \
        if (w == 0) { bgb = BG[(size_t)(b_ * SEQ + n_ * 64 + lane) * 8 + h_]; bgg = BG[(size_t)(b_ * SEQ + n_ * 64 + lane) * 8 + 4 + h_]; } }
    if (F.bid < BATCH * 4 * 256) CH_LOAD(F.bid)
    for (int vu = F.bid; vu < BATCH * 4 * 256; vu += F.nb) {
        const int n = (vu >> 2) & 255, h = vu & 3, b = vu >> 10, unit = (b * 4 + h) * 256 + n;
        const int t0 = b * SEQ + n * 64;
        int ln_ = F.lane; asm volatile("" : "+v"(ln_));
        const int lane = ln_, l15 = lane & 15, q4 = lane >> 4;
        __syncthreads();
        if (h != cur_h) { cur_h = h;
            for (int idx = F.tid; idx < DN_CONV * 3 * 64; idx += NTHREADS) { const int k = idx / 192, kd = (idx / 64) % 3, cc = idx & 63; cwL[idx] = cw[k * 768 + kd * 256 + h * 64 + cc]; }
            __syncthreads(); }
        {
            const int i = ci, sq = n * 64 + i;
#pragma unroll
            for (int kd = 0; kd < 3; ++kd) {
                float acc[8];
#pragma unroll
                for (int e = 0; e < 8; ++e) acc[e] = 0.f;
#pragma unroll
                for (int k = 0; k < DN_CONV; ++k) {
                    const u32x4 xv = xr[kd][k]; const float vm = (sq - (DN_CONV - 1) + k >= 0) ? 1.f : 0.f;
                    const f32x4 w0 = *(const LAS f32x4*)(cwL + (k * 3 + kd) * 64 + c8 * 8) * vm, w1 = *(const LAS f32x4*)(cwL + (k * 3 + kd) * 64 + c8 * 8 + 4) * vm;
                    acc[0] += w0.x * bf2f(xv.x & 0xffffu); acc[1] += w0.y * bf2f(xv.x >> 16); acc[2] += w0.z * bf2f(xv.y & 0xffffu); acc[3] += w0.w * bf2f(xv.y >> 16);
                    acc[4] += w1.x * bf2f(xv.z & 0xffffu); acc[5] += w1.y * bf2f(xv.z >> 16); acc[6] += w1.z * bf2f(xv.w & 0xffffu); acc[7] += w1.w * bf2f(xv.w >> 16);
                }
                float ss = 0.f;
#pragma unroll
                for (int e = 0; e < 8; ++e) { acc[e] = siluf_(acc[e]); ss += acc[e] * acc[e]; }
                if (kd < 2) {
                    ss = group8_sum(ss);
                    const float rn = rsqrtf(ss + EPS) * (kd == 0 ? 0.125f : 1.0f);
#pragma unroll
                    for (int e = 0; e < 8; ++e) acc[e] *= rn;
                }
                u32x4 pk; pk.x = cvtpk(acc[0], acc[1]); pk.y = cvtpk(acc[2], acc[3]); pk.z = cvtpk(acc[4], acc[5]); pk.w = cvtpk(acc[6], acc[7]);
                if (kd == 0) *(LAS u32x4*)(lds + L_QR + (i * DL + c8 * 8) * 2) = pk;
                if (kd == 1) *(LAS u32x4*)(lds + L_KR + (i * DL + c8 * 8) * 2) = pk;
                if (kd >= 1) {
                    LAS bf16_t* Tt = (LAS bf16_t*)(lds + (kd == 1 ? L_KT : L_VT));
                    const unsigned pw[4] = {pk.x, pk.y, pk.z, pk.w};
#pragma unroll
                    for (int e = 0; e < 8; ++e) Tt[(c8 * 8 + e) * DL + i] = (bf16_t)((pw[e >> 1] >> (16 * (e & 1))) & 0xffffu);
                }
            }
            for (int idx = F.tid; idx < 2 * LB / 16; idx += NTHREADS) *(LAS u32x4*)(lds + L_T1 + idx * 16) = (u32x4){0u, 0u, 0u, 0u};
            if (w == 0) {
                float x = bgg;
#pragma unroll
                for (int o = 1; o < 64; o <<= 1) { const float y = __shfl_up(x, o); if (lane >= o) x += y; }
                gcL[lane] = x; betaL[lane] = bgb;
            }
            if (vu + F.nb < BATCH * 4 * 256) CH_LOAD(vu + F.nb)
            asm volatile("" ::: "memory");
        }
        __syncthreads();
        REP(134217728)
#pragma unroll
        for (int tt = 0; tt < 2; ++tt) {
            const int tidx = 2 * w + tt, tx = tidx >> 2, ty = tidx & 3, i = 16 * ty + l15, j0 = 16 * tx + 4 * q4;
            const float gi = gcL[i], bi = betaL[i]; const f32x4 gj = *(const LAS f32x4*)(gcL + j0);
            const float gjv[4] = {gj.x, gj.y, gj.z, gj.w};
            const f32x4 zk = mm16<2>(lds, L_KR, L_KR, tx, ty, lane);
            const f32x4 zq = mm16<2>(lds, L_KR, L_QR, tx, ty, lane);
            f32x4 lv, av;
#pragma unroll
            for (int r = 0; r < 4; ++r) { const float dc = __expf(fminf(gi - gjv[r], 0.f)); lv[r] = (j0 + r < i) ? bi * zk[r] * dc : 0.f; av[r] = (j0 + r <= i) ? zq[r] * dc : 0.f; }
            if ((tx >> 1) == (ty >> 1)) {
                LAS float* lt = (LAS float*)(lds + L_LR) + ((ty >> 1) * 32 + (j0 & 31)) * 36 + ((i & 3) * 8 + ((i & 31) >> 2));
#pragma unroll
                for (int r = 0; r < 4; ++r) lt[r * 36] = lv[r]; }
            if (i >= 32 && j0 < 32) *(LAS u32x2*)(lds + L_L21 + ((i - 32) * DL + j0) * 2) = pack4(lv);
            *(LAS u32x2*)(lds + L_AR + (i * DL + j0) * 2) = pack4(av);
        }
        __syncthreads();
        REP(32768) if (w < 4) {
            const int c = 16 * w + (lane >> 2), blk = c >> 5, cb = c & 31, q = lane & 3;
            const LAS float* Lt = (const LAS float*)(lds + L_LR) + blk * 32 * 36 + q * 8;
            float d[8], xs[8];
#pragma unroll
            for (int jj = 0; jj < 8; ++jj) { d[jj] = (4 * jj + q == cb) ? 1.f : 0.f; xs[jj] = 0.f; }
            f32x4 X[8], Y[8];
#define SUB_HEAD(k_, ctrl_) constexpr int j_ = (k_) >> 2; const float t_ = d[j_]; const float xk_ = DPP_MOV(t_, ctrl_); xs[j_] = (q == ((k_) & 3)) ? t_ : xs[j_];
#define SUB_AB(k_, ctrl_, BUF_) { SUB_HEAD(k_, ctrl_) const f32x4 la_ = BUF_[(k_) & 3], lb_ = BUF_[4 + ((k_) & 3)]; \
                if (j_ <= 0) d[0] = __builtin_fmaf(-la_.x, xk_, d[0]); if (j_ <= 1) d[1] = __builtin_fmaf(-la_.y, xk_, d[1]); if (j_ <= 2) d[2] = __builtin_fmaf(-la_.z, xk_, d[2]); d[3] = __builtin_fmaf(-la_.w, xk_, d[3]); \
                d[4] = __builtin_fmaf(-lb_.x, xk_, d[4]); d[5] = __builtin_fmaf(-lb_.y, xk_, d[5]); d[6] = __builtin_fmaf(-lb_.z, xk_, d[6]); d[7] = __builtin_fmaf(-lb_.w, xk_, d[7]); }
#define SUB_B(k_, ctrl_, BUF_) { SUB_HEAD(k_, ctrl_) const f32x4 lb_ = BUF_[(k_) & 7]; \
                if (j_ <= 4) d[4] = __builtin_fmaf(-lb_.x, xk_, d[4]); if (j_ <= 5) d[5] = __builtin_fmaf(-lb_.y, xk_, d[5]); if (j_ <= 6) d[6] = __builtin_fmaf(-lb_.z, xk_, d[6]); d[7] = __builtin_fmaf(-lb_.w, xk_, d[7]); }
#define SUB_LD4(BUF_, k0_) { _Pragma("unroll") for (int k = 0; k < 4; ++k) { BUF_[k] = *(const LAS f32x4*)(Lt + ((k0_) + k) * 36); BUF_[4 + k] = *(const LAS f32x4*)(Lt + ((k0_) + k) * 36 + 4); } }
#define SUB_LD8(BUF_, k0_) { _Pragma("unroll") for (int k = 0; k < 8; ++k) BUF_[k] = *(const LAS f32x4*)(Lt + ((k0_) + k) * 36 + 4); }
#define SUB_FENCE __builtin_amdgcn_sched_barrier(0);
            SUB_LD4(X, 0) SUB_LD4(Y, 4) SUB_FENCE
            SUB_AB(0, 0x00, X) SUB_AB(1, 0x55, X) SUB_AB(2, 0xAA, X) SUB_AB(3, 0xFF, X) SUB_FENCE SUB_LD4(X, 8) SUB_FENCE
            SUB_AB(4, 0x00, Y) SUB_AB(5, 0x55, Y) SUB_AB(6, 0xAA, Y) SUB_AB(7, 0xFF, Y) SUB_FENCE SUB_LD4(Y, 12) SUB_FENCE
            SUB_AB(8, 0x00, X) SUB_AB(9, 0x55, X) SUB_AB(10, 0xAA, X) SUB_AB(11, 0xFF, X) SUB_FENCE SUB_LD8(X, 16) SUB_FENCE
            SUB_AB(12, 0x00, Y) SUB_AB(13, 0x55, Y) SUB_AB(14, 0xAA, Y) SUB_AB(15, 0xFF, Y) SUB_FENCE SUB_LD8(Y, 24) SUB_FENCE
            SUB_B(16, 0x00, X) SUB_B(17, 0x55, X) SUB_B(18, 0xAA, X) SUB_B(19, 0xFF, X) SUB_B(20, 0x00, X) SUB_B(21, 0x55, X) SUB_B(22, 0xAA, X) SUB_B(23, 0xFF, X)
            SUB_B(24, 0x00, Y) SUB_B(25, 0x55, Y) SUB_B(26, 0xAA, Y) SUB_B(27, 0xFF, Y) SUB_B(28, 0x00, Y) SUB_B(29, 0x55, Y) SUB_B(30, 0xAA, Y) SUB_B(31, 0xFF, Y)
#undef SUB_FENCE
#undef SUB_LD8
#undef SUB_LD4
#undef SUB_B
#undef SUB_AB
#undef SUB_HEAD
            const int jg = 32 * blk + cb; const float bj = betaL[jg], bej = bj * __expf(gcL[jg]);
            LAS bf16_t* T1 = (LAS bf16_t*)(lds + L_T1); LAS bf16_t* T2 = (LAS bf16_t*)(lds + L_T2);
#pragma unroll
            for (int jj = 0; jj < 8; ++jj) { const int rg = 32 * blk + 4 * jj + q; T1[rg * DL + jg] = (bf16_t)f2bf(xs[jj] * bj); T2[rg * DL + jg] = (bf16_t)f2bf(xs[jj] * bej); }
            if (blk == 0) { LAS bf16_t* T11 = (LAS bf16_t*)(lds + L_T11T);
#pragma unroll
                for (int jj = 0; jj < 8; ++jj) T11[cb * DL + 4 * jj + q] = (bf16_t)f2bf(xs[jj]); }
            else { LAS bf16_t* T22 = (LAS bf16_t*)(lds + L_T22R);
#pragma unroll
                for (int jj = 0; jj < 8; ++jj) T22[(4 * jj + q) * DL + cb] = (bf16_t)f2bf(xs[jj]); }
        }
        __syncthreads();
        if (w < 4) {
            const int tx = w >> 1, ty = w & 1;
            const f32x4 z = mm16<1>(lds, L_L21, L_T11T, tx, ty, lane);
            *(LAS u32x2*)(lds + L_YT + ((16 * ty + l15) * DL + 16 * tx + 4 * q4) * 2) = pack4(z);
        }
        __syncthreads();
        if (w < 4) {
            const int tx = w >> 1, ty = w & 1, y = 16 * ty + l15, x0 = 16 * tx + 4 * q4;
            const f32x4 z = mm16<1>(lds, L_T22R, L_YT, tx, ty, lane);
            const float bj = betaL[y], bej = bj * __expf(gcL[y]);
            LAS bf16_t* T1 = (LAS bf16_t*)(lds + L_T1); LAS bf16_t* T2 = (LAS bf16_t*)(lds + L_T2);
#pragma unroll
            for (int r = 0; r < 4; ++r) { T1[(32 + x0 + r) * DL + y] = (bf16_t)f2bf(-z[r] * bj); T2[(32 + x0 + r) * DL + y] = (bf16_t)f2bf(-z[r] * bej); }
        }
        __syncthreads();
        const float gl = gcL[63];
        REP(268435456)
#pragma unroll
        for (int tt = 0; tt < 2; ++tt) {
            const int tidx = 2 * w + tt, tx = tidx >> 2, ty = tidx & 3, y = 16 * ty + l15, x0 = 16 * tx + 4 * q4;
            const f32x4 gx = *(const LAS f32x4*)(gcL + x0);
            f32x4 sc; sc.x = __expf(gl - gx.x); sc.y = __expf(gl - gx.y); sc.z = __expf(gl - gx.z); sc.w = __expf(gl - gx.w);
            const f32x4 zu = mm16<2>(lds, L_T1, L_VT, tx, ty, lane);
            const f32x4 zw = mm16<2>(lds, L_T2, L_KT, tx, ty, lane);
            *(LAS u32x2*)(lds + L_UT + (y * DL + x0) * 2) = pack4(zu); *(LAS u32x2*)(lds + L_UPT + (y * DL + x0) * 2) = pack4(zu * sc);
            *(LAS u32x2*)(lds + L_WT + (y * DL + x0) * 2) = pack4(zw); *(LAS u32x2*)(lds + L_WPT + (y * DL + x0) * 2) = pack4(zw * sc);
        }
        __syncthreads();
        REP(65536) {
            const size_t cho = (size_t)unit * 4096;
            const float egl = __expf(gl);
#pragma unroll
            for (int tt = 0; tt < 2; ++tt) {
                const int tidx = 2 * w + tt, tx = tidx >> 2, ty = tidx & 3, y = 16 * ty + l15, x0 = 16 * tx + 4 * q4;
                f32x4 zm = mm16<2>(lds, L_WPT, L_KT, tx, ty, lane);
#pragma unroll
                for (int r = 0; r < 4; ++r) zm[r] = ((x0 + r) == y ? egl : 0.f) - zm[r];
                *(u32x2*)(MR + cho + (ty * 2 + (tx >> 1)) * 512 + lane * 8 + 4 * (tx & 1)) = pack4(zm);
                const f32x4 zb = mm16<2>(lds, L_KT, L_UPT, tx, ty, lane);
                *(u32x2*)(BNT + cho + (ty * 4 + tx) * 256 + lane * 4) = pack4(zb);
                const f32x4 zq = mm16<2>(lds, L_WT, L_AR, tx, ty, lane);
                const u32x2 qv = *(const LAS u32x2*)(lds + L_QR + (y * DL + x0) * 2); const float eg = __expf(gcL[y]);
                f32x4 qp; qp.x = bf2f(qv.x & 0xffffu) * eg - zq.x; qp.y = bf2f(qv.x >> 16) * eg - zq.y; qp.z = bf2f(qv.y & 0xffffu) * eg - zq.z; qp.w = bf2f(qv.y >> 16) * eg - zq.w;
                *(u32x2*)(QP + cho + y * 64 + x0) = pack4(qp);
                const f32x4 zo = mm16<2>(lds, L_AR, L_UT, tx, ty, lane);
                *(u32x2*)(OLT + cho + y * 64 + x0) = pack4(zo);
            }
        }
    }
    __syncthreads();
}
#undef CH_LOAD
constexpr int SC_SLOT = 10240, SC_DEPTH = 12, SC_AHEAD = 10, SC_STS = 2 * 16 * 144;
__device__ __forceinline__ void ph_dn_scan(const Args& a, Frame& F, int l) {
    if (F.bid >= NSCAN) return;
    GAS unsigned* prog = (GAS unsigned*)(F.ws + WS_CTL) + CW_SCANP + l * 4096 + 64 * F.bid;
    const unsigned char* MRb = (const unsigned char*)(F.ws + WS_DN_MR); const unsigned char* BNb = (const unsigned char*)(F.ws + WS_DN_BNT); GAS bf16_t* ST = (GAS bf16_t*)(F.ws + WS_DN_ST);
    const int lane = F.lane, l15 = lane & 15, q4 = lane >> 4, wq = F.bid >> 3;
    const size_t ch0 = (size_t)(F.bid & 7) * 256;
    LAS unsigned char* lds = F.lds; LAS unsigned char* stl = F.lds + RI_OFF;
    __syncthreads();
    if (F.wave >= 3) {
        const int lw = F.wave - 3;
#define DN_ISSUE(nn) do { const size_t chb_ = (ch0 + (size_t)((nn) < 255 ? (nn) : 255)) * 8192; const int slot_ = ((nn) % SC_DEPTH) * SC_SLOT; \
        _Pragma("unroll") for (int p_ = 0; p_ < 2; ++p_) { const int piece_ = lw * 2 + p_; \
            const unsigned char* src_ = (piece_ < 8 ? MRb + chb_ + piece_ * 1024 : BNb + chb_ + wq * 2048 + (piece_ - 8) * 1024) + lane * 16; \
            __builtin_amdgcn_global_load_lds((const unsigned*)src_, (LAS unsigned*)(lds + slot_ + piece_ * 1024), 16, 0, 2); } } while (0)
        for (int n = 0; n < SC_AHEAD; ++n) DN_ISSUE(n);
        for (int n = 0; n < 256; n += 2) {
            asm volatile("s_waitcnt vmcnt(16)" ::: "memory");
            __builtin_amdgcn_s_barrier();
            DN_ISSUE(n + SC_AHEAD); DN_ISSUE(n + SC_AHEAD + 1);
        }
        asm volatile("s_waitcnt vmcnt(0)" ::: "memory");
        __builtin_amdgcn_s_barrier();
#undef DN_ISSUE
    } else if (F.wave == 0) {
        const int dv = 16 * wq + l15;
        f32x4 S[4];
#pragma unroll
        for (int ti = 0; ti < 4; ++ti) S[ti] = (f32x4){0.f, 0.f, 0.f, 0.f};
        for (int n0 = 0; n0 < 256; n0 += 2) {
            __builtin_amdgcn_s_barrier();
            bf16x8_t A[2][4][2]; u32x2 Bc[2][4];
#pragma unroll
            for (int e = 0; e < 2; ++e) { const LAS unsigned char* slot = lds + ((n0 + e) % SC_DEPTH) * SC_SLOT;
#pragma unroll
                for (int ti = 0; ti < 4; ++ti) {
#pragma unroll
                    for (int ks = 0; ks < 2; ++ks) A[e][ti][ks] = *(const LAS bf16x8_t*)(slot + (ti * 2 + ks) * 1024 + lane * 16);
                    Bc[e][ti] = *(const LAS u32x2*)(slot + 8192 + ti * 512 + lane * 8);
                } }
#pragma unroll
            for (int e = 0; e < 2; ++e) {
                const int n = n0 + e;
                u32x2 sp[4];
#pragma unroll
                for (int ti = 0; ti < 4; ++ti) { sp[ti] = pack4(S[ti]); *(LAS u32x2*)(stl + ((n0 >> 1) & 1) * SC_STS + e * (SC_STS / 2) + l15 * 144 + (16 * ti + 4 * q4) * 2) = sp[ti]; }
                const bf16x8_t b0 = __builtin_bit_cast(bf16x8_t, (u32x4){sp[0].x, sp[0].y, sp[1].x, sp[1].y});
                const bf16x8_t b1 = __builtin_bit_cast(bf16x8_t, (u32x4){sp[2].x, sp[2].y, sp[3].x, sp[3].y});
#pragma unroll
                for (int ti = 0; ti < 4; ++ti) {
                    f32x4 c; c.x = bf2f(Bc[e][ti].x & 0xffffu); c.y = bf2f(Bc[e][ti].x >> 16); c.z = bf2f(Bc[e][ti].y & 0xffffu); c.w = bf2f(Bc[e][ti].y >> 16);
                    c = __builtin_amdgcn_mfma_f32_16x16x32_bf16(A[e][ti][0], b0, c, 0, 0, 0);
                    c = __builtin_amdgcn_mfma_f32_16x16x32_bf16(A[e][ti][1], b1, c, 0, 0, 0);
                    S[ti] = c;
                }
            }
            asm volatile("s_waitcnt lgkmcnt(0)" ::: "memory");
        }
        __builtin_amdgcn_s_barrier();
    } else if (F.wave == 1) {
        GAS unsigned char* stg = (GAS unsigned char*)(ST + ch0 * 4096 + (size_t)(16 * wq) * 64);
        for (int n0 = 0; n0 <= 256; n0 += 2) {
            __builtin_amdgcn_s_barrier();
            if (n0 >= 2) {
                const LAS unsigned char* slot = stl + (((n0 - 2) >> 1) & 1) * SC_STS;
#pragma unroll
                for (int e = 0; e < 2; ++e)
#pragma unroll
                    for (int i = 0; i < 2; ++i) { const int pc = i * 64 + lane; const u32x4 v = *(const LAS u32x4*)(slot + e * (SC_STS / 2) + (pc >> 3) * 144 + (pc & 7) * 16);
                        const unsigned long long gp = (unsigned long long)(stg + (size_t)(n0 - 2 + e) * 8192 + pc * 16);
                        asm volatile("global_store_dwordx4 %0, %1, off sc1" :: "v"(gp), "v"(v) : "memory"); }
                asm volatile("s_waitcnt vmcnt(40)" ::: "memory");
                if (lane == 0) __hip_atomic_store(prog, (unsigned)(n0 >= 16 ? n0 - 16 : 0), __ATOMIC_RELAXED, __HIP_MEMORY_SCOPE_AGENT);
            }
        }
        asm volatile("s_waitcnt vmcnt(0)" ::: "memory");
        if (lane == 0) __hip_atomic_store(prog, 256u, __ATOMIC_RELAXED, __HIP_MEMORY_SCOPE_AGENT);
    } else {
        for (int n = 0; n <= 256; n += 2) __builtin_amdgcn_s_barrier();
    }
    __syncthreads();
}
__device__ __forceinline__ void ph_dn_out(const Args& a, Frame& F, int l) {
    const bf16_t* QP = (const bf16_t*)(F.ws + WS_DN_QP); const bf16_t* OLT = (const bf16_t*)(F.ws + WS_DN_OLT); const bf16_t* ST = (const bf16_t*)(F.ws + WS_DN_ST);
    const bf16_t* P = (const bf16_t*)(F.ws + WS_PROJ); bf16_t* Y = (bf16_t*)(F.ws + WS_YMIX);
    const int lane = F.lane, l15 = lane & 15, q4 = lane >> 4, ti = F.wave & 3;
    LAS bf16_t* TL = (LAS bf16_t*)(F.lds + F.wave * 2560);
    const int er = lane >> 2, ec = (lane & 3) * 16;
    f32x4 gnv[4];
#pragma unroll
    for (int j = 0; j < 4; ++j) gnv[j] = *(const f32x4*)(a.dn_norm_g + l * 64 + ec + 4 * j);
    bf16x8_t af[2], bfv[4][2]; u32x2 ov[4];
    int pr0, prs, pre;
    if (F.nb == 256 && NSCAN == 32) { const int v = F.bid - NSCAN;
        if (v >= 32) { pr0 = v - 32; prs = 192; pre = 960; } else if (v >= 0) { pr0 = 960 + v; prs = 1024; pre = 1024; } else { pr0 = 992 + F.bid; prs = 1024; pre = 1024; } }
    else { if (F.bid < NSCAN) return; pr0 = F.bid - NSCAN; prs = F.nb - NSCAN; pre = 1024; }
    GAS unsigned* prog = (GAS unsigned*)(F.ws + WS_CTL) + CW_SCANP + l * 4096; unsigned* tmo = (unsigned*)(F.ws + WS_CTL) + CW_BAR + XB_TMO;
    unsigned seen = 0;
    volatile LAS unsigned* seenl = (volatile LAS unsigned*)(F.lds + MISC_OFF) + 16;
#define DNO_WAIT(prv) { const unsigned need_ = 2u * (unsigned)((prv) >> 3) + 2u; const int bh_ = (prv) & 7; if ((prs & 7) != 0) seen = 0; if (seen < need_) {   \
        if (F.wave == 0) { unsigned sp_ = 0, m_; \
            for (;;) { unsigned v_ = lane < 4 ? __hip_atomic_load(prog + 64 * (bh_ + 8 * lane), __ATOMIC_RELAXED, __HIP_MEMORY_SCOPE_AGENT) : 0xffffffffu; \
                _Pragma("unroll") for (int o_ = 2; o_ >= 1; o_ >>= 1) { const unsigned w_ = (unsigned)__shfl_xor((int)v_, o_); v_ = w_ < v_ ? w_ : v_; } \
                m_ = (unsigned)__builtin_amdgcn_readfirstlane((int)v_); if (m_ >= need_) break; \
                __builtin_amdgcn_s_sleep(8); \
                if ((++sp_ & 63u) == 0u) { if (xb_ld(tmo)) break; if (sp_ > (1u << 16)) { atomicAdd(tmo, 1u); break; } } } \
            __builtin_amdgcn_fence(__ATOMIC_ACQUIRE, "agent"); asm volatile("s_waitcnt vmcnt(0)" ::: "memory"); \
            if (lane == 0) *seenl = m_; } \
        __syncthreads(); seen = *seenl; __syncthreads(); } }
#define DNO_LOAD(prv) { const int unit_ = (((prv) & 7) << 8) + 2 * ((prv) >> 3) + (F.wave >> 2); const size_t cho_ = (size_t)unit_ * 4096; \
        _Pragma("unroll") for (int ks = 0; ks < 2; ++ks) af[ks] = *(const bf16x8_t*)(QP + cho_ + (16 * ti + l15) * 64 + 32 * ks + 8 * q4); \
        _Pragma("unroll") for (int tj = 0; tj < 4; ++tj) { ov[tj] = *(const u32x2*)(OLT + cho_ + (16 * tj + l15) * 64 + 16 * ti + 4 * q4); \
            _Pragma("unroll") for (int ks = 0; ks < 2; ++ks) bfv[tj][ks] = *(const bf16x8_t*)(ST + cho_ + (16 * tj + l15) * 64 + 32 * ks + 8 * q4); } }
    if (pr0 < pre) { DNO_WAIT(pr0) DNO_LOAD(pr0) }
    for (int pr = pr0; pr < pre; pr += prs) {
        const int unit = ((pr & 7) << 8) + 2 * (pr >> 3) + (F.wave >> 2), n = unit & 255, h = (unit >> 8) & 3, b = unit >> 10;
        f32x4 acc[4];
#pragma unroll
        for (int tj = 0; tj < 4; ++tj) {
            f32x4 c; c.x = bf2f(ov[tj].x & 0xffffu); c.y = bf2f(ov[tj].x >> 16); c.z = bf2f(ov[tj].y & 0xffffu); c.w = bf2f(ov[tj].y >> 16);
#pragma unroll
            for (int ks = 0; ks < 2; ++ks) c = __builtin_amdgcn_mfma_f32_16x16x32_bf16(af[ks], bfv[tj][ks], c, 0, 0, 0);
            acc[tj] = c;
        }
        const size_t trow = (size_t)b * SEQ + n * 64 + 16 * ti + er;
        const u32x4 z0 = *(const u32x4*)(P + trow * NP + C_DZ + h * 64 + ec), z1 = *(const u32x4*)(P + trow * NP + C_DZ + h * 64 + ec + 8);
        if (pr + prs < pre) { DNO_WAIT(pr + prs) DNO_LOAD(pr + prs) }
        f32x4 ss = acc[0] * acc[0] + acc[1] * acc[1] + acc[2] * acc[2] + acc[3] * acc[3];
        ss.x = row16_sum(ss.x); ss.y = row16_sum(ss.y); ss.z = row16_sum(ss.z); ss.w = row16_sum(ss.w);
        const float rs[4] = {rsqrtf(ss.x * (1.f / 64.f) + EPS), rsqrtf(ss.y * (1.f / 64.f) + EPS), rsqrtf(ss.z * (1.f / 64.f) + EPS), rsqrtf(ss.w * (1.f / 64.f) + EPS)};
#pragma unroll
        for (int tj = 0; tj < 4; ++tj)
#pragma unroll
            for (int r = 0; r < 4; ++r) TL[(4 * q4 + r) * 80 + 16 * tj + l15] = (bf16_t)f2bf(acc[tj][r] * rs[r]);
        const u32x4 t0 = *(const LAS u32x4*)(TL + er * 80 + ec), t1 = *(const LAS u32x4*)(TL + er * 80 + ec + 8);
        const unsigned tw[8] = {t0.x, t0.y, t0.z, t0.w, t1.x, t1.y, t1.z, t1.w}, zw[8] = {z0.x, z0.y, z0.z, z0.w, z1.x, z1.y, z1.z, z1.w};
        unsigned yw[8];
#pragma unroll
        for (int j = 0; j < 8; ++j) {
            const float g0 = gnv[j >> 1][(2 * j) & 3], g1 = gnv[j >> 1][(2 * j + 1) & 3];
            yw[j] = cvtpk(bf2f(tw[j] & 0xffffu) * g0 * siluf_(bf2f(zw[j] & 0xffffu)), bf2f(tw[j] >> 16) * g1 * siluf_(bf2f(zw[j] >> 16)));
        }
        bf16_t* yp = Y + trow * D + 512 + h * 64 + ec;
        *(u32x4*)yp = (u32x4){yw[0], yw[1], yw[2], yw[3]}; *(u32x4*)(yp + 8) = (u32x4){yw[4], yw[5], yw[6], yw[7]};
    }
#undef DNO_LOAD
#undef DNO_WAIT
}

__device__ __forceinline__ void ph_conv_fast(const Args& a, Frame& F, int l) {
    const bf16_t* P = (const bf16_t*)(F.ws + WS_PROJ); bf16_t* Y = (bf16_t*)(F.ws + WS_YMIX);
    LAS float* OUTL = (LAS float*)F.lds;
    const int c = F.tid & 255, rsel = F.tid >> 8;
    float wk[CV_K];
#pragma unroll
    for (int k = 0; k < CV_K; ++k) wk[k] = a.cv_dw_w[((size_t)l * CV_K + k) * CV_C + c];
    const float bias = a.cv_dw_b[l * CV_C + c];
    const int nsc = NSCAN;
    if (F.bid < nsc) return;
    for (int pr = F.bid - nsc; pr < T / 128; pr += F.nb - nsc) {
        const int run = 2 * pr + rsel, t0 = run * 64, s0 = t0 % SEQ;
        __syncthreads();
        float win[CV_K];
        const bf16_t* pc = P + (size_t)(t0 - 30) * NP + C_CA + c;
        const bool first = (s0 == 0);
        LAS float* outp = OUTL + (rsel * 64) * 256 + c;
#define CV_U(ti_, dst) { const bool ok_ = !(first && (ti_) < 30); const bf16_t* q_ = ok_ ? pc + (size_t)(ti_) * NP : pc + (size_t)30 * NP; \
            const float ca_ = bf2f(q_[0]), cb_ = bf2f(q_[256]); dst = ok_ ? ca_ * sigmoidf_(cb_) : 0.f; }
#pragma unroll
        for (int p = 0; p < CV_K; ++p) CV_U(p, win[p])
        { float acc = bias;
#pragma unroll
            for (int k = 0; k < CV_K; ++k) acc += wk[k] * win[(30 + 1 + k) % CV_K];
            outp[0] = acc; }
        for (int cb3 = 1; cb3 < 3; ++cb3) {
            float un[CV_K];
#pragma unroll
            for (int p = 0; p < CV_K; ++p) CV_U(cb3 * CV_K + p, un[p])
#pragma unroll
            for (int p = 0; p < CV_K; ++p) {
                win[p] = un[p];
                float acc = bias;
#pragma unroll
                for (int k = 0; k < CV_K; ++k) acc += wk[k] * win[(p + 1 + k) % CV_K];
                outp[(cb3 * CV_K + p - 30) * 256] = acc;
            }
        }
        { float u93; CV_U(93, u93) win[0] = u93; float acc = bias;
#pragma unroll
            for (int k = 0; k < CV_K; ++k) acc += wk[k] * win[(0 + 1 + k) % CV_K];
            outp[63 * 256] = acc; }
#undef CV_U
        __syncthreads();
        const f32x4 g4 = *(const f32x4*)(a.cv_ln_g + l * CV_C + 4 * F.lane), b4 = *(const f32x4*)(a.cv_ln_b + l * CV_C + 4 * F.lane);
        for (int j = 0; j < 16; ++j) {
            const int tl = F.wave * 16 + j;
            const f32x4 v = *(const LAS f32x4*)(OUTL + tl * 256 + 4 * F.lane);
            const float mean = wave_sum((v.x + v.y) + (v.z + v.w)) * (1.0f / CV_C);
            const f32x4 dv = v - mean;
            const float var = wave_sum((dv.x * dv.x + dv.y * dv.y) + (dv.z * dv.z + dv.w * dv.w)) * (1.0f / CV_C);
            const float rstd = rsqrtf(var + EPS);
            const f32x4 y = (dv * rstd) * g4 + b4;
            u32x2 o; o.x = cvtpk(siluf_(y.x), siluf_(y.y)); o.y = cvtpk(siluf_(y.z), siluf_(y.w));
            *(u32x2*)(Y + (size_t)(pr * 128 + tl) * D + 768 + 4 * F.lane) = o;
        }
    }
    __syncthreads();
}

__device__ __forceinline__ void moe_bases(Frame& F, int (&base)[9], int (&cnt)[8]) {
    const unsigned* c = (const unsigned*)(F.ws + WS_CTL) + CW_MOECNT;
    int acc = 0;
#pragma unroll
    for (int e = 0; e < 8; ++e) { cnt[e] = (int)__hip_atomic_load(c + 64 * e, __ATOMIC_RELAXED, __HIP_MEMORY_SCOPE_AGENT); base[e] = acc; acc += (cnt[e] + 255) & ~255; }
    base[8] = acc;
}
__device__ __forceinline__ void moe_range(Frame& F, int e, int& lo, int& hi) {
    const unsigned* c = (const unsigned*)(F.ws + WS_CTL) + CW_MOECNT;
    int acc = 0; lo = 0; hi = 0;
#pragma unroll
    for (int k = 0; k < 8; ++k) { const int n = ((int)__hip_atomic_load(c + 64 * k, __ATOMIC_RELAXED, __HIP_MEMORY_SCOPE_AGENT) + 255) & ~255; if (k == e) { lo = acc; hi = acc + n; } acc += n; }
}
__device__ __forceinline__ void ph_moe_list(const Args& a, Frame& F) {
    int base[9], cnt[8]; moe_bases(F, base, cnt);
    int* RM = (int*)(F.ws + WS_RMAP); const int* R = (const int*)(F.ws + WS_ROUTE); const int* Pq = (const int*)(F.ws + WS_POS);
    for (int t = F.bid * NTHREADS + F.tid; t < T; t += F.nb * NTHREADS) {
        const int e0 = R[t * 4], e1 = R[t * 4 + 1];
        int b0 = 0, b1 = 0;
#pragma unroll
        for (int e = 0; e < 8; ++e) { if (e == e0) b0 = base[e]; if (e == e1) b1 = base[e]; }
        RM[b0 + Pq[t * 2]] = t; RM[b1 + Pq[t * 2 + 1]] = t;
    }
    if (F.bid == 0) {
#pragma unroll
        for (int e = 0; e < 8; ++e) { const int lo = base[e] + cnt[e], hi = base[e + 1]; for (int r = lo + F.tid; r < hi; r += NTHREADS) RM[r] = 0; }
    }
}
__device__ __forceinline__ void ph_final(const Args& a, Frame& F) {
    int base[9], cnt[8]; moe_bases(F, base, cnt);
    const float* MOD = (const float*)(F.ws + WS_MOD);
    const bf16_t* YM = (const bf16_t*)(F.ws + WS_YMOE); const int* R = (const int*)(F.ws + WS_ROUTE); const int* Pq = (const int*)(F.ws + WS_POS); const bf16_t* X16 = (const bf16_t*)(F.ws + WS_X16);
    const int c0 = 8 * F.lane;
    f32x4 fg[4], gt[4]; int cur_b = -1;
#pragma unroll
    for (int j = 0; j < 4; ++j) fg[j] = *(const f32x4*)(a.final_g + 512 * (j >> 1) + c0 + 4 * (j & 1));
    u32x4 rt_n; u32x2 pq_n;
    u32x4 dx[2], dy0[2], dy1[2]; float p0c = 0.f, p1c = 0.f;
#define FIN_ROUTE(row_, rt_, pq_) { rt_ = *(const u32x4*)(R + (size_t)(row_) * 4); pq_ = *(const u32x2*)(Pq + (size_t)(row_) * 2); }
#define FIN_DATA(row_, rt_, pq_) { int b0_ = 0, b1_ = 0; _Pragma("unroll") for (int e = 0; e < 8; ++e) { if (e == (int)rt_.x) b0_ = base[e]; if (e == (int)rt_.y) b1_ = base[e]; } \
        const size_t s0_ = (size_t)(b0_ + (int)pq_.x), s1_ = (size_t)(b1_ + (int)pq_.y); p0c = __uint_as_float(rt_.z); p1c = __uint_as_float(rt_.w); \
        _Pragma("unroll") for (int jj = 0; jj < 2; ++jj) { dx[jj] = __builtin_nontemporal_load((const u32x4*)(X16 + (size_t)(row_) * D + 512 * jj + c0)); dy0[jj] = __builtin_nontemporal_load((const u32x4*)(YM + s0_ * D + 512 * jj + c0)); dy1[jj] = __builtin_nontemporal_load((const u32x4*)(YM + s1_ * D + 512 * jj + c0)); } }
    if (F.gw < T) { u32x4 rt0; u32x2 pq0; FIN_ROUTE(F.gw, rt0, pq0) FIN_DATA(F.gw, rt0, pq0) }
    if (F.gw + F.ngw < T) FIN_ROUTE(F.gw + F.ngw, rt_n, pq_n)
    for (int row = F.gw; row < T; row += F.ngw) {
        const int b = row / SEQ;
        if (b != cur_b) { cur_b = b; const float* gt2 = MOD + ((size_t)(1 * 2 + 1) * 2 + b) * 3072 + 2048;
#pragma unroll
            for (int j = 0; j < 4; ++j) gt[j] = *(const f32x4*)(gt2 + 512 * (j >> 1) + c0 + 4 * (j & 1)); }
        f32x4 v[4]; float ss = 0.f; const float p0 = p0c, p1 = p1c;
#pragma unroll
        for (int jj = 0; jj < 2; ++jj) {
            const unsigned xw[4] = {dx[jj].x, dx[jj].y, dx[jj].z, dx[jj].w}, y0w[4] = {dy0[jj].x, dy0[jj].y, dy0[jj].z, dy0[jj].w}, y1w[4] = {dy1[jj].x, dy1[jj].y, dy1[jj].z, dy1[jj].w};
#pragma unroll
            for (int hf = 0; hf < 2; ++hf) {
                f32x4 f, xo;
                f.x = p0 * bf2f(y0w[2 * hf] & 0xffffu) + p1 * bf2f(y1w[2 * hf] & 0xffffu); f.y = p0 * bf2f(y0w[2 * hf] >> 16) + p1 * bf2f(y1w[2 * hf] >> 16);
                f.z = p0 * bf2f(y0w[2 * hf + 1] & 0xffffu) + p1 * bf2f(y1w[2 * hf + 1] & 0xffffu); f.w = p0 * bf2f(y0w[2 * hf + 1] >> 16) + p1 * bf2f(y1w[2 * hf + 1] >> 16);
                xo.x = bf2f(xw[2 * hf] & 0xffffu); xo.y = bf2f(xw[2 * hf] >> 16); xo.z = bf2f(xw[2 * hf + 1] & 0xffffu); xo.w = bf2f(xw[2 * hf + 1] >> 16);
                const f32x4 vv = xo + gt[2 * jj + hf] * f; v[2 * jj + hf] = vv;
                ss += (vv.x * vv.x + vv.y * vv.y) + (vv.z * vv.z + vv.w * vv.w);
            }
        }
        if (row + F.ngw < T) { FIN_DATA(row + F.ngw, rt_n, pq_n) }
        if (row + 2 * F.ngw < T) FIN_ROUTE(row + 2 * F.ngw, rt_n, pq_n)
        const float rstd = rsqrtf(wave_sum(ss) * (1.0f / D) + EPS);
        float* op = a.out + (size_t)row * D + c0;
#pragma unroll
        for (int j = 0; j < 4; ++j) __builtin_nontemporal_store((v[j] * rstd) * fg[j], (f32x4*)(op + 512 * (j >> 1) + 4 * (j & 1)));
    }
#undef FIN_ROUTE
#undef FIN_DATA
}


namespace pg8 {
typedef short bf16x8 __attribute__((ext_vector_type(8)));
constexpr int BM = 256, BK = 64, HALF = 128, HTB = HALF * BK * 2, STAGE_BYTES = 8 * HTB;
__device__ __forceinline__ int lds_byte(int r, int c) { const int st = (r >> 4) * 2 + (c >> 5), rr = r & 15, cc = c & 31, ob = rr * 64 + cc * 2; return st * 1024 + (ob ^ (((ob >> 9) & 1) << 5)); }
__device__ __forceinline__ void stage_rc(int b, int& R, int& C) { const int st = b / 1024, sb = b % 1024, swz = sb ^ (((sb >> 9) & 1) << 5); R = (st >> 1) * 16 + swz / 64; C = (st & 1) * 32 + (swz % 64) / 2; }
__device__ __forceinline__ int perm32(int rho) { const int n = rho >> 4, i = rho & 15; return 8 * (i >> 2) + 4 * n + (i & 3); }
struct Unit { int pm, pn, ord; };
struct Gemm { const bf16_t* A; const bf16_t* Bt; int K; };
constexpr int NXCD = 8, WGM = 8;
struct StaticOrder {
    int nM, nN, nwg, G, c;
    __device__ void init(int M, int N, int G_, int c_) { nM = M / BM; nN = N / BM; nwg = nM * nN; G = G_; c = c_; }
    __device__ __forceinline__ bool next(int i, Unit& u) const {
        const long L = (long)i * G + c; if (L >= nwg) return false;
        int wgid = (int)L; { const int q = nwg / NXCD, r = nwg % NXCD, xcd = wgid % NXCD, off = wgid / NXCD; wgid = (xcd < r ? xcd * (q + 1) : r * (q + 1) + (xcd - r) * q) + off; }
        const int nig = WGM * nN, gid = wgid / nig, fm = gid * WGM, gsz = (nM - fm) < WGM ? (nM - fm) : WGM;
        u.pm = fm + ((wgid % nig) % gsz); u.pn = (wgid % nig) / gsz; return true;
    }
};
template <int NT> struct MoeOrder {
    int bt[9]; int cnt[8]; int G, c;
    __device__ __forceinline__ bool next(int i, Unit& u) const {
        int q, tn;
        if ((G & 7) == 0) { const int x = c & 7, Ll = i * (G >> 3) + (c >> 3); q = (Ll / NT) * 8 + x; tn = Ll % NT; if (q >= bt[8]) return false; }
        else { const int L = i * G + c; if (L >= bt[8] * NT) return false; q = L / NT; tn = L % NT; }
        int e = 0;
#pragma unroll
        for (int k = 1; k < 8; ++k) e += (q >= bt[k]) ? 1 : 0;
        u.pm = q; u.pn = e * NT + tn; return true;
    }
};
__device__ __forceinline__ unsigned cvt_pk_bf16(float lo, float hi) { unsigned r; asm volatile("v_cvt_pk_bf16_f32 %0, %1, %2" : "=v"(r) : "v"(lo), "v"(hi)); return r; }
__device__ __forceinline__ float fast_silu(float x) { return x * __builtin_amdgcn_rcpf(1.0f + __builtin_amdgcn_exp2f(x * -1.4426950408889634f)); }

struct EpiBf16 {
    static constexpr bool PERM = true, WIDE = false;
    bf16_t* O; int ldc; int nmod;
    __device__ __forceinline__ void operator()(const f32x4 (&acc)[2][2][4][2], const Unit& u, int wr, int wc, int fr, int fq) const {
        const int row0 = u.pm * BM + wr * 64 + fr, col0 = (u.pn % nmod) * BM + wc * 32 + 8 * fq;
#pragma unroll
        for (int ai = 0; ai < 2; ++ai)
#pragma unroll
            for (int m = 0; m < 4; ++m) { bf16_t* rowp = O + (size_t)(row0 + ai * HALF + m * 16) * ldc + col0;
#pragma unroll
                for (int bj = 0; bj < 2; ++bj) { const f32x4 v0 = acc[ai][bj][m][0], v1 = acc[ai][bj][m][1];
                    u32x4 w; w.x = cvt_pk_bf16(v0[0], v0[1]); w.y = cvt_pk_bf16(v0[2], v0[3]); w.z = cvt_pk_bf16(v1[0], v1[1]); w.w = cvt_pk_bf16(v1[2], v1[3]);
                    *(u32x4*)(rowp + bj * HALF) = w; } }
    }
};
struct EpiSwiGLU {
    static constexpr bool PERM = true, WIDE = false;
    bf16_t* O; int ldc; int nmod;
    __device__ __forceinline__ void operator()(const f32x4 (&acc)[2][2][4][2], const Unit& u, int wr, int wc, int fr, int fq) const {
        const int row0 = u.pm * BM + wr * 64 + fr, col0 = (u.pn % nmod) * HALF + wc * 32 + 8 * fq;
#pragma unroll
        for (int ai = 0; ai < 2; ++ai)
#pragma unroll
            for (int m = 0; m < 4; ++m) {
                const f32x4 g0 = acc[ai][0][m][0], g1 = acc[ai][0][m][1], u0 = acc[ai][1][m][0], u1 = acc[ai][1][m][1];
                u32x4 w;
                w.x = cvt_pk_bf16(fast_silu(g0[0]) * u0[0], fast_silu(g0[1]) * u0[1]); w.y = cvt_pk_bf16(fast_silu(g0[2]) * u0[2], fast_silu(g0[3]) * u0[3]);
                w.z = cvt_pk_bf16(fast_silu(g1[0]) * u1[0], fast_silu(g1[1]) * u1[1]); w.w = cvt_pk_bf16(fast_silu(g1[2]) * u1[2], fast_silu(g1[3]) * u1[3]);
                *(u32x4*)(O + (size_t)(row0 + ai * HALF + m * 16) * ldc + col0) = w; }
    }
};
struct EpiResidF32 {
    static constexpr bool PERM = false, WIDE = false;
    const float* xin; float* xout; const float* gate;
    __device__ __forceinline__ void operator()(const f32x4 (&acc)[2][2][4][2], const Unit& u, int wr, int wc, int fr, int fq) const {
        const int row0 = u.pm * BM + wr * 64 + fr, col0 = u.pn * BM + wc * 32 + 4 * fq;
        const float* gp = gate + (size_t)((u.pm * BM) / SEQ) * 3072 + col0;
#pragma unroll
        for (int bj = 0; bj < 2; ++bj)
#pragma unroll
            for (int n = 0; n < 2; ++n) { const f32x4 g4 = *(const f32x4*)(gp + bj * HALF + n * 16);
#pragma unroll
                for (int ai = 0; ai < 2; ++ai)
#pragma unroll
                    for (int m = 0; m < 4; ++m) { const size_t off = (size_t)(row0 + ai * HALF + m * 16) * D + col0 + bj * HALF + n * 16;
                        const f32x4 x4 = *(const f32x4*)(xin + off); *(f32x4*)(xout + off) = x4 + g4 * acc[ai][bj][m][n]; } }
    }
};


__device__ __forceinline__ u32x4 xchg8(u32x4 v) { u32x4 r;
    r.x = (unsigned)__builtin_amdgcn_update_dpp(0, (int)v.x, 0x128, 0xf, 0xf, false); r.y = (unsigned)__builtin_amdgcn_update_dpp(0, (int)v.y, 0x128, 0xf, 0xf, false);
    r.z = (unsigned)__builtin_amdgcn_update_dpp(0, (int)v.z, 0x128, 0xf, 0xf, false); r.w = (unsigned)__builtin_amdgcn_update_dpp(0, (int)v.w, 0x128, 0xf, 0xf, false); return r; }
__device__ __forceinline__ u32x4 pack8(f32x4 v0, f32x4 v1) { u32x4 w; w.x = cvt_pk_bf16(v0[0], v0[1]); w.y = cvt_pk_bf16(v0[2], v0[3]); w.z = cvt_pk_bf16(v1[0], v1[1]); w.w = cvt_pk_bf16(v1[2], v1[3]); return w; }
template <bool NT = true> __device__ __forceinline__ void store_wide(bf16_t* p, int ld, int fr, int fq, u32x4 pk0, u32x4 pk1) {
    const bool lo = fr < 8; const u32x4 rcv = xchg8(lo ? pk1 : pk0);
    bf16_t* q = p + (size_t)(fr & 7) * ld + 8 * fq + (lo ? 0 : 32);
    if constexpr (NT) { __builtin_nontemporal_store(lo ? pk0 : rcv, (u32x4*)q); __builtin_nontemporal_store(lo ? rcv : pk1, (u32x4*)(q + (size_t)8 * ld)); }
    else { *(u32x4*)q = lo ? pk0 : rcv; *(u32x4*)(q + (size_t)8 * ld) = lo ? rcv : pk1; }
}
struct EpiBf16W {
    static constexpr bool PERM = true, WIDE = true;
    bf16_t* O; int ldc; int nmod;
    __device__ __forceinline__ void operator()(const f32x4 (&acc)[2][2][4][2], const Unit& u, int wr, int wc, int fr, int fq) const {
        bf16_t* base = O + (size_t)(u.pm * BM + wr * 64) * ldc + (u.pn % nmod) * BM + wc * 64;
#pragma unroll
        for (int ai = 0; ai < 2; ++ai)
#pragma unroll
            for (int m = 0; m < 4; ++m) store_wide(base + (size_t)(ai * HALF + m * 16) * ldc, ldc, fr, fq, pack8(acc[ai][0][m][0], acc[ai][0][m][1]), pack8(acc[ai][1][m][0], acc[ai][1][m][1]));
    }
};
struct EpiResidNorm {
    static constexpr bool PERM = true, WIDE = true;
    const bf16_t* xin; bf16_t* x16; const float* gate; const float* av; bf16_t* xa; float* ssqp;
    __device__ __forceinline__ void operator()(const f32x4 (&acc)[2][2][4][2], const Unit& u, int wr, int wc, int fr, int fq) const {
        const int rowb = u.pm * BM + wr * 64, colw = u.pn * BM + wc * 64, b = (u.pm * BM) / SEQ;
        const bool lo = fr < 8;
        const size_t lane_off = (size_t)(fr & 7) * D + colw + 8 * fq + (lo ? 0 : 32);
        f32x4 gv[2][2], avv[2][2];
#pragma unroll
        for (int bj = 0; bj < 2; ++bj)
#pragma unroll
            for (int n = 0; n < 2; ++n) { gv[bj][n] = *(const f32x4*)(gate + (size_t)b * 3072 + colw + 32 * bj + 8 * fq + 4 * n); avv[bj][n] = *(const f32x4*)(av + (size_t)b * 1024 + colw + 32 * bj + 8 * fq + 4 * n); }
        u32x4 la[4][2], lb[4][2];
#define ERN_LOAD(k_) { _Pragma("unroll") for (int mm = 0; mm < 2; ++mm) { const bf16_t* q = xin + (size_t)(rowb + ((k_) >> 1) * HALF + (2 * ((k_) & 1) + mm) * 16) * D + lane_off; la[k_][mm] = __builtin_nontemporal_load((const u32x4*)q); lb[k_][mm] = __builtin_nontemporal_load((const u32x4*)(q + (size_t)8 * D)); } }
        ERN_LOAD(0)
#pragma unroll
        for (int k = 0; k < 4; ++k) {
            const int ai = k >> 1;
            if (k == 0) ERN_LOAD(1) else if (k == 1) ERN_LOAD(2) else if (k == 2) ERN_LOAD(3)
            asm volatile("" ::: "memory");
#pragma unroll
            for (int mm = 0; mm < 2; ++mm) {
                const int m = 2 * (k & 1) + mm;
                const u32x4 rcv = xchg8(lo ? lb[k][mm] : la[k][mm]);
                const u32x4 xb0 = lo ? la[k][mm] : rcv, xb1 = lo ? rcv : lb[k][mm];
                f32x4 x00, x01, x10, x11;
                x00.x = __uint_as_float(xb0.x << 16); x00.y = __uint_as_float(xb0.x & 0xffff0000u); x00.z = __uint_as_float(xb0.y << 16); x00.w = __uint_as_float(xb0.y & 0xffff0000u);
                x01.x = __uint_as_float(xb0.z << 16); x01.y = __uint_as_float(xb0.z & 0xffff0000u); x01.z = __uint_as_float(xb0.w << 16); x01.w = __uint_as_float(xb0.w & 0xffff0000u);
                x10.x = __uint_as_float(xb1.x << 16); x10.y = __uint_as_float(xb1.x & 0xffff0000u); x10.z = __uint_as_float(xb1.y << 16); x10.w = __uint_as_float(xb1.y & 0xffff0000u);
                x11.x = __uint_as_float(xb1.z << 16); x11.y = __uint_as_float(xb1.z & 0xffff0000u); x11.z = __uint_as_float(xb1.w << 16); x11.w = __uint_as_float(xb1.w & 0xffff0000u);
                const f32x4 n00 = x00 + gv[0][0] * acc[ai][0][m][0], n01 = x01 + gv[0][1] * acc[ai][0][m][1], n10 = x10 + gv[1][0] * acc[ai][1][m][0], n11 = x11 + gv[1][1] * acc[ai][1][m][1];
                float sv = (((n00.x * n00.x + n00.y * n00.y) + (n00.z * n00.z + n00.w * n00.w)) + ((n01.x * n01.x + n01.y * n01.y) + (n01.z * n01.z + n01.w * n01.w)))
                         + (((n10.x * n10.x + n10.y * n10.y) + (n10.z * n10.z + n10.w * n10.w)) + ((n11.x * n11.x + n11.y * n11.y) + (n11.z * n11.z + n11.w * n11.w)));
                const size_t ro = (size_t)(rowb + ai * HALF + m * 16) * D + colw;
                store_wide<false>(x16 + ro, D, fr, fq, pack8(n00, n01), pack8(n10, n11));
                store_wide<false>(xa + ro, D, fr, fq, pack8(n00 * avv[0][0], n01 * avv[0][1]), pack8(n10 * avv[1][0], n11 * avv[1][1]));
                sv = xor32_sum(xor16_sum(sv));
                if (fq == 0) ssqp[(size_t)(rowb + ai * HALF + m * 16 + fr) * 16 + u.pn * 4 + wc] = sv;
            }
        }
#undef ERN_LOAD
    }
};
struct EpiProjNorm {
    static constexpr bool PERM = true, WIDE = true;
    bf16_t* O; const LAS float* RS; const float* cv; float* BG; const float* a_log; const float* dt_bias;
    __device__ __forceinline__ void operator()(const f32x4 (&acc)[2][2][4][2], const Unit& u, int wr, int wc, int fr, int fq) const {
        const int rl0 = wr * 64 + fr, colw = u.pn * BM + wc * 64, b = (u.pm * BM) / SEQ;
        const float* cp = cv + (size_t)b * NPW + colw + 8 * fq;
        if (u.pn < NP / BM) {
            f32x4 c4[2][2];
#pragma unroll
            for (int bj = 0; bj < 2; ++bj)
#pragma unroll
                for (int n = 0; n < 2; ++n) c4[bj][n] = *(const f32x4*)(cp + 32 * bj + 4 * n);
            bf16_t* base = O + (size_t)(u.pm * BM + wr * 64) * NP + colw;
#pragma unroll
            for (int ai = 0; ai < 2; ++ai)
#pragma unroll
                for (int m = 0; m < 4; ++m) { const float rs = fabsf(RS[u.ord * 256 + rl0 + ai * HALF + m * 16]);
                    store_wide(base + (size_t)(ai * HALF + m * 16) * NP, NP, fr, fq, pack8(acc[ai][0][m][0] * rs + c4[0][0], acc[ai][0][m][1] * rs + c4[0][1]), pack8(acc[ai][1][m][0] * rs + c4[1][0], acc[ai][1][m][1] * rs + c4[1][1])); }
        } else if (wc == 0 && fq == 0) {
            const f32x4 c0 = *(const f32x4*)(cp), c1 = *(const f32x4*)(cp + 4);
            const f32x4 al = *(const f32x4*)a_log, db = *(const f32x4*)dt_bias;
#pragma unroll
            for (int ai = 0; ai < 2; ++ai)
#pragma unroll
                for (int m = 0; m < 4; ++m) { const int rl = rl0 + ai * HALF + m * 16; const float rs = fabsf(RS[u.ord * 256 + rl]);
                    const f32x4 vb = acc[ai][0][m][0] * rs + c0, va = acc[ai][0][m][1] * rs + c1;
                    f32x4 be, gg;
#pragma unroll
                    for (int hh = 0; hh < 4; ++hh) { be[hh] = sigmoidf_(vb[hh]); gg[hh] = -__expf(al[hh]) * softplusf_(va[hh] + db[hh]); }
                    float* bg = BG + (size_t)(u.pm * BM + rl) * 8; *(f32x4*)bg = be; *(f32x4*)(bg + 4) = gg; }
        }
    }
};
struct EpiNull {
    static constexpr bool PERM = true, WIDE = false;
    __device__ __forceinline__ void operator()(const f32x4 (&acc)[2][2][4][2], const Unit& u, int wr, int wc, int fr, int fq) const {
#pragma unroll
        for (int ai = 0; ai < 2; ++ai)
#pragma unroll
            for (int bj = 0; bj < 2; ++bj)
#pragma unroll
                for (int m = 0; m < 4; ++m)
#pragma unroll
                    for (int n = 0; n < 2; ++n) asm volatile("" :: "v"(acc[ai][bj][m][n]));
    }
};
struct EpiSwiGLUNorm {
    static constexpr bool PERM = true, WIDE = false;
    bf16_t* O; int ldc; int nmod; const LAS float* RS; const float* cv; int ncv;
    __device__ __forceinline__ void operator()(const f32x4 (&acc)[2][2][4][2], const Unit& u, int wr, int wc, int fr, int fq) const {
        const int rl0 = wr * 64 + fr, col0 = (u.pn % nmod) * HALF + wc * 32 + 8 * fq;
        const float* cp = cv + (size_t)u.pn * BM + wc * 32 + 8 * fq;
        f32x4 cg[2][2], cu[2][2];
#pragma unroll
        for (int bb = 0; bb < 2; ++bb)
#pragma unroll
            for (int n = 0; n < 2; ++n) { cg[bb][n] = *(const f32x4*)(cp + (size_t)bb * ncv + 4 * n); cu[bb][n] = *(const f32x4*)(cp + (size_t)bb * ncv + HALF + 4 * n); }
#pragma unroll
        for (int ai = 0; ai < 2; ++ai)
#pragma unroll
            for (int m = 0; m < 4; ++m) { const int rl = rl0 + ai * HALF + m * 16; const float rsv = RS[u.ord * 256 + rl], rs = fabsf(rsv); const bool b1 = rsv < 0.f;
                const f32x4 g0 = acc[ai][0][m][0] * rs + (b1 ? cg[1][0] : cg[0][0]), g1 = acc[ai][0][m][1] * rs + (b1 ? cg[1][1] : cg[0][1]);
                const f32x4 u0 = acc[ai][1][m][0] * rs + (b1 ? cu[1][0] : cu[0][0]), u1 = acc[ai][1][m][1] * rs + (b1 ? cu[1][1] : cu[0][1]);
                u32x4 w;
                w.x = cvt_pk_bf16(fast_silu(g0[0]) * u0[0], fast_silu(g0[1]) * u0[1]); w.y = cvt_pk_bf16(fast_silu(g0[2]) * u0[2], fast_silu(g0[3]) * u0[3]);
                w.z = cvt_pk_bf16(fast_silu(g1[0]) * u1[0], fast_silu(g1[1]) * u1[1]); w.w = cvt_pk_bf16(fast_silu(g1[2]) * u1[2], fast_silu(g1[3]) * u1[3]);
                __builtin_nontemporal_store(w, (u32x4*)(O + (size_t)(u.pm * BM + rl) * ldc + col0)); }
    }
};

template <class Epi, class Sched, bool GATHER, bool ALIGN_EPI, bool SP2>
__device__ __forceinline__ void gemm_phase(LAS unsigned char* lds, const LAS int* RI, const Gemm g, const Sched& S, const Epi& E) {
    const int tid = threadIdx.x, wid = __builtin_amdgcn_readfirstlane(tid >> 6), lane = tid & 63, wr = wid >> 2, wc = wid & 3, fr = lane & 15, fq = lane >> 4;
    const int K = g.K, nt = K / BK;
    unsigned voffB[2]; int Ra[2]; unsigned Ca2[2];
#pragma unroll
    for (int i = 0; i < 2; ++i) { int R, C; stage_rc(tid * 16 + i * 8192, R, C); const int Rb = Epi::WIDE ? ((R >> 5) * 64 + perm32(R & 31)) : (Epi::PERM ? ((R & ~31) + perm32(R & 31)) : R);
        Ra[i] = R; Ca2[i] = (unsigned)C * 2u; voffB[i] = (unsigned)(Rb * K + C) * 2u; }
    const size_t kstep = (size_t)(BK * 2);
    const size_t hstep = (size_t)HALF * K * 2;
    const size_t tstep = 2 * hstep;
    const size_t hstepB = Epi::WIDE ? (size_t)32 * K * 2 : hstep;
    const unsigned rowb = (unsigned)K * 2u;
    const unsigned ldsw = (unsigned)wid * 1024u;
    const int aoff = lds_byte(wr * 64 + fr, fq * 8), boff = lds_byte(wc * 32 + fr, fq * 8);
#define PG8_SA(b, h) (((b) * 2 + (h)) * HTB)
#define PG8_SB(b, h) ((4 + (b) * 2 + (h)) * HTB)
#define PG8_STAGE_B(bufoff, gbase) do { _Pragma("unroll") for (int _i = 0; _i < 2; ++_i) \
        __builtin_amdgcn_global_load_lds((const unsigned*)((const char*)(gbase) + voffB[_i]), (LAS unsigned*)(lds + (bufoff) + ldsw + _i * 8192), 16, 0, 0); } while (0)
#define PG8_STAGE_A(bufoff, kb, off) do { _Pragma("unroll") for (int _i = 0; _i < 2; ++_i) \
        __builtin_amdgcn_global_load_lds((const unsigned*)((const char*)g.A + (size_t)(kb) + (off)[_i]), (LAS unsigned*)(lds + (bufoff) + ldsw + _i * 8192), 16, 0, 0); } while (0)
#define PG8_LDA(dst, b, h) do { _Pragma("unroll") for (int m = 0; m < 4; ++m) _Pragma("unroll") for (int k = 0; k < 2; ++k) dst[m][k] = *(const LAS bf16x8*)(lds + PG8_SA(b, h) + aoff + m * 2048 + k * 1024); } while (0)
#define PG8_LDB(dst, b, h) do { _Pragma("unroll") for (int n = 0; n < 2; ++n) _Pragma("unroll") for (int k = 0; k < 2; ++k) dst[n][k] = *(const LAS bf16x8*)(lds + PG8_SB(b, h) + boff + n * 2048 + k * 1024); } while (0)
#define PG8_MMA(ai, bj, At, Bt) do { __builtin_amdgcn_s_setprio(1); _Pragma("unroll") for (int m = 0; m < 4; ++m) _Pragma("unroll") for (int n = 0; n < 2; ++n) _Pragma("unroll") for (int k = 0; k < 2; ++k) \
        acc[ai][bj][m][n] = __builtin_amdgcn_mfma_f32_16x16x32_bf16(Bt[n][k], At[m][k], acc[ai][bj][m][n], 0, 0, 0); __builtin_amdgcn_s_setprio(0); } while (0)
#define PG8_WAIT_V(n) asm volatile("s_waitcnt vmcnt(" #n ")" ::: "memory")
#define PG8_WAIT_L(n) asm volatile("s_waitcnt lgkmcnt(" #n ")" ::: "memory")
#define PG8_BAR __builtin_amdgcn_s_barrier()
#define PG8_SCHED __builtin_amdgcn_sched_barrier(0)
#define PG8_AOFFS(dst, ui_, un_) do { _Pragma("unroll") for (int _h = 0; _h < 2; ++_h) _Pragma("unroll") for (int _i = 0; _i < 2; ++_i) { \
        const unsigned _row = GATHER ? (unsigned)RI[(ui_) * 256 + _h * HALF + Ra[_i]] : (unsigned)((un_).pm * BM + _h * HALF + Ra[_i]); dst[_h][_i] = _row * rowb + Ca2[_i]; } } while (0)
    Unit cur, nxt; int ui = 0;
    if (!S.next(0, cur)) return;
    cur.ord = 0;
    f32x4 acc[2][2][4][2];
#pragma unroll
    for (int a = 0; a < 2; ++a)
#pragma unroll
        for (int b = 0; b < 2; ++b)
#pragma unroll
            for (int m = 0; m < 4; ++m)
#pragma unroll
                for (int n = 0; n < 2; ++n) acc[a][b][m][n] = (f32x4){0.f, 0.f, 0.f, 0.f};
    bf16x8 At[4][2], B0[2][2], B1[2][2];
    unsigned cv[2][2], nv[2][2];
    PG8_AOFFS(cv, 0, cur);
    const char* cB = (const char*)g.Bt + (size_t)cur.pn * tstep;
    if constexpr (SP2) {
        PG8_STAGE_B(PG8_SB(0, 0), cB); PG8_STAGE_B(PG8_SB(0, 1), cB + hstepB); PG8_STAGE_A(PG8_SA(0, 0), 0, cv[0]); PG8_STAGE_A(PG8_SA(0, 1), 0, cv[1]);
        if (wr == 1) PG8_BAR;
        PG8_WAIT_V(2); PG8_BAR;
        PG8_STAGE_B(PG8_SB(1, 0), cB + kstep); PG8_STAGE_A(PG8_SA(1, 0), kstep, cv[0]); PG8_STAGE_B(PG8_SB(1, 1), cB + hstepB + kstep);
        PG8_WAIT_V(6); PG8_BAR;
    } else {
        PG8_STAGE_B(PG8_SB(0, 0), cB); PG8_STAGE_A(PG8_SA(0, 0), 0, cv[0]); PG8_STAGE_B(PG8_SB(0, 1), cB + hstepB); PG8_STAGE_A(PG8_SA(0, 1), 0, cv[1]);
        if (wr == 1) PG8_BAR;
        PG8_WAIT_V(4); PG8_BAR;
        PG8_STAGE_B(PG8_SB(1, 0), cB + kstep); PG8_STAGE_A(PG8_SA(1, 0), kstep, cv[0]); PG8_STAGE_B(PG8_SB(1, 1), cB + hstepB + kstep);
        PG8_WAIT_V(6); PG8_BAR;
    }
    for (;;) {
        const bool has_next = S.next(ui + 1, nxt); nxt.ord = ui + 1;
        const char* nB = has_next ? (const char*)g.Bt + (size_t)nxt.pn * tstep : cB;
        if (has_next) { PG8_AOFFS(nv, ui + 1, nxt); }
        else {
#pragma unroll
            for (int h = 0; h < 2; ++h)
#pragma unroll
                for (int i = 0; i < 2; ++i) nv[h][i] = cv[h][i]; }
        for (int t = 0; t < nt; t += 2) {
            const bool last = (t == nt - 2);
            const size_t kb1 = (size_t)(t + 1) * kstep, kb2 = last ? (size_t)0 : (size_t)(t + 2) * kstep, kb3 = kb2 + kstep;
            const char* b2 = last ? nB : cB + (size_t)(t + 2) * kstep; const char* b3 = b2 + kstep;
            unsigned o2[2][2];
#pragma unroll
            for (int h = 0; h < 2; ++h)
#pragma unroll
                for (int i = 0; i < 2; ++i) o2[h][i] = last ? nv[h][i] : cv[h][i];
            if constexpr (SP2) {
            PG8_LDB(B0, 0, 0); PG8_LDB(B1, 0, 1); PG8_SCHED; PG8_LDA(At, 0, 0); PG8_STAGE_A(PG8_SA(1, 1), kb1, cv[1]);
            PG8_WAIT_V(8); PG8_WAIT_L(0); PG8_BAR; PG8_MMA(0, 0, At, B0); PG8_MMA(0, 1, At, B1); PG8_BAR; PG8_SCHED;
            PG8_LDA(At, 0, 1); PG8_STAGE_B(PG8_SB(0, 0), b2); PG8_STAGE_B(PG8_SB(0, 1), b2 + hstepB); PG8_STAGE_A(PG8_SA(0, 0), kb2, o2[0]);
            PG8_WAIT_V(8); PG8_WAIT_L(0); PG8_BAR; PG8_MMA(1, 0, At, B0); PG8_MMA(1, 1, At, B1); PG8_BAR; PG8_SCHED;
            PG8_LDB(B0, 1, 0); PG8_LDB(B1, 1, 1); PG8_SCHED; PG8_LDA(At, 1, 0); PG8_STAGE_A(PG8_SA(0, 1), kb2, o2[1]);
            PG8_WAIT_V(8); PG8_WAIT_L(0); PG8_BAR; PG8_MMA(0, 0, At, B0); PG8_MMA(0, 1, At, B1); PG8_BAR; PG8_SCHED;
            PG8_LDA(At, 1, 1); PG8_STAGE_B(PG8_SB(1, 0), b3); PG8_STAGE_B(PG8_SB(1, 1), b3 + hstepB); PG8_STAGE_A(PG8_SA(1, 0), kb3, o2[0]);
            PG8_WAIT_V(8); PG8_WAIT_L(0); PG8_BAR; PG8_MMA(1, 0, At, B0); PG8_MMA(1, 1, At, B1); PG8_BAR; PG8_SCHED;
            } else {
            PG8_LDB(B0, 0, 0); PG8_SCHED; PG8_LDA(At, 0, 0); PG8_STAGE_A(PG8_SA(1, 1), kb1, cv[1]);
            PG8_WAIT_L(8); PG8_BAR; PG8_WAIT_L(0); PG8_MMA(0, 0, At, B0); PG8_BAR; PG8_SCHED;
            PG8_LDB(B1, 0, 1); PG8_STAGE_B(PG8_SB(0, 0), b2);
            PG8_BAR; PG8_WAIT_L(0); PG8_MMA(0, 1, At, B1); PG8_BAR;
            PG8_LDA(At, 0, 1); PG8_STAGE_A(PG8_SA(0, 0), kb2, o2[0]);
            PG8_BAR; PG8_WAIT_L(0); PG8_MMA(1, 0, At, B0); PG8_BAR; PG8_SCHED;
            PG8_STAGE_B(PG8_SB(0, 1), b2 + hstepB);
            PG8_WAIT_V(6); PG8_BAR; PG8_MMA(1, 1, At, B1); PG8_BAR;
            PG8_LDB(B0, 1, 0); PG8_SCHED; PG8_LDA(At, 1, 0); PG8_STAGE_A(PG8_SA(0, 1), kb2, o2[1]);
            PG8_WAIT_L(8); PG8_BAR; PG8_WAIT_L(0); PG8_MMA(0, 0, At, B0); PG8_BAR; PG8_SCHED;
            PG8_LDB(B1, 1, 1); PG8_STAGE_B(PG8_SB(1, 0), b3);
            PG8_BAR; PG8_WAIT_L(0); PG8_MMA(0, 1, At, B1); PG8_BAR;
            PG8_LDA(At, 1, 1); PG8_STAGE_A(PG8_SA(1, 0), kb3, o2[0]);
            PG8_BAR; PG8_WAIT_L(0); PG8_MMA(1, 0, At, B0); PG8_BAR; PG8_SCHED;
            PG8_STAGE_B(PG8_SB(1, 1), b3 + hstepB);
            PG8_WAIT_V(6); PG8_BAR; PG8_MMA(1, 1, At, B1); PG8_BAR;
            }
        }
        if constexpr (ALIGN_EPI) { if (wr == 0) PG8_BAR; }
        E(acc, cur, wr, wc, fr, fq);
        if (!has_next) break;
#pragma unroll
        for (int a = 0; a < 2; ++a)
#pragma unroll
            for (int b = 0; b < 2; ++b)
#pragma unroll
                for (int m = 0; m < 4; ++m)
#pragma unroll
                    for (int n = 0; n < 2; ++n) acc[a][b][m][n] = (f32x4){0.f, 0.f, 0.f, 0.f};
        cur = nxt; cB = nB; ++ui;
#pragma unroll
        for (int h = 0; h < 2; ++h)
#pragma unroll
            for (int i = 0; i < 2; ++i) cv[h][i] = nv[h][i];
        if constexpr (ALIGN_EPI) { if (wr == 1) PG8_BAR; }
    }
    PG8_WAIT_V(0);
    if constexpr (!ALIGN_EPI) { if (wr == 0) PG8_BAR; }
    PG8_BAR;
#undef PG8_SA
#undef PG8_SB
#undef PG8_STAGE_A
#undef PG8_STAGE_B
#undef PG8_LDA
#undef PG8_LDB
#undef PG8_MMA
#undef PG8_WAIT_V
#undef PG8_WAIT_L
#undef PG8_BAR
#undef PG8_SCHED
#undef PG8_AOFFS
}
}

__device__ __forceinline__ void transpose_item(const float* W, int pitch, int k0, int n0, bf16_t* WT, int Kd, int drow0, LAS float* scr, int lane) {
#pragma unroll 8
    for (int i = 0; i < 32; ++i) { const int kk = 2 * i + (lane >> 5); scr[kk * 33 + (lane & 31)] = __builtin_nontemporal_load(W + (size_t)(k0 + kk) * pitch + n0 + (lane & 31)); }
    asm volatile("s_waitcnt lgkmcnt(0)" ::: "memory");
    const int c = lane & 7;
#pragma unroll
    for (int j = 0; j < 4; ++j) { const int n = (lane >> 3) + 8 * j; const LAS float* s = scr + (8 * c) * 33 + n;
        u32x4 o; o.x = pk2(s[0 * 33], s[1 * 33]); o.y = pk2(s[2 * 33], s[3 * 33]); o.z = pk2(s[4 * 33], s[5 * 33]); o.w = pk2(s[6 * 33], s[7 * 33]);
        *(u32x4*)(WT + (size_t)(drow0 + n) * Kd + k0 + 8 * c) = o; }
    asm volatile("s_waitcnt lgkmcnt(0)" ::: "memory");
}
constexpr size_t WT_WIN = 0, WT_WOUT = WT_WIN + (size_t)2 * NPW * D, WT_FGU = WT_WOUT + (size_t)2 * D * D, WT_FD = WT_FGU + (size_t)2 * D_FF * D,
                 WT_MGU = WT_FD + (size_t)D * D_FF, WT_MD = WT_MGU + (size_t)NE * 2 * D_FFE * D, WT_END = WT_MD + (size_t)NE * D * D_FFE;
static_assert(WT_END * 2 <= 80 * MiB, "weight copies fit");
__device__ __forceinline__ void ph_pro_weights(const Args& a, Frame& F) {
    LAS float* scr = (LAS float*)(F.lds + F.wave * 16384);
    bf16_t* WT = (bf16_t*)(F.ws + WS_WT);
    constexpr int I_IN0 = 16 * 48, I_IN1 = 16 * 24, I_OUT = 16 * 32, I_FG = 16 * 88, I_FD = 44 * 32, I_M = 16 * 32;
    constexpr int NITEMS = 2 * (I_IN0 + I_IN1 + I_OUT) + 2 * I_FG + I_FD + 24 * I_M;
    for (int it = F.gw; it < NITEMS; it += F.ngw) {
        int r = it; const float* src; int pitch, k0, n0, Kd, drow0; bf16_t* dst;
        if (r < 2 * I_IN0) { const int l = r / I_IN0; r %= I_IN0; src = a.w_in + (size_t)l * D * N_IN; pitch = N_IN; k0 = (r / 48) * 64; n0 = (r % 48) * 32; dst = WT + WT_WIN + (size_t)l * NPW * D; Kd = D; drow0 = n0; }
        else if ((r -= 2 * I_IN0) < 2 * I_IN1) { const int l = r / I_IN1; r %= I_IN1; src = a.w_in + (size_t)l * D * N_IN + 1544; pitch = N_IN; k0 = (r / 24) * 64; n0 = (r % 24) * 32; dst = WT + WT_WIN + (size_t)l * NPW * D; Kd = D; drow0 = 1536 + n0; }
        else if ((r -= 2 * I_IN1) < 2 * I_OUT) { const int l = r / I_OUT; r %= I_OUT; src = a.w_out + (size_t)l * D * D; pitch = D; k0 = (r / 32) * 64; n0 = (r % 32) * 32; dst = WT + WT_WOUT + (size_t)l * D * D; Kd = D; drow0 = n0; }
        else if ((r -= 2 * I_OUT) < 2 * I_FG) { const int up = r / I_FG; r %= I_FG; src = up ? a.ffn_wu : a.ffn_wg; pitch = D_FF; k0 = (r / 88) * 64; n0 = (r % 88) * 32; dst = WT + WT_FGU; Kd = D; drow0 = (n0 / 128) * 256 + up * 128 + (n0 % 128); }
        else if ((r -= 2 * I_FG) < I_FD) { src = a.ffn_wd; pitch = D; k0 = (r / 32) * 64; n0 = (r % 32) * 32; dst = WT + WT_FD; Kd = D_FF; drow0 = n0; }
        else if ((r -= I_FD) < 16 * I_M) { const int e = r / (2 * I_M); r %= 2 * I_M; const int up = r / I_M; r %= I_M; src = (up ? a.moe_wu : a.moe_wg) + (size_t)e * D * D_FFE; pitch = D_FFE; k0 = (r / 32) * 64; n0 = (r % 32) * 32;
            dst = WT + WT_MGU + (size_t)e * 2 * D_FFE * D; Kd = D; drow0 = (n0 / 128) * 256 + up * 128 + (n0 % 128); }
        else { r -= 16 * I_M; const int e = r / I_M; r %= I_M; src = a.moe_wd + (size_t)e * D_FFE * D; pitch = D; k0 = (r / 32) * 64; n0 = (r % 32) * 32; dst = WT + WT_MD + (size_t)e * D * D_FFE; Kd = D_FFE; drow0 = n0; }
        transpose_item(src, pitch, k0, n0, dst, Kd, drow0, scr, F.lane);
    }
    for (int idx = F.bid * NTHREADS + F.tid; idx < 2 * 256 * D; idx += F.nb * NTHREADS) {
        const int l = idx / (256 * D), r = (idx / D) % 256, k = idx % D;
        WT[WT_WIN + (size_t)l * NPW * D + (size_t)(2304 + r) * D + k] = (r < 8) ? (bf16_t)f2bf(a.w_in[(size_t)l * D * N_IN + (size_t)k * N_IN + W_DB + r]) : (bf16_t)0;
    }
}

template <int NT> __device__ __forceinline__ void moe_order_init(Frame& F, pg8::MoeOrder<NT>& S) {
    const unsigned* c = (const unsigned*)(F.ws + WS_CTL) + CW_MOECNT;
    int acc = 0;
#pragma unroll
    for (int e = 0; e < 8; ++e) { S.cnt[e] = (int)__hip_atomic_load(c + 64 * e, __ATOMIC_RELAXED, __HIP_MEMORY_SCOPE_AGENT); S.bt[e] = acc; acc += (S.cnt[e] + 255) >> 8; }
    S.bt[8] = acc; S.G = F.nb; S.c = F.bid;
}
template <int NT> __device__ __forceinline__ int moe_ri_one(Frame& F, const pg8::MoeOrder<NT>& S, const int* RM, int o, int t) {
    pg8::Unit u; if (!S.next(o, u)) return -1;
    const int e = u.pn / NT; int bte = 0, cne = 0;
#pragma unroll
    for (int kk = 0; kk < 8; ++kk) { if (kk == e) { bte = S.bt[kk]; cne = S.cnt[kk]; } }
    const int sl = (u.pm - bte) * 256 + t; return (sl < cne) ? RM[(size_t)e * T + sl] : 0;
}
template <int NT> __device__ __forceinline__ void moe_ri_preload(Frame& F, const pg8::MoeOrder<NT>& S) {
    LAS int* RI = (LAS int*)(F.lds + RI_OFF); const int* RM = (const int*)(F.ws + WS_RMAP);
    const int t = F.tid & 255, par = F.tid >> 8;
    const int v0 = moe_ri_one<NT>(F, S, RM, par, t), v1 = moe_ri_one<NT>(F, S, RM, par + 2, t), v2 = moe_ri_one<NT>(F, S, RM, par + 4, t), v3 = moe_ri_one<NT>(F, S, RM, par + 6, t);
    const int v4 = moe_ri_one<NT>(F, S, RM, par + 8, t), v5 = moe_ri_one<NT>(F, S, RM, par + 10, t), v6 = moe_ri_one<NT>(F, S, RM, par + 12, t), v7 = moe_ri_one<NT>(F, S, RM, par + 14, t);
    if (v0 >= 0) RI[(par) * 256 + t] = v0; if (v1 >= 0) RI[(par + 2) * 256 + t] = v1; if (v2 >= 0) RI[(par + 4) * 256 + t] = v2; if (v3 >= 0) RI[(par + 6) * 256 + t] = v3;
    if (v4 >= 0) RI[(par + 8) * 256 + t] = v4; if (v5 >= 0) RI[(par + 10) * 256 + t] = v5; if (v6 >= 0) RI[(par + 12) * 256 + t] = v6;
    if (v7 >= 0 && par + 14 < 15) RI[(par + 14) * 256 + t] = v7;
    __syncthreads();
}

__device__ __forceinline__ void ph_norm0(const Args& a, Frame& F) {
    const float* MOD = (const float*)(F.ws + WS_MOD);
    bf16_t* XA = (bf16_t*)(F.ws + WS_H); bf16_t* X16 = (bf16_t*)(F.ws + WS_X16); float* SSQ = (float*)(F.ws + WS_SSQ) + (size_t)3 * T * 16;
    f32x4 vn[4], A4[4]; int cur_b = -1;
#define N0_LOAD(row_) { const f32x4* p_ = (const f32x4*)(a.x + (size_t)(row_) * D) + 2 * F.lane; vn[0] = __builtin_nontemporal_load(p_); vn[1] = __builtin_nontemporal_load(p_ + 1); vn[2] = __builtin_nontemporal_load(p_ + 128); vn[3] = __builtin_nontemporal_load(p_ + 129); }
    if (F.gw < T) N0_LOAD(F.gw)
    for (int row = F.gw; row < T; row += F.ngw) {
        const int b = row / SEQ;
        f32x4 v[4]; float ss = 0.f;
#pragma unroll
        for (int j = 0; j < 4; ++j) { v[j] = vn[j]; ss += (v[j].x * v[j].x + v[j].y * v[j].y) + (v[j].z * v[j].z + v[j].w * v[j].w); }
        if (row + F.ngw < T) N0_LOAD(row + F.ngw)
        if (b != cur_b) { cur_b = b;
#pragma unroll
            for (int j = 0; j < 4; ++j) { const int d = 512 * (j >> 1) + 8 * F.lane + 4 * (j & 1); A4[j] = *(const f32x4*)(a.nmg + d) * (*(const f32x4*)(MOD + (size_t)b * 3072 + 1024 + d) + 1.0f); } }
#pragma unroll
        for (int jj = 0; jj < 2; ++jj) {
            const int d = 512 * jj + 8 * F.lane; const f32x4 v0 = v[2 * jj], v1 = v[2 * jj + 1], s0 = v0 * A4[2 * jj], s1 = v1 * A4[2 * jj + 1];
            u32x4 o; o.x = pk2(v0.x, v0.y); o.y = pk2(v0.z, v0.w); o.z = pk2(v1.x, v1.y); o.w = pk2(v1.z, v1.w); *(u32x4*)(X16 + (size_t)row * D + d) = o;
            u32x4 p; p.x = pk2(s0.x, s0.y); p.y = pk2(s0.z, s0.w); p.z = pk2(s1.x, s1.y); p.w = pk2(s1.z, s1.w); *(u32x4*)(XA + (size_t)row * D + d) = p;
        }
        ss = wave_sum(ss);
        if (F.lane < 16) SSQ[(size_t)row * 16 + F.lane] = (F.lane == 0) ? ss : 0.f;
    }
#undef N0_LOAD
}
__device__ __forceinline__ void ph_prep_vectors(const Args& a, Frame& F) {
    const float* MOD = (const float*)(F.ws + WS_MOD); float* AV = (float*)(F.ws + WS_AV);
    for (int idx = F.bid * NTHREADS + F.tid; idx < 3 * BATCH * D; idx += F.nb * NTHREADS) {
        const int inst = idx / (BATCH * D), b = (idx / D) % BATCH, d = idx % D;
        const int lk = (inst == 0) ? 1 : (inst == 1 ? 2 : 3);
        const float gn = (inst == 0) ? a.nfg[d] : (inst == 1 ? a.nmg[D + d] : a.nfg[D + d]);
        AV[idx] = gn * (1.0f + MOD[((size_t)lk * 2 + b) * 3072 + 1024 + d]);
    }
    const bf16_t* WT = (const bf16_t*)(F.ws + WS_WT);
    constexpr int NR = 5632 + NPW + 16384 + NPW;
    LAS float* SH = (LAS float*)F.lds;
    for (int i = F.tid; i < 4 * BATCH * D; i += NTHREADS) { const int which = i / (BATCH * D), b = (i / D) % BATCH, d = i % D; SH[i] = MOD[((size_t)((which + 1) & 3) * 2 + b) * 3072 + d]; }
    __syncthreads();
    for (int g8 = F.gw; g8 < NR / 8; g8 += F.ngw) {
        const int row = g8 * 8 + (F.lane >> 3), part = F.lane & 7;
        int which, r; const bf16_t* wrow; float* out; int ncv;
        if (row < 5632) { which = 0; r = row; wrow = WT + WT_FGU + (size_t)r * D; out = (float*)(F.ws + WS_CVF); ncv = 5632; }
        else if (row < 5632 + NPW) { which = 1; r = row - 5632; wrow = WT + WT_WIN + (size_t)NPW * D + (size_t)r * D; out = (float*)(F.ws + WS_CVI); ncv = NPW; }
        else if (row < 5632 + NPW + 16384) { which = 2; r = row - 5632 - NPW; wrow = WT + WT_MGU + (size_t)r * D; out = (float*)(F.ws + WS_CVM); ncv = 16384; }
        else { which = 3; r = row - 5632 - NPW - 16384; wrow = WT + WT_WIN + (size_t)r * D; out = (float*)(F.ws + WS_CVI0); ncv = NPW; }
        u32x4 wv[16];
#pragma unroll
        for (int j = 0; j < 16; ++j) wv[j] = *(const u32x4*)(wrow + 128 * part + 8 * j);
        const LAS float* s0p = SH + (which * 2 + 0) * 1024 + 128 * part; const LAS float* s1p = s0p + 1024;
        float s0 = 0.f, s1 = 0.f;
#pragma unroll
        for (int j = 0; j < 16; ++j) {
            const f32x4 a0 = *(const LAS f32x4*)(s0p + 8 * j), a1 = *(const LAS f32x4*)(s0p + 8 * j + 4), b0 = *(const LAS f32x4*)(s1p + 8 * j), b1 = *(const LAS f32x4*)(s1p + 8 * j + 4);
            const float x0 = bf2f(wv[j].x & 0xffffu), x1 = bf2f(wv[j].x >> 16), x2 = bf2f(wv[j].y & 0xffffu), x3 = bf2f(wv[j].y >> 16), x4 = bf2f(wv[j].z & 0xffffu), x5 = bf2f(wv[j].z >> 16), x6 = bf2f(wv[j].w & 0xffffu), x7 = bf2f(wv[j].w >> 16);
            s0 += ((x0 * a0.x + x1 * a0.y) + (x2 * a0.z + x3 * a0.w)) + ((x4 * a1.x + x5 * a1.y) + (x6 * a1.z + x7 * a1.w));
            s1 += ((x0 * b0.x + x1 * b0.y) + (x2 * b0.z + x3 * b0.w)) + ((x4 * b1.x + x5 * b1.y) + (x6 * b1.z + x7 * b1.w));
        }
        s0 += __shfl_xor(s0, 1); s0 += __shfl_xor(s0, 2); s0 += __shfl_xor(s0, 4);
        s1 += __shfl_xor(s1, 1); s1 += __shfl_xor(s1, 2); s1 += __shfl_xor(s1, 4);
        if (part == 0) { out[r] = s0; out[ncv + r] = s1; }
    }
    __syncthreads();
    if (F.gw < BATCH * 8) {
        const int b = F.gw >> 3, e = F.gw & 7; float sacc = 0.f;
        for (int d = F.lane; d < D; d += 64) sacc += MOD[((size_t)3 * 2 + b) * 3072 + d] * a.router_w[(size_t)d * NE + e];
        sacc = wave_sum(sacc);
        if (F.lane == 0) ((float*)(F.ws + WS_CR))[b * 8 + e] = sacc;
    }
}
template <class Sched> __device__ __forceinline__ int count_units(const Sched& S) { int n = 0; pg8::Unit u; while (n < 16 && S.next(n, u)) ++n; return n; }
template <class Sched> __device__ __forceinline__ void rstd_preload(Frame& F, const Sched& S, const float* ssqp, const LAS int* RI) {
    LAS float* RS = (LAS float*)(F.lds + RS_OFF);
    const int t = F.tid & 255, par = F.tid >> 8, nu = count_units(S);
#pragma unroll
    for (int k0 = 0; k0 < 8; k0 += 4) {
        f32x4 p0[4], p1[4], p2[4], p3[4]; int r0, r1, r2, r3;
#define RSP_LOAD(k, pk, rk) { const int o = par + 2 * (k0 + k); pg8::Unit u; u.pm = 0; rk = 0; if (o < nu) { S.next(o, u); rk = RI ? RI[o * 256 + t] : u.pm * 256 + t; } \
            const f32x4* q = (const f32x4*)(ssqp + (size_t)rk * 16); pk[0] = q[0]; pk[1] = q[1]; pk[2] = q[2]; pk[3] = q[3]; }
        RSP_LOAD(0, p0, r0) RSP_LOAD(1, p1, r1) RSP_LOAD(2, p2, r2) RSP_LOAD(3, p3, r3)
#undef RSP_LOAD
#define RSP_STORE(k, pk, rk) { const int o = par + 2 * (k0 + k); if (o < nu) { const f32x4 s4 = (pk[0] + pk[1]) + (pk[2] + pk[3]); \
            const float rs = rsqrtf(((s4.x + s4.y) + (s4.z + s4.w)) * (1.0f / D) + EPS); RS[o * 256 + t] = (rk >= SEQ) ? -rs : rs; } }
        RSP_STORE(0, p0, r0) RSP_STORE(1, p1, r1) RSP_STORE(2, p2, r2) RSP_STORE(3, p3, r3)
#undef RSP_STORE
    }
    __syncthreads();
}
__device__ __forceinline__ void ph_router(const Args& a, Frame& F) {
    const bf16_t* XA = (const bf16_t*)(F.ws + WS_H); const float* SSQ = (const float*)(F.ws + WS_SSQ) + (size_t)2 * T * 16; const float* CR = (const float*)(F.ws + WS_CR);
    constexpr int RW = 1032;
    LAS bf16_t* WH = (LAS bf16_t*)F.lds; LAS bf16_t* WL = WH + 16 * RW; LAS float* LG = (LAS float*)(F.lds + 2 * 16 * RW * 2) + F.wave * 256;
    for (int i = F.tid; i < 16 * 1024; i += NTHREADS) { const int e = i >> 10, d = i & 1023;
        const float w = (e < 8) ? a.router_w[(size_t)d * NE + e] : 0.f; const unsigned hi = f2bf(w); const float lo = w - bf2f(hi);
        WH[e * RW + d] = (bf16_t)hi; WL[e * RW + d] = (bf16_t)f2bf(lo); }
    __syncthreads();
    const int l15 = F.lane & 15, q4 = F.lane >> 4;
    for (int r0 = F.gw * 16; r0 < T; r0 += F.ngw * 16) {
        const bf16_t* xrow = XA + (size_t)(r0 + l15) * D + 8 * q4;
        f32x4 acc = (f32x4){0.f, 0.f, 0.f, 0.f};
#pragma unroll
        for (int kb = 0; kb < 32; kb += 8) {
            bf16x8_t av[8];
#pragma unroll
            for (int k = 0; k < 8; ++k) av[k] = *(const bf16x8_t*)(xrow + 32 * (kb + k));
#pragma unroll
            for (int k = 0; k < 8; ++k) {
                const bf16x8_t bh = *(const LAS bf16x8_t*)(WH + l15 * RW + 32 * (kb + k) + 8 * q4), bl = *(const LAS bf16x8_t*)(WL + l15 * RW + 32 * (kb + k) + 8 * q4);
                acc = __builtin_amdgcn_mfma_f32_16x16x32_bf16(av[k], bh, acc, 0, 0, 0);
                acc = __builtin_amdgcn_mfma_f32_16x16x32_bf16(av[k], bl, acc, 0, 0, 0);
            }
        }
#pragma unroll
        for (int r = 0; r < 4; ++r) LG[(4 * q4 + r) * 16 + l15] = acc[r];
        if (F.lane < 16) {
            const int row = r0 + F.lane, b = row / SEQ;
            const f32x4* sp = (const f32x4*)(SSQ + (size_t)row * 16); const f32x4 s4 = (sp[0] + sp[1]) + (sp[2] + sp[3]);
            const float rstd = rsqrtf(((s4.x + s4.y) + (s4.z + s4.w)) * (1.0f / D) + EPS);
            const f32x4 l0 = *(const LAS f32x4*)(LG + F.lane * 16), l1 = *(const LAS f32x4*)(LG + F.lane * 16 + 4);
            const float dots[8] = {l0.x, l0.y, l0.z, l0.w, l1.x, l1.y, l1.z, l1.w};
            float v0 = -INFINITY, v1 = -INFINITY; int e0 = 0, e1 = 0;
#pragma unroll
            for (int e = 0; e < 8; ++e) { const float lg = rstd * dots[e] + CR[b * 8 + e] + a.router_b[e]; if (lg > v0) { v1 = v0; e1 = e0; v0 = lg; e0 = e; } else if (lg > v1) { v1 = lg; e1 = e; } }
            const float ex = __expf(v1 - v0), p0 = 1.0f / (1.0f + ex), p1 = ex / (1.0f + ex);
            unsigned* cnt = (unsigned*)(F.ws + WS_CTL) + CW_MOECNT;
            const int q0 = (int)atomicAdd(cnt + 64 * e0, 1u), q1 = (int)atomicAdd(cnt + 64 * e1, 1u);
            int* R = (int*)(F.ws + WS_ROUTE) + (size_t)row * 4; R[0] = e0; R[1] = e1; ((float*)R)[2] = p0; ((float*)R)[3] = p1;
            int* Pq = (int*)(F.ws + WS_POS) + (size_t)row * 2; Pq[0] = q0; Pq[1] = q1;
            int* RM = (int*)(F.ws + WS_RMAP); RM[(size_t)e0 * T + q0] = row; RM[(size_t)e1 * T + q1] = row;
        }
    }
    __syncthreads();
}

__global__ void __launch_bounds__(NTHREADS, 2) fwd(Args a) {
    extern __shared__ __attribute__((aligned(16))) unsigned char lds_raw[];
    Frame F;
    F.lds = (LAS unsigned char*)lds_raw;
    F.tid = threadIdx.x; F.lane = F.tid & 63; F.wave = __builtin_amdgcn_readfirstlane(F.tid >> 6);
    F.bid = blockIdx.x; F.nb = gridDim.x; F.gw = F.bid * NWAVES + F.wave; F.ngw = F.nb * NWAVES; F.ws = (GAS unsigned char*)a.ws;
    volatile LAS unsigned* MISC = (volatile LAS unsigned*)(F.lds + MISC_OFF);
    for (int u = F.tid; u < 32; u += NTHREADS) MISC[u] = 0u;
    __syncthreads();
    unsigned* ctl = (unsigned*)(a.ws + WS_CTL);
    const int lo = a.ph_lo, hi = a.ph_hi;
    const bool multi = (hi - lo) > 1;
    XcdBarrier bar; bar.bar = ctl + CW_BAR; bar.x = 0; bar.st = MISC + 8;
    if (multi) bar = xcd_barrier_post(ctl + CW_BAR, MISC + 8);
#define IN(k) (lo <= (k) && (k) < hi && (frame_refresh(F, a, (LAS unsigned char*)lds_raw), true))
#define SEAM(k) do { if (hi > (k) + 1 && lo <= (k)) { xcd_barrier(bar); if constexpr ((PROBE_MASK & 4194304) != 0) xcd_barrier(bar); } } while (0)
    float* MOD = (float*)(a.ws + WS_MOD);
    bf16_t* H = (bf16_t*)(a.ws + WS_H); bf16_t* PROJ = (bf16_t*)(a.ws + WS_PROJ); bf16_t* YMIX = (bf16_t*)(a.ws + WS_YMIX);
    bf16_t* WT = (bf16_t*)(a.ws + WS_WT);
    bf16_t* ACT = (bf16_t*)(a.ws + WS_ACT); bf16_t* ACTM = (bf16_t*)(a.ws + WS_ACTM); bf16_t* YMOE = (bf16_t*)(a.ws + WS_YMOE);

    if (IN(PH_PRO)) { REP(1) { ph_pro_vectors(a, F); ph_pro_weights(a, F); } SEAM(PH_PRO); }

#define TWICE(bit, stmt) do { stmt; if constexpr ((PROBE_MASK & (bit)) != 0) { stmt; } } while (0)
    float* AV = (float*)(a.ws + WS_AV); float* SSQ = (float*)(a.ws + WS_SSQ); bf16_t* X16 = (bf16_t*)(a.ws + WS_X16);
    const LAS float* RSL = (const LAS float*)(F.lds + RS_OFF);
#define LAYER_BODY(l) {\
        const int pb = PH_LAYER0 + PH_PER_LAYER * l; \
        const float* xin = (l == 0) ? a.x : a.out; \
        const float* mod0 = MOD + (size_t)(l * 2 + 0) * 2 * 3072; const float* mod1 = MOD + (size_t)(l * 2 + 1) * 2 * 3072; \
        if (l == 0) { if (IN(pb + K_NORM1)) { REP(2) ph_norm0(a, F); ph_prep_vectors(a, F); SEAM(pb + K_NORM1); } } \
        if (IN(pb + K_GEMM_IN)) { \
            TWICE(4, ({ pg8::Gemm g{H, WT + WT_WIN + (size_t)l * NPW * D, D}; pg8::StaticOrder S; S.init(T, NPW, F.nb, F.bid); rstd_preload(F, S, SSQ + (size_t)(l == 0 ? 3 : 1) * T * 16, nullptr); \
                pg8::EpiProjNorm E{PROJ, RSL, (const float*)(a.ws + (l == 0 ? WS_CVI0 : WS_CVI)), (float*)(a.ws + WS_BG), a.dn_a_log + 4 * l, a.dn_dt_bias + 4 * l}; \
                pg8::gemm_phase<pg8::EpiProjNorm, pg8::StaticOrder, false, true, true>(F.lds, nullptr, g, S, E); })); \
            SEAM(pb + K_GEMM_IN); \
        } \
        if (IN(pb + K_DN_PREP)) { REP(8) ph_dn_chunk(a, F, l); ph_rope(a, F); SEAM(pb + K_DN_PREP); } \
        if (IN(pb + K_MIX)) { ph_dn_scan(a, F, l); REP(512) ph_attn_mfma(a, F, l); REP(1024) ph_conv_fast(a, F, l); __syncthreads(); REP(32) ph_dn_out(a, F, l); SEAM(pb + K_MIX); } \
        if (IN(pb + K_GEMM_OUT)) { \
            TWICE(0, ({ pg8::Gemm g{YMIX, WT + WT_WOUT + (size_t)l * D * D, D}; pg8::StaticOrder S; S.init(T, D, F.nb, F.bid); \
                pg8::EpiResidNorm E{X16, X16, mod0 + 2048, AV + (size_t)(l == 0 ? 0 : 2) * BATCH * D, H, SSQ + (size_t)(l == 0 ? 0 : 2) * T * 16}; \
                pg8::gemm_phase<pg8::EpiResidNorm, pg8::StaticOrder, false, true, true>(F.lds, nullptr, g, S, E); })); \
            if constexpr ((PROBE_MASK & 8388608) != 0 && l == 0) { pg8::Gemm g{YMIX, WT + WT_WOUT + (size_t)l * D * D, D}; pg8::StaticOrder S; S.init(T, D, F.nb, F.bid); pg8::EpiBf16 E{(bf16_t*)(a.ws + WS_DN_MR), D, 1 << 20}; \
                pg8::gemm_phase<pg8::EpiBf16, pg8::StaticOrder, false, true, true>(F.lds, nullptr, g, S, E); } \
            if constexpr ((PROBE_MASK & 16777216) != 0 && l == 0) { pg8::Gemm g{YMIX, WT + WT_WOUT + (size_t)l * D * D, D}; pg8::StaticOrder S; S.init(T, D, F.nb, F.bid); \
                pg8::EpiResidNorm E{X16, (bf16_t*)(a.ws + WS_DN_MR), mod0 + 2048, AV, (bf16_t*)(a.ws + WS_DN_MR), (float*)(a.ws + WS_DN_ST)}; \
                pg8::gemm_phase<pg8::EpiResidNorm, pg8::StaticOrder, false, true, true>(F.lds, nullptr, g, S, E); } \
            if constexpr ((PROBE_MASK & 131072) != 0 && l == 0) { pg8::Gemm g{YMIX, WT + WT_WOUT + (size_t)l * D * D, D}; pg8::StaticOrder S; S.init(T, D, F.nb, F.bid); pg8::EpiNull E{}; \
                pg8::gemm_phase<pg8::EpiNull, pg8::StaticOrder, false, true, true>(F.lds, nullptr, g, S, E); } \
            SEAM(pb + K_GEMM_OUT); \
        } \
        if (l == 0) { \
            if (IN(pb + K_FFN1)) { \
                TWICE(256, ({ pg8::Gemm g{H, WT + WT_FGU, D}; pg8::StaticOrder S; S.init(T, 2 * D_FF, F.nb, F.bid); rstd_preload(F, S, SSQ, nullptr); \
                    pg8::EpiSwiGLUNorm E{ACT, D_FF, 1 << 20, RSL, (const float*)(a.ws + WS_CVF), 5632}; \
                    pg8::gemm_phase<pg8::EpiSwiGLUNorm, pg8::StaticOrder, false, true, true>(F.lds, nullptr, g, S, E); })); \
                SEAM(pb + K_FFN1); \
            } \
            if (IN(pb + K_FFN2)) { \
                { pg8::Gemm g{ACT, WT + WT_FD, D_FF}; pg8::StaticOrder S; S.init(T, D, F.nb, F.bid); \
                    pg8::EpiResidNorm E{X16, X16, mod1 + 2048, AV + (size_t)1 * BATCH * D, H, SSQ + (size_t)1 * T * 16}; \
                    pg8::gemm_phase<pg8::EpiResidNorm, pg8::StaticOrder, false, true, true>(F.lds, nullptr, g, S, E); } \
                SEAM(pb + K_FFN2); \
            } \
        } else { \
            if (IN(pb + K_NORM2)) { ph_router(a, F); SEAM(pb + K_NORM2); } \
            if (IN(pb + K_FFN1)) { \
                TWICE(2048, ({ pg8::MoeOrder<8> S; moe_order_init<8>(F, S); moe_ri_preload<8>(F, S); rstd_preload(F, S, SSQ + (size_t)2 * T * 16, (const LAS int*)(F.lds + RI_OFF)); \
                    pg8::Gemm g{H, WT + WT_MGU, D}; pg8::EpiSwiGLUNorm E{ACTM, D_FFE, 8, RSL, (const float*)(a.ws + WS_CVM), 16384}; \
                    pg8::gemm_phase<pg8::EpiSwiGLUNorm, pg8::MoeOrder<8>, true, true, true>(F.lds, (const LAS int*)(F.lds + RI_OFF), g, S, E); })); \
                SEAM(pb + K_FFN1); \
            } \
            if (IN(pb + K_FFN2)) { \
                TWICE(4096, ({ pg8::MoeOrder<4> S; moe_order_init<4>(F, S); \
                    pg8::Gemm g{ACTM, WT + WT_MD, D_FFE}; pg8::EpiBf16W E{YMOE, D, 4}; \
                    pg8::gemm_phase<pg8::EpiBf16W, pg8::MoeOrder<4>, false, true, true>(F.lds, nullptr, g, S, E); })); \
                SEAM(pb + K_FFN2); \
            } \
        } \
    }
    LAYER_BODY(0)
    LAYER_BODY(1)
#undef LAYER_BODY
    if (IN(PH_FINAL)) { ph_final(a, F); }
#undef IN
#undef SEAM
}

extern "C" void kernel_launch(void* const* d_in, const int* in_sizes, int n_in, void* d_out, int out_size, void* d_ws, size_t ws_size, hipStream_t stream) {
    static int grid = 0;
    if (grid == 0) {
        if (n_in != 27 || out_size != T * D || ws_size < WS_END) { fprintf(stderr, "kernel_launch: unexpected shapes n_in %d out %d ws %zu\n", n_in, out_size, ws_size); grid = -1; return; }
        int dev = 0, cus = 0, per_cu = 0;
        if (hipGetDevice(&dev) != hipSuccess || hipDeviceGetAttribute(&cus, hipDeviceAttributeMultiprocessorCount, dev) != hipSuccess) { grid = -1; return; }
        if (hipFuncSetAttribute((const void*)fwd, hipFuncAttributeMaxDynamicSharedMemorySize, LDS_BYTES) != hipSuccess) { fprintf(stderr, "kernel_launch: hipFuncSetAttribute failed\n"); grid = -1; return; }
        if (hipOccupancyMaxActiveBlocksPerMultiprocessor(&per_cu, (const void*)fwd, NTHREADS, LDS_BYTES) != hipSuccess || per_cu < 1) fprintf(stderr, "kernel_launch: occupancy query says %d\n", per_cu);
        (void)hipGetLastError();
        grid = cus;
    }
    if (grid < 0) return;
    (void)hipMemsetAsync((char*)d_ws + WS_CTL, 0, CTL_ZERO_BYTES, stream);
    Args a{};
    const void** pp = (const void**)&a;
    for (int i = 0; i < 27; ++i) pp[i] = d_in[i];
    a.out = (float*)d_out; a.ws = (unsigned char*)d_ws;
#if MK_ONE_LAUNCH
    a.ph_lo = 0; a.ph_hi = NPH;
    hipLaunchKernelGGL(fwd, dim3(grid), dim3(NTHREADS), LDS_BYTES, stream, a);
#else
    static const int phases[] = {0, 1, 2, 3, 4, 5, 6, 7, 9, 10, 11, 12, 13, 14, 15, 16, 17, 18, 19, 20, 21};
    for (int p : phases) { a.ph_lo = p; a.ph_hi = p + 1; hipLaunchKernelGGL(fwd, dim3(grid), dim3(NTHREADS), LDS_BYTES, stream, a); }
#endif
}
```

```cpp
#include <hip/hip_runtime.h>
#include <cstdio>
#include <cstdint>

#define LAS __attribute__((address_space(3)))
#define GAS __attribute__((address_space(1)))
typedef unsigned short bf16_t;
typedef float f32x4 __attribute__((ext_vector_type(4)));
typedef float f32x2 __attribute__((ext_vector_type(2)));
typedef unsigned u32x2 __attribute__((ext_vector_type(2)));
typedef unsigned u32x4 __attribute__((ext_vector_type(4)));

#ifndef GEMM_MASK
#define GEMM_MASK 63
#endif
#ifndef ATTN_MFMA
#define ATTN_MFMA 1
#endif
#ifndef DN_CHUNKED
#define DN_CHUNKED 1
#endif
#ifndef CONV_FAST
#define CONV_FAST 1
#endif
#ifndef PROBE_MASK
#define PROBE_MASK 0
#endif
#define REP(bit) for (int rep_ = 0; rep_ < ((PROBE_MASK & (bit)) ? 2 : 1); ++rep_)
#ifndef MK_ONE_LAUNCH
#define MK_ONE_LAUNCH 1
#endif

constexpr int BATCH = 2, SEQ = 16384, T = BATCH * SEQ, D = 1024, DEPTH = 2;
constexpr int NPW = 2560;
constexpr int N_IN = 2312, NP = 2304;
constexpr int C_AQ = 0, C_AK = 512, C_AV = 640, C_DQ = 768, C_DK = 1024, C_DV = 1280, C_DZ = 1536, C_CA = 1792, C_CB = 2048;
constexpr int W_DB = 1536;
constexpr int D_FF = 2816, NE = 8, D_FFE = 1024;
constexpr int WINDOW = 128, CV_K = 31, CV_C = 256, DN_CONV = 4;
constexpr float EPS = 1e-6f;
constexpr int NSCAN = BATCH * 4 * 4;
constexpr int MOE_CAP = 67584;

constexpr size_t MiB = 1u << 20;
constexpr size_t WS_CTL = 0, CTL_ZERO_BYTES = 256 * 1024;
constexpr size_t WS_MOD = 1 * MiB;
constexpr size_t WS_CS = 2 * MiB;
constexpr size_t WS_BG = 4 * MiB;
constexpr size_t WS_ROUTE = 5 * MiB;
constexpr size_t WS_POS = 6 * MiB;
constexpr size_t WS_RMAP = 7 * MiB;
constexpr size_t WS_WT = 8 * MiB;
constexpr size_t WS_H = 88 * MiB;
constexpr size_t WS_PROJ = 152 * MiB;
constexpr size_t WS_YMIX = 296 * MiB;
constexpr size_t WS_DNQKV = 360 * MiB;
constexpr size_t WS_ODN = 456 * MiB;
constexpr size_t WS_ACT = 152 * MiB;
constexpr size_t WS_ACTM = 152 * MiB;
constexpr size_t WS_YMOE = 284 * MiB;
constexpr size_t WS_X16 = 440 * MiB;
constexpr size_t WS_SSQ = 504 * MiB;
constexpr size_t WS_AV = WS_MOD + 128 * 1024;
constexpr size_t WS_CVF = WS_MOD + 256 * 1024;
constexpr size_t WS_CVI = WS_CVF + 2 * 5632 * 4;
constexpr size_t WS_CVM = WS_CVI + 2 * 2560 * 4;
constexpr size_t WS_CR = WS_CVM + 2 * 16384 * 4;
constexpr size_t WS_CVI0 = WS_CR + 64;
static_assert(WS_CVI0 + 2 * 2560 * 4 <= WS_CS, "vector area");
constexpr size_t WS_END = 512 * MiB;
constexpr int CW_BAR = 4096;
constexpr int CW_MOECNT = 16384;
constexpr int CW_F1DONE = 30720;
constexpr int CW_TREADY = 32768;
constexpr int CW_SCANP = 20480;

constexpr int NWAVES = 8, NTHREADS = 512;
constexpr int LDS_BYTES = 163840;
constexpr int MISC_OFF = 131072 + 320;
constexpr int RI_OFF = 132096;
constexpr int RS_OFF = 147456;

constexpr int PH_PRO = 0, PH_LAYER0 = 1, PH_PER_LAYER = 10, PH_FINAL = 21, NPH = 22;
enum { K_NORM1 = 0, K_GEMM_IN, K_DN_PREP, K_MIX, K_DN_OUT, K_GEMM_OUT, K_NORM2, K_MOE_LIST, K_FFN1, K_FFN2 };

struct Args {
    const float* x; const float* c; const int* pos; const float* ada_w; const float* ada_b; const float* nmg; const float* nfg;
    const float* w_in; const float* sinks; const float* dn_conv_w; const float* dn_a_log; const float* dn_dt_bias; const float* dn_norm_g;
    const float* cv_dw_w; const float* cv_dw_b; const float* cv_ln_g; const float* cv_ln_b; const float* w_out;
    const float* ffn_wg; const float* ffn_wu; const float* ffn_wd; const float* router_w; const float* router_b;
    const float* moe_wg; const float* moe_wu; const float* moe_wd; const float* final_g;
    float* out; unsigned char* ws; int ph_lo, ph_hi;
};

__device__ __forceinline__ float bf2f(unsigned u) { return __uint_as_float(u << 16); }
__device__ __forceinline__ unsigned f2bf(float f) { unsigned u = __float_as_uint(f); return (u + 0x7fffu + ((u >> 16) & 1u)) >> 16; }
__device__ __forceinline__ unsigned pk2(float lo, float hi) { return f2bf(lo) | (f2bf(hi) << 16); }
#define DPP_MOV(v, ctrl) __int_as_float(__builtin_amdgcn_update_dpp(0, __float_as_int(v), (ctrl), 0xf, 0xf, false))
__device__ __forceinline__ float row16_sum(float v) { v += DPP_MOV(v, 0xB1); v += DPP_MOV(v, 0x4E); v += DPP_MOV(v, 0x141); v += DPP_MOV(v, 0x140); return v; }
__device__ __forceinline__ float wave_sum(float v) {
    v = row16_sum(v);
    const int vi = __float_as_int(v);
    return (__int_as_float(__builtin_amdgcn_readlane(vi, 0)) + __int_as_float(__builtin_amdgcn_readlane(vi, 16))) + (__int_as_float(__builtin_amdgcn_readlane(vi, 32)) + __int_as_float(__builtin_amdgcn_readlane(vi, 48)));
}
__device__ __forceinline__ float xor32_sum(float v) { const auto r = __builtin_amdgcn_permlane32_swap(__float_as_uint(v), __float_as_uint(v), false, false); return __uint_as_float(r[0]) + __uint_as_float(r[1]); }
__device__ __forceinline__ float xor32_max(float v) { const auto r = __builtin_amdgcn_permlane32_swap(__float_as_uint(v), __float_as_uint(v), false, false); return fmaxf(__uint_as_float(r[0]), __uint_as_float(r[1])); }
__device__ __forceinline__ float xor16_sum(float v) { const auto r = __builtin_amdgcn_permlane16_swap(__float_as_uint(v), __float_as_uint(v), false, false); return __uint_as_float(r[0]) + __uint_as_float(r[1]); }
__device__ __forceinline__ float group8_sum(float v) { v += DPP_MOV(v, 0xB1); v += DPP_MOV(v, 0x4E); v += DPP_MOV(v, 0x141); return v; }
__device__ __forceinline__ float wave_max(float v) {
#pragma unroll
    for (int o = 1; o < 64; o <<= 1) v = fmaxf(v, __shfl_xor(v, o));
    return v;
}
__device__ __forceinline__ float sigmoidf_(float x) { return __builtin_amdgcn_rcpf(1.0f + __builtin_amdgcn_exp2f(x * -1.4426950408889634f)); }
__device__ __forceinline__ float siluf_(float x) { return x * __builtin_amdgcn_rcpf(1.0f + __builtin_amdgcn_exp2f(x * -1.4426950408889634f)); }
__device__ __forceinline__ float softplusf_(float x) { return fmaxf(x, 0.f) + log1pf(__expf(-fabsf(x))); }

#define XB_TMO      128
#define XB_XCNT(j)  (256  + 64 * (j))
#define XB_XSUB(j)  (1280 + 64 * (j))
#define XB_XGEN(j)  (2304 + 64 * (j))
#define XB_TOP      3328
#define XB_TOPGEN   3392
#define XCD_BAR_WORDS 3456
#define XB_SPIN_CAP (1u << 18)

__device__ __forceinline__ unsigned xb_ld(unsigned* p)              { return __hip_atomic_load(p, __ATOMIC_RELAXED, __HIP_MEMORY_SCOPE_AGENT); }
__device__ __forceinline__ unsigned xb_add(unsigned* p, unsigned v) { return __hip_atomic_fetch_add(p, v, __ATOMIC_RELAXED, __HIP_MEMORY_SCOPE_AGENT); }
__device__ __forceinline__ unsigned xb_xcc_id() { return (unsigned)__builtin_amdgcn_s_getreg((3 << 11) | 20) & 0xFu; }
#define XB_SPIN(cond, bar) do { unsigned _sp = 0; while (cond) { __builtin_amdgcn_s_sleep(1); \
    if ((++_sp & 255u) == 0u) { if (xb_ld(&(bar)[XB_TMO])) break; if (_sp > XB_SPIN_CAP) { atomicAdd(&(bar)[XB_TMO], 1u); break; } } } } while (0)

struct XcdBarrier { unsigned* bar; unsigned x; volatile LAS unsigned* st; };

__device__ __forceinline__ XcdBarrier xcd_barrier_post(unsigned* bar, volatile LAS unsigned* st) {
    XcdBarrier b; b.bar = bar; b.x = xb_xcc_id(); b.st = st;
    if (threadIdx.x == 0) (void)xb_add(&bar[XB_XCNT(b.x)], 1u);
    return b;
}
__device__ __forceinline__ void xcd_barrier_complete(unsigned* bar, unsigned x, unsigned& nloc, unsigned& nx, unsigned& mask) {
    const unsigned G = gridDim.x * gridDim.y * gridDim.z;
    unsigned sum, cnt, mine, sp = 0u;
    for (;;) {
        sum = 0u; cnt = 0u; mine = 0u; mask = 0u;
#pragma unroll
        for (unsigned j = 0; j < 16; ++j) { const unsigned c = xb_ld(&bar[XB_XCNT(j)]); sum += c; cnt += (c > 0u) ? 1u : 0u; mask |= (c > 0u) ? (1u << j) : 0u; mine = (j == x) ? c : mine; }
        if (sum == G) break;
        __builtin_amdgcn_s_sleep(1);
        if ((++sp & 255u) == 0u) { if (xb_ld(&bar[XB_TMO])) break; if (sp > XB_SPIN_CAP) { atomicAdd(&bar[XB_TMO], 1u); break; } }
    }
    nloc = mine > 0u ? mine : 1u; nx = cnt > 0u ? cnt : 1u;
}
#define XB_XFLAG(y) (3584 + 64 * (y))
__device__ __forceinline__ void xcd_barrier(const XcdBarrier& b) {
    asm volatile("s_waitcnt vmcnt(0)" ::: "memory");
    __syncthreads();
    if (threadIdx.x < 64) {
        unsigned* bar = b.bar; const unsigned lane = threadIdx.x;
        unsigned gen = 0u, mask = 0u;
        if (lane == 0u) {
            __builtin_amdgcn_s_waitcnt(0);
            unsigned nloc = b.st[0], nx = b.st[1]; mask = b.st[2];
            if (nloc == 0u) { xcd_barrier_complete(bar, b.x, nloc, nx, mask); b.st[0] = nloc; b.st[1] = nx; b.st[2] = mask; }
            const unsigned old = xb_add(&bar[XB_XSUB(b.x)], 1u);
            gen = old / nloc;
            if (old + 1u == (gen + 1u) * nloc) {
                __builtin_amdgcn_fence(__ATOMIC_RELEASE, "agent");
                asm volatile("s_waitcnt vmcnt(0)" ::: "memory");
#pragma unroll
                for (unsigned y = 0; y < 16; ++y) if ((mask >> y) & 1u) (void)xb_add(&bar[XB_XFLAG(y) + b.x], 1u);
            }
        }
        gen = (unsigned)__builtin_amdgcn_readfirstlane((int)gen); mask = (unsigned)__builtin_amdgcn_readfirstlane((int)mask);
        __builtin_amdgcn_fence(__ATOMIC_ACQUIRE, "agent");
        const bool mine = lane < 16u && ((mask >> lane) & 1u);
        unsigned sp = 0u;
        for (;;) {
            const unsigned v = mine ? xb_ld(&bar[XB_XFLAG(b.x) + lane]) : 0xffffffffu;
            if (__ballot(v <= gen) == 0ull) break;
            __builtin_amdgcn_s_sleep(1);
            if ((++sp & 255u) == 0u) { if (xb_ld(&bar[XB_TMO])) break; if (sp > XB_SPIN_CAP) { if (lane == 0u) atomicAdd(&bar[XB_TMO], 1u); break; } }
        }
        asm volatile("s_waitcnt vmcnt(0)" ::: "memory");
    }
    __syncthreads();
}

struct Frame {
    LAS unsigned char* lds;
    int tid, lane, wave, gw, ngw, bid, nb;
    GAS unsigned char* ws;
};

__device__ __forceinline__ void frame_refresh(Frame& F, const Args& a, LAS unsigned char* lds) {
    int tid = threadIdx.x; asm volatile("" : "+v"(tid));
    int bid = blockIdx.x; asm volatile("" : "+s"(bid));
    unsigned char* ws = a.ws; asm volatile("" : "+s"(ws));
    F.lds = lds; F.tid = tid; F.lane = tid & 63; F.wave = __builtin_amdgcn_readfirstlane(tid >> 6);
    F.bid = bid; F.nb = gridDim.x; F.gw = F.bid * NWAVES + F.wave; F.ngw = F.nb * NWAVES; F.ws = (GAS unsigned char*)ws;
}
__device__ __forceinline__ void ph_pro_vectors(const Args& a, Frame& F) {
    float* MOD = (float*)(F.ws + WS_MOD);
    LAS float* red = (LAS float*)F.lds;
    LAS float* scl = (LAS float*)(F.lds + 8192);
    if (F.bid < 4 * 48) { const f32x4 cv4 = *(const f32x4*)(a.c + 4 * F.tid);
        *(LAS f32x4*)(scl + 4 * F.tid) = (f32x4){siluf_(cv4.x), siluf_(cv4.y), siluf_(cv4.z), siluf_(cv4.w)}; __syncthreads(); }
    for (int it = F.bid; it < 4 * 48; it += F.nb) {
        const int lk = it / 48, cg = it % 48, e = cg * 64 + F.lane;
        const float* W = a.ada_w + (size_t)lk * D * 3072 + e;
        float a0 = 0.f, a1 = 0.f;
        const int d0 = F.wave * 128;
#pragma unroll 1
        for (int db = d0; db < d0 + 128; db += 32) {
            float wv[32];
#pragma unroll
            for (int i = 0; i < 32; ++i) wv[i] = __builtin_nontemporal_load(W + (size_t)(db + i) * 3072);
#pragma unroll
            for (int i = 0; i < 32; i += 4) { const f32x4 s0 = *(const LAS f32x4*)(scl + db + i), s1 = *(const LAS f32x4*)(scl + D + db + i);
                a0 += (s0.x * wv[i] + s0.y * wv[i + 1]) + (s0.z * wv[i + 2] + s0.w * wv[i + 3]); a1 += (s1.x * wv[i] + s1.y * wv[i + 1]) + (s1.z * wv[i + 2] + s1.w * wv[i + 3]); }
        }
        red[(F.wave * 2 + 0) * 64 + F.lane] = a0; red[(F.wave * 2 + 1) * 64 + F.lane] = a1;
        __syncthreads();
        if (F.wave < 2) {
            float s = 0.f;
            for (int w = 0; w < 8; ++w) s += red[(w * 2 + F.wave) * 64 + F.lane];
            MOD[((size_t)lk * 2 + F.wave) * 3072 + e] = s + a.ada_b[lk * 3072 + e];
        }
        __syncthreads();
    }
    float* CS = (float*)(F.ws + WS_CS);
    for (int idx = F.bid * NTHREADS + F.tid; idx < T * 8; idx += F.nb * NTHREADS) {
        const int t = idx >> 3, i = idx & 7;
        const float inv = powf(500000.0f, -(float)(2 * i) / 16.0f);
        const float ang = (float)a.pos[t] * inv;
        CS[t * 16 + i] = cosf(ang); CS[t * 16 + 8 + i] = sinf(ang);
    }
}

template <int MODE>
__device__ __forceinline__ void ph_norm(const Args& a, Frame& F, int l, const float* xin, const float* gain, const float* modk  ,
                                        const float* W8, int pitch) {
    bf16_t* H = (bf16_t*)(F.ws + WS_H);
    LAS float* W8T = (LAS float*)F.lds;
    if (MODE != 0) {
        for (int i = F.tid; i < 8192; i += NTHREADS) { const int d = i >> 3, j = i & 7; W8T[j * 1024 + d] = W8[(size_t)d * pitch + j]; }
        __syncthreads();
    }
    f32x4 vn[4], A4[4], B4[4]; int cur_b = -1;
    if (F.gw < T) {
#pragma unroll
        for (int j = 0; j < 4; ++j) vn[j] = ((const f32x4*)(xin + (size_t)F.gw * D) + F.lane)[64 * j];
    }
    for (int row = F.gw; row < T; row += F.ngw) {
        const int b = row / SEQ;
        f32x4 v[4]; float ss = 0.f;
#pragma unroll
        for (int j = 0; j < 4; ++j) { v[j] = vn[j]; ss += (v[j].x * v[j].x + v[j].y * v[j].y) + (v[j].z * v[j].z + v[j].w * v[j].w); }
        if (row + F.ngw < T) {
#pragma unroll
            for (int j = 0; j < 4; ++j) vn[j] = ((const f32x4*)(xin + (size_t)(row + F.ngw) * D) + F.lane)[64 * j];
        }
        if (b != cur_b) {
            cur_b = b; const float* sh = modk + (size_t)b * 3072; const float* sc = sh + 1024;
#pragma unroll
            for (int j = 0; j < 4; ++j) { const int d = 256 * j + 4 * F.lane; A4[j] = *(const f32x4*)(gain + d) * (*(const f32x4*)(sc + d) + 1.0f); B4[j] = *(const f32x4*)(sh + d); }
        }
        const float rstd = rsqrtf(wave_sum(ss) * (1.0f / D) + EPS);
        float acc[8];
#pragma unroll
        for (int e = 0; e < 8; ++e) acc[e] = 0.f;
#pragma unroll
        for (int j = 0; j < 4; ++j) {
            const int d = 256 * j + 4 * F.lane;
            const f32x4 hv = (v[j] * rstd) * A4[j] + B4[j];
            u32x2 o; o.x = pk2(hv.x, hv.y); o.y = pk2(hv.z, hv.w);
            *(u32x2*)(H + (size_t)row * D + d) = o;
            if (MODE == 1) { u32x2 xo; xo.x = pk2(v[j].x, v[j].y); xo.y = pk2(v[j].z, v[j].w); *(u32x2*)((bf16_t*)(F.ws + WS_X16) + (size_t)row * D + d) = xo; }
            if (MODE != 0) {
#pragma unroll
                for (int e = 0; e < 8; ++e) { const f32x4 w4 = *(const LAS f32x4*)(W8T + e * 1024 + d); acc[e] += (hv.x * w4.x + hv.y * w4.y) + (hv.z * w4.z + hv.w * w4.w); }
            }
        }
        if (MODE != 0) {
#pragma unroll
            for (int e = 0; e < 8; ++e) acc[e] = wave_sum(acc[e]);
        }
        if (MODE == 1 && F.lane == 0) {
            float* BG = (float*)(F.ws + WS_BG) + (size_t)row * 8;
#pragma unroll
            for (int h = 0; h < 4; ++h) {
                BG[h] = sigmoidf_(acc[h]);
                BG[4 + h] = -__expf(a.dn_a_log[l * 4 + h]) * softplusf_(acc[4 + h] + a.dn_dt_bias[l * 4 + h]);
            }
        }
        if (MODE == 2 && F.lane == 0) {
            float v0 = -INFINITY, v1 = -INFINITY; int e0 = 0, e1 = 0;
#pragma unroll
            for (int e = 0; e < 8; ++e) { const float lg = acc[e] + a.router_b[e]; if (lg > v0) { v1 = v0; e1 = e0; v0 = lg; e0 = e; } else if (lg > v1) { v1 = lg; e1 = e; } }
            const float ex = __expf(v1 - v0), p0 = 1.0f / (1.0f + ex), p1 = ex / (1.0f + ex);
            unsigned* cnt = (unsigned*)(F.ws + WS_CTL) + CW_MOECNT;
            const int q0 = (int)atomicAdd(cnt + 64 * e0, 1u), q1 = (int)atomicAdd(cnt + 64 * e1, 1u);
            int* R = (int*)(F.ws + WS_ROUTE) + (size_t)row * 4; R[0] = e0; R[1] = e1; ((float*)R)[2] = p0; ((float*)R)[3] = p1;
            int* P = (int*)(F.ws + WS_POS) + (size_t)row * 2; P[0] = q0; P[1] = q1;
        }
    }
    if (MODE != 0) __syncthreads();
}

typedef float f32x16 __attribute__((ext_vector_type(16)));
typedef short s16x4 __attribute__((ext_vector_type(4)));
typedef short bf16x8_t __attribute__((ext_vector_type(8)));
__device__ __forceinline__ unsigned cvtpk(float lo, float hi) { typedef float f2_t __attribute__((ext_vector_type(2))); typedef __bf16 b2_t __attribute__((ext_vector_type(2)));
    f2_t v = {lo, hi}; b2_t b = __builtin_convertvector(v, b2_t); return __builtin_bit_cast(unsigned, b); }
__device__ __forceinline__ void ph_rope(const Args& a, Frame& F) {
    bf16_t* P = (bf16_t*)(F.ws + WS_PROJ); const float* CS = (const float*)(F.ws + WS_CS);
    for (int it = F.bid * NTHREADS + F.tid; it < T * 10; it += F.nb * NTHREADS) {
        const int t = it / 10, hh = it % 10;
        bf16_t* p = P + (size_t)t * NP + hh * 64;
        const u32x4 x1 = *(const u32x4*)p, x2 = *(const u32x4*)(p + 8);
        const f32x4 c0 = *(const f32x4*)(CS + (size_t)t * 16), c1 = *(const f32x4*)(CS + (size_t)t * 16 + 4), s0 = *(const f32x4*)(CS + (size_t)t * 16 + 8), s1 = *(const f32x4*)(CS + (size_t)t * 16 + 12);
        const float cs[8] = {c0.x, c0.y, c0.z, c0.w, c1.x, c1.y, c1.z, c1.w}, sn[8] = {s0.x, s0.y, s0.z, s0.w, s1.x, s1.y, s1.z, s1.w};
        const unsigned xa[4] = {x1.x, x1.y, x1.z, x1.w}, xb[4] = {x2.x, x2.y, x2.z, x2.w};
        unsigned ra[4], rb[4];
#pragma unroll
        for (int i = 0; i < 4; ++i) {
            const float a0 = bf2f(xa[i] & 0xffffu), a1 = bf2f(xa[i] >> 16), b0 = bf2f(xb[i] & 0xffffu), b1 = bf2f(xb[i] >> 16);
            ra[i] = pk2(a0 * cs[2 * i] - b0 * sn[2 * i], a1 * cs[2 * i + 1] - b1 * sn[2 * i + 1]);
            rb[i] = pk2(b0 * cs[2 * i] + a0 * sn[2 * i], b1 * cs[2 * i + 1] + a1 * sn[2 * i + 1]);
        }
        *(u32x4*)p = (u32x4){ra[0], ra[1], ra[2], ra[3]}; *(u32x4*)(p + 8) = (u32x4){rb[0], rb[1], rb[2], rb[3]};
    }
}
__device__ __forceinline__ u32x4 rope_piece(u32x4 own, u32x4 par, const float* csrow, bool first_half) {
    const f32x4 c0 = *(const f32x4*)csrow, c1 = *(const f32x4*)(csrow + 4), s0 = *(const f32x4*)(csrow + 8), s1 = *(const f32x4*)(csrow + 12);
    const float cs[8] = {c0.x, c0.y, c0.z, c0.w, c1.x, c1.y, c1.z, c1.w}, sn[8] = {s0.x, s0.y, s0.z, s0.w, s1.x, s1.y, s1.z, s1.w};
    const unsigned xo[4] = {own.x, own.y, own.z, own.w}, xp[4] = {par.x, par.y, par.z, par.w};
    unsigned ro[4];
#pragma unroll
    for (int i = 0; i < 4; ++i) {
        const float o0 = bf2f(xo[i] & 0xffffu), o1 = bf2f(xo[i] >> 16), p0 = bf2f(xp[i] & 0xffffu), p1 = bf2f(xp[i] >> 16);
        ro[i] = first_half ? pk2(o0 * cs[2 * i] - p0 * sn[2 * i], o1 * cs[2 * i + 1] - p1 * sn[2 * i + 1]) : pk2(o0 * cs[2 * i] + p0 * sn[2 * i], o1 * cs[2 * i + 1] + p1 * sn[2 * i + 1]);
    }
    return (u32x4){ro[0], ro[1], ro[2], ro[3]};
}
constexpr int AT_KROW = 144, AT_VOFF = 256 * AT_KROW;
__device__ __forceinline__ void ph_attn_mfma(const Args& a, Frame& F, int l) {
    const bf16_t* P = (const bf16_t*)(F.ws + WS_PROJ); bf16_t* Y = (bf16_t*)(F.ws + WS_YMIX);
    LAS unsigned char* Kl = F.lds; LAS unsigned char* Vl = F.lds + AT_VOFF;
    const int lane = F.lane, r = lane & 31, h = lane >> 5, g = F.wave >> 1, qh = F.wave & 1;
    const int i16 = lane & 15, tq_ = i16 >> 2, tp_ = i16 & 3, g16 = (lane >> 4) & 1, sw = (tq_ >> 1) & 1;
    const int vlane = (4 * h + tq_) * 128 + (2 * g16 + (tp_ >> 1)) * 16 + (tp_ & 1) * 8;
    const float C = 0.125f * 1.4426950408889634f;
    const int nsc = NSCAN;
    if (F.bid < nsc) return;
    u32x4 kreg[4], vreg[4];
#define AT_LOAD(uu) { const int hk_ = (uu) & 1, n_ = ((uu) >> 1) & 127, b_ = (uu) >> 8, tk0_ = b_ * SEQ + n_ * 128 - 128; \
        _Pragma("unroll") for (int i = 0; i < 4; ++i) { const int piece = F.tid + NTHREADS * i, key = piece >> 3, c = piece & 7; \
            const bf16_t* rowp = P + (size_t)(tk0_ + ((n_ > 0 || key >= 128) ? key : key + 128)) * NP; \
            kreg[i] = *(const u32x4*)(rowp + C_AK + hk_ * 64 + c * 8); vreg[i] = *(const u32x4*)(rowp + C_AV + hk_ * 64 + c * 8); } }
    const int V = F.nb - nsc, nheavy = (T / 128 > V && T / 128 < 2 * V) ? T / 128 - V : 0, va = F.bid - nsc - nheavy, Va = V - nheavy;
    if (va < 0) return;
    if (va < BATCH * 128 * 2) AT_LOAD(va)
    for (int u = va; u < BATCH * 128 * 2; u += Va) {
        const int hk = u & 1, n = (u >> 1) & 127, b = u >> 8;
        const int tq0 = b * SEQ + n * 128;
        __syncthreads();
#pragma unroll
        for (int i = 0; i < 4; ++i) {
            const int piece = F.tid + NTHREADS * i, key = piece >> 3, c = piece & 7;
            const bool ok = (n > 0 || key >= 128);
            const u32x4 z4 = (u32x4){0u, 0u, 0u, 0u};
            u32x4 kv = kreg[i];
            {
                u32x4 pv; pv.x = (unsigned)__builtin_amdgcn_update_dpp(0, (int)kv.x, 0xB1, 0xf, 0xf, false); pv.y = (unsigned)__builtin_amdgcn_update_dpp(0, (int)kv.y, 0xB1, 0xf, 0xf, false);
                pv.z = (unsigned)__builtin_amdgcn_update_dpp(0, (int)kv.z, 0xB1, 0xf, 0xf, false); pv.w = (unsigned)__builtin_amdgcn_update_dpp(0, (int)kv.w, 0xB1, 0xf, 0xf, false);
                if (c < 2) { const int tkey = b * SEQ + n * 128 - 128 + (ok ? key : key + 128); kv = rope_piece(kv, pv, (const float*)(F.ws + WS_CS) + (size_t)tkey * 16, c == 0); }
            }
            *(LAS u32x4*)(Kl + key * AT_KROW + c * 16) = ok ? kv : z4;
            *(LAS u32x4*)(Vl + key * 128 + ((c ^ (((key >> 1) & 1) << 2)) * 16)) = ok ? vreg[i] : z4;
        }
        __syncthreads();
        if (u + Va < BATCH * 128 * 2) AT_LOAD(u + Va)
        asm volatile("" ::: "memory");
        const int hq = hk * 4 + g;
        const float sinkl = a.sinks[l * 8 + hq] * 1.4426950408889634f;
#pragma unroll 1
        for (int sb = 0; sb < 2; ++sb) {
            const int q0 = qh * 64 + sb * 32, kt0 = qh * 2 + sb;
            const size_t tq = (size_t)(tq0 + q0 + r);
            bf16x8_t qf[4];
#pragma unroll
            for (int ks = 0; ks < 4; ++ks) qf[ks] = *(const bf16x8_t*)(P + tq * NP + hq * 64 + 16 * ks + 8 * h);
            {
                const u32x4 ov = __builtin_bit_cast(u32x4, qf[0]); u32x4 pv;
                { const auto r0 = __builtin_amdgcn_permlane32_swap(ov.x, ov.x, false, false); pv.x = h ? r0[0] : r0[1]; }
                { const auto r1 = __builtin_amdgcn_permlane32_swap(ov.y, ov.y, false, false); pv.y = h ? r1[0] : r1[1]; }
                { const auto r2 = __builtin_amdgcn_permlane32_swap(ov.z, ov.z, false, false); pv.z = h ? r2[0] : r2[1]; }
                { const auto r3 = __builtin_amdgcn_permlane32_swap(ov.w, ov.w, false, false); pv.w = h ? r3[0] : r3[1]; }
                qf[0] = __builtin_bit_cast(bf16x8_t, rope_piece(ov, pv, (const float*)(F.ws + WS_CS) + tq * 16, h == 0));
            }
            f32x16 S[5];
#pragma unroll
            for (int kr = 0; kr < 5; ++kr) {
                f32x16 acc;
#pragma unroll
                for (int i = 0; i < 16; ++i) acc[i] = 0.f;
#pragma unroll
                for (int ks = 0; ks < 4; ++ks) { const bf16x8_t kf = *(const LAS bf16x8_t*)(Kl + (32 * (kt0 + kr) + r) * AT_KROW + (16 * ks + 8 * h) * 2);
                    acc = __builtin_amdgcn_mfma_f32_32x32x16_bf16(kf, qf[ks], acc, 0, 0, 0); }
                S[kr] = acc;
            }
            float m = sinkl;
#pragma unroll
            for (int kr = 0; kr < 5; ++kr) {
                const bool tile_ok = !(n == 0 && (kt0 + kr) < 4);
#pragma unroll
                for (int i = 0; i < 16; ++i) {
                    const int kl = (i & 3) + 8 * (i >> 2) + 4 * h;
                    bool ok = tile_ok; if (kr == 0) ok = ok && (kl > r); if (kr == 4) ok = ok && (kl <= r);
                    const float sv = ok ? S[kr][i] * C : -INFINITY; S[kr][i] = sv; m = fmaxf(m, sv);
                }
            }
            m = xor32_max(m);
            float lsum = 0.f;
#pragma unroll
            for (int kr = 0; kr < 5; ++kr)
#pragma unroll
                for (int i = 0; i < 16; ++i) { const float p = __builtin_amdgcn_exp2f(S[kr][i] - m); S[kr][i] = p; lsum += p; }
            lsum = xor32_sum(lsum); lsum += __builtin_amdgcn_exp2f(sinkl - m);
            f32x16 O0, O1;
#pragma unroll
            for (int i = 0; i < 16; ++i) { O0[i] = 0.f; O1[i] = 0.f; }
#pragma unroll
            for (int kr = 0; kr < 5; ++kr) {
#pragma unroll
                for (int s2 = 0; s2 < 2; ++s2) {
                    u32x4 pw; pw.x = cvtpk(S[kr][8 * s2 + 0], S[kr][8 * s2 + 1]); pw.y = cvtpk(S[kr][8 * s2 + 2], S[kr][8 * s2 + 3]); pw.z = cvtpk(S[kr][8 * s2 + 4], S[kr][8 * s2 + 5]); pw.w = cvtpk(S[kr][8 * s2 + 6], S[kr][8 * s2 + 7]);
                    const bf16x8_t pf = __builtin_bit_cast(bf16x8_t, pw);
                    const int kb = (32 * (kt0 + kr) + 16 * s2) * 128 + vlane;
                    const s16x4 lo0 = __builtin_amdgcn_ds_read_tr16_b64_v4i16((LAS s16x4*)(Vl + kb + (0 ^ sw) * 64));
                    const s16x4 hi0 = __builtin_amdgcn_ds_read_tr16_b64_v4i16((LAS s16x4*)(Vl + kb + 8 * 128 + (0 ^ sw) * 64));
                    const s16x4 lo1 = __builtin_amdgcn_ds_read_tr16_b64_v4i16((LAS s16x4*)(Vl + kb + (1 ^ sw) * 64));
                    const s16x4 hi1 = __builtin_amdgcn_ds_read_tr16_b64_v4i16((LAS s16x4*)(Vl + kb + 8 * 128 + (1 ^ sw) * 64));
                    const bf16x8_t va0 = __builtin_shufflevector(lo0, hi0, 0, 1, 2, 3, 4, 5, 6, 7), va1 = __builtin_shufflevector(lo1, hi1, 0, 1, 2, 3, 4, 5, 6, 7);
                    O0 = __builtin_amdgcn_mfma_f32_32x32x16_bf16(va0, pf, O0, 0, 0, 0);
                    O1 = __builtin_amdgcn_mfma_f32_32x32x16_bf16(va1, pf, O1, 0, 0, 0);
                }
            }
            const float inv = __builtin_amdgcn_rcpf(lsum);
            bf16_t* yp = Y + tq * D + hq * 64 + 4 * h;
#pragma unroll
            for (int gq = 0; gq < 4; ++gq) {
                u32x2 o0; o0.x = cvtpk(O0[4 * gq] * inv, O0[4 * gq + 1] * inv); o0.y = cvtpk(O0[4 * gq + 2] * inv, O0[4 * gq + 3] * inv);
                u32x2 o1; o1.x = cvtpk(O1[4 * gq] * inv, O1[4 * gq + 1] * inv); o1.y = cvtpk(O1[4 * gq + 2] * inv, O1[4 * gq + 3] * inv);
                *(u32x2*)(yp + 8 * gq) = o0; *(u32x2*)(yp + 32 + 8 * gq) = o1;
            }
        }
    }
    __syncthreads();
}


#undef AT_LOAD
constexpr size_t WS_DN_MR = 360 * MiB, WS_DN_BNT = 376 * MiB, WS_DN_QP = 392 * MiB, WS_DN_OLT = 408 * MiB, WS_DN_ST = 424 * MiB;
constexpr int DL = 72, LB = 9216;
constexpr int L_KR = 0, L_KT = LB, L_QR = 2 * LB, L_VT = 3 * LB, L_AR = 4 * LB, L_T1 = 5 * LB, L_T2 = 6 * LB, L_UT = 7 * LB, L_UPT = 8 * LB, L_WPT = 9 * LB, L_WT = 0;
constexpr int L_LR = 7 * LB, L_L21 = L_LR + 17408, L_T11T = L_L21 + 4608, L_T22R = L_T11T + 4608, L_YT = L_T22R + 4608, L_GC = 100352, L_BETA = L_GC + 256;
static_assert(L_YT + 4608 == L_GC && L_GC + 512 <= 131072, "DeltaNet LDS map");
template <int KS> __device__ __forceinline__ f32x4 mm16(const LAS unsigned char* lds, int offX, int offY, int tx, int ty, int lane) {
    f32x4 acc = (f32x4){0.f, 0.f, 0.f, 0.f};
    const int l15 = lane & 15, q = lane >> 4;
#pragma unroll
    for (int ks = 0; ks < KS; ++ks) {
        const bf16x8_t xa = *(const LAS bf16x8_t*)(lds + offX + ((16 * tx + l15) * DL + 32 * ks + 8 * q) * 2);
        const bf16x8_t yb = *(const LAS bf16x8_t*)(lds + offY + ((16 * ty + l15) * DL + 32 * ks + 8 * q) * 2);
        acc = __builtin_amdgcn_mfma_f32_16x16x32_bf16(xa, yb, acc, 0, 0, 0);
    }
    return acc;
}
__device__ __forceinline__ u32x2 pack4(f32x4 v) { u32x2 o; o.x = cvtpk(v.x, v.y); o.y = cvtpk(v.z, v.w); return o; }

__device__ __forceinline__ void ph_dn_chunk(const Args& a, Frame& F, int l) {
    const bf16_t* P = (const bf16_t*)(F.ws + WS_PROJ); const float* BG = (const float*)(F.ws + WS_BG);
    bf16_t* MR = (bf16_t*)(F.ws + WS_DN_MR); bf16_t* BNT = (bf16_t*)(F.ws + WS_DN_BNT); bf16_t* QP = (bf16_t*)(F.ws + WS_DN_QP); bf16_t* OLT = (bf16_t*)(F.ws + WS_DN_OLT);
    LAS unsigned char* lds = F.lds;
    LAS float* gcL = (LAS float*)(lds + L_GC); LAS float* betaL = (LAS float*)(lds + L_BETA);
    const float* cw = a.dn_conv_w + (size_t)l * DN_CONV * 768;
    const int lane = F.lane, w = F.wave, l15 = lane & 15, q4 = lane >> 4;
    LAS float* cwL = (LAS float*)(lds + L_GC + 512);
    int cur_h = -1;
    const int ci = F.tid >> 3, c8 = F.tid & 7;
    u32x4 xr[3][4]; float bgb = 0.f, bgg = 0.f;
#define CH_LOAD(vu_) { const int n_ = ((vu_) >> 2) & 255, h_ = (vu_) & 3, b_ = (vu_) >> 10; const int t_ = b_ * SEQ + n_ * 64 + ci; \
        _Pragma("unroll") for (int kd = 0; kd < 3; ++kd) _Pragma("unroll") for (int k = 0; k < DN_CONV; ++k) { \
            const int tt_ = (n_ * 64 + ci - (DN_CONV - 1) + k >= 0) ? t_ - (DN_CONV - 1) + k : t_; xr[kd][k] = *(const u32x4*)(P + (size_t)tt_ * NP + C_DQ + kd * 256 + h_ * 64 + c8 * 8); } \
        if (w == 0) { bgb = BG[(size_t)(b_ * SEQ + n_ * 64 + lane) * 8 + h_]; bgg = BG[(size_t)(b_ * SEQ + n_ * 64 + lane) * 8 + 4 + h_]; } }
    if (F.bid < BATCH * 4 * 256) CH_LOAD(F.bid)
    for (int vu = F.bid; vu < BATCH * 4 * 256; vu += F.nb) {
        const int n = (vu >> 2) & 255, h = vu & 3, b = vu >> 10, unit = (b * 4 + h) * 256 + n;
        const int t0 = b * SEQ + n * 64;
        int ln_ = F.lane; asm volatile("" : "+v"(ln_));
        const int lane = ln_, l15 = lane & 15, q4 = lane >> 4;
        __syncthreads();
        if (h != cur_h) { cur_h = h;
            for (int idx = F.tid; idx < DN_CONV * 3 * 64; idx += NTHREADS) { const int k = idx / 192, kd = (idx / 64) % 3, cc = idx & 63; cwL[idx] = cw[k * 768 + kd * 256 + h * 64 + cc]; }
            __syncthreads(); }
        {
            const int i = ci, sq = n * 64 + i;
#pragma unroll
            for (int kd = 0; kd < 3; ++kd) {
                float acc[8];
#pragma unroll
                for (int e = 0; e < 8; ++e) acc[e] = 0.f;
#pragma unroll
                for (int k = 0; k < DN_CONV; ++k) {
                    const u32x4 xv = xr[kd][k]; const float vm = (sq - (DN_CONV - 1) + k >= 0) ? 1.f : 0.f;
                    const f32x4 w0 = *(const LAS f32x4*)(cwL + (k * 3 + kd) * 64 + c8 * 8) * vm, w1 = *(const LAS f32x4*)(cwL + (k * 3 + kd) * 64 + c8 * 8 + 4) * vm;
                    acc[0] += w0.x * bf2f(xv.x & 0xffffu); acc[1] += w0.y * bf2f(xv.x >> 16); acc[2] += w0.z * bf2f(xv.y & 0xffffu); acc[3] += w0.w * bf2f(xv.y >> 16);
                    acc[4] += w1.x * bf2f(xv.z & 0xffffu); acc[5] += w1.y * bf2f(xv.z >> 16); acc[6] += w1.z * bf2f(xv.w & 0xffffu); acc[7] += w1.w * bf2f(xv.w >> 16);
                }
                float ss = 0.f;
#pragma unroll
                for (int e = 0; e < 8; ++e) { acc[e] = siluf_(acc[e]); ss += acc[e] * acc[e]; }
                if (kd < 2) {
                    ss = group8_sum(ss);
                    const float rn = rsqrtf(ss + EPS) * (kd == 0 ? 0.125f : 1.0f);
#pragma unroll
                    for (int e = 0; e < 8; ++e) acc[e] *= rn;
                }
                u32x4 pk; pk.x = cvtpk(acc[0], acc[1]); pk.y = cvtpk(acc[2], acc[3]); pk.z = cvtpk(acc[4], acc[5]); pk.w = cvtpk(acc[6], acc[7]);
                if (kd == 0) *(LAS u32x4*)(lds + L_QR + (i * DL + c8 * 8) * 2) = pk;
                if (kd == 1) *(LAS u32x4*)(lds + L_KR + (i * DL + c8 * 8) * 2) = pk;
                if (kd >= 1) {
                    LAS bf16_t* Tt = (LAS bf16_t*)(lds + (kd == 1 ? L_KT : L_VT));
                    const unsigned pw[4] = {pk.x, pk.y, pk.z, pk.w};
#pragma unroll
                    for (int e = 0; e < 8; ++e) Tt[(c8 * 8 + e) * DL + i] = (bf16_t)((pw[e >> 1] >> (16 * (e & 1))) & 0xffffu);
                }
            }
            for (int idx = F.tid; idx < 2 * LB / 16; idx += NTHREADS) *(LAS u32x4*)(lds + L_T1 + idx * 16) = (u32x4){0u, 0u, 0u, 0u};
            if (w == 0) {
                float x = bgg;
#pragma unroll
                for (int o = 1; o < 64; o <<= 1) { const float y = __shfl_up(x, o); if (lane >= o) x += y; }
                gcL[lane] = x; betaL[lane] = bgb;
            }
            if (vu + F.nb < BATCH * 4 * 256) CH_LOAD(vu + F.nb)
            asm volatile("" ::: "memory");
        }
        __syncthreads();
        REP(134217728)
#pragma unroll
        for (int tt = 0; tt < 2; ++tt) {
            const int tidx = 2 * w + tt, tx = tidx >> 2, ty = tidx & 3, i = 16 * ty + l15, j0 = 16 * tx + 4 * q4;
            const float gi = gcL[i], bi = betaL[i]; const f32x4 gj = *(const LAS f32x4*)(gcL + j0);
            const float gjv[4] = {gj.x, gj.y, gj.z, gj.w};
            const f32x4 zk = mm16<2>(lds, L_KR, L_KR, tx, ty, lane);
            const f32x4 zq = mm16<2>(lds, L_KR, L_QR, tx, ty, lane);
            f32x4 lv, av;
#pragma unroll
            for (int r = 0; r < 4; ++r) { const float dc = __expf(fminf(gi - gjv[r], 0.f)); lv[r] = (j0 + r < i) ? bi * zk[r] * dc : 0.f; av[r] = (j0 + r <= i) ? zq[r] * dc : 0.f; }
            if ((tx >> 1) == (ty >> 1)) {
                LAS float* lt = (LAS float*)(lds + L_LR) + ((ty >> 1) * 32 + (j0 & 31)) * 36 + ((i & 3) * 8 + ((i & 31) >> 2));
#pragma unroll
                for (int r = 0; r < 4; ++r) lt[r * 36] = lv[r]; }
            if (i >= 32 && j0 < 32) *(LAS u32x2*)(lds + L_L21 + ((i - 32) * DL + j0) * 2) = pack4(lv);
            *(LAS u32x2*)(lds + L_AR + (i * DL + j0) * 2) = pack4(av);
        }
        __syncthreads();
        REP(32768) if (w < 4) {
            const int c = 16 * w + (lane >> 2), blk = c >> 5, cb = c & 31, q = lane & 3;
            const LAS float* Lt = (const LAS float*)(lds + L_LR) + blk * 32 * 36 + q * 8;
            float d[8], xs[8];
#pragma unroll
            for (int jj = 0; jj < 8; ++jj) { d[jj] = (4 * jj + q == cb) ? 1.f : 0.f; xs[jj] = 0.f; }
            f32x4 X[8], Y[8];
#define SUB_HEAD(k_, ctrl_) constexpr int j_ = (k_) >> 2; const float t_ = d[j_]; const float xk_ = DPP_MOV(t_, ctrl_); xs[j_] = (q == ((k_) & 3)) ? t_ : xs[j_];
#define SUB_AB(k_, ctrl_, BUF_) { SUB_HEAD(k_, ctrl_) const f32x4 la_ = BUF_[(k_) & 3], lb_ = BUF_[4 + ((k_) & 3)]; \
                if (j_ <= 0) d[0] = __builtin_fmaf(-la_.x, xk_, d[0]); if (j_ <= 1) d[1] = __builtin_fmaf(-la_.y, xk_, d[1]); if (j_ <= 2) d[2] = __builtin_fmaf(-la_.z, xk_, d[2]); d[3] = __builtin_fmaf(-la_.w, xk_, d[3]); \
                d[4] = __builtin_fmaf(-lb_.x, xk_, d[4]); d[5] = __builtin_fmaf(-lb_.y, xk_, d[5]); d[6] = __builtin_fmaf(-lb_.z, xk_, d[6]); d[7] = __builtin_fmaf(-lb_.w, xk_, d[7]); }
#define SUB_B(k_, ctrl_, BUF_) { SUB_HEAD(k_, ctrl_) const f32x4 lb_ = BUF_[(k_) & 7]; \
                if (j_ <= 4) d[4] = __builtin_fmaf(-lb_.x, xk_, d[4]); if (j_ <= 5) d[5] = __builtin_fmaf(-lb_.y, xk_, d[5]); if (j_ <= 6) d[6] = __builtin_fmaf(-lb_.z, xk_, d[6]); d[7] = __builtin_fmaf(-lb_.w, xk_, d[7]); }
#define SUB_LD4(BUF_, k0_) { _Pragma("unroll") for (int k = 0; k < 4; ++k) { BUF_[k] = *(const LAS f32x4*)(Lt + ((k0_) + k) * 36); BUF_[4 + k] = *(const LAS f32x4*)(Lt + ((k0_) + k) * 36 + 4); } }
#define SUB_LD8(BUF_, k0_) { _Pragma("unroll") for (int k = 0; k < 8; ++k) BUF_[k] = *(const LAS f32x4*)(Lt + ((k0_) + k) * 36 + 4); }
#define SUB_FENCE __builtin_amdgcn_sched_barrier(0);
            SUB_LD4(X, 0) SUB_LD4(Y, 4) SUB_FENCE
            SUB_AB(0, 0x00, X) SUB_AB(1, 0x55, X) SUB_AB(2, 0xAA, X) SUB_AB(3, 0xFF, X) SUB_FENCE SUB_LD4(X, 8) SUB_FENCE
            SUB_AB(4, 0x00, Y) SUB_AB(5, 0x55, Y) SUB_AB(6, 0xAA, Y) SUB_AB(7, 0xFF, Y) SUB_FENCE SUB_LD4(Y, 12) SUB_FENCE
            SUB_AB(8, 0x00, X) SUB_AB(9, 0x55, X) SUB_AB(10, 0xAA, X) SUB_AB(11, 0xFF, X) SUB_FENCE SUB_LD8(X, 16) SUB_FENCE
            SUB_AB(12, 0x00, Y) SUB_AB(13, 0x55, Y) SUB_AB(14, 0xAA, Y) SUB_AB(15, 0xFF, Y) SUB_FENCE SUB_LD8(Y, 24) SUB_FENCE
            SUB_B(16, 0x00, X) SUB_B(17, 0x55, X) SUB_B(18, 0xAA, X) SUB_B(19, 0xFF, X) SUB_B(20, 0x00, X) SUB_B(21, 0x55, X) SUB_B(22, 0xAA, X) SUB_B(23, 0xFF, X)
            SUB_B(24, 0x00, Y) SUB_B(25, 0x55, Y) SUB_B(26, 0xAA, Y) SUB_B(27, 0xFF, Y) SUB_B(28, 0x00, Y) SUB_B(29, 0x55, Y) SUB_B(30, 0xAA, Y) SUB_B(31, 0xFF, Y)
#undef SUB_FENCE
#undef SUB_LD8
#undef SUB_LD4
#undef SUB_B
#undef SUB_AB
#undef SUB_HEAD
            const int jg = 32 * blk + cb; const float bj = betaL[jg], bej = bj * __expf(gcL[jg]);
            LAS bf16_t* T1 = (LAS bf16_t*)(lds + L_T1); LAS bf16_t* T2 = (LAS bf16_t*)(lds + L_T2);
#pragma unroll
            for (int jj = 0; jj < 8; ++jj) { const int rg = 32 * blk + 4 * jj + q; T1[rg * DL + jg] = (bf16_t)f2bf(xs[jj] * bj); T2[rg * DL + jg] = (bf16_t)f2bf(xs[jj] * bej); }
            if (blk == 0) { LAS bf16_t* T11 = (LAS bf16_t*)(lds + L_T11T);
#pragma unroll
                for (int jj = 0; jj < 8; ++jj) T11[cb * DL + 4 * jj + q] = (bf16_t)f2bf(xs[jj]); }
            else { LAS bf16_t* T22 = (LAS bf16_t*)(lds + L_T22R);
#pragma unroll
                for (int jj = 0; jj < 8; ++jj) T22[(4 * jj + q) * DL + cb] = (bf16_t)f2bf(xs[jj]); }
        }
        __syncthreads();
        if (w < 4) {
            const int tx = w >> 1, ty = w & 1;
            const f32x4 z = mm16<1>(lds, L_L21, L_T11T, tx, ty, lane);
            *(LAS u32x2*)(lds + L_YT + ((16 * ty + l15) * DL + 16 * tx + 4 * q4) * 2) = pack4(z);
        }
        __syncthreads();
        if (w < 4) {
            const int tx = w >> 1, ty = w & 1, y = 16 * ty + l15, x0 = 16 * tx + 4 * q4;
            const f32x4 z = mm16<1>(lds, L_T22R, L_YT, tx, ty, lane);
            const float bj = betaL[y], bej = bj * __expf(gcL[y]);
            LAS bf16_t* T1 = (LAS bf16_t*)(lds + L_T1); LAS bf16_t* T2 = (LAS bf16_t*)(lds + L_T2);
#pragma unroll
            for (int r = 0; r < 4; ++r) { T1[(32 + x0 + r) * DL + y] = (bf16_t)f2bf(-z[r] * bj); T2[(32 + x0 + r) * DL + y] = (bf16_t)f2bf(-z[r] * bej); }
        }
        __syncthreads();
        const float gl = gcL[63];
        REP(268435456)
#pragma unroll
        for (int tt = 0; tt < 2; ++tt) {
            const int tidx = 2 * w + tt, tx = tidx >> 2, ty = tidx & 3, y = 16 * ty + l15, x0 = 16 * tx + 4 * q4;
            const f32x4 gx = *(const LAS f32x4*)(gcL + x0);
            f32x4 sc; sc.x = __expf(gl - gx.x); sc.y = __expf(gl - gx.y); sc.z = __expf(gl - gx.z); sc.w = __expf(gl - gx.w);
            const f32x4 zu = mm16<2>(lds, L_T1, L_VT, tx, ty, lane);
            const f32x4 zw = mm16<2>(lds, L_T2, L_KT, tx, ty, lane);
            *(LAS u32x2*)(lds + L_UT + (y * DL + x0) * 2) = pack4(zu); *(LAS u32x2*)(lds + L_UPT + (y * DL + x0) * 2) = pack4(zu * sc);
            *(LAS u32x2*)(lds + L_WT + (y * DL + x0) * 2) = pack4(zw); *(LAS u32x2*)(lds + L_WPT + (y * DL + x0) * 2) = pack4(zw * sc);
        }
        __syncthreads();
        REP(65536) {
            const size_t cho = (size_t)unit * 4096;
            const float egl = __expf(gl);
#pragma unroll
            for (int tt = 0; tt < 2; ++tt) {
                const int tidx = 2 * w + tt, tx = tidx >> 2, ty = tidx & 3, y = 16 * ty + l15, x0 = 16 * tx + 4 * q4;
                f32x4 zm = mm16<2>(lds, L_WPT, L_KT, tx, ty, lane);
#pragma unroll
                for (int r = 0; r < 4; ++r) zm[r] = ((x0 + r) == y ? egl : 0.f) - zm[r];
                *(u32x2*)(MR + cho + (ty * 2 + (tx >> 1)) * 512 + lane * 8 + 4 * (tx & 1)) = pack4(zm);
                const f32x4 zb = mm16<2>(lds, L_KT, L_UPT, tx, ty, lane);
                *(u32x2*)(BNT + cho + (ty * 4 + tx) * 256 + lane * 4) = pack4(zb);
                const f32x4 zq = mm16<2>(lds, L_WT, L_AR, tx, ty, lane);
                const u32x2 qv = *(const LAS u32x2*)(lds + L_QR + (y * DL + x0) * 2); const float eg = __expf(gcL[y]);
                f32x4 qp; qp.x = bf2f(qv.x & 0xffffu) * eg - zq.x; qp.y = bf2f(qv.x >> 16) * eg - zq.y; qp.z = bf2f(qv.y & 0xffffu) * eg - zq.z; qp.w = bf2f(qv.y >> 16) * eg - zq.w;
                *(u32x2*)(QP + cho + y * 64 + x0) = pack4(qp);
                const f32x4 zo = mm16<2>(lds, L_AR, L_UT, tx, ty, lane);
                *(u32x2*)(OLT + cho + y * 64 + x0) = pack4(zo);
            }
        }
    }
    __syncthreads();
}
#undef CH_LOAD
constexpr int SC_SLOT = 10240, SC_DEPTH = 12, SC_AHEAD = 10, SC_STS = 2 * 16 * 144;
#define SC_BAR() do { asm volatile("" ::: "memory"); __builtin_amdgcn_s_barrier(); asm volatile("" ::: "memory"); } while (0)
__device__ __forceinline__ void ph_dn_scan(const Args& a, Frame& F, int l) {
    if (F.bid >= NSCAN) return;
    GAS unsigned* prog = (GAS unsigned*)(F.ws + WS_CTL) + CW_SCANP + l * 4096 + 64 * F.bid;
    const unsigned char* MRb = (const unsigned char*)(F.ws + WS_DN_MR); const unsigned char* BNb = (const unsigned char*)(F.ws + WS_DN_BNT); GAS bf16_t* ST = (GAS bf16_t*)(F.ws + WS_DN_ST);
    const int lane = F.lane, l15 = lane & 15, q4 = lane >> 4, wq = F.bid >> 3;
    const size_t ch0 = (size_t)(F.bid & 7) * 256;
    LAS unsigned char* lds = F.lds; LAS unsigned char* stl = F.lds + RI_OFF;
    __syncthreads();
    if (F.wave >= 3) {
        const int lw = F.wave - 3;
        const int pc0 = lw * 2, pc1 = lw * 2 + 1;
        const unsigned char* s0 = (pc0 < 8 ? MRb + pc0 * 1024 : BNb + wq * 2048 + (pc0 - 8) * 1024) + ch0 * 8192 + lane * 16;
        int slo = 0, nis = 0;
#define DN_ISSUE1() do { \
            __builtin_amdgcn_global_load_lds((const unsigned*)s0, (LAS unsigned*)(lds + slo + pc0 * 1024), 16, 0, 2); \
            __builtin_amdgcn_global_load_lds((const unsigned*)s0, (LAS unsigned*)(lds + slo + pc0 * 1024), 16, 1024, 2);     \
            const int adv_ = nis < 255 ? 8192 : 0; s0 += adv_; ++nis; slo = (slo + SC_SLOT == SC_DEPTH * SC_SLOT) ? 0 : slo + SC_SLOT; } while (0)
        for (int n = 0; n < SC_AHEAD; ++n) DN_ISSUE1();
        for (int n = 0; n < 256; n += 2) {
            asm volatile("s_waitcnt vmcnt(16)" ::: "memory");
            SC_BAR();
            DN_ISSUE1(); DN_ISSUE1();
        }
        asm volatile("s_waitcnt vmcnt(0)" ::: "memory");
        SC_BAR();
#undef DN_ISSUE1
    } else if (F.wave == 0) {
        const int dv = 16 * wq + l15;
        f32x4 S[4];
#pragma unroll
        for (int ti = 0; ti < 4; ++ti) S[ti] = (f32x4){0.f, 0.f, 0.f, 0.f};
        for (int n0 = 0; n0 < 256; n0 += 2) {
            SC_BAR();
            bf16x8_t A[2][4][2]; u32x2 Bc[2][4];
#pragma unroll
            for (int e = 0; e < 2; ++e) { const LAS unsigned char* slot = lds + ((n0 + e) % SC_DEPTH) * SC_SLOT;
#pragma unroll
                for (int ti = 0; ti < 4; ++ti) {
#pragma unroll
                    for (int ks = 0; ks < 2; ++ks) A[e][ti][ks] = *(const LAS bf16x8_t*)(slot + (ti * 2 + ks) * 1024 + lane * 16);
                    Bc[e][ti] = *(const LAS u32x2*)(slot + 8192 + ti * 512 + lane * 8);
                } }
#pragma unroll
            for (int e = 0; e < 2; ++e) {
                const int n = n0 + e;
                u32x2 sp[4];
#pragma unroll
                for (int ti = 0; ti < 4; ++ti) { sp[ti] = pack4(S[ti]); *(LAS u32x2*)(stl + ((n0 >> 1) & 1) * SC_STS + e * (SC_STS / 2) + l15 * 144 + (16 * ti + 4 * q4) * 2) = sp[ti]; }
                const bf16x8_t b0 = __builtin_bit_cast(bf16x8_t, (u32x4){sp[0].x, sp[0].y, sp[1].x, sp[1].y});
                const bf16x8_t b1 = __builtin_bit_cast(bf16x8_t, (u32x4){sp[2].x, sp[2].y, sp[3].x, sp[3].y});
#pragma unroll
                for (int ti = 0; ti < 4; ++ti) {
                    f32x4 c; c.x = bf2f(Bc[e][ti].x & 0xffffu); c.y = bf2f(Bc[e][ti].x >> 16); c.z = bf2f(Bc[e][ti].y & 0xffffu); c.w = bf2f(Bc[e][ti].y >> 16);
                    c = __builtin_amdgcn_mfma_f32_16x16x32_bf16(A[e][ti][0], b0, c, 0, 0, 0);
                    c = __builtin_amdgcn_mfma_f32_16x16x32_bf16(A[e][ti][1], b1, c, 0, 0, 0);
                    S[ti] = c;
                }
            }
            asm volatile("s_waitcnt lgkmcnt(0)" ::: "memory");
        }
        SC_BAR();
    } else if (F.wave == 1) {
        GAS unsigned char* stg = (GAS unsigned char*)(ST + ch0 * 4096 + (size_t)(16 * wq) * 64);
        for (int n0 = 0; n0 <= 256; n0 += 2) {
            SC_BAR();
            if (n0 >= 2) {
                const LAS unsigned char* slot = stl + (((n0 - 2) >> 1) & 1) * SC_STS;
                u32x4 sv[4];
#pragma unroll
                for (int e = 0; e < 2; ++e)
#pragma unroll
                    for (int i = 0; i < 2; ++i) { const int pc = i * 64 + lane; sv[e * 2 + i] = *(const LAS u32x4*)(slot + e * (SC_STS / 2) + (pc >> 3) * 144 + (pc & 7) * 16); }
                __builtin_amdgcn_sched_barrier(0);
#pragma unroll
                for (int e = 0; e < 2; ++e)
#pragma unroll
                    for (int i = 0; i < 2; ++i) { const int pc = i * 64 + lane;
                        const unsigned long long gp = (unsigned long long)(stg + (size_t)(n0 - 2 + e) * 8192 + pc * 16);
                        asm volatile("global_store_dwordx4 %0, %1, off sc1\n\ts_nop 2" :: "v"(gp), "v"(sv[e * 2 + i]) : "memory"); }
                asm volatile("s_waitcnt vmcnt(40)" ::: "memory");
                if (lane == 0) __hip_atomic_store(prog, (unsigned)(n0 >= 16 ? n0 - 16 : 0), __ATOMIC_RELAXED, __HIP_MEMORY_SCOPE_AGENT);
            }
        }
        asm volatile("s_waitcnt vmcnt(0)" ::: "memory");
        if (lane == 0) __hip_atomic_store(prog, 256u, __ATOMIC_RELAXED, __HIP_MEMORY_SCOPE_AGENT);
    } else {
        for (int n = 0; n <= 256; n += 2) SC_BAR();
    }
    __syncthreads();
}
#undef SC_BAR
__device__ __forceinline__ void ph_dn_out(const Args& a, Frame& F, int l) {
    const bf16_t* QP = (const bf16_t*)(F.ws + WS_DN_QP); const bf16_t* OLT = (const bf16_t*)(F.ws + WS_DN_OLT); const bf16_t* ST = (const bf16_t*)(F.ws + WS_DN_ST);
    const bf16_t* P = (const bf16_t*)(F.ws + WS_PROJ); bf16_t* Y = (bf16_t*)(F.ws + WS_YMIX);
    const int lane = F.lane, l15 = lane & 15, q4 = lane >> 4, ti = F.wave & 3;
    LAS bf16_t* TL = (LAS bf16_t*)(F.lds + F.wave * 2560);
    const int er = lane >> 2, ec = (lane & 3) * 16;
    f32x4 gnv[4];
#pragma unroll
    for (int j = 0; j < 4; ++j) gnv[j] = *(const f32x4*)(a.dn_norm_g + l * 64 + ec + 4 * j);
    bf16x8_t af[2], bfv[4][2]; u32x2 ov[4];
    int pr0, prs, pre;
    if (F.nb == 256 && NSCAN == 32) { const int v = F.bid - NSCAN;
        if (v >= 32) { pr0 = v - 32; prs = 192; pre = 960; } else if (v >= 0) { pr0 = 960 + v; prs = 1024; pre = 1024; } else { pr0 = 992 + F.bid; prs = 1024; pre = 1024; } }
    else { if (F.bid < NSCAN) return; pr0 = F.bid - NSCAN; prs = F.nb - NSCAN; pre = 1024; }
    GAS unsigned* prog = (GAS unsigned*)(F.ws + WS_CTL) + CW_SCANP + l * 4096; unsigned* tmo = (unsigned*)(F.ws + WS_CTL) + CW_BAR + XB_TMO;
    unsigned seen = 0;
    volatile LAS unsigned* seenl = (volatile LAS unsigned*)(F.lds + MISC_OFF) + 16;
#define DNO_WAIT(prv) { const unsigned need_ = 2u * (unsigned)((prv) >> 3) + 2u; const int bh_ = (prv) & 7; if ((prs & 7) != 0) seen = 0; if (seen < need_) {   \
        if (F.wave == 0) { unsigned sp_ = 0, m_; \
            for (;;) { unsigned v_ = lane < 4 ? __hip_atomic_load(prog + 64 * (bh_ + 8 * lane), __ATOMIC_RELAXED, __HIP_MEMORY_SCOPE_AGENT) : 0xffffffffu; \
                _Pragma("unroll") for (int o_ = 2; o_ >= 1; o_ >>= 1) { const unsigned w_ = (unsigned)__shfl_xor((int)v_, o_); v_ = w_ < v_ ? w_ : v_; } \
                m_ = (unsigned)__builtin_amdgcn_readfirstlane((int)v_); if (m_ >= need_) break; \
                __builtin_amdgcn_s_sleep(8); \
                if ((++sp_ & 63u) == 0u) { if (xb_ld(tmo)) break; if (sp_ > (1u << 16)) { atomicAdd(tmo, 1u); break; } } } \
            __builtin_amdgcn_fence(__ATOMIC_ACQUIRE, "agent"); asm volatile("s_waitcnt vmcnt(0)" ::: "memory"); \
            if (lane == 0) *seenl = m_; } \
        __syncthreads(); seen = *seenl; __syncthreads(); } }
#define DNO_LOAD(prv) { const int unit_ = (((prv) & 7) << 8) + 2 * ((prv) >> 3) + (F.wave >> 2); const size_t cho_ = (size_t)unit_ * 4096; \
        _Pragma("unroll") for (int ks = 0; ks < 2; ++ks) af[ks] = *(const bf16x8_t*)(QP + cho_ + (16 * ti + l15) * 64 + 32 * ks + 8 * q4); \
        _Pragma("unroll") for (int tj = 0; tj < 4; ++tj) { ov[tj] = *(const u32x2*)(OLT + cho_ + (16 * tj + l15) * 64 + 16 * ti + 4 * q4); \
            _Pragma("unroll") for (int ks = 0; ks < 2; ++ks) bfv[tj][ks] = *(const bf16x8_t*)(ST + cho_ + (16 * tj + l15) * 64 + 32 * ks + 8 * q4); } }
    if (pr0 < pre) { DNO_WAIT(pr0) DNO_LOAD(pr0) }
    for (int pr = pr0; pr < pre; pr += prs) {
        const int unit = ((pr & 7) << 8) + 2 * (pr >> 3) + (F.wave >> 2), n = unit & 255, h = (unit >> 8) & 3, b = unit >> 10;
        f32x4 acc[4];
#pragma unroll
        for (int tj = 0; tj < 4; ++tj) {
            f32x4 c; c.x = bf2f(ov[tj].x & 0xffffu); c.y = bf2f(ov[tj].x >> 16); c.z = bf2f(ov[tj].y & 0xffffu); c.w = bf2f(ov[tj].y >> 16);
#pragma unroll
            for (int ks = 0; ks < 2; ++ks) c = __builtin_amdgcn_mfma_f32_16x16x32_bf16(af[ks], bfv[tj][ks], c, 0, 0, 0);
            acc[tj] = c;
        }
        const size_t trow = (size_t)b * SEQ + n * 64 + 16 * ti + er;
        const u32x4 z0 = *(const u32x4*)(P + trow * NP + C_DZ + h * 64 + ec), z1 = *(const u32x4*)(P + trow * NP + C_DZ + h * 64 + ec + 8);
        if (pr + prs < pre) { DNO_WAIT(pr + prs) DNO_LOAD(pr + prs) }
        f32x4 ss = acc[0] * acc[0] + acc[1] * acc[1] + acc[2] * acc[2] + acc[3] * acc[3];
        ss.x = row16_sum(ss.x); ss.y = row16_sum(ss.y); ss.z = row16_sum(ss.z); ss.w = row16_sum(ss.w);
        const float rs[4] = {rsqrtf(ss.x * (1.f / 64.f) + EPS), rsqrtf(ss.y * (1.f / 64.f) + EPS), rsqrtf(ss.z * (1.f / 64.f) + EPS), rsqrtf(ss.w * (1.f / 64.f) + EPS)};
#pragma unroll
        for (int tj = 0; tj < 4; ++tj)
#pragma unroll
            for (int r = 0; r < 4; ++r) TL[(4 * q4 + r) * 80 + 16 * tj + l15] = (bf16_t)f2bf(acc[tj][r] * rs[r]);
        const u32x4 t0 = *(const LAS u32x4*)(TL + er * 80 + ec), t1 = *(const LAS u32x4*)(TL + er * 80 + ec + 8);
        const unsigned tw[8] = {t0.x, t0.y, t0.z, t0.w, t1.x, t1.y, t1.z, t1.w}, zw[8] = {z0.x, z0.y, z0.z, z0.w, z1.x, z1.y, z1.z, z1.w};
        unsigned yw[8];
#pragma unroll
        for (int j = 0; j < 8; ++j) {
            const float g0 = gnv[j >> 1][(2 * j) & 3], g1 = gnv[j >> 1][(2 * j + 1) & 3];
            yw[j] = cvtpk(bf2f(tw[j] & 0xffffu) * g0 * siluf_(bf2f(zw[j] & 0xffffu)), bf2f(tw[j] >> 16) * g1 * siluf_(bf2f(zw[j] >> 16)));
        }
        bf16_t* yp = Y + trow * D + 512 + h * 64 + ec;
        *(u32x4*)yp = (u32x4){yw[0], yw[1], yw[2], yw[3]}; *(u32x4*)(yp + 8) = (u32x4){yw[4], yw[5], yw[6], yw[7]};
    }
#undef DNO_LOAD
#undef DNO_WAIT
}

__device__ __forceinline__ void ph_conv_fast(const Args& a, Frame& F, int l) {
    const bf16_t* P = (const bf16_t*)(F.ws + WS_PROJ); bf16_t* Y = (bf16_t*)(F.ws + WS_YMIX);
    LAS float* OUTL = (LAS float*)F.lds;
    const int c = F.tid & 255, rsel = F.tid >> 8;
    float wk[CV_K];
#pragma unroll
    for (int k = 0; k < CV_K; ++k) wk[k] = a.cv_dw_w[((size_t)l * CV_K + k) * CV_C + c];
    const float bias = a.cv_dw_b[l * CV_C + c];
    const int nsc = NSCAN;
    if (F.bid < nsc) return;
    for (int pr = F.bid - nsc; pr < T / 128; pr += F.nb - nsc) {
        const int run = 2 * pr + rsel, t0 = run * 64, s0 = t0 % SEQ;
        __syncthreads();
        float win[CV_K];
        const bf16_t* pc = P + (size_t)(t0 - 30) * NP + C_CA + c;
        const bool first = (s0 == 0);
        LAS float* outp = OUTL + (rsel * 64) * 256 + c;
        unsigned short ra0[CV_K], rb0[CV_K], ra1[CV_K], rb1[CV_K];
#define CV_RAW(blk_, RA_, RB_) { _Pragma("unroll") for (int p = 0; p < CV_K; ++p) { const int ti_ = (blk_) * CV_K + p; const bool ok_ = !(first && ti_ < 30); \
            const bf16_t* q_ = ok_ ? pc + (size_t)ti_ * NP : pc + (size_t)30 * NP; RA_[p] = q_[0]; RB_[p] = q_[256]; } }
#define CV_GLU(a_, b_) (bf2f(a_) * sigmoidf_(bf2f(b_)))
        CV_RAW(0, ra0, rb0) CV_RAW(1, ra1, rb1)
        __builtin_amdgcn_sched_barrier(0);
#pragma unroll
        for (int p = 0; p < CV_K; ++p) win[p] = (first && p < 30) ? 0.f : CV_GLU(ra0[p], rb0[p]);
        { float acc = bias;
#pragma unroll
            for (int k = 0; k < CV_K; ++k) acc += wk[k] * win[(30 + 1 + k) % CV_K];
            outp[0] = acc; }
        __builtin_amdgcn_sched_barrier(0);
        CV_RAW(2, ra0, rb0)
        const bf16_t* q93 = pc + (size_t)93 * NP; const unsigned short a93 = q93[0], b93 = q93[256];
        __builtin_amdgcn_sched_barrier(0);
#pragma unroll
        for (int p = 0; p < CV_K; ++p) {
            win[p] = CV_GLU(ra1[p], rb1[p]);
            float acc = bias;
#pragma unroll
            for (int k = 0; k < CV_K; ++k) acc += wk[k] * win[(p + 1 + k) % CV_K];
            outp[(CV_K + p - 30) * 256] = acc;
        }
#pragma unroll
        for (int p = 0; p < CV_K; ++p) {
            win[p] = CV_GLU(ra0[p], rb0[p]);
            float acc = bias;
#pragma unroll
            for (int k = 0; k < CV_K; ++k) acc += wk[k] * win[(p + 1 + k) % CV_K];
            outp[(2 * CV_K + p - 30) * 256] = acc;
        }
        { win[0] = CV_GLU(a93, b93); float acc = bias;
#pragma unroll
            for (int k = 0; k < CV_K; ++k) acc += wk[k] * win[(0 + 1 + k) % CV_K];
            outp[63 * 256] = acc; }
#undef CV_GLU
#undef CV_RAW
        __syncthreads();
        const f32x4 g4 = *(const f32x4*)(a.cv_ln_g + l * CV_C + 4 * F.lane), b4 = *(const f32x4*)(a.cv_ln_b + l * CV_C + 4 * F.lane);
#pragma unroll 4
        for (int j = 0; j < 16; ++j) {
            const int tl = F.wave * 16 + j;
            const f32x4 v = *(const LAS f32x4*)(OUTL + tl * 256 + 4 * F.lane);
            const float mean = wave_sum((v.x + v.y) + (v.z + v.w)) * (1.0f / CV_C);
            const f32x4 dv = v - mean;
            const float var = wave_sum((dv.x * dv.x + dv.y * dv.y) + (dv.z * dv.z + dv.w * dv.w)) * (1.0f / CV_C);
            const float rstd = rsqrtf(var + EPS);
            const f32x4 y = (dv * rstd) * g4 + b4;
            u32x2 o; o.x = cvtpk(siluf_(y.x), siluf_(y.y)); o.y = cvtpk(siluf_(y.z), siluf_(y.w));
            *(u32x2*)(Y + (size_t)(pr * 128 + tl) * D + 768 + 4 * F.lane) = o;
        }
    }
    __syncthreads();
}

__device__ __forceinline__ void moe_bases(Frame& F, int (&base)[9], int (&cnt)[8]) {
    const unsigned* c = (const unsigned*)(F.ws + WS_CTL) + CW_MOECNT;
    int acc = 0;
#pragma unroll
    for (int e = 0; e < 8; ++e) { cnt[e] = (int)__hip_atomic_load(c + 64 * e, __ATOMIC_RELAXED, __HIP_MEMORY_SCOPE_AGENT); base[e] = acc; acc += (cnt[e] + 255) & ~255; }
    base[8] = acc;
}
__device__ __forceinline__ void moe_range(Frame& F, int e, int& lo, int& hi) {
    const unsigned* c = (const unsigned*)(F.ws + WS_CTL) + CW_MOECNT;
    int acc = 0; lo = 0; hi = 0;
#pragma unroll
    for (int k = 0; k < 8; ++k) { const int n = ((int)__hip_atomic_load(c + 64 * k, __ATOMIC_RELAXED, __HIP_MEMORY_SCOPE_AGENT) + 255) & ~255; if (k == e) { lo = acc; hi = acc + n; } acc += n; }
}
__device__ __forceinline__ void ph_moe_list(const Args& a, Frame& F) {
    int base[9], cnt[8]; moe_bases(F, base, cnt);
    int* RM = (int*)(F.ws + WS_RMAP); const int* R = (const int*)(F.ws + WS_ROUTE); const int* Pq = (const int*)(F.ws + WS_POS);
    for (int t = F.bid * NTHREADS + F.tid; t < T; t += F.nb * NTHREADS) {
        const int e0 = R[t * 4], e1 = R[t * 4 + 1];
        int b0 = 0, b1 = 0;
#pragma unroll
        for (int e = 0; e < 8; ++e) { if (e == e0) b0 = base[e]; if (e == e1) b1 = base[e]; }
        RM[b0 + Pq[t * 2]] = t; RM[b1 + Pq[t * 2 + 1]] = t;
    }
    if (F.bid == 0) {
#pragma unroll
        for (int e = 0; e < 8; ++e) { const int lo = base[e] + cnt[e], hi = base[e + 1]; for (int r = lo + F.tid; r < hi; r += NTHREADS) RM[r] = 0; }
    }
}
__device__ __forceinline__ void ph_final(const Args& a, Frame& F) {
    int base[9], cnt[8]; moe_bases(F, base, cnt);
    const float* MOD = (const float*)(F.ws + WS_MOD);
    const bf16_t* YM = (const bf16_t*)(F.ws + WS_YMOE); const int* R = (const int*)(F.ws + WS_ROUTE); const int* Pq = (const int*)(F.ws + WS_POS); const bf16_t* X16 = (const bf16_t*)(F.ws + WS_X16);
    const int c0 = 8 * F.lane;
    f32x4 fg[4], gt[4]; int cur_b = -1;
#pragma unroll
    for (int j = 0; j < 4; ++j) fg[j] = *(const f32x4*)(a.final_g + 512 * (j >> 1) + c0 + 4 * (j & 1));
    u32x4 dxA[2], dy0A[2], dy1A[2], dxB[2], dy0B[2], dy1B[2]; float p0A = 0.f, p1A = 0.f, p0B = 0.f, p1B = 0.f;
#define FIN_DATA(i_, DX, DY0, DY1, P0, P1) { const int row_ = row0 + (i_) * F.ngw; if ((i_) < 16 && row_ < T) { \
        const int e0_ = __builtin_amdgcn_readlane((int)rtv.x, (i_) & 15), e1_ = __builtin_amdgcn_readlane((int)rtv.y, (i_) & 15), q0_ = __builtin_amdgcn_readlane((int)pqv.x, (i_) & 15), q1_ = __builtin_amdgcn_readlane((int)pqv.y, (i_) & 15); \
        P0 = __uint_as_float((unsigned)__builtin_amdgcn_readlane((int)rtv.z, (i_) & 15)); P1 = __uint_as_float((unsigned)__builtin_amdgcn_readlane((int)rtv.w, (i_) & 15)); \
        int b0_ = 0, b1_ = 0; _Pragma("unroll") for (int e = 0; e < 8; ++e) { if (e == e0_) b0_ = base[e]; if (e == e1_) b1_ = base[e]; } \
        const size_t s0_ = (size_t)(b0_ + q0_), s1_ = (size_t)(b1_ + q1_); \
        _Pragma("unroll") for (int jj = 0; jj < 2; ++jj) { DX[jj] = __builtin_nontemporal_load((const u32x4*)(X16 + (size_t)row_ * D + 512 * jj + c0)); DY0[jj] = __builtin_nontemporal_load((const u32x4*)(YM + s0_ * D + 512 * jj + c0)); \
            DY1[jj] = __builtin_nontemporal_load((const u32x4*)(YM + s1_ * D + 512 * jj + c0)); } } }
#define FIN_ROW(i_, DX, DY0, DY1, P0, P1) { const int row = row0 + (i_) * F.ngw; if (row < T) { \
        const int b = row / SEQ; \
        if (b != cur_b) { cur_b = b; const float* gt2 = MOD + ((size_t)(1 * 2 + 1) * 2 + b) * 3072 + 2048; \
            _Pragma("unroll") for (int j = 0; j < 4; ++j) gt[j] = *(const f32x4*)(gt2 + 512 * (j >> 1) + c0 + 4 * (j & 1)); } \
        f32x4 v[4]; float ss = 0.f; const float p0 = P0, p1 = P1; \
        _Pragma("unroll") for (int jj = 0; jj < 2; ++jj) { \
            const unsigned xw[4] = {DX[jj].x, DX[jj].y, DX[jj].z, DX[jj].w}, y0w[4] = {DY0[jj].x, DY0[jj].y, DY0[jj].z, DY0[jj].w}, y1w[4] = {DY1[jj].x, DY1[jj].y, DY1[jj].z, DY1[jj].w}; \
            _Pragma("unroll") for (int hf = 0; hf < 2; ++hf) { \
                f32x4 f, xo; \
                f.x = p0 * bf2f(y0w[2 * hf] & 0xffffu) + p1 * bf2f(y1w[2 * hf] & 0xffffu); f.y = p0 * bf2f(y0w[2 * hf] >> 16) + p1 * bf2f(y1w[2 * hf] >> 16); \
                f.z = p0 * bf2f(y0w[2 * hf + 1] & 0xffffu) + p1 * bf2f(y1w[2 * hf + 1] & 0xffffu); f.w = p0 * bf2f(y0w[2 * hf + 1] >> 16) + p1 * bf2f(y1w[2 * hf + 1] >> 16); \
                xo.x = bf2f(xw[2 * hf] & 0xffffu); xo.y = bf2f(xw[2 * hf] >> 16); xo.z = bf2f(xw[2 * hf + 1] & 0xffffu); xo.w = bf2f(xw[2 * hf + 1] >> 16); \
                const f32x4 vv = xo + gt[2 * jj + hf] * f; v[2 * jj + hf] = vv; \
                ss += (vv.x * vv.x + vv.y * vv.y) + (vv.z * vv.z + vv.w * vv.w); } } \
        FIN_DATA((i_) + 2, DX, DY0, DY1, P0, P1) \
        const float rstd = rsqrtf(wave_sum(ss) * (1.0f / D) + EPS); \
        float* op = a.out + (size_t)row * D + c0; \
        _Pragma("unroll") for (int j = 0; j < 4; ++j) __builtin_nontemporal_store((v[j] * rstd) * fg[j], (f32x4*)(op + 512 * (j >> 1) + 4 * (j & 1))); } }
    for (int row0 = F.gw; row0 < T; row0 += 16 * F.ngw) {
        const int rj = row0 + (F.lane & 15) * F.ngw, rjc = rj < T ? rj : row0;
        const u32x4 rtv = *(const u32x4*)(R + (size_t)rjc * 4); const u32x2 pqv = *(const u32x2*)(Pq + (size_t)rjc * 2);
        FIN_DATA(0, dxA, dy0A, dy1A, p0A, p1A) FIN_DATA(1, dxB, dy0B, dy1B, p0B, p1B)
#pragma unroll 1
        for (int i = 0; i < 16; i += 2) { FIN_ROW(i, dxA, dy0A, dy1A, p0A, p1A) FIN_ROW(i + 1, dxB, dy0B, dy1B, p0B, p1B) }
    }
#undef FIN_ROW
#undef FIN_DATA
}


namespace pg8 {
typedef short bf16x8 __attribute__((ext_vector_type(8)));
constexpr int BM = 256, BK = 64, HALF = 128, HTB = HALF * BK * 2, STAGE_BYTES = 8 * HTB;
__device__ __forceinline__ int lds_byte(int r, int c) { const int st = (r >> 4) * 2 + (c >> 5), rr = r & 15, cc = c & 31, ob = rr * 64 + cc * 2; return st * 1024 + (ob ^ (((ob >> 9) & 1) << 5)); }
__device__ __forceinline__ void stage_rc(int b, int& R, int& C) { const int st = b / 1024, sb = b % 1024, swz = sb ^ (((sb >> 9) & 1) << 5); R = (st >> 1) * 16 + swz / 64; C = (st & 1) * 32 + (swz % 64) / 2; }
__device__ __forceinline__ int perm32(int rho) { const int n = rho >> 4, i = rho & 15; return 8 * (i >> 2) + 4 * n + (i & 3); }
struct Unit { int pm, pn, ord, pnb; };
struct Gemm { const bf16_t* A; const bf16_t* Bt; int K; };
constexpr int NXCD = 8, WGM = 8;
constexpr int PNB_B0 = 160, PNB_B1 = 224;
struct StaticOrder {
    int nM, nN, nwg, G, c, bsplit;
    __device__ void init(int M, int N, int G_, int c_) { nM = M / BM; nN = N / BM; nwg = nM * nN; G = G_; c = c_; bsplit = 0; }
    __device__ __forceinline__ bool next(int i, Unit& u) const {
        const long L = (long)i * G + c; if (L >= nwg) return false;
        int wgid = (int)L; { const int q = nwg / NXCD, r = nwg % NXCD, xcd = wgid % NXCD, off = wgid / NXCD; wgid = (xcd < r ? xcd * (q + 1) : r * (q + 1) + (xcd - r) * q) + off; }
        const int nig = WGM * nN, gid = wgid / nig, fm = gid * WGM, gsz = (nM - fm) < WGM ? (nM - fm) : WGM;
        u.pm = fm + ((wgid % nig) % gsz); u.pn = (wgid % nig) / gsz; u.pnb = u.pn + (bsplit ? (u.pm >= bsplit ? PNB_B1 : PNB_B0) : 0); return true;
    }
};
template <int NT> struct MoeOrder {
    int bt[9]; int cnt[8]; int G, c, rk;
    GAS unsigned* alld; volatile LAS unsigned* seen_all;
    GAS unsigned* ready; unsigned need; unsigned* tmo;
    __device__ __forceinline__ void a_ready(const Unit& u) const {
        if (threadIdx.x < 64 && *seen_all == 0u) { unsigned sp = 0;
            if ((unsigned)__builtin_amdgcn_readfirstlane((int)__hip_atomic_load(alld, __ATOMIC_RELAXED, __HIP_MEMORY_SCOPE_AGENT)) == (unsigned)G) { if (threadIdx.x == 0) *seen_all = 1u; }
            else while ((unsigned)__builtin_amdgcn_readfirstlane((int)__hip_atomic_load(ready + 64 * u.pm, __ATOMIC_RELAXED, __HIP_MEMORY_SCOPE_AGENT)) < need) {
                __builtin_amdgcn_s_sleep(4);
                if ((++sp & 63u) == 0u) { if (__hip_atomic_load(tmo, __ATOMIC_RELAXED, __HIP_MEMORY_SCOPE_AGENT)) break; if (sp > (1u << 16)) { atomicAdd(tmo, 1u); break; } } }
            __builtin_amdgcn_fence(__ATOMIC_ACQUIRE, "agent"); asm volatile("s_waitcnt vmcnt(0)" ::: "memory"); }
        asm volatile("" ::: "memory"); __builtin_amdgcn_s_barrier(); asm volatile("" ::: "memory");
    }
    __device__ __forceinline__ bool next(int i, Unit& u) const {
        int q, tn;
        if ((G & 7) == 0) { const int x = c & 7, Ll = i * (G >> 3) + rk; q = (Ll / NT) * 8 + x; tn = Ll % NT; if (q >= bt[8]) return false; }
        else { const int L = i * G + c; if (L >= bt[8] * NT) return false; q = L / NT; tn = L % NT; }
        int e = 0;
#pragma unroll
        for (int k = 1; k < 8; ++k) e += (q >= bt[k]) ? 1 : 0;
        u.pm = q; u.pn = e * NT + tn; u.pnb = u.pn; return true;
    }
};
__device__ __forceinline__ unsigned cvt_pk_bf16(float lo, float hi) { unsigned r; asm volatile("v_cvt_pk_bf16_f32 %0, %1, %2" : "=v"(r) : "v"(lo), "v"(hi)); return r; }
__device__ __forceinline__ float fast_silu(float x) { return x * __builtin_amdgcn_rcpf(1.0f + __builtin_amdgcn_exp2f(x * -1.4426950408889634f)); }

struct EpiBf16 {
    static constexpr bool PERM = true, WIDE = false;
    bf16_t* O; int ldc; int nmod;
    __device__ __forceinline__ void operator()(const f32x4 (&acc)[2][2][4][2], const Unit& u, int wr, int wc, int fr, int fq) const {
        const int row0 = u.pm * BM + wr * 64 + fr, col0 = (u.pn % nmod) * BM + wc * 32 + 8 * fq;
#pragma unroll
        for (int ai = 0; ai < 2; ++ai)
#pragma unroll
            for (int m = 0; m < 4; ++m) { bf16_t* rowp = O + (size_t)(row0 + ai * HALF + m * 16) * ldc + col0;
#pragma unroll
                for (int bj = 0; bj < 2; ++bj) { const f32x4 v0 = acc[ai][bj][m][0], v1 = acc[ai][bj][m][1];
                    u32x4 w; w.x = cvt_pk_bf16(v0[0], v0[1]); w.y = cvt_pk_bf16(v0[2], v0[3]); w.z = cvt_pk_bf16(v1[0], v1[1]); w.w = cvt_pk_bf16(v1[2], v1[3]);
                    *(u32x4*)(rowp + bj * HALF) = w; } }
    }
};
struct EpiSwiGLU {
    static constexpr bool PERM = true, WIDE = false;
    bf16_t* O; int ldc; int nmod;
    __device__ __forceinline__ void operator()(const f32x4 (&acc)[2][2][4][2], const Unit& u, int wr, int wc, int fr, int fq) const {
        const int row0 = u.pm * BM + wr * 64 + fr, col0 = (u.pn % nmod) * HALF + wc * 32 + 8 * fq;
#pragma unroll
        for (int ai = 0; ai < 2; ++ai)
#pragma unroll
            for (int m = 0; m < 4; ++m) {
                const f32x4 g0 = acc[ai][0][m][0], g1 = acc[ai][0][m][1], u0 = acc[ai][1][m][0], u1 = acc[ai][1][m][1];
                u32x4 w;
                w.x = cvt_pk_bf16(fast_silu(g0[0]) * u0[0], fast_silu(g0[1]) * u0[1]); w.y = cvt_pk_bf16(fast_silu(g0[2]) * u0[2], fast_silu(g0[3]) * u0[3]);
                w.z = cvt_pk_bf16(fast_silu(g1[0]) * u1[0], fast_silu(g1[1]) * u1[1]); w.w = cvt_pk_bf16(fast_silu(g1[2]) * u1[2], fast_silu(g1[3]) * u1[3]);
                *(u32x4*)(O + (size_t)(row0 + ai * HALF + m * 16) * ldc + col0) = w; }
    }
};
struct EpiResidF32 {
    static constexpr bool PERM = false, WIDE = false;
    const float* xin; float* xout; const float* gate;
    __device__ __forceinline__ void operator()(const f32x4 (&acc)[2][2][4][2], const Unit& u, int wr, int wc, int fr, int fq) const {
        const int row0 = u.pm * BM + wr * 64 + fr, col0 = u.pn * BM + wc * 32 + 4 * fq;
        const float* gp = gate + (size_t)((u.pm * BM) / SEQ) * 3072 + col0;
#pragma unroll
        for (int bj = 0; bj < 2; ++bj)
#pragma unroll
            for (int n = 0; n < 2; ++n) { const f32x4 g4 = *(const f32x4*)(gp + bj * HALF + n * 16);
#pragma unroll
                for (int ai = 0; ai < 2; ++ai)
#pragma unroll
                    for (int m = 0; m < 4; ++m) { const size_t off = (size_t)(row0 + ai * HALF + m * 16) * D + col0 + bj * HALF + n * 16;
                        const f32x4 x4 = *(const f32x4*)(xin + off); *(f32x4*)(xout + off) = x4 + g4 * acc[ai][bj][m][n]; } }
    }
};


__device__ __forceinline__ u32x4 xchg8(u32x4 v) { u32x4 r;
    r.x = (unsigned)__builtin_amdgcn_update_dpp(0, (int)v.x, 0x128, 0xf, 0xf, false); r.y = (unsigned)__builtin_amdgcn_update_dpp(0, (int)v.y, 0x128, 0xf, 0xf, false);
    r.z = (unsigned)__builtin_amdgcn_update_dpp(0, (int)v.z, 0x128, 0xf, 0xf, false); r.w = (unsigned)__builtin_amdgcn_update_dpp(0, (int)v.w, 0x128, 0xf, 0xf, false); return r; }
__device__ __forceinline__ u32x4 pack8(f32x4 v0, f32x4 v1) { u32x4 w; w.x = cvt_pk_bf16(v0[0], v0[1]); w.y = cvt_pk_bf16(v0[2], v0[3]); w.z = cvt_pk_bf16(v1[0], v1[1]); w.w = cvt_pk_bf16(v1[2], v1[3]); return w; }
template <bool NT = true> __device__ __forceinline__ void store_wide(bf16_t* p, int ld, int fr, int fq, u32x4 pk0, u32x4 pk1) {
    const bool lo = fr < 8; const u32x4 rcv = xchg8(lo ? pk1 : pk0);
    bf16_t* q = p + (size_t)(fr & 7) * ld + 8 * fq + (lo ? 0 : 32);
    if constexpr (NT) { __builtin_nontemporal_store(lo ? pk0 : rcv, (u32x4*)q); __builtin_nontemporal_store(lo ? rcv : pk1, (u32x4*)(q + (size_t)8 * ld)); }
    else { *(u32x4*)q = lo ? pk0 : rcv; *(u32x4*)(q + (size_t)8 * ld) = lo ? rcv : pk1; }
}
struct EpiBf16W {
    static constexpr bool PERM = true, WIDE = true;
    bf16_t* O; int ldc; int nmod;
    __device__ __forceinline__ void operator()(const f32x4 (&acc)[2][2][4][2], const Unit& u, int wr, int wc, int fr, int fq) const {
        bf16_t* base = O + (size_t)(u.pm * BM + wr * 64) * ldc + (u.pn % nmod) * BM + wc * 64;
#pragma unroll
        for (int ai = 0; ai < 2; ++ai)
#pragma unroll
            for (int m = 0; m < 4; ++m) store_wide(base + (size_t)(ai * HALF + m * 16) * ldc, ldc, fr, fq, pack8(acc[ai][0][m][0], acc[ai][0][m][1]), pack8(acc[ai][1][m][0], acc[ai][1][m][1]));
    }
};
template <bool XA> struct EpiResidNormT {
    static constexpr bool PERM = true, WIDE = true;
    const bf16_t* xin; bf16_t* x16; const float* gate; const float* av; bf16_t* xa; float* ssqp;
    __device__ __forceinline__ void operator()(const f32x4 (&acc)[2][2][4][2], const Unit& u, int wr, int wc, int fr, int fq) const {
        const int rowb = u.pm * BM + wr * 64, colw = u.pn * BM + wc * 64, b = (u.pm * BM) / SEQ;
        const bool lo = fr < 8;
        const size_t lane_off = (size_t)(fr & 7) * D + colw + 8 * fq + (lo ? 0 : 32);
        f32x4 gv[2][2], avv[2][2];
#pragma unroll
        for (int bj = 0; bj < 2; ++bj)
#pragma unroll
            for (int n = 0; n < 2; ++n) { gv[bj][n] = *(const f32x4*)(gate + (size_t)b * 3072 + colw + 32 * bj + 8 * fq + 4 * n); avv[bj][n] = *(const f32x4*)(av + (size_t)b * 1024 + colw + 32 * bj + 8 * fq + 4 * n); }
        u32x4 la[4][2], lb[4][2];
#define ERN_LOAD(k_) { _Pragma("unroll") for (int mm = 0; mm < 2; ++mm) { const bf16_t* q = xin + (size_t)(rowb + ((k_) >> 1) * HALF + (2 * ((k_) & 1) + mm) * 16) * D + lane_off; la[k_][mm] = __builtin_nontemporal_load((const u32x4*)q); lb[k_][mm] = __builtin_nontemporal_load((const u32x4*)(q + (size_t)8 * D)); } }
        ERN_LOAD(0)
#pragma unroll
        for (int k = 0; k < 4; ++k) {
            const int ai = k >> 1;
            if (k == 0) ERN_LOAD(1) else if (k == 1) ERN_LOAD(2) else if (k == 2) ERN_LOAD(3)
            asm volatile("" ::: "memory");
#pragma unroll
            for (int mm = 0; mm < 2; ++mm) {
                const int m = 2 * (k & 1) + mm;
                const u32x4 rcv = xchg8(lo ? lb[k][mm] : la[k][mm]);
                const u32x4 xb0 = lo ? la[k][mm] : rcv, xb1 = lo ? rcv : lb[k][mm];
                f32x4 x00, x01, x10, x11;
                x00.x = __uint_as_float(xb0.x << 16); x00.y = __uint_as_float(xb0.x & 0xffff0000u); x00.z = __uint_as_float(xb0.y << 16); x00.w = __uint_as_float(xb0.y & 0xffff0000u);
                x01.x = __uint_as_float(xb0.z << 16); x01.y = __uint_as_float(xb0.z & 0xffff0000u); x01.z = __uint_as_float(xb0.w << 16); x01.w = __uint_as_float(xb0.w & 0xffff0000u);
                x10.x = __uint_as_float(xb1.x << 16); x10.y = __uint_as_float(xb1.x & 0xffff0000u); x10.z = __uint_as_float(xb1.y << 16); x10.w = __uint_as_float(xb1.y & 0xffff0000u);
                x11.x = __uint_as_float(xb1.z << 16); x11.y = __uint_as_float(xb1.z & 0xffff0000u); x11.z = __uint_as_float(xb1.w << 16); x11.w = __uint_as_float(xb1.w & 0xffff0000u);
                const f32x4 n00 = x00 + gv[0][0] * acc[ai][0][m][0], n01 = x01 + gv[0][1] * acc[ai][0][m][1], n10 = x10 + gv[1][0] * acc[ai][1][m][0], n11 = x11 + gv[1][1] * acc[ai][1][m][1];
                float sv = (((n00.x * n00.x + n00.y * n00.y) + (n00.z * n00.z + n00.w * n00.w)) + ((n01.x * n01.x + n01.y * n01.y) + (n01.z * n01.z + n01.w * n01.w)))
                         + (((n10.x * n10.x + n10.y * n10.y) + (n10.z * n10.z + n10.w * n10.w)) + ((n11.x * n11.x + n11.y * n11.y) + (n11.z * n11.z + n11.w * n11.w)));
                const size_t ro = (size_t)(rowb + ai * HALF + m * 16) * D + colw;
                store_wide<false>(x16 + ro, D, fr, fq, pack8(n00, n01), pack8(n10, n11));
                if constexpr (XA) store_wide<false>(xa + ro, D, fr, fq, pack8(n00 * avv[0][0], n01 * avv[0][1]), pack8(n10 * avv[1][0], n11 * avv[1][1]));
                sv = xor32_sum(xor16_sum(sv));
                if (fq == 0) ssqp[(size_t)(rowb + ai * HALF + m * 16 + fr) * 16 + u.pn * 4 + wc] = sv;
            }
        }
#undef ERN_LOAD
    }
};
typedef EpiResidNormT<true> EpiResidNorm;
struct EpiProjNorm {
    static constexpr bool PERM = true, WIDE = true;
    bf16_t* O; const LAS float* RS; const float* cv; float* BG; const float* a_log; const float* dt_bias;
    __device__ __forceinline__ void operator()(const f32x4 (&acc)[2][2][4][2], const Unit& u, int wr, int wc, int fr, int fq) const {
        const int rl0 = wr * 64 + fr, colw = u.pn * BM + wc * 64, b = (u.pm * BM) / SEQ;
        const float* cp = cv + (size_t)b * NPW + colw + 8 * fq;
        if (u.pn < NP / BM) {
            f32x4 c4[2][2];
#pragma unroll
            for (int bj = 0; bj < 2; ++bj)
#pragma unroll
                for (int n = 0; n < 2; ++n) c4[bj][n] = *(const f32x4*)(cp + 32 * bj + 4 * n);
            bf16_t* base = O + (size_t)(u.pm * BM + wr * 64) * NP + colw;
#pragma unroll
            for (int ai = 0; ai < 2; ++ai)
#pragma unroll
                for (int m = 0; m < 4; ++m) { const float rs = fabsf(RS[u.ord * 256 + rl0 + ai * HALF + m * 16]);
                    store_wide(base + (size_t)(ai * HALF + m * 16) * NP, NP, fr, fq, pack8(acc[ai][0][m][0] * rs + c4[0][0], acc[ai][0][m][1] * rs + c4[0][1]), pack8(acc[ai][1][m][0] * rs + c4[1][0], acc[ai][1][m][1] * rs + c4[1][1])); }
        } else if (wc == 0 && fq == 0) {
            const f32x4 c0 = *(const f32x4*)(cp), c1 = *(const f32x4*)(cp + 4);
            const f32x4 al = *(const f32x4*)a_log, db = *(const f32x4*)dt_bias;
#pragma unroll
            for (int ai = 0; ai < 2; ++ai)
#pragma unroll
                for (int m = 0; m < 4; ++m) { const int rl = rl0 + ai * HALF + m * 16; const float rs = fabsf(RS[u.ord * 256 + rl]);
                    const f32x4 vb = acc[ai][0][m][0] * rs + c0, va = acc[ai][0][m][1] * rs + c1;
                    f32x4 be, gg;
#pragma unroll
                    for (int hh = 0; hh < 4; ++hh) { be[hh] = sigmoidf_(vb[hh]); gg[hh] = -__expf(al[hh]) * softplusf_(va[hh] + db[hh]); }
                    float* bg = BG + (size_t)(u.pm * BM + rl) * 8; *(f32x4*)bg = be; *(f32x4*)(bg + 4) = gg; }
        }
    }
};
struct EpiNull {
    static constexpr bool PERM = true, WIDE = false;
    __device__ __forceinline__ void operator()(const f32x4 (&acc)[2][2][4][2], const Unit& u, int wr, int wc, int fr, int fq) const {
#pragma unroll
        for (int ai = 0; ai < 2; ++ai)
#pragma unroll
            for (int bj = 0; bj < 2; ++bj)
#pragma unroll
                for (int m = 0; m < 4; ++m)
#pragma unroll
                    for (int n = 0; n < 2; ++n) asm volatile("" :: "v"(acc[ai][bj][m][n]));
    }
};
template <bool WT> struct EpiSwiGLUNormT {
    static constexpr bool PERM = true, WIDE = false;
    bf16_t* O; int ldc; int nmod; const LAS float* RS; const float* cv; int ncv;
    __device__ __forceinline__ void operator()(const f32x4 (&acc)[2][2][4][2], const Unit& u, int wr, int wc, int fr, int fq) const {
        const int rl0 = wr * 64 + fr, col0 = (u.pn % nmod) * HALF + wc * 32 + 8 * fq;
        const float* cp = cv + (size_t)u.pn * BM + wc * 32 + 8 * fq;
        f32x4 cg[2][2], cu[2][2];
#pragma unroll
        for (int bb = 0; bb < 2; ++bb)
#pragma unroll
            for (int n = 0; n < 2; ++n) { cg[bb][n] = *(const f32x4*)(cp + (size_t)bb * ncv + 4 * n); cu[bb][n] = *(const f32x4*)(cp + (size_t)bb * ncv + HALF + 4 * n); }
#pragma unroll
        for (int ai = 0; ai < 2; ++ai)
#pragma unroll
            for (int m = 0; m < 4; ++m) { const int rl = rl0 + ai * HALF + m * 16; const float rsv = RS[u.ord * 256 + rl], rs = fabsf(rsv); const bool b1 = rsv < 0.f;
                const f32x4 g0 = acc[ai][0][m][0] * rs + (b1 ? cg[1][0] : cg[0][0]), g1 = acc[ai][0][m][1] * rs + (b1 ? cg[1][1] : cg[0][1]);
                const f32x4 u0 = acc[ai][1][m][0] * rs + (b1 ? cu[1][0] : cu[0][0]), u1 = acc[ai][1][m][1] * rs + (b1 ? cu[1][1] : cu[0][1]);
                u32x4 w;
                w.x = cvt_pk_bf16(fast_silu(g0[0]) * u0[0], fast_silu(g0[1]) * u0[1]); w.y = cvt_pk_bf16(fast_silu(g0[2]) * u0[2], fast_silu(g0[3]) * u0[3]);
                w.z = cvt_pk_bf16(fast_silu(g1[0]) * u1[0], fast_silu(g1[1]) * u1[1]); w.w = cvt_pk_bf16(fast_silu(g1[2]) * u1[2], fast_silu(g1[3]) * u1[3]);
                bf16_t* op = O + (size_t)(u.pm * BM + rl) * ldc + col0;
                if constexpr (WT) asm volatile("global_store_dwordx4 %0, %1, off sc1\n\ts_nop 2" :: "v"((unsigned long long)op), "v"(w) : "memory"); else __builtin_nontemporal_store(w, (u32x4*)op); }
    }
};
typedef EpiSwiGLUNormT<false> EpiSwiGLUNorm;

struct NoPre { __device__ __forceinline__ void operator()() const {} };
template <class Epi, class Sched, bool GATHER, bool ALIGN_EPI, bool SP2, bool WAITA = false, bool PUBL = false, class Pre = NoPre>
__device__ __forceinline__ void gemm_phase(LAS unsigned char* lds, const LAS int* RI, const Gemm g, const Sched& S, const Epi& E, const Pre& P = Pre()) {
    const int tid = threadIdx.x, wid = __builtin_amdgcn_readfirstlane(tid >> 6), lane = tid & 63, wr = wid >> 2, wc = wid & 3, fr = lane & 15, fq = lane >> 4;
    const int K = g.K, nt = K / BK;
    unsigned voffB[2]; int Ra[2]; unsigned Ca2[2];
#pragma unroll
    for (int i = 0; i < 2; ++i) { int R, C; stage_rc(tid * 16 + i * 8192, R, C); const int Rb = Epi::WIDE ? ((R >> 5) * 64 + perm32(R & 31)) : (Epi::PERM ? ((R & ~31) + perm32(R & 31)) : R);
        Ra[i] = R; Ca2[i] = (unsigned)C * 2u; voffB[i] = (unsigned)(Rb * K + C) * 2u; }
    const size_t kstep = (size_t)(BK * 2);
    const size_t hstep = (size_t)HALF * K * 2;
    const size_t tstep = 2 * hstep;
    const size_t hstepB = Epi::WIDE ? (size_t)32 * K * 2 : hstep;
    const unsigned rowb = (unsigned)K * 2u;
    const unsigned ldsw = (unsigned)wid * 1024u;
    const int aoff = lds_byte(wr * 64 + fr, fq * 8), boff = lds_byte(wc * 32 + fr, fq * 8);
#define PG8_SA(b, h) (((b) * 2 + (h)) * HTB)
#define PG8_SB(b, h) ((4 + (b) * 2 + (h)) * HTB)
#define PG8_STAGE_B(bufoff, gbase) do { _Pragma("unroll") for (int _i = 0; _i < 2; ++_i) \
        __builtin_amdgcn_global_load_lds((const unsigned*)((const char*)(gbase) + voffB[_i]), (LAS unsigned*)(lds + (bufoff) + ldsw + _i * 8192), 16, 0, 0); } while (0)
#define PG8_STAGE_A(bufoff, kb, off) do { _Pragma("unroll") for (int _i = 0; _i < 2; ++_i) \
        __builtin_amdgcn_global_load_lds((const unsigned*)((const char*)g.A + (size_t)(kb) + (off)[_i]), (LAS unsigned*)(lds + (bufoff) + ldsw + _i * 8192), 16, 0, 0); } while (0)
#define PG8_LDA(dst, b, h) do { _Pragma("unroll") for (int m = 0; m < 4; ++m) _Pragma("unroll") for (int k = 0; k < 2; ++k) dst[m][k] = *(const LAS bf16x8*)(lds + PG8_SA(b, h) + aoff + m * 2048 + k * 1024); } while (0)
#define PG8_LDB(dst, b, h) do { _Pragma("unroll") for (int n = 0; n < 2; ++n) _Pragma("unroll") for (int k = 0; k < 2; ++k) dst[n][k] = *(const LAS bf16x8*)(lds + PG8_SB(b, h) + boff + n * 2048 + k * 1024); } while (0)
#define PG8_MMA(ai, bj, At, Bt) do { __builtin_amdgcn_s_setprio(1); _Pragma("unroll") for (int m = 0; m < 4; ++m) _Pragma("unroll") for (int n = 0; n < 2; ++n) _Pragma("unroll") for (int k = 0; k < 2; ++k) \
        acc[ai][bj][m][n] = __builtin_amdgcn_mfma_f32_16x16x32_bf16(Bt[n][k], At[m][k], acc[ai][bj][m][n], 0, 0, 0); __builtin_amdgcn_s_setprio(0); } while (0)
#define PG8_WAIT_V(n) asm volatile("s_waitcnt vmcnt(" #n ")" ::: "memory")
#define PG8_WAIT_L(n) asm volatile("s_waitcnt lgkmcnt(" #n ")" ::: "memory")
#define PG8_BAR __builtin_amdgcn_s_barrier()
#define PG8_SCHED __builtin_amdgcn_sched_barrier(0)
#define PG8_AOFFS(dst, ui_, un_) do { _Pragma("unroll") for (int _h = 0; _h < 2; ++_h) _Pragma("unroll") for (int _i = 0; _i < 2; ++_i) { \
        const unsigned _row = GATHER ? (unsigned)RI[(ui_) * 256 + _h * HALF + Ra[_i]] : (unsigned)((un_).pm * BM + _h * HALF + Ra[_i]); dst[_h][_i] = _row * rowb + Ca2[_i]; } } while (0)
    Unit cur, nxt; int ui = 0; int ppm = -1;
    if (!S.next(0, cur)) return;
    cur.ord = 0;
    if constexpr (WAITA && !SP2) S.a_ready(cur);
    f32x4 acc[2][2][4][2];
#pragma unroll
    for (int a = 0; a < 2; ++a)
#pragma unroll
        for (int b = 0; b < 2; ++b)
#pragma unroll
            for (int m = 0; m < 4; ++m)
#pragma unroll
                for (int n = 0; n < 2; ++n) acc[a][b][m][n] = (f32x4){0.f, 0.f, 0.f, 0.f};
    bf16x8 At[4][2], B0[2][2], B1[2][2];
    unsigned cv[2][2], nv[2][2];
    PG8_AOFFS(cv, 0, cur);
    const char* cB = (const char*)g.Bt + (size_t)cur.pnb * tstep;
    if constexpr (SP2) {
        PG8_STAGE_B(PG8_SB(0, 0), cB); PG8_STAGE_B(PG8_SB(0, 1), cB + hstepB);
        if constexpr (WAITA) S.a_ready(cur);
        PG8_STAGE_A(PG8_SA(0, 0), 0, cv[0]); PG8_STAGE_A(PG8_SA(0, 1), 0, cv[1]);
        P();
        if (wr == 1) PG8_BAR;
        PG8_WAIT_V(2); PG8_BAR;
        PG8_STAGE_B(PG8_SB(1, 0), cB + kstep); PG8_STAGE_A(PG8_SA(1, 0), kstep, cv[0]); PG8_STAGE_B(PG8_SB(1, 1), cB + hstepB + kstep);
        PG8_WAIT_V(6); PG8_BAR;
    } else {
        PG8_STAGE_B(PG8_SB(0, 0), cB); PG8_STAGE_A(PG8_SA(0, 0), 0, cv[0]); PG8_STAGE_B(PG8_SB(0, 1), cB + hstepB); PG8_STAGE_A(PG8_SA(0, 1), 0, cv[1]);
        if (wr == 1) PG8_BAR;
        PG8_WAIT_V(4); PG8_BAR;
        PG8_STAGE_B(PG8_SB(1, 0), cB + kstep); PG8_STAGE_A(PG8_SA(1, 0), kstep, cv[0]); PG8_STAGE_B(PG8_SB(1, 1), cB + hstepB + kstep);
        PG8_WAIT_V(6); PG8_BAR;
    }
    for (;;) {
        const bool has_next = S.next(ui + 1, nxt); nxt.ord = ui + 1;
        if constexpr (WAITA) { if (has_next) S.a_ready(nxt); }
        const char* nB = has_next ? (const char*)g.Bt + (size_t)nxt.pnb * tstep : cB;
        if (has_next) { PG8_AOFFS(nv, ui + 1, nxt); }
        else {
#pragma unroll
            for (int h = 0; h < 2; ++h)
#pragma unroll
                for (int i = 0; i < 2; ++i) nv[h][i] = cv[h][i]; }
        for (int t = 0; t < nt; t += 2) {
            const bool last = (t == nt - 2);
            const size_t kb1 = (size_t)(t + 1) * kstep, kb2 = last ? (size_t)0 : (size_t)(t + 2) * kstep, kb3 = kb2 + kstep;
            const char* b2 = last ? nB : cB + (size_t)(t + 2) * kstep; const char* b3 = b2 + kstep;
            unsigned o2[2][2];
#pragma unroll
            for (int h = 0; h < 2; ++h)
#pragma unroll
                for (int i = 0; i < 2; ++i) o2[h][i] = last ? nv[h][i] : cv[h][i];
            if constexpr (SP2) {
            PG8_LDB(B0, 0, 0); PG8_LDB(B1, 0, 1); PG8_SCHED; PG8_LDA(At, 0, 0); PG8_STAGE_A(PG8_SA(1, 1), kb1, cv[1]);
            PG8_WAIT_V(8); PG8_WAIT_L(0); PG8_BAR; PG8_MMA(0, 0, At, B0); PG8_MMA(0, 1, At, B1); PG8_BAR; PG8_SCHED;
            PG8_LDA(At, 0, 1); PG8_STAGE_B(PG8_SB(0, 0), b2); PG8_STAGE_B(PG8_SB(0, 1), b2 + hstepB); PG8_STAGE_A(PG8_SA(0, 0), kb2, o2[0]);
            PG8_WAIT_V(8); PG8_WAIT_L(0); PG8_BAR; PG8_MMA(1, 0, At, B0); PG8_MMA(1, 1, At, B1); PG8_BAR; PG8_SCHED;
            PG8_LDB(B0, 1, 0); PG8_LDB(B1, 1, 1); PG8_SCHED; PG8_LDA(At, 1, 0); PG8_STAGE_A(PG8_SA(0, 1), kb2, o2[1]);
            PG8_WAIT_V(8); PG8_WAIT_L(0); PG8_BAR; PG8_MMA(0, 0, At, B0); PG8_MMA(0, 1, At, B1); PG8_BAR; PG8_SCHED;
            PG8_LDA(At, 1, 1); PG8_STAGE_B(PG8_SB(1, 0), b3); PG8_STAGE_B(PG8_SB(1, 1), b3 + hstepB); PG8_STAGE_A(PG8_SA(1, 0), kb3, o2[0]);
            PG8_WAIT_V(8); PG8_WAIT_L(0); PG8_BAR; PG8_MMA(1, 0, At, B0); PG8_MMA(1, 1, At, B1); PG8_BAR; PG8_SCHED;
            } else {
            PG8_LDB(B0, 0, 0); PG8_SCHED; PG8_LDA(At, 0, 0); PG8_STAGE_A(PG8_SA(1, 1), kb1, cv[1]);
            PG8_WAIT_L(8); PG8_BAR; PG8_WAIT_L(0); PG8_MMA(0, 0, At, B0); PG8_BAR; PG8_SCHED;
            PG8_LDB(B1, 0, 1); PG8_STAGE_B(PG8_SB(0, 0), b2);
            PG8_BAR; PG8_WAIT_L(0); PG8_MMA(0, 1, At, B1); PG8_BAR;
            PG8_LDA(At, 0, 1); PG8_STAGE_A(PG8_SA(0, 0), kb2, o2[0]);
            PG8_BAR; PG8_WAIT_L(0); PG8_MMA(1, 0, At, B0); PG8_BAR; PG8_SCHED;
            PG8_STAGE_B(PG8_SB(0, 1), b2 + hstepB);
            PG8_WAIT_V(6); PG8_BAR; PG8_MMA(1, 1, At, B1); PG8_BAR;
            PG8_LDB(B0, 1, 0); PG8_SCHED; PG8_LDA(At, 1, 0); PG8_STAGE_A(PG8_SA(0, 1), kb2, o2[1]);
            PG8_WAIT_L(8); PG8_BAR; PG8_WAIT_L(0); PG8_MMA(0, 0, At, B0); PG8_BAR; PG8_SCHED;
            PG8_LDB(B1, 1, 1); PG8_STAGE_B(PG8_SB(1, 0), b3);
            PG8_BAR; PG8_WAIT_L(0); PG8_MMA(0, 1, At, B1); PG8_BAR;
            PG8_LDA(At, 1, 1); PG8_STAGE_A(PG8_SA(1, 0), kb3, o2[0]);
            PG8_BAR; PG8_WAIT_L(0); PG8_MMA(1, 0, At, B0); PG8_BAR; PG8_SCHED;
            PG8_STAGE_B(PG8_SB(1, 1), b3 + hstepB);
            PG8_WAIT_V(6); PG8_BAR; PG8_MMA(1, 1, At, B1); PG8_BAR;
            }
        }
        if constexpr (PUBL) { if (ppm >= 0 && lane == 0) (void)__hip_atomic_fetch_add(S.ready + 64 * ppm, 1u, __ATOMIC_RELAXED, __HIP_MEMORY_SCOPE_AGENT); }
        if constexpr (ALIGN_EPI) { if (wr == 0) PG8_BAR; }
        E(acc, cur, wr, wc, fr, fq);
        if constexpr (PUBL) ppm = cur.pm;
        if (!has_next) break;
#pragma unroll
        for (int a = 0; a < 2; ++a)
#pragma unroll
            for (int b = 0; b < 2; ++b)
#pragma unroll
                for (int m = 0; m < 4; ++m)
#pragma unroll
                    for (int n = 0; n < 2; ++n) acc[a][b][m][n] = (f32x4){0.f, 0.f, 0.f, 0.f};
        cur = nxt; cB = nB; ++ui;
#pragma unroll
        for (int h = 0; h < 2; ++h)
#pragma unroll
            for (int i = 0; i < 2; ++i) cv[h][i] = nv[h][i];
        if constexpr (ALIGN_EPI) { if (wr == 1) PG8_BAR; }
    }
    PG8_WAIT_V(0);
    if constexpr (PUBL) { if (ppm >= 0 && lane == 0) (void)__hip_atomic_fetch_add(S.ready + 64 * ppm, 1u, __ATOMIC_RELAXED, __HIP_MEMORY_SCOPE_AGENT); }
    if constexpr (!ALIGN_EPI) { if (wr == 0) PG8_BAR; }
    PG8_BAR;
#undef PG8_SA
#undef PG8_SB
#undef PG8_STAGE_A
#undef PG8_STAGE_B
#undef PG8_LDA
#undef PG8_LDB
#undef PG8_MMA
#undef PG8_WAIT_V
#undef PG8_WAIT_L
#undef PG8_BAR
#undef PG8_SCHED
#undef PG8_AOFFS
}
}

__device__ __forceinline__ void transpose_item(const float* W, int pitch, int k0, int n0, bf16_t* WT, int Kd, int drow0, LAS float* scr, int lane) {
    float v[32];
#pragma unroll
    for (int i = 0; i < 32; ++i) v[i] = __builtin_nontemporal_load(W + (size_t)(k0 + 2 * i + (lane >> 5)) * pitch + n0 + (lane & 31));
#pragma unroll
    for (int i = 0; i < 32; ++i) scr[(2 * i + (lane >> 5)) * 33 + (lane & 31)] = v[i];
    asm volatile("s_waitcnt lgkmcnt(0)" ::: "memory");
    const int c = lane & 7;
#pragma unroll
    for (int j = 0; j < 4; ++j) { const int n = (lane >> 3) + 8 * j; const LAS float* s = scr + (8 * c) * 33 + n;
        u32x4 o; o.x = pk2(s[0 * 33], s[1 * 33]); o.y = pk2(s[2 * 33], s[3 * 33]); o.z = pk2(s[4 * 33], s[5 * 33]); o.w = pk2(s[6 * 33], s[7 * 33]);
        *(u32x4*)(WT + (size_t)(drow0 + n) * Kd + k0 + 8 * c) = o; }
    asm volatile("s_waitcnt lgkmcnt(0)" ::: "memory");
}
constexpr size_t WT_WIN = 0, WT_WOUT = WT_WIN + (size_t)2 * NPW * D, WT_FGU = WT_WOUT + (size_t)2 * D * D, WT_FD = WT_FGU + (size_t)2 * D_FF * D,
                 WT_MGU = WT_FD + (size_t)D * D_FF, WT_MD = WT_MGU + (size_t)NE * 2 * D_FFE * D, WT_END = WT_MD + (size_t)NE * D * D_FFE;
static_assert(WT_END * 2 <= 80 * MiB, "weight copies fit");
__device__ __forceinline__ void ph_pro_weights(const Args& a, Frame& F) {
    LAS float* scr = (LAS float*)(F.lds + F.wave * 16384);
    bf16_t* WT = (bf16_t*)(F.ws + WS_WT);
    constexpr int I_IN0 = 16 * 48, I_IN1 = 16 * 24, I_OUT = 16 * 32, I_FG = 16 * 88, I_FD = 44 * 32, I_M = 16 * 32;
    constexpr int NITEMS = 2 * (I_IN0 + I_IN1 + I_OUT) + 2 * I_FG + I_FD + 24 * I_M;
    const int nvw = 4 * 48 * NWAVES, nfree = F.ngw - nvw, nx = (F.nb == 256) ? 2 * nfree : 0, fw = F.gw - nvw;
    for (int j = (fw >= 0 && nx > 0) ? -2 : 0; ; ++j) {
        const int it = j < 0 ? fw + (j + 2) * nfree : nx + F.gw + j * F.ngw;
        if (it >= NITEMS) break;
        int r = it; const float* src; int pitch, k0, n0, Kd, drow0; bf16_t* dst;
        if (r < 2 * I_IN0) { const int l = r / I_IN0; r %= I_IN0; src = a.w_in + (size_t)l * D * N_IN; pitch = N_IN; k0 = (r / 48) * 64; n0 = (r % 48) * 32; dst = WT + WT_WIN + (size_t)l * NPW * D; Kd = D; drow0 = n0; }
        else if ((r -= 2 * I_IN0) < 2 * I_IN1) { const int l = r / I_IN1; r %= I_IN1; src = a.w_in + (size_t)l * D * N_IN + 1544; pitch = N_IN; k0 = (r / 24) * 64; n0 = (r % 24) * 32; dst = WT + WT_WIN + (size_t)l * NPW * D; Kd = D; drow0 = 1536 + n0; }
        else if ((r -= 2 * I_IN1) < 2 * I_OUT) { const int l = r / I_OUT; r %= I_OUT; src = a.w_out + (size_t)l * D * D; pitch = D; k0 = (r / 32) * 64; n0 = (r % 32) * 32; dst = WT + WT_WOUT + (size_t)l * D * D; Kd = D; drow0 = n0; }
        else if ((r -= 2 * I_OUT) < 2 * I_FG) { const int up = r / I_FG; r %= I_FG; src = up ? a.ffn_wu : a.ffn_wg; pitch = D_FF; k0 = (r / 88) * 64; n0 = (r % 88) * 32; dst = WT + WT_FGU; Kd = D; drow0 = (n0 / 128) * 256 + up * 128 + (n0 % 128); }
        else if ((r -= 2 * I_FG) < I_FD) { src = a.ffn_wd; pitch = D; k0 = (r / 32) * 64; n0 = (r % 32) * 32; dst = WT + WT_FD; Kd = D_FF; drow0 = n0; }
        else if ((r -= I_FD) < 16 * I_M) { const int e = r / (2 * I_M); r %= 2 * I_M; const int up = r / I_M; r %= I_M; src = (up ? a.moe_wu : a.moe_wg) + (size_t)e * D * D_FFE; pitch = D_FFE; k0 = (r / 32) * 64; n0 = (r % 32) * 32;
            dst = WT + WT_MGU + (size_t)e * 2 * D_FFE * D; Kd = D; drow0 = (n0 / 128) * 256 + up * 128 + (n0 % 128); }
        else { r -= 16 * I_M; const int e = r / I_M; r %= I_M; src = a.moe_wd + (size_t)e * D_FFE * D; pitch = D; k0 = (r / 32) * 64; n0 = (r % 32) * 32; dst = WT + WT_MD + (size_t)e * D * D_FFE; Kd = D_FFE; drow0 = n0; }
        transpose_item(src, pitch, k0, n0, dst, Kd, drow0, scr, F.lane);
    }
    for (int idx = F.bid * NTHREADS + F.tid; idx < 2 * 256 * D; idx += F.nb * NTHREADS) {
        const int l = idx / (256 * D), r = (idx / D) % 256, k = idx % D;
        WT[WT_WIN + (size_t)l * NPW * D + (size_t)(2304 + r) * D + k] = (r < 8) ? (bf16_t)f2bf(a.w_in[(size_t)l * D * N_IN + (size_t)k * N_IN + W_DB + r]) : (bf16_t)0;
    }
}

template <int NT> __device__ __forceinline__ void moe_order_init(Frame& F, pg8::MoeOrder<NT>& S) {
    const unsigned* c = (const unsigned*)(F.ws + WS_CTL) + CW_MOECNT;
    int acc = 0;
#pragma unroll
    for (int e = 0; e < 8; ++e) { S.cnt[e] = (int)__hip_atomic_load(c + 64 * e, __ATOMIC_RELAXED, __HIP_MEMORY_SCOPE_AGENT); S.bt[e] = acc; acc += (S.cnt[e] + 255) >> 8; }
    S.bt[8] = acc; S.G = F.nb; S.c = F.bid; S.rk = F.bid >> 3;
    S.ready = (GAS unsigned*)(F.ws + WS_CTL) + CW_TREADY; S.need = 64u; S.tmo = (unsigned*)(F.ws + WS_CTL) + CW_BAR + XB_TMO;
    S.alld = (GAS unsigned*)(F.ws + WS_CTL) + CW_F1DONE; S.seen_all = (volatile LAS unsigned*)(F.lds + MISC_OFF) + 20;
}
template <int NT> __device__ __forceinline__ int moe_ri_one(Frame& F, const pg8::MoeOrder<NT>& S, const int* RM, int o, int t) {
    pg8::Unit u; if (!S.next(o, u)) return -1;
    const int e = u.pn / NT; int bte = 0, cne = 0;
#pragma unroll
    for (int kk = 0; kk < 8; ++kk) { if (kk == e) { bte = S.bt[kk]; cne = S.cnt[kk]; } }
    const int sl = (u.pm - bte) * 256 + t; return (sl < cne) ? RM[(size_t)e * T + sl] : 0;
}
template <int NT> __device__ __forceinline__ void moe_ri_preload(Frame& F, const pg8::MoeOrder<NT>& S) {
    LAS int* RI = (LAS int*)(F.lds + RI_OFF); const int* RM = (const int*)(F.ws + WS_RMAP);
    const int t = F.tid & 255, par = F.tid >> 8;
    const int v0 = moe_ri_one<NT>(F, S, RM, par, t), v1 = moe_ri_one<NT>(F, S, RM, par + 2, t), v2 = moe_ri_one<NT>(F, S, RM, par + 4, t), v3 = moe_ri_one<NT>(F, S, RM, par + 6, t);
    const int v4 = moe_ri_one<NT>(F, S, RM, par + 8, t), v5 = moe_ri_one<NT>(F, S, RM, par + 10, t), v6 = moe_ri_one<NT>(F, S, RM, par + 12, t), v7 = moe_ri_one<NT>(F, S, RM, par + 14, t);
    if (v0 >= 0) RI[(par) * 256 + t] = v0; if (v1 >= 0) RI[(par + 2) * 256 + t] = v1; if (v2 >= 0) RI[(par + 4) * 256 + t] = v2; if (v3 >= 0) RI[(par + 6) * 256 + t] = v3;
    if (v4 >= 0) RI[(par + 8) * 256 + t] = v4; if (v5 >= 0) RI[(par + 10) * 256 + t] = v5; if (v6 >= 0) RI[(par + 12) * 256 + t] = v6;
    if (v7 >= 0 && par + 14 < 15) RI[(par + 14) * 256 + t] = v7;
    __syncthreads();
}

__device__ __forceinline__ void ph_norm0(const Args& a, Frame& F) {
    const float* MOD = (const float*)(F.ws + WS_MOD);
    bf16_t* X16 = (bf16_t*)(F.ws + WS_X16); float* SSQ = (float*)(F.ws + WS_SSQ) + (size_t)3 * T * 16;
    f32x4 vn[4];
#define N0_LOAD(row_) { const f32x4* p_ = (const f32x4*)(a.x + (size_t)(row_) * D) + 2 * F.lane; vn[0] = __builtin_nontemporal_load(p_); vn[1] = __builtin_nontemporal_load(p_ + 1); vn[2] = __builtin_nontemporal_load(p_ + 128); vn[3] = __builtin_nontemporal_load(p_ + 129); }
    if (F.gw < T) N0_LOAD(F.gw)
    for (int row = F.gw; row < T; row += F.ngw) {
        const int b = row / SEQ;
        f32x4 v[4]; float ss = 0.f;
#pragma unroll
        for (int j = 0; j < 4; ++j) { v[j] = vn[j]; ss += (v[j].x * v[j].x + v[j].y * v[j].y) + (v[j].z * v[j].z + v[j].w * v[j].w); }
        if (row + F.ngw < T) N0_LOAD(row + F.ngw)
#pragma unroll
        for (int jj = 0; jj < 2; ++jj) {
            const int d = 512 * jj + 8 * F.lane; const f32x4 v0 = v[2 * jj], v1 = v[2 * jj + 1];
            u32x4 o; o.x = pk2(v0.x, v0.y); o.y = pk2(v0.z, v0.w); o.z = pk2(v1.x, v1.y); o.w = pk2(v1.z, v1.w); *(u32x4*)(X16 + (size_t)row * D + d) = o;
        }
        ss = wave_sum(ss);
        if (F.lane < 16) SSQ[(size_t)row * 16 + F.lane] = (F.lane == 0) ? ss : 0.f;
    }
#undef N0_LOAD
}
__device__ __forceinline__ void ph_prep_vectors(const Args& a, Frame& F) {
    const float* MOD = (const float*)(F.ws + WS_MOD); float* AV = (float*)(F.ws + WS_AV);
    for (int idx = F.bid * NTHREADS + F.tid; idx < 3 * BATCH * D; idx += F.nb * NTHREADS) {
        const int inst = idx / (BATCH * D), b = (idx / D) % BATCH, d = idx % D;
        const int lk = (inst == 0) ? 1 : (inst == 1 ? 2 : 3);
        const float gn = (inst == 0) ? a.nfg[d] : (inst == 1 ? a.nmg[D + d] : a.nfg[D + d]);
        AV[idx] = gn * (1.0f + MOD[((size_t)lk * 2 + b) * 3072 + 1024 + d]);
    }
    const bf16_t* WT = (const bf16_t*)(F.ws + WS_WT);
    constexpr int NR = 5632 + NPW + 16384 + NPW;
    LAS float* SH = (LAS float*)F.lds;
    {
        f32x4 sv[4];
#pragma unroll
        for (int j = 0; j < 4; ++j) { const int i = (F.tid + NTHREADS * j) * 4, which = i / (BATCH * D), b = (i / D) % BATCH, d = i % D; sv[j] = *(const f32x4*)(MOD + ((size_t)((which + 1) & 3) * 2 + b) * 3072 + d); }
#pragma unroll
        for (int j = 0; j < 4; ++j) *(LAS f32x4*)(SH + (F.tid + NTHREADS * j) * 4) = sv[j];
    }
    __syncthreads();
    for (int g8 = F.gw; g8 < NR / 8; g8 += F.ngw) {
        const int row = g8 * 8 + (F.lane >> 3), part = F.lane & 7;
        int which, r; const bf16_t* wrow; float* out; int ncv;
        if (row < 5632) { which = 0; r = row; wrow = WT + WT_FGU + (size_t)r * D; out = (float*)(F.ws + WS_CVF); ncv = 5632; }
        else if (row < 5632 + NPW) { which = 1; r = row - 5632; wrow = WT + WT_WIN + (size_t)NPW * D + (size_t)r * D; out = (float*)(F.ws + WS_CVI); ncv = NPW; }
        else if (row < 5632 + NPW + 16384) { which = 2; r = row - 5632 - NPW; wrow = WT + WT_MGU + (size_t)r * D; out = (float*)(F.ws + WS_CVM); ncv = 16384; }
        else { which = 3; r = row - 5632 - NPW - 16384; wrow = WT + WT_WIN + (size_t)r * D; out = (float*)(F.ws + WS_CVI0); ncv = NPW; }
        u32x4 wv[16];
#pragma unroll
        for (int j = 0; j < 16; ++j) wv[j] = *(const u32x4*)(wrow + 128 * part + 8 * j);
        const LAS float* s0p = SH + (which * 2 + 0) * 1024 + 128 * part; const LAS float* s1p = s0p + 1024;
        float s0 = 0.f, s1 = 0.f;
#pragma unroll
        for (int j = 0; j < 16; ++j) {
            const f32x4 a0 = *(const LAS f32x4*)(s0p + 8 * j), a1 = *(const LAS f32x4*)(s0p + 8 * j + 4), b0 = *(const LAS f32x4*)(s1p + 8 * j), b1 = *(const LAS f32x4*)(s1p + 8 * j + 4);
            const float x0 = bf2f(wv[j].x & 0xffffu), x1 = bf2f(wv[j].x >> 16), x2 = bf2f(wv[j].y & 0xffffu), x3 = bf2f(wv[j].y >> 16), x4 = bf2f(wv[j].z & 0xffffu), x5 = bf2f(wv[j].z >> 16), x6 = bf2f(wv[j].w & 0xffffu), x7 = bf2f(wv[j].w >> 16);
            s0 += ((x0 * a0.x + x1 * a0.y) + (x2 * a0.z + x3 * a0.w)) + ((x4 * a1.x + x5 * a1.y) + (x6 * a1.z + x7 * a1.w));
            s1 += ((x0 * b0.x + x1 * b0.y) + (x2 * b0.z + x3 * b0.w)) + ((x4 * b1.x + x5 * b1.y) + (x6 * b1.z + x7 * b1.w));
        }
        s0 += __shfl_xor(s0, 1); s0 += __shfl_xor(s0, 2); s0 += __shfl_xor(s0, 4);
        s1 += __shfl_xor(s1, 1); s1 += __shfl_xor(s1, 2); s1 += __shfl_xor(s1, 4);
        if (part == 0) { out[r] = s0; out[ncv + r] = s1; }
    }
    __syncthreads();
    if (F.gw < BATCH * 8) {
        const int b = F.gw >> 3, e = F.gw & 7; float sacc = 0.f;
#pragma unroll
        for (int d = F.lane; d < D; d += 64) sacc += MOD[((size_t)3 * 2 + b) * 3072 + d] * a.router_w[(size_t)d * NE + e];
        sacc = wave_sum(sacc);
        if (F.lane == 0) ((float*)(F.ws + WS_CR))[b * 8 + e] = sacc;
    }
}
__device__ __forceinline__ void ph_scale_weights(const Args& a, Frame& F) {
    const float* MOD = (const float*)(F.ws + WS_MOD);
    LAS float* AVL = (LAS float*)(F.lds + 65536);
    {
        f32x4 gv[3], mv[3];
#pragma unroll
        for (int j = 0; j < 3; ++j) { const int i = (F.tid + NTHREADS * j) * 4, set = i / (BATCH * D), b = (i / D) % BATCH, d = i % D;
            const int lk = set == 0 ? 0 : (set == 1 ? 2 : 1); const float* gp = set == 0 ? a.nmg + d : (set == 1 ? a.nmg + D + d : a.nfg + d);
            gv[j] = *(const f32x4*)gp; mv[j] = *(const f32x4*)(MOD + ((size_t)lk * 2 + b) * 3072 + 1024 + d); }
#pragma unroll
        for (int j = 0; j < 3; ++j) *(LAS f32x4*)(AVL + (F.tid + NTHREADS * j) * 4) = gv[j] * (mv[j] + 1.0f);
    }
    __syncthreads();
    const bf16_t* WT = (const bf16_t*)(F.ws + WS_WT);
    constexpr int R0 = NPW, R1 = 2 * NPW, R2 = 2 * NPW + 5632;
    constexpr size_t OFF0 = (size_t)pg8::PNB_B0 * 256 * D, OFF1 = (size_t)pg8::PNB_B1 * 256 * D;
    const int stride = F.nb * NTHREADS;
    for (int idx0 = F.bid * NTHREADS + F.tid; idx0 < R2 * 128; idx0 += 4 * stride) {
        u32x4 w[4]; size_t eo[4]; int st[4], kk[4];
#pragma unroll
        for (int u = 0; u < 4; ++u) { const int idx = idx0 + u * stride, idc = idx < R2 * 128 ? idx : idx0; const int row = idc >> 7; kk[u] = (idc & 127) * 8;
            st[u] = row < R0 ? 0 : (row < R1 ? 1 : 2); eo[u] = (st[u] < 2 ? WT_WIN + (size_t)row * D : WT_FGU + (size_t)(row - R1) * D) + kk[u];
            w[u] = *(const u32x4*)(WT + eo[u]); }
#pragma unroll
        for (int u = 0; u < 4; ++u) { if (idx0 + u * stride < R2 * 128) {
            const float x[8] = {bf2f(w[u].x & 0xffffu), bf2f(w[u].x >> 16), bf2f(w[u].y & 0xffffu), bf2f(w[u].y >> 16), bf2f(w[u].z & 0xffffu), bf2f(w[u].z >> 16), bf2f(w[u].w & 0xffffu), bf2f(w[u].w >> 16)};
#pragma unroll
            for (int b = 0; b < 2; ++b) {
                const f32x4 a0 = *(const LAS f32x4*)(AVL + (st[u] * 2 + b) * D + kk[u]), a1 = *(const LAS f32x4*)(AVL + (st[u] * 2 + b) * D + kk[u] + 4);
                u32x4 o; o.x = pg8::cvt_pk_bf16(x[0] * a0.x, x[1] * a0.y); o.y = pg8::cvt_pk_bf16(x[2] * a0.z, x[3] * a0.w); o.z = pg8::cvt_pk_bf16(x[4] * a1.x, x[5] * a1.y); o.w = pg8::cvt_pk_bf16(x[6] * a1.z, x[7] * a1.w);
                *(u32x4*)((bf16_t*)(F.ws + WS_WT) + eo[u] + (b ? OFF1 : OFF0)) = o;
            } } }
    }
}
template <class Sched> __device__ __forceinline__ int count_units(const Sched& S) { int n = 0; pg8::Unit u; while (n < 16 && S.next(n, u)) ++n; return n; }
template <class Sched> __device__ __forceinline__ void rstd_preload(Frame& F, const Sched& S, const float* ssqp, const LAS int* RI) {
    LAS float* RS = (LAS float*)(F.lds + RS_OFF);
    const int t = F.tid & 255, par = F.tid >> 8, nu = count_units(S);
    {
        constexpr int k0 = 0;
        f32x4 p0[4], p1[4], p2[4], p3[4], p4[4], p5[4], p6[4], p7[4]; int r0, r1, r2, r3, r4, r5, r6, r7;
#define RSP_LOAD(k, pk, rk) { const int o = par + 2 * (k0 + k); pg8::Unit u; u.pm = 0; rk = 0; if (o < nu) { S.next(o, u); rk = RI ? RI[o * 256 + t] : u.pm * 256 + t; } \
            const f32x4* q = (const f32x4*)(ssqp + (size_t)rk * 16); pk[0] = q[0]; pk[1] = q[1]; pk[2] = q[2]; pk[3] = q[3]; }
        RSP_LOAD(0, p0, r0) RSP_LOAD(1, p1, r1) RSP_LOAD(2, p2, r2) RSP_LOAD(3, p3, r3) RSP_LOAD(4, p4, r4) RSP_LOAD(5, p5, r5) RSP_LOAD(6, p6, r6) RSP_LOAD(7, p7, r7)
#undef RSP_LOAD
#define RSP_STORE(k, pk, rk) { const int o = par + 2 * (k0 + k); if (o < nu) { const f32x4 s4 = (pk[0] + pk[1]) + (pk[2] + pk[3]); \
            const float rs = rsqrtf(((s4.x + s4.y) + (s4.z + s4.w)) * (1.0f / D) + EPS); RS[o * 256 + t] = (rk >= SEQ) ? -rs : rs; } }
        RSP_STORE(0, p0, r0) RSP_STORE(1, p1, r1) RSP_STORE(2, p2, r2) RSP_STORE(3, p3, r3) RSP_STORE(4, p4, r4) RSP_STORE(5, p5, r5) RSP_STORE(6, p6, r6) RSP_STORE(7, p7, r7)
#undef RSP_STORE
    }
    __syncthreads();
}
__device__ __forceinline__ void ph_router(const Args& a, Frame& F) {
    const bf16_t* XA = (const bf16_t*)(F.ws + WS_H); const float* SSQ = (const float*)(F.ws + WS_SSQ) + (size_t)2 * T * 16; const float* CR = (const float*)(F.ws + WS_CR);
    constexpr int RW = 1032;
    LAS bf16_t* WH = (LAS bf16_t*)F.lds; LAS bf16_t* WL = WH + 16 * RW; LAS float* LG = (LAS float*)(F.lds + 2 * 16 * RW * 2) + F.wave * 256;
    {
        f32x4 wv[2][2];
#pragma unroll
        for (int j = 0; j < 2; ++j) { const f32x4* rp = (const f32x4*)(a.router_w + (size_t)(F.tid + NTHREADS * j) * NE); wv[j][0] = rp[0]; wv[j][1] = rp[1]; }
#pragma unroll
        for (int j = 0; j < 2; ++j) { const int d = F.tid + NTHREADS * j; const float w8[8] = {wv[j][0].x, wv[j][0].y, wv[j][0].z, wv[j][0].w, wv[j][1].x, wv[j][1].y, wv[j][1].z, wv[j][1].w};
#pragma unroll
            for (int e = 0; e < 8; ++e) { const unsigned hi = f2bf(w8[e]); const float lo = w8[e] - bf2f(hi); WH[e * RW + d] = (bf16_t)hi; WL[e * RW + d] = (bf16_t)f2bf(lo); WH[(e + 8) * RW + d] = (bf16_t)0; WL[(e + 8) * RW + d] = (bf16_t)0; } }
    }
    __syncthreads();
    const int l15 = F.lane & 15, q4 = F.lane >> 4;
    LAS unsigned* cntL = (LAS unsigned*)(F.lds + 2 * 16 * RW * 2 + NWAVES * 1024); LAS unsigned* baseL = cntL + 8;
    for (int rb = F.bid * 16 * NWAVES; rb < T; rb += F.nb * 16 * NWAVES) {
        const int r0 = rb + F.wave * 16;
        if (F.tid < 8) cntL[F.tid] = 0u;
        __syncthreads();
        const bf16_t* xrow = XA + (size_t)(r0 + l15) * D + 8 * q4;
        f32x4 acc = (f32x4){0.f, 0.f, 0.f, 0.f};
#pragma unroll
        for (int kb = 0; kb < 32; kb += 8) {
            bf16x8_t av[8];
#pragma unroll
            for (int k = 0; k < 8; ++k) av[k] = *(const bf16x8_t*)(xrow + 32 * (kb + k));
#pragma unroll
            for (int k = 0; k < 8; ++k) {
                const bf16x8_t bh = *(const LAS bf16x8_t*)(WH + l15 * RW + 32 * (kb + k) + 8 * q4), bl = *(const LAS bf16x8_t*)(WL + l15 * RW + 32 * (kb + k) + 8 * q4);
                acc = __builtin_amdgcn_mfma_f32_16x16x32_bf16(av[k], bh, acc, 0, 0, 0);
                acc = __builtin_amdgcn_mfma_f32_16x16x32_bf16(av[k], bl, acc, 0, 0, 0);
            }
        }
#pragma unroll
        for (int r = 0; r < 4; ++r) LG[(4 * q4 + r) * 16 + l15] = acc[r];
        int e0 = 0, e1 = 0; unsigned k0 = 0u, k1 = 0u; float p0 = 0.f, p1 = 0.f;
        if (F.lane < 16) {
            const int row = r0 + F.lane, b = row / SEQ;
            const f32x4* sp = (const f32x4*)(SSQ + (size_t)row * 16); const f32x4 s4 = (sp[0] + sp[1]) + (sp[2] + sp[3]);
            const float rstd = rsqrtf(((s4.x + s4.y) + (s4.z + s4.w)) * (1.0f / D) + EPS);
            const f32x4 l0 = *(const LAS f32x4*)(LG + F.lane * 16), l1 = *(const LAS f32x4*)(LG + F.lane * 16 + 4);
            const float dots[8] = {l0.x, l0.y, l0.z, l0.w, l1.x, l1.y, l1.z, l1.w};
            float v0 = -INFINITY, v1 = -INFINITY;
#pragma unroll
            for (int e = 0; e < 8; ++e) { const float lg = rstd * dots[e] + CR[b * 8 + e] + a.router_b[e]; if (lg > v0) { v1 = v0; e1 = e0; v0 = lg; e0 = e; } else if (lg > v1) { v1 = lg; e1 = e; } }
            const float ex = __expf(v1 - v0); p0 = 1.0f / (1.0f + ex); p1 = ex / (1.0f + ex);
            k0 = __hip_atomic_fetch_add(cntL + e0, 1u, __ATOMIC_RELAXED, __HIP_MEMORY_SCOPE_WORKGROUP); k1 = __hip_atomic_fetch_add(cntL + e1, 1u, __ATOMIC_RELAXED, __HIP_MEMORY_SCOPE_WORKGROUP);
        }
        __syncthreads();
        if (F.tid < 8) { unsigned* cnt = (unsigned*)(F.ws + WS_CTL) + CW_MOECNT; baseL[F.tid] = atomicAdd(cnt + 64 * F.tid, cntL[F.tid]); }
        __syncthreads();
        if (F.lane < 16) {
            const int row = r0 + F.lane, q0 = (int)(baseL[e0] + k0), q1 = (int)(baseL[e1] + k1);
            int* R = (int*)(F.ws + WS_ROUTE) + (size_t)row * 4; R[0] = e0; R[1] = e1; ((float*)R)[2] = p0; ((float*)R)[3] = p1;
            int* Pq = (int*)(F.ws + WS_POS) + (size_t)row * 2; Pq[0] = q0; Pq[1] = q1;
            int* RM = (int*)(F.ws + WS_RMAP); RM[(size_t)e0 * T + q0] = row; RM[(size_t)e1 * T + q1] = row;
        }
        __syncthreads();
    }
    __syncthreads();
}

__global__ void __launch_bounds__(NTHREADS, 2) fwd(Args a) {
    extern __shared__ __attribute__((aligned(16))) unsigned char lds_raw[];
    Frame F;
    F.lds = (LAS unsigned char*)lds_raw;
    F.tid = threadIdx.x; F.lane = F.tid & 63; F.wave = __builtin_amdgcn_readfirstlane(F.tid >> 6);
    F.bid = blockIdx.x; F.nb = gridDim.x; F.gw = F.bid * NWAVES + F.wave; F.ngw = F.nb * NWAVES; F.ws = (GAS unsigned char*)a.ws;
    volatile LAS unsigned* MISC = (volatile LAS unsigned*)(F.lds + MISC_OFF);
    for (int u = F.tid; u < 32; u += NTHREADS) MISC[u] = 0u;
    __syncthreads();
    unsigned* ctl = (unsigned*)(a.ws + WS_CTL);
    const int lo = a.ph_lo, hi = a.ph_hi;
    const bool multi = (hi - lo) > 1;
    XcdBarrier bar; bar.bar = ctl + CW_BAR; bar.x = 0; bar.st = MISC + 8;
    if (multi) bar = xcd_barrier_post(ctl + CW_BAR, MISC + 8);
#define IN(k) (lo <= (k) && (k) < hi && (frame_refresh(F, a, (LAS unsigned char*)lds_raw), true))
#define SEAM(k) do { if (hi > (k) + 1 && lo <= (k)) { xcd_barrier(bar); if constexpr ((PROBE_MASK & 4194304) != 0) xcd_barrier(bar); } } while (0)
    float* MOD = (float*)(a.ws + WS_MOD);
    bf16_t* H = (bf16_t*)(a.ws + WS_H); bf16_t* PROJ = (bf16_t*)(a.ws + WS_PROJ); bf16_t* YMIX = (bf16_t*)(a.ws + WS_YMIX);
    bf16_t* WT = (bf16_t*)(a.ws + WS_WT);
    bf16_t* ACT = (bf16_t*)(a.ws + WS_ACT); bf16_t* ACTM = (bf16_t*)(a.ws + WS_ACTM); bf16_t* YMOE = (bf16_t*)(a.ws + WS_YMOE);

    if (IN(PH_PRO)) { REP(1) { ph_pro_vectors(a, F); ph_pro_weights(a, F); } SEAM(PH_PRO); }

#define TWICE(bit, stmt) do { stmt; if constexpr ((PROBE_MASK & (bit)) != 0) { stmt; } } while (0)
    float* AV = (float*)(a.ws + WS_AV); float* SSQ = (float*)(a.ws + WS_SSQ); bf16_t* X16 = (bf16_t*)(a.ws + WS_X16);
    const LAS float* RSL = (const LAS float*)(F.lds + RS_OFF);
#define LAYER_BODY(l) {\
        const int pb = PH_LAYER0 + PH_PER_LAYER * l; \
        const float* xin = (l == 0) ? a.x : a.out; \
        const float* mod0 = MOD + (size_t)(l * 2 + 0) * 2 * 3072; const float* mod1 = MOD + (size_t)(l * 2 + 1) * 2 * 3072; \
        if (l == 0) { if (IN(pb + K_NORM1)) { REP(2) ph_norm0(a, F); ph_prep_vectors(a, F); ph_scale_weights(a, F); SEAM(pb + K_NORM1); } } \
        if (IN(pb + K_GEMM_IN)) { \
            TWICE(4, ({ pg8::Gemm g{X16, WT + WT_WIN + (size_t)l * NPW * D, D}; pg8::StaticOrder S; S.init(T, NPW, F.nb, F.bid); S.bsplit = SEQ / 256; auto pre = [&]() { rstd_preload(F, S, SSQ + (size_t)(l == 0 ? 3 : 1) * T * 16, nullptr); }; \
                pg8::EpiProjNorm E{PROJ, RSL, (const float*)(a.ws + (l == 0 ? WS_CVI0 : WS_CVI)), (float*)(a.ws + WS_BG), a.dn_a_log + 4 * l, a.dn_dt_bias + 4 * l}; \
                pg8::gemm_phase<pg8::EpiProjNorm, pg8::StaticOrder, false, true, true, false, false, decltype(pre)>(F.lds, nullptr, g, S, E, pre); })); \
            SEAM(pb + K_GEMM_IN); \
        } \
        if (IN(pb + K_DN_PREP)) { REP(8) ph_dn_chunk(a, F, l); SEAM(pb + K_DN_PREP); } \
        if (IN(pb + K_MIX)) { ph_dn_scan(a, F, l); REP(512) ph_attn_mfma(a, F, l); REP(1024) ph_conv_fast(a, F, l); __syncthreads(); REP(32) ph_dn_out(a, F, l); SEAM(pb + K_MIX); } \
        if (IN(pb + K_GEMM_OUT)) { \
            TWICE(0, ({ pg8::Gemm g{YMIX, WT + WT_WOUT + (size_t)l * D * D, D}; pg8::StaticOrder S; S.init(T, D, F.nb, F.bid); \
                pg8::EpiResidNormT<(l == 1)> E{X16, X16, mod0 + 2048, AV + (size_t)(l == 0 ? 0 : 2) * BATCH * D, H, SSQ + (size_t)(l == 0 ? 0 : 2) * T * 16}; \
                pg8::gemm_phase<pg8::EpiResidNormT<(l == 1)>, pg8::StaticOrder, false, true, true>(F.lds, nullptr, g, S, E); })); \
            SEAM(pb + K_GEMM_OUT); \
        } \
        if (l == 0) { \
            if (IN(pb + K_FFN1)) { \
                TWICE(256, ({ pg8::Gemm g{X16, WT + WT_FGU, D}; pg8::StaticOrder S; S.init(T, 2 * D_FF, F.nb, F.bid); S.bsplit = SEQ / 256; auto pre = [&]() { rstd_preload(F, S, SSQ, nullptr); }; \
                    pg8::EpiSwiGLUNorm E{ACT, D_FF, 1 << 20, RSL, (const float*)(a.ws + WS_CVF), 5632}; \
                    pg8::gemm_phase<pg8::EpiSwiGLUNorm, pg8::StaticOrder, false, true, true, false, false, decltype(pre)>(F.lds, nullptr, g, S, E, pre); })); \
                SEAM(pb + K_FFN1); \
            } \
            if (IN(pb + K_FFN2)) { \
                { pg8::Gemm g{ACT, WT + WT_FD, D_FF}; pg8::StaticOrder S; S.init(T, D, F.nb, F.bid); \
                    pg8::EpiResidNormT<false> E{X16, X16, mod1 + 2048, AV + (size_t)1 * BATCH * D, H, SSQ + (size_t)1 * T * 16}; \
                    pg8::gemm_phase<pg8::EpiResidNormT<false>, pg8::StaticOrder, false, true, true>(F.lds, nullptr, g, S, E); } \
                SEAM(pb + K_FFN2); \
            } \
        } else { \
            if (IN(pb + K_NORM2)) { ph_router(a, F); SEAM(pb + K_NORM2); } \
            if (IN(pb + K_FFN1)) {   \
                { pg8::MoeOrder<8> S; moe_order_init<8>(F, S); moe_ri_preload<8>(F, S); auto pre = [&]() { rstd_preload(F, S, SSQ + (size_t)2 * T * 16, (const LAS int*)(F.lds + RI_OFF)); }; \
                    pg8::Gemm g{H, WT + WT_MGU, D}; pg8::EpiSwiGLUNormT<true> E{ACTM, D_FFE, 8, RSL, (const float*)(a.ws + WS_CVM), 16384}; \
                    pg8::gemm_phase<pg8::EpiSwiGLUNormT<true>, pg8::MoeOrder<8>, true, true, true, false, true, decltype(pre)>(F.lds, (const LAS int*)(F.lds + RI_OFF), g, S, E, pre); } \
                __syncthreads(); \
                if (F.tid == 0) { *((volatile LAS unsigned*)(F.lds + MISC_OFF) + 20) = 0u; (void)__hip_atomic_fetch_add((GAS unsigned*)(F.ws + WS_CTL) + CW_F1DONE, 1u, __ATOMIC_RELAXED, __HIP_MEMORY_SCOPE_AGENT); } \
                __syncthreads(); \
                { pg8::MoeOrder<4> S; moe_order_init<4>(F, S); \
                    if ((S.G & 7) == 0) { const int x_ = S.c & 7, W_ = S.G >> 3, r_ = S.c >> 3, nl_ = S.bt[8] > x_ ? (S.bt[8] - x_ + 7) >> 3 : 0, n1_ = nl_ * 8, i2_ = n1_ > r_ ? (n1_ - r_ + W_ - 1) / W_ : 0; \
                        S.rk = r_ + W_ * i2_ - n1_; } \
                    pg8::Gemm g{ACTM, WT + WT_MD, D_FFE}; pg8::EpiBf16W E{YMOE, D, 4}; \
                    pg8::gemm_phase<pg8::EpiBf16W, pg8::MoeOrder<4>, false, true, true, true, false>(F.lds, nullptr, g, S, E); } \
                SEAM(pb + K_FFN1); \
            } \
        } \
    }
    LAYER_BODY(0)
    LAYER_BODY(1)
#undef LAYER_BODY
    if (IN(PH_FINAL)) { ph_final(a, F); }
#undef IN
#undef SEAM
}

extern "C" void kernel_launch(void* const* d_in, const int* in_sizes, int n_in, void* d_out, int out_size, void* d_ws, size_t ws_size, hipStream_t stream) {
    static int grid = 0;
    if (grid == 0) {
        if (n_in != 27 || out_size != T * D || ws_size < WS_END) { fprintf(stderr, "kernel_launch: unexpected shapes n_in %d out %d ws %zu\n", n_in, out_size, ws_size); grid = -1; return; }
        int dev = 0, cus = 0, per_cu = 0;
        if (hipGetDevice(&dev) != hipSuccess || hipDeviceGetAttribute(&cus, hipDeviceAttributeMultiprocessorCount, dev) != hipSuccess) { grid = -1; return; }
        if (hipFuncSetAttribute((const void*)fwd, hipFuncAttributeMaxDynamicSharedMemorySize, LDS_BYTES) != hipSuccess) { fprintf(stderr, "kernel_launch: hipFuncSetAttribute failed\n"); grid = -1; return; }
        if (hipOccupancyMaxActiveBlocksPerMultiprocessor(&per_cu, (const void*)fwd, NTHREADS, LDS_BYTES) != hipSuccess || per_cu < 1) fprintf(stderr, "kernel_launch: occupancy query says %d\n", per_cu);
        (void)hipGetLastError();
        grid = cus;
    }
    if (grid < 0) return;
    (void)hipMemsetAsync((char*)d_ws + WS_CTL, 0, CTL_ZERO_BYTES, stream);
    Args a{};
    const void** pp = (const void**)&a;
    for (int i = 0; i < 27; ++i) pp[i] = d_in[i];
    a.out = (float*)d_out; a.ws = (unsigned char*)d_ws;
#if MK_ONE_LAUNCH
    a.ph_lo = 0; a.ph_hi = NPH;
    hipLaunchKernelGGL(fwd, dim3(grid), dim3(NTHREADS), LDS_BYTES, stream, a);
#else
    static const int phases[] = {0, 1, 2, 3, 4, 5, 6, 7, 9, 10, 11, 12, 13, 14, 15, 16, 17, 18, 19, 20, 21};
    for (int p : phases) { a.ph_lo = p; a.ph_hi = p + 1; hipLaunchKernelGGL(fwd, dim3(grid), dim3(NTHREADS), LDS_BYTES, stream, a); }
#endif
}
```
